# Optimizing an MI355X kernel written in HIP

```python
import jax, jax.numpy as jnp
from jax import lax
import numpy as np

D_MODEL = 4096
BATCH = 1
SEQ = 16384
DEPTH = 1
DEC_BATCH = 1
DEC_SEQ = 8192
PAST_LEN = 128

GRID_W = 64
HEAD_DIM = 128
NA_HEADS = D_MODEL // 256
NA_WIDTH = NA_HEADS * HEAD_DIM
WIN_ROWS = 8
WIN_COLS = 16
LRU_WIDTH = D_MODEL // 2
LRU_BLOCKS = 16
LRU_BLOCK_W = LRU_WIDTH // LRU_BLOCKS
CONV_W = 4
LRU_C = 8.0
D_FF = -(-8 * D_MODEL // (3 * 256)) * 256
IN_WIDTH = 3 * NA_WIDTH + 2 * LRU_WIDTH
EPS = 1e-6

kernel_name = "hybrid_natten_rglru_encoder"


def rmsnorm(x, g):
    x32 = x.astype(jnp.float32)
    y = x32 * lax.rsqrt(jnp.mean(x32 * x32, axis=-1, keepdims=True) + EPS)
    return y.astype(x.dtype) * g


def neighbourhood_attention(q, k, v, rpb):
    b, L, h, dh = q.shape
    rows = L // GRID_W
    kr = min(WIN_ROWS, rows)
    qg = q.reshape(b, rows, GRID_W, h, dh)
    kg = k.reshape(b, rows, GRID_W, h, dh)
    vg = v.reshape(b, rows, GRID_W, h, dh)
    cols = jnp.arange(GRID_W)
    col_start = jnp.clip(cols - WIN_COLS // 2, 0, GRID_W - WIN_COLS)
    col_idx = col_start[:, None] + jnp.arange(WIN_COLS)[None, :]
    dc = col_idx - cols[:, None] + (WIN_COLS - 1)
    scale = dh ** -0.5

    def row_block(args):
        r, q_row = args
        rs = jnp.clip(r - kr // 2, 0, rows - kr)
        k_rows = lax.dynamic_slice_in_dim(kg, rs, kr, axis=1)
        v_rows = lax.dynamic_slice_in_dim(vg, rs, kr, axis=1)
        k_win = k_rows[:, :, col_idx]
        v_win = v_rows[:, :, col_idx]
        dr = rs + jnp.arange(kr) - r + (WIN_ROWS - 1)
        bias = rpb[:, dr[None, :, None], dc[:, None, :]]
        s = jnp.einsum('bqhd,brqwhd->bhqrw', q_row, k_win).astype(jnp.float32) * scale
        s = s + bias.astype(jnp.float32)[None]
        p = jax.nn.softmax(s.reshape(b, h, GRID_W, kr * WIN_COLS), axis=-1)
        p = p.reshape(s.shape).astype(v.dtype)
        return jnp.einsum('bhqrw,brqwhd->bqhd', p, v_win)

    out = lax.map(row_block, (jnp.arange(rows), jnp.moveaxis(qg, 1, 0)))
    return jnp.moveaxis(out, 0, 1).reshape(b, L, h * dh)


def depthwise_conv_centred(x, w, bias):
    L = x.shape[1]
    left = CONV_W // 2
    right = CONV_W - 1 - left
    xp = jnp.pad(x, ((0, 0), (left, right), (0, 0)))
    return sum(xp[:, j:j + L] * w[j] for j in range(CONV_W)) + bias


def rg_lru_direction(x, w_r, b_r, w_i, b_i, lam, reverse):
    b, L, c = x.shape
    xb = x.reshape(b, L, LRU_BLOCKS, LRU_BLOCK_W)
    r = jax.nn.sigmoid(jnp.einsum('blnc,ncm->blnm', xb, w_r).reshape(b, L, c) + b_r)
    i = jax.nn.sigmoid(jnp.einsum('blnc,ncm->blnm', xb, w_i).reshape(b, L, c) + b_i)
    log_a = (-LRU_C * r.astype(jnp.float32)) * jax.nn.softplus(-lam.astype(jnp.float32))
    a = jnp.exp(log_a)
    mult = jnp.sqrt(-jnp.expm1(2.0 * log_a))
    first = L - 1 if reverse else 0
    is_first = (jnp.arange(L) == first)[None, :, None]
    mult = jnp.where(is_first, 1.0, mult)
    u = mult * (i * x).astype(jnp.float32)

    def combine(e1, e2):
        a1, b1 = e1
        a2, b2 = e2
        return a1 * a2, a2 * b1 + b2

    _, h = lax.associative_scan(combine, (a, u), axis=1, reverse=reverse)
    return h


def swiglu(x, w_gate, w_up, w_down):
    return (jax.nn.silu(x @ w_gate) * (x @ w_up)) @ w_down


def encoder_layer(x, w_in, w_conv, b_conv, w_rgate, b_rgate, w_igate, b_igate, lru_lambda,
                  rpb, w_na_out, w_lru_out, w_merge, b_merge, w_out,
                  g_mix_pre, g_mix_post, g_ffn_pre, g_ffn_post, w_ffn_gate, w_ffn_up, w_ffn_down):
    b, L, _ = x.shape
    xn = rmsnorm(x, g_mix_pre)
    proj = xn @ w_in
    q, k, v, xr, gr = jnp.split(
        proj, [NA_WIDTH, 2 * NA_WIDTH, 3 * NA_WIDTH, 3 * NA_WIDTH + LRU_WIDTH], axis=-1)
    q = q.reshape(b, L, NA_HEADS, HEAD_DIM)
    k = k.reshape(b, L, NA_HEADS, HEAD_DIM)
    v = v.reshape(b, L, NA_HEADS, HEAD_DIM)
    na = neighbourhood_attention(q, k, v, rpb)

    xc = depthwise_conv_centred(xr, w_conv, b_conv)
    h = (rg_lru_direction(xc, w_rgate[0], b_rgate[0], w_igate[0], b_igate[0], lru_lambda[0], False)
         + rg_lru_direction(xc, w_rgate[1], b_rgate[1], w_igate[1], b_igate[1], lru_lambda[1], True))
    lru = h.astype(x.dtype) * jax.nn.gelu(gr)

    o_na = na @ w_na_out
    o_lru = lru @ w_lru_out
    gates = jax.nn.sigmoid(xn @ w_merge + b_merge)
    g_na, g_lru = jnp.split(gates, 2, axis=-1)
    mix = (g_na * o_na + g_lru * o_lru) @ w_out
    x = x + rmsnorm(mix, g_mix_post)
    f = swiglu(rmsnorm(x, g_ffn_pre), w_ffn_gate, w_ffn_up, w_ffn_down)
    return x + rmsnorm(f, g_ffn_post)


def setup_inputs(seed: int = 0) -> dict:
    key = jax.random.key(seed)
    ks = jax.random.split(key, 24)
    f32 = jnp.float32
    n = lambda k, shape, s: jax.random.normal(k, shape, f32) * s
    u = jax.random.uniform(ks[10], (DEPTH, 2, LRU_WIDTH), f32, minval=0.9, maxval=0.999)
    a0 = u ** (1.0 / LRU_C)
    lam = jnp.log(a0) - jnp.log1p(-a0)
    return {
        "x_prompt": n(ks[0], (BATCH, SEQ, D_MODEL), 1.0),
        "x_sample": n(ks[1], (DEC_BATCH, DEC_SEQ, D_MODEL), 1.0),
        "w_in": n(ks[2], (DEPTH, D_MODEL, IN_WIDTH), D_MODEL ** -0.5),
        "w_conv": n(ks[3], (DEPTH, CONV_W, LRU_WIDTH), CONV_W ** -0.5),
        "b_conv": n(ks[4], (DEPTH, LRU_WIDTH), 0.01),
        "w_rgate": n(ks[5], (DEPTH, 2, LRU_BLOCKS, LRU_BLOCK_W, LRU_BLOCK_W), LRU_BLOCK_W ** -0.5),
        "b_rgate": n(ks[6], (DEPTH, 2, LRU_WIDTH), 0.1),
        "w_igate": n(ks[7], (DEPTH, 2, LRU_BLOCKS, LRU_BLOCK_W, LRU_BLOCK_W), LRU_BLOCK_W ** -0.5),
        "b_igate": n(ks[8], (DEPTH, 2, LRU_WIDTH), 0.1),
        "lru_lambda": lam,
        "rpb": n(ks[9], (DEPTH, NA_HEADS, 2 * WIN_ROWS - 1, 2 * WIN_COLS - 1), 0.1),
        "w_na_out": n(ks[11], (DEPTH, NA_WIDTH, D_MODEL), NA_WIDTH ** -0.5),
        "w_lru_out": n(ks[12], (DEPTH, LRU_WIDTH, D_MODEL), LRU_WIDTH ** -0.5),
        "w_merge": n(ks[13], (DEPTH, D_MODEL, 2 * D_MODEL), D_MODEL ** -0.5),
        "b_merge": n(ks[14], (DEPTH, 2 * D_MODEL), 0.1),
        "w_out": n(ks[15], (DEPTH, D_MODEL, D_MODEL), D_MODEL ** -0.5),
        "g_mix_pre": 1.0 + n(ks[16], (DEPTH, D_MODEL), 0.02),
        "g_mix_post": 1.0 + n(ks[17], (DEPTH, D_MODEL), 0.02),
        "g_ffn_pre": 1.0 + n(ks[18], (DEPTH, D_MODEL), 0.02),
        "g_ffn_post": 1.0 + n(ks[19], (DEPTH, D_MODEL), 0.02),
        "w_ffn_gate": n(ks[20], (DEPTH, D_MODEL, D_FF), D_MODEL ** -0.5),
        "w_ffn_up": n(ks[21], (DEPTH, D_MODEL, D_FF), D_MODEL ** -0.5),
        "w_ffn_down": n(ks[22], (DEPTH, D_FF, D_MODEL), D_FF ** -0.5),
    }


def reference(x_prompt, x_sample, w_in, w_conv, b_conv, w_rgate, b_rgate, w_igate, b_igate,
              lru_lambda, rpb, w_na_out, w_lru_out, w_merge, b_merge, w_out,
              g_mix_pre, g_mix_post, g_ffn_pre, g_ffn_post, w_ffn_gate, w_ffn_up, w_ffn_down):
    y_prompt = x_prompt
    y_sample = x_sample
    for l in range(DEPTH):
        params = (w_in[l], w_conv[l], b_conv[l], w_rgate[l], b_rgate[l], w_igate[l], b_igate[l],
                  lru_lambda[l], rpb[l], w_na_out[l], w_lru_out[l], w_merge[l], b_merge[l], w_out[l],
                  g_mix_pre[l], g_mix_post[l], g_ffn_pre[l], g_ffn_post[l],
                  w_ffn_gate[l], w_ffn_up[l], w_ffn_down[l])
        y_prompt = encoder_layer(y_prompt, *params)
        y_sample = encoder_layer(y_sample, *params)
    return (y_prompt, y_sample)
```

```cpp
#include <hip/hip_runtime.h>
#include <cstdio>
#include <cstdint>

#define LAS __attribute__((address_space(3)))
typedef unsigned short bf16_t;
typedef short bf16x8 __attribute__((ext_vector_type(8)));
typedef float f32x4 __attribute__((ext_vector_type(4)));
typedef float f32x2 __attribute__((ext_vector_type(2)));
typedef unsigned u32x4 __attribute__((ext_vector_type(4)));
typedef unsigned u32x2 __attribute__((ext_vector_type(2)));

constexpr int D = 4096, LP = 16384, LS = 8192, L = LP + LS;
constexpr int GRIDW = 64, HD = 128, NH = 16, NAW = 2048, LW = 2048, NBLK = 16, BW = 128, DFF = 11008, INW = 10240;
constexpr float EPS = 1e-6f;
constexpr int NWAVES = 8, NTHR = 512;

constexpr size_t MiB = 1u << 20;
constexpr size_t WS_CTL = 0, CTL_ZERO_BYTES = 64 * 1024;
constexpr size_t WS_RSTD = 1 * MiB;
constexpr size_t WS_SUM = 2 * MiB;
constexpr size_t WS_WCAT = 8 * MiB;
constexpr size_t WS_WVT = 72 * MiB;
constexpr size_t WS_W8 = 88 * MiB;
constexpr size_t WS_XN8 = 120 * MiB;
constexpr size_t WS_WNO = 216 * MiB;
constexpr size_t WS_WLO = 232 * MiB;
constexpr size_t WS_WO = 248 * MiB;
constexpr size_t WS_WGU = 280 * MiB;
constexpr size_t WS_WD = 452 * MiB;
constexpr size_t WS_WG = 538 * MiB;
constexpr size_t WS_XN = 540 * MiB;
constexpr size_t WS_Q = 732 * MiB;
constexpr size_t WS_XR = 828 * MiB;
constexpr size_t WS_K = 924 * MiB;
constexpr size_t WS_VT = 1020 * MiB;
constexpr size_t WS_GR = 1116 * MiB;
constexpr size_t WS_XC = 1212 * MiB;
constexpr size_t WS_END = 1308 * MiB;
constexpr size_t WS_T1 = WS_K;
constexpr size_t WS_MIX = WS_GR;
constexpr size_t WS_HIDS = WS_Q;
constexpr size_t WS_F = WS_K;
constexpr size_t WS_HF = WS_K;

#define LDS_WAIT() asm volatile("s_waitcnt lgkmcnt(0)" ::: "memory")
#define VM_WAIT() asm volatile("s_waitcnt vmcnt(0)" ::: "memory")
typedef __bf16 bf16x2n_t __attribute__((ext_vector_type(2)));
__device__ __forceinline__ unsigned pk2(float lo, float hi) { const bf16x2n_t r = __builtin_convertvector((f32x2){lo, hi}, bf16x2n_t); return __builtin_bit_cast(unsigned, r); }
__device__ __forceinline__ unsigned f2bf(float f) { return pk2(f, 0.f) & 0xffffu; }
__device__ __forceinline__ float bflo(unsigned u) { return __builtin_bit_cast(float, u << 16); }
__device__ __forceinline__ float bfhi(unsigned u) { return __builtin_bit_cast(float, u & 0xffff0000u); }
__device__ __forceinline__ float bf1(bf16_t u) { return __builtin_bit_cast(float, (unsigned)u << 16); }
__device__ __forceinline__ float wave_sum(float v) {
#pragma unroll
    for (int o = 1; o < 64; o <<= 1) v += __shfl_xor(v, o);
    return v;
}
__device__ __forceinline__ float wave_max(float v) {
#pragma unroll
    for (int o = 1; o < 64; o <<= 1) v = fmaxf(v, __shfl_xor(v, o));
    return v;
}
__device__ __forceinline__ float sigmoidf_(float v) { return __builtin_amdgcn_rcpf(1.0f + __expf(-v)); }
__device__ __forceinline__ float gelu_tanh(float v) { const float y = 0.7978845608f * (v + 0.044715f * v * v * v); const float e = __expf(2.0f * y); return 0.5f * v * (2.0f - 2.0f * __builtin_amdgcn_rcpf(e + 1.0f)); }

namespace pg8 {
constexpr int BM = 256, BK = 64, HALF = 128, HTB = HALF * BK * 2  , STAGE_BYTES = 8 * HTB, NXCD = 8, WGM = 8;

__host__ __device__ __forceinline__ int lds_byte(int r, int c) { return (r >> 3) * 1024 + (r & 7) * 128 + ((((c >> 3) ^ r) & 7) << 4) + (c & 7) * 2; }
__host__ __device__ __forceinline__ void stage_rc(int b, int& R, int& C) { const int ch = b >> 10, rr = (b >> 7) & 7, slot = (b >> 4) & 7; R = ch * 8 + rr; C = ((slot ^ rr) & 7) * 8; }
__host__ __device__ __forceinline__ int perm32(int rho) { const int n = rho >> 4, i = rho & 15; return 8 * (i >> 2) + 4 * n + (i & 3); }

struct Unit { int pm, pn; };
struct Gemm {
    const bf16_t* A; const bf16_t* A2; int pm_split; const bf16_t* Bt; int M, N, rb;
    __device__ __forceinline__ const char* abase(int pm) const { const size_t t = (size_t)BM * rb; return pm < pm_split ? (const char*)A + (size_t)pm * t : (const char*)A2 + (size_t)(pm - pm_split) * t; }
    __device__ __forceinline__ const char* bbase(int pn) const { return (const char*)Bt + (size_t)pn * BM * rb; }
};

struct StaticOrder {
    int nM, nN, nwg, G, c;
    __host__ __device__ void init(int M, int N, int G_, int c_) { nM = M / BM; nN = N / BM; nwg = nM * nN; G = G_; c = c_; }
    __host__ __device__ bool next(int i, Unit& u) const {
        const long Lx = (long)i * G + c; if (Lx >= nwg) return false;
        int wgid = (int)Lx; { const int q = nwg / NXCD, r = nwg % NXCD, xcd = wgid % NXCD, off = wgid / NXCD; wgid = (xcd < r ? xcd * (q + 1) : r * (q + 1) + (xcd - r) * q) + off; }
        const int nig = WGM * nN, gid = wgid / nig, fm = gid * WGM, gsz = (nM - fm) < WGM ? (nM - fm) : WGM;
        u.pm = fm + ((wgid % nig) % gsz); u.pn = (wgid % nig) / gsz; return true;
    }
    __device__ __forceinline__ void a_ready(const Unit&) const {}
    __device__ __forceinline__ void done(const Unit&) const {}
};

typedef __bf16 bf16x2_t __attribute__((ext_vector_type(2)));
__device__ __forceinline__ unsigned cvt_pk_bf16(float lo, float hi) { const bf16x2_t r = __builtin_convertvector((f32x2){lo, hi}, bf16x2_t); return __builtin_bit_cast(unsigned, r); }
__device__ __forceinline__ u32x4 pack8(const f32x4 v0, const f32x4 v1) { u32x4 w; w.x = cvt_pk_bf16(v0[0], v0[1]); w.y = cvt_pk_bf16(v0[2], v0[3]); w.z = cvt_pk_bf16(v1[0], v1[1]); w.w = cvt_pk_bf16(v1[2], v1[3]); return w; }
__device__ __forceinline__ void unpack8(const u32x4 w, f32x4& v0, f32x4& v1) { v0 = (f32x4){bflo(w.x), bfhi(w.x), bflo(w.y), bfhi(w.y)}; v1 = (f32x4){bflo(w.z), bfhi(w.z), bflo(w.w), bfhi(w.w)}; }
__device__ __forceinline__ f32x4 sig4(const f32x4 v) { f32x4 r; r[0] = sigmoidf_(v[0]); r[1] = sigmoidf_(v[1]); r[2] = sigmoidf_(v[2]); r[3] = sigmoidf_(v[3]); return r; }

struct EpiPlain {
    static constexpr bool PERM = true, AFTER_DRAIN = false;
    bf16_t* O; int ldc;
    __device__ __forceinline__ void operator()(const f32x4 (&acc)[2][2][4][2], const Unit& u, int wr, int wc, int fr, int fq) const {
        const int row0 = u.pm * BM + wr * 64 + fr, col0 = u.pn * BM + wc * 32 + 8 * fq;
#pragma unroll
        for (int ai = 0; ai < 2; ++ai)
#pragma unroll
            for (int m = 0; m < 4; ++m) { bf16_t* rowp = O + (size_t)(row0 + ai * HALF + m * 16) * ldc + col0;
#pragma unroll
                for (int bj = 0; bj < 2; ++bj) *(u32x4*)(rowp + bj * HALF) = pack8(acc[ai][bj][m][0], acc[ai][bj][m][1]); }
    }
};
struct EpiVT {
    static constexpr bool PERM = true, AFTER_DRAIN = false;
    bf16_t* O;
    __device__ __forceinline__ void operator()(const f32x4 (&acc)[2][2][4][2], const Unit& u, int wr, int wc, int fr, int fq) const {
        const int row0 = u.pm * BM + wr * 64 + fr, col0 = u.pn * BM + wc * 32 + 8 * fq;
#pragma unroll
        for (int ai = 0; ai < 2; ++ai)
#pragma unroll
            for (int m = 0; m < 4; ++m) { const int row = row0 + ai * HALF + m * 16, hh = row >> 7, d = row & 127;
                const int dt = 2 * (d >> 5) + ((d >> 2) & 1), i = 4 * ((d >> 3) & 3) + (d & 3);
#pragma unroll
                for (int bj = 0; bj < 2; ++bj) { const int tok = col0 + bj * HALF, R = tok >> 6, o = (tok & 63) >> 3;
                    *(u32x4*)(O + ((size_t)((((R * 16 + hh) * 8 + dt) * 8 + o) * 16 + i)) * 8) = pack8(acc[ai][bj][m][0], acc[ai][bj][m][1]); } }
    }
};
struct EpiProj {
    static constexpr bool PERM = true, AFTER_DRAIN = false;
    bf16_t* P0; bf16_t* P1; bf16_t* P2; bf16_t* P3; bf16_t* G; const float* bias; int pn_gate0;
    __device__ __forceinline__ void operator()(const f32x4 (&acc)[2][2][4][2], const Unit& u, int wr, int wc, int fr, int fq) const {
        const int row0 = u.pm * BM + wr * 64 + fr;
        if (u.pn < pn_gate0) {
            const int t = u.pn >> 3; bf16_t* base = t == 0 ? P0 : (t == 1 ? P1 : (t == 2 ? P2 : P3));
            const int col0 = (u.pn & 7) * BM + wc * 32 + 8 * fq;
            if (t == 2) {
#pragma unroll
                for (int ai = 0; ai < 2; ++ai)
#pragma unroll
                    for (int m = 0; m < 4; ++m) { const int tok = row0 + ai * HALF + m * 16, R = tok >> 6, cl = tok & 63;
                        const int tokpart = (((cl >> 2) & 1) * 8 + (cl >> 3)) * 4 + (cl & 3);
#pragma unroll
                        for (int bj = 0; bj < 2; ++bj) { const int c = col0 + bj * HALF, hh = c >> 7, d0 = c & 127;
                            *(u32x4*)(base + ((size_t)(((R * 16 + hh) * 4 + (d0 >> 5)) * 64 + tokpart) * 4 + ((d0 >> 3) & 3)) * 8) = pack8(acc[ai][bj][m][0], acc[ai][bj][m][1]); } }
            } else {
#pragma unroll
            for (int ai = 0; ai < 2; ++ai)
#pragma unroll
                for (int m = 0; m < 4; ++m) { bf16_t* rowp = base + (size_t)(row0 + ai * HALF + m * 16) * NAW + col0;
#pragma unroll
                    for (int bj = 0; bj < 2; ++bj) *(u32x4*)(rowp + bj * HALF) = pack8(acc[ai][bj][m][0], acc[ai][bj][m][1]); }
            }
        } else {
            const int col0 = (u.pn - pn_gate0) * BM + wc * 32 + 8 * fq;
            f32x4 bv[2][2];
#pragma unroll
            for (int bj = 0; bj < 2; ++bj)
#pragma unroll
                for (int n = 0; n < 2; ++n) bv[bj][n] = *(const f32x4*)(bias + col0 + bj * HALF + 4 * n);
#pragma unroll
            for (int ai = 0; ai < 2; ++ai)
#pragma unroll
                for (int m = 0; m < 4; ++m) { bf16_t* rowp = G + (size_t)(row0 + ai * HALF + m * 16) * (2 * D) + col0;
#pragma unroll
                    for (int bj = 0; bj < 2; ++bj) *(u32x4*)(rowp + bj * HALF) = pack8(sig4(acc[ai][bj][m][0] + bv[bj][0]), sig4(acc[ai][bj][m][1] + bv[bj][1])); }
        }
    }
};
template <bool ADD> struct EpiMulG {
    static constexpr bool PERM = true, AFTER_DRAIN = false;
    bf16_t* O; const bf16_t* G; int goff;
    __device__ __forceinline__ void operator()(const f32x4 (&acc)[2][2][4][2], const Unit& u, int wr, int wc, int fr, int fq) const {
        const int row0 = u.pm * BM + wr * 64 + fr, col0 = u.pn * BM + wc * 32 + 8 * fq;
#pragma unroll
        for (int ai = 0; ai < 2; ++ai)
#pragma unroll
            for (int m = 0; m < 4; ++m) { const size_t row = (size_t)(row0 + ai * HALF + m * 16); bf16_t* rowp = O + row * D + col0; const bf16_t* gp = G + row * (2 * D) + goff + col0;
#pragma unroll
                for (int bj = 0; bj < 2; ++bj) {
                    f32x4 g0, g1; unpack8(*(const u32x4*)(gp + bj * HALF), g0, g1);
                    f32x4 v0 = acc[ai][bj][m][0] * g0, v1 = acc[ai][bj][m][1] * g1;
                    if (ADD) { f32x4 t0, t1; unpack8(*(const u32x4*)(rowp + bj * HALF), t0, t1); v0 += t0; v1 += t1; }
                    *(u32x4*)(rowp + bj * HALF) = pack8(v0, v1); } }
    }
};
struct EpiSwiglu {
    static constexpr bool PERM = true, AFTER_DRAIN = false;
    bf16_t* H0; bf16_t* H1; int pm_split;
    __device__ __forceinline__ void operator()(const f32x4 (&acc)[2][2][4][2], const Unit& u, int wr, int wc, int fr, int fq) const {
        bf16_t* base = u.pm < pm_split ? H0 + (size_t)u.pm * BM * DFF : H1 + (size_t)(u.pm - pm_split) * BM * DFF;
        const int row0 = wr * 64 + fr, col0 = u.pn * HALF + wc * 32 + 8 * fq;
#pragma unroll
        for (int ai = 0; ai < 2; ++ai)
#pragma unroll
            for (int m = 0; m < 4; ++m) {
                f32x4 h[2];
#pragma unroll
                for (int n = 0; n < 2; ++n) { const f32x4 g = acc[ai][0][m][n], up = acc[ai][1][m][n];
#pragma unroll
                    for (int j = 0; j < 4; ++j) h[n][j] = g[j] * sigmoidf_(g[j]) * up[j]; }
                *(u32x4*)(base + (size_t)(row0 + ai * HALF + m * 16) * DFF + col0) = pack8(h[0], h[1]); }
    }
};

typedef int v8i32 __attribute__((ext_vector_type(8)));
typedef int v4i32 __attribute__((ext_vector_type(4)));
__device__ __forceinline__ v8i32 cat8(const bf16x8 lo, const bf16x8 hi) { return __builtin_shufflevector(__builtin_bit_cast(v4i32, lo), __builtin_bit_cast(v4i32, hi), 0, 1, 2, 3, 4, 5, 6, 7); }
__device__ __forceinline__ void mfma_fp8_acc(f32x4& c, const v8i32 a, const v8i32 b, int sa, int sb) {
    asm volatile("v_mfma_scale_f32_16x16x128_f8f6f4 %0, %1, %2, %0, %3, %4 op_sel_hi:[0,0,0]" : "+v"(c) : "v"(a), "v"(b), "v"(sa), "v"(sb)); }
constexpr int FP8_SCALE = 0x73737373;
template <class Epi, class Sched, bool ALIGN_EPI = false, bool SP2 = false, bool FP8 = false, int DBG = 0>
__device__ __forceinline__ void gemm_phase(LAS unsigned char* lds, const Gemm g, const Sched& S, const Epi& E) {
    const int tid = threadIdx.x, wid = __builtin_amdgcn_readfirstlane(tid >> 6), lane = tid & 63, wr = wid >> 2, wc = wid & 3, fr = lane & 15, fq = lane >> 4;
    const int RB = g.rb, nt = RB / (BK * 2);
    unsigned voffA[2], voffB[2];
#pragma unroll
    for (int i = 0; i < 2; ++i) { int R, C; stage_rc(tid * 16 + i * 8192, R, C); const int Rb = Epi::PERM ? ((R & ~31) + perm32(R & 31)) : R;
        voffA[i] = (unsigned)(R * RB + C * 2); voffB[i] = (unsigned)(Rb * RB + C * 2); }
    const size_t kstep = (size_t)(BK * 2);
    const size_t hstep = (size_t)HALF * RB;
    const unsigned ldsw = (unsigned)wid * 1024u;
    const int aoff0 = lds_byte(wr * 64 + fr, fq * 8), aoff1 = lds_byte(wr * 64 + fr, 32 + fq * 8), boff0 = lds_byte(wc * 32 + fr, fq * 8), boff1 = lds_byte(wc * 32 + fr, 32 + fq * 8);
#define PG8_SA(b, h) (((b) * 2 + (h)) * HTB)
#define PG8_SB(b, h) ((4 + (b) * 2 + (h)) * HTB)
#define PG8_STAGE(bufoff, gbase, voff) do { if constexpr (DBG != 3) _Pragma("unroll") for (int _i = 0; _i < 2; ++_i) \
        __builtin_amdgcn_global_load_lds((const unsigned*)((const char*)(gbase) + (voff)[_i]), (LAS unsigned*)(lds + (bufoff) + ldsw + _i * 8192), 16, 0, 0); } while (0)
#define PG8_LDA(dst, b, h) do { if constexpr (DBG != 2) _Pragma("unroll") for (int m = 0; m < 4; ++m) _Pragma("unroll") for (int k = 0; k < 2; ++k) dst[m][k] = *(const LAS bf16x8*)(lds + PG8_SA(b, h) + (k ? aoff1 : aoff0) + m * 2048); } while (0)
#define PG8_LDB(dst, b, h) do { if constexpr (DBG != 2) _Pragma("unroll") for (int n = 0; n < 2; ++n) _Pragma("unroll") for (int k = 0; k < 2; ++k) dst[n][k] = *(const LAS bf16x8*)(lds + PG8_SB(b, h) + (k ? boff1 : boff0) + n * 2048); } while (0)
#define PG8_MMA(ai, bj, At, Bt) do { __builtin_amdgcn_s_setprio(1); if constexpr (DBG == 1) { } else if constexpr (FP8) { _Pragma("unroll") for (int m = 0; m < 4; ++m) _Pragma("unroll") for (int n = 0; n < 2; ++n) \
        mfma_fp8_acc(acc[ai][bj][m][n], cat8(Bt[n][0], Bt[n][1]), cat8(At[m][0], At[m][1]), fp8_sa, fp8_sb); } else { \
        _Pragma("unroll") for (int m = 0; m < 4; ++m) _Pragma("unroll") for (int n = 0; n < 2; ++n) _Pragma("unroll") for (int k = 0; k < 2; ++k) \
        acc[ai][bj][m][n] = __builtin_amdgcn_mfma_f32_16x16x32_bf16(Bt[n][k], At[m][k], acc[ai][bj][m][n], 0, 0, 0); } __builtin_amdgcn_s_setprio(0); } while (0)
#define PG8_WAIT_V(n) asm volatile("s_waitcnt vmcnt(" #n ")" ::: "memory")
#define PG8_WAIT_L(n) asm volatile("s_waitcnt lgkmcnt(" #n ")" ::: "memory")
#define PG8_BAR __builtin_amdgcn_s_barrier()
#define PG8_SCHED __builtin_amdgcn_sched_barrier(0)
    Unit cur, nxt; int ui = 0;
    const int fp8_sa = FP8_SCALE, fp8_sb = 0x7F7F7F7F;
    if (!S.next(0, cur)) return;
    f32x4 acc[2][2][4][2];
#pragma unroll
    for (int a = 0; a < 2; ++a)
#pragma unroll
        for (int b = 0; b < 2; ++b)
#pragma unroll
            for (int m = 0; m < 4; ++m)
#pragma unroll
                for (int n = 0; n < 2; ++n) acc[a][b][m][n] = (f32x4){0.f, 0.f, 0.f, 0.f};
    bf16x8 At[4][2], B0[2][2], B1[2][2];
    const char* cA = g.abase(cur.pm); const char* cB = g.bbase(cur.pn);
    S.a_ready(cur);
    if constexpr (SP2) {
        PG8_STAGE(PG8_SB(0, 0), cB, voffB); PG8_STAGE(PG8_SB(0, 1), cB + hstep, voffB); PG8_STAGE(PG8_SA(0, 0), cA, voffA); PG8_STAGE(PG8_SA(0, 1), cA + hstep, voffA);
        if (wr == 1) PG8_BAR;
        PG8_WAIT_V(2); PG8_BAR;
        PG8_STAGE(PG8_SB(1, 0), cB + kstep, voffB); PG8_STAGE(PG8_SA(1, 0), cA + kstep, voffA); PG8_STAGE(PG8_SB(1, 1), cB + hstep + kstep, voffB);
        PG8_WAIT_V(6); PG8_BAR;
    } else {
        PG8_STAGE(PG8_SB(0, 0), cB, voffB); PG8_STAGE(PG8_SA(0, 0), cA, voffA); PG8_STAGE(PG8_SB(0, 1), cB + hstep, voffB); PG8_STAGE(PG8_SA(0, 1), cA + hstep, voffA);
        if (wr == 1) PG8_BAR;
        PG8_WAIT_V(4); PG8_BAR;
        PG8_STAGE(PG8_SB(1, 0), cB + kstep, voffB); PG8_STAGE(PG8_SA(1, 0), cA + kstep, voffA); PG8_STAGE(PG8_SB(1, 1), cB + hstep + kstep, voffB);
        PG8_WAIT_V(6); PG8_BAR;
    }
    for (;;) {
        const bool has_next = S.next(ui + 1, nxt);
        const char* nA = has_next ? g.abase(nxt.pm) : cA; const char* nB = has_next ? g.bbase(nxt.pn) : cB;
        for (int t = 0; t < nt; t += 2) {
            const bool last = (t == nt - 2);
            const char* a1 = cA + (size_t)(t + 1) * kstep;
            const char* a2 = last ? nA : cA + (size_t)(t + 2) * kstep; const char* b2 = last ? nB : cB + (size_t)(t + 2) * kstep;
            const char* a3 = a2 + kstep; const char* b3 = b2 + kstep;
            if (last && has_next) S.a_ready(nxt);
            if constexpr (SP2) {
            PG8_LDB(B0, 0, 0); PG8_LDB(B1, 0, 1); PG8_SCHED; PG8_LDA(At, 0, 0); PG8_STAGE(PG8_SA(1, 1), a1 + hstep, voffA);
            PG8_WAIT_V(8); PG8_WAIT_L(0); PG8_BAR; PG8_MMA(0, 0, At, B0); PG8_MMA(0, 1, At, B1); PG8_BAR; PG8_SCHED;
            PG8_LDA(At, 0, 1); PG8_STAGE(PG8_SB(0, 0), b2, voffB); PG8_STAGE(PG8_SB(0, 1), b2 + hstep, voffB); PG8_STAGE(PG8_SA(0, 0), a2, voffA);
            PG8_WAIT_V(8); PG8_WAIT_L(0); PG8_BAR; PG8_MMA(1, 0, At, B0); PG8_MMA(1, 1, At, B1); PG8_BAR; PG8_SCHED;
            PG8_LDB(B0, 1, 0); PG8_LDB(B1, 1, 1); PG8_SCHED; PG8_LDA(At, 1, 0); PG8_STAGE(PG8_SA(0, 1), a2 + hstep, voffA);
            PG8_WAIT_V(8); PG8_WAIT_L(0); PG8_BAR; PG8_MMA(0, 0, At, B0); PG8_MMA(0, 1, At, B1); PG8_BAR; PG8_SCHED;
            PG8_LDA(At, 1, 1); PG8_STAGE(PG8_SB(1, 0), b3, voffB); PG8_STAGE(PG8_SB(1, 1), b3 + hstep, voffB); PG8_STAGE(PG8_SA(1, 0), a3, voffA);
            PG8_WAIT_V(8); PG8_WAIT_L(0); PG8_BAR; PG8_MMA(1, 0, At, B0); PG8_MMA(1, 1, At, B1); PG8_BAR; PG8_SCHED;
            } else {
            PG8_LDB(B0, 0, 0); PG8_SCHED; PG8_LDA(At, 0, 0); PG8_STAGE(PG8_SA(1, 1), a1 + hstep, voffA);
            PG8_WAIT_L(8); PG8_BAR; PG8_WAIT_L(0); PG8_MMA(0, 0, At, B0); PG8_BAR; PG8_SCHED;
            PG8_LDB(B1, 0, 1); PG8_STAGE(PG8_SB(0, 0), b2, voffB);
            PG8_BAR; PG8_WAIT_L(0); PG8_MMA(0, 1, At, B1); PG8_BAR;
            PG8_LDA(At, 0, 1); PG8_STAGE(PG8_SA(0, 0), a2, voffA);
            PG8_BAR; PG8_WAIT_L(0); PG8_MMA(1, 0, At, B0); PG8_BAR; PG8_SCHED;
            PG8_STAGE(PG8_SB(0, 1), b2 + hstep, voffB);
            PG8_WAIT_V(6); PG8_BAR; PG8_MMA(1, 1, At, B1); PG8_BAR;
            PG8_LDB(B0, 1, 0); PG8_SCHED; PG8_LDA(At, 1, 0); PG8_STAGE(PG8_SA(0, 1), a2 + hstep, voffA);
            PG8_WAIT_L(8); PG8_BAR; PG8_WAIT_L(0); PG8_MMA(0, 0, At, B0); PG8_BAR; PG8_SCHED;
            PG8_LDB(B1, 1, 1); PG8_STAGE(PG8_SB(1, 0), b3, voffB);
            PG8_BAR; PG8_WAIT_L(0); PG8_MMA(0, 1, At, B1); PG8_BAR;
            PG8_LDA(At, 1, 1); PG8_STAGE(PG8_SA(1, 0), a3, voffA);
            PG8_BAR; PG8_WAIT_L(0); PG8_MMA(1, 0, At, B0); PG8_BAR; PG8_SCHED;
            PG8_STAGE(PG8_SB(1, 1), b3 + hstep, voffB);
            PG8_WAIT_V(6); PG8_BAR; PG8_MMA(1, 1, At, B1); PG8_BAR;
            }
        }
        if constexpr (ALIGN_EPI) { if (wr == 0) PG8_BAR; }
        if constexpr (!Epi::AFTER_DRAIN) { if constexpr (DBG != 4) E(acc, cur, wr, wc, fr, fq); else { _Pragma("unroll") for (int a_ = 0; a_ < 2; ++a_) _Pragma("unroll") for (int b_ = 0; b_ < 2; ++b_) _Pragma("unroll") for (int m_ = 0; m_ < 4; ++m_) _Pragma("unroll") for (int n_ = 0; n_ < 2; ++n_) asm volatile("" :: "v"(acc[a_][b_][m_][n_])); } S.done(cur); }
        if (!has_next) break;
#pragma unroll
        for (int a = 0; a < 2; ++a)
#pragma unroll
            for (int b = 0; b < 2; ++b)
#pragma unroll
                for (int m = 0; m < 4; ++m)
#pragma unroll
                    for (int n = 0; n < 2; ++n) acc[a][b][m][n] = (f32x4){0.f, 0.f, 0.f, 0.f};
        cur = nxt; cA = nA; cB = nB; ++ui;
        if constexpr (ALIGN_EPI) { if (wr == 1) PG8_BAR; }
    }
    PG8_WAIT_V(0);
    if constexpr (!ALIGN_EPI) { if (wr == 0) PG8_BAR; }
    PG8_BAR;
    if constexpr (Epi::AFTER_DRAIN) { E.fused(acc, cur, wr, wc, fr, fq, lds, wid, lane); S.done(cur); }
#undef PG8_SA
#undef PG8_SB
#undef PG8_STAGE
#undef PG8_LDA
#undef PG8_LDB
#undef PG8_MMA
#undef PG8_WAIT_V
#undef PG8_WAIT_L
#undef PG8_BAR
#undef PG8_SCHED
}
}
#define XB_TMO      128
#define XB_XCNT(j)  (256  + 64 * (j))
#define XB_XSUB(j)  (1280 + 64 * (j))
#define XB_XGEN(j)  (2304 + 64 * (j))
#define XB_TOP      3328
#define XB_TOPGEN   3392
#define XCD_BAR_WORDS 3456
#define XB_SPIN_CAP (1u << 18)

__device__ __forceinline__ unsigned xb_ld(unsigned* p)              { return __hip_atomic_load(p, __ATOMIC_RELAXED, __HIP_MEMORY_SCOPE_AGENT); }
__device__ __forceinline__ unsigned xb_add(unsigned* p, unsigned v) { return __hip_atomic_fetch_add(p, v, __ATOMIC_RELAXED, __HIP_MEMORY_SCOPE_AGENT); }
__device__ __forceinline__ unsigned xb_xcc_id() { return (unsigned)__builtin_amdgcn_s_getreg((3 << 11) | 20) & 0xFu; }
#define XB_SPIN(cond, bar) do { unsigned _sp = 0; while (cond) { __builtin_amdgcn_s_sleep(1); \
    if ((++_sp & 255u) == 0u) { if (xb_ld(&(bar)[XB_TMO])) break; if (_sp > XB_SPIN_CAP) { atomicAdd(&(bar)[XB_TMO], 1u); break; } } } } while (0)

struct XcdBarrier {
    unsigned* bar; unsigned x;
    volatile LAS unsigned* st;
};

__device__ __forceinline__ XcdBarrier xcd_barrier_post(unsigned* bar, volatile LAS unsigned* st) {
    XcdBarrier b; b.bar = bar; b.x = xb_xcc_id(); b.st = st;
    if (threadIdx.x == 0) (void)xb_add(&bar[XB_XCNT(b.x)], 1u);
    return b;
}
__device__ __forceinline__ void xcd_barrier_complete(unsigned* bar, unsigned x, unsigned& nloc, unsigned& nx) {
    const unsigned G = gridDim.x * gridDim.y * gridDim.z;
    unsigned sum, cnt, mine, sp = 0u;
    for (;;) {
        sum = 0u; cnt = 0u; mine = 0u;
#pragma unroll
        for (unsigned j = 0; j < 16; ++j) { const unsigned c = xb_ld(&bar[XB_XCNT(j)]); sum += c; cnt += (c > 0u) ? 1u : 0u; mine = (j == x) ? c : mine; }
        if (sum == G) break;
        __builtin_amdgcn_s_sleep(1);
        if ((++sp & 255u) == 0u) { if (xb_ld(&bar[XB_TMO])) break; if (sp > XB_SPIN_CAP) { atomicAdd(&bar[XB_TMO], 1u); break; } }
    }
    nloc = mine > 0u ? mine : 1u; nx = cnt > 0u ? cnt : 1u;
}

__device__ __forceinline__ void xcd_barrier(const XcdBarrier& b) {
    asm volatile("s_waitcnt vmcnt(0)" ::: "memory");
    __syncthreads();
    if (threadIdx.x == 0) {
        unsigned* bar = b.bar;
        __builtin_amdgcn_s_waitcnt(0);
        unsigned nloc = b.st[0], nx = b.st[1];
        if (nloc == 0u) { xcd_barrier_complete(bar, b.x, nloc, nx); b.st[0] = nloc; b.st[1] = nx; }
        const unsigned old = xb_add(&bar[XB_XSUB(b.x)], 1u);
        const unsigned gen = old / nloc;
        if (old + 1u == (gen + 1u) * nloc) {
            __builtin_amdgcn_fence(__ATOMIC_RELEASE, "agent");
            asm volatile("s_waitcnt vmcnt(0)" ::: "memory");
            const unsigned og = xb_add(&bar[XB_TOP], 1u);
            const unsigned tg = og / nx;
            if (og + 1u == (tg + 1u) * nx) xb_add(&bar[XB_TOPGEN], 1u);
            else XB_SPIN(xb_ld(&bar[XB_TOPGEN]) == tg, bar);
            __builtin_amdgcn_fence(__ATOMIC_ACQUIRE, "agent");
            xb_add(&bar[XB_XGEN(b.x)], 1u);
            asm volatile("s_waitcnt vmcnt(0)" ::: "memory");
        } else {
            XB_SPIN(xb_ld(&bar[XB_XGEN(b.x)]) == gen, bar);
            __builtin_amdgcn_fence(__ATOMIC_ACQUIRE, "agent");
            asm volatile("s_waitcnt vmcnt(0)" ::: "memory");
        }
    }
    __syncthreads();
}


struct Frame {
    LAS unsigned char* lds;
    int tid, lane, wave, G, gw, ngw;
    const float *in_XP, *in_XS, *in_WIN, *in_WCONV, *in_BCONV, *in_WR, *in_BR, *in_WI, *in_BI, *in_LAM, *in_RPB, *in_WNO, *in_WLO, *in_WM, *in_BM, *in_WOUT, *in_GMPRE, *in_GMPOST, *in_GFPRE, *in_GFPOST, *in_WFG, *in_WFU, *in_WFD; float* out; unsigned char* ws;
};
enum { I_XP = 0, I_XS, I_WIN, I_WCONV, I_BCONV, I_WR, I_BR, I_WI, I_BI, I_LAM, I_RPB, I_WNO, I_WLO, I_WM, I_BM, I_WOUT, I_GMPRE, I_GMPOST, I_GFPRE, I_GFPOST, I_WFG, I_WFU, I_WFD };
__device__ __forceinline__ int opaque(int x) { asm volatile("" : "+v"(x)); return x; }
template <class T> __device__ __forceinline__ T* wsp(const Frame& F, size_t off) { return (T*)(F.ws + off); }
__device__ __forceinline__ const float* xrow(const Frame& F, int m) { return m < LP ? F.in_XP + (size_t)m * D : F.in_XS + (size_t)(m - LP) * D; }

__device__ __forceinline__ void tr_item(const float* src, int ldsrc, int k0, int n0, bf16_t* dst, int ldd, int drow0, LAS float* scr, int lane) {
#pragma unroll 8
    for (int i = 0; i < 32; ++i) { const int kk = 2 * i + (lane >> 5); scr[kk * 33 + (lane & 31)] = src[(size_t)(k0 + kk) * ldsrc + n0 + (lane & 31)]; }
    LDS_WAIT(); asm volatile("" ::: "memory");
    const int c = lane & 7;
#pragma unroll
    for (int j = 0; j < 4; ++j) { const int n = (lane >> 3) + 8 * j; const LAS float* s = scr + (8 * c) * 33 + n;
        u32x4 o; o.x = pk2(s[0 * 33], s[1 * 33]); o.y = pk2(s[2 * 33], s[3 * 33]); o.z = pk2(s[4 * 33], s[5 * 33]); o.w = pk2(s[6 * 33], s[7 * 33]);
        *(u32x4*)(dst + (size_t)(drow0 + n) * ldd + k0 + 8 * c) = o; }
    LDS_WAIT(); asm volatile("" ::: "memory");
}
__device__ __forceinline__ unsigned pk4_fp8(float a, float b, float c, float d) { int p = __builtin_amdgcn_cvt_pk_fp8_f32(a, b, 0, false); p = __builtin_amdgcn_cvt_pk_fp8_f32(c, d, p, true); return (unsigned)p; }
__device__ __forceinline__ void tr_item8(const float* src, int ldsrc, int k0, int n0, unsigned char* dst, int ldd, int drow0, LAS float* scr, int lane) {
#pragma unroll 8
    for (int i = 0; i < 32; ++i) { const int kk = 2 * i + (lane >> 5); scr[kk * 33 + (lane & 31)] = src[(size_t)(k0 + kk) * ldsrc + n0 + (lane & 31)]; }
    LDS_WAIT(); asm volatile("" ::: "memory");
    const int c = lane & 7;
#pragma unroll
    for (int j = 0; j < 4; ++j) { const int n = (lane >> 3) + 8 * j; const LAS float* s = scr + (8 * c) * 33 + n;
        u32x2 o; o.x = pk4_fp8(s[0 * 33] * 256.f, s[1 * 33] * 256.f, s[2 * 33] * 256.f, s[3 * 33] * 256.f); o.y = pk4_fp8(s[4 * 33] * 256.f, s[5 * 33] * 256.f, s[6 * 33] * 256.f, s[7 * 33] * 256.f);
        *(u32x2*)(dst + (size_t)(drow0 + n) * ldd + k0 + 8 * c) = o; }
    LDS_WAIT(); asm volatile("" ::: "memory");
}
#define TR_JOB(SRC, LDSRC, KK, NN, DST, DROW_EXPR) { const int nblk = (NN) / 32, nit = ((KK) / 64) * nblk; \
    if (r < nit) { const int kb = r / nblk, nb = r % nblk, n0 = 32 * nb; tr_item((SRC), (LDSRC), 64 * kb, n0, (DST), (KK), (DROW_EXPR), scr, F.lane); continue; } r -= nit; }
#define TR_JOB8(SRC, LDSRC, KK, NN, DST, DROW_EXPR) { const int nblk = (NN) / 32, nit = ((KK) / 64) * nblk; \
    if (r < nit) { const int kb = r / nblk, nb = r % nblk, n0 = 32 * nb; tr_item8((SRC), (LDSRC), 64 * kb, n0, (DST), (KK), (DROW_EXPR), scr, F.lane); continue; } r -= nit; }

__device__ __forceinline__ void p0_prologue(Frame& F) {
    const int tid_ = opaque(F.tid);
    LAS float* scr = (LAS float*)(F.lds + F.wave * 8448);
    const float* w_in = F.in_WIN;
    bf16_t* WCAT = wsp<bf16_t>(F, WS_WCAT); unsigned char* W8 = wsp<unsigned char>(F, WS_W8); bf16_t* WVT = wsp<bf16_t>(F, WS_WVT); bf16_t* WGU = wsp<bf16_t>(F, WS_WGU);
    constexpr int NSM = 64;
    constexpr int IT_SM = 2 * 4;
    constexpr int N_BIG = 5 * (D / 64) * (NAW / 32) + (D / 64) * (2 * D / 32) + 2 * (NAW / 64) * (D / 32) + (D / 64) * (D / 32) + 2 * (D / 64) * (DFF / 32) + (DFF / 64) * (D / 32);
    constexpr int NITEMS = N_BIG + NSM * IT_SM;
    for (int it = F.gw; it < NITEMS; it += F.ngw) {
        int r = it;
        TR_JOB(w_in + 0, INW, D, NAW, WCAT, 0 + n0)
        TR_JOB(w_in + 3 * NAW, INW, D, NAW, WCAT, 2048 + n0)
        TR_JOB(w_in + NAW, INW, D, NAW, WCAT, 4096 + n0)
        TR_JOB(w_in + 4 * NAW, INW, D, NAW, WCAT, 6144 + n0)
        TR_JOB8(F.in_WM, 2 * D, D, 2 * D, W8, n0)
        TR_JOB(w_in + 2 * NAW, INW, D, NAW, WVT, n0)
        TR_JOB(F.in_WNO, D, NAW, D, wsp<bf16_t>(F, WS_WNO), n0)
        TR_JOB(F.in_WLO, D, LW, D, wsp<bf16_t>(F, WS_WLO), n0)
        TR_JOB(F.in_WOUT, D, D, D, wsp<bf16_t>(F, WS_WO), n0)
        TR_JOB(F.in_WFG, DFF, D, DFF, WGU, (n0 >> 7) * 256 + (n0 & 127))
        TR_JOB(F.in_WFU, DFF, D, DFF, WGU, (n0 >> 7) * 256 + 128 + (n0 & 127))
        TR_JOB(F.in_WFD, D, DFF, D, wsp<bf16_t>(F, WS_WD), n0)
        {
            const int mi = r / IT_SM, ri = r % IT_SM, d = mi >> 5, g = (mi >> 4) & 1, n = mi & 15, kb = ri >> 2, nb = ri & 3;
            const float* src = (g ? F.in_WI : F.in_WR) + (size_t)(d * NBLK + n) * BW * BW;
            tr_item(src, BW, 64 * kb, 32 * nb, wsp<bf16_t>(F, WS_WG) + (size_t)mi * BW * BW, BW, 32 * nb, scr, F.lane);
        }
    }
    LAS f32x4* gl = (LAS f32x4*)(F.lds + 69632);
    for (int i = tid_; i < D / 4; i += NTHR) gl[i] = ((const f32x4*)F.in_GMPRE)[i];
    __syncthreads();
    bf16_t* XN = wsp<bf16_t>(F, WS_XN); unsigned char* XN8 = wsp<unsigned char>(F, WS_XN8);
    for (int m = F.gw; m < L; m += F.ngw) {
        asm volatile("" ::: "memory");
        const f32x4* xr = (const f32x4*)xrow(F, m) + F.lane;
        f32x4 v[16]; float s = 0.f;
#pragma unroll
        for (int j = 0; j < 16; ++j) { v[j] = xr[64 * j]; s += (v[j].x * v[j].x + v[j].y * v[j].y) + (v[j].z * v[j].z + v[j].w * v[j].w); }
        const float rstd = 1.0f / sqrtf(wave_sum(s) * (1.0f / D) + EPS);
        u32x2* o8 = (u32x2*)(XN + (size_t)m * D) + F.lane; unsigned* o4 = (unsigned*)(XN8 + (size_t)m * D) + F.lane;
#pragma unroll
        for (int j = 0; j < 16; ++j) { const f32x4 g = gl[F.lane + 64 * j]; const f32x4 y = v[j] * rstd * g; u32x2 o; o.x = pk2(y.x, y.y); o.y = pk2(y.z, y.w); o8[64 * j] = o;
            o4[64 * j] = pk4_fp8(y.x * 16.f, y.y * 16.f, y.z * 16.f, y.w * 16.f); }
    }
    __syncthreads();
}

#ifndef ATT_SYNC
#define ATT_SYNC 1
#endif
template <int ADBG = 0> __device__ __forceinline__ void attn_mfma(Frame& F) {
    const int tid_ = opaque(F.tid);
    bf16_t* Q = wsp<bf16_t>(F, WS_Q); const bf16_t* Kb = wsp<bf16_t>(F, WS_K); const bf16_t* VT = wsp<bf16_t>(F, WS_VT);
    LAS float* rp = (LAS float*)F.lds;
    for (int i = tid_; i < NH * 15 * 31; i += NTHR) rp[i] = F.in_RPB[i];
    __syncthreads();
    const int fr = F.lane & 15, fq = F.lane >> 4;
    const float scale = 0.08838834764831845f;
    for (int item = F.gw; item < (L / GRIDW) * NH * 4; item += F.ngw) {
        asm volatile("" ::: "memory");
        const int g = item & 3, h = (item >> 2) & 15, rg = item >> 6;
        const int s0 = rg < LP / GRIDW ? 0 : LP, rows = rg < LP / GRIDW ? LP / GRIDW : LS / GRIDW, r = rg < LP / GRIDW ? rg : rg - LP / GRIDW;
        int rs = r - 4; rs = rs < 0 ? 0 : (rs > rows - 8 ? rows - 8 : rs);
        const int w0 = g == 0 ? 0 : (g == 1 ? 8 : (g == 2 ? 24 : 32));
        const int c = 16 * g + fr;
        int cs = c - 8; cs = cs < 0 ? 0 : (cs > GRIDW - 16 ? GRIDW - 16 : cs);
        bf16_t* qrow = Q + (size_t)(s0 + r * GRIDW + c) * NAW + h * HD;
        bf16x8 qf[4];
#pragma unroll
        for (int s = 0; s < 4; ++s) qf[s] = *(const bf16x8*)(qrow + 8 * fq + 32 * s);
        f32x4 sacc[8][2];
        const int Rg = s0 / GRIDW + rs, p0 = w0 >> 3;
        const bf16_t* kbase = Kb + (size_t)(Rg * 16 + h) * 8192 + p0 * 128 + fr * 32 + fq * 8;
        bf16x8 kb[8][2][4];
#define ATT_LDK(kr) do { _Pragma("unroll") for (int T = 0; T < 2; ++T) _Pragma("unroll") for (int s = 0; s < 4; ++s) kb[kr][T][s] = (ADBG & 1) ? qf[s] : (ADBG & 4) ? *(const bf16x8*)(Kb + (size_t)(s0 + rs * GRIDW) * NAW + h * HD * GRIDW + ((kr) * 8 + T * 4 + s) * 512 + F.lane * 8) : *(const bf16x8*)(kbase + (size_t)(kr) * (16 * 8192) + (s * 2 + T) * 1024); } while (0)
        ATT_LDK(0); ATT_LDK(1);
#pragma unroll
        for (int kr = 0; kr < 8; ++kr) {
            if (ATT_SYNC && (kr & 1) == 0) __builtin_amdgcn_s_barrier();
            if (kr + 2 < 8) ATT_LDK(kr + 2);
            __builtin_amdgcn_sched_barrier(0);
#pragma unroll
            for (int T = 0; T < 2; ++T) { f32x4 a = (f32x4){0.f, 0.f, 0.f, 0.f};
#pragma unroll
                for (int s = 0; s < 4; ++s) a = __builtin_amdgcn_mfma_f32_16x16x32_bf16(kb[kr][T][s], qf[s], a, 0, 0, 0);
                sacc[kr][T] = a; }
            __builtin_amdgcn_sched_barrier(0);
        }
#undef ATT_LDK
        bf16x8 vb[8][8];
        const bf16_t* vbase = VT + (size_t)(Rg * 16 + h) * 8192 + p0 * 128 + fq * 128 + fr * 8;
#define ATT_LDV(kr) do { _Pragma("unroll") for (int dt = 0; dt < 8; ++dt) vb[kr][dt] = (ADBG & 2) ? qf[dt & 3] : (ADBG & 4) ? *(const bf16x8*)(VT + (size_t)(h * HD) * L + s0 + rs * GRIDW + ((kr) * 8 + dt) * 512 + F.lane * 8) : *(const bf16x8*)(vbase + (size_t)(kr) * (16 * 8192) + dt * 1024); } while (0)
        ATT_LDV(0); ATT_LDV(1);
        __builtin_amdgcn_sched_barrier(0);
        const int elo = cs - w0 - 8 * fq, dc0 = w0 + 8 * fq - c + 15;
        const LAS float* rph = rp + h * 465 + (rs - r + 7) * 31;
        float mx = -3.0e38f;
#pragma unroll
        for (int e = 0; e < 8; ++e) { const bool valid = (e >= elo) && (e < elo + 16); const int bi = valid ? dc0 + e : 0;
#pragma unroll
            for (int kr = 0; kr < 8; ++kr) { const float sv = valid ? sacc[kr][e >> 2][e & 3] * scale + rph[kr * 31 + bi] : -3.0e38f; sacc[kr][e >> 2][e & 3] = sv; mx = fmaxf(mx, sv); } }
        mx = fmaxf(mx, __shfl_xor(mx, 16)); mx = fmaxf(mx, __shfl_xor(mx, 32));
        float lsum = 0.f; bf16x8 pf[8];
#pragma unroll
        for (int kr = 0; kr < 8; ++kr) { float p[8];
#pragma unroll
            for (int e = 0; e < 8; ++e) { p[e] = __expf(sacc[kr][e >> 2][e & 3] - mx); lsum += p[e]; }
            u32x4 w; w.x = pk2(p[0], p[1]); w.y = pk2(p[2], p[3]); w.z = pk2(p[4], p[5]); w.w = pk2(p[6], p[7]);
            pf[kr] = __builtin_bit_cast(bf16x8, w); }
        lsum += __shfl_xor(lsum, 16); lsum += __shfl_xor(lsum, 32);
        f32x4 oacc[8];
#pragma unroll
        for (int dt = 0; dt < 8; ++dt) oacc[dt] = (f32x4){0.f, 0.f, 0.f, 0.f};
#pragma unroll
        for (int kr = 0; kr < 8; ++kr) {
            if (ATT_SYNC && (kr & 1) == 0) __builtin_amdgcn_s_barrier();
            if (kr + 2 < 8) ATT_LDV(kr + 2);
            __builtin_amdgcn_sched_barrier(0);
#pragma unroll
            for (int dt = 0; dt < 8; ++dt) oacc[dt] = __builtin_amdgcn_mfma_f32_16x16x32_bf16(vb[kr][dt], pf[kr], oacc[dt], 0, 0, 0);
            __builtin_amdgcn_sched_barrier(0);
        }
#undef ATT_LDV
        const float inv = 1.0f / lsum;
#ifdef ATTN_OUT_OFF
        bf16_t* orow = wsp<bf16_t>(F, (size_t)ATTN_OUT_OFF * MiB) + (size_t)(s0 + r * GRIDW + c) * NAW + h * HD;
#else
        bf16_t* orow = qrow;
#endif
#pragma unroll
        for (int u = 0; u < 4; ++u) *(u32x4*)(orow + 32 * u + 8 * fq) = pg8::pack8(oacc[2 * u] * inv, oacc[2 * u + 1] * inv);
    }
    __syncthreads();
}

__device__ __forceinline__ void conv_phase(Frame& F) {
    const int tid_ = opaque(F.tid);
    const bf16_t* XR = wsp<bf16_t>(F, WS_XR); bf16_t* XC = wsp<bf16_t>(F, WS_XC);
    const float* wc = F.in_WCONV; const float* bc = F.in_BCONV;
    const int nth = F.G * NTHR;
    for (int it = blockIdx.x * NTHR + tid_; it < L * (LW / 8); it += nth) {
        const int t = it / (LW / 8), c0 = (it % (LW / 8)) * 8;
        const int s0 = t < LP ? 0 : LP, len = t < LP ? LP : LS, tl = t - s0;
        float acc[8];
#pragma unroll
        for (int e = 0; e < 8; ++e) acc[e] = bc[c0 + e];
#pragma unroll
        for (int j = 0; j < 4; ++j) { const int tt = tl + j - 2; if (tt < 0 || tt >= len) continue;
            f32x4 x0, x1; pg8::unpack8(*(const u32x4*)(XR + (size_t)(s0 + tt) * LW + c0), x0, x1);
            const f32x4 w0 = *(const f32x4*)(wc + j * LW + c0), w1 = *(const f32x4*)(wc + j * LW + c0 + 4);
#pragma unroll
            for (int e = 0; e < 4; ++e) { acc[e] += w0[e] * x0[e]; acc[4 + e] += w1[e] * x1[e]; } }
        *(u32x4*)(XC + (size_t)t * LW + c0) = pg8::pack8((f32x4){acc[0], acc[1], acc[2], acc[3]}, (f32x4){acc[4], acc[5], acc[6], acc[7]});
    }
}

struct LruW { bf16x8 w[2][4]; float br, bi, cl; };
template <int DIR> __device__ __forceinline__ void lru_load_w(const Frame& F, LruW& W, int n, int w, int fr, int fq) {
    const bf16_t* wg = wsp<bf16_t>(F, WS_WG);
#pragma unroll
    for (int g = 0; g < 2; ++g)
#pragma unroll
        for (int s = 0; s < 4; ++s) W.w[g][s] = *(const bf16x8*)(wg + ((size_t)((DIR * 2 + g) * NBLK + n) * BW + 16 * w + fr) * BW + 32 * fq + 8 * s);
    const int ch = n * BW + 16 * w + fr;
    W.br = F.in_BR[DIR * LW + ch]; W.bi = F.in_BI[DIR * LW + ch];
    const float lam = F.in_LAM[DIR * LW + ch];
    W.cl = -8.0f * ((lam > 15.f) ? __expf(-lam) : log1pf(__expf(-lam)));
}
template <int LDBG = 0> __device__ __forceinline__ void lru_gate(float pr, float pi, float xc, const LruW& W, bool first, float& a, float& u) {
    if constexpr (LDBG == 1) { a = pr + W.br; u = pi * xc + W.bi; return; }
    const float r = sigmoidf_(pr + W.br), ig = sigmoidf_(pi + W.bi);
    a = __expf(W.cl * r);
    const float mult = first ? 1.0f : __builtin_amdgcn_sqrtf(fmaxf(1.0f - a * a, 0.f));
    u = mult * ig * xc;
}
struct LruX { bf16x8 x[4][4]; };
__device__ __forceinline__ void lru_load_x(LruX& X, const bf16_t* XC, int tb, int n, int fr, int fq) {
#pragma unroll
    for (int tau = 0; tau < 4; ++tau) { const bf16_t* xp = XC + ((size_t)((((tb >> 6) * NBLK + n) * 4 + tau) * 4) * 64 + fr * 4 + fq) * 8;
#pragma unroll
        for (int s = 0; s < 4; ++s) X.x[tau][s] = *(const bf16x8*)(xp + s * 512); }
}
__device__ __forceinline__ void lru_tile(const LruX& X, int tau, bool hiw, const LruW& W, const bf16x8 idf0, const bf16x8 idf1, f32x4& pr, f32x4& pi, f32x4& xct) {
    pr = (f32x4){0.f, 0.f, 0.f, 0.f}; pi = pr;
#pragma unroll
    for (int s = 0; s < 4; ++s) { pr = __builtin_amdgcn_mfma_f32_16x16x32_bf16(X.x[tau][s], W.w[0][s], pr, 0, 0, 0); pi = __builtin_amdgcn_mfma_f32_16x16x32_bf16(X.x[tau][s], W.w[1][s], pi, 0, 0, 0); }
    const bf16x8 x0 = hiw ? X.x[tau][2] : X.x[tau][0], x1 = hiw ? X.x[tau][3] : X.x[tau][1];
    xct = __builtin_amdgcn_mfma_f32_16x16x32_bf16(x0, idf0, (f32x4){0.f, 0.f, 0.f, 0.f}, 0, 0, 0);
    xct = __builtin_amdgcn_mfma_f32_16x16x32_bf16(x1, idf1, xct, 0, 0, 0);
}
__device__ __forceinline__ void lru_idfrags(int w, int fr, int fq, bf16x8& idf0, bf16x8& idf1) {
#pragma unroll
    for (int e = 0; e < 8; ++e) { const bool on = (fq == (w >> 1)) && ((fr & 7) == e); idf0[e] = (on && fr < 8) ? (short)0x3F80 : (short)0; idf1[e] = (on && fr >= 8) ? (short)0x3F80 : (short)0; }
}
constexpr int LRU_CH = 256, LRU_NCH = L / LRU_CH, LRU_NCH_P = LP / LRU_CH;
__device__ __forceinline__ void conv_unit(Frame& F, int cg, int n) {
    const int tid_ = opaque(F.tid);
    const bf16_t* XR = wsp<bf16_t>(F, WS_XR); bf16_t* XC = wsp<bf16_t>(F, WS_XC);
    const float* wc = F.in_WCONV; const float* bc = F.in_BCONV;
    const int c0 = n * BW + (tid_ & 15) * 8;
    const int s0 = cg < LRU_NCH_P ? 0 : LP, len = cg < LRU_NCH_P ? LP : LS;
    f32x4 w[4][2]; f32x4 b0 = *(const f32x4*)(bc + c0), b1 = *(const f32x4*)(bc + c0 + 4);
#pragma unroll
    for (int j = 0; j < 4; ++j) { w[j][0] = *(const f32x4*)(wc + j * LW + c0); w[j][1] = *(const f32x4*)(wc + j * LW + c0 + 4); }
#pragma unroll
    for (int i = 0; i < 8; ++i) {
        const int t = cg * LRU_CH + (tid_ >> 4) + 32 * i, tl = t - s0;
        f32x4 a0 = b0, a1 = b1;
#pragma unroll
        for (int j = 0; j < 4; ++j) { const int tt = tl + j - 2; if (tt < 0 || tt >= len) continue;
            f32x4 x0, x1; pg8::unpack8(*(const u32x4*)(XR + (size_t)(s0 + tt) * LW + c0), x0, x1); a0 += w[j][0] * x0; a1 += w[j][1] * x1; }
        const int tg = t & 63, cq = tid_ & 15;
        *(u32x4*)(XC + ((size_t)(((((t >> 6) * NBLK + n) * 4 + ((tg >> 2) & 3)) * 4 + (cq & 3)) * 16 + 4 * (tg >> 4) + (tg & 3)) * 4 + (cq >> 2)) * 8) = pg8::pack8(a0, a1);
    }
}
__device__ __forceinline__ void lru_pass_a(Frame& F) {
    const int fr = F.lane & 15, fq = F.lane >> 4, w = F.wave;
    const bf16_t* XC = wsp<bf16_t>(F, WS_XC); f32x2* SUMM = wsp<f32x2>(F, WS_SUM);
    bf16x8 idf0, idf1; lru_idfrags(w, fr, fq, idf0, idf1);
    for (int u = blockIdx.x; u < LRU_NCH * NBLK; u += F.G) {
        const int cg = u >> 4, n = u & 15;
        conv_unit(F, cg, n); VM_WAIT(); __syncthreads();
        LruW Wf, Wb; lru_load_w<0>(F, Wf, n, w, fr, fq); lru_load_w<1>(F, Wb, n, w, fr, fq);
        const bool c_first = (cg == 0 || cg == LRU_NCH_P), c_last = (cg == LRU_NCH_P - 1 || cg == LRU_NCH - 1);
        float Af = 1.f, Hf = 0.f, Ab = 1.f, Hb = 0.f;
        LruX X, Xn; lru_load_x(X, XC, cg * LRU_CH, n, fr, fq);
        for (int gi = 0; gi < 4; ++gi) {
            if (gi < 3) lru_load_x(Xn, XC, cg * LRU_CH + (gi + 1) * 64, n, fr, fq);
            float pf = 1.f, hf = 0.f, pb = 1.f, hb = 0.f;
#pragma unroll
            for (int tau = 0; tau < 4; ++tau) {
                f32x4 prf, pif, prb, pib, xct, xct2;
                lru_tile(X, tau, (w & 1) != 0, Wf, idf0, idf1, prf, pif, xct);
                lru_tile(X, tau, (w & 1) != 0, Wb, idf0, idf1, prb, pib, xct2);
#pragma unroll
                for (int j = 0; j < 4; ++j) {
                    float a, uu;
                    lru_gate(prf[j], pif[j], xct[j], Wf, c_first && gi == 0 && fq == 0 && tau == 0 && j == 0, a, uu); hf = a * hf + uu; pf *= a;
                    lru_gate(prb[j], pib[j], xct[j], Wb, c_last && gi == 3 && fq == 3 && tau == 3 && j == 3, a, uu); hb += pb * uu; pb *= a;
                }
            }
            float gPf = 1.f, gHf = 0.f, gPb = 1.f, gHb = 0.f;
#pragma unroll
            for (int qq = 0; qq < 4; ++qq) { const int src = fr + 16 * qq;
                float P = __shfl(pf, src), H = __shfl(hf, src); gHf = P * gHf + H; gPf *= P;
                P = __shfl(pb, src); H = __shfl(hb, src); gHb += gPb * H; gPb *= P; }
            Hf = gPf * Hf + gHf; Af *= gPf; Hb += Ab * gHb; Ab *= gPb;
            X = Xn;
        }
        if (fq == 0) { const int ch = n * BW + 16 * w + fr; SUMM[(size_t)(cg * 2 + 0) * LW + ch] = (f32x2){Af, Hf}; SUMM[(size_t)(cg * 2 + 1) * LW + ch] = (f32x2){Ab, Hb}; }
    }
}
__device__ __forceinline__ void lru_pass_b(Frame& F) {
    const int tid_ = opaque(F.tid);
    const int gt = blockIdx.x * NTHR + tid_; if (gt >= 4 * LW) return;
    const int ch = gt % LW, d = (gt / LW) & 1, seq = gt / (2 * LW), c0 = seq ? LRU_NCH_P : 0, nc = seq ? LRU_NCH - LRU_NCH_P : LRU_NCH_P;
    const f32x2* SUMM = wsp<f32x2>(F, WS_SUM); float* CIN = wsp<float>(F, WS_SUM + 4 * MiB);
    float s = 0.f;
    for (int i0 = 0; i0 < nc; i0 += 8) {
        f32x2 ah[8];
#pragma unroll
        for (int e = 0; e < 8; ++e) { const int cg = d ? c0 + nc - 1 - (i0 + e) : c0 + i0 + e; ah[e] = SUMM[(size_t)(cg * 2 + d) * LW + ch]; }
#pragma unroll
        for (int e = 0; e < 8; ++e) { const int cg = d ? c0 + nc - 1 - (i0 + e) : c0 + i0 + e; CIN[(size_t)(cg * 2 + d) * LW + ch] = s; s = ah[e].x * s + ah[e].y; }
    }
}
template <int LDBG = 0> __device__ __forceinline__ void lru_pass_c(Frame& F) {
    const int tid_ = opaque(F.tid);
    const int fr = F.lane & 15, fq = F.lane >> 4, w = F.wave;
    const bf16_t* XC = wsp<bf16_t>(F, WS_XC); const float* CIN = wsp<float>(F, WS_SUM + 4 * MiB);
    const bf16_t* GR = wsp<bf16_t>(F, WS_GR); bf16_t* LRU = wsp<bf16_t>(F, WS_XR);
    LAS bf16_t* hfb = (LAS bf16_t*)(F.lds + w * 8192);
    LAS bf16_t* grt = (LAS bf16_t*)(F.lds + 65536);
    bf16x8 idf0, idf1; lru_idfrags(w, fr, fq, idf0, idf1);
    for (int u = blockIdx.x; u < LRU_NCH * NBLK; u += F.G) {
        const int cg = u >> 4, n = u & 15, ch = n * BW + 16 * w + fr;
        const bool c_first = (cg == 0 || cg == LRU_NCH_P), c_last = (cg == LRU_NCH_P - 1 || cg == LRU_NCH - 1);
        { const bf16_t* gsrc = GR + (size_t)(cg * LRU_CH + (tid_ >> 4)) * LW + n * BW + (tid_ & 15) * 8; LAS bf16_t* ldst = grt + w * 512;
#pragma unroll 1
          for (int k = 0; k < 8; ++k) { __builtin_amdgcn_global_load_lds((const unsigned*)gsrc, (LAS unsigned*)ldst, 16, 0, 0); gsrc += (size_t)32 * LW; ldst += NTHR * 8; } }
        {
            LruW W; lru_load_w<0>(F, W, n, w, fr, fq);
            float s = CIN[(size_t)(cg * 2 + 0) * LW + ch];
            LruX X, Xn; lru_load_x(X, XC, cg * LRU_CH, n, fr, fq);
            for (int gi = 0; gi < 4; ++gi) {
                if (gi < 3 && LDBG != 2) lru_load_x(Xn, XC, cg * LRU_CH + (gi + 1) * 64, n, fr, fq);
                float a[16], uu[16];
#pragma unroll
                for (int tau = 0; tau < 4; ++tau) { f32x4 pr, pi, xct; lru_tile(X, tau, (w & 1) != 0, W, idf0, idf1, pr, pi, xct);
#pragma unroll
                    for (int j = 0; j < 4; ++j) lru_gate<LDBG>(pr[j], pi[j], xct[j], W, c_first && gi == 0 && fq == 0 && tau == 0 && j == 0, a[4 * tau + j], uu[4 * tau + j]); }
                float p = 1.f, h = 0.f;
#pragma unroll
                for (int t = 0; t < 16; ++t) { h = a[t] * h + uu[t]; p *= a[t]; }
                float hin = s, sg = s;
#pragma unroll
                for (int qq = 0; qq < 4; ++qq) { const float P = __shfl(p, fr + 16 * qq), H = __shfl(h, fr + 16 * qq); sg = P * sg + H; if (qq < fq) hin = P * hin + H; }
                s = sg;
                float hh = hin;
#pragma unroll
                for (int t = 0; t < 16; ++t) { hh = a[t] * hh + uu[t]; hfb[(gi * 64 + 16 * fq + t) * 16 + fr] = (bf16_t)f2bf(hh); }
                X = Xn;
            }
        }
        VM_WAIT(); __syncthreads();
        {
            LruW W; lru_load_w<1>(F, W, n, w, fr, fq);
            float s = CIN[(size_t)(cg * 2 + 1) * LW + ch];
            LruX X, Xn; lru_load_x(X, XC, cg * LRU_CH + 3 * 64, n, fr, fq);
            for (int gi = 3; gi >= 0; --gi) {
                if (gi > 0 && LDBG != 2) lru_load_x(Xn, XC, cg * LRU_CH + (gi - 1) * 64, n, fr, fq);
                float a[16], uu[16];
#pragma unroll
                for (int tau = 0; tau < 4; ++tau) { f32x4 pr, pi, xct; lru_tile(X, tau, (w & 1) != 0, W, idf0, idf1, pr, pi, xct);
#pragma unroll
                    for (int j = 0; j < 4; ++j) lru_gate<LDBG>(pr[j], pi[j], xct[j], W, c_last && gi == 3 && fq == 3 && tau == 3 && j == 3, a[4 * tau + j], uu[4 * tau + j]); }
                float p = 1.f, h = 0.f;
#pragma unroll
                for (int t = 15; t >= 0; --t) { h = a[t] * h + uu[t]; p *= a[t]; }
                float hin = s, sg = s;
#pragma unroll
                for (int qq = 3; qq >= 0; --qq) { const float P = __shfl(p, fr + 16 * qq), H = __shfl(h, fr + 16 * qq); sg = P * sg + H; if (qq > fq) hin = P * hin + H; }
                s = sg;
                float hh = hin;
#pragma unroll
                for (int t = 15; t >= 0; --t) { hh = a[t] * hh + uu[t];
                    const int tl = gi * 64 + 16 * fq + t; LAS bf16_t* gp = grt + tl * BW + 16 * w + fr;
                    *gp = (bf16_t)f2bf((bf1(hfb[tl * 16 + fr]) + hh) * gelu_tanh(bf1(*gp))); }
                X = Xn;
            }
        }
        LDS_WAIT(); __syncthreads();
        { bf16_t* gdst = LRU + (size_t)(cg * LRU_CH + (tid_ >> 4)) * LW + n * BW + (tid_ & 15) * 8; const LAS bf16_t* lsrc = grt + tid_ * 8;
#pragma unroll 1
          for (int k = 0; k < 8; ++k) { *(u32x4*)gdst = *(const LAS u32x4*)lsrc; gdst += (size_t)32 * LW; lsrc += NTHR * 8; } }
        LDS_WAIT(); __syncthreads();
    }
}

__device__ __forceinline__ f32x4 up4(const u32x2 u) { return (f32x4){bflo(u.x), bfhi(u.x), bflo(u.y), bfhi(u.y)}; }
__device__ __forceinline__ void mid_phase(Frame& F) {
    const int tid_ = opaque(F.tid);
    const bf16_t* MIX = wsp<bf16_t>(F, WS_MIX); bf16_t* XN = wsp<bf16_t>(F, WS_XN); float* RSTD = wsp<float>(F, WS_RSTD);
    LAS f32x4* gpost = (LAS f32x4*)F.lds; LAS f32x4* gpre = gpost + D / 4;
    for (int i = tid_; i < D / 4; i += NTHR) { gpost[i] = ((const f32x4*)F.in_GMPOST)[i]; gpre[i] = ((const f32x4*)F.in_GFPRE)[i]; }
    __syncthreads();
    for (int m = F.gw; m < L; m += F.ngw) {
        asm volatile("" ::: "memory");
        const f32x4* xr = (const f32x4*)xrow(F, m) + F.lane; const u32x2* mr = (const u32x2*)(MIX + (size_t)m * D) + F.lane;
        f32x4 v[16]; u32x2 mx[16]; float s = 0.f;
#pragma unroll
        for (int j = 0; j < 16; ++j) { v[j] = xr[64 * j]; mx[j] = mr[64 * j]; const f32x4 a = up4(mx[j]); s += (a.x * a.x + a.y * a.y) + (a.z * a.z + a.w * a.w); }
        const float rstd1 = 1.0f / sqrtf(wave_sum(s) * (1.0f / D) + EPS);
        if (F.lane == 0) RSTD[m] = rstd1;
        float s2 = 0.f;
#pragma unroll
        for (int j = 0; j < 16; ++j) { v[j] = v[j] + up4(mx[j]) * rstd1 * gpost[F.lane + 64 * j]; s2 += (v[j].x * v[j].x + v[j].y * v[j].y) + (v[j].z * v[j].z + v[j].w * v[j].w); }
        const float rstd2 = 1.0f / sqrtf(wave_sum(s2) * (1.0f / D) + EPS);
        u32x2* o8 = (u32x2*)(XN + (size_t)m * D) + F.lane;
#pragma unroll
        for (int j = 0; j < 16; ++j) { const f32x4 g = gpre[F.lane + 64 * j]; u32x2 o; o.x = pk2(v[j].x * rstd2 * g.x, v[j].y * rstd2 * g.y); o.y = pk2(v[j].z * rstd2 * g.z, v[j].w * rstd2 * g.w); o8[64 * j] = o; }
    }
    __syncthreads();
}
__device__ __forceinline__ void final_phase(Frame& F) {
    const int tid_ = opaque(F.tid);
    const bf16_t* MIX = wsp<bf16_t>(F, WS_MIX); const bf16_t* FB = wsp<bf16_t>(F, WS_F); const float* RSTD = wsp<float>(F, WS_RSTD);
    LAS f32x4* gpost = (LAS f32x4*)F.lds; LAS f32x4* gfp = gpost + D / 4;
    for (int i = tid_; i < D / 4; i += NTHR) { gpost[i] = ((const f32x4*)F.in_GMPOST)[i]; gfp[i] = ((const f32x4*)F.in_GFPOST)[i]; }
    __syncthreads();
    for (int m = F.gw; m < L; m += F.ngw) {
        asm volatile("" ::: "memory");
        const f32x4* xr = (const f32x4*)xrow(F, m) + F.lane; const u32x2* mr = (const u32x2*)(MIX + (size_t)m * D) + F.lane; const u32x2* fr = (const u32x2*)(FB + (size_t)m * D) + F.lane;
        const float rstd1 = RSTD[m];
        u32x2 fx[16]; float s = 0.f;
#pragma unroll
        for (int j = 0; j < 16; ++j) { fx[j] = fr[64 * j]; const f32x4 a = up4(fx[j]); s += (a.x * a.x + a.y * a.y) + (a.z * a.z + a.w * a.w); }
        const float rstd3 = 1.0f / sqrtf(wave_sum(s) * (1.0f / D) + EPS);
        f32x4* o = (f32x4*)(F.out + (size_t)m * D) + F.lane;
#pragma unroll
        for (int j = 0; j < 16; ++j) o[64 * j] = xr[64 * j] + up4(mr[64 * j]) * rstd1 * gpost[F.lane + 64 * j] + up4(fx[j]) * rstd3 * gfp[F.lane + 64 * j];
    }
}

constexpr int LDS_STAGE = pg8::STAGE_BYTES;
constexpr int LDS_MISC = LDS_STAGE;
constexpr int LDS_BYTES = LDS_STAGE + 1024;
#ifndef MK_N_LAUNCHES
#define MK_N_LAUNCHES 1
#endif
constexpr int NPHASE = 11;
struct Args { const float* in[23]; float* out; unsigned char* ws; int ph_lo, ph_hi; };

__global__ void __launch_bounds__(NTHR, 2) fwd_kernel(Args args) {
    extern __shared__ __attribute__((aligned(16))) unsigned char lds_raw[];
    Frame F;
    F.lds = (LAS unsigned char*)lds_raw;
    F.tid = threadIdx.x; F.lane = (int)__builtin_amdgcn_mbcnt_hi(~0u, __builtin_amdgcn_mbcnt_lo(~0u, 0u)); F.wave = __builtin_amdgcn_readfirstlane(F.tid >> 6);
    F.G = gridDim.x; F.gw = blockIdx.x * NWAVES + F.wave; F.ngw = F.G * NWAVES;
    F.in_XP = args.in[0]; F.in_XS = args.in[1]; F.in_WIN = args.in[2]; F.in_WCONV = args.in[3]; F.in_BCONV = args.in[4]; F.in_WR = args.in[5]; F.in_BR = args.in[6]; F.in_WI = args.in[7]; F.in_BI = args.in[8]; F.in_LAM = args.in[9]; F.in_RPB = args.in[10]; F.in_WNO = args.in[11]; F.in_WLO = args.in[12]; F.in_WM = args.in[13]; F.in_BM = args.in[14]; F.in_WOUT = args.in[15]; F.in_GMPRE = args.in[16]; F.in_GMPOST = args.in[17]; F.in_GFPRE = args.in[18]; F.in_GFPOST = args.in[19]; F.in_WFG = args.in[20]; F.in_WFU = args.in[21]; F.in_WFD = args.in[22];
    F.out = args.out; F.ws = args.ws;
    volatile LAS unsigned* MISC = (volatile LAS unsigned*)(F.lds + LDS_MISC);
    if (F.tid < 256) MISC[F.tid] = 0u;
    __syncthreads();
    const int lo = args.ph_lo, hi = args.ph_hi;
    const bool fused = (hi - lo) > 1;
    XcdBarrier bar; bar.bar = (unsigned*)(F.ws + WS_CTL); bar.x = 0; bar.st = nullptr;
    if (fused) bar = xcd_barrier_post((unsigned*)(F.ws + WS_CTL), MISC + 8);
#ifndef PH_MASK
#define PH_MASK 0x7ff
#endif
#define IN(k) (((PH_MASK >> (k)) & 1) && lo <= (k) && (k) < hi)
#define SEAM(k) do { if (IN(k) && IN((k) + 1)) xcd_barrier(bar); } while (0)
    LAS unsigned char* stage = F.lds;

#ifdef ATTN_OUT_OFF
#define NA_BUF ((size_t)ATTN_OUT_OFF * MiB)
#else
#define NA_BUF WS_Q
#endif
#ifndef DUP_MASK
#define DUP_MASK 0
#endif
#define RUN(k, ...) if (IN(k)) { __VA_ARGS__ if (((DUP_MASK) >> (k)) & 1) { __VA_ARGS__ } }
    RUN(0, { p0_prologue(F); }) SEAM(0);
    RUN(1, {
        { pg8::Gemm g{wsp<bf16_t>(F, WS_XN), wsp<bf16_t>(F, WS_XN), 1 << 30, wsp<bf16_t>(F, WS_WCAT), L, 4 * NAW, 2 * D}; pg8::StaticOrder S; S.init(L, 4 * NAW, F.G, (int)blockIdx.x);
          pg8::EpiProj E{wsp<bf16_t>(F, WS_Q), wsp<bf16_t>(F, WS_XR), wsp<bf16_t>(F, WS_K), wsp<bf16_t>(F, WS_GR), (bf16_t*)F.out, F.in_BM, 1 << 30};
          pg8::gemm_phase<pg8::EpiProj, pg8::StaticOrder, true, true, false>(stage, g, S, E); }
        { pg8::Gemm g{wsp<bf16_t>(F, WS_XN8), wsp<bf16_t>(F, WS_XN8), 1 << 30, wsp<bf16_t>(F, WS_W8), L, 2 * D, D}; pg8::StaticOrder S; S.init(L, 2 * D, F.G, (int)blockIdx.x);
          pg8::EpiProj E{wsp<bf16_t>(F, WS_Q), wsp<bf16_t>(F, WS_XR), wsp<bf16_t>(F, WS_K), wsp<bf16_t>(F, WS_GR), (bf16_t*)F.out, F.in_BM, 0};
          pg8::gemm_phase<pg8::EpiProj, pg8::StaticOrder, true, true, true>(stage, g, S, E); }
        { pg8::Gemm g{wsp<bf16_t>(F, WS_WVT), wsp<bf16_t>(F, WS_WVT), 1 << 30, wsp<bf16_t>(F, WS_XN), NAW, L, 2 * D}; pg8::StaticOrder S; S.init(NAW, L, F.G, (int)blockIdx.x);
          pg8::EpiVT E{wsp<bf16_t>(F, WS_VT)};
          pg8::gemm_phase<pg8::EpiVT, pg8::StaticOrder, true, true, false>(stage, g, S, E); }
    }) SEAM(1);
    RUN(2, { lru_pass_a(F); }) SEAM(2);
    #ifdef ATTN_OUT_OFF
    if (IN(3)) { lru_pass_b(F); } SEAM(3);
    if (IN(4)) { lru_pass_c<0>(F); xcd_barrier(bar); if (ATTN_DUP) attn_mfma<ATTN_DUP - 1>(F); attn_mfma<0>(F); } SEAM(4);
#else
    if (IN(3)) { lru_pass_b(F); attn_mfma<0>(F); } SEAM(3);
#ifdef LRUC_DBG
    if (IN(4)) { lru_pass_c<LRUC_DBG>(F); lru_pass_c<0>(F); } SEAM(4);
#else
    RUN(4, { lru_pass_c<0>(F); }) SEAM(4);
#endif
#endif
    if (IN(5)) {
        { pg8::Gemm g{wsp<bf16_t>(F, NA_BUF), wsp<bf16_t>(F, NA_BUF), 1 << 30, wsp<bf16_t>(F, WS_WNO), L, D, 2 * NAW}; pg8::StaticOrder S; S.init(L, D, F.G, (int)blockIdx.x);
          pg8::EpiMulG<false> E{wsp<bf16_t>(F, WS_T1), (const bf16_t*)F.out, 0};
          pg8::gemm_phase<pg8::EpiMulG<false>, pg8::StaticOrder, true, true>(stage, g, S, E); }
        { pg8::Gemm g{wsp<bf16_t>(F, WS_XR), wsp<bf16_t>(F, WS_XR), 1 << 30, wsp<bf16_t>(F, WS_WLO), L, D, 2 * LW}; pg8::StaticOrder S; S.init(L, D, F.G, (int)blockIdx.x);
          pg8::EpiMulG<true> E{wsp<bf16_t>(F, WS_T1), (const bf16_t*)F.out, D};
          pg8::gemm_phase<pg8::EpiMulG<true>, pg8::StaticOrder, true, true>(stage, g, S, E); }
    } SEAM(5);
    RUN(6, {
        pg8::Gemm g{wsp<bf16_t>(F, WS_T1), wsp<bf16_t>(F, WS_T1), 1 << 30, wsp<bf16_t>(F, WS_WO), L, D, 2 * D}; pg8::StaticOrder S; S.init(L, D, F.G, (int)blockIdx.x);
        pg8::EpiPlain E{wsp<bf16_t>(F, WS_MIX), D};
        pg8::gemm_phase<pg8::EpiPlain, pg8::StaticOrder, true, true>(stage, g, S, E);
    }) SEAM(6);
    RUN(7, { mid_phase(F); }) SEAM(7);
#ifdef GEMM_DBG
    if (IN(8)) {
        pg8::Gemm g{wsp<bf16_t>(F, WS_XN), wsp<bf16_t>(F, WS_XN), 1 << 30, wsp<bf16_t>(F, WS_WGU), L, 2 * DFF, 2 * D}; pg8::StaticOrder S; S.init(L, 2 * DFF, F.G, (int)blockIdx.x);
        pg8::EpiSwiglu E{(bf16_t*)F.out, wsp<bf16_t>(F, WS_HIDS), LP / 256};
        pg8::gemm_phase<pg8::EpiSwiglu, pg8::StaticOrder, true, true, false, GEMM_DBG>(stage, g, S, E);
    }
#endif
    RUN(8, {
        pg8::Gemm g{wsp<bf16_t>(F, WS_XN), wsp<bf16_t>(F, WS_XN), 1 << 30, wsp<bf16_t>(F, WS_WGU), L, 2 * DFF, 2 * D}; pg8::StaticOrder S; S.init(L, 2 * DFF, F.G, (int)blockIdx.x);
        pg8::EpiSwiglu E{(bf16_t*)F.out, wsp<bf16_t>(F, WS_HIDS), LP / 256};
        pg8::gemm_phase<pg8::EpiSwiglu, pg8::StaticOrder, false, true>(stage, g, S, E);
    }) SEAM(8);
    RUN(9, {
        pg8::Gemm g{(const bf16_t*)F.out, wsp<bf16_t>(F, WS_HIDS), LP / 256, wsp<bf16_t>(F, WS_WD), L, D, 2 * DFF}; pg8::StaticOrder S; S.init(L, D, F.G, (int)blockIdx.x);
        pg8::EpiPlain E{wsp<bf16_t>(F, WS_F), D};
        pg8::gemm_phase<pg8::EpiPlain, pg8::StaticOrder, true, true>(stage, g, S, E);
    }) SEAM(9);
    RUN(10, { final_phase(F); })
#undef RUN
#undef IN
#undef SEAM
}

extern "C" void kernel_launch(void* const* d_in, const int* in_sizes, int n_in, void* d_out, int out_size, void* d_ws, size_t ws_size, hipStream_t stream) {
    static int grid = 0;
    if (grid == 0) {
        if (n_in != 23 || in_sizes[0] != LP * D || in_sizes[1] != LS * D || out_size != L * D || ws_size < WS_END) {
            fprintf(stderr, "kernel_launch: unexpected shapes: n_in %d in0 %d out %d ws %zu (need %zu)\n", n_in, n_in > 0 ? in_sizes[0] : -1, out_size, ws_size, (size_t)WS_END); grid = -1; return; }
        int dev = 0, cus = 0, per_cu = 0;
        if (hipGetDevice(&dev) != hipSuccess || hipDeviceGetAttribute(&cus, hipDeviceAttributeMultiprocessorCount, dev) != hipSuccess) { grid = -1; return; }
        if (hipFuncSetAttribute((const void*)fwd_kernel, hipFuncAttributeMaxDynamicSharedMemorySize, LDS_BYTES) != hipSuccess) { fprintf(stderr, "kernel_launch: hipFuncSetAttribute failed\n"); grid = -1; return; }
        if (hipOccupancyMaxActiveBlocksPerMultiprocessor(&per_cu, (const void*)fwd_kernel, NTHR, LDS_BYTES) != hipSuccess || per_cu < 1) { fprintf(stderr, "kernel_launch: occupancy query says %d\n", per_cu); }
        (void)hipGetLastError();
        grid = cus;
    }
    if (grid < 0) return;
    (void)hipMemsetAsync((char*)d_ws + WS_CTL, 0, CTL_ZERO_BYTES, stream);
#ifdef DBG_ZERO_ALL
    (void)hipMemsetAsync((char*)d_ws, 0, WS_END, stream); (void)hipMemsetAsync((char*)d_out, 0, (size_t)L * D * 4, stream);
#endif
    Args a{};
    for (int i = 0; i < 23; ++i) a.in[i] = (const float*)d_in[i];
    a.out = (float*)d_out; a.ws = (unsigned char*)d_ws;
#if MK_N_LAUNCHES == 1
    a.ph_lo = 0; a.ph_hi = NPHASE;
    hipLaunchKernelGGL(fwd_kernel, dim3(grid), dim3(NTHR), LDS_BYTES, stream, a);
#else
    for (int p = 0; p < NPHASE; ++p) {
#ifdef DBG_PH_MASK
        if (!((DBG_PH_MASK >> p) & 1)) continue;
#endif
        a.ph_lo = p; a.ph_hi = p + 1; hipLaunchKernelGGL(fwd_kernel, dim3(grid), dim3(NTHR), LDS_BYTES, stream, a); }
#endif
}
```

```cpp
#include <hip/hip_runtime.h>
#include <cstdio>
#include <cstdint>

#define LAS __attribute__((address_space(3)))
typedef unsigned short bf16_t;
typedef short bf16x8 __attribute__((ext_vector_type(8)));
typedef float f32x4 __attribute__((ext_vector_type(4)));
typedef float f32x2 __attribute__((ext_vector_type(2)));
typedef unsigned u32x4 __attribute__((ext_vector_type(4)));
typedef unsigned u32x2 __attribute__((ext_vector_type(2)));

constexpr int D = 4096, LP = 16384, LS = 8192, L = LP + LS;
constexpr int GRIDW = 64, HD = 128, NH = 16, NAW = 2048, LW = 2048, NBLK = 16, BW = 128, DFF = 11008, INW = 10240;
constexpr float EPS = 1e-6f;
constexpr int NWAVES = 8, NTHR = 512;

constexpr size_t MiB = 1u << 20;
constexpr size_t WS_CTL = 0, CTL_ZERO_BYTES = 64 * 1024;
constexpr size_t WS_RSTD = 1 * MiB;
constexpr size_t WS_SUM = 2 * MiB;
constexpr size_t WS_WCAT = 8 * MiB;
constexpr size_t WS_WVT = 72 * MiB;
constexpr size_t WS_W8 = 88 * MiB;
constexpr size_t WS_XN8 = 120 * MiB;
constexpr size_t WS_WNO = 216 * MiB;
constexpr size_t WS_WLO = 232 * MiB;
constexpr size_t WS_WO = 248 * MiB;
constexpr size_t WS_WGU = 280 * MiB;
constexpr size_t WS_WD = 452 * MiB;
constexpr size_t WS_WG = 538 * MiB;
constexpr size_t WS_XN = 540 * MiB;
constexpr size_t WS_Q = 732 * MiB;
constexpr size_t WS_XR = 828 * MiB;
constexpr size_t WS_K = 924 * MiB;
constexpr size_t WS_VT = 1020 * MiB;
constexpr size_t WS_GR = 1116 * MiB;
constexpr size_t WS_XC = 1212 * MiB;
constexpr size_t WS_END = 1308 * MiB;
constexpr size_t WS_T1 = WS_K;
constexpr size_t WS_MIX = WS_GR;
constexpr size_t WS_HIDS = WS_Q;
constexpr size_t WS_F = WS_K;
constexpr size_t WS_HF = WS_K;

#define LDS_WAIT() asm volatile("s_waitcnt lgkmcnt(0)" ::: "memory")
#define VM_WAIT() asm volatile("s_waitcnt vmcnt(0)" ::: "memory")
typedef __bf16 bf16x2n_t __attribute__((ext_vector_type(2)));
__device__ __forceinline__ unsigned pk2(float lo, float hi) { const bf16x2n_t r = __builtin_convertvector((f32x2){lo, hi}, bf16x2n_t); return __builtin_bit_cast(unsigned, r); }
__device__ __forceinline__ unsigned f2bf(float f) { return pk2(f, 0.f) & 0xffffu; }
__device__ __forceinline__ float bflo(unsigned u) { return __builtin_bit_cast(float, u << 16); }
__device__ __forceinline__ float bfhi(unsigned u) { return __builtin_bit_cast(float, u & 0xffff0000u); }
__device__ __forceinline__ float bf1(bf16_t u) { return __builtin_bit_cast(float, (unsigned)u << 16); }
__device__ __forceinline__ float wave_sum(float v) {
#pragma unroll
    for (int o = 1; o < 64; o <<= 1) v += __shfl_xor(v, o);
    return v;
}
__device__ __forceinline__ float wave_max(float v) {
#pragma unroll
    for (int o = 1; o < 64; o <<= 1) v = fmaxf(v, __shfl_xor(v, o));
    return v;
}
__device__ __forceinline__ float sigmoidf_(float v) { return __builtin_amdgcn_rcpf(1.0f + __expf(-v)); }
__device__ __forceinline__ float gelu_tanh(float v) { const float y = 0.7978845608f * (v + 0.044715f * v * v * v); const float e = __expf(2.0f * y); return 0.5f * v * (2.0f - 2.0f * __builtin_amdgcn_rcpf(e + 1.0f)); }

namespace pg8 {
constexpr int BM = 256, BK = 64, HALF = 128, HTB = HALF * BK * 2  , STAGE_BYTES = 8 * HTB, NXCD = 8, WGM = 8;

__host__ __device__ __forceinline__ int lds_byte(int r, int c) { return (r >> 3) * 1024 + (r & 7) * 128 + ((((c >> 3) ^ r) & 7) << 4) + (c & 7) * 2; }
__host__ __device__ __forceinline__ void stage_rc(int b, int& R, int& C) { const int ch = b >> 10, rr = (b >> 7) & 7, slot = (b >> 4) & 7; R = ch * 8 + rr; C = ((slot ^ rr) & 7) * 8; }
__host__ __device__ __forceinline__ int perm32(int rho) { const int n = rho >> 4, i = rho & 15; return 8 * (i >> 2) + 4 * n + (i & 3); }

struct Unit { int pm, pn; };
struct Gemm {
    const bf16_t* A; const bf16_t* A2; int pm_split; const bf16_t* Bt; int M, N, rb;
    __device__ __forceinline__ const char* abase(int pm) const { const size_t t = (size_t)BM * rb; return pm < pm_split ? (const char*)A + (size_t)pm * t : (const char*)A2 + (size_t)(pm - pm_split) * t; }
    __device__ __forceinline__ const char* bbase(int pn) const { return (const char*)Bt + (size_t)pn * BM * rb; }
};

struct StaticOrder {
    int nM, nN, nwg, G, c;
    __host__ __device__ void init(int M, int N, int G_, int c_) { nM = M / BM; nN = N / BM; nwg = nM * nN; G = G_; c = c_; }
    __host__ __device__ bool next(int i, Unit& u) const {
        const long Lx = (long)i * G + c; if (Lx >= nwg) return false;
        int wgid = (int)Lx; { const int q = nwg / NXCD, r = nwg % NXCD, xcd = wgid % NXCD, off = wgid / NXCD; wgid = (xcd < r ? xcd * (q + 1) : r * (q + 1) + (xcd - r) * q) + off; }
        const int nig = WGM * nN, gid = wgid / nig, fm = gid * WGM, gsz = (nM - fm) < WGM ? (nM - fm) : WGM;
        u.pm = fm + ((wgid % nig) % gsz); u.pn = (wgid % nig) / gsz; return true;
    }
    __device__ __forceinline__ void a_ready(const Unit&) const {}
    __device__ __forceinline__ void done(const Unit&) const {}
};

typedef __bf16 bf16x2_t __attribute__((ext_vector_type(2)));
__device__ __forceinline__ unsigned cvt_pk_bf16(float lo, float hi) { const bf16x2_t r = __builtin_convertvector((f32x2){lo, hi}, bf16x2_t); return __builtin_bit_cast(unsigned, r); }
__device__ __forceinline__ u32x4 pack8(const f32x4 v0, const f32x4 v1) { u32x4 w; w.x = cvt_pk_bf16(v0[0], v0[1]); w.y = cvt_pk_bf16(v0[2], v0[3]); w.z = cvt_pk_bf16(v1[0], v1[1]); w.w = cvt_pk_bf16(v1[2], v1[3]); return w; }
__device__ __forceinline__ void unpack8(const u32x4 w, f32x4& v0, f32x4& v1) { v0 = (f32x4){bflo(w.x), bfhi(w.x), bflo(w.y), bfhi(w.y)}; v1 = (f32x4){bflo(w.z), bfhi(w.z), bflo(w.w), bfhi(w.w)}; }
__device__ __forceinline__ f32x4 sig4(const f32x4 v) { f32x4 r; r[0] = sigmoidf_(v[0]); r[1] = sigmoidf_(v[1]); r[2] = sigmoidf_(v[2]); r[3] = sigmoidf_(v[3]); return r; }

struct EpiPlain {
    static constexpr bool PERM = true, AFTER_DRAIN = false;
    bf16_t* O; int ldc;
    __device__ __forceinline__ void operator()(const f32x4 (&acc)[2][2][4][2], const Unit& u, int wr, int wc, int fr, int fq) const {
        const int row0 = u.pm * BM + wr * 64 + fr, col0 = u.pn * BM + wc * 32 + 8 * fq;
#pragma unroll
        for (int ai = 0; ai < 2; ++ai)
#pragma unroll
            for (int m = 0; m < 4; ++m) { bf16_t* rowp = O + (size_t)(row0 + ai * HALF + m * 16) * ldc + col0;
#pragma unroll
                for (int bj = 0; bj < 2; ++bj) *(u32x4*)(rowp + bj * HALF) = pack8(acc[ai][bj][m][0], acc[ai][bj][m][1]); }
    }
};
struct EpiVT {
    static constexpr bool PERM = true, AFTER_DRAIN = false;
    bf16_t* O;
    __device__ __forceinline__ void operator()(const f32x4 (&acc)[2][2][4][2], const Unit& u, int wr, int wc, int fr, int fq) const {
        const int row0 = u.pm * BM + wr * 64 + fr, col0 = u.pn * BM + wc * 32 + 8 * fq;
#pragma unroll
        for (int ai = 0; ai < 2; ++ai)
#pragma unroll
            for (int m = 0; m < 4; ++m) { const int row = row0 + ai * HALF + m * 16, hh = row >> 7, d = row & 127;
                const int dt = 2 * (d >> 5) + ((d >> 2) & 1), i = 4 * ((d >> 3) & 3) + (d & 3);
#pragma unroll
                for (int bj = 0; bj < 2; ++bj) { const int tok = col0 + bj * HALF, R = tok >> 6, o = (tok & 63) >> 3;
                    *(u32x4*)(O + ((size_t)((((R * 16 + hh) * 8 + dt) * 8 + o) * 16 + i)) * 8) = pack8(acc[ai][bj][m][0], acc[ai][bj][m][1]); } }
    }
};
struct EpiProj {
    static constexpr bool PERM = true, AFTER_DRAIN = false;
    bf16_t* P0; bf16_t* P1; bf16_t* P2; bf16_t* P3; bf16_t* G; const float* bias; int pn_gate0;
    __device__ __forceinline__ void operator()(const f32x4 (&acc)[2][2][4][2], const Unit& u, int wr, int wc, int fr, int fq) const {
        const int row0 = u.pm * BM + wr * 64 + fr;
        if (u.pn < pn_gate0) {
            const int t = u.pn >> 3; bf16_t* base = t == 0 ? P0 : (t == 1 ? P1 : (t == 2 ? P2 : P3));
            const int col0 = (u.pn & 7) * BM + wc * 32 + 8 * fq;
            if (t == 2) {
#pragma unroll
                for (int ai = 0; ai < 2; ++ai)
#pragma unroll
                    for (int m = 0; m < 4; ++m) { const int tok = row0 + ai * HALF + m * 16, R = tok >> 6, cl = tok & 63;
                        const int tokpart = (((cl >> 2) & 1) * 8 + (cl >> 3)) * 4 + (cl & 3);
#pragma unroll
                        for (int bj = 0; bj < 2; ++bj) { const int c = col0 + bj * HALF, hh = c >> 7, d0 = c & 127;
                            *(u32x4*)(base + ((size_t)(((R * 16 + hh) * 4 + (d0 >> 5)) * 64 + tokpart) * 4 + ((d0 >> 3) & 3)) * 8) = pack8(acc[ai][bj][m][0], acc[ai][bj][m][1]); } }
            } else {
#pragma unroll
            for (int ai = 0; ai < 2; ++ai)
#pragma unroll
                for (int m = 0; m < 4; ++m) { bf16_t* rowp = base + (size_t)(row0 + ai * HALF + m * 16) * NAW + col0;
#pragma unroll
                    for (int bj = 0; bj < 2; ++bj) *(u32x4*)(rowp + bj * HALF) = pack8(acc[ai][bj][m][0], acc[ai][bj][m][1]); }
            }
        } else {
            const int col0 = (u.pn - pn_gate0) * BM + wc * 32 + 8 * fq;
            f32x4 bv[2][2];
#pragma unroll
            for (int bj = 0; bj < 2; ++bj)
#pragma unroll
                for (int n = 0; n < 2; ++n) bv[bj][n] = *(const f32x4*)(bias + col0 + bj * HALF + 4 * n);
#pragma unroll
            for (int ai = 0; ai < 2; ++ai)
#pragma unroll
                for (int m = 0; m < 4; ++m) { bf16_t* rowp = G + (size_t)(row0 + ai * HALF + m * 16) * (2 * D) + col0;
#pragma unroll
                    for (int bj = 0; bj < 2; ++bj) *(u32x4*)(rowp + bj * HALF) = pack8(sig4(acc[ai][bj][m][0] + bv[bj][0]), sig4(acc[ai][bj][m][1] + bv[bj][1])); }
        }
    }
};
template <bool ADD> struct EpiMulG {
    static constexpr bool PERM = true, AFTER_DRAIN = false;
    bf16_t* O; const bf16_t* G; int goff;
    __device__ __forceinline__ void operator()(const f32x4 (&acc)[2][2][4][2], const Unit& u, int wr, int wc, int fr, int fq) const {
        const int row0 = u.pm * BM + wr * 64 + fr, col0 = u.pn * BM + wc * 32 + 8 * fq;
#pragma unroll
        for (int ai = 0; ai < 2; ++ai)
#pragma unroll
            for (int m = 0; m < 4; ++m) { const size_t row = (size_t)(row0 + ai * HALF + m * 16); bf16_t* rowp = O + row * D + col0; const bf16_t* gp = G + row * (2 * D) + goff + col0;
#pragma unroll
                for (int bj = 0; bj < 2; ++bj) {
                    f32x4 g0, g1; unpack8(*(const u32x4*)(gp + bj * HALF), g0, g1);
                    f32x4 v0 = acc[ai][bj][m][0] * g0, v1 = acc[ai][bj][m][1] * g1;
                    if (ADD) { f32x4 t0, t1; unpack8(*(const u32x4*)(rowp + bj * HALF), t0, t1); v0 += t0; v1 += t1; }
                    *(u32x4*)(rowp + bj * HALF) = pack8(v0, v1); } }
    }
};
struct EpiSwiglu {
    static constexpr bool PERM = true, AFTER_DRAIN = false;
    bf16_t* H0; bf16_t* H1; int pm_split;
    __device__ __forceinline__ void operator()(const f32x4 (&acc)[2][2][4][2], const Unit& u, int wr, int wc, int fr, int fq) const {
        bf16_t* base = u.pm < pm_split ? H0 + (size_t)u.pm * BM * DFF : H1 + (size_t)(u.pm - pm_split) * BM * DFF;
        const int row0 = wr * 64 + fr, col0 = u.pn * HALF + wc * 32 + 8 * fq;
#pragma unroll
        for (int ai = 0; ai < 2; ++ai)
#pragma unroll
            for (int m = 0; m < 4; ++m) {
                f32x4 h[2];
#pragma unroll
                for (int n = 0; n < 2; ++n) { const f32x4 g = acc[ai][0][m][n], up = acc[ai][1][m][n];
#pragma unroll
                    for (int j = 0; j < 4; ++j) h[n][j] = g[j] * sigmoidf_(g[j]) * up[j]; }
                *(u32x4*)(base + (size_t)(row0 + ai * HALF + m * 16) * DFF + col0) = pack8(h[0], h[1]); }
    }
};

typedef int v8i32 __attribute__((ext_vector_type(8)));
typedef int v4i32 __attribute__((ext_vector_type(4)));
__device__ __forceinline__ v8i32 cat8(const bf16x8 lo, const bf16x8 hi) { return __builtin_shufflevector(__builtin_bit_cast(v4i32, lo), __builtin_bit_cast(v4i32, hi), 0, 1, 2, 3, 4, 5, 6, 7); }
__device__ __forceinline__ void mfma_fp8_acc(f32x4& c, const v8i32 a, const v8i32 b, int sa, int sb) {
    asm volatile("v_mfma_scale_f32_16x16x128_f8f6f4 %0, %1, %2, %0, %3, %4 op_sel_hi:[0,0,0]" : "+v"(c) : "v"(a), "v"(b), "v"(sa), "v"(sb)); }
constexpr int FP8_SCALE = 0x73737373;
template <class Epi, class Sched, bool ALIGN_EPI = false, bool SP2 = false, bool FP8 = false, int DBG = 0>
__device__ __forceinline__ void gemm_phase(LAS unsigned char* lds, const Gemm g, const Sched& S, const Epi& E) {
    const int tid = threadIdx.x, wid = __builtin_amdgcn_readfirstlane(tid >> 6), lane = tid & 63, wr = wid >> 2, wc = wid & 3, fr = lane & 15, fq = lane >> 4;
    const int RB = g.rb, nt = RB / (BK * 2);
    unsigned voffA[2], voffB[2];
#pragma unroll
    for (int i = 0; i < 2; ++i) { int R, C; stage_rc(tid * 16 + i * 8192, R, C); const int Rb = Epi::PERM ? ((R & ~31) + perm32(R & 31)) : R;
        voffA[i] = (unsigned)(R * RB + C * 2); voffB[i] = (unsigned)(Rb * RB + C * 2); }
    const size_t kstep = (size_t)(BK * 2);
    const size_t hstep = (size_t)HALF * RB;
    const unsigned ldsw = (unsigned)wid * 1024u;
    const int aoff0 = lds_byte(wr * 64 + fr, fq * 8), aoff1 = lds_byte(wr * 64 + fr, 32 + fq * 8), boff0 = lds_byte(wc * 32 + fr, fq * 8), boff1 = lds_byte(wc * 32 + fr, 32 + fq * 8);
#define PG8_SA(b, h) (((b) * 2 + (h)) * HTB)
#define PG8_SB(b, h) ((4 + (b) * 2 + (h)) * HTB)
#define PG8_STAGE(bufoff, gbase, voff) do { if constexpr (DBG != 3) _Pragma("unroll") for (int _i = 0; _i < 2; ++_i) \
        __builtin_amdgcn_global_load_lds((const unsigned*)((const char*)(gbase) + (voff)[_i]), (LAS unsigned*)(lds + (bufoff) + ldsw + _i * 8192), 16, 0, 0); } while (0)
#define PG8_LDA(dst, b, h) do { if constexpr (DBG != 2) _Pragma("unroll") for (int m = 0; m < 4; ++m) _Pragma("unroll") for (int k = 0; k < 2; ++k) dst[m][k] = *(const LAS bf16x8*)(lds + PG8_SA(b, h) + (k ? aoff1 : aoff0) + m * 2048); } while (0)
#define PG8_LDB(dst, b, h) do { if constexpr (DBG != 2) _Pragma("unroll") for (int n = 0; n < 2; ++n) _Pragma("unroll") for (int k = 0; k < 2; ++k) dst[n][k] = *(const LAS bf16x8*)(lds + PG8_SB(b, h) + (k ? boff1 : boff0) + n * 2048); } while (0)
#define PG8_MMA(ai, bj, At, Bt) do { __builtin_amdgcn_s_setprio(1); if constexpr (DBG == 1) { } else if constexpr (FP8) { _Pragma("unroll") for (int m = 0; m < 4; ++m) _Pragma("unroll") for (int n = 0; n < 2; ++n) \
        mfma_fp8_acc(acc[ai][bj][m][n], cat8(Bt[n][0], Bt[n][1]), cat8(At[m][0], At[m][1]), fp8_sa, fp8_sb); } else { \
        _Pragma("unroll") for (int m = 0; m < 4; ++m) _Pragma("unroll") for (int n = 0; n < 2; ++n) _Pragma("unroll") for (int k = 0; k < 2; ++k) \
        acc[ai][bj][m][n] = __builtin_amdgcn_mfma_f32_16x16x32_bf16(Bt[n][k], At[m][k], acc[ai][bj][m][n], 0, 0, 0); } __builtin_amdgcn_s_setprio(0); } while (0)
#define PG8_WAIT_V(n) asm volatile("s_waitcnt vmcnt(" #n ")" ::: "memory")
#define PG8_WAIT_L(n) asm volatile("s_waitcnt lgkmcnt(" #n ")" ::: "memory")
#define PG8_BAR __builtin_amdgcn_s_barrier()
#define PG8_SCHED __builtin_amdgcn_sched_barrier(0)
    Unit cur, nxt; int ui = 0;
    const int fp8_sa = FP8_SCALE, fp8_sb = 0x7F7F7F7F;
    if (!S.next(0, cur)) return;
    f32x4 acc[2][2][4][2];
#pragma unroll
    for (int a = 0; a < 2; ++a)
#pragma unroll
        for (int b = 0; b < 2; ++b)
#pragma unroll
            for (int m = 0; m < 4; ++m)
#pragma unroll
                for (int n = 0; n < 2; ++n) acc[a][b][m][n] = (f32x4){0.f, 0.f, 0.f, 0.f};
    bf16x8 At[4][2], B0[2][2], B1[2][2];
    const char* cA = g.abase(cur.pm); const char* cB = g.bbase(cur.pn);
    S.a_ready(cur);
    if constexpr (SP2) {
        PG8_STAGE(PG8_SB(0, 0), cB, voffB); PG8_STAGE(PG8_SB(0, 1), cB + hstep, voffB); PG8_STAGE(PG8_SA(0, 0), cA, voffA); PG8_STAGE(PG8_SA(0, 1), cA + hstep, voffA);
        if (wr == 1) PG8_BAR;
        PG8_WAIT_V(2); PG8_BAR;
        PG8_STAGE(PG8_SB(1, 0), cB + kstep, voffB); PG8_STAGE(PG8_SA(1, 0), cA + kstep, voffA); PG8_STAGE(PG8_SB(1, 1), cB + hstep + kstep, voffB);
        PG8_WAIT_V(6); PG8_BAR;
    } else {
        PG8_STAGE(PG8_SB(0, 0), cB, voffB); PG8_STAGE(PG8_SA(0, 0), cA, voffA); PG8_STAGE(PG8_SB(0, 1), cB + hstep, voffB); PG8_STAGE(PG8_SA(0, 1), cA + hstep, voffA);
        if (wr == 1) PG8_BAR;
        PG8_WAIT_V(4); PG8_BAR;
        PG8_STAGE(PG8_SB(1, 0), cB + kstep, voffB); PG8_STAGE(PG8_SA(1, 0), cA + kstep, voffA); PG8_STAGE(PG8_SB(1, 1), cB + hstep + kstep, voffB);
        PG8_WAIT_V(6); PG8_BAR;
    }
    for (;;) {
        const bool has_next = S.next(ui + 1, nxt);
        const char* nA = has_next ? g.abase(nxt.pm) : cA; const char* nB = has_next ? g.bbase(nxt.pn) : cB;
        for (int t = 0; t < nt; t += 2) {
            const bool last = (t == nt - 2);
            const char* a1 = cA + (size_t)(t + 1) * kstep;
            const char* a2 = last ? nA : cA + (size_t)(t + 2) * kstep; const char* b2 = last ? nB : cB + (size_t)(t + 2) * kstep;
            const char* a3 = a2 + kstep; const char* b3 = b2 + kstep;
            if (last && has_next) S.a_ready(nxt);
            if constexpr (SP2) {
            PG8_LDB(B0, 0, 0); PG8_LDB(B1, 0, 1); PG8_SCHED; PG8_LDA(At, 0, 0); PG8_STAGE(PG8_SA(1, 1), a1 + hstep, voffA);
            PG8_WAIT_V(8); PG8_WAIT_L(0); PG8_BAR; PG8_MMA(0, 0, At, B0); PG8_MMA(0, 1, At, B1); PG8_BAR; PG8_SCHED;
            PG8_LDA(At, 0, 1); PG8_STAGE(PG8_SB(0, 0), b2, voffB); PG8_STAGE(PG8_SB(0, 1), b2 + hstep, voffB); PG8_STAGE(PG8_SA(0, 0), a2, voffA);
            PG8_WAIT_V(8); PG8_WAIT_L(0); PG8_BAR; PG8_MMA(1, 0, At, B0); PG8_MMA(1, 1, At, B1); PG8_BAR; PG8_SCHED;
            PG8_LDB(B0, 1, 0); PG8_LDB(B1, 1, 1); PG8_SCHED; PG8_LDA(At, 1, 0); PG8_STAGE(PG8_SA(0, 1), a2 + hstep, voffA);
            PG8_WAIT_V(8); PG8_WAIT_L(0); PG8_BAR; PG8_MMA(0, 0, At, B0); PG8_MMA(0, 1, At, B1); PG8_BAR; PG8_SCHED;
            PG8_LDA(At, 1, 1); PG8_STAGE(PG8_SB(1, 0), b3, voffB); PG8_STAGE(PG8_SB(1, 1), b3 + hstep, voffB); PG8_STAGE(PG8_SA(1, 0), a3, voffA);
            PG8_WAIT_V(8); PG8_WAIT_L(0); PG8_BAR; PG8_MMA(1, 0, At, B0); PG8_MMA(1, 1, At, B1); PG8_BAR; PG8_SCHED;
            } else {
            PG8_LDB(B0, 0, 0); PG8_SCHED; PG8_LDA(At, 0, 0); PG8_STAGE(PG8_SA(1, 1), a1 + hstep, voffA);
            PG8_WAIT_L(8); PG8_BAR; PG8_WAIT_L(0); PG8_MMA(0, 0, At, B0); PG8_BAR; PG8_SCHED;
            PG8_LDB(B1, 0, 1); PG8_STAGE(PG8_SB(0, 0), b2, voffB);
            PG8_BAR; PG8_WAIT_L(0); PG8_MMA(0, 1, At, B1); PG8_BAR;
            PG8_LDA(At, 0, 1); PG8_STAGE(PG8_SA(0, 0), a2, voffA);
            PG8_BAR; PG8_WAIT_L(0); PG8_MMA(1, 0, At, B0); PG8_BAR; PG8_SCHED;
            PG8_STAGE(PG8_SB(0, 1), b2 + hstep, voffB);
            PG8_WAIT_V(6); PG8_BAR; PG8_MMA(1, 1, At, B1); PG8_BAR;
            PG8_LDB(B0, 1, 0); PG8_SCHED; PG8_LDA(At, 1, 0); PG8_STAGE(PG8_SA(0, 1), a2 + hstep, voffA);
            PG8_WAIT_L(8); PG8_BAR; PG8_WAIT_L(0); PG8_MMA(0, 0, At, B0); PG8_BAR; PG8_SCHED;
            PG8_LDB(B1, 1, 1); PG8_STAGE(PG8_SB(1, 0), b3, voffB);
            PG8_BAR; PG8_WAIT_L(0); PG8_MMA(0, 1, At, B1); PG8_BAR;
            PG8_LDA(At, 1, 1); PG8_STAGE(PG8_SA(1, 0), a3, voffA);
            PG8_BAR; PG8_WAIT_L(0); PG8_MMA(1, 0, At, B0); PG8_BAR; PG8_SCHED;
            PG8_STAGE(PG8_SB(1, 1), b3 + hstep, voffB);
            PG8_WAIT_V(6); PG8_BAR; PG8_MMA(1, 1, At, B1); PG8_BAR;
            }
        }
        if constexpr (ALIGN_EPI) { if (wr == 0) PG8_BAR; }
        if constexpr (!Epi::AFTER_DRAIN) { if constexpr (DBG != 4) E(acc, cur, wr, wc, fr, fq); else { _Pragma("unroll") for (int a_ = 0; a_ < 2; ++a_) _Pragma("unroll") for (int b_ = 0; b_ < 2; ++b_) _Pragma("unroll") for (int m_ = 0; m_ < 4; ++m_) _Pragma("unroll") for (int n_ = 0; n_ < 2; ++n_) asm volatile("" :: "v"(acc[a_][b_][m_][n_])); } S.done(cur); }
        if (!has_next) break;
#pragma unroll
        for (int a = 0; a < 2; ++a)
#pragma unroll
            for (int b = 0; b < 2; ++b)
#pragma unroll
                for (int m = 0; m < 4; ++m)
#pragma unroll
                    for (int n = 0; n < 2; ++n) acc[a][b][m][n] = (f32x4){0.f, 0.f, 0.f, 0.f};
        cur = nxt; cA = nA; cB = nB; ++ui;
        if constexpr (ALIGN_EPI) { if (wr == 1) PG8_BAR; }
    }
    PG8_WAIT_V(0);
    if constexpr (!ALIGN_EPI) { if (wr == 0) PG8_BAR; }
    PG8_BAR;
    if constexpr (Epi::AFTER_DRAIN) { E.fused(acc, cur, wr, wc, fr, fq, lds, wid, lane); S.done(cur); }
#undef PG8_SA
#undef PG8_SB
#undef PG8_STAGE
#undef PG8_LDA
#undef PG8_LDB
#undef PG8_MMA
#undef PG8_WAIT_V
#undef PG8_WAIT_L
#undef PG8_BAR
#undef PG8_SCHED
}
}
#define XB_TMO      128
#define XB_XCNT(j)  (256  + 64 * (j))
#define XB_XSUB(j)  (1280 + 64 * (j))
#define XB_XGEN(j)  (2304 + 64 * (j))
#define XB_TOP      3328
#define XB_TOPGEN   3392
#define XCD_BAR_WORDS 3456
#define XB_SPIN_CAP (1u << 18)

__device__ __forceinline__ unsigned xb_ld(unsigned* p)              { return __hip_atomic_load(p, __ATOMIC_RELAXED, __HIP_MEMORY_SCOPE_AGENT); }
__device__ __forceinline__ unsigned xb_add(unsigned* p, unsigned v) { return __hip_atomic_fetch_add(p, v, __ATOMIC_RELAXED, __HIP_MEMORY_SCOPE_AGENT); }
__device__ __forceinline__ unsigned xb_xcc_id() { return (unsigned)__builtin_amdgcn_s_getreg((3 << 11) | 20) & 0xFu; }
#define XB_SPIN(cond, bar) do { unsigned _sp = 0; while (cond) { __builtin_amdgcn_s_sleep(1); \
    if ((++_sp & 255u) == 0u) { if (xb_ld(&(bar)[XB_TMO])) break; if (_sp > XB_SPIN_CAP) { atomicAdd(&(bar)[XB_TMO], 1u); break; } } } } while (0)

struct XcdBarrier {
    unsigned* bar; unsigned x;
    volatile LAS unsigned* st;
};

__device__ __forceinline__ XcdBarrier xcd_barrier_post(unsigned* bar, volatile LAS unsigned* st) {
    XcdBarrier b; b.bar = bar; b.x = xb_xcc_id(); b.st = st;
    if (threadIdx.x == 0) (void)xb_add(&bar[XB_XCNT(b.x)], 1u);
    return b;
}
__device__ __forceinline__ void xcd_barrier_complete(unsigned* bar, unsigned x, unsigned& nloc, unsigned& nx) {
    const unsigned G = gridDim.x * gridDim.y * gridDim.z;
    unsigned sum, cnt, mine, sp = 0u;
    for (;;) {
        sum = 0u; cnt = 0u; mine = 0u;
#pragma unroll
        for (unsigned j = 0; j < 16; ++j) { const unsigned c = xb_ld(&bar[XB_XCNT(j)]); sum += c; cnt += (c > 0u) ? 1u : 0u; mine = (j == x) ? c : mine; }
        if (sum == G) break;
        __builtin_amdgcn_s_sleep(1);
        if ((++sp & 255u) == 0u) { if (xb_ld(&bar[XB_TMO])) break; if (sp > XB_SPIN_CAP) { atomicAdd(&bar[XB_TMO], 1u); break; } }
    }
    nloc = mine > 0u ? mine : 1u; nx = cnt > 0u ? cnt : 1u;
}

__device__ __forceinline__ void xcd_barrier(const XcdBarrier& b) {
    asm volatile("s_waitcnt vmcnt(0)" ::: "memory");
    __syncthreads();
    if (threadIdx.x == 0) {
        unsigned* bar = b.bar;
        __builtin_amdgcn_s_waitcnt(0);
        unsigned nloc = b.st[0], nx = b.st[1];
        if (nloc == 0u) { xcd_barrier_complete(bar, b.x, nloc, nx); b.st[0] = nloc; b.st[1] = nx; }
        const unsigned old = xb_add(&bar[XB_XSUB(b.x)], 1u);
        const unsigned gen = old / nloc;
        if (old + 1u == (gen + 1u) * nloc) {
            __builtin_amdgcn_fence(__ATOMIC_RELEASE, "agent");
            asm volatile("s_waitcnt vmcnt(0)" ::: "memory");
            const unsigned og = xb_add(&bar[XB_TOP], 1u);
            const unsigned tg = og / nx;
            if (og + 1u == (tg + 1u) * nx) xb_add(&bar[XB_TOPGEN], 1u);
            else XB_SPIN(xb_ld(&bar[XB_TOPGEN]) == tg, bar);
            __builtin_amdgcn_fence(__ATOMIC_ACQUIRE, "agent");
            xb_add(&bar[XB_XGEN(b.x)], 1u);
            asm volatile("s_waitcnt vmcnt(0)" ::: "memory");
        } else {
            XB_SPIN(xb_ld(&bar[XB_XGEN(b.x)]) == gen, bar);
            __builtin_amdgcn_fence(__ATOMIC_ACQUIRE, "agent");
            asm volatile("s_waitcnt vmcnt(0)" ::: "memory");
        }
    }
    __syncthreads();
}


struct Frame {
    LAS unsigned char* lds;
    int tid, lane, wave, G, gw, ngw;
    const float *in_XP, *in_XS, *in_WIN, *in_WCONV, *in_BCONV, *in_WR, *in_BR, *in_WI, *in_BI, *in_LAM, *in_RPB, *in_WNO, *in_WLO, *in_WM, *in_BM, *in_WOUT, *in_GMPRE, *in_GMPOST, *in_GFPRE, *in_GFPOST, *in_WFG, *in_WFU, *in_WFD; float* out; unsigned char* ws;
};
enum { I_XP = 0, I_XS, I_WIN, I_WCONV, I_BCONV, I_WR, I_BR, I_WI, I_BI, I_LAM, I_RPB, I_WNO, I_WLO, I_WM, I_BM, I_WOUT, I_GMPRE, I_GMPOST, I_GFPRE, I_GFPOST, I_WFG, I_WFU, I_WFD };
__device__ __forceinline__ int opaque(int x) { asm volatile("" : "+v"(x)); return x; }
template <class T> __device__ __forceinline__ T* wsp(const Frame& F, size_t off) { return (T*)(F.ws + off); }
__device__ __forceinline__ const float* xrow(const Frame& F, int m) { return m < LP ? F.in_XP + (size_t)m * D : F.in_XS + (size_t)(m - LP) * D; }

__device__ __forceinline__ void tr_item(const float* src, int ldsrc, int k0, int n0, bf16_t* dst, int ldd, int drow0, LAS float* scr, int lane) {
#pragma unroll 8
    for (int i = 0; i < 32; ++i) { const int kk = 2 * i + (lane >> 5); scr[kk * 33 + (lane & 31)] = src[(size_t)(k0 + kk) * ldsrc + n0 + (lane & 31)]; }
    LDS_WAIT(); asm volatile("" ::: "memory");
    const int c = lane & 7;
#pragma unroll
    for (int j = 0; j < 4; ++j) { const int n = (lane >> 3) + 8 * j; const LAS float* s = scr + (8 * c) * 33 + n;
        u32x4 o; o.x = pk2(s[0 * 33], s[1 * 33]); o.y = pk2(s[2 * 33], s[3 * 33]); o.z = pk2(s[4 * 33], s[5 * 33]); o.w = pk2(s[6 * 33], s[7 * 33]);
        *(u32x4*)(dst + (size_t)(drow0 + n) * ldd + k0 + 8 * c) = o; }
    LDS_WAIT(); asm volatile("" ::: "memory");
}
__device__ __forceinline__ unsigned pk4_fp8(float a, float b, float c, float d) { int p = __builtin_amdgcn_cvt_pk_fp8_f32(a, b, 0, false); p = __builtin_amdgcn_cvt_pk_fp8_f32(c, d, p, true); return (unsigned)p; }
__device__ __forceinline__ void tr_item8(const float* src, int ldsrc, int k0, int n0, unsigned char* dst, int ldd, int drow0, LAS float* scr, int lane) {
#pragma unroll 8
    for (int i = 0; i < 32; ++i) { const int kk = 2 * i + (lane >> 5); scr[kk * 33 + (lane & 31)] = src[(size_t)(k0 + kk) * ldsrc + n0 + (lane & 31)]; }
    LDS_WAIT(); asm volatile("" ::: "memory");
    const int c = lane & 7;
#pragma unroll
    for (int j = 0; j < 4; ++j) { const int n = (lane >> 3) + 8 * j; const LAS float* s = scr + (8 * c) * 33 + n;
        u32x2 o; o.x = pk4_fp8(s[0 * 33] * 256.f, s[1 * 33] * 256.f, s[2 * 33] * 256.f, s[3 * 33] * 256.f); o.y = pk4_fp8(s[4 * 33] * 256.f, s[5 * 33] * 256.f, s[6 * 33] * 256.f, s[7 * 33] * 256.f);
        *(u32x2*)(dst + (size_t)(drow0 + n) * ldd + k0 + 8 * c) = o; }
    LDS_WAIT(); asm volatile("" ::: "memory");
}
#define TR_JOB(SRC, LDSRC, KK, NN, DST, DROW_EXPR) { const int nblk = (NN) / 32, nit = ((KK) / 64) * nblk; \
    if (r < nit) { const int kb = r / nblk, nb = r % nblk, n0 = 32 * nb; tr_item((SRC), (LDSRC), 64 * kb, n0, (DST), (KK), (DROW_EXPR), scr, F.lane); continue; } r -= nit; }
#define TR_JOB8(SRC, LDSRC, KK, NN, DST, DROW_EXPR) { const int nblk = (NN) / 32, nit = ((KK) / 64) * nblk; \
    if (r < nit) { const int kb = r / nblk, nb = r % nblk, n0 = 32 * nb; tr_item8((SRC), (LDSRC), 64 * kb, n0, (DST), (KK), (DROW_EXPR), scr, F.lane); continue; } r -= nit; }

__device__ __forceinline__ void p0_prologue(Frame& F) {
    const int tid_ = opaque(F.tid);
    LAS float* scr = (LAS float*)(F.lds + F.wave * 8448);
    const float* w_in = F.in_WIN;
    bf16_t* WCAT = wsp<bf16_t>(F, WS_WCAT); unsigned char* W8 = wsp<unsigned char>(F, WS_W8); unsigned char* WV8 = wsp<unsigned char>(F, WS_WVT); bf16_t* WGU = wsp<bf16_t>(F, WS_WGU);
    constexpr int NSM = 64;
    constexpr int IT_SM = 2 * 4;
    constexpr int N_BIG = 5 * (D / 64) * (NAW / 32) + (D / 64) * (2 * D / 32) + 2 * (NAW / 64) * (D / 32) + (D / 64) * (D / 32) + 2 * (D / 64) * (DFF / 32) + (DFF / 64) * (D / 32);
    constexpr int NITEMS = N_BIG + NSM * IT_SM;
    for (int it = F.gw; it < NITEMS; it += F.ngw) {
        int r = it;
        TR_JOB(w_in + 0, INW, D, NAW, WCAT, 0 + n0)
        TR_JOB(w_in + 3 * NAW, INW, D, NAW, WCAT, 2048 + n0)
        TR_JOB(w_in + NAW, INW, D, NAW, WCAT, 4096 + n0)
        TR_JOB(w_in + 4 * NAW, INW, D, NAW, WCAT, 6144 + n0)
        TR_JOB8(F.in_WM, 2 * D, D, 2 * D, W8, n0)
        TR_JOB8(w_in + 2 * NAW, INW, D, NAW, WV8, n0)
        TR_JOB(F.in_WNO, D, NAW, D, wsp<bf16_t>(F, WS_WNO), n0)
        TR_JOB(F.in_WLO, D, LW, D, wsp<bf16_t>(F, WS_WLO), n0)
        TR_JOB(F.in_WOUT, D, D, D, wsp<bf16_t>(F, WS_WO), n0)
        TR_JOB(F.in_WFG, DFF, D, DFF, WGU, (n0 >> 7) * 256 + (n0 & 127))
        TR_JOB(F.in_WFU, DFF, D, DFF, WGU, (n0 >> 7) * 256 + 128 + (n0 & 127))
        TR_JOB(F.in_WFD, D, DFF, D, wsp<bf16_t>(F, WS_WD), n0)
        {
            const int mi = r / IT_SM, ri = r % IT_SM, d = mi >> 5, g = (mi >> 4) & 1, n = mi & 15, kb = ri >> 2, nb = ri & 3;
            const float* src = (g ? F.in_WI : F.in_WR) + (size_t)(d * NBLK + n) * BW * BW;
            tr_item(src, BW, 64 * kb, 32 * nb, wsp<bf16_t>(F, WS_WG) + (size_t)mi * BW * BW, BW, 32 * nb, scr, F.lane);
        }
    }
    LAS f32x4* gl = (LAS f32x4*)(F.lds + 69632);
    for (int i = tid_; i < D / 4; i += NTHR) gl[i] = ((const f32x4*)F.in_GMPRE)[i];
    __syncthreads();
    bf16_t* XN = wsp<bf16_t>(F, WS_XN); unsigned char* XN8 = wsp<unsigned char>(F, WS_XN8);
    for (int m = F.gw; m < L; m += F.ngw) {
        asm volatile("" ::: "memory");
        const f32x4* xr = (const f32x4*)xrow(F, m) + F.lane;
        f32x4 v[16]; float s = 0.f;
#pragma unroll
        for (int j = 0; j < 16; ++j) { v[j] = xr[64 * j]; s += (v[j].x * v[j].x + v[j].y * v[j].y) + (v[j].z * v[j].z + v[j].w * v[j].w); }
        const float rstd = 1.0f / sqrtf(wave_sum(s) * (1.0f / D) + EPS);
        u32x2* o8 = (u32x2*)(XN + (size_t)m * D) + F.lane; unsigned* o4 = (unsigned*)(XN8 + (size_t)m * D) + F.lane;
#pragma unroll
        for (int j = 0; j < 16; ++j) { const f32x4 g = gl[F.lane + 64 * j]; const f32x4 y = v[j] * rstd * g; u32x2 o; o.x = pk2(y.x, y.y); o.y = pk2(y.z, y.w); o8[64 * j] = o;
            o4[64 * j] = pk4_fp8(y.x * 16.f, y.y * 16.f, y.z * 16.f, y.w * 16.f); }
    }
    __syncthreads();
}

#ifndef ATT_SYNC
#define ATT_SYNC 1
#endif
template <int ADBG = 0> __device__ __forceinline__ void attn_mfma(Frame& F) {
    const int tid_ = opaque(F.tid);
    bf16_t* Q = wsp<bf16_t>(F, WS_Q); const bf16_t* Kb = wsp<bf16_t>(F, WS_K); const bf16_t* VT = wsp<bf16_t>(F, WS_VT);
    LAS float* rp = (LAS float*)F.lds;
    for (int i = tid_; i < NH * 15 * 31; i += NTHR) rp[i] = F.in_RPB[i];
    __syncthreads();
    const int fr = F.lane & 15, fq = F.lane >> 4;
    const float scale = 0.08838834764831845f;
    for (int item = F.gw; item < (L / GRIDW) * NH * 4; item += F.ngw) {
        asm volatile("" ::: "memory");
        const int g = item & 3, h = (item >> 2) & 15, rg = item >> 6;
        const int s0 = rg < LP / GRIDW ? 0 : LP, rows = rg < LP / GRIDW ? LP / GRIDW : LS / GRIDW, r = rg < LP / GRIDW ? rg : rg - LP / GRIDW;
        int rs = r - 4; rs = rs < 0 ? 0 : (rs > rows - 8 ? rows - 8 : rs);
        const int w0 = g == 0 ? 0 : (g == 1 ? 8 : (g == 2 ? 24 : 32));
        const int c = 16 * g + fr;
        int cs = c - 8; cs = cs < 0 ? 0 : (cs > GRIDW - 16 ? GRIDW - 16 : cs);
        bf16_t* qrow = Q + (size_t)(s0 + r * GRIDW + c) * NAW + h * HD;
        bf16x8 qf[4];
#pragma unroll
        for (int s = 0; s < 4; ++s) qf[s] = *(const bf16x8*)(qrow + 8 * fq + 32 * s);
        f32x4 sacc[8][2];
        const int Rg = s0 / GRIDW + rs, p0 = w0 >> 3;
        const bf16_t* kbase = Kb + (size_t)(Rg * 16 + h) * 8192 + p0 * 128 + fr * 32 + fq * 8;
        bf16x8 kb[8][2][4];
#define ATT_LDK(kr) do { _Pragma("unroll") for (int T = 0; T < 2; ++T) _Pragma("unroll") for (int s = 0; s < 4; ++s) kb[kr][T][s] = (ADBG & 1) ? qf[s] : (ADBG & 4) ? *(const bf16x8*)(Kb + (size_t)(s0 + rs * GRIDW) * NAW + h * HD * GRIDW + ((kr) * 8 + T * 4 + s) * 512 + F.lane * 8) : *(const bf16x8*)(kbase + (size_t)(kr) * (16 * 8192) + (s * 2 + T) * 1024); } while (0)
        ATT_LDK(0); ATT_LDK(1);
#pragma unroll
        for (int kr = 0; kr < 8; ++kr) {
            if (ATT_SYNC && (kr & 1) == 0) __builtin_amdgcn_s_barrier();
            if (kr + 2 < 8) ATT_LDK(kr + 2);
            __builtin_amdgcn_sched_barrier(0);
#pragma unroll
            for (int T = 0; T < 2; ++T) { f32x4 a = (f32x4){0.f, 0.f, 0.f, 0.f};
#pragma unroll
                for (int s = 0; s < 4; ++s) a = __builtin_amdgcn_mfma_f32_16x16x32_bf16(kb[kr][T][s], qf[s], a, 0, 0, 0);
                sacc[kr][T] = a; }
            __builtin_amdgcn_sched_barrier(0);
        }
#undef ATT_LDK
        bf16x8 vb[8][8];
        const bf16_t* vbase = VT + (size_t)(Rg * 16 + h) * 8192 + p0 * 128 + fq * 128 + fr * 8;
#define ATT_LDV(kr) do { _Pragma("unroll") for (int dt = 0; dt < 8; ++dt) vb[kr][dt] = (ADBG & 2) ? qf[dt & 3] : (ADBG & 4) ? *(const bf16x8*)(VT + (size_t)(h * HD) * L + s0 + rs * GRIDW + ((kr) * 8 + dt) * 512 + F.lane * 8) : *(const bf16x8*)(vbase + (size_t)(kr) * (16 * 8192) + dt * 1024); } while (0)
        ATT_LDV(0); ATT_LDV(1);
        __builtin_amdgcn_sched_barrier(0);
        const int elo = cs - w0 - 8 * fq, dc0 = w0 + 8 * fq - c + 15;
        const LAS float* rph = rp + h * 465 + (rs - r + 7) * 31;
        float mx = -3.0e38f;
#pragma unroll
        for (int e = 0; e < 8; ++e) { const bool valid = (e >= elo) && (e < elo + 16); const int bi = valid ? dc0 + e : 0;
#pragma unroll
            for (int kr = 0; kr < 8; ++kr) { const float sv = valid ? sacc[kr][e >> 2][e & 3] * scale + rph[kr * 31 + bi] : -3.0e38f; sacc[kr][e >> 2][e & 3] = sv; mx = fmaxf(mx, sv); } }
        mx = fmaxf(mx, __shfl_xor(mx, 16)); mx = fmaxf(mx, __shfl_xor(mx, 32));
        float lsum = 0.f; bf16x8 pf[8];
#pragma unroll
        for (int kr = 0; kr < 8; ++kr) { float p[8];
#pragma unroll
            for (int e = 0; e < 8; ++e) { p[e] = __expf(sacc[kr][e >> 2][e & 3] - mx); lsum += p[e]; }
            u32x4 w; w.x = pk2(p[0], p[1]); w.y = pk2(p[2], p[3]); w.z = pk2(p[4], p[5]); w.w = pk2(p[6], p[7]);
            pf[kr] = __builtin_bit_cast(bf16x8, w); }
        lsum += __shfl_xor(lsum, 16); lsum += __shfl_xor(lsum, 32);
        f32x4 oacc[8];
#pragma unroll
        for (int dt = 0; dt < 8; ++dt) oacc[dt] = (f32x4){0.f, 0.f, 0.f, 0.f};
#pragma unroll
        for (int kr = 0; kr < 8; ++kr) {
            if (ATT_SYNC && (kr & 1) == 0) __builtin_amdgcn_s_barrier();
            if (kr + 2 < 8) ATT_LDV(kr + 2);
            __builtin_amdgcn_sched_barrier(0);
#pragma unroll
            for (int dt = 0; dt < 8; ++dt) oacc[dt] = __builtin_amdgcn_mfma_f32_16x16x32_bf16(vb[kr][dt], pf[kr], oacc[dt], 0, 0, 0);
            __builtin_amdgcn_sched_barrier(0);
        }
#undef ATT_LDV
        const float inv = 1.0f / lsum;
#ifdef ATTN_OUT_OFF
        bf16_t* orow = wsp<bf16_t>(F, (size_t)ATTN_OUT_OFF * MiB) + (size_t)(s0 + r * GRIDW + c) * NAW + h * HD;
#else
        bf16_t* orow = qrow;
#endif
#pragma unroll
        for (int u = 0; u < 4; ++u) *(u32x4*)(orow + 32 * u + 8 * fq) = pg8::pack8(oacc[2 * u] * inv, oacc[2 * u + 1] * inv);
    }
    __syncthreads();
}

__device__ __forceinline__ void conv_phase(Frame& F) {
    const int tid_ = opaque(F.tid);
    const bf16_t* XR = wsp<bf16_t>(F, WS_XR); bf16_t* XC = wsp<bf16_t>(F, WS_XC);
    const float* wc = F.in_WCONV; const float* bc = F.in_BCONV;
    const int nth = F.G * NTHR;
    for (int it = blockIdx.x * NTHR + tid_; it < L * (LW / 8); it += nth) {
        const int t = it / (LW / 8), c0 = (it % (LW / 8)) * 8;
        const int s0 = t < LP ? 0 : LP, len = t < LP ? LP : LS, tl = t - s0;
        float acc[8];
#pragma unroll
        for (int e = 0; e < 8; ++e) acc[e] = bc[c0 + e];
#pragma unroll
        for (int j = 0; j < 4; ++j) { const int tt = tl + j - 2; if (tt < 0 || tt >= len) continue;
            f32x4 x0, x1; pg8::unpack8(*(const u32x4*)(XR + (size_t)(s0 + tt) * LW + c0), x0, x1);
            const f32x4 w0 = *(const f32x4*)(wc + j * LW + c0), w1 = *(const f32x4*)(wc + j * LW + c0 + 4);
#pragma unroll
            for (int e = 0; e < 4; ++e) { acc[e] += w0[e] * x0[e]; acc[4 + e] += w1[e] * x1[e]; } }
        *(u32x4*)(XC + (size_t)t * LW + c0) = pg8::pack8((f32x4){acc[0], acc[1], acc[2], acc[3]}, (f32x4){acc[4], acc[5], acc[6], acc[7]});
    }
}

struct LruW { bf16x8 w[2][4]; float br, bi, cl; };
template <int DIR> __device__ __forceinline__ void lru_load_w(const Frame& F, LruW& W, int n, int w, int fr, int fq) {
    const bf16_t* wg = wsp<bf16_t>(F, WS_WG);
#pragma unroll
    for (int g = 0; g < 2; ++g)
#pragma unroll
        for (int s = 0; s < 4; ++s) W.w[g][s] = *(const bf16x8*)(wg + ((size_t)((DIR * 2 + g) * NBLK + n) * BW + 16 * w + fr) * BW + 32 * fq + 8 * s);
    const int ch = n * BW + 16 * w + fr;
    W.br = F.in_BR[DIR * LW + ch]; W.bi = F.in_BI[DIR * LW + ch];
    const float lam = F.in_LAM[DIR * LW + ch];
    W.cl = -8.0f * ((lam > 15.f) ? __expf(-lam) : log1pf(__expf(-lam)));
}
template <int LDBG = 0> __device__ __forceinline__ void lru_gate(float pr, float pi, float xc, const LruW& W, bool first, float& a, float& u) {
    if constexpr (LDBG == 1) { a = pr + W.br; u = pi * xc + W.bi; return; }
    const float r = sigmoidf_(pr + W.br), ig = sigmoidf_(pi + W.bi);
    a = __expf(W.cl * r);
    const float mult = first ? 1.0f : __builtin_amdgcn_sqrtf(fmaxf(1.0f - a * a, 0.f));
    u = mult * ig * xc;
}
struct LruX { bf16x8 x[4][4]; };
__device__ __forceinline__ void lru_load_x(LruX& X, const bf16_t* XC, int tb, int n, int fr, int fq) {
#pragma unroll
    for (int tau = 0; tau < 4; ++tau) { const bf16_t* xp = XC + ((size_t)((((tb >> 6) * NBLK + n) * 4 + tau) * 4) * 64 + fr * 4 + fq) * 8;
#pragma unroll
        for (int s = 0; s < 4; ++s) X.x[tau][s] = *(const bf16x8*)(xp + s * 512); }
}
__device__ __forceinline__ void lru_tile(const LruX& X, int tau, bool hiw, const LruW& W, const bf16x8 idf0, const bf16x8 idf1, f32x4& pr, f32x4& pi, f32x4& xct) {
    pr = (f32x4){0.f, 0.f, 0.f, 0.f}; pi = pr;
#pragma unroll
    for (int s = 0; s < 4; ++s) { pr = __builtin_amdgcn_mfma_f32_16x16x32_bf16(X.x[tau][s], W.w[0][s], pr, 0, 0, 0); pi = __builtin_amdgcn_mfma_f32_16x16x32_bf16(X.x[tau][s], W.w[1][s], pi, 0, 0, 0); }
    const bf16x8 x0 = hiw ? X.x[tau][2] : X.x[tau][0], x1 = hiw ? X.x[tau][3] : X.x[tau][1];
    xct = __builtin_amdgcn_mfma_f32_16x16x32_bf16(x0, idf0, (f32x4){0.f, 0.f, 0.f, 0.f}, 0, 0, 0);
    xct = __builtin_amdgcn_mfma_f32_16x16x32_bf16(x1, idf1, xct, 0, 0, 0);
}
__device__ __forceinline__ void lru_idfrags(int w, int fr, int fq, bf16x8& idf0, bf16x8& idf1) {
#pragma unroll
    for (int e = 0; e < 8; ++e) { const bool on = (fq == (w >> 1)) && ((fr & 7) == e); idf0[e] = (on && fr < 8) ? (short)0x3F80 : (short)0; idf1[e] = (on && fr >= 8) ? (short)0x3F80 : (short)0; }
}
constexpr int LRU_CH = 256, LRU_NCH = L / LRU_CH, LRU_NCH_P = LP / LRU_CH;
__device__ __forceinline__ void conv_unit(Frame& F, int cg, int n) {
    const int tid_ = opaque(F.tid);
    const bf16_t* XR = wsp<bf16_t>(F, WS_XR); bf16_t* XC = wsp<bf16_t>(F, WS_XC);
    const float* wc = F.in_WCONV; const float* bc = F.in_BCONV;
    const int c0 = n * BW + (tid_ & 15) * 8;
    const int s0 = cg < LRU_NCH_P ? 0 : LP, len = cg < LRU_NCH_P ? LP : LS;
    f32x4 w[4][2]; f32x4 b0 = *(const f32x4*)(bc + c0), b1 = *(const f32x4*)(bc + c0 + 4);
#pragma unroll
    for (int j = 0; j < 4; ++j) { w[j][0] = *(const f32x4*)(wc + j * LW + c0); w[j][1] = *(const f32x4*)(wc + j * LW + c0 + 4); }
#pragma unroll
    for (int i = 0; i < 8; ++i) {
        const int t = cg * LRU_CH + (tid_ >> 4) + 32 * i, tl = t - s0;
        f32x4 a0 = b0, a1 = b1;
#pragma unroll
        for (int j = 0; j < 4; ++j) { const int tt = tl + j - 2; if (tt < 0 || tt >= len) continue;
            f32x4 x0, x1; pg8::unpack8(*(const u32x4*)(XR + (size_t)(s0 + tt) * LW + c0), x0, x1); a0 += w[j][0] * x0; a1 += w[j][1] * x1; }
        const int tg = t & 63, cq = tid_ & 15;
        *(u32x4*)(XC + ((size_t)(((((t >> 6) * NBLK + n) * 4 + ((tg >> 2) & 3)) * 4 + (cq & 3)) * 16 + 4 * (tg >> 4) + (tg & 3)) * 4 + (cq >> 2)) * 8) = pg8::pack8(a0, a1);
    }
}
__device__ __forceinline__ void lru_pass_a(Frame& F) {
    const int fr = F.lane & 15, fq = F.lane >> 4, w = F.wave;
    const bf16_t* XC = wsp<bf16_t>(F, WS_XC); f32x2* SUMM = wsp<f32x2>(F, WS_SUM);
    bf16x8 idf0, idf1; lru_idfrags(w, fr, fq, idf0, idf1);
    for (int u = blockIdx.x; u < LRU_NCH * NBLK; u += F.G) {
        const int cg = u >> 4, n = u & 15;
        conv_unit(F, cg, n); VM_WAIT(); __syncthreads();
        LruW Wf, Wb; lru_load_w<0>(F, Wf, n, w, fr, fq); lru_load_w<1>(F, Wb, n, w, fr, fq);
        const bool c_first = (cg == 0 || cg == LRU_NCH_P), c_last = (cg == LRU_NCH_P - 1 || cg == LRU_NCH - 1);
        float Af = 1.f, Hf = 0.f, Ab = 1.f, Hb = 0.f;
        LruX X, Xn; lru_load_x(X, XC, cg * LRU_CH, n, fr, fq);
        for (int gi = 0; gi < 4; ++gi) {
            if (gi < 3) lru_load_x(Xn, XC, cg * LRU_CH + (gi + 1) * 64, n, fr, fq);
            float pf = 1.f, hf = 0.f, pb = 1.f, hb = 0.f;
#pragma unroll
            for (int tau = 0; tau < 4; ++tau) {
                f32x4 prf, pif, prb, pib, xct, xct2;
                lru_tile(X, tau, (w & 1) != 0, Wf, idf0, idf1, prf, pif, xct);
                lru_tile(X, tau, (w & 1) != 0, Wb, idf0, idf1, prb, pib, xct2);
#pragma unroll
                for (int j = 0; j < 4; ++j) {
                    float a, uu;
                    lru_gate(prf[j], pif[j], xct[j], Wf, c_first && gi == 0 && fq == 0 && tau == 0 && j == 0, a, uu); hf = a * hf + uu; pf *= a;
                    lru_gate(prb[j], pib[j], xct[j], Wb, c_last && gi == 3 && fq == 3 && tau == 3 && j == 3, a, uu); hb += pb * uu; pb *= a;
                }
            }
            float gPf = 1.f, gHf = 0.f, gPb = 1.f, gHb = 0.f;
#pragma unroll
            for (int qq = 0; qq < 4; ++qq) { const int src = fr + 16 * qq;
                float P = __shfl(pf, src), H = __shfl(hf, src); gHf = P * gHf + H; gPf *= P;
                P = __shfl(pb, src); H = __shfl(hb, src); gHb += gPb * H; gPb *= P; }
            Hf = gPf * Hf + gHf; Af *= gPf; Hb += Ab * gHb; Ab *= gPb;
            X = Xn;
        }
        if (fq == 0) { const int ch = n * BW + 16 * w + fr; SUMM[(size_t)(cg * 2 + 0) * LW + ch] = (f32x2){Af, Hf}; SUMM[(size_t)(cg * 2 + 1) * LW + ch] = (f32x2){Ab, Hb}; }
    }
}
__device__ __forceinline__ void lru_pass_b(Frame& F) {
    const int tid_ = opaque(F.tid);
    const int gt = blockIdx.x * NTHR + tid_; if (gt >= 4 * LW) return;
    const int ch = gt % LW, d = (gt / LW) & 1, seq = gt / (2 * LW), c0 = seq ? LRU_NCH_P : 0, nc = seq ? LRU_NCH - LRU_NCH_P : LRU_NCH_P;
    const f32x2* SUMM = wsp<f32x2>(F, WS_SUM); float* CIN = wsp<float>(F, WS_SUM + 4 * MiB);
    float s = 0.f;
    for (int i0 = 0; i0 < nc; i0 += 8) {
        f32x2 ah[8];
#pragma unroll
        for (int e = 0; e < 8; ++e) { const int cg = d ? c0 + nc - 1 - (i0 + e) : c0 + i0 + e; ah[e] = SUMM[(size_t)(cg * 2 + d) * LW + ch]; }
#pragma unroll
        for (int e = 0; e < 8; ++e) { const int cg = d ? c0 + nc - 1 - (i0 + e) : c0 + i0 + e; CIN[(size_t)(cg * 2 + d) * LW + ch] = s; s = ah[e].x * s + ah[e].y; }
    }
}
template <int LDBG = 0> __device__ __forceinline__ void lru_pass_c(Frame& F) {
    const int tid_ = opaque(F.tid);
    const int fr = F.lane & 15, fq = F.lane >> 4, w = F.wave;
    const bf16_t* XC = wsp<bf16_t>(F, WS_XC); const float* CIN = wsp<float>(F, WS_SUM + 4 * MiB);
    const bf16_t* GR = wsp<bf16_t>(F, WS_GR); bf16_t* LRU = wsp<bf16_t>(F, WS_XR);
    LAS bf16_t* hfb = (LAS bf16_t*)(F.lds + w * 8192);
    LAS bf16_t* grt = (LAS bf16_t*)(F.lds + 65536);
    bf16x8 idf0, idf1; lru_idfrags(w, fr, fq, idf0, idf1);
    for (int u = blockIdx.x; u < LRU_NCH * NBLK; u += F.G) {
        const int cg = u >> 4, n = u & 15, ch = n * BW + 16 * w + fr;
        const bool c_first = (cg == 0 || cg == LRU_NCH_P), c_last = (cg == LRU_NCH_P - 1 || cg == LRU_NCH - 1);
        { const bf16_t* gsrc = GR + (size_t)(cg * LRU_CH + (tid_ >> 4)) * LW + n * BW + (tid_ & 15) * 8; LAS bf16_t* ldst = grt + w * 512;
#pragma unroll 1
          for (int k = 0; k < 8; ++k) { __builtin_amdgcn_global_load_lds((const unsigned*)gsrc, (LAS unsigned*)ldst, 16, 0, 0); gsrc += (size_t)32 * LW; ldst += NTHR * 8; } }
        {
            LruW W; lru_load_w<0>(F, W, n, w, fr, fq);
            float s = CIN[(size_t)(cg * 2 + 0) * LW + ch];
            LruX X, Xn; lru_load_x(X, XC, cg * LRU_CH, n, fr, fq);
            for (int gi = 0; gi < 4; ++gi) {
                if (gi < 3 && LDBG != 2) lru_load_x(Xn, XC, cg * LRU_CH + (gi + 1) * 64, n, fr, fq);
                float a[16], uu[16];
#pragma unroll
                for (int tau = 0; tau < 4; ++tau) { f32x4 pr, pi, xct; lru_tile(X, tau, (w & 1) != 0, W, idf0, idf1, pr, pi, xct);
#pragma unroll
                    for (int j = 0; j < 4; ++j) lru_gate<LDBG>(pr[j], pi[j], xct[j], W, c_first && gi == 0 && fq == 0 && tau == 0 && j == 0, a[4 * tau + j], uu[4 * tau + j]); }
                float p = 1.f, h = 0.f;
#pragma unroll
                for (int t = 0; t < 16; ++t) { h = a[t] * h + uu[t]; p *= a[t]; }
                float hin = s, sg = s;
#pragma unroll
                for (int qq = 0; qq < 4; ++qq) { const float P = __shfl(p, fr + 16 * qq), H = __shfl(h, fr + 16 * qq); sg = P * sg + H; if (qq < fq) hin = P * hin + H; }
                s = sg;
                float hh = hin;
#pragma unroll
                for (int t = 0; t < 16; ++t) { hh = a[t] * hh + uu[t]; hfb[(gi * 64 + 16 * fq + t) * 16 + fr] = (bf16_t)f2bf(hh); }
                X = Xn;
            }
        }
        VM_WAIT(); __syncthreads();
        {
            LruW W; lru_load_w<1>(F, W, n, w, fr, fq);
            float s = CIN[(size_t)(cg * 2 + 1) * LW + ch];
            LruX X, Xn; lru_load_x(X, XC, cg * LRU_CH + 3 * 64, n, fr, fq);
            for (int gi = 3; gi >= 0; --gi) {
                if (gi > 0 && LDBG != 2) lru_load_x(Xn, XC, cg * LRU_CH + (gi - 1) * 64, n, fr, fq);
                float a[16], uu[16];
#pragma unroll
                for (int tau = 0; tau < 4; ++tau) { f32x4 pr, pi, xct; lru_tile(X, tau, (w & 1) != 0, W, idf0, idf1, pr, pi, xct);
#pragma unroll
                    for (int j = 0; j < 4; ++j) lru_gate<LDBG>(pr[j], pi[j], xct[j], W, c_last && gi == 3 && fq == 3 && tau == 3 && j == 3, a[4 * tau + j], uu[4 * tau + j]); }
                float p = 1.f, h = 0.f;
#pragma unroll
                for (int t = 15; t >= 0; --t) { h = a[t] * h + uu[t]; p *= a[t]; }
                float hin = s, sg = s;
#pragma unroll
                for (int qq = 3; qq >= 0; --qq) { const float P = __shfl(p, fr + 16 * qq), H = __shfl(h, fr + 16 * qq); sg = P * sg + H; if (qq > fq) hin = P * hin + H; }
                s = sg;
                float hh = hin;
#pragma unroll
                for (int t = 15; t >= 0; --t) { hh = a[t] * hh + uu[t];
                    const int tl = gi * 64 + 16 * fq + t; LAS bf16_t* gp = grt + tl * BW + 16 * w + fr;
                    *gp = (bf16_t)f2bf((bf1(hfb[tl * 16 + fr]) + hh) * gelu_tanh(bf1(*gp))); }
                X = Xn;
            }
        }
        LDS_WAIT(); __syncthreads();
        { bf16_t* gdst = LRU + (size_t)(cg * LRU_CH + (tid_ >> 4)) * LW + n * BW + (tid_ & 15) * 8; const LAS bf16_t* lsrc = grt + tid_ * 8;
#pragma unroll 1
          for (int k = 0; k < 8; ++k) { *(u32x4*)gdst = *(const LAS u32x4*)lsrc; gdst += (size_t)32 * LW; lsrc += NTHR * 8; } }
        LDS_WAIT(); __syncthreads();
    }
}

__device__ __forceinline__ f32x4 up4(const u32x2 u) { return (f32x4){bflo(u.x), bfhi(u.x), bflo(u.y), bfhi(u.y)}; }
__device__ __forceinline__ void mid_phase(Frame& F) {
    const int tid_ = opaque(F.tid);
    const bf16_t* MIX = wsp<bf16_t>(F, WS_MIX); bf16_t* XN = wsp<bf16_t>(F, WS_XN); float* RSTD = wsp<float>(F, WS_RSTD);
    LAS f32x4* gpost = (LAS f32x4*)F.lds; LAS f32x4* gpre = gpost + D / 4;
    for (int i = tid_; i < D / 4; i += NTHR) { gpost[i] = ((const f32x4*)F.in_GMPOST)[i]; gpre[i] = ((const f32x4*)F.in_GFPRE)[i]; }
    __syncthreads();
    for (int m = F.gw; m < L; m += F.ngw) {
        asm volatile("" ::: "memory");
        const f32x4* xr = (const f32x4*)xrow(F, m) + F.lane; const u32x2* mr = (const u32x2*)(MIX + (size_t)m * D) + F.lane;
        f32x4 v[16]; u32x2 mx[16]; float s = 0.f;
#pragma unroll
        for (int j = 0; j < 16; ++j) { v[j] = xr[64 * j]; mx[j] = mr[64 * j]; const f32x4 a = up4(mx[j]); s += (a.x * a.x + a.y * a.y) + (a.z * a.z + a.w * a.w); }
        const float rstd1 = 1.0f / sqrtf(wave_sum(s) * (1.0f / D) + EPS);
        if (F.lane == 0) RSTD[m] = rstd1;
        float s2 = 0.f;
#pragma unroll
        for (int j = 0; j < 16; ++j) { v[j] = v[j] + up4(mx[j]) * rstd1 * gpost[F.lane + 64 * j]; s2 += (v[j].x * v[j].x + v[j].y * v[j].y) + (v[j].z * v[j].z + v[j].w * v[j].w); }
        const float rstd2 = 1.0f / sqrtf(wave_sum(s2) * (1.0f / D) + EPS);
        u32x2* o8 = (u32x2*)(XN + (size_t)m * D) + F.lane;
#pragma unroll
        for (int j = 0; j < 16; ++j) { const f32x4 g = gpre[F.lane + 64 * j]; u32x2 o; o.x = pk2(v[j].x * rstd2 * g.x, v[j].y * rstd2 * g.y); o.y = pk2(v[j].z * rstd2 * g.z, v[j].w * rstd2 * g.w); o8[64 * j] = o; }
    }
    __syncthreads();
}
__device__ __forceinline__ void final_phase(Frame& F) {
    const int tid_ = opaque(F.tid);
    const bf16_t* MIX = wsp<bf16_t>(F, WS_MIX); const bf16_t* FB = wsp<bf16_t>(F, WS_F); const float* RSTD = wsp<float>(F, WS_RSTD);
    LAS f32x4* gpost = (LAS f32x4*)F.lds; LAS f32x4* gfp = gpost + D / 4;
    for (int i = tid_; i < D / 4; i += NTHR) { gpost[i] = ((const f32x4*)F.in_GMPOST)[i]; gfp[i] = ((const f32x4*)F.in_GFPOST)[i]; }
    __syncthreads();
    for (int m = F.gw; m < L; m += F.ngw) {
        asm volatile("" ::: "memory");
        const f32x4* xr = (const f32x4*)xrow(F, m) + F.lane; const u32x2* mr = (const u32x2*)(MIX + (size_t)m * D) + F.lane; const u32x2* fr = (const u32x2*)(FB + (size_t)m * D) + F.lane;
        const float rstd1 = RSTD[m];
        u32x2 fx[16]; float s = 0.f;
#pragma unroll
        for (int j = 0; j < 16; ++j) { fx[j] = fr[64 * j]; const f32x4 a = up4(fx[j]); s += (a.x * a.x + a.y * a.y) + (a.z * a.z + a.w * a.w); }
        const float rstd3 = 1.0f / sqrtf(wave_sum(s) * (1.0f / D) + EPS);
        f32x4* o = (f32x4*)(F.out + (size_t)m * D) + F.lane;
#pragma unroll
        for (int j = 0; j < 16; ++j) o[64 * j] = xr[64 * j] + up4(mr[64 * j]) * rstd1 * gpost[F.lane + 64 * j] + up4(fx[j]) * rstd3 * gfp[F.lane + 64 * j];
    }
}

constexpr int LDS_STAGE = pg8::STAGE_BYTES;
constexpr int LDS_MISC = LDS_STAGE;
constexpr int LDS_BYTES = LDS_STAGE + 1024;
#ifndef MK_N_LAUNCHES
#define MK_N_LAUNCHES 1
#endif
constexpr int NPHASE = 11;
struct Args { const float* in[23]; float* out; unsigned char* ws; int ph_lo, ph_hi; };

__global__ void __launch_bounds__(NTHR, 2) fwd_kernel(Args args) {
    extern __shared__ __attribute__((aligned(16))) unsigned char lds_raw[];
    Frame F;
    F.lds = (LAS unsigned char*)lds_raw;
    F.tid = threadIdx.x; F.lane = (int)__builtin_amdgcn_mbcnt_hi(~0u, __builtin_amdgcn_mbcnt_lo(~0u, 0u)); F.wave = __builtin_amdgcn_readfirstlane(F.tid >> 6);
    F.G = gridDim.x; F.gw = blockIdx.x * NWAVES + F.wave; F.ngw = F.G * NWAVES;
    F.in_XP = args.in[0]; F.in_XS = args.in[1]; F.in_WIN = args.in[2]; F.in_WCONV = args.in[3]; F.in_BCONV = args.in[4]; F.in_WR = args.in[5]; F.in_BR = args.in[6]; F.in_WI = args.in[7]; F.in_BI = args.in[8]; F.in_LAM = args.in[9]; F.in_RPB = args.in[10]; F.in_WNO = args.in[11]; F.in_WLO = args.in[12]; F.in_WM = args.in[13]; F.in_BM = args.in[14]; F.in_WOUT = args.in[15]; F.in_GMPRE = args.in[16]; F.in_GMPOST = args.in[17]; F.in_GFPRE = args.in[18]; F.in_GFPOST = args.in[19]; F.in_WFG = args.in[20]; F.in_WFU = args.in[21]; F.in_WFD = args.in[22];
    F.out = args.out; F.ws = args.ws;
    volatile LAS unsigned* MISC = (volatile LAS unsigned*)(F.lds + LDS_MISC);
    if (F.tid < 256) MISC[F.tid] = 0u;
    __syncthreads();
    const int lo = args.ph_lo, hi = args.ph_hi;
    const bool fused = (hi - lo) > 1;
    XcdBarrier bar; bar.bar = (unsigned*)(F.ws + WS_CTL); bar.x = 0; bar.st = nullptr;
    if (fused) bar = xcd_barrier_post((unsigned*)(F.ws + WS_CTL), MISC + 8);
#ifndef PH_MASK
#define PH_MASK 0x7ff
#endif
#define IN(k) (((PH_MASK >> (k)) & 1) && lo <= (k) && (k) < hi)
#define SEAM(k) do { if (IN(k) && IN((k) + 1)) xcd_barrier(bar); } while (0)
    LAS unsigned char* stage = F.lds;

#ifdef ATTN_OUT_OFF
#define NA_BUF ((size_t)ATTN_OUT_OFF * MiB)
#else
#define NA_BUF WS_Q
#endif
#ifndef DUP_MASK
#define DUP_MASK 0
#endif
#define RUN(k, ...) if (IN(k)) { __VA_ARGS__ if (((DUP_MASK) >> (k)) & 1) { __VA_ARGS__ } }
    RUN(0, { p0_prologue(F); }) SEAM(0);
    RUN(1, {
        { pg8::Gemm g{wsp<bf16_t>(F, WS_XN), wsp<bf16_t>(F, WS_XN), 1 << 30, wsp<bf16_t>(F, WS_WCAT), L, 4 * NAW, 2 * D}; pg8::StaticOrder S; S.init(L, 4 * NAW, F.G, (int)blockIdx.x);
          pg8::EpiProj E{wsp<bf16_t>(F, WS_Q), wsp<bf16_t>(F, WS_XR), wsp<bf16_t>(F, WS_K), wsp<bf16_t>(F, WS_GR), (bf16_t*)F.out, F.in_BM, 1 << 30};
          pg8::gemm_phase<pg8::EpiProj, pg8::StaticOrder, true, true, false>(stage, g, S, E); }
        { pg8::Gemm g{wsp<bf16_t>(F, WS_XN8), wsp<bf16_t>(F, WS_XN8), 1 << 30, wsp<bf16_t>(F, WS_W8), L, 2 * D, D}; pg8::StaticOrder S; S.init(L, 2 * D, F.G, (int)blockIdx.x);
          pg8::EpiProj E{wsp<bf16_t>(F, WS_Q), wsp<bf16_t>(F, WS_XR), wsp<bf16_t>(F, WS_K), wsp<bf16_t>(F, WS_GR), (bf16_t*)F.out, F.in_BM, 0};
          pg8::gemm_phase<pg8::EpiProj, pg8::StaticOrder, true, true, true>(stage, g, S, E); }
        { pg8::Gemm g{wsp<bf16_t>(F, WS_WVT), wsp<bf16_t>(F, WS_WVT), 1 << 30, wsp<bf16_t>(F, WS_XN8), NAW, L, D}; pg8::StaticOrder S; S.init(NAW, L, F.G, (int)blockIdx.x);
          pg8::EpiVT E{wsp<bf16_t>(F, WS_VT)};
          pg8::gemm_phase<pg8::EpiVT, pg8::StaticOrder, true, true, true>(stage, g, S, E); }
    }) SEAM(1);
    RUN(2, { lru_pass_a(F); }) SEAM(2);
    #ifdef ATTN_OUT_OFF
    if (IN(3)) { lru_pass_b(F); } SEAM(3);
    if (IN(4)) { lru_pass_c<0>(F); xcd_barrier(bar); if (ATTN_DUP) attn_mfma<ATTN_DUP - 1>(F); attn_mfma<0>(F); } SEAM(4);
#else
    if (IN(3)) { lru_pass_b(F); attn_mfma<0>(F); } SEAM(3);
#ifdef LRUC_DBG
    if (IN(4)) { lru_pass_c<LRUC_DBG>(F); lru_pass_c<0>(F); } SEAM(4);
#else
    RUN(4, { lru_pass_c<0>(F); }) SEAM(4);
#endif
#endif
    if (IN(5)) {
        { pg8::Gemm g{wsp<bf16_t>(F, NA_BUF), wsp<bf16_t>(F, NA_BUF), 1 << 30, wsp<bf16_t>(F, WS_WNO), L, D, 2 * NAW}; pg8::StaticOrder S; S.init(L, D, F.G, (int)blockIdx.x);
          pg8::EpiMulG<false> E{wsp<bf16_t>(F, WS_T1), (const bf16_t*)F.out, 0};
          pg8::gemm_phase<pg8::EpiMulG<false>, pg8::StaticOrder, true, true>(stage, g, S, E); }
        { pg8::Gemm g{wsp<bf16_t>(F, WS_XR), wsp<bf16_t>(F, WS_XR), 1 << 30, wsp<bf16_t>(F, WS_WLO), L, D, 2 * LW}; pg8::StaticOrder S; S.init(L, D, F.G, (int)blockIdx.x);
          pg8::EpiMulG<true> E{wsp<bf16_t>(F, WS_T1), (const bf16_t*)F.out, D};
          pg8::gemm_phase<pg8::EpiMulG<true>, pg8::StaticOrder, true, true>(stage, g, S, E); }
    } SEAM(5);
    RUN(6, {
        pg8::Gemm g{wsp<bf16_t>(F, WS_T1), wsp<bf16_t>(F, WS_T1), 1 << 30, wsp<bf16_t>(F, WS_WO), L, D, 2 * D}; pg8::StaticOrder S; S.init(L, D, F.G, (int)blockIdx.x);
        pg8::EpiPlain E{wsp<bf16_t>(F, WS_MIX), D};
        pg8::gemm_phase<pg8::EpiPlain, pg8::StaticOrder, true, true>(stage, g, S, E);
    }) SEAM(6);
    RUN(7, { mid_phase(F); }) SEAM(7);
#ifdef GEMM_DBG
    if (IN(8)) {
        pg8::Gemm g{wsp<bf16_t>(F, WS_XN), wsp<bf16_t>(F, WS_XN), 1 << 30, wsp<bf16_t>(F, WS_WGU), L, 2 * DFF, 2 * D}; pg8::StaticOrder S; S.init(L, 2 * DFF, F.G, (int)blockIdx.x);
        pg8::EpiSwiglu E{(bf16_t*)F.out, wsp<bf16_t>(F, WS_HIDS), LP / 256};
        pg8::gemm_phase<pg8::EpiSwiglu, pg8::StaticOrder, true, true, false, GEMM_DBG>(stage, g, S, E);
    }
#endif
    RUN(8, {
        pg8::Gemm g{wsp<bf16_t>(F, WS_XN), wsp<bf16_t>(F, WS_XN), 1 << 30, wsp<bf16_t>(F, WS_WGU), L, 2 * DFF, 2 * D}; pg8::StaticOrder S; S.init(L, 2 * DFF, F.G, (int)blockIdx.x);
        pg8::EpiSwiglu E{(bf16_t*)F.out, wsp<bf16_t>(F, WS_HIDS), LP / 256};
        pg8::gemm_phase<pg8::EpiSwiglu, pg8::StaticOrder, false, true>(stage, g, S, E);
    }) SEAM(8);
    RUN(9, {
        pg8::Gemm g{(const bf16_t*)F.out, wsp<bf16_t>(F, WS_HIDS), LP / 256, wsp<bf16_t>(F, WS_WD), L, D, 2 * DFF}; pg8::StaticOrder S; S.init(L, D, F.G, (int)blockIdx.x);
        pg8::EpiPlain E{wsp<bf16_t>(F, WS_F), D};
        pg8::gemm_phase<pg8::EpiPlain, pg8::StaticOrder, true, true>(stage, g, S, E);
    }) SEAM(9);
    RUN(10, { final_phase(F); })
#undef RUN
#undef IN
#undef SEAM
}

extern "C" void kernel_launch(void* const* d_in, const int* in_sizes, int n_in, void* d_out, int out_size, void* d_ws, size_t ws_size, hipStream_t stream) {
    static int grid = 0;
    if (grid == 0) {
        if (n_in != 23 || in_sizes[0] != LP * D || in_sizes[1] != LS * D || out_size != L * D || ws_size < WS_END) {
            fprintf(stderr, "kernel_launch: unexpected shapes: n_in %d in0 %d out %d ws %zu (need %zu)\n", n_in, n_in > 0 ? in_sizes[0] : -1, out_size, ws_size, (size_t)WS_END); grid = -1; return; }
        int dev = 0, cus = 0, per_cu = 0;
        if (hipGetDevice(&dev) != hipSuccess || hipDeviceGetAttribute(&cus, hipDeviceAttributeMultiprocessorCount, dev) != hipSuccess) { grid = -1; return; }
        if (hipFuncSetAttribute((const void*)fwd_kernel, hipFuncAttributeMaxDynamicSharedMemorySize, LDS_BYTES) != hipSuccess) { fprintf(stderr, "kernel_launch: hipFuncSetAttribute failed\n"); grid = -1; return; }
        if (hipOccupancyMaxActiveBlocksPerMultiprocessor(&per_cu, (const void*)fwd_kernel, NTHR, LDS_BYTES) != hipSuccess || per_cu < 1) { fprintf(stderr, "kernel_launch: occupancy query says %d\n", per_cu); }
        (void)hipGetLastError();
        grid = cus;
    }
    if (grid < 0) return;
    (void)hipMemsetAsync((char*)d_ws + WS_CTL, 0, CTL_ZERO_BYTES, stream);
#ifdef DBG_ZERO_ALL
    (void)hipMemsetAsync((char*)d_ws, 0, WS_END, stream); (void)hipMemsetAsync((char*)d_out, 0, (size_t)L * D * 4, stream);
#endif
    Args a{};
    for (int i = 0; i < 23; ++i) a.in[i] = (const float*)d_in[i];
    a.out = (float*)d_out; a.ws = (unsigned char*)d_ws;
#if MK_N_LAUNCHES == 1
    a.ph_lo = 0; a.ph_hi = NPHASE;
    hipLaunchKernelGGL(fwd_kernel, dim3(grid), dim3(NTHR), LDS_BYTES, stream, a);
#else
    for (int p = 0; p < NPHASE; ++p) {
#ifdef DBG_PH_MASK
        if (!((DBG_PH_MASK >> p) & 1)) continue;
#endif
        a.ph_lo = p; a.ph_hi = p + 1; hipLaunchKernelGGL(fwd_kernel, dim3(grid), dim3(NTHR), LDS_BYTES, stream, a); }
#endif
}
```

```cpp
#include <hip/hip_runtime.h>
#include <cstdio>
#include <cstdint>

#define LAS __attribute__((address_space(3)))
typedef unsigned short bf16_t;
typedef short bf16x8 __attribute__((ext_vector_type(8)));
typedef float f32x4 __attribute__((ext_vector_type(4)));
typedef float f32x2 __attribute__((ext_vector_type(2)));
typedef unsigned u32x4 __attribute__((ext_vector_type(4)));
typedef unsigned u32x2 __attribute__((ext_vector_type(2)));

constexpr int D = 4096, LP = 16384, LS = 8192, L = LP + LS;
constexpr int GRIDW = 64, HD = 128, NH = 16, NAW = 2048, LW = 2048, NBLK = 16, BW = 128, DFF = 11008, INW = 10240;
constexpr float EPS = 1e-6f;
constexpr int NWAVES = 8, NTHR = 512;

constexpr size_t MiB = 1u << 20;
constexpr size_t WS_CTL = 0, CTL_ZERO_BYTES = 64 * 1024;
constexpr size_t WS_RSTD = 1 * MiB;
constexpr size_t WS_SUM = 2 * MiB;
constexpr size_t WS_WCAT = 8 * MiB;
constexpr size_t WS_WVT = 72 * MiB;
constexpr size_t WS_W8 = 88 * MiB;
constexpr size_t WS_XN8 = 120 * MiB;
constexpr size_t WS_WNO = 216 * MiB;
constexpr size_t WS_WLO = 232 * MiB;
constexpr size_t WS_WO = 248 * MiB;
constexpr size_t WS_WGU = 280 * MiB;
constexpr size_t WS_WD = 452 * MiB;
constexpr size_t WS_WG = 538 * MiB;
constexpr size_t WS_XN = 540 * MiB;
constexpr size_t WS_Q = 732 * MiB;
constexpr size_t WS_XR = 828 * MiB;
constexpr size_t WS_K = 924 * MiB;
constexpr size_t WS_VT = 1020 * MiB;
constexpr size_t WS_GR = 1116 * MiB;
constexpr size_t WS_XC = 1212 * MiB;
constexpr size_t WS_END = 1308 * MiB;
constexpr size_t WS_T1 = WS_K;
constexpr size_t WS_MIX = WS_GR;
constexpr size_t WS_HIDS = WS_Q;
constexpr size_t WS_F = WS_K;
constexpr size_t WS_HF = WS_K;

#define LDS_WAIT() asm volatile("s_waitcnt lgkmcnt(0)" ::: "memory")
#define VM_WAIT() asm volatile("s_waitcnt vmcnt(0)" ::: "memory")
typedef __bf16 bf16x2n_t __attribute__((ext_vector_type(2)));
__device__ __forceinline__ unsigned pk2(float lo, float hi) { const bf16x2n_t r = __builtin_convertvector((f32x2){lo, hi}, bf16x2n_t); return __builtin_bit_cast(unsigned, r); }
__device__ __forceinline__ unsigned f2bf(float f) { return pk2(f, 0.f) & 0xffffu; }
__device__ __forceinline__ float bflo(unsigned u) { return __builtin_bit_cast(float, u << 16); }
__device__ __forceinline__ float bfhi(unsigned u) { return __builtin_bit_cast(float, u & 0xffff0000u); }
__device__ __forceinline__ float bf1(bf16_t u) { return __builtin_bit_cast(float, (unsigned)u << 16); }
__device__ __forceinline__ float wave_sum(float v) {
#pragma unroll
    for (int o = 1; o < 64; o <<= 1) v += __shfl_xor(v, o);
    return v;
}
__device__ __forceinline__ float wave_max(float v) {
#pragma unroll
    for (int o = 1; o < 64; o <<= 1) v = fmaxf(v, __shfl_xor(v, o));
    return v;
}
__device__ __forceinline__ float sigmoidf_(float v) { return __builtin_amdgcn_rcpf(1.0f + __expf(-v)); }
__device__ __forceinline__ float gelu_tanh(float v) { const float y = 0.7978845608f * (v + 0.044715f * v * v * v); const float e = __expf(2.0f * y); return 0.5f * v * (2.0f - 2.0f * __builtin_amdgcn_rcpf(e + 1.0f)); }

namespace pg8 {
constexpr int BM = 256, BK = 64, HALF = 128, HTB = HALF * BK * 2  , STAGE_BYTES = 8 * HTB, NXCD = 8, WGM = 4;

__host__ __device__ __forceinline__ int lds_byte(int r, int c) { return (r >> 3) * 1024 + (r & 7) * 128 + ((((c >> 3) ^ r) & 7) << 4) + (c & 7) * 2; }
__host__ __device__ __forceinline__ void stage_rc(int b, int& R, int& C) { const int ch = b >> 10, rr = (b >> 7) & 7, slot = (b >> 4) & 7; R = ch * 8 + rr; C = ((slot ^ rr) & 7) * 8; }
__host__ __device__ __forceinline__ int perm32(int rho) { const int n = rho >> 4, i = rho & 15; return 8 * (i >> 2) + 4 * n + (i & 3); }

struct Unit { int pm, pn; };
struct Gemm {
    const bf16_t* A; const bf16_t* A2; int pm_split; const bf16_t* Bt; int M, N, rb;
    __device__ __forceinline__ const char* abase(int pm) const { const size_t t = (size_t)BM * rb; return pm < pm_split ? (const char*)A + (size_t)pm * t : (const char*)A2 + (size_t)(pm - pm_split) * t; }
    __device__ __forceinline__ const char* bbase(int pn) const { return (const char*)Bt + (size_t)pn * BM * rb; }
};

struct StaticOrder {
    int nM, nN, nwg, G, c;
    __host__ __device__ void init(int M, int N, int G_, int c_) { nM = M / BM; nN = N / BM; nwg = nM * nN; G = G_; c = c_; }
    __host__ __device__ bool next(int i, Unit& u) const {
        const long Lx = (long)i * G + c; if (Lx >= nwg) return false;
        int wgid = (int)Lx; { const int q = nwg / NXCD, r = nwg % NXCD, xcd = wgid % NXCD, off = wgid / NXCD; wgid = (xcd < r ? xcd * (q + 1) : r * (q + 1) + (xcd - r) * q) + off; }
        const int nig = WGM * nN, gid = wgid / nig, fm = gid * WGM, gsz = (nM - fm) < WGM ? (nM - fm) : WGM;
        u.pm = fm + ((wgid % nig) % gsz); u.pn = (wgid % nig) / gsz; return true;
    }
    __device__ __forceinline__ void a_ready(const Unit&) const {}
    __device__ __forceinline__ void done(const Unit&) const {}
};

typedef __bf16 bf16x2_t __attribute__((ext_vector_type(2)));
__device__ __forceinline__ unsigned cvt_pk_bf16(float lo, float hi) { const bf16x2_t r = __builtin_convertvector((f32x2){lo, hi}, bf16x2_t); return __builtin_bit_cast(unsigned, r); }
__device__ __forceinline__ u32x4 pack8(const f32x4 v0, const f32x4 v1) { u32x4 w; w.x = cvt_pk_bf16(v0[0], v0[1]); w.y = cvt_pk_bf16(v0[2], v0[3]); w.z = cvt_pk_bf16(v1[0], v1[1]); w.w = cvt_pk_bf16(v1[2], v1[3]); return w; }
__device__ __forceinline__ void unpack8(const u32x4 w, f32x4& v0, f32x4& v1) { v0 = (f32x4){bflo(w.x), bfhi(w.x), bflo(w.y), bfhi(w.y)}; v1 = (f32x4){bflo(w.z), bfhi(w.z), bflo(w.w), bfhi(w.w)}; }
__device__ __forceinline__ f32x4 sig4(const f32x4 v) { f32x4 r; r[0] = sigmoidf_(v[0]); r[1] = sigmoidf_(v[1]); r[2] = sigmoidf_(v[2]); r[3] = sigmoidf_(v[3]); return r; }

struct EpiPlain {
    static constexpr bool PERM = true, AFTER_DRAIN = false;
    bf16_t* O; int ldc;
    __device__ __forceinline__ void operator()(const f32x4 (&acc)[2][2][4][2], const Unit& u, int wr, int wc, int fr, int fq) const {
        const int row0 = u.pm * BM + wr * 64 + fr, col0 = u.pn * BM + wc * 32 + 8 * fq;
#pragma unroll
        for (int ai = 0; ai < 2; ++ai)
#pragma unroll
            for (int m = 0; m < 4; ++m) { bf16_t* rowp = O + (size_t)(row0 + ai * HALF + m * 16) * ldc + col0;
#pragma unroll
                for (int bj = 0; bj < 2; ++bj) *(u32x4*)(rowp + bj * HALF) = pack8(acc[ai][bj][m][0], acc[ai][bj][m][1]); }
    }
};
struct EpiVT {
    static constexpr bool PERM = true, AFTER_DRAIN = false;
    bf16_t* O;
    __device__ __forceinline__ void operator()(const f32x4 (&acc)[2][2][4][2], const Unit& u, int wr, int wc, int fr, int fq) const {
        const int row0 = u.pm * BM + wr * 64 + fr, col0 = u.pn * BM + wc * 32 + 8 * fq;
#pragma unroll
        for (int ai = 0; ai < 2; ++ai)
#pragma unroll
            for (int m = 0; m < 4; ++m) { const int row = row0 + ai * HALF + m * 16, hh = row >> 7, d = row & 127;
                const int dt = 2 * (d >> 5) + ((d >> 2) & 1), i = 4 * ((d >> 3) & 3) + (d & 3);
#pragma unroll
                for (int bj = 0; bj < 2; ++bj) { const int tok = col0 + bj * HALF, R = tok >> 6, o = (tok & 63) >> 3;
                    *(u32x4*)(O + ((size_t)((((R * 16 + hh) * 8 + dt) * 8 + o) * 16 + i)) * 8) = pack8(acc[ai][bj][m][0], acc[ai][bj][m][1]); } }
    }
};
struct EpiProj {
    static constexpr bool PERM = true, AFTER_DRAIN = false;
    bf16_t* P0; bf16_t* P1; bf16_t* P2; bf16_t* P3; bf16_t* G; const float* bias; int pn_gate0;
    __device__ __forceinline__ void operator()(const f32x4 (&acc)[2][2][4][2], const Unit& u, int wr, int wc, int fr, int fq) const {
        const int row0 = u.pm * BM + wr * 64 + fr;
        if (u.pn < pn_gate0) {
            const int t = u.pn >> 3; bf16_t* base = t == 0 ? P0 : (t == 1 ? P1 : (t == 2 ? P2 : P3));
            const int col0 = (u.pn & 7) * BM + wc * 32 + 8 * fq;
            if (t == 2) {
#pragma unroll
                for (int ai = 0; ai < 2; ++ai)
#pragma unroll
                    for (int m = 0; m < 4; ++m) { const int tok = row0 + ai * HALF + m * 16, R = tok >> 6, cl = tok & 63;
                        const int tokpart = (((cl >> 2) & 1) * 8 + (cl >> 3)) * 4 + (cl & 3);
#pragma unroll
                        for (int bj = 0; bj < 2; ++bj) { const int c = col0 + bj * HALF, hh = c >> 7, d0 = c & 127;
                            *(u32x4*)(base + ((size_t)(((R * 16 + hh) * 4 + (d0 >> 5)) * 64 + tokpart) * 4 + ((d0 >> 3) & 3)) * 8) = pack8(acc[ai][bj][m][0], acc[ai][bj][m][1]); } }
            } else {
#pragma unroll
            for (int ai = 0; ai < 2; ++ai)
#pragma unroll
                for (int m = 0; m < 4; ++m) { bf16_t* rowp = base + (size_t)(row0 + ai * HALF + m * 16) * NAW + col0;
#pragma unroll
                    for (int bj = 0; bj < 2; ++bj) *(u32x4*)(rowp + bj * HALF) = pack8(acc[ai][bj][m][0], acc[ai][bj][m][1]); }
            }
        } else {
            const int col0 = (u.pn - pn_gate0) * BM + wc * 32 + 8 * fq;
            f32x4 bv[2][2];
#pragma unroll
            for (int bj = 0; bj < 2; ++bj)
#pragma unroll
                for (int n = 0; n < 2; ++n) bv[bj][n] = *(const f32x4*)(bias + col0 + bj * HALF + 4 * n);
#pragma unroll
            for (int ai = 0; ai < 2; ++ai)
#pragma unroll
                for (int m = 0; m < 4; ++m) { bf16_t* rowp = G + (size_t)(row0 + ai * HALF + m * 16) * (2 * D) + col0;
#pragma unroll
                    for (int bj = 0; bj < 2; ++bj) *(u32x4*)(rowp + bj * HALF) = pack8(sig4(acc[ai][bj][m][0] + bv[bj][0]), sig4(acc[ai][bj][m][1] + bv[bj][1])); }
        }
    }
};
template <bool ADD> struct EpiMulG {
    static constexpr bool PERM = true, AFTER_DRAIN = false;
    bf16_t* O; const bf16_t* G; int goff;
    __device__ __forceinline__ void operator()(const f32x4 (&acc)[2][2][4][2], const Unit& u, int wr, int wc, int fr, int fq) const {
        const int row0 = u.pm * BM + wr * 64 + fr, col0 = u.pn * BM + wc * 32 + 8 * fq;
#pragma unroll
        for (int ai = 0; ai < 2; ++ai)
#pragma unroll
            for (int m = 0; m < 4; ++m) { const size_t row = (size_t)(row0 + ai * HALF + m * 16); bf16_t* rowp = O + row * D + col0; const bf16_t* gp = G + row * (2 * D) + goff + col0;
#pragma unroll
                for (int bj = 0; bj < 2; ++bj) {
                    f32x4 g0, g1; unpack8(*(const u32x4*)(gp + bj * HALF), g0, g1);
                    f32x4 v0 = acc[ai][bj][m][0] * g0, v1 = acc[ai][bj][m][1] * g1;
                    if (ADD) { f32x4 t0, t1; unpack8(*(const u32x4*)(rowp + bj * HALF), t0, t1); v0 += t0; v1 += t1; }
                    *(u32x4*)(rowp + bj * HALF) = pack8(v0, v1); } }
    }
};
struct EpiSwiglu {
    static constexpr bool PERM = true, AFTER_DRAIN = false;
    bf16_t* H0; bf16_t* H1; int pm_split;
    __device__ __forceinline__ void operator()(const f32x4 (&acc)[2][2][4][2], const Unit& u, int wr, int wc, int fr, int fq) const {
        bf16_t* base = u.pm < pm_split ? H0 + (size_t)u.pm * BM * DFF : H1 + (size_t)(u.pm - pm_split) * BM * DFF;
        const int row0 = wr * 64 + fr, col0 = u.pn * HALF + wc * 32 + 8 * fq;
#pragma unroll
        for (int ai = 0; ai < 2; ++ai)
#pragma unroll
            for (int m = 0; m < 4; ++m) {
                f32x4 h[2];
#pragma unroll
                for (int n = 0; n < 2; ++n) { const f32x4 g = acc[ai][0][m][n], up = acc[ai][1][m][n];
#pragma unroll
                    for (int j = 0; j < 4; ++j) h[n][j] = g[j] * sigmoidf_(g[j]) * up[j]; }
                *(u32x4*)(base + (size_t)(row0 + ai * HALF + m * 16) * DFF + col0) = pack8(h[0], h[1]); }
    }
};

typedef int v8i32 __attribute__((ext_vector_type(8)));
typedef int v4i32 __attribute__((ext_vector_type(4)));
__device__ __forceinline__ v8i32 cat8(const bf16x8 lo, const bf16x8 hi) { return __builtin_shufflevector(__builtin_bit_cast(v4i32, lo), __builtin_bit_cast(v4i32, hi), 0, 1, 2, 3, 4, 5, 6, 7); }
__device__ __forceinline__ void mfma_fp8_acc(f32x4& c, const v8i32 a, const v8i32 b, int sa, int sb) {
    asm volatile("v_mfma_scale_f32_16x16x128_f8f6f4 %0, %1, %2, %0, %3, %4 op_sel_hi:[0,0,0]" : "+v"(c) : "v"(a), "v"(b), "v"(sa), "v"(sb)); }
constexpr int FP8_SCALE = 0x73737373;
template <class Epi, class Sched, bool ALIGN_EPI = false, bool SP2 = false, bool FP8 = false, int DBG = 0>
__device__ __forceinline__ void gemm_phase(LAS unsigned char* lds, const Gemm g, const Sched& S, const Epi& E) {
    const int tid = threadIdx.x, wid = __builtin_amdgcn_readfirstlane(tid >> 6), lane = tid & 63, wr = wid >> 2, wc = wid & 3, fr = lane & 15, fq = lane >> 4;
    const int RB = g.rb, nt = RB / (BK * 2);
    unsigned voffA[2], voffB[2];
#pragma unroll
    for (int i = 0; i < 2; ++i) { int R, C; stage_rc(tid * 16 + i * 8192, R, C); const int Rb = Epi::PERM ? ((R & ~31) + perm32(R & 31)) : R;
        voffA[i] = (unsigned)(R * RB + C * 2); voffB[i] = (unsigned)(Rb * RB + C * 2); }
    const size_t kstep = (size_t)(BK * 2);
    const size_t hstep = (size_t)HALF * RB;
    const unsigned ldsw = (unsigned)wid * 1024u;
    const int aoff0 = lds_byte(wr * 64 + fr, fq * 8), aoff1 = lds_byte(wr * 64 + fr, 32 + fq * 8), boff0 = lds_byte(wc * 32 + fr, fq * 8), boff1 = lds_byte(wc * 32 + fr, 32 + fq * 8);
#define PG8_SA(b, h) (((b) * 2 + (h)) * HTB)
#define PG8_SB(b, h) ((4 + (b) * 2 + (h)) * HTB)
#define PG8_STAGE(bufoff, gbase, voff) do { if constexpr (DBG != 3) _Pragma("unroll") for (int _i = 0; _i < 2; ++_i) \
        __builtin_amdgcn_global_load_lds((const unsigned*)((const char*)(gbase) + (voff)[_i]), (LAS unsigned*)(lds + (bufoff) + ldsw + _i * 8192), 16, 0, 0); } while (0)
#define PG8_LDA(dst, b, h) do { if constexpr (DBG != 2) _Pragma("unroll") for (int m = 0; m < 4; ++m) _Pragma("unroll") for (int k = 0; k < 2; ++k) dst[m][k] = *(const LAS bf16x8*)(lds + PG8_SA(b, h) + (k ? aoff1 : aoff0) + m * 2048); } while (0)
#define PG8_LDB(dst, b, h) do { if constexpr (DBG != 2) _Pragma("unroll") for (int n = 0; n < 2; ++n) _Pragma("unroll") for (int k = 0; k < 2; ++k) dst[n][k] = *(const LAS bf16x8*)(lds + PG8_SB(b, h) + (k ? boff1 : boff0) + n * 2048); } while (0)
#define PG8_MMA(ai, bj, At, Bt) do { __builtin_amdgcn_s_setprio(1); if constexpr (DBG == 1) { } else if constexpr (FP8) { _Pragma("unroll") for (int m = 0; m < 4; ++m) _Pragma("unroll") for (int n = 0; n < 2; ++n) \
        mfma_fp8_acc(acc[ai][bj][m][n], cat8(Bt[n][0], Bt[n][1]), cat8(At[m][0], At[m][1]), fp8_sa, fp8_sb); } else { \
        _Pragma("unroll") for (int m = 0; m < 4; ++m) _Pragma("unroll") for (int n = 0; n < 2; ++n) _Pragma("unroll") for (int k = 0; k < 2; ++k) \
        acc[ai][bj][m][n] = __builtin_amdgcn_mfma_f32_16x16x32_bf16(Bt[n][k], At[m][k], acc[ai][bj][m][n], 0, 0, 0); } __builtin_amdgcn_s_setprio(0); } while (0)
#define PG8_WAIT_V(n) asm volatile("s_waitcnt vmcnt(" #n ")" ::: "memory")
#define PG8_WAIT_L(n) asm volatile("s_waitcnt lgkmcnt(" #n ")" ::: "memory")
#define PG8_BAR __builtin_amdgcn_s_barrier()
#define PG8_SCHED __builtin_amdgcn_sched_barrier(0)
    Unit cur, nxt; int ui = 0;
    const int fp8_sa = FP8_SCALE, fp8_sb = 0x7F7F7F7F;
    if (!S.next(0, cur)) return;
    f32x4 acc[2][2][4][2];
#pragma unroll
    for (int a = 0; a < 2; ++a)
#pragma unroll
        for (int b = 0; b < 2; ++b)
#pragma unroll
            for (int m = 0; m < 4; ++m)
#pragma unroll
                for (int n = 0; n < 2; ++n) acc[a][b][m][n] = (f32x4){0.f, 0.f, 0.f, 0.f};
    bf16x8 At[4][2], B0[2][2], B1[2][2];
    const char* cA = g.abase(cur.pm); const char* cB = g.bbase(cur.pn);
    S.a_ready(cur);
    if constexpr (SP2) {
        PG8_STAGE(PG8_SB(0, 0), cB, voffB); PG8_STAGE(PG8_SB(0, 1), cB + hstep, voffB); PG8_STAGE(PG8_SA(0, 0), cA, voffA); PG8_STAGE(PG8_SA(0, 1), cA + hstep, voffA);
        if (wr == 1) PG8_BAR;
        PG8_WAIT_V(2); PG8_BAR;
        PG8_STAGE(PG8_SB(1, 0), cB + kstep, voffB); PG8_STAGE(PG8_SA(1, 0), cA + kstep, voffA); PG8_STAGE(PG8_SB(1, 1), cB + hstep + kstep, voffB);
        PG8_WAIT_V(6); PG8_BAR;
    } else {
        PG8_STAGE(PG8_SB(0, 0), cB, voffB); PG8_STAGE(PG8_SA(0, 0), cA, voffA); PG8_STAGE(PG8_SB(0, 1), cB + hstep, voffB); PG8_STAGE(PG8_SA(0, 1), cA + hstep, voffA);
        if (wr == 1) PG8_BAR;
        PG8_WAIT_V(4); PG8_BAR;
        PG8_STAGE(PG8_SB(1, 0), cB + kstep, voffB); PG8_STAGE(PG8_SA(1, 0), cA + kstep, voffA); PG8_STAGE(PG8_SB(1, 1), cB + hstep + kstep, voffB);
        PG8_WAIT_V(6); PG8_BAR;
    }
    for (;;) {
        const bool has_next = S.next(ui + 1, nxt);
        const char* nA = has_next ? g.abase(nxt.pm) : cA; const char* nB = has_next ? g.bbase(nxt.pn) : cB;
        for (int t = 0; t < nt; t += 2) {
            const bool last = (t == nt - 2);
            const char* a1 = cA + (size_t)(t + 1) * kstep;
            const char* a2 = last ? nA : cA + (size_t)(t + 2) * kstep; const char* b2 = last ? nB : cB + (size_t)(t + 2) * kstep;
            const char* a3 = a2 + kstep; const char* b3 = b2 + kstep;
            if (last && has_next) S.a_ready(nxt);
            if constexpr (SP2) {
            PG8_LDB(B0, 0, 0); PG8_LDB(B1, 0, 1); PG8_SCHED; PG8_LDA(At, 0, 0); PG8_STAGE(PG8_SA(1, 1), a1 + hstep, voffA);
            PG8_WAIT_V(8); PG8_WAIT_L(0); PG8_BAR; PG8_MMA(0, 0, At, B0); PG8_MMA(0, 1, At, B1); PG8_BAR; PG8_SCHED;
            PG8_LDA(At, 0, 1); PG8_STAGE(PG8_SB(0, 0), b2, voffB); PG8_STAGE(PG8_SB(0, 1), b2 + hstep, voffB); PG8_STAGE(PG8_SA(0, 0), a2, voffA);
            PG8_WAIT_V(8); PG8_WAIT_L(0); PG8_BAR; PG8_MMA(1, 0, At, B0); PG8_MMA(1, 1, At, B1); PG8_BAR; PG8_SCHED;
            PG8_LDB(B0, 1, 0); PG8_LDB(B1, 1, 1); PG8_SCHED; PG8_LDA(At, 1, 0); PG8_STAGE(PG8_SA(0, 1), a2 + hstep, voffA);
            PG8_WAIT_V(8); PG8_WAIT_L(0); PG8_BAR; PG8_MMA(0, 0, At, B0); PG8_MMA(0, 1, At, B1); PG8_BAR; PG8_SCHED;
            PG8_LDA(At, 1, 1); PG8_STAGE(PG8_SB(1, 0), b3, voffB); PG8_STAGE(PG8_SB(1, 1), b3 + hstep, voffB); PG8_STAGE(PG8_SA(1, 0), a3, voffA);
            PG8_WAIT_V(8); PG8_WAIT_L(0); PG8_BAR; PG8_MMA(1, 0, At, B0); PG8_MMA(1, 1, At, B1); PG8_BAR; PG8_SCHED;
            } else {
            PG8_LDB(B0, 0, 0); PG8_SCHED; PG8_LDA(At, 0, 0); PG8_STAGE(PG8_SA(1, 1), a1 + hstep, voffA);
            PG8_WAIT_L(8); PG8_BAR; PG8_WAIT_L(0); PG8_MMA(0, 0, At, B0); PG8_BAR; PG8_SCHED;
            PG8_LDB(B1, 0, 1); PG8_STAGE(PG8_SB(0, 0), b2, voffB);
            PG8_BAR; PG8_WAIT_L(0); PG8_MMA(0, 1, At, B1); PG8_BAR;
            PG8_LDA(At, 0, 1); PG8_STAGE(PG8_SA(0, 0), a2, voffA);
            PG8_BAR; PG8_WAIT_L(0); PG8_MMA(1, 0, At, B0); PG8_BAR; PG8_SCHED;
            PG8_STAGE(PG8_SB(0, 1), b2 + hstep, voffB);
            PG8_WAIT_V(6); PG8_BAR; PG8_MMA(1, 1, At, B1); PG8_BAR;
            PG8_LDB(B0, 1, 0); PG8_SCHED; PG8_LDA(At, 1, 0); PG8_STAGE(PG8_SA(0, 1), a2 + hstep, voffA);
            PG8_WAIT_L(8); PG8_BAR; PG8_WAIT_L(0); PG8_MMA(0, 0, At, B0); PG8_BAR; PG8_SCHED;
            PG8_LDB(B1, 1, 1); PG8_STAGE(PG8_SB(1, 0), b3, voffB);
            PG8_BAR; PG8_WAIT_L(0); PG8_MMA(0, 1, At, B1); PG8_BAR;
            PG8_LDA(At, 1, 1); PG8_STAGE(PG8_SA(1, 0), a3, voffA);
            PG8_BAR; PG8_WAIT_L(0); PG8_MMA(1, 0, At, B0); PG8_BAR; PG8_SCHED;
            PG8_STAGE(PG8_SB(1, 1), b3 + hstep, voffB);
            PG8_WAIT_V(6); PG8_BAR; PG8_MMA(1, 1, At, B1); PG8_BAR;
            }
        }
        if constexpr (ALIGN_EPI) { if (wr == 0) PG8_BAR; }
        if constexpr (!Epi::AFTER_DRAIN) { if constexpr (DBG != 4) E(acc, cur, wr, wc, fr, fq); else { _Pragma("unroll") for (int a_ = 0; a_ < 2; ++a_) _Pragma("unroll") for (int b_ = 0; b_ < 2; ++b_) _Pragma("unroll") for (int m_ = 0; m_ < 4; ++m_) _Pragma("unroll") for (int n_ = 0; n_ < 2; ++n_) asm volatile("" :: "v"(acc[a_][b_][m_][n_])); } S.done(cur); }
        if (!has_next) break;
#pragma unroll
        for (int a = 0; a < 2; ++a)
#pragma unroll
            for (int b = 0; b < 2; ++b)
#pragma unroll
                for (int m = 0; m < 4; ++m)
#pragma unroll
                    for (int n = 0; n < 2; ++n) acc[a][b][m][n] = (f32x4){0.f, 0.f, 0.f, 0.f};
        cur = nxt; cA = nA; cB = nB; ++ui;
        if constexpr (ALIGN_EPI) { if (wr == 1) PG8_BAR; }
    }
    PG8_WAIT_V(0);
    if constexpr (!ALIGN_EPI) { if (wr == 0) PG8_BAR; }
    PG8_BAR;
    if constexpr (Epi::AFTER_DRAIN) { E.fused(acc, cur, wr, wc, fr, fq, lds, wid, lane); S.done(cur); }
#undef PG8_SA
#undef PG8_SB
#undef PG8_STAGE
#undef PG8_LDA
#undef PG8_LDB
#undef PG8_MMA
#undef PG8_WAIT_V
#undef PG8_WAIT_L
#undef PG8_BAR
#undef PG8_SCHED
}
}
#define XB_TMO      128
#define XB_XCNT(j)  (256  + 64 * (j))
#define XB_XSUB(j)  (1280 + 64 * (j))
#define XB_XGEN(j)  (2304 + 64 * (j))
#define XB_TOP      3328
#define XB_TOPGEN   3392
#define XCD_BAR_WORDS 3456
#define XB_SPIN_CAP (1u << 18)

__device__ __forceinline__ unsigned xb_ld(unsigned* p)              { return __hip_atomic_load(p, __ATOMIC_RELAXED, __HIP_MEMORY_SCOPE_AGENT); }
__device__ __forceinline__ unsigned xb_add(unsigned* p, unsigned v) { return __hip_atomic_fetch_add(p, v, __ATOMIC_RELAXED, __HIP_MEMORY_SCOPE_AGENT); }
__device__ __forceinline__ unsigned xb_xcc_id() { return (unsigned)__builtin_amdgcn_s_getreg((3 << 11) | 20) & 0xFu; }
#define XB_SPIN(cond, bar) do { unsigned _sp = 0; while (cond) { __builtin_amdgcn_s_sleep(1); \
    if ((++_sp & 255u) == 0u) { if (xb_ld(&(bar)[XB_TMO])) break; if (_sp > XB_SPIN_CAP) { atomicAdd(&(bar)[XB_TMO], 1u); break; } } } } while (0)

struct XcdBarrier {
    unsigned* bar; unsigned x;
    volatile LAS unsigned* st;
};

__device__ __forceinline__ XcdBarrier xcd_barrier_post(unsigned* bar, volatile LAS unsigned* st) {
    XcdBarrier b; b.bar = bar; b.x = xb_xcc_id(); b.st = st;
    if (threadIdx.x == 0) (void)xb_add(&bar[XB_XCNT(b.x)], 1u);
    return b;
}
__device__ __forceinline__ void xcd_barrier_complete(unsigned* bar, unsigned x, unsigned& nloc, unsigned& nx) {
    const unsigned G = gridDim.x * gridDim.y * gridDim.z;
    unsigned sum, cnt, mine, sp = 0u;
    for (;;) {
        sum = 0u; cnt = 0u; mine = 0u;
#pragma unroll
        for (unsigned j = 0; j < 16; ++j) { const unsigned c = xb_ld(&bar[XB_XCNT(j)]); sum += c; cnt += (c > 0u) ? 1u : 0u; mine = (j == x) ? c : mine; }
        if (sum == G) break;
        __builtin_amdgcn_s_sleep(1);
        if ((++sp & 255u) == 0u) { if (xb_ld(&bar[XB_TMO])) break; if (sp > XB_SPIN_CAP) { atomicAdd(&bar[XB_TMO], 1u); break; } }
    }
    nloc = mine > 0u ? mine : 1u; nx = cnt > 0u ? cnt : 1u;
}

__device__ __forceinline__ void xcd_barrier(const XcdBarrier& b) {
    asm volatile("s_waitcnt vmcnt(0)" ::: "memory");
    __syncthreads();
    if (threadIdx.x == 0) {
        unsigned* bar = b.bar;
        __builtin_amdgcn_s_waitcnt(0);
        unsigned nloc = b.st[0], nx = b.st[1];
        if (nloc == 0u) { xcd_barrier_complete(bar, b.x, nloc, nx); b.st[0] = nloc; b.st[1] = nx; }
        const unsigned old = xb_add(&bar[XB_XSUB(b.x)], 1u);
        const unsigned gen = old / nloc;
        if (old + 1u == (gen + 1u) * nloc) {
            __builtin_amdgcn_fence(__ATOMIC_RELEASE, "agent");
            asm volatile("s_waitcnt vmcnt(0)" ::: "memory");
            const unsigned og = xb_add(&bar[XB_TOP], 1u);
            const unsigned tg = og / nx;
            if (og + 1u == (tg + 1u) * nx) xb_add(&bar[XB_TOPGEN], 1u);
            else XB_SPIN(xb_ld(&bar[XB_TOPGEN]) == tg, bar);
            __builtin_amdgcn_fence(__ATOMIC_ACQUIRE, "agent");
            xb_add(&bar[XB_XGEN(b.x)], 1u);
            asm volatile("s_waitcnt vmcnt(0)" ::: "memory");
        } else {
            XB_SPIN(xb_ld(&bar[XB_XGEN(b.x)]) == gen, bar);
            __builtin_amdgcn_fence(__ATOMIC_ACQUIRE, "agent");
            asm volatile("s_waitcnt vmcnt(0)" ::: "memory");
        }
    }
    __syncthreads();
}


struct Frame {
    LAS unsigned char* lds;
    int tid, lane, wave, G, gw, ngw;
    const float *in_XP, *in_XS, *in_WIN, *in_WCONV, *in_BCONV, *in_WR, *in_BR, *in_WI, *in_BI, *in_LAM, *in_RPB, *in_WNO, *in_WLO, *in_WM, *in_BM, *in_WOUT, *in_GMPRE, *in_GMPOST, *in_GFPRE, *in_GFPOST, *in_WFG, *in_WFU, *in_WFD; float* out; unsigned char* ws;
};
enum { I_XP = 0, I_XS, I_WIN, I_WCONV, I_BCONV, I_WR, I_BR, I_WI, I_BI, I_LAM, I_RPB, I_WNO, I_WLO, I_WM, I_BM, I_WOUT, I_GMPRE, I_GMPOST, I_GFPRE, I_GFPOST, I_WFG, I_WFU, I_WFD };
__device__ __forceinline__ int opaque(int x) { asm volatile("" : "+v"(x)); return x; }
template <class T> __device__ __forceinline__ T* wsp(const Frame& F, size_t off) { return (T*)(F.ws + off); }
__device__ __forceinline__ const float* xrow(const Frame& F, int m) { return m < LP ? F.in_XP + (size_t)m * D : F.in_XS + (size_t)(m - LP) * D; }

__device__ __forceinline__ void tr_item(const float* src, int ldsrc, int k0, int n0, bf16_t* dst, int ldd, int drow0, LAS float* scr, int lane) {
#pragma unroll 8
    for (int i = 0; i < 32; ++i) { const int kk = 2 * i + (lane >> 5); scr[kk * 33 + (lane & 31)] = src[(size_t)(k0 + kk) * ldsrc + n0 + (lane & 31)]; }
    LDS_WAIT(); asm volatile("" ::: "memory");
    const int c = lane & 7;
#pragma unroll
    for (int j = 0; j < 4; ++j) { const int n = (lane >> 3) + 8 * j; const LAS float* s = scr + (8 * c) * 33 + n;
        u32x4 o; o.x = pk2(s[0 * 33], s[1 * 33]); o.y = pk2(s[2 * 33], s[3 * 33]); o.z = pk2(s[4 * 33], s[5 * 33]); o.w = pk2(s[6 * 33], s[7 * 33]);
        *(u32x4*)(dst + (size_t)(drow0 + n) * ldd + k0 + 8 * c) = o; }
    LDS_WAIT(); asm volatile("" ::: "memory");
}
__device__ __forceinline__ unsigned pk4_fp8(float a, float b, float c, float d) { int p = __builtin_amdgcn_cvt_pk_fp8_f32(a, b, 0, false); p = __builtin_amdgcn_cvt_pk_fp8_f32(c, d, p, true); return (unsigned)p; }
__device__ __forceinline__ void tr_item8(const float* src, int ldsrc, int k0, int n0, unsigned char* dst, int ldd, int drow0, LAS float* scr, int lane) {
#pragma unroll 8
    for (int i = 0; i < 32; ++i) { const int kk = 2 * i + (lane >> 5); scr[kk * 33 + (lane & 31)] = src[(size_t)(k0 + kk) * ldsrc + n0 + (lane & 31)]; }
    LDS_WAIT(); asm volatile("" ::: "memory");
    const int c = lane & 7;
#pragma unroll
    for (int j = 0; j < 4; ++j) { const int n = (lane >> 3) + 8 * j; const LAS float* s = scr + (8 * c) * 33 + n;
        u32x2 o; o.x = pk4_fp8(s[0 * 33] * 256.f, s[1 * 33] * 256.f, s[2 * 33] * 256.f, s[3 * 33] * 256.f); o.y = pk4_fp8(s[4 * 33] * 256.f, s[5 * 33] * 256.f, s[6 * 33] * 256.f, s[7 * 33] * 256.f);
        *(u32x2*)(dst + (size_t)(drow0 + n) * ldd + k0 + 8 * c) = o; }
    LDS_WAIT(); asm volatile("" ::: "memory");
}
#define TR_JOB(SRC, LDSRC, KK, NN, DST, DROW_EXPR) { const int nblk = (NN) / 32, nit = ((KK) / 64) * nblk; \
    if (r < nit) { const int kb = r / nblk, nb = r % nblk, n0 = 32 * nb; tr_item((SRC), (LDSRC), 64 * kb, n0, (DST), (KK), (DROW_EXPR), scr, F.lane); continue; } r -= nit; }
#define TR_JOB8(SRC, LDSRC, KK, NN, DST, DROW_EXPR) { const int nblk = (NN) / 32, nit = ((KK) / 64) * nblk; \
    if (r < nit) { const int kb = r / nblk, nb = r % nblk, n0 = 32 * nb; tr_item8((SRC), (LDSRC), 64 * kb, n0, (DST), (KK), (DROW_EXPR), scr, F.lane); continue; } r -= nit; }

__device__ __forceinline__ void p0_prologue(Frame& F) {
    const int tid_ = opaque(F.tid);
    LAS float* scr = (LAS float*)(F.lds + F.wave * 8448);
    const float* w_in = F.in_WIN;
    bf16_t* WCAT = wsp<bf16_t>(F, WS_WCAT); unsigned char* W8 = wsp<unsigned char>(F, WS_W8); unsigned char* WV8 = wsp<unsigned char>(F, WS_WVT); bf16_t* WGU = wsp<bf16_t>(F, WS_WGU);
    constexpr int NSM = 64;
    constexpr int IT_SM = 2 * 4;
    constexpr int N_BIG = 5 * (D / 64) * (NAW / 32) + (D / 64) * (2 * D / 32) + 2 * (NAW / 64) * (D / 32) + (D / 64) * (D / 32) + 2 * (D / 64) * (DFF / 32) + (DFF / 64) * (D / 32);
    constexpr int NITEMS = N_BIG + NSM * IT_SM;
    for (int it = F.gw; it < NITEMS; it += F.ngw) {
        int r = it;
        TR_JOB(w_in + 0, INW, D, NAW, WCAT, 0 + n0)
        TR_JOB(w_in + 3 * NAW, INW, D, NAW, WCAT, 2048 + n0)
        TR_JOB(w_in + NAW, INW, D, NAW, WCAT, 4096 + n0)
        TR_JOB(w_in + 4 * NAW, INW, D, NAW, WCAT, 6144 + n0)
        TR_JOB8(F.in_WM, 2 * D, D, 2 * D, W8, n0)
        TR_JOB8(w_in + 2 * NAW, INW, D, NAW, WV8, n0)
        TR_JOB(F.in_WNO, D, NAW, D, wsp<bf16_t>(F, WS_WNO), n0)
        TR_JOB(F.in_WLO, D, LW, D, wsp<bf16_t>(F, WS_WLO), n0)
        TR_JOB(F.in_WOUT, D, D, D, wsp<bf16_t>(F, WS_WO), n0)
        TR_JOB(F.in_WFG, DFF, D, DFF, WGU, (n0 >> 7) * 256 + (n0 & 127))
        TR_JOB(F.in_WFU, DFF, D, DFF, WGU, (n0 >> 7) * 256 + 128 + (n0 & 127))
        TR_JOB(F.in_WFD, D, DFF, D, wsp<bf16_t>(F, WS_WD), n0)
        {
            const int mi = r / IT_SM, ri = r % IT_SM, d = mi >> 5, g = (mi >> 4) & 1, n = mi & 15, kb = ri >> 2, nb = ri & 3;
            const float* src = (g ? F.in_WI : F.in_WR) + (size_t)(d * NBLK + n) * BW * BW;
            tr_item(src, BW, 64 * kb, 32 * nb, wsp<bf16_t>(F, WS_WG) + (size_t)mi * BW * BW, BW, 32 * nb, scr, F.lane);
        }
    }
    LAS f32x4* gl = (LAS f32x4*)(F.lds + 69632);
    for (int i = tid_; i < D / 4; i += NTHR) gl[i] = ((const f32x4*)F.in_GMPRE)[i];
    __syncthreads();
    bf16_t* XN = wsp<bf16_t>(F, WS_XN); unsigned char* XN8 = wsp<unsigned char>(F, WS_XN8);
    for (int m = F.gw; m < L; m += F.ngw) {
        asm volatile("" ::: "memory");
        const f32x4* xr = (const f32x4*)xrow(F, m) + F.lane;
        f32x4 v[16]; float s = 0.f;
#pragma unroll
        for (int j = 0; j < 16; ++j) { v[j] = xr[64 * j]; s += (v[j].x * v[j].x + v[j].y * v[j].y) + (v[j].z * v[j].z + v[j].w * v[j].w); }
        const float rstd = 1.0f / sqrtf(wave_sum(s) * (1.0f / D) + EPS);
        u32x2* o8 = (u32x2*)(XN + (size_t)m * D) + F.lane; unsigned* o4 = (unsigned*)(XN8 + (size_t)m * D) + F.lane;
#pragma unroll
        for (int j = 0; j < 16; ++j) { const f32x4 g = gl[F.lane + 64 * j]; const f32x4 y = v[j] * rstd * g; u32x2 o; o.x = pk2(y.x, y.y); o.y = pk2(y.z, y.w); o8[64 * j] = o;
            o4[64 * j] = pk4_fp8(y.x * 16.f, y.y * 16.f, y.z * 16.f, y.w * 16.f); }
    }
    __syncthreads();
}

#ifndef ATT_SYNC
#define ATT_SYNC 1
#endif
template <int ADBG = 0> __device__ __forceinline__ void attn_mfma(Frame& F) {
    const int tid_ = opaque(F.tid);
    bf16_t* Q = wsp<bf16_t>(F, WS_Q); const bf16_t* Kb = wsp<bf16_t>(F, WS_K); const bf16_t* VT = wsp<bf16_t>(F, WS_VT);
    LAS float* rp = (LAS float*)F.lds;
    for (int i = tid_; i < NH * 15 * 31; i += NTHR) rp[i] = F.in_RPB[i];
    __syncthreads();
    const int fr = F.lane & 15, fq = F.lane >> 4;
    const float scale = 0.08838834764831845f;
    for (int item = F.gw; item < (L / GRIDW) * NH * 4; item += F.ngw) {
        asm volatile("" ::: "memory");
        const int g = item & 3, h = (item >> 2) & 15, rg = item >> 6;
        const int s0 = rg < LP / GRIDW ? 0 : LP, rows = rg < LP / GRIDW ? LP / GRIDW : LS / GRIDW, r = rg < LP / GRIDW ? rg : rg - LP / GRIDW;
        int rs = r - 4; rs = rs < 0 ? 0 : (rs > rows - 8 ? rows - 8 : rs);
        const int w0 = g == 0 ? 0 : (g == 1 ? 8 : (g == 2 ? 24 : 32));
        const int c = 16 * g + fr;
        int cs = c - 8; cs = cs < 0 ? 0 : (cs > GRIDW - 16 ? GRIDW - 16 : cs);
        bf16_t* qrow = Q + (size_t)(s0 + r * GRIDW + c) * NAW + h * HD;
        bf16x8 qf[4];
#pragma unroll
        for (int s = 0; s < 4; ++s) qf[s] = *(const bf16x8*)(qrow + 8 * fq + 32 * s);
        f32x4 sacc[8][2];
        const int Rg = s0 / GRIDW + rs, p0 = w0 >> 3;
        const bf16_t* kbase = Kb + (size_t)(Rg * 16 + h) * 8192 + p0 * 128 + fr * 32 + fq * 8;
        bf16x8 kb[8][2][4];
#define ATT_LDK(kr) do { _Pragma("unroll") for (int T = 0; T < 2; ++T) _Pragma("unroll") for (int s = 0; s < 4; ++s) kb[kr][T][s] = (ADBG & 1) ? qf[s] : (ADBG & 4) ? *(const bf16x8*)(Kb + (size_t)(s0 + rs * GRIDW) * NAW + h * HD * GRIDW + ((kr) * 8 + T * 4 + s) * 512 + F.lane * 8) : *(const bf16x8*)(kbase + (size_t)(kr) * (16 * 8192) + (s * 2 + T) * 1024); } while (0)
        ATT_LDK(0); ATT_LDK(1);
#pragma unroll
        for (int kr = 0; kr < 8; ++kr) {
            if (ATT_SYNC && (kr & 1) == 0) __builtin_amdgcn_s_barrier();
            if (kr + 2 < 8) ATT_LDK(kr + 2);
            __builtin_amdgcn_sched_barrier(0);
#pragma unroll
            for (int T = 0; T < 2; ++T) { f32x4 a = (f32x4){0.f, 0.f, 0.f, 0.f};
#pragma unroll
                for (int s = 0; s < 4; ++s) a = __builtin_amdgcn_mfma_f32_16x16x32_bf16(kb[kr][T][s], qf[s], a, 0, 0, 0);
                sacc[kr][T] = a; }
            __builtin_amdgcn_sched_barrier(0);
        }
#undef ATT_LDK
        bf16x8 vb[8][8];
        const bf16_t* vbase = VT + (size_t)(Rg * 16 + h) * 8192 + p0 * 128 + fq * 128 + fr * 8;
#define ATT_LDV(kr) do { _Pragma("unroll") for (int dt = 0; dt < 8; ++dt) vb[kr][dt] = (ADBG & 2) ? qf[dt & 3] : (ADBG & 4) ? *(const bf16x8*)(VT + (size_t)(h * HD) * L + s0 + rs * GRIDW + ((kr) * 8 + dt) * 512 + F.lane * 8) : *(const bf16x8*)(vbase + (size_t)(kr) * (16 * 8192) + dt * 1024); } while (0)
        ATT_LDV(0); ATT_LDV(1);
        __builtin_amdgcn_sched_barrier(0);
        const int elo = cs - w0 - 8 * fq, dc0 = w0 + 8 * fq - c + 15;
        const LAS float* rph = rp + h * 465 + (rs - r + 7) * 31;
        float mx = -3.0e38f;
#pragma unroll
        for (int e = 0; e < 8; ++e) { const bool valid = (e >= elo) && (e < elo + 16); const int bi = valid ? dc0 + e : 0;
#pragma unroll
            for (int kr = 0; kr < 8; ++kr) { const float sv = valid ? sacc[kr][e >> 2][e & 3] * scale + rph[kr * 31 + bi] : -3.0e38f; sacc[kr][e >> 2][e & 3] = sv; mx = fmaxf(mx, sv); } }
        mx = fmaxf(mx, __shfl_xor(mx, 16)); mx = fmaxf(mx, __shfl_xor(mx, 32));
        float lsum = 0.f; bf16x8 pf[8];
#pragma unroll
        for (int kr = 0; kr < 8; ++kr) { float p[8];
#pragma unroll
            for (int e = 0; e < 8; ++e) { p[e] = __expf(sacc[kr][e >> 2][e & 3] - mx); lsum += p[e]; }
            u32x4 w; w.x = pk2(p[0], p[1]); w.y = pk2(p[2], p[3]); w.z = pk2(p[4], p[5]); w.w = pk2(p[6], p[7]);
            pf[kr] = __builtin_bit_cast(bf16x8, w); }
        lsum += __shfl_xor(lsum, 16); lsum += __shfl_xor(lsum, 32);
        f32x4 oacc[8];
#pragma unroll
        for (int dt = 0; dt < 8; ++dt) oacc[dt] = (f32x4){0.f, 0.f, 0.f, 0.f};
#pragma unroll
        for (int kr = 0; kr < 8; ++kr) {
            if (ATT_SYNC && (kr & 1) == 0) __builtin_amdgcn_s_barrier();
            if (kr + 2 < 8) ATT_LDV(kr + 2);
            __builtin_amdgcn_sched_barrier(0);
#pragma unroll
            for (int dt = 0; dt < 8; ++dt) oacc[dt] = __builtin_amdgcn_mfma_f32_16x16x32_bf16(vb[kr][dt], pf[kr], oacc[dt], 0, 0, 0);
            __builtin_amdgcn_sched_barrier(0);
        }
#undef ATT_LDV
        const float inv = 1.0f / lsum;
#ifdef ATTN_OUT_OFF
        bf16_t* orow = wsp<bf16_t>(F, (size_t)ATTN_OUT_OFF * MiB) + (size_t)(s0 + r * GRIDW + c) * NAW + h * HD;
#else
        bf16_t* orow = qrow;
#endif
#pragma unroll
        for (int u = 0; u < 4; ++u) *(u32x4*)(orow + 32 * u + 8 * fq) = pg8::pack8(oacc[2 * u] * inv, oacc[2 * u + 1] * inv);
    }
    __syncthreads();
}

__device__ __forceinline__ void conv_phase(Frame& F) {
    const int tid_ = opaque(F.tid);
    const bf16_t* XR = wsp<bf16_t>(F, WS_XR); bf16_t* XC = wsp<bf16_t>(F, WS_XC);
    const float* wc = F.in_WCONV; const float* bc = F.in_BCONV;
    const int nth = F.G * NTHR;
    for (int it = blockIdx.x * NTHR + tid_; it < L * (LW / 8); it += nth) {
        const int t = it / (LW / 8), c0 = (it % (LW / 8)) * 8;
        const int s0 = t < LP ? 0 : LP, len = t < LP ? LP : LS, tl = t - s0;
        float acc[8];
#pragma unroll
        for (int e = 0; e < 8; ++e) acc[e] = bc[c0 + e];
#pragma unroll
        for (int j = 0; j < 4; ++j) { const int tt = tl + j - 2; if (tt < 0 || tt >= len) continue;
            f32x4 x0, x1; pg8::unpack8(*(const u32x4*)(XR + (size_t)(s0 + tt) * LW + c0), x0, x1);
            const f32x4 w0 = *(const f32x4*)(wc + j * LW + c0), w1 = *(const f32x4*)(wc + j * LW + c0 + 4);
#pragma unroll
            for (int e = 0; e < 4; ++e) { acc[e] += w0[e] * x0[e]; acc[4 + e] += w1[e] * x1[e]; } }
        *(u32x4*)(XC + (size_t)t * LW + c0) = pg8::pack8((f32x4){acc[0], acc[1], acc[2], acc[3]}, (f32x4){acc[4], acc[5], acc[6], acc[7]});
    }
}

struct LruW { bf16x8 w[2][4]; float br, bi, cl; };
template <int DIR> __device__ __forceinline__ void lru_load_w(const Frame& F, LruW& W, int n, int w, int fr, int fq) {
    const bf16_t* wg = wsp<bf16_t>(F, WS_WG);
#pragma unroll
    for (int g = 0; g < 2; ++g)
#pragma unroll
        for (int s = 0; s < 4; ++s) W.w[g][s] = *(const bf16x8*)(wg + ((size_t)((DIR * 2 + g) * NBLK + n) * BW + 16 * w + fr) * BW + 32 * fq + 8 * s);
    const int ch = n * BW + 16 * w + fr;
    W.br = F.in_BR[DIR * LW + ch]; W.bi = F.in_BI[DIR * LW + ch];
    const float lam = F.in_LAM[DIR * LW + ch];
    W.cl = -8.0f * ((lam > 15.f) ? __expf(-lam) : log1pf(__expf(-lam)));
}
template <int LDBG = 0> __device__ __forceinline__ void lru_gate(float pr, float pi, float xc, const LruW& W, bool first, float& a, float& u) {
    if constexpr (LDBG == 1) { a = pr + W.br; u = pi * xc + W.bi; return; }
    const float r = sigmoidf_(pr + W.br), ig = sigmoidf_(pi + W.bi);
    a = __expf(W.cl * r);
    const float mult = first ? 1.0f : __builtin_amdgcn_sqrtf(fmaxf(1.0f - a * a, 0.f));
    u = mult * ig * xc;
}
struct LruX { bf16x8 x[4][4]; };
__device__ __forceinline__ void lru_load_x(LruX& X, const bf16_t* XC, int tb, int n, int fr, int fq) {
#pragma unroll
    for (int tau = 0; tau < 4; ++tau) { const bf16_t* xp = XC + ((size_t)((((tb >> 6) * NBLK + n) * 4 + tau) * 4) * 64 + fr * 4 + fq) * 8;
#pragma unroll
        for (int s = 0; s < 4; ++s) X.x[tau][s] = *(const bf16x8*)(xp + s * 512); }
}
__device__ __forceinline__ void lru_tile(const LruX& X, int tau, bool hiw, const LruW& W, const bf16x8 idf0, const bf16x8 idf1, f32x4& pr, f32x4& pi, f32x4& xct) {
    pr = (f32x4){0.f, 0.f, 0.f, 0.f}; pi = pr;
#pragma unroll
    for (int s = 0; s < 4; ++s) { pr = __builtin_amdgcn_mfma_f32_16x16x32_bf16(X.x[tau][s], W.w[0][s], pr, 0, 0, 0); pi = __builtin_amdgcn_mfma_f32_16x16x32_bf16(X.x[tau][s], W.w[1][s], pi, 0, 0, 0); }
    const bf16x8 x0 = hiw ? X.x[tau][2] : X.x[tau][0], x1 = hiw ? X.x[tau][3] : X.x[tau][1];
    xct = __builtin_amdgcn_mfma_f32_16x16x32_bf16(x0, idf0, (f32x4){0.f, 0.f, 0.f, 0.f}, 0, 0, 0);
    xct = __builtin_amdgcn_mfma_f32_16x16x32_bf16(x1, idf1, xct, 0, 0, 0);
}
__device__ __forceinline__ void lru_idfrags(int w, int fr, int fq, bf16x8& idf0, bf16x8& idf1) {
#pragma unroll
    for (int e = 0; e < 8; ++e) { const bool on = (fq == (w >> 1)) && ((fr & 7) == e); idf0[e] = (on && fr < 8) ? (short)0x3F80 : (short)0; idf1[e] = (on && fr >= 8) ? (short)0x3F80 : (short)0; }
}
constexpr int LRU_CH = 256, LRU_NCH = L / LRU_CH, LRU_NCH_P = LP / LRU_CH;
__device__ __forceinline__ void conv_unit(Frame& F, int cg, int n) {
    const int tid_ = opaque(F.tid);
    const bf16_t* XR = wsp<bf16_t>(F, WS_XR); bf16_t* XC = wsp<bf16_t>(F, WS_XC);
    const float* wc = F.in_WCONV; const float* bc = F.in_BCONV;
    const int c0 = n * BW + (tid_ & 15) * 8;
    const int s0 = cg < LRU_NCH_P ? 0 : LP, len = cg < LRU_NCH_P ? LP : LS;
    f32x4 w[4][2]; f32x4 b0 = *(const f32x4*)(bc + c0), b1 = *(const f32x4*)(bc + c0 + 4);
#pragma unroll
    for (int j = 0; j < 4; ++j) { w[j][0] = *(const f32x4*)(wc + j * LW + c0); w[j][1] = *(const f32x4*)(wc + j * LW + c0 + 4); }
#pragma unroll
    for (int i = 0; i < 8; ++i) {
        const int t = cg * LRU_CH + (tid_ >> 4) + 32 * i, tl = t - s0;
        f32x4 a0 = b0, a1 = b1;
#pragma unroll
        for (int j = 0; j < 4; ++j) { const int tt = tl + j - 2; if (tt < 0 || tt >= len) continue;
            f32x4 x0, x1; pg8::unpack8(*(const u32x4*)(XR + (size_t)(s0 + tt) * LW + c0), x0, x1); a0 += w[j][0] * x0; a1 += w[j][1] * x1; }
        const int tg = t & 63, cq = tid_ & 15;
        *(u32x4*)(XC + ((size_t)(((((t >> 6) * NBLK + n) * 4 + ((tg >> 2) & 3)) * 4 + (cq & 3)) * 16 + 4 * (tg >> 4) + (tg & 3)) * 4 + (cq >> 2)) * 8) = pg8::pack8(a0, a1);
    }
}
__device__ __forceinline__ void lru_pass_a(Frame& F) {
    const int fr = F.lane & 15, fq = F.lane >> 4, w = F.wave;
    const bf16_t* XC = wsp<bf16_t>(F, WS_XC); f32x2* SUMM = wsp<f32x2>(F, WS_SUM);
    bf16x8 idf0, idf1; lru_idfrags(w, fr, fq, idf0, idf1);
    for (int u = blockIdx.x; u < LRU_NCH * NBLK; u += F.G) {
        const int cg = u >> 4, n = u & 15;
        conv_unit(F, cg, n); VM_WAIT(); __syncthreads();
        LruW Wf, Wb; lru_load_w<0>(F, Wf, n, w, fr, fq); lru_load_w<1>(F, Wb, n, w, fr, fq);
        const bool c_first = (cg == 0 || cg == LRU_NCH_P), c_last = (cg == LRU_NCH_P - 1 || cg == LRU_NCH - 1);
        float Af = 1.f, Hf = 0.f, Ab = 1.f, Hb = 0.f;
        LruX X, Xn; lru_load_x(X, XC, cg * LRU_CH, n, fr, fq);
        for (int gi = 0; gi < 4; ++gi) {
            if (gi < 3) lru_load_x(Xn, XC, cg * LRU_CH + (gi + 1) * 64, n, fr, fq);
            float pf = 1.f, hf = 0.f, pb = 1.f, hb = 0.f;
#pragma unroll
            for (int tau = 0; tau < 4; ++tau) {
                f32x4 prf, pif, prb, pib, xct, xct2;
                lru_tile(X, tau, (w & 1) != 0, Wf, idf0, idf1, prf, pif, xct);
                lru_tile(X, tau, (w & 1) != 0, Wb, idf0, idf1, prb, pib, xct2);
#pragma unroll
                for (int j = 0; j < 4; ++j) {
                    float a, uu;
                    lru_gate(prf[j], pif[j], xct[j], Wf, c_first && gi == 0 && fq == 0 && tau == 0 && j == 0, a, uu); hf = a * hf + uu; pf *= a;
                    lru_gate(prb[j], pib[j], xct[j], Wb, c_last && gi == 3 && fq == 3 && tau == 3 && j == 3, a, uu); hb += pb * uu; pb *= a;
                }
            }
            float gPf = 1.f, gHf = 0.f, gPb = 1.f, gHb = 0.f;
#pragma unroll
            for (int qq = 0; qq < 4; ++qq) { const int src = fr + 16 * qq;
                float P = __shfl(pf, src), H = __shfl(hf, src); gHf = P * gHf + H; gPf *= P;
                P = __shfl(pb, src); H = __shfl(hb, src); gHb += gPb * H; gPb *= P; }
            Hf = gPf * Hf + gHf; Af *= gPf; Hb += Ab * gHb; Ab *= gPb;
            X = Xn;
        }
        if (fq == 0) { const int ch = n * BW + 16 * w + fr; SUMM[(size_t)(cg * 2 + 0) * LW + ch] = (f32x2){Af, Hf}; SUMM[(size_t)(cg * 2 + 1) * LW + ch] = (f32x2){Ab, Hb}; }
    }
}
__device__ __forceinline__ void lru_pass_b(Frame& F) {
    const int tid_ = opaque(F.tid);
    const int gt = blockIdx.x * NTHR + tid_; if (gt >= 4 * LW) return;
    const int ch = gt % LW, d = (gt / LW) & 1, seq = gt / (2 * LW), c0 = seq ? LRU_NCH_P : 0, nc = seq ? LRU_NCH - LRU_NCH_P : LRU_NCH_P;
    const f32x2* SUMM = wsp<f32x2>(F, WS_SUM); float* CIN = wsp<float>(F, WS_SUM + 4 * MiB);
    float s = 0.f;
    for (int i0 = 0; i0 < nc; i0 += 8) {
        f32x2 ah[8];
#pragma unroll
        for (int e = 0; e < 8; ++e) { const int cg = d ? c0 + nc - 1 - (i0 + e) : c0 + i0 + e; ah[e] = SUMM[(size_t)(cg * 2 + d) * LW + ch]; }
#pragma unroll
        for (int e = 0; e < 8; ++e) { const int cg = d ? c0 + nc - 1 - (i0 + e) : c0 + i0 + e; CIN[(size_t)(cg * 2 + d) * LW + ch] = s; s = ah[e].x * s + ah[e].y; }
    }
}
template <int LDBG = 0> __device__ __forceinline__ void lru_pass_c(Frame& F) {
    const int tid_ = opaque(F.tid);
    const int fr = F.lane & 15, fq = F.lane >> 4, w = F.wave;
    const bf16_t* XC = wsp<bf16_t>(F, WS_XC); const float* CIN = wsp<float>(F, WS_SUM + 4 * MiB);
    const bf16_t* GR = wsp<bf16_t>(F, WS_GR); bf16_t* LRU = wsp<bf16_t>(F, WS_XR);
    LAS bf16_t* hfb = (LAS bf16_t*)(F.lds + w * 8192);
    LAS bf16_t* grt = (LAS bf16_t*)(F.lds + 65536);
    bf16x8 idf0, idf1; lru_idfrags(w, fr, fq, idf0, idf1);
    for (int u = blockIdx.x; u < LRU_NCH * NBLK; u += F.G) {
        const int cg = u >> 4, n = u & 15, ch = n * BW + 16 * w + fr;
        const bool c_first = (cg == 0 || cg == LRU_NCH_P), c_last = (cg == LRU_NCH_P - 1 || cg == LRU_NCH - 1);
        { const bf16_t* gsrc = GR + (size_t)(cg * LRU_CH + (tid_ >> 4)) * LW + n * BW + (tid_ & 15) * 8; LAS bf16_t* ldst = grt + w * 512;
#pragma unroll 1
          for (int k = 0; k < 8; ++k) { __builtin_amdgcn_global_load_lds((const unsigned*)gsrc, (LAS unsigned*)ldst, 16, 0, 0); gsrc += (size_t)32 * LW; ldst += NTHR * 8; } }
        {
            LruW W; lru_load_w<0>(F, W, n, w, fr, fq);
            float s = CIN[(size_t)(cg * 2 + 0) * LW + ch];
            LruX X, Xn; lru_load_x(X, XC, cg * LRU_CH, n, fr, fq);
            for (int gi = 0; gi < 4; ++gi) {
                if (gi < 3 && LDBG != 2) lru_load_x(Xn, XC, cg * LRU_CH + (gi + 1) * 64, n, fr, fq);
                float a[16], uu[16];
#pragma unroll
                for (int tau = 0; tau < 4; ++tau) { f32x4 pr, pi, xct; lru_tile(X, tau, (w & 1) != 0, W, idf0, idf1, pr, pi, xct);
#pragma unroll
                    for (int j = 0; j < 4; ++j) lru_gate<LDBG>(pr[j], pi[j], xct[j], W, c_first && gi == 0 && fq == 0 && tau == 0 && j == 0, a[4 * tau + j], uu[4 * tau + j]); }
                float p = 1.f, h = 0.f;
#pragma unroll
                for (int t = 0; t < 16; ++t) { h = a[t] * h + uu[t]; p *= a[t]; }
                float hin = s, sg = s;
#pragma unroll
                for (int qq = 0; qq < 4; ++qq) { const float P = __shfl(p, fr + 16 * qq), H = __shfl(h, fr + 16 * qq); sg = P * sg + H; if (qq < fq) hin = P * hin + H; }
                s = sg;
                float hh = hin;
#pragma unroll
                for (int t = 0; t < 16; ++t) { hh = a[t] * hh + uu[t]; hfb[(gi * 64 + 16 * fq + t) * 16 + fr] = (bf16_t)f2bf(hh); }
                X = Xn;
            }
        }
        VM_WAIT(); __syncthreads();
        {
            LruW W; lru_load_w<1>(F, W, n, w, fr, fq);
            float s = CIN[(size_t)(cg * 2 + 1) * LW + ch];
            LruX X, Xn; lru_load_x(X, XC, cg * LRU_CH + 3 * 64, n, fr, fq);
            for (int gi = 3; gi >= 0; --gi) {
                if (gi > 0 && LDBG != 2) lru_load_x(Xn, XC, cg * LRU_CH + (gi - 1) * 64, n, fr, fq);
                float a[16], uu[16];
#pragma unroll
                for (int tau = 0; tau < 4; ++tau) { f32x4 pr, pi, xct; lru_tile(X, tau, (w & 1) != 0, W, idf0, idf1, pr, pi, xct);
#pragma unroll
                    for (int j = 0; j < 4; ++j) lru_gate<LDBG>(pr[j], pi[j], xct[j], W, c_last && gi == 3 && fq == 3 && tau == 3 && j == 3, a[4 * tau + j], uu[4 * tau + j]); }
                float p = 1.f, h = 0.f;
#pragma unroll
                for (int t = 15; t >= 0; --t) { h = a[t] * h + uu[t]; p *= a[t]; }
                float hin = s, sg = s;
#pragma unroll
                for (int qq = 3; qq >= 0; --qq) { const float P = __shfl(p, fr + 16 * qq), H = __shfl(h, fr + 16 * qq); sg = P * sg + H; if (qq > fq) hin = P * hin + H; }
                s = sg;
                float hh = hin;
#pragma unroll
                for (int t = 15; t >= 0; --t) { hh = a[t] * hh + uu[t];
                    const int tl = gi * 64 + 16 * fq + t; LAS bf16_t* gp = grt + tl * BW + 16 * w + fr;
                    *gp = (bf16_t)f2bf((bf1(hfb[tl * 16 + fr]) + hh) * gelu_tanh(bf1(*gp))); }
                X = Xn;
            }
        }
        LDS_WAIT(); __syncthreads();
        { bf16_t* gdst = LRU + (size_t)(cg * LRU_CH + (tid_ >> 4)) * LW + n * BW + (tid_ & 15) * 8; const LAS bf16_t* lsrc = grt + tid_ * 8;
#pragma unroll 1
          for (int k = 0; k < 8; ++k) { *(u32x4*)gdst = *(const LAS u32x4*)lsrc; gdst += (size_t)32 * LW; lsrc += NTHR * 8; } }
        LDS_WAIT(); __syncthreads();
    }
}

__device__ __forceinline__ f32x4 up4(const u32x2 u) { return (f32x4){bflo(u.x), bfhi(u.x), bflo(u.y), bfhi(u.y)}; }
__device__ __forceinline__ void mid_phase(Frame& F) {
    const int tid_ = opaque(F.tid);
    const bf16_t* MIX = wsp<bf16_t>(F, WS_MIX); bf16_t* XN = wsp<bf16_t>(F, WS_XN); float* RSTD = wsp<float>(F, WS_RSTD);
    LAS f32x4* gpost = (LAS f32x4*)F.lds; LAS f32x4* gpre = gpost + D / 4;
    for (int i = tid_; i < D / 4; i += NTHR) { gpost[i] = ((const f32x4*)F.in_GMPOST)[i]; gpre[i] = ((const f32x4*)F.in_GFPRE)[i]; }
    __syncthreads();
    for (int m = F.gw; m < L; m += F.ngw) {
        asm volatile("" ::: "memory");
        const f32x4* xr = (const f32x4*)xrow(F, m) + F.lane; const u32x2* mr = (const u32x2*)(MIX + (size_t)m * D) + F.lane;
        f32x4 v[16]; u32x2 mx[16]; float s = 0.f;
#pragma unroll
        for (int j = 0; j < 16; ++j) { v[j] = xr[64 * j]; mx[j] = mr[64 * j]; const f32x4 a = up4(mx[j]); s += (a.x * a.x + a.y * a.y) + (a.z * a.z + a.w * a.w); }
        const float rstd1 = 1.0f / sqrtf(wave_sum(s) * (1.0f / D) + EPS);
        if (F.lane == 0) RSTD[m] = rstd1;
        float s2 = 0.f;
#pragma unroll
        for (int j = 0; j < 16; ++j) { v[j] = v[j] + up4(mx[j]) * rstd1 * gpost[F.lane + 64 * j]; s2 += (v[j].x * v[j].x + v[j].y * v[j].y) + (v[j].z * v[j].z + v[j].w * v[j].w); }
        const float rstd2 = 1.0f / sqrtf(wave_sum(s2) * (1.0f / D) + EPS);
        u32x2* o8 = (u32x2*)(XN + (size_t)m * D) + F.lane;
#pragma unroll
        for (int j = 0; j < 16; ++j) { const f32x4 g = gpre[F.lane + 64 * j]; u32x2 o; o.x = pk2(v[j].x * rstd2 * g.x, v[j].y * rstd2 * g.y); o.y = pk2(v[j].z * rstd2 * g.z, v[j].w * rstd2 * g.w); o8[64 * j] = o; }
    }
    __syncthreads();
}
__device__ __forceinline__ void final_phase(Frame& F) {
    const int tid_ = opaque(F.tid);
    const bf16_t* MIX = wsp<bf16_t>(F, WS_MIX); const bf16_t* FB = wsp<bf16_t>(F, WS_F); const float* RSTD = wsp<float>(F, WS_RSTD);
    LAS f32x4* gpost = (LAS f32x4*)F.lds; LAS f32x4* gfp = gpost + D / 4;
    for (int i = tid_; i < D / 4; i += NTHR) { gpost[i] = ((const f32x4*)F.in_GMPOST)[i]; gfp[i] = ((const f32x4*)F.in_GFPOST)[i]; }
    __syncthreads();
    for (int m = F.gw; m < L; m += F.ngw) {
        asm volatile("" ::: "memory");
        const f32x4* xr = (const f32x4*)xrow(F, m) + F.lane; const u32x2* mr = (const u32x2*)(MIX + (size_t)m * D) + F.lane; const u32x2* fr = (const u32x2*)(FB + (size_t)m * D) + F.lane;
        const float rstd1 = RSTD[m];
        u32x2 fx[16]; float s = 0.f;
#pragma unroll
        for (int j = 0; j < 16; ++j) { fx[j] = fr[64 * j]; const f32x4 a = up4(fx[j]); s += (a.x * a.x + a.y * a.y) + (a.z * a.z + a.w * a.w); }
        const float rstd3 = 1.0f / sqrtf(wave_sum(s) * (1.0f / D) + EPS);
        f32x4* o = (f32x4*)(F.out + (size_t)m * D) + F.lane;
#pragma unroll
        for (int j = 0; j < 16; ++j) o[64 * j] = xr[64 * j] + up4(mr[64 * j]) * rstd1 * gpost[F.lane + 64 * j] + up4(fx[j]) * rstd3 * gfp[F.lane + 64 * j];
    }
}

constexpr int LDS_STAGE = pg8::STAGE_BYTES;
constexpr int LDS_MISC = LDS_STAGE;
constexpr int LDS_BYTES = LDS_STAGE + 1024;
#ifndef MK_N_LAUNCHES
#define MK_N_LAUNCHES 1
#endif
constexpr int NPHASE = 11;
struct Args { const float* in[23]; float* out; unsigned char* ws; int ph_lo, ph_hi; };

__global__ void __launch_bounds__(NTHR, 2) fwd_kernel(Args args) {
    extern __shared__ __attribute__((aligned(16))) unsigned char lds_raw[];
    Frame F;
    F.lds = (LAS unsigned char*)lds_raw;
    F.tid = threadIdx.x; F.lane = (int)__builtin_amdgcn_mbcnt_hi(~0u, __builtin_amdgcn_mbcnt_lo(~0u, 0u)); F.wave = __builtin_amdgcn_readfirstlane(F.tid >> 6);
    F.G = gridDim.x; F.gw = blockIdx.x * NWAVES + F.wave; F.ngw = F.G * NWAVES;
    F.in_XP = args.in[0]; F.in_XS = args.in[1]; F.in_WIN = args.in[2]; F.in_WCONV = args.in[3]; F.in_BCONV = args.in[4]; F.in_WR = args.in[5]; F.in_BR = args.in[6]; F.in_WI = args.in[7]; F.in_BI = args.in[8]; F.in_LAM = args.in[9]; F.in_RPB = args.in[10]; F.in_WNO = args.in[11]; F.in_WLO = args.in[12]; F.in_WM = args.in[13]; F.in_BM = args.in[14]; F.in_WOUT = args.in[15]; F.in_GMPRE = args.in[16]; F.in_GMPOST = args.in[17]; F.in_GFPRE = args.in[18]; F.in_GFPOST = args.in[19]; F.in_WFG = args.in[20]; F.in_WFU = args.in[21]; F.in_WFD = args.in[22];
    F.out = args.out; F.ws = args.ws;
    volatile LAS unsigned* MISC = (volatile LAS unsigned*)(F.lds + LDS_MISC);
    if (F.tid < 256) MISC[F.tid] = 0u;
    __syncthreads();
    const int lo = args.ph_lo, hi = args.ph_hi;
    const bool fused = (hi - lo) > 1;
    XcdBarrier bar; bar.bar = (unsigned*)(F.ws + WS_CTL); bar.x = 0; bar.st = nullptr;
    if (fused) bar = xcd_barrier_post((unsigned*)(F.ws + WS_CTL), MISC + 8);
#ifndef PH_MASK
#define PH_MASK 0x7ff
#endif
#define IN(k) (((PH_MASK >> (k)) & 1) && lo <= (k) && (k) < hi)
#define SEAM(k) do { if (IN(k) && IN((k) + 1)) xcd_barrier(bar); } while (0)
    LAS unsigned char* stage = F.lds;

#ifdef ATTN_OUT_OFF
#define NA_BUF ((size_t)ATTN_OUT_OFF * MiB)
#else
#define NA_BUF WS_Q
#endif
#ifndef DUP_MASK
#define DUP_MASK 0
#endif
#define RUN(k, ...) if (IN(k)) { __VA_ARGS__ if (((DUP_MASK) >> (k)) & 1) { __VA_ARGS__ } }
    RUN(0, { p0_prologue(F); }) SEAM(0);
    RUN(1, {
        { pg8::Gemm g{wsp<bf16_t>(F, WS_XN), wsp<bf16_t>(F, WS_XN), 1 << 30, wsp<bf16_t>(F, WS_WCAT), L, 4 * NAW, 2 * D}; pg8::StaticOrder S; S.init(L, 4 * NAW, F.G, (int)blockIdx.x);
          pg8::EpiProj E{wsp<bf16_t>(F, WS_Q), wsp<bf16_t>(F, WS_XR), wsp<bf16_t>(F, WS_K), wsp<bf16_t>(F, WS_GR), (bf16_t*)F.out, F.in_BM, 1 << 30};
          pg8::gemm_phase<pg8::EpiProj, pg8::StaticOrder, true, true, false>(stage, g, S, E); }
        { pg8::Gemm g{wsp<bf16_t>(F, WS_XN8), wsp<bf16_t>(F, WS_XN8), 1 << 30, wsp<bf16_t>(F, WS_W8), L, 2 * D, D}; pg8::StaticOrder S; S.init(L, 2 * D, F.G, (int)blockIdx.x);
          pg8::EpiProj E{wsp<bf16_t>(F, WS_Q), wsp<bf16_t>(F, WS_XR), wsp<bf16_t>(F, WS_K), wsp<bf16_t>(F, WS_GR), (bf16_t*)F.out, F.in_BM, 0};
          pg8::gemm_phase<pg8::EpiProj, pg8::StaticOrder, true, true, true>(stage, g, S, E); }
        { pg8::Gemm g{wsp<bf16_t>(F, WS_WVT), wsp<bf16_t>(F, WS_WVT), 1 << 30, wsp<bf16_t>(F, WS_XN8), NAW, L, D}; pg8::StaticOrder S; S.init(NAW, L, F.G, (int)blockIdx.x);
          pg8::EpiVT E{wsp<bf16_t>(F, WS_VT)};
          pg8::gemm_phase<pg8::EpiVT, pg8::StaticOrder, true, true, true>(stage, g, S, E); }
    }) SEAM(1);
    RUN(2, { lru_pass_a(F); }) SEAM(2);
    #ifdef ATTN_OUT_OFF
    if (IN(3)) { lru_pass_b(F); } SEAM(3);
    if (IN(4)) { lru_pass_c<0>(F); xcd_barrier(bar); if (ATTN_DUP) attn_mfma<ATTN_DUP - 1>(F); attn_mfma<0>(F); } SEAM(4);
#else
    if (IN(3)) { lru_pass_b(F); attn_mfma<0>(F); } SEAM(3);
#ifdef LRUC_DBG
    if (IN(4)) { lru_pass_c<LRUC_DBG>(F); lru_pass_c<0>(F); } SEAM(4);
#else
    RUN(4, { lru_pass_c<0>(F); }) SEAM(4);
#endif
#endif
    if (IN(5)) {
        { pg8::Gemm g{wsp<bf16_t>(F, NA_BUF), wsp<bf16_t>(F, NA_BUF), 1 << 30, wsp<bf16_t>(F, WS_WNO), L, D, 2 * NAW}; pg8::StaticOrder S; S.init(L, D, F.G, (int)blockIdx.x);
          pg8::EpiMulG<false> E{wsp<bf16_t>(F, WS_T1), (const bf16_t*)F.out, 0};
          pg8::gemm_phase<pg8::EpiMulG<false>, pg8::StaticOrder, true, true>(stage, g, S, E); }
        { pg8::Gemm g{wsp<bf16_t>(F, WS_XR), wsp<bf16_t>(F, WS_XR), 1 << 30, wsp<bf16_t>(F, WS_WLO), L, D, 2 * LW}; pg8::StaticOrder S; S.init(L, D, F.G, (int)blockIdx.x);
          pg8::EpiMulG<true> E{wsp<bf16_t>(F, WS_T1), (const bf16_t*)F.out, D};
          pg8::gemm_phase<pg8::EpiMulG<true>, pg8::StaticOrder, true, true>(stage, g, S, E); }
    } SEAM(5);
    RUN(6, {
        pg8::Gemm g{wsp<bf16_t>(F, WS_T1), wsp<bf16_t>(F, WS_T1), 1 << 30, wsp<bf16_t>(F, WS_WO), L, D, 2 * D}; pg8::StaticOrder S; S.init(L, D, F.G, (int)blockIdx.x);
        pg8::EpiPlain E{wsp<bf16_t>(F, WS_MIX), D};
        pg8::gemm_phase<pg8::EpiPlain, pg8::StaticOrder, true, true>(stage, g, S, E);
    }) SEAM(6);
    RUN(7, { mid_phase(F); }) SEAM(7);
#ifdef GEMM_DBG
    if (IN(8)) {
        pg8::Gemm g{wsp<bf16_t>(F, WS_XN), wsp<bf16_t>(F, WS_XN), 1 << 30, wsp<bf16_t>(F, WS_WGU), L, 2 * DFF, 2 * D}; pg8::StaticOrder S; S.init(L, 2 * DFF, F.G, (int)blockIdx.x);
        pg8::EpiSwiglu E{(bf16_t*)F.out, wsp<bf16_t>(F, WS_HIDS), LP / 256};
        pg8::gemm_phase<pg8::EpiSwiglu, pg8::StaticOrder, true, true, false, GEMM_DBG>(stage, g, S, E);
    }
#endif
    RUN(8, {
        pg8::Gemm g{wsp<bf16_t>(F, WS_XN), wsp<bf16_t>(F, WS_XN), 1 << 30, wsp<bf16_t>(F, WS_WGU), L, 2 * DFF, 2 * D}; pg8::StaticOrder S; S.init(L, 2 * DFF, F.G, (int)blockIdx.x);
        pg8::EpiSwiglu E{(bf16_t*)F.out, wsp<bf16_t>(F, WS_HIDS), LP / 256};
        pg8::gemm_phase<pg8::EpiSwiglu, pg8::StaticOrder, false, true>(stage, g, S, E);
    }) SEAM(8);
    RUN(9, {
        pg8::Gemm g{(const bf16_t*)F.out, wsp<bf16_t>(F, WS_HIDS), LP / 256, wsp<bf16_t>(F, WS_WD), L, D, 2 * DFF}; pg8::StaticOrder S; S.init(L, D, F.G, (int)blockIdx.x);
        pg8::EpiPlain E{wsp<bf16_t>(F, WS_F), D};
        pg8::gemm_phase<pg8::EpiPlain, pg8::StaticOrder, true, true>(stage, g, S, E);
    }) SEAM(9);
    RUN(10, { final_phase(F); })
#undef RUN
#undef IN
#undef SEAM
}

extern "C" void kernel_launch(void* const* d_in, const int* in_sizes, int n_in, void* d_out, int out_size, void* d_ws, size_t ws_size, hipStream_t stream) {
    static int grid = 0;
    if (grid == 0) {
        if (n_in != 23 || in_sizes[0] != LP * D || in_sizes[1] != LS * D || out_size != L * D || ws_size < WS_END) {
            fprintf(stderr, "kernel_launch: unexpected shapes: n_in %d in0 %d out %d ws %zu (need %zu)\n", n_in, n_in > 0 ? in_sizes[0] : -1, out_size, ws_size, (size_t)WS_END); grid = -1; return; }
        int dev = 0, cus = 0, per_cu = 0;
        if (hipGetDevice(&dev) != hipSuccess || hipDeviceGetAttribute(&cus, hipDeviceAttributeMultiprocessorCount, dev) != hipSuccess) { grid = -1; return; }
        if (hipFuncSetAttribute((const void*)fwd_kernel, hipFuncAttributeMaxDynamicSharedMemorySize, LDS_BYTES) != hipSuccess) { fprintf(stderr, "kernel_launch: hipFuncSetAttribute failed\n"); grid = -1; return; }
        if (hipOccupancyMaxActiveBlocksPerMultiprocessor(&per_cu, (const void*)fwd_kernel, NTHR, LDS_BYTES) != hipSuccess || per_cu < 1) { fprintf(stderr, "kernel_launch: occupancy query says %d\n", per_cu); }
        (void)hipGetLastError();
        grid = cus;
    }
    if (grid < 0) return;
    (void)hipMemsetAsync((char*)d_ws + WS_CTL, 0, CTL_ZERO_BYTES, stream);
#ifdef DBG_ZERO_ALL
    (void)hipMemsetAsync((char*)d_ws, 0, WS_END, stream); (void)hipMemsetAsync((char*)d_out, 0, (size_t)L * D * 4, stream);
#endif
    Args a{};
    for (int i = 0; i < 23; ++i) a.in[i] = (const float*)d_in[i];
    a.out = (float*)d_out; a.ws = (unsigned char*)d_ws;
#if MK_N_LAUNCHES == 1
    a.ph_lo = 0; a.ph_hi = NPHASE;
    hipLaunchKernelGGL(fwd_kernel, dim3(grid), dim3(NTHR), LDS_BYTES, stream, a);
#else
    for (int p = 0; p < NPHASE; ++p) {
#ifdef DBG_PH_MASK
        if (!((DBG_PH_MASK >> p) & 1)) continue;
#endif
        a.ph_lo = p; a.ph_hi = p + 1; hipLaunchKernelGGL(fwd_kernel, dim3(grid), dim3(NTHR), LDS_BYTES, stream, a); }
#endif
}
```

```cpp
#include <hip/hip_runtime.h>
#include <cstdio>
#include <cstdint>

#define LAS __attribute__((address_space(3)))
typedef unsigned short bf16_t;
typedef short bf16x8 __attribute__((ext_vector_type(8)));
typedef float f32x4 __attribute__((ext_vector_type(4)));
typedef float f32x2 __attribute__((ext_vector_type(2)));
typedef unsigned u32x4 __attribute__((ext_vector_type(4)));
typedef unsigned u32x2 __attribute__((ext_vector_type(2)));

constexpr int D = 4096, LP = 16384, LS = 8192, L = LP + LS;
constexpr int GRIDW = 64, HD = 128, NH = 16, NAW = 2048, LW = 2048, NBLK = 16, BW = 128, DFF = 11008, INW = 10240;
constexpr float EPS = 1e-6f;
constexpr int NWAVES = 8, NTHR = 512;

constexpr size_t MiB = 1u << 20;
constexpr size_t WS_CTL = 0, CTL_ZERO_BYTES = 64 * 1024;
constexpr size_t WS_RSTD = 1 * MiB;
constexpr size_t WS_SUM = 2 * MiB;
constexpr size_t WS_WCAT = 8 * MiB;
constexpr size_t WS_WVT = 72 * MiB;
constexpr size_t WS_W8 = 88 * MiB;
constexpr size_t WS_XN8 = 120 * MiB;
constexpr size_t WS_WNO = 216 * MiB;
constexpr size_t WS_WLO = 232 * MiB;
constexpr size_t WS_WO = 248 * MiB;
constexpr size_t WS_WGU = 280 * MiB;
constexpr size_t WS_WD = 452 * MiB;
constexpr size_t WS_WG = 538 * MiB;
constexpr size_t WS_XN = 540 * MiB;
constexpr size_t WS_Q = 732 * MiB;
constexpr size_t WS_XR = 828 * MiB;
constexpr size_t WS_K = 924 * MiB;
constexpr size_t WS_VT = 1020 * MiB;
constexpr size_t WS_GR = 1116 * MiB;
constexpr size_t WS_XC = 1212 * MiB;
constexpr size_t WS_END = 1308 * MiB;
constexpr size_t WS_T1 = WS_K;
constexpr size_t WS_MIX = WS_GR;
constexpr size_t WS_HIDS = WS_Q;
constexpr size_t WS_F = WS_K;
constexpr size_t WS_HF = WS_K;

#define LDS_WAIT() asm volatile("s_waitcnt lgkmcnt(0)" ::: "memory")
#define VM_WAIT() asm volatile("s_waitcnt vmcnt(0)" ::: "memory")
typedef __bf16 bf16x2n_t __attribute__((ext_vector_type(2)));
__device__ __forceinline__ unsigned pk2(float lo, float hi) { const bf16x2n_t r = __builtin_convertvector((f32x2){lo, hi}, bf16x2n_t); return __builtin_bit_cast(unsigned, r); }
__device__ __forceinline__ unsigned f2bf(float f) { return pk2(f, 0.f) & 0xffffu; }
__device__ __forceinline__ float bflo(unsigned u) { return __builtin_bit_cast(float, u << 16); }
__device__ __forceinline__ float bfhi(unsigned u) { return __builtin_bit_cast(float, u & 0xffff0000u); }
__device__ __forceinline__ float bf1(bf16_t u) { return __builtin_bit_cast(float, (unsigned)u << 16); }
__device__ __forceinline__ float wave_sum(float v) {
#pragma unroll
    for (int o = 1; o < 64; o <<= 1) v += __shfl_xor(v, o);
    return v;
}
__device__ __forceinline__ float wave_max(float v) {
#pragma unroll
    for (int o = 1; o < 64; o <<= 1) v = fmaxf(v, __shfl_xor(v, o));
    return v;
}
__device__ __forceinline__ float sigmoidf_(float v) { return __builtin_amdgcn_rcpf(1.0f + __expf(-v)); }
__device__ __forceinline__ float gelu_tanh(float v) { const float y = 0.7978845608f * (v + 0.044715f * v * v * v); const float e = __expf(2.0f * y); return 0.5f * v * (2.0f - 2.0f * __builtin_amdgcn_rcpf(e + 1.0f)); }

namespace pg8 {
constexpr int BM = 256, BK = 64, HALF = 128, HTB = HALF * BK * 2  , STAGE_BYTES = 8 * HTB, NXCD = 8, WGM = 4;

__host__ __device__ __forceinline__ int lds_byte(int r, int c) { return (r >> 3) * 1024 + (r & 7) * 128 + ((((c >> 3) ^ r) & 7) << 4) + (c & 7) * 2; }
__host__ __device__ __forceinline__ void stage_rc(int b, int& R, int& C) { const int ch = b >> 10, rr = (b >> 7) & 7, slot = (b >> 4) & 7; R = ch * 8 + rr; C = ((slot ^ rr) & 7) * 8; }
__host__ __device__ __forceinline__ int perm32(int rho) { const int n = rho >> 4, i = rho & 15; return 8 * (i >> 2) + 4 * n + (i & 3); }

struct Unit { int pm, pn; };
struct Gemm {
    const bf16_t* A; const bf16_t* A2; int pm_split; const bf16_t* Bt; int M, N, rb;
    __device__ __forceinline__ const char* abase(int pm) const { const size_t t = (size_t)BM * rb; return pm < pm_split ? (const char*)A + (size_t)pm * t : (const char*)A2 + (size_t)(pm - pm_split) * t; }
    __device__ __forceinline__ const char* bbase(int pn) const { return (const char*)Bt + (size_t)pn * BM * rb; }
};

struct StaticOrder {
    int nM, nN, nwg, G, c;
    __host__ __device__ void init(int M, int N, int G_, int c_) { nM = M / BM; nN = N / BM; nwg = nM * nN; G = G_; c = c_; }
    __host__ __device__ bool next(int i, Unit& u) const {
        const long Lx = (long)i * G + c; if (Lx >= nwg) return false;
        int wgid = (int)Lx; { const int q = nwg / NXCD, r = nwg % NXCD, xcd = wgid % NXCD, off = wgid / NXCD; wgid = (xcd < r ? xcd * (q + 1) : r * (q + 1) + (xcd - r) * q) + off; }
        const int nig = WGM * nN, gid = wgid / nig, fm = gid * WGM, gsz = (nM - fm) < WGM ? (nM - fm) : WGM;
        u.pm = fm + ((wgid % nig) % gsz); u.pn = (wgid % nig) / gsz; return true;
    }
    __device__ __forceinline__ void a_ready(const Unit&) const {}
    __device__ __forceinline__ void done(const Unit&) const {}
};

typedef __bf16 bf16x2_t __attribute__((ext_vector_type(2)));
__device__ __forceinline__ unsigned cvt_pk_bf16(float lo, float hi) { const bf16x2_t r = __builtin_convertvector((f32x2){lo, hi}, bf16x2_t); return __builtin_bit_cast(unsigned, r); }
__device__ __forceinline__ u32x4 pack8(const f32x4 v0, const f32x4 v1) { u32x4 w; w.x = cvt_pk_bf16(v0[0], v0[1]); w.y = cvt_pk_bf16(v0[2], v0[3]); w.z = cvt_pk_bf16(v1[0], v1[1]); w.w = cvt_pk_bf16(v1[2], v1[3]); return w; }
__device__ __forceinline__ void unpack8(const u32x4 w, f32x4& v0, f32x4& v1) { v0 = (f32x4){bflo(w.x), bfhi(w.x), bflo(w.y), bfhi(w.y)}; v1 = (f32x4){bflo(w.z), bfhi(w.z), bflo(w.w), bfhi(w.w)}; }
__device__ __forceinline__ f32x4 sig4(const f32x4 v) { f32x4 r; r[0] = sigmoidf_(v[0]); r[1] = sigmoidf_(v[1]); r[2] = sigmoidf_(v[2]); r[3] = sigmoidf_(v[3]); return r; }

struct EpiPlain {
    static constexpr bool PERM = true, AFTER_DRAIN = false;
    bf16_t* O; int ldc;
    __device__ __forceinline__ void operator()(const f32x4 (&acc)[2][2][4][2], const Unit& u, int wr, int wc, int fr, int fq) const {
        const int row0 = u.pm * BM + wr * 64 + fr, col0 = u.pn * BM + wc * 32 + 8 * fq;
#pragma unroll
        for (int ai = 0; ai < 2; ++ai)
#pragma unroll
            for (int m = 0; m < 4; ++m) { bf16_t* rowp = O + (size_t)(row0 + ai * HALF + m * 16) * ldc + col0;
#pragma unroll
                for (int bj = 0; bj < 2; ++bj) *(u32x4*)(rowp + bj * HALF) = pack8(acc[ai][bj][m][0], acc[ai][bj][m][1]); }
    }
};
struct EpiVT {
    static constexpr bool PERM = true, AFTER_DRAIN = false;
    bf16_t* O;
    __device__ __forceinline__ void operator()(const f32x4 (&acc)[2][2][4][2], const Unit& u, int wr, int wc, int fr, int fq) const {
        const int row0 = u.pm * BM + wr * 64 + fr, col0 = u.pn * BM + wc * 32 + 8 * fq;
#pragma unroll
        for (int ai = 0; ai < 2; ++ai)
#pragma unroll
            for (int m = 0; m < 4; ++m) { const int row = row0 + ai * HALF + m * 16, hh = row >> 7, d = row & 127;
                const int dt = 2 * (d >> 5) + ((d >> 2) & 1), i = 4 * ((d >> 3) & 3) + (d & 3);
#pragma unroll
                for (int bj = 0; bj < 2; ++bj) { const int tok = col0 + bj * HALF, R = tok >> 6, o = (tok & 63) >> 3;
                    *(u32x4*)(O + ((size_t)((((R * 16 + hh) * 8 + dt) * 8 + o) * 16 + i)) * 8) = pack8(acc[ai][bj][m][0], acc[ai][bj][m][1]); } }
    }
};
struct EpiProj {
    static constexpr bool PERM = true, AFTER_DRAIN = false;
    bf16_t* P0; bf16_t* P1; bf16_t* P2; bf16_t* P3; bf16_t* G; const float* bias; int pn_gate0;
    __device__ __forceinline__ void operator()(const f32x4 (&acc)[2][2][4][2], const Unit& u, int wr, int wc, int fr, int fq) const {
        const int row0 = u.pm * BM + wr * 64 + fr;
        if (u.pn < pn_gate0) {
            const int t = u.pn >> 3; bf16_t* base = t == 0 ? P0 : (t == 1 ? P1 : (t == 2 ? P2 : P3));
            const int col0 = (u.pn & 7) * BM + wc * 32 + 8 * fq;
            if (t == 2) {
#pragma unroll
                for (int ai = 0; ai < 2; ++ai)
#pragma unroll
                    for (int m = 0; m < 4; ++m) { const int tok = row0 + ai * HALF + m * 16, R = tok >> 6, cl = tok & 63;
                        const int tokpart = (((cl >> 2) & 1) * 8 + (cl >> 3)) * 4 + (cl & 3);
#pragma unroll
                        for (int bj = 0; bj < 2; ++bj) { const int c = col0 + bj * HALF, hh = c >> 7, d0 = c & 127;
                            *(u32x4*)(base + ((size_t)(((R * 16 + hh) * 4 + (d0 >> 5)) * 64 + tokpart) * 4 + ((d0 >> 3) & 3)) * 8) = pack8(acc[ai][bj][m][0], acc[ai][bj][m][1]); } }
            } else {
#pragma unroll
            for (int ai = 0; ai < 2; ++ai)
#pragma unroll
                for (int m = 0; m < 4; ++m) { bf16_t* rowp = base + (size_t)(row0 + ai * HALF + m * 16) * NAW + col0;
#pragma unroll
                    for (int bj = 0; bj < 2; ++bj) *(u32x4*)(rowp + bj * HALF) = pack8(acc[ai][bj][m][0], acc[ai][bj][m][1]); }
            }
        } else {
            const int col0 = (u.pn - pn_gate0) * BM + wc * 32 + 8 * fq;
            f32x4 bv[2][2];
#pragma unroll
            for (int bj = 0; bj < 2; ++bj)
#pragma unroll
                for (int n = 0; n < 2; ++n) bv[bj][n] = *(const f32x4*)(bias + col0 + bj * HALF + 4 * n);
#pragma unroll
            for (int ai = 0; ai < 2; ++ai)
#pragma unroll
                for (int m = 0; m < 4; ++m) { bf16_t* rowp = G + (size_t)(row0 + ai * HALF + m * 16) * (2 * D) + col0;
#pragma unroll
                    for (int bj = 0; bj < 2; ++bj) *(u32x4*)(rowp + bj * HALF) = pack8(sig4(acc[ai][bj][m][0] + bv[bj][0]), sig4(acc[ai][bj][m][1] + bv[bj][1])); }
        }
    }
};
template <bool ADD> struct EpiMulG {
    static constexpr bool PERM = true, AFTER_DRAIN = false;
    bf16_t* O; const bf16_t* G; int goff;
    __device__ __forceinline__ void operator()(const f32x4 (&acc)[2][2][4][2], const Unit& u, int wr, int wc, int fr, int fq) const {
        const int row0 = u.pm * BM + wr * 64 + fr, col0 = u.pn * BM + wc * 32 + 8 * fq;
#pragma unroll
        for (int ai = 0; ai < 2; ++ai)
#pragma unroll
            for (int m = 0; m < 4; ++m) { const size_t row = (size_t)(row0 + ai * HALF + m * 16); bf16_t* rowp = O + row * D + col0; const bf16_t* gp = G + row * (2 * D) + goff + col0;
#pragma unroll
                for (int bj = 0; bj < 2; ++bj) {
                    f32x4 g0, g1; unpack8(*(const u32x4*)(gp + bj * HALF), g0, g1);
                    f32x4 v0 = acc[ai][bj][m][0] * g0, v1 = acc[ai][bj][m][1] * g1;
                    if (ADD) { f32x4 t0, t1; unpack8(*(const u32x4*)(rowp + bj * HALF), t0, t1); v0 += t0; v1 += t1; }
                    *(u32x4*)(rowp + bj * HALF) = pack8(v0, v1); } }
    }
};
struct EpiSwiglu {
    static constexpr bool PERM = true, AFTER_DRAIN = false;
    bf16_t* H0; bf16_t* H1; int pm_split;
    __device__ __forceinline__ void operator()(const f32x4 (&acc)[2][2][4][2], const Unit& u, int wr, int wc, int fr, int fq) const {
        bf16_t* base = u.pm < pm_split ? H0 + (size_t)u.pm * BM * DFF : H1 + (size_t)(u.pm - pm_split) * BM * DFF;
        const int row0 = wr * 64 + fr, col0 = u.pn * HALF + wc * 32 + 8 * fq;
#pragma unroll
        for (int ai = 0; ai < 2; ++ai)
#pragma unroll
            for (int m = 0; m < 4; ++m) {
                f32x4 h[2];
#pragma unroll
                for (int n = 0; n < 2; ++n) { const f32x4 g = acc[ai][0][m][n], up = acc[ai][1][m][n];
#pragma unroll
                    for (int j = 0; j < 4; ++j) h[n][j] = g[j] * sigmoidf_(g[j]) * up[j]; }
                *(u32x4*)(base + (size_t)(row0 + ai * HALF + m * 16) * DFF + col0) = pack8(h[0], h[1]); }
    }
};

typedef int v8i32 __attribute__((ext_vector_type(8)));
typedef int v4i32 __attribute__((ext_vector_type(4)));
__device__ __forceinline__ v8i32 cat8(const bf16x8 lo, const bf16x8 hi) { return __builtin_shufflevector(__builtin_bit_cast(v4i32, lo), __builtin_bit_cast(v4i32, hi), 0, 1, 2, 3, 4, 5, 6, 7); }
__device__ __forceinline__ void mfma_fp8_acc(f32x4& c, const v8i32 a, const v8i32 b, int sa, int sb) {
    asm volatile("v_mfma_scale_f32_16x16x128_f8f6f4 %0, %1, %2, %0, %3, %4 op_sel_hi:[0,0,0]" : "+v"(c) : "v"(a), "v"(b), "v"(sa), "v"(sb)); }
constexpr int FP8_SCALE = 0x73737373;
template <class Epi, class Sched, bool ALIGN_EPI = false, bool SP2 = false, bool FP8 = false, int DBG = 0>
__device__ __forceinline__ void gemm_phase(LAS unsigned char* lds, const Gemm g, const Sched& S, const Epi& E) {
    const int tid = threadIdx.x, wid = __builtin_amdgcn_readfirstlane(tid >> 6), lane = tid & 63, wr = wid >> 2, wc = wid & 3, fr = lane & 15, fq = lane >> 4;
    const int RB = g.rb, nt = RB / (BK * 2);
    unsigned voffA[2], voffB[2];
#pragma unroll
    for (int i = 0; i < 2; ++i) { int R, C; stage_rc(tid * 16 + i * 8192, R, C); const int Rb = Epi::PERM ? ((R & ~31) + perm32(R & 31)) : R;
        voffA[i] = (unsigned)(R * RB + C * 2); voffB[i] = (unsigned)(Rb * RB + C * 2); }
    const size_t kstep = (size_t)(BK * 2);
    const size_t hstep = (size_t)HALF * RB;
    const unsigned ldsw = (unsigned)wid * 1024u;
    const int aoff0 = lds_byte(wr * 64 + fr, fq * 8), aoff1 = lds_byte(wr * 64 + fr, 32 + fq * 8), boff0 = lds_byte(wc * 32 + fr, fq * 8), boff1 = lds_byte(wc * 32 + fr, 32 + fq * 8);
#define PG8_SA(b, h) (((b) * 2 + (h)) * HTB)
#define PG8_SB(b, h) ((4 + (b) * 2 + (h)) * HTB)
#define PG8_STAGE(bufoff, gbase, voff) do { if constexpr (DBG != 3) _Pragma("unroll") for (int _i = 0; _i < 2; ++_i) \
        __builtin_amdgcn_global_load_lds((const unsigned*)((const char*)(gbase) + (voff)[_i]), (LAS unsigned*)(lds + (bufoff) + ldsw + _i * 8192), 16, 0, 0); } while (0)
#define PG8_LDA(dst, b, h) do { if constexpr (DBG != 2) _Pragma("unroll") for (int m = 0; m < 4; ++m) _Pragma("unroll") for (int k = 0; k < 2; ++k) dst[m][k] = *(const LAS bf16x8*)(lds + PG8_SA(b, h) + (k ? aoff1 : aoff0) + m * 2048); } while (0)
#define PG8_LDB(dst, b, h) do { if constexpr (DBG != 2) _Pragma("unroll") for (int n = 0; n < 2; ++n) _Pragma("unroll") for (int k = 0; k < 2; ++k) dst[n][k] = *(const LAS bf16x8*)(lds + PG8_SB(b, h) + (k ? boff1 : boff0) + n * 2048); } while (0)
#define PG8_MMA(ai, bj, At, Bt) do { __builtin_amdgcn_s_setprio(1); if constexpr (DBG == 1) { } else if constexpr (FP8) { _Pragma("unroll") for (int m = 0; m < 4; ++m) _Pragma("unroll") for (int n = 0; n < 2; ++n) \
        mfma_fp8_acc(acc[ai][bj][m][n], cat8(Bt[n][0], Bt[n][1]), cat8(At[m][0], At[m][1]), fp8_sa, fp8_sb); } else { \
        _Pragma("unroll") for (int m = 0; m < 4; ++m) _Pragma("unroll") for (int n = 0; n < 2; ++n) _Pragma("unroll") for (int k = 0; k < 2; ++k) \
        acc[ai][bj][m][n] = __builtin_amdgcn_mfma_f32_16x16x32_bf16(Bt[n][k], At[m][k], acc[ai][bj][m][n], 0, 0, 0); } __builtin_amdgcn_s_setprio(0); } while (0)
#define PG8_WAIT_V(n) asm volatile("s_waitcnt vmcnt(" #n ")" ::: "memory")
#define PG8_WAIT_L(n) asm volatile("s_waitcnt lgkmcnt(" #n ")" ::: "memory")
#define PG8_BAR __builtin_amdgcn_s_barrier()
#define PG8_SCHED __builtin_amdgcn_sched_barrier(0)
    Unit cur, nxt; int ui = 0;
    const int fp8_sa = FP8_SCALE, fp8_sb = 0x7F7F7F7F;
    if (!S.next(0, cur)) return;
    f32x4 acc[2][2][4][2];
#pragma unroll
    for (int a = 0; a < 2; ++a)
#pragma unroll
        for (int b = 0; b < 2; ++b)
#pragma unroll
            for (int m = 0; m < 4; ++m)
#pragma unroll
                for (int n = 0; n < 2; ++n) acc[a][b][m][n] = (f32x4){0.f, 0.f, 0.f, 0.f};
    bf16x8 At[4][2], B0[2][2], B1[2][2];
    const char* cA = g.abase(cur.pm); const char* cB = g.bbase(cur.pn);
    S.a_ready(cur);
    if constexpr (SP2) {
        PG8_STAGE(PG8_SB(0, 0), cB, voffB); PG8_STAGE(PG8_SB(0, 1), cB + hstep, voffB); PG8_STAGE(PG8_SA(0, 0), cA, voffA); PG8_STAGE(PG8_SA(0, 1), cA + hstep, voffA);
        if (wr == 1) PG8_BAR;
        PG8_WAIT_V(2); PG8_BAR;
        PG8_STAGE(PG8_SB(1, 0), cB + kstep, voffB); PG8_STAGE(PG8_SA(1, 0), cA + kstep, voffA); PG8_STAGE(PG8_SB(1, 1), cB + hstep + kstep, voffB);
        PG8_WAIT_V(6); PG8_BAR;
    } else {
        PG8_STAGE(PG8_SB(0, 0), cB, voffB); PG8_STAGE(PG8_SA(0, 0), cA, voffA); PG8_STAGE(PG8_SB(0, 1), cB + hstep, voffB); PG8_STAGE(PG8_SA(0, 1), cA + hstep, voffA);
        if (wr == 1) PG8_BAR;
        PG8_WAIT_V(4); PG8_BAR;
        PG8_STAGE(PG8_SB(1, 0), cB + kstep, voffB); PG8_STAGE(PG8_SA(1, 0), cA + kstep, voffA); PG8_STAGE(PG8_SB(1, 1), cB + hstep + kstep, voffB);
        PG8_WAIT_V(6); PG8_BAR;
    }
    for (;;) {
        const bool has_next = S.next(ui + 1, nxt);
        const char* nA = has_next ? g.abase(nxt.pm) : cA; const char* nB = has_next ? g.bbase(nxt.pn) : cB;
        for (int t = 0; t < nt; t += 2) {
            const bool last = (t == nt - 2);
            const char* a1 = cA + (size_t)(t + 1) * kstep;
            const char* a2 = last ? nA : cA + (size_t)(t + 2) * kstep; const char* b2 = last ? nB : cB + (size_t)(t + 2) * kstep;
            const char* a3 = a2 + kstep; const char* b3 = b2 + kstep;
            if (last && has_next) S.a_ready(nxt);
            if constexpr (SP2) {
            PG8_LDB(B0, 0, 0); PG8_LDB(B1, 0, 1); PG8_SCHED; PG8_LDA(At, 0, 0); PG8_STAGE(PG8_SA(1, 1), a1 + hstep, voffA);
            PG8_WAIT_V(8); PG8_WAIT_L(0); PG8_BAR; PG8_MMA(0, 0, At, B0); PG8_MMA(0, 1, At, B1); PG8_BAR; PG8_SCHED;
            PG8_LDA(At, 0, 1); PG8_STAGE(PG8_SB(0, 0), b2, voffB); PG8_STAGE(PG8_SB(0, 1), b2 + hstep, voffB); PG8_STAGE(PG8_SA(0, 0), a2, voffA);
            PG8_WAIT_V(8); PG8_WAIT_L(0); PG8_BAR; PG8_MMA(1, 0, At, B0); PG8_MMA(1, 1, At, B1); PG8_BAR; PG8_SCHED;
            PG8_LDB(B0, 1, 0); PG8_LDB(B1, 1, 1); PG8_SCHED; PG8_LDA(At, 1, 0); PG8_STAGE(PG8_SA(0, 1), a2 + hstep, voffA);
            PG8_WAIT_V(8); PG8_WAIT_L(0); PG8_BAR; PG8_MMA(0, 0, At, B0); PG8_MMA(0, 1, At, B1); PG8_BAR; PG8_SCHED;
            PG8_LDA(At, 1, 1); PG8_STAGE(PG8_SB(1, 0), b3, voffB); PG8_STAGE(PG8_SB(1, 1), b3 + hstep, voffB); PG8_STAGE(PG8_SA(1, 0), a3, voffA);
            PG8_WAIT_V(8); PG8_WAIT_L(0); PG8_BAR; PG8_MMA(1, 0, At, B0); PG8_MMA(1, 1, At, B1); PG8_BAR; PG8_SCHED;
            } else {
            PG8_LDB(B0, 0, 0); PG8_SCHED; PG8_LDA(At, 0, 0); PG8_STAGE(PG8_SA(1, 1), a1 + hstep, voffA);
            PG8_WAIT_L(8); PG8_BAR; PG8_WAIT_L(0); PG8_MMA(0, 0, At, B0); PG8_BAR; PG8_SCHED;
            PG8_LDB(B1, 0, 1); PG8_STAGE(PG8_SB(0, 0), b2, voffB);
            PG8_BAR; PG8_WAIT_L(0); PG8_MMA(0, 1, At, B1); PG8_BAR;
            PG8_LDA(At, 0, 1); PG8_STAGE(PG8_SA(0, 0), a2, voffA);
            PG8_BAR; PG8_WAIT_L(0); PG8_MMA(1, 0, At, B0); PG8_BAR; PG8_SCHED;
            PG8_STAGE(PG8_SB(0, 1), b2 + hstep, voffB);
            PG8_WAIT_V(6); PG8_BAR; PG8_MMA(1, 1, At, B1); PG8_BAR;
            PG8_LDB(B0, 1, 0); PG8_SCHED; PG8_LDA(At, 1, 0); PG8_STAGE(PG8_SA(0, 1), a2 + hstep, voffA);
            PG8_WAIT_L(8); PG8_BAR; PG8_WAIT_L(0); PG8_MMA(0, 0, At, B0); PG8_BAR; PG8_SCHED;
            PG8_LDB(B1, 1, 1); PG8_STAGE(PG8_SB(1, 0), b3, voffB);
            PG8_BAR; PG8_WAIT_L(0); PG8_MMA(0, 1, At, B1); PG8_BAR;
            PG8_LDA(At, 1, 1); PG8_STAGE(PG8_SA(1, 0), a3, voffA);
            PG8_BAR; PG8_WAIT_L(0); PG8_MMA(1, 0, At, B0); PG8_BAR; PG8_SCHED;
            PG8_STAGE(PG8_SB(1, 1), b3 + hstep, voffB);
            PG8_WAIT_V(6); PG8_BAR; PG8_MMA(1, 1, At, B1); PG8_BAR;
            }
        }
        if constexpr (ALIGN_EPI) { if (wr == 0) PG8_BAR; }
        if constexpr (!Epi::AFTER_DRAIN) { if constexpr (DBG != 4) E(acc, cur, wr, wc, fr, fq); else { _Pragma("unroll") for (int a_ = 0; a_ < 2; ++a_) _Pragma("unroll") for (int b_ = 0; b_ < 2; ++b_) _Pragma("unroll") for (int m_ = 0; m_ < 4; ++m_) _Pragma("unroll") for (int n_ = 0; n_ < 2; ++n_) asm volatile("" :: "v"(acc[a_][b_][m_][n_])); } S.done(cur); }
        if (!has_next) break;
#pragma unroll
        for (int a = 0; a < 2; ++a)
#pragma unroll
            for (int b = 0; b < 2; ++b)
#pragma unroll
                for (int m = 0; m < 4; ++m)
#pragma unroll
                    for (int n = 0; n < 2; ++n) acc[a][b][m][n] = (f32x4){0.f, 0.f, 0.f, 0.f};
        cur = nxt; cA = nA; cB = nB; ++ui;
        if constexpr (ALIGN_EPI) { if (wr == 1) PG8_BAR; }
    }
    PG8_WAIT_V(0);
    if constexpr (!ALIGN_EPI) { if (wr == 0) PG8_BAR; }
    PG8_BAR;
    if constexpr (Epi::AFTER_DRAIN) { E.fused(acc, cur, wr, wc, fr, fq, lds, wid, lane); S.done(cur); }
#undef PG8_SA
#undef PG8_SB
#undef PG8_STAGE
#undef PG8_LDA
#undef PG8_LDB
#undef PG8_MMA
#undef PG8_WAIT_V
#undef PG8_WAIT_L
#undef PG8_BAR
#undef PG8_SCHED
}
}
#define XB_TMO      128
#define XB_XCNT(j)  (256  + 64 * (j))
#define XB_XSUB(j)  (1280 + 64 * (j))
#define XB_XGEN(j)  (2304 + 64 * (j))
#define XB_TOP      3328
#define XB_TOPGEN   3392
#define XCD_BAR_WORDS 3456
#define XB_SPIN_CAP (1u << 18)

__device__ __forceinline__ unsigned xb_ld(unsigned* p)              { return __hip_atomic_load(p, __ATOMIC_RELAXED, __HIP_MEMORY_SCOPE_AGENT); }
__device__ __forceinline__ unsigned xb_add(unsigned* p, unsigned v) { return __hip_atomic_fetch_add(p, v, __ATOMIC_RELAXED, __HIP_MEMORY_SCOPE_AGENT); }
__device__ __forceinline__ unsigned xb_xcc_id() { return (unsigned)__builtin_amdgcn_s_getreg((3 << 11) | 20) & 0xFu; }
#define XB_SPIN(cond, bar) do { unsigned _sp = 0; while (cond) { __builtin_amdgcn_s_sleep(1); \
    if ((++_sp & 255u) == 0u) { if (xb_ld(&(bar)[XB_TMO])) break; if (_sp > XB_SPIN_CAP) { atomicAdd(&(bar)[XB_TMO], 1u); break; } } } } while (0)

struct XcdBarrier {
    unsigned* bar; unsigned x;
    volatile LAS unsigned* st;
};

__device__ __forceinline__ XcdBarrier xcd_barrier_post(unsigned* bar, volatile LAS unsigned* st) {
    XcdBarrier b; b.bar = bar; b.x = xb_xcc_id(); b.st = st;
    if (threadIdx.x == 0) (void)xb_add(&bar[XB_XCNT(b.x)], 1u);
    return b;
}
__device__ __forceinline__ void xcd_barrier_complete(unsigned* bar, unsigned x, unsigned& nloc, unsigned& nx) {
    const unsigned G = gridDim.x * gridDim.y * gridDim.z;
    unsigned sum, cnt, mine, sp = 0u;
    for (;;) {
        sum = 0u; cnt = 0u; mine = 0u;
#pragma unroll
        for (unsigned j = 0; j < 16; ++j) { const unsigned c = xb_ld(&bar[XB_XCNT(j)]); sum += c; cnt += (c > 0u) ? 1u : 0u; mine = (j == x) ? c : mine; }
        if (sum == G) break;
        __builtin_amdgcn_s_sleep(1);
        if ((++sp & 255u) == 0u) { if (xb_ld(&bar[XB_TMO])) break; if (sp > XB_SPIN_CAP) { atomicAdd(&bar[XB_TMO], 1u); break; } }
    }
    nloc = mine > 0u ? mine : 1u; nx = cnt > 0u ? cnt : 1u;
}

__device__ __forceinline__ void xcd_barrier(const XcdBarrier& b) {
    asm volatile("s_waitcnt vmcnt(0)" ::: "memory");
    __syncthreads();
    if (threadIdx.x == 0) {
        unsigned* bar = b.bar;
        __builtin_amdgcn_s_waitcnt(0);
        unsigned nloc = b.st[0], nx = b.st[1];
        if (nloc == 0u) { xcd_barrier_complete(bar, b.x, nloc, nx); b.st[0] = nloc; b.st[1] = nx; }
        const unsigned old = xb_add(&bar[XB_XSUB(b.x)], 1u);
        const unsigned gen = old / nloc;
        if (old + 1u == (gen + 1u) * nloc) {
            __builtin_amdgcn_fence(__ATOMIC_RELEASE, "agent");
            asm volatile("s_waitcnt vmcnt(0)" ::: "memory");
            const unsigned og = xb_add(&bar[XB_TOP], 1u);
            const unsigned tg = og / nx;
            if (og + 1u == (tg + 1u) * nx) xb_add(&bar[XB_TOPGEN], 1u);
            else XB_SPIN(xb_ld(&bar[XB_TOPGEN]) == tg, bar);
            __builtin_amdgcn_fence(__ATOMIC_ACQUIRE, "agent");
            xb_add(&bar[XB_XGEN(b.x)], 1u);
            asm volatile("s_waitcnt vmcnt(0)" ::: "memory");
        } else {
            XB_SPIN(xb_ld(&bar[XB_XGEN(b.x)]) == gen, bar);
            __builtin_amdgcn_fence(__ATOMIC_ACQUIRE, "agent");
            asm volatile("s_waitcnt vmcnt(0)" ::: "memory");
        }
    }
    __syncthreads();
}


struct Frame {
    LAS unsigned char* lds;
    int tid, lane, wave, G, gw, ngw;
    const float *in_XP, *in_XS, *in_WIN, *in_WCONV, *in_BCONV, *in_WR, *in_BR, *in_WI, *in_BI, *in_LAM, *in_RPB, *in_WNO, *in_WLO, *in_WM, *in_BM, *in_WOUT, *in_GMPRE, *in_GMPOST, *in_GFPRE, *in_GFPOST, *in_WFG, *in_WFU, *in_WFD; float* out; unsigned char* ws;
};
enum { I_XP = 0, I_XS, I_WIN, I_WCONV, I_BCONV, I_WR, I_BR, I_WI, I_BI, I_LAM, I_RPB, I_WNO, I_WLO, I_WM, I_BM, I_WOUT, I_GMPRE, I_GMPOST, I_GFPRE, I_GFPOST, I_WFG, I_WFU, I_WFD };
__device__ __forceinline__ int opaque(int x) { asm volatile("" : "+v"(x)); return x; }
template <class T> __device__ __forceinline__ T* wsp(const Frame& F, size_t off) { return (T*)(F.ws + off); }
__device__ __forceinline__ const float* xrow(const Frame& F, int m) { return m < LP ? F.in_XP + (size_t)m * D : F.in_XS + (size_t)(m - LP) * D; }

__device__ __forceinline__ void tr_item(const float* src, int ldsrc, int k0, int n0, bf16_t* dst, int ldd, int drow0, LAS float* scr, int lane) {
#pragma unroll 8
    for (int i = 0; i < 32; ++i) { const int kk = 2 * i + (lane >> 5); scr[kk * 33 + (lane & 31)] = src[(size_t)(k0 + kk) * ldsrc + n0 + (lane & 31)]; }
    LDS_WAIT(); asm volatile("" ::: "memory");
    const int c = lane & 7;
#pragma unroll
    for (int j = 0; j < 4; ++j) { const int n = (lane >> 3) + 8 * j; const LAS float* s = scr + (8 * c) * 33 + n;
        u32x4 o; o.x = pk2(s[0 * 33], s[1 * 33]); o.y = pk2(s[2 * 33], s[3 * 33]); o.z = pk2(s[4 * 33], s[5 * 33]); o.w = pk2(s[6 * 33], s[7 * 33]);
        *(u32x4*)(dst + (size_t)(drow0 + n) * ldd + k0 + 8 * c) = o; }
    LDS_WAIT(); asm volatile("" ::: "memory");
}
__device__ __forceinline__ unsigned pk4_fp8(float a, float b, float c, float d) { int p = __builtin_amdgcn_cvt_pk_fp8_f32(a, b, 0, false); p = __builtin_amdgcn_cvt_pk_fp8_f32(c, d, p, true); return (unsigned)p; }
__device__ __forceinline__ void tr_item8(const float* src, int ldsrc, int k0, int n0, unsigned char* dst, int ldd, int drow0, LAS float* scr, int lane) {
#pragma unroll 8
    for (int i = 0; i < 32; ++i) { const int kk = 2 * i + (lane >> 5); scr[kk * 33 + (lane & 31)] = src[(size_t)(k0 + kk) * ldsrc + n0 + (lane & 31)]; }
    LDS_WAIT(); asm volatile("" ::: "memory");
    const int c = lane & 7;
#pragma unroll
    for (int j = 0; j < 4; ++j) { const int n = (lane >> 3) + 8 * j; const LAS float* s = scr + (8 * c) * 33 + n;
        u32x2 o; o.x = pk4_fp8(s[0 * 33] * 256.f, s[1 * 33] * 256.f, s[2 * 33] * 256.f, s[3 * 33] * 256.f); o.y = pk4_fp8(s[4 * 33] * 256.f, s[5 * 33] * 256.f, s[6 * 33] * 256.f, s[7 * 33] * 256.f);
        *(u32x2*)(dst + (size_t)(drow0 + n) * ldd + k0 + 8 * c) = o; }
    LDS_WAIT(); asm volatile("" ::: "memory");
}
#define TR_JOB(SRC, LDSRC, KK, NN, DST, DROW_EXPR) { const int nblk = (NN) / 32, nit = ((KK) / 64) * nblk; \
    if (r < nit) { const int kb = r / nblk, nb = r % nblk, n0 = 32 * nb; tr_item((SRC), (LDSRC), 64 * kb, n0, (DST), (KK), (DROW_EXPR), scr, F.lane); continue; } r -= nit; }
#define TR_JOB8(SRC, LDSRC, KK, NN, DST, DROW_EXPR) { const int nblk = (NN) / 32, nit = ((KK) / 64) * nblk; \
    if (r < nit) { const int kb = r / nblk, nb = r % nblk, n0 = 32 * nb; tr_item8((SRC), (LDSRC), 64 * kb, n0, (DST), (KK), (DROW_EXPR), scr, F.lane); continue; } r -= nit; }

__device__ __forceinline__ void p0_prologue(Frame& F) {
    const int tid_ = opaque(F.tid);
    LAS float* scr = (LAS float*)(F.lds + F.wave * 8448);
    const float* w_in = F.in_WIN;
    bf16_t* WCAT = wsp<bf16_t>(F, WS_WCAT); unsigned char* W8 = wsp<unsigned char>(F, WS_W8); unsigned char* WV8 = wsp<unsigned char>(F, WS_WVT); bf16_t* WGU = wsp<bf16_t>(F, WS_WGU);
    constexpr int NSM = 64;
    constexpr int IT_SM = 2 * 4;
    constexpr int N_BIG = 5 * (D / 64) * (NAW / 32) + (D / 64) * (2 * D / 32) + 2 * (NAW / 64) * (D / 32) + (D / 64) * (D / 32) + 2 * (D / 64) * (DFF / 32) + (DFF / 64) * (D / 32);
    constexpr int NITEMS = N_BIG + NSM * IT_SM;
    for (int it = F.gw; it < NITEMS; it += F.ngw) {
        int r = it;
        TR_JOB(w_in + 0, INW, D, NAW, WCAT, 0 + n0)
        TR_JOB(w_in + 3 * NAW, INW, D, NAW, WCAT, 2048 + n0)
        TR_JOB(w_in + NAW, INW, D, NAW, WCAT, 4096 + n0)
        TR_JOB(w_in + 4 * NAW, INW, D, NAW, WCAT, 6144 + n0)
        TR_JOB8(F.in_WM, 2 * D, D, 2 * D, W8, n0)
        TR_JOB8(w_in + 2 * NAW, INW, D, NAW, WV8, n0)
        TR_JOB(F.in_WNO, D, NAW, D, wsp<bf16_t>(F, WS_WNO), n0)
        TR_JOB(F.in_WLO, D, LW, D, wsp<bf16_t>(F, WS_WLO), n0)
        TR_JOB(F.in_WOUT, D, D, D, wsp<bf16_t>(F, WS_WO), n0)
        TR_JOB(F.in_WFG, DFF, D, DFF, WGU, (n0 >> 7) * 256 + (n0 & 127))
        TR_JOB(F.in_WFU, DFF, D, DFF, WGU, (n0 >> 7) * 256 + 128 + (n0 & 127))
        TR_JOB(F.in_WFD, D, DFF, D, wsp<bf16_t>(F, WS_WD), n0)
        {
            const int mi = r / IT_SM, ri = r % IT_SM, d = mi >> 5, g = (mi >> 4) & 1, n = mi & 15, kb = ri >> 2, nb = ri & 3;
            const float* src = (g ? F.in_WI : F.in_WR) + (size_t)(d * NBLK + n) * BW * BW;
            tr_item(src, BW, 64 * kb, 32 * nb, wsp<bf16_t>(F, WS_WG) + (size_t)mi * BW * BW, BW, 32 * nb, scr, F.lane);
        }
    }
    LAS f32x4* gl = (LAS f32x4*)(F.lds + 69632);
    for (int i = tid_; i < D / 4; i += NTHR) gl[i] = ((const f32x4*)F.in_GMPRE)[i];
    __syncthreads();
    bf16_t* XN = wsp<bf16_t>(F, WS_XN); unsigned char* XN8 = wsp<unsigned char>(F, WS_XN8);
    for (int m = F.gw; m < L; m += F.ngw) {
        asm volatile("" ::: "memory");
        const f32x4* xr = (const f32x4*)xrow(F, m) + F.lane;
        f32x4 v[16]; float s = 0.f;
#pragma unroll
        for (int j = 0; j < 16; ++j) { v[j] = xr[64 * j]; s += (v[j].x * v[j].x + v[j].y * v[j].y) + (v[j].z * v[j].z + v[j].w * v[j].w); }
        const float rstd = 1.0f / sqrtf(wave_sum(s) * (1.0f / D) + EPS);
        u32x2* o8 = (u32x2*)(XN + (size_t)m * D) + F.lane; unsigned* o4 = (unsigned*)(XN8 + (size_t)m * D) + F.lane;
#pragma unroll
        for (int j = 0; j < 16; ++j) { const f32x4 g = gl[F.lane + 64 * j]; const f32x4 y = v[j] * rstd * g; u32x2 o; o.x = pk2(y.x, y.y); o.y = pk2(y.z, y.w); o8[64 * j] = o;
            o4[64 * j] = pk4_fp8(y.x * 16.f, y.y * 16.f, y.z * 16.f, y.w * 16.f); }
    }
    __syncthreads();
}

#ifndef ATT_SYNC
#define ATT_SYNC 1
#endif
template <int ADBG = 0> __device__ __forceinline__ void attn_mfma(Frame& F) {
    const int tid_ = opaque(F.tid);
    bf16_t* Q = wsp<bf16_t>(F, WS_Q); const bf16_t* Kb = wsp<bf16_t>(F, WS_K); const bf16_t* VT = wsp<bf16_t>(F, WS_VT);
    LAS float* rp = (LAS float*)F.lds;
    for (int i = tid_; i < NH * 15 * 31; i += NTHR) rp[i] = F.in_RPB[i];
    __syncthreads();
    const int fr = F.lane & 15, fq = F.lane >> 4;
    const float scale = 0.08838834764831845f;
    for (int base = blockIdx.x * NWAVES; base < (L / GRIDW) * NH * 4; base += F.ngw) {
        const int item = base + F.wave;
        asm volatile("" ::: "memory");
        const int g = item & 3, h = (item >> 2) & 15, rg = item >> 6;
        const int s0 = rg < LP / GRIDW ? 0 : LP, rows = rg < LP / GRIDW ? LP / GRIDW : LS / GRIDW, r = rg < LP / GRIDW ? rg : rg - LP / GRIDW;
        int rs = r - 4; rs = rs < 0 ? 0 : (rs > rows - 8 ? rows - 8 : rs);
        const int w0 = g == 0 ? 0 : (g == 1 ? 8 : (g == 2 ? 24 : 32));
        const int c = 16 * g + fr;
        int cs = c - 8; cs = cs < 0 ? 0 : (cs > GRIDW - 16 ? GRIDW - 16 : cs);
        bf16_t* qrow = Q + (size_t)(s0 + r * GRIDW + c) * NAW + h * HD;
        bf16x8 qf[4];
#pragma unroll
        for (int s = 0; s < 4; ++s) qf[s] = *(const bf16x8*)(qrow + 8 * fq + 32 * s);
        f32x4 sacc[8][2];
        const int Rg = s0 / GRIDW + rs, p0 = w0 >> 3;
        const bf16_t* kbase = Kb + (size_t)(Rg * 16 + h) * 8192 + p0 * 128 + fr * 32 + fq * 8;
        bf16x8 kb[8][2][4];
#define ATT_LDK(kr) do { _Pragma("unroll") for (int T = 0; T < 2; ++T) _Pragma("unroll") for (int s = 0; s < 4; ++s) kb[kr][T][s] = (ADBG & 1) ? qf[s] : (ADBG & 4) ? *(const bf16x8*)(Kb + (size_t)(s0 + rs * GRIDW) * NAW + h * HD * GRIDW + ((kr) * 8 + T * 4 + s) * 512 + F.lane * 8) : *(const bf16x8*)(kbase + (size_t)(kr) * (16 * 8192) + (s * 2 + T) * 1024); } while (0)
        ATT_LDK(0); ATT_LDK(1);
#pragma unroll
        for (int kr = 0; kr < 8; ++kr) {
            if (ATT_SYNC && (kr & 1) == 0) __builtin_amdgcn_s_barrier();
            if (kr + 2 < 8) ATT_LDK(kr + 2);
            __builtin_amdgcn_sched_barrier(0);
#pragma unroll
            for (int T = 0; T < 2; ++T) { f32x4 a = (f32x4){0.f, 0.f, 0.f, 0.f};
#pragma unroll
                for (int s = 0; s < 4; ++s) a = __builtin_amdgcn_mfma_f32_16x16x32_bf16(kb[kr][T][s], qf[s], a, 0, 0, 0);
                sacc[kr][T] = a; }
            __builtin_amdgcn_sched_barrier(0);
        }
#undef ATT_LDK
        bf16x8 vb[8][8];
        const bf16_t* vbase = VT + (size_t)(Rg * 16 + h) * 8192 + p0 * 128 + fq * 128 + fr * 8;
#define ATT_LDV(kr) do { _Pragma("unroll") for (int dt = 0; dt < 8; ++dt) vb[kr][dt] = (ADBG & 2) ? qf[dt & 3] : (ADBG & 4) ? *(const bf16x8*)(VT + (size_t)(h * HD) * L + s0 + rs * GRIDW + ((kr) * 8 + dt) * 512 + F.lane * 8) : *(const bf16x8*)(vbase + (size_t)(kr) * (16 * 8192) + dt * 1024); } while (0)
        ATT_LDV(0); ATT_LDV(1);
        __builtin_amdgcn_sched_barrier(0);
        const int elo = cs - w0 - 8 * fq, dc0 = w0 + 8 * fq - c + 15;
        const LAS float* rph = rp + h * 465 + (rs - r + 7) * 31;
        float mx = -3.0e38f;
#pragma unroll
        for (int e = 0; e < 8; ++e) { const bool valid = (e >= elo) && (e < elo + 16); const int bi = valid ? dc0 + e : 0;
#pragma unroll
            for (int kr = 0; kr < 8; ++kr) { const float sv = valid ? sacc[kr][e >> 2][e & 3] * scale + rph[kr * 31 + bi] : -3.0e38f; sacc[kr][e >> 2][e & 3] = sv; mx = fmaxf(mx, sv); } }
        mx = fmaxf(mx, __shfl_xor(mx, 16)); mx = fmaxf(mx, __shfl_xor(mx, 32));
        float lsum = 0.f; bf16x8 pf[8];
#pragma unroll
        for (int kr = 0; kr < 8; ++kr) { float p[8];
#pragma unroll
            for (int e = 0; e < 8; ++e) { p[e] = __expf(sacc[kr][e >> 2][e & 3] - mx); lsum += p[e]; }
            u32x4 w; w.x = pk2(p[0], p[1]); w.y = pk2(p[2], p[3]); w.z = pk2(p[4], p[5]); w.w = pk2(p[6], p[7]);
            pf[kr] = __builtin_bit_cast(bf16x8, w); }
        lsum += __shfl_xor(lsum, 16); lsum += __shfl_xor(lsum, 32);
        f32x4 oacc[8];
#pragma unroll
        for (int dt = 0; dt < 8; ++dt) oacc[dt] = (f32x4){0.f, 0.f, 0.f, 0.f};
#pragma unroll
        for (int kr = 0; kr < 8; ++kr) {
            if (ATT_SYNC && (kr & 1) == 0) __builtin_amdgcn_s_barrier();
            if (kr + 2 < 8) ATT_LDV(kr + 2);
            __builtin_amdgcn_sched_barrier(0);
#pragma unroll
            for (int dt = 0; dt < 8; ++dt) oacc[dt] = __builtin_amdgcn_mfma_f32_16x16x32_bf16(vb[kr][dt], pf[kr], oacc[dt], 0, 0, 0);
            __builtin_amdgcn_sched_barrier(0);
        }
#undef ATT_LDV
        const float inv = 1.0f / lsum;
#ifdef ATTN_OUT_OFF
        bf16_t* orow = wsp<bf16_t>(F, (size_t)ATTN_OUT_OFF * MiB) + (size_t)(s0 + r * GRIDW + c) * NAW + h * HD;
#else
        bf16_t* orow = qrow;
#endif
#pragma unroll
        for (int u = 0; u < 4; ++u) *(u32x4*)(orow + 32 * u + 8 * fq) = pg8::pack8(oacc[2 * u] * inv, oacc[2 * u + 1] * inv);
    }
    __syncthreads();
}

__device__ __forceinline__ void conv_phase(Frame& F) {
    const int tid_ = opaque(F.tid);
    const bf16_t* XR = wsp<bf16_t>(F, WS_XR); bf16_t* XC = wsp<bf16_t>(F, WS_XC);
    const float* wc = F.in_WCONV; const float* bc = F.in_BCONV;
    const int nth = F.G * NTHR;
    for (int it = blockIdx.x * NTHR + tid_; it < L * (LW / 8); it += nth) {
        const int t = it / (LW / 8), c0 = (it % (LW / 8)) * 8;
        const int s0 = t < LP ? 0 : LP, len = t < LP ? LP : LS, tl = t - s0;
        float acc[8];
#pragma unroll
        for (int e = 0; e < 8; ++e) acc[e] = bc[c0 + e];
#pragma unroll
        for (int j = 0; j < 4; ++j) { const int tt = tl + j - 2; if (tt < 0 || tt >= len) continue;
            f32x4 x0, x1; pg8::unpack8(*(const u32x4*)(XR + (size_t)(s0 + tt) * LW + c0), x0, x1);
            const f32x4 w0 = *(const f32x4*)(wc + j * LW + c0), w1 = *(const f32x4*)(wc + j * LW + c0 + 4);
#pragma unroll
            for (int e = 0; e < 4; ++e) { acc[e] += w0[e] * x0[e]; acc[4 + e] += w1[e] * x1[e]; } }
        *(u32x4*)(XC + (size_t)t * LW + c0) = pg8::pack8((f32x4){acc[0], acc[1], acc[2], acc[3]}, (f32x4){acc[4], acc[5], acc[6], acc[7]});
    }
}

struct LruW { bf16x8 w[2][4]; float br, bi, cl; };
template <int DIR> __device__ __forceinline__ void lru_load_w(const Frame& F, LruW& W, int n, int w, int fr, int fq) {
    const bf16_t* wg = wsp<bf16_t>(F, WS_WG);
#pragma unroll
    for (int g = 0; g < 2; ++g)
#pragma unroll
        for (int s = 0; s < 4; ++s) W.w[g][s] = *(const bf16x8*)(wg + ((size_t)((DIR * 2 + g) * NBLK + n) * BW + 16 * w + fr) * BW + 32 * fq + 8 * s);
    const int ch = n * BW + 16 * w + fr;
    W.br = F.in_BR[DIR * LW + ch]; W.bi = F.in_BI[DIR * LW + ch];
    const float lam = F.in_LAM[DIR * LW + ch];
    W.cl = -8.0f * ((lam > 15.f) ? __expf(-lam) : log1pf(__expf(-lam)));
}
template <int LDBG = 0> __device__ __forceinline__ void lru_gate(float pr, float pi, float xc, const LruW& W, bool first, float& a, float& u) {
    if constexpr (LDBG == 1) { a = pr + W.br; u = pi * xc + W.bi; return; }
    const float r = sigmoidf_(pr + W.br), ig = sigmoidf_(pi + W.bi);
    a = __expf(W.cl * r);
    const float mult = first ? 1.0f : __builtin_amdgcn_sqrtf(fmaxf(1.0f - a * a, 0.f));
    u = mult * ig * xc;
}
struct LruX { bf16x8 x[4][4]; };
__device__ __forceinline__ void lru_load_x(LruX& X, const bf16_t* XC, int tb, int n, int fr, int fq) {
#pragma unroll
    for (int tau = 0; tau < 4; ++tau) { const bf16_t* xp = XC + ((size_t)((((tb >> 6) * NBLK + n) * 4 + tau) * 4) * 64 + fr * 4 + fq) * 8;
#pragma unroll
        for (int s = 0; s < 4; ++s) X.x[tau][s] = *(const bf16x8*)(xp + s * 512); }
}
__device__ __forceinline__ void lru_tile(const LruX& X, int tau, bool hiw, const LruW& W, const bf16x8 idf0, const bf16x8 idf1, f32x4& pr, f32x4& pi, f32x4& xct) {
    pr = (f32x4){0.f, 0.f, 0.f, 0.f}; pi = pr;
#pragma unroll
    for (int s = 0; s < 4; ++s) { pr = __builtin_amdgcn_mfma_f32_16x16x32_bf16(X.x[tau][s], W.w[0][s], pr, 0, 0, 0); pi = __builtin_amdgcn_mfma_f32_16x16x32_bf16(X.x[tau][s], W.w[1][s], pi, 0, 0, 0); }
    const bf16x8 x0 = hiw ? X.x[tau][2] : X.x[tau][0], x1 = hiw ? X.x[tau][3] : X.x[tau][1];
    xct = __builtin_amdgcn_mfma_f32_16x16x32_bf16(x0, idf0, (f32x4){0.f, 0.f, 0.f, 0.f}, 0, 0, 0);
    xct = __builtin_amdgcn_mfma_f32_16x16x32_bf16(x1, idf1, xct, 0, 0, 0);
}
__device__ __forceinline__ void lru_idfrags(int w, int fr, int fq, bf16x8& idf0, bf16x8& idf1) {
#pragma unroll
    for (int e = 0; e < 8; ++e) { const bool on = (fq == (w >> 1)) && ((fr & 7) == e); idf0[e] = (on && fr < 8) ? (short)0x3F80 : (short)0; idf1[e] = (on && fr >= 8) ? (short)0x3F80 : (short)0; }
}
constexpr int LRU_CH = 256, LRU_NCH = L / LRU_CH, LRU_NCH_P = LP / LRU_CH;
__device__ __forceinline__ void conv_unit(Frame& F, int cg, int n) {
    const int tid_ = opaque(F.tid);
    const bf16_t* XR = wsp<bf16_t>(F, WS_XR); bf16_t* XC = wsp<bf16_t>(F, WS_XC);
    const float* wc = F.in_WCONV; const float* bc = F.in_BCONV;
    const int c0 = n * BW + (tid_ & 15) * 8;
    const int s0 = cg < LRU_NCH_P ? 0 : LP, len = cg < LRU_NCH_P ? LP : LS;
    f32x4 w[4][2]; f32x4 b0 = *(const f32x4*)(bc + c0), b1 = *(const f32x4*)(bc + c0 + 4);
#pragma unroll
    for (int j = 0; j < 4; ++j) { w[j][0] = *(const f32x4*)(wc + j * LW + c0); w[j][1] = *(const f32x4*)(wc + j * LW + c0 + 4); }
#pragma unroll
    for (int i = 0; i < 8; ++i) {
        const int t = cg * LRU_CH + (tid_ >> 4) + 32 * i, tl = t - s0;
        f32x4 a0 = b0, a1 = b1;
#pragma unroll
        for (int j = 0; j < 4; ++j) { const int tt = tl + j - 2; if (tt < 0 || tt >= len) continue;
            f32x4 x0, x1; pg8::unpack8(*(const u32x4*)(XR + (size_t)(s0 + tt) * LW + c0), x0, x1); a0 += w[j][0] * x0; a1 += w[j][1] * x1; }
        const int tg = t & 63, cq = tid_ & 15;
        *(u32x4*)(XC + ((size_t)(((((t >> 6) * NBLK + n) * 4 + ((tg >> 2) & 3)) * 4 + (cq & 3)) * 16 + 4 * (tg >> 4) + (tg & 3)) * 4 + (cq >> 2)) * 8) = pg8::pack8(a0, a1);
    }
}
__device__ __forceinline__ void lru_pass_a(Frame& F) {
    const int fr = F.lane & 15, fq = F.lane >> 4, w = F.wave;
    const bf16_t* XC = wsp<bf16_t>(F, WS_XC); f32x2* SUMM = wsp<f32x2>(F, WS_SUM);
    bf16x8 idf0, idf1; lru_idfrags(w, fr, fq, idf0, idf1);
    for (int u = blockIdx.x; u < LRU_NCH * NBLK; u += F.G) {
        const int cg = u >> 4, n = u & 15;
        conv_unit(F, cg, n); VM_WAIT(); __syncthreads();
        LruW Wf, Wb; lru_load_w<0>(F, Wf, n, w, fr, fq); lru_load_w<1>(F, Wb, n, w, fr, fq);
        const bool c_first = (cg == 0 || cg == LRU_NCH_P), c_last = (cg == LRU_NCH_P - 1 || cg == LRU_NCH - 1);
        float Af = 1.f, Hf = 0.f, Ab = 1.f, Hb = 0.f;
        LruX X, Xn; lru_load_x(X, XC, cg * LRU_CH, n, fr, fq);
        for (int gi = 0; gi < 4; ++gi) {
            if (gi < 3) lru_load_x(Xn, XC, cg * LRU_CH + (gi + 1) * 64, n, fr, fq);
            float pf = 1.f, hf = 0.f, pb = 1.f, hb = 0.f;
#pragma unroll
            for (int tau = 0; tau < 4; ++tau) {
                f32x4 prf, pif, prb, pib, xct, xct2;
                lru_tile(X, tau, (w & 1) != 0, Wf, idf0, idf1, prf, pif, xct);
                lru_tile(X, tau, (w & 1) != 0, Wb, idf0, idf1, prb, pib, xct2);
#pragma unroll
                for (int j = 0; j < 4; ++j) {
                    float a, uu;
                    lru_gate(prf[j], pif[j], xct[j], Wf, c_first && gi == 0 && fq == 0 && tau == 0 && j == 0, a, uu); hf = a * hf + uu; pf *= a;
                    lru_gate(prb[j], pib[j], xct[j], Wb, c_last && gi == 3 && fq == 3 && tau == 3 && j == 3, a, uu); hb += pb * uu; pb *= a;
                }
            }
            float gPf = 1.f, gHf = 0.f, gPb = 1.f, gHb = 0.f;
#pragma unroll
            for (int qq = 0; qq < 4; ++qq) { const int src = fr + 16 * qq;
                float P = __shfl(pf, src), H = __shfl(hf, src); gHf = P * gHf + H; gPf *= P;
                P = __shfl(pb, src); H = __shfl(hb, src); gHb += gPb * H; gPb *= P; }
            Hf = gPf * Hf + gHf; Af *= gPf; Hb += Ab * gHb; Ab *= gPb;
            X = Xn;
        }
        if (fq == 0) { const int ch = n * BW + 16 * w + fr; SUMM[(size_t)(cg * 2 + 0) * LW + ch] = (f32x2){Af, Hf}; SUMM[(size_t)(cg * 2 + 1) * LW + ch] = (f32x2){Ab, Hb}; }
    }
}
__device__ __forceinline__ void lru_pass_b(Frame& F) {
    const int tid_ = opaque(F.tid);
    const int gt = blockIdx.x * NTHR + tid_; if (gt >= 4 * LW) return;
    const int ch = gt % LW, d = (gt / LW) & 1, seq = gt / (2 * LW), c0 = seq ? LRU_NCH_P : 0, nc = seq ? LRU_NCH - LRU_NCH_P : LRU_NCH_P;
    const f32x2* SUMM = wsp<f32x2>(F, WS_SUM); float* CIN = wsp<float>(F, WS_SUM + 4 * MiB);
    float s = 0.f;
    for (int i0 = 0; i0 < nc; i0 += 8) {
        f32x2 ah[8];
#pragma unroll
        for (int e = 0; e < 8; ++e) { const int cg = d ? c0 + nc - 1 - (i0 + e) : c0 + i0 + e; ah[e] = SUMM[(size_t)(cg * 2 + d) * LW + ch]; }
#pragma unroll
        for (int e = 0; e < 8; ++e) { const int cg = d ? c0 + nc - 1 - (i0 + e) : c0 + i0 + e; CIN[(size_t)(cg * 2 + d) * LW + ch] = s; s = ah[e].x * s + ah[e].y; }
    }
}
template <int LDBG = 0> __device__ __forceinline__ void lru_pass_c(Frame& F) {
    const int tid_ = opaque(F.tid);
    const int fr = F.lane & 15, fq = F.lane >> 4, w = F.wave;
    const bf16_t* XC = wsp<bf16_t>(F, WS_XC); const float* CIN = wsp<float>(F, WS_SUM + 4 * MiB);
    const bf16_t* GR = wsp<bf16_t>(F, WS_GR); bf16_t* LRU = wsp<bf16_t>(F, WS_XR);
    LAS bf16_t* hfb = (LAS bf16_t*)(F.lds + w * 8192);
    LAS bf16_t* grt = (LAS bf16_t*)(F.lds + 65536);
    bf16x8 idf0, idf1; lru_idfrags(w, fr, fq, idf0, idf1);
    for (int u = blockIdx.x; u < LRU_NCH * NBLK; u += F.G) {
        const int cg = u >> 4, n = u & 15, ch = n * BW + 16 * w + fr;
        const bool c_first = (cg == 0 || cg == LRU_NCH_P), c_last = (cg == LRU_NCH_P - 1 || cg == LRU_NCH - 1);
        { const bf16_t* gsrc = GR + (size_t)(cg * LRU_CH + (tid_ >> 4)) * LW + n * BW + (tid_ & 15) * 8; LAS bf16_t* ldst = grt + w * 512;
#pragma unroll 1
          for (int k = 0; k < 8; ++k) { __builtin_amdgcn_global_load_lds((const unsigned*)gsrc, (LAS unsigned*)ldst, 16, 0, 0); gsrc += (size_t)32 * LW; ldst += NTHR * 8; } }
        {
            LruW W; lru_load_w<0>(F, W, n, w, fr, fq);
            float s = CIN[(size_t)(cg * 2 + 0) * LW + ch];
            LruX X, Xn; lru_load_x(X, XC, cg * LRU_CH, n, fr, fq);
            for (int gi = 0; gi < 4; ++gi) {
                if (gi < 3 && LDBG != 2) lru_load_x(Xn, XC, cg * LRU_CH + (gi + 1) * 64, n, fr, fq);
                float a[16], uu[16];
#pragma unroll
                for (int tau = 0; tau < 4; ++tau) { f32x4 pr, pi, xct; lru_tile(X, tau, (w & 1) != 0, W, idf0, idf1, pr, pi, xct);
#pragma unroll
                    for (int j = 0; j < 4; ++j) lru_gate<LDBG>(pr[j], pi[j], xct[j], W, c_first && gi == 0 && fq == 0 && tau == 0 && j == 0, a[4 * tau + j], uu[4 * tau + j]); }
                float p = 1.f, h = 0.f;
#pragma unroll
                for (int t = 0; t < 16; ++t) { h = a[t] * h + uu[t]; p *= a[t]; }
                float hin = s, sg = s;
#pragma unroll
                for (int qq = 0; qq < 4; ++qq) { const float P = __shfl(p, fr + 16 * qq), H = __shfl(h, fr + 16 * qq); sg = P * sg + H; if (qq < fq) hin = P * hin + H; }
                s = sg;
                float hh = hin;
#pragma unroll
                for (int t = 0; t < 16; ++t) { hh = a[t] * hh + uu[t]; hfb[(gi * 64 + 16 * fq + t) * 16 + fr] = (bf16_t)f2bf(hh); }
                X = Xn;
            }
        }
        VM_WAIT(); __syncthreads();
        {
            LruW W; lru_load_w<1>(F, W, n, w, fr, fq);
            float s = CIN[(size_t)(cg * 2 + 1) * LW + ch];
            LruX X, Xn; lru_load_x(X, XC, cg * LRU_CH + 3 * 64, n, fr, fq);
            for (int gi = 3; gi >= 0; --gi) {
                if (gi > 0 && LDBG != 2) lru_load_x(Xn, XC, cg * LRU_CH + (gi - 1) * 64, n, fr, fq);
                float a[16], uu[16];
#pragma unroll
                for (int tau = 0; tau < 4; ++tau) { f32x4 pr, pi, xct; lru_tile(X, tau, (w & 1) != 0, W, idf0, idf1, pr, pi, xct);
#pragma unroll
                    for (int j = 0; j < 4; ++j) lru_gate<LDBG>(pr[j], pi[j], xct[j], W, c_last && gi == 3 && fq == 3 && tau == 3 && j == 3, a[4 * tau + j], uu[4 * tau + j]); }
                float p = 1.f, h = 0.f;
#pragma unroll
                for (int t = 15; t >= 0; --t) { h = a[t] * h + uu[t]; p *= a[t]; }
                float hin = s, sg = s;
#pragma unroll
                for (int qq = 3; qq >= 0; --qq) { const float P = __shfl(p, fr + 16 * qq), H = __shfl(h, fr + 16 * qq); sg = P * sg + H; if (qq > fq) hin = P * hin + H; }
                s = sg;
                float hh = hin;
#pragma unroll
                for (int t = 15; t >= 0; --t) { hh = a[t] * hh + uu[t];
                    const int tl = gi * 64 + 16 * fq + t; LAS bf16_t* gp = grt + tl * BW + 16 * w + fr;
                    *gp = (bf16_t)f2bf((bf1(hfb[tl * 16 + fr]) + hh) * gelu_tanh(bf1(*gp))); }
                X = Xn;
            }
        }
        LDS_WAIT(); __syncthreads();
        { bf16_t* gdst = LRU + (size_t)(cg * LRU_CH + (tid_ >> 4)) * LW + n * BW + (tid_ & 15) * 8; const LAS bf16_t* lsrc = grt + tid_ * 8;
#pragma unroll 1
          for (int k = 0; k < 8; ++k) { *(u32x4*)gdst = *(const LAS u32x4*)lsrc; gdst += (size_t)32 * LW; lsrc += NTHR * 8; } }
        LDS_WAIT(); __syncthreads();
    }
}

__device__ __forceinline__ f32x4 up4(const u32x2 u) { return (f32x4){bflo(u.x), bfhi(u.x), bflo(u.y), bfhi(u.y)}; }
__device__ __forceinline__ void mid_phase(Frame& F) {
    const int tid_ = opaque(F.tid);
    const bf16_t* MIX = wsp<bf16_t>(F, WS_MIX); bf16_t* XN = wsp<bf16_t>(F, WS_XN); float* RSTD = wsp<float>(F, WS_RSTD);
    LAS f32x4* gpost = (LAS f32x4*)F.lds; LAS f32x4* gpre = gpost + D / 4;
    for (int i = tid_; i < D / 4; i += NTHR) { gpost[i] = ((const f32x4*)F.in_GMPOST)[i]; gpre[i] = ((const f32x4*)F.in_GFPRE)[i]; }
    __syncthreads();
    for (int m = F.gw; m < L; m += F.ngw) {
        asm volatile("" ::: "memory");
        const f32x4* xr = (const f32x4*)xrow(F, m) + F.lane; const u32x2* mr = (const u32x2*)(MIX + (size_t)m * D) + F.lane;
        f32x4 v[16]; u32x2 mx[16]; float s = 0.f;
#pragma unroll
        for (int j = 0; j < 16; ++j) { v[j] = xr[64 * j]; mx[j] = mr[64 * j]; const f32x4 a = up4(mx[j]); s += (a.x * a.x + a.y * a.y) + (a.z * a.z + a.w * a.w); }
        const float rstd1 = 1.0f / sqrtf(wave_sum(s) * (1.0f / D) + EPS);
        if (F.lane == 0) RSTD[m] = rstd1;
        float s2 = 0.f;
#pragma unroll
        for (int j = 0; j < 16; ++j) { v[j] = v[j] + up4(mx[j]) * rstd1 * gpost[F.lane + 64 * j]; s2 += (v[j].x * v[j].x + v[j].y * v[j].y) + (v[j].z * v[j].z + v[j].w * v[j].w); }
        const float rstd2 = 1.0f / sqrtf(wave_sum(s2) * (1.0f / D) + EPS);
        u32x2* o8 = (u32x2*)(XN + (size_t)m * D) + F.lane;
#pragma unroll
        for (int j = 0; j < 16; ++j) { const f32x4 g = gpre[F.lane + 64 * j]; u32x2 o; o.x = pk2(v[j].x * rstd2 * g.x, v[j].y * rstd2 * g.y); o.y = pk2(v[j].z * rstd2 * g.z, v[j].w * rstd2 * g.w); o8[64 * j] = o; }
    }
    __syncthreads();
}
__device__ __forceinline__ void final_phase(Frame& F) {
    const int tid_ = opaque(F.tid);
    const bf16_t* MIX = wsp<bf16_t>(F, WS_MIX); const bf16_t* FB = wsp<bf16_t>(F, WS_F); const float* RSTD = wsp<float>(F, WS_RSTD);
    LAS f32x4* gpost = (LAS f32x4*)F.lds; LAS f32x4* gfp = gpost + D / 4;
    for (int i = tid_; i < D / 4; i += NTHR) { gpost[i] = ((const f32x4*)F.in_GMPOST)[i]; gfp[i] = ((const f32x4*)F.in_GFPOST)[i]; }
    __syncthreads();
    for (int m = F.gw; m < L; m += F.ngw) {
        asm volatile("" ::: "memory");
        const f32x4* xr = (const f32x4*)xrow(F, m) + F.lane; const u32x2* mr = (const u32x2*)(MIX + (size_t)m * D) + F.lane; const u32x2* fr = (const u32x2*)(FB + (size_t)m * D) + F.lane;
        const float rstd1 = RSTD[m];
        u32x2 fx[16]; float s = 0.f;
#pragma unroll
        for (int j = 0; j < 16; ++j) { fx[j] = fr[64 * j]; const f32x4 a = up4(fx[j]); s += (a.x * a.x + a.y * a.y) + (a.z * a.z + a.w * a.w); }
        const float rstd3 = 1.0f / sqrtf(wave_sum(s) * (1.0f / D) + EPS);
        f32x4* o = (f32x4*)(F.out + (size_t)m * D) + F.lane;
#pragma unroll
        for (int j = 0; j < 16; ++j) o[64 * j] = xr[64 * j] + up4(mr[64 * j]) * rstd1 * gpost[F.lane + 64 * j] + up4(fx[j]) * rstd3 * gfp[F.lane + 64 * j];
    }
}

constexpr int LDS_STAGE = pg8::STAGE_BYTES;
constexpr int LDS_MISC = LDS_STAGE;
constexpr int LDS_BYTES = LDS_STAGE + 1024;
#ifndef MK_N_LAUNCHES
#define MK_N_LAUNCHES 1
#endif
constexpr int NPHASE = 11;
struct Args { const float* in[23]; float* out; unsigned char* ws; int ph_lo, ph_hi; };

__global__ void __launch_bounds__(NTHR, 2) fwd_kernel(Args args) {
    extern __shared__ __attribute__((aligned(16))) unsigned char lds_raw[];
    Frame F;
    F.lds = (LAS unsigned char*)lds_raw;
    F.tid = threadIdx.x; F.lane = (int)__builtin_amdgcn_mbcnt_hi(~0u, __builtin_amdgcn_mbcnt_lo(~0u, 0u)); F.wave = __builtin_amdgcn_readfirstlane(F.tid >> 6);
    F.G = gridDim.x; F.gw = blockIdx.x * NWAVES + F.wave; F.ngw = F.G * NWAVES;
    F.in_XP = args.in[0]; F.in_XS = args.in[1]; F.in_WIN = args.in[2]; F.in_WCONV = args.in[3]; F.in_BCONV = args.in[4]; F.in_WR = args.in[5]; F.in_BR = args.in[6]; F.in_WI = args.in[7]; F.in_BI = args.in[8]; F.in_LAM = args.in[9]; F.in_RPB = args.in[10]; F.in_WNO = args.in[11]; F.in_WLO = args.in[12]; F.in_WM = args.in[13]; F.in_BM = args.in[14]; F.in_WOUT = args.in[15]; F.in_GMPRE = args.in[16]; F.in_GMPOST = args.in[17]; F.in_GFPRE = args.in[18]; F.in_GFPOST = args.in[19]; F.in_WFG = args.in[20]; F.in_WFU = args.in[21]; F.in_WFD = args.in[22];
    F.out = args.out; F.ws = args.ws;
    volatile LAS unsigned* MISC = (volatile LAS unsigned*)(F.lds + LDS_MISC);
    if (F.tid < 256) MISC[F.tid] = 0u;
    __syncthreads();
    const int lo = args.ph_lo, hi = args.ph_hi;
    const bool fused = (hi - lo) > 1;
    XcdBarrier bar; bar.bar = (unsigned*)(F.ws + WS_CTL); bar.x = 0; bar.st = nullptr;
    if (fused) bar = xcd_barrier_post((unsigned*)(F.ws + WS_CTL), MISC + 8);
#ifndef PH_MASK
#define PH_MASK 0x7ff
#endif
#define IN(k) (((PH_MASK >> (k)) & 1) && lo <= (k) && (k) < hi)
#define SEAM(k) do { if (IN(k) && IN((k) + 1)) xcd_barrier(bar); } while (0)
    LAS unsigned char* stage = F.lds;

#ifdef ATTN_OUT_OFF
#define NA_BUF ((size_t)ATTN_OUT_OFF * MiB)
#else
#define NA_BUF WS_Q
#endif
#ifndef DUP_MASK
#define DUP_MASK 0
#endif
#define RUN(k, ...) if (IN(k)) { __VA_ARGS__ if (((DUP_MASK) >> (k)) & 1) { __VA_ARGS__ } }
    RUN(0, { p0_prologue(F); }) SEAM(0);
    RUN(1, {
        { pg8::Gemm g{wsp<bf16_t>(F, WS_XN), wsp<bf16_t>(F, WS_XN), 1 << 30, wsp<bf16_t>(F, WS_WCAT), L, 4 * NAW, 2 * D}; pg8::StaticOrder S; S.init(L, 4 * NAW, F.G, (int)blockIdx.x);
          pg8::EpiProj E{wsp<bf16_t>(F, WS_Q), wsp<bf16_t>(F, WS_XR), wsp<bf16_t>(F, WS_K), wsp<bf16_t>(F, WS_GR), (bf16_t*)F.out, F.in_BM, 1 << 30};
          pg8::gemm_phase<pg8::EpiProj, pg8::StaticOrder, true, true, false>(stage, g, S, E); }
        { pg8::Gemm g{wsp<bf16_t>(F, WS_XN8), wsp<bf16_t>(F, WS_XN8), 1 << 30, wsp<bf16_t>(F, WS_W8), L, 2 * D, D}; pg8::StaticOrder S; S.init(L, 2 * D, F.G, (int)blockIdx.x);
          pg8::EpiProj E{wsp<bf16_t>(F, WS_Q), wsp<bf16_t>(F, WS_XR), wsp<bf16_t>(F, WS_K), wsp<bf16_t>(F, WS_GR), (bf16_t*)F.out, F.in_BM, 0};
          pg8::gemm_phase<pg8::EpiProj, pg8::StaticOrder, true, true, true>(stage, g, S, E); }
        { pg8::Gemm g{wsp<bf16_t>(F, WS_WVT), wsp<bf16_t>(F, WS_WVT), 1 << 30, wsp<bf16_t>(F, WS_XN8), NAW, L, D}; pg8::StaticOrder S; S.init(NAW, L, F.G, (int)blockIdx.x);
          pg8::EpiVT E{wsp<bf16_t>(F, WS_VT)};
          pg8::gemm_phase<pg8::EpiVT, pg8::StaticOrder, true, true, true>(stage, g, S, E); }
    }) SEAM(1);
    RUN(2, { lru_pass_a(F); }) SEAM(2);
    #ifdef ATTN_OUT_OFF
    if (IN(3)) { lru_pass_b(F); } SEAM(3);
    if (IN(4)) { lru_pass_c<0>(F); xcd_barrier(bar); if (ATTN_DUP) attn_mfma<ATTN_DUP - 1>(F); attn_mfma<0>(F); } SEAM(4);
#else
    if (IN(3)) { lru_pass_b(F); attn_mfma<0>(F); } SEAM(3);
#ifdef LRUC_DBG
    if (IN(4)) { lru_pass_c<LRUC_DBG>(F); lru_pass_c<0>(F); } SEAM(4);
#else
    RUN(4, { lru_pass_c<0>(F); }) SEAM(4);
#endif
#endif
    if (IN(5)) {
        { pg8::Gemm g{wsp<bf16_t>(F, NA_BUF), wsp<bf16_t>(F, NA_BUF), 1 << 30, wsp<bf16_t>(F, WS_WNO), L, D, 2 * NAW}; pg8::StaticOrder S; S.init(L, D, F.G, (int)blockIdx.x);
          pg8::EpiMulG<false> E{wsp<bf16_t>(F, WS_T1), (const bf16_t*)F.out, 0};
          pg8::gemm_phase<pg8::EpiMulG<false>, pg8::StaticOrder, true, true>(stage, g, S, E); }
        { pg8::Gemm g{wsp<bf16_t>(F, WS_XR), wsp<bf16_t>(F, WS_XR), 1 << 30, wsp<bf16_t>(F, WS_WLO), L, D, 2 * LW}; pg8::StaticOrder S; S.init(L, D, F.G, (int)blockIdx.x);
          pg8::EpiMulG<true> E{wsp<bf16_t>(F, WS_T1), (const bf16_t*)F.out, D};
          pg8::gemm_phase<pg8::EpiMulG<true>, pg8::StaticOrder, true, true>(stage, g, S, E); }
    } SEAM(5);
    RUN(6, {
        pg8::Gemm g{wsp<bf16_t>(F, WS_T1), wsp<bf16_t>(F, WS_T1), 1 << 30, wsp<bf16_t>(F, WS_WO), L, D, 2 * D}; pg8::StaticOrder S; S.init(L, D, F.G, (int)blockIdx.x);
        pg8::EpiPlain E{wsp<bf16_t>(F, WS_MIX), D};
        pg8::gemm_phase<pg8::EpiPlain, pg8::StaticOrder, true, true>(stage, g, S, E);
    }) SEAM(6);
    RUN(7, { mid_phase(F); }) SEAM(7);
#ifdef GEMM_DBG
    if (IN(8)) {
        pg8::Gemm g{wsp<bf16_t>(F, WS_XN), wsp<bf16_t>(F, WS_XN), 1 << 30, wsp<bf16_t>(F, WS_WGU), L, 2 * DFF, 2 * D}; pg8::StaticOrder S; S.init(L, 2 * DFF, F.G, (int)blockIdx.x);
        pg8::EpiSwiglu E{(bf16_t*)F.out, wsp<bf16_t>(F, WS_HIDS), LP / 256};
        pg8::gemm_phase<pg8::EpiSwiglu, pg8::StaticOrder, true, true, false, GEMM_DBG>(stage, g, S, E);
    }
#endif
    RUN(8, {
        pg8::Gemm g{wsp<bf16_t>(F, WS_XN), wsp<bf16_t>(F, WS_XN), 1 << 30, wsp<bf16_t>(F, WS_WGU), L, 2 * DFF, 2 * D}; pg8::StaticOrder S; S.init(L, 2 * DFF, F.G, (int)blockIdx.x);
        pg8::EpiSwiglu E{(bf16_t*)F.out, wsp<bf16_t>(F, WS_HIDS), LP / 256};
        pg8::gemm_phase<pg8::EpiSwiglu, pg8::StaticOrder, false, true>(stage, g, S, E);
    }) SEAM(8);
    RUN(9, {
        pg8::Gemm g{(const bf16_t*)F.out, wsp<bf16_t>(F, WS_HIDS), LP / 256, wsp<bf16_t>(F, WS_WD), L, D, 2 * DFF}; pg8::StaticOrder S; S.init(L, D, F.G, (int)blockIdx.x);
        pg8::EpiPlain E{wsp<bf16_t>(F, WS_F), D};
        pg8::gemm_phase<pg8::EpiPlain, pg8::StaticOrder, true, true>(stage, g, S, E);
    }) SEAM(9);
    RUN(10, { final_phase(F); })
#undef RUN
#undef IN
#undef SEAM
}

extern "C" void kernel_launch(void* const* d_in, const int* in_sizes, int n_in, void* d_out, int out_size, void* d_ws, size_t ws_size, hipStream_t stream) {
    static int grid = 0;
    if (grid == 0) {
        if (n_in != 23 || in_sizes[0] != LP * D || in_sizes[1] != LS * D || out_size != L * D || ws_size < WS_END) {
            fprintf(stderr, "kernel_launch: unexpected shapes: n_in %d in0 %d out %d ws %zu (need %zu)\n", n_in, n_in > 0 ? in_sizes[0] : -1, out_size, ws_size, (size_t)WS_END); grid = -1; return; }
        int dev = 0, cus = 0, per_cu = 0;
        if (hipGetDevice(&dev) != hipSuccess || hipDeviceGetAttribute(&cus, hipDeviceAttributeMultiprocessorCount, dev) != hipSuccess) { grid = -1; return; }
        if (hipFuncSetAttribute((const void*)fwd_kernel, hipFuncAttributeMaxDynamicSharedMemorySize, LDS_BYTES) != hipSuccess) { fprintf(stderr, "kernel_launch: hipFuncSetAttribute failed\n"); grid = -1; return; }
        if (hipOccupancyMaxActiveBlocksPerMultiprocessor(&per_cu, (const void*)fwd_kernel, NTHR, LDS_BYTES) != hipSuccess || per_cu < 1) { fprintf(stderr, "kernel_launch: occupancy query says %d\n", per_cu); }
        (void)hipGetLastError();
        grid = cus;
    }
    if (grid < 0) return;
    (void)hipMemsetAsync((char*)d_ws + WS_CTL, 0, CTL_ZERO_BYTES, stream);
#ifdef DBG_ZERO_ALL
    (void)hipMemsetAsync((char*)d_ws, 0, WS_END, stream); (void)hipMemsetAsync((char*)d_out, 0, (size_t)L * D * 4, stream);
#endif
    Args a{};
    for (int i = 0; i < 23; ++i) a.in[i] = (const float*)d_in[i];
    a.out = (float*)d_out; a.ws = (unsigned char*)d_ws;
#if MK_N_LAUNCHES == 1
    a.ph_lo = 0; a.ph_hi = NPHASE;
    hipLaunchKernelGGL(fwd_kernel, dim3(grid), dim3(NTHR), LDS_BYTES, stream, a);
#else
    for (int p = 0; p < NPHASE; ++p) {
#ifdef DBG_PH_MASK
        if (!((DBG_PH_MASK >> p) & 1)) continue;
#endif
        a.ph_lo = p; a.ph_hi = p + 1; hipLaunchKernelGGL(fwd_kernel, dim3(grid), dim3(NTHR), LDS_BYTES, stream, a); }
#endif
}
```

```cpp
#include <hip/hip_runtime.h>
#include <cstdio>
#include <cstdint>

#define LAS __attribute__((address_space(3)))
typedef unsigned short bf16_t;
typedef short bf16x8 __attribute__((ext_vector_type(8)));
typedef float f32x4 __attribute__((ext_vector_type(4)));
typedef float f32x2 __attribute__((ext_vector_type(2)));
typedef unsigned u32x4 __attribute__((ext_vector_type(4)));
typedef unsigned u32x2 __attribute__((ext_vector_type(2)));

constexpr int D = 4096, LP = 16384, LS = 8192, L = LP + LS;
constexpr int GRIDW = 64, HD = 128, NH = 16, NAW = 2048, LW = 2048, NBLK = 16, BW = 128, DFF = 11008, INW = 10240;
constexpr float EPS = 1e-6f;
constexpr int NWAVES = 8, NTHR = 512;

constexpr size_t MiB = 1u << 20;
constexpr size_t WS_CTL = 0, CTL_ZERO_BYTES = 64 * 1024;
constexpr size_t WS_RSTD = 1 * MiB;
constexpr size_t WS_RS1 = 1 * MiB + 128 * 1024;
constexpr size_t WS_RS2 = 1 * MiB + 256 * 1024;
constexpr size_t WS_CS = 1 * MiB + 384 * 1024;
constexpr size_t WS_SUM = 2 * MiB;
constexpr size_t WS_WCAT = 8 * MiB;
constexpr size_t WS_W8 = 40 * MiB;
constexpr size_t WS_WVT = 88 * MiB;
constexpr size_t WS_XN8 = 96 * MiB;
constexpr size_t WS_WNO = 192 * MiB;
constexpr size_t WS_WLO = 208 * MiB;
constexpr size_t WS_WO = 224 * MiB;
constexpr size_t WS_WGU = 256 * MiB;
constexpr size_t WS_WD = 342 * MiB;
constexpr size_t WS_WG = 428 * MiB;
constexpr size_t WS_XN = 430 * MiB;
constexpr size_t WS_Q = 622 * MiB;
constexpr size_t WS_XR = 718 * MiB;
constexpr size_t WS_K = 814 * MiB;
constexpr size_t WS_VT = 910 * MiB;
constexpr size_t WS_GR = 1006 * MiB;
constexpr size_t WS_XC = 1102 * MiB;
constexpr size_t WS_END = 1198 * MiB;
constexpr int CS_QKM = 0, CS_V = 12288, CS_GU = 12288 + 2048;
constexpr size_t WS_T1 = WS_K;
constexpr size_t WS_MIX = WS_GR;
constexpr size_t WS_HIDS = WS_Q;
constexpr size_t WS_F = WS_K;
constexpr size_t WS_HF = WS_K;

#define LDS_WAIT() asm volatile("s_waitcnt lgkmcnt(0)" ::: "memory")
#define VM_WAIT() asm volatile("s_waitcnt vmcnt(0)" ::: "memory")
typedef __bf16 bf16x2n_t __attribute__((ext_vector_type(2)));
__device__ __forceinline__ unsigned pk2(float lo, float hi) { const bf16x2n_t r = __builtin_convertvector((f32x2){lo, hi}, bf16x2n_t); return __builtin_bit_cast(unsigned, r); }
__device__ __forceinline__ unsigned f2bf(float f) { return pk2(f, 0.f) & 0xffffu; }
__device__ __forceinline__ float bflo(unsigned u) { return __builtin_bit_cast(float, u << 16); }
__device__ __forceinline__ float bfhi(unsigned u) { return __builtin_bit_cast(float, u & 0xffff0000u); }
__device__ __forceinline__ float bf1(bf16_t u) { return __builtin_bit_cast(float, (unsigned)u << 16); }
__device__ __forceinline__ float wave_sum(float v) {
#pragma unroll
    for (int o = 1; o < 64; o <<= 1) v += __shfl_xor(v, o);
    return v;
}
__device__ __forceinline__ float wave_max(float v) {
#pragma unroll
    for (int o = 1; o < 64; o <<= 1) v = fmaxf(v, __shfl_xor(v, o));
    return v;
}
__device__ __forceinline__ float sigmoidf_(float v) { return __builtin_amdgcn_rcpf(1.0f + __expf(-v)); }
__device__ __forceinline__ float gelu_tanh(float v) { const float y = 0.7978845608f * (v + 0.044715f * v * v * v); const float e = __expf(2.0f * y); return 0.5f * v * (2.0f - 2.0f * __builtin_amdgcn_rcpf(e + 1.0f)); }

namespace pg8 {
constexpr int BM = 256, BK = 64, HALF = 128, HTB = HALF * BK * 2  , STAGE_BYTES = 8 * HTB, NXCD = 8, WGM = 4;

__host__ __device__ __forceinline__ int lds_byte(int r, int c) { return (r >> 3) * 1024 + (r & 7) * 128 + ((((c >> 3) ^ r) & 7) << 4) + (c & 7) * 2; }
__host__ __device__ __forceinline__ void stage_rc(int b, int& R, int& C) { const int ch = b >> 10, rr = (b >> 7) & 7, slot = (b >> 4) & 7; R = ch * 8 + rr; C = ((slot ^ rr) & 7) * 8; }
__host__ __device__ __forceinline__ int perm32(int rho) { const int n = rho >> 4, i = rho & 15; return 8 * (i >> 2) + 4 * n + (i & 3); }

struct Unit { int pm, pn; };
struct Gemm {
    const bf16_t* A; const bf16_t* A2; int pm_split; const bf16_t* Bt; int M, N, rb;
    __device__ __forceinline__ const char* abase(int pm) const { const size_t t = (size_t)BM * rb; return pm < pm_split ? (const char*)A + (size_t)pm * t : (const char*)A2 + (size_t)(pm - pm_split) * t; }
    __device__ __forceinline__ const char* bbase(int pn) const { return (const char*)Bt + (size_t)pn * BM * rb; }
};

struct StaticOrder {
    int nM, nN, nwg, G, c;
    __host__ __device__ void init(int M, int N, int G_, int c_) { nM = M / BM; nN = N / BM; nwg = nM * nN; G = G_; c = c_; }
    __host__ __device__ bool next(int i, Unit& u) const {
        const long Lx = (long)i * G + c; if (Lx >= nwg) return false;
        int wgid = (int)Lx; { const int q = nwg / NXCD, r = nwg % NXCD, xcd = wgid % NXCD, off = wgid / NXCD; wgid = (xcd < r ? xcd * (q + 1) : r * (q + 1) + (xcd - r) * q) + off; }
        const int nig = WGM * nN, gid = wgid / nig, fm = gid * WGM, gsz = (nM - fm) < WGM ? (nM - fm) : WGM;
        u.pm = fm + ((wgid % nig) % gsz); u.pn = (wgid % nig) / gsz; return true;
    }
    __device__ __forceinline__ void a_ready(const Unit&) const {}
    __device__ __forceinline__ void done(const Unit&) const {}
};

typedef int v8i32 __attribute__((ext_vector_type(8)));
typedef int v4i32 __attribute__((ext_vector_type(4)));
typedef __bf16 bf16x2_t __attribute__((ext_vector_type(2)));
__device__ __forceinline__ unsigned cvt_pk_bf16(float lo, float hi) { const bf16x2_t r = __builtin_convertvector((f32x2){lo, hi}, bf16x2_t); return __builtin_bit_cast(unsigned, r); }
__device__ __forceinline__ u32x4 pack8(const f32x4 v0, const f32x4 v1) { u32x4 w; w.x = cvt_pk_bf16(v0[0], v0[1]); w.y = cvt_pk_bf16(v0[2], v0[3]); w.z = cvt_pk_bf16(v1[0], v1[1]); w.w = cvt_pk_bf16(v1[2], v1[3]); return w; }
__device__ __forceinline__ void unpack8(const u32x4 w, f32x4& v0, f32x4& v1) { v0 = (f32x4){bflo(w.x), bfhi(w.x), bflo(w.y), bfhi(w.y)}; v1 = (f32x4){bflo(w.z), bfhi(w.z), bflo(w.w), bfhi(w.w)}; }
__device__ __forceinline__ f32x4 sig4(const f32x4 v) { f32x4 r; r[0] = sigmoidf_(v[0]); r[1] = sigmoidf_(v[1]); r[2] = sigmoidf_(v[2]); r[3] = sigmoidf_(v[3]); return r; }

struct EpiPlain {
    static constexpr bool PERM = true, AFTER_DRAIN = false;
    bf16_t* O; int ldc;
    __device__ __forceinline__ void operator()(const f32x4 (&acc)[2][2][4][2], const Unit& u, int wr, int wc, int fr, int fq) const {
        const int row0 = u.pm * BM + wr * 64 + fr, col0 = u.pn * BM + wc * 32 + 8 * fq;
#pragma unroll
        for (int ai = 0; ai < 2; ++ai)
#pragma unroll
            for (int m = 0; m < 4; ++m) { bf16_t* rowp = O + (size_t)(row0 + ai * HALF + m * 16) * ldc + col0;
#pragma unroll
                for (int bj = 0; bj < 2; ++bj) *(u32x4*)(rowp + bj * HALF) = pack8(acc[ai][bj][m][0], acc[ai][bj][m][1]); }
    }
};
struct EpiVT {
    static constexpr bool PERM = true, AFTER_DRAIN = false;
    bf16_t* O;
    __device__ __forceinline__ void operator()(const f32x4 (&acc)[2][2][4][2], const Unit& u, int wr, int wc, int fr, int fq) const {
        const int row0 = u.pm * BM + wr * 64 + fr, col0 = u.pn * BM + wc * 32 + 8 * fq;
#pragma unroll
        for (int ai = 0; ai < 2; ++ai)
#pragma unroll
            for (int m = 0; m < 4; ++m) { const int row = row0 + ai * HALF + m * 16, hh = row >> 7, d = row & 127;
                const int dt = 2 * (d >> 5) + ((d >> 2) & 1), i = 4 * ((d >> 3) & 3) + (d & 3);
#pragma unroll
                for (int bj = 0; bj < 2; ++bj) { const int tok = col0 + bj * HALF, R = tok >> 6, o = (tok & 63) >> 3;
                    *(u32x4*)(O + ((size_t)((((R * 16 + hh) * 8 + dt) * 8 + o) * 16 + i)) * 8) = pack8(acc[ai][bj][m][0], acc[ai][bj][m][1]); } }
    }
};
struct EpiProj {
    static constexpr bool PERM = true, AFTER_DRAIN = false;
    bf16_t* P0; bf16_t* P1; bf16_t* P2; bf16_t* P3; bf16_t* G; const float* bias; int pn_gate0;
    __device__ __forceinline__ void operator()(const f32x4 (&acc)[2][2][4][2], const Unit& u, int wr, int wc, int fr, int fq) const {
        const int row0 = u.pm * BM + wr * 64 + fr;
        if (u.pn < pn_gate0) {
            const int t = u.pn >> 3; bf16_t* base = t == 0 ? P0 : (t == 1 ? P1 : (t == 2 ? P2 : P3));
            const int col0 = (u.pn & 7) * BM + wc * 32 + 8 * fq;
            if (t == 2) {
#pragma unroll
                for (int ai = 0; ai < 2; ++ai)
#pragma unroll
                    for (int m = 0; m < 4; ++m) { const int tok = row0 + ai * HALF + m * 16, R = tok >> 6, cl = tok & 63;
                        const int tokpart = (((cl >> 2) & 1) * 8 + (cl >> 3)) * 4 + (cl & 3);
#pragma unroll
                        for (int bj = 0; bj < 2; ++bj) { const int c = col0 + bj * HALF, hh = c >> 7, d0 = c & 127;
                            *(u32x4*)(base + ((size_t)(((R * 16 + hh) * 4 + (d0 >> 5)) * 64 + tokpart) * 4 + ((d0 >> 3) & 3)) * 8) = pack8(acc[ai][bj][m][0], acc[ai][bj][m][1]); } }
            } else {
#pragma unroll
            for (int ai = 0; ai < 2; ++ai)
#pragma unroll
                for (int m = 0; m < 4; ++m) { bf16_t* rowp = base + (size_t)(row0 + ai * HALF + m * 16) * NAW + col0;
#pragma unroll
                    for (int bj = 0; bj < 2; ++bj) *(u32x4*)(rowp + bj * HALF) = pack8(acc[ai][bj][m][0], acc[ai][bj][m][1]); }
            }
        } else {
            const int col0 = (u.pn - pn_gate0) * BM + wc * 32 + 8 * fq;
            f32x4 bv[2][2];
#pragma unroll
            for (int bj = 0; bj < 2; ++bj)
#pragma unroll
                for (int n = 0; n < 2; ++n) bv[bj][n] = *(const f32x4*)(bias + col0 + bj * HALF + 4 * n);
#pragma unroll
            for (int ai = 0; ai < 2; ++ai)
#pragma unroll
                for (int m = 0; m < 4; ++m) { bf16_t* rowp = G + (size_t)(row0 + ai * HALF + m * 16) * (2 * D) + col0;
#pragma unroll
                    for (int bj = 0; bj < 2; ++bj) *(u32x4*)(rowp + bj * HALF) = pack8(sig4(acc[ai][bj][m][0] + bv[bj][0]), sig4(acc[ai][bj][m][1] + bv[bj][1])); }
        }
    }
};
template <bool ADD> struct EpiMulG {
    static constexpr bool PERM = true, AFTER_DRAIN = false;
    bf16_t* O; const bf16_t* G; int goff;
    __device__ __forceinline__ void operator()(const f32x4 (&acc)[2][2][4][2], const Unit& u, int wr, int wc, int fr, int fq) const {
        const int row0 = u.pm * BM + wr * 64 + fr, col0 = u.pn * BM + wc * 32 + 8 * fq;
#pragma unroll
        for (int ai = 0; ai < 2; ++ai)
#pragma unroll
            for (int m = 0; m < 4; ++m) { const size_t row = (size_t)(row0 + ai * HALF + m * 16); bf16_t* rowp = O + row * D + col0; const bf16_t* gp = G + row * (2 * D) + goff + col0;
#pragma unroll
                for (int bj = 0; bj < 2; ++bj) {
                    f32x4 g0, g1; unpack8(*(const u32x4*)(gp + bj * HALF), g0, g1);
                    f32x4 v0 = acc[ai][bj][m][0] * g0, v1 = acc[ai][bj][m][1] * g1;
                    if (ADD) { f32x4 t0, t1; unpack8(*(const u32x4*)(rowp + bj * HALF), t0, t1); v0 += t0; v1 += t1; }
                    *(u32x4*)(rowp + bj * HALF) = pack8(v0, v1); } }
    }
};
struct EpiSwiglu {
    static constexpr bool PERM = true, AFTER_DRAIN = false;
    bf16_t* H0; bf16_t* H1; int pm_split;
    __device__ __forceinline__ void operator()(const f32x4 (&acc)[2][2][4][2], const Unit& u, int wr, int wc, int fr, int fq) const {
        bf16_t* base = u.pm < pm_split ? H0 + (size_t)u.pm * BM * DFF : H1 + (size_t)(u.pm - pm_split) * BM * DFF;
        const int row0 = wr * 64 + fr, col0 = u.pn * HALF + wc * 32 + 8 * fq;
#pragma unroll
        for (int ai = 0; ai < 2; ++ai)
#pragma unroll
            for (int m = 0; m < 4; ++m) {
                f32x4 h[2];
#pragma unroll
                for (int n = 0; n < 2; ++n) { const f32x4 g = acc[ai][0][m][n], up = acc[ai][1][m][n];
#pragma unroll
                    for (int j = 0; j < 4; ++j) h[n][j] = g[j] * sigmoidf_(g[j]) * up[j]; }
                *(u32x4*)(base + (size_t)(row0 + ai * HALF + m * 16) * DFF + col0) = pack8(h[0], h[1]); }
    }
};

__device__ __forceinline__ f32x4 deq4(const f32x4 accbits, const float sa, const f32x4 sb) { const v4i32 q = __builtin_bit_cast(v4i32, accbits); return (f32x4){(float)q.x, (float)q.y, (float)q.z, (float)q.w} * sa * sb; }
struct EpiProjQ {
    static constexpr bool PERM = true, AFTER_DRAIN = false;
    bf16_t* Qb; bf16_t* Kb; bf16_t* G; const float* bias; const float* sa; const float* sb;
    __device__ __forceinline__ void operator()(const f32x4 (&acc)[2][2][4][2], const Unit& u, int wr, int wc, int fr, int fq) const {
        const int row0 = u.pm * BM + wr * 64 + fr, cg0 = u.pn * BM + wc * 32 + 8 * fq;
        f32x4 sbv[2][2];
#pragma unroll
        for (int bj = 0; bj < 2; ++bj)
#pragma unroll
            for (int n = 0; n < 2; ++n) sbv[bj][n] = *(const f32x4*)(sb + cg0 + bj * HALF + 4 * n);
        if (u.pn < 8) {
            const int col0 = u.pn * BM + wc * 32 + 8 * fq;
#pragma unroll
            for (int ai = 0; ai < 2; ++ai)
#pragma unroll
                for (int m = 0; m < 4; ++m) { const int row = row0 + ai * HALF + m * 16; const float sr = sa[row]; bf16_t* rowp = Qb + (size_t)row * NAW + col0;
#pragma unroll
                    for (int bj = 0; bj < 2; ++bj) *(u32x4*)(rowp + bj * HALF) = pack8(deq4(acc[ai][bj][m][0], sr, sbv[bj][0]), deq4(acc[ai][bj][m][1], sr, sbv[bj][1])); }
        } else if (u.pn < 16) {
            const int col0 = (u.pn - 8) * BM + wc * 32 + 8 * fq;
#pragma unroll
            for (int ai = 0; ai < 2; ++ai)
#pragma unroll
                for (int m = 0; m < 4; ++m) { const int tok = row0 + ai * HALF + m * 16, R = tok >> 6, cl = tok & 63; const float sr = sa[tok];
                    const int tokpart = (((cl >> 2) & 1) * 8 + (cl >> 3)) * 4 + (cl & 3);
#pragma unroll
                    for (int bj = 0; bj < 2; ++bj) { const int c = col0 + bj * HALF, hh = c >> 7, d0 = c & 127;
                        *(u32x4*)(Kb + ((size_t)(((R * 16 + hh) * 4 + (d0 >> 5)) * 64 + tokpart) * 4 + ((d0 >> 3) & 3)) * 8) = pack8(deq4(acc[ai][bj][m][0], sr, sbv[bj][0]), deq4(acc[ai][bj][m][1], sr, sbv[bj][1])); } }
        } else {
            const int col0 = (u.pn - 16) * BM + wc * 32 + 8 * fq;
            f32x4 bv[2][2];
#pragma unroll
            for (int bj = 0; bj < 2; ++bj)
#pragma unroll
                for (int n = 0; n < 2; ++n) bv[bj][n] = *(const f32x4*)(bias + col0 + bj * HALF + 4 * n);
#pragma unroll
            for (int ai = 0; ai < 2; ++ai)
#pragma unroll
                for (int m = 0; m < 4; ++m) { const int row = row0 + ai * HALF + m * 16; const float sr = sa[row]; bf16_t* rowp = G + (size_t)row * (2 * D) + col0;
#pragma unroll
                    for (int bj = 0; bj < 2; ++bj) *(u32x4*)(rowp + bj * HALF) = pack8(sig4(deq4(acc[ai][bj][m][0], sr, sbv[bj][0]) + bv[bj][0]), sig4(deq4(acc[ai][bj][m][1], sr, sbv[bj][1]) + bv[bj][1])); }
        }
    }
};
struct EpiVTQ {
    static constexpr bool PERM = true, AFTER_DRAIN = false;
    bf16_t* O; const float* sa; const float* sb;
    __device__ __forceinline__ void operator()(const f32x4 (&acc)[2][2][4][2], const Unit& u, int wr, int wc, int fr, int fq) const {
        const int row0 = u.pm * BM + wr * 64 + fr, col0 = u.pn * BM + wc * 32 + 8 * fq;
        f32x4 sbv[2][2];
#pragma unroll
        for (int bj = 0; bj < 2; ++bj)
#pragma unroll
            for (int n = 0; n < 2; ++n) sbv[bj][n] = *(const f32x4*)(sb + col0 + bj * HALF + 4 * n);
#pragma unroll
        for (int ai = 0; ai < 2; ++ai)
#pragma unroll
            for (int m = 0; m < 4; ++m) { const int row = row0 + ai * HALF + m * 16, hh = row >> 7, d = row & 127; const float sr = sa[row];
                const int dt = 2 * (d >> 5) + ((d >> 2) & 1), i = 4 * ((d >> 3) & 3) + (d & 3);
#pragma unroll
                for (int bj = 0; bj < 2; ++bj) { const int tok = col0 + bj * HALF, R = tok >> 6, o = (tok & 63) >> 3;
                    *(u32x4*)(O + ((size_t)((((R * 16 + hh) * 8 + dt) * 8 + o) * 16 + i)) * 8) = pack8(deq4(acc[ai][bj][m][0], sr, sbv[bj][0]), deq4(acc[ai][bj][m][1], sr, sbv[bj][1])); } }
    }
};
struct EpiSwigluQ {
    static constexpr bool PERM = true, AFTER_DRAIN = false;
    bf16_t* H0; bf16_t* H1; int pm_split; const float* sa; const float* sb;
    __device__ __forceinline__ void operator()(const f32x4 (&acc)[2][2][4][2], const Unit& u, int wr, int wc, int fr, int fq) const {
        bf16_t* base = u.pm < pm_split ? H0 + (size_t)u.pm * BM * DFF : H1 + (size_t)(u.pm - pm_split) * BM * DFF;
        const int row0 = wr * 64 + fr, col0 = u.pn * HALF + wc * 32 + 8 * fq, cg0 = u.pn * BM + wc * 32 + 8 * fq;
        f32x4 sbv[2][2];
#pragma unroll
        for (int bj = 0; bj < 2; ++bj)
#pragma unroll
            for (int n = 0; n < 2; ++n) sbv[bj][n] = *(const f32x4*)(sb + cg0 + bj * HALF + 4 * n);
#pragma unroll
        for (int ai = 0; ai < 2; ++ai)
#pragma unroll
            for (int m = 0; m < 4; ++m) { const float sr = sa[u.pm * BM + row0 + ai * HALF + m * 16];
                f32x4 h[2];
#pragma unroll
                for (int n = 0; n < 2; ++n) { const f32x4 g = deq4(acc[ai][0][m][n], sr, sbv[0][n]), up = deq4(acc[ai][1][m][n], sr, sbv[1][n]);
#pragma unroll
                    for (int j = 0; j < 4; ++j) h[n][j] = g[j] * sigmoidf_(g[j]) * up[j]; }
                *(u32x4*)(base + (size_t)(row0 + ai * HALF + m * 16) * DFF + col0) = pack8(h[0], h[1]); }
    }
};

__device__ __forceinline__ v8i32 cat8(const bf16x8 lo, const bf16x8 hi) { return __builtin_shufflevector(__builtin_bit_cast(v4i32, lo), __builtin_bit_cast(v4i32, hi), 0, 1, 2, 3, 4, 5, 6, 7); }
__device__ __forceinline__ void mfma_fp8_acc(f32x4& c, const v8i32 a, const v8i32 b, int sa, int sb) {
    asm volatile("v_mfma_scale_f32_16x16x128_f8f6f4 %0, %1, %2, %0, %3, %4 op_sel_hi:[0,0,0]" : "+v"(c) : "v"(a), "v"(b), "v"(sa), "v"(sb)); }
constexpr int FP8_SCALE = 0x73737373;
template <class Epi, class Sched, bool ALIGN_EPI = false, bool SP2 = false, int QM = 0  , int DBG = 0>
__device__ __forceinline__ void gemm_phase(LAS unsigned char* lds, const Gemm g, const Sched& S, const Epi& E) {
    int tid = threadIdx.x; asm volatile("" : "+v"(tid));
    const int wid = __builtin_amdgcn_readfirstlane(tid >> 6), lane = tid & 63, wr = wid >> 2, wc = wid & 3, fr = lane & 15, fq = lane >> 4;
    const int RB = g.rb, nt = RB / (BK * 2);
    unsigned voffA[2], voffB[2];
#pragma unroll
    for (int i = 0; i < 2; ++i) { int R, C; stage_rc(tid * 16 + i * 8192, R, C); const int Rb = Epi::PERM ? ((R & ~31) + perm32(R & 31)) : R;
        voffA[i] = (unsigned)(R * RB + C * 2); voffB[i] = (unsigned)(Rb * RB + C * 2); }
    const size_t kstep = (size_t)(BK * 2);
    const size_t hstep = (size_t)HALF * RB;
    const unsigned ldsw = (unsigned)wid * 1024u;
    const int aoff0 = lds_byte(wr * 64 + fr, fq * 8), aoff1 = lds_byte(wr * 64 + fr, 32 + fq * 8), boff0 = lds_byte(wc * 32 + fr, fq * 8), boff1 = lds_byte(wc * 32 + fr, 32 + fq * 8);
#define PG8_SA(b, h) (((b) * 2 + (h)) * HTB)
#define PG8_SB(b, h) ((4 + (b) * 2 + (h)) * HTB)
#define PG8_STAGE(bufoff, gbase, voff) do { if constexpr (DBG != 3) _Pragma("unroll") for (int _i = 0; _i < 2; ++_i) \
        __builtin_amdgcn_global_load_lds((const unsigned*)((const char*)(gbase) + (voff)[_i]), (LAS unsigned*)(lds + (bufoff) + ldsw + _i * 8192), 16, 0, 0); } while (0)
#define PG8_LDA(dst, b, h) do { if constexpr (DBG != 2) _Pragma("unroll") for (int m = 0; m < 4; ++m) _Pragma("unroll") for (int k = 0; k < 2; ++k) dst[m][k] = *(const LAS bf16x8*)(lds + PG8_SA(b, h) + (k ? aoff1 : aoff0) + m * 2048); } while (0)
#define PG8_LDB(dst, b, h) do { if constexpr (DBG != 2) _Pragma("unroll") for (int n = 0; n < 2; ++n) _Pragma("unroll") for (int k = 0; k < 2; ++k) dst[n][k] = *(const LAS bf16x8*)(lds + PG8_SB(b, h) + (k ? boff1 : boff0) + n * 2048); } while (0)
#define PG8_MMA(ai, bj, At, Bt) do { __builtin_amdgcn_s_setprio(1); if constexpr (DBG == 1) { } else if constexpr (QM == 2) { _Pragma("unroll") for (int m = 0; m < 4; ++m) _Pragma("unroll") for (int n = 0; n < 2; ++n) _Pragma("unroll") for (int k = 0; k < 2; ++k) \
        acc[ai][bj][m][n] = __builtin_bit_cast(f32x4, __builtin_amdgcn_mfma_i32_16x16x64_i8(__builtin_bit_cast(v4i32, Bt[n][k]), __builtin_bit_cast(v4i32, At[m][k]), __builtin_bit_cast(v4i32, acc[ai][bj][m][n]), 0, 0, 0)); } else if constexpr (QM == 1) { _Pragma("unroll") for (int m = 0; m < 4; ++m) _Pragma("unroll") for (int n = 0; n < 2; ++n) \
        mfma_fp8_acc(acc[ai][bj][m][n], cat8(Bt[n][0], Bt[n][1]), cat8(At[m][0], At[m][1]), fp8_sa, fp8_sb); } else { \
        _Pragma("unroll") for (int m = 0; m < 4; ++m) _Pragma("unroll") for (int n = 0; n < 2; ++n) _Pragma("unroll") for (int k = 0; k < 2; ++k) \
        acc[ai][bj][m][n] = __builtin_amdgcn_mfma_f32_16x16x32_bf16(Bt[n][k], At[m][k], acc[ai][bj][m][n], 0, 0, 0); } __builtin_amdgcn_s_setprio(0); } while (0)
#define PG8_WAIT_V(n) asm volatile("s_waitcnt vmcnt(" #n ")" ::: "memory")
#define PG8_WAIT_L(n) asm volatile("s_waitcnt lgkmcnt(" #n ")" ::: "memory")
#define PG8_BAR __builtin_amdgcn_s_barrier()
#define PG8_SCHED __builtin_amdgcn_sched_barrier(0)
    Unit cur, nxt; int ui = 0;
    const int fp8_sa = FP8_SCALE, fp8_sb = 0x7F7F7F7F;
    if (!S.next(0, cur)) return;
    f32x4 acc[2][2][4][2];
#pragma unroll
    for (int a = 0; a < 2; ++a)
#pragma unroll
        for (int b = 0; b < 2; ++b)
#pragma unroll
            for (int m = 0; m < 4; ++m)
#pragma unroll
                for (int n = 0; n < 2; ++n) acc[a][b][m][n] = (f32x4){0.f, 0.f, 0.f, 0.f};
    bf16x8 At[4][2], B0[2][2], B1[2][2];
    const char* cA = g.abase(cur.pm); const char* cB = g.bbase(cur.pn);
    S.a_ready(cur);
    if constexpr (SP2) {
        PG8_STAGE(PG8_SB(0, 0), cB, voffB); PG8_STAGE(PG8_SB(0, 1), cB + hstep, voffB); PG8_STAGE(PG8_SA(0, 0), cA, voffA); PG8_STAGE(PG8_SA(0, 1), cA + hstep, voffA);
        if (wr == 1) PG8_BAR;
        PG8_WAIT_V(2); PG8_BAR;
        PG8_STAGE(PG8_SB(1, 0), cB + kstep, voffB); PG8_STAGE(PG8_SA(1, 0), cA + kstep, voffA); PG8_STAGE(PG8_SB(1, 1), cB + hstep + kstep, voffB);
        PG8_WAIT_V(6); PG8_BAR;
    } else {
        PG8_STAGE(PG8_SB(0, 0), cB, voffB); PG8_STAGE(PG8_SA(0, 0), cA, voffA); PG8_STAGE(PG8_SB(0, 1), cB + hstep, voffB); PG8_STAGE(PG8_SA(0, 1), cA + hstep, voffA);
        if (wr == 1) PG8_BAR;
        PG8_WAIT_V(4); PG8_BAR;
        PG8_STAGE(PG8_SB(1, 0), cB + kstep, voffB); PG8_STAGE(PG8_SA(1, 0), cA + kstep, voffA); PG8_STAGE(PG8_SB(1, 1), cB + hstep + kstep, voffB);
        PG8_WAIT_V(6); PG8_BAR;
    }
    for (;;) {
        const bool has_next = S.next(ui + 1, nxt);
        const char* nA = has_next ? g.abase(nxt.pm) : cA; const char* nB = has_next ? g.bbase(nxt.pn) : cB;
        for (int t = 0; t < nt; t += 2) {
            const bool last = (t == nt - 2);
            const char* a1 = cA + (size_t)(t + 1) * kstep;
            const char* a2 = last ? nA : cA + (size_t)(t + 2) * kstep; const char* b2 = last ? nB : cB + (size_t)(t + 2) * kstep;
            const char* a3 = a2 + kstep; const char* b3 = b2 + kstep;
            if (last && has_next) S.a_ready(nxt);
            if constexpr (SP2) {
            PG8_LDB(B0, 0, 0); PG8_LDB(B1, 0, 1); PG8_SCHED; PG8_LDA(At, 0, 0); PG8_STAGE(PG8_SA(1, 1), a1 + hstep, voffA);
            PG8_WAIT_V(8); PG8_WAIT_L(0); PG8_BAR; PG8_MMA(0, 0, At, B0); PG8_MMA(0, 1, At, B1); PG8_BAR; PG8_SCHED;
            PG8_LDA(At, 0, 1); PG8_STAGE(PG8_SB(0, 0), b2, voffB); PG8_STAGE(PG8_SB(0, 1), b2 + hstep, voffB); PG8_STAGE(PG8_SA(0, 0), a2, voffA);
            PG8_WAIT_V(8); PG8_WAIT_L(0); PG8_BAR; PG8_MMA(1, 0, At, B0); PG8_MMA(1, 1, At, B1); PG8_BAR; PG8_SCHED;
            PG8_LDB(B0, 1, 0); PG8_LDB(B1, 1, 1); PG8_SCHED; PG8_LDA(At, 1, 0); PG8_STAGE(PG8_SA(0, 1), a2 + hstep, voffA);
            PG8_WAIT_V(8); PG8_WAIT_L(0); PG8_BAR; PG8_MMA(0, 0, At, B0); PG8_MMA(0, 1, At, B1); PG8_BAR; PG8_SCHED;
            PG8_LDA(At, 1, 1); PG8_STAGE(PG8_SB(1, 0), b3, voffB); PG8_STAGE(PG8_SB(1, 1), b3 + hstep, voffB); PG8_STAGE(PG8_SA(1, 0), a3, voffA);
            PG8_WAIT_V(8); PG8_WAIT_L(0); PG8_BAR; PG8_MMA(1, 0, At, B0); PG8_MMA(1, 1, At, B1); PG8_BAR; PG8_SCHED;
            } else {
            PG8_LDB(B0, 0, 0); PG8_SCHED; PG8_LDA(At, 0, 0); PG8_STAGE(PG8_SA(1, 1), a1 + hstep, voffA);
            PG8_WAIT_L(8); PG8_BAR; PG8_WAIT_L(0); PG8_MMA(0, 0, At, B0); PG8_BAR; PG8_SCHED;
            PG8_LDB(B1, 0, 1); PG8_STAGE(PG8_SB(0, 0), b2, voffB);
            PG8_BAR; PG8_WAIT_L(0); PG8_MMA(0, 1, At, B1); PG8_BAR;
            PG8_LDA(At, 0, 1); PG8_STAGE(PG8_SA(0, 0), a2, voffA);
            PG8_BAR; PG8_WAIT_L(0); PG8_MMA(1, 0, At, B0); PG8_BAR; PG8_SCHED;
            PG8_STAGE(PG8_SB(0, 1), b2 + hstep, voffB);
            PG8_WAIT_V(6); PG8_BAR; PG8_MMA(1, 1, At, B1); PG8_BAR;
            PG8_LDB(B0, 1, 0); PG8_SCHED; PG8_LDA(At, 1, 0); PG8_STAGE(PG8_SA(0, 1), a2 + hstep, voffA);
            PG8_WAIT_L(8); PG8_BAR; PG8_WAIT_L(0); PG8_MMA(0, 0, At, B0); PG8_BAR; PG8_SCHED;
            PG8_LDB(B1, 1, 1); PG8_STAGE(PG8_SB(1, 0), b3, voffB);
            PG8_BAR; PG8_WAIT_L(0); PG8_MMA(0, 1, At, B1); PG8_BAR;
            PG8_LDA(At, 1, 1); PG8_STAGE(PG8_SA(1, 0), a3, voffA);
            PG8_BAR; PG8_WAIT_L(0); PG8_MMA(1, 0, At, B0); PG8_BAR; PG8_SCHED;
            PG8_STAGE(PG8_SB(1, 1), b3 + hstep, voffB);
            PG8_WAIT_V(6); PG8_BAR; PG8_MMA(1, 1, At, B1); PG8_BAR;
            }
        }
        if constexpr (ALIGN_EPI) { if (wr == 0) PG8_BAR; }
        if constexpr (!Epi::AFTER_DRAIN) { if constexpr (DBG != 4) E(acc, cur, wr, wc, fr, fq); else { _Pragma("unroll") for (int a_ = 0; a_ < 2; ++a_) _Pragma("unroll") for (int b_ = 0; b_ < 2; ++b_) _Pragma("unroll") for (int m_ = 0; m_ < 4; ++m_) _Pragma("unroll") for (int n_ = 0; n_ < 2; ++n_) asm volatile("" :: "v"(acc[a_][b_][m_][n_])); } S.done(cur); }
        if (!has_next) break;
#pragma unroll
        for (int a = 0; a < 2; ++a)
#pragma unroll
            for (int b = 0; b < 2; ++b)
#pragma unroll
                for (int m = 0; m < 4; ++m)
#pragma unroll
                    for (int n = 0; n < 2; ++n) acc[a][b][m][n] = (f32x4){0.f, 0.f, 0.f, 0.f};
        cur = nxt; cA = nA; cB = nB; ++ui;
        if constexpr (ALIGN_EPI) { if (wr == 1) PG8_BAR; }
    }
    PG8_WAIT_V(0);
    if constexpr (!ALIGN_EPI) { if (wr == 0) PG8_BAR; }
    PG8_BAR;
    if constexpr (Epi::AFTER_DRAIN) { E.fused(acc, cur, wr, wc, fr, fq, lds, wid, lane); S.done(cur); }
#undef PG8_SA
#undef PG8_SB
#undef PG8_STAGE
#undef PG8_LDA
#undef PG8_LDB
#undef PG8_MMA
#undef PG8_WAIT_V
#undef PG8_WAIT_L
#undef PG8_BAR
#undef PG8_SCHED
}
}
#define XB_TMO      128
#define XB_XCNT(j)  (256  + 64 * (j))
#define XB_XSUB(j)  (1280 + 64 * (j))
#define XB_XGEN(j)  (2304 + 64 * (j))
#define XB_TOP      3328
#define XB_TOPGEN   3392
#define XCD_BAR_WORDS 3456
#define XB_SPIN_CAP (1u << 18)

__device__ __forceinline__ unsigned xb_ld(unsigned* p)              { return __hip_atomic_load(p, __ATOMIC_RELAXED, __HIP_MEMORY_SCOPE_AGENT); }
__device__ __forceinline__ unsigned xb_add(unsigned* p, unsigned v) { return __hip_atomic_fetch_add(p, v, __ATOMIC_RELAXED, __HIP_MEMORY_SCOPE_AGENT); }
__device__ __forceinline__ unsigned xb_xcc_id() { return (unsigned)__builtin_amdgcn_s_getreg((3 << 11) | 20) & 0xFu; }
#define XB_SPIN(cond, bar) do { unsigned _sp = 0; while (cond) { __builtin_amdgcn_s_sleep(1); \
    if ((++_sp & 255u) == 0u) { if (xb_ld(&(bar)[XB_TMO])) break; if (_sp > XB_SPIN_CAP) { atomicAdd(&(bar)[XB_TMO], 1u); break; } } } } while (0)

struct XcdBarrier {
    unsigned* bar; unsigned x;
    volatile LAS unsigned* st;
};

__device__ __forceinline__ XcdBarrier xcd_barrier_post(unsigned* bar, volatile LAS unsigned* st) {
    XcdBarrier b; b.bar = bar; b.x = xb_xcc_id(); b.st = st;
    if (threadIdx.x == 0) (void)xb_add(&bar[XB_XCNT(b.x)], 1u);
    return b;
}
__device__ __forceinline__ void xcd_barrier_complete(unsigned* bar, unsigned x, unsigned& nloc, unsigned& nx) {
    const unsigned G = gridDim.x * gridDim.y * gridDim.z;
    unsigned sum, cnt, mine, sp = 0u;
    for (;;) {
        sum = 0u; cnt = 0u; mine = 0u;
#pragma unroll
        for (unsigned j = 0; j < 16; ++j) { const unsigned c = xb_ld(&bar[XB_XCNT(j)]); sum += c; cnt += (c > 0u) ? 1u : 0u; mine = (j == x) ? c : mine; }
        if (sum == G) break;
        __builtin_amdgcn_s_sleep(1);
        if ((++sp & 255u) == 0u) { if (xb_ld(&bar[XB_TMO])) break; if (sp > XB_SPIN_CAP) { atomicAdd(&bar[XB_TMO], 1u); break; } }
    }
    nloc = mine > 0u ? mine : 1u; nx = cnt > 0u ? cnt : 1u;
}

__device__ __forceinline__ void xcd_barrier(const XcdBarrier& b) {
    asm volatile("s_waitcnt vmcnt(0)" ::: "memory");
    __syncthreads();
    if (threadIdx.x == 0) {
        unsigned* bar = b.bar;
        __builtin_amdgcn_s_waitcnt(0);
        unsigned nloc = b.st[0], nx = b.st[1];
        if (nloc == 0u) { xcd_barrier_complete(bar, b.x, nloc, nx); b.st[0] = nloc; b.st[1] = nx; }
        const unsigned old = xb_add(&bar[XB_XSUB(b.x)], 1u);
        const unsigned gen = old / nloc;
        if (old + 1u == (gen + 1u) * nloc) {
            __builtin_amdgcn_fence(__ATOMIC_RELEASE, "agent");
            asm volatile("s_waitcnt vmcnt(0)" ::: "memory");
            const unsigned og = xb_add(&bar[XB_TOP], 1u);
            const unsigned tg = og / nx;
            if (og + 1u == (tg + 1u) * nx) xb_add(&bar[XB_TOPGEN], 1u);
            else XB_SPIN(xb_ld(&bar[XB_TOPGEN]) == tg, bar);
            __builtin_amdgcn_fence(__ATOMIC_ACQUIRE, "agent");
            xb_add(&bar[XB_XGEN(b.x)], 1u);
            asm volatile("s_waitcnt vmcnt(0)" ::: "memory");
        } else {
            XB_SPIN(xb_ld(&bar[XB_XGEN(b.x)]) == gen, bar);
            __builtin_amdgcn_fence(__ATOMIC_ACQUIRE, "agent");
            asm volatile("s_waitcnt vmcnt(0)" ::: "memory");
        }
    }
    __syncthreads();
}


struct Frame {
    LAS unsigned char* lds;
    int tid, lane, wave, G, gw, ngw;
    const float *in_XP, *in_XS, *in_WIN, *in_WCONV, *in_BCONV, *in_WR, *in_BR, *in_WI, *in_BI, *in_LAM, *in_RPB, *in_WNO, *in_WLO, *in_WM, *in_BM, *in_WOUT, *in_GMPRE, *in_GMPOST, *in_GFPRE, *in_GFPOST, *in_WFG, *in_WFU, *in_WFD; float* out; unsigned char* ws;
};
enum { I_XP = 0, I_XS, I_WIN, I_WCONV, I_BCONV, I_WR, I_BR, I_WI, I_BI, I_LAM, I_RPB, I_WNO, I_WLO, I_WM, I_BM, I_WOUT, I_GMPRE, I_GMPOST, I_GFPRE, I_GFPOST, I_WFG, I_WFU, I_WFD };
__device__ __forceinline__ int opaque(int x) { asm volatile("" : "+v"(x)); return x; }
template <class T> __device__ __forceinline__ T* wsp(const Frame& F, size_t off) { return (T*)(F.ws + off); }
__device__ __forceinline__ const float* xrow(const Frame& F, int m) { return m < LP ? F.in_XP + (size_t)m * D : F.in_XS + (size_t)(m - LP) * D; }

__device__ __forceinline__ void tr_item(const float* src, int ldsrc, int k0, int n0, bf16_t* dst, int ldd, int drow0, LAS float* scr, int lane) {
#pragma unroll 8
    for (int i = 0; i < 32; ++i) { const int kk = 2 * i + (lane >> 5); scr[kk * 33 + (lane & 31)] = src[(size_t)(k0 + kk) * ldsrc + n0 + (lane & 31)]; }
    LDS_WAIT(); asm volatile("" ::: "memory");
    const int c = lane & 7;
#pragma unroll
    for (int j = 0; j < 4; ++j) { const int n = (lane >> 3) + 8 * j; const LAS float* s = scr + (8 * c) * 33 + n;
        u32x4 o; o.x = pk2(s[0 * 33], s[1 * 33]); o.y = pk2(s[2 * 33], s[3 * 33]); o.z = pk2(s[4 * 33], s[5 * 33]); o.w = pk2(s[6 * 33], s[7 * 33]);
        *(u32x4*)(dst + (size_t)(drow0 + n) * ldd + k0 + 8 * c) = o; }
    LDS_WAIT(); asm volatile("" ::: "memory");
}
__device__ __forceinline__ unsigned pk4_fp8(float a, float b, float c, float d) { int p = __builtin_amdgcn_cvt_pk_fp8_f32(a, b, 0, false); p = __builtin_amdgcn_cvt_pk_fp8_f32(c, d, p, true); return (unsigned)p; }
__device__ __forceinline__ void tr_item8(const float* src, int ldsrc, int k0, int n0, unsigned char* dst, int ldd, int drow0, LAS float* scr, int lane) {
#pragma unroll 8
    for (int i = 0; i < 32; ++i) { const int kk = 2 * i + (lane >> 5); scr[kk * 33 + (lane & 31)] = src[(size_t)(k0 + kk) * ldsrc + n0 + (lane & 31)]; }
    LDS_WAIT(); asm volatile("" ::: "memory");
    const int c = lane & 7;
#pragma unroll
    for (int j = 0; j < 4; ++j) { const int n = (lane >> 3) + 8 * j; const LAS float* s = scr + (8 * c) * 33 + n;
        u32x2 o; o.x = pk4_fp8(s[0 * 33] * 256.f, s[1 * 33] * 256.f, s[2 * 33] * 256.f, s[3 * 33] * 256.f); o.y = pk4_fp8(s[4 * 33] * 256.f, s[5 * 33] * 256.f, s[6 * 33] * 256.f, s[7 * 33] * 256.f);
        *(u32x2*)(dst + (size_t)(drow0 + n) * ldd + k0 + 8 * c) = o; }
    LDS_WAIT(); asm volatile("" ::: "memory");
}
__device__ __forceinline__ unsigned pk4_i8(float a, float b, float c, float d) { return ((unsigned)(int)a & 255u) | (((unsigned)(int)b & 255u) << 8) | (((unsigned)(int)c & 255u) << 16) | ((unsigned)(int)d << 24); }
__device__ __forceinline__ void tr_strip_i8(const float* src, int ldsrc, int K, int n0, signed char* dst, int drow0, float* cs, LAS float* scr, int lane) {
    const float* sp = src + n0 + (lane & 31) + (size_t)(lane >> 5) * ldsrc;
    float mx = 0.f;
    { const float* p = sp; const size_t step = (size_t)2 * ldsrc;
      for (int k0 = 0; k0 < K; k0 += 16) {
#pragma unroll
        for (int i = 0; i < 8; ++i) { mx = fmaxf(mx, fabsf(*p)); p += step; }
      } }
    mx = fmaxf(mx, __shfl_xor(mx, 32));
    const float amax = fmaxf(mx, 1e-20f), inv = 127.0f / amax;
    if (lane < 32) cs[drow0 + lane] = amax * (1.0f / 127.0f);
    const int c = lane & 7;
    for (int k0 = 0; k0 < K; k0 += 64) {
        { const float* p = sp + (size_t)k0 * ldsrc; const size_t step = (size_t)2 * ldsrc; LAS float* w = scr + (lane >> 5) * 33 + (lane & 31);
#pragma unroll 8
          for (int i = 0; i < 32; ++i) { w[i * 66] = rintf(*p * inv); p += step; } }
        LDS_WAIT(); asm volatile("" ::: "memory");
#pragma unroll
        for (int j = 0; j < 4; ++j) { const int n = (lane >> 3) + 8 * j; const LAS float* t = scr + (8 * c) * 33 + n;
            u32x2 o; o.x = pk4_i8(t[0 * 33], t[1 * 33], t[2 * 33], t[3 * 33]); o.y = pk4_i8(t[4 * 33], t[5 * 33], t[6 * 33], t[7 * 33]);
            *(u32x2*)(dst + (size_t)(drow0 + n) * K + k0 + 8 * c) = o; }
        LDS_WAIT(); asm volatile("" ::: "memory");
    }
}
#define TR_JOB(SRC, LDSRC, KK, NN, DST, DROW_EXPR) { const int nblk = (NN) / 32, nit = ((KK) / 64) * nblk; \
    if (r < nit) { const int kb = r / nblk, nb = r % nblk, n0 = 32 * nb; tr_item((SRC), (LDSRC), 64 * kb, n0, (DST), (KK), (DROW_EXPR), scr, F.lane); continue; } r -= nit; }
#define TR_JOB8(SRC, LDSRC, KK, NN, DST, DROW_EXPR) { const int nblk = (NN) / 32, nit = ((KK) / 64) * nblk; \
    if (r < nit) { const int kb = r / nblk, nb = r % nblk, n0 = 32 * nb; tr_item8((SRC), (LDSRC), 64 * kb, n0, (DST), (KK), (DROW_EXPR), scr, F.lane); continue; } r -= nit; }

__device__ __forceinline__ void p0_prologue(Frame& F) {
    const int tid_ = opaque(F.tid);
    LAS float* scr = (LAS float*)(F.lds + F.wave * 8448);
    const float* w_in = F.in_WIN;
    bf16_t* WCAT = wsp<bf16_t>(F, WS_WCAT); signed char* W8 = wsp<signed char>(F, WS_W8); signed char* WV8 = wsp<signed char>(F, WS_WVT); signed char* WGU8 = wsp<signed char>(F, WS_WGU);
    float* CS = wsp<float>(F, WS_CS);
    constexpr int NSM = 64;
    constexpr int IT_SM = 2 * 4;
    constexpr int S_Q = NAW / 32, S_M = 2 * D / 32, S_F = DFF / 32;
    constexpr int NSTRIP = 3 * S_Q + S_M + 2 * S_F;
    constexpr int N_BIG = 2 * (D / 64) * (NAW / 32) + 2 * (NAW / 64) * (D / 32) + (D / 64) * (D / 32) + (DFF / 64) * (D / 32);
    constexpr int NITEMS = N_BIG + NSM * IT_SM;
    for (int it = F.gw; it < NSTRIP + NITEMS; it += F.ngw) {
        if (it < NSTRIP) {
            int q = it; const float* src; int ld, n0, drow0; signed char* dst; float* cs;
            if (q < S_Q) { src = w_in; ld = INW; n0 = 32 * q; dst = W8; drow0 = n0; cs = CS + CS_QKM; }
            else if ((q -= S_Q) < S_Q) { src = w_in + NAW; ld = INW; n0 = 32 * q; dst = W8; drow0 = 2048 + n0; cs = CS + CS_QKM; }
            else if ((q -= S_Q) < S_M) { src = F.in_WM; ld = 2 * D; n0 = 32 * q; dst = W8; drow0 = 4096 + n0; cs = CS + CS_QKM; }
            else if ((q -= S_M) < S_Q) { src = w_in + 2 * NAW; ld = INW; n0 = 32 * q; dst = WV8; drow0 = n0; cs = CS + CS_V; }
            else if ((q -= S_Q) < S_F) { src = F.in_WFG; ld = DFF; n0 = 32 * q; dst = WGU8; drow0 = (n0 >> 7) * 256 + (n0 & 127); cs = CS + CS_GU; }
            else { q -= S_F; src = F.in_WFU; ld = DFF; n0 = 32 * q; dst = WGU8; drow0 = (n0 >> 7) * 256 + 128 + (n0 & 127); cs = CS + CS_GU; }
            tr_strip_i8(src, ld, D, n0, dst, drow0, cs, scr, F.lane);
            continue;
        }
        int r = it - NSTRIP;
        TR_JOB(w_in + 3 * NAW, INW, D, NAW, WCAT, 0 + n0)
        TR_JOB(w_in + 4 * NAW, INW, D, NAW, WCAT, 2048 + n0)
        TR_JOB(F.in_WNO, D, NAW, D, wsp<bf16_t>(F, WS_WNO), n0)
        TR_JOB(F.in_WLO, D, LW, D, wsp<bf16_t>(F, WS_WLO), n0)
        TR_JOB(F.in_WOUT, D, D, D, wsp<bf16_t>(F, WS_WO), n0)
        TR_JOB(F.in_WFD, D, DFF, D, wsp<bf16_t>(F, WS_WD), n0)
        {
            const int mi = r / IT_SM, ri = r % IT_SM, d = mi >> 5, g = (mi >> 4) & 1, n = mi & 15, kb = ri >> 2, nb = ri & 3;
            const float* src = (g ? F.in_WI : F.in_WR) + (size_t)(d * NBLK + n) * BW * BW;
            tr_item(src, BW, 64 * kb, 32 * nb, wsp<bf16_t>(F, WS_WG) + (size_t)mi * BW * BW, BW, 32 * nb, scr, F.lane);
        }
    }
    LAS f32x4* gl = (LAS f32x4*)(F.lds + 69632);
    for (int i = tid_; i < D / 4; i += NTHR) gl[i] = ((const f32x4*)F.in_GMPRE)[i];
    __syncthreads();
    bf16_t* XN = wsp<bf16_t>(F, WS_XN); signed char* XN8 = wsp<signed char>(F, WS_XN8); float* RS1 = wsp<float>(F, WS_RS1);
    for (int m = F.gw; m < L; m += F.ngw) {
        asm volatile("" ::: "memory");
        const f32x4* xr = (const f32x4*)xrow(F, m) + F.lane;
        f32x4 v[16]; float s = 0.f;
#pragma unroll
        for (int j = 0; j < 16; ++j) { v[j] = xr[64 * j]; s += (v[j].x * v[j].x + v[j].y * v[j].y) + (v[j].z * v[j].z + v[j].w * v[j].w); }
        const float rstd = 1.0f / sqrtf(wave_sum(s) * (1.0f / D) + EPS);
        u32x2* o8 = (u32x2*)(XN + (size_t)m * D) + F.lane; unsigned* o4 = (unsigned*)(XN8 + (size_t)m * D) + F.lane;
        float mx = 0.f;
#pragma unroll
        for (int j = 0; j < 16; ++j) { v[j] = v[j] * rstd * gl[F.lane + 64 * j]; mx = fmaxf(fmaxf(mx, fmaxf(fabsf(v[j].x), fabsf(v[j].y))), fmaxf(fabsf(v[j].z), fabsf(v[j].w))); }
        const float amax = fmaxf(wave_max(mx), 1e-20f), inv = 127.0f / amax;
        if (F.lane == 0) RS1[m] = amax * (1.0f / 127.0f);
#pragma unroll
        for (int j = 0; j < 16; ++j) { const f32x4 y = v[j]; u32x2 o; o.x = pk2(y.x, y.y); o.y = pk2(y.z, y.w); o8[64 * j] = o;
            o4[64 * j] = pk4_i8(rintf(y.x * inv), rintf(y.y * inv), rintf(y.z * inv), rintf(y.w * inv)); }
    }
    __syncthreads();
}

#ifndef ATT_SYNC
#define ATT_SYNC 1
#endif
template <int ADBG = 0> __device__ __forceinline__ void attn_mfma(Frame& F) {
    const int tid_ = opaque(F.tid);
    bf16_t* Q = wsp<bf16_t>(F, WS_Q); const bf16_t* Kb = wsp<bf16_t>(F, WS_K); const bf16_t* VT = wsp<bf16_t>(F, WS_VT);
    LAS float* rp = (LAS float*)F.lds;
    for (int i = tid_; i < NH * 15 * 31; i += NTHR) rp[i] = F.in_RPB[i];
    __syncthreads();
    const int fr = F.lane & 15, fq = F.lane >> 4;
    const float scale = 0.08838834764831845f;
    for (int base = blockIdx.x * NWAVES; base < (L / GRIDW) * NH * 4; base += F.ngw) {
        const int item = base + F.wave;
        asm volatile("" ::: "memory");
        const int g = item & 3, h = (item >> 2) & 15, rg = item >> 6;
        const int s0 = rg < LP / GRIDW ? 0 : LP, rows = rg < LP / GRIDW ? LP / GRIDW : LS / GRIDW, r = rg < LP / GRIDW ? rg : rg - LP / GRIDW;
        int rs = r - 4; rs = rs < 0 ? 0 : (rs > rows - 8 ? rows - 8 : rs);
        const int w0 = g == 0 ? 0 : (g == 1 ? 8 : (g == 2 ? 24 : 32));
        const int c = 16 * g + fr;
        int cs = c - 8; cs = cs < 0 ? 0 : (cs > GRIDW - 16 ? GRIDW - 16 : cs);
        bf16_t* qrow = Q + (size_t)(s0 + r * GRIDW + c) * NAW + h * HD;
        bf16x8 qf[4];
#pragma unroll
        for (int s = 0; s < 4; ++s) qf[s] = *(const bf16x8*)(qrow + 8 * fq + 32 * s);
        f32x4 sacc[8][2];
        const int Rg = s0 / GRIDW + rs, p0 = w0 >> 3;
        const bf16_t* kbase = Kb + (size_t)(Rg * 16 + h) * 8192 + p0 * 128 + fr * 32 + fq * 8;
        bf16x8 kb[8][2][4];
#define ATT_LDK(kr) do { _Pragma("unroll") for (int T = 0; T < 2; ++T) _Pragma("unroll") for (int s = 0; s < 4; ++s) kb[kr][T][s] = (ADBG & 1) ? qf[s] : (ADBG & 4) ? *(const bf16x8*)(Kb + (size_t)(s0 + rs * GRIDW) * NAW + h * HD * GRIDW + ((kr) * 8 + T * 4 + s) * 512 + F.lane * 8) : *(const bf16x8*)(kbase + (size_t)(kr) * (16 * 8192) + (s * 2 + T) * 1024); } while (0)
        ATT_LDK(0); ATT_LDK(1);
#pragma unroll
        for (int kr = 0; kr < 8; ++kr) {
            if (ATT_SYNC && (kr & 1) == 0) __builtin_amdgcn_s_barrier();
            if (kr + 2 < 8) ATT_LDK(kr + 2);
            __builtin_amdgcn_sched_barrier(0);
#pragma unroll
            for (int T = 0; T < 2; ++T) { f32x4 a = (f32x4){0.f, 0.f, 0.f, 0.f};
#pragma unroll
                for (int s = 0; s < 4; ++s) a = __builtin_amdgcn_mfma_f32_16x16x32_bf16(kb[kr][T][s], qf[s], a, 0, 0, 0);
                sacc[kr][T] = a; }
            __builtin_amdgcn_sched_barrier(0);
        }
#undef ATT_LDK
        bf16x8 vb[8][8];
        const bf16_t* vbase = VT + (size_t)(Rg * 16 + h) * 8192 + p0 * 128 + fq * 128 + fr * 8;
#define ATT_LDV(kr) do { _Pragma("unroll") for (int dt = 0; dt < 8; ++dt) vb[kr][dt] = (ADBG & 2) ? qf[dt & 3] : (ADBG & 4) ? *(const bf16x8*)(VT + (size_t)(h * HD) * L + s0 + rs * GRIDW + ((kr) * 8 + dt) * 512 + F.lane * 8) : *(const bf16x8*)(vbase + (size_t)(kr) * (16 * 8192) + dt * 1024); } while (0)
        ATT_LDV(0); ATT_LDV(1);
        __builtin_amdgcn_sched_barrier(0);
        const int elo = cs - w0 - 8 * fq, dc0 = w0 + 8 * fq - c + 15;
        const LAS float* rph = rp + h * 465 + (rs - r + 7) * 31;
        float mx = -3.0e38f;
#pragma unroll
        for (int e = 0; e < 8; ++e) { const bool valid = (e >= elo) && (e < elo + 16); const int bi = valid ? dc0 + e : 0;
#pragma unroll
            for (int kr = 0; kr < 8; ++kr) { const float sv = valid ? sacc[kr][e >> 2][e & 3] * scale + rph[kr * 31 + bi] : -3.0e38f; sacc[kr][e >> 2][e & 3] = sv; mx = fmaxf(mx, sv); } }
        mx = fmaxf(mx, __shfl_xor(mx, 16)); mx = fmaxf(mx, __shfl_xor(mx, 32));
        float lsum = 0.f; bf16x8 pf[8];
#pragma unroll
        for (int kr = 0; kr < 8; ++kr) { float p[8];
#pragma unroll
            for (int e = 0; e < 8; ++e) { p[e] = __expf(sacc[kr][e >> 2][e & 3] - mx); lsum += p[e]; }
            u32x4 w; w.x = pk2(p[0], p[1]); w.y = pk2(p[2], p[3]); w.z = pk2(p[4], p[5]); w.w = pk2(p[6], p[7]);
            pf[kr] = __builtin_bit_cast(bf16x8, w); }
        lsum += __shfl_xor(lsum, 16); lsum += __shfl_xor(lsum, 32);
        f32x4 oacc[8];
#pragma unroll
        for (int dt = 0; dt < 8; ++dt) oacc[dt] = (f32x4){0.f, 0.f, 0.f, 0.f};
#pragma unroll
        for (int kr = 0; kr < 8; ++kr) {
            if (ATT_SYNC && (kr & 1) == 0) __builtin_amdgcn_s_barrier();
            if (kr + 2 < 8) ATT_LDV(kr + 2);
            __builtin_amdgcn_sched_barrier(0);
#pragma unroll
            for (int dt = 0; dt < 8; ++dt) oacc[dt] = __builtin_amdgcn_mfma_f32_16x16x32_bf16(vb[kr][dt], pf[kr], oacc[dt], 0, 0, 0);
            __builtin_amdgcn_sched_barrier(0);
        }
#undef ATT_LDV
        const float inv = 1.0f / lsum;
#ifdef ATTN_OUT_OFF
        bf16_t* orow = wsp<bf16_t>(F, (size_t)ATTN_OUT_OFF * MiB) + (size_t)(s0 + r * GRIDW + c) * NAW + h * HD;
#else
        bf16_t* orow = qrow;
#endif
#pragma unroll
        for (int u = 0; u < 4; ++u) *(u32x4*)(orow + 32 * u + 8 * fq) = pg8::pack8(oacc[2 * u] * inv, oacc[2 * u + 1] * inv);
    }
    __syncthreads();
}

__device__ __forceinline__ void conv_phase(Frame& F) {
    const int tid_ = opaque(F.tid);
    const bf16_t* XR = wsp<bf16_t>(F, WS_XR); bf16_t* XC = wsp<bf16_t>(F, WS_XC);
    const float* wc = F.in_WCONV; const float* bc = F.in_BCONV;
    const int nth = F.G * NTHR;
    for (int it = blockIdx.x * NTHR + tid_; it < L * (LW / 8); it += nth) {
        const int t = it / (LW / 8), c0 = (it % (LW / 8)) * 8;
        const int s0 = t < LP ? 0 : LP, len = t < LP ? LP : LS, tl = t - s0;
        float acc[8];
#pragma unroll
        for (int e = 0; e < 8; ++e) acc[e] = bc[c0 + e];
#pragma unroll
        for (int j = 0; j < 4; ++j) { const int tt = tl + j - 2; if (tt < 0 || tt >= len) continue;
            f32x4 x0, x1; pg8::unpack8(*(const u32x4*)(XR + (size_t)(s0 + tt) * LW + c0), x0, x1);
            const f32x4 w0 = *(const f32x4*)(wc + j * LW + c0), w1 = *(const f32x4*)(wc + j * LW + c0 + 4);
#pragma unroll
            for (int e = 0; e < 4; ++e) { acc[e] += w0[e] * x0[e]; acc[4 + e] += w1[e] * x1[e]; } }
        *(u32x4*)(XC + (size_t)t * LW + c0) = pg8::pack8((f32x4){acc[0], acc[1], acc[2], acc[3]}, (f32x4){acc[4], acc[5], acc[6], acc[7]});
    }
}

struct LruW { bf16x8 w[2][4]; float br, bi, cl; };
template <int DIR> __device__ __forceinline__ void lru_load_w(const Frame& F, LruW& W, int n, int w, int fr, int fq) {
    const bf16_t* wg = wsp<bf16_t>(F, WS_WG);
#pragma unroll
    for (int g = 0; g < 2; ++g)
#pragma unroll
        for (int s = 0; s < 4; ++s) W.w[g][s] = *(const bf16x8*)(wg + ((size_t)((DIR * 2 + g) * NBLK + n) * BW + 16 * w + fr) * BW + 32 * fq + 8 * s);
    const int ch = n * BW + 16 * w + fr;
    W.br = F.in_BR[DIR * LW + ch]; W.bi = F.in_BI[DIR * LW + ch];
    const float lam = F.in_LAM[DIR * LW + ch];
    W.cl = -8.0f * ((lam > 15.f) ? __expf(-lam) : log1pf(__expf(-lam)));
}
template <int LDBG = 0> __device__ __forceinline__ void lru_gate(float pr, float pi, float xc, const LruW& W, bool first, float& a, float& u) {
    if constexpr (LDBG == 1) { a = pr + W.br; u = pi * xc + W.bi; return; }
    const float r = sigmoidf_(pr + W.br), ig = sigmoidf_(pi + W.bi);
    a = __expf(W.cl * r);
    const float mult = first ? 1.0f : __builtin_amdgcn_sqrtf(fmaxf(1.0f - a * a, 0.f));
    u = mult * ig * xc;
}
struct LruX { bf16x8 x[4][4]; };
__device__ __forceinline__ void lru_load_x(LruX& X, const bf16_t* XC, int tb, int n, int fr, int fq) {
#pragma unroll
    for (int tau = 0; tau < 4; ++tau) { const bf16_t* xp = XC + ((size_t)((((tb >> 6) * NBLK + n) * 4 + tau) * 4) * 64 + fr * 4 + fq) * 8;
#pragma unroll
        for (int s = 0; s < 4; ++s) X.x[tau][s] = *(const bf16x8*)(xp + s * 512); }
}
__device__ __forceinline__ void lru_tile(const LruX& X, int tau, bool hiw, const LruW& W, const bf16x8 idf0, const bf16x8 idf1, f32x4& pr, f32x4& pi, f32x4& xct) {
    pr = (f32x4){0.f, 0.f, 0.f, 0.f}; pi = pr;
#pragma unroll
    for (int s = 0; s < 4; ++s) { pr = __builtin_amdgcn_mfma_f32_16x16x32_bf16(X.x[tau][s], W.w[0][s], pr, 0, 0, 0); pi = __builtin_amdgcn_mfma_f32_16x16x32_bf16(X.x[tau][s], W.w[1][s], pi, 0, 0, 0); }
    const bf16x8 x0 = hiw ? X.x[tau][2] : X.x[tau][0], x1 = hiw ? X.x[tau][3] : X.x[tau][1];
    xct = __builtin_amdgcn_mfma_f32_16x16x32_bf16(x0, idf0, (f32x4){0.f, 0.f, 0.f, 0.f}, 0, 0, 0);
    xct = __builtin_amdgcn_mfma_f32_16x16x32_bf16(x1, idf1, xct, 0, 0, 0);
}
__device__ __forceinline__ void lru_idfrags(int w, int fr, int fq, bf16x8& idf0, bf16x8& idf1) {
#pragma unroll
    for (int e = 0; e < 8; ++e) { const bool on = (fq == (w >> 1)) && ((fr & 7) == e); idf0[e] = (on && fr < 8) ? (short)0x3F80 : (short)0; idf1[e] = (on && fr >= 8) ? (short)0x3F80 : (short)0; }
}
constexpr int LRU_CH = 256, LRU_NCH = L / LRU_CH, LRU_NCH_P = LP / LRU_CH;
__device__ __forceinline__ void conv_unit(Frame& F, int cg, int n) {
    const int tid_ = opaque(F.tid);
    const bf16_t* XR = wsp<bf16_t>(F, WS_XR); bf16_t* XC = wsp<bf16_t>(F, WS_XC);
    const float* wc = F.in_WCONV; const float* bc = F.in_BCONV;
    const int c0 = n * BW + (tid_ & 15) * 8;
    const int s0 = cg < LRU_NCH_P ? 0 : LP, len = cg < LRU_NCH_P ? LP : LS;
    f32x4 w[4][2]; f32x4 b0 = *(const f32x4*)(bc + c0), b1 = *(const f32x4*)(bc + c0 + 4);
#pragma unroll
    for (int j = 0; j < 4; ++j) { w[j][0] = *(const f32x4*)(wc + j * LW + c0); w[j][1] = *(const f32x4*)(wc + j * LW + c0 + 4); }
#pragma unroll
    for (int i = 0; i < 8; ++i) {
        const int t = cg * LRU_CH + (tid_ >> 4) + 32 * i, tl = t - s0;
        f32x4 a0 = b0, a1 = b1;
#pragma unroll
        for (int j = 0; j < 4; ++j) { const int tt = tl + j - 2; if (tt < 0 || tt >= len) continue;
            f32x4 x0, x1; pg8::unpack8(*(const u32x4*)(XR + (size_t)(s0 + tt) * LW + c0), x0, x1); a0 += w[j][0] * x0; a1 += w[j][1] * x1; }
        const int tg = t & 63, cq = tid_ & 15;
        *(u32x4*)(XC + ((size_t)(((((t >> 6) * NBLK + n) * 4 + ((tg >> 2) & 3)) * 4 + (cq & 3)) * 16 + 4 * (tg >> 4) + (tg & 3)) * 4 + (cq >> 2)) * 8) = pg8::pack8(a0, a1);
    }
}
__device__ __forceinline__ void lru_pass_a(Frame& F) {
    const int fr = F.lane & 15, fq = F.lane >> 4, w = F.wave;
    const bf16_t* XC = wsp<bf16_t>(F, WS_XC); f32x2* SUMM = wsp<f32x2>(F, WS_SUM);
    bf16x8 idf0, idf1; lru_idfrags(w, fr, fq, idf0, idf1);
    for (int u = blockIdx.x; u < LRU_NCH * NBLK; u += F.G) {
        const int cg = u >> 4, n = u & 15;
        conv_unit(F, cg, n); VM_WAIT(); __syncthreads();
        LruW Wf, Wb; lru_load_w<0>(F, Wf, n, w, fr, fq); lru_load_w<1>(F, Wb, n, w, fr, fq);
        const bool c_first = (cg == 0 || cg == LRU_NCH_P), c_last = (cg == LRU_NCH_P - 1 || cg == LRU_NCH - 1);
        float Af = 1.f, Hf = 0.f, Ab = 1.f, Hb = 0.f;
        LruX X, Xn; lru_load_x(X, XC, cg * LRU_CH, n, fr, fq);
        for (int gi = 0; gi < 4; ++gi) {
            if (gi < 3) lru_load_x(Xn, XC, cg * LRU_CH + (gi + 1) * 64, n, fr, fq);
            float pf = 1.f, hf = 0.f, pb = 1.f, hb = 0.f;
#pragma unroll
            for (int tau = 0; tau < 4; ++tau) {
                f32x4 prf, pif, prb, pib, xct, xct2;
                lru_tile(X, tau, (w & 1) != 0, Wf, idf0, idf1, prf, pif, xct);
                lru_tile(X, tau, (w & 1) != 0, Wb, idf0, idf1, prb, pib, xct2);
#pragma unroll
                for (int j = 0; j < 4; ++j) {
                    float a, uu;
                    lru_gate(prf[j], pif[j], xct[j], Wf, c_first && gi == 0 && fq == 0 && tau == 0 && j == 0, a, uu); hf = a * hf + uu; pf *= a;
                    lru_gate(prb[j], pib[j], xct[j], Wb, c_last && gi == 3 && fq == 3 && tau == 3 && j == 3, a, uu); hb += pb * uu; pb *= a;
                }
            }
            float gPf = 1.f, gHf = 0.f, gPb = 1.f, gHb = 0.f;
#pragma unroll
            for (int qq = 0; qq < 4; ++qq) { const int src = fr + 16 * qq;
                float P = __shfl(pf, src), H = __shfl(hf, src); gHf = P * gHf + H; gPf *= P;
                P = __shfl(pb, src); H = __shfl(hb, src); gHb += gPb * H; gPb *= P; }
            Hf = gPf * Hf + gHf; Af *= gPf; Hb += Ab * gHb; Ab *= gPb;
            X = Xn;
        }
        if (fq == 0) { const int ch = n * BW + 16 * w + fr; SUMM[(size_t)(cg * 2 + 0) * LW + ch] = (f32x2){Af, Hf}; SUMM[(size_t)(cg * 2 + 1) * LW + ch] = (f32x2){Ab, Hb}; }
    }
}
__device__ __forceinline__ void lru_pass_b(Frame& F) {
    const int tid_ = opaque(F.tid);
    const int gt = blockIdx.x * NTHR + tid_; if (gt >= 4 * LW) return;
    const int ch = gt % LW, d = (gt / LW) & 1, seq = gt / (2 * LW), c0 = seq ? LRU_NCH_P : 0, nc = seq ? LRU_NCH - LRU_NCH_P : LRU_NCH_P;
    const f32x2* SUMM = wsp<f32x2>(F, WS_SUM); float* CIN = wsp<float>(F, WS_SUM + 4 * MiB);
    float s = 0.f;
    for (int i0 = 0; i0 < nc; i0 += 8) {
        f32x2 ah[8];
#pragma unroll
        for (int e = 0; e < 8; ++e) { const int cg = d ? c0 + nc - 1 - (i0 + e) : c0 + i0 + e; ah[e] = SUMM[(size_t)(cg * 2 + d) * LW + ch]; }
#pragma unroll
        for (int e = 0; e < 8; ++e) { const int cg = d ? c0 + nc - 1 - (i0 + e) : c0 + i0 + e; CIN[(size_t)(cg * 2 + d) * LW + ch] = s; s = ah[e].x * s + ah[e].y; }
    }
}
template <int LDBG = 0> __device__ __forceinline__ void lru_pass_c(Frame& F) {
    const int tid_ = opaque(F.tid);
    const int fr = F.lane & 15, fq = F.lane >> 4, w = F.wave;
    const bf16_t* XC = wsp<bf16_t>(F, WS_XC); const float* CIN = wsp<float>(F, WS_SUM + 4 * MiB);
    const bf16_t* GR = wsp<bf16_t>(F, WS_GR); bf16_t* LRU = wsp<bf16_t>(F, WS_XR);
    LAS bf16_t* hfb = (LAS bf16_t*)(F.lds + w * 8192);
    LAS bf16_t* grt = (LAS bf16_t*)(F.lds + 65536);
    bf16x8 idf0, idf1; lru_idfrags(w, fr, fq, idf0, idf1);
    for (int u = blockIdx.x; u < LRU_NCH * NBLK; u += F.G) {
        const int cg = u >> 4, n = u & 15, ch = n * BW + 16 * w + fr;
        const bool c_first = (cg == 0 || cg == LRU_NCH_P), c_last = (cg == LRU_NCH_P - 1 || cg == LRU_NCH - 1);
        { const bf16_t* gsrc = GR + (size_t)(cg * LRU_CH + (tid_ >> 4)) * LW + n * BW + (tid_ & 15) * 8; LAS bf16_t* ldst = grt + w * 512;
#pragma unroll 1
          for (int k = 0; k < 8; ++k) { __builtin_amdgcn_global_load_lds((const unsigned*)gsrc, (LAS unsigned*)ldst, 16, 0, 0); gsrc += (size_t)32 * LW; ldst += NTHR * 8; } }
        {
            LruW W; lru_load_w<0>(F, W, n, w, fr, fq);
            float s = CIN[(size_t)(cg * 2 + 0) * LW + ch];
            LruX X, Xn; lru_load_x(X, XC, cg * LRU_CH, n, fr, fq);
            for (int gi = 0; gi < 4; ++gi) {
                if (gi < 3 && LDBG != 2) lru_load_x(Xn, XC, cg * LRU_CH + (gi + 1) * 64, n, fr, fq);
                float a[16], uu[16];
#pragma unroll
                for (int tau = 0; tau < 4; ++tau) { f32x4 pr, pi, xct; lru_tile(X, tau, (w & 1) != 0, W, idf0, idf1, pr, pi, xct);
#pragma unroll
                    for (int j = 0; j < 4; ++j) lru_gate<LDBG>(pr[j], pi[j], xct[j], W, c_first && gi == 0 && fq == 0 && tau == 0 && j == 0, a[4 * tau + j], uu[4 * tau + j]); }
                float p = 1.f, h = 0.f;
#pragma unroll
                for (int t = 0; t < 16; ++t) { h = a[t] * h + uu[t]; p *= a[t]; }
                float hin = s, sg = s;
#pragma unroll
                for (int qq = 0; qq < 4; ++qq) { const float P = __shfl(p, fr + 16 * qq), H = __shfl(h, fr + 16 * qq); sg = P * sg + H; if (qq < fq) hin = P * hin + H; }
                s = sg;
                float hh = hin;
#pragma unroll
                for (int t = 0; t < 16; ++t) { hh = a[t] * hh + uu[t]; hfb[(gi * 64 + 16 * fq + t) * 16 + fr] = (bf16_t)f2bf(hh); }
                X = Xn;
            }
        }
        VM_WAIT(); __syncthreads();
        {
            LruW W; lru_load_w<1>(F, W, n, w, fr, fq);
            float s = CIN[(size_t)(cg * 2 + 1) * LW + ch];
            LruX X, Xn; lru_load_x(X, XC, cg * LRU_CH + 3 * 64, n, fr, fq);
            for (int gi = 3; gi >= 0; --gi) {
                if (gi > 0 && LDBG != 2) lru_load_x(Xn, XC, cg * LRU_CH + (gi - 1) * 64, n, fr, fq);
                float a[16], uu[16];
#pragma unroll
                for (int tau = 0; tau < 4; ++tau) { f32x4 pr, pi, xct; lru_tile(X, tau, (w & 1) != 0, W, idf0, idf1, pr, pi, xct);
#pragma unroll
                    for (int j = 0; j < 4; ++j) lru_gate<LDBG>(pr[j], pi[j], xct[j], W, c_last && gi == 3 && fq == 3 && tau == 3 && j == 3, a[4 * tau + j], uu[4 * tau + j]); }
                float p = 1.f, h = 0.f;
#pragma unroll
                for (int t = 15; t >= 0; --t) { h = a[t] * h + uu[t]; p *= a[t]; }
                float hin = s, sg = s;
#pragma unroll
                for (int qq = 3; qq >= 0; --qq) { const float P = __shfl(p, fr + 16 * qq), H = __shfl(h, fr + 16 * qq); sg = P * sg + H; if (qq > fq) hin = P * hin + H; }
                s = sg;
                float hh = hin;
#pragma unroll
                for (int t = 15; t >= 0; --t) { hh = a[t] * hh + uu[t];
                    const int tl = gi * 64 + 16 * fq + t; LAS bf16_t* gp = grt + tl * BW + 16 * w + fr;
                    *gp = (bf16_t)f2bf((bf1(hfb[tl * 16 + fr]) + hh) * gelu_tanh(bf1(*gp))); }
                X = Xn;
            }
        }
        LDS_WAIT(); __syncthreads();
        { bf16_t* gdst = LRU + (size_t)(cg * LRU_CH + (tid_ >> 4)) * LW + n * BW + (tid_ & 15) * 8; const LAS bf16_t* lsrc = grt + tid_ * 8;
#pragma unroll 1
          for (int k = 0; k < 8; ++k) { *(u32x4*)gdst = *(const LAS u32x4*)lsrc; gdst += (size_t)32 * LW; lsrc += NTHR * 8; } }
        LDS_WAIT(); __syncthreads();
    }
}

__device__ __forceinline__ f32x4 up4(const u32x2 u) { return (f32x4){bflo(u.x), bfhi(u.x), bflo(u.y), bfhi(u.y)}; }
__device__ __forceinline__ void mid_phase(Frame& F) {
    const int tid_ = opaque(F.tid);
    const bf16_t* MIX = wsp<bf16_t>(F, WS_MIX); signed char* XN8 = wsp<signed char>(F, WS_XN8); float* RSTD = wsp<float>(F, WS_RSTD); float* RS2 = wsp<float>(F, WS_RS2);
    LAS f32x4* gpost = (LAS f32x4*)F.lds; LAS f32x4* gpre = gpost + D / 4;
    for (int i = tid_; i < D / 4; i += NTHR) { gpost[i] = ((const f32x4*)F.in_GMPOST)[i]; gpre[i] = ((const f32x4*)F.in_GFPRE)[i]; }
    __syncthreads();
    for (int m = F.gw; m < L; m += F.ngw) {
        asm volatile("" ::: "memory");
        const f32x4* xr = (const f32x4*)xrow(F, m) + F.lane; const u32x2* mr = (const u32x2*)(MIX + (size_t)m * D) + F.lane;
        f32x4 v[16]; u32x2 mx[16]; float s = 0.f;
#pragma unroll
        for (int j = 0; j < 16; ++j) { v[j] = xr[64 * j]; mx[j] = mr[64 * j]; const f32x4 a = up4(mx[j]); s += (a.x * a.x + a.y * a.y) + (a.z * a.z + a.w * a.w); }
        const float rstd1 = 1.0f / sqrtf(wave_sum(s) * (1.0f / D) + EPS);
        if (F.lane == 0) RSTD[m] = rstd1;
        float s2 = 0.f;
#pragma unroll
        for (int j = 0; j < 16; ++j) { v[j] = v[j] + up4(mx[j]) * rstd1 * gpost[F.lane + 64 * j]; s2 += (v[j].x * v[j].x + v[j].y * v[j].y) + (v[j].z * v[j].z + v[j].w * v[j].w); }
        const float rstd2 = 1.0f / sqrtf(wave_sum(s2) * (1.0f / D) + EPS);
        float mx2 = 0.f;
#pragma unroll
        for (int j = 0; j < 16; ++j) { v[j] = v[j] * rstd2 * gpre[F.lane + 64 * j]; mx2 = fmaxf(fmaxf(mx2, fmaxf(fabsf(v[j].x), fabsf(v[j].y))), fmaxf(fabsf(v[j].z), fabsf(v[j].w))); }
        const float amax = fmaxf(wave_max(mx2), 1e-20f), inv = 127.0f / amax;
        if (F.lane == 0) RS2[m] = amax * (1.0f / 127.0f);
        unsigned* o4 = (unsigned*)(XN8 + (size_t)m * D) + F.lane;
#pragma unroll
        for (int j = 0; j < 16; ++j) o4[64 * j] = pk4_i8(rintf(v[j].x * inv), rintf(v[j].y * inv), rintf(v[j].z * inv), rintf(v[j].w * inv));
    }
    __syncthreads();
}
__device__ __forceinline__ void final_phase(Frame& F) {
    const int tid_ = opaque(F.tid);
    const bf16_t* MIX = wsp<bf16_t>(F, WS_MIX); const bf16_t* FB = wsp<bf16_t>(F, WS_F); const float* RSTD = wsp<float>(F, WS_RSTD);
    LAS f32x4* gpost = (LAS f32x4*)F.lds; LAS f32x4* gfp = gpost + D / 4;
    for (int i = tid_; i < D / 4; i += NTHR) { gpost[i] = ((const f32x4*)F.in_GMPOST)[i]; gfp[i] = ((const f32x4*)F.in_GFPOST)[i]; }
    __syncthreads();
    for (int m = F.gw; m < L; m += F.ngw) {
        asm volatile("" ::: "memory");
        const f32x4* xr = (const f32x4*)xrow(F, m) + F.lane; const u32x2* mr = (const u32x2*)(MIX + (size_t)m * D) + F.lane; const u32x2* fr = (const u32x2*)(FB + (size_t)m * D) + F.lane;
        const float rstd1 = RSTD[m];
        u32x2 fx[16]; float s = 0.f;
#pragma unroll
        for (int j = 0; j < 16; ++j) { fx[j] = fr[64 * j]; const f32x4 a = up4(fx[j]); s += (a.x * a.x + a.y * a.y) + (a.z * a.z + a.w * a.w); }
        const float rstd3 = 1.0f / sqrtf(wave_sum(s) * (1.0f / D) + EPS);
        f32x4* o = (f32x4*)(F.out + (size_t)m * D) + F.lane;
#pragma unroll
        for (int j = 0; j < 16; ++j) o[64 * j] = xr[64 * j] + up4(mr[64 * j]) * rstd1 * gpost[F.lane + 64 * j] + up4(fx[j]) * rstd3 * gfp[F.lane + 64 * j];
    }
}

constexpr int LDS_STAGE = pg8::STAGE_BYTES;
constexpr int LDS_MISC = LDS_STAGE;
constexpr int LDS_BYTES = LDS_STAGE + 1024;
#ifndef MK_N_LAUNCHES
#define MK_N_LAUNCHES 1
#endif
constexpr int NPHASE = 11;
struct Args { const float* in[23]; float* out; unsigned char* ws; int ph_lo, ph_hi; };

__global__ void __launch_bounds__(NTHR, 2) fwd_kernel(Args args) {
    extern __shared__ __attribute__((aligned(16))) unsigned char lds_raw[];
    Frame F;
    F.lds = (LAS unsigned char*)lds_raw;
    F.tid = threadIdx.x; F.lane = (int)__builtin_amdgcn_mbcnt_hi(~0u, __builtin_amdgcn_mbcnt_lo(~0u, 0u)); F.wave = __builtin_amdgcn_readfirstlane(F.tid >> 6);
    F.G = gridDim.x; F.gw = blockIdx.x * NWAVES + F.wave; F.ngw = F.G * NWAVES;
    F.in_XP = args.in[0]; F.in_XS = args.in[1]; F.in_WIN = args.in[2]; F.in_WCONV = args.in[3]; F.in_BCONV = args.in[4]; F.in_WR = args.in[5]; F.in_BR = args.in[6]; F.in_WI = args.in[7]; F.in_BI = args.in[8]; F.in_LAM = args.in[9]; F.in_RPB = args.in[10]; F.in_WNO = args.in[11]; F.in_WLO = args.in[12]; F.in_WM = args.in[13]; F.in_BM = args.in[14]; F.in_WOUT = args.in[15]; F.in_GMPRE = args.in[16]; F.in_GMPOST = args.in[17]; F.in_GFPRE = args.in[18]; F.in_GFPOST = args.in[19]; F.in_WFG = args.in[20]; F.in_WFU = args.in[21]; F.in_WFD = args.in[22];
    F.out = args.out; F.ws = args.ws;
    volatile LAS unsigned* MISC = (volatile LAS unsigned*)(F.lds + LDS_MISC);
    if (F.tid < 256) MISC[F.tid] = 0u;
    __syncthreads();
    const int lo = args.ph_lo, hi = args.ph_hi;
    const bool fused = (hi - lo) > 1;
    XcdBarrier bar; bar.bar = (unsigned*)(F.ws + WS_CTL); bar.x = 0; bar.st = nullptr;
    if (fused) bar = xcd_barrier_post((unsigned*)(F.ws + WS_CTL), MISC + 8);
#ifndef PH_MASK
#define PH_MASK 0x7ff
#endif
#define IN(k) (((PH_MASK >> (k)) & 1) && lo <= (k) && (k) < hi)
#define SEAM(k) do { if (IN(k) && IN((k) + 1)) xcd_barrier(bar); } while (0)
    LAS unsigned char* stage = F.lds;

#ifdef ATTN_OUT_OFF
#define NA_BUF ((size_t)ATTN_OUT_OFF * MiB)
#else
#define NA_BUF WS_Q
#endif
#ifndef DUP_MASK
#define DUP_MASK 0
#endif
#define RUN(k, ...) if (IN(k)) { __VA_ARGS__ if (((DUP_MASK) >> (k)) & 1) { __VA_ARGS__ } }
    RUN(0, { p0_prologue(F); }) SEAM(0);
    RUN(1, {
        { pg8::Gemm g{wsp<bf16_t>(F, WS_XN8), wsp<bf16_t>(F, WS_XN8), 1 << 30, wsp<bf16_t>(F, WS_W8), L, 2 * NAW + 2 * D, D}; pg8::StaticOrder S; S.init(L, 2 * NAW + 2 * D, F.G, (int)blockIdx.x);
          pg8::EpiProjQ E{wsp<bf16_t>(F, WS_Q), wsp<bf16_t>(F, WS_K), (bf16_t*)F.out, F.in_BM, wsp<float>(F, WS_RS1), wsp<float>(F, WS_CS) + CS_QKM};
          pg8::gemm_phase<pg8::EpiProjQ, pg8::StaticOrder, true, true, 2>(stage, g, S, E); }
        { pg8::Gemm g{wsp<bf16_t>(F, WS_XN), wsp<bf16_t>(F, WS_XN), 1 << 30, wsp<bf16_t>(F, WS_WCAT), L, 2 * NAW, 2 * D}; pg8::StaticOrder S; S.init(L, 2 * NAW, F.G, (int)blockIdx.x);
          pg8::EpiProj E{wsp<bf16_t>(F, WS_XR), wsp<bf16_t>(F, WS_GR), wsp<bf16_t>(F, WS_GR), wsp<bf16_t>(F, WS_GR), (bf16_t*)F.out, F.in_BM, 1 << 30};
          pg8::gemm_phase<pg8::EpiProj, pg8::StaticOrder, true, true, 0>(stage, g, S, E); }
        { pg8::Gemm g{wsp<bf16_t>(F, WS_WVT), wsp<bf16_t>(F, WS_WVT), 1 << 30, wsp<bf16_t>(F, WS_XN8), NAW, L, D}; pg8::StaticOrder S; S.init(NAW, L, F.G, (int)blockIdx.x);
          pg8::EpiVTQ E{wsp<bf16_t>(F, WS_VT), wsp<float>(F, WS_CS) + CS_V, wsp<float>(F, WS_RS1)};
          pg8::gemm_phase<pg8::EpiVTQ, pg8::StaticOrder, true, true, 2>(stage, g, S, E); }
    }) SEAM(1);
    RUN(2, { lru_pass_a(F); }) SEAM(2);
    #ifdef ATTN_OUT_OFF
    if (IN(3)) { lru_pass_b(F); } SEAM(3);
    if (IN(4)) { lru_pass_c<0>(F); xcd_barrier(bar); if (ATTN_DUP) attn_mfma<ATTN_DUP - 1>(F); attn_mfma<0>(F); } SEAM(4);
#else
    if (IN(3)) { lru_pass_b(F); attn_mfma<0>(F); } SEAM(3);
#ifdef LRUC_DBG
    if (IN(4)) { lru_pass_c<LRUC_DBG>(F); lru_pass_c<0>(F); } SEAM(4);
#else
    RUN(4, { lru_pass_c<0>(F); }) SEAM(4);
#endif
#endif
    if (IN(5)) {
        { pg8::Gemm g{wsp<bf16_t>(F, NA_BUF), wsp<bf16_t>(F, NA_BUF), 1 << 30, wsp<bf16_t>(F, WS_WNO), L, D, 2 * NAW}; pg8::StaticOrder S; S.init(L, D, F.G, (int)blockIdx.x);
          pg8::EpiMulG<false> E{wsp<bf16_t>(F, WS_T1), (const bf16_t*)F.out, 0};
          pg8::gemm_phase<pg8::EpiMulG<false>, pg8::StaticOrder, true, true>(stage, g, S, E); }
        { pg8::Gemm g{wsp<bf16_t>(F, WS_XR), wsp<bf16_t>(F, WS_XR), 1 << 30, wsp<bf16_t>(F, WS_WLO), L, D, 2 * LW}; pg8::StaticOrder S; S.init(L, D, F.G, (int)blockIdx.x);
          pg8::EpiMulG<true> E{wsp<bf16_t>(F, WS_T1), (const bf16_t*)F.out, D};
          pg8::gemm_phase<pg8::EpiMulG<true>, pg8::StaticOrder, true, true>(stage, g, S, E); }
    } SEAM(5);
    RUN(6, {
        pg8::Gemm g{wsp<bf16_t>(F, WS_T1), wsp<bf16_t>(F, WS_T1), 1 << 30, wsp<bf16_t>(F, WS_WO), L, D, 2 * D}; pg8::StaticOrder S; S.init(L, D, F.G, (int)blockIdx.x);
        pg8::EpiPlain E{wsp<bf16_t>(F, WS_MIX), D};
        pg8::gemm_phase<pg8::EpiPlain, pg8::StaticOrder, true, true>(stage, g, S, E);
    }) SEAM(6);
    RUN(7, { mid_phase(F); }) SEAM(7);
    RUN(8, {
        pg8::Gemm g{wsp<bf16_t>(F, WS_XN8), wsp<bf16_t>(F, WS_XN8), 1 << 30, wsp<bf16_t>(F, WS_WGU), L, 2 * DFF, D}; pg8::StaticOrder S; S.init(L, 2 * DFF, F.G, (int)blockIdx.x);
        pg8::EpiSwigluQ E{(bf16_t*)F.out, wsp<bf16_t>(F, WS_HIDS), LP / 256, wsp<float>(F, WS_RS2), wsp<float>(F, WS_CS) + CS_GU};
        pg8::gemm_phase<pg8::EpiSwigluQ, pg8::StaticOrder, false, true, 2>(stage, g, S, E);
    }) SEAM(8);
    RUN(9, {
        pg8::Gemm g{(const bf16_t*)F.out, wsp<bf16_t>(F, WS_HIDS), LP / 256, wsp<bf16_t>(F, WS_WD), L, D, 2 * DFF}; pg8::StaticOrder S; S.init(L, D, F.G, (int)blockIdx.x);
        pg8::EpiPlain E{wsp<bf16_t>(F, WS_F), D};
        pg8::gemm_phase<pg8::EpiPlain, pg8::StaticOrder, true, true>(stage, g, S, E);
    }) SEAM(9);
    RUN(10, { final_phase(F); })
#undef RUN
#undef IN
#undef SEAM
}

extern "C" void kernel_launch(void* const* d_in, const int* in_sizes, int n_in, void* d_out, int out_size, void* d_ws, size_t ws_size, hipStream_t stream) {
    static int grid = 0;
    if (grid == 0) {
        if (n_in != 23 || in_sizes[0] != LP * D || in_sizes[1] != LS * D || out_size != L * D || ws_size < WS_END) {
            fprintf(stderr, "kernel_launch: unexpected shapes: n_in %d in0 %d out %d ws %zu (need %zu)\n", n_in, n_in > 0 ? in_sizes[0] : -1, out_size, ws_size, (size_t)WS_END); grid = -1; return; }
        int dev = 0, cus = 0, per_cu = 0;
        if (hipGetDevice(&dev) != hipSuccess || hipDeviceGetAttribute(&cus, hipDeviceAttributeMultiprocessorCount, dev) != hipSuccess) { grid = -1; return; }
        if (hipFuncSetAttribute((const void*)fwd_kernel, hipFuncAttributeMaxDynamicSharedMemorySize, LDS_BYTES) != hipSuccess) { fprintf(stderr, "kernel_launch: hipFuncSetAttribute failed\n"); grid = -1; return; }
        if (hipOccupancyMaxActiveBlocksPerMultiprocessor(&per_cu, (const void*)fwd_kernel, NTHR, LDS_BYTES) != hipSuccess || per_cu < 1) { fprintf(stderr, "kernel_launch: occupancy query says %d\n", per_cu); }
        (void)hipGetLastError();
        grid = cus;
    }
    if (grid < 0) return;
    (void)hipMemsetAsync((char*)d_ws + WS_CTL, 0, CTL_ZERO_BYTES, stream);
#ifdef DBG_ZERO_ALL
    (void)hipMemsetAsync((char*)d_ws, 0, WS_END, stream); (void)hipMemsetAsync((char*)d_out, 0, (size_t)L * D * 4, stream);
#endif
    Args a{};
    for (int i = 0; i < 23; ++i) a.in[i] = (const float*)d_in[i];
    a.out = (float*)d_out; a.ws = (unsigned char*)d_ws;
#if MK_N_LAUNCHES == 1
    a.ph_lo = 0; a.ph_hi = NPHASE;
    hipLaunchKernelGGL(fwd_kernel, dim3(grid), dim3(NTHR), LDS_BYTES, stream, a);
#else
    for (int p = 0; p < NPHASE; ++p) {
#ifdef DBG_PH_MASK
        if (!((DBG_PH_MASK >> p) & 1)) continue;
#endif
        a.ph_lo = p; a.ph_hi = p + 1; hipLaunchKernelGGL(fwd_kernel, dim3(grid), dim3(NTHR), LDS_BYTES, stream, a); }
#endif
}
```

```cpp
#include <hip/hip_runtime.h>
#include <cstdio>
#include <cstdint>

#define LAS __attribute__((address_space(3)))
typedef unsigned short bf16_t;
typedef short bf16x8 __attribute__((ext_vector_type(8)));
typedef float f32x4 __attribute__((ext_vector_type(4)));
typedef float f32x2 __attribute__((ext_vector_type(2)));
typedef unsigned u32x4 __attribute__((ext_vector_type(4)));
typedef unsigned u32x2 __attribute__((ext_vector_type(2)));

constexpr int D = 4096, LP = 16384, LS = 8192, L = LP + LS;
constexpr int GRIDW = 64, HD = 128, NH = 16, NAW = 2048, LW = 2048, NBLK = 16, BW = 128, DFF = 11008, INW = 10240;
constexpr float EPS = 1e-6f;
constexpr int NWAVES = 8, NTHR = 512;

constexpr size_t MiB = 1u << 20;
constexpr size_t WS_CTL = 0, CTL_ZERO_BYTES = 64 * 1024;
constexpr size_t WS_RSTD = 1 * MiB;
constexpr size_t WS_RS1 = 1 * MiB + 128 * 1024;
constexpr size_t WS_RS2 = 1 * MiB + 256 * 1024;
constexpr size_t WS_CS = 1 * MiB + 384 * 1024;
constexpr size_t WS_SUM = 2 * MiB;
constexpr size_t WS_WCAT = 8 * MiB;
constexpr size_t WS_W8 = 40 * MiB;
constexpr size_t WS_WVT = 88 * MiB;
constexpr size_t WS_XN8 = 96 * MiB;
constexpr size_t WS_WNO = 192 * MiB;
constexpr size_t WS_WLO = 208 * MiB;
constexpr size_t WS_WO = 224 * MiB;
constexpr size_t WS_WGU = 256 * MiB;
constexpr size_t WS_WD = 342 * MiB;
constexpr size_t WS_WG = 428 * MiB;
constexpr size_t WS_XN = 430 * MiB;
constexpr size_t WS_Q = 622 * MiB;
constexpr size_t WS_XR = 718 * MiB;
constexpr size_t WS_K = 814 * MiB;
constexpr size_t WS_VT = 910 * MiB;
constexpr size_t WS_GR = 1006 * MiB;
constexpr size_t WS_XC = 1102 * MiB;
constexpr size_t WS_END = 1198 * MiB;
constexpr int CS_QKM = 0, CS_V = 12288, CS_GU = 12288 + 2048;
constexpr size_t WS_T1 = WS_K;
constexpr size_t WS_MIX = WS_GR;
constexpr size_t WS_HIDS = WS_Q;
constexpr size_t WS_F = WS_K;
constexpr size_t WS_HF = WS_K;

#define LDS_WAIT() asm volatile("s_waitcnt lgkmcnt(0)" ::: "memory")
#define VM_WAIT() asm volatile("s_waitcnt vmcnt(0)" ::: "memory")
typedef __bf16 bf16x2n_t __attribute__((ext_vector_type(2)));
__device__ __forceinline__ unsigned pk2(float lo, float hi) { const bf16x2n_t r = __builtin_convertvector((f32x2){lo, hi}, bf16x2n_t); return __builtin_bit_cast(unsigned, r); }
__device__ __forceinline__ unsigned f2bf(float f) { return pk2(f, 0.f) & 0xffffu; }
__device__ __forceinline__ float bflo(unsigned u) { return __builtin_bit_cast(float, u << 16); }
__device__ __forceinline__ float bfhi(unsigned u) { return __builtin_bit_cast(float, u & 0xffff0000u); }
__device__ __forceinline__ float bf1(bf16_t u) { return __builtin_bit_cast(float, (unsigned)u << 16); }
__device__ __forceinline__ float wave_sum(float v) {
#pragma unroll
    for (int o = 1; o < 64; o <<= 1) v += __shfl_xor(v, o);
    return v;
}
__device__ __forceinline__ float wave_max(float v) {
#pragma unroll
    for (int o = 1; o < 64; o <<= 1) v = fmaxf(v, __shfl_xor(v, o));
    return v;
}
__device__ __forceinline__ float sigmoidf_(float v) { return __builtin_amdgcn_rcpf(1.0f + __expf(-v)); }
__device__ __forceinline__ float gelu_tanh(float v) { const float y = 0.7978845608f * (v + 0.044715f * v * v * v); const float e = __expf(2.0f * y); return 0.5f * v * (2.0f - 2.0f * __builtin_amdgcn_rcpf(e + 1.0f)); }

namespace pg8 {
constexpr int BM = 256, BK = 64, HALF = 128, HTB = HALF * BK * 2  , STAGE_BYTES = 8 * HTB, NXCD = 8, WGM = 4;

__host__ __device__ __forceinline__ int lds_byte(int r, int c) { return (r >> 3) * 1024 + (r & 7) * 128 + ((((c >> 3) ^ r) & 7) << 4) + (c & 7) * 2; }
__host__ __device__ __forceinline__ void stage_rc(int b, int& R, int& C) { const int ch = b >> 10, rr = (b >> 7) & 7, slot = (b >> 4) & 7; R = ch * 8 + rr; C = ((slot ^ rr) & 7) * 8; }
__host__ __device__ __forceinline__ int perm32(int rho) { const int n = rho >> 4, i = rho & 15; return 8 * (i >> 2) + 4 * n + (i & 3); }

struct Unit { int pm, pn; };
struct Gemm {
    const bf16_t* A; const bf16_t* A2; int pm_split; const bf16_t* Bt; int M, N, rb;
    __device__ __forceinline__ const char* abase(int pm) const { const size_t t = (size_t)BM * rb; return pm < pm_split ? (const char*)A + (size_t)pm * t : (const char*)A2 + (size_t)(pm - pm_split) * t; }
    __device__ __forceinline__ const char* bbase(int pn) const { return (const char*)Bt + (size_t)pn * BM * rb; }
};

struct StaticOrder {
    int nM, nN, nwg, G, c;
    __host__ __device__ void init(int M, int N, int G_, int c_) { nM = M / BM; nN = N / BM; nwg = nM * nN; G = G_; c = c_; }
    __host__ __device__ bool next(int i, Unit& u) const {
        const long Lx = (long)i * G + c; if (Lx >= nwg) return false;
        int wgid = (int)Lx; { const int q = nwg / NXCD, r = nwg % NXCD, xcd = wgid % NXCD, off = wgid / NXCD; wgid = (xcd < r ? xcd * (q + 1) : r * (q + 1) + (xcd - r) * q) + off; }
        const int nig = WGM * nN, gid = wgid / nig, fm = gid * WGM, gsz = (nM - fm) < WGM ? (nM - fm) : WGM;
        u.pm = fm + ((wgid % nig) % gsz); u.pn = (wgid % nig) / gsz; return true;
    }
    __device__ __forceinline__ void a_ready(const Unit&) const {}
    __device__ __forceinline__ void done(const Unit&) const {}
};

typedef int v8i32 __attribute__((ext_vector_type(8)));
typedef int v4i32 __attribute__((ext_vector_type(4)));
typedef __bf16 bf16x2_t __attribute__((ext_vector_type(2)));
__device__ __forceinline__ unsigned cvt_pk_bf16(float lo, float hi) { const bf16x2_t r = __builtin_convertvector((f32x2){lo, hi}, bf16x2_t); return __builtin_bit_cast(unsigned, r); }
__device__ __forceinline__ u32x4 pack8(const f32x4 v0, const f32x4 v1) { u32x4 w; w.x = cvt_pk_bf16(v0[0], v0[1]); w.y = cvt_pk_bf16(v0[2], v0[3]); w.z = cvt_pk_bf16(v1[0], v1[1]); w.w = cvt_pk_bf16(v1[2], v1[3]); return w; }
__device__ __forceinline__ void unpack8(const u32x4 w, f32x4& v0, f32x4& v1) { v0 = (f32x4){bflo(w.x), bfhi(w.x), bflo(w.y), bfhi(w.y)}; v1 = (f32x4){bflo(w.z), bfhi(w.z), bflo(w.w), bfhi(w.w)}; }
__device__ __forceinline__ f32x4 sig4(const f32x4 v) { f32x4 r; r[0] = sigmoidf_(v[0]); r[1] = sigmoidf_(v[1]); r[2] = sigmoidf_(v[2]); r[3] = sigmoidf_(v[3]); return r; }

struct EpiPlain {
    static constexpr bool PERM = true, AFTER_DRAIN = false;
    bf16_t* O; int ldc;
    __device__ __forceinline__ void operator()(const f32x4 (&acc)[2][2][4][2], const Unit& u, int wr, int wc, int fr, int fq) const {
        const int row0 = u.pm * BM + wr * 64 + fr, col0 = u.pn * BM + wc * 32 + 8 * fq;
#pragma unroll
        for (int ai = 0; ai < 2; ++ai)
#pragma unroll
            for (int m = 0; m < 4; ++m) { bf16_t* rowp = O + (size_t)(row0 + ai * HALF + m * 16) * ldc + col0;
#pragma unroll
                for (int bj = 0; bj < 2; ++bj) *(u32x4*)(rowp + bj * HALF) = pack8(acc[ai][bj][m][0], acc[ai][bj][m][1]); }
    }
};
struct EpiVT {
    static constexpr bool PERM = true, AFTER_DRAIN = false;
    bf16_t* O;
    __device__ __forceinline__ void operator()(const f32x4 (&acc)[2][2][4][2], const Unit& u, int wr, int wc, int fr, int fq) const {
        const int row0 = u.pm * BM + wr * 64 + fr, col0 = u.pn * BM + wc * 32 + 8 * fq;
#pragma unroll
        for (int ai = 0; ai < 2; ++ai)
#pragma unroll
            for (int m = 0; m < 4; ++m) { const int row = row0 + ai * HALF + m * 16, hh = row >> 7, d = row & 127;
                const int dt = 2 * (d >> 5) + ((d >> 2) & 1), i = 4 * ((d >> 3) & 3) + (d & 3);
#pragma unroll
                for (int bj = 0; bj < 2; ++bj) { const int tok = col0 + bj * HALF, R = tok >> 6, o = (tok & 63) >> 3;
                    *(u32x4*)(O + ((size_t)((((R * 16 + hh) * 8 + dt) * 8 + o) * 16 + i)) * 8) = pack8(acc[ai][bj][m][0], acc[ai][bj][m][1]); } }
    }
};
struct EpiProj {
    static constexpr bool PERM = true, AFTER_DRAIN = false;
    bf16_t* P0; bf16_t* P1; bf16_t* P2; bf16_t* P3; bf16_t* G; const float* bias; int pn_gate0;
    __device__ __forceinline__ void operator()(const f32x4 (&acc)[2][2][4][2], const Unit& u, int wr, int wc, int fr, int fq) const {
        const int row0 = u.pm * BM + wr * 64 + fr;
        if (u.pn < pn_gate0) {
            const int t = u.pn >> 3; bf16_t* base = t == 0 ? P0 : (t == 1 ? P1 : (t == 2 ? P2 : P3));
            const int col0 = (u.pn & 7) * BM + wc * 32 + 8 * fq;
            if (t == 2) {
#pragma unroll
                for (int ai = 0; ai < 2; ++ai)
#pragma unroll
                    for (int m = 0; m < 4; ++m) { const int tok = row0 + ai * HALF + m * 16, R = tok >> 6, cl = tok & 63;
                        const int tokpart = (((cl >> 2) & 1) * 8 + (cl >> 3)) * 4 + (cl & 3);
#pragma unroll
                        for (int bj = 0; bj < 2; ++bj) { const int c = col0 + bj * HALF, hh = c >> 7, d0 = c & 127;
                            *(u32x4*)(base + ((size_t)(((R * 16 + hh) * 4 + (d0 >> 5)) * 64 + tokpart) * 4 + ((d0 >> 3) & 3)) * 8) = pack8(acc[ai][bj][m][0], acc[ai][bj][m][1]); } }
            } else {
#pragma unroll
            for (int ai = 0; ai < 2; ++ai)
#pragma unroll
                for (int m = 0; m < 4; ++m) { bf16_t* rowp = base + (size_t)(row0 + ai * HALF + m * 16) * NAW + col0;
#pragma unroll
                    for (int bj = 0; bj < 2; ++bj) *(u32x4*)(rowp + bj * HALF) = pack8(acc[ai][bj][m][0], acc[ai][bj][m][1]); }
            }
        } else {
            const int col0 = (u.pn - pn_gate0) * BM + wc * 32 + 8 * fq;
            f32x4 bv[2][2];
#pragma unroll
            for (int bj = 0; bj < 2; ++bj)
#pragma unroll
                for (int n = 0; n < 2; ++n) bv[bj][n] = *(const f32x4*)(bias + col0 + bj * HALF + 4 * n);
#pragma unroll
            for (int ai = 0; ai < 2; ++ai)
#pragma unroll
                for (int m = 0; m < 4; ++m) { bf16_t* rowp = G + (size_t)(row0 + ai * HALF + m * 16) * (2 * D) + col0;
#pragma unroll
                    for (int bj = 0; bj < 2; ++bj) *(u32x4*)(rowp + bj * HALF) = pack8(sig4(acc[ai][bj][m][0] + bv[bj][0]), sig4(acc[ai][bj][m][1] + bv[bj][1])); }
        }
    }
};
template <bool ADD> struct EpiMulG {
    static constexpr bool PERM = true, AFTER_DRAIN = false;
    bf16_t* O; const bf16_t* G; int goff;
    __device__ __forceinline__ void operator()(const f32x4 (&acc)[2][2][4][2], const Unit& u, int wr, int wc, int fr, int fq) const {
        const int row0 = u.pm * BM + wr * 64 + fr, col0 = u.pn * BM + wc * 32 + 8 * fq;
#pragma unroll
        for (int ai = 0; ai < 2; ++ai)
#pragma unroll
            for (int m = 0; m < 4; ++m) { const size_t row = (size_t)(row0 + ai * HALF + m * 16); bf16_t* rowp = O + row * D + col0; const bf16_t* gp = G + row * (2 * D) + goff + col0;
#pragma unroll
                for (int bj = 0; bj < 2; ++bj) {
                    f32x4 g0, g1; unpack8(*(const u32x4*)(gp + bj * HALF), g0, g1);
                    f32x4 v0 = acc[ai][bj][m][0] * g0, v1 = acc[ai][bj][m][1] * g1;
                    if (ADD) { f32x4 t0, t1; unpack8(*(const u32x4*)(rowp + bj * HALF), t0, t1); v0 += t0; v1 += t1; }
                    *(u32x4*)(rowp + bj * HALF) = pack8(v0, v1); } }
    }
};
struct EpiSwiglu {
    static constexpr bool PERM = true, AFTER_DRAIN = false;
    bf16_t* H0; bf16_t* H1; int pm_split;
    __device__ __forceinline__ void operator()(const f32x4 (&acc)[2][2][4][2], const Unit& u, int wr, int wc, int fr, int fq) const {
        bf16_t* base = u.pm < pm_split ? H0 + (size_t)u.pm * BM * DFF : H1 + (size_t)(u.pm - pm_split) * BM * DFF;
        const int row0 = wr * 64 + fr, col0 = u.pn * HALF + wc * 32 + 8 * fq;
#pragma unroll
        for (int ai = 0; ai < 2; ++ai)
#pragma unroll
            for (int m = 0; m < 4; ++m) {
                f32x4 h[2];
#pragma unroll
                for (int n = 0; n < 2; ++n) { const f32x4 g = acc[ai][0][m][n], up = acc[ai][1][m][n];
#pragma unroll
                    for (int j = 0; j < 4; ++j) h[n][j] = g[j] * sigmoidf_(g[j]) * up[j]; }
                *(u32x4*)(base + (size_t)(row0 + ai * HALF + m * 16) * DFF + col0) = pack8(h[0], h[1]); }
    }
};

__device__ __forceinline__ f32x4 deq4(const f32x4 accbits, const float sa, const f32x4 sb) { const v4i32 q = __builtin_bit_cast(v4i32, accbits); return (f32x4){(float)q.x, (float)q.y, (float)q.z, (float)q.w} * sa * sb; }
struct EpiProjQ {
    static constexpr bool PERM = true, AFTER_DRAIN = false;
    bf16_t* Qb; bf16_t* Kb; bf16_t* G; const float* bias; const float* sa; const float* sb;
    __device__ __forceinline__ void operator()(const f32x4 (&acc)[2][2][4][2], const Unit& u, int wr, int wc, int fr, int fq) const {
        const int row0 = u.pm * BM + wr * 64 + fr, cg0 = u.pn * BM + wc * 32 + 8 * fq;
        f32x4 sbv[2][2];
#pragma unroll
        for (int bj = 0; bj < 2; ++bj)
#pragma unroll
            for (int n = 0; n < 2; ++n) sbv[bj][n] = *(const f32x4*)(sb + cg0 + bj * HALF + 4 * n);
        if (u.pn < 8) {
            const int col0 = u.pn * BM + wc * 32 + 8 * fq;
#pragma unroll
            for (int ai = 0; ai < 2; ++ai)
#pragma unroll
                for (int m = 0; m < 4; ++m) { const int row = row0 + ai * HALF + m * 16; const float sr = sa[row]; bf16_t* rowp = Qb + (size_t)row * NAW + col0;
#pragma unroll
                    for (int bj = 0; bj < 2; ++bj) *(u32x4*)(rowp + bj * HALF) = pack8(deq4(acc[ai][bj][m][0], sr, sbv[bj][0]), deq4(acc[ai][bj][m][1], sr, sbv[bj][1])); }
        } else if (u.pn < 16) {
            const int col0 = (u.pn - 8) * BM + wc * 32 + 8 * fq;
#pragma unroll
            for (int ai = 0; ai < 2; ++ai)
#pragma unroll
                for (int m = 0; m < 4; ++m) { const int tok = row0 + ai * HALF + m * 16, R = tok >> 6, cl = tok & 63; const float sr = sa[tok];
                    const int tokpart = (((cl >> 2) & 1) * 8 + (cl >> 3)) * 4 + (cl & 3);
#pragma unroll
                    for (int bj = 0; bj < 2; ++bj) { const int c = col0 + bj * HALF, hh = c >> 7, d0 = c & 127;
                        *(u32x4*)(Kb + ((size_t)(((R * 16 + hh) * 4 + (d0 >> 5)) * 64 + tokpart) * 4 + ((d0 >> 3) & 3)) * 8) = pack8(deq4(acc[ai][bj][m][0], sr, sbv[bj][0]), deq4(acc[ai][bj][m][1], sr, sbv[bj][1])); } }
        } else {
            const int col0 = (u.pn - 16) * BM + wc * 32 + 8 * fq;
            f32x4 bv[2][2];
#pragma unroll
            for (int bj = 0; bj < 2; ++bj)
#pragma unroll
                for (int n = 0; n < 2; ++n) bv[bj][n] = *(const f32x4*)(bias + col0 + bj * HALF + 4 * n);
#pragma unroll
            for (int ai = 0; ai < 2; ++ai)
#pragma unroll
                for (int m = 0; m < 4; ++m) { const int row = row0 + ai * HALF + m * 16; const float sr = sa[row]; bf16_t* rowp = G + (size_t)row * (2 * D) + col0;
#pragma unroll
                    for (int bj = 0; bj < 2; ++bj) *(u32x4*)(rowp + bj * HALF) = pack8(sig4(deq4(acc[ai][bj][m][0], sr, sbv[bj][0]) + bv[bj][0]), sig4(deq4(acc[ai][bj][m][1], sr, sbv[bj][1]) + bv[bj][1])); }
        }
    }
};
struct EpiVTQ {
    static constexpr bool PERM = true, AFTER_DRAIN = false;
    bf16_t* O; const float* sa; const float* sb;
    __device__ __forceinline__ void operator()(const f32x4 (&acc)[2][2][4][2], const Unit& u, int wr, int wc, int fr, int fq) const {
        const int row0 = u.pm * BM + wr * 64 + fr, col0 = u.pn * BM + wc * 32 + 8 * fq;
        f32x4 sbv[2][2];
#pragma unroll
        for (int bj = 0; bj < 2; ++bj)
#pragma unroll
            for (int n = 0; n < 2; ++n) sbv[bj][n] = *(const f32x4*)(sb + col0 + bj * HALF + 4 * n);
#pragma unroll
        for (int ai = 0; ai < 2; ++ai)
#pragma unroll
            for (int m = 0; m < 4; ++m) { const int row = row0 + ai * HALF + m * 16, hh = row >> 7, d = row & 127; const float sr = sa[row];
                const int dt = 2 * (d >> 5) + ((d >> 2) & 1), i = 4 * ((d >> 3) & 3) + (d & 3);
#pragma unroll
                for (int bj = 0; bj < 2; ++bj) { const int tok = col0 + bj * HALF, R = tok >> 6, o = (tok & 63) >> 3;
                    *(u32x4*)(O + ((size_t)((((R * 16 + hh) * 8 + dt) * 8 + o) * 16 + i)) * 8) = pack8(deq4(acc[ai][bj][m][0], sr, sbv[bj][0]), deq4(acc[ai][bj][m][1], sr, sbv[bj][1])); } }
    }
};
struct EpiSwigluQ {
    static constexpr bool PERM = true, AFTER_DRAIN = false;
    bf16_t* H0; bf16_t* H1; int pm_split; const float* sa; const float* sb;
    __device__ __forceinline__ void operator()(const f32x4 (&acc)[2][2][4][2], const Unit& u, int wr, int wc, int fr, int fq) const {
        bf16_t* base = u.pm < pm_split ? H0 + (size_t)u.pm * BM * DFF : H1 + (size_t)(u.pm - pm_split) * BM * DFF;
        const int row0 = wr * 64 + fr, col0 = u.pn * HALF + wc * 32 + 8 * fq, cg0 = u.pn * BM + wc * 32 + 8 * fq;
        f32x4 sbv[2][2];
#pragma unroll
        for (int bj = 0; bj < 2; ++bj)
#pragma unroll
            for (int n = 0; n < 2; ++n) sbv[bj][n] = *(const f32x4*)(sb + cg0 + bj * HALF + 4 * n);
#pragma unroll
        for (int ai = 0; ai < 2; ++ai)
#pragma unroll
            for (int m = 0; m < 4; ++m) { const float sr = sa[u.pm * BM + row0 + ai * HALF + m * 16];
                f32x4 h[2];
#pragma unroll
                for (int n = 0; n < 2; ++n) { const f32x4 g = deq4(acc[ai][0][m][n], sr, sbv[0][n]), up = deq4(acc[ai][1][m][n], sr, sbv[1][n]);
#pragma unroll
                    for (int j = 0; j < 4; ++j) h[n][j] = g[j] * sigmoidf_(g[j]) * up[j]; }
                *(u32x4*)(base + (size_t)(row0 + ai * HALF + m * 16) * DFF + col0) = pack8(h[0], h[1]); }
    }
};

__device__ __forceinline__ v8i32 cat8(const bf16x8 lo, const bf16x8 hi) { return __builtin_shufflevector(__builtin_bit_cast(v4i32, lo), __builtin_bit_cast(v4i32, hi), 0, 1, 2, 3, 4, 5, 6, 7); }
__device__ __forceinline__ void mfma_fp8_acc(f32x4& c, const v8i32 a, const v8i32 b, int sa, int sb) {
    asm volatile("v_mfma_scale_f32_16x16x128_f8f6f4 %0, %1, %2, %0, %3, %4 op_sel_hi:[0,0,0]" : "+v"(c) : "v"(a), "v"(b), "v"(sa), "v"(sb)); }
constexpr int FP8_SCALE = 0x73737373;
template <class Epi, class Sched, bool ALIGN_EPI = false, bool SP2 = false, int QM = 0  , int DBG = 0>
__device__ __forceinline__ void gemm_phase(LAS unsigned char* lds, const Gemm g, const Sched& S, const Epi& E) {
    int tid = threadIdx.x; asm volatile("" : "+v"(tid));
    const int wid = __builtin_amdgcn_readfirstlane(tid >> 6), lane = tid & 63, wr = wid >> 2, wc = wid & 3, fr = lane & 15, fq = lane >> 4;
    const int RB = g.rb, nt = RB / (BK * 2);
    unsigned voffA[2], voffB[2];
#pragma unroll
    for (int i = 0; i < 2; ++i) { int R, C; stage_rc(tid * 16 + i * 8192, R, C); const int Rb = Epi::PERM ? ((R & ~31) + perm32(R & 31)) : R;
        voffA[i] = (unsigned)(R * RB + C * 2); voffB[i] = (unsigned)(Rb * RB + C * 2); }
    const size_t kstep = (size_t)(BK * 2);
    const size_t hstep = (size_t)HALF * RB;
    const unsigned ldsw = (unsigned)wid * 1024u;
    const int aoff0 = lds_byte(wr * 64 + fr, fq * 8), aoff1 = lds_byte(wr * 64 + fr, 32 + fq * 8), boff0 = lds_byte(wc * 32 + fr, fq * 8), boff1 = lds_byte(wc * 32 + fr, 32 + fq * 8);
#define PG8_SA(b, h) (((b) * 2 + (h)) * HTB)
#define PG8_SB(b, h) ((4 + (b) * 2 + (h)) * HTB)
#define PG8_STAGE(bufoff, gbase, voff) do { if constexpr (DBG != 3) _Pragma("unroll") for (int _i = 0; _i < 2; ++_i) \
        __builtin_amdgcn_global_load_lds((const unsigned*)((const char*)(gbase) + (voff)[_i]), (LAS unsigned*)(lds + (bufoff) + ldsw + _i * 8192), 16, 0, 0); } while (0)
#define PG8_LDA(dst, b, h) do { if constexpr (DBG != 2) _Pragma("unroll") for (int m = 0; m < 4; ++m) _Pragma("unroll") for (int k = 0; k < 2; ++k) dst[m][k] = *(const LAS bf16x8*)(lds + PG8_SA(b, h) + (k ? aoff1 : aoff0) + m * 2048); } while (0)
#define PG8_LDB(dst, b, h) do { if constexpr (DBG != 2) _Pragma("unroll") for (int n = 0; n < 2; ++n) _Pragma("unroll") for (int k = 0; k < 2; ++k) dst[n][k] = *(const LAS bf16x8*)(lds + PG8_SB(b, h) + (k ? boff1 : boff0) + n * 2048); } while (0)
#define PG8_MMA(ai, bj, At, Bt) do { __builtin_amdgcn_s_setprio(1); if constexpr (DBG == 1) { } else if constexpr (QM == 2) { _Pragma("unroll") for (int m = 0; m < 4; ++m) _Pragma("unroll") for (int n = 0; n < 2; ++n) _Pragma("unroll") for (int k = 0; k < 2; ++k) \
        acc[ai][bj][m][n] = __builtin_bit_cast(f32x4, __builtin_amdgcn_mfma_i32_16x16x64_i8(__builtin_bit_cast(v4i32, Bt[n][k]), __builtin_bit_cast(v4i32, At[m][k]), __builtin_bit_cast(v4i32, acc[ai][bj][m][n]), 0, 0, 0)); } else if constexpr (QM == 1) { _Pragma("unroll") for (int m = 0; m < 4; ++m) _Pragma("unroll") for (int n = 0; n < 2; ++n) \
        mfma_fp8_acc(acc[ai][bj][m][n], cat8(Bt[n][0], Bt[n][1]), cat8(At[m][0], At[m][1]), fp8_sa, fp8_sb); } else { \
        _Pragma("unroll") for (int m = 0; m < 4; ++m) _Pragma("unroll") for (int n = 0; n < 2; ++n) _Pragma("unroll") for (int k = 0; k < 2; ++k) \
        acc[ai][bj][m][n] = __builtin_amdgcn_mfma_f32_16x16x32_bf16(Bt[n][k], At[m][k], acc[ai][bj][m][n], 0, 0, 0); } __builtin_amdgcn_s_setprio(0); } while (0)
#define PG8_WAIT_V(n) asm volatile("s_waitcnt vmcnt(" #n ")" ::: "memory")
#define PG8_WAIT_L(n) asm volatile("s_waitcnt lgkmcnt(" #n ")" ::: "memory")
#define PG8_BAR __builtin_amdgcn_s_barrier()
#define PG8_SCHED __builtin_amdgcn_sched_barrier(0)
    Unit cur, nxt; int ui = 0;
    const int fp8_sa = FP8_SCALE, fp8_sb = 0x7F7F7F7F;
    if (!S.next(0, cur)) return;
    f32x4 acc[2][2][4][2];
#pragma unroll
    for (int a = 0; a < 2; ++a)
#pragma unroll
        for (int b = 0; b < 2; ++b)
#pragma unroll
            for (int m = 0; m < 4; ++m)
#pragma unroll
                for (int n = 0; n < 2; ++n) acc[a][b][m][n] = (f32x4){0.f, 0.f, 0.f, 0.f};
    bf16x8 At[4][2], B0[2][2], B1[2][2];
    const char* cA = g.abase(cur.pm); const char* cB = g.bbase(cur.pn);
    S.a_ready(cur);
    if constexpr (SP2) {
        PG8_STAGE(PG8_SB(0, 0), cB, voffB); PG8_STAGE(PG8_SB(0, 1), cB + hstep, voffB); PG8_STAGE(PG8_SA(0, 0), cA, voffA); PG8_STAGE(PG8_SA(0, 1), cA + hstep, voffA);
        if (wr == 1) PG8_BAR;
        PG8_WAIT_V(2); PG8_BAR;
        PG8_STAGE(PG8_SB(1, 0), cB + kstep, voffB); PG8_STAGE(PG8_SA(1, 0), cA + kstep, voffA); PG8_STAGE(PG8_SB(1, 1), cB + hstep + kstep, voffB);
        PG8_WAIT_V(6); PG8_BAR;
    } else {
        PG8_STAGE(PG8_SB(0, 0), cB, voffB); PG8_STAGE(PG8_SA(0, 0), cA, voffA); PG8_STAGE(PG8_SB(0, 1), cB + hstep, voffB); PG8_STAGE(PG8_SA(0, 1), cA + hstep, voffA);
        if (wr == 1) PG8_BAR;
        PG8_WAIT_V(4); PG8_BAR;
        PG8_STAGE(PG8_SB(1, 0), cB + kstep, voffB); PG8_STAGE(PG8_SA(1, 0), cA + kstep, voffA); PG8_STAGE(PG8_SB(1, 1), cB + hstep + kstep, voffB);
        PG8_WAIT_V(6); PG8_BAR;
    }
    for (;;) {
        const bool has_next = S.next(ui + 1, nxt);
        const char* nA = has_next ? g.abase(nxt.pm) : cA; const char* nB = has_next ? g.bbase(nxt.pn) : cB;
        for (int t = 0; t < nt; t += 2) {
            const bool last = (t == nt - 2);
            const char* a1 = cA + (size_t)(t + 1) * kstep;
            const char* a2 = last ? nA : cA + (size_t)(t + 2) * kstep; const char* b2 = last ? nB : cB + (size_t)(t + 2) * kstep;
            const char* a3 = a2 + kstep; const char* b3 = b2 + kstep;
            if (last && has_next) S.a_ready(nxt);
            if constexpr (SP2) {
            PG8_LDB(B0, 0, 0); PG8_LDB(B1, 0, 1); PG8_SCHED; PG8_LDA(At, 0, 0); PG8_STAGE(PG8_SA(1, 1), a1 + hstep, voffA);
            PG8_WAIT_V(8); PG8_WAIT_L(0); PG8_BAR; PG8_MMA(0, 0, At, B0); PG8_MMA(0, 1, At, B1); PG8_BAR; PG8_SCHED;
            PG8_LDA(At, 0, 1); PG8_STAGE(PG8_SB(0, 0), b2, voffB); PG8_STAGE(PG8_SB(0, 1), b2 + hstep, voffB); PG8_STAGE(PG8_SA(0, 0), a2, voffA);
            PG8_WAIT_V(8); PG8_WAIT_L(0); PG8_BAR; PG8_MMA(1, 0, At, B0); PG8_MMA(1, 1, At, B1); PG8_BAR; PG8_SCHED;
            PG8_LDB(B0, 1, 0); PG8_LDB(B1, 1, 1); PG8_SCHED; PG8_LDA(At, 1, 0); PG8_STAGE(PG8_SA(0, 1), a2 + hstep, voffA);
            PG8_WAIT_V(8); PG8_WAIT_L(0); PG8_BAR; PG8_MMA(0, 0, At, B0); PG8_MMA(0, 1, At, B1); PG8_BAR; PG8_SCHED;
            PG8_LDA(At, 1, 1); PG8_STAGE(PG8_SB(1, 0), b3, voffB); PG8_STAGE(PG8_SB(1, 1), b3 + hstep, voffB); PG8_STAGE(PG8_SA(1, 0), a3, voffA);
            PG8_WAIT_V(8); PG8_WAIT_L(0); PG8_BAR; PG8_MMA(1, 0, At, B0); PG8_MMA(1, 1, At, B1); PG8_BAR; PG8_SCHED;
            } else {
            PG8_LDB(B0, 0, 0); PG8_SCHED; PG8_LDA(At, 0, 0); PG8_STAGE(PG8_SA(1, 1), a1 + hstep, voffA);
            PG8_WAIT_L(8); PG8_BAR; PG8_WAIT_L(0); PG8_MMA(0, 0, At, B0); PG8_BAR; PG8_SCHED;
            PG8_LDB(B1, 0, 1); PG8_STAGE(PG8_SB(0, 0), b2, voffB);
            PG8_BAR; PG8_WAIT_L(0); PG8_MMA(0, 1, At, B1); PG8_BAR;
            PG8_LDA(At, 0, 1); PG8_STAGE(PG8_SA(0, 0), a2, voffA);
            PG8_BAR; PG8_WAIT_L(0); PG8_MMA(1, 0, At, B0); PG8_BAR; PG8_SCHED;
            PG8_STAGE(PG8_SB(0, 1), b2 + hstep, voffB);
            PG8_WAIT_V(6); PG8_BAR; PG8_MMA(1, 1, At, B1); PG8_BAR;
            PG8_LDB(B0, 1, 0); PG8_SCHED; PG8_LDA(At, 1, 0); PG8_STAGE(PG8_SA(0, 1), a2 + hstep, voffA);
            PG8_WAIT_L(8); PG8_BAR; PG8_WAIT_L(0); PG8_MMA(0, 0, At, B0); PG8_BAR; PG8_SCHED;
            PG8_LDB(B1, 1, 1); PG8_STAGE(PG8_SB(1, 0), b3, voffB);
            PG8_BAR; PG8_WAIT_L(0); PG8_MMA(0, 1, At, B1); PG8_BAR;
            PG8_LDA(At, 1, 1); PG8_STAGE(PG8_SA(1, 0), a3, voffA);
            PG8_BAR; PG8_WAIT_L(0); PG8_MMA(1, 0, At, B0); PG8_BAR; PG8_SCHED;
            PG8_STAGE(PG8_SB(1, 1), b3 + hstep, voffB);
            PG8_WAIT_V(6); PG8_BAR; PG8_MMA(1, 1, At, B1); PG8_BAR;
            }
        }
        if constexpr (ALIGN_EPI) { if (wr == 0) PG8_BAR; }
        if constexpr (!Epi::AFTER_DRAIN) { if constexpr (DBG != 4) E(acc, cur, wr, wc, fr, fq); else { _Pragma("unroll") for (int a_ = 0; a_ < 2; ++a_) _Pragma("unroll") for (int b_ = 0; b_ < 2; ++b_) _Pragma("unroll") for (int m_ = 0; m_ < 4; ++m_) _Pragma("unroll") for (int n_ = 0; n_ < 2; ++n_) asm volatile("" :: "v"(acc[a_][b_][m_][n_])); } S.done(cur); }
        if (!has_next) break;
#pragma unroll
        for (int a = 0; a < 2; ++a)
#pragma unroll
            for (int b = 0; b < 2; ++b)
#pragma unroll
                for (int m = 0; m < 4; ++m)
#pragma unroll
                    for (int n = 0; n < 2; ++n) acc[a][b][m][n] = (f32x4){0.f, 0.f, 0.f, 0.f};
        cur = nxt; cA = nA; cB = nB; ++ui;
        if constexpr (ALIGN_EPI) { if (wr == 1) PG8_BAR; }
    }
    PG8_WAIT_V(0);
    if constexpr (!ALIGN_EPI) { if (wr == 0) PG8_BAR; }
    PG8_BAR;
    if constexpr (Epi::AFTER_DRAIN) { E.fused(acc, cur, wr, wc, fr, fq, lds, wid, lane); S.done(cur); }
#undef PG8_SA
#undef PG8_SB
#undef PG8_STAGE
#undef PG8_LDA
#undef PG8_LDB
#undef PG8_MMA
#undef PG8_WAIT_V
#undef PG8_WAIT_L
#undef PG8_BAR
#undef PG8_SCHED
}
}
#define XB_TMO      128
#define XB_XCNT(j)  (256  + 64 * (j))
#define XB_XSUB(j)  (1280 + 64 * (j))
#define XB_XGEN(j)  (2304 + 64 * (j))
#define XB_TOP      3328
#define XB_TOPGEN   3392
#define XCD_BAR_WORDS 3456
#define XB_SPIN_CAP (1u << 18)

__device__ __forceinline__ unsigned xb_ld(unsigned* p)              { return __hip_atomic_load(p, __ATOMIC_RELAXED, __HIP_MEMORY_SCOPE_AGENT); }
__device__ __forceinline__ unsigned xb_add(unsigned* p, unsigned v) { return __hip_atomic_fetch_add(p, v, __ATOMIC_RELAXED, __HIP_MEMORY_SCOPE_AGENT); }
__device__ __forceinline__ unsigned xb_xcc_id() { return (unsigned)__builtin_amdgcn_s_getreg((3 << 11) | 20) & 0xFu; }
#define XB_SPIN(cond, bar) do { unsigned _sp = 0; while (cond) { __builtin_amdgcn_s_sleep(1); \
    if ((++_sp & 255u) == 0u) { if (xb_ld(&(bar)[XB_TMO])) break; if (_sp > XB_SPIN_CAP) { atomicAdd(&(bar)[XB_TMO], 1u); break; } } } } while (0)

struct XcdBarrier {
    unsigned* bar; unsigned x;
    volatile LAS unsigned* st;
};

__device__ __forceinline__ XcdBarrier xcd_barrier_post(unsigned* bar, volatile LAS unsigned* st) {
    XcdBarrier b; b.bar = bar; b.x = xb_xcc_id(); b.st = st;
    if (threadIdx.x == 0) (void)xb_add(&bar[XB_XCNT(b.x)], 1u);
    return b;
}
__device__ __forceinline__ void xcd_barrier_complete(unsigned* bar, unsigned x, unsigned& nloc, unsigned& nx) {
    const unsigned G = gridDim.x * gridDim.y * gridDim.z;
    unsigned sum, cnt, mine, sp = 0u;
    for (;;) {
        sum = 0u; cnt = 0u; mine = 0u;
#pragma unroll
        for (unsigned j = 0; j < 16; ++j) { const unsigned c = xb_ld(&bar[XB_XCNT(j)]); sum += c; cnt += (c > 0u) ? 1u : 0u; mine = (j == x) ? c : mine; }
        if (sum == G) break;
        __builtin_amdgcn_s_sleep(1);
        if ((++sp & 255u) == 0u) { if (xb_ld(&bar[XB_TMO])) break; if (sp > XB_SPIN_CAP) { atomicAdd(&bar[XB_TMO], 1u); break; } }
    }
    nloc = mine > 0u ? mine : 1u; nx = cnt > 0u ? cnt : 1u;
}

__device__ __forceinline__ void xcd_barrier(const XcdBarrier& b) {
    asm volatile("s_waitcnt vmcnt(0)" ::: "memory");
    __syncthreads();
    if (threadIdx.x == 0) {
        unsigned* bar = b.bar;
        __builtin_amdgcn_s_waitcnt(0);
        unsigned nloc = b.st[0], nx = b.st[1];
        if (nloc == 0u) { xcd_barrier_complete(bar, b.x, nloc, nx); b.st[0] = nloc; b.st[1] = nx; }
        const unsigned old = xb_add(&bar[XB_XSUB(b.x)], 1u);
        const unsigned gen = old / nloc;
        if (old + 1u == (gen + 1u) * nloc) {
            __builtin_amdgcn_fence(__ATOMIC_RELEASE, "agent");
            asm volatile("s_waitcnt vmcnt(0)" ::: "memory");
            const unsigned og = xb_add(&bar[XB_TOP], 1u);
            const unsigned tg = og / nx;
            if (og + 1u == (tg + 1u) * nx) xb_add(&bar[XB_TOPGEN], 1u);
            else XB_SPIN(xb_ld(&bar[XB_TOPGEN]) == tg, bar);
            __builtin_amdgcn_fence(__ATOMIC_ACQUIRE, "agent");
            xb_add(&bar[XB_XGEN(b.x)], 1u);
            asm volatile("s_waitcnt vmcnt(0)" ::: "memory");
        } else {
            XB_SPIN(xb_ld(&bar[XB_XGEN(b.x)]) == gen, bar);
            __builtin_amdgcn_fence(__ATOMIC_ACQUIRE, "agent");
            asm volatile("s_waitcnt vmcnt(0)" ::: "memory");
        }
    }
    __syncthreads();
}


struct Frame {
    LAS unsigned char* lds;
    int tid, lane, wave, G, gw, ngw;
    const float *in_XP, *in_XS, *in_WIN, *in_WCONV, *in_BCONV, *in_WR, *in_BR, *in_WI, *in_BI, *in_LAM, *in_RPB, *in_WNO, *in_WLO, *in_WM, *in_BM, *in_WOUT, *in_GMPRE, *in_GMPOST, *in_GFPRE, *in_GFPOST, *in_WFG, *in_WFU, *in_WFD; float* out; unsigned char* ws;
};
enum { I_XP = 0, I_XS, I_WIN, I_WCONV, I_BCONV, I_WR, I_BR, I_WI, I_BI, I_LAM, I_RPB, I_WNO, I_WLO, I_WM, I_BM, I_WOUT, I_GMPRE, I_GMPOST, I_GFPRE, I_GFPOST, I_WFG, I_WFU, I_WFD };
__device__ __forceinline__ int opaque(int x) { asm volatile("" : "+v"(x)); return x; }
template <class T> __device__ __forceinline__ T* wsp(const Frame& F, size_t off) { return (T*)(F.ws + off); }
__device__ __forceinline__ const float* xrow(const Frame& F, int m) { return m < LP ? F.in_XP + (size_t)m * D : F.in_XS + (size_t)(m - LP) * D; }

__device__ __forceinline__ void tr_item(const float* src, int ldsrc, int k0, int n0, bf16_t* dst, int ldd, int drow0, LAS float* scr, int lane) {
#pragma unroll 8
    for (int i = 0; i < 32; ++i) { const int kk = 2 * i + (lane >> 5); scr[kk * 33 + (lane & 31)] = src[(size_t)(k0 + kk) * ldsrc + n0 + (lane & 31)]; }
    LDS_WAIT(); asm volatile("" ::: "memory");
    const int c = lane & 7;
#pragma unroll
    for (int j = 0; j < 4; ++j) { const int n = (lane >> 3) + 8 * j; const LAS float* s = scr + (8 * c) * 33 + n;
        u32x4 o; o.x = pk2(s[0 * 33], s[1 * 33]); o.y = pk2(s[2 * 33], s[3 * 33]); o.z = pk2(s[4 * 33], s[5 * 33]); o.w = pk2(s[6 * 33], s[7 * 33]);
        *(u32x4*)(dst + (size_t)(drow0 + n) * ldd + k0 + 8 * c) = o; }
    LDS_WAIT(); asm volatile("" ::: "memory");
}
__device__ __forceinline__ unsigned pk4_fp8(float a, float b, float c, float d) { int p = __builtin_amdgcn_cvt_pk_fp8_f32(a, b, 0, false); p = __builtin_amdgcn_cvt_pk_fp8_f32(c, d, p, true); return (unsigned)p; }
__device__ __forceinline__ void tr_item8(const float* src, int ldsrc, int k0, int n0, unsigned char* dst, int ldd, int drow0, LAS float* scr, int lane) {
#pragma unroll 8
    for (int i = 0; i < 32; ++i) { const int kk = 2 * i + (lane >> 5); scr[kk * 33 + (lane & 31)] = src[(size_t)(k0 + kk) * ldsrc + n0 + (lane & 31)]; }
    LDS_WAIT(); asm volatile("" ::: "memory");
    const int c = lane & 7;
#pragma unroll
    for (int j = 0; j < 4; ++j) { const int n = (lane >> 3) + 8 * j; const LAS float* s = scr + (8 * c) * 33 + n;
        u32x2 o; o.x = pk4_fp8(s[0 * 33] * 256.f, s[1 * 33] * 256.f, s[2 * 33] * 256.f, s[3 * 33] * 256.f); o.y = pk4_fp8(s[4 * 33] * 256.f, s[5 * 33] * 256.f, s[6 * 33] * 256.f, s[7 * 33] * 256.f);
        *(u32x2*)(dst + (size_t)(drow0 + n) * ldd + k0 + 8 * c) = o; }
    LDS_WAIT(); asm volatile("" ::: "memory");
}
__device__ __forceinline__ unsigned pk4_i8(float a, float b, float c, float d) { return ((unsigned)(int)a & 255u) | (((unsigned)(int)b & 255u) << 8) | (((unsigned)(int)c & 255u) << 16) | ((unsigned)(int)d << 24); }
__device__ __forceinline__ void tr_strip_i8(const float* src, int ldsrc, int K, int n0, signed char* dst, int drow0, float* cs, LAS float* scr, int lane) {
    const float* sp = src + n0 + (lane & 31) + (size_t)(lane >> 5) * ldsrc;
    float mx = 0.f;
    { const float* p = sp; const size_t step = (size_t)2 * ldsrc;
      for (int k0 = 0; k0 < K; k0 += 16) {
#pragma unroll
        for (int i = 0; i < 8; ++i) { mx = fmaxf(mx, fabsf(*p)); p += step; }
      } }
    mx = fmaxf(mx, __shfl_xor(mx, 32));
    const float amax = fmaxf(mx, 1e-20f), inv = 127.0f / amax;
    if (lane < 32) cs[drow0 + lane] = amax * (1.0f / 127.0f);
    const int c = lane & 7;
    for (int k0 = 0; k0 < K; k0 += 64) {
        { const float* p = sp + (size_t)k0 * ldsrc; const size_t step = (size_t)2 * ldsrc; LAS float* w = scr + (lane >> 5) * 33 + (lane & 31);
#pragma unroll 8
          for (int i = 0; i < 32; ++i) { w[i * 66] = rintf(*p * inv); p += step; } }
        LDS_WAIT(); asm volatile("" ::: "memory");
#pragma unroll
        for (int j = 0; j < 4; ++j) { const int n = (lane >> 3) + 8 * j; const LAS float* t = scr + (8 * c) * 33 + n;
            u32x2 o; o.x = pk4_i8(t[0 * 33], t[1 * 33], t[2 * 33], t[3 * 33]); o.y = pk4_i8(t[4 * 33], t[5 * 33], t[6 * 33], t[7 * 33]);
            *(u32x2*)(dst + (size_t)(drow0 + n) * K + k0 + 8 * c) = o; }
        LDS_WAIT(); asm volatile("" ::: "memory");
    }
}
#define TR_JOB(SRC, LDSRC, KK, NN, DST, DROW_EXPR) { const int nblk = (NN) / 32, nit = ((KK) / 64) * nblk; \
    if (r < nit) { const int kb = r / nblk, nb = r % nblk, n0 = 32 * nb; tr_item((SRC), (LDSRC), 64 * kb, n0, (DST), (KK), (DROW_EXPR), scr, F.lane); continue; } r -= nit; }
#define TR_JOB8(SRC, LDSRC, KK, NN, DST, DROW_EXPR) { const int nblk = (NN) / 32, nit = ((KK) / 64) * nblk; \
    if (r < nit) { const int kb = r / nblk, nb = r % nblk, n0 = 32 * nb; tr_item8((SRC), (LDSRC), 64 * kb, n0, (DST), (KK), (DROW_EXPR), scr, F.lane); continue; } r -= nit; }

__device__ __forceinline__ void p0_prologue(Frame& F) {
    const int tid_ = opaque(F.tid);
    LAS float* scr = (LAS float*)(F.lds + F.wave * 8448);
    const float* w_in = F.in_WIN;
    bf16_t* WCAT = wsp<bf16_t>(F, WS_WCAT); signed char* W8 = wsp<signed char>(F, WS_W8); signed char* WV8 = wsp<signed char>(F, WS_WVT); signed char* WGU8 = wsp<signed char>(F, WS_WGU);
    float* CS = wsp<float>(F, WS_CS);
    constexpr int NSM = 64;
    constexpr int IT_SM = 2 * 4;
    constexpr int S_Q = NAW / 32, S_M = 2 * D / 32, S_F = DFF / 32;
    constexpr int NSTRIP = 3 * S_Q + S_M + 2 * S_F;
    constexpr int N_BIG = 2 * (D / 64) * (NAW / 32) + 2 * (NAW / 64) * (D / 32) + (D / 64) * (D / 32) + (DFF / 64) * (D / 32);
    constexpr int NITEMS = N_BIG + NSM * IT_SM;
    for (int it = F.gw; it < NSTRIP + NITEMS; it += F.ngw) {
        if (it < NSTRIP) {
            int q = it; const float* src; int ld, n0, drow0; signed char* dst; float* cs;
            if (q < S_Q) { src = w_in; ld = INW; n0 = 32 * q; dst = W8; drow0 = n0; cs = CS + CS_QKM; }
            else if ((q -= S_Q) < S_Q) { src = w_in + NAW; ld = INW; n0 = 32 * q; dst = W8; drow0 = 2048 + n0; cs = CS + CS_QKM; }
            else if ((q -= S_Q) < S_M) { src = F.in_WM; ld = 2 * D; n0 = 32 * q; dst = W8; drow0 = 4096 + n0; cs = CS + CS_QKM; }
            else if ((q -= S_M) < S_Q) { src = w_in + 2 * NAW; ld = INW; n0 = 32 * q; dst = WV8; drow0 = n0; cs = CS + CS_V; }
            else if ((q -= S_Q) < S_F) { src = F.in_WFG; ld = DFF; n0 = 32 * q; dst = WGU8; drow0 = (n0 >> 7) * 256 + (n0 & 127); cs = CS + CS_GU; }
            else { q -= S_F; src = F.in_WFU; ld = DFF; n0 = 32 * q; dst = WGU8; drow0 = (n0 >> 7) * 256 + 128 + (n0 & 127); cs = CS + CS_GU; }
            tr_strip_i8(src, ld, D, n0, dst, drow0, cs, scr, F.lane);
            continue;
        }
        int r = it - NSTRIP;
        TR_JOB(w_in + 3 * NAW, INW, D, NAW, WCAT, 0 + n0)
        TR_JOB(w_in + 4 * NAW, INW, D, NAW, WCAT, 2048 + n0)
        TR_JOB(F.in_WNO, D, NAW, D, wsp<bf16_t>(F, WS_WNO), n0)
        TR_JOB(F.in_WLO, D, LW, D, wsp<bf16_t>(F, WS_WLO), n0)
        TR_JOB(F.in_WOUT, D, D, D, wsp<bf16_t>(F, WS_WO), n0)
        TR_JOB(F.in_WFD, D, DFF, D, wsp<bf16_t>(F, WS_WD), n0)
        {
            const int mi = r / IT_SM, ri = r % IT_SM, d = mi >> 5, g = (mi >> 4) & 1, n = mi & 15, kb = ri >> 2, nb = ri & 3;
            const float* src = (g ? F.in_WI : F.in_WR) + (size_t)(d * NBLK + n) * BW * BW;
            tr_item(src, BW, 64 * kb, 32 * nb, wsp<bf16_t>(F, WS_WG) + (size_t)mi * BW * BW, BW, 32 * nb, scr, F.lane);
        }
    }
    LAS f32x4* gl = (LAS f32x4*)(F.lds + 69632);
    for (int i = tid_; i < D / 4; i += NTHR) gl[i] = ((const f32x4*)F.in_GMPRE)[i];
    __syncthreads();
    bf16_t* XN = wsp<bf16_t>(F, WS_XN); signed char* XN8 = wsp<signed char>(F, WS_XN8); float* RS1 = wsp<float>(F, WS_RS1);
    for (int m = F.gw; m < L; m += F.ngw) {
        asm volatile("" ::: "memory");
        const f32x4* xr = (const f32x4*)xrow(F, m) + F.lane;
        f32x4 v[16]; float s = 0.f;
#pragma unroll
        for (int j = 0; j < 16; ++j) { v[j] = xr[64 * j]; s += (v[j].x * v[j].x + v[j].y * v[j].y) + (v[j].z * v[j].z + v[j].w * v[j].w); }
        const float rstd = 1.0f / sqrtf(wave_sum(s) * (1.0f / D) + EPS);
        u32x2* o8 = (u32x2*)(XN + (size_t)m * D) + F.lane; unsigned* o4 = (unsigned*)(XN8 + (size_t)m * D) + F.lane;
        float mx = 0.f;
#pragma unroll
        for (int j = 0; j < 16; ++j) { v[j] = v[j] * rstd * gl[F.lane + 64 * j]; mx = fmaxf(fmaxf(mx, fmaxf(fabsf(v[j].x), fabsf(v[j].y))), fmaxf(fabsf(v[j].z), fabsf(v[j].w))); }
        const float amax = fmaxf(wave_max(mx), 1e-20f), inv = 127.0f / amax;
        if (F.lane == 0) RS1[m] = amax * (1.0f / 127.0f);
#pragma unroll
        for (int j = 0; j < 16; ++j) { const f32x4 y = v[j]; u32x2 o; o.x = pk2(y.x, y.y); o.y = pk2(y.z, y.w); o8[64 * j] = o;
            o4[64 * j] = pk4_i8(rintf(y.x * inv), rintf(y.y * inv), rintf(y.z * inv), rintf(y.w * inv)); }
    }
    __syncthreads();
}

#ifndef ATT_SYNC
#define ATT_SYNC 1
#endif
template <int ADBG = 0> __device__ __forceinline__ void attn_mfma(Frame& F) {
    const int tid_ = opaque(F.tid);
    bf16_t* Q = wsp<bf16_t>(F, WS_Q); const bf16_t* Kb = wsp<bf16_t>(F, WS_K); const bf16_t* VT = wsp<bf16_t>(F, WS_VT);
    LAS float* rp = (LAS float*)F.lds;
    for (int i = tid_; i < NH * 15 * 31; i += NTHR) rp[i] = F.in_RPB[i];
    __syncthreads();
    const int fr = F.lane & 15, fq = F.lane >> 4;
    const float scale = 0.08838834764831845f;
    for (int base = blockIdx.x * NWAVES; base < (L / GRIDW) * NH * 4; base += F.ngw) {
        const int item = base + F.wave;
        asm volatile("" ::: "memory");
        const int g = item & 3, h = (item >> 2) & 15, rg = item >> 6;
        const int s0 = rg < LP / GRIDW ? 0 : LP, rows = rg < LP / GRIDW ? LP / GRIDW : LS / GRIDW, r = rg < LP / GRIDW ? rg : rg - LP / GRIDW;
        int rs = r - 4; rs = rs < 0 ? 0 : (rs > rows - 8 ? rows - 8 : rs);
        const int w0 = g == 0 ? 0 : (g == 1 ? 8 : (g == 2 ? 24 : 32));
        const int c = 16 * g + fr;
        int cs = c - 8; cs = cs < 0 ? 0 : (cs > GRIDW - 16 ? GRIDW - 16 : cs);
        bf16_t* qrow = Q + (size_t)(s0 + r * GRIDW + c) * NAW + h * HD;
        bf16x8 qf[4];
#pragma unroll
        for (int s = 0; s < 4; ++s) qf[s] = *(const bf16x8*)(qrow + 8 * fq + 32 * s);
        f32x4 sacc[8][2];
        const int Rg = s0 / GRIDW + rs, p0 = w0 >> 3;
        const bf16_t* kbase = Kb + (size_t)(Rg * 16 + h) * 8192 + p0 * 128 + fr * 32 + fq * 8;
        bf16x8 kb[8][2][4];
#define ATT_LDK(kr) do { _Pragma("unroll") for (int T = 0; T < 2; ++T) _Pragma("unroll") for (int s = 0; s < 4; ++s) kb[kr][T][s] = (ADBG & 1) ? qf[s] : (ADBG & 4) ? *(const bf16x8*)(Kb + (size_t)(s0 + rs * GRIDW) * NAW + h * HD * GRIDW + ((kr) * 8 + T * 4 + s) * 512 + F.lane * 8) : *(const bf16x8*)(kbase + (size_t)(kr) * (16 * 8192) + (s * 2 + T) * 1024); } while (0)
        ATT_LDK(0); ATT_LDK(1);
#pragma unroll
        for (int kr = 0; kr < 8; ++kr) {
            if (ATT_SYNC && (kr & 1) == 0) __builtin_amdgcn_s_barrier();
            if (kr + 2 < 8) ATT_LDK(kr + 2);
            __builtin_amdgcn_sched_barrier(0);
#pragma unroll
            for (int T = 0; T < 2; ++T) { f32x4 a = (f32x4){0.f, 0.f, 0.f, 0.f};
#pragma unroll
                for (int s = 0; s < 4; ++s) a = __builtin_amdgcn_mfma_f32_16x16x32_bf16(kb[kr][T][s], qf[s], a, 0, 0, 0);
                sacc[kr][T] = a; }
            __builtin_amdgcn_sched_barrier(0);
        }
#undef ATT_LDK
        bf16x8 vb[8][8];
        const bf16_t* vbase = VT + (size_t)(Rg * 16 + h) * 8192 + p0 * 128 + fq * 128 + fr * 8;
#define ATT_LDV(kr) do { _Pragma("unroll") for (int dt = 0; dt < 8; ++dt) vb[kr][dt] = (ADBG & 2) ? qf[dt & 3] : (ADBG & 4) ? *(const bf16x8*)(VT + (size_t)(h * HD) * L + s0 + rs * GRIDW + ((kr) * 8 + dt) * 512 + F.lane * 8) : *(const bf16x8*)(vbase + (size_t)(kr) * (16 * 8192) + dt * 1024); } while (0)
        ATT_LDV(0); ATT_LDV(1);
        __builtin_amdgcn_sched_barrier(0);
        const int elo = cs - w0 - 8 * fq, dc0 = w0 + 8 * fq - c + 15;
        const LAS float* rph = rp + h * 465 + (rs - r + 7) * 31;
        float mx = -3.0e38f;
#pragma unroll
        for (int e = 0; e < 8; ++e) { const bool valid = (e >= elo) && (e < elo + 16); const int bi = valid ? dc0 + e : 0;
#pragma unroll
            for (int kr = 0; kr < 8; ++kr) { const float sv = valid ? sacc[kr][e >> 2][e & 3] * scale + rph[kr * 31 + bi] : -3.0e38f; sacc[kr][e >> 2][e & 3] = sv; mx = fmaxf(mx, sv); } }
        mx = fmaxf(mx, __shfl_xor(mx, 16)); mx = fmaxf(mx, __shfl_xor(mx, 32));
        float lsum = 0.f; bf16x8 pf[8];
#pragma unroll
        for (int kr = 0; kr < 8; ++kr) { float p[8];
#pragma unroll
            for (int e = 0; e < 8; ++e) { p[e] = __expf(sacc[kr][e >> 2][e & 3] - mx); lsum += p[e]; }
            u32x4 w; w.x = pk2(p[0], p[1]); w.y = pk2(p[2], p[3]); w.z = pk2(p[4], p[5]); w.w = pk2(p[6], p[7]);
            pf[kr] = __builtin_bit_cast(bf16x8, w); }
        lsum += __shfl_xor(lsum, 16); lsum += __shfl_xor(lsum, 32);
        f32x4 oacc[8];
#pragma unroll
        for (int dt = 0; dt < 8; ++dt) oacc[dt] = (f32x4){0.f, 0.f, 0.f, 0.f};
#pragma unroll
        for (int kr = 0; kr < 8; ++kr) {
            if (ATT_SYNC && (kr & 1) == 0) __builtin_amdgcn_s_barrier();
            if (kr + 2 < 8) ATT_LDV(kr + 2);
            __builtin_amdgcn_sched_barrier(0);
#pragma unroll
            for (int dt = 0; dt < 8; ++dt) oacc[dt] = __builtin_amdgcn_mfma_f32_16x16x32_bf16(vb[kr][dt], pf[kr], oacc[dt], 0, 0, 0);
            __builtin_amdgcn_sched_barrier(0);
        }
#undef ATT_LDV
        const float inv = 1.0f / lsum;
#ifdef ATTN_OUT_OFF
        bf16_t* orow = wsp<bf16_t>(F, (size_t)ATTN_OUT_OFF * MiB) + (size_t)(s0 + r * GRIDW + c) * NAW + h * HD;
#else
        bf16_t* orow = qrow;
#endif
#pragma unroll
        for (int u = 0; u < 4; ++u) *(u32x4*)(orow + 32 * u + 8 * fq) = pg8::pack8(oacc[2 * u] * inv, oacc[2 * u + 1] * inv);
    }
    __syncthreads();
}

__device__ __forceinline__ void attn_mfma_lds(Frame& F) {
    const int tid_ = opaque(F.tid);
    bf16_t* Q = wsp<bf16_t>(F, WS_Q); const bf16_t* Kb = wsp<bf16_t>(F, WS_K); const bf16_t* VT = wsp<bf16_t>(F, WS_VT);
    LAS float* rp = (LAS float*)F.lds;
    LAS unsigned char* ring = F.lds + 30720;
    for (int i = tid_; i < NH * 15 * 31; i += NTHR) rp[i] = F.in_RPB[i];
    __syncthreads();
    const int lane = tid_ & 63, fr = lane & 15, fq = lane >> 4, w = F.wave, hl = w >> 2, g = w & 3;
    const float scale = 0.08838834764831845f;
    constexpr int NIT = (L / GRIDW) * NH * 4;
    const int w0 = g == 0 ? 0 : (g == 1 ? 8 : (g == 2 ? 24 : 32)), p0 = w0 >> 3;
    const int c = 16 * g + fr;
    int cs = c - 8; cs = cs < 0 ? 0 : (cs > GRIDW - 16 ? GRIDW - 16 : cs);
#define ATL_SRC(b, st) ([&]() -> const bf16_t* { const int rg_ = (b) >> 6, hb_ = ((b) >> 2) & 15; const int rows_ = rg_ < LP / GRIDW ? LP / GRIDW : LS / GRIDW, r_ = rg_ < LP / GRIDW ? rg_ : rg_ - LP / GRIDW; \
        int rs_ = r_ - 4; rs_ = rs_ < 0 ? 0 : (rs_ > rows_ - 8 ? rows_ - 8 : rs_); const int Rg_ = (rg_ < LP / GRIDW ? 0 : LP / GRIDW) + rs_; \
        return ((st) < 8 ? Kb : VT) + (size_t)((Rg_ + ((st) & 7)) * 16 + hb_) * 8192; }())
#define ATL_ISSUE(src, slot) do { const bf16_t* s_ = (src) + tid_ * 8; LAS unsigned char* d_ = ring + (slot) * 32768 + w * 1024; _Pragma("unroll") for (int k_ = 0; k_ < 4; ++k_) \
        __builtin_amdgcn_global_load_lds((const unsigned*)(s_ + k_ * 4096), (LAS unsigned*)(d_ + k_ * 8192), 16, 0, 0); } while (0)
    int base = blockIdx.x * NWAVES;
    if (base < NIT) { ATL_ISSUE(ATL_SRC(base, 0), 0); ATL_ISSUE(ATL_SRC(base, 1), 1); }
    int b0 = 0;
    for (; base < NIT; base += F.ngw) {
        asm volatile("" ::: "memory");
        const int h = ((base >> 2) & 15) + hl, rg = base >> 6;
        const int s0 = rg < LP / GRIDW ? 0 : LP, rows = rg < LP / GRIDW ? LP / GRIDW : LS / GRIDW, r = rg < LP / GRIDW ? rg : rg - LP / GRIDW;
        int rs = r - 4; rs = rs < 0 ? 0 : (rs > rows - 8 ? rows - 8 : rs);
        const int nbase = base + F.ngw < NIT ? base + F.ngw : base;
        bf16_t* qrow = Q + (size_t)(s0 + r * GRIDW + c) * NAW + h * HD;
        bf16x8 qf[4];
#pragma unroll
        for (int s = 0; s < 4; ++s) qf[s] = *(const bf16x8*)(qrow + 8 * fq + 32 * s);
        f32x4 sacc[8][2]; f32x4 oacc[8]; bf16x8 pf[8]; float lsum = 0.f;
#pragma unroll
        for (int dt = 0; dt < 8; ++dt) oacc[dt] = (f32x4){0.f, 0.f, 0.f, 0.f};
        const int koff = hl * 16384 + (p0 * 128 + fr * 32 + fq * 8) * 2, voff = hl * 16384 + (p0 * 128 + fq * 128 + fr * 8) * 2;
#pragma unroll
        for (int st = 0; st < 16; ++st) {
            asm volatile("s_waitcnt vmcnt(4)" ::: "memory"); asm volatile("s_waitcnt lgkmcnt(0)" ::: "memory"); __builtin_amdgcn_s_barrier(); asm volatile("" ::: "memory");
            { const int slot2 = (b0 + st + 2) % 3; if (st + 2 < 16) ATL_ISSUE(ATL_SRC(base, st + 2), slot2); else ATL_ISSUE(ATL_SRC(nbase, st + 2 - 16), slot2); }
            const LAS unsigned char* buf = ring + ((b0 + st) % 3) * 32768;
            if (st < 8) {
#pragma unroll
                for (int T = 0; T < 2; ++T) { f32x4 a = (f32x4){0.f, 0.f, 0.f, 0.f};
#pragma unroll
                    for (int s2 = 0; s2 < 4; ++s2) a = __builtin_amdgcn_mfma_f32_16x16x32_bf16(*(const LAS bf16x8*)(buf + koff + (s2 * 2 + T) * 2048), qf[s2], a, 0, 0, 0);
                    sacc[st][T] = a; }
            } else {
                if (st == 8) {
                    const int elo = cs - w0 - 8 * fq, dc0 = w0 + 8 * fq - c + 15;
                    const LAS float* rph = rp + h * 465 + (rs - r + 7) * 31;
                    float mx = -3.0e38f;
#pragma unroll
                    for (int e = 0; e < 8; ++e) { const bool valid = (e >= elo) && (e < elo + 16); const int bi = valid ? dc0 + e : 0;
#pragma unroll
                        for (int kr = 0; kr < 8; ++kr) { const float sv = valid ? sacc[kr][e >> 2][e & 3] * scale + rph[kr * 31 + bi] : -3.0e38f; sacc[kr][e >> 2][e & 3] = sv; mx = fmaxf(mx, sv); } }
                    mx = fmaxf(mx, __shfl_xor(mx, 16)); mx = fmaxf(mx, __shfl_xor(mx, 32));
#pragma unroll
                    for (int kr = 0; kr < 8; ++kr) { float p[8];
#pragma unroll
                        for (int e = 0; e < 8; ++e) { p[e] = __expf(sacc[kr][e >> 2][e & 3] - mx); lsum += p[e]; }
                        u32x4 wv; wv.x = pk2(p[0], p[1]); wv.y = pk2(p[2], p[3]); wv.z = pk2(p[4], p[5]); wv.w = pk2(p[6], p[7]);
                        pf[kr] = __builtin_bit_cast(bf16x8, wv); }
                    lsum += __shfl_xor(lsum, 16); lsum += __shfl_xor(lsum, 32);
                }
#pragma unroll
                for (int dt = 0; dt < 8; ++dt) oacc[dt] = __builtin_amdgcn_mfma_f32_16x16x32_bf16(*(const LAS bf16x8*)(buf + voff + dt * 2048), pf[st - 8], oacc[dt], 0, 0, 0);
            }
        }
        b0 = (b0 + 16) % 3;
        const float inv = 1.0f / lsum;
#pragma unroll
        for (int u = 0; u < 4; ++u) *(u32x4*)(qrow + 32 * u + 8 * fq) = pg8::pack8(oacc[2 * u] * inv, oacc[2 * u + 1] * inv);
    }
#undef ATL_SRC
#undef ATL_ISSUE
    asm volatile("s_waitcnt vmcnt(0)" ::: "memory");
    __syncthreads();
}

__device__ __forceinline__ void conv_phase(Frame& F) {
    const int tid_ = opaque(F.tid);
    const bf16_t* XR = wsp<bf16_t>(F, WS_XR); bf16_t* XC = wsp<bf16_t>(F, WS_XC);
    const float* wc = F.in_WCONV; const float* bc = F.in_BCONV;
    const int nth = F.G * NTHR;
    for (int it = blockIdx.x * NTHR + tid_; it < L * (LW / 8); it += nth) {
        const int t = it / (LW / 8), c0 = (it % (LW / 8)) * 8;
        const int s0 = t < LP ? 0 : LP, len = t < LP ? LP : LS, tl = t - s0;
        float acc[8];
#pragma unroll
        for (int e = 0; e < 8; ++e) acc[e] = bc[c0 + e];
#pragma unroll
        for (int j = 0; j < 4; ++j) { const int tt = tl + j - 2; if (tt < 0 || tt >= len) continue;
            f32x4 x0, x1; pg8::unpack8(*(const u32x4*)(XR + (size_t)(s0 + tt) * LW + c0), x0, x1);
            const f32x4 w0 = *(const f32x4*)(wc + j * LW + c0), w1 = *(const f32x4*)(wc + j * LW + c0 + 4);
#pragma unroll
            for (int e = 0; e < 4; ++e) { acc[e] += w0[e] * x0[e]; acc[4 + e] += w1[e] * x1[e]; } }
        *(u32x4*)(XC + (size_t)t * LW + c0) = pg8::pack8((f32x4){acc[0], acc[1], acc[2], acc[3]}, (f32x4){acc[4], acc[5], acc[6], acc[7]});
    }
}

struct LruW { bf16x8 w[2][4]; float br, bi, cl; };
template <int DIR> __device__ __forceinline__ void lru_load_w(const Frame& F, LruW& W, int n, int w, int fr, int fq) {
    const bf16_t* wg = wsp<bf16_t>(F, WS_WG);
#pragma unroll
    for (int g = 0; g < 2; ++g)
#pragma unroll
        for (int s = 0; s < 4; ++s) W.w[g][s] = *(const bf16x8*)(wg + ((size_t)((DIR * 2 + g) * NBLK + n) * BW + 16 * w + fr) * BW + 32 * fq + 8 * s);
    const int ch = n * BW + 16 * w + fr;
    W.br = F.in_BR[DIR * LW + ch]; W.bi = F.in_BI[DIR * LW + ch];
    const float lam = F.in_LAM[DIR * LW + ch];
    W.cl = -8.0f * ((lam > 15.f) ? __expf(-lam) : log1pf(__expf(-lam)));
}
template <int LDBG = 0> __device__ __forceinline__ void lru_gate(float pr, float pi, float xc, const LruW& W, bool first, float& a, float& u) {
    if constexpr (LDBG == 1) { a = pr + W.br; u = pi * xc + W.bi; return; }
    const float r = sigmoidf_(pr + W.br), ig = sigmoidf_(pi + W.bi);
    a = __expf(W.cl * r);
    const float mult = first ? 1.0f : __builtin_amdgcn_sqrtf(fmaxf(1.0f - a * a, 0.f));
    u = mult * ig * xc;
}
struct LruX { bf16x8 x[4][4]; };
__device__ __forceinline__ void lru_load_x(LruX& X, const bf16_t* XC, int tb, int n, int fr, int fq) {
#pragma unroll
    for (int tau = 0; tau < 4; ++tau) { const bf16_t* xp = XC + ((size_t)((((tb >> 6) * NBLK + n) * 4 + tau) * 4) * 64 + fr * 4 + fq) * 8;
#pragma unroll
        for (int s = 0; s < 4; ++s) X.x[tau][s] = *(const bf16x8*)(xp + s * 512); }
}
__device__ __forceinline__ void lru_tile(const LruX& X, int tau, bool hiw, const LruW& W, const bf16x8 idf0, const bf16x8 idf1, f32x4& pr, f32x4& pi, f32x4& xct) {
    pr = (f32x4){0.f, 0.f, 0.f, 0.f}; pi = pr;
#pragma unroll
    for (int s = 0; s < 4; ++s) { pr = __builtin_amdgcn_mfma_f32_16x16x32_bf16(X.x[tau][s], W.w[0][s], pr, 0, 0, 0); pi = __builtin_amdgcn_mfma_f32_16x16x32_bf16(X.x[tau][s], W.w[1][s], pi, 0, 0, 0); }
    const bf16x8 x0 = hiw ? X.x[tau][2] : X.x[tau][0], x1 = hiw ? X.x[tau][3] : X.x[tau][1];
    xct = __builtin_amdgcn_mfma_f32_16x16x32_bf16(x0, idf0, (f32x4){0.f, 0.f, 0.f, 0.f}, 0, 0, 0);
    xct = __builtin_amdgcn_mfma_f32_16x16x32_bf16(x1, idf1, xct, 0, 0, 0);
}
__device__ __forceinline__ void lru_idfrags(int w, int fr, int fq, bf16x8& idf0, bf16x8& idf1) {
#pragma unroll
    for (int e = 0; e < 8; ++e) { const bool on = (fq == (w >> 1)) && ((fr & 7) == e); idf0[e] = (on && fr < 8) ? (short)0x3F80 : (short)0; idf1[e] = (on && fr >= 8) ? (short)0x3F80 : (short)0; }
}
constexpr int LRU_CH = 256, LRU_NCH = L / LRU_CH, LRU_NCH_P = LP / LRU_CH;
__device__ __forceinline__ void conv_unit(Frame& F, int cg, int n) {
    const int tid_ = opaque(F.tid);
    const bf16_t* XR = wsp<bf16_t>(F, WS_XR); bf16_t* XC = wsp<bf16_t>(F, WS_XC);
    const float* wc = F.in_WCONV; const float* bc = F.in_BCONV;
    const int c0 = n * BW + (tid_ & 15) * 8;
    const int s0 = cg < LRU_NCH_P ? 0 : LP, len = cg < LRU_NCH_P ? LP : LS;
    f32x4 w[4][2]; f32x4 b0 = *(const f32x4*)(bc + c0), b1 = *(const f32x4*)(bc + c0 + 4);
#pragma unroll
    for (int j = 0; j < 4; ++j) { w[j][0] = *(const f32x4*)(wc + j * LW + c0); w[j][1] = *(const f32x4*)(wc + j * LW + c0 + 4); }
#pragma unroll
    for (int i = 0; i < 8; ++i) {
        const int t = cg * LRU_CH + (tid_ >> 4) + 32 * i, tl = t - s0;
        f32x4 a0 = b0, a1 = b1;
#pragma unroll
        for (int j = 0; j < 4; ++j) { const int tt = tl + j - 2; if (tt < 0 || tt >= len) continue;
            f32x4 x0, x1; pg8::unpack8(*(const u32x4*)(XR + (size_t)(s0 + tt) * LW + c0), x0, x1); a0 += w[j][0] * x0; a1 += w[j][1] * x1; }
        const int tg = t & 63, cq = tid_ & 15;
        *(u32x4*)(XC + ((size_t)(((((t >> 6) * NBLK + n) * 4 + ((tg >> 2) & 3)) * 4 + (cq & 3)) * 16 + 4 * (tg >> 4) + (tg & 3)) * 4 + (cq >> 2)) * 8) = pg8::pack8(a0, a1);
    }
}
__device__ __forceinline__ void lru_pass_a(Frame& F) {
    const int fr = F.lane & 15, fq = F.lane >> 4, w = F.wave;
    const bf16_t* XC = wsp<bf16_t>(F, WS_XC); f32x2* SUMM = wsp<f32x2>(F, WS_SUM);
    bf16x8 idf0, idf1; lru_idfrags(w, fr, fq, idf0, idf1);
    for (int u = blockIdx.x; u < LRU_NCH * NBLK; u += F.G) {
        const int cg = u >> 4, n = u & 15;
        conv_unit(F, cg, n); VM_WAIT(); __syncthreads();
        LruW Wf, Wb; lru_load_w<0>(F, Wf, n, w, fr, fq); lru_load_w<1>(F, Wb, n, w, fr, fq);
        const bool c_first = (cg == 0 || cg == LRU_NCH_P), c_last = (cg == LRU_NCH_P - 1 || cg == LRU_NCH - 1);
        float Af = 1.f, Hf = 0.f, Ab = 1.f, Hb = 0.f;
        LruX X, Xn; lru_load_x(X, XC, cg * LRU_CH, n, fr, fq);
        for (int gi = 0; gi < 4; ++gi) {
            if (gi < 3) lru_load_x(Xn, XC, cg * LRU_CH + (gi + 1) * 64, n, fr, fq);
            float pf = 1.f, hf = 0.f, pb = 1.f, hb = 0.f;
#pragma unroll
            for (int tau = 0; tau < 4; ++tau) {
                f32x4 prf, pif, prb, pib, xct, xct2;
                lru_tile(X, tau, (w & 1) != 0, Wf, idf0, idf1, prf, pif, xct);
                lru_tile(X, tau, (w & 1) != 0, Wb, idf0, idf1, prb, pib, xct2);
#pragma unroll
                for (int j = 0; j < 4; ++j) {
                    float a, uu;
                    lru_gate(prf[j], pif[j], xct[j], Wf, c_first && gi == 0 && fq == 0 && tau == 0 && j == 0, a, uu); hf = a * hf + uu; pf *= a;
                    lru_gate(prb[j], pib[j], xct[j], Wb, c_last && gi == 3 && fq == 3 && tau == 3 && j == 3, a, uu); hb += pb * uu; pb *= a;
                }
            }
            float gPf = 1.f, gHf = 0.f, gPb = 1.f, gHb = 0.f;
#pragma unroll
            for (int qq = 0; qq < 4; ++qq) { const int src = fr + 16 * qq;
                float P = __shfl(pf, src), H = __shfl(hf, src); gHf = P * gHf + H; gPf *= P;
                P = __shfl(pb, src); H = __shfl(hb, src); gHb += gPb * H; gPb *= P; }
            Hf = gPf * Hf + gHf; Af *= gPf; Hb += Ab * gHb; Ab *= gPb;
            X = Xn;
        }
        if (fq == 0) { const int ch = n * BW + 16 * w + fr; SUMM[(size_t)(cg * 2 + 0) * LW + ch] = (f32x2){Af, Hf}; SUMM[(size_t)(cg * 2 + 1) * LW + ch] = (f32x2){Ab, Hb}; }
    }
}
__device__ __forceinline__ void lru_pass_b(Frame& F) {
    const int tid_ = opaque(F.tid);
    const int gt = blockIdx.x * NTHR + tid_; if (gt >= 4 * LW) return;
    const int ch = gt % LW, d = (gt / LW) & 1, seq = gt / (2 * LW), c0 = seq ? LRU_NCH_P : 0, nc = seq ? LRU_NCH - LRU_NCH_P : LRU_NCH_P;
    const f32x2* SUMM = wsp<f32x2>(F, WS_SUM); float* CIN = wsp<float>(F, WS_SUM + 4 * MiB);
    float s = 0.f;
    for (int i0 = 0; i0 < nc; i0 += 8) {
        f32x2 ah[8];
#pragma unroll
        for (int e = 0; e < 8; ++e) { const int cg = d ? c0 + nc - 1 - (i0 + e) : c0 + i0 + e; ah[e] = SUMM[(size_t)(cg * 2 + d) * LW + ch]; }
#pragma unroll
        for (int e = 0; e < 8; ++e) { const int cg = d ? c0 + nc - 1 - (i0 + e) : c0 + i0 + e; CIN[(size_t)(cg * 2 + d) * LW + ch] = s; s = ah[e].x * s + ah[e].y; }
    }
}
template <int LDBG = 0> __device__ __forceinline__ void lru_pass_c(Frame& F) {
    const int tid_ = opaque(F.tid);
    const int fr = F.lane & 15, fq = F.lane >> 4, w = F.wave;
    const bf16_t* XC = wsp<bf16_t>(F, WS_XC); const float* CIN = wsp<float>(F, WS_SUM + 4 * MiB);
    const bf16_t* GR = wsp<bf16_t>(F, WS_GR); bf16_t* LRU = wsp<bf16_t>(F, WS_XR);
    LAS bf16_t* hfb = (LAS bf16_t*)(F.lds + w * 8192);
    LAS bf16_t* grt = (LAS bf16_t*)(F.lds + 65536);
    bf16x8 idf0, idf1; lru_idfrags(w, fr, fq, idf0, idf1);
    for (int u = blockIdx.x; u < LRU_NCH * NBLK; u += F.G) {
        const int cg = u >> 4, n = u & 15, ch = n * BW + 16 * w + fr;
        const bool c_first = (cg == 0 || cg == LRU_NCH_P), c_last = (cg == LRU_NCH_P - 1 || cg == LRU_NCH - 1);
        { const bf16_t* gsrc = GR + (size_t)(cg * LRU_CH + (tid_ >> 4)) * LW + n * BW + (tid_ & 15) * 8; LAS bf16_t* ldst = grt + w * 512;
#pragma unroll 1
          for (int k = 0; k < 8; ++k) { __builtin_amdgcn_global_load_lds((const unsigned*)gsrc, (LAS unsigned*)ldst, 16, 0, 0); gsrc += (size_t)32 * LW; ldst += NTHR * 8; } }
        {
            LruW W; lru_load_w<0>(F, W, n, w, fr, fq);
            float s = CIN[(size_t)(cg * 2 + 0) * LW + ch];
            LruX X, Xn; lru_load_x(X, XC, cg * LRU_CH, n, fr, fq);
            for (int gi = 0; gi < 4; ++gi) {
                if (gi < 3 && LDBG != 2) lru_load_x(Xn, XC, cg * LRU_CH + (gi + 1) * 64, n, fr, fq);
                float a[16], uu[16];
#pragma unroll
                for (int tau = 0; tau < 4; ++tau) { f32x4 pr, pi, xct; lru_tile(X, tau, (w & 1) != 0, W, idf0, idf1, pr, pi, xct);
#pragma unroll
                    for (int j = 0; j < 4; ++j) lru_gate<LDBG>(pr[j], pi[j], xct[j], W, c_first && gi == 0 && fq == 0 && tau == 0 && j == 0, a[4 * tau + j], uu[4 * tau + j]); }
                float p = 1.f, h = 0.f;
#pragma unroll
                for (int t = 0; t < 16; ++t) { h = a[t] * h + uu[t]; p *= a[t]; }
                float hin = s, sg = s;
#pragma unroll
                for (int qq = 0; qq < 4; ++qq) { const float P = __shfl(p, fr + 16 * qq), H = __shfl(h, fr + 16 * qq); sg = P * sg + H; if (qq < fq) hin = P * hin + H; }
                s = sg;
                float hh = hin;
#pragma unroll
                for (int t = 0; t < 16; ++t) { hh = a[t] * hh + uu[t]; hfb[(gi * 64 + 16 * fq + t) * 16 + fr] = (bf16_t)f2bf(hh); }
                X = Xn;
            }
        }
        VM_WAIT(); __syncthreads();
        {
            LruW W; lru_load_w<1>(F, W, n, w, fr, fq);
            float s = CIN[(size_t)(cg * 2 + 1) * LW + ch];
            LruX X, Xn; lru_load_x(X, XC, cg * LRU_CH + 3 * 64, n, fr, fq);
            for (int gi = 3; gi >= 0; --gi) {
                if (gi > 0 && LDBG != 2) lru_load_x(Xn, XC, cg * LRU_CH + (gi - 1) * 64, n, fr, fq);
                float a[16], uu[16];
#pragma unroll
                for (int tau = 0; tau < 4; ++tau) { f32x4 pr, pi, xct; lru_tile(X, tau, (w & 1) != 0, W, idf0, idf1, pr, pi, xct);
#pragma unroll
                    for (int j = 0; j < 4; ++j) lru_gate<LDBG>(pr[j], pi[j], xct[j], W, c_last && gi == 3 && fq == 3 && tau == 3 && j == 3, a[4 * tau + j], uu[4 * tau + j]); }
                float p = 1.f, h = 0.f;
#pragma unroll
                for (int t = 15; t >= 0; --t) { h = a[t] * h + uu[t]; p *= a[t]; }
                float hin = s, sg = s;
#pragma unroll
                for (int qq = 3; qq >= 0; --qq) { const float P = __shfl(p, fr + 16 * qq), H = __shfl(h, fr + 16 * qq); sg = P * sg + H; if (qq > fq) hin = P * hin + H; }
                s = sg;
                float hh = hin;
#pragma unroll
                for (int t = 15; t >= 0; --t) { hh = a[t] * hh + uu[t];
                    const int tl = gi * 64 + 16 * fq + t; LAS bf16_t* gp = grt + tl * BW + 16 * w + fr;
                    *gp = (bf16_t)f2bf((bf1(hfb[tl * 16 + fr]) + hh) * gelu_tanh(bf1(*gp))); }
                X = Xn;
            }
        }
        LDS_WAIT(); __syncthreads();
        { bf16_t* gdst = LRU + (size_t)(cg * LRU_CH + (tid_ >> 4)) * LW + n * BW + (tid_ & 15) * 8; const LAS bf16_t* lsrc = grt + tid_ * 8;
#pragma unroll 1
          for (int k = 0; k < 8; ++k) { *(u32x4*)gdst = *(const LAS u32x4*)lsrc; gdst += (size_t)32 * LW; lsrc += NTHR * 8; } }
        LDS_WAIT(); __syncthreads();
    }
}

__device__ __forceinline__ f32x4 up4(const u32x2 u) { return (f32x4){bflo(u.x), bfhi(u.x), bflo(u.y), bfhi(u.y)}; }
__device__ __forceinline__ void mid_phase(Frame& F) {
    const int tid_ = opaque(F.tid);
    const bf16_t* MIX = wsp<bf16_t>(F, WS_MIX); signed char* XN8 = wsp<signed char>(F, WS_XN8); float* RSTD = wsp<float>(F, WS_RSTD); float* RS2 = wsp<float>(F, WS_RS2);
    LAS f32x4* gpost = (LAS f32x4*)F.lds; LAS f32x4* gpre = gpost + D / 4;
    for (int i = tid_; i < D / 4; i += NTHR) { gpost[i] = ((const f32x4*)F.in_GMPOST)[i]; gpre[i] = ((const f32x4*)F.in_GFPRE)[i]; }
    __syncthreads();
    for (int m = F.gw; m < L; m += F.ngw) {
        asm volatile("" ::: "memory");
        const f32x4* xr = (const f32x4*)xrow(F, m) + F.lane; const u32x2* mr = (const u32x2*)(MIX + (size_t)m * D) + F.lane;
        f32x4 v[16]; u32x2 mx[16]; float s = 0.f;
#pragma unroll
        for (int j = 0; j < 16; ++j) { v[j] = xr[64 * j]; mx[j] = mr[64 * j]; const f32x4 a = up4(mx[j]); s += (a.x * a.x + a.y * a.y) + (a.z * a.z + a.w * a.w); }
        const float rstd1 = 1.0f / sqrtf(wave_sum(s) * (1.0f / D) + EPS);
        if (F.lane == 0) RSTD[m] = rstd1;
        float s2 = 0.f;
#pragma unroll
        for (int j = 0; j < 16; ++j) { v[j] = v[j] + up4(mx[j]) * rstd1 * gpost[F.lane + 64 * j]; s2 += (v[j].x * v[j].x + v[j].y * v[j].y) + (v[j].z * v[j].z + v[j].w * v[j].w); }
        const float rstd2 = 1.0f / sqrtf(wave_sum(s2) * (1.0f / D) + EPS);
        float mx2 = 0.f;
#pragma unroll
        for (int j = 0; j < 16; ++j) { v[j] = v[j] * rstd2 * gpre[F.lane + 64 * j]; mx2 = fmaxf(fmaxf(mx2, fmaxf(fabsf(v[j].x), fabsf(v[j].y))), fmaxf(fabsf(v[j].z), fabsf(v[j].w))); }
        const float amax = fmaxf(wave_max(mx2), 1e-20f), inv = 127.0f / amax;
        if (F.lane == 0) RS2[m] = amax * (1.0f / 127.0f);
        unsigned* o4 = (unsigned*)(XN8 + (size_t)m * D) + F.lane;
#pragma unroll
        for (int j = 0; j < 16; ++j) o4[64 * j] = pk4_i8(rintf(v[j].x * inv), rintf(v[j].y * inv), rintf(v[j].z * inv), rintf(v[j].w * inv));
    }
    __syncthreads();
}
__device__ __forceinline__ void final_phase(Frame& F) {
    const int tid_ = opaque(F.tid);
    const bf16_t* MIX = wsp<bf16_t>(F, WS_MIX); const bf16_t* FB = wsp<bf16_t>(F, WS_F); const float* RSTD = wsp<float>(F, WS_RSTD);
    LAS f32x4* gpost = (LAS f32x4*)F.lds; LAS f32x4* gfp = gpost + D / 4;
    for (int i = tid_; i < D / 4; i += NTHR) { gpost[i] = ((const f32x4*)F.in_GMPOST)[i]; gfp[i] = ((const f32x4*)F.in_GFPOST)[i]; }
    __syncthreads();
    for (int m = F.gw; m < L; m += F.ngw) {
        asm volatile("" ::: "memory");
        const f32x4* xr = (const f32x4*)xrow(F, m) + F.lane; const u32x2* mr = (const u32x2*)(MIX + (size_t)m * D) + F.lane; const u32x2* fr = (const u32x2*)(FB + (size_t)m * D) + F.lane;
        const float rstd1 = RSTD[m];
        u32x2 fx[16]; float s = 0.f;
#pragma unroll
        for (int j = 0; j < 16; ++j) { fx[j] = fr[64 * j]; const f32x4 a = up4(fx[j]); s += (a.x * a.x + a.y * a.y) + (a.z * a.z + a.w * a.w); }
        const float rstd3 = 1.0f / sqrtf(wave_sum(s) * (1.0f / D) + EPS);
        f32x4* o = (f32x4*)(F.out + (size_t)m * D) + F.lane;
#pragma unroll
        for (int j = 0; j < 16; ++j) o[64 * j] = xr[64 * j] + up4(mr[64 * j]) * rstd1 * gpost[F.lane + 64 * j] + up4(fx[j]) * rstd3 * gfp[F.lane + 64 * j];
    }
}

constexpr int LDS_STAGE = pg8::STAGE_BYTES;
constexpr int LDS_MISC = LDS_STAGE;
constexpr int LDS_BYTES = LDS_STAGE + 1024;
#ifndef MK_N_LAUNCHES
#define MK_N_LAUNCHES 1
#endif
constexpr int NPHASE = 11;
struct Args { const float* in[23]; float* out; unsigned char* ws; int ph_lo, ph_hi; };

__global__ void __launch_bounds__(NTHR, 2) fwd_kernel(Args args) {
    extern __shared__ __attribute__((aligned(16))) unsigned char lds_raw[];
    Frame F;
    F.lds = (LAS unsigned char*)lds_raw;
    F.tid = threadIdx.x; F.lane = (int)__builtin_amdgcn_mbcnt_hi(~0u, __builtin_amdgcn_mbcnt_lo(~0u, 0u)); F.wave = __builtin_amdgcn_readfirstlane(F.tid >> 6);
    F.G = gridDim.x; F.gw = blockIdx.x * NWAVES + F.wave; F.ngw = F.G * NWAVES;
    F.in_XP = args.in[0]; F.in_XS = args.in[1]; F.in_WIN = args.in[2]; F.in_WCONV = args.in[3]; F.in_BCONV = args.in[4]; F.in_WR = args.in[5]; F.in_BR = args.in[6]; F.in_WI = args.in[7]; F.in_BI = args.in[8]; F.in_LAM = args.in[9]; F.in_RPB = args.in[10]; F.in_WNO = args.in[11]; F.in_WLO = args.in[12]; F.in_WM = args.in[13]; F.in_BM = args.in[14]; F.in_WOUT = args.in[15]; F.in_GMPRE = args.in[16]; F.in_GMPOST = args.in[17]; F.in_GFPRE = args.in[18]; F.in_GFPOST = args.in[19]; F.in_WFG = args.in[20]; F.in_WFU = args.in[21]; F.in_WFD = args.in[22];
    F.out = args.out; F.ws = args.ws;
    volatile LAS unsigned* MISC = (volatile LAS unsigned*)(F.lds + LDS_MISC);
    if (F.tid < 256) MISC[F.tid] = 0u;
    __syncthreads();
    const int lo = args.ph_lo, hi = args.ph_hi;
    const bool fused = (hi - lo) > 1;
    XcdBarrier bar; bar.bar = (unsigned*)(F.ws + WS_CTL); bar.x = 0; bar.st = nullptr;
    if (fused) bar = xcd_barrier_post((unsigned*)(F.ws + WS_CTL), MISC + 8);
#ifndef PH_MASK
#define PH_MASK 0x7ff
#endif
#define IN(k) (((PH_MASK >> (k)) & 1) && lo <= (k) && (k) < hi)
#define SEAM(k) do { if (IN(k) && IN((k) + 1)) xcd_barrier(bar); } while (0)
    LAS unsigned char* stage = F.lds;

#ifdef ATTN_OUT_OFF
#define NA_BUF ((size_t)ATTN_OUT_OFF * MiB)
#else
#define NA_BUF WS_Q
#endif
#ifndef DUP_MASK
#define DUP_MASK 0
#endif
#define RUN(k, ...) if (IN(k)) { __VA_ARGS__ if (((DUP_MASK) >> (k)) & 1) { __VA_ARGS__ } }
    RUN(0, { p0_prologue(F); }) SEAM(0);
    RUN(1, {
        { pg8::Gemm g{wsp<bf16_t>(F, WS_XN8), wsp<bf16_t>(F, WS_XN8), 1 << 30, wsp<bf16_t>(F, WS_W8), L, 2 * NAW + 2 * D, D}; pg8::StaticOrder S; S.init(L, 2 * NAW + 2 * D, F.G, (int)blockIdx.x);
          pg8::EpiProjQ E{wsp<bf16_t>(F, WS_Q), wsp<bf16_t>(F, WS_K), (bf16_t*)F.out, F.in_BM, wsp<float>(F, WS_RS1), wsp<float>(F, WS_CS) + CS_QKM};
          pg8::gemm_phase<pg8::EpiProjQ, pg8::StaticOrder, true, true, 2>(stage, g, S, E); }
        { pg8::Gemm g{wsp<bf16_t>(F, WS_XN), wsp<bf16_t>(F, WS_XN), 1 << 30, wsp<bf16_t>(F, WS_WCAT), L, 2 * NAW, 2 * D}; pg8::StaticOrder S; S.init(L, 2 * NAW, F.G, (int)blockIdx.x);
          pg8::EpiProj E{wsp<bf16_t>(F, WS_XR), wsp<bf16_t>(F, WS_GR), wsp<bf16_t>(F, WS_GR), wsp<bf16_t>(F, WS_GR), (bf16_t*)F.out, F.in_BM, 1 << 30};
          pg8::gemm_phase<pg8::EpiProj, pg8::StaticOrder, true, true, 0>(stage, g, S, E); }
        { pg8::Gemm g{wsp<bf16_t>(F, WS_WVT), wsp<bf16_t>(F, WS_WVT), 1 << 30, wsp<bf16_t>(F, WS_XN8), NAW, L, D}; pg8::StaticOrder S; S.init(NAW, L, F.G, (int)blockIdx.x);
          pg8::EpiVTQ E{wsp<bf16_t>(F, WS_VT), wsp<float>(F, WS_CS) + CS_V, wsp<float>(F, WS_RS1)};
          pg8::gemm_phase<pg8::EpiVTQ, pg8::StaticOrder, true, true, 2>(stage, g, S, E); }
    }) SEAM(1);
    RUN(2, { lru_pass_a(F); }) SEAM(2);
    #ifdef ATTN_OUT_OFF
    if (IN(3)) { lru_pass_b(F); } SEAM(3);
    if (IN(4)) { lru_pass_c<0>(F); xcd_barrier(bar); if (ATTN_DUP) attn_mfma<ATTN_DUP - 1>(F); attn_mfma<0>(F); } SEAM(4);
#else
    if (IN(3)) { lru_pass_b(F); attn_mfma_lds(F); } SEAM(3);
#ifdef LRUC_DBG
    if (IN(4)) { lru_pass_c<LRUC_DBG>(F); lru_pass_c<0>(F); } SEAM(4);
#else
    RUN(4, { lru_pass_c<0>(F); }) SEAM(4);
#endif
#endif
    if (IN(5)) {
        { pg8::Gemm g{wsp<bf16_t>(F, NA_BUF), wsp<bf16_t>(F, NA_BUF), 1 << 30, wsp<bf16_t>(F, WS_WNO), L, D, 2 * NAW}; pg8::StaticOrder S; S.init(L, D, F.G, (int)blockIdx.x);
          pg8::EpiMulG<false> E{wsp<bf16_t>(F, WS_T1), (const bf16_t*)F.out, 0};
          pg8::gemm_phase<pg8::EpiMulG<false>, pg8::StaticOrder, true, true>(stage, g, S, E); }
        { pg8::Gemm g{wsp<bf16_t>(F, WS_XR), wsp<bf16_t>(F, WS_XR), 1 << 30, wsp<bf16_t>(F, WS_WLO), L, D, 2 * LW}; pg8::StaticOrder S; S.init(L, D, F.G, (int)blockIdx.x);
          pg8::EpiMulG<true> E{wsp<bf16_t>(F, WS_T1), (const bf16_t*)F.out, D};
          pg8::gemm_phase<pg8::EpiMulG<true>, pg8::StaticOrder, true, true>(stage, g, S, E); }
    } SEAM(5);
    RUN(6, {
        pg8::Gemm g{wsp<bf16_t>(F, WS_T1), wsp<bf16_t>(F, WS_T1), 1 << 30, wsp<bf16_t>(F, WS_WO), L, D, 2 * D}; pg8::StaticOrder S; S.init(L, D, F.G, (int)blockIdx.x);
        pg8::EpiPlain E{wsp<bf16_t>(F, WS_MIX), D};
        pg8::gemm_phase<pg8::EpiPlain, pg8::StaticOrder, true, true>(stage, g, S, E);
    }) SEAM(6);
    RUN(7, { mid_phase(F); }) SEAM(7);
    RUN(8, {
        pg8::Gemm g{wsp<bf16_t>(F, WS_XN8), wsp<bf16_t>(F, WS_XN8), 1 << 30, wsp<bf16_t>(F, WS_WGU), L, 2 * DFF, D}; pg8::StaticOrder S; S.init(L, 2 * DFF, F.G, (int)blockIdx.x);
        pg8::EpiSwigluQ E{(bf16_t*)F.out, wsp<bf16_t>(F, WS_HIDS), LP / 256, wsp<float>(F, WS_RS2), wsp<float>(F, WS_CS) + CS_GU};
        pg8::gemm_phase<pg8::EpiSwigluQ, pg8::StaticOrder, false, true, 2>(stage, g, S, E);
    }) SEAM(8);
    RUN(9, {
        pg8::Gemm g{(const bf16_t*)F.out, wsp<bf16_t>(F, WS_HIDS), LP / 256, wsp<bf16_t>(F, WS_WD), L, D, 2 * DFF}; pg8::StaticOrder S; S.init(L, D, F.G, (int)blockIdx.x);
        pg8::EpiPlain E{wsp<bf16_t>(F, WS_F), D};
        pg8::gemm_phase<pg8::EpiPlain, pg8::StaticOrder, true, true>(stage, g, S, E);
    }) SEAM(9);
    RUN(10, { final_phase(F); })
#undef RUN
#undef IN
#undef SEAM
}

extern "C" void kernel_launch(void* const* d_in, const int* in_sizes, int n_in, void* d_out, int out_size, void* d_ws, size_t ws_size, hipStream_t stream) {
    static int grid = 0;
    if (grid == 0) {
        if (n_in != 23 || in_sizes[0] != LP * D || in_sizes[1] != LS * D || out_size != L * D || ws_size < WS_END) {
            fprintf(stderr, "kernel_launch: unexpected shapes: n_in %d in0 %d out %d ws %zu (need %zu)\n", n_in, n_in > 0 ? in_sizes[0] : -1, out_size, ws_size, (size_t)WS_END); grid = -1; return; }
        int dev = 0, cus = 0, per_cu = 0;
        if (hipGetDevice(&dev) != hipSuccess || hipDeviceGetAttribute(&cus, hipDeviceAttributeMultiprocessorCount, dev) != hipSuccess) { grid = -1; return; }
        if (hipFuncSetAttribute((const void*)fwd_kernel, hipFuncAttributeMaxDynamicSharedMemorySize, LDS_BYTES) != hipSuccess) { fprintf(stderr, "kernel_launch: hipFuncSetAttribute failed\n"); grid = -1; return; }
        if (hipOccupancyMaxActiveBlocksPerMultiprocessor(&per_cu, (const void*)fwd_kernel, NTHR, LDS_BYTES) != hipSuccess || per_cu < 1) { fprintf(stderr, "kernel_launch: occupancy query says %d\n", per_cu); }
        (void)hipGetLastError();
        grid = cus;
    }
    if (grid < 0) return;
    (void)hipMemsetAsync((char*)d_ws + WS_CTL, 0, CTL_ZERO_BYTES, stream);
#ifdef DBG_ZERO_ALL
    (void)hipMemsetAsync((char*)d_ws, 0, WS_END, stream); (void)hipMemsetAsync((char*)d_out, 0, (size_t)L * D * 4, stream);
#endif
    Args a{};
    for (int i = 0; i < 23; ++i) a.in[i] = (const float*)d_in[i];
    a.out = (float*)d_out; a.ws = (unsigned char*)d_ws;
#if MK_N_LAUNCHES == 1
    a.ph_lo = 0; a.ph_hi = NPHASE;
    hipLaunchKernelGGL(fwd_kernel, dim3(grid), dim3(NTHR), LDS_BYTES, stream, a);
#else
    for (int p = 0; p < NPHASE; ++p) {
#ifdef DBG_PH_MASK
        if (!((DBG_PH_MASK >> p) & 1)) continue;
#endif
        a.ph_lo = p; a.ph_hi = p + 1; hipLaunchKernelGGL(fwd_kernel, dim3(grid), dim3(NTHR), LDS_BYTES, stream, a); }
#endif
}
```

```cpp
#include <hip/hip_runtime.h>
#include <cstdio>
#include <cstdint>

#define LAS __attribute__((address_space(3)))
typedef unsigned short bf16_t;
typedef short bf16x8 __attribute__((ext_vector_type(8)));
typedef float f32x4 __attribute__((ext_vector_type(4)));
typedef float f32x2 __attribute__((ext_vector_type(2)));
typedef unsigned u32x4 __attribute__((ext_vector_type(4)));
typedef unsigned u32x2 __attribute__((ext_vector_type(2)));

constexpr int D = 4096, LP = 16384, LS = 8192, L = LP + LS;
constexpr int GRIDW = 64, HD = 128, NH = 16, NAW = 2048, LW = 2048, NBLK = 16, BW = 128, DFF = 11008, INW = 10240;
constexpr float EPS = 1e-6f;
constexpr int NWAVES = 8, NTHR = 512;

constexpr size_t MiB = 1u << 20;
constexpr size_t WS_CTL = 0, CTL_ZERO_BYTES = 64 * 1024;
constexpr size_t WS_RSTD = 1 * MiB;
constexpr size_t WS_RS1 = 1 * MiB + 128 * 1024;
constexpr size_t WS_RS2 = 1 * MiB + 256 * 1024;
constexpr size_t WS_CS = 1 * MiB + 384 * 1024;
constexpr size_t WS_SUM = 2 * MiB;
constexpr size_t WS_WCAT = 8 * MiB;
constexpr size_t WS_W8 = 40 * MiB;
constexpr size_t WS_WVT = 88 * MiB;
constexpr size_t WS_XN8 = 96 * MiB;
constexpr size_t WS_WNO = 192 * MiB;
constexpr size_t WS_WLO = 208 * MiB;
constexpr size_t WS_WO = 224 * MiB;
constexpr size_t WS_WGU = 256 * MiB;
constexpr size_t WS_WD = 342 * MiB;
constexpr size_t WS_WG = 428 * MiB;
constexpr size_t WS_XN = 430 * MiB;
constexpr size_t WS_Q = 622 * MiB;
constexpr size_t WS_XR = 718 * MiB;
constexpr size_t WS_K = 814 * MiB;
constexpr size_t WS_VT = 910 * MiB;
constexpr size_t WS_GR = 1006 * MiB;
constexpr size_t WS_XC = 1102 * MiB;
constexpr size_t WS_END = 1198 * MiB;
constexpr int CS_QKM = 0, CS_V = 12288, CS_GU = 12288 + 2048;
constexpr size_t WS_T1 = WS_K;
constexpr size_t WS_MIX = WS_GR;
constexpr size_t WS_HIDS = WS_Q;
constexpr size_t WS_F = WS_K;
constexpr size_t WS_HF = WS_K;

#define LDS_WAIT() asm volatile("s_waitcnt lgkmcnt(0)" ::: "memory")
#define VM_WAIT() asm volatile("s_waitcnt vmcnt(0)" ::: "memory")
typedef __bf16 bf16x2n_t __attribute__((ext_vector_type(2)));
__device__ __forceinline__ unsigned pk2(float lo, float hi) { const bf16x2n_t r = __builtin_convertvector((f32x2){lo, hi}, bf16x2n_t); return __builtin_bit_cast(unsigned, r); }
__device__ __forceinline__ unsigned f2bf(float f) { return pk2(f, 0.f) & 0xffffu; }
__device__ __forceinline__ float bflo(unsigned u) { return __builtin_bit_cast(float, u << 16); }
__device__ __forceinline__ float bfhi(unsigned u) { return __builtin_bit_cast(float, u & 0xffff0000u); }
__device__ __forceinline__ float bf1(bf16_t u) { return __builtin_bit_cast(float, (unsigned)u << 16); }
__device__ __forceinline__ float wave_sum(float v) {
#pragma unroll
    for (int o = 1; o < 64; o <<= 1) v += __shfl_xor(v, o);
    return v;
}
__device__ __forceinline__ float wave_max(float v) {
#pragma unroll
    for (int o = 1; o < 64; o <<= 1) v = fmaxf(v, __shfl_xor(v, o));
    return v;
}
__device__ __forceinline__ float sigmoidf_(float v) { return __builtin_amdgcn_rcpf(1.0f + __expf(-v)); }
__device__ __forceinline__ float gelu_tanh(float v) { const float y = 0.7978845608f * (v + 0.044715f * v * v * v); const float e = __expf(2.0f * y); return 0.5f * v * (2.0f - 2.0f * __builtin_amdgcn_rcpf(e + 1.0f)); }

namespace pg8 {
constexpr int BM = 256, BK = 64, HALF = 128, HTB = HALF * BK * 2  , STAGE_BYTES = 8 * HTB, NXCD = 8, WGM = 4;

__host__ __device__ __forceinline__ int lds_byte(int r, int c) { return (r >> 3) * 1024 + (r & 7) * 128 + ((((c >> 3) ^ r) & 7) << 4) + (c & 7) * 2; }
__host__ __device__ __forceinline__ void stage_rc(int b, int& R, int& C) { const int ch = b >> 10, rr = (b >> 7) & 7, slot = (b >> 4) & 7; R = ch * 8 + rr; C = ((slot ^ rr) & 7) * 8; }
__host__ __device__ __forceinline__ int perm32(int rho) { const int n = rho >> 4, i = rho & 15; return 8 * (i >> 2) + 4 * n + (i & 3); }

struct Unit { int pm, pn; };
struct Gemm {
    const bf16_t* A; const bf16_t* A2; int pm_split; const bf16_t* Bt; int M, N, rb;
    __device__ __forceinline__ const char* abase(int pm) const { const size_t t = (size_t)BM * rb; return pm < pm_split ? (const char*)A + (size_t)pm * t : (const char*)A2 + (size_t)(pm - pm_split) * t; }
    __device__ __forceinline__ const char* bbase(int pn) const { return (const char*)Bt + (size_t)pn * BM * rb; }
};

struct StaticOrder {
    int nM, nN, nwg, G, c;
    __host__ __device__ void init(int M, int N, int G_, int c_) { nM = M / BM; nN = N / BM; nwg = nM * nN; G = G_; c = c_; }
    __host__ __device__ bool next(int i, Unit& u) const {
        const long Lx = (long)i * G + c; if (Lx >= nwg) return false;
        int wgid = (int)Lx; { const int q = nwg / NXCD, r = nwg % NXCD, xcd = wgid % NXCD, off = wgid / NXCD; wgid = (xcd < r ? xcd * (q + 1) : r * (q + 1) + (xcd - r) * q) + off; }
        const int nig = WGM * nN, gid = wgid / nig, fm = gid * WGM, gsz = (nM - fm) < WGM ? (nM - fm) : WGM;
        u.pm = fm + ((wgid % nig) % gsz); u.pn = (wgid % nig) / gsz; return true;
    }
    __device__ __forceinline__ void a_ready(const Unit&) const {}
    __device__ __forceinline__ void done(const Unit&) const {}
};

typedef int v8i32 __attribute__((ext_vector_type(8)));
typedef int v4i32 __attribute__((ext_vector_type(4)));
typedef __bf16 bf16x2_t __attribute__((ext_vector_type(2)));
__device__ __forceinline__ unsigned cvt_pk_bf16(float lo, float hi) { const bf16x2_t r = __builtin_convertvector((f32x2){lo, hi}, bf16x2_t); return __builtin_bit_cast(unsigned, r); }
__device__ __forceinline__ u32x4 pack8(const f32x4 v0, const f32x4 v1) { u32x4 w; w.x = cvt_pk_bf16(v0[0], v0[1]); w.y = cvt_pk_bf16(v0[2], v0[3]); w.z = cvt_pk_bf16(v1[0], v1[1]); w.w = cvt_pk_bf16(v1[2], v1[3]); return w; }
__device__ __forceinline__ void unpack8(const u32x4 w, f32x4& v0, f32x4& v1) { v0 = (f32x4){bflo(w.x), bfhi(w.x), bflo(w.y), bfhi(w.y)}; v1 = (f32x4){bflo(w.z), bfhi(w.z), bflo(w.w), bfhi(w.w)}; }
__device__ __forceinline__ f32x4 sig4(const f32x4 v) { f32x4 r; r[0] = sigmoidf_(v[0]); r[1] = sigmoidf_(v[1]); r[2] = sigmoidf_(v[2]); r[3] = sigmoidf_(v[3]); return r; }

struct EpiPlain {
    static constexpr bool PERM = true, AFTER_DRAIN = false;
    bf16_t* O; int ldc;
    __device__ __forceinline__ void operator()(const f32x4 (&acc)[2][2][4][2], const Unit& u, int wr, int wc, int fr, int fq) const {
        const int row0 = u.pm * BM + wr * 64 + fr, col0 = u.pn * BM + wc * 32 + 8 * fq;
#pragma unroll
        for (int ai = 0; ai < 2; ++ai)
#pragma unroll
            for (int m = 0; m < 4; ++m) { bf16_t* rowp = O + (size_t)(row0 + ai * HALF + m * 16) * ldc + col0;
#pragma unroll
                for (int bj = 0; bj < 2; ++bj) *(u32x4*)(rowp + bj * HALF) = pack8(acc[ai][bj][m][0], acc[ai][bj][m][1]); }
    }
};
struct EpiVT {
    static constexpr bool PERM = true, AFTER_DRAIN = false;
    bf16_t* O;
    __device__ __forceinline__ void operator()(const f32x4 (&acc)[2][2][4][2], const Unit& u, int wr, int wc, int fr, int fq) const {
        const int row0 = u.pm * BM + wr * 64 + fr, col0 = u.pn * BM + wc * 32 + 8 * fq;
#pragma unroll
        for (int ai = 0; ai < 2; ++ai)
#pragma unroll
            for (int m = 0; m < 4; ++m) { const int row = row0 + ai * HALF + m * 16, hh = row >> 7, d = row & 127;
                const int dt = 2 * (d >> 5) + ((d >> 2) & 1), i = 4 * ((d >> 3) & 3) + (d & 3);
#pragma unroll
                for (int bj = 0; bj < 2; ++bj) { const int tok = col0 + bj * HALF, R = tok >> 6, o = (tok & 63) >> 3;
                    *(u32x4*)(O + ((size_t)((((R * 16 + hh) * 8 + dt) * 8 + o) * 16 + i)) * 8) = pack8(acc[ai][bj][m][0], acc[ai][bj][m][1]); } }
    }
};
struct EpiProj {
    static constexpr bool PERM = true, AFTER_DRAIN = false;
    bf16_t* P0; bf16_t* P1; bf16_t* P2; bf16_t* P3; bf16_t* G; const float* bias; int pn_gate0;
    __device__ __forceinline__ void operator()(const f32x4 (&acc)[2][2][4][2], const Unit& u, int wr, int wc, int fr, int fq) const {
        const int row0 = u.pm * BM + wr * 64 + fr;
        if (u.pn < pn_gate0) {
            const int t = u.pn >> 3; bf16_t* base = t == 0 ? P0 : (t == 1 ? P1 : (t == 2 ? P2 : P3));
            const int col0 = (u.pn & 7) * BM + wc * 32 + 8 * fq;
            if (t == 2) {
#pragma unroll
                for (int ai = 0; ai < 2; ++ai)
#pragma unroll
                    for (int m = 0; m < 4; ++m) { const int tok = row0 + ai * HALF + m * 16, R = tok >> 6, cl = tok & 63;
                        const int tokpart = (((cl >> 2) & 1) * 8 + (cl >> 3)) * 4 + (cl & 3);
#pragma unroll
                        for (int bj = 0; bj < 2; ++bj) { const int c = col0 + bj * HALF, hh = c >> 7, d0 = c & 127;
                            *(u32x4*)(base + ((size_t)(((R * 16 + hh) * 4 + (d0 >> 5)) * 64 + tokpart) * 4 + ((d0 >> 3) & 3)) * 8) = pack8(acc[ai][bj][m][0], acc[ai][bj][m][1]); } }
            } else {
#pragma unroll
            for (int ai = 0; ai < 2; ++ai)
#pragma unroll
                for (int m = 0; m < 4; ++m) { bf16_t* rowp = base + (size_t)(row0 + ai * HALF + m * 16) * NAW + col0;
#pragma unroll
                    for (int bj = 0; bj < 2; ++bj) *(u32x4*)(rowp + bj * HALF) = pack8(acc[ai][bj][m][0], acc[ai][bj][m][1]); }
            }
        } else {
            const int col0 = (u.pn - pn_gate0) * BM + wc * 32 + 8 * fq;
            f32x4 bv[2][2];
#pragma unroll
            for (int bj = 0; bj < 2; ++bj)
#pragma unroll
                for (int n = 0; n < 2; ++n) bv[bj][n] = *(const f32x4*)(bias + col0 + bj * HALF + 4 * n);
#pragma unroll
            for (int ai = 0; ai < 2; ++ai)
#pragma unroll
                for (int m = 0; m < 4; ++m) { bf16_t* rowp = G + (size_t)(row0 + ai * HALF + m * 16) * (2 * D) + col0;
#pragma unroll
                    for (int bj = 0; bj < 2; ++bj) *(u32x4*)(rowp + bj * HALF) = pack8(sig4(acc[ai][bj][m][0] + bv[bj][0]), sig4(acc[ai][bj][m][1] + bv[bj][1])); }
        }
    }
};
template <bool ADD> struct EpiMulG {
    static constexpr bool PERM = true, AFTER_DRAIN = false;
    bf16_t* O; const bf16_t* G; int goff;
    __device__ __forceinline__ void operator()(const f32x4 (&acc)[2][2][4][2], const Unit& u, int wr, int wc, int fr, int fq) const {
        const int row0 = u.pm * BM + wr * 64 + fr, col0 = u.pn * BM + wc * 32 + 8 * fq;
#pragma unroll
        for (int ai = 0; ai < 2; ++ai)
#pragma unroll
            for (int m = 0; m < 4; ++m) { const size_t row = (size_t)(row0 + ai * HALF + m * 16); bf16_t* rowp = O + row * D + col0; const bf16_t* gp = G + row * (2 * D) + goff + col0;
#pragma unroll
                for (int bj = 0; bj < 2; ++bj) {
                    f32x4 g0, g1; unpack8(*(const u32x4*)(gp + bj * HALF), g0, g1);
                    f32x4 v0 = acc[ai][bj][m][0] * g0, v1 = acc[ai][bj][m][1] * g1;
                    if (ADD) { f32x4 t0, t1; unpack8(*(const u32x4*)(rowp + bj * HALF), t0, t1); v0 += t0; v1 += t1; }
                    *(u32x4*)(rowp + bj * HALF) = pack8(v0, v1); } }
    }
};
struct EpiSwiglu {
    static constexpr bool PERM = true, AFTER_DRAIN = false;
    bf16_t* H0; bf16_t* H1; int pm_split;
    __device__ __forceinline__ void operator()(const f32x4 (&acc)[2][2][4][2], const Unit& u, int wr, int wc, int fr, int fq) const {
        bf16_t* base = u.pm < pm_split ? H0 + (size_t)u.pm * BM * DFF : H1 + (size_t)(u.pm - pm_split) * BM * DFF;
        const int row0 = wr * 64 + fr, col0 = u.pn * HALF + wc * 32 + 8 * fq;
#pragma unroll
        for (int ai = 0; ai < 2; ++ai)
#pragma unroll
            for (int m = 0; m < 4; ++m) {
                f32x4 h[2];
#pragma unroll
                for (int n = 0; n < 2; ++n) { const f32x4 g = acc[ai][0][m][n], up = acc[ai][1][m][n];
#pragma unroll
                    for (int j = 0; j < 4; ++j) h[n][j] = g[j] * sigmoidf_(g[j]) * up[j]; }
                *(u32x4*)(base + (size_t)(row0 + ai * HALF + m * 16) * DFF + col0) = pack8(h[0], h[1]); }
    }
};

__device__ __forceinline__ f32x4 deq4(const f32x4 accbits, const float sa, const f32x4 sb) { const v4i32 q = __builtin_bit_cast(v4i32, accbits); return (f32x4){(float)q.x, (float)q.y, (float)q.z, (float)q.w} * sa * sb; }
struct EpiProjQ {
    static constexpr bool PERM = true, AFTER_DRAIN = false;
    bf16_t* Qb; bf16_t* Kb; bf16_t* G; const float* bias; const float* sa; const float* sb;
    __device__ __forceinline__ void operator()(const f32x4 (&acc)[2][2][4][2], const Unit& u, int wr, int wc, int fr, int fq) const {
        const int row0 = u.pm * BM + wr * 64 + fr, cg0 = u.pn * BM + wc * 32 + 8 * fq;
        f32x4 sbv[2][2];
#pragma unroll
        for (int bj = 0; bj < 2; ++bj)
#pragma unroll
            for (int n = 0; n < 2; ++n) sbv[bj][n] = *(const f32x4*)(sb + cg0 + bj * HALF + 4 * n);
        if (u.pn < 8) {
            const int col0 = u.pn * BM + wc * 32 + 8 * fq;
#pragma unroll
            for (int ai = 0; ai < 2; ++ai)
#pragma unroll
                for (int m = 0; m < 4; ++m) { const int row = row0 + ai * HALF + m * 16; const float sr = sa[row]; bf16_t* rowp = Qb + (size_t)row * NAW + col0;
#pragma unroll
                    for (int bj = 0; bj < 2; ++bj) *(u32x4*)(rowp + bj * HALF) = pack8(deq4(acc[ai][bj][m][0], sr, sbv[bj][0]), deq4(acc[ai][bj][m][1], sr, sbv[bj][1])); }
        } else if (u.pn < 16) {
            const int col0 = (u.pn - 8) * BM + wc * 32 + 8 * fq;
#pragma unroll
            for (int ai = 0; ai < 2; ++ai)
#pragma unroll
                for (int m = 0; m < 4; ++m) { const int tok = row0 + ai * HALF + m * 16, R = tok >> 6, cl = tok & 63; const float sr = sa[tok];
                    const int tokpart = (((cl >> 2) & 1) * 8 + (cl >> 3)) * 4 + (cl & 3);
#pragma unroll
                    for (int bj = 0; bj < 2; ++bj) { const int c = col0 + bj * HALF, hh = c >> 7, d0 = c & 127;
                        *(u32x4*)(Kb + ((size_t)(((R * 16 + hh) * 4 + (d0 >> 5)) * 64 + tokpart) * 4 + ((d0 >> 3) & 3)) * 8) = pack8(deq4(acc[ai][bj][m][0], sr, sbv[bj][0]), deq4(acc[ai][bj][m][1], sr, sbv[bj][1])); } }
        } else {
            const int col0 = (u.pn - 16) * BM + wc * 32 + 8 * fq;
            f32x4 bv[2][2];
#pragma unroll
            for (int bj = 0; bj < 2; ++bj)
#pragma unroll
                for (int n = 0; n < 2; ++n) bv[bj][n] = *(const f32x4*)(bias + col0 + bj * HALF + 4 * n);
#pragma unroll
            for (int ai = 0; ai < 2; ++ai)
#pragma unroll
                for (int m = 0; m < 4; ++m) { const int row = row0 + ai * HALF + m * 16; const float sr = sa[row]; bf16_t* rowp = G + (size_t)row * (2 * D) + col0;
#pragma unroll
                    for (int bj = 0; bj < 2; ++bj) *(u32x4*)(rowp + bj * HALF) = pack8(sig4(deq4(acc[ai][bj][m][0], sr, sbv[bj][0]) + bv[bj][0]), sig4(deq4(acc[ai][bj][m][1], sr, sbv[bj][1]) + bv[bj][1])); }
        }
    }
};
struct EpiVTQ {
    static constexpr bool PERM = true, AFTER_DRAIN = false;
    bf16_t* O; const float* sa; const float* sb;
    __device__ __forceinline__ void operator()(const f32x4 (&acc)[2][2][4][2], const Unit& u, int wr, int wc, int fr, int fq) const {
        const int row0 = u.pm * BM + wr * 64 + fr, col0 = u.pn * BM + wc * 32 + 8 * fq;
        f32x4 sbv[2][2];
#pragma unroll
        for (int bj = 0; bj < 2; ++bj)
#pragma unroll
            for (int n = 0; n < 2; ++n) sbv[bj][n] = *(const f32x4*)(sb + col0 + bj * HALF + 4 * n);
#pragma unroll
        for (int ai = 0; ai < 2; ++ai)
#pragma unroll
            for (int m = 0; m < 4; ++m) { const int row = row0 + ai * HALF + m * 16, hh = row >> 7, d = row & 127; const float sr = sa[row];
                const int dt = 2 * (d >> 5) + ((d >> 2) & 1), i = 4 * ((d >> 3) & 3) + (d & 3);
#pragma unroll
                for (int bj = 0; bj < 2; ++bj) { const int tok = col0 + bj * HALF, R = tok >> 6, o = (tok & 63) >> 3;
                    *(u32x4*)(O + ((size_t)((((R * 16 + hh) * 8 + dt) * 8 + o) * 16 + i)) * 8) = pack8(deq4(acc[ai][bj][m][0], sr, sbv[bj][0]), deq4(acc[ai][bj][m][1], sr, sbv[bj][1])); } }
    }
};
struct EpiSwigluQ {
    static constexpr bool PERM = true, AFTER_DRAIN = false;
    bf16_t* H0; bf16_t* H1; int pm_split; const float* sa; const float* sb;
    __device__ __forceinline__ void operator()(const f32x4 (&acc)[2][2][4][2], const Unit& u, int wr, int wc, int fr, int fq) const {
        bf16_t* base = u.pm < pm_split ? H0 + (size_t)u.pm * BM * DFF : H1 + (size_t)(u.pm - pm_split) * BM * DFF;
        const int row0 = wr * 64 + fr, col0 = u.pn * HALF + wc * 32 + 8 * fq, cg0 = u.pn * BM + wc * 32 + 8 * fq;
        f32x4 sbv[2][2];
#pragma unroll
        for (int bj = 0; bj < 2; ++bj)
#pragma unroll
            for (int n = 0; n < 2; ++n) sbv[bj][n] = *(const f32x4*)(sb + cg0 + bj * HALF + 4 * n);
#pragma unroll
        for (int ai = 0; ai < 2; ++ai)
#pragma unroll
            for (int m = 0; m < 4; ++m) { const float sr = sa[u.pm * BM + row0 + ai * HALF + m * 16];
                f32x4 h[2];
#pragma unroll
                for (int n = 0; n < 2; ++n) { const f32x4 g = deq4(acc[ai][0][m][n], sr, sbv[0][n]), up = deq4(acc[ai][1][m][n], sr, sbv[1][n]);
#pragma unroll
                    for (int j = 0; j < 4; ++j) h[n][j] = g[j] * sigmoidf_(g[j]) * up[j]; }
                *(u32x4*)(base + (size_t)(row0 + ai * HALF + m * 16) * DFF + col0) = pack8(h[0], h[1]); }
    }
};

__device__ __forceinline__ v8i32 cat8(const bf16x8 lo, const bf16x8 hi) { return __builtin_shufflevector(__builtin_bit_cast(v4i32, lo), __builtin_bit_cast(v4i32, hi), 0, 1, 2, 3, 4, 5, 6, 7); }
__device__ __forceinline__ void mfma_fp8_acc(f32x4& c, const v8i32 a, const v8i32 b, int sa, int sb) {
    asm volatile("v_mfma_scale_f32_16x16x128_f8f6f4 %0, %1, %2, %0, %3, %4 op_sel_hi:[0,0,0]" : "+v"(c) : "v"(a), "v"(b), "v"(sa), "v"(sb)); }
constexpr int FP8_SCALE = 0x73737373;
template <class Epi, class Sched, bool ALIGN_EPI = false, bool SP2 = false, int QM = 0  , int DBG = 0>
__device__ __forceinline__ void gemm_phase(LAS unsigned char* lds, const Gemm g, const Sched& S, const Epi& E) {
    int tid = threadIdx.x; asm volatile("" : "+v"(tid));
    const int wid = __builtin_amdgcn_readfirstlane(tid >> 6), lane = tid & 63, wr = wid >> 2, wc = wid & 3, fr = lane & 15, fq = lane >> 4;
    const int RB = g.rb, nt = RB / (BK * 2);
    unsigned voffA[2], voffB[2];
#pragma unroll
    for (int i = 0; i < 2; ++i) { int R, C; stage_rc(tid * 16 + i * 8192, R, C); const int Rb = Epi::PERM ? ((R & ~31) + perm32(R & 31)) : R;
        voffA[i] = (unsigned)(R * RB + C * 2); voffB[i] = (unsigned)(Rb * RB + C * 2); }
    const size_t kstep = (size_t)(BK * 2);
    const size_t hstep = (size_t)HALF * RB;
    const unsigned ldsw = (unsigned)wid * 1024u;
    const int aoff0 = lds_byte(wr * 64 + fr, fq * 8), aoff1 = lds_byte(wr * 64 + fr, 32 + fq * 8), boff0 = lds_byte(wc * 32 + fr, fq * 8), boff1 = lds_byte(wc * 32 + fr, 32 + fq * 8);
#define PG8_SA(b, h) (((b) * 2 + (h)) * HTB)
#define PG8_SB(b, h) ((4 + (b) * 2 + (h)) * HTB)
#define PG8_STAGE(bufoff, gbase, voff) do { if constexpr (DBG != 3) _Pragma("unroll") for (int _i = 0; _i < 2; ++_i) \
        __builtin_amdgcn_global_load_lds((const unsigned*)((const char*)(gbase) + (voff)[_i]), (LAS unsigned*)(lds + (bufoff) + ldsw + _i * 8192), 16, 0, 0); } while (0)
#define PG8_LDA(dst, b, h) do { if constexpr (DBG != 2) _Pragma("unroll") for (int m = 0; m < 4; ++m) _Pragma("unroll") for (int k = 0; k < 2; ++k) dst[m][k] = *(const LAS bf16x8*)(lds + PG8_SA(b, h) + (k ? aoff1 : aoff0) + m * 2048); } while (0)
#define PG8_LDB(dst, b, h) do { if constexpr (DBG != 2) _Pragma("unroll") for (int n = 0; n < 2; ++n) _Pragma("unroll") for (int k = 0; k < 2; ++k) dst[n][k] = *(const LAS bf16x8*)(lds + PG8_SB(b, h) + (k ? boff1 : boff0) + n * 2048); } while (0)
#define PG8_MMA(ai, bj, At, Bt) do { __builtin_amdgcn_s_setprio(1); if constexpr (DBG == 1) { } else if constexpr (QM == 2) { _Pragma("unroll") for (int m = 0; m < 4; ++m) _Pragma("unroll") for (int n = 0; n < 2; ++n) _Pragma("unroll") for (int k = 0; k < 2; ++k) \
        acc[ai][bj][m][n] = __builtin_bit_cast(f32x4, __builtin_amdgcn_mfma_i32_16x16x64_i8(__builtin_bit_cast(v4i32, Bt[n][k]), __builtin_bit_cast(v4i32, At[m][k]), __builtin_bit_cast(v4i32, acc[ai][bj][m][n]), 0, 0, 0)); } else if constexpr (QM == 1) { _Pragma("unroll") for (int m = 0; m < 4; ++m) _Pragma("unroll") for (int n = 0; n < 2; ++n) \
        mfma_fp8_acc(acc[ai][bj][m][n], cat8(Bt[n][0], Bt[n][1]), cat8(At[m][0], At[m][1]), fp8_sa, fp8_sb); } else { \
        _Pragma("unroll") for (int m = 0; m < 4; ++m) _Pragma("unroll") for (int n = 0; n < 2; ++n) _Pragma("unroll") for (int k = 0; k < 2; ++k) \
        acc[ai][bj][m][n] = __builtin_amdgcn_mfma_f32_16x16x32_bf16(Bt[n][k], At[m][k], acc[ai][bj][m][n], 0, 0, 0); } __builtin_amdgcn_s_setprio(0); } while (0)
#define PG8_WAIT_V(n) asm volatile("s_waitcnt vmcnt(" #n ")" ::: "memory")
#define PG8_WAIT_L(n) asm volatile("s_waitcnt lgkmcnt(" #n ")" ::: "memory")
#define PG8_BAR __builtin_amdgcn_s_barrier()
#define PG8_SCHED __builtin_amdgcn_sched_barrier(0)
    Unit cur, nxt; int ui = 0;
    const int fp8_sa = FP8_SCALE, fp8_sb = 0x7F7F7F7F;
    if (!S.next(0, cur)) return;
    f32x4 acc[2][2][4][2];
#pragma unroll
    for (int a = 0; a < 2; ++a)
#pragma unroll
        for (int b = 0; b < 2; ++b)
#pragma unroll
            for (int m = 0; m < 4; ++m)
#pragma unroll
                for (int n = 0; n < 2; ++n) acc[a][b][m][n] = (f32x4){0.f, 0.f, 0.f, 0.f};
    bf16x8 At[4][2], B0[2][2], B1[2][2];
    const char* cA = g.abase(cur.pm); const char* cB = g.bbase(cur.pn);
    S.a_ready(cur);
    if constexpr (SP2) {
        PG8_STAGE(PG8_SB(0, 0), cB, voffB); PG8_STAGE(PG8_SB(0, 1), cB + hstep, voffB); PG8_STAGE(PG8_SA(0, 0), cA, voffA); PG8_STAGE(PG8_SA(0, 1), cA + hstep, voffA);
        if (wr == 1) PG8_BAR;
        PG8_WAIT_V(2); PG8_BAR;
        PG8_STAGE(PG8_SB(1, 0), cB + kstep, voffB); PG8_STAGE(PG8_SA(1, 0), cA + kstep, voffA); PG8_STAGE(PG8_SB(1, 1), cB + hstep + kstep, voffB);
        PG8_WAIT_V(6); PG8_BAR;
    } else {
        PG8_STAGE(PG8_SB(0, 0), cB, voffB); PG8_STAGE(PG8_SA(0, 0), cA, voffA); PG8_STAGE(PG8_SB(0, 1), cB + hstep, voffB); PG8_STAGE(PG8_SA(0, 1), cA + hstep, voffA);
        if (wr == 1) PG8_BAR;
        PG8_WAIT_V(4); PG8_BAR;
        PG8_STAGE(PG8_SB(1, 0), cB + kstep, voffB); PG8_STAGE(PG8_SA(1, 0), cA + kstep, voffA); PG8_STAGE(PG8_SB(1, 1), cB + hstep + kstep, voffB);
        PG8_WAIT_V(6); PG8_BAR;
    }
    for (;;) {
        const bool has_next = S.next(ui + 1, nxt);
        const char* nA = has_next ? g.abase(nxt.pm) : cA; const char* nB = has_next ? g.bbase(nxt.pn) : cB;
        for (int t = 0; t < nt; t += 2) {
            const bool last = (t == nt - 2);
            const char* a1 = cA + (size_t)(t + 1) * kstep;
            const char* a2 = last ? nA : cA + (size_t)(t + 2) * kstep; const char* b2 = last ? nB : cB + (size_t)(t + 2) * kstep;
            const char* a3 = a2 + kstep; const char* b3 = b2 + kstep;
            if (last && has_next) S.a_ready(nxt);
            if constexpr (SP2) {
            PG8_LDB(B0, 0, 0); PG8_LDB(B1, 0, 1); PG8_SCHED; PG8_LDA(At, 0, 0); PG8_STAGE(PG8_SA(1, 1), a1 + hstep, voffA);
            PG8_WAIT_V(8); PG8_WAIT_L(0); PG8_BAR; PG8_MMA(0, 0, At, B0); PG8_MMA(0, 1, At, B1); PG8_BAR; PG8_SCHED;
            PG8_LDA(At, 0, 1); PG8_STAGE(PG8_SB(0, 0), b2, voffB); PG8_STAGE(PG8_SB(0, 1), b2 + hstep, voffB); PG8_STAGE(PG8_SA(0, 0), a2, voffA);
            PG8_WAIT_V(8); PG8_WAIT_L(0); PG8_BAR; PG8_MMA(1, 0, At, B0); PG8_MMA(1, 1, At, B1); PG8_BAR; PG8_SCHED;
            PG8_LDB(B0, 1, 0); PG8_LDB(B1, 1, 1); PG8_SCHED; PG8_LDA(At, 1, 0); PG8_STAGE(PG8_SA(0, 1), a2 + hstep, voffA);
            PG8_WAIT_V(8); PG8_WAIT_L(0); PG8_BAR; PG8_MMA(0, 0, At, B0); PG8_MMA(0, 1, At, B1); PG8_BAR; PG8_SCHED;
            PG8_LDA(At, 1, 1); PG8_STAGE(PG8_SB(1, 0), b3, voffB); PG8_STAGE(PG8_SB(1, 1), b3 + hstep, voffB); PG8_STAGE(PG8_SA(1, 0), a3, voffA);
            PG8_WAIT_V(8); PG8_WAIT_L(0); PG8_BAR; PG8_MMA(1, 0, At, B0); PG8_MMA(1, 1, At, B1); PG8_BAR; PG8_SCHED;
            } else {
            PG8_LDB(B0, 0, 0); PG8_SCHED; PG8_LDA(At, 0, 0); PG8_STAGE(PG8_SA(1, 1), a1 + hstep, voffA);
            PG8_WAIT_L(8); PG8_BAR; PG8_WAIT_L(0); PG8_MMA(0, 0, At, B0); PG8_BAR; PG8_SCHED;
            PG8_LDB(B1, 0, 1); PG8_STAGE(PG8_SB(0, 0), b2, voffB);
            PG8_BAR; PG8_WAIT_L(0); PG8_MMA(0, 1, At, B1); PG8_BAR;
            PG8_LDA(At, 0, 1); PG8_STAGE(PG8_SA(0, 0), a2, voffA);
            PG8_BAR; PG8_WAIT_L(0); PG8_MMA(1, 0, At, B0); PG8_BAR; PG8_SCHED;
            PG8_STAGE(PG8_SB(0, 1), b2 + hstep, voffB);
            PG8_WAIT_V(6); PG8_BAR; PG8_MMA(1, 1, At, B1); PG8_BAR;
            PG8_LDB(B0, 1, 0); PG8_SCHED; PG8_LDA(At, 1, 0); PG8_STAGE(PG8_SA(0, 1), a2 + hstep, voffA);
            PG8_WAIT_L(8); PG8_BAR; PG8_WAIT_L(0); PG8_MMA(0, 0, At, B0); PG8_BAR; PG8_SCHED;
            PG8_LDB(B1, 1, 1); PG8_STAGE(PG8_SB(1, 0), b3, voffB);
            PG8_BAR; PG8_WAIT_L(0); PG8_MMA(0, 1, At, B1); PG8_BAR;
            PG8_LDA(At, 1, 1); PG8_STAGE(PG8_SA(1, 0), a3, voffA);
            PG8_BAR; PG8_WAIT_L(0); PG8_MMA(1, 0, At, B0); PG8_BAR; PG8_SCHED;
            PG8_STAGE(PG8_SB(1, 1), b3 + hstep, voffB);
            PG8_WAIT_V(6); PG8_BAR; PG8_MMA(1, 1, At, B1); PG8_BAR;
            }
        }
        if constexpr (ALIGN_EPI) { if (wr == 0) PG8_BAR; }
        if constexpr (!Epi::AFTER_DRAIN) { if constexpr (DBG != 4) E(acc, cur, wr, wc, fr, fq); else { _Pragma("unroll") for (int a_ = 0; a_ < 2; ++a_) _Pragma("unroll") for (int b_ = 0; b_ < 2; ++b_) _Pragma("unroll") for (int m_ = 0; m_ < 4; ++m_) _Pragma("unroll") for (int n_ = 0; n_ < 2; ++n_) asm volatile("" :: "v"(acc[a_][b_][m_][n_])); } S.done(cur); }
        if (!has_next) break;
#pragma unroll
        for (int a = 0; a < 2; ++a)
#pragma unroll
            for (int b = 0; b < 2; ++b)
#pragma unroll
                for (int m = 0; m < 4; ++m)
#pragma unroll
                    for (int n = 0; n < 2; ++n) acc[a][b][m][n] = (f32x4){0.f, 0.f, 0.f, 0.f};
        cur = nxt; cA = nA; cB = nB; ++ui;
        if constexpr (ALIGN_EPI) { if (wr == 1) PG8_BAR; }
    }
    PG8_WAIT_V(0);
    if constexpr (!ALIGN_EPI) { if (wr == 0) PG8_BAR; }
    PG8_BAR;
    if constexpr (Epi::AFTER_DRAIN) { E.fused(acc, cur, wr, wc, fr, fq, lds, wid, lane); S.done(cur); }
#undef PG8_SA
#undef PG8_SB
#undef PG8_STAGE
#undef PG8_LDA
#undef PG8_LDB
#undef PG8_MMA
#undef PG8_WAIT_V
#undef PG8_WAIT_L
#undef PG8_BAR
#undef PG8_SCHED
}
}
#define XB_TMO      128
#define XB_XCNT(j)  (256  + 64 * (j))
#define XB_XSUB(j)  (1280 + 64 * (j))
#define XB_XGEN(j)  (2304 + 64 * (j))
#define XB_TOP      3328
#define XB_TOPGEN   3392
#define XCD_BAR_WORDS 3456
#define XB_SPIN_CAP (1u << 18)

__device__ __forceinline__ unsigned xb_ld(unsigned* p)              { return __hip_atomic_load(p, __ATOMIC_RELAXED, __HIP_MEMORY_SCOPE_AGENT); }
__device__ __forceinline__ unsigned xb_add(unsigned* p, unsigned v) { return __hip_atomic_fetch_add(p, v, __ATOMIC_RELAXED, __HIP_MEMORY_SCOPE_AGENT); }
__device__ __forceinline__ unsigned xb_xcc_id() { return (unsigned)__builtin_amdgcn_s_getreg((3 << 11) | 20) & 0xFu; }
#define XB_SPIN(cond, bar) do { unsigned _sp = 0; while (cond) { __builtin_amdgcn_s_sleep(1); \
    if ((++_sp & 255u) == 0u) { if (xb_ld(&(bar)[XB_TMO])) break; if (_sp > XB_SPIN_CAP) { atomicAdd(&(bar)[XB_TMO], 1u); break; } } } } while (0)

struct XcdBarrier {
    unsigned* bar; unsigned x;
    volatile LAS unsigned* st;
};

__device__ __forceinline__ XcdBarrier xcd_barrier_post(unsigned* bar, volatile LAS unsigned* st) {
    XcdBarrier b; b.bar = bar; b.x = xb_xcc_id(); b.st = st;
    if (threadIdx.x == 0) (void)xb_add(&bar[XB_XCNT(b.x)], 1u);
    return b;
}
__device__ __forceinline__ void xcd_barrier_complete(unsigned* bar, unsigned x, unsigned& nloc, unsigned& nx) {
    const unsigned G = gridDim.x * gridDim.y * gridDim.z;
    unsigned sum, cnt, mine, sp = 0u;
    for (;;) {
        sum = 0u; cnt = 0u; mine = 0u;
#pragma unroll
        for (unsigned j = 0; j < 16; ++j) { const unsigned c = xb_ld(&bar[XB_XCNT(j)]); sum += c; cnt += (c > 0u) ? 1u : 0u; mine = (j == x) ? c : mine; }
        if (sum == G) break;
        __builtin_amdgcn_s_sleep(1);
        if ((++sp & 255u) == 0u) { if (xb_ld(&bar[XB_TMO])) break; if (sp > XB_SPIN_CAP) { atomicAdd(&bar[XB_TMO], 1u); break; } }
    }
    nloc = mine > 0u ? mine : 1u; nx = cnt > 0u ? cnt : 1u;
}

__device__ __forceinline__ void xcd_barrier(const XcdBarrier& b) {
    asm volatile("s_waitcnt vmcnt(0)" ::: "memory");
    __syncthreads();
    if (threadIdx.x == 0) {
        unsigned* bar = b.bar;
        __builtin_amdgcn_s_waitcnt(0);
        unsigned nloc = b.st[0], nx = b.st[1];
        if (nloc == 0u) { xcd_barrier_complete(bar, b.x, nloc, nx); b.st[0] = nloc; b.st[1] = nx; }
        const unsigned old = xb_add(&bar[XB_XSUB(b.x)], 1u);
        const unsigned gen = old / nloc;
        if (old + 1u == (gen + 1u) * nloc) {
            __builtin_amdgcn_fence(__ATOMIC_RELEASE, "agent");
            asm volatile("s_waitcnt vmcnt(0)" ::: "memory");
            const unsigned og = xb_add(&bar[XB_TOP], 1u);
            const unsigned tg = og / nx;
            if (og + 1u == (tg + 1u) * nx) xb_add(&bar[XB_TOPGEN], 1u);
            else XB_SPIN(xb_ld(&bar[XB_TOPGEN]) == tg, bar);
            __builtin_amdgcn_fence(__ATOMIC_ACQUIRE, "agent");
            xb_add(&bar[XB_XGEN(b.x)], 1u);
            asm volatile("s_waitcnt vmcnt(0)" ::: "memory");
        } else {
            XB_SPIN(xb_ld(&bar[XB_XGEN(b.x)]) == gen, bar);
            __builtin_amdgcn_fence(__ATOMIC_ACQUIRE, "agent");
            asm volatile("s_waitcnt vmcnt(0)" ::: "memory");
        }
    }
    __syncthreads();
}


struct Frame {
    LAS unsigned char* lds;
    int tid, lane, wave, G, gw, ngw;
    const float *in_XP, *in_XS, *in_WIN, *in_WCONV, *in_BCONV, *in_WR, *in_BR, *in_WI, *in_BI, *in_LAM, *in_RPB, *in_WNO, *in_WLO, *in_WM, *in_BM, *in_WOUT, *in_GMPRE, *in_GMPOST, *in_GFPRE, *in_GFPOST, *in_WFG, *in_WFU, *in_WFD; float* out; unsigned char* ws;
};
enum { I_XP = 0, I_XS, I_WIN, I_WCONV, I_BCONV, I_WR, I_BR, I_WI, I_BI, I_LAM, I_RPB, I_WNO, I_WLO, I_WM, I_BM, I_WOUT, I_GMPRE, I_GMPOST, I_GFPRE, I_GFPOST, I_WFG, I_WFU, I_WFD };
__device__ __forceinline__ int opaque(int x) { asm volatile("" : "+v"(x)); return x; }
template <class T> __device__ __forceinline__ T* wsp(const Frame& F, size_t off) { return (T*)(F.ws + off); }
__device__ __forceinline__ const float* xrow(const Frame& F, int m) { return m < LP ? F.in_XP + (size_t)m * D : F.in_XS + (size_t)(m - LP) * D; }

__device__ __forceinline__ void tr_item(const float* src, int ldsrc, int k0, int n0, bf16_t* dst, int ldd, int drow0, LAS float* scr, int lane) {
#pragma unroll 8
    for (int i = 0; i < 32; ++i) { const int kk = 2 * i + (lane >> 5); scr[kk * 33 + (lane & 31)] = src[(size_t)(k0 + kk) * ldsrc + n0 + (lane & 31)]; }
    LDS_WAIT(); asm volatile("" ::: "memory");
    const int c = lane & 7;
#pragma unroll
    for (int j = 0; j < 4; ++j) { const int n = (lane >> 3) + 8 * j; const LAS float* s = scr + (8 * c) * 33 + n;
        u32x4 o; o.x = pk2(s[0 * 33], s[1 * 33]); o.y = pk2(s[2 * 33], s[3 * 33]); o.z = pk2(s[4 * 33], s[5 * 33]); o.w = pk2(s[6 * 33], s[7 * 33]);
        *(u32x4*)(dst + (size_t)(drow0 + n) * ldd + k0 + 8 * c) = o; }
    LDS_WAIT(); asm volatile("" ::: "memory");
}
__device__ __forceinline__ unsigned pk4_fp8(float a, float b, float c, float d) { int p = __builtin_amdgcn_cvt_pk_fp8_f32(a, b, 0, false); p = __builtin_amdgcn_cvt_pk_fp8_f32(c, d, p, true); return (unsigned)p; }
__device__ __forceinline__ void tr_item8(const float* src, int ldsrc, int k0, int n0, unsigned char* dst, int ldd, int drow0, LAS float* scr, int lane) {
#pragma unroll 8
    for (int i = 0; i < 32; ++i) { const int kk = 2 * i + (lane >> 5); scr[kk * 33 + (lane & 31)] = src[(size_t)(k0 + kk) * ldsrc + n0 + (lane & 31)]; }
    LDS_WAIT(); asm volatile("" ::: "memory");
    const int c = lane & 7;
#pragma unroll
    for (int j = 0; j < 4; ++j) { const int n = (lane >> 3) + 8 * j; const LAS float* s = scr + (8 * c) * 33 + n;
        u32x2 o; o.x = pk4_fp8(s[0 * 33] * 256.f, s[1 * 33] * 256.f, s[2 * 33] * 256.f, s[3 * 33] * 256.f); o.y = pk4_fp8(s[4 * 33] * 256.f, s[5 * 33] * 256.f, s[6 * 33] * 256.f, s[7 * 33] * 256.f);
        *(u32x2*)(dst + (size_t)(drow0 + n) * ldd + k0 + 8 * c) = o; }
    LDS_WAIT(); asm volatile("" ::: "memory");
}
__device__ __forceinline__ unsigned pk4_i8(float a, float b, float c, float d) { return ((unsigned)(int)a & 255u) | (((unsigned)(int)b & 255u) << 8) | (((unsigned)(int)c & 255u) << 16) | ((unsigned)(int)d << 24); }
__device__ __forceinline__ void tr_strip_i8(const float* src, int ldsrc, int K, int n0, signed char* dst, int drow0, float* cs, LAS float* scr, int lane) {
    const float* sp = src + n0 + (lane & 31) + (size_t)(lane >> 5) * ldsrc;
    float mx = 0.f;
    { const float* p = sp; const size_t step = (size_t)2 * ldsrc;
      for (int k0 = 0; k0 < K; k0 += 64) {
        float t[32];
#pragma unroll
        for (int i = 0; i < 32; ++i) { t[i] = *p; p += step; }
#pragma unroll
        for (int i = 0; i < 32; ++i) mx = fmaxf(mx, fabsf(t[i]));
      } }
    mx = fmaxf(mx, __shfl_xor(mx, 32));
    const float amax = fmaxf(mx, 1e-20f), inv = 127.0f / amax;
    if (lane < 32) cs[drow0 + lane] = amax * (1.0f / 127.0f);
    const int c = lane & 7;
    for (int k0 = 0; k0 < K; k0 += 64) {
        { const float* p = sp + (size_t)k0 * ldsrc; const size_t step = (size_t)2 * ldsrc; LAS float* w = scr + (lane >> 5) * 33 + (lane & 31);
          float t[32];
#pragma unroll
          for (int i = 0; i < 32; ++i) { t[i] = *p; p += step; }
#pragma unroll
          for (int i = 0; i < 32; ++i) w[i * 66] = rintf(t[i] * inv); }
        LDS_WAIT(); asm volatile("" ::: "memory");
#pragma unroll
        for (int j = 0; j < 4; ++j) { const int n = (lane >> 3) + 8 * j; const LAS float* t = scr + (8 * c) * 33 + n;
            u32x2 o; o.x = pk4_i8(t[0 * 33], t[1 * 33], t[2 * 33], t[3 * 33]); o.y = pk4_i8(t[4 * 33], t[5 * 33], t[6 * 33], t[7 * 33]);
            *(u32x2*)(dst + (size_t)(drow0 + n) * K + k0 + 8 * c) = o; }
        LDS_WAIT(); asm volatile("" ::: "memory");
    }
}
#define TR_JOB(SRC, LDSRC, KK, NN, DST, DROW_EXPR) { const int nblk = (NN) / 32, nit = ((KK) / 64) * nblk; \
    if (r < nit) { const int kb = r / nblk, nb = r % nblk, n0 = 32 * nb; tr_item((SRC), (LDSRC), 64 * kb, n0, (DST), (KK), (DROW_EXPR), scr, F.lane); continue; } r -= nit; }
#define TR_JOB8(SRC, LDSRC, KK, NN, DST, DROW_EXPR) { const int nblk = (NN) / 32, nit = ((KK) / 64) * nblk; \
    if (r < nit) { const int kb = r / nblk, nb = r % nblk, n0 = 32 * nb; tr_item8((SRC), (LDSRC), 64 * kb, n0, (DST), (KK), (DROW_EXPR), scr, F.lane); continue; } r -= nit; }

__device__ __forceinline__ void p0_prologue(Frame& F) {
    const int tid_ = opaque(F.tid);
    LAS float* scr = (LAS float*)(F.lds + F.wave * 8448);
    const float* w_in = F.in_WIN;
    bf16_t* WCAT = wsp<bf16_t>(F, WS_WCAT); signed char* W8 = wsp<signed char>(F, WS_W8); signed char* WV8 = wsp<signed char>(F, WS_WVT); signed char* WGU8 = wsp<signed char>(F, WS_WGU);
    float* CS = wsp<float>(F, WS_CS);
    constexpr int NSM = 64;
    constexpr int IT_SM = 2 * 4;
    constexpr int S_Q = NAW / 32, S_M = 2 * D / 32, S_F = DFF / 32;
    constexpr int NSTRIP = 3 * S_Q + S_M + 2 * S_F;
    constexpr int N_BIG = 2 * (D / 64) * (NAW / 32) + 2 * (NAW / 64) * (D / 32) + (D / 64) * (D / 32) + (DFF / 64) * (D / 32);
    constexpr int NITEMS = N_BIG + NSM * IT_SM;
    for (int it = F.gw; it < NSTRIP + NITEMS; it += F.ngw) {
        if (it < NSTRIP) {
            int q = it; const float* src; int ld, n0, drow0; signed char* dst; float* cs;
            if (q < S_Q) { src = w_in; ld = INW; n0 = 32 * q; dst = W8; drow0 = n0; cs = CS + CS_QKM; }
            else if ((q -= S_Q) < S_Q) { src = w_in + NAW; ld = INW; n0 = 32 * q; dst = W8; drow0 = 2048 + n0; cs = CS + CS_QKM; }
            else if ((q -= S_Q) < S_M) { src = F.in_WM; ld = 2 * D; n0 = 32 * q; dst = W8; drow0 = 4096 + n0; cs = CS + CS_QKM; }
            else if ((q -= S_M) < S_Q) { src = w_in + 2 * NAW; ld = INW; n0 = 32 * q; dst = WV8; drow0 = n0; cs = CS + CS_V; }
            else if ((q -= S_Q) < S_F) { src = F.in_WFG; ld = DFF; n0 = 32 * q; dst = WGU8; drow0 = (n0 >> 7) * 256 + (n0 & 127); cs = CS + CS_GU; }
            else { q -= S_F; src = F.in_WFU; ld = DFF; n0 = 32 * q; dst = WGU8; drow0 = (n0 >> 7) * 256 + 128 + (n0 & 127); cs = CS + CS_GU; }
            tr_strip_i8(src, ld, D, n0, dst, drow0, cs, scr, F.lane);
            continue;
        }
        int r = it - NSTRIP;
        TR_JOB(w_in + 3 * NAW, INW, D, NAW, WCAT, 0 + n0)
        TR_JOB(w_in + 4 * NAW, INW, D, NAW, WCAT, 2048 + n0)
        TR_JOB(F.in_WNO, D, NAW, D, wsp<bf16_t>(F, WS_WNO), n0)
        TR_JOB(F.in_WLO, D, LW, D, wsp<bf16_t>(F, WS_WLO), n0)
        TR_JOB(F.in_WOUT, D, D, D, wsp<bf16_t>(F, WS_WO), n0)
        TR_JOB(F.in_WFD, D, DFF, D, wsp<bf16_t>(F, WS_WD), n0)
        {
            const int mi = r / IT_SM, ri = r % IT_SM, d = mi >> 5, g = (mi >> 4) & 1, n = mi & 15, kb = ri >> 2, nb = ri & 3;
            const float* src = (g ? F.in_WI : F.in_WR) + (size_t)(d * NBLK + n) * BW * BW;
            tr_item(src, BW, 64 * kb, 32 * nb, wsp<bf16_t>(F, WS_WG) + (size_t)mi * BW * BW, BW, 32 * nb, scr, F.lane);
        }
    }
    LAS f32x4* gl = (LAS f32x4*)(F.lds + 69632);
    for (int i = tid_; i < D / 4; i += NTHR) gl[i] = ((const f32x4*)F.in_GMPRE)[i];
    __syncthreads();
    bf16_t* XN = wsp<bf16_t>(F, WS_XN); signed char* XN8 = wsp<signed char>(F, WS_XN8); float* RS1 = wsp<float>(F, WS_RS1);
    for (int m = F.gw; m < L; m += F.ngw) {
        asm volatile("" ::: "memory");
        const f32x4* xr = (const f32x4*)xrow(F, m) + F.lane;
        f32x4 v[16]; float s = 0.f;
#pragma unroll
        for (int j = 0; j < 16; ++j) { v[j] = xr[64 * j]; s += (v[j].x * v[j].x + v[j].y * v[j].y) + (v[j].z * v[j].z + v[j].w * v[j].w); }
        const float rstd = 1.0f / sqrtf(wave_sum(s) * (1.0f / D) + EPS);
        u32x2* o8 = (u32x2*)(XN + (size_t)m * D) + F.lane; unsigned* o4 = (unsigned*)(XN8 + (size_t)m * D) + F.lane;
        float mx = 0.f;
#pragma unroll
        for (int j = 0; j < 16; ++j) { v[j] = v[j] * rstd * gl[F.lane + 64 * j]; mx = fmaxf(fmaxf(mx, fmaxf(fabsf(v[j].x), fabsf(v[j].y))), fmaxf(fabsf(v[j].z), fabsf(v[j].w))); }
        const float amax = fmaxf(wave_max(mx), 1e-20f), inv = 127.0f / amax;
        if (F.lane == 0) RS1[m] = amax * (1.0f / 127.0f);
#pragma unroll
        for (int j = 0; j < 16; ++j) { const f32x4 y = v[j]; u32x2 o; o.x = pk2(y.x, y.y); o.y = pk2(y.z, y.w); o8[64 * j] = o;
            o4[64 * j] = pk4_i8(rintf(y.x * inv), rintf(y.y * inv), rintf(y.z * inv), rintf(y.w * inv)); }
    }
    __syncthreads();
}

#ifndef ATT_SYNC
#define ATT_SYNC 1
#endif
template <int ADBG = 0> __device__ __forceinline__ void attn_mfma(Frame& F) {
    const int tid_ = opaque(F.tid);
    bf16_t* Q = wsp<bf16_t>(F, WS_Q); const bf16_t* Kb = wsp<bf16_t>(F, WS_K); const bf16_t* VT = wsp<bf16_t>(F, WS_VT);
    LAS float* rp = (LAS float*)F.lds;
    for (int i = tid_; i < NH * 15 * 31; i += NTHR) rp[i] = F.in_RPB[i];
    __syncthreads();
    const int fr = F.lane & 15, fq = F.lane >> 4;
    const float scale = 0.08838834764831845f;
    for (int base = blockIdx.x * NWAVES; base < (L / GRIDW) * NH * 4; base += F.ngw) {
        const int item = base + F.wave;
        asm volatile("" ::: "memory");
        const int g = item & 3, h = (item >> 2) & 15, rg = item >> 6;
        const int s0 = rg < LP / GRIDW ? 0 : LP, rows = rg < LP / GRIDW ? LP / GRIDW : LS / GRIDW, r = rg < LP / GRIDW ? rg : rg - LP / GRIDW;
        int rs = r - 4; rs = rs < 0 ? 0 : (rs > rows - 8 ? rows - 8 : rs);
        const int w0 = g == 0 ? 0 : (g == 1 ? 8 : (g == 2 ? 24 : 32));
        const int c = 16 * g + fr;
        int cs = c - 8; cs = cs < 0 ? 0 : (cs > GRIDW - 16 ? GRIDW - 16 : cs);
        bf16_t* qrow = Q + (size_t)(s0 + r * GRIDW + c) * NAW + h * HD;
        bf16x8 qf[4];
#pragma unroll
        for (int s = 0; s < 4; ++s) qf[s] = *(const bf16x8*)(qrow + 8 * fq + 32 * s);
        f32x4 sacc[8][2];
        const int Rg = s0 / GRIDW + rs, p0 = w0 >> 3;
        const bf16_t* kbase = Kb + (size_t)(Rg * 16 + h) * 8192 + p0 * 128 + fr * 32 + fq * 8;
        bf16x8 kb[8][2][4];
#define ATT_LDK(kr) do { _Pragma("unroll") for (int T = 0; T < 2; ++T) _Pragma("unroll") for (int s = 0; s < 4; ++s) kb[kr][T][s] = (ADBG & 1) ? qf[s] : (ADBG & 4) ? *(const bf16x8*)(Kb + (size_t)(s0 + rs * GRIDW) * NAW + h * HD * GRIDW + ((kr) * 8 + T * 4 + s) * 512 + F.lane * 8) : *(const bf16x8*)(kbase + (size_t)(kr) * (16 * 8192) + (s * 2 + T) * 1024); } while (0)
        ATT_LDK(0); ATT_LDK(1);
#pragma unroll
        for (int kr = 0; kr < 8; ++kr) {
            if (ATT_SYNC && (kr & 1) == 0) __builtin_amdgcn_s_barrier();
            if (kr + 2 < 8) ATT_LDK(kr + 2);
            __builtin_amdgcn_sched_barrier(0);
#pragma unroll
            for (int T = 0; T < 2; ++T) { f32x4 a = (f32x4){0.f, 0.f, 0.f, 0.f};
#pragma unroll
                for (int s = 0; s < 4; ++s) a = __builtin_amdgcn_mfma_f32_16x16x32_bf16(kb[kr][T][s], qf[s], a, 0, 0, 0);
                sacc[kr][T] = a; }
            __builtin_amdgcn_sched_barrier(0);
        }
#undef ATT_LDK
        bf16x8 vb[8][8];
        const bf16_t* vbase = VT + (size_t)(Rg * 16 + h) * 8192 + p0 * 128 + fq * 128 + fr * 8;
#define ATT_LDV(kr) do { _Pragma("unroll") for (int dt = 0; dt < 8; ++dt) vb[kr][dt] = (ADBG & 2) ? qf[dt & 3] : (ADBG & 4) ? *(const bf16x8*)(VT + (size_t)(h * HD) * L + s0 + rs * GRIDW + ((kr) * 8 + dt) * 512 + F.lane * 8) : *(const bf16x8*)(vbase + (size_t)(kr) * (16 * 8192) + dt * 1024); } while (0)
        ATT_LDV(0); ATT_LDV(1);
        __builtin_amdgcn_sched_barrier(0);
        const int elo = cs - w0 - 8 * fq, dc0 = w0 + 8 * fq - c + 15;
        const LAS float* rph = rp + h * 465 + (rs - r + 7) * 31;
        float mx = -3.0e38f;
#pragma unroll
        for (int e = 0; e < 8; ++e) { const bool valid = (e >= elo) && (e < elo + 16); const int bi = valid ? dc0 + e : 0;
#pragma unroll
            for (int kr = 0; kr < 8; ++kr) { const float sv = valid ? sacc[kr][e >> 2][e & 3] * scale + rph[kr * 31 + bi] : -3.0e38f; sacc[kr][e >> 2][e & 3] = sv; mx = fmaxf(mx, sv); } }
        mx = fmaxf(mx, __shfl_xor(mx, 16)); mx = fmaxf(mx, __shfl_xor(mx, 32));
        float lsum = 0.f; bf16x8 pf[8];
#pragma unroll
        for (int kr = 0; kr < 8; ++kr) { float p[8];
#pragma unroll
            for (int e = 0; e < 8; ++e) { p[e] = __expf(sacc[kr][e >> 2][e & 3] - mx); lsum += p[e]; }
            u32x4 w; w.x = pk2(p[0], p[1]); w.y = pk2(p[2], p[3]); w.z = pk2(p[4], p[5]); w.w = pk2(p[6], p[7]);
            pf[kr] = __builtin_bit_cast(bf16x8, w); }
        lsum += __shfl_xor(lsum, 16); lsum += __shfl_xor(lsum, 32);
        f32x4 oacc[8];
#pragma unroll
        for (int dt = 0; dt < 8; ++dt) oacc[dt] = (f32x4){0.f, 0.f, 0.f, 0.f};
#pragma unroll
        for (int kr = 0; kr < 8; ++kr) {
            if (ATT_SYNC && (kr & 1) == 0) __builtin_amdgcn_s_barrier();
            if (kr + 2 < 8) ATT_LDV(kr + 2);
            __builtin_amdgcn_sched_barrier(0);
#pragma unroll
            for (int dt = 0; dt < 8; ++dt) oacc[dt] = __builtin_amdgcn_mfma_f32_16x16x32_bf16(vb[kr][dt], pf[kr], oacc[dt], 0, 0, 0);
            __builtin_amdgcn_sched_barrier(0);
        }
#undef ATT_LDV
        const float inv = 1.0f / lsum;
#ifdef ATTN_OUT_OFF
        bf16_t* orow = wsp<bf16_t>(F, (size_t)ATTN_OUT_OFF * MiB) + (size_t)(s0 + r * GRIDW + c) * NAW + h * HD;
#else
        bf16_t* orow = qrow;
#endif
#pragma unroll
        for (int u = 0; u < 4; ++u) *(u32x4*)(orow + 32 * u + 8 * fq) = pg8::pack8(oacc[2 * u] * inv, oacc[2 * u + 1] * inv);
    }
    __syncthreads();
}

__device__ __forceinline__ void attn_mfma_lds(Frame& F) {
    const int tid_ = opaque(F.tid);
    bf16_t* Q = wsp<bf16_t>(F, WS_Q); const bf16_t* Kb = wsp<bf16_t>(F, WS_K); const bf16_t* VT = wsp<bf16_t>(F, WS_VT);
    LAS float* rp = (LAS float*)F.lds;
    LAS unsigned char* ring = F.lds + 30720;
    for (int i = tid_; i < NH * 15 * 31; i += NTHR) rp[i] = F.in_RPB[i];
    __syncthreads();
    const int lane = tid_ & 63, fr = lane & 15, fq = lane >> 4, w = F.wave, hl = w >> 2, g = w & 3;
    const float scale = 0.08838834764831845f;
    constexpr int NIT = (L / GRIDW) * NH * 4;
    const int w0 = g == 0 ? 0 : (g == 1 ? 8 : (g == 2 ? 24 : 32)), p0 = w0 >> 3;
    const int c = 16 * g + fr;
    int cs = c - 8; cs = cs < 0 ? 0 : (cs > GRIDW - 16 ? GRIDW - 16 : cs);
#define ATL_SRC(b, st) ([&]() -> const bf16_t* { const int rg_ = (b) >> 6, hb_ = ((b) >> 2) & 15; const int rows_ = rg_ < LP / GRIDW ? LP / GRIDW : LS / GRIDW, r_ = rg_ < LP / GRIDW ? rg_ : rg_ - LP / GRIDW; \
        int rs_ = r_ - 4; rs_ = rs_ < 0 ? 0 : (rs_ > rows_ - 8 ? rows_ - 8 : rs_); const int Rg_ = (rg_ < LP / GRIDW ? 0 : LP / GRIDW) + rs_; \
        return ((st) < 8 ? Kb : VT) + (size_t)((Rg_ + ((st) & 7)) * 16 + hb_) * 8192; }())
#define ATL_ISSUE(src, slot) do { const bf16_t* s_ = (src) + tid_ * 8; LAS unsigned char* d_ = ring + (slot) * 32768 + w * 1024; _Pragma("unroll") for (int k_ = 0; k_ < 4; ++k_) \
        __builtin_amdgcn_global_load_lds((const unsigned*)(s_ + k_ * 4096), (LAS unsigned*)(d_ + k_ * 8192), 16, 0, 0); } while (0)
    int base = blockIdx.x * NWAVES;
    if (base < NIT) { ATL_ISSUE(ATL_SRC(base, 0), 0); ATL_ISSUE(ATL_SRC(base, 1), 1); }
    int b0 = 0;
    for (; base < NIT; base += F.ngw) {
        asm volatile("" ::: "memory");
        const int h = ((base >> 2) & 15) + hl, rg = base >> 6;
        const int s0 = rg < LP / GRIDW ? 0 : LP, rows = rg < LP / GRIDW ? LP / GRIDW : LS / GRIDW, r = rg < LP / GRIDW ? rg : rg - LP / GRIDW;
        int rs = r - 4; rs = rs < 0 ? 0 : (rs > rows - 8 ? rows - 8 : rs);
        const int nbase = base + F.ngw < NIT ? base + F.ngw : base;
        bf16_t* qrow = Q + (size_t)(s0 + r * GRIDW + c) * NAW + h * HD;
        bf16x8 qf[4];
#pragma unroll
        for (int s = 0; s < 4; ++s) qf[s] = *(const bf16x8*)(qrow + 8 * fq + 32 * s);
        f32x4 sacc[8][2]; f32x4 oacc[8]; bf16x8 pf[8]; float lsum = 0.f;
#pragma unroll
        for (int dt = 0; dt < 8; ++dt) oacc[dt] = (f32x4){0.f, 0.f, 0.f, 0.f};
        const int koff = hl * 16384 + (p0 * 128 + fr * 32 + fq * 8) * 2, voff = hl * 16384 + (p0 * 128 + fq * 128 + fr * 8) * 2;
#pragma unroll
        for (int st = 0; st < 16; ++st) {
            asm volatile("s_waitcnt vmcnt(4)" ::: "memory"); asm volatile("s_waitcnt lgkmcnt(0)" ::: "memory"); __builtin_amdgcn_s_barrier(); asm volatile("" ::: "memory");
            { const int slot2 = (b0 + st + 2) % 3; if (st + 2 < 16) ATL_ISSUE(ATL_SRC(base, st + 2), slot2); else ATL_ISSUE(ATL_SRC(nbase, st + 2 - 16), slot2); }
            const LAS unsigned char* buf = ring + ((b0 + st) % 3) * 32768;
            if (st < 8) {
#pragma unroll
                for (int T = 0; T < 2; ++T) { f32x4 a = (f32x4){0.f, 0.f, 0.f, 0.f};
#pragma unroll
                    for (int s2 = 0; s2 < 4; ++s2) a = __builtin_amdgcn_mfma_f32_16x16x32_bf16(*(const LAS bf16x8*)(buf + koff + (s2 * 2 + T) * 2048), qf[s2], a, 0, 0, 0);
                    sacc[st][T] = a; }
            } else {
                if (st == 8) {
                    const int elo = cs - w0 - 8 * fq, dc0 = w0 + 8 * fq - c + 15;
                    const LAS float* rph = rp + h * 465 + (rs - r + 7) * 31;
                    float mx = -3.0e38f;
#pragma unroll
                    for (int e = 0; e < 8; ++e) { const bool valid = (e >= elo) && (e < elo + 16); const int bi = valid ? dc0 + e : 0;
#pragma unroll
                        for (int kr = 0; kr < 8; ++kr) { const float sv = valid ? sacc[kr][e >> 2][e & 3] * scale + rph[kr * 31 + bi] : -3.0e38f; sacc[kr][e >> 2][e & 3] = sv; mx = fmaxf(mx, sv); } }
                    mx = fmaxf(mx, __shfl_xor(mx, 16)); mx = fmaxf(mx, __shfl_xor(mx, 32));
#pragma unroll
                    for (int kr = 0; kr < 8; ++kr) { float p[8];
#pragma unroll
                        for (int e = 0; e < 8; ++e) { p[e] = __expf(sacc[kr][e >> 2][e & 3] - mx); lsum += p[e]; }
                        u32x4 wv; wv.x = pk2(p[0], p[1]); wv.y = pk2(p[2], p[3]); wv.z = pk2(p[4], p[5]); wv.w = pk2(p[6], p[7]);
                        pf[kr] = __builtin_bit_cast(bf16x8, wv); }
                    lsum += __shfl_xor(lsum, 16); lsum += __shfl_xor(lsum, 32);
                }
#pragma unroll
                for (int dt = 0; dt < 8; ++dt) oacc[dt] = __builtin_amdgcn_mfma_f32_16x16x32_bf16(*(const LAS bf16x8*)(buf + voff + dt * 2048), pf[st - 8], oacc[dt], 0, 0, 0);
            }
        }
        b0 = (b0 + 16) % 3;
        const float inv = 1.0f / lsum;
#pragma unroll
        for (int u = 0; u < 4; ++u) *(u32x4*)(qrow + 32 * u + 8 * fq) = pg8::pack8(oacc[2 * u] * inv, oacc[2 * u + 1] * inv);
    }
#undef ATL_SRC
#undef ATL_ISSUE
    asm volatile("s_waitcnt vmcnt(0)" ::: "memory");
    __syncthreads();
}

__device__ __forceinline__ void conv_phase(Frame& F) {
    const int tid_ = opaque(F.tid);
    const bf16_t* XR = wsp<bf16_t>(F, WS_XR); bf16_t* XC = wsp<bf16_t>(F, WS_XC);
    const float* wc = F.in_WCONV; const float* bc = F.in_BCONV;
    const int nth = F.G * NTHR;
    for (int it = blockIdx.x * NTHR + tid_; it < L * (LW / 8); it += nth) {
        const int t = it / (LW / 8), c0 = (it % (LW / 8)) * 8;
        const int s0 = t < LP ? 0 : LP, len = t < LP ? LP : LS, tl = t - s0;
        float acc[8];
#pragma unroll
        for (int e = 0; e < 8; ++e) acc[e] = bc[c0 + e];
#pragma unroll
        for (int j = 0; j < 4; ++j) { const int tt = tl + j - 2; if (tt < 0 || tt >= len) continue;
            f32x4 x0, x1; pg8::unpack8(*(const u32x4*)(XR + (size_t)(s0 + tt) * LW + c0), x0, x1);
            const f32x4 w0 = *(const f32x4*)(wc + j * LW + c0), w1 = *(const f32x4*)(wc + j * LW + c0 + 4);
#pragma unroll
            for (int e = 0; e < 4; ++e) { acc[e] += w0[e] * x0[e]; acc[4 + e] += w1[e] * x1[e]; } }
        *(u32x4*)(XC + (size_t)t * LW + c0) = pg8::pack8((f32x4){acc[0], acc[1], acc[2], acc[3]}, (f32x4){acc[4], acc[5], acc[6], acc[7]});
    }
}

struct LruW { bf16x8 w[2][4]; float br, bi, cl; };
template <int DIR> __device__ __forceinline__ void lru_load_w(const Frame& F, LruW& W, int n, int w, int fr, int fq) {
    const bf16_t* wg = wsp<bf16_t>(F, WS_WG);
#pragma unroll
    for (int g = 0; g < 2; ++g)
#pragma unroll
        for (int s = 0; s < 4; ++s) W.w[g][s] = *(const bf16x8*)(wg + ((size_t)((DIR * 2 + g) * NBLK + n) * BW + 16 * w + fr) * BW + 32 * fq + 8 * s);
    const int ch = n * BW + 16 * w + fr;
    W.br = F.in_BR[DIR * LW + ch]; W.bi = F.in_BI[DIR * LW + ch];
    const float lam = F.in_LAM[DIR * LW + ch];
    W.cl = -8.0f * ((lam > 15.f) ? __expf(-lam) : log1pf(__expf(-lam)));
}
template <int LDBG = 0> __device__ __forceinline__ void lru_gate(float pr, float pi, float xc, const LruW& W, bool first, float& a, float& u) {
    if constexpr (LDBG == 1) { a = pr + W.br; u = pi * xc + W.bi; return; }
    const float r = sigmoidf_(pr + W.br), ig = sigmoidf_(pi + W.bi);
    a = __expf(W.cl * r);
    const float mult = first ? 1.0f : __builtin_amdgcn_sqrtf(fmaxf(1.0f - a * a, 0.f));
    u = mult * ig * xc;
}
struct LruX { bf16x8 x[4][4]; };
__device__ __forceinline__ void lru_load_x(LruX& X, const bf16_t* XC, int tb, int n, int fr, int fq) {
#pragma unroll
    for (int tau = 0; tau < 4; ++tau) { const bf16_t* xp = XC + ((size_t)((((tb >> 6) * NBLK + n) * 4 + tau) * 4) * 64 + fr * 4 + fq) * 8;
#pragma unroll
        for (int s = 0; s < 4; ++s) X.x[tau][s] = *(const bf16x8*)(xp + s * 512); }
}
__device__ __forceinline__ void lru_tile(const LruX& X, int tau, bool hiw, const LruW& W, const bf16x8 idf0, const bf16x8 idf1, f32x4& pr, f32x4& pi, f32x4& xct) {
    pr = (f32x4){0.f, 0.f, 0.f, 0.f}; pi = pr;
#pragma unroll
    for (int s = 0; s < 4; ++s) { pr = __builtin_amdgcn_mfma_f32_16x16x32_bf16(X.x[tau][s], W.w[0][s], pr, 0, 0, 0); pi = __builtin_amdgcn_mfma_f32_16x16x32_bf16(X.x[tau][s], W.w[1][s], pi, 0, 0, 0); }
    const bf16x8 x0 = hiw ? X.x[tau][2] : X.x[tau][0], x1 = hiw ? X.x[tau][3] : X.x[tau][1];
    xct = __builtin_amdgcn_mfma_f32_16x16x32_bf16(x0, idf0, (f32x4){0.f, 0.f, 0.f, 0.f}, 0, 0, 0);
    xct = __builtin_amdgcn_mfma_f32_16x16x32_bf16(x1, idf1, xct, 0, 0, 0);
}
__device__ __forceinline__ void lru_idfrags(int w, int fr, int fq, bf16x8& idf0, bf16x8& idf1) {
#pragma unroll
    for (int e = 0; e < 8; ++e) { const bool on = (fq == (w >> 1)) && ((fr & 7) == e); idf0[e] = (on && fr < 8) ? (short)0x3F80 : (short)0; idf1[e] = (on && fr >= 8) ? (short)0x3F80 : (short)0; }
}
constexpr int LRU_CH = 256, LRU_NCH = L / LRU_CH, LRU_NCH_P = LP / LRU_CH;
__device__ __forceinline__ void conv_unit(Frame& F, int cg, int n) {
    const int tid_ = opaque(F.tid);
    const bf16_t* XR = wsp<bf16_t>(F, WS_XR); bf16_t* XC = wsp<bf16_t>(F, WS_XC);
    const float* wc = F.in_WCONV; const float* bc = F.in_BCONV;
    const int c0 = n * BW + (tid_ & 15) * 8;
    const int s0 = cg < LRU_NCH_P ? 0 : LP, len = cg < LRU_NCH_P ? LP : LS;
    f32x4 w[4][2]; f32x4 b0 = *(const f32x4*)(bc + c0), b1 = *(const f32x4*)(bc + c0 + 4);
#pragma unroll
    for (int j = 0; j < 4; ++j) { w[j][0] = *(const f32x4*)(wc + j * LW + c0); w[j][1] = *(const f32x4*)(wc + j * LW + c0 + 4); }
#pragma unroll
    for (int i = 0; i < 8; ++i) {
        const int t = cg * LRU_CH + (tid_ >> 4) + 32 * i, tl = t - s0;
        f32x4 a0 = b0, a1 = b1;
#pragma unroll
        for (int j = 0; j < 4; ++j) { const int tt = tl + j - 2; if (tt < 0 || tt >= len) continue;
            f32x4 x0, x1; pg8::unpack8(*(const u32x4*)(XR + (size_t)(s0 + tt) * LW + c0), x0, x1); a0 += w[j][0] * x0; a1 += w[j][1] * x1; }
        const int tg = t & 63, cq = tid_ & 15;
        *(u32x4*)(XC + ((size_t)(((((t >> 6) * NBLK + n) * 4 + ((tg >> 2) & 3)) * 4 + (cq & 3)) * 16 + 4 * (tg >> 4) + (tg & 3)) * 4 + (cq >> 2)) * 8) = pg8::pack8(a0, a1);
    }
}
__device__ __forceinline__ void lru_pass_a(Frame& F) {
    const int fr = F.lane & 15, fq = F.lane >> 4, w = F.wave;
    const bf16_t* XC = wsp<bf16_t>(F, WS_XC); f32x2* SUMM = wsp<f32x2>(F, WS_SUM);
    bf16x8 idf0, idf1; lru_idfrags(w, fr, fq, idf0, idf1);
    for (int u = blockIdx.x; u < LRU_NCH * NBLK; u += F.G) {
        const int cg = u >> 4, n = u & 15;
        conv_unit(F, cg, n); VM_WAIT(); __syncthreads();
        LruW Wf, Wb; lru_load_w<0>(F, Wf, n, w, fr, fq); lru_load_w<1>(F, Wb, n, w, fr, fq);
        const bool c_first = (cg == 0 || cg == LRU_NCH_P), c_last = (cg == LRU_NCH_P - 1 || cg == LRU_NCH - 1);
        float Af = 1.f, Hf = 0.f, Ab = 1.f, Hb = 0.f;
        LruX X, Xn; lru_load_x(X, XC, cg * LRU_CH, n, fr, fq);
        for (int gi = 0; gi < 4; ++gi) {
            if (gi < 3) lru_load_x(Xn, XC, cg * LRU_CH + (gi + 1) * 64, n, fr, fq);
            float pf = 1.f, hf = 0.f, pb = 1.f, hb = 0.f;
#pragma unroll
            for (int tau = 0; tau < 4; ++tau) {
                f32x4 prf, pif, prb, pib, xct, xct2;
                lru_tile(X, tau, (w & 1) != 0, Wf, idf0, idf1, prf, pif, xct);
                lru_tile(X, tau, (w & 1) != 0, Wb, idf0, idf1, prb, pib, xct2);
#pragma unroll
                for (int j = 0; j < 4; ++j) {
                    float a, uu;
                    lru_gate(prf[j], pif[j], xct[j], Wf, c_first && gi == 0 && fq == 0 && tau == 0 && j == 0, a, uu); hf = a * hf + uu; pf *= a;
                    lru_gate(prb[j], pib[j], xct[j], Wb, c_last && gi == 3 && fq == 3 && tau == 3 && j == 3, a, uu); hb += pb * uu; pb *= a;
                }
            }
            float gPf = 1.f, gHf = 0.f, gPb = 1.f, gHb = 0.f;
#pragma unroll
            for (int qq = 0; qq < 4; ++qq) { const int src = fr + 16 * qq;
                float P = __shfl(pf, src), H = __shfl(hf, src); gHf = P * gHf + H; gPf *= P;
                P = __shfl(pb, src); H = __shfl(hb, src); gHb += gPb * H; gPb *= P; }
            Hf = gPf * Hf + gHf; Af *= gPf; Hb += Ab * gHb; Ab *= gPb;
            X = Xn;
        }
        if (fq == 0) { const int ch = n * BW + 16 * w + fr; SUMM[(size_t)(cg * 2 + 0) * LW + ch] = (f32x2){Af, Hf}; SUMM[(size_t)(cg * 2 + 1) * LW + ch] = (f32x2){Ab, Hb}; }
    }
}
__device__ __forceinline__ void lru_pass_b(Frame& F) {
    const int tid_ = opaque(F.tid);
    const int gt = blockIdx.x * NTHR + tid_; if (gt >= 4 * LW) return;
    const int ch = gt % LW, d = (gt / LW) & 1, seq = gt / (2 * LW), c0 = seq ? LRU_NCH_P : 0, nc = seq ? LRU_NCH - LRU_NCH_P : LRU_NCH_P;
    const f32x2* SUMM = wsp<f32x2>(F, WS_SUM); float* CIN = wsp<float>(F, WS_SUM + 4 * MiB);
    float s = 0.f;
    for (int i0 = 0; i0 < nc; i0 += 8) {
        f32x2 ah[8];
#pragma unroll
        for (int e = 0; e < 8; ++e) { const int cg = d ? c0 + nc - 1 - (i0 + e) : c0 + i0 + e; ah[e] = SUMM[(size_t)(cg * 2 + d) * LW + ch]; }
#pragma unroll
        for (int e = 0; e < 8; ++e) { const int cg = d ? c0 + nc - 1 - (i0 + e) : c0 + i0 + e; CIN[(size_t)(cg * 2 + d) * LW + ch] = s; s = ah[e].x * s + ah[e].y; }
    }
}
template <int LDBG = 0> __device__ __forceinline__ void lru_pass_c(Frame& F) {
    const int tid_ = opaque(F.tid);
    const int fr = F.lane & 15, fq = F.lane >> 4, w = F.wave;
    const bf16_t* XC = wsp<bf16_t>(F, WS_XC); const float* CIN = wsp<float>(F, WS_SUM + 4 * MiB);
    const bf16_t* GR = wsp<bf16_t>(F, WS_GR); bf16_t* LRU = wsp<bf16_t>(F, WS_XR);
    LAS bf16_t* hfb = (LAS bf16_t*)(F.lds + w * 8192);
    LAS bf16_t* grt = (LAS bf16_t*)(F.lds + 65536);
    bf16x8 idf0, idf1; lru_idfrags(w, fr, fq, idf0, idf1);
    for (int u = blockIdx.x; u < LRU_NCH * NBLK; u += F.G) {
        const int cg = u >> 4, n = u & 15, ch = n * BW + 16 * w + fr;
        const bool c_first = (cg == 0 || cg == LRU_NCH_P), c_last = (cg == LRU_NCH_P - 1 || cg == LRU_NCH - 1);
        { const bf16_t* gsrc = GR + (size_t)(cg * LRU_CH + (tid_ >> 4)) * LW + n * BW + (tid_ & 15) * 8; LAS bf16_t* ldst = grt + w * 512;
#pragma unroll 1
          for (int k = 0; k < 8; ++k) { __builtin_amdgcn_global_load_lds((const unsigned*)gsrc, (LAS unsigned*)ldst, 16, 0, 0); gsrc += (size_t)32 * LW; ldst += NTHR * 8; } }
        {
            LruW W; lru_load_w<0>(F, W, n, w, fr, fq);
            float s = CIN[(size_t)(cg * 2 + 0) * LW + ch];
            LruX X, Xn; lru_load_x(X, XC, cg * LRU_CH, n, fr, fq);
            for (int gi = 0; gi < 4; ++gi) {
                if (gi < 3 && LDBG != 2) lru_load_x(Xn, XC, cg * LRU_CH + (gi + 1) * 64, n, fr, fq);
                float a[16], uu[16];
#pragma unroll
                for (int tau = 0; tau < 4; ++tau) { f32x4 pr, pi, xct; lru_tile(X, tau, (w & 1) != 0, W, idf0, idf1, pr, pi, xct);
#pragma unroll
                    for (int j = 0; j < 4; ++j) lru_gate<LDBG>(pr[j], pi[j], xct[j], W, c_first && gi == 0 && fq == 0 && tau == 0 && j == 0, a[4 * tau + j], uu[4 * tau + j]); }
                float p = 1.f, h = 0.f;
#pragma unroll
                for (int t = 0; t < 16; ++t) { h = a[t] * h + uu[t]; p *= a[t]; }
                float hin = s, sg = s;
#pragma unroll
                for (int qq = 0; qq < 4; ++qq) { const float P = __shfl(p, fr + 16 * qq), H = __shfl(h, fr + 16 * qq); sg = P * sg + H; if (qq < fq) hin = P * hin + H; }
                s = sg;
                float hh = hin;
#pragma unroll
                for (int t = 0; t < 16; ++t) { hh = a[t] * hh + uu[t]; hfb[(gi * 64 + 16 * fq + t) * 16 + fr] = (bf16_t)f2bf(hh); }
                X = Xn;
            }
        }
        VM_WAIT(); __syncthreads();
        {
            LruW W; lru_load_w<1>(F, W, n, w, fr, fq);
            float s = CIN[(size_t)(cg * 2 + 1) * LW + ch];
            LruX X, Xn; lru_load_x(X, XC, cg * LRU_CH + 3 * 64, n, fr, fq);
            for (int gi = 3; gi >= 0; --gi) {
                if (gi > 0 && LDBG != 2) lru_load_x(Xn, XC, cg * LRU_CH + (gi - 1) * 64, n, fr, fq);
                float a[16], uu[16];
#pragma unroll
                for (int tau = 0; tau < 4; ++tau) { f32x4 pr, pi, xct; lru_tile(X, tau, (w & 1) != 0, W, idf0, idf1, pr, pi, xct);
#pragma unroll
                    for (int j = 0; j < 4; ++j) lru_gate<LDBG>(pr[j], pi[j], xct[j], W, c_last && gi == 3 && fq == 3 && tau == 3 && j == 3, a[4 * tau + j], uu[4 * tau + j]); }
                float p = 1.f, h = 0.f;
#pragma unroll
                for (int t = 15; t >= 0; --t) { h = a[t] * h + uu[t]; p *= a[t]; }
                float hin = s, sg = s;
#pragma unroll
                for (int qq = 3; qq >= 0; --qq) { const float P = __shfl(p, fr + 16 * qq), H = __shfl(h, fr + 16 * qq); sg = P * sg + H; if (qq > fq) hin = P * hin + H; }
                s = sg;
                float hh = hin;
#pragma unroll
                for (int t = 15; t >= 0; --t) { hh = a[t] * hh + uu[t];
                    const int tl = gi * 64 + 16 * fq + t; LAS bf16_t* gp = grt + tl * BW + 16 * w + fr;
                    *gp = (bf16_t)f2bf((bf1(hfb[tl * 16 + fr]) + hh) * gelu_tanh(bf1(*gp))); }
                X = Xn;
            }
        }
        LDS_WAIT(); __syncthreads();
        { bf16_t* gdst = LRU + (size_t)(cg * LRU_CH + (tid_ >> 4)) * LW + n * BW + (tid_ & 15) * 8; const LAS bf16_t* lsrc = grt + tid_ * 8;
#pragma unroll 1
          for (int k = 0; k < 8; ++k) { *(u32x4*)gdst = *(const LAS u32x4*)lsrc; gdst += (size_t)32 * LW; lsrc += NTHR * 8; } }
        LDS_WAIT(); __syncthreads();
    }
}

__device__ __forceinline__ f32x4 up4(const u32x2 u) { return (f32x4){bflo(u.x), bfhi(u.x), bflo(u.y), bfhi(u.y)}; }
__device__ __forceinline__ void mid_phase(Frame& F) {
    const int tid_ = opaque(F.tid);
    const bf16_t* MIX = wsp<bf16_t>(F, WS_MIX); signed char* XN8 = wsp<signed char>(F, WS_XN8); float* RSTD = wsp<float>(F, WS_RSTD); float* RS2 = wsp<float>(F, WS_RS2);
    LAS f32x4* gpost = (LAS f32x4*)F.lds; LAS f32x4* gpre = gpost + D / 4;
    for (int i = tid_; i < D / 4; i += NTHR) { gpost[i] = ((const f32x4*)F.in_GMPOST)[i]; gpre[i] = ((const f32x4*)F.in_GFPRE)[i]; }
    __syncthreads();
    for (int m = F.gw; m < L; m += F.ngw) {
        asm volatile("" ::: "memory");
        const f32x4* xr = (const f32x4*)xrow(F, m) + F.lane; const u32x2* mr = (const u32x2*)(MIX + (size_t)m * D) + F.lane;
        f32x4 v[16]; u32x2 mx[16]; float s = 0.f;
#pragma unroll
        for (int j = 0; j < 16; ++j) { v[j] = xr[64 * j]; mx[j] = mr[64 * j]; const f32x4 a = up4(mx[j]); s += (a.x * a.x + a.y * a.y) + (a.z * a.z + a.w * a.w); }
        const float rstd1 = 1.0f / sqrtf(wave_sum(s) * (1.0f / D) + EPS);
        if (F.lane == 0) RSTD[m] = rstd1;
        float s2 = 0.f;
#pragma unroll
        for (int j = 0; j < 16; ++j) { v[j] = v[j] + up4(mx[j]) * rstd1 * gpost[F.lane + 64 * j]; s2 += (v[j].x * v[j].x + v[j].y * v[j].y) + (v[j].z * v[j].z + v[j].w * v[j].w); }
        const float rstd2 = 1.0f / sqrtf(wave_sum(s2) * (1.0f / D) + EPS);
        float mx2 = 0.f;
#pragma unroll
        for (int j = 0; j < 16; ++j) { v[j] = v[j] * rstd2 * gpre[F.lane + 64 * j]; mx2 = fmaxf(fmaxf(mx2, fmaxf(fabsf(v[j].x), fabsf(v[j].y))), fmaxf(fabsf(v[j].z), fabsf(v[j].w))); }
        const float amax = fmaxf(wave_max(mx2), 1e-20f), inv = 127.0f / amax;
        if (F.lane == 0) RS2[m] = amax * (1.0f / 127.0f);
        unsigned* o4 = (unsigned*)(XN8 + (size_t)m * D) + F.lane;
#pragma unroll
        for (int j = 0; j < 16; ++j) o4[64 * j] = pk4_i8(rintf(v[j].x * inv), rintf(v[j].y * inv), rintf(v[j].z * inv), rintf(v[j].w * inv));
    }
    __syncthreads();
}
__device__ __forceinline__ void final_phase(Frame& F) {
    const int tid_ = opaque(F.tid);
    const bf16_t* MIX = wsp<bf16_t>(F, WS_MIX); const bf16_t* FB = wsp<bf16_t>(F, WS_F); const float* RSTD = wsp<float>(F, WS_RSTD);
    LAS f32x4* gpost = (LAS f32x4*)F.lds; LAS f32x4* gfp = gpost + D / 4;
    for (int i = tid_; i < D / 4; i += NTHR) { gpost[i] = ((const f32x4*)F.in_GMPOST)[i]; gfp[i] = ((const f32x4*)F.in_GFPOST)[i]; }
    __syncthreads();
    for (int m = F.gw; m < L; m += F.ngw) {
        asm volatile("" ::: "memory");
        const f32x4* xr = (const f32x4*)xrow(F, m) + F.lane; const u32x2* mr = (const u32x2*)(MIX + (size_t)m * D) + F.lane; const u32x2* fr = (const u32x2*)(FB + (size_t)m * D) + F.lane;
        const float rstd1 = RSTD[m];
        u32x2 fx[16]; float s = 0.f;
#pragma unroll
        for (int j = 0; j < 16; ++j) { fx[j] = fr[64 * j]; const f32x4 a = up4(fx[j]); s += (a.x * a.x + a.y * a.y) + (a.z * a.z + a.w * a.w); }
        const float rstd3 = 1.0f / sqrtf(wave_sum(s) * (1.0f / D) + EPS);
        f32x4* o = (f32x4*)(F.out + (size_t)m * D) + F.lane;
#pragma unroll
        for (int j = 0; j < 16; ++j) o[64 * j] = xr[64 * j] + up4(mr[64 * j]) * rstd1 * gpost[F.lane + 64 * j] + up4(fx[j]) * rstd3 * gfp[F.lane + 64 * j];
    }
}

constexpr int LDS_STAGE = pg8::STAGE_BYTES;
constexpr int LDS_MISC = LDS_STAGE;
constexpr int LDS_BYTES = LDS_STAGE + 1024;
#ifndef MK_N_LAUNCHES
#define MK_N_LAUNCHES 1
#endif
constexpr int NPHASE = 11;
struct Args { const float* in[23]; float* out; unsigned char* ws; int ph_lo, ph_hi; };

__global__ void __launch_bounds__(NTHR, 2) fwd_kernel(Args args) {
    extern __shared__ __attribute__((aligned(16))) unsigned char lds_raw[];
    Frame F;
    F.lds = (LAS unsigned char*)lds_raw;
    F.tid = threadIdx.x; F.lane = (int)__builtin_amdgcn_mbcnt_hi(~0u, __builtin_amdgcn_mbcnt_lo(~0u, 0u)); F.wave = __builtin_amdgcn_readfirstlane(F.tid >> 6);
    F.G = gridDim.x; F.gw = blockIdx.x * NWAVES + F.wave; F.ngw = F.G * NWAVES;
    F.in_XP = args.in[0]; F.in_XS = args.in[1]; F.in_WIN = args.in[2]; F.in_WCONV = args.in[3]; F.in_BCONV = args.in[4]; F.in_WR = args.in[5]; F.in_BR = args.in[6]; F.in_WI = args.in[7]; F.in_BI = args.in[8]; F.in_LAM = args.in[9]; F.in_RPB = args.in[10]; F.in_WNO = args.in[11]; F.in_WLO = args.in[12]; F.in_WM = args.in[13]; F.in_BM = args.in[14]; F.in_WOUT = args.in[15]; F.in_GMPRE = args.in[16]; F.in_GMPOST = args.in[17]; F.in_GFPRE = args.in[18]; F.in_GFPOST = args.in[19]; F.in_WFG = args.in[20]; F.in_WFU = args.in[21]; F.in_WFD = args.in[22];
    F.out = args.out; F.ws = args.ws;
    volatile LAS unsigned* MISC = (volatile LAS unsigned*)(F.lds + LDS_MISC);
    if (F.tid < 256) MISC[F.tid] = 0u;
    __syncthreads();
    const int lo = args.ph_lo, hi = args.ph_hi;
    const bool fused = (hi - lo) > 1;
    XcdBarrier bar; bar.bar = (unsigned*)(F.ws + WS_CTL); bar.x = 0; bar.st = nullptr;
    if (fused) bar = xcd_barrier_post((unsigned*)(F.ws + WS_CTL), MISC + 8);
#ifndef PH_MASK
#define PH_MASK 0x7ff
#endif
#define IN(k) (((PH_MASK >> (k)) & 1) && lo <= (k) && (k) < hi)
#define SEAM(k) do { if (IN(k) && IN((k) + 1)) xcd_barrier(bar); } while (0)
    LAS unsigned char* stage = F.lds;

#ifdef ATTN_OUT_OFF
#define NA_BUF ((size_t)ATTN_OUT_OFF * MiB)
#else
#define NA_BUF WS_Q
#endif
#ifndef DUP_MASK
#define DUP_MASK 0
#endif
#define RUN(k, ...) if (IN(k)) { __VA_ARGS__ if (((DUP_MASK) >> (k)) & 1) { __VA_ARGS__ } }
    RUN(0, { p0_prologue(F); }) SEAM(0);
    RUN(1, {
        { pg8::Gemm g{wsp<bf16_t>(F, WS_XN8), wsp<bf16_t>(F, WS_XN8), 1 << 30, wsp<bf16_t>(F, WS_W8), L, 2 * NAW + 2 * D, D}; pg8::StaticOrder S; S.init(L, 2 * NAW + 2 * D, F.G, (int)blockIdx.x);
          pg8::EpiProjQ E{wsp<bf16_t>(F, WS_Q), wsp<bf16_t>(F, WS_K), (bf16_t*)F.out, F.in_BM, wsp<float>(F, WS_RS1), wsp<float>(F, WS_CS) + CS_QKM};
          pg8::gemm_phase<pg8::EpiProjQ, pg8::StaticOrder, true, true, 2>(stage, g, S, E); }
        { pg8::Gemm g{wsp<bf16_t>(F, WS_XN), wsp<bf16_t>(F, WS_XN), 1 << 30, wsp<bf16_t>(F, WS_WCAT), L, 2 * NAW, 2 * D}; pg8::StaticOrder S; S.init(L, 2 * NAW, F.G, (int)blockIdx.x);
          pg8::EpiProj E{wsp<bf16_t>(F, WS_XR), wsp<bf16_t>(F, WS_GR), wsp<bf16_t>(F, WS_GR), wsp<bf16_t>(F, WS_GR), (bf16_t*)F.out, F.in_BM, 1 << 30};
          pg8::gemm_phase<pg8::EpiProj, pg8::StaticOrder, true, true, 0>(stage, g, S, E); }
        { pg8::Gemm g{wsp<bf16_t>(F, WS_WVT), wsp<bf16_t>(F, WS_WVT), 1 << 30, wsp<bf16_t>(F, WS_XN8), NAW, L, D}; pg8::StaticOrder S; S.init(NAW, L, F.G, (int)blockIdx.x);
          pg8::EpiVTQ E{wsp<bf16_t>(F, WS_VT), wsp<float>(F, WS_CS) + CS_V, wsp<float>(F, WS_RS1)};
          pg8::gemm_phase<pg8::EpiVTQ, pg8::StaticOrder, true, true, 2>(stage, g, S, E); }
    }) SEAM(1);
    RUN(2, { lru_pass_a(F); }) SEAM(2);
    #ifdef ATTN_OUT_OFF
    if (IN(3)) { lru_pass_b(F); } SEAM(3);
    if (IN(4)) { lru_pass_c<0>(F); xcd_barrier(bar); if (ATTN_DUP) attn_mfma<ATTN_DUP - 1>(F); attn_mfma<0>(F); } SEAM(4);
#else
    if (IN(3)) { lru_pass_b(F); attn_mfma_lds(F); } SEAM(3);
#ifdef LRUC_DBG
    if (IN(4)) { lru_pass_c<LRUC_DBG>(F); lru_pass_c<0>(F); } SEAM(4);
#else
    RUN(4, { lru_pass_c<0>(F); }) SEAM(4);
#endif
#endif
    if (IN(5)) {
        { pg8::Gemm g{wsp<bf16_t>(F, NA_BUF), wsp<bf16_t>(F, NA_BUF), 1 << 30, wsp<bf16_t>(F, WS_WNO), L, D, 2 * NAW}; pg8::StaticOrder S; S.init(L, D, F.G, (int)blockIdx.x);
          pg8::EpiMulG<false> E{wsp<bf16_t>(F, WS_T1), (const bf16_t*)F.out, 0};
          pg8::gemm_phase<pg8::EpiMulG<false>, pg8::StaticOrder, true, true>(stage, g, S, E); }
        { pg8::Gemm g{wsp<bf16_t>(F, WS_XR), wsp<bf16_t>(F, WS_XR), 1 << 30, wsp<bf16_t>(F, WS_WLO), L, D, 2 * LW}; pg8::StaticOrder S; S.init(L, D, F.G, (int)blockIdx.x);
          pg8::EpiMulG<true> E{wsp<bf16_t>(F, WS_T1), (const bf16_t*)F.out, D};
          pg8::gemm_phase<pg8::EpiMulG<true>, pg8::StaticOrder, true, true>(stage, g, S, E); }
    } SEAM(5);
    RUN(6, {
        pg8::Gemm g{wsp<bf16_t>(F, WS_T1), wsp<bf16_t>(F, WS_T1), 1 << 30, wsp<bf16_t>(F, WS_WO), L, D, 2 * D}; pg8::StaticOrder S; S.init(L, D, F.G, (int)blockIdx.x);
        pg8::EpiPlain E{wsp<bf16_t>(F, WS_MIX), D};
        pg8::gemm_phase<pg8::EpiPlain, pg8::StaticOrder, true, true>(stage, g, S, E);
    }) SEAM(6);
    RUN(7, { mid_phase(F); }) SEAM(7);
    RUN(8, {
        pg8::Gemm g{wsp<bf16_t>(F, WS_XN8), wsp<bf16_t>(F, WS_XN8), 1 << 30, wsp<bf16_t>(F, WS_WGU), L, 2 * DFF, D}; pg8::StaticOrder S; S.init(L, 2 * DFF, F.G, (int)blockIdx.x);
        pg8::EpiSwigluQ E{(bf16_t*)F.out, wsp<bf16_t>(F, WS_HIDS), LP / 256, wsp<float>(F, WS_RS2), wsp<float>(F, WS_CS) + CS_GU};
        pg8::gemm_phase<pg8::EpiSwigluQ, pg8::StaticOrder, false, true, 2>(stage, g, S, E);
    }) SEAM(8);
    RUN(9, {
        pg8::Gemm g{(const bf16_t*)F.out, wsp<bf16_t>(F, WS_HIDS), LP / 256, wsp<bf16_t>(F, WS_WD), L, D, 2 * DFF}; pg8::StaticOrder S; S.init(L, D, F.G, (int)blockIdx.x);
        pg8::EpiPlain E{wsp<bf16_t>(F, WS_F), D};
        pg8::gemm_phase<pg8::EpiPlain, pg8::StaticOrder, true, true>(stage, g, S, E);
    }) SEAM(9);
    RUN(10, { final_phase(F); })
#undef RUN
#undef IN
#undef SEAM
}

extern "C" void kernel_launch(void* const* d_in, const int* in_sizes, int n_in, void* d_out, int out_size, void* d_ws, size_t ws_size, hipStream_t stream) {
    static int grid = 0;
    if (grid == 0) {
        if (n_in != 23 || in_sizes[0] != LP * D || in_sizes[1] != LS * D || out_size != L * D || ws_size < WS_END) {
            fprintf(stderr, "kernel_launch: unexpected shapes: n_in %d in0 %d out %d ws %zu (need %zu)\n", n_in, n_in > 0 ? in_sizes[0] : -1, out_size, ws_size, (size_t)WS_END); grid = -1; return; }
        int dev = 0, cus = 0, per_cu = 0;
        if (hipGetDevice(&dev) != hipSuccess || hipDeviceGetAttribute(&cus, hipDeviceAttributeMultiprocessorCount, dev) != hipSuccess) { grid = -1; return; }
        if (hipFuncSetAttribute((const void*)fwd_kernel, hipFuncAttributeMaxDynamicSharedMemorySize, LDS_BYTES) != hipSuccess) { fprintf(stderr, "kernel_launch: hipFuncSetAttribute failed\n"); grid = -1; return; }
        if (hipOccupancyMaxActiveBlocksPerMultiprocessor(&per_cu, (const void*)fwd_kernel, NTHR, LDS_BYTES) != hipSuccess || per_cu < 1) { fprintf(stderr, "kernel_launch: occupancy query says %d\n", per_cu); }
        (void)hipGetLastError();
        grid = cus;
    }
    if (grid < 0) return;
    (void)hipMemsetAsync((char*)d_ws + WS_CTL, 0, CTL_ZERO_BYTES, stream);
#ifdef DBG_ZERO_ALL
    (void)hipMemsetAsync((char*)d_ws, 0, WS_END, stream); (void)hipMemsetAsync((char*)d_out, 0, (size_t)L * D * 4, stream);
#endif
    Args a{};
    for (int i = 0; i < 23; ++i) a.in[i] = (const float*)d_in[i];
    a.out = (float*)d_out; a.ws = (unsigned char*)d_ws;
#if MK_N_LAUNCHES == 1
    a.ph_lo = 0; a.ph_hi = NPHASE;
    hipLaunchKernelGGL(fwd_kernel, dim3(grid), dim3(NTHR), LDS_BYTES, stream, a);
#else
    for (int p = 0; p < NPHASE; ++p) {
#ifdef DBG_PH_MASK
        if (!((DBG_PH_MASK >> p) & 1)) continue;
#endif
        a.ph_lo = p; a.ph_hi = p + 1; hipLaunchKernelGGL(fwd_kernel, dim3(grid), dim3(NTHR), LDS_BYTES, stream, a); }
#endif
}
```

```cpp
#include <hip/hip_runtime.h>
#include <cstdio>
#include <cstdint>

#define LAS __attribute__((address_space(3)))
typedef unsigned short bf16_t;
typedef short bf16x8 __attribute__((ext_vector_type(8)));
typedef float f32x4 __attribute__((ext_vector_type(4)));
typedef float f32x2 __attribute__((ext_vector_type(2)));
typedef unsigned u32x4 __attribute__((ext_vector_type(4)));
typedef unsigned u32x2 __attribute__((ext_vector_type(2)));

constexpr int D = 4096, LP = 16384, LS = 8192, L = LP + LS;
constexpr int GRIDW = 64, HD = 128, NH = 16, NAW = 2048, LW = 2048, NBLK = 16, BW = 128, DFF = 11008, INW = 10240;
constexpr float EPS = 1e-6f;
constexpr int NWAVES = 8, NTHR = 512;

constexpr size_t MiB = 1u << 20;
constexpr size_t WS_CTL = 0, CTL_ZERO_BYTES = 64 * 1024;
constexpr size_t WS_AM = 32 * 1024;
constexpr size_t WS_RSTD = 1 * MiB;
constexpr size_t WS_RS1 = 1 * MiB + 128 * 1024;
constexpr size_t WS_RS2 = 1 * MiB + 256 * 1024;
constexpr size_t WS_CS = 1 * MiB + 384 * 1024;
constexpr size_t WS_SUM = 2 * MiB;
constexpr size_t WS_WCAT = 8 * MiB;
constexpr size_t WS_W8 = 40 * MiB;
constexpr size_t WS_WVT = 88 * MiB;
constexpr size_t WS_XN8 = 96 * MiB;
constexpr size_t WS_WNO = 192 * MiB;
constexpr size_t WS_WLO = 208 * MiB;
constexpr size_t WS_WO = 224 * MiB;
constexpr size_t WS_WGU = 256 * MiB;
constexpr size_t WS_WD = 342 * MiB;
constexpr size_t WS_WG = 428 * MiB;
constexpr size_t WS_XN = 430 * MiB;
constexpr size_t WS_Q = 622 * MiB;
constexpr size_t WS_XR = 718 * MiB;
constexpr size_t WS_K = 814 * MiB;
constexpr size_t WS_VT = 910 * MiB;
constexpr size_t WS_GR = 1006 * MiB;
constexpr size_t WS_XC = 1102 * MiB;
constexpr size_t WS_END = 1198 * MiB;
constexpr int CS_QKM = 0, CS_V = 12288, CS_GU = 12288 + 2048, CS_D = 12288 + 2048 + 22016;
constexpr size_t WS_RS3 = 1 * MiB + 640 * 1024;
constexpr size_t WS_H8P = WS_XN, WS_H8S = WS_XN8;
constexpr size_t WS_T1 = WS_K;
constexpr size_t WS_MIX = WS_GR;
constexpr size_t WS_HIDS = WS_Q;
constexpr size_t WS_F = WS_K;
constexpr size_t WS_HF = WS_K;

#define LDS_WAIT() asm volatile("s_waitcnt lgkmcnt(0)" ::: "memory")
#define VM_WAIT() asm volatile("s_waitcnt vmcnt(0)" ::: "memory")
typedef __bf16 bf16x2n_t __attribute__((ext_vector_type(2)));
__device__ __forceinline__ unsigned pk2(float lo, float hi) { const bf16x2n_t r = __builtin_convertvector((f32x2){lo, hi}, bf16x2n_t); return __builtin_bit_cast(unsigned, r); }
__device__ __forceinline__ unsigned f2bf(float f) { return pk2(f, 0.f) & 0xffffu; }
__device__ __forceinline__ float bflo(unsigned u) { return __builtin_bit_cast(float, u << 16); }
__device__ __forceinline__ float bfhi(unsigned u) { return __builtin_bit_cast(float, u & 0xffff0000u); }
__device__ __forceinline__ float bf1(bf16_t u) { return __builtin_bit_cast(float, (unsigned)u << 16); }
__device__ __forceinline__ float wave_sum(float v) {
#pragma unroll
    for (int o = 1; o < 64; o <<= 1) v += __shfl_xor(v, o);
    return v;
}
__device__ __forceinline__ float wave_max(float v) {
#pragma unroll
    for (int o = 1; o < 64; o <<= 1) v = fmaxf(v, __shfl_xor(v, o));
    return v;
}
__device__ __forceinline__ float sigmoidf_(float v) { return __builtin_amdgcn_rcpf(1.0f + __expf(-v)); }
__device__ __forceinline__ float gelu_tanh(float v) { const float y = 0.7978845608f * (v + 0.044715f * v * v * v); const float e = __expf(2.0f * y); return 0.5f * v * (2.0f - 2.0f * __builtin_amdgcn_rcpf(e + 1.0f)); }

namespace pg8 {
constexpr int BM = 256, BK = 64, HALF = 128, HTB = HALF * BK * 2  , STAGE_BYTES = 8 * HTB, NXCD = 8, WGM = 4;

__host__ __device__ __forceinline__ int lds_byte(int r, int c) { return (r >> 3) * 1024 + (r & 7) * 128 + ((((c >> 3) ^ r) & 7) << 4) + (c & 7) * 2; }
__host__ __device__ __forceinline__ void stage_rc(int b, int& R, int& C) { const int ch = b >> 10, rr = (b >> 7) & 7, slot = (b >> 4) & 7; R = ch * 8 + rr; C = ((slot ^ rr) & 7) * 8; }
__host__ __device__ __forceinline__ int perm32(int rho) { const int n = rho >> 4, i = rho & 15; return 8 * (i >> 2) + 4 * n + (i & 3); }

struct Unit { int pm, pn; };
struct Gemm {
    const bf16_t* A; const bf16_t* A2; int pm_split; const bf16_t* Bt; int M, N, rb;
    __device__ __forceinline__ const char* abase(int pm) const { const size_t t = (size_t)BM * rb; return pm < pm_split ? (const char*)A + (size_t)pm * t : (const char*)A2 + (size_t)(pm - pm_split) * t; }
    __device__ __forceinline__ const char* bbase(int pn) const { return (const char*)Bt + (size_t)pn * BM * rb; }
};

struct StaticOrder {
    int nM, nN, nwg, G, c;
    __host__ __device__ void init(int M, int N, int G_, int c_) { nM = M / BM; nN = N / BM; nwg = nM * nN; G = G_; c = c_; }
    __host__ __device__ bool next(int i, Unit& u) const {
        const long Lx = (long)i * G + c; if (Lx >= nwg) return false;
        int wgid = (int)Lx; { const int q = nwg / NXCD, r = nwg % NXCD, xcd = wgid % NXCD, off = wgid / NXCD; wgid = (xcd < r ? xcd * (q + 1) : r * (q + 1) + (xcd - r) * q) + off; }
        const int nig = WGM * nN, gid = wgid / nig, fm = gid * WGM, gsz = (nM - fm) < WGM ? (nM - fm) : WGM;
        u.pm = fm + ((wgid % nig) % gsz); u.pn = (wgid % nig) / gsz; return true;
    }
    __device__ __forceinline__ void a_ready(const Unit&) const {}
    __device__ __forceinline__ void done(const Unit&) const {}
};

typedef int v8i32 __attribute__((ext_vector_type(8)));
typedef int v4i32 __attribute__((ext_vector_type(4)));
typedef __bf16 bf16x2_t __attribute__((ext_vector_type(2)));
__device__ __forceinline__ unsigned cvt_pk_bf16(float lo, float hi) { const bf16x2_t r = __builtin_convertvector((f32x2){lo, hi}, bf16x2_t); return __builtin_bit_cast(unsigned, r); }
__device__ __forceinline__ u32x4 pack8(const f32x4 v0, const f32x4 v1) { u32x4 w; w.x = cvt_pk_bf16(v0[0], v0[1]); w.y = cvt_pk_bf16(v0[2], v0[3]); w.z = cvt_pk_bf16(v1[0], v1[1]); w.w = cvt_pk_bf16(v1[2], v1[3]); return w; }
__device__ __forceinline__ void unpack8(const u32x4 w, f32x4& v0, f32x4& v1) { v0 = (f32x4){bflo(w.x), bfhi(w.x), bflo(w.y), bfhi(w.y)}; v1 = (f32x4){bflo(w.z), bfhi(w.z), bflo(w.w), bfhi(w.w)}; }
__device__ __forceinline__ f32x4 sig4(const f32x4 v) { f32x4 r; r[0] = sigmoidf_(v[0]); r[1] = sigmoidf_(v[1]); r[2] = sigmoidf_(v[2]); r[3] = sigmoidf_(v[3]); return r; }

struct EpiPlain {
    static constexpr bool PERM = true, AFTER_DRAIN = false;
    bf16_t* O; int ldc;
    __device__ __forceinline__ void operator()(const f32x4 (&acc)[2][2][4][2], const Unit& u, int wr, int wc, int fr, int fq) const {
        const int row0 = u.pm * BM + wr * 64 + fr, col0 = u.pn * BM + wc * 32 + 8 * fq;
#pragma unroll
        for (int ai = 0; ai < 2; ++ai)
#pragma unroll
            for (int m = 0; m < 4; ++m) { bf16_t* rowp = O + (size_t)(row0 + ai * HALF + m * 16) * ldc + col0;
#pragma unroll
                for (int bj = 0; bj < 2; ++bj) *(u32x4*)(rowp + bj * HALF) = pack8(acc[ai][bj][m][0], acc[ai][bj][m][1]); }
    }
};
struct EpiVT {
    static constexpr bool PERM = true, AFTER_DRAIN = false;
    bf16_t* O;
    __device__ __forceinline__ void operator()(const f32x4 (&acc)[2][2][4][2], const Unit& u, int wr, int wc, int fr, int fq) const {
        const int row0 = u.pm * BM + wr * 64 + fr, col0 = u.pn * BM + wc * 32 + 8 * fq;
#pragma unroll
        for (int ai = 0; ai < 2; ++ai)
#pragma unroll
            for (int m = 0; m < 4; ++m) { const int row = row0 + ai * HALF + m * 16, hh = row >> 7, d = row & 127;
                const int dt = 2 * (d >> 5) + ((d >> 2) & 1), i = 4 * ((d >> 3) & 3) + (d & 3);
#pragma unroll
                for (int bj = 0; bj < 2; ++bj) { const int tok = col0 + bj * HALF, R = tok >> 6, o = (tok & 63) >> 3;
                    *(u32x4*)(O + ((size_t)((((R * 16 + hh) * 8 + dt) * 8 + o) * 16 + i)) * 8) = pack8(acc[ai][bj][m][0], acc[ai][bj][m][1]); } }
    }
};
struct EpiProj {
    static constexpr bool PERM = true, AFTER_DRAIN = false;
    bf16_t* P0; bf16_t* P1; bf16_t* P2; bf16_t* P3; bf16_t* G; const float* bias; int pn_gate0;
    __device__ __forceinline__ void operator()(const f32x4 (&acc)[2][2][4][2], const Unit& u, int wr, int wc, int fr, int fq) const {
        const int row0 = u.pm * BM + wr * 64 + fr;
        if (u.pn < pn_gate0) {
            const int t = u.pn >> 3; bf16_t* base = t == 0 ? P0 : (t == 1 ? P1 : (t == 2 ? P2 : P3));
            const int col0 = (u.pn & 7) * BM + wc * 32 + 8 * fq;
            if (t == 2) {
#pragma unroll
                for (int ai = 0; ai < 2; ++ai)
#pragma unroll
                    for (int m = 0; m < 4; ++m) { const int tok = row0 + ai * HALF + m * 16, R = tok >> 6, cl = tok & 63;
                        const int tokpart = (((cl >> 2) & 1) * 8 + (cl >> 3)) * 4 + (cl & 3);
#pragma unroll
                        for (int bj = 0; bj < 2; ++bj) { const int c = col0 + bj * HALF, hh = c >> 7, d0 = c & 127;
                            *(u32x4*)(base + ((size_t)(((R * 16 + hh) * 4 + (d0 >> 5)) * 64 + tokpart) * 4 + ((d0 >> 3) & 3)) * 8) = pack8(acc[ai][bj][m][0], acc[ai][bj][m][1]); } }
            } else {
#pragma unroll
            for (int ai = 0; ai < 2; ++ai)
#pragma unroll
                for (int m = 0; m < 4; ++m) { bf16_t* rowp = base + (size_t)(row0 + ai * HALF + m * 16) * NAW + col0;
#pragma unroll
                    for (int bj = 0; bj < 2; ++bj) *(u32x4*)(rowp + bj * HALF) = pack8(acc[ai][bj][m][0], acc[ai][bj][m][1]); }
            }
        } else {
            const int col0 = (u.pn - pn_gate0) * BM + wc * 32 + 8 * fq;
            f32x4 bv[2][2];
#pragma unroll
            for (int bj = 0; bj < 2; ++bj)
#pragma unroll
                for (int n = 0; n < 2; ++n) bv[bj][n] = *(const f32x4*)(bias + col0 + bj * HALF + 4 * n);
#pragma unroll
            for (int ai = 0; ai < 2; ++ai)
#pragma unroll
                for (int m = 0; m < 4; ++m) { bf16_t* rowp = G + (size_t)(row0 + ai * HALF + m * 16) * (2 * D) + col0;
#pragma unroll
                    for (int bj = 0; bj < 2; ++bj) *(u32x4*)(rowp + bj * HALF) = pack8(sig4(acc[ai][bj][m][0] + bv[bj][0]), sig4(acc[ai][bj][m][1] + bv[bj][1])); }
        }
    }
};
template <bool ADD> struct EpiMulG {
    static constexpr bool PERM = true, AFTER_DRAIN = false;
    bf16_t* O; const bf16_t* G; int goff;
    __device__ __forceinline__ void operator()(const f32x4 (&acc)[2][2][4][2], const Unit& u, int wr, int wc, int fr, int fq) const {
        const int row0 = u.pm * BM + wr * 64 + fr, col0 = u.pn * BM + wc * 32 + 8 * fq;
#pragma unroll
        for (int ai = 0; ai < 2; ++ai)
#pragma unroll
            for (int m = 0; m < 4; ++m) { const size_t row = (size_t)(row0 + ai * HALF + m * 16); bf16_t* rowp = O + row * D + col0; const bf16_t* gp = G + row * (2 * D) + goff + col0;
#pragma unroll
                for (int bj = 0; bj < 2; ++bj) {
                    f32x4 g0, g1; unpack8(*(const u32x4*)(gp + bj * HALF), g0, g1);
                    f32x4 v0 = acc[ai][bj][m][0] * g0, v1 = acc[ai][bj][m][1] * g1;
                    if (ADD) { f32x4 t0, t1; unpack8(*(const u32x4*)(rowp + bj * HALF), t0, t1); v0 += t0; v1 += t1; }
                    *(u32x4*)(rowp + bj * HALF) = pack8(v0, v1); } }
    }
};
struct EpiSwiglu {
    static constexpr bool PERM = true, AFTER_DRAIN = false;
    bf16_t* H0; bf16_t* H1; int pm_split;
    __device__ __forceinline__ void operator()(const f32x4 (&acc)[2][2][4][2], const Unit& u, int wr, int wc, int fr, int fq) const {
        bf16_t* base = u.pm < pm_split ? H0 + (size_t)u.pm * BM * DFF : H1 + (size_t)(u.pm - pm_split) * BM * DFF;
        const int row0 = wr * 64 + fr, col0 = u.pn * HALF + wc * 32 + 8 * fq;
#pragma unroll
        for (int ai = 0; ai < 2; ++ai)
#pragma unroll
            for (int m = 0; m < 4; ++m) {
                f32x4 h[2];
#pragma unroll
                for (int n = 0; n < 2; ++n) { const f32x4 g = acc[ai][0][m][n], up = acc[ai][1][m][n];
#pragma unroll
                    for (int j = 0; j < 4; ++j) h[n][j] = g[j] * sigmoidf_(g[j]) * up[j]; }
                *(u32x4*)(base + (size_t)(row0 + ai * HALF + m * 16) * DFF + col0) = pack8(h[0], h[1]); }
    }
};

__device__ __forceinline__ f32x4 deq4(const f32x4 accbits, const float sa, const f32x4 sb) { const v4i32 q = __builtin_bit_cast(v4i32, accbits); return (f32x4){(float)q.x, (float)q.y, (float)q.z, (float)q.w} * sa * sb; }
struct EpiProjQ {
    static constexpr bool PERM = true, AFTER_DRAIN = false;
    bf16_t* Qb; bf16_t* Kb; bf16_t* G; const float* bias; const float* sa; const float* sb;
    __device__ __forceinline__ void operator()(const f32x4 (&acc)[2][2][4][2], const Unit& u, int wr, int wc, int fr, int fq) const {
        const int row0 = u.pm * BM + wr * 64 + fr, cg0 = u.pn * BM + wc * 32 + 8 * fq;
        f32x4 sbv[2][2];
#pragma unroll
        for (int bj = 0; bj < 2; ++bj)
#pragma unroll
            for (int n = 0; n < 2; ++n) sbv[bj][n] = *(const f32x4*)(sb + cg0 + bj * HALF + 4 * n);
        if (u.pn < 8) {
            const int col0 = u.pn * BM + wc * 32 + 8 * fq;
#pragma unroll
            for (int ai = 0; ai < 2; ++ai)
#pragma unroll
                for (int m = 0; m < 4; ++m) { const int row = row0 + ai * HALF + m * 16; const float sr = sa[row]; bf16_t* rowp = Qb + (size_t)row * NAW + col0;
#pragma unroll
                    for (int bj = 0; bj < 2; ++bj) *(u32x4*)(rowp + bj * HALF) = pack8(deq4(acc[ai][bj][m][0], sr, sbv[bj][0]), deq4(acc[ai][bj][m][1], sr, sbv[bj][1])); }
        } else if (u.pn < 16) {
            const int col0 = (u.pn - 8) * BM + wc * 32 + 8 * fq;
#pragma unroll
            for (int ai = 0; ai < 2; ++ai)
#pragma unroll
                for (int m = 0; m < 4; ++m) { const int tok = row0 + ai * HALF + m * 16, R = tok >> 6, cl = tok & 63; const float sr = sa[tok];
                    const int tokpart = (((cl >> 2) & 1) * 8 + (cl >> 3)) * 4 + (cl & 3);
#pragma unroll
                    for (int bj = 0; bj < 2; ++bj) { const int c = col0 + bj * HALF, hh = c >> 7, d0 = c & 127;
                        *(u32x4*)(Kb + ((size_t)(((R * 16 + hh) * 4 + (d0 >> 5)) * 64 + tokpart) * 4 + ((d0 >> 3) & 3)) * 8) = pack8(deq4(acc[ai][bj][m][0], sr, sbv[bj][0]), deq4(acc[ai][bj][m][1], sr, sbv[bj][1])); } }
        } else {
            const int col0 = (u.pn - 16) * BM + wc * 32 + 8 * fq;
            f32x4 bv[2][2];
#pragma unroll
            for (int bj = 0; bj < 2; ++bj)
#pragma unroll
                for (int n = 0; n < 2; ++n) bv[bj][n] = *(const f32x4*)(bias + col0 + bj * HALF + 4 * n);
#pragma unroll
            for (int ai = 0; ai < 2; ++ai)
#pragma unroll
                for (int m = 0; m < 4; ++m) { const int row = row0 + ai * HALF + m * 16; const float sr = sa[row]; bf16_t* rowp = G + (size_t)row * (2 * D) + col0;
#pragma unroll
                    for (int bj = 0; bj < 2; ++bj) *(u32x4*)(rowp + bj * HALF) = pack8(sig4(deq4(acc[ai][bj][m][0], sr, sbv[bj][0]) + bv[bj][0]), sig4(deq4(acc[ai][bj][m][1], sr, sbv[bj][1]) + bv[bj][1])); }
        }
    }
};
struct EpiPlainQ {
    static constexpr bool PERM = true, AFTER_DRAIN = false;
    bf16_t* O; int ldc; const float* sa; const float* sb;
    __device__ __forceinline__ void operator()(const f32x4 (&acc)[2][2][4][2], const Unit& u, int wr, int wc, int fr, int fq) const {
        const int row0 = u.pm * BM + wr * 64 + fr, col0 = u.pn * BM + wc * 32 + 8 * fq;
        f32x4 sbv[2][2];
#pragma unroll
        for (int bj = 0; bj < 2; ++bj)
#pragma unroll
            for (int n = 0; n < 2; ++n) sbv[bj][n] = *(const f32x4*)(sb + col0 + bj * HALF + 4 * n);
#pragma unroll
        for (int ai = 0; ai < 2; ++ai)
#pragma unroll
            for (int m = 0; m < 4; ++m) { const int row = row0 + ai * HALF + m * 16; const float sr = sa[row]; bf16_t* rowp = O + (size_t)row * ldc + col0;
#pragma unroll
                for (int bj = 0; bj < 2; ++bj) *(u32x4*)(rowp + bj * HALF) = pack8(deq4(acc[ai][bj][m][0], sr, sbv[bj][0]), deq4(acc[ai][bj][m][1], sr, sbv[bj][1])); }
    }
};
struct EpiVTQ {
    static constexpr bool PERM = true, AFTER_DRAIN = false;
    bf16_t* O; const float* sa; const float* sb;
    __device__ __forceinline__ void operator()(const f32x4 (&acc)[2][2][4][2], const Unit& u, int wr, int wc, int fr, int fq) const {
        const int row0 = u.pm * BM + wr * 64 + fr, col0 = u.pn * BM + wc * 32 + 8 * fq;
        f32x4 sbv[2][2];
#pragma unroll
        for (int bj = 0; bj < 2; ++bj)
#pragma unroll
            for (int n = 0; n < 2; ++n) sbv[bj][n] = *(const f32x4*)(sb + col0 + bj * HALF + 4 * n);
#pragma unroll
        for (int ai = 0; ai < 2; ++ai)
#pragma unroll
            for (int m = 0; m < 4; ++m) { const int row = row0 + ai * HALF + m * 16, hh = row >> 7, d = row & 127; const float sr = sa[row];
                const int dt = 2 * (d >> 5) + ((d >> 2) & 1), i = 4 * ((d >> 3) & 3) + (d & 3);
#pragma unroll
                for (int bj = 0; bj < 2; ++bj) { const int tok = col0 + bj * HALF, R = tok >> 6, o = (tok & 63) >> 3;
                    *(u32x4*)(O + ((size_t)((((R * 16 + hh) * 8 + dt) * 8 + o) * 16 + i)) * 8) = pack8(deq4(acc[ai][bj][m][0], sr, sbv[bj][0]), deq4(acc[ai][bj][m][1], sr, sbv[bj][1])); } }
    }
};
struct EpiSwigluQ {
    static constexpr bool PERM = true, AFTER_DRAIN = false;
    bf16_t* H0; bf16_t* H1; int pm_split; const float* sa; const float* sb;
    __device__ __forceinline__ void operator()(const f32x4 (&acc)[2][2][4][2], const Unit& u, int wr, int wc, int fr, int fq) const {
        bf16_t* base = u.pm < pm_split ? H0 + (size_t)u.pm * BM * DFF : H1 + (size_t)(u.pm - pm_split) * BM * DFF;
        const int row0 = wr * 64 + fr, col0 = u.pn * HALF + wc * 32 + 8 * fq, cg0 = u.pn * BM + wc * 32 + 8 * fq;
        f32x4 sbv[2][2];
#pragma unroll
        for (int bj = 0; bj < 2; ++bj)
#pragma unroll
            for (int n = 0; n < 2; ++n) sbv[bj][n] = *(const f32x4*)(sb + cg0 + bj * HALF + 4 * n);
#pragma unroll
        for (int ai = 0; ai < 2; ++ai)
#pragma unroll
            for (int m = 0; m < 4; ++m) { const float sr = sa[u.pm * BM + row0 + ai * HALF + m * 16];
                f32x4 h[2];
#pragma unroll
                for (int n = 0; n < 2; ++n) { const f32x4 g = deq4(acc[ai][0][m][n], sr, sbv[0][n]), up = deq4(acc[ai][1][m][n], sr, sbv[1][n]);
#pragma unroll
                    for (int j = 0; j < 4; ++j) h[n][j] = g[j] * sigmoidf_(g[j]) * up[j]; }
                *(u32x4*)(base + (size_t)(row0 + ai * HALF + m * 16) * DFF + col0) = pack8(h[0], h[1]); }
    }
};

__device__ __forceinline__ v8i32 cat8(const bf16x8 lo, const bf16x8 hi) { return __builtin_shufflevector(__builtin_bit_cast(v4i32, lo), __builtin_bit_cast(v4i32, hi), 0, 1, 2, 3, 4, 5, 6, 7); }
__device__ __forceinline__ void mfma_fp8_acc(f32x4& c, const v8i32 a, const v8i32 b, int sa, int sb) {
    asm volatile("v_mfma_scale_f32_16x16x128_f8f6f4 %0, %1, %2, %0, %3, %4 op_sel_hi:[0,0,0]" : "+v"(c) : "v"(a), "v"(b), "v"(sa), "v"(sb)); }
constexpr int FP8_SCALE = 0x73737373;
template <class Epi, class Sched, bool ALIGN_EPI = false, bool SP2 = false, int QM = 0  , int DBG = 0>
__device__ __forceinline__ void gemm_phase(LAS unsigned char* lds, const Gemm g, const Sched& S, const Epi& E) {
    int tid = threadIdx.x; asm volatile("" : "+v"(tid));
    const int wid = __builtin_amdgcn_readfirstlane(tid >> 6), lane = tid & 63, wr = wid >> 2, wc = wid & 3, fr = lane & 15, fq = lane >> 4;
    const int RB = g.rb, nt = RB / (BK * 2);
    unsigned voffA[2], voffB[2];
#pragma unroll
    for (int i = 0; i < 2; ++i) { int R, C; stage_rc(tid * 16 + i * 8192, R, C); const int Rb = Epi::PERM ? ((R & ~31) + perm32(R & 31)) : R;
        voffA[i] = (unsigned)(R * RB + C * 2); voffB[i] = (unsigned)(Rb * RB + C * 2); }
    const size_t kstep = (size_t)(BK * 2);
    const size_t hstep = (size_t)HALF * RB;
    const unsigned ldsw = (unsigned)wid * 1024u;
    const int aoff0 = lds_byte(wr * 64 + fr, fq * 8), aoff1 = lds_byte(wr * 64 + fr, 32 + fq * 8), boff0 = lds_byte(wc * 32 + fr, fq * 8), boff1 = lds_byte(wc * 32 + fr, 32 + fq * 8);
#define PG8_SA(b, h) (((b) * 2 + (h)) * HTB)
#define PG8_SB(b, h) ((4 + (b) * 2 + (h)) * HTB)
#define PG8_STAGE(bufoff, gbase, voff) do { if constexpr (DBG != 3) _Pragma("unroll") for (int _i = 0; _i < 2; ++_i) \
        __builtin_amdgcn_global_load_lds((const unsigned*)((const char*)(gbase) + (voff)[_i]), (LAS unsigned*)(lds + (bufoff) + ldsw + _i * 8192), 16, 0, 0); } while (0)
#define PG8_LDA(dst, b, h) do { if constexpr (DBG != 2) _Pragma("unroll") for (int m = 0; m < 4; ++m) _Pragma("unroll") for (int k = 0; k < 2; ++k) dst[m][k] = *(const LAS bf16x8*)(lds + PG8_SA(b, h) + (k ? aoff1 : aoff0) + m * 2048); } while (0)
#define PG8_LDB(dst, b, h) do { if constexpr (DBG != 2) _Pragma("unroll") for (int n = 0; n < 2; ++n) _Pragma("unroll") for (int k = 0; k < 2; ++k) dst[n][k] = *(const LAS bf16x8*)(lds + PG8_SB(b, h) + (k ? boff1 : boff0) + n * 2048); } while (0)
#define PG8_MMA(ai, bj, At, Bt) do { __builtin_amdgcn_s_setprio(1); if constexpr (DBG == 1) { } else if constexpr (QM == 2) { _Pragma("unroll") for (int m = 0; m < 4; ++m) _Pragma("unroll") for (int n = 0; n < 2; ++n) _Pragma("unroll") for (int k = 0; k < 2; ++k) \
        acc[ai][bj][m][n] = __builtin_bit_cast(f32x4, __builtin_amdgcn_mfma_i32_16x16x64_i8(__builtin_bit_cast(v4i32, Bt[n][k]), __builtin_bit_cast(v4i32, At[m][k]), __builtin_bit_cast(v4i32, acc[ai][bj][m][n]), 0, 0, 0)); } else if constexpr (QM == 1) { _Pragma("unroll") for (int m = 0; m < 4; ++m) _Pragma("unroll") for (int n = 0; n < 2; ++n) \
        mfma_fp8_acc(acc[ai][bj][m][n], cat8(Bt[n][0], Bt[n][1]), cat8(At[m][0], At[m][1]), fp8_sa, fp8_sb); } else { \
        _Pragma("unroll") for (int m = 0; m < 4; ++m) _Pragma("unroll") for (int n = 0; n < 2; ++n) _Pragma("unroll") for (int k = 0; k < 2; ++k) \
        acc[ai][bj][m][n] = __builtin_amdgcn_mfma_f32_16x16x32_bf16(Bt[n][k], At[m][k], acc[ai][bj][m][n], 0, 0, 0); } __builtin_amdgcn_s_setprio(0); } while (0)
#define PG8_WAIT_V(n) asm volatile("s_waitcnt vmcnt(" #n ")" ::: "memory")
#define PG8_WAIT_L(n) asm volatile("s_waitcnt lgkmcnt(" #n ")" ::: "memory")
#define PG8_BAR __builtin_amdgcn_s_barrier()
#define PG8_SCHED __builtin_amdgcn_sched_barrier(0)
    Unit cur, nxt; int ui = 0;
    const int fp8_sa = FP8_SCALE, fp8_sb = 0x7F7F7F7F;
    if (!S.next(0, cur)) return;
    f32x4 acc[2][2][4][2];
#pragma unroll
    for (int a = 0; a < 2; ++a)
#pragma unroll
        for (int b = 0; b < 2; ++b)
#pragma unroll
            for (int m = 0; m < 4; ++m)
#pragma unroll
                for (int n = 0; n < 2; ++n) acc[a][b][m][n] = (f32x4){0.f, 0.f, 0.f, 0.f};
    bf16x8 At[4][2], B0[2][2], B1[2][2];
    const char* cA = g.abase(cur.pm); const char* cB = g.bbase(cur.pn);
    S.a_ready(cur);
    if constexpr (SP2) {
        PG8_STAGE(PG8_SB(0, 0), cB, voffB); PG8_STAGE(PG8_SB(0, 1), cB + hstep, voffB); PG8_STAGE(PG8_SA(0, 0), cA, voffA); PG8_STAGE(PG8_SA(0, 1), cA + hstep, voffA);
        if (wr == 1) PG8_BAR;
        PG8_WAIT_V(2); PG8_BAR;
        PG8_STAGE(PG8_SB(1, 0), cB + kstep, voffB); PG8_STAGE(PG8_SA(1, 0), cA + kstep, voffA); PG8_STAGE(PG8_SB(1, 1), cB + hstep + kstep, voffB);
        PG8_WAIT_V(6); PG8_BAR;
    } else {
        PG8_STAGE(PG8_SB(0, 0), cB, voffB); PG8_STAGE(PG8_SA(0, 0), cA, voffA); PG8_STAGE(PG8_SB(0, 1), cB + hstep, voffB); PG8_STAGE(PG8_SA(0, 1), cA + hstep, voffA);
        if (wr == 1) PG8_BAR;
        PG8_WAIT_V(4); PG8_BAR;
        PG8_STAGE(PG8_SB(1, 0), cB + kstep, voffB); PG8_STAGE(PG8_SA(1, 0), cA + kstep, voffA); PG8_STAGE(PG8_SB(1, 1), cB + hstep + kstep, voffB);
        PG8_WAIT_V(6); PG8_BAR;
    }
    for (;;) {
        const bool has_next = S.next(ui + 1, nxt);
        const char* nA = has_next ? g.abase(nxt.pm) : cA; const char* nB = has_next ? g.bbase(nxt.pn) : cB;
        for (int t = 0; t < nt; t += 2) {
            const bool last = (t == nt - 2);
            const char* a1 = cA + (size_t)(t + 1) * kstep;
            const char* a2 = last ? nA : cA + (size_t)(t + 2) * kstep; const char* b2 = last ? nB : cB + (size_t)(t + 2) * kstep;
            const char* a3 = a2 + kstep; const char* b3 = b2 + kstep;
            if (last && has_next) S.a_ready(nxt);
            if constexpr (SP2) {
            PG8_LDB(B0, 0, 0); PG8_LDB(B1, 0, 1); PG8_SCHED; PG8_LDA(At, 0, 0); PG8_STAGE(PG8_SA(1, 1), a1 + hstep, voffA);
            PG8_WAIT_V(8); PG8_WAIT_L(0); PG8_BAR; PG8_MMA(0, 0, At, B0); PG8_MMA(0, 1, At, B1); PG8_BAR; PG8_SCHED;
            PG8_LDA(At, 0, 1); PG8_STAGE(PG8_SB(0, 0), b2, voffB); PG8_STAGE(PG8_SB(0, 1), b2 + hstep, voffB); PG8_STAGE(PG8_SA(0, 0), a2, voffA);
            PG8_WAIT_V(8); PG8_WAIT_L(0); PG8_BAR; PG8_MMA(1, 0, At, B0); PG8_MMA(1, 1, At, B1); PG8_BAR; PG8_SCHED;
            PG8_LDB(B0, 1, 0); PG8_LDB(B1, 1, 1); PG8_SCHED; PG8_LDA(At, 1, 0); PG8_STAGE(PG8_SA(0, 1), a2 + hstep, voffA);
            PG8_WAIT_V(8); PG8_WAIT_L(0); PG8_BAR; PG8_MMA(0, 0, At, B0); PG8_MMA(0, 1, At, B1); PG8_BAR; PG8_SCHED;
            PG8_LDA(At, 1, 1); PG8_STAGE(PG8_SB(1, 0), b3, voffB); PG8_STAGE(PG8_SB(1, 1), b3 + hstep, voffB); PG8_STAGE(PG8_SA(1, 0), a3, voffA);
            PG8_WAIT_V(8); PG8_WAIT_L(0); PG8_BAR; PG8_MMA(1, 0, At, B0); PG8_MMA(1, 1, At, B1); PG8_BAR; PG8_SCHED;
            } else {
            PG8_LDB(B0, 0, 0); PG8_SCHED; PG8_LDA(At, 0, 0); PG8_STAGE(PG8_SA(1, 1), a1 + hstep, voffA);
            PG8_WAIT_L(8); PG8_BAR; PG8_WAIT_L(0); PG8_MMA(0, 0, At, B0); PG8_BAR; PG8_SCHED;
            PG8_LDB(B1, 0, 1); PG8_STAGE(PG8_SB(0, 0), b2, voffB);
            PG8_BAR; PG8_WAIT_L(0); PG8_MMA(0, 1, At, B1); PG8_BAR;
            PG8_LDA(At, 0, 1); PG8_STAGE(PG8_SA(0, 0), a2, voffA);
            PG8_BAR; PG8_WAIT_L(0); PG8_MMA(1, 0, At, B0); PG8_BAR; PG8_SCHED;
            PG8_STAGE(PG8_SB(0, 1), b2 + hstep, voffB);
            PG8_WAIT_V(6); PG8_BAR; PG8_MMA(1, 1, At, B1); PG8_BAR;
            PG8_LDB(B0, 1, 0); PG8_SCHED; PG8_LDA(At, 1, 0); PG8_STAGE(PG8_SA(0, 1), a2 + hstep, voffA);
            PG8_WAIT_L(8); PG8_BAR; PG8_WAIT_L(0); PG8_MMA(0, 0, At, B0); PG8_BAR; PG8_SCHED;
            PG8_LDB(B1, 1, 1); PG8_STAGE(PG8_SB(1, 0), b3, voffB);
            PG8_BAR; PG8_WAIT_L(0); PG8_MMA(0, 1, At, B1); PG8_BAR;
            PG8_LDA(At, 1, 1); PG8_STAGE(PG8_SA(1, 0), a3, voffA);
            PG8_BAR; PG8_WAIT_L(0); PG8_MMA(1, 0, At, B0); PG8_BAR; PG8_SCHED;
            PG8_STAGE(PG8_SB(1, 1), b3 + hstep, voffB);
            PG8_WAIT_V(6); PG8_BAR; PG8_MMA(1, 1, At, B1); PG8_BAR;
            }
        }
        if constexpr (ALIGN_EPI) { if (wr == 0) PG8_BAR; }
        if constexpr (!Epi::AFTER_DRAIN) { if constexpr (DBG != 4) E(acc, cur, wr, wc, fr, fq); else { _Pragma("unroll") for (int a_ = 0; a_ < 2; ++a_) _Pragma("unroll") for (int b_ = 0; b_ < 2; ++b_) _Pragma("unroll") for (int m_ = 0; m_ < 4; ++m_) _Pragma("unroll") for (int n_ = 0; n_ < 2; ++n_) asm volatile("" :: "v"(acc[a_][b_][m_][n_])); } S.done(cur); }
        if (!has_next) break;
#pragma unroll
        for (int a = 0; a < 2; ++a)
#pragma unroll
            for (int b = 0; b < 2; ++b)
#pragma unroll
                for (int m = 0; m < 4; ++m)
#pragma unroll
                    for (int n = 0; n < 2; ++n) acc[a][b][m][n] = (f32x4){0.f, 0.f, 0.f, 0.f};
        cur = nxt; cA = nA; cB = nB; ++ui;
        if constexpr (ALIGN_EPI) { if (wr == 1) PG8_BAR; }
    }
    PG8_WAIT_V(0);
    if constexpr (!ALIGN_EPI) { if (wr == 0) PG8_BAR; }
    PG8_BAR;
    if constexpr (Epi::AFTER_DRAIN) { E.fused(acc, cur, wr, wc, fr, fq, lds, wid, lane); S.done(cur); }
#undef PG8_SA
#undef PG8_SB
#undef PG8_STAGE
#undef PG8_LDA
#undef PG8_LDB
#undef PG8_MMA
#undef PG8_WAIT_V
#undef PG8_WAIT_L
#undef PG8_BAR
#undef PG8_SCHED
}
}
#define XB_TMO      128
#define XB_XCNT(j)  (256  + 64 * (j))
#define XB_XSUB(j)  (1280 + 64 * (j))
#define XB_XGEN(j)  (2304 + 64 * (j))
#define XB_TOP      3328
#define XB_TOPGEN   3392
#define XCD_BAR_WORDS 3456
#define XB_SPIN_CAP (1u << 18)

__device__ __forceinline__ unsigned xb_ld(unsigned* p)              { return __hip_atomic_load(p, __ATOMIC_RELAXED, __HIP_MEMORY_SCOPE_AGENT); }
__device__ __forceinline__ unsigned xb_add(unsigned* p, unsigned v) { return __hip_atomic_fetch_add(p, v, __ATOMIC_RELAXED, __HIP_MEMORY_SCOPE_AGENT); }
__device__ __forceinline__ unsigned xb_xcc_id() { return (unsigned)__builtin_amdgcn_s_getreg((3 << 11) | 20) & 0xFu; }
#define XB_SPIN(cond, bar) do { unsigned _sp = 0; while (cond) { __builtin_amdgcn_s_sleep(1); \
    if ((++_sp & 255u) == 0u) { if (xb_ld(&(bar)[XB_TMO])) break; if (_sp > XB_SPIN_CAP) { atomicAdd(&(bar)[XB_TMO], 1u); break; } } } } while (0)

struct XcdBarrier {
    unsigned* bar; unsigned x;
    volatile LAS unsigned* st;
};

__device__ __forceinline__ XcdBarrier xcd_barrier_post(unsigned* bar, volatile LAS unsigned* st) {
    XcdBarrier b; b.bar = bar; b.x = xb_xcc_id(); b.st = st;
    if (threadIdx.x == 0) (void)xb_add(&bar[XB_XCNT(b.x)], 1u);
    return b;
}
__device__ __forceinline__ void xcd_barrier_complete(unsigned* bar, unsigned x, unsigned& nloc, unsigned& nx) {
    const unsigned G = gridDim.x * gridDim.y * gridDim.z;
    unsigned sum, cnt, mine, sp = 0u;
    for (;;) {
        sum = 0u; cnt = 0u; mine = 0u;
#pragma unroll
        for (unsigned j = 0; j < 16; ++j) { const unsigned c = xb_ld(&bar[XB_XCNT(j)]); sum += c; cnt += (c > 0u) ? 1u : 0u; mine = (j == x) ? c : mine; }
        if (sum == G) break;
        __builtin_amdgcn_s_sleep(1);
        if ((++sp & 255u) == 0u) { if (xb_ld(&bar[XB_TMO])) break; if (sp > XB_SPIN_CAP) { atomicAdd(&bar[XB_TMO], 1u); break; } }
    }
    nloc = mine > 0u ? mine : 1u; nx = cnt > 0u ? cnt : 1u;
}

__device__ __forceinline__ void xcd_barrier(const XcdBarrier& b) {
    asm volatile("s_waitcnt vmcnt(0)" ::: "memory");
    __syncthreads();
    if (threadIdx.x == 0) {
        unsigned* bar = b.bar;
        __builtin_amdgcn_s_waitcnt(0);
        unsigned nloc = b.st[0], nx = b.st[1];
        if (nloc == 0u) { xcd_barrier_complete(bar, b.x, nloc, nx); b.st[0] = nloc; b.st[1] = nx; }
        const unsigned old = xb_add(&bar[XB_XSUB(b.x)], 1u);
        const unsigned gen = old / nloc;
        if (old + 1u == (gen + 1u) * nloc) {
            __builtin_amdgcn_fence(__ATOMIC_RELEASE, "agent");
            asm volatile("s_waitcnt vmcnt(0)" ::: "memory");
            const unsigned og = xb_add(&bar[XB_TOP], 1u);
            const unsigned tg = og / nx;
            if (og + 1u == (tg + 1u) * nx) xb_add(&bar[XB_TOPGEN], 1u);
            else XB_SPIN(xb_ld(&bar[XB_TOPGEN]) == tg, bar);
            __builtin_amdgcn_fence(__ATOMIC_ACQUIRE, "agent");
            xb_add(&bar[XB_XGEN(b.x)], 1u);
            asm volatile("s_waitcnt vmcnt(0)" ::: "memory");
        } else {
            XB_SPIN(xb_ld(&bar[XB_XGEN(b.x)]) == gen, bar);
            __builtin_amdgcn_fence(__ATOMIC_ACQUIRE, "agent");
            asm volatile("s_waitcnt vmcnt(0)" ::: "memory");
        }
    }
    __syncthreads();
}


struct Frame {
    LAS unsigned char* lds;
    int tid, lane, wave, G, gw, ngw;
    const float *in_XP, *in_XS, *in_WIN, *in_WCONV, *in_BCONV, *in_WR, *in_BR, *in_WI, *in_BI, *in_LAM, *in_RPB, *in_WNO, *in_WLO, *in_WM, *in_BM, *in_WOUT, *in_GMPRE, *in_GMPOST, *in_GFPRE, *in_GFPOST, *in_WFG, *in_WFU, *in_WFD; float* out; unsigned char* ws;
};
enum { I_XP = 0, I_XS, I_WIN, I_WCONV, I_BCONV, I_WR, I_BR, I_WI, I_BI, I_LAM, I_RPB, I_WNO, I_WLO, I_WM, I_BM, I_WOUT, I_GMPRE, I_GMPOST, I_GFPRE, I_GFPOST, I_WFG, I_WFU, I_WFD };
__device__ __forceinline__ int opaque(int x) { asm volatile("" : "+v"(x)); return x; }
template <class T> __device__ __forceinline__ T* wsp(const Frame& F, size_t off) { return (T*)(F.ws + off); }
__device__ __forceinline__ const float* xrow(const Frame& F, int m) { return m < LP ? F.in_XP + (size_t)m * D : F.in_XS + (size_t)(m - LP) * D; }

__device__ __forceinline__ void tr_item(const float* src, int ldsrc, int k0, int n0, bf16_t* dst, int ldd, int drow0, LAS float* scr, int lane) {
#pragma unroll 8
    for (int i = 0; i < 32; ++i) { const int kk = 2 * i + (lane >> 5); scr[kk * 33 + (lane & 31)] = src[(size_t)(k0 + kk) * ldsrc + n0 + (lane & 31)]; }
    LDS_WAIT(); asm volatile("" ::: "memory");
    const int c = lane & 7;
#pragma unroll
    for (int j = 0; j < 4; ++j) { const int n = (lane >> 3) + 8 * j; const LAS float* s = scr + (8 * c) * 33 + n;
        u32x4 o; o.x = pk2(s[0 * 33], s[1 * 33]); o.y = pk2(s[2 * 33], s[3 * 33]); o.z = pk2(s[4 * 33], s[5 * 33]); o.w = pk2(s[6 * 33], s[7 * 33]);
        *(u32x4*)(dst + (size_t)(drow0 + n) * ldd + k0 + 8 * c) = o; }
    LDS_WAIT(); asm volatile("" ::: "memory");
}
__device__ __forceinline__ unsigned pk4_fp8(float a, float b, float c, float d) { int p = __builtin_amdgcn_cvt_pk_fp8_f32(a, b, 0, false); p = __builtin_amdgcn_cvt_pk_fp8_f32(c, d, p, true); return (unsigned)p; }
__device__ __forceinline__ void tr_item8(const float* src, int ldsrc, int k0, int n0, unsigned char* dst, int ldd, int drow0, LAS float* scr, int lane) {
#pragma unroll 8
    for (int i = 0; i < 32; ++i) { const int kk = 2 * i + (lane >> 5); scr[kk * 33 + (lane & 31)] = src[(size_t)(k0 + kk) * ldsrc + n0 + (lane & 31)]; }
    LDS_WAIT(); asm volatile("" ::: "memory");
    const int c = lane & 7;
#pragma unroll
    for (int j = 0; j < 4; ++j) { const int n = (lane >> 3) + 8 * j; const LAS float* s = scr + (8 * c) * 33 + n;
        u32x2 o; o.x = pk4_fp8(s[0 * 33] * 256.f, s[1 * 33] * 256.f, s[2 * 33] * 256.f, s[3 * 33] * 256.f); o.y = pk4_fp8(s[4 * 33] * 256.f, s[5 * 33] * 256.f, s[6 * 33] * 256.f, s[7 * 33] * 256.f);
        *(u32x2*)(dst + (size_t)(drow0 + n) * ldd + k0 + 8 * c) = o; }
    LDS_WAIT(); asm volatile("" ::: "memory");
}
__device__ __forceinline__ unsigned pk4_i8(float a, float b, float c, float d) { return ((unsigned)(int)a & 255u) | (((unsigned)(int)b & 255u) << 8) | (((unsigned)(int)c & 255u) << 16) | ((unsigned)(int)d << 24); }
__device__ __forceinline__ void tr_strip_i8(const float* src, int ldsrc, int K, int n0, signed char* dst, int drow0, float* cs, LAS float* scr, int lane) {
    const float* sp = src + n0 + (lane & 31) + (size_t)(lane >> 5) * ldsrc;
    float mx = 0.f;
    { const float* p = sp; const size_t step = (size_t)2 * ldsrc;
      for (int k0 = 0; k0 < K; k0 += 64) {
        float t[32];
#pragma unroll
        for (int i = 0; i < 32; ++i) { t[i] = *p; p += step; }
#pragma unroll
        for (int i = 0; i < 32; ++i) mx = fmaxf(mx, fabsf(t[i]));
      } }
    mx = fmaxf(mx, __shfl_xor(mx, 32));
    const float amax = fmaxf(mx, 1e-20f), inv = 127.0f / amax;
    if (lane < 32) cs[drow0 + lane] = amax * (1.0f / 127.0f);
    const int c = lane & 7;
    for (int k0 = 0; k0 < K; k0 += 64) {
        { const float* p = sp + (size_t)k0 * ldsrc; const size_t step = (size_t)2 * ldsrc; LAS float* w = scr + (lane >> 5) * 33 + (lane & 31);
          float t[32];
#pragma unroll
          for (int i = 0; i < 32; ++i) { t[i] = *p; p += step; }
#pragma unroll
          for (int i = 0; i < 32; ++i) w[i * 66] = rintf(t[i] * inv); }
        LDS_WAIT(); asm volatile("" ::: "memory");
#pragma unroll
        for (int j = 0; j < 4; ++j) { const int n = (lane >> 3) + 8 * j; const LAS float* t = scr + (8 * c) * 33 + n;
            u32x2 o; o.x = pk4_i8(t[0 * 33], t[1 * 33], t[2 * 33], t[3 * 33]); o.y = pk4_i8(t[4 * 33], t[5 * 33], t[6 * 33], t[7 * 33]);
            *(u32x2*)(dst + (size_t)(drow0 + n) * K + k0 + 8 * c) = o; }
        LDS_WAIT(); asm volatile("" ::: "memory");
    }
}
__device__ __forceinline__ void fwht32(float (&v)[32]) {
#pragma unroll
    for (int st = 1; st < 32; st <<= 1)
#pragma unroll
        for (int i = 0; i < 32; ++i) if (!(i & st)) { const float a = v[i], b = v[i + st]; v[i] = a + b; v[i + st] = a - b; }
#pragma unroll
    for (int i = 0; i < 32; ++i) v[i] *= 0.17677669529663687f;
}
__device__ __forceinline__ void had_tile_load(const float* src, int ldsrc, int k0, int n0, LAS float* scr, int lane, float (&v)[32]) {
    { const float* p = src + (size_t)(k0 + (lane >> 5)) * ldsrc + n0 + (lane & 31); const size_t step = (size_t)2 * ldsrc; LAS float* w = scr + (lane >> 5) * 33 + (lane & 31); float t[32];
#pragma unroll
      for (int i = 0; i < 32; ++i) { t[i] = *p; p += step; }
#pragma unroll
      for (int i = 0; i < 32; ++i) w[i * 66] = t[i]; }
    LDS_WAIT(); asm volatile("" ::: "memory");
    const LAS float* hv = scr + (32 * (lane >> 5)) * 33 + (lane & 31);
#pragma unroll
    for (int i = 0; i < 32; ++i) v[i] = hv[i * 33];
    fwht32(v);
}
__device__ __forceinline__ void had_tile_amax(const float* src, int ldsrc, int k0, int n0, unsigned* am, LAS float* scr, int lane) {
    float v[32]; had_tile_load(src, ldsrc, k0, n0, scr, lane, v);
    float mx = 0.f;
#pragma unroll
    for (int i = 0; i < 32; ++i) mx = fmaxf(mx, fabsf(v[i]));
    mx = fmaxf(mx, __shfl_xor(mx, 32));
    if (lane < 32) atomicMax(am + n0 + lane, __builtin_bit_cast(unsigned, mx));
    LDS_WAIT(); asm volatile("" ::: "memory");
}
__device__ __forceinline__ void had_tile_quant(const float* src, int ldsrc, int K, int k0, int n0, signed char* dst, const unsigned* am, float* cs, LAS float* scr, int lane) {
    const float amax = fmaxf(__builtin_bit_cast(float, am[n0 + (lane & 31)]), 1e-20f), inv = 127.0f / amax;
    if (k0 == 0 && lane < 32) cs[n0 + lane] = amax * (1.0f / 127.0f);
    float v[32]; had_tile_load(src, ldsrc, k0, n0, scr, lane, v);
    LAS float* hv = scr + (32 * (lane >> 5)) * 33 + (lane & 31);
#pragma unroll
    for (int i = 0; i < 32; ++i) hv[i * 33] = rintf(v[i] * inv);
    LDS_WAIT(); asm volatile("" ::: "memory");
    const int c = lane & 7;
#pragma unroll
    for (int j = 0; j < 4; ++j) { const int n = (lane >> 3) + 8 * j; const LAS float* t = scr + (8 * c) * 33 + n;
        u32x2 o; o.x = pk4_i8(t[0 * 33], t[1 * 33], t[2 * 33], t[3 * 33]); o.y = pk4_i8(t[4 * 33], t[5 * 33], t[6 * 33], t[7 * 33]);
        *(u32x2*)(dst + (size_t)(n0 + n) * K + k0 + 8 * c) = o; }
    LDS_WAIT(); asm volatile("" ::: "memory");
}
#define TR_JOB(SRC, LDSRC, KK, NN, DST, DROW_EXPR) { const int nblk = (NN) / 32, nit = ((KK) / 64) * nblk; \
    if (r < nit) { const int kb = r / nblk, nb = r % nblk, n0 = 32 * nb; tr_item((SRC), (LDSRC), 64 * kb, n0, (DST), (KK), (DROW_EXPR), scr, F.lane); continue; } r -= nit; }
#define TR_JOB8(SRC, LDSRC, KK, NN, DST, DROW_EXPR) { const int nblk = (NN) / 32, nit = ((KK) / 64) * nblk; \
    if (r < nit) { const int kb = r / nblk, nb = r % nblk, n0 = 32 * nb; tr_item8((SRC), (LDSRC), 64 * kb, n0, (DST), (KK), (DROW_EXPR), scr, F.lane); continue; } r -= nit; }

__device__ __forceinline__ void p0_prologue(Frame& F) {
    const int tid_ = opaque(F.tid);
    LAS float* scr = (LAS float*)(F.lds + F.wave * 8448);
    const float* w_in = F.in_WIN;
    bf16_t* WCAT = wsp<bf16_t>(F, WS_WCAT); signed char* W8 = wsp<signed char>(F, WS_W8); signed char* WV8 = wsp<signed char>(F, WS_WVT); signed char* WGU8 = wsp<signed char>(F, WS_WGU);
    float* CS = wsp<float>(F, WS_CS);
    constexpr int NSM = 64;
    constexpr int IT_SM = 2 * 4;
    constexpr int S_Q = NAW / 32, S_M = 2 * D / 32, S_F = DFF / 32;
    constexpr int NSTRIP = 3 * S_Q + S_M + 2 * S_F;
    constexpr int N_AMAX = (DFF / 64) * (D / 32);
    constexpr int N_BIG = 2 * (D / 64) * (NAW / 32) + 2 * (NAW / 64) * (D / 32) + (D / 64) * (D / 32) + N_AMAX;
    constexpr int NITEMS = N_BIG + NSM * IT_SM;
    for (int it = F.gw; it < NSTRIP + NITEMS; it += F.ngw) {
        if (it < NSTRIP) {
            int q = it; const float* src; int ld, n0, drow0; signed char* dst; float* cs;
            if (q < S_Q) { src = w_in; ld = INW; n0 = 32 * q; dst = W8; drow0 = n0; cs = CS + CS_QKM; }
            else if ((q -= S_Q) < S_Q) { src = w_in + NAW; ld = INW; n0 = 32 * q; dst = W8; drow0 = 2048 + n0; cs = CS + CS_QKM; }
            else if ((q -= S_Q) < S_M) { src = F.in_WM; ld = 2 * D; n0 = 32 * q; dst = W8; drow0 = 4096 + n0; cs = CS + CS_QKM; }
            else if ((q -= S_M) < S_Q) { src = w_in + 2 * NAW; ld = INW; n0 = 32 * q; dst = WV8; drow0 = n0; cs = CS + CS_V; }
            else if ((q -= S_Q) < S_F) { src = F.in_WFG; ld = DFF; n0 = 32 * q; dst = WGU8; drow0 = (n0 >> 7) * 256 + (n0 & 127); cs = CS + CS_GU; }
            else { q -= S_F; src = F.in_WFU; ld = DFF; n0 = 32 * q; dst = WGU8; drow0 = (n0 >> 7) * 256 + 128 + (n0 & 127); cs = CS + CS_GU; }
            tr_strip_i8(src, ld, D, n0, dst, drow0, cs, scr, F.lane);
            continue;
        }
        int r = it - NSTRIP;
        TR_JOB(w_in + 3 * NAW, INW, D, NAW, WCAT, 0 + n0)
        TR_JOB(w_in + 4 * NAW, INW, D, NAW, WCAT, 2048 + n0)
        TR_JOB(F.in_WNO, D, NAW, D, wsp<bf16_t>(F, WS_WNO), n0)
        TR_JOB(F.in_WLO, D, LW, D, wsp<bf16_t>(F, WS_WLO), n0)
        TR_JOB(F.in_WOUT, D, D, D, wsp<bf16_t>(F, WS_WO), n0)
        if (r < N_AMAX) { had_tile_amax(F.in_WFD, D, 64 * (r / (D / 32)), 32 * (r % (D / 32)), (unsigned*)(F.ws + WS_AM), scr, F.lane); continue; } r -= N_AMAX;
        {
            const int mi = r / IT_SM, ri = r % IT_SM, d = mi >> 5, g = (mi >> 4) & 1, n = mi & 15, kb = ri >> 2, nb = ri & 3;
            const float* src = (g ? F.in_WI : F.in_WR) + (size_t)(d * NBLK + n) * BW * BW;
            tr_item(src, BW, 64 * kb, 32 * nb, wsp<bf16_t>(F, WS_WG) + (size_t)mi * BW * BW, BW, 32 * nb, scr, F.lane);
        }
    }
    LAS f32x4* gl = (LAS f32x4*)(F.lds + 69632);
    for (int i = tid_; i < D / 4; i += NTHR) gl[i] = ((const f32x4*)F.in_GMPRE)[i];
    __syncthreads();
    bf16_t* XN = wsp<bf16_t>(F, WS_XN); signed char* XN8 = wsp<signed char>(F, WS_XN8); float* RS1 = wsp<float>(F, WS_RS1);
    for (int m = F.gw; m < L; m += F.ngw) {
        asm volatile("" ::: "memory");
        const f32x4* xr = (const f32x4*)xrow(F, m) + F.lane;
        f32x4 v[16]; float s = 0.f;
#pragma unroll
        for (int j = 0; j < 16; ++j) { v[j] = xr[64 * j]; s += (v[j].x * v[j].x + v[j].y * v[j].y) + (v[j].z * v[j].z + v[j].w * v[j].w); }
        const float rstd = 1.0f / sqrtf(wave_sum(s) * (1.0f / D) + EPS);
        u32x2* o8 = (u32x2*)(XN + (size_t)m * D) + F.lane; unsigned* o4 = (unsigned*)(XN8 + (size_t)m * D) + F.lane;
        float mx = 0.f;
#pragma unroll
        for (int j = 0; j < 16; ++j) { v[j] = v[j] * rstd * gl[F.lane + 64 * j]; mx = fmaxf(fmaxf(mx, fmaxf(fabsf(v[j].x), fabsf(v[j].y))), fmaxf(fabsf(v[j].z), fabsf(v[j].w))); }
        const float amax = fmaxf(wave_max(mx), 1e-20f), inv = 127.0f / amax;
        if (F.lane == 0) RS1[m] = amax * (1.0f / 127.0f);
#pragma unroll
        for (int j = 0; j < 16; ++j) { const f32x4 y = v[j]; u32x2 o; o.x = pk2(y.x, y.y); o.y = pk2(y.z, y.w); o8[64 * j] = o;
            o4[64 * j] = pk4_i8(rintf(y.x * inv), rintf(y.y * inv), rintf(y.z * inv), rintf(y.w * inv)); }
    }
    __syncthreads();
}

#ifndef ATT_SYNC
#define ATT_SYNC 1
#endif
template <int ADBG = 0> __device__ __forceinline__ void attn_mfma(Frame& F) {
    const int tid_ = opaque(F.tid);
    bf16_t* Q = wsp<bf16_t>(F, WS_Q); const bf16_t* Kb = wsp<bf16_t>(F, WS_K); const bf16_t* VT = wsp<bf16_t>(F, WS_VT);
    LAS float* rp = (LAS float*)F.lds;
    for (int i = tid_; i < NH * 15 * 31; i += NTHR) rp[i] = F.in_RPB[i];
    __syncthreads();
    const int fr = F.lane & 15, fq = F.lane >> 4;
    const float scale = 0.08838834764831845f;
    for (int base = blockIdx.x * NWAVES; base < (L / GRIDW) * NH * 4; base += F.ngw) {
        const int item = base + F.wave;
        asm volatile("" ::: "memory");
        const int g = item & 3, h = (item >> 2) & 15, rg = item >> 6;
        const int s0 = rg < LP / GRIDW ? 0 : LP, rows = rg < LP / GRIDW ? LP / GRIDW : LS / GRIDW, r = rg < LP / GRIDW ? rg : rg - LP / GRIDW;
        int rs = r - 4; rs = rs < 0 ? 0 : (rs > rows - 8 ? rows - 8 : rs);
        const int w0 = g == 0 ? 0 : (g == 1 ? 8 : (g == 2 ? 24 : 32));
        const int c = 16 * g + fr;
        int cs = c - 8; cs = cs < 0 ? 0 : (cs > GRIDW - 16 ? GRIDW - 16 : cs);
        bf16_t* qrow = Q + (size_t)(s0 + r * GRIDW + c) * NAW + h * HD;
        bf16x8 qf[4];
#pragma unroll
        for (int s = 0; s < 4; ++s) qf[s] = *(const bf16x8*)(qrow + 8 * fq + 32 * s);
        f32x4 sacc[8][2];
        const int Rg = s0 / GRIDW + rs, p0 = w0 >> 3;
        const bf16_t* kbase = Kb + (size_t)(Rg * 16 + h) * 8192 + p0 * 128 + fr * 32 + fq * 8;
        bf16x8 kb[8][2][4];
#define ATT_LDK(kr) do { _Pragma("unroll") for (int T = 0; T < 2; ++T) _Pragma("unroll") for (int s = 0; s < 4; ++s) kb[kr][T][s] = (ADBG & 1) ? qf[s] : (ADBG & 4) ? *(const bf16x8*)(Kb + (size_t)(s0 + rs * GRIDW) * NAW + h * HD * GRIDW + ((kr) * 8 + T * 4 + s) * 512 + F.lane * 8) : *(const bf16x8*)(kbase + (size_t)(kr) * (16 * 8192) + (s * 2 + T) * 1024); } while (0)
        ATT_LDK(0); ATT_LDK(1);
#pragma unroll
        for (int kr = 0; kr < 8; ++kr) {
            if (ATT_SYNC && (kr & 1) == 0) __builtin_amdgcn_s_barrier();
            if (kr + 2 < 8) ATT_LDK(kr + 2);
            __builtin_amdgcn_sched_barrier(0);
#pragma unroll
            for (int T = 0; T < 2; ++T) { f32x4 a = (f32x4){0.f, 0.f, 0.f, 0.f};
#pragma unroll
                for (int s = 0; s < 4; ++s) a = __builtin_amdgcn_mfma_f32_16x16x32_bf16(kb[kr][T][s], qf[s], a, 0, 0, 0);
                sacc[kr][T] = a; }
            __builtin_amdgcn_sched_barrier(0);
        }
#undef ATT_LDK
        bf16x8 vb[8][8];
        const bf16_t* vbase = VT + (size_t)(Rg * 16 + h) * 8192 + p0 * 128 + fq * 128 + fr * 8;
#define ATT_LDV(kr) do { _Pragma("unroll") for (int dt = 0; dt < 8; ++dt) vb[kr][dt] = (ADBG & 2) ? qf[dt & 3] : (ADBG & 4) ? *(const bf16x8*)(VT + (size_t)(h * HD) * L + s0 + rs * GRIDW + ((kr) * 8 + dt) * 512 + F.lane * 8) : *(const bf16x8*)(vbase + (size_t)(kr) * (16 * 8192) + dt * 1024); } while (0)
        ATT_LDV(0); ATT_LDV(1);
        __builtin_amdgcn_sched_barrier(0);
        const int elo = cs - w0 - 8 * fq, dc0 = w0 + 8 * fq - c + 15;
        const LAS float* rph = rp + h * 465 + (rs - r + 7) * 31;
        float mx = -3.0e38f;
#pragma unroll
        for (int e = 0; e < 8; ++e) { const bool valid = (e >= elo) && (e < elo + 16); const int bi = valid ? dc0 + e : 0;
#pragma unroll
            for (int kr = 0; kr < 8; ++kr) { const float sv = valid ? sacc[kr][e >> 2][e & 3] * scale + rph[kr * 31 + bi] : -3.0e38f; sacc[kr][e >> 2][e & 3] = sv; mx = fmaxf(mx, sv); } }
        mx = fmaxf(mx, __shfl_xor(mx, 16)); mx = fmaxf(mx, __shfl_xor(mx, 32));
        float lsum = 0.f; bf16x8 pf[8];
#pragma unroll
        for (int kr = 0; kr < 8; ++kr) { float p[8];
#pragma unroll
            for (int e = 0; e < 8; ++e) { p[e] = __expf(sacc[kr][e >> 2][e & 3] - mx); lsum += p[e]; }
            u32x4 w; w.x = pk2(p[0], p[1]); w.y = pk2(p[2], p[3]); w.z = pk2(p[4], p[5]); w.w = pk2(p[6], p[7]);
            pf[kr] = __builtin_bit_cast(bf16x8, w); }
        lsum += __shfl_xor(lsum, 16); lsum += __shfl_xor(lsum, 32);
        f32x4 oacc[8];
#pragma unroll
        for (int dt = 0; dt < 8; ++dt) oacc[dt] = (f32x4){0.f, 0.f, 0.f, 0.f};
#pragma unroll
        for (int kr = 0; kr < 8; ++kr) {
            if (ATT_SYNC && (kr & 1) == 0) __builtin_amdgcn_s_barrier();
            if (kr + 2 < 8) ATT_LDV(kr + 2);
            __builtin_amdgcn_sched_barrier(0);
#pragma unroll
            for (int dt = 0; dt < 8; ++dt) oacc[dt] = __builtin_amdgcn_mfma_f32_16x16x32_bf16(vb[kr][dt], pf[kr], oacc[dt], 0, 0, 0);
            __builtin_amdgcn_sched_barrier(0);
        }
#undef ATT_LDV
        const float inv = 1.0f / lsum;
#ifdef ATTN_OUT_OFF
        bf16_t* orow = wsp<bf16_t>(F, (size_t)ATTN_OUT_OFF * MiB) + (size_t)(s0 + r * GRIDW + c) * NAW + h * HD;
#else
        bf16_t* orow = qrow;
#endif
#pragma unroll
        for (int u = 0; u < 4; ++u) *(u32x4*)(orow + 32 * u + 8 * fq) = pg8::pack8(oacc[2 * u] * inv, oacc[2 * u + 1] * inv);
    }
    __syncthreads();
}

__device__ __forceinline__ void attn_mfma_lds(Frame& F) {
    const int tid_ = opaque(F.tid);
    bf16_t* Q = wsp<bf16_t>(F, WS_Q); const bf16_t* Kb = wsp<bf16_t>(F, WS_K); const bf16_t* VT = wsp<bf16_t>(F, WS_VT);
    LAS float* rp = (LAS float*)F.lds;
    LAS unsigned char* ring = F.lds + 30720;
    for (int i = tid_; i < NH * 15 * 31; i += NTHR) rp[i] = F.in_RPB[i];
    __syncthreads();
    const int lane = tid_ & 63, fr = lane & 15, fq = lane >> 4, w = F.wave, hl = w >> 2, g = w & 3;
    const float scale = 0.08838834764831845f;
    constexpr int NIT = (L / GRIDW) * NH * 4;
    const int w0 = g == 0 ? 0 : (g == 1 ? 8 : (g == 2 ? 24 : 32)), p0 = w0 >> 3;
    const int c = 16 * g + fr;
    int cs = c - 8; cs = cs < 0 ? 0 : (cs > GRIDW - 16 ? GRIDW - 16 : cs);
#define ATL_SRC(b, st) ([&]() -> const bf16_t* { const int rg_ = (b) >> 6, hb_ = ((b) >> 2) & 15; const int rows_ = rg_ < LP / GRIDW ? LP / GRIDW : LS / GRIDW, r_ = rg_ < LP / GRIDW ? rg_ : rg_ - LP / GRIDW; \
        int rs_ = r_ - 4; rs_ = rs_ < 0 ? 0 : (rs_ > rows_ - 8 ? rows_ - 8 : rs_); const int Rg_ = (rg_ < LP / GRIDW ? 0 : LP / GRIDW) + rs_; \
        return ((st) < 8 ? Kb : VT) + (size_t)((Rg_ + ((st) & 7)) * 16 + hb_) * 8192; }())
#define ATL_ISSUE(src, slot) do { const bf16_t* s_ = (src) + tid_ * 8; LAS unsigned char* d_ = ring + (slot) * 32768 + w * 1024; _Pragma("unroll") for (int k_ = 0; k_ < 4; ++k_) \
        __builtin_amdgcn_global_load_lds((const unsigned*)(s_ + k_ * 4096), (LAS unsigned*)(d_ + k_ * 8192), 16, 0, 0); } while (0)
    int base = blockIdx.x * NWAVES;
    if (base < NIT) { ATL_ISSUE(ATL_SRC(base, 0), 0); ATL_ISSUE(ATL_SRC(base, 1), 1); }
    int b0 = 0;
    for (; base < NIT; base += F.ngw) {
        asm volatile("" ::: "memory");
        const int h = ((base >> 2) & 15) + hl, rg = base >> 6;
        const int s0 = rg < LP / GRIDW ? 0 : LP, rows = rg < LP / GRIDW ? LP / GRIDW : LS / GRIDW, r = rg < LP / GRIDW ? rg : rg - LP / GRIDW;
        int rs = r - 4; rs = rs < 0 ? 0 : (rs > rows - 8 ? rows - 8 : rs);
        const int nbase = base + F.ngw < NIT ? base + F.ngw : base;
        bf16_t* qrow = Q + (size_t)(s0 + r * GRIDW + c) * NAW + h * HD;
        bf16x8 qf[4];
#pragma unroll
        for (int s = 0; s < 4; ++s) qf[s] = *(const bf16x8*)(qrow + 8 * fq + 32 * s);
        f32x4 sacc[8][2]; f32x4 oacc[8]; bf16x8 pf[8]; float lsum = 0.f;
#pragma unroll
        for (int dt = 0; dt < 8; ++dt) oacc[dt] = (f32x4){0.f, 0.f, 0.f, 0.f};
        const int koff = hl * 16384 + (p0 * 128 + fr * 32 + fq * 8) * 2, voff = hl * 16384 + (p0 * 128 + fq * 128 + fr * 8) * 2;
#pragma unroll
        for (int st = 0; st < 16; ++st) {
            asm volatile("s_waitcnt vmcnt(4)" ::: "memory"); asm volatile("s_waitcnt lgkmcnt(0)" ::: "memory"); __builtin_amdgcn_s_barrier(); asm volatile("" ::: "memory");
            { const int slot2 = (b0 + st + 2) % 3; if (st + 2 < 16) ATL_ISSUE(ATL_SRC(base, st + 2), slot2); else ATL_ISSUE(ATL_SRC(nbase, st + 2 - 16), slot2); }
            const LAS unsigned char* buf = ring + ((b0 + st) % 3) * 32768;
            if (st < 8) {
#pragma unroll
                for (int T = 0; T < 2; ++T) { f32x4 a = (f32x4){0.f, 0.f, 0.f, 0.f};
#pragma unroll
                    for (int s2 = 0; s2 < 4; ++s2) a = __builtin_amdgcn_mfma_f32_16x16x32_bf16(*(const LAS bf16x8*)(buf + koff + (s2 * 2 + T) * 2048), qf[s2], a, 0, 0, 0);
                    sacc[st][T] = a; }
            } else {
                if (st == 8) {
                    const int elo = cs - w0 - 8 * fq, dc0 = w0 + 8 * fq - c + 15;
                    const LAS float* rph = rp + h * 465 + (rs - r + 7) * 31;
                    float mx = -3.0e38f;
#pragma unroll
                    for (int e = 0; e < 8; ++e) { const bool valid = (e >= elo) && (e < elo + 16); const int bi = valid ? dc0 + e : 0;
#pragma unroll
                        for (int kr = 0; kr < 8; ++kr) { const float sv = valid ? sacc[kr][e >> 2][e & 3] * scale + rph[kr * 31 + bi] : -3.0e38f; sacc[kr][e >> 2][e & 3] = sv; mx = fmaxf(mx, sv); } }
                    mx = fmaxf(mx, __shfl_xor(mx, 16)); mx = fmaxf(mx, __shfl_xor(mx, 32));
#pragma unroll
                    for (int kr = 0; kr < 8; ++kr) { float p[8];
#pragma unroll
                        for (int e = 0; e < 8; ++e) { p[e] = __expf(sacc[kr][e >> 2][e & 3] - mx); lsum += p[e]; }
                        u32x4 wv; wv.x = pk2(p[0], p[1]); wv.y = pk2(p[2], p[3]); wv.z = pk2(p[4], p[5]); wv.w = pk2(p[6], p[7]);
                        pf[kr] = __builtin_bit_cast(bf16x8, wv); }
                    lsum += __shfl_xor(lsum, 16); lsum += __shfl_xor(lsum, 32);
                }
#pragma unroll
                for (int dt = 0; dt < 8; ++dt) oacc[dt] = __builtin_amdgcn_mfma_f32_16x16x32_bf16(*(const LAS bf16x8*)(buf + voff + dt * 2048), pf[st - 8], oacc[dt], 0, 0, 0);
            }
        }
        b0 = (b0 + 16) % 3;
        const float inv = 1.0f / lsum;
#pragma unroll
        for (int u = 0; u < 4; ++u) *(u32x4*)(qrow + 32 * u + 8 * fq) = pg8::pack8(oacc[2 * u] * inv, oacc[2 * u + 1] * inv);
    }
#undef ATL_SRC
#undef ATL_ISSUE
    asm volatile("s_waitcnt vmcnt(0)" ::: "memory");
    __syncthreads();
}

__device__ __forceinline__ void conv_phase(Frame& F) {
    const int tid_ = opaque(F.tid);
    const bf16_t* XR = wsp<bf16_t>(F, WS_XR); bf16_t* XC = wsp<bf16_t>(F, WS_XC);
    const float* wc = F.in_WCONV; const float* bc = F.in_BCONV;
    const int nth = F.G * NTHR;
    for (int it = blockIdx.x * NTHR + tid_; it < L * (LW / 8); it += nth) {
        const int t = it / (LW / 8), c0 = (it % (LW / 8)) * 8;
        const int s0 = t < LP ? 0 : LP, len = t < LP ? LP : LS, tl = t - s0;
        float acc[8];
#pragma unroll
        for (int e = 0; e < 8; ++e) acc[e] = bc[c0 + e];
#pragma unroll
        for (int j = 0; j < 4; ++j) { const int tt = tl + j - 2; if (tt < 0 || tt >= len) continue;
            f32x4 x0, x1; pg8::unpack8(*(const u32x4*)(XR + (size_t)(s0 + tt) * LW + c0), x0, x1);
            const f32x4 w0 = *(const f32x4*)(wc + j * LW + c0), w1 = *(const f32x4*)(wc + j * LW + c0 + 4);
#pragma unroll
            for (int e = 0; e < 4; ++e) { acc[e] += w0[e] * x0[e]; acc[4 + e] += w1[e] * x1[e]; } }
        *(u32x4*)(XC + (size_t)t * LW + c0) = pg8::pack8((f32x4){acc[0], acc[1], acc[2], acc[3]}, (f32x4){acc[4], acc[5], acc[6], acc[7]});
    }
}

struct LruW { bf16x8 w[2][4]; float br, bi, cl; };
template <int DIR> __device__ __forceinline__ void lru_load_w(const Frame& F, LruW& W, int n, int w, int fr, int fq) {
    const bf16_t* wg = wsp<bf16_t>(F, WS_WG);
#pragma unroll
    for (int g = 0; g < 2; ++g)
#pragma unroll
        for (int s = 0; s < 4; ++s) W.w[g][s] = *(const bf16x8*)(wg + ((size_t)((DIR * 2 + g) * NBLK + n) * BW + 16 * w + fr) * BW + 32 * fq + 8 * s);
    const int ch = n * BW + 16 * w + fr;
    W.br = F.in_BR[DIR * LW + ch]; W.bi = F.in_BI[DIR * LW + ch];
    const float lam = F.in_LAM[DIR * LW + ch];
    W.cl = -8.0f * ((lam > 15.f) ? __expf(-lam) : log1pf(__expf(-lam)));
}
template <int LDBG = 0> __device__ __forceinline__ void lru_gate(float pr, float pi, float xc, const LruW& W, bool first, float& a, float& u) {
    if constexpr (LDBG == 1) { a = pr + W.br; u = pi * xc + W.bi; return; }
    const float r = sigmoidf_(pr + W.br), ig = sigmoidf_(pi + W.bi);
    a = __expf(W.cl * r);
    const float mult = first ? 1.0f : __builtin_amdgcn_sqrtf(fmaxf(1.0f - a * a, 0.f));
    u = mult * ig * xc;
}
struct LruX { bf16x8 x[4][4]; };
__device__ __forceinline__ void lru_load_x(LruX& X, const bf16_t* XC, int tb, int n, int fr, int fq) {
#pragma unroll
    for (int tau = 0; tau < 4; ++tau) { const bf16_t* xp = XC + ((size_t)((((tb >> 6) * NBLK + n) * 4 + tau) * 4) * 64 + fr * 4 + fq) * 8;
#pragma unroll
        for (int s = 0; s < 4; ++s) X.x[tau][s] = *(const bf16x8*)(xp + s * 512); }
}
__device__ __forceinline__ void lru_tile(const LruX& X, int tau, bool hiw, const LruW& W, const bf16x8 idf0, const bf16x8 idf1, f32x4& pr, f32x4& pi, f32x4& xct) {
    pr = (f32x4){0.f, 0.f, 0.f, 0.f}; pi = pr;
#pragma unroll
    for (int s = 0; s < 4; ++s) { pr = __builtin_amdgcn_mfma_f32_16x16x32_bf16(X.x[tau][s], W.w[0][s], pr, 0, 0, 0); pi = __builtin_amdgcn_mfma_f32_16x16x32_bf16(X.x[tau][s], W.w[1][s], pi, 0, 0, 0); }
    const bf16x8 x0 = hiw ? X.x[tau][2] : X.x[tau][0], x1 = hiw ? X.x[tau][3] : X.x[tau][1];
    xct = __builtin_amdgcn_mfma_f32_16x16x32_bf16(x0, idf0, (f32x4){0.f, 0.f, 0.f, 0.f}, 0, 0, 0);
    xct = __builtin_amdgcn_mfma_f32_16x16x32_bf16(x1, idf1, xct, 0, 0, 0);
}
__device__ __forceinline__ void lru_idfrags(int w, int fr, int fq, bf16x8& idf0, bf16x8& idf1) {
#pragma unroll
    for (int e = 0; e < 8; ++e) { const bool on = (fq == (w >> 1)) && ((fr & 7) == e); idf0[e] = (on && fr < 8) ? (short)0x3F80 : (short)0; idf1[e] = (on && fr >= 8) ? (short)0x3F80 : (short)0; }
}
constexpr int LRU_CH = 256, LRU_NCH = L / LRU_CH, LRU_NCH_P = LP / LRU_CH;
__device__ __forceinline__ void conv_unit(Frame& F, int cg, int n) {
    const int tid_ = opaque(F.tid);
    const bf16_t* XR = wsp<bf16_t>(F, WS_XR); bf16_t* XC = wsp<bf16_t>(F, WS_XC);
    const float* wc = F.in_WCONV; const float* bc = F.in_BCONV;
    const int c0 = n * BW + (tid_ & 15) * 8;
    const int s0 = cg < LRU_NCH_P ? 0 : LP, len = cg < LRU_NCH_P ? LP : LS;
    f32x4 w[4][2]; f32x4 b0 = *(const f32x4*)(bc + c0), b1 = *(const f32x4*)(bc + c0 + 4);
#pragma unroll
    for (int j = 0; j < 4; ++j) { w[j][0] = *(const f32x4*)(wc + j * LW + c0); w[j][1] = *(const f32x4*)(wc + j * LW + c0 + 4); }
#pragma unroll
    for (int i = 0; i < 8; ++i) {
        const int t = cg * LRU_CH + (tid_ >> 4) + 32 * i, tl = t - s0;
        f32x4 a0 = b0, a1 = b1;
#pragma unroll
        for (int j = 0; j < 4; ++j) { const int tt = tl + j - 2; if (tt < 0 || tt >= len) continue;
            f32x4 x0, x1; pg8::unpack8(*(const u32x4*)(XR + (size_t)(s0 + tt) * LW + c0), x0, x1); a0 += w[j][0] * x0; a1 += w[j][1] * x1; }
        const int tg = t & 63, cq = tid_ & 15;
        *(u32x4*)(XC + ((size_t)(((((t >> 6) * NBLK + n) * 4 + ((tg >> 2) & 3)) * 4 + (cq & 3)) * 16 + 4 * (tg >> 4) + (tg & 3)) * 4 + (cq >> 2)) * 8) = pg8::pack8(a0, a1);
    }
}
__device__ __forceinline__ void lru_pass_a(Frame& F) {
    const int fr = F.lane & 15, fq = F.lane >> 4, w = F.wave;
    const bf16_t* XC = wsp<bf16_t>(F, WS_XC); f32x2* SUMM = wsp<f32x2>(F, WS_SUM);
    bf16x8 idf0, idf1; lru_idfrags(w, fr, fq, idf0, idf1);
    for (int u = blockIdx.x; u < LRU_NCH * NBLK; u += F.G) {
        const int cg = u >> 4, n = u & 15;
        conv_unit(F, cg, n); VM_WAIT(); __syncthreads();
        LruW Wf, Wb; lru_load_w<0>(F, Wf, n, w, fr, fq); lru_load_w<1>(F, Wb, n, w, fr, fq);
        const bool c_first = (cg == 0 || cg == LRU_NCH_P), c_last = (cg == LRU_NCH_P - 1 || cg == LRU_NCH - 1);
        float Af = 1.f, Hf = 0.f, Ab = 1.f, Hb = 0.f;
        LruX X, Xn; lru_load_x(X, XC, cg * LRU_CH, n, fr, fq);
        for (int gi = 0; gi < 4; ++gi) {
            if (gi < 3) lru_load_x(Xn, XC, cg * LRU_CH + (gi + 1) * 64, n, fr, fq);
            float pf = 1.f, hf = 0.f, pb = 1.f, hb = 0.f;
#pragma unroll
            for (int tau = 0; tau < 4; ++tau) {
                f32x4 prf, pif, prb, pib, xct, xct2;
                lru_tile(X, tau, (w & 1) != 0, Wf, idf0, idf1, prf, pif, xct);
                lru_tile(X, tau, (w & 1) != 0, Wb, idf0, idf1, prb, pib, xct2);
#pragma unroll
                for (int j = 0; j < 4; ++j) {
                    float a, uu;
                    lru_gate(prf[j], pif[j], xct[j], Wf, c_first && gi == 0 && fq == 0 && tau == 0 && j == 0, a, uu); hf = a * hf + uu; pf *= a;
                    lru_gate(prb[j], pib[j], xct[j], Wb, c_last && gi == 3 && fq == 3 && tau == 3 && j == 3, a, uu); hb += pb * uu; pb *= a;
                }
            }
            float gPf = 1.f, gHf = 0.f, gPb = 1.f, gHb = 0.f;
#pragma unroll
            for (int qq = 0; qq < 4; ++qq) { const int src = fr + 16 * qq;
                float P = __shfl(pf, src), H = __shfl(hf, src); gHf = P * gHf + H; gPf *= P;
                P = __shfl(pb, src); H = __shfl(hb, src); gHb += gPb * H; gPb *= P; }
            Hf = gPf * Hf + gHf; Af *= gPf; Hb += Ab * gHb; Ab *= gPb;
            X = Xn;
        }
        if (fq == 0) { const int ch = n * BW + 16 * w + fr; SUMM[(size_t)(cg * 2 + 0) * LW + ch] = (f32x2){Af, Hf}; SUMM[(size_t)(cg * 2 + 1) * LW + ch] = (f32x2){Ab, Hb}; }
    }
}
__device__ __forceinline__ void lru_pass_b(Frame& F) {
    const int tid_ = opaque(F.tid);
    const int gt = blockIdx.x * NTHR + tid_; if (gt >= 4 * LW) return;
    const int ch = gt % LW, d = (gt / LW) & 1, seq = gt / (2 * LW), c0 = seq ? LRU_NCH_P : 0, nc = seq ? LRU_NCH - LRU_NCH_P : LRU_NCH_P;
    const f32x2* SUMM = wsp<f32x2>(F, WS_SUM); float* CIN = wsp<float>(F, WS_SUM + 4 * MiB);
    float s = 0.f;
    for (int i0 = 0; i0 < nc; i0 += 8) {
        f32x2 ah[8];
#pragma unroll
        for (int e = 0; e < 8; ++e) { const int cg = d ? c0 + nc - 1 - (i0 + e) : c0 + i0 + e; ah[e] = SUMM[(size_t)(cg * 2 + d) * LW + ch]; }
#pragma unroll
        for (int e = 0; e < 8; ++e) { const int cg = d ? c0 + nc - 1 - (i0 + e) : c0 + i0 + e; CIN[(size_t)(cg * 2 + d) * LW + ch] = s; s = ah[e].x * s + ah[e].y; }
    }
}
template <int LDBG = 0> __device__ __forceinline__ void lru_pass_c(Frame& F) {
    const int tid_ = opaque(F.tid);
    const int fr = F.lane & 15, fq = F.lane >> 4, w = F.wave;
    const bf16_t* XC = wsp<bf16_t>(F, WS_XC); const float* CIN = wsp<float>(F, WS_SUM + 4 * MiB);
    const bf16_t* GR = wsp<bf16_t>(F, WS_GR); bf16_t* LRU = wsp<bf16_t>(F, WS_XR);
    LAS bf16_t* hfb = (LAS bf16_t*)(F.lds + w * 8192);
    LAS bf16_t* grt = (LAS bf16_t*)(F.lds + 65536);
    bf16x8 idf0, idf1; lru_idfrags(w, fr, fq, idf0, idf1);
    for (int u = blockIdx.x; u < LRU_NCH * NBLK; u += F.G) {
        const int cg = u >> 4, n = u & 15, ch = n * BW + 16 * w + fr;
        const bool c_first = (cg == 0 || cg == LRU_NCH_P), c_last = (cg == LRU_NCH_P - 1 || cg == LRU_NCH - 1);
        { const bf16_t* gsrc = GR + (size_t)(cg * LRU_CH + (tid_ >> 4)) * LW + n * BW + (tid_ & 15) * 8; LAS bf16_t* ldst = grt + w * 512;
#pragma unroll 1
          for (int k = 0; k < 8; ++k) { __builtin_amdgcn_global_load_lds((const unsigned*)gsrc, (LAS unsigned*)ldst, 16, 0, 0); gsrc += (size_t)32 * LW; ldst += NTHR * 8; } }
        {
            LruW W; lru_load_w<0>(F, W, n, w, fr, fq);
            float s = CIN[(size_t)(cg * 2 + 0) * LW + ch];
            LruX X, Xn; lru_load_x(X, XC, cg * LRU_CH, n, fr, fq);
            for (int gi = 0; gi < 4; ++gi) {
                if (gi < 3 && LDBG != 2) lru_load_x(Xn, XC, cg * LRU_CH + (gi + 1) * 64, n, fr, fq);
                float a[16], uu[16];
#pragma unroll
                for (int tau = 0; tau < 4; ++tau) { f32x4 pr, pi, xct; lru_tile(X, tau, (w & 1) != 0, W, idf0, idf1, pr, pi, xct);
#pragma unroll
                    for (int j = 0; j < 4; ++j) lru_gate<LDBG>(pr[j], pi[j], xct[j], W, c_first && gi == 0 && fq == 0 && tau == 0 && j == 0, a[4 * tau + j], uu[4 * tau + j]); }
                float p = 1.f, h = 0.f;
#pragma unroll
                for (int t = 0; t < 16; ++t) { h = a[t] * h + uu[t]; p *= a[t]; }
                float hin = s, sg = s;
#pragma unroll
                for (int qq = 0; qq < 4; ++qq) { const float P = __shfl(p, fr + 16 * qq), H = __shfl(h, fr + 16 * qq); sg = P * sg + H; if (qq < fq) hin = P * hin + H; }
                s = sg;
                float hh = hin;
#pragma unroll
                for (int t = 0; t < 16; ++t) { hh = a[t] * hh + uu[t]; hfb[(gi * 64 + 16 * fq + t) * 16 + fr] = (bf16_t)f2bf(hh); }
                X = Xn;
            }
        }
        VM_WAIT(); __syncthreads();
        {
            LruW W; lru_load_w<1>(F, W, n, w, fr, fq);
            float s = CIN[(size_t)(cg * 2 + 1) * LW + ch];
            LruX X, Xn; lru_load_x(X, XC, cg * LRU_CH + 3 * 64, n, fr, fq);
            for (int gi = 3; gi >= 0; --gi) {
                if (gi > 0 && LDBG != 2) lru_load_x(Xn, XC, cg * LRU_CH + (gi - 1) * 64, n, fr, fq);
                float a[16], uu[16];
#pragma unroll
                for (int tau = 0; tau < 4; ++tau) { f32x4 pr, pi, xct; lru_tile(X, tau, (w & 1) != 0, W, idf0, idf1, pr, pi, xct);
#pragma unroll
                    for (int j = 0; j < 4; ++j) lru_gate<LDBG>(pr[j], pi[j], xct[j], W, c_last && gi == 3 && fq == 3 && tau == 3 && j == 3, a[4 * tau + j], uu[4 * tau + j]); }
                float p = 1.f, h = 0.f;
#pragma unroll
                for (int t = 15; t >= 0; --t) { h = a[t] * h + uu[t]; p *= a[t]; }
                float hin = s, sg = s;
#pragma unroll
                for (int qq = 3; qq >= 0; --qq) { const float P = __shfl(p, fr + 16 * qq), H = __shfl(h, fr + 16 * qq); sg = P * sg + H; if (qq > fq) hin = P * hin + H; }
                s = sg;
                float hh = hin;
#pragma unroll
                for (int t = 15; t >= 0; --t) { hh = a[t] * hh + uu[t];
                    const int tl = gi * 64 + 16 * fq + t; LAS bf16_t* gp = grt + tl * BW + 16 * w + fr;
                    *gp = (bf16_t)f2bf((bf1(hfb[tl * 16 + fr]) + hh) * gelu_tanh(bf1(*gp))); }
                X = Xn;
            }
        }
        LDS_WAIT(); __syncthreads();
        { bf16_t* gdst = LRU + (size_t)(cg * LRU_CH + (tid_ >> 4)) * LW + n * BW + (tid_ & 15) * 8; const LAS bf16_t* lsrc = grt + tid_ * 8;
#pragma unroll 1
          for (int k = 0; k < 8; ++k) { *(u32x4*)gdst = *(const LAS u32x4*)lsrc; gdst += (size_t)32 * LW; lsrc += NTHR * 8; } }
        LDS_WAIT(); __syncthreads();
    }
}

__device__ __forceinline__ void hq_phase(Frame& F) {
    const int lane = opaque(F.tid) & 63;
    const bf16_t* H0 = (const bf16_t*)F.out; const bf16_t* H1 = wsp<bf16_t>(F, WS_HIDS);
    signed char* Q0 = wsp<signed char>(F, WS_H8P); signed char* Q1 = wsp<signed char>(F, WS_H8S); float* RS3 = wsp<float>(F, WS_RS3);
    {
        LAS float* scr = (LAS float*)(F.lds + F.wave * 8448);
        for (int it = F.gw; it < (DFF / 64) * (D / 32); it += F.ngw)
            had_tile_quant(F.in_WFD, D, DFF, 64 * (it / (D / 32)), 32 * (it % (D / 32)), wsp<signed char>(F, WS_WD), (const unsigned*)(F.ws + WS_AM), wsp<float>(F, WS_CS) + CS_D, scr, lane);
    }
    constexpr int NB = DFF / 32;
    for (int m = F.gw; m < L; m += F.ngw) {
        const bf16_t* src = m < LP ? H0 + (size_t)m * DFF : H1 + (size_t)(m - LP) * DFF;
        signed char* dst = m < LP ? Q0 + (size_t)m * DFF : Q1 + (size_t)(m - LP) * DFF;
        float mx = 0.f;
#pragma unroll 1
        for (int b = lane; b < NB; b += 64) {
            const u32x4* p = (const u32x4*)(src + b * 32); float v[32];
#pragma unroll
            for (int i = 0; i < 4; ++i) { const u32x4 u = p[i]; v[8 * i + 0] = bflo(u.x); v[8 * i + 1] = bfhi(u.x); v[8 * i + 2] = bflo(u.y); v[8 * i + 3] = bfhi(u.y); v[8 * i + 4] = bflo(u.z); v[8 * i + 5] = bfhi(u.z); v[8 * i + 6] = bflo(u.w); v[8 * i + 7] = bfhi(u.w); }
            fwht32(v);
#pragma unroll
            for (int i = 0; i < 32; ++i) mx = fmaxf(mx, fabsf(v[i]));
        }
        const float amax = fmaxf(wave_max(mx), 1e-20f), inv = 127.0f / amax;
        if (lane == 0) RS3[m] = amax * (1.0f / 127.0f);
#pragma unroll 1
        for (int b = lane; b < NB; b += 64) {
            const u32x4* p = (const u32x4*)(src + b * 32); float v[32];
#pragma unroll
            for (int i = 0; i < 4; ++i) { const u32x4 u = p[i]; v[8 * i + 0] = bflo(u.x); v[8 * i + 1] = bfhi(u.x); v[8 * i + 2] = bflo(u.y); v[8 * i + 3] = bfhi(u.y); v[8 * i + 4] = bflo(u.z); v[8 * i + 5] = bfhi(u.z); v[8 * i + 6] = bflo(u.w); v[8 * i + 7] = bfhi(u.w); }
            fwht32(v);
            u32x4 o0, o1;
            o0.x = pk4_i8(rintf(v[0] * inv), rintf(v[1] * inv), rintf(v[2] * inv), rintf(v[3] * inv)); o0.y = pk4_i8(rintf(v[4] * inv), rintf(v[5] * inv), rintf(v[6] * inv), rintf(v[7] * inv));
            o0.z = pk4_i8(rintf(v[8] * inv), rintf(v[9] * inv), rintf(v[10] * inv), rintf(v[11] * inv)); o0.w = pk4_i8(rintf(v[12] * inv), rintf(v[13] * inv), rintf(v[14] * inv), rintf(v[15] * inv));
            o1.x = pk4_i8(rintf(v[16] * inv), rintf(v[17] * inv), rintf(v[18] * inv), rintf(v[19] * inv)); o1.y = pk4_i8(rintf(v[20] * inv), rintf(v[21] * inv), rintf(v[22] * inv), rintf(v[23] * inv));
            o1.z = pk4_i8(rintf(v[24] * inv), rintf(v[25] * inv), rintf(v[26] * inv), rintf(v[27] * inv)); o1.w = pk4_i8(rintf(v[28] * inv), rintf(v[29] * inv), rintf(v[30] * inv), rintf(v[31] * inv));
            *(u32x4*)(dst + b * 32) = o0; *(u32x4*)(dst + b * 32 + 16) = o1;
        }
    }
}

__device__ __forceinline__ f32x4 up4(const u32x2 u) { return (f32x4){bflo(u.x), bfhi(u.x), bflo(u.y), bfhi(u.y)}; }
__device__ __forceinline__ void mid_phase(Frame& F) {
    const int tid_ = opaque(F.tid);
    const bf16_t* MIX = wsp<bf16_t>(F, WS_MIX); signed char* XN8 = wsp<signed char>(F, WS_XN8); float* RSTD = wsp<float>(F, WS_RSTD); float* RS2 = wsp<float>(F, WS_RS2);
    LAS f32x4* gpost = (LAS f32x4*)F.lds; LAS f32x4* gpre = gpost + D / 4;
    for (int i = tid_; i < D / 4; i += NTHR) { gpost[i] = ((const f32x4*)F.in_GMPOST)[i]; gpre[i] = ((const f32x4*)F.in_GFPRE)[i]; }
    __syncthreads();
    for (int m = F.gw; m < L; m += F.ngw) {
        asm volatile("" ::: "memory");
        const f32x4* xr = (const f32x4*)xrow(F, m) + F.lane; const u32x2* mr = (const u32x2*)(MIX + (size_t)m * D) + F.lane;
        f32x4 v[16]; u32x2 mx[16]; float s = 0.f;
#pragma unroll
        for (int j = 0; j < 16; ++j) { v[j] = xr[64 * j]; mx[j] = mr[64 * j]; const f32x4 a = up4(mx[j]); s += (a.x * a.x + a.y * a.y) + (a.z * a.z + a.w * a.w); }
        const float rstd1 = 1.0f / sqrtf(wave_sum(s) * (1.0f / D) + EPS);
        if (F.lane == 0) RSTD[m] = rstd1;
        float s2 = 0.f;
#pragma unroll
        for (int j = 0; j < 16; ++j) { v[j] = v[j] + up4(mx[j]) * rstd1 * gpost[F.lane + 64 * j]; s2 += (v[j].x * v[j].x + v[j].y * v[j].y) + (v[j].z * v[j].z + v[j].w * v[j].w); }
        const float rstd2 = 1.0f / sqrtf(wave_sum(s2) * (1.0f / D) + EPS);
        float mx2 = 0.f;
#pragma unroll
        for (int j = 0; j < 16; ++j) { v[j] = v[j] * rstd2 * gpre[F.lane + 64 * j]; mx2 = fmaxf(fmaxf(mx2, fmaxf(fabsf(v[j].x), fabsf(v[j].y))), fmaxf(fabsf(v[j].z), fabsf(v[j].w))); }
        const float amax = fmaxf(wave_max(mx2), 1e-20f), inv = 127.0f / amax;
        if (F.lane == 0) RS2[m] = amax * (1.0f / 127.0f);
        unsigned* o4 = (unsigned*)(XN8 + (size_t)m * D) + F.lane;
#pragma unroll
        for (int j = 0; j < 16; ++j) o4[64 * j] = pk4_i8(rintf(v[j].x * inv), rintf(v[j].y * inv), rintf(v[j].z * inv), rintf(v[j].w * inv));
    }
    __syncthreads();
}
__device__ __forceinline__ void final_phase(Frame& F) {
    const int tid_ = opaque(F.tid);
    const bf16_t* MIX = wsp<bf16_t>(F, WS_MIX); const bf16_t* FB = wsp<bf16_t>(F, WS_F); const float* RSTD = wsp<float>(F, WS_RSTD);
    LAS f32x4* gpost = (LAS f32x4*)F.lds; LAS f32x4* gfp = gpost + D / 4;
    for (int i = tid_; i < D / 4; i += NTHR) { gpost[i] = ((const f32x4*)F.in_GMPOST)[i]; gfp[i] = ((const f32x4*)F.in_GFPOST)[i]; }
    __syncthreads();
    for (int m = F.gw; m < L; m += F.ngw) {
        asm volatile("" ::: "memory");
        const f32x4* xr = (const f32x4*)xrow(F, m) + F.lane; const u32x2* mr = (const u32x2*)(MIX + (size_t)m * D) + F.lane; const u32x2* fr = (const u32x2*)(FB + (size_t)m * D) + F.lane;
        const float rstd1 = RSTD[m];
        u32x2 fx[16]; float s = 0.f;
#pragma unroll
        for (int j = 0; j < 16; ++j) { fx[j] = fr[64 * j]; const f32x4 a = up4(fx[j]); s += (a.x * a.x + a.y * a.y) + (a.z * a.z + a.w * a.w); }
        const float rstd3 = 1.0f / sqrtf(wave_sum(s) * (1.0f / D) + EPS);
        f32x4* o = (f32x4*)(F.out + (size_t)m * D) + F.lane;
#pragma unroll
        for (int j = 0; j < 16; ++j) o[64 * j] = xr[64 * j] + up4(mr[64 * j]) * rstd1 * gpost[F.lane + 64 * j] + up4(fx[j]) * rstd3 * gfp[F.lane + 64 * j];
    }
}

constexpr int LDS_STAGE = pg8::STAGE_BYTES;
constexpr int LDS_MISC = LDS_STAGE;
constexpr int LDS_BYTES = LDS_STAGE + 1024;
#ifndef MK_N_LAUNCHES
#define MK_N_LAUNCHES 1
#endif
constexpr int NPHASE = 12;
struct Args { const float* in[23]; float* out; unsigned char* ws; int ph_lo, ph_hi; };

__global__ void __launch_bounds__(NTHR, 2) fwd_kernel(Args args) {
    extern __shared__ __attribute__((aligned(16))) unsigned char lds_raw[];
    Frame F;
    F.lds = (LAS unsigned char*)lds_raw;
    F.tid = threadIdx.x; F.lane = (int)__builtin_amdgcn_mbcnt_hi(~0u, __builtin_amdgcn_mbcnt_lo(~0u, 0u)); F.wave = __builtin_amdgcn_readfirstlane(F.tid >> 6);
    F.G = gridDim.x; F.gw = blockIdx.x * NWAVES + F.wave; F.ngw = F.G * NWAVES;
    F.in_XP = args.in[0]; F.in_XS = args.in[1]; F.in_WIN = args.in[2]; F.in_WCONV = args.in[3]; F.in_BCONV = args.in[4]; F.in_WR = args.in[5]; F.in_BR = args.in[6]; F.in_WI = args.in[7]; F.in_BI = args.in[8]; F.in_LAM = args.in[9]; F.in_RPB = args.in[10]; F.in_WNO = args.in[11]; F.in_WLO = args.in[12]; F.in_WM = args.in[13]; F.in_BM = args.in[14]; F.in_WOUT = args.in[15]; F.in_GMPRE = args.in[16]; F.in_GMPOST = args.in[17]; F.in_GFPRE = args.in[18]; F.in_GFPOST = args.in[19]; F.in_WFG = args.in[20]; F.in_WFU = args.in[21]; F.in_WFD = args.in[22];
    F.out = args.out; F.ws = args.ws;
    volatile LAS unsigned* MISC = (volatile LAS unsigned*)(F.lds + LDS_MISC);
    if (F.tid < 256) MISC[F.tid] = 0u;
    __syncthreads();
    const int lo = args.ph_lo, hi = args.ph_hi;
    const bool fused = (hi - lo) > 1;
    XcdBarrier bar; bar.bar = (unsigned*)(F.ws + WS_CTL); bar.x = 0; bar.st = nullptr;
    if (fused) bar = xcd_barrier_post((unsigned*)(F.ws + WS_CTL), MISC + 8);
#ifndef PH_MASK
#define PH_MASK 0xfff
#endif
#define IN(k) (((PH_MASK >> (k)) & 1) && lo <= (k) && (k) < hi)
#define SEAM(k) do { if (IN(k) && IN((k) + 1)) xcd_barrier(bar); } while (0)
    LAS unsigned char* stage = F.lds;

#ifdef ATTN_OUT_OFF
#define NA_BUF ((size_t)ATTN_OUT_OFF * MiB)
#else
#define NA_BUF WS_Q
#endif
#ifndef DUP_MASK
#define DUP_MASK 0
#endif
#define RUN(k, ...) if (IN(k)) { __VA_ARGS__ if (((DUP_MASK) >> (k)) & 1) { __VA_ARGS__ } }
    RUN(0, { p0_prologue(F); }) SEAM(0);
    RUN(1, {
        { pg8::Gemm g{wsp<bf16_t>(F, WS_XN8), wsp<bf16_t>(F, WS_XN8), 1 << 30, wsp<bf16_t>(F, WS_W8), L, 2 * NAW + 2 * D, D}; pg8::StaticOrder S; S.init(L, 2 * NAW + 2 * D, F.G, (int)blockIdx.x);
          pg8::EpiProjQ E{wsp<bf16_t>(F, WS_Q), wsp<bf16_t>(F, WS_K), (bf16_t*)F.out, F.in_BM, wsp<float>(F, WS_RS1), wsp<float>(F, WS_CS) + CS_QKM};
          pg8::gemm_phase<pg8::EpiProjQ, pg8::StaticOrder, true, true, 2>(stage, g, S, E); }
        { pg8::Gemm g{wsp<bf16_t>(F, WS_XN), wsp<bf16_t>(F, WS_XN), 1 << 30, wsp<bf16_t>(F, WS_WCAT), L, 2 * NAW, 2 * D}; pg8::StaticOrder S; S.init(L, 2 * NAW, F.G, (int)blockIdx.x);
          pg8::EpiProj E{wsp<bf16_t>(F, WS_XR), wsp<bf16_t>(F, WS_GR), wsp<bf16_t>(F, WS_GR), wsp<bf16_t>(F, WS_GR), (bf16_t*)F.out, F.in_BM, 1 << 30};
          pg8::gemm_phase<pg8::EpiProj, pg8::StaticOrder, true, true, 0>(stage, g, S, E); }
        { pg8::Gemm g{wsp<bf16_t>(F, WS_WVT), wsp<bf16_t>(F, WS_WVT), 1 << 30, wsp<bf16_t>(F, WS_XN8), NAW, L, D}; pg8::StaticOrder S; S.init(NAW, L, F.G, (int)blockIdx.x);
          pg8::EpiVTQ E{wsp<bf16_t>(F, WS_VT), wsp<float>(F, WS_CS) + CS_V, wsp<float>(F, WS_RS1)};
          pg8::gemm_phase<pg8::EpiVTQ, pg8::StaticOrder, true, true, 2>(stage, g, S, E); }
    }) SEAM(1);
    RUN(2, { lru_pass_a(F); }) SEAM(2);
    #ifdef ATTN_OUT_OFF
    if (IN(3)) { lru_pass_b(F); } SEAM(3);
    if (IN(4)) { lru_pass_c<0>(F); xcd_barrier(bar); if (ATTN_DUP) attn_mfma<ATTN_DUP - 1>(F); attn_mfma<0>(F); } SEAM(4);
#else
    if (IN(3)) { lru_pass_b(F); attn_mfma_lds(F); } SEAM(3);
#ifdef LRUC_DBG
    if (IN(4)) { lru_pass_c<LRUC_DBG>(F); lru_pass_c<0>(F); } SEAM(4);
#else
    RUN(4, { lru_pass_c<0>(F); }) SEAM(4);
#endif
#endif
    if (IN(5)) {
        { pg8::Gemm g{wsp<bf16_t>(F, NA_BUF), wsp<bf16_t>(F, NA_BUF), 1 << 30, wsp<bf16_t>(F, WS_WNO), L, D, 2 * NAW}; pg8::StaticOrder S; S.init(L, D, F.G, (int)blockIdx.x);
          pg8::EpiMulG<false> E{wsp<bf16_t>(F, WS_T1), (const bf16_t*)F.out, 0};
          pg8::gemm_phase<pg8::EpiMulG<false>, pg8::StaticOrder, true, true>(stage, g, S, E); }
        { pg8::Gemm g{wsp<bf16_t>(F, WS_XR), wsp<bf16_t>(F, WS_XR), 1 << 30, wsp<bf16_t>(F, WS_WLO), L, D, 2 * LW}; pg8::StaticOrder S; S.init(L, D, F.G, (int)blockIdx.x);
          pg8::EpiMulG<true> E{wsp<bf16_t>(F, WS_T1), (const bf16_t*)F.out, D};
          pg8::gemm_phase<pg8::EpiMulG<true>, pg8::StaticOrder, true, true>(stage, g, S, E); }
    } SEAM(5);
    RUN(6, {
        pg8::Gemm g{wsp<bf16_t>(F, WS_T1), wsp<bf16_t>(F, WS_T1), 1 << 30, wsp<bf16_t>(F, WS_WO), L, D, 2 * D}; pg8::StaticOrder S; S.init(L, D, F.G, (int)blockIdx.x);
        pg8::EpiPlain E{wsp<bf16_t>(F, WS_MIX), D};
        pg8::gemm_phase<pg8::EpiPlain, pg8::StaticOrder, true, true>(stage, g, S, E);
    }) SEAM(6);
    RUN(7, { mid_phase(F); }) SEAM(7);
    RUN(8, {
        pg8::Gemm g{wsp<bf16_t>(F, WS_XN8), wsp<bf16_t>(F, WS_XN8), 1 << 30, wsp<bf16_t>(F, WS_WGU), L, 2 * DFF, D}; pg8::StaticOrder S; S.init(L, 2 * DFF, F.G, (int)blockIdx.x);
        pg8::EpiSwigluQ E{(bf16_t*)F.out, wsp<bf16_t>(F, WS_HIDS), LP / 256, wsp<float>(F, WS_RS2), wsp<float>(F, WS_CS) + CS_GU};
        pg8::gemm_phase<pg8::EpiSwigluQ, pg8::StaticOrder, false, true, 2>(stage, g, S, E);
    }) SEAM(8);
    RUN(9, { hq_phase(F); }) SEAM(9);
    RUN(10, {
        pg8::Gemm g{wsp<bf16_t>(F, WS_H8P), wsp<bf16_t>(F, WS_H8S), LP / 256, wsp<bf16_t>(F, WS_WD), L, D, DFF}; pg8::StaticOrder S; S.init(L, D, F.G, (int)blockIdx.x);
        pg8::EpiPlainQ E{wsp<bf16_t>(F, WS_F), D, wsp<float>(F, WS_RS3), wsp<float>(F, WS_CS) + CS_D};
        pg8::gemm_phase<pg8::EpiPlainQ, pg8::StaticOrder, true, true, 2>(stage, g, S, E);
    }) SEAM(10);
    RUN(11, { final_phase(F); })
#undef RUN
#undef IN
#undef SEAM
}

extern "C" void kernel_launch(void* const* d_in, const int* in_sizes, int n_in, void* d_out, int out_size, void* d_ws, size_t ws_size, hipStream_t stream) {
    static int grid = 0;
    if (grid == 0) {
        if (n_in != 23 || in_sizes[0] != LP * D || in_sizes[1] != LS * D || out_size != L * D || ws_size < WS_END) {
            fprintf(stderr, "kernel_launch: unexpected shapes: n_in %d in0 %d out %d ws %zu (need %zu)\n", n_in, n_in > 0 ? in_sizes[0] : -1, out_size, ws_size, (size_t)WS_END); grid = -1; return; }
        int dev = 0, cus = 0, per_cu = 0;
        if (hipGetDevice(&dev) != hipSuccess || hipDeviceGetAttribute(&cus, hipDeviceAttributeMultiprocessorCount, dev) != hipSuccess) { grid = -1; return; }
        if (hipFuncSetAttribute((const void*)fwd_kernel, hipFuncAttributeMaxDynamicSharedMemorySize, LDS_BYTES) != hipSuccess) { fprintf(stderr, "kernel_launch: hipFuncSetAttribute failed\n"); grid = -1; return; }
        if (hipOccupancyMaxActiveBlocksPerMultiprocessor(&per_cu, (const void*)fwd_kernel, NTHR, LDS_BYTES) != hipSuccess || per_cu < 1) { fprintf(stderr, "kernel_launch: occupancy query says %d\n", per_cu); }
        (void)hipGetLastError();
        grid = cus;
    }
    if (grid < 0) return;
    (void)hipMemsetAsync((char*)d_ws + WS_CTL, 0, CTL_ZERO_BYTES, stream);
#ifdef DBG_ZERO_ALL
    (void)hipMemsetAsync((char*)d_ws, 0, WS_END, stream); (void)hipMemsetAsync((char*)d_out, 0, (size_t)L * D * 4, stream);
#endif
    Args a{};
    for (int i = 0; i < 23; ++i) a.in[i] = (const float*)d_in[i];
    a.out = (float*)d_out; a.ws = (unsigned char*)d_ws;
#if MK_N_LAUNCHES == 1
    a.ph_lo = 0; a.ph_hi = NPHASE;
    hipLaunchKernelGGL(fwd_kernel, dim3(grid), dim3(NTHR), LDS_BYTES, stream, a);
#else
    for (int p = 0; p < NPHASE; ++p) {
#ifdef DBG_PH_MASK
        if (!((DBG_PH_MASK >> p) & 1)) continue;
#endif
        a.ph_lo = p; a.ph_hi = p + 1; hipLaunchKernelGGL(fwd_kernel, dim3(grid), dim3(NTHR), LDS_BYTES, stream, a); }
#endif
}
```

```cpp
#include <hip/hip_runtime.h>
#include <cstdio>
#include <cstdint>

#define LAS __attribute__((address_space(3)))
typedef unsigned short bf16_t;
typedef short bf16x8 __attribute__((ext_vector_type(8)));
typedef float f32x4 __attribute__((ext_vector_type(4)));
typedef float f32x2 __attribute__((ext_vector_type(2)));
typedef unsigned u32x4 __attribute__((ext_vector_type(4)));
typedef unsigned u32x2 __attribute__((ext_vector_type(2)));

constexpr int D = 4096, LP = 16384, LS = 8192, L = LP + LS;
constexpr int GRIDW = 64, HD = 128, NH = 16, NAW = 2048, LW = 2048, NBLK = 16, BW = 128, DFF = 11008, INW = 10240;
constexpr float EPS = 1e-6f;
constexpr int NWAVES = 8, NTHR = 512;

constexpr size_t MiB = 1u << 20;
constexpr size_t WS_CTL = 0, CTL_ZERO_BYTES = 64 * 1024;
constexpr size_t WS_AM = 32 * 1024;
constexpr size_t WS_RSTD = 1 * MiB;
constexpr size_t WS_RS1 = 1 * MiB + 128 * 1024;
constexpr size_t WS_RS2 = 1 * MiB + 256 * 1024;
constexpr size_t WS_CS = 1 * MiB + 384 * 1024;
constexpr size_t WS_SUM = 2 * MiB;
constexpr size_t WS_WCAT = 8 * MiB;
constexpr size_t WS_W8 = 40 * MiB;
constexpr size_t WS_WVT = 88 * MiB;
constexpr size_t WS_XN8 = 96 * MiB;
constexpr size_t WS_WNO = 192 * MiB;
constexpr size_t WS_WLO = 208 * MiB;
constexpr size_t WS_WO = 224 * MiB;
constexpr size_t WS_WGU = 256 * MiB;
constexpr size_t WS_WD = 342 * MiB;
constexpr size_t WS_WG = 428 * MiB;
constexpr size_t WS_XN = 430 * MiB;
constexpr size_t WS_Q = 622 * MiB;
constexpr size_t WS_XR = 718 * MiB;
constexpr size_t WS_K = 814 * MiB;
constexpr size_t WS_VT = 910 * MiB;
constexpr size_t WS_GR = 1006 * MiB;
constexpr size_t WS_XC = 1102 * MiB;
constexpr size_t WS_END = 1198 * MiB;
constexpr int CS_QKM = 0, CS_V = 12288, CS_GU = 12288 + 2048, CS_D = 12288 + 2048 + 22016;
constexpr size_t WS_RS3 = 1 * MiB + 640 * 1024;
constexpr size_t WS_H8P = WS_XN, WS_H8S = WS_XN8;
constexpr size_t WS_T1 = WS_K;
constexpr size_t WS_MIX = WS_GR;
constexpr size_t WS_HIDS = WS_Q;
constexpr size_t WS_F = WS_K;
constexpr size_t WS_HF = WS_K;

#define LDS_WAIT() asm volatile("s_waitcnt lgkmcnt(0)" ::: "memory")
#define VM_WAIT() asm volatile("s_waitcnt vmcnt(0)" ::: "memory")
typedef __bf16 bf16x2n_t __attribute__((ext_vector_type(2)));
__device__ __forceinline__ unsigned pk2(float lo, float hi) { const bf16x2n_t r = __builtin_convertvector((f32x2){lo, hi}, bf16x2n_t); return __builtin_bit_cast(unsigned, r); }
__device__ __forceinline__ unsigned f2bf(float f) { return pk2(f, 0.f) & 0xffffu; }
__device__ __forceinline__ float bflo(unsigned u) { return __builtin_bit_cast(float, u << 16); }
__device__ __forceinline__ float bfhi(unsigned u) { return __builtin_bit_cast(float, u & 0xffff0000u); }
__device__ __forceinline__ float bf1(bf16_t u) { return __builtin_bit_cast(float, (unsigned)u << 16); }
__device__ __forceinline__ float wave_sum(float v) {
#pragma unroll
    for (int o = 1; o < 64; o <<= 1) v += __shfl_xor(v, o);
    return v;
}
__device__ __forceinline__ float wave_max(float v) {
#pragma unroll
    for (int o = 1; o < 64; o <<= 1) v = fmaxf(v, __shfl_xor(v, o));
    return v;
}
__device__ __forceinline__ float sigmoidf_(float v) { return __builtin_amdgcn_rcpf(1.0f + __expf(-v)); }
__device__ __forceinline__ float gelu_tanh(float v) { const float y = 0.7978845608f * (v + 0.044715f * v * v * v); const float e = __expf(2.0f * y); return 0.5f * v * (2.0f - 2.0f * __builtin_amdgcn_rcpf(e + 1.0f)); }

namespace pg8 {
constexpr int BM = 256, BK = 64, HALF = 128, HTB = HALF * BK * 2  , STAGE_BYTES = 8 * HTB, NXCD = 8, WGM = 4;

__host__ __device__ __forceinline__ int lds_byte(int r, int c) { return (r >> 3) * 1024 + (r & 7) * 128 + ((((c >> 3) ^ r) & 7) << 4) + (c & 7) * 2; }
__host__ __device__ __forceinline__ void stage_rc(int b, int& R, int& C) { const int ch = b >> 10, rr = (b >> 7) & 7, slot = (b >> 4) & 7; R = ch * 8 + rr; C = ((slot ^ rr) & 7) * 8; }
__host__ __device__ __forceinline__ int perm32(int rho) { const int n = rho >> 4, i = rho & 15; return 8 * (i >> 2) + 4 * n + (i & 3); }

struct Unit { int pm, pn; };
struct Gemm {
    const bf16_t* A; const bf16_t* A2; int pm_split; const bf16_t* Bt; int M, N, rb;
    __device__ __forceinline__ const char* abase(int pm) const { const size_t t = (size_t)BM * rb; return pm < pm_split ? (const char*)A + (size_t)pm * t : (const char*)A2 + (size_t)(pm - pm_split) * t; }
    __device__ __forceinline__ const char* bbase(int pn) const { return (const char*)Bt + (size_t)pn * BM * rb; }
};

struct StaticOrder {
    int nM, nN, nwg, G, c;
    __host__ __device__ void init(int M, int N, int G_, int c_) { nM = M / BM; nN = N / BM; nwg = nM * nN; G = G_; c = c_; }
    __host__ __device__ bool next(int i, Unit& u) const {
        const long Lx = (long)i * G + c; if (Lx >= nwg) return false;
        int wgid = (int)Lx; { const int q = nwg / NXCD, r = nwg % NXCD, xcd = wgid % NXCD, off = wgid / NXCD; wgid = (xcd < r ? xcd * (q + 1) : r * (q + 1) + (xcd - r) * q) + off; }
        const int nig = WGM * nN, gid = wgid / nig, fm = gid * WGM, gsz = (nM - fm) < WGM ? (nM - fm) : WGM;
        u.pm = fm + ((wgid % nig) % gsz); u.pn = (wgid % nig) / gsz; return true;
    }
    __device__ __forceinline__ void a_ready(const Unit&) const {}
    __device__ __forceinline__ void done(const Unit&) const {}
};

typedef int v8i32 __attribute__((ext_vector_type(8)));
typedef int v4i32 __attribute__((ext_vector_type(4)));
typedef __bf16 bf16x2_t __attribute__((ext_vector_type(2)));
__device__ __forceinline__ unsigned cvt_pk_bf16(float lo, float hi) { const bf16x2_t r = __builtin_convertvector((f32x2){lo, hi}, bf16x2_t); return __builtin_bit_cast(unsigned, r); }
__device__ __forceinline__ u32x4 pack8(const f32x4 v0, const f32x4 v1) { u32x4 w; w.x = cvt_pk_bf16(v0[0], v0[1]); w.y = cvt_pk_bf16(v0[2], v0[3]); w.z = cvt_pk_bf16(v1[0], v1[1]); w.w = cvt_pk_bf16(v1[2], v1[3]); return w; }
__device__ __forceinline__ void unpack8(const u32x4 w, f32x4& v0, f32x4& v1) { v0 = (f32x4){bflo(w.x), bfhi(w.x), bflo(w.y), bfhi(w.y)}; v1 = (f32x4){bflo(w.z), bfhi(w.z), bflo(w.w), bfhi(w.w)}; }
__device__ __forceinline__ f32x4 sig4(const f32x4 v) { f32x4 r; r[0] = sigmoidf_(v[0]); r[1] = sigmoidf_(v[1]); r[2] = sigmoidf_(v[2]); r[3] = sigmoidf_(v[3]); return r; }

struct EpiPlain {
    static constexpr bool PERM = true, AFTER_DRAIN = false;
    bf16_t* O; int ldc;
    __device__ __forceinline__ void operator()(const f32x4 (&acc)[2][2][4][2], const Unit& u, int wr, int wc, int fr, int fq) const {
        const int row0 = u.pm * BM + wr * 64 + fr, col0 = u.pn * BM + wc * 32 + 8 * fq;
#pragma unroll
        for (int ai = 0; ai < 2; ++ai)
#pragma unroll
            for (int m = 0; m < 4; ++m) { bf16_t* rowp = O + (size_t)(row0 + ai * HALF + m * 16) * ldc + col0;
#pragma unroll
                for (int bj = 0; bj < 2; ++bj) *(u32x4*)(rowp + bj * HALF) = pack8(acc[ai][bj][m][0], acc[ai][bj][m][1]); }
    }
};
struct EpiVT {
    static constexpr bool PERM = true, AFTER_DRAIN = false;
    bf16_t* O;
    __device__ __forceinline__ void operator()(const f32x4 (&acc)[2][2][4][2], const Unit& u, int wr, int wc, int fr, int fq) const {
        const int row0 = u.pm * BM + wr * 64 + fr, col0 = u.pn * BM + wc * 32 + 8 * fq;
#pragma unroll
        for (int ai = 0; ai < 2; ++ai)
#pragma unroll
            for (int m = 0; m < 4; ++m) { const int row = row0 + ai * HALF + m * 16, hh = row >> 7, d = row & 127;
                const int dt = 2 * (d >> 5) + ((d >> 2) & 1), i = 4 * ((d >> 3) & 3) + (d & 3);
#pragma unroll
                for (int bj = 0; bj < 2; ++bj) { const int tok = col0 + bj * HALF, R = tok >> 6, o = (tok & 63) >> 3;
                    *(u32x4*)(O + ((size_t)((((R * 16 + hh) * 8 + dt) * 8 + o) * 16 + i)) * 8) = pack8(acc[ai][bj][m][0], acc[ai][bj][m][1]); } }
    }
};
struct EpiProj {
    static constexpr bool PERM = true, AFTER_DRAIN = false;
    bf16_t* P0; bf16_t* P1; bf16_t* P2; bf16_t* P3; bf16_t* G; const float* bias; int pn_gate0;
    __device__ __forceinline__ void operator()(const f32x4 (&acc)[2][2][4][2], const Unit& u, int wr, int wc, int fr, int fq) const {
        const int row0 = u.pm * BM + wr * 64 + fr;
        if (u.pn < pn_gate0) {
            const int t = u.pn >> 3; bf16_t* base = t == 0 ? P0 : (t == 1 ? P1 : (t == 2 ? P2 : P3));
            const int col0 = (u.pn & 7) * BM + wc * 32 + 8 * fq;
            if (t == 2) {
#pragma unroll
                for (int ai = 0; ai < 2; ++ai)
#pragma unroll
                    for (int m = 0; m < 4; ++m) { const int tok = row0 + ai * HALF + m * 16, R = tok >> 6, cl = tok & 63;
                        const int tokpart = (((cl >> 2) & 1) * 8 + (cl >> 3)) * 4 + (cl & 3);
#pragma unroll
                        for (int bj = 0; bj < 2; ++bj) { const int c = col0 + bj * HALF, hh = c >> 7, d0 = c & 127;
                            *(u32x4*)(base + ((size_t)(((R * 16 + hh) * 4 + (d0 >> 5)) * 64 + tokpart) * 4 + ((d0 >> 3) & 3)) * 8) = pack8(acc[ai][bj][m][0], acc[ai][bj][m][1]); } }
            } else {
#pragma unroll
            for (int ai = 0; ai < 2; ++ai)
#pragma unroll
                for (int m = 0; m < 4; ++m) { bf16_t* rowp = base + (size_t)(row0 + ai * HALF + m * 16) * NAW + col0;
#pragma unroll
                    for (int bj = 0; bj < 2; ++bj) *(u32x4*)(rowp + bj * HALF) = pack8(acc[ai][bj][m][0], acc[ai][bj][m][1]); }
            }
        } else {
            const int col0 = (u.pn - pn_gate0) * BM + wc * 32 + 8 * fq;
            f32x4 bv[2][2];
#pragma unroll
            for (int bj = 0; bj < 2; ++bj)
#pragma unroll
                for (int n = 0; n < 2; ++n) bv[bj][n] = *(const f32x4*)(bias + col0 + bj * HALF + 4 * n);
#pragma unroll
            for (int ai = 0; ai < 2; ++ai)
#pragma unroll
                for (int m = 0; m < 4; ++m) { bf16_t* rowp = G + (size_t)(row0 + ai * HALF + m * 16) * (2 * D) + col0;
#pragma unroll
                    for (int bj = 0; bj < 2; ++bj) *(u32x4*)(rowp + bj * HALF) = pack8(sig4(acc[ai][bj][m][0] + bv[bj][0]), sig4(acc[ai][bj][m][1] + bv[bj][1])); }
        }
    }
};
template <bool ADD> struct EpiMulG {
    static constexpr bool PERM = true, AFTER_DRAIN = false;
    bf16_t* O; const bf16_t* G; int goff;
    __device__ __forceinline__ void operator()(const f32x4 (&acc)[2][2][4][2], const Unit& u, int wr, int wc, int fr, int fq) const {
        const int row0 = u.pm * BM + wr * 64 + fr, col0 = u.pn * BM + wc * 32 + 8 * fq;
#pragma unroll
        for (int ai = 0; ai < 2; ++ai)
#pragma unroll
            for (int m = 0; m < 4; ++m) { const size_t row = (size_t)(row0 + ai * HALF + m * 16); bf16_t* rowp = O + row * D + col0; const bf16_t* gp = G + row * (2 * D) + goff + col0;
#pragma unroll
                for (int bj = 0; bj < 2; ++bj) {
                    f32x4 g0, g1; unpack8(*(const u32x4*)(gp + bj * HALF), g0, g1);
                    f32x4 v0 = acc[ai][bj][m][0] * g0, v1 = acc[ai][bj][m][1] * g1;
                    if (ADD) { f32x4 t0, t1; unpack8(*(const u32x4*)(rowp + bj * HALF), t0, t1); v0 += t0; v1 += t1; }
                    *(u32x4*)(rowp + bj * HALF) = pack8(v0, v1); } }
    }
};
struct EpiSwiglu {
    static constexpr bool PERM = true, AFTER_DRAIN = false;
    bf16_t* H0; bf16_t* H1; int pm_split;
    __device__ __forceinline__ void operator()(const f32x4 (&acc)[2][2][4][2], const Unit& u, int wr, int wc, int fr, int fq) const {
        bf16_t* base = u.pm < pm_split ? H0 + (size_t)u.pm * BM * DFF : H1 + (size_t)(u.pm - pm_split) * BM * DFF;
        const int row0 = wr * 64 + fr, col0 = u.pn * HALF + wc * 32 + 8 * fq;
#pragma unroll
        for (int ai = 0; ai < 2; ++ai)
#pragma unroll
            for (int m = 0; m < 4; ++m) {
                f32x4 h[2];
#pragma unroll
                for (int n = 0; n < 2; ++n) { const f32x4 g = acc[ai][0][m][n], up = acc[ai][1][m][n];
#pragma unroll
                    for (int j = 0; j < 4; ++j) h[n][j] = g[j] * sigmoidf_(g[j]) * up[j]; }
                *(u32x4*)(base + (size_t)(row0 + ai * HALF + m * 16) * DFF + col0) = pack8(h[0], h[1]); }
    }
};

__device__ __forceinline__ f32x4 deq4(const f32x4 accbits, const float sa, const f32x4 sb) { const v4i32 q = __builtin_bit_cast(v4i32, accbits); return (f32x4){(float)q.x, (float)q.y, (float)q.z, (float)q.w} * sa * sb; }
struct EpiProjQ {
    static constexpr bool PERM = true, AFTER_DRAIN = false;
    bf16_t* Qb; bf16_t* Kb; bf16_t* G; const float* bias; const float* sa; const float* sb;
    __device__ __forceinline__ void operator()(const f32x4 (&acc)[2][2][4][2], const Unit& u, int wr, int wc, int fr, int fq) const {
        const int row0 = u.pm * BM + wr * 64 + fr, cg0 = u.pn * BM + wc * 32 + 8 * fq;
        f32x4 sbv[2][2];
#pragma unroll
        for (int bj = 0; bj < 2; ++bj)
#pragma unroll
            for (int n = 0; n < 2; ++n) sbv[bj][n] = *(const f32x4*)(sb + cg0 + bj * HALF + 4 * n);
        if (u.pn < 8) {
            const int col0 = u.pn * BM + wc * 32 + 8 * fq;
#pragma unroll
            for (int ai = 0; ai < 2; ++ai)
#pragma unroll
                for (int m = 0; m < 4; ++m) { const int row = row0 + ai * HALF + m * 16; const float sr = sa[row]; bf16_t* rowp = Qb + (size_t)row * NAW + col0;
#pragma unroll
                    for (int bj = 0; bj < 2; ++bj) *(u32x4*)(rowp + bj * HALF) = pack8(deq4(acc[ai][bj][m][0], sr, sbv[bj][0]), deq4(acc[ai][bj][m][1], sr, sbv[bj][1])); }
        } else if (u.pn < 16) {
            const int col0 = (u.pn - 8) * BM + wc * 32 + 8 * fq;
#pragma unroll
            for (int ai = 0; ai < 2; ++ai)
#pragma unroll
                for (int m = 0; m < 4; ++m) { const int tok = row0 + ai * HALF + m * 16, R = tok >> 6, cl = tok & 63; const float sr = sa[tok];
                    const int tokpart = (((cl >> 2) & 1) * 8 + (cl >> 3)) * 4 + (cl & 3);
#pragma unroll
                    for (int bj = 0; bj < 2; ++bj) { const int c = col0 + bj * HALF, hh = c >> 7, d0 = c & 127;
                        *(u32x4*)(Kb + ((size_t)(((R * 16 + hh) * 4 + (d0 >> 5)) * 64 + tokpart) * 4 + ((d0 >> 3) & 3)) * 8) = pack8(deq4(acc[ai][bj][m][0], sr, sbv[bj][0]), deq4(acc[ai][bj][m][1], sr, sbv[bj][1])); } }
        } else {
            const int col0 = (u.pn - 16) * BM + wc * 32 + 8 * fq;
            f32x4 bv[2][2];
#pragma unroll
            for (int bj = 0; bj < 2; ++bj)
#pragma unroll
                for (int n = 0; n < 2; ++n) bv[bj][n] = *(const f32x4*)(bias + col0 + bj * HALF + 4 * n);
#pragma unroll
            for (int ai = 0; ai < 2; ++ai)
#pragma unroll
                for (int m = 0; m < 4; ++m) { const int row = row0 + ai * HALF + m * 16; const float sr = sa[row]; bf16_t* rowp = G + (size_t)row * (2 * D) + col0;
#pragma unroll
                    for (int bj = 0; bj < 2; ++bj) *(u32x4*)(rowp + bj * HALF) = pack8(sig4(deq4(acc[ai][bj][m][0], sr, sbv[bj][0]) + bv[bj][0]), sig4(deq4(acc[ai][bj][m][1], sr, sbv[bj][1]) + bv[bj][1])); }
        }
    }
};
struct EpiPlainQ {
    static constexpr bool PERM = true, AFTER_DRAIN = false;
    bf16_t* O; int ldc; const float* sa; const float* sb;
    __device__ __forceinline__ void operator()(const f32x4 (&acc)[2][2][4][2], const Unit& u, int wr, int wc, int fr, int fq) const {
        const int row0 = u.pm * BM + wr * 64 + fr, col0 = u.pn * BM + wc * 32 + 8 * fq;
        f32x4 sbv[2][2];
#pragma unroll
        for (int bj = 0; bj < 2; ++bj)
#pragma unroll
            for (int n = 0; n < 2; ++n) sbv[bj][n] = *(const f32x4*)(sb + col0 + bj * HALF + 4 * n);
#pragma unroll
        for (int ai = 0; ai < 2; ++ai)
#pragma unroll
            for (int m = 0; m < 4; ++m) { const int row = row0 + ai * HALF + m * 16; const float sr = sa[row]; bf16_t* rowp = O + (size_t)row * ldc + col0;
#pragma unroll
                for (int bj = 0; bj < 2; ++bj) *(u32x4*)(rowp + bj * HALF) = pack8(deq4(acc[ai][bj][m][0], sr, sbv[bj][0]), deq4(acc[ai][bj][m][1], sr, sbv[bj][1])); }
    }
};
struct EpiVTQ {
    static constexpr bool PERM = true, AFTER_DRAIN = false;
    bf16_t* O; const float* sa; const float* sb;
    __device__ __forceinline__ void operator()(const f32x4 (&acc)[2][2][4][2], const Unit& u, int wr, int wc, int fr, int fq) const {
        const int row0 = u.pm * BM + wr * 64 + fr, col0 = u.pn * BM + wc * 32 + 8 * fq;
        f32x4 sbv[2][2];
#pragma unroll
        for (int bj = 0; bj < 2; ++bj)
#pragma unroll
            for (int n = 0; n < 2; ++n) sbv[bj][n] = *(const f32x4*)(sb + col0 + bj * HALF + 4 * n);
#pragma unroll
        for (int ai = 0; ai < 2; ++ai)
#pragma unroll
            for (int m = 0; m < 4; ++m) { const int row = row0 + ai * HALF + m * 16, hh = row >> 7, d = row & 127; const float sr = sa[row];
                const int dt = 2 * (d >> 5) + ((d >> 2) & 1), i = 4 * ((d >> 3) & 3) + (d & 3);
#pragma unroll
                for (int bj = 0; bj < 2; ++bj) { const int tok = col0 + bj * HALF, R = tok >> 6, o = (tok & 63) >> 3;
                    *(u32x4*)(O + ((size_t)((((R * 16 + hh) * 8 + dt) * 8 + o) * 16 + i)) * 8) = pack8(deq4(acc[ai][bj][m][0], sr, sbv[bj][0]), deq4(acc[ai][bj][m][1], sr, sbv[bj][1])); } }
    }
};
struct EpiSwigluQ {
    static constexpr bool PERM = true, AFTER_DRAIN = false;
    bf16_t* H0; bf16_t* H1; int pm_split; const float* sa; const float* sb;
    __device__ __forceinline__ void operator()(const f32x4 (&acc)[2][2][4][2], const Unit& u, int wr, int wc, int fr, int fq) const {
        bf16_t* base = u.pm < pm_split ? H0 + (size_t)u.pm * BM * DFF : H1 + (size_t)(u.pm - pm_split) * BM * DFF;
        const int row0 = wr * 64 + fr, col0 = u.pn * HALF + wc * 32 + 8 * fq, cg0 = u.pn * BM + wc * 32 + 8 * fq;
        f32x4 sbv[2][2];
#pragma unroll
        for (int bj = 0; bj < 2; ++bj)
#pragma unroll
            for (int n = 0; n < 2; ++n) sbv[bj][n] = *(const f32x4*)(sb + cg0 + bj * HALF + 4 * n);
#pragma unroll
        for (int ai = 0; ai < 2; ++ai)
#pragma unroll
            for (int m = 0; m < 4; ++m) { const float sr = sa[u.pm * BM + row0 + ai * HALF + m * 16];
                f32x4 h[2];
#pragma unroll
                for (int n = 0; n < 2; ++n) { const f32x4 g = deq4(acc[ai][0][m][n], sr, sbv[0][n]), up = deq4(acc[ai][1][m][n], sr, sbv[1][n]);
#pragma unroll
                    for (int j = 0; j < 4; ++j) h[n][j] = g[j] * sigmoidf_(g[j]) * up[j]; }
                *(u32x4*)(base + (size_t)(row0 + ai * HALF + m * 16) * DFF + col0) = pack8(h[0], h[1]); }
    }
};

__device__ __forceinline__ v8i32 cat8(const bf16x8 lo, const bf16x8 hi) { return __builtin_shufflevector(__builtin_bit_cast(v4i32, lo), __builtin_bit_cast(v4i32, hi), 0, 1, 2, 3, 4, 5, 6, 7); }
__device__ __forceinline__ void mfma_fp8_acc(f32x4& c, const v8i32 a, const v8i32 b, int sa, int sb) {
    asm volatile("v_mfma_scale_f32_16x16x128_f8f6f4 %0, %1, %2, %0, %3, %4 op_sel_hi:[0,0,0]" : "+v"(c) : "v"(a), "v"(b), "v"(sa), "v"(sb)); }
constexpr int FP8_SCALE = 0x73737373;
template <class Epi, class Sched, bool ALIGN_EPI = false, bool SP2 = false, int QM = 0  , int DBG = 0>
__device__ __forceinline__ void gemm_phase(LAS unsigned char* lds, const Gemm g, const Sched& S, const Epi& E) {
    int tid = threadIdx.x; asm volatile("" : "+v"(tid));
    const int wid = __builtin_amdgcn_readfirstlane(tid >> 6), lane = tid & 63, wr = wid >> 2, wc = wid & 3, fr = lane & 15, fq = lane >> 4;
    const int RB = g.rb, nt = RB / (BK * 2);
    unsigned voffA[2], voffB[2];
#pragma unroll
    for (int i = 0; i < 2; ++i) { int R, C; stage_rc(tid * 16 + i * 8192, R, C); const int Rb = Epi::PERM ? ((R & ~31) + perm32(R & 31)) : R;
        voffA[i] = (unsigned)(R * RB + C * 2); voffB[i] = (unsigned)(Rb * RB + C * 2); }
    const size_t kstep = (size_t)(BK * 2);
    const size_t hstep = (size_t)HALF * RB;
    const unsigned ldsw = (unsigned)wid * 1024u;
    const int aoff0 = lds_byte(wr * 64 + fr, fq * 8), aoff1 = lds_byte(wr * 64 + fr, 32 + fq * 8), boff0 = lds_byte(wc * 32 + fr, fq * 8), boff1 = lds_byte(wc * 32 + fr, 32 + fq * 8);
#define PG8_SA(b, h) (((b) * 2 + (h)) * HTB)
#define PG8_SB(b, h) ((4 + (b) * 2 + (h)) * HTB)
#define PG8_STAGE(bufoff, gbase, voff) do { if constexpr (DBG != 3) _Pragma("unroll") for (int _i = 0; _i < 2; ++_i) \
        __builtin_amdgcn_global_load_lds((const unsigned*)((const char*)(gbase) + (voff)[_i]), (LAS unsigned*)(lds + (bufoff) + ldsw + _i * 8192), 16, 0, 0); } while (0)
#define PG8_LDA(dst, b, h) do { if constexpr (DBG != 2) _Pragma("unroll") for (int m = 0; m < 4; ++m) _Pragma("unroll") for (int k = 0; k < 2; ++k) dst[m][k] = *(const LAS bf16x8*)(lds + PG8_SA(b, h) + (k ? aoff1 : aoff0) + m * 2048); } while (0)
#define PG8_LDB(dst, b, h) do { if constexpr (DBG != 2) _Pragma("unroll") for (int n = 0; n < 2; ++n) _Pragma("unroll") for (int k = 0; k < 2; ++k) dst[n][k] = *(const LAS bf16x8*)(lds + PG8_SB(b, h) + (k ? boff1 : boff0) + n * 2048); } while (0)
#define PG8_MMA(ai, bj, At, Bt) do { __builtin_amdgcn_s_setprio(1); if constexpr (DBG == 1) { } else if constexpr (QM == 2) { _Pragma("unroll") for (int m = 0; m < 4; ++m) _Pragma("unroll") for (int n = 0; n < 2; ++n) _Pragma("unroll") for (int k = 0; k < 2; ++k) \
        acc[ai][bj][m][n] = __builtin_bit_cast(f32x4, __builtin_amdgcn_mfma_i32_16x16x64_i8(__builtin_bit_cast(v4i32, Bt[n][k]), __builtin_bit_cast(v4i32, At[m][k]), __builtin_bit_cast(v4i32, acc[ai][bj][m][n]), 0, 0, 0)); } else if constexpr (QM == 1) { _Pragma("unroll") for (int m = 0; m < 4; ++m) _Pragma("unroll") for (int n = 0; n < 2; ++n) \
        mfma_fp8_acc(acc[ai][bj][m][n], cat8(Bt[n][0], Bt[n][1]), cat8(At[m][0], At[m][1]), fp8_sa, fp8_sb); } else { \
        _Pragma("unroll") for (int m = 0; m < 4; ++m) _Pragma("unroll") for (int n = 0; n < 2; ++n) _Pragma("unroll") for (int k = 0; k < 2; ++k) \
        acc[ai][bj][m][n] = __builtin_amdgcn_mfma_f32_16x16x32_bf16(Bt[n][k], At[m][k], acc[ai][bj][m][n], 0, 0, 0); } __builtin_amdgcn_s_setprio(0); } while (0)
#define PG8_WAIT_V(n) asm volatile("s_waitcnt vmcnt(" #n ")" ::: "memory")
#define PG8_WAIT_L(n) asm volatile("s_waitcnt lgkmcnt(" #n ")" ::: "memory")
#define PG8_BAR __builtin_amdgcn_s_barrier()
#define PG8_SCHED __builtin_amdgcn_sched_barrier(0)
    Unit cur, nxt; int ui = 0;
    const int fp8_sa = FP8_SCALE, fp8_sb = 0x7F7F7F7F;
    if (!S.next(0, cur)) return;
    f32x4 acc[2][2][4][2];
#pragma unroll
    for (int a = 0; a < 2; ++a)
#pragma unroll
        for (int b = 0; b < 2; ++b)
#pragma unroll
            for (int m = 0; m < 4; ++m)
#pragma unroll
                for (int n = 0; n < 2; ++n) acc[a][b][m][n] = (f32x4){0.f, 0.f, 0.f, 0.f};
    bf16x8 At[4][2], B0[2][2], B1[2][2];
    const char* cA = g.abase(cur.pm); const char* cB = g.bbase(cur.pn);
    S.a_ready(cur);
    if constexpr (SP2) {
        PG8_STAGE(PG8_SB(0, 0), cB, voffB); PG8_STAGE(PG8_SB(0, 1), cB + hstep, voffB); PG8_STAGE(PG8_SA(0, 0), cA, voffA); PG8_STAGE(PG8_SA(0, 1), cA + hstep, voffA);
        if (wr == 1) PG8_BAR;
        PG8_WAIT_V(2); PG8_BAR;
        PG8_STAGE(PG8_SB(1, 0), cB + kstep, voffB); PG8_STAGE(PG8_SA(1, 0), cA + kstep, voffA); PG8_STAGE(PG8_SB(1, 1), cB + hstep + kstep, voffB);
        PG8_WAIT_V(6); PG8_BAR;
    } else {
        PG8_STAGE(PG8_SB(0, 0), cB, voffB); PG8_STAGE(PG8_SA(0, 0), cA, voffA); PG8_STAGE(PG8_SB(0, 1), cB + hstep, voffB); PG8_STAGE(PG8_SA(0, 1), cA + hstep, voffA);
        if (wr == 1) PG8_BAR;
        PG8_WAIT_V(4); PG8_BAR;
        PG8_STAGE(PG8_SB(1, 0), cB + kstep, voffB); PG8_STAGE(PG8_SA(1, 0), cA + kstep, voffA); PG8_STAGE(PG8_SB(1, 1), cB + hstep + kstep, voffB);
        PG8_WAIT_V(6); PG8_BAR;
    }
    for (;;) {
        const bool has_next = S.next(ui + 1, nxt);
        const char* nA = has_next ? g.abase(nxt.pm) : cA; const char* nB = has_next ? g.bbase(nxt.pn) : cB;
        for (int t = 0; t < nt; t += 2) {
            const bool last = (t == nt - 2);
            const char* a1 = cA + (size_t)(t + 1) * kstep;
            const char* a2 = last ? nA : cA + (size_t)(t + 2) * kstep; const char* b2 = last ? nB : cB + (size_t)(t + 2) * kstep;
            const char* a3 = a2 + kstep; const char* b3 = b2 + kstep;
            if (last && has_next) S.a_ready(nxt);
            if constexpr (SP2) {
            PG8_LDB(B0, 0, 0); PG8_LDB(B1, 0, 1); PG8_SCHED; PG8_LDA(At, 0, 0); PG8_STAGE(PG8_SA(1, 1), a1 + hstep, voffA);
            PG8_WAIT_V(8); PG8_WAIT_L(0); PG8_BAR; PG8_MMA(0, 0, At, B0); PG8_MMA(0, 1, At, B1); PG8_BAR; PG8_SCHED;
            PG8_LDA(At, 0, 1); PG8_STAGE(PG8_SB(0, 0), b2, voffB); PG8_STAGE(PG8_SB(0, 1), b2 + hstep, voffB); PG8_STAGE(PG8_SA(0, 0), a2, voffA);
            PG8_WAIT_V(8); PG8_WAIT_L(0); PG8_BAR; PG8_MMA(1, 0, At, B0); PG8_MMA(1, 1, At, B1); PG8_BAR; PG8_SCHED;
            PG8_LDB(B0, 1, 0); PG8_LDB(B1, 1, 1); PG8_SCHED; PG8_LDA(At, 1, 0); PG8_STAGE(PG8_SA(0, 1), a2 + hstep, voffA);
            PG8_WAIT_V(8); PG8_WAIT_L(0); PG8_BAR; PG8_MMA(0, 0, At, B0); PG8_MMA(0, 1, At, B1); PG8_BAR; PG8_SCHED;
            PG8_LDA(At, 1, 1); PG8_STAGE(PG8_SB(1, 0), b3, voffB); PG8_STAGE(PG8_SB(1, 1), b3 + hstep, voffB); PG8_STAGE(PG8_SA(1, 0), a3, voffA);
            PG8_WAIT_V(8); PG8_WAIT_L(0); PG8_BAR; PG8_MMA(1, 0, At, B0); PG8_MMA(1, 1, At, B1); PG8_BAR; PG8_SCHED;
            } else {
            PG8_LDB(B0, 0, 0); PG8_SCHED; PG8_LDA(At, 0, 0); PG8_STAGE(PG8_SA(1, 1), a1 + hstep, voffA);
            PG8_WAIT_L(8); PG8_BAR; PG8_WAIT_L(0); PG8_MMA(0, 0, At, B0); PG8_BAR; PG8_SCHED;
            PG8_LDB(B1, 0, 1); PG8_STAGE(PG8_SB(0, 0), b2, voffB);
            PG8_BAR; PG8_WAIT_L(0); PG8_MMA(0, 1, At, B1); PG8_BAR;
            PG8_LDA(At, 0, 1); PG8_STAGE(PG8_SA(0, 0), a2, voffA);
            PG8_BAR; PG8_WAIT_L(0); PG8_MMA(1, 0, At, B0); PG8_BAR; PG8_SCHED;
            PG8_STAGE(PG8_SB(0, 1), b2 + hstep, voffB);
            PG8_WAIT_V(6); PG8_BAR; PG8_MMA(1, 1, At, B1); PG8_BAR;
            PG8_LDB(B0, 1, 0); PG8_SCHED; PG8_LDA(At, 1, 0); PG8_STAGE(PG8_SA(0, 1), a2 + hstep, voffA);
            PG8_WAIT_L(8); PG8_BAR; PG8_WAIT_L(0); PG8_MMA(0, 0, At, B0); PG8_BAR; PG8_SCHED;
            PG8_LDB(B1, 1, 1); PG8_STAGE(PG8_SB(1, 0), b3, voffB);
            PG8_BAR; PG8_WAIT_L(0); PG8_MMA(0, 1, At, B1); PG8_BAR;
            PG8_LDA(At, 1, 1); PG8_STAGE(PG8_SA(1, 0), a3, voffA);
            PG8_BAR; PG8_WAIT_L(0); PG8_MMA(1, 0, At, B0); PG8_BAR; PG8_SCHED;
            PG8_STAGE(PG8_SB(1, 1), b3 + hstep, voffB);
            PG8_WAIT_V(6); PG8_BAR; PG8_MMA(1, 1, At, B1); PG8_BAR;
            }
        }
        if constexpr (ALIGN_EPI) { if (wr == 0) PG8_BAR; }
        if constexpr (!Epi::AFTER_DRAIN) { if constexpr (DBG != 4) E(acc, cur, wr, wc, fr, fq); else { _Pragma("unroll") for (int a_ = 0; a_ < 2; ++a_) _Pragma("unroll") for (int b_ = 0; b_ < 2; ++b_) _Pragma("unroll") for (int m_ = 0; m_ < 4; ++m_) _Pragma("unroll") for (int n_ = 0; n_ < 2; ++n_) asm volatile("" :: "v"(acc[a_][b_][m_][n_])); } S.done(cur); }
        if (!has_next) break;
#pragma unroll
        for (int a = 0; a < 2; ++a)
#pragma unroll
            for (int b = 0; b < 2; ++b)
#pragma unroll
                for (int m = 0; m < 4; ++m)
#pragma unroll
                    for (int n = 0; n < 2; ++n) acc[a][b][m][n] = (f32x4){0.f, 0.f, 0.f, 0.f};
        cur = nxt; cA = nA; cB = nB; ++ui;
        if constexpr (ALIGN_EPI) { if (wr == 1) PG8_BAR; }
    }
    PG8_WAIT_V(0);
    if constexpr (!ALIGN_EPI) { if (wr == 0) PG8_BAR; }
    PG8_BAR;
    if constexpr (Epi::AFTER_DRAIN) { E.fused(acc, cur, wr, wc, fr, fq, lds, wid, lane); S.done(cur); }
#undef PG8_SA
#undef PG8_SB
#undef PG8_STAGE
#undef PG8_LDA
#undef PG8_LDB
#undef PG8_MMA
#undef PG8_WAIT_V
#undef PG8_WAIT_L
#undef PG8_BAR
#undef PG8_SCHED
}
}
#define XB_TMO      128
#define XB_XCNT(j)  (256  + 64 * (j))
#define XB_XSUB(j)  (1280 + 64 * (j))
#define XB_XGEN(j)  (2304 + 64 * (j))
#define XB_TOP      3328
#define XB_TOPGEN   3392
#define XCD_BAR_WORDS 3456
#define XB_SPIN_CAP (1u << 18)

__device__ __forceinline__ unsigned xb_ld(unsigned* p)              { return __hip_atomic_load(p, __ATOMIC_RELAXED, __HIP_MEMORY_SCOPE_AGENT); }
__device__ __forceinline__ unsigned xb_add(unsigned* p, unsigned v) { return __hip_atomic_fetch_add(p, v, __ATOMIC_RELAXED, __HIP_MEMORY_SCOPE_AGENT); }
__device__ __forceinline__ unsigned xb_xcc_id() { return (unsigned)__builtin_amdgcn_s_getreg((3 << 11) | 20) & 0xFu; }
#define XB_SPIN(cond, bar) do { unsigned _sp = 0; while (cond) { __builtin_amdgcn_s_sleep(1); \
    if ((++_sp & 255u) == 0u) { if (xb_ld(&(bar)[XB_TMO])) break; if (_sp > XB_SPIN_CAP) { atomicAdd(&(bar)[XB_TMO], 1u); break; } } } } while (0)

struct XcdBarrier {
    unsigned* bar; unsigned x;
    volatile LAS unsigned* st;
};

__device__ __forceinline__ XcdBarrier xcd_barrier_post(unsigned* bar, volatile LAS unsigned* st) {
    XcdBarrier b; b.bar = bar; b.x = xb_xcc_id(); b.st = st;
    if (threadIdx.x == 0) (void)xb_add(&bar[XB_XCNT(b.x)], 1u);
    return b;
}
__device__ __forceinline__ void xcd_barrier_complete(unsigned* bar, unsigned x, unsigned& nloc, unsigned& nx) {
    const unsigned G = gridDim.x * gridDim.y * gridDim.z;
    unsigned sum, cnt, mine, sp = 0u;
    for (;;) {
        sum = 0u; cnt = 0u; mine = 0u;
#pragma unroll
        for (unsigned j = 0; j < 16; ++j) { const unsigned c = xb_ld(&bar[XB_XCNT(j)]); sum += c; cnt += (c > 0u) ? 1u : 0u; mine = (j == x) ? c : mine; }
        if (sum == G) break;
        __builtin_amdgcn_s_sleep(1);
        if ((++sp & 255u) == 0u) { if (xb_ld(&bar[XB_TMO])) break; if (sp > XB_SPIN_CAP) { atomicAdd(&bar[XB_TMO], 1u); break; } }
    }
    nloc = mine > 0u ? mine : 1u; nx = cnt > 0u ? cnt : 1u;
}

__device__ __forceinline__ void xcd_barrier(const XcdBarrier& b) {
    asm volatile("s_waitcnt vmcnt(0)" ::: "memory");
    __syncthreads();
    if (threadIdx.x == 0) {
        unsigned* bar = b.bar;
        __builtin_amdgcn_s_waitcnt(0);
        unsigned nloc = b.st[0], nx = b.st[1];
        if (nloc == 0u) { xcd_barrier_complete(bar, b.x, nloc, nx); b.st[0] = nloc; b.st[1] = nx; }
        const unsigned old = xb_add(&bar[XB_XSUB(b.x)], 1u);
        const unsigned gen = old / nloc;
        if (old + 1u == (gen + 1u) * nloc) {
            __builtin_amdgcn_fence(__ATOMIC_RELEASE, "agent");
            asm volatile("s_waitcnt vmcnt(0)" ::: "memory");
            const unsigned og = xb_add(&bar[XB_TOP], 1u);
            const unsigned tg = og / nx;
            if (og + 1u == (tg + 1u) * nx) xb_add(&bar[XB_TOPGEN], 1u);
            else XB_SPIN(xb_ld(&bar[XB_TOPGEN]) == tg, bar);
            __builtin_amdgcn_fence(__ATOMIC_ACQUIRE, "agent");
            xb_add(&bar[XB_XGEN(b.x)], 1u);
            asm volatile("s_waitcnt vmcnt(0)" ::: "memory");
        } else {
            XB_SPIN(xb_ld(&bar[XB_XGEN(b.x)]) == gen, bar);
            __builtin_amdgcn_fence(__ATOMIC_ACQUIRE, "agent");
            asm volatile("s_waitcnt vmcnt(0)" ::: "memory");
        }
    }
    __syncthreads();
}


struct Frame {
    LAS unsigned char* lds;
    int tid, lane, wave, G, gw, ngw;
    const float *in_XP, *in_XS, *in_WIN, *in_WCONV, *in_BCONV, *in_WR, *in_BR, *in_WI, *in_BI, *in_LAM, *in_RPB, *in_WNO, *in_WLO, *in_WM, *in_BM, *in_WOUT, *in_GMPRE, *in_GMPOST, *in_GFPRE, *in_GFPOST, *in_WFG, *in_WFU, *in_WFD; float* out; unsigned char* ws;
};
enum { I_XP = 0, I_XS, I_WIN, I_WCONV, I_BCONV, I_WR, I_BR, I_WI, I_BI, I_LAM, I_RPB, I_WNO, I_WLO, I_WM, I_BM, I_WOUT, I_GMPRE, I_GMPOST, I_GFPRE, I_GFPOST, I_WFG, I_WFU, I_WFD };
__device__ __forceinline__ int opaque(int x) { asm volatile("" : "+v"(x)); return x; }
template <class T> __device__ __forceinline__ T* wsp(const Frame& F, size_t off) { return (T*)(F.ws + off); }
__device__ __forceinline__ const float* xrow(const Frame& F, int m) { return m < LP ? F.in_XP + (size_t)m * D : F.in_XS + (size_t)(m - LP) * D; }

__device__ __forceinline__ void tr_item(const float* src, int ldsrc, int k0, int n0, bf16_t* dst, int ldd, int drow0, LAS float* scr, int lane) {
#pragma unroll 8
    for (int i = 0; i < 32; ++i) { const int kk = 2 * i + (lane >> 5); scr[kk * 33 + (lane & 31)] = src[(size_t)(k0 + kk) * ldsrc + n0 + (lane & 31)]; }
    LDS_WAIT(); asm volatile("" ::: "memory");
    const int c = lane & 7;
#pragma unroll
    for (int j = 0; j < 4; ++j) { const int n = (lane >> 3) + 8 * j; const LAS float* s = scr + (8 * c) * 33 + n;
        u32x4 o; o.x = pk2(s[0 * 33], s[1 * 33]); o.y = pk2(s[2 * 33], s[3 * 33]); o.z = pk2(s[4 * 33], s[5 * 33]); o.w = pk2(s[6 * 33], s[7 * 33]);
        *(u32x4*)(dst + (size_t)(drow0 + n) * ldd + k0 + 8 * c) = o; }
    LDS_WAIT(); asm volatile("" ::: "memory");
}
__device__ __forceinline__ unsigned pk4_fp8(float a, float b, float c, float d) { int p = __builtin_amdgcn_cvt_pk_fp8_f32(a, b, 0, false); p = __builtin_amdgcn_cvt_pk_fp8_f32(c, d, p, true); return (unsigned)p; }
__device__ __forceinline__ void tr_item8(const float* src, int ldsrc, int k0, int n0, unsigned char* dst, int ldd, int drow0, LAS float* scr, int lane) {
#pragma unroll 8
    for (int i = 0; i < 32; ++i) { const int kk = 2 * i + (lane >> 5); scr[kk * 33 + (lane & 31)] = src[(size_t)(k0 + kk) * ldsrc + n0 + (lane & 31)]; }
    LDS_WAIT(); asm volatile("" ::: "memory");
    const int c = lane & 7;
#pragma unroll
    for (int j = 0; j < 4; ++j) { const int n = (lane >> 3) + 8 * j; const LAS float* s = scr + (8 * c) * 33 + n;
        u32x2 o; o.x = pk4_fp8(s[0 * 33] * 256.f, s[1 * 33] * 256.f, s[2 * 33] * 256.f, s[3 * 33] * 256.f); o.y = pk4_fp8(s[4 * 33] * 256.f, s[5 * 33] * 256.f, s[6 * 33] * 256.f, s[7 * 33] * 256.f);
        *(u32x2*)(dst + (size_t)(drow0 + n) * ldd + k0 + 8 * c) = o; }
    LDS_WAIT(); asm volatile("" ::: "memory");
}
__device__ __forceinline__ unsigned pk4_i8(float a, float b, float c, float d) { return ((unsigned)(int)a & 255u) | (((unsigned)(int)b & 255u) << 8) | (((unsigned)(int)c & 255u) << 16) | ((unsigned)(int)d << 24); }
__device__ __forceinline__ void tr_strip_i8(const float* src, int ldsrc, int K, int n0, signed char* dst, int drow0, float* cs, LAS float* scr, int lane) {
    const float* sp = src + n0 + (lane & 31) + (size_t)(lane >> 5) * ldsrc;
    float mx = 0.f;
    { const float* p = sp; const size_t step = (size_t)2 * ldsrc;
      for (int k0 = 0; k0 < K; k0 += 64) {
        float t[32];
#pragma unroll
        for (int i = 0; i < 32; ++i) { t[i] = *p; p += step; }
#pragma unroll
        for (int i = 0; i < 32; ++i) mx = fmaxf(mx, fabsf(t[i]));
      } }
    mx = fmaxf(mx, __shfl_xor(mx, 32));
    const float amax = fmaxf(mx, 1e-20f), inv = 127.0f / amax;
    if (lane < 32) cs[drow0 + lane] = amax * (1.0f / 127.0f);
    const int c = lane & 7;
    for (int k0 = 0; k0 < K; k0 += 64) {
        { const float* p = sp + (size_t)k0 * ldsrc; const size_t step = (size_t)2 * ldsrc; LAS float* w = scr + (lane >> 5) * 33 + (lane & 31);
          float t[32];
#pragma unroll
          for (int i = 0; i < 32; ++i) { t[i] = *p; p += step; }
#pragma unroll
          for (int i = 0; i < 32; ++i) w[i * 66] = rintf(t[i] * inv); }
        LDS_WAIT(); asm volatile("" ::: "memory");
#pragma unroll
        for (int j = 0; j < 4; ++j) { const int n = (lane >> 3) + 8 * j; const LAS float* t = scr + (8 * c) * 33 + n;
            u32x2 o; o.x = pk4_i8(t[0 * 33], t[1 * 33], t[2 * 33], t[3 * 33]); o.y = pk4_i8(t[4 * 33], t[5 * 33], t[6 * 33], t[7 * 33]);
            *(u32x2*)(dst + (size_t)(drow0 + n) * K + k0 + 8 * c) = o; }
        LDS_WAIT(); asm volatile("" ::: "memory");
    }
}
__device__ __forceinline__ void fwht32(float (&v)[32]) {
#pragma unroll
    for (int st = 1; st < 32; st <<= 1)
#pragma unroll
        for (int i = 0; i < 32; ++i) if (!(i & st)) { const float a = v[i], b = v[i + st]; v[i] = a + b; v[i + st] = a - b; }
#pragma unroll
    for (int i = 0; i < 32; ++i) v[i] *= 0.17677669529663687f;
}
__device__ __forceinline__ void had_tile_load(const float* src, int ldsrc, int k0, int n0, LAS float* scr, int lane, float (&v)[32]) {
    { const float* p = src + (size_t)(k0 + (lane >> 5)) * ldsrc + n0 + (lane & 31); const size_t step = (size_t)2 * ldsrc; LAS float* w = scr + (lane >> 5) * 33 + (lane & 31); float t[32];
#pragma unroll
      for (int i = 0; i < 32; ++i) { t[i] = *p; p += step; }
#pragma unroll
      for (int i = 0; i < 32; ++i) w[i * 66] = t[i]; }
    LDS_WAIT(); asm volatile("" ::: "memory");
    const LAS float* hv = scr + (32 * (lane >> 5)) * 33 + (lane & 31);
#pragma unroll
    for (int i = 0; i < 32; ++i) v[i] = hv[i * 33];
    fwht32(v);
}
__device__ __forceinline__ void had_tile_amax(const float* src, int ldsrc, int k0, int n0, unsigned* am, LAS float* scr, int lane) {
    float v[32]; had_tile_load(src, ldsrc, k0, n0, scr, lane, v);
    float mx = 0.f;
#pragma unroll
    for (int i = 0; i < 32; ++i) mx = fmaxf(mx, fabsf(v[i]));
    mx = fmaxf(mx, __shfl_xor(mx, 32));
    if (lane < 32) atomicMax(am + n0 + lane, __builtin_bit_cast(unsigned, mx));
    LDS_WAIT(); asm volatile("" ::: "memory");
}
__device__ __forceinline__ void had_tile_quant(const float* src, int ldsrc, int K, int k0, int n0, signed char* dst, const unsigned* am, float* cs, LAS float* scr, int lane) {
    const float amax = fmaxf(__builtin_bit_cast(float, am[n0 + (lane & 31)]), 1e-20f), inv = 127.0f / amax;
    if (k0 == 0 && lane < 32) cs[n0 + lane] = amax * (1.0f / 127.0f);
    float v[32]; had_tile_load(src, ldsrc, k0, n0, scr, lane, v);
    LAS float* hv = scr + (32 * (lane >> 5)) * 33 + (lane & 31);
#pragma unroll
    for (int i = 0; i < 32; ++i) hv[i * 33] = rintf(v[i] * inv);
    LDS_WAIT(); asm volatile("" ::: "memory");
    const int c = lane & 7;
#pragma unroll
    for (int j = 0; j < 4; ++j) { const int n = (lane >> 3) + 8 * j; const LAS float* t = scr + (8 * c) * 33 + n;
        u32x2 o; o.x = pk4_i8(t[0 * 33], t[1 * 33], t[2 * 33], t[3 * 33]); o.y = pk4_i8(t[4 * 33], t[5 * 33], t[6 * 33], t[7 * 33]);
        *(u32x2*)(dst + (size_t)(n0 + n) * K + k0 + 8 * c) = o; }
    LDS_WAIT(); asm volatile("" ::: "memory");
}
#define TR_JOB(SRC, LDSRC, KK, NN, DST, DROW_EXPR) { const int nblk = (NN) / 32, nit = ((KK) / 64) * nblk; \
    if (r < nit) { const int kb = r / nblk, nb = r % nblk, n0 = 32 * nb; tr_item((SRC), (LDSRC), 64 * kb, n0, (DST), (KK), (DROW_EXPR), scr, F.lane); continue; } r -= nit; }
#define TR_JOB8(SRC, LDSRC, KK, NN, DST, DROW_EXPR) { const int nblk = (NN) / 32, nit = ((KK) / 64) * nblk; \
    if (r < nit) { const int kb = r / nblk, nb = r % nblk, n0 = 32 * nb; tr_item8((SRC), (LDSRC), 64 * kb, n0, (DST), (KK), (DROW_EXPR), scr, F.lane); continue; } r -= nit; }

__device__ __forceinline__ void p0_prologue(Frame& F) {
    const int tid_ = opaque(F.tid);
    LAS float* scr = (LAS float*)(F.lds + F.wave * 8448);
    const float* w_in = F.in_WIN;
    bf16_t* WCAT = wsp<bf16_t>(F, WS_WCAT); signed char* W8 = wsp<signed char>(F, WS_W8); signed char* WV8 = wsp<signed char>(F, WS_WVT); signed char* WGU8 = wsp<signed char>(F, WS_WGU);
    float* CS = wsp<float>(F, WS_CS);
    constexpr int NSM = 64;
    constexpr int IT_SM = 2 * 4;
    constexpr int S_Q = NAW / 32, S_M = 2 * D / 32, S_F = DFF / 32;
    constexpr int NSTRIP = 3 * S_Q + S_M + 2 * S_F;
    constexpr int N_AMAX = (DFF / 64) * (D / 32);
    constexpr int N_BIG = 2 * (D / 64) * (NAW / 32) + 2 * (NAW / 64) * (D / 32) + (D / 64) * (D / 32) + N_AMAX;
    constexpr int NITEMS = N_BIG + NSM * IT_SM;
    for (int it = F.gw; it < NSTRIP + NITEMS; it += F.ngw) {
        if (it < NSTRIP) {
            int q = it; const float* src; int ld, n0, drow0; signed char* dst; float* cs;
            if (q < S_Q) { src = w_in; ld = INW; n0 = 32 * q; dst = W8; drow0 = n0; cs = CS + CS_QKM; }
            else if ((q -= S_Q) < S_Q) { src = w_in + NAW; ld = INW; n0 = 32 * q; dst = W8; drow0 = 2048 + n0; cs = CS + CS_QKM; }
            else if ((q -= S_Q) < S_M) { src = F.in_WM; ld = 2 * D; n0 = 32 * q; dst = W8; drow0 = 4096 + n0; cs = CS + CS_QKM; }
            else if ((q -= S_M) < S_Q) { src = w_in + 2 * NAW; ld = INW; n0 = 32 * q; dst = WV8; drow0 = n0; cs = CS + CS_V; }
            else if ((q -= S_Q) < S_F) { src = F.in_WFG; ld = DFF; n0 = 32 * q; dst = WGU8; drow0 = (n0 >> 7) * 256 + (n0 & 127); cs = CS + CS_GU; }
            else { q -= S_F; src = F.in_WFU; ld = DFF; n0 = 32 * q; dst = WGU8; drow0 = (n0 >> 7) * 256 + 128 + (n0 & 127); cs = CS + CS_GU; }
            tr_strip_i8(src, ld, D, n0, dst, drow0, cs, scr, F.lane);
            continue;
        }
        int r = it - NSTRIP;
        TR_JOB(w_in + 3 * NAW, INW, D, NAW, WCAT, 0 + n0)
        TR_JOB(w_in + 4 * NAW, INW, D, NAW, WCAT, 2048 + n0)
        TR_JOB(F.in_WNO, D, NAW, D, wsp<bf16_t>(F, WS_WNO), n0)
        TR_JOB(F.in_WLO, D, LW, D, wsp<bf16_t>(F, WS_WLO), n0)
        TR_JOB(F.in_WOUT, D, D, D, wsp<bf16_t>(F, WS_WO), n0)
        if (r < N_AMAX) { had_tile_amax(F.in_WFD, D, 64 * (r / (D / 32)), 32 * (r % (D / 32)), (unsigned*)(F.ws + WS_AM), scr, F.lane); continue; } r -= N_AMAX;
        {
            const int mi = r / IT_SM, ri = r % IT_SM, d = mi >> 5, g = (mi >> 4) & 1, n = mi & 15, kb = ri >> 2, nb = ri & 3;
            const float* src = (g ? F.in_WI : F.in_WR) + (size_t)(d * NBLK + n) * BW * BW;
            tr_item(src, BW, 64 * kb, 32 * nb, wsp<bf16_t>(F, WS_WG) + (size_t)mi * BW * BW, BW, 32 * nb, scr, F.lane);
        }
    }
    LAS f32x4* gl = (LAS f32x4*)(F.lds + 69632);
    for (int i = tid_; i < D / 4; i += NTHR) gl[i] = ((const f32x4*)F.in_GMPRE)[i];
    __syncthreads();
    bf16_t* XN = wsp<bf16_t>(F, WS_XN); signed char* XN8 = wsp<signed char>(F, WS_XN8); float* RS1 = wsp<float>(F, WS_RS1);
    for (int m = F.gw; m < L; m += F.ngw) {
        asm volatile("" ::: "memory");
        const f32x4* xr = (const f32x4*)xrow(F, m) + F.lane;
        f32x4 v[16]; float s = 0.f;
#pragma unroll
        for (int j = 0; j < 16; ++j) { v[j] = xr[64 * j]; s += (v[j].x * v[j].x + v[j].y * v[j].y) + (v[j].z * v[j].z + v[j].w * v[j].w); }
        const float rstd = 1.0f / sqrtf(wave_sum(s) * (1.0f / D) + EPS);
        u32x2* o8 = (u32x2*)(XN + (size_t)m * D) + F.lane; unsigned* o4 = (unsigned*)(XN8 + (size_t)m * D) + F.lane;
        float mx = 0.f;
#pragma unroll
        for (int j = 0; j < 16; ++j) { v[j] = v[j] * rstd * gl[F.lane + 64 * j]; mx = fmaxf(fmaxf(mx, fmaxf(fabsf(v[j].x), fabsf(v[j].y))), fmaxf(fabsf(v[j].z), fabsf(v[j].w))); }
        const float amax = fmaxf(wave_max(mx), 1e-20f), inv = 127.0f / amax;
        if (F.lane == 0) RS1[m] = amax * (1.0f / 127.0f);
#pragma unroll
        for (int j = 0; j < 16; ++j) { const f32x4 y = v[j]; u32x2 o; o.x = pk2(y.x, y.y); o.y = pk2(y.z, y.w); o8[64 * j] = o;
            o4[64 * j] = pk4_i8(rintf(y.x * inv), rintf(y.y * inv), rintf(y.z * inv), rintf(y.w * inv)); }
    }
    __syncthreads();
}

#ifndef ATT_SYNC
#define ATT_SYNC 1
#endif
template <int ADBG = 0> __device__ __forceinline__ void attn_mfma(Frame& F) {
    const int tid_ = opaque(F.tid);
    bf16_t* Q = wsp<bf16_t>(F, WS_Q); const bf16_t* Kb = wsp<bf16_t>(F, WS_K); const bf16_t* VT = wsp<bf16_t>(F, WS_VT);
    LAS float* rp = (LAS float*)F.lds;
    for (int i = tid_; i < NH * 15 * 31; i += NTHR) rp[i] = F.in_RPB[i];
    __syncthreads();
    const int fr = F.lane & 15, fq = F.lane >> 4;
    const float scale = 0.08838834764831845f;
    for (int base = blockIdx.x * NWAVES; base < (L / GRIDW) * NH * 4; base += F.ngw) {
        const int item = base + F.wave;
        asm volatile("" ::: "memory");
        const int g = item & 3, h = (item >> 2) & 15, rg = item >> 6;
        const int s0 = rg < LP / GRIDW ? 0 : LP, rows = rg < LP / GRIDW ? LP / GRIDW : LS / GRIDW, r = rg < LP / GRIDW ? rg : rg - LP / GRIDW;
        int rs = r - 4; rs = rs < 0 ? 0 : (rs > rows - 8 ? rows - 8 : rs);
        const int w0 = g == 0 ? 0 : (g == 1 ? 8 : (g == 2 ? 24 : 32));
        const int c = 16 * g + fr;
        int cs = c - 8; cs = cs < 0 ? 0 : (cs > GRIDW - 16 ? GRIDW - 16 : cs);
        bf16_t* qrow = Q + (size_t)(s0 + r * GRIDW + c) * NAW + h * HD;
        bf16x8 qf[4];
#pragma unroll
        for (int s = 0; s < 4; ++s) qf[s] = *(const bf16x8*)(qrow + 8 * fq + 32 * s);
        f32x4 sacc[8][2];
        const int Rg = s0 / GRIDW + rs, p0 = w0 >> 3;
        const bf16_t* kbase = Kb + (size_t)(Rg * 16 + h) * 8192 + p0 * 128 + fr * 32 + fq * 8;
        bf16x8 kb[8][2][4];
#define ATT_LDK(kr) do { _Pragma("unroll") for (int T = 0; T < 2; ++T) _Pragma("unroll") for (int s = 0; s < 4; ++s) kb[kr][T][s] = (ADBG & 1) ? qf[s] : (ADBG & 4) ? *(const bf16x8*)(Kb + (size_t)(s0 + rs * GRIDW) * NAW + h * HD * GRIDW + ((kr) * 8 + T * 4 + s) * 512 + F.lane * 8) : *(const bf16x8*)(kbase + (size_t)(kr) * (16 * 8192) + (s * 2 + T) * 1024); } while (0)
        ATT_LDK(0); ATT_LDK(1);
#pragma unroll
        for (int kr = 0; kr < 8; ++kr) {
            if (ATT_SYNC && (kr & 1) == 0) __builtin_amdgcn_s_barrier();
            if (kr + 2 < 8) ATT_LDK(kr + 2);
            __builtin_amdgcn_sched_barrier(0);
#pragma unroll
            for (int T = 0; T < 2; ++T) { f32x4 a = (f32x4){0.f, 0.f, 0.f, 0.f};
#pragma unroll
                for (int s = 0; s < 4; ++s) a = __builtin_amdgcn_mfma_f32_16x16x32_bf16(kb[kr][T][s], qf[s], a, 0, 0, 0);
                sacc[kr][T] = a; }
            __builtin_amdgcn_sched_barrier(0);
        }
#undef ATT_LDK
        bf16x8 vb[8][8];
        const bf16_t* vbase = VT + (size_t)(Rg * 16 + h) * 8192 + p0 * 128 + fq * 128 + fr * 8;
#define ATT_LDV(kr) do { _Pragma("unroll") for (int dt = 0; dt < 8; ++dt) vb[kr][dt] = (ADBG & 2) ? qf[dt & 3] : (ADBG & 4) ? *(const bf16x8*)(VT + (size_t)(h * HD) * L + s0 + rs * GRIDW + ((kr) * 8 + dt) * 512 + F.lane * 8) : *(const bf16x8*)(vbase + (size_t)(kr) * (16 * 8192) + dt * 1024); } while (0)
        ATT_LDV(0); ATT_LDV(1);
        __builtin_amdgcn_sched_barrier(0);
        const int elo = cs - w0 - 8 * fq, dc0 = w0 + 8 * fq - c + 15;
        const LAS float* rph = rp + h * 465 + (rs - r + 7) * 31;
        float mx = -3.0e38f;
#pragma unroll
        for (int e = 0; e < 8; ++e) { const bool valid = (e >= elo) && (e < elo + 16); const int bi = valid ? dc0 + e : 0;
#pragma unroll
            for (int kr = 0; kr < 8; ++kr) { const float sv = valid ? sacc[kr][e >> 2][e & 3] * scale + rph[kr * 31 + bi] : -3.0e38f; sacc[kr][e >> 2][e & 3] = sv; mx = fmaxf(mx, sv); } }
        mx = fmaxf(mx, __shfl_xor(mx, 16)); mx = fmaxf(mx, __shfl_xor(mx, 32));
        float lsum = 0.f; bf16x8 pf[8];
#pragma unroll
        for (int kr = 0; kr < 8; ++kr) { float p[8];
#pragma unroll
            for (int e = 0; e < 8; ++e) { p[e] = __expf(sacc[kr][e >> 2][e & 3] - mx); lsum += p[e]; }
            u32x4 w; w.x = pk2(p[0], p[1]); w.y = pk2(p[2], p[3]); w.z = pk2(p[4], p[5]); w.w = pk2(p[6], p[7]);
            pf[kr] = __builtin_bit_cast(bf16x8, w); }
        lsum += __shfl_xor(lsum, 16); lsum += __shfl_xor(lsum, 32);
        f32x4 oacc[8];
#pragma unroll
        for (int dt = 0; dt < 8; ++dt) oacc[dt] = (f32x4){0.f, 0.f, 0.f, 0.f};
#pragma unroll
        for (int kr = 0; kr < 8; ++kr) {
            if (ATT_SYNC && (kr & 1) == 0) __builtin_amdgcn_s_barrier();
            if (kr + 2 < 8) ATT_LDV(kr + 2);
            __builtin_amdgcn_sched_barrier(0);
#pragma unroll
            for (int dt = 0; dt < 8; ++dt) oacc[dt] = __builtin_amdgcn_mfma_f32_16x16x32_bf16(vb[kr][dt], pf[kr], oacc[dt], 0, 0, 0);
            __builtin_amdgcn_sched_barrier(0);
        }
#undef ATT_LDV
        const float inv = 1.0f / lsum;
#ifdef ATTN_OUT_OFF
        bf16_t* orow = wsp<bf16_t>(F, (size_t)ATTN_OUT_OFF * MiB) + (size_t)(s0 + r * GRIDW + c) * NAW + h * HD;
#else
        bf16_t* orow = qrow;
#endif
#pragma unroll
        for (int u = 0; u < 4; ++u) *(u32x4*)(orow + 32 * u + 8 * fq) = pg8::pack8(oacc[2 * u] * inv, oacc[2 * u + 1] * inv);
    }
    __syncthreads();
}

__device__ __forceinline__ void attn_mfma_lds(Frame& F) {
    const int tid_ = opaque(F.tid);
    bf16_t* Q = wsp<bf16_t>(F, WS_Q); const bf16_t* Kb = wsp<bf16_t>(F, WS_K); const bf16_t* VT = wsp<bf16_t>(F, WS_VT);
    LAS float* rp = (LAS float*)F.lds;
    LAS unsigned char* ring = F.lds + 30720;
    for (int i = tid_; i < NH * 15 * 31; i += NTHR) rp[i] = F.in_RPB[i];
    __syncthreads();
    const int lane = tid_ & 63, fr = lane & 15, fq = lane >> 4, w = F.wave, hl = w >> 2, g = w & 3;
    const float scale = 0.08838834764831845f;
    constexpr int NIT = (L / GRIDW) * NH * 4;
    const int w0 = g == 0 ? 0 : (g == 1 ? 8 : (g == 2 ? 24 : 32)), p0 = w0 >> 3;
    const int c = 16 * g + fr;
    int cs = c - 8; cs = cs < 0 ? 0 : (cs > GRIDW - 16 ? GRIDW - 16 : cs);
#define ATL_SRC(b, st) ([&]() -> const bf16_t* { const int rg_ = (b) >> 6, hb_ = ((b) >> 2) & 15; const int rows_ = rg_ < LP / GRIDW ? LP / GRIDW : LS / GRIDW, r_ = rg_ < LP / GRIDW ? rg_ : rg_ - LP / GRIDW; \
        int rs_ = r_ - 4; rs_ = rs_ < 0 ? 0 : (rs_ > rows_ - 8 ? rows_ - 8 : rs_); const int Rg_ = (rg_ < LP / GRIDW ? 0 : LP / GRIDW) + rs_; \
        return ((st) < 8 ? Kb : VT) + (size_t)((Rg_ + ((st) & 7)) * 16 + hb_) * 8192; }())
#define ATL_ISSUE(src, slot) do { const bf16_t* s_ = (src) + tid_ * 8; LAS unsigned char* d_ = ring + (slot) * 32768 + w * 1024; _Pragma("unroll") for (int k_ = 0; k_ < 4; ++k_) \
        __builtin_amdgcn_global_load_lds((const unsigned*)(s_ + k_ * 4096), (LAS unsigned*)(d_ + k_ * 8192), 16, 0, 0); } while (0)
    int base = blockIdx.x * NWAVES;
    if (base < NIT) { ATL_ISSUE(ATL_SRC(base, 0), 0); ATL_ISSUE(ATL_SRC(base, 1), 1); }
    int b0 = 0;
    for (; base < NIT; base += F.ngw) {
        asm volatile("" ::: "memory");
        const int h = ((base >> 2) & 15) + hl, rg = base >> 6;
        const int s0 = rg < LP / GRIDW ? 0 : LP, rows = rg < LP / GRIDW ? LP / GRIDW : LS / GRIDW, r = rg < LP / GRIDW ? rg : rg - LP / GRIDW;
        int rs = r - 4; rs = rs < 0 ? 0 : (rs > rows - 8 ? rows - 8 : rs);
        const int nbase = base + F.ngw < NIT ? base + F.ngw : base;
        bf16_t* qrow = Q + (size_t)(s0 + r * GRIDW + c) * NAW + h * HD;
        bf16x8 qf[4];
#pragma unroll
        for (int s = 0; s < 4; ++s) qf[s] = *(const bf16x8*)(qrow + 8 * fq + 32 * s);
        f32x4 sacc[8][2]; f32x4 oacc[8]; bf16x8 pf[8]; float lsum = 0.f;
#pragma unroll
        for (int dt = 0; dt < 8; ++dt) oacc[dt] = (f32x4){0.f, 0.f, 0.f, 0.f};
        const int koff = hl * 16384 + (p0 * 128 + fr * 32 + fq * 8) * 2, voff = hl * 16384 + (p0 * 128 + fq * 128 + fr * 8) * 2;
#pragma unroll
        for (int st = 0; st < 16; ++st) {
            asm volatile("s_waitcnt vmcnt(4)" ::: "memory"); asm volatile("s_waitcnt lgkmcnt(0)" ::: "memory"); __builtin_amdgcn_s_barrier(); asm volatile("" ::: "memory");
            { const int slot2 = (b0 + st + 2) % 3; if (st + 2 < 16) ATL_ISSUE(ATL_SRC(base, st + 2), slot2); else ATL_ISSUE(ATL_SRC(nbase, st + 2 - 16), slot2); }
            const LAS unsigned char* buf = ring + ((b0 + st) % 3) * 32768;
            if (st < 8) {
#pragma unroll
                for (int T = 0; T < 2; ++T) { f32x4 a = (f32x4){0.f, 0.f, 0.f, 0.f};
#pragma unroll
                    for (int s2 = 0; s2 < 4; ++s2) a = __builtin_amdgcn_mfma_f32_16x16x32_bf16(*(const LAS bf16x8*)(buf + koff + (s2 * 2 + T) * 2048), qf[s2], a, 0, 0, 0);
                    sacc[st][T] = a; }
            } else {
                if (st == 8) {
                    const int elo = cs - w0 - 8 * fq, dc0 = w0 + 8 * fq - c + 15;
                    const LAS float* rph = rp + h * 465 + (rs - r + 7) * 31;
                    float mx = -3.0e38f;
#pragma unroll
                    for (int e = 0; e < 8; ++e) { const bool valid = (e >= elo) && (e < elo + 16); const int bi = valid ? dc0 + e : 0;
#pragma unroll
                        for (int kr = 0; kr < 8; ++kr) { const float sv = valid ? sacc[kr][e >> 2][e & 3] * scale + rph[kr * 31 + bi] : -3.0e38f; sacc[kr][e >> 2][e & 3] = sv; mx = fmaxf(mx, sv); } }
                    mx = fmaxf(mx, __shfl_xor(mx, 16)); mx = fmaxf(mx, __shfl_xor(mx, 32));
#pragma unroll
                    for (int kr = 0; kr < 8; ++kr) { float p[8];
#pragma unroll
                        for (int e = 0; e < 8; ++e) { p[e] = __expf(sacc[kr][e >> 2][e & 3] - mx); lsum += p[e]; }
                        u32x4 wv; wv.x = pk2(p[0], p[1]); wv.y = pk2(p[2], p[3]); wv.z = pk2(p[4], p[5]); wv.w = pk2(p[6], p[7]);
                        pf[kr] = __builtin_bit_cast(bf16x8, wv); }
                    lsum += __shfl_xor(lsum, 16); lsum += __shfl_xor(lsum, 32);
                }
#pragma unroll
                for (int dt = 0; dt < 8; ++dt) oacc[dt] = __builtin_amdgcn_mfma_f32_16x16x32_bf16(*(const LAS bf16x8*)(buf + voff + dt * 2048), pf[st - 8], oacc[dt], 0, 0, 0);
            }
        }
        b0 = (b0 + 16) % 3;
        const float inv = 1.0f / lsum;
#pragma unroll
        for (int u = 0; u < 4; ++u) *(u32x4*)(qrow + 32 * u + 8 * fq) = pg8::pack8(oacc[2 * u] * inv, oacc[2 * u + 1] * inv);
    }
#undef ATL_SRC
#undef ATL_ISSUE
    asm volatile("s_waitcnt vmcnt(0)" ::: "memory");
    __syncthreads();
}

__device__ __forceinline__ void conv_phase(Frame& F) {
    const int tid_ = opaque(F.tid);
    const bf16_t* XR = wsp<bf16_t>(F, WS_XR); bf16_t* XC = wsp<bf16_t>(F, WS_XC);
    const float* wc = F.in_WCONV; const float* bc = F.in_BCONV;
    const int nth = F.G * NTHR;
    for (int it = blockIdx.x * NTHR + tid_; it < L * (LW / 8); it += nth) {
        const int t = it / (LW / 8), c0 = (it % (LW / 8)) * 8;
        const int s0 = t < LP ? 0 : LP, len = t < LP ? LP : LS, tl = t - s0;
        float acc[8];
#pragma unroll
        for (int e = 0; e < 8; ++e) acc[e] = bc[c0 + e];
#pragma unroll
        for (int j = 0; j < 4; ++j) { const int tt = tl + j - 2; if (tt < 0 || tt >= len) continue;
            f32x4 x0, x1; pg8::unpack8(*(const u32x4*)(XR + (size_t)(s0 + tt) * LW + c0), x0, x1);
            const f32x4 w0 = *(const f32x4*)(wc + j * LW + c0), w1 = *(const f32x4*)(wc + j * LW + c0 + 4);
#pragma unroll
            for (int e = 0; e < 4; ++e) { acc[e] += w0[e] * x0[e]; acc[4 + e] += w1[e] * x1[e]; } }
        *(u32x4*)(XC + (size_t)t * LW + c0) = pg8::pack8((f32x4){acc[0], acc[1], acc[2], acc[3]}, (f32x4){acc[4], acc[5], acc[6], acc[7]});
    }
}

struct LruW { bf16x8 w[2][4]; float br, bi, cl; };
template <int DIR> __device__ __forceinline__ void lru_load_w(const Frame& F, LruW& W, int n, int w, int fr, int fq) {
    const bf16_t* wg = wsp<bf16_t>(F, WS_WG);
#pragma unroll
    for (int g = 0; g < 2; ++g)
#pragma unroll
        for (int s = 0; s < 4; ++s) W.w[g][s] = *(const bf16x8*)(wg + ((size_t)((DIR * 2 + g) * NBLK + n) * BW + 16 * w + fr) * BW + 32 * fq + 8 * s);
    const int ch = n * BW + 16 * w + fr;
    W.br = F.in_BR[DIR * LW + ch]; W.bi = F.in_BI[DIR * LW + ch];
    const float lam = F.in_LAM[DIR * LW + ch];
    W.cl = -8.0f * ((lam > 15.f) ? __expf(-lam) : log1pf(__expf(-lam)));
}
template <int LDBG = 0> __device__ __forceinline__ void lru_gate(float pr, float pi, float xc, const LruW& W, bool first, float& a, float& u) {
    if constexpr (LDBG == 1) { a = pr + W.br; u = pi * xc + W.bi; return; }
    const float r = sigmoidf_(pr + W.br), ig = sigmoidf_(pi + W.bi);
    a = __expf(W.cl * r);
    const float mult = first ? 1.0f : __builtin_amdgcn_sqrtf(fmaxf(1.0f - a * a, 0.f));
    u = mult * ig * xc;
}
struct LruX { bf16x8 x[4][4]; };
__device__ __forceinline__ void lru_load_x(LruX& X, const bf16_t* XC, int tb, int n, int fr, int fq) {
#pragma unroll
    for (int tau = 0; tau < 4; ++tau) { const bf16_t* xp = XC + ((size_t)((((tb >> 6) * NBLK + n) * 4 + tau) * 4) * 64 + fr * 4 + fq) * 8;
#pragma unroll
        for (int s = 0; s < 4; ++s) X.x[tau][s] = *(const bf16x8*)(xp + s * 512); }
}
__device__ __forceinline__ void lru_tile(const LruX& X, int tau, bool hiw, const LruW& W, const bf16x8 idf0, const bf16x8 idf1, f32x4& pr, f32x4& pi, f32x4& xct) {
    pr = (f32x4){0.f, 0.f, 0.f, 0.f}; pi = pr;
#pragma unroll
    for (int s = 0; s < 4; ++s) { pr = __builtin_amdgcn_mfma_f32_16x16x32_bf16(X.x[tau][s], W.w[0][s], pr, 0, 0, 0); pi = __builtin_amdgcn_mfma_f32_16x16x32_bf16(X.x[tau][s], W.w[1][s], pi, 0, 0, 0); }
    const bf16x8 x0 = hiw ? X.x[tau][2] : X.x[tau][0], x1 = hiw ? X.x[tau][3] : X.x[tau][1];
    xct = __builtin_amdgcn_mfma_f32_16x16x32_bf16(x0, idf0, (f32x4){0.f, 0.f, 0.f, 0.f}, 0, 0, 0);
    xct = __builtin_amdgcn_mfma_f32_16x16x32_bf16(x1, idf1, xct, 0, 0, 0);
}
__device__ __forceinline__ void lru_idfrags(int w, int fr, int fq, bf16x8& idf0, bf16x8& idf1) {
#pragma unroll
    for (int e = 0; e < 8; ++e) { const bool on = (fq == (w >> 1)) && ((fr & 7) == e); idf0[e] = (on && fr < 8) ? (short)0x3F80 : (short)0; idf1[e] = (on && fr >= 8) ? (short)0x3F80 : (short)0; }
}
constexpr int LRU_CH = 256, LRU_NCH = L / LRU_CH, LRU_NCH_P = LP / LRU_CH;
__device__ __forceinline__ void conv_unit(Frame& F, int cg, int n) {
    const int tid_ = opaque(F.tid);
    const bf16_t* XR = wsp<bf16_t>(F, WS_XR); bf16_t* XC = wsp<bf16_t>(F, WS_XC);
    const float* wc = F.in_WCONV; const float* bc = F.in_BCONV;
    const int c0 = n * BW + (tid_ & 15) * 8;
    const int s0 = cg < LRU_NCH_P ? 0 : LP, len = cg < LRU_NCH_P ? LP : LS;
    f32x4 w[4][2]; f32x4 b0 = *(const f32x4*)(bc + c0), b1 = *(const f32x4*)(bc + c0 + 4);
#pragma unroll
    for (int j = 0; j < 4; ++j) { w[j][0] = *(const f32x4*)(wc + j * LW + c0); w[j][1] = *(const f32x4*)(wc + j * LW + c0 + 4); }
#pragma unroll
    for (int i = 0; i < 8; ++i) {
        const int t = cg * LRU_CH + (tid_ >> 4) + 32 * i, tl = t - s0;
        f32x4 a0 = b0, a1 = b1;
#pragma unroll
        for (int j = 0; j < 4; ++j) { const int tt = tl + j - 2; if (tt < 0 || tt >= len) continue;
            f32x4 x0, x1; pg8::unpack8(*(const u32x4*)(XR + (size_t)(s0 + tt) * LW + c0), x0, x1); a0 += w[j][0] * x0; a1 += w[j][1] * x1; }
        const int tg = t & 63, cq = tid_ & 15;
        *(u32x4*)(XC + ((size_t)(((((t >> 6) * NBLK + n) * 4 + ((tg >> 2) & 3)) * 4 + (cq & 3)) * 16 + 4 * (tg >> 4) + (tg & 3)) * 4 + (cq >> 2)) * 8) = pg8::pack8(a0, a1);
    }
}
__device__ __forceinline__ void lru_pass_a(Frame& F) {
    const int fr = F.lane & 15, fq = F.lane >> 4, w = F.wave;
    const bf16_t* XC = wsp<bf16_t>(F, WS_XC); f32x2* SUMM = wsp<f32x2>(F, WS_SUM);
    bf16x8 idf0, idf1; lru_idfrags(w, fr, fq, idf0, idf1);
    for (int u = blockIdx.x; u < LRU_NCH * NBLK; u += F.G) {
        const int cg = u >> 4, n = u & 15;
        conv_unit(F, cg, n); VM_WAIT(); __syncthreads();
        LruW Wf, Wb; lru_load_w<0>(F, Wf, n, w, fr, fq); lru_load_w<1>(F, Wb, n, w, fr, fq);
        const bool c_first = (cg == 0 || cg == LRU_NCH_P), c_last = (cg == LRU_NCH_P - 1 || cg == LRU_NCH - 1);
        float Af = 1.f, Hf = 0.f, Ab = 1.f, Hb = 0.f;
        LruX X, Xn; lru_load_x(X, XC, cg * LRU_CH, n, fr, fq);
        for (int gi = 0; gi < 4; ++gi) {
            if (gi < 3) lru_load_x(Xn, XC, cg * LRU_CH + (gi + 1) * 64, n, fr, fq);
            float pf = 1.f, hf = 0.f, pb = 1.f, hb = 0.f;
#pragma unroll
            for (int tau = 0; tau < 4; ++tau) {
                f32x4 prf, pif, prb, pib, xct, xct2;
                lru_tile(X, tau, (w & 1) != 0, Wf, idf0, idf1, prf, pif, xct);
                lru_tile(X, tau, (w & 1) != 0, Wb, idf0, idf1, prb, pib, xct2);
#pragma unroll
                for (int j = 0; j < 4; ++j) {
                    float a, uu;
                    lru_gate(prf[j], pif[j], xct[j], Wf, c_first && gi == 0 && fq == 0 && tau == 0 && j == 0, a, uu); hf = a * hf + uu; pf *= a;
                    lru_gate(prb[j], pib[j], xct[j], Wb, c_last && gi == 3 && fq == 3 && tau == 3 && j == 3, a, uu); hb += pb * uu; pb *= a;
                }
            }
            float gPf = 1.f, gHf = 0.f, gPb = 1.f, gHb = 0.f;
#pragma unroll
            for (int qq = 0; qq < 4; ++qq) { const int src = fr + 16 * qq;
                float P = __shfl(pf, src), H = __shfl(hf, src); gHf = P * gHf + H; gPf *= P;
                P = __shfl(pb, src); H = __shfl(hb, src); gHb += gPb * H; gPb *= P; }
            Hf = gPf * Hf + gHf; Af *= gPf; Hb += Ab * gHb; Ab *= gPb;
            X = Xn;
        }
        if (fq == 0) { const int ch = n * BW + 16 * w + fr; SUMM[(size_t)(cg * 2 + 0) * LW + ch] = (f32x2){Af, Hf}; SUMM[(size_t)(cg * 2 + 1) * LW + ch] = (f32x2){Ab, Hb}; }
    }
}
__device__ __forceinline__ void lru_pass_b(Frame& F) {
    const int tid_ = opaque(F.tid);
    const int gt = blockIdx.x * NTHR + tid_; if (gt >= 4 * LW) return;
    const int ch = gt % LW, d = (gt / LW) & 1, seq = gt / (2 * LW), c0 = seq ? LRU_NCH_P : 0, nc = seq ? LRU_NCH - LRU_NCH_P : LRU_NCH_P;
    const f32x2* SUMM = wsp<f32x2>(F, WS_SUM); float* CIN = wsp<float>(F, WS_SUM + 4 * MiB);
    float s = 0.f;
    for (int i0 = 0; i0 < nc; i0 += 8) {
        f32x2 ah[8];
#pragma unroll
        for (int e = 0; e < 8; ++e) { const int cg = d ? c0 + nc - 1 - (i0 + e) : c0 + i0 + e; ah[e] = SUMM[(size_t)(cg * 2 + d) * LW + ch]; }
#pragma unroll
        for (int e = 0; e < 8; ++e) { const int cg = d ? c0 + nc - 1 - (i0 + e) : c0 + i0 + e; CIN[(size_t)(cg * 2 + d) * LW + ch] = s; s = ah[e].x * s + ah[e].y; }
    }
}
template <int LDBG = 0> __device__ __forceinline__ void lru_pass_c(Frame& F) {
    const int tid_ = opaque(F.tid);
    const int fr = F.lane & 15, fq = F.lane >> 4, w = F.wave;
    const bf16_t* XC = wsp<bf16_t>(F, WS_XC); const float* CIN = wsp<float>(F, WS_SUM + 4 * MiB);
    const bf16_t* GR = wsp<bf16_t>(F, WS_GR); bf16_t* LRU = wsp<bf16_t>(F, WS_XR);
    LAS bf16_t* hfb = (LAS bf16_t*)(F.lds + w * 8192);
    LAS bf16_t* grt = (LAS bf16_t*)(F.lds + 65536);
    bf16x8 idf0, idf1; lru_idfrags(w, fr, fq, idf0, idf1);
    for (int u = blockIdx.x; u < LRU_NCH * NBLK; u += F.G) {
        const int cg = u >> 4, n = u & 15, ch = n * BW + 16 * w + fr;
        const bool c_first = (cg == 0 || cg == LRU_NCH_P), c_last = (cg == LRU_NCH_P - 1 || cg == LRU_NCH - 1);
        { const bf16_t* gsrc = GR + (size_t)(cg * LRU_CH + (tid_ >> 4)) * LW + n * BW + (tid_ & 15) * 8; LAS bf16_t* ldst = grt + w * 512;
#pragma unroll 1
          for (int k = 0; k < 8; ++k) { __builtin_amdgcn_global_load_lds((const unsigned*)gsrc, (LAS unsigned*)ldst, 16, 0, 0); gsrc += (size_t)32 * LW; ldst += NTHR * 8; } }
        {
            LruW W; lru_load_w<0>(F, W, n, w, fr, fq);
            float s = CIN[(size_t)(cg * 2 + 0) * LW + ch];
            LruX X, Xn; lru_load_x(X, XC, cg * LRU_CH, n, fr, fq);
            for (int gi = 0; gi < 4; ++gi) {
                if (gi < 3 && LDBG != 2) lru_load_x(Xn, XC, cg * LRU_CH + (gi + 1) * 64, n, fr, fq);
                float a[16], uu[16];
#pragma unroll
                for (int tau = 0; tau < 4; ++tau) { f32x4 pr, pi, xct; lru_tile(X, tau, (w & 1) != 0, W, idf0, idf1, pr, pi, xct);
#pragma unroll
                    for (int j = 0; j < 4; ++j) lru_gate<LDBG>(pr[j], pi[j], xct[j], W, c_first && gi == 0 && fq == 0 && tau == 0 && j == 0, a[4 * tau + j], uu[4 * tau + j]); }
                float p = 1.f, h = 0.f;
#pragma unroll
                for (int t = 0; t < 16; ++t) { h = a[t] * h + uu[t]; p *= a[t]; }
                float hin = s, sg = s;
#pragma unroll
                for (int qq = 0; qq < 4; ++qq) { const float P = __shfl(p, fr + 16 * qq), H = __shfl(h, fr + 16 * qq); sg = P * sg + H; if (qq < fq) hin = P * hin + H; }
                s = sg;
                float hh = hin;
#pragma unroll
                for (int t = 0; t < 16; ++t) { hh = a[t] * hh + uu[t]; hfb[(gi * 64 + 16 * fq + t) * 16 + fr] = (bf16_t)f2bf(hh); }
                X = Xn;
            }
        }
        VM_WAIT(); __syncthreads();
        {
            LruW W; lru_load_w<1>(F, W, n, w, fr, fq);
            float s = CIN[(size_t)(cg * 2 + 1) * LW + ch];
            LruX X, Xn; lru_load_x(X, XC, cg * LRU_CH + 3 * 64, n, fr, fq);
            for (int gi = 3; gi >= 0; --gi) {
                if (gi > 0 && LDBG != 2) lru_load_x(Xn, XC, cg * LRU_CH + (gi - 1) * 64, n, fr, fq);
                float a[16], uu[16];
#pragma unroll
                for (int tau = 0; tau < 4; ++tau) { f32x4 pr, pi, xct; lru_tile(X, tau, (w & 1) != 0, W, idf0, idf1, pr, pi, xct);
#pragma unroll
                    for (int j = 0; j < 4; ++j) lru_gate<LDBG>(pr[j], pi[j], xct[j], W, c_last && gi == 3 && fq == 3 && tau == 3 && j == 3, a[4 * tau + j], uu[4 * tau + j]); }
                float p = 1.f, h = 0.f;
#pragma unroll
                for (int t = 15; t >= 0; --t) { h = a[t] * h + uu[t]; p *= a[t]; }
                float hin = s, sg = s;
#pragma unroll
                for (int qq = 3; qq >= 0; --qq) { const float P = __shfl(p, fr + 16 * qq), H = __shfl(h, fr + 16 * qq); sg = P * sg + H; if (qq > fq) hin = P * hin + H; }
                s = sg;
                float hh = hin;
#pragma unroll
                for (int t = 15; t >= 0; --t) { hh = a[t] * hh + uu[t];
                    const int tl = gi * 64 + 16 * fq + t; LAS bf16_t* gp = grt + tl * BW + 16 * w + fr;
                    *gp = (bf16_t)f2bf((bf1(hfb[tl * 16 + fr]) + hh) * gelu_tanh(bf1(*gp))); }
                X = Xn;
            }
        }
        LDS_WAIT(); __syncthreads();
        { bf16_t* gdst = LRU + (size_t)(cg * LRU_CH + (tid_ >> 4)) * LW + n * BW + (tid_ & 15) * 8; const LAS bf16_t* lsrc = grt + tid_ * 8;
#pragma unroll 1
          for (int k = 0; k < 8; ++k) { *(u32x4*)gdst = *(const LAS u32x4*)lsrc; gdst += (size_t)32 * LW; lsrc += NTHR * 8; } }
        LDS_WAIT(); __syncthreads();
    }
}

__device__ __forceinline__ void hq_phase(Frame& F) {
    const int lane = opaque(F.tid) & 63;
    const bf16_t* H0 = (const bf16_t*)F.out; const bf16_t* H1 = wsp<bf16_t>(F, WS_HIDS);
    signed char* Q0 = wsp<signed char>(F, WS_H8P); signed char* Q1 = wsp<signed char>(F, WS_H8S); float* RS3 = wsp<float>(F, WS_RS3);
    {
        LAS float* scr = (LAS float*)(F.lds + F.wave * 8448);
        for (int it = F.gw; it < (DFF / 64) * (D / 32); it += F.ngw)
            had_tile_quant(F.in_WFD, D, DFF, 64 * (it / (D / 32)), 32 * (it % (D / 32)), wsp<signed char>(F, WS_WD), (const unsigned*)(F.ws + WS_AM), wsp<float>(F, WS_CS) + CS_D, scr, lane);
    }
    constexpr int NB = DFF / 32;
    for (int m = F.gw; m < L; m += F.ngw) {
        const bf16_t* src = m < LP ? H0 + (size_t)m * DFF : H1 + (size_t)(m - LP) * DFF;
        signed char* dst = m < LP ? Q0 + (size_t)m * DFF : Q1 + (size_t)(m - LP) * DFF;
        u32x4 raw[6][4];
#pragma unroll
        for (int it = 0; it < 6; ++it) { const int b = lane + 64 * it; const u32x4* p = (const u32x4*)(src + (b < NB ? b : lane) * 32);
#pragma unroll
            for (int i = 0; i < 4; ++i) raw[it][i] = p[i]; }
        float mx = 0.f;
#pragma unroll
        for (int it = 0; it < 6; ++it) { float v[32];
#pragma unroll
            for (int i = 0; i < 4; ++i) { const u32x4 u = raw[it][i]; v[8 * i + 0] = bflo(u.x); v[8 * i + 1] = bfhi(u.x); v[8 * i + 2] = bflo(u.y); v[8 * i + 3] = bfhi(u.y); v[8 * i + 4] = bflo(u.z); v[8 * i + 5] = bfhi(u.z); v[8 * i + 6] = bflo(u.w); v[8 * i + 7] = bfhi(u.w); }
            fwht32(v);
            float bm = 0.f;
#pragma unroll
            for (int i = 0; i < 32; ++i) bm = fmaxf(bm, fabsf(v[i]));
            mx = fmaxf(mx, (lane + 64 * it < NB) ? bm : 0.f); }
        const float amax = fmaxf(wave_max(mx), 1e-20f), inv = 127.0f / amax;
        if (lane == 0) RS3[m] = amax * (1.0f / 127.0f);
#pragma unroll
        for (int it = 0; it < 6; ++it) { const int b = lane + 64 * it; float v[32];
#pragma unroll
            for (int i = 0; i < 4; ++i) { const u32x4 u = raw[it][i]; v[8 * i + 0] = bflo(u.x); v[8 * i + 1] = bfhi(u.x); v[8 * i + 2] = bflo(u.y); v[8 * i + 3] = bfhi(u.y); v[8 * i + 4] = bflo(u.z); v[8 * i + 5] = bfhi(u.z); v[8 * i + 6] = bflo(u.w); v[8 * i + 7] = bfhi(u.w); }
            fwht32(v);
            u32x4 o0, o1;
            o0.x = pk4_i8(rintf(v[0] * inv), rintf(v[1] * inv), rintf(v[2] * inv), rintf(v[3] * inv)); o0.y = pk4_i8(rintf(v[4] * inv), rintf(v[5] * inv), rintf(v[6] * inv), rintf(v[7] * inv));
            o0.z = pk4_i8(rintf(v[8] * inv), rintf(v[9] * inv), rintf(v[10] * inv), rintf(v[11] * inv)); o0.w = pk4_i8(rintf(v[12] * inv), rintf(v[13] * inv), rintf(v[14] * inv), rintf(v[15] * inv));
            o1.x = pk4_i8(rintf(v[16] * inv), rintf(v[17] * inv), rintf(v[18] * inv), rintf(v[19] * inv)); o1.y = pk4_i8(rintf(v[20] * inv), rintf(v[21] * inv), rintf(v[22] * inv), rintf(v[23] * inv));
            o1.z = pk4_i8(rintf(v[24] * inv), rintf(v[25] * inv), rintf(v[26] * inv), rintf(v[27] * inv)); o1.w = pk4_i8(rintf(v[28] * inv), rintf(v[29] * inv), rintf(v[30] * inv), rintf(v[31] * inv));
            if (b < NB) { *(u32x4*)(dst + b * 32) = o0; *(u32x4*)(dst + b * 32 + 16) = o1; } }
    }
}

__device__ __forceinline__ f32x4 up4(const u32x2 u) { return (f32x4){bflo(u.x), bfhi(u.x), bflo(u.y), bfhi(u.y)}; }
__device__ __forceinline__ void mid_phase(Frame& F) {
    const int tid_ = opaque(F.tid);
    const bf16_t* MIX = wsp<bf16_t>(F, WS_MIX); signed char* XN8 = wsp<signed char>(F, WS_XN8); float* RSTD = wsp<float>(F, WS_RSTD); float* RS2 = wsp<float>(F, WS_RS2);
    LAS f32x4* gpost = (LAS f32x4*)F.lds; LAS f32x4* gpre = gpost + D / 4;
    for (int i = tid_; i < D / 4; i += NTHR) { gpost[i] = ((const f32x4*)F.in_GMPOST)[i]; gpre[i] = ((const f32x4*)F.in_GFPRE)[i]; }
    __syncthreads();
    for (int m = F.gw; m < L; m += F.ngw) {
        asm volatile("" ::: "memory");
        const f32x4* xr = (const f32x4*)xrow(F, m) + F.lane; const u32x2* mr = (const u32x2*)(MIX + (size_t)m * D) + F.lane;
        f32x4 v[16]; u32x2 mx[16]; float s = 0.f;
#pragma unroll
        for (int j = 0; j < 16; ++j) { v[j] = xr[64 * j]; mx[j] = mr[64 * j]; const f32x4 a = up4(mx[j]); s += (a.x * a.x + a.y * a.y) + (a.z * a.z + a.w * a.w); }
        const float rstd1 = 1.0f / sqrtf(wave_sum(s) * (1.0f / D) + EPS);
        if (F.lane == 0) RSTD[m] = rstd1;
        float s2 = 0.f;
#pragma unroll
        for (int j = 0; j < 16; ++j) { v[j] = v[j] + up4(mx[j]) * rstd1 * gpost[F.lane + 64 * j]; s2 += (v[j].x * v[j].x + v[j].y * v[j].y) + (v[j].z * v[j].z + v[j].w * v[j].w); }
        const float rstd2 = 1.0f / sqrtf(wave_sum(s2) * (1.0f / D) + EPS);
        float mx2 = 0.f;
#pragma unroll
        for (int j = 0; j < 16; ++j) { v[j] = v[j] * rstd2 * gpre[F.lane + 64 * j]; mx2 = fmaxf(fmaxf(mx2, fmaxf(fabsf(v[j].x), fabsf(v[j].y))), fmaxf(fabsf(v[j].z), fabsf(v[j].w))); }
        const float amax = fmaxf(wave_max(mx2), 1e-20f), inv = 127.0f / amax;
        if (F.lane == 0) RS2[m] = amax * (1.0f / 127.0f);
        unsigned* o4 = (unsigned*)(XN8 + (size_t)m * D) + F.lane;
#pragma unroll
        for (int j = 0; j < 16; ++j) o4[64 * j] = pk4_i8(rintf(v[j].x * inv), rintf(v[j].y * inv), rintf(v[j].z * inv), rintf(v[j].w * inv));
    }
    __syncthreads();
}
__device__ __forceinline__ void final_phase(Frame& F) {
    const int tid_ = opaque(F.tid);
    const bf16_t* MIX = wsp<bf16_t>(F, WS_MIX); const bf16_t* FB = wsp<bf16_t>(F, WS_F); const float* RSTD = wsp<float>(F, WS_RSTD);
    LAS f32x4* gpost = (LAS f32x4*)F.lds; LAS f32x4* gfp = gpost + D / 4;
    for (int i = tid_; i < D / 4; i += NTHR) { gpost[i] = ((const f32x4*)F.in_GMPOST)[i]; gfp[i] = ((const f32x4*)F.in_GFPOST)[i]; }
    __syncthreads();
    for (int m = F.gw; m < L; m += F.ngw) {
        asm volatile("" ::: "memory");
        const f32x4* xr = (const f32x4*)xrow(F, m) + F.lane; const u32x2* mr = (const u32x2*)(MIX + (size_t)m * D) + F.lane; const u32x2* fr = (const u32x2*)(FB + (size_t)m * D) + F.lane;
        const float rstd1 = RSTD[m];
        u32x2 fx[16]; float s = 0.f;
#pragma unroll
        for (int j = 0; j < 16; ++j) { fx[j] = fr[64 * j]; const f32x4 a = up4(fx[j]); s += (a.x * a.x + a.y * a.y) + (a.z * a.z + a.w * a.w); }
        const float rstd3 = 1.0f / sqrtf(wave_sum(s) * (1.0f / D) + EPS);
        f32x4* o = (f32x4*)(F.out + (size_t)m * D) + F.lane;
#pragma unroll
        for (int j = 0; j < 16; ++j) o[64 * j] = xr[64 * j] + up4(mr[64 * j]) * rstd1 * gpost[F.lane + 64 * j] + up4(fx[j]) * rstd3 * gfp[F.lane + 64 * j];
    }
}

constexpr int LDS_STAGE = pg8::STAGE_BYTES;
constexpr int LDS_MISC = LDS_STAGE;
constexpr int LDS_BYTES = LDS_STAGE + 1024;
#ifndef MK_N_LAUNCHES
#define MK_N_LAUNCHES 1
#endif
constexpr int NPHASE = 12;
struct Args { const float* in[23]; float* out; unsigned char* ws; int ph_lo, ph_hi; };

__global__ void __launch_bounds__(NTHR, 2) fwd_kernel(Args args) {
    extern __shared__ __attribute__((aligned(16))) unsigned char lds_raw[];
    Frame F;
    F.lds = (LAS unsigned char*)lds_raw;
    F.tid = threadIdx.x; F.lane = (int)__builtin_amdgcn_mbcnt_hi(~0u, __builtin_amdgcn_mbcnt_lo(~0u, 0u)); F.wave = __builtin_amdgcn_readfirstlane(F.tid >> 6);
    F.G = gridDim.x; F.gw = blockIdx.x * NWAVES + F.wave; F.ngw = F.G * NWAVES;
    F.in_XP = args.in[0]; F.in_XS = args.in[1]; F.in_WIN = args.in[2]; F.in_WCONV = args.in[3]; F.in_BCONV = args.in[4]; F.in_WR = args.in[5]; F.in_BR = args.in[6]; F.in_WI = args.in[7]; F.in_BI = args.in[8]; F.in_LAM = args.in[9]; F.in_RPB = args.in[10]; F.in_WNO = args.in[11]; F.in_WLO = args.in[12]; F.in_WM = args.in[13]; F.in_BM = args.in[14]; F.in_WOUT = args.in[15]; F.in_GMPRE = args.in[16]; F.in_GMPOST = args.in[17]; F.in_GFPRE = args.in[18]; F.in_GFPOST = args.in[19]; F.in_WFG = args.in[20]; F.in_WFU = args.in[21]; F.in_WFD = args.in[22];
    F.out = args.out; F.ws = args.ws;
    volatile LAS unsigned* MISC = (volatile LAS unsigned*)(F.lds + LDS_MISC);
    if (F.tid < 256) MISC[F.tid] = 0u;
    __syncthreads();
    const int lo = args.ph_lo, hi = args.ph_hi;
    const bool fused = (hi - lo) > 1;
    XcdBarrier bar; bar.bar = (unsigned*)(F.ws + WS_CTL); bar.x = 0; bar.st = nullptr;
    if (fused) bar = xcd_barrier_post((unsigned*)(F.ws + WS_CTL), MISC + 8);
#ifndef PH_MASK
#define PH_MASK 0xfff
#endif
#define IN(k) (((PH_MASK >> (k)) & 1) && lo <= (k) && (k) < hi)
#define SEAM(k) do { if (IN(k) && IN((k) + 1)) xcd_barrier(bar); } while (0)
    LAS unsigned char* stage = F.lds;

#ifdef ATTN_OUT_OFF
#define NA_BUF ((size_t)ATTN_OUT_OFF * MiB)
#else
#define NA_BUF WS_Q
#endif
#ifndef DUP_MASK
#define DUP_MASK 0
#endif
#define RUN(k, ...) if (IN(k)) { __VA_ARGS__ if (((DUP_MASK) >> (k)) & 1) { __VA_ARGS__ } }
    RUN(0, { p0_prologue(F); }) SEAM(0);
    RUN(1, {
        { pg8::Gemm g{wsp<bf16_t>(F, WS_XN8), wsp<bf16_t>(F, WS_XN8), 1 << 30, wsp<bf16_t>(F, WS_W8), L, 2 * NAW + 2 * D, D}; pg8::StaticOrder S; S.init(L, 2 * NAW + 2 * D, F.G, (int)blockIdx.x);
          pg8::EpiProjQ E{wsp<bf16_t>(F, WS_Q), wsp<bf16_t>(F, WS_K), (bf16_t*)F.out, F.in_BM, wsp<float>(F, WS_RS1), wsp<float>(F, WS_CS) + CS_QKM};
          pg8::gemm_phase<pg8::EpiProjQ, pg8::StaticOrder, true, true, 2>(stage, g, S, E); }
        { pg8::Gemm g{wsp<bf16_t>(F, WS_XN), wsp<bf16_t>(F, WS_XN), 1 << 30, wsp<bf16_t>(F, WS_WCAT), L, 2 * NAW, 2 * D}; pg8::StaticOrder S; S.init(L, 2 * NAW, F.G, (int)blockIdx.x);
          pg8::EpiProj E{wsp<bf16_t>(F, WS_XR), wsp<bf16_t>(F, WS_GR), wsp<bf16_t>(F, WS_GR), wsp<bf16_t>(F, WS_GR), (bf16_t*)F.out, F.in_BM, 1 << 30};
          pg8::gemm_phase<pg8::EpiProj, pg8::StaticOrder, true, true, 0>(stage, g, S, E); }
        { pg8::Gemm g{wsp<bf16_t>(F, WS_WVT), wsp<bf16_t>(F, WS_WVT), 1 << 30, wsp<bf16_t>(F, WS_XN8), NAW, L, D}; pg8::StaticOrder S; S.init(NAW, L, F.G, (int)blockIdx.x);
          pg8::EpiVTQ E{wsp<bf16_t>(F, WS_VT), wsp<float>(F, WS_CS) + CS_V, wsp<float>(F, WS_RS1)};
          pg8::gemm_phase<pg8::EpiVTQ, pg8::StaticOrder, true, true, 2>(stage, g, S, E); }
    }) SEAM(1);
    RUN(2, { lru_pass_a(F); }) SEAM(2);
    #ifdef ATTN_OUT_OFF
    if (IN(3)) { lru_pass_b(F); } SEAM(3);
    if (IN(4)) { lru_pass_c<0>(F); xcd_barrier(bar); if (ATTN_DUP) attn_mfma<ATTN_DUP - 1>(F); attn_mfma<0>(F); } SEAM(4);
#else
    if (IN(3)) { lru_pass_b(F); attn_mfma_lds(F); } SEAM(3);
#ifdef LRUC_DBG
    if (IN(4)) { lru_pass_c<LRUC_DBG>(F); lru_pass_c<0>(F); } SEAM(4);
#else
    RUN(4, { lru_pass_c<0>(F); }) SEAM(4);
#endif
#endif
    if (IN(5)) {
        { pg8::Gemm g{wsp<bf16_t>(F, NA_BUF), wsp<bf16_t>(F, NA_BUF), 1 << 30, wsp<bf16_t>(F, WS_WNO), L, D, 2 * NAW}; pg8::StaticOrder S; S.init(L, D, F.G, (int)blockIdx.x);
          pg8::EpiMulG<false> E{wsp<bf16_t>(F, WS_T1), (const bf16_t*)F.out, 0};
          pg8::gemm_phase<pg8::EpiMulG<false>, pg8::StaticOrder, true, true>(stage, g, S, E); }
        { pg8::Gemm g{wsp<bf16_t>(F, WS_XR), wsp<bf16_t>(F, WS_XR), 1 << 30, wsp<bf16_t>(F, WS_WLO), L, D, 2 * LW}; pg8::StaticOrder S; S.init(L, D, F.G, (int)blockIdx.x);
          pg8::EpiMulG<true> E{wsp<bf16_t>(F, WS_T1), (const bf16_t*)F.out, D};
          pg8::gemm_phase<pg8::EpiMulG<true>, pg8::StaticOrder, true, true>(stage, g, S, E); }
    } SEAM(5);
    RUN(6, {
        pg8::Gemm g{wsp<bf16_t>(F, WS_T1), wsp<bf16_t>(F, WS_T1), 1 << 30, wsp<bf16_t>(F, WS_WO), L, D, 2 * D}; pg8::StaticOrder S; S.init(L, D, F.G, (int)blockIdx.x);
        pg8::EpiPlain E{wsp<bf16_t>(F, WS_MIX), D};
        pg8::gemm_phase<pg8::EpiPlain, pg8::StaticOrder, true, true>(stage, g, S, E);
    }) SEAM(6);
    RUN(7, { mid_phase(F); }) SEAM(7);
    RUN(8, {
        pg8::Gemm g{wsp<bf16_t>(F, WS_XN8), wsp<bf16_t>(F, WS_XN8), 1 << 30, wsp<bf16_t>(F, WS_WGU), L, 2 * DFF, D}; pg8::StaticOrder S; S.init(L, 2 * DFF, F.G, (int)blockIdx.x);
        pg8::EpiSwigluQ E{(bf16_t*)F.out, wsp<bf16_t>(F, WS_HIDS), LP / 256, wsp<float>(F, WS_RS2), wsp<float>(F, WS_CS) + CS_GU};
        pg8::gemm_phase<pg8::EpiSwigluQ, pg8::StaticOrder, false, true, 2>(stage, g, S, E);
    }) SEAM(8);
    RUN(9, { hq_phase(F); }) SEAM(9);
    RUN(10, {
        pg8::Gemm g{wsp<bf16_t>(F, WS_H8P), wsp<bf16_t>(F, WS_H8S), LP / 256, wsp<bf16_t>(F, WS_WD), L, D, DFF}; pg8::StaticOrder S; S.init(L, D, F.G, (int)blockIdx.x);
        pg8::EpiPlainQ E{wsp<bf16_t>(F, WS_F), D, wsp<float>(F, WS_RS3), wsp<float>(F, WS_CS) + CS_D};
        pg8::gemm_phase<pg8::EpiPlainQ, pg8::StaticOrder, true, true, 2>(stage, g, S, E);
    }) SEAM(10);
    RUN(11, { final_phase(F); })
#undef RUN
#undef IN
#undef SEAM
}

extern "C" void kernel_launch(void* const* d_in, const int* in_sizes, int n_in, void* d_out, int out_size, void* d_ws, size_t ws_size, hipStream_t stream) {
    static int grid = 0;
    if (grid == 0) {
        if (n_in != 23 || in_sizes[0] != LP * D || in_sizes[1] != LS * D || out_size != L * D || ws_size < WS_END) {
            fprintf(stderr, "kernel_launch: unexpected shapes: n_in %d in0 %d out %d ws %zu (need %zu)\n", n_in, n_in > 0 ? in_sizes[0] : -1, out_size, ws_size, (size_t)WS_END); grid = -1; return; }
        int dev = 0, cus = 0, per_cu = 0;
        if (hipGetDevice(&dev) != hipSuccess || hipDeviceGetAttribute(&cus, hipDeviceAttributeMultiprocessorCount, dev) != hipSuccess) { grid = -1; return; }
        if (hipFuncSetAttribute((const void*)fwd_kernel, hipFuncAttributeMaxDynamicSharedMemorySize, LDS_BYTES) != hipSuccess) { fprintf(stderr, "kernel_launch: hipFuncSetAttribute failed\n"); grid = -1; return; }
        if (hipOccupancyMaxActiveBlocksPerMultiprocessor(&per_cu, (const void*)fwd_kernel, NTHR, LDS_BYTES) != hipSuccess || per_cu < 1) { fprintf(stderr, "kernel_launch: occupancy query says %d\n", per_cu); }
        (void)hipGetLastError();
        grid = cus;
    }
    if (grid < 0) return;
    (void)hipMemsetAsync((char*)d_ws + WS_CTL, 0, CTL_ZERO_BYTES, stream);
#ifdef DBG_ZERO_ALL
    (void)hipMemsetAsync((char*)d_ws, 0, WS_END, stream); (void)hipMemsetAsync((char*)d_out, 0, (size_t)L * D * 4, stream);
#endif
    Args a{};
    for (int i = 0; i < 23; ++i) a.in[i] = (const float*)d_in[i];
    a.out = (float*)d_out; a.ws = (unsigned char*)d_ws;
#if MK_N_LAUNCHES == 1
    a.ph_lo = 0; a.ph_hi = NPHASE;
    hipLaunchKernelGGL(fwd_kernel, dim3(grid), dim3(NTHR), LDS_BYTES, stream, a);
#else
    for (int p = 0; p < NPHASE; ++p) {
#ifdef DBG_PH_MASK
        if (!((DBG_PH_MASK >> p) & 1)) continue;
#endif
        a.ph_lo = p; a.ph_hi = p + 1; hipLaunchKernelGGL(fwd_kernel, dim3(grid), dim3(NTHR), LDS_BYTES, stream, a); }
#endif
}
```

```cpp
#include <hip/hip_runtime.h>
#include <cstdio>
#include <cstdint>

#define LAS __attribute__((address_space(3)))
typedef unsigned short bf16_t;
typedef short bf16x8 __attribute__((ext_vector_type(8)));
typedef float f32x4 __attribute__((ext_vector_type(4)));
typedef float f32x2 __attribute__((ext_vector_type(2)));
typedef unsigned u32x4 __attribute__((ext_vector_type(4)));
typedef unsigned u32x2 __attribute__((ext_vector_type(2)));

constexpr int D = 4096, LP = 16384, LS = 8192, L = LP + LS;
constexpr int GRIDW = 64, HD = 128, NH = 16, NAW = 2048, LW = 2048, NBLK = 16, BW = 128, DFF = 11008, INW = 10240;
constexpr float EPS = 1e-6f;
constexpr int NWAVES = 8, NTHR = 512;

constexpr size_t MiB = 1u << 20;
constexpr size_t WS_CTL = 0, CTL_ZERO_BYTES = 64 * 1024;
constexpr size_t WS_AM = 32 * 1024;
constexpr size_t WS_RSTD = 1 * MiB;
constexpr size_t WS_RS1 = 1 * MiB + 128 * 1024;
constexpr size_t WS_RS2 = 1 * MiB + 256 * 1024;
constexpr size_t WS_CS = 1 * MiB + 384 * 1024;
constexpr size_t WS_SUM = 2 * MiB;
constexpr size_t WS_WCAT = 8 * MiB;
constexpr size_t WS_W8 = 40 * MiB;
constexpr size_t WS_WVT = 88 * MiB;
constexpr size_t WS_XN8 = 96 * MiB;
constexpr size_t WS_WNO = 192 * MiB;
constexpr size_t WS_WLO = 208 * MiB;
constexpr size_t WS_WO = 224 * MiB;
constexpr size_t WS_WGU = 256 * MiB;
constexpr size_t WS_WD = 342 * MiB;
constexpr size_t WS_WG = 428 * MiB;
constexpr size_t WS_XN = 430 * MiB;
constexpr size_t WS_Q = 622 * MiB;
constexpr size_t WS_XR = 718 * MiB;
constexpr size_t WS_K = 814 * MiB;
constexpr size_t WS_VT = 910 * MiB;
constexpr size_t WS_GR = 1006 * MiB;
constexpr size_t WS_XC = 1102 * MiB;
constexpr size_t WS_END = 1198 * MiB;
constexpr int CS_QKM = 0, CS_V = 12288, CS_GU = 12288 + 2048, CS_D = 12288 + 2048 + 22016;
constexpr size_t WS_RS3 = 1 * MiB + 640 * 1024;
constexpr size_t WS_H8P = WS_XN, WS_H8S = WS_XN8;
constexpr size_t WS_T1 = WS_K;
constexpr size_t WS_MIX = WS_GR;
constexpr size_t WS_HIDS = WS_Q;
constexpr size_t WS_F = WS_K;
constexpr size_t WS_HF = WS_K;

#define LDS_WAIT() asm volatile("s_waitcnt lgkmcnt(0)" ::: "memory")
#define VM_WAIT() asm volatile("s_waitcnt vmcnt(0)" ::: "memory")
typedef __bf16 bf16x2n_t __attribute__((ext_vector_type(2)));
__device__ __forceinline__ unsigned pk2(float lo, float hi) { const bf16x2n_t r = __builtin_convertvector((f32x2){lo, hi}, bf16x2n_t); return __builtin_bit_cast(unsigned, r); }
__device__ __forceinline__ unsigned f2bf(float f) { return pk2(f, 0.f) & 0xffffu; }
__device__ __forceinline__ float bflo(unsigned u) { return __builtin_bit_cast(float, u << 16); }
__device__ __forceinline__ float bfhi(unsigned u) { return __builtin_bit_cast(float, u & 0xffff0000u); }
__device__ __forceinline__ float bf1(bf16_t u) { return __builtin_bit_cast(float, (unsigned)u << 16); }
__device__ __forceinline__ float wave_sum(float v) {
#pragma unroll
    for (int o = 1; o < 64; o <<= 1) v += __shfl_xor(v, o);
    return v;
}
__device__ __forceinline__ float wave_max(float v) {
#pragma unroll
    for (int o = 1; o < 64; o <<= 1) v = fmaxf(v, __shfl_xor(v, o));
    return v;
}
__device__ __forceinline__ float sigmoidf_(float v) { return __builtin_amdgcn_rcpf(1.0f + __expf(-v)); }
__device__ __forceinline__ float gelu_tanh(float v) { const float y = 0.7978845608f * (v + 0.044715f * v * v * v); const float e = __expf(2.0f * y); return 0.5f * v * (2.0f - 2.0f * __builtin_amdgcn_rcpf(e + 1.0f)); }

namespace pg8 {
constexpr int BM = 256, BK = 64, HALF = 128, HTB = HALF * BK * 2  , STAGE_BYTES = 8 * HTB, NXCD = 8, WGM = 4;

__host__ __device__ __forceinline__ int lds_byte(int r, int c) { return (r >> 3) * 1024 + (r & 7) * 128 + ((((c >> 3) ^ r) & 7) << 4) + (c & 7) * 2; }
__host__ __device__ __forceinline__ void stage_rc(int b, int& R, int& C) { const int ch = b >> 10, rr = (b >> 7) & 7, slot = (b >> 4) & 7; R = ch * 8 + rr; C = ((slot ^ rr) & 7) * 8; }
__host__ __device__ __forceinline__ int perm32(int rho) { const int n = rho >> 4, i = rho & 15; return 8 * (i >> 2) + 4 * n + (i & 3); }

struct Unit { int pm, pn; };
struct Gemm {
    const bf16_t* A; const bf16_t* A2; int pm_split; const bf16_t* Bt; int M, N, rb;
    __device__ __forceinline__ const char* abase(int pm) const { const size_t t = (size_t)BM * rb; return pm < pm_split ? (const char*)A + (size_t)pm * t : (const char*)A2 + (size_t)(pm - pm_split) * t; }
    __device__ __forceinline__ const char* bbase(int pn) const { return (const char*)Bt + (size_t)pn * BM * rb; }
};

struct StaticOrder {
    int nM, nN, nwg, G, c;
    __host__ __device__ void init(int M, int N, int G_, int c_) { nM = M / BM; nN = N / BM; nwg = nM * nN; G = G_; c = c_; }
    __host__ __device__ bool next(int i, Unit& u) const {
        const long Lx = (long)i * G + c; if (Lx >= nwg) return false;
        int wgid = (int)Lx; { const int q = nwg / NXCD, r = nwg % NXCD, xcd = wgid % NXCD, off = wgid / NXCD; wgid = (xcd < r ? xcd * (q + 1) : r * (q + 1) + (xcd - r) * q) + off; }
        const int nig = WGM * nN, gid = wgid / nig, fm = gid * WGM, gsz = (nM - fm) < WGM ? (nM - fm) : WGM;
        u.pm = fm + ((wgid % nig) % gsz); u.pn = (wgid % nig) / gsz; return true;
    }
    __device__ __forceinline__ void a_ready(const Unit&) const {}
    __device__ __forceinline__ void done(const Unit&) const {}
};

typedef int v8i32 __attribute__((ext_vector_type(8)));
typedef int v4i32 __attribute__((ext_vector_type(4)));
typedef __bf16 bf16x2_t __attribute__((ext_vector_type(2)));
__device__ __forceinline__ unsigned cvt_pk_bf16(float lo, float hi) { const bf16x2_t r = __builtin_convertvector((f32x2){lo, hi}, bf16x2_t); return __builtin_bit_cast(unsigned, r); }
__device__ __forceinline__ u32x4 pack8(const f32x4 v0, const f32x4 v1) { u32x4 w; w.x = cvt_pk_bf16(v0[0], v0[1]); w.y = cvt_pk_bf16(v0[2], v0[3]); w.z = cvt_pk_bf16(v1[0], v1[1]); w.w = cvt_pk_bf16(v1[2], v1[3]); return w; }
__device__ __forceinline__ void unpack8(const u32x4 w, f32x4& v0, f32x4& v1) { v0 = (f32x4){bflo(w.x), bfhi(w.x), bflo(w.y), bfhi(w.y)}; v1 = (f32x4){bflo(w.z), bfhi(w.z), bflo(w.w), bfhi(w.w)}; }
__device__ __forceinline__ f32x4 sig4(const f32x4 v) { f32x4 r; r[0] = sigmoidf_(v[0]); r[1] = sigmoidf_(v[1]); r[2] = sigmoidf_(v[2]); r[3] = sigmoidf_(v[3]); return r; }

struct EpiPlain {
    static constexpr bool PERM = true, AFTER_DRAIN = false;
    bf16_t* O; int ldc;
    __device__ __forceinline__ void operator()(const f32x4 (&acc)[2][2][4][2], const Unit& u, int wr, int wc, int fr, int fq) const {
        const int row0 = u.pm * BM + wr * 64 + fr, col0 = u.pn * BM + wc * 32 + 8 * fq;
#pragma unroll
        for (int ai = 0; ai < 2; ++ai)
#pragma unroll
            for (int m = 0; m < 4; ++m) { bf16_t* rowp = O + (size_t)(row0 + ai * HALF + m * 16) * ldc + col0;
#pragma unroll
                for (int bj = 0; bj < 2; ++bj) *(u32x4*)(rowp + bj * HALF) = pack8(acc[ai][bj][m][0], acc[ai][bj][m][1]); }
    }
};
struct EpiVT {
    static constexpr bool PERM = true, AFTER_DRAIN = false;
    bf16_t* O;
    __device__ __forceinline__ void operator()(const f32x4 (&acc)[2][2][4][2], const Unit& u, int wr, int wc, int fr, int fq) const {
        const int row0 = u.pm * BM + wr * 64 + fr, col0 = u.pn * BM + wc * 32 + 8 * fq;
#pragma unroll
        for (int ai = 0; ai < 2; ++ai)
#pragma unroll
            for (int m = 0; m < 4; ++m) { const int row = row0 + ai * HALF + m * 16, hh = row >> 7, d = row & 127;
                const int dt = 2 * (d >> 5) + ((d >> 2) & 1), i = 4 * ((d >> 3) & 3) + (d & 3);
#pragma unroll
                for (int bj = 0; bj < 2; ++bj) { const int tok = col0 + bj * HALF, R = tok >> 6, o = (tok & 63) >> 3;
                    *(u32x4*)(O + ((size_t)((((R * 16 + hh) * 8 + dt) * 8 + o) * 16 + i)) * 8) = pack8(acc[ai][bj][m][0], acc[ai][bj][m][1]); } }
    }
};
struct EpiProj {
    static constexpr bool PERM = true, AFTER_DRAIN = false;
    bf16_t* P0; bf16_t* P1; bf16_t* P2; bf16_t* P3; bf16_t* G; const float* bias; int pn_gate0;
    __device__ __forceinline__ void operator()(const f32x4 (&acc)[2][2][4][2], const Unit& u, int wr, int wc, int fr, int fq) const {
        const int row0 = u.pm * BM + wr * 64 + fr;
        if (u.pn < pn_gate0) {
            const int t = u.pn >> 3; bf16_t* base = t == 0 ? P0 : (t == 1 ? P1 : (t == 2 ? P2 : P3));
            const int col0 = (u.pn & 7) * BM + wc * 32 + 8 * fq;
            if (t == 2) {
#pragma unroll
                for (int ai = 0; ai < 2; ++ai)
#pragma unroll
                    for (int m = 0; m < 4; ++m) { const int tok = row0 + ai * HALF + m * 16, R = tok >> 6, cl = tok & 63;
                        const int tokpart = (((cl >> 2) & 1) * 8 + (cl >> 3)) * 4 + (cl & 3);
#pragma unroll
                        for (int bj = 0; bj < 2; ++bj) { const int c = col0 + bj * HALF, hh = c >> 7, d0 = c & 127;
                            *(u32x4*)(base + ((size_t)(((R * 16 + hh) * 4 + (d0 >> 5)) * 64 + tokpart) * 4 + ((d0 >> 3) & 3)) * 8) = pack8(acc[ai][bj][m][0], acc[ai][bj][m][1]); } }
            } else {
#pragma unroll
            for (int ai = 0; ai < 2; ++ai)
#pragma unroll
                for (int m = 0; m < 4; ++m) { bf16_t* rowp = base + (size_t)(row0 + ai * HALF + m * 16) * NAW + col0;
#pragma unroll
                    for (int bj = 0; bj < 2; ++bj) *(u32x4*)(rowp + bj * HALF) = pack8(acc[ai][bj][m][0], acc[ai][bj][m][1]); }
            }
        } else {
            const int col0 = (u.pn - pn_gate0) * BM + wc * 32 + 8 * fq;
            f32x4 bv[2][2];
#pragma unroll
            for (int bj = 0; bj < 2; ++bj)
#pragma unroll
                for (int n = 0; n < 2; ++n) bv[bj][n] = *(const f32x4*)(bias + col0 + bj * HALF + 4 * n);
#pragma unroll
            for (int ai = 0; ai < 2; ++ai)
#pragma unroll
                for (int m = 0; m < 4; ++m) { bf16_t* rowp = G + (size_t)(row0 + ai * HALF + m * 16) * (2 * D) + col0;
#pragma unroll
                    for (int bj = 0; bj < 2; ++bj) *(u32x4*)(rowp + bj * HALF) = pack8(sig4(acc[ai][bj][m][0] + bv[bj][0]), sig4(acc[ai][bj][m][1] + bv[bj][1])); }
        }
    }
};
template <bool ADD> struct EpiMulG {
    static constexpr bool PERM = true, AFTER_DRAIN = false;
    bf16_t* O; const bf16_t* G; int goff;
    __device__ __forceinline__ void operator()(const f32x4 (&acc)[2][2][4][2], const Unit& u, int wr, int wc, int fr, int fq) const {
        const int row0 = u.pm * BM + wr * 64 + fr, col0 = u.pn * BM + wc * 32 + 8 * fq;
#pragma unroll
        for (int ai = 0; ai < 2; ++ai)
#pragma unroll
            for (int m = 0; m < 4; ++m) { const size_t row = (size_t)(row0 + ai * HALF + m * 16); bf16_t* rowp = O + row * D + col0; const bf16_t* gp = G + row * (2 * D) + goff + col0;
#pragma unroll
                for (int bj = 0; bj < 2; ++bj) {
                    f32x4 g0, g1; unpack8(*(const u32x4*)(gp + bj * HALF), g0, g1);
                    f32x4 v0 = acc[ai][bj][m][0] * g0, v1 = acc[ai][bj][m][1] * g1;
                    if (ADD) { f32x4 t0, t1; unpack8(*(const u32x4*)(rowp + bj * HALF), t0, t1); v0 += t0; v1 += t1; }
                    *(u32x4*)(rowp + bj * HALF) = pack8(v0, v1); } }
    }
};
struct EpiSwiglu {
    static constexpr bool PERM = true, AFTER_DRAIN = false;
    bf16_t* H0; bf16_t* H1; int pm_split;
    __device__ __forceinline__ void operator()(const f32x4 (&acc)[2][2][4][2], const Unit& u, int wr, int wc, int fr, int fq) const {
        bf16_t* base = u.pm < pm_split ? H0 + (size_t)u.pm * BM * DFF : H1 + (size_t)(u.pm - pm_split) * BM * DFF;
        const int row0 = wr * 64 + fr, col0 = u.pn * HALF + wc * 32 + 8 * fq;
#pragma unroll
        for (int ai = 0; ai < 2; ++ai)
#pragma unroll
            for (int m = 0; m < 4; ++m) {
                f32x4 h[2];
#pragma unroll
                for (int n = 0; n < 2; ++n) { const f32x4 g = acc[ai][0][m][n], up = acc[ai][1][m][n];
#pragma unroll
                    for (int j = 0; j < 4; ++j) h[n][j] = g[j] * sigmoidf_(g[j]) * up[j]; }
                *(u32x4*)(base + (size_t)(row0 + ai * HALF + m * 16) * DFF + col0) = pack8(h[0], h[1]); }
    }
};

__device__ __forceinline__ f32x4 deq4(const f32x4 accbits, const float sa, const f32x4 sb) { const v4i32 q = __builtin_bit_cast(v4i32, accbits); return (f32x4){(float)q.x, (float)q.y, (float)q.z, (float)q.w} * sa * sb; }
struct EpiProjQ {
    static constexpr bool PERM = true, AFTER_DRAIN = false;
    bf16_t* Qb; bf16_t* Kb; bf16_t* G; const float* bias; const float* sa; const float* sb;
    __device__ __forceinline__ void operator()(const f32x4 (&acc)[2][2][4][2], const Unit& u, int wr, int wc, int fr, int fq) const {
        const int row0 = u.pm * BM + wr * 64 + fr, cg0 = u.pn * BM + wc * 32 + 8 * fq;
        f32x4 sbv[2][2];
#pragma unroll
        for (int bj = 0; bj < 2; ++bj)
#pragma unroll
            for (int n = 0; n < 2; ++n) sbv[bj][n] = *(const f32x4*)(sb + cg0 + bj * HALF + 4 * n);
        if (u.pn < 8) {
            const int col0 = u.pn * BM + wc * 32 + 8 * fq;
#pragma unroll
            for (int ai = 0; ai < 2; ++ai)
#pragma unroll
                for (int m = 0; m < 4; ++m) { const int row = row0 + ai * HALF + m * 16; const float sr = sa[row]; bf16_t* rowp = Qb + (size_t)row * NAW + col0;
#pragma unroll
                    for (int bj = 0; bj < 2; ++bj) *(u32x4*)(rowp + bj * HALF) = pack8(deq4(acc[ai][bj][m][0], sr, sbv[bj][0]), deq4(acc[ai][bj][m][1], sr, sbv[bj][1])); }
        } else if (u.pn < 16) {
            const int col0 = (u.pn - 8) * BM + wc * 32 + 8 * fq;
#pragma unroll
            for (int ai = 0; ai < 2; ++ai)
#pragma unroll
                for (int m = 0; m < 4; ++m) { const int tok = row0 + ai * HALF + m * 16, R = tok >> 6, cl = tok & 63; const float sr = sa[tok];
                    const int tokpart = (((cl >> 2) & 1) * 8 + (cl >> 3)) * 4 + (cl & 3);
#pragma unroll
                    for (int bj = 0; bj < 2; ++bj) { const int c = col0 + bj * HALF, hh = c >> 7, d0 = c & 127;
                        *(u32x4*)(Kb + ((size_t)(((R * 16 + hh) * 4 + (d0 >> 5)) * 64 + tokpart) * 4 + ((d0 >> 3) & 3)) * 8) = pack8(deq4(acc[ai][bj][m][0], sr, sbv[bj][0]), deq4(acc[ai][bj][m][1], sr, sbv[bj][1])); } }
        } else {
            const int col0 = (u.pn - 16) * BM + wc * 32 + 8 * fq;
            f32x4 bv[2][2];
#pragma unroll
            for (int bj = 0; bj < 2; ++bj)
#pragma unroll
                for (int n = 0; n < 2; ++n) bv[bj][n] = *(const f32x4*)(bias + col0 + bj * HALF + 4 * n);
#pragma unroll
            for (int ai = 0; ai < 2; ++ai)
#pragma unroll
                for (int m = 0; m < 4; ++m) { const int row = row0 + ai * HALF + m * 16; const float sr = sa[row]; bf16_t* rowp = G + (size_t)row * (2 * D) + col0;
#pragma unroll
                    for (int bj = 0; bj < 2; ++bj) *(u32x4*)(rowp + bj * HALF) = pack8(sig4(deq4(acc[ai][bj][m][0], sr, sbv[bj][0]) + bv[bj][0]), sig4(deq4(acc[ai][bj][m][1], sr, sbv[bj][1]) + bv[bj][1])); }
        }
    }
};
struct EpiPlainQ {
    static constexpr bool PERM = true, AFTER_DRAIN = false;
    bf16_t* O; int ldc; const float* sa; const float* sb;
    __device__ __forceinline__ void operator()(const f32x4 (&acc)[2][2][4][2], const Unit& u, int wr, int wc, int fr, int fq) const {
        const int row0 = u.pm * BM + wr * 64 + fr, col0 = u.pn * BM + wc * 32 + 8 * fq;
        f32x4 sbv[2][2];
#pragma unroll
        for (int bj = 0; bj < 2; ++bj)
#pragma unroll
            for (int n = 0; n < 2; ++n) sbv[bj][n] = *(const f32x4*)(sb + col0 + bj * HALF + 4 * n);
#pragma unroll
        for (int ai = 0; ai < 2; ++ai)
#pragma unroll
            for (int m = 0; m < 4; ++m) { const int row = row0 + ai * HALF + m * 16; const float sr = sa[row]; bf16_t* rowp = O + (size_t)row * ldc + col0;
#pragma unroll
                for (int bj = 0; bj < 2; ++bj) *(u32x4*)(rowp + bj * HALF) = pack8(deq4(acc[ai][bj][m][0], sr, sbv[bj][0]), deq4(acc[ai][bj][m][1], sr, sbv[bj][1])); }
    }
};
struct EpiVTQ {
    static constexpr bool PERM = true, AFTER_DRAIN = false;
    bf16_t* O; const float* sa; const float* sb;
    __device__ __forceinline__ void operator()(const f32x4 (&acc)[2][2][4][2], const Unit& u, int wr, int wc, int fr, int fq) const {
        const int row0 = u.pm * BM + wr * 64 + fr, col0 = u.pn * BM + wc * 32 + 8 * fq;
        f32x4 sbv[2][2];
#pragma unroll
        for (int bj = 0; bj < 2; ++bj)
#pragma unroll
            for (int n = 0; n < 2; ++n) sbv[bj][n] = *(const f32x4*)(sb + col0 + bj * HALF + 4 * n);
#pragma unroll
        for (int ai = 0; ai < 2; ++ai)
#pragma unroll
            for (int m = 0; m < 4; ++m) { const int row = row0 + ai * HALF + m * 16, hh = row >> 7, d = row & 127; const float sr = sa[row];
                const int dt = 2 * (d >> 5) + ((d >> 2) & 1), i = 4 * ((d >> 3) & 3) + (d & 3);
#pragma unroll
                for (int bj = 0; bj < 2; ++bj) { const int tok = col0 + bj * HALF, R = tok >> 6, o = (tok & 63) >> 3;
                    *(u32x4*)(O + ((size_t)((((R * 16 + hh) * 8 + dt) * 8 + o) * 16 + i)) * 8) = pack8(deq4(acc[ai][bj][m][0], sr, sbv[bj][0]), deq4(acc[ai][bj][m][1], sr, sbv[bj][1])); } }
    }
};
struct EpiSwigluQ {
    static constexpr bool PERM = true, AFTER_DRAIN = false;
    bf16_t* H0; bf16_t* H1; int pm_split; const float* sa; const float* sb;
    __device__ __forceinline__ void operator()(const f32x4 (&acc)[2][2][4][2], const Unit& u, int wr, int wc, int fr, int fq) const {
        bf16_t* base = u.pm < pm_split ? H0 + (size_t)u.pm * BM * DFF : H1 + (size_t)(u.pm - pm_split) * BM * DFF;
        const int row0 = wr * 64 + fr, col0 = u.pn * HALF + wc * 32 + 8 * fq, cg0 = u.pn * BM + wc * 32 + 8 * fq;
        f32x4 sbv[2][2];
#pragma unroll
        for (int bj = 0; bj < 2; ++bj)
#pragma unroll
            for (int n = 0; n < 2; ++n) sbv[bj][n] = *(const f32x4*)(sb + cg0 + bj * HALF + 4 * n);
#pragma unroll
        for (int ai = 0; ai < 2; ++ai)
#pragma unroll
            for (int m = 0; m < 4; ++m) { const float sr = sa[u.pm * BM + row0 + ai * HALF + m * 16];
                f32x4 h[2];
#pragma unroll
                for (int n = 0; n < 2; ++n) { const f32x4 g = deq4(acc[ai][0][m][n], sr, sbv[0][n]), up = deq4(acc[ai][1][m][n], sr, sbv[1][n]);
#pragma unroll
                    for (int j = 0; j < 4; ++j) h[n][j] = g[j] * sigmoidf_(g[j]) * up[j]; }
                *(u32x4*)(base + (size_t)(row0 + ai * HALF + m * 16) * DFF + col0) = pack8(h[0], h[1]); }
    }
};

__device__ __forceinline__ v8i32 cat8(const bf16x8 lo, const bf16x8 hi) { return __builtin_shufflevector(__builtin_bit_cast(v4i32, lo), __builtin_bit_cast(v4i32, hi), 0, 1, 2, 3, 4, 5, 6, 7); }
__device__ __forceinline__ void mfma_fp8_acc(f32x4& c, const v8i32 a, const v8i32 b, int sa, int sb) {
    asm volatile("v_mfma_scale_f32_16x16x128_f8f6f4 %0, %1, %2, %0, %3, %4 op_sel_hi:[0,0,0]" : "+v"(c) : "v"(a), "v"(b), "v"(sa), "v"(sb)); }
constexpr int FP8_SCALE = 0x73737373;
template <class Epi, class Sched, bool ALIGN_EPI = false, bool SP2 = false, int QM = 0  , int DBG = 0>
__device__ __forceinline__ void gemm_phase(LAS unsigned char* lds, const Gemm g, const Sched& S, const Epi& E) {
    int tid = threadIdx.x; asm volatile("" : "+v"(tid));
    const int wid = __builtin_amdgcn_readfirstlane(tid >> 6), lane = tid & 63, wr = wid >> 2, wc = wid & 3, fr = lane & 15, fq = lane >> 4;
    const int RB = g.rb, nt = RB / (BK * 2);
    unsigned voffA[2], voffB[2];
#pragma unroll
    for (int i = 0; i < 2; ++i) { int R, C; stage_rc(tid * 16 + i * 8192, R, C); const int Rb = Epi::PERM ? ((R & ~31) + perm32(R & 31)) : R;
        voffA[i] = (unsigned)(R * RB + C * 2); voffB[i] = (unsigned)(Rb * RB + C * 2); }
    const size_t kstep = (size_t)(BK * 2);
    const size_t hstep = (size_t)HALF * RB;
    const unsigned ldsw = (unsigned)wid * 1024u;
    const int aoff0 = lds_byte(wr * 64 + fr, fq * 8), aoff1 = lds_byte(wr * 64 + fr, 32 + fq * 8), boff0 = lds_byte(wc * 32 + fr, fq * 8), boff1 = lds_byte(wc * 32 + fr, 32 + fq * 8);
#define PG8_SA(b, h) (((b) * 2 + (h)) * HTB)
#define PG8_SB(b, h) ((4 + (b) * 2 + (h)) * HTB)
#define PG8_STAGE(bufoff, gbase, voff) do { if constexpr (DBG != 3) _Pragma("unroll") for (int _i = 0; _i < 2; ++_i) \
        __builtin_amdgcn_global_load_lds((const unsigned*)((const char*)(gbase) + (voff)[_i]), (LAS unsigned*)(lds + (bufoff) + ldsw + _i * 8192), 16, 0, 0); } while (0)
#define PG8_LDA(dst, b, h) do { if constexpr (DBG != 2) _Pragma("unroll") for (int m = 0; m < 4; ++m) _Pragma("unroll") for (int k = 0; k < 2; ++k) dst[m][k] = *(const LAS bf16x8*)(lds + PG8_SA(b, h) + (k ? aoff1 : aoff0) + m * 2048); } while (0)
#define PG8_LDB(dst, b, h) do { if constexpr (DBG != 2) _Pragma("unroll") for (int n = 0; n < 2; ++n) _Pragma("unroll") for (int k = 0; k < 2; ++k) dst[n][k] = *(const LAS bf16x8*)(lds + PG8_SB(b, h) + (k ? boff1 : boff0) + n * 2048); } while (0)
#define PG8_MMA(ai, bj, At, Bt) do { __builtin_amdgcn_s_setprio(1); if constexpr (DBG == 1) { } else if constexpr (QM == 2) { _Pragma("unroll") for (int m = 0; m < 4; ++m) _Pragma("unroll") for (int n = 0; n < 2; ++n) _Pragma("unroll") for (int k = 0; k < 2; ++k) \
        acc[ai][bj][m][n] = __builtin_bit_cast(f32x4, __builtin_amdgcn_mfma_i32_16x16x64_i8(__builtin_bit_cast(v4i32, Bt[n][k]), __builtin_bit_cast(v4i32, At[m][k]), __builtin_bit_cast(v4i32, acc[ai][bj][m][n]), 0, 0, 0)); } else if constexpr (QM == 1) { _Pragma("unroll") for (int m = 0; m < 4; ++m) _Pragma("unroll") for (int n = 0; n < 2; ++n) \
        mfma_fp8_acc(acc[ai][bj][m][n], cat8(Bt[n][0], Bt[n][1]), cat8(At[m][0], At[m][1]), fp8_sa, fp8_sb); } else { \
        _Pragma("unroll") for (int m = 0; m < 4; ++m) _Pragma("unroll") for (int n = 0; n < 2; ++n) _Pragma("unroll") for (int k = 0; k < 2; ++k) \
        acc[ai][bj][m][n] = __builtin_amdgcn_mfma_f32_16x16x32_bf16(Bt[n][k], At[m][k], acc[ai][bj][m][n], 0, 0, 0); } __builtin_amdgcn_s_setprio(0); } while (0)
#define PG8_WAIT_V(n) asm volatile("s_waitcnt vmcnt(" #n ")" ::: "memory")
#define PG8_WAIT_L(n) asm volatile("s_waitcnt lgkmcnt(" #n ")" ::: "memory")
#define PG8_BAR __builtin_amdgcn_s_barrier()
#define PG8_SCHED __builtin_amdgcn_sched_barrier(0)
    Unit cur, nxt; int ui = 0;
    const int fp8_sa = FP8_SCALE, fp8_sb = 0x7F7F7F7F;
    if (!S.next(0, cur)) return;
    f32x4 acc[2][2][4][2];
#pragma unroll
    for (int a = 0; a < 2; ++a)
#pragma unroll
        for (int b = 0; b < 2; ++b)
#pragma unroll
            for (int m = 0; m < 4; ++m)
#pragma unroll
                for (int n = 0; n < 2; ++n) acc[a][b][m][n] = (f32x4){0.f, 0.f, 0.f, 0.f};
    bf16x8 At[4][2], B0[2][2], B1[2][2];
    const char* cA = g.abase(cur.pm); const char* cB = g.bbase(cur.pn);
    S.a_ready(cur);
    if constexpr (SP2) {
        PG8_STAGE(PG8_SB(0, 0), cB, voffB); PG8_STAGE(PG8_SB(0, 1), cB + hstep, voffB); PG8_STAGE(PG8_SA(0, 0), cA, voffA); PG8_STAGE(PG8_SA(0, 1), cA + hstep, voffA);
        if (wr == 1) PG8_BAR;
        PG8_WAIT_V(2); PG8_BAR;
        PG8_STAGE(PG8_SB(1, 0), cB + kstep, voffB); PG8_STAGE(PG8_SA(1, 0), cA + kstep, voffA); PG8_STAGE(PG8_SB(1, 1), cB + hstep + kstep, voffB);
        PG8_WAIT_V(6); PG8_BAR;
    } else {
        PG8_STAGE(PG8_SB(0, 0), cB, voffB); PG8_STAGE(PG8_SA(0, 0), cA, voffA); PG8_STAGE(PG8_SB(0, 1), cB + hstep, voffB); PG8_STAGE(PG8_SA(0, 1), cA + hstep, voffA);
        if (wr == 1) PG8_BAR;
        PG8_WAIT_V(4); PG8_BAR;
        PG8_STAGE(PG8_SB(1, 0), cB + kstep, voffB); PG8_STAGE(PG8_SA(1, 0), cA + kstep, voffA); PG8_STAGE(PG8_SB(1, 1), cB + hstep + kstep, voffB);
        PG8_WAIT_V(6); PG8_BAR;
    }
    for (;;) {
        const bool has_next = S.next(ui + 1, nxt);
        const char* nA = has_next ? g.abase(nxt.pm) : cA; const char* nB = has_next ? g.bbase(nxt.pn) : cB;
        for (int t = 0; t < nt; t += 2) {
            const bool last = (t == nt - 2);
            const char* a1 = cA + (size_t)(t + 1) * kstep;
            const char* a2 = last ? nA : cA + (size_t)(t + 2) * kstep; const char* b2 = last ? nB : cB + (size_t)(t + 2) * kstep;
            const char* a3 = a2 + kstep; const char* b3 = b2 + kstep;
            if (last && has_next) S.a_ready(nxt);
            if constexpr (SP2) {
            PG8_LDB(B0, 0, 0); PG8_LDB(B1, 0, 1); PG8_SCHED; PG8_LDA(At, 0, 0); PG8_STAGE(PG8_SA(1, 1), a1 + hstep, voffA);
            PG8_WAIT_V(8); PG8_WAIT_L(0); PG8_BAR; PG8_MMA(0, 0, At, B0); PG8_MMA(0, 1, At, B1); PG8_BAR; PG8_SCHED;
            PG8_LDA(At, 0, 1); PG8_STAGE(PG8_SB(0, 0), b2, voffB); PG8_STAGE(PG8_SB(0, 1), b2 + hstep, voffB); PG8_STAGE(PG8_SA(0, 0), a2, voffA);
            PG8_WAIT_V(8); PG8_WAIT_L(0); PG8_BAR; PG8_MMA(1, 0, At, B0); PG8_MMA(1, 1, At, B1); PG8_BAR; PG8_SCHED;
            PG8_LDB(B0, 1, 0); PG8_LDB(B1, 1, 1); PG8_SCHED; PG8_LDA(At, 1, 0); PG8_STAGE(PG8_SA(0, 1), a2 + hstep, voffA);
            PG8_WAIT_V(8); PG8_WAIT_L(0); PG8_BAR; PG8_MMA(0, 0, At, B0); PG8_MMA(0, 1, At, B1); PG8_BAR; PG8_SCHED;
            PG8_LDA(At, 1, 1); PG8_STAGE(PG8_SB(1, 0), b3, voffB); PG8_STAGE(PG8_SB(1, 1), b3 + hstep, voffB); PG8_STAGE(PG8_SA(1, 0), a3, voffA);
            PG8_WAIT_V(8); PG8_WAIT_L(0); PG8_BAR; PG8_MMA(1, 0, At, B0); PG8_MMA(1, 1, At, B1); PG8_BAR; PG8_SCHED;
            } else {
            PG8_LDB(B0, 0, 0); PG8_SCHED; PG8_LDA(At, 0, 0); PG8_STAGE(PG8_SA(1, 1), a1 + hstep, voffA);
            PG8_WAIT_L(8); PG8_BAR; PG8_WAIT_L(0); PG8_MMA(0, 0, At, B0); PG8_BAR; PG8_SCHED;
            PG8_LDB(B1, 0, 1); PG8_STAGE(PG8_SB(0, 0), b2, voffB);
            PG8_BAR; PG8_WAIT_L(0); PG8_MMA(0, 1, At, B1); PG8_BAR;
            PG8_LDA(At, 0, 1); PG8_STAGE(PG8_SA(0, 0), a2, voffA);
            PG8_BAR; PG8_WAIT_L(0); PG8_MMA(1, 0, At, B0); PG8_BAR; PG8_SCHED;
            PG8_STAGE(PG8_SB(0, 1), b2 + hstep, voffB);
            PG8_WAIT_V(6); PG8_BAR; PG8_MMA(1, 1, At, B1); PG8_BAR;
            PG8_LDB(B0, 1, 0); PG8_SCHED; PG8_LDA(At, 1, 0); PG8_STAGE(PG8_SA(0, 1), a2 + hstep, voffA);
            PG8_WAIT_L(8); PG8_BAR; PG8_WAIT_L(0); PG8_MMA(0, 0, At, B0); PG8_BAR; PG8_SCHED;
            PG8_LDB(B1, 1, 1); PG8_STAGE(PG8_SB(1, 0), b3, voffB);
            PG8_BAR; PG8_WAIT_L(0); PG8_MMA(0, 1, At, B1); PG8_BAR;
            PG8_LDA(At, 1, 1); PG8_STAGE(PG8_SA(1, 0), a3, voffA);
            PG8_BAR; PG8_WAIT_L(0); PG8_MMA(1, 0, At, B0); PG8_BAR; PG8_SCHED;
            PG8_STAGE(PG8_SB(1, 1), b3 + hstep, voffB);
            PG8_WAIT_V(6); PG8_BAR; PG8_MMA(1, 1, At, B1); PG8_BAR;
            }
        }
        if constexpr (ALIGN_EPI) { if (wr == 0) PG8_BAR; }
        if constexpr (!Epi::AFTER_DRAIN) { if constexpr (DBG != 4) E(acc, cur, wr, wc, fr, fq); else { _Pragma("unroll") for (int a_ = 0; a_ < 2; ++a_) _Pragma("unroll") for (int b_ = 0; b_ < 2; ++b_) _Pragma("unroll") for (int m_ = 0; m_ < 4; ++m_) _Pragma("unroll") for (int n_ = 0; n_ < 2; ++n_) asm volatile("" :: "v"(acc[a_][b_][m_][n_])); } S.done(cur); }
        if (!has_next) break;
#pragma unroll
        for (int a = 0; a < 2; ++a)
#pragma unroll
            for (int b = 0; b < 2; ++b)
#pragma unroll
                for (int m = 0; m < 4; ++m)
#pragma unroll
                    for (int n = 0; n < 2; ++n) acc[a][b][m][n] = (f32x4){0.f, 0.f, 0.f, 0.f};
        cur = nxt; cA = nA; cB = nB; ++ui;
        if constexpr (ALIGN_EPI) { if (wr == 1) PG8_BAR; }
    }
    PG8_WAIT_V(0);
    if constexpr (!ALIGN_EPI) { if (wr == 0) PG8_BAR; }
    PG8_BAR;
    if constexpr (Epi::AFTER_DRAIN) { E.fused(acc, cur, wr, wc, fr, fq, lds, wid, lane); S.done(cur); }
#undef PG8_SA
#undef PG8_SB
#undef PG8_STAGE
#undef PG8_LDA
#undef PG8_LDB
#undef PG8_MMA
#undef PG8_WAIT_V
#undef PG8_WAIT_L
#undef PG8_BAR
#undef PG8_SCHED
}
}
#define XB_TMO      128
#define XB_XCNT(j)  (256  + 64 * (j))
#define XB_XSUB(j)  (1280 + 64 * (j))
#define XB_XGEN(j)  (2304 + 64 * (j))
#define XB_TOP      3328
#define XB_TOPGEN   3392
#define XCD_BAR_WORDS 3456
#define XB_SPIN_CAP (1u << 18)

__device__ __forceinline__ unsigned xb_ld(unsigned* p)              { return __hip_atomic_load(p, __ATOMIC_RELAXED, __HIP_MEMORY_SCOPE_AGENT); }
__device__ __forceinline__ unsigned xb_add(unsigned* p, unsigned v) { return __hip_atomic_fetch_add(p, v, __ATOMIC_RELAXED, __HIP_MEMORY_SCOPE_AGENT); }
__device__ __forceinline__ unsigned xb_xcc_id() { return (unsigned)__builtin_amdgcn_s_getreg((3 << 11) | 20) & 0xFu; }
#define XB_SPIN(cond, bar) do { unsigned _sp = 0; while (cond) { __builtin_amdgcn_s_sleep(1); \
    if ((++_sp & 255u) == 0u) { if (xb_ld(&(bar)[XB_TMO])) break; if (_sp > XB_SPIN_CAP) { atomicAdd(&(bar)[XB_TMO], 1u); break; } } } } while (0)

struct XcdBarrier {
    unsigned* bar; unsigned x;
    volatile LAS unsigned* st;
};

__device__ __forceinline__ XcdBarrier xcd_barrier_post(unsigned* bar, volatile LAS unsigned* st) {
    XcdBarrier b; b.bar = bar; b.x = xb_xcc_id(); b.st = st;
    if (threadIdx.x == 0) (void)xb_add(&bar[XB_XCNT(b.x)], 1u);
    return b;
}
__device__ __forceinline__ void xcd_barrier_complete(unsigned* bar, unsigned x, unsigned& nloc, unsigned& nx) {
    const unsigned G = gridDim.x * gridDim.y * gridDim.z;
    unsigned sum, cnt, mine, sp = 0u;
    for (;;) {
        sum = 0u; cnt = 0u; mine = 0u;
#pragma unroll
        for (unsigned j = 0; j < 16; ++j) { const unsigned c = xb_ld(&bar[XB_XCNT(j)]); sum += c; cnt += (c > 0u) ? 1u : 0u; mine = (j == x) ? c : mine; }
        if (sum == G) break;
        __builtin_amdgcn_s_sleep(1);
        if ((++sp & 255u) == 0u) { if (xb_ld(&bar[XB_TMO])) break; if (sp > XB_SPIN_CAP) { atomicAdd(&bar[XB_TMO], 1u); break; } }
    }
    nloc = mine > 0u ? mine : 1u; nx = cnt > 0u ? cnt : 1u;
}

__device__ __forceinline__ void xcd_barrier(const XcdBarrier& b) {
    asm volatile("s_waitcnt vmcnt(0)" ::: "memory");
    __syncthreads();
    if (threadIdx.x == 0) {
        unsigned* bar = b.bar;
        __builtin_amdgcn_s_waitcnt(0);
        unsigned nloc = b.st[0], nx = b.st[1];
        if (nloc == 0u) { xcd_barrier_complete(bar, b.x, nloc, nx); b.st[0] = nloc; b.st[1] = nx; }
        const unsigned old = xb_add(&bar[XB_XSUB(b.x)], 1u);
        const unsigned gen = old / nloc;
        if (old + 1u == (gen + 1u) * nloc) {
            __builtin_amdgcn_fence(__ATOMIC_RELEASE, "agent");
            asm volatile("s_waitcnt vmcnt(0)" ::: "memory");
            const unsigned og = xb_add(&bar[XB_TOP], 1u);
            const unsigned tg = og / nx;
            if (og + 1u == (tg + 1u) * nx) xb_add(&bar[XB_TOPGEN], 1u);
            else XB_SPIN(xb_ld(&bar[XB_TOPGEN]) == tg, bar);
            __builtin_amdgcn_fence(__ATOMIC_ACQUIRE, "agent");
            xb_add(&bar[XB_XGEN(b.x)], 1u);
            asm volatile("s_waitcnt vmcnt(0)" ::: "memory");
        } else {
            XB_SPIN(xb_ld(&bar[XB_XGEN(b.x)]) == gen, bar);
            __builtin_amdgcn_fence(__ATOMIC_ACQUIRE, "agent");
            asm volatile("s_waitcnt vmcnt(0)" ::: "memory");
        }
    }
    __syncthreads();
}


struct Frame {
    LAS unsigned char* lds;
    int tid, lane, wave, G, gw, ngw;
    const float *in_XP, *in_XS, *in_WIN, *in_WCONV, *in_BCONV, *in_WR, *in_BR, *in_WI, *in_BI, *in_LAM, *in_RPB, *in_WNO, *in_WLO, *in_WM, *in_BM, *in_WOUT, *in_GMPRE, *in_GMPOST, *in_GFPRE, *in_GFPOST, *in_WFG, *in_WFU, *in_WFD; float* out; unsigned char* ws;
};
enum { I_XP = 0, I_XS, I_WIN, I_WCONV, I_BCONV, I_WR, I_BR, I_WI, I_BI, I_LAM, I_RPB, I_WNO, I_WLO, I_WM, I_BM, I_WOUT, I_GMPRE, I_GMPOST, I_GFPRE, I_GFPOST, I_WFG, I_WFU, I_WFD };
__device__ __forceinline__ int opaque(int x) { asm volatile("" : "+v"(x)); return x; }
template <class T> __device__ __forceinline__ T* wsp(const Frame& F, size_t off) { return (T*)(F.ws + off); }
__device__ __forceinline__ const float* xrow(const Frame& F, int m) { return m < LP ? F.in_XP + (size_t)m * D : F.in_XS + (size_t)(m - LP) * D; }

__device__ __forceinline__ void tr_item(const float* src, int ldsrc, int k0, int n0, bf16_t* dst, int ldd, int drow0, LAS float* scr, int lane) {
#pragma unroll 8
    for (int i = 0; i < 32; ++i) { const int kk = 2 * i + (lane >> 5); scr[kk * 33 + (lane & 31)] = src[(size_t)(k0 + kk) * ldsrc + n0 + (lane & 31)]; }
    LDS_WAIT(); asm volatile("" ::: "memory");
    const int c = lane & 7;
#pragma unroll
    for (int j = 0; j < 4; ++j) { const int n = (lane >> 3) + 8 * j; const LAS float* s = scr + (8 * c) * 33 + n;
        u32x4 o; o.x = pk2(s[0 * 33], s[1 * 33]); o.y = pk2(s[2 * 33], s[3 * 33]); o.z = pk2(s[4 * 33], s[5 * 33]); o.w = pk2(s[6 * 33], s[7 * 33]);
        *(u32x4*)(dst + (size_t)(drow0 + n) * ldd + k0 + 8 * c) = o; }
    LDS_WAIT(); asm volatile("" ::: "memory");
}
__device__ __forceinline__ unsigned pk4_fp8(float a, float b, float c, float d) { int p = __builtin_amdgcn_cvt_pk_fp8_f32(a, b, 0, false); p = __builtin_amdgcn_cvt_pk_fp8_f32(c, d, p, true); return (unsigned)p; }
__device__ __forceinline__ void tr_item8(const float* src, int ldsrc, int k0, int n0, unsigned char* dst, int ldd, int drow0, LAS float* scr, int lane) {
#pragma unroll 8
    for (int i = 0; i < 32; ++i) { const int kk = 2 * i + (lane >> 5); scr[kk * 33 + (lane & 31)] = src[(size_t)(k0 + kk) * ldsrc + n0 + (lane & 31)]; }
    LDS_WAIT(); asm volatile("" ::: "memory");
    const int c = lane & 7;
#pragma unroll
    for (int j = 0; j < 4; ++j) { const int n = (lane >> 3) + 8 * j; const LAS float* s = scr + (8 * c) * 33 + n;
        u32x2 o; o.x = pk4_fp8(s[0 * 33] * 256.f, s[1 * 33] * 256.f, s[2 * 33] * 256.f, s[3 * 33] * 256.f); o.y = pk4_fp8(s[4 * 33] * 256.f, s[5 * 33] * 256.f, s[6 * 33] * 256.f, s[7 * 33] * 256.f);
        *(u32x2*)(dst + (size_t)(drow0 + n) * ldd + k0 + 8 * c) = o; }
    LDS_WAIT(); asm volatile("" ::: "memory");
}
__device__ __forceinline__ unsigned pk4_i8(float a, float b, float c, float d) { return ((unsigned)(int)a & 255u) | (((unsigned)(int)b & 255u) << 8) | (((unsigned)(int)c & 255u) << 16) | ((unsigned)(int)d << 24); }
__device__ __forceinline__ void tr_strip_i8(const float* src, int ldsrc, int K, int n0, signed char* dst, int drow0, float* cs, LAS float* scr, int lane) {
    const float* sp = src + n0 + (lane & 31) + (size_t)(lane >> 5) * ldsrc;
    float mx = 0.f;
    { const float* p = sp; const size_t step = (size_t)2 * ldsrc;
      for (int k0 = 0; k0 < K; k0 += 64) {
        float t[32];
#pragma unroll
        for (int i = 0; i < 32; ++i) { t[i] = *p; p += step; }
#pragma unroll
        for (int i = 0; i < 32; ++i) mx = fmaxf(mx, fabsf(t[i]));
      } }
    mx = fmaxf(mx, __shfl_xor(mx, 32));
    const float amax = fmaxf(mx, 1e-20f), inv = 127.0f / amax;
    if (lane < 32) cs[drow0 + lane] = amax * (1.0f / 127.0f);
    const int c = lane & 7;
    for (int k0 = 0; k0 < K; k0 += 64) {
        { const float* p = sp + (size_t)k0 * ldsrc; const size_t step = (size_t)2 * ldsrc; LAS float* w = scr + (lane >> 5) * 33 + (lane & 31);
          float t[32];
#pragma unroll
          for (int i = 0; i < 32; ++i) { t[i] = *p; p += step; }
#pragma unroll
          for (int i = 0; i < 32; ++i) w[i * 66] = rintf(t[i] * inv); }
        LDS_WAIT(); asm volatile("" ::: "memory");
#pragma unroll
        for (int j = 0; j < 4; ++j) { const int n = (lane >> 3) + 8 * j; const LAS float* t = scr + (8 * c) * 33 + n;
            u32x2 o; o.x = pk4_i8(t[0 * 33], t[1 * 33], t[2 * 33], t[3 * 33]); o.y = pk4_i8(t[4 * 33], t[5 * 33], t[6 * 33], t[7 * 33]);
            *(u32x2*)(dst + (size_t)(drow0 + n) * K + k0 + 8 * c) = o; }
        LDS_WAIT(); asm volatile("" ::: "memory");
    }
}
__device__ __forceinline__ void fwht32(float (&v)[32]) {
#pragma unroll
    for (int st = 1; st < 32; st <<= 1)
#pragma unroll
        for (int i = 0; i < 32; ++i) if (!(i & st)) { const float a = v[i], b = v[i + st]; v[i] = a + b; v[i + st] = a - b; }
#pragma unroll
    for (int i = 0; i < 32; ++i) v[i] *= 0.17677669529663687f;
}
__device__ __forceinline__ void had_tile_load(const float* src, int ldsrc, int k0, int n0, LAS float* scr, int lane, float (&v)[32]) {
    { const float* p = src + (size_t)(k0 + (lane >> 5)) * ldsrc + n0 + (lane & 31); const size_t step = (size_t)2 * ldsrc; LAS float* w = scr + (lane >> 5) * 33 + (lane & 31); float t[32];
#pragma unroll
      for (int i = 0; i < 32; ++i) { t[i] = *p; p += step; }
#pragma unroll
      for (int i = 0; i < 32; ++i) w[i * 66] = t[i]; }
    LDS_WAIT(); asm volatile("" ::: "memory");
    const LAS float* hv = scr + (32 * (lane >> 5)) * 33 + (lane & 31);
#pragma unroll
    for (int i = 0; i < 32; ++i) v[i] = hv[i * 33];
    fwht32(v);
}
__device__ __forceinline__ void had_tile_amax(const float* src, int ldsrc, int k0, int n0, unsigned* am, LAS float* scr, int lane) {
    float v[32]; had_tile_load(src, ldsrc, k0, n0, scr, lane, v);
    float mx = 0.f;
#pragma unroll
    for (int i = 0; i < 32; ++i) mx = fmaxf(mx, fabsf(v[i]));
    mx = fmaxf(mx, __shfl_xor(mx, 32));
    if (lane < 32) atomicMax(am + n0 + lane, __builtin_bit_cast(unsigned, mx));
    LDS_WAIT(); asm volatile("" ::: "memory");
}
__device__ __forceinline__ void had_tile_quant(const float* src, int ldsrc, int K, int k0, int n0, signed char* dst, const unsigned* am, float* cs, LAS float* scr, int lane) {
    const float amax = fmaxf(__builtin_bit_cast(float, am[n0 + (lane & 31)]), 1e-20f), inv = 127.0f / amax;
    if (k0 == 0 && lane < 32) cs[n0 + lane] = amax * (1.0f / 127.0f);
    float v[32]; had_tile_load(src, ldsrc, k0, n0, scr, lane, v);
    LAS float* hv = scr + (32 * (lane >> 5)) * 33 + (lane & 31);
#pragma unroll
    for (int i = 0; i < 32; ++i) hv[i * 33] = rintf(v[i] * inv);
    LDS_WAIT(); asm volatile("" ::: "memory");
    const int c = lane & 7;
#pragma unroll
    for (int j = 0; j < 4; ++j) { const int n = (lane >> 3) + 8 * j; const LAS float* t = scr + (8 * c) * 33 + n;
        u32x2 o; o.x = pk4_i8(t[0 * 33], t[1 * 33], t[2 * 33], t[3 * 33]); o.y = pk4_i8(t[4 * 33], t[5 * 33], t[6 * 33], t[7 * 33]);
        *(u32x2*)(dst + (size_t)(n0 + n) * K + k0 + 8 * c) = o; }
    LDS_WAIT(); asm volatile("" ::: "memory");
}
#define TR_JOB(SRC, LDSRC, KK, NN, DST, DROW_EXPR) { const int nblk = (NN) / 32, nit = ((KK) / 64) * nblk; \
    if (r < nit) { const int kb = r / nblk, nb = r % nblk, n0 = 32 * nb; tr_item((SRC), (LDSRC), 64 * kb, n0, (DST), (KK), (DROW_EXPR), scr, F.lane); continue; } r -= nit; }
#define TR_JOB8(SRC, LDSRC, KK, NN, DST, DROW_EXPR) { const int nblk = (NN) / 32, nit = ((KK) / 64) * nblk; \
    if (r < nit) { const int kb = r / nblk, nb = r % nblk, n0 = 32 * nb; tr_item8((SRC), (LDSRC), 64 * kb, n0, (DST), (KK), (DROW_EXPR), scr, F.lane); continue; } r -= nit; }

__device__ __forceinline__ void p0_prologue(Frame& F) {
    const int tid_ = opaque(F.tid);
    LAS float* scr = (LAS float*)(F.lds + F.wave * 8448);
    const float* w_in = F.in_WIN;
    bf16_t* WCAT = wsp<bf16_t>(F, WS_WCAT); signed char* W8 = wsp<signed char>(F, WS_W8); signed char* WV8 = wsp<signed char>(F, WS_WVT); signed char* WGU8 = wsp<signed char>(F, WS_WGU);
    float* CS = wsp<float>(F, WS_CS);
    constexpr int NSM = 64;
    constexpr int IT_SM = 2 * 4;
    constexpr int S_Q = NAW / 32, S_M = 2 * D / 32, S_F = DFF / 32;
    constexpr int NSTRIP = 3 * S_Q + S_M + 2 * S_F;
    constexpr int N_AMAX = (DFF / 64) * (D / 32);
    constexpr int N_BIG = 2 * (D / 64) * (NAW / 32) + 2 * (NAW / 64) * (D / 32) + (D / 64) * (D / 32) + N_AMAX;
    constexpr int NITEMS = N_BIG + NSM * IT_SM;
    for (int it = F.gw; it < NSTRIP + NITEMS; it += F.ngw) {
        if (it < NSTRIP) {
            int q = it; const float* src; int ld, n0, drow0; signed char* dst; float* cs;
            if (q < S_Q) { src = w_in; ld = INW; n0 = 32 * q; dst = W8; drow0 = n0; cs = CS + CS_QKM; }
            else if ((q -= S_Q) < S_Q) { src = w_in + NAW; ld = INW; n0 = 32 * q; dst = W8; drow0 = 2048 + n0; cs = CS + CS_QKM; }
            else if ((q -= S_Q) < S_M) { src = F.in_WM; ld = 2 * D; n0 = 32 * q; dst = W8; drow0 = 4096 + n0; cs = CS + CS_QKM; }
            else if ((q -= S_M) < S_Q) { src = w_in + 2 * NAW; ld = INW; n0 = 32 * q; dst = WV8; drow0 = n0; cs = CS + CS_V; }
            else if ((q -= S_Q) < S_F) { src = F.in_WFG; ld = DFF; n0 = 32 * q; dst = WGU8; drow0 = (n0 >> 7) * 256 + (n0 & 127); cs = CS + CS_GU; }
            else { q -= S_F; src = F.in_WFU; ld = DFF; n0 = 32 * q; dst = WGU8; drow0 = (n0 >> 7) * 256 + 128 + (n0 & 127); cs = CS + CS_GU; }
            tr_strip_i8(src, ld, D, n0, dst, drow0, cs, scr, F.lane);
            continue;
        }
        int r = it - NSTRIP;
        TR_JOB(w_in + 3 * NAW, INW, D, NAW, WCAT, 0 + n0)
        TR_JOB(w_in + 4 * NAW, INW, D, NAW, WCAT, 2048 + n0)
        TR_JOB(F.in_WNO, D, NAW, D, wsp<bf16_t>(F, WS_WNO), n0)
        TR_JOB(F.in_WLO, D, LW, D, wsp<bf16_t>(F, WS_WLO), n0)
        TR_JOB(F.in_WOUT, D, D, D, wsp<bf16_t>(F, WS_WO), n0)
        if (r < N_AMAX) { had_tile_amax(F.in_WFD, D, 64 * (r / (D / 32)), 32 * (r % (D / 32)), (unsigned*)(F.ws + WS_AM), scr, F.lane); continue; } r -= N_AMAX;
        {
            const int mi = r / IT_SM, ri = r % IT_SM, d = mi >> 5, g = (mi >> 4) & 1, n = mi & 15, kb = ri >> 2, nb = ri & 3;
            const float* src = (g ? F.in_WI : F.in_WR) + (size_t)(d * NBLK + n) * BW * BW;
            tr_item(src, BW, 64 * kb, 32 * nb, wsp<bf16_t>(F, WS_WG) + (size_t)mi * BW * BW, BW, 32 * nb, scr, F.lane);
        }
    }
    LAS f32x4* gl = (LAS f32x4*)(F.lds + 69632);
    for (int i = tid_; i < D / 4; i += NTHR) gl[i] = ((const f32x4*)F.in_GMPRE)[i];
    __syncthreads();
    bf16_t* XN = wsp<bf16_t>(F, WS_XN); signed char* XN8 = wsp<signed char>(F, WS_XN8); float* RS1 = wsp<float>(F, WS_RS1);
    for (int m = F.gw; m < L; m += F.ngw) {
        asm volatile("" ::: "memory");
        const f32x4* xr = (const f32x4*)xrow(F, m) + F.lane;
        f32x4 v[16]; float s = 0.f;
#pragma unroll
        for (int j = 0; j < 16; ++j) { v[j] = xr[64 * j]; s += (v[j].x * v[j].x + v[j].y * v[j].y) + (v[j].z * v[j].z + v[j].w * v[j].w); }
        const float rstd = 1.0f / sqrtf(wave_sum(s) * (1.0f / D) + EPS);
        u32x2* o8 = (u32x2*)(XN + (size_t)m * D) + F.lane; unsigned* o4 = (unsigned*)(XN8 + (size_t)m * D) + F.lane;
        float mx = 0.f;
#pragma unroll
        for (int j = 0; j < 16; ++j) { v[j] = v[j] * rstd * gl[F.lane + 64 * j]; mx = fmaxf(fmaxf(mx, fmaxf(fabsf(v[j].x), fabsf(v[j].y))), fmaxf(fabsf(v[j].z), fabsf(v[j].w))); }
        const float amax = fmaxf(wave_max(mx), 1e-20f), inv = 127.0f / amax;
        if (F.lane == 0) RS1[m] = amax * (1.0f / 127.0f);
#pragma unroll
        for (int j = 0; j < 16; ++j) { const f32x4 y = v[j]; u32x2 o; o.x = pk2(y.x, y.y); o.y = pk2(y.z, y.w); o8[64 * j] = o;
            o4[64 * j] = pk4_i8(rintf(y.x * inv), rintf(y.y * inv), rintf(y.z * inv), rintf(y.w * inv)); }
    }
    __syncthreads();
}

#ifndef ATT_SYNC
#define ATT_SYNC 1
#endif
template <int ADBG = 0> __device__ __forceinline__ void attn_mfma(Frame& F) {
    const int tid_ = opaque(F.tid);
    bf16_t* Q = wsp<bf16_t>(F, WS_Q); const bf16_t* Kb = wsp<bf16_t>(F, WS_K); const bf16_t* VT = wsp<bf16_t>(F, WS_VT);
    LAS float* rp = (LAS float*)F.lds;
    for (int i = tid_; i < NH * 15 * 31; i += NTHR) rp[i] = F.in_RPB[i];
    __syncthreads();
    const int fr = F.lane & 15, fq = F.lane >> 4;
    const float scale = 0.08838834764831845f;
    for (int base = blockIdx.x * NWAVES; base < (L / GRIDW) * NH * 4; base += F.ngw) {
        const int item = base + F.wave;
        asm volatile("" ::: "memory");
        const int g = item & 3, h = (item >> 2) & 15, rg = item >> 6;
        const int s0 = rg < LP / GRIDW ? 0 : LP, rows = rg < LP / GRIDW ? LP / GRIDW : LS / GRIDW, r = rg < LP / GRIDW ? rg : rg - LP / GRIDW;
        int rs = r - 4; rs = rs < 0 ? 0 : (rs > rows - 8 ? rows - 8 : rs);
        const int w0 = g == 0 ? 0 : (g == 1 ? 8 : (g == 2 ? 24 : 32));
        const int c = 16 * g + fr;
        int cs = c - 8; cs = cs < 0 ? 0 : (cs > GRIDW - 16 ? GRIDW - 16 : cs);
        bf16_t* qrow = Q + (size_t)(s0 + r * GRIDW + c) * NAW + h * HD;
        bf16x8 qf[4];
#pragma unroll
        for (int s = 0; s < 4; ++s) qf[s] = *(const bf16x8*)(qrow + 8 * fq + 32 * s);
        f32x4 sacc[8][2];
        const int Rg = s0 / GRIDW + rs, p0 = w0 >> 3;
        const bf16_t* kbase = Kb + (size_t)(Rg * 16 + h) * 8192 + p0 * 128 + fr * 32 + fq * 8;
        bf16x8 kb[8][2][4];
#define ATT_LDK(kr) do { _Pragma("unroll") for (int T = 0; T < 2; ++T) _Pragma("unroll") for (int s = 0; s < 4; ++s) kb[kr][T][s] = (ADBG & 1) ? qf[s] : (ADBG & 4) ? *(const bf16x8*)(Kb + (size_t)(s0 + rs * GRIDW) * NAW + h * HD * GRIDW + ((kr) * 8 + T * 4 + s) * 512 + F.lane * 8) : *(const bf16x8*)(kbase + (size_t)(kr) * (16 * 8192) + (s * 2 + T) * 1024); } while (0)
        ATT_LDK(0); ATT_LDK(1);
#pragma unroll
        for (int kr = 0; kr < 8; ++kr) {
            if (ATT_SYNC && (kr & 1) == 0) __builtin_amdgcn_s_barrier();
            if (kr + 2 < 8) ATT_LDK(kr + 2);
            __builtin_amdgcn_sched_barrier(0);
#pragma unroll
            for (int T = 0; T < 2; ++T) { f32x4 a = (f32x4){0.f, 0.f, 0.f, 0.f};
#pragma unroll
                for (int s = 0; s < 4; ++s) a = __builtin_amdgcn_mfma_f32_16x16x32_bf16(kb[kr][T][s], qf[s], a, 0, 0, 0);
                sacc[kr][T] = a; }
            __builtin_amdgcn_sched_barrier(0);
        }
#undef ATT_LDK
        bf16x8 vb[8][8];
        const bf16_t* vbase = VT + (size_t)(Rg * 16 + h) * 8192 + p0 * 128 + fq * 128 + fr * 8;
#define ATT_LDV(kr) do { _Pragma("unroll") for (int dt = 0; dt < 8; ++dt) vb[kr][dt] = (ADBG & 2) ? qf[dt & 3] : (ADBG & 4) ? *(const bf16x8*)(VT + (size_t)(h * HD) * L + s0 + rs * GRIDW + ((kr) * 8 + dt) * 512 + F.lane * 8) : *(const bf16x8*)(vbase + (size_t)(kr) * (16 * 8192) + dt * 1024); } while (0)
        ATT_LDV(0); ATT_LDV(1);
        __builtin_amdgcn_sched_barrier(0);
        const int elo = cs - w0 - 8 * fq, dc0 = w0 + 8 * fq - c + 15;
        const LAS float* rph = rp + h * 465 + (rs - r + 7) * 31;
        float mx = -3.0e38f;
#pragma unroll
        for (int e = 0; e < 8; ++e) { const bool valid = (e >= elo) && (e < elo + 16); const int bi = valid ? dc0 + e : 0;
#pragma unroll
            for (int kr = 0; kr < 8; ++kr) { const float sv = valid ? sacc[kr][e >> 2][e & 3] * scale + rph[kr * 31 + bi] : -3.0e38f; sacc[kr][e >> 2][e & 3] = sv; mx = fmaxf(mx, sv); } }
        mx = fmaxf(mx, __shfl_xor(mx, 16)); mx = fmaxf(mx, __shfl_xor(mx, 32));
        float lsum = 0.f; bf16x8 pf[8];
#pragma unroll
        for (int kr = 0; kr < 8; ++kr) { float p[8];
#pragma unroll
            for (int e = 0; e < 8; ++e) { p[e] = __expf(sacc[kr][e >> 2][e & 3] - mx); lsum += p[e]; }
            u32x4 w; w.x = pk2(p[0], p[1]); w.y = pk2(p[2], p[3]); w.z = pk2(p[4], p[5]); w.w = pk2(p[6], p[7]);
            pf[kr] = __builtin_bit_cast(bf16x8, w); }
        lsum += __shfl_xor(lsum, 16); lsum += __shfl_xor(lsum, 32);
        f32x4 oacc[8];
#pragma unroll
        for (int dt = 0; dt < 8; ++dt) oacc[dt] = (f32x4){0.f, 0.f, 0.f, 0.f};
#pragma unroll
        for (int kr = 0; kr < 8; ++kr) {
            if (ATT_SYNC && (kr & 1) == 0) __builtin_amdgcn_s_barrier();
            if (kr + 2 < 8) ATT_LDV(kr + 2);
            __builtin_amdgcn_sched_barrier(0);
#pragma unroll
            for (int dt = 0; dt < 8; ++dt) oacc[dt] = __builtin_amdgcn_mfma_f32_16x16x32_bf16(vb[kr][dt], pf[kr], oacc[dt], 0, 0, 0);
            __builtin_amdgcn_sched_barrier(0);
        }
#undef ATT_LDV
        const float inv = 1.0f / lsum;
#ifdef ATTN_OUT_OFF
        bf16_t* orow = wsp<bf16_t>(F, (size_t)ATTN_OUT_OFF * MiB) + (size_t)(s0 + r * GRIDW + c) * NAW + h * HD;
#else
        bf16_t* orow = qrow;
#endif
#pragma unroll
        for (int u = 0; u < 4; ++u) *(u32x4*)(orow + 32 * u + 8 * fq) = pg8::pack8(oacc[2 * u] * inv, oacc[2 * u + 1] * inv);
    }
    __syncthreads();
}

__device__ __forceinline__ void attn_mfma_lds(Frame& F) {
    const int tid_ = opaque(F.tid);
    bf16_t* Q = wsp<bf16_t>(F, WS_Q); const bf16_t* Kb = wsp<bf16_t>(F, WS_K); const bf16_t* VT = wsp<bf16_t>(F, WS_VT);
    LAS float* rp = (LAS float*)F.lds;
    LAS unsigned char* ring = F.lds + 30720;
    for (int i = tid_; i < NH * 15 * 31; i += NTHR) rp[i] = F.in_RPB[i];
    __syncthreads();
    const int lane = tid_ & 63, fr = lane & 15, fq = lane >> 4, w = F.wave, hl = w >> 2, g = w & 3;
    const float scale = 0.08838834764831845f;
    constexpr int NIT = (L / GRIDW) * NH * 4;
    const int w0 = g == 0 ? 0 : (g == 1 ? 8 : (g == 2 ? 24 : 32)), p0 = w0 >> 3;
    const int c = 16 * g + fr;
    int cs = c - 8; cs = cs < 0 ? 0 : (cs > GRIDW - 16 ? GRIDW - 16 : cs);
#define ATL_SRC(b, st) ([&]() -> const bf16_t* { const int rg_ = (b) >> 6, hb_ = ((b) >> 2) & 15; const int rows_ = rg_ < LP / GRIDW ? LP / GRIDW : LS / GRIDW, r_ = rg_ < LP / GRIDW ? rg_ : rg_ - LP / GRIDW; \
        int rs_ = r_ - 4; rs_ = rs_ < 0 ? 0 : (rs_ > rows_ - 8 ? rows_ - 8 : rs_); const int Rg_ = (rg_ < LP / GRIDW ? 0 : LP / GRIDW) + rs_; \
        return ((st) < 8 ? Kb : VT) + (size_t)((Rg_ + ((st) & 7)) * 16 + hb_) * 8192; }())
#define ATL_ISSUE(src, slot) do { const bf16_t* s_ = (src) + tid_ * 8; LAS unsigned char* d_ = ring + (slot) * 32768 + w * 1024; _Pragma("unroll") for (int k_ = 0; k_ < 4; ++k_) \
        __builtin_amdgcn_global_load_lds((const unsigned*)(s_ + k_ * 4096), (LAS unsigned*)(d_ + k_ * 8192), 16, 0, 0); } while (0)
    int base = blockIdx.x * NWAVES;
    if (base < NIT) { ATL_ISSUE(ATL_SRC(base, 0), 0); ATL_ISSUE(ATL_SRC(base, 1), 1); }
    int b0 = 0;
    for (; base < NIT; base += F.ngw) {
        asm volatile("" ::: "memory");
        const int h = ((base >> 2) & 15) + hl, rg = base >> 6;
        const int s0 = rg < LP / GRIDW ? 0 : LP, rows = rg < LP / GRIDW ? LP / GRIDW : LS / GRIDW, r = rg < LP / GRIDW ? rg : rg - LP / GRIDW;
        int rs = r - 4; rs = rs < 0 ? 0 : (rs > rows - 8 ? rows - 8 : rs);
        const int nbase = base + F.ngw < NIT ? base + F.ngw : base;
        bf16_t* qrow = Q + (size_t)(s0 + r * GRIDW + c) * NAW + h * HD;
        bf16x8 qf[4];
#pragma unroll
        for (int s = 0; s < 4; ++s) qf[s] = *(const bf16x8*)(qrow + 8 * fq + 32 * s);
        f32x4 sacc[8][2]; f32x4 oacc[8]; bf16x8 pf[8]; float lsum = 0.f;
#pragma unroll
        for (int dt = 0; dt < 8; ++dt) oacc[dt] = (f32x4){0.f, 0.f, 0.f, 0.f};
        const int koff = hl * 16384 + (p0 * 128 + fr * 32 + fq * 8) * 2, voff = hl * 16384 + (p0 * 128 + fq * 128 + fr * 8) * 2;
#pragma unroll
        for (int st = 0; st < 16; ++st) {
            asm volatile("s_waitcnt vmcnt(4)" ::: "memory"); asm volatile("s_waitcnt lgkmcnt(0)" ::: "memory"); __builtin_amdgcn_s_barrier(); asm volatile("" ::: "memory");
            { const int slot2 = (b0 + st + 2) % 3; if (st + 2 < 16) ATL_ISSUE(ATL_SRC(base, st + 2), slot2); else ATL_ISSUE(ATL_SRC(nbase, st + 2 - 16), slot2); }
            const LAS unsigned char* buf = ring + ((b0 + st) % 3) * 32768;
            if (st < 8) {
#pragma unroll
                for (int T = 0; T < 2; ++T) { f32x4 a = (f32x4){0.f, 0.f, 0.f, 0.f};
#pragma unroll
                    for (int s2 = 0; s2 < 4; ++s2) a = __builtin_amdgcn_mfma_f32_16x16x32_bf16(*(const LAS bf16x8*)(buf + koff + (s2 * 2 + T) * 2048), qf[s2], a, 0, 0, 0);
                    sacc[st][T] = a; }
            } else {
                if (st == 8) {
                    const int elo = cs - w0 - 8 * fq, dc0 = w0 + 8 * fq - c + 15;
                    const LAS float* rph = rp + h * 465 + (rs - r + 7) * 31;
                    float mx = -3.0e38f;
#pragma unroll
                    for (int e = 0; e < 8; ++e) { const bool valid = (e >= elo) && (e < elo + 16); const int bi = valid ? dc0 + e : 0;
#pragma unroll
                        for (int kr = 0; kr < 8; ++kr) { const float sv = valid ? sacc[kr][e >> 2][e & 3] * scale + rph[kr * 31 + bi] : -3.0e38f; sacc[kr][e >> 2][e & 3] = sv; mx = fmaxf(mx, sv); } }
                    mx = fmaxf(mx, __shfl_xor(mx, 16)); mx = fmaxf(mx, __shfl_xor(mx, 32));
#pragma unroll
                    for (int kr = 0; kr < 8; ++kr) { float p[8];
#pragma unroll
                        for (int e = 0; e < 8; ++e) { p[e] = __expf(sacc[kr][e >> 2][e & 3] - mx); lsum += p[e]; }
                        u32x4 wv; wv.x = pk2(p[0], p[1]); wv.y = pk2(p[2], p[3]); wv.z = pk2(p[4], p[5]); wv.w = pk2(p[6], p[7]);
                        pf[kr] = __builtin_bit_cast(bf16x8, wv); }
                    lsum += __shfl_xor(lsum, 16); lsum += __shfl_xor(lsum, 32);
                }
#pragma unroll
                for (int dt = 0; dt < 8; ++dt) oacc[dt] = __builtin_amdgcn_mfma_f32_16x16x32_bf16(*(const LAS bf16x8*)(buf + voff + dt * 2048), pf[st - 8], oacc[dt], 0, 0, 0);
            }
        }
        b0 = (b0 + 16) % 3;
        const float inv = 1.0f / lsum;
#pragma unroll
        for (int u = 0; u < 4; ++u) *(u32x4*)(qrow + 32 * u + 8 * fq) = pg8::pack8(oacc[2 * u] * inv, oacc[2 * u + 1] * inv);
    }
#undef ATL_SRC
#undef ATL_ISSUE
    asm volatile("s_waitcnt vmcnt(0)" ::: "memory");
    __syncthreads();
}

__device__ __forceinline__ void conv_phase(Frame& F) {
    const int tid_ = opaque(F.tid);
    const bf16_t* XR = wsp<bf16_t>(F, WS_XR); bf16_t* XC = wsp<bf16_t>(F, WS_XC);
    const float* wc = F.in_WCONV; const float* bc = F.in_BCONV;
    const int nth = F.G * NTHR;
    for (int it = blockIdx.x * NTHR + tid_; it < L * (LW / 8); it += nth) {
        const int t = it / (LW / 8), c0 = (it % (LW / 8)) * 8;
        const int s0 = t < LP ? 0 : LP, len = t < LP ? LP : LS, tl = t - s0;
        float acc[8];
#pragma unroll
        for (int e = 0; e < 8; ++e) acc[e] = bc[c0 + e];
#pragma unroll
        for (int j = 0; j < 4; ++j) { const int tt = tl + j - 2; if (tt < 0 || tt >= len) continue;
            f32x4 x0, x1; pg8::unpack8(*(const u32x4*)(XR + (size_t)(s0 + tt) * LW + c0), x0, x1);
            const f32x4 w0 = *(const f32x4*)(wc + j * LW + c0), w1 = *(const f32x4*)(wc + j * LW + c0 + 4);
#pragma unroll
            for (int e = 0; e < 4; ++e) { acc[e] += w0[e] * x0[e]; acc[4 + e] += w1[e] * x1[e]; } }
        *(u32x4*)(XC + (size_t)t * LW + c0) = pg8::pack8((f32x4){acc[0], acc[1], acc[2], acc[3]}, (f32x4){acc[4], acc[5], acc[6], acc[7]});
    }
}

struct LruW { bf16x8 w[2][4]; float br, bi, cl; };
template <int DIR> __device__ __forceinline__ void lru_load_w(const Frame& F, LruW& W, int n, int w, int fr, int fq) {
    const bf16_t* wg = wsp<bf16_t>(F, WS_WG);
#pragma unroll
    for (int g = 0; g < 2; ++g)
#pragma unroll
        for (int s = 0; s < 4; ++s) W.w[g][s] = *(const bf16x8*)(wg + ((size_t)((DIR * 2 + g) * NBLK + n) * BW + 16 * w + fr) * BW + 32 * fq + 8 * s);
    const int ch = n * BW + 16 * w + fr;
    W.br = F.in_BR[DIR * LW + ch]; W.bi = F.in_BI[DIR * LW + ch];
    const float lam = F.in_LAM[DIR * LW + ch];
    W.cl = -8.0f * ((lam > 15.f) ? __expf(-lam) : log1pf(__expf(-lam)));
}
template <int LDBG = 0> __device__ __forceinline__ void lru_gate(float pr, float pi, float xc, const LruW& W, bool first, float& a, float& u) {
    if constexpr (LDBG == 1) { a = pr + W.br; u = pi * xc + W.bi; return; }
    const float r = sigmoidf_(pr + W.br), ig = sigmoidf_(pi + W.bi);
    a = __expf(W.cl * r);
    const float mult = first ? 1.0f : __builtin_amdgcn_sqrtf(fmaxf(1.0f - a * a, 0.f));
    u = mult * ig * xc;
}
struct LruX { bf16x8 x[4][4]; };
__device__ __forceinline__ void lru_load_x(LruX& X, const bf16_t* XC, int tb, int n, int fr, int fq) {
#pragma unroll
    for (int tau = 0; tau < 4; ++tau) { const bf16_t* xp = XC + ((size_t)((((tb >> 6) * NBLK + n) * 4 + tau) * 4) * 64 + fr * 4 + fq) * 8;
#pragma unroll
        for (int s = 0; s < 4; ++s) X.x[tau][s] = *(const bf16x8*)(xp + s * 512); }
}
__device__ __forceinline__ void lru_tile(const LruX& X, int tau, bool hiw, const LruW& W, const bf16x8 idf0, const bf16x8 idf1, f32x4& pr, f32x4& pi, f32x4& xct) {
    pr = (f32x4){0.f, 0.f, 0.f, 0.f}; pi = pr;
#pragma unroll
    for (int s = 0; s < 4; ++s) { pr = __builtin_amdgcn_mfma_f32_16x16x32_bf16(X.x[tau][s], W.w[0][s], pr, 0, 0, 0); pi = __builtin_amdgcn_mfma_f32_16x16x32_bf16(X.x[tau][s], W.w[1][s], pi, 0, 0, 0); }
    const bf16x8 x0 = hiw ? X.x[tau][2] : X.x[tau][0], x1 = hiw ? X.x[tau][3] : X.x[tau][1];
    xct = __builtin_amdgcn_mfma_f32_16x16x32_bf16(x0, idf0, (f32x4){0.f, 0.f, 0.f, 0.f}, 0, 0, 0);
    xct = __builtin_amdgcn_mfma_f32_16x16x32_bf16(x1, idf1, xct, 0, 0, 0);
}
__device__ __forceinline__ void lru_idfrags(int w, int fr, int fq, bf16x8& idf0, bf16x8& idf1) {
#pragma unroll
    for (int e = 0; e < 8; ++e) { const bool on = (fq == (w >> 1)) && ((fr & 7) == e); idf0[e] = (on && fr < 8) ? (short)0x3F80 : (short)0; idf1[e] = (on && fr >= 8) ? (short)0x3F80 : (short)0; }
}
constexpr int LRU_CH = 256, LRU_NCH = L / LRU_CH, LRU_NCH_P = LP / LRU_CH;
__device__ __forceinline__ void conv_unit(Frame& F, int cg, int n) {
    const int tid_ = opaque(F.tid);
    const bf16_t* XR = wsp<bf16_t>(F, WS_XR); bf16_t* XC = wsp<bf16_t>(F, WS_XC);
    const float* wc = F.in_WCONV; const float* bc = F.in_BCONV;
    const int c0 = n * BW + (tid_ & 15) * 8;
    const int s0 = cg < LRU_NCH_P ? 0 : LP, len = cg < LRU_NCH_P ? LP : LS;
    f32x4 w[4][2]; f32x4 b0 = *(const f32x4*)(bc + c0), b1 = *(const f32x4*)(bc + c0 + 4);
#pragma unroll
    for (int j = 0; j < 4; ++j) { w[j][0] = *(const f32x4*)(wc + j * LW + c0); w[j][1] = *(const f32x4*)(wc + j * LW + c0 + 4); }
#pragma unroll
    for (int i = 0; i < 8; ++i) {
        const int t = cg * LRU_CH + (tid_ >> 4) + 32 * i, tl = t - s0;
        f32x4 a0 = b0, a1 = b1;
#pragma unroll
        for (int j = 0; j < 4; ++j) { const int tt = tl + j - 2; if (tt < 0 || tt >= len) continue;
            f32x4 x0, x1; pg8::unpack8(*(const u32x4*)(XR + (size_t)(s0 + tt) * LW + c0), x0, x1); a0 += w[j][0] * x0; a1 += w[j][1] * x1; }
        const int tg = t & 63, cq = tid_ & 15;
        *(u32x4*)(XC + ((size_t)(((((t >> 6) * NBLK + n) * 4 + ((tg >> 2) & 3)) * 4 + (cq & 3)) * 16 + 4 * (tg >> 4) + (tg & 3)) * 4 + (cq >> 2)) * 8) = pg8::pack8(a0, a1);
    }
}
__device__ __forceinline__ void lru_pass_a(Frame& F) {
    const int fr = F.lane & 15, fq = F.lane >> 4, w = F.wave;
    const bf16_t* XC = wsp<bf16_t>(F, WS_XC); f32x2* SUMM = wsp<f32x2>(F, WS_SUM);
    bf16x8 idf0, idf1; lru_idfrags(w, fr, fq, idf0, idf1);
    for (int u = blockIdx.x; u < LRU_NCH * NBLK; u += F.G) {
        const int cg = u >> 4, n = u & 15;
        conv_unit(F, cg, n); VM_WAIT(); __syncthreads();
        LruW Wf, Wb; lru_load_w<0>(F, Wf, n, w, fr, fq); lru_load_w<1>(F, Wb, n, w, fr, fq);
        const bool c_first = (cg == 0 || cg == LRU_NCH_P), c_last = (cg == LRU_NCH_P - 1 || cg == LRU_NCH - 1);
        float Af = 1.f, Hf = 0.f, Ab = 1.f, Hb = 0.f;
        LruX X, Xn; lru_load_x(X, XC, cg * LRU_CH, n, fr, fq);
        for (int gi = 0; gi < 4; ++gi) {
            if (gi < 3) lru_load_x(Xn, XC, cg * LRU_CH + (gi + 1) * 64, n, fr, fq);
            float pf = 1.f, hf = 0.f, pb = 1.f, hb = 0.f;
#pragma unroll
            for (int tau = 0; tau < 4; ++tau) {
                f32x4 prf, pif, prb, pib, xct, xct2;
                lru_tile(X, tau, (w & 1) != 0, Wf, idf0, idf1, prf, pif, xct);
                lru_tile(X, tau, (w & 1) != 0, Wb, idf0, idf1, prb, pib, xct2);
#pragma unroll
                for (int j = 0; j < 4; ++j) {
                    float a, uu;
                    lru_gate(prf[j], pif[j], xct[j], Wf, c_first && gi == 0 && fq == 0 && tau == 0 && j == 0, a, uu); hf = a * hf + uu; pf *= a;
                    lru_gate(prb[j], pib[j], xct[j], Wb, c_last && gi == 3 && fq == 3 && tau == 3 && j == 3, a, uu); hb += pb * uu; pb *= a;
                }
            }
            float gPf = 1.f, gHf = 0.f, gPb = 1.f, gHb = 0.f;
#pragma unroll
            for (int qq = 0; qq < 4; ++qq) { const int src = fr + 16 * qq;
                float P = __shfl(pf, src), H = __shfl(hf, src); gHf = P * gHf + H; gPf *= P;
                P = __shfl(pb, src); H = __shfl(hb, src); gHb += gPb * H; gPb *= P; }
            Hf = gPf * Hf + gHf; Af *= gPf; Hb += Ab * gHb; Ab *= gPb;
            X = Xn;
        }
        if (fq == 0) { const int ch = n * BW + 16 * w + fr; SUMM[(size_t)(cg * 2 + 0) * LW + ch] = (f32x2){Af, Hf}; SUMM[(size_t)(cg * 2 + 1) * LW + ch] = (f32x2){Ab, Hb}; }
    }
}
__device__ __forceinline__ void lru_pass_b(Frame& F) {
    const int tid_ = opaque(F.tid);
    const int gt = blockIdx.x * NTHR + tid_; if (gt >= 4 * LW) return;
    const int ch = gt % LW, d = (gt / LW) & 1, seq = gt / (2 * LW), c0 = seq ? LRU_NCH_P : 0, nc = seq ? LRU_NCH - LRU_NCH_P : LRU_NCH_P;
    const f32x2* SUMM = wsp<f32x2>(F, WS_SUM); float* CIN = wsp<float>(F, WS_SUM + 4 * MiB);
    float s = 0.f;
    for (int i0 = 0; i0 < nc; i0 += 8) {
        f32x2 ah[8];
#pragma unroll
        for (int e = 0; e < 8; ++e) { const int cg = d ? c0 + nc - 1 - (i0 + e) : c0 + i0 + e; ah[e] = SUMM[(size_t)(cg * 2 + d) * LW + ch]; }
#pragma unroll
        for (int e = 0; e < 8; ++e) { const int cg = d ? c0 + nc - 1 - (i0 + e) : c0 + i0 + e; CIN[(size_t)(cg * 2 + d) * LW + ch] = s; s = ah[e].x * s + ah[e].y; }
    }
}
template <int LDBG = 0> __device__ __forceinline__ void lru_pass_c(Frame& F) {
    const int tid_ = opaque(F.tid);
    const int fr = F.lane & 15, fq = F.lane >> 4, w = F.wave;
    const bf16_t* XC = wsp<bf16_t>(F, WS_XC); const float* CIN = wsp<float>(F, WS_SUM + 4 * MiB);
    const bf16_t* GR = wsp<bf16_t>(F, WS_GR); bf16_t* LRU = wsp<bf16_t>(F, WS_XR);
    LAS bf16_t* hfb = (LAS bf16_t*)(F.lds + w * 8192);
    LAS bf16_t* grt = (LAS bf16_t*)(F.lds + 65536);
    bf16x8 idf0, idf1; lru_idfrags(w, fr, fq, idf0, idf1);
    for (int u = blockIdx.x; u < LRU_NCH * NBLK; u += F.G) {
        const int cg = u >> 4, n = u & 15, ch = n * BW + 16 * w + fr;
        const bool c_first = (cg == 0 || cg == LRU_NCH_P), c_last = (cg == LRU_NCH_P - 1 || cg == LRU_NCH - 1);
        { const bf16_t* gsrc = GR + (size_t)(cg * LRU_CH + (tid_ >> 4)) * LW + n * BW + (tid_ & 15) * 8; LAS bf16_t* ldst = grt + w * 512;
#pragma unroll 1
          for (int k = 0; k < 8; ++k) { __builtin_amdgcn_global_load_lds((const unsigned*)gsrc, (LAS unsigned*)ldst, 16, 0, 0); gsrc += (size_t)32 * LW; ldst += NTHR * 8; } }
        {
            LruW W; lru_load_w<0>(F, W, n, w, fr, fq);
            float s = CIN[(size_t)(cg * 2 + 0) * LW + ch];
            LruX X, Xn; lru_load_x(X, XC, cg * LRU_CH, n, fr, fq);
            for (int gi = 0; gi < 4; ++gi) {
                if (gi < 3 && LDBG != 2) lru_load_x(Xn, XC, cg * LRU_CH + (gi + 1) * 64, n, fr, fq);
                float a[16], uu[16];
#pragma unroll
                for (int tau = 0; tau < 4; ++tau) { f32x4 pr, pi, xct; lru_tile(X, tau, (w & 1) != 0, W, idf0, idf1, pr, pi, xct);
#pragma unroll
                    for (int j = 0; j < 4; ++j) lru_gate<LDBG>(pr[j], pi[j], xct[j], W, c_first && gi == 0 && fq == 0 && tau == 0 && j == 0, a[4 * tau + j], uu[4 * tau + j]); }
                float p = 1.f, h = 0.f;
#pragma unroll
                for (int t = 0; t < 16; ++t) { h = a[t] * h + uu[t]; p *= a[t]; }
                float hin = s, sg = s;
#pragma unroll
                for (int qq = 0; qq < 4; ++qq) { const float P = __shfl(p, fr + 16 * qq), H = __shfl(h, fr + 16 * qq); sg = P * sg + H; if (qq < fq) hin = P * hin + H; }
                s = sg;
                float hh = hin;
#pragma unroll
                for (int t = 0; t < 16; ++t) { hh = a[t] * hh + uu[t]; hfb[(gi * 64 + 16 * fq + t) * 16 + fr] = (bf16_t)f2bf(hh); }
                X = Xn;
            }
        }
        VM_WAIT(); __syncthreads();
        {
            LruW W; lru_load_w<1>(F, W, n, w, fr, fq);
            float s = CIN[(size_t)(cg * 2 + 1) * LW + ch];
            LruX X, Xn; lru_load_x(X, XC, cg * LRU_CH + 3 * 64, n, fr, fq);
            for (int gi = 3; gi >= 0; --gi) {
                if (gi > 0 && LDBG != 2) lru_load_x(Xn, XC, cg * LRU_CH + (gi - 1) * 64, n, fr, fq);
                float a[16], uu[16];
#pragma unroll
                for (int tau = 0; tau < 4; ++tau) { f32x4 pr, pi, xct; lru_tile(X, tau, (w & 1) != 0, W, idf0, idf1, pr, pi, xct);
#pragma unroll
                    for (int j = 0; j < 4; ++j) lru_gate<LDBG>(pr[j], pi[j], xct[j], W, c_last && gi == 3 && fq == 3 && tau == 3 && j == 3, a[4 * tau + j], uu[4 * tau + j]); }
                float p = 1.f, h = 0.f;
#pragma unroll
                for (int t = 15; t >= 0; --t) { h = a[t] * h + uu[t]; p *= a[t]; }
                float hin = s, sg = s;
#pragma unroll
                for (int qq = 3; qq >= 0; --qq) { const float P = __shfl(p, fr + 16 * qq), H = __shfl(h, fr + 16 * qq); sg = P * sg + H; if (qq > fq) hin = P * hin + H; }
                s = sg;
                float hh = hin;
#pragma unroll
                for (int t = 15; t >= 0; --t) { hh = a[t] * hh + uu[t];
                    const int tl = gi * 64 + 16 * fq + t; LAS bf16_t* gp = grt + tl * BW + 16 * w + fr;
                    *gp = (bf16_t)f2bf((bf1(hfb[tl * 16 + fr]) + hh) * gelu_tanh(bf1(*gp))); }
                X = Xn;
            }
        }
        LDS_WAIT(); __syncthreads();
        { bf16_t* gdst = LRU + (size_t)(cg * LRU_CH + (tid_ >> 4)) * LW + n * BW + (tid_ & 15) * 8; const LAS bf16_t* lsrc = grt + tid_ * 8;
#pragma unroll 1
          for (int k = 0; k < 8; ++k) { *(u32x4*)gdst = *(const LAS u32x4*)lsrc; gdst += (size_t)32 * LW; lsrc += NTHR * 8; } }
        LDS_WAIT(); __syncthreads();
    }
}

__device__ __forceinline__ void hq_phase(Frame& F) {
    const int lane = opaque(F.tid) & 63;
    const bf16_t* H0 = (const bf16_t*)F.out; const bf16_t* H1 = wsp<bf16_t>(F, WS_HIDS);
    signed char* Q0 = wsp<signed char>(F, WS_H8P); signed char* Q1 = wsp<signed char>(F, WS_H8S); float* RS3 = wsp<float>(F, WS_RS3);
    {
        LAS float* scr = (LAS float*)(F.lds + F.wave * 8448);
        for (int it = F.gw; it < (DFF / 64) * (D / 32); it += F.ngw)
            had_tile_quant(F.in_WFD, D, DFF, 64 * (it / (D / 32)), 32 * (it % (D / 32)), wsp<signed char>(F, WS_WD), (const unsigned*)(F.ws + WS_AM), wsp<float>(F, WS_CS) + CS_D, scr, lane);
    }
    constexpr int NB = DFF / 32;
    for (int m = F.gw; m < L; m += F.ngw) {
        const bf16_t* src = m < LP ? H0 + (size_t)m * DFF : H1 + (size_t)(m - LP) * DFF;
        signed char* dst = m < LP ? Q0 + (size_t)m * DFF : Q1 + (size_t)(m - LP) * DFF;
        u32x4 raw[6][4];
#pragma unroll
        for (int it = 0; it < 6; ++it) { const int b = lane + 64 * it; const u32x4* p = (const u32x4*)(src + (b < NB ? b : lane) * 32);
#pragma unroll
            for (int i = 0; i < 4; ++i) raw[it][i] = p[i]; }
        float mx = 0.f;
#pragma unroll
        for (int it = 0; it < 6; ++it) { float v[32];
#pragma unroll
            for (int i = 0; i < 4; ++i) { const u32x4 u = raw[it][i]; v[8 * i + 0] = bflo(u.x); v[8 * i + 1] = bfhi(u.x); v[8 * i + 2] = bflo(u.y); v[8 * i + 3] = bfhi(u.y); v[8 * i + 4] = bflo(u.z); v[8 * i + 5] = bfhi(u.z); v[8 * i + 6] = bflo(u.w); v[8 * i + 7] = bfhi(u.w); }
            fwht32(v);
            float bm = 0.f;
#pragma unroll
            for (int i = 0; i < 32; ++i) bm = fmaxf(bm, fabsf(v[i]));
            mx = fmaxf(mx, (lane + 64 * it < NB) ? bm : 0.f); }
        const float amax = fmaxf(wave_max(mx), 1e-20f), inv = 127.0f / amax;
        if (lane == 0) RS3[m] = amax * (1.0f / 127.0f);
#pragma unroll
        for (int it = 0; it < 6; ++it) { const int b = lane + 64 * it; float v[32];
#pragma unroll
            for (int i = 0; i < 4; ++i) { const u32x4 u = raw[it][i]; v[8 * i + 0] = bflo(u.x); v[8 * i + 1] = bfhi(u.x); v[8 * i + 2] = bflo(u.y); v[8 * i + 3] = bfhi(u.y); v[8 * i + 4] = bflo(u.z); v[8 * i + 5] = bfhi(u.z); v[8 * i + 6] = bflo(u.w); v[8 * i + 7] = bfhi(u.w); }
            fwht32(v);
            u32x4 o0, o1;
            o0.x = pk4_i8(rintf(v[0] * inv), rintf(v[1] * inv), rintf(v[2] * inv), rintf(v[3] * inv)); o0.y = pk4_i8(rintf(v[4] * inv), rintf(v[5] * inv), rintf(v[6] * inv), rintf(v[7] * inv));
            o0.z = pk4_i8(rintf(v[8] * inv), rintf(v[9] * inv), rintf(v[10] * inv), rintf(v[11] * inv)); o0.w = pk4_i8(rintf(v[12] * inv), rintf(v[13] * inv), rintf(v[14] * inv), rintf(v[15] * inv));
            o1.x = pk4_i8(rintf(v[16] * inv), rintf(v[17] * inv), rintf(v[18] * inv), rintf(v[19] * inv)); o1.y = pk4_i8(rintf(v[20] * inv), rintf(v[21] * inv), rintf(v[22] * inv), rintf(v[23] * inv));
            o1.z = pk4_i8(rintf(v[24] * inv), rintf(v[25] * inv), rintf(v[26] * inv), rintf(v[27] * inv)); o1.w = pk4_i8(rintf(v[28] * inv), rintf(v[29] * inv), rintf(v[30] * inv), rintf(v[31] * inv));
            if (b < NB) { *(u32x4*)(dst + b * 32) = o0; *(u32x4*)(dst + b * 32 + 16) = o1; } }
    }
}

__device__ __forceinline__ f32x4 up4(const u32x2 u) { return (f32x4){bflo(u.x), bfhi(u.x), bflo(u.y), bfhi(u.y)}; }
__device__ __forceinline__ void mid_phase(Frame& F) {
    const int tid_ = opaque(F.tid);
    bf16_t* MIX = wsp<bf16_t>(F, WS_MIX); signed char* XN8 = wsp<signed char>(F, WS_XN8); float* RS2 = wsp<float>(F, WS_RS2);
    LAS f32x4* gpost = (LAS f32x4*)F.lds; LAS f32x4* gpre = gpost + D / 4;
    for (int i = tid_; i < D / 4; i += NTHR) { gpost[i] = ((const f32x4*)F.in_GMPOST)[i]; gpre[i] = ((const f32x4*)F.in_GFPRE)[i]; }
    __syncthreads();
    for (int m = F.gw; m < L; m += F.ngw) {
        asm volatile("" ::: "memory");
        const f32x4* xr = (const f32x4*)xrow(F, m) + F.lane; const u32x2* mr = (const u32x2*)(MIX + (size_t)m * D) + F.lane;
        f32x4 v[16]; u32x2 mx[16]; float s = 0.f;
#pragma unroll
        for (int j = 0; j < 16; ++j) { v[j] = xr[64 * j]; mx[j] = mr[64 * j]; const f32x4 a = up4(mx[j]); s += (a.x * a.x + a.y * a.y) + (a.z * a.z + a.w * a.w); }
        const float rstd1 = 1.0f / sqrtf(wave_sum(s) * (1.0f / D) + EPS);
        float s2 = 0.f;
#pragma unroll
        for (int j = 0; j < 16; ++j) { v[j] = v[j] + up4(mx[j]) * rstd1 * gpost[F.lane + 64 * j]; s2 += (v[j].x * v[j].x + v[j].y * v[j].y) + (v[j].z * v[j].z + v[j].w * v[j].w); }
        const float rstd2 = 1.0f / sqrtf(wave_sum(s2) * (1.0f / D) + EPS);
        { u32x2* xw = (u32x2*)(MIX + (size_t)m * D) + F.lane;
#pragma unroll
          for (int j = 0; j < 16; ++j) xw[64 * j] = (u32x2){pk2(v[j].x, v[j].y), pk2(v[j].z, v[j].w)}; }
        float mx2 = 0.f;
#pragma unroll
        for (int j = 0; j < 16; ++j) { v[j] = v[j] * rstd2 * gpre[F.lane + 64 * j]; mx2 = fmaxf(fmaxf(mx2, fmaxf(fabsf(v[j].x), fabsf(v[j].y))), fmaxf(fabsf(v[j].z), fabsf(v[j].w))); }
        const float amax = fmaxf(wave_max(mx2), 1e-20f), inv = 127.0f / amax;
        if (F.lane == 0) RS2[m] = amax * (1.0f / 127.0f);
        unsigned* o4 = (unsigned*)(XN8 + (size_t)m * D) + F.lane;
#pragma unroll
        for (int j = 0; j < 16; ++j) o4[64 * j] = pk4_i8(rintf(v[j].x * inv), rintf(v[j].y * inv), rintf(v[j].z * inv), rintf(v[j].w * inv));
    }
    __syncthreads();
}
__device__ __forceinline__ void final_phase(Frame& F) {
    const int tid_ = opaque(F.tid);
    const bf16_t* X1 = wsp<bf16_t>(F, WS_MIX); const bf16_t* FB = wsp<bf16_t>(F, WS_F);
    LAS f32x4* gfp = (LAS f32x4*)F.lds;
    for (int i = tid_; i < D / 4; i += NTHR) gfp[i] = ((const f32x4*)F.in_GFPOST)[i];
    __syncthreads();
    for (int m = F.gw; m < L; m += F.ngw) {
        asm volatile("" ::: "memory");
        const u32x2* mr = (const u32x2*)(X1 + (size_t)m * D) + F.lane; const u32x2* fr = (const u32x2*)(FB + (size_t)m * D) + F.lane;
        u32x2 fx[16], x1[16]; float s = 0.f;
#pragma unroll
        for (int j = 0; j < 16; ++j) { fx[j] = fr[64 * j]; x1[j] = mr[64 * j]; const f32x4 a = up4(fx[j]); s += (a.x * a.x + a.y * a.y) + (a.z * a.z + a.w * a.w); }
        const float rstd3 = 1.0f / sqrtf(wave_sum(s) * (1.0f / D) + EPS);
        f32x4* o = (f32x4*)(F.out + (size_t)m * D) + F.lane;
#pragma unroll
        for (int j = 0; j < 16; ++j) o[64 * j] = up4(x1[j]) + up4(fx[j]) * rstd3 * gfp[F.lane + 64 * j];
    }
}

constexpr int LDS_STAGE = pg8::STAGE_BYTES;
constexpr int LDS_MISC = LDS_STAGE;
constexpr int LDS_BYTES = LDS_STAGE + 1024;
#ifndef MK_N_LAUNCHES
#define MK_N_LAUNCHES 1
#endif
constexpr int NPHASE = 12;
struct Args { const float* in[23]; float* out; unsigned char* ws; int ph_lo, ph_hi; };

__global__ void __launch_bounds__(NTHR, 2) fwd_kernel(Args args) {
    extern __shared__ __attribute__((aligned(16))) unsigned char lds_raw[];
    Frame F;
    F.lds = (LAS unsigned char*)lds_raw;
    F.tid = threadIdx.x; F.lane = (int)__builtin_amdgcn_mbcnt_hi(~0u, __builtin_amdgcn_mbcnt_lo(~0u, 0u)); F.wave = __builtin_amdgcn_readfirstlane(F.tid >> 6);
    F.G = gridDim.x; F.gw = blockIdx.x * NWAVES + F.wave; F.ngw = F.G * NWAVES;
    F.in_XP = args.in[0]; F.in_XS = args.in[1]; F.in_WIN = args.in[2]; F.in_WCONV = args.in[3]; F.in_BCONV = args.in[4]; F.in_WR = args.in[5]; F.in_BR = args.in[6]; F.in_WI = args.in[7]; F.in_BI = args.in[8]; F.in_LAM = args.in[9]; F.in_RPB = args.in[10]; F.in_WNO = args.in[11]; F.in_WLO = args.in[12]; F.in_WM = args.in[13]; F.in_BM = args.in[14]; F.in_WOUT = args.in[15]; F.in_GMPRE = args.in[16]; F.in_GMPOST = args.in[17]; F.in_GFPRE = args.in[18]; F.in_GFPOST = args.in[19]; F.in_WFG = args.in[20]; F.in_WFU = args.in[21]; F.in_WFD = args.in[22];
    F.out = args.out; F.ws = args.ws;
    volatile LAS unsigned* MISC = (volatile LAS unsigned*)(F.lds + LDS_MISC);
    if (F.tid < 256) MISC[F.tid] = 0u;
    __syncthreads();
    const int lo = args.ph_lo, hi = args.ph_hi;
    const bool fused = (hi - lo) > 1;
    XcdBarrier bar; bar.bar = (unsigned*)(F.ws + WS_CTL); bar.x = 0; bar.st = nullptr;
    if (fused) bar = xcd_barrier_post((unsigned*)(F.ws + WS_CTL), MISC + 8);
#ifndef PH_MASK
#define PH_MASK 0xfff
#endif
#define IN(k) (((PH_MASK >> (k)) & 1) && lo <= (k) && (k) < hi)
#define SEAM(k) do { if (IN(k) && IN((k) + 1)) xcd_barrier(bar); } while (0)
    LAS unsigned char* stage = F.lds;

#ifdef ATTN_OUT_OFF
#define NA_BUF ((size_t)ATTN_OUT_OFF * MiB)
#else
#define NA_BUF WS_Q
#endif
#ifndef DUP_MASK
#define DUP_MASK 0
#endif
#define RUN(k, ...) if (IN(k)) { __VA_ARGS__ if (((DUP_MASK) >> (k)) & 1) { __VA_ARGS__ } }
    RUN(0, { p0_prologue(F); }) SEAM(0);
    RUN(1, {
        { pg8::Gemm g{wsp<bf16_t>(F, WS_XN8), wsp<bf16_t>(F, WS_XN8), 1 << 30, wsp<bf16_t>(F, WS_W8), L, 2 * NAW + 2 * D, D}; pg8::StaticOrder S; S.init(L, 2 * NAW + 2 * D, F.G, (int)blockIdx.x);
          pg8::EpiProjQ E{wsp<bf16_t>(F, WS_Q), wsp<bf16_t>(F, WS_K), (bf16_t*)F.out, F.in_BM, wsp<float>(F, WS_RS1), wsp<float>(F, WS_CS) + CS_QKM};
          pg8::gemm_phase<pg8::EpiProjQ, pg8::StaticOrder, true, true, 2>(stage, g, S, E); }
        { pg8::Gemm g{wsp<bf16_t>(F, WS_XN), wsp<bf16_t>(F, WS_XN), 1 << 30, wsp<bf16_t>(F, WS_WCAT), L, 2 * NAW, 2 * D}; pg8::StaticOrder S; S.init(L, 2 * NAW, F.G, (int)blockIdx.x);
          pg8::EpiProj E{wsp<bf16_t>(F, WS_XR), wsp<bf16_t>(F, WS_GR), wsp<bf16_t>(F, WS_GR), wsp<bf16_t>(F, WS_GR), (bf16_t*)F.out, F.in_BM, 1 << 30};
          pg8::gemm_phase<pg8::EpiProj, pg8::StaticOrder, true, true, 0>(stage, g, S, E); }
        { pg8::Gemm g{wsp<bf16_t>(F, WS_WVT), wsp<bf16_t>(F, WS_WVT), 1 << 30, wsp<bf16_t>(F, WS_XN8), NAW, L, D}; pg8::StaticOrder S; S.init(NAW, L, F.G, (int)blockIdx.x);
          pg8::EpiVTQ E{wsp<bf16_t>(F, WS_VT), wsp<float>(F, WS_CS) + CS_V, wsp<float>(F, WS_RS1)};
          pg8::gemm_phase<pg8::EpiVTQ, pg8::StaticOrder, true, true, 2>(stage, g, S, E); }
    }) SEAM(1);
    RUN(2, { lru_pass_a(F); }) SEAM(2);
    #ifdef ATTN_OUT_OFF
    if (IN(3)) { lru_pass_b(F); } SEAM(3);
    if (IN(4)) { lru_pass_c<0>(F); xcd_barrier(bar); if (ATTN_DUP) attn_mfma<ATTN_DUP - 1>(F); attn_mfma<0>(F); } SEAM(4);
#else
    if (IN(3)) { lru_pass_b(F); attn_mfma_lds(F); } SEAM(3);
#ifdef LRUC_DBG
    if (IN(4)) { lru_pass_c<LRUC_DBG>(F); lru_pass_c<0>(F); } SEAM(4);
#else
    RUN(4, { lru_pass_c<0>(F); }) SEAM(4);
#endif
#endif
    if (IN(5)) {
        { pg8::Gemm g{wsp<bf16_t>(F, NA_BUF), wsp<bf16_t>(F, NA_BUF), 1 << 30, wsp<bf16_t>(F, WS_WNO), L, D, 2 * NAW}; pg8::StaticOrder S; S.init(L, D, F.G, (int)blockIdx.x);
          pg8::EpiMulG<false> E{wsp<bf16_t>(F, WS_T1), (const bf16_t*)F.out, 0};
          pg8::gemm_phase<pg8::EpiMulG<false>, pg8::StaticOrder, true, true>(stage, g, S, E); }
        { pg8::Gemm g{wsp<bf16_t>(F, WS_XR), wsp<bf16_t>(F, WS_XR), 1 << 30, wsp<bf16_t>(F, WS_WLO), L, D, 2 * LW}; pg8::StaticOrder S; S.init(L, D, F.G, (int)blockIdx.x);
          pg8::EpiMulG<true> E{wsp<bf16_t>(F, WS_T1), (const bf16_t*)F.out, D};
          pg8::gemm_phase<pg8::EpiMulG<true>, pg8::StaticOrder, true, true>(stage, g, S, E); }
    } SEAM(5);
    RUN(6, {
        pg8::Gemm g{wsp<bf16_t>(F, WS_T1), wsp<bf16_t>(F, WS_T1), 1 << 30, wsp<bf16_t>(F, WS_WO), L, D, 2 * D}; pg8::StaticOrder S; S.init(L, D, F.G, (int)blockIdx.x);
        pg8::EpiPlain E{wsp<bf16_t>(F, WS_MIX), D};
        pg8::gemm_phase<pg8::EpiPlain, pg8::StaticOrder, true, true>(stage, g, S, E);
    }) SEAM(6);
    RUN(7, { mid_phase(F); }) SEAM(7);
    RUN(8, {
        pg8::Gemm g{wsp<bf16_t>(F, WS_XN8), wsp<bf16_t>(F, WS_XN8), 1 << 30, wsp<bf16_t>(F, WS_WGU), L, 2 * DFF, D}; pg8::StaticOrder S; S.init(L, 2 * DFF, F.G, (int)blockIdx.x);
        pg8::EpiSwigluQ E{(bf16_t*)F.out, wsp<bf16_t>(F, WS_HIDS), LP / 256, wsp<float>(F, WS_RS2), wsp<float>(F, WS_CS) + CS_GU};
        pg8::gemm_phase<pg8::EpiSwigluQ, pg8::StaticOrder, false, true, 2>(stage, g, S, E);
    }) SEAM(8);
    RUN(9, { hq_phase(F); }) SEAM(9);
    RUN(10, {
        pg8::Gemm g{wsp<bf16_t>(F, WS_H8P), wsp<bf16_t>(F, WS_H8S), LP / 256, wsp<bf16_t>(F, WS_WD), L, D, DFF}; pg8::StaticOrder S; S.init(L, D, F.G, (int)blockIdx.x);
        pg8::EpiPlainQ E{wsp<bf16_t>(F, WS_F), D, wsp<float>(F, WS_RS3), wsp<float>(F, WS_CS) + CS_D};
        pg8::gemm_phase<pg8::EpiPlainQ, pg8::StaticOrder, true, true, 2>(stage, g, S, E);
    }) SEAM(10);
    RUN(11, { final_phase(F); })
#undef RUN
#undef IN
#undef SEAM
}

extern "C" void kernel_launch(void* const* d_in, const int* in_sizes, int n_in, void* d_out, int out_size, void* d_ws, size_t ws_size, hipStream_t stream) {
    static int grid = 0;
    if (grid == 0) {
        if (n_in != 23 || in_sizes[0] != LP * D || in_sizes[1] != LS * D || out_size != L * D || ws_size < WS_END) {
            fprintf(stderr, "kernel_launch: unexpected shapes: n_in %d in0 %d out %d ws %zu (need %zu)\n", n_in, n_in > 0 ? in_sizes[0] : -1, out_size, ws_size, (size_t)WS_END); grid = -1; return; }
        int dev = 0, cus = 0, per_cu = 0;
        if (hipGetDevice(&dev) != hipSuccess || hipDeviceGetAttribute(&cus, hipDeviceAttributeMultiprocessorCount, dev) != hipSuccess) { grid = -1; return; }
        if (hipFuncSetAttribute((const void*)fwd_kernel, hipFuncAttributeMaxDynamicSharedMemorySize, LDS_BYTES) != hipSuccess) { fprintf(stderr, "kernel_launch: hipFuncSetAttribute failed\n"); grid = -1; return; }
        if (hipOccupancyMaxActiveBlocksPerMultiprocessor(&per_cu, (const void*)fwd_kernel, NTHR, LDS_BYTES) != hipSuccess || per_cu < 1) { fprintf(stderr, "kernel_launch: occupancy query says %d\n", per_cu); }
        (void)hipGetLastError();
        grid = cus;
    }
    if (grid < 0) return;
    (void)hipMemsetAsync((char*)d_ws + WS_CTL, 0, CTL_ZERO_BYTES, stream);
#ifdef DBG_ZERO_ALL
    (void)hipMemsetAsync((char*)d_ws, 0, WS_END, stream); (void)hipMemsetAsync((char*)d_out, 0, (size_t)L * D * 4, stream);
#endif
    Args a{};
    for (int i = 0; i < 23; ++i) a.in[i] = (const float*)d_in[i];
    a.out = (float*)d_out; a.ws = (unsigned char*)d_ws;
#if MK_N_LAUNCHES == 1
    a.ph_lo = 0; a.ph_hi = NPHASE;
    hipLaunchKernelGGL(fwd_kernel, dim3(grid), dim3(NTHR), LDS_BYTES, stream, a);
#else
    for (int p = 0; p < NPHASE; ++p) {
#ifdef DBG_PH_MASK
        if (!((DBG_PH_MASK >> p) & 1)) continue;
#endif
        a.ph_lo = p; a.ph_hi = p + 1; hipLaunchKernelGGL(fwd_kernel, dim3(grid), dim3(NTHR), LDS_BYTES, stream, a); }
#endif
}
```

```cpp
#include <hip/hip_runtime.h>
#include <cstdio>
#include <cstdint>

#define LAS __attribute__((address_space(3)))
typedef unsigned short bf16_t;
typedef short bf16x8 __attribute__((ext_vector_type(8)));
typedef float f32x4 __attribute__((ext_vector_type(4)));
typedef float f32x2 __attribute__((ext_vector_type(2)));
typedef unsigned u32x4 __attribute__((ext_vector_type(4)));
typedef unsigned u32x2 __attribute__((ext_vector_type(2)));

constexpr int D = 4096, LP = 16384, LS = 8192, L = LP + LS;
constexpr int GRIDW = 64, HD = 128, NH = 16, NAW = 2048, LW = 2048, NBLK = 16, BW = 128, DFF = 11008, INW = 10240;
constexpr float EPS = 1e-6f;
constexpr int NWAVES = 8, NTHR = 512;

constexpr size_t MiB = 1u << 20;
constexpr size_t WS_CTL = 0, CTL_ZERO_BYTES = 64 * 1024;
constexpr size_t WS_AM = 32 * 1024;
constexpr size_t WS_RSTD = 1 * MiB;
constexpr size_t WS_RS1 = 1 * MiB + 128 * 1024;
constexpr size_t WS_RS2 = 1 * MiB + 256 * 1024;
constexpr size_t WS_CS = 1 * MiB + 384 * 1024;
constexpr size_t WS_SUM = 2 * MiB;
constexpr size_t WS_WCAT = 8 * MiB;
constexpr size_t WS_W8 = 40 * MiB;
constexpr size_t WS_WVT = 88 * MiB;
constexpr size_t WS_XN8 = 96 * MiB;
constexpr size_t WS_WNO = 192 * MiB;
constexpr size_t WS_WLO = 208 * MiB;
constexpr size_t WS_WO = 224 * MiB;
constexpr size_t WS_WGU = 256 * MiB;
constexpr size_t WS_WD = 342 * MiB;
constexpr size_t WS_WG = 428 * MiB;
constexpr size_t WS_XN = 430 * MiB;
constexpr size_t WS_Q = 622 * MiB;
constexpr size_t WS_XR = 718 * MiB;
constexpr size_t WS_K = 814 * MiB;
constexpr size_t WS_VT = 910 * MiB;
constexpr size_t WS_GR = 1006 * MiB;
constexpr size_t WS_XC = 1102 * MiB;
constexpr size_t WS_END = 1198 * MiB;
constexpr int CS_QKM = 0, CS_V = 12288, CS_GU = 12288 + 2048, CS_D = 12288 + 2048 + 22016;
constexpr size_t WS_RS3 = 1 * MiB + 640 * 1024;
constexpr size_t WS_H8P = WS_XN, WS_H8S = WS_XN8;
constexpr size_t WS_T1 = WS_K;
constexpr size_t WS_MIX = WS_GR;
constexpr size_t WS_HIDS = WS_Q;
constexpr size_t WS_F = WS_K;
constexpr size_t WS_HF = WS_K;

#define LDS_WAIT() asm volatile("s_waitcnt lgkmcnt(0)" ::: "memory")
#define VM_WAIT() asm volatile("s_waitcnt vmcnt(0)" ::: "memory")
typedef __bf16 bf16x2n_t __attribute__((ext_vector_type(2)));
__device__ __forceinline__ unsigned pk2(float lo, float hi) { const bf16x2n_t r = __builtin_convertvector((f32x2){lo, hi}, bf16x2n_t); return __builtin_bit_cast(unsigned, r); }
__device__ __forceinline__ unsigned f2bf(float f) { return pk2(f, 0.f) & 0xffffu; }
__device__ __forceinline__ float bflo(unsigned u) { return __builtin_bit_cast(float, u << 16); }
__device__ __forceinline__ float bfhi(unsigned u) { return __builtin_bit_cast(float, u & 0xffff0000u); }
__device__ __forceinline__ float bf1(bf16_t u) { return __builtin_bit_cast(float, (unsigned)u << 16); }
__device__ __forceinline__ float wave_sum(float v) {
#pragma unroll
    for (int o = 1; o < 64; o <<= 1) v += __shfl_xor(v, o);
    return v;
}
__device__ __forceinline__ float wave_max(float v) {
#pragma unroll
    for (int o = 1; o < 64; o <<= 1) v = fmaxf(v, __shfl_xor(v, o));
    return v;
}
__device__ __forceinline__ float sigmoidf_(float v) { return __builtin_amdgcn_rcpf(1.0f + __expf(-v)); }
__device__ __forceinline__ float gelu_tanh(float v) { const float y = 0.7978845608f * (v + 0.044715f * v * v * v); const float e = __expf(2.0f * y); return 0.5f * v * (2.0f - 2.0f * __builtin_amdgcn_rcpf(e + 1.0f)); }

namespace pg8 {
constexpr int BM = 256, BK = 64, HALF = 128, HTB = HALF * BK * 2  , STAGE_BYTES = 8 * HTB, NXCD = 8, WGM = 4;

__host__ __device__ __forceinline__ int lds_byte(int r, int c) { return (r >> 3) * 1024 + (r & 7) * 128 + ((((c >> 3) ^ r) & 7) << 4) + (c & 7) * 2; }
__host__ __device__ __forceinline__ void stage_rc(int b, int& R, int& C) { const int ch = b >> 10, rr = (b >> 7) & 7, slot = (b >> 4) & 7; R = ch * 8 + rr; C = ((slot ^ rr) & 7) * 8; }
__host__ __device__ __forceinline__ int perm32(int rho) { const int n = rho >> 4, i = rho & 15; return 8 * (i >> 2) + 4 * n + (i & 3); }

struct Unit { int pm, pn; };
struct Gemm {
    const bf16_t* A; const bf16_t* A2; int pm_split; const bf16_t* Bt; int M, N, rb;
    __device__ __forceinline__ const char* abase(int pm) const { const size_t t = (size_t)BM * rb; return pm < pm_split ? (const char*)A + (size_t)pm * t : (const char*)A2 + (size_t)(pm - pm_split) * t; }
    __device__ __forceinline__ const char* bbase(int pn) const { return (const char*)Bt + (size_t)pn * BM * rb; }
};

struct StaticOrder {
    int nM, nN, nwg, G, c;
    __host__ __device__ void init(int M, int N, int G_, int c_) { nM = M / BM; nN = N / BM; nwg = nM * nN; G = G_; c = c_; }
    __host__ __device__ bool next(int i, Unit& u) const {
        const long Lx = (long)i * G + c; if (Lx >= nwg) return false;
        int wgid = (int)Lx; { const int q = nwg / NXCD, r = nwg % NXCD, xcd = wgid % NXCD, off = wgid / NXCD; wgid = (xcd < r ? xcd * (q + 1) : r * (q + 1) + (xcd - r) * q) + off; }
        const int nig = WGM * nN, gid = wgid / nig, fm = gid * WGM, gsz = (nM - fm) < WGM ? (nM - fm) : WGM;
        u.pm = fm + ((wgid % nig) % gsz); u.pn = (wgid % nig) / gsz; return true;
    }
    __device__ __forceinline__ void a_ready(const Unit&) const {}
    __device__ __forceinline__ void done(const Unit&) const {}
};

typedef int v8i32 __attribute__((ext_vector_type(8)));
typedef int v4i32 __attribute__((ext_vector_type(4)));
typedef __bf16 bf16x2_t __attribute__((ext_vector_type(2)));
__device__ __forceinline__ unsigned cvt_pk_bf16(float lo, float hi) { const bf16x2_t r = __builtin_convertvector((f32x2){lo, hi}, bf16x2_t); return __builtin_bit_cast(unsigned, r); }
__device__ __forceinline__ u32x4 pack8(const f32x4 v0, const f32x4 v1) { u32x4 w; w.x = cvt_pk_bf16(v0[0], v0[1]); w.y = cvt_pk_bf16(v0[2], v0[3]); w.z = cvt_pk_bf16(v1[0], v1[1]); w.w = cvt_pk_bf16(v1[2], v1[3]); return w; }
__device__ __forceinline__ void unpack8(const u32x4 w, f32x4& v0, f32x4& v1) { v0 = (f32x4){bflo(w.x), bfhi(w.x), bflo(w.y), bfhi(w.y)}; v1 = (f32x4){bflo(w.z), bfhi(w.z), bflo(w.w), bfhi(w.w)}; }
__device__ __forceinline__ f32x4 sig4(const f32x4 v) { f32x4 r; r[0] = sigmoidf_(v[0]); r[1] = sigmoidf_(v[1]); r[2] = sigmoidf_(v[2]); r[3] = sigmoidf_(v[3]); return r; }

struct EpiPlain {
    static constexpr bool PERM = true, AFTER_DRAIN = false;
    bf16_t* O; int ldc;
    __device__ __forceinline__ void operator()(const f32x4 (&acc)[2][2][4][2], const Unit& u, int wr, int wc, int fr, int fq) const {
        const int row0 = u.pm * BM + wr * 64 + fr, col0 = u.pn * BM + wc * 32 + 8 * fq;
#pragma unroll
        for (int ai = 0; ai < 2; ++ai)
#pragma unroll
            for (int m = 0; m < 4; ++m) { bf16_t* rowp = O + (size_t)(row0 + ai * HALF + m * 16) * ldc + col0;
#pragma unroll
                for (int bj = 0; bj < 2; ++bj) *(u32x4*)(rowp + bj * HALF) = pack8(acc[ai][bj][m][0], acc[ai][bj][m][1]); }
    }
};
struct EpiVT {
    static constexpr bool PERM = true, AFTER_DRAIN = false;
    bf16_t* O;
    __device__ __forceinline__ void operator()(const f32x4 (&acc)[2][2][4][2], const Unit& u, int wr, int wc, int fr, int fq) const {
        const int row0 = u.pm * BM + wr * 64 + fr, col0 = u.pn * BM + wc * 32 + 8 * fq;
#pragma unroll
        for (int ai = 0; ai < 2; ++ai)
#pragma unroll
            for (int m = 0; m < 4; ++m) { const int row = row0 + ai * HALF + m * 16, hh = row >> 7, d = row & 127;
                const int dt = 2 * (d >> 5) + ((d >> 2) & 1), i = 4 * ((d >> 3) & 3) + (d & 3);
#pragma unroll
                for (int bj = 0; bj < 2; ++bj) { const int tok = col0 + bj * HALF, R = tok >> 6, o = (tok & 63) >> 3;
                    *(u32x4*)(O + ((size_t)((((R * 16 + hh) * 8 + dt) * 8 + o) * 16 + i)) * 8) = pack8(acc[ai][bj][m][0], acc[ai][bj][m][1]); } }
    }
};
struct EpiProj {
    static constexpr bool PERM = true, AFTER_DRAIN = false;
    bf16_t* P0; bf16_t* P1; bf16_t* P2; bf16_t* P3; bf16_t* G; const float* bias; int pn_gate0;
    __device__ __forceinline__ void operator()(const f32x4 (&acc)[2][2][4][2], const Unit& u, int wr, int wc, int fr, int fq) const {
        const int row0 = u.pm * BM + wr * 64 + fr;
        if (u.pn < pn_gate0) {
            const int t = u.pn >> 3; bf16_t* base = t == 0 ? P0 : (t == 1 ? P1 : (t == 2 ? P2 : P3));
            const int col0 = (u.pn & 7) * BM + wc * 32 + 8 * fq;
            if (t == 2) {
#pragma unroll
                for (int ai = 0; ai < 2; ++ai)
#pragma unroll
                    for (int m = 0; m < 4; ++m) { const int tok = row0 + ai * HALF + m * 16, R = tok >> 6, cl = tok & 63;
                        const int tokpart = (((cl >> 2) & 1) * 8 + (cl >> 3)) * 4 + (cl & 3);
#pragma unroll
                        for (int bj = 0; bj < 2; ++bj) { const int c = col0 + bj * HALF, hh = c >> 7, d0 = c & 127;
                            *(u32x4*)(base + ((size_t)(((R * 16 + hh) * 4 + (d0 >> 5)) * 64 + tokpart) * 4 + ((d0 >> 3) & 3)) * 8) = pack8(acc[ai][bj][m][0], acc[ai][bj][m][1]); } }
            } else {
#pragma unroll
            for (int ai = 0; ai < 2; ++ai)
#pragma unroll
                for (int m = 0; m < 4; ++m) { bf16_t* rowp = base + (size_t)(row0 + ai * HALF + m * 16) * NAW + col0;
#pragma unroll
                    for (int bj = 0; bj < 2; ++bj) *(u32x4*)(rowp + bj * HALF) = pack8(acc[ai][bj][m][0], acc[ai][bj][m][1]); }
            }
        } else {
            const int col0 = (u.pn - pn_gate0) * BM + wc * 32 + 8 * fq;
            f32x4 bv[2][2];
#pragma unroll
            for (int bj = 0; bj < 2; ++bj)
#pragma unroll
                for (int n = 0; n < 2; ++n) bv[bj][n] = *(const f32x4*)(bias + col0 + bj * HALF + 4 * n);
#pragma unroll
            for (int ai = 0; ai < 2; ++ai)
#pragma unroll
                for (int m = 0; m < 4; ++m) { bf16_t* rowp = G + (size_t)(row0 + ai * HALF + m * 16) * (2 * D) + col0;
#pragma unroll
                    for (int bj = 0; bj < 2; ++bj) *(u32x4*)(rowp + bj * HALF) = pack8(sig4(acc[ai][bj][m][0] + bv[bj][0]), sig4(acc[ai][bj][m][1] + bv[bj][1])); }
        }
    }
};
template <bool ADD> struct EpiMulG {
    static constexpr bool PERM = true, AFTER_DRAIN = false;
    bf16_t* O; const bf16_t* G; int goff;
    __device__ __forceinline__ void operator()(const f32x4 (&acc)[2][2][4][2], const Unit& u, int wr, int wc, int fr, int fq) const {
        const int row0 = u.pm * BM + wr * 64 + fr, col0 = u.pn * BM + wc * 32 + 8 * fq;
#pragma unroll
        for (int ai = 0; ai < 2; ++ai)
#pragma unroll
            for (int m = 0; m < 4; ++m) { const size_t row = (size_t)(row0 + ai * HALF + m * 16); bf16_t* rowp = O + row * D + col0; const bf16_t* gp = G + row * (2 * D) + goff + col0;
#pragma unroll
                for (int bj = 0; bj < 2; ++bj) {
                    f32x4 g0, g1; unpack8(*(const u32x4*)(gp + bj * HALF), g0, g1);
                    f32x4 v0 = acc[ai][bj][m][0] * g0, v1 = acc[ai][bj][m][1] * g1;
                    if (ADD) { f32x4 t0, t1; unpack8(*(const u32x4*)(rowp + bj * HALF), t0, t1); v0 += t0; v1 += t1; }
                    *(u32x4*)(rowp + bj * HALF) = pack8(v0, v1); } }
    }
};
struct EpiSwiglu {
    static constexpr bool PERM = true, AFTER_DRAIN = false;
    bf16_t* H0; bf16_t* H1; int pm_split;
    __device__ __forceinline__ void operator()(const f32x4 (&acc)[2][2][4][2], const Unit& u, int wr, int wc, int fr, int fq) const {
        bf16_t* base = u.pm < pm_split ? H0 + (size_t)u.pm * BM * DFF : H1 + (size_t)(u.pm - pm_split) * BM * DFF;
        const int row0 = wr * 64 + fr, col0 = u.pn * HALF + wc * 32 + 8 * fq;
#pragma unroll
        for (int ai = 0; ai < 2; ++ai)
#pragma unroll
            for (int m = 0; m < 4; ++m) {
                f32x4 h[2];
#pragma unroll
                for (int n = 0; n < 2; ++n) { const f32x4 g = acc[ai][0][m][n], up = acc[ai][1][m][n];
#pragma unroll
                    for (int j = 0; j < 4; ++j) h[n][j] = g[j] * sigmoidf_(g[j]) * up[j]; }
                *(u32x4*)(base + (size_t)(row0 + ai * HALF + m * 16) * DFF + col0) = pack8(h[0], h[1]); }
    }
};

__device__ __forceinline__ f32x4 deq4(const f32x4 accbits, const float sa, const f32x4 sb) { const v4i32 q = __builtin_bit_cast(v4i32, accbits); return (f32x4){(float)q.x, (float)q.y, (float)q.z, (float)q.w} * sa * sb; }
struct EpiProjQ {
    static constexpr bool PERM = true, AFTER_DRAIN = false;
    bf16_t* Qb; bf16_t* Kb; bf16_t* G; const float* bias; const float* sa; const float* sb;
    __device__ __forceinline__ void operator()(const f32x4 (&acc)[2][2][4][2], const Unit& u, int wr, int wc, int fr, int fq) const {
        const int row0 = u.pm * BM + wr * 64 + fr, cg0 = u.pn * BM + wc * 32 + 8 * fq;
        f32x4 sbv[2][2];
#pragma unroll
        for (int bj = 0; bj < 2; ++bj)
#pragma unroll
            for (int n = 0; n < 2; ++n) sbv[bj][n] = *(const f32x4*)(sb + cg0 + bj * HALF + 4 * n);
        if (u.pn < 8) {
            const int col0 = u.pn * BM + wc * 32 + 8 * fq;
#pragma unroll
            for (int ai = 0; ai < 2; ++ai)
#pragma unroll
                for (int m = 0; m < 4; ++m) { const int row = row0 + ai * HALF + m * 16; const float sr = sa[row]; bf16_t* rowp = Qb + (size_t)row * NAW + col0;
#pragma unroll
                    for (int bj = 0; bj < 2; ++bj) *(u32x4*)(rowp + bj * HALF) = pack8(deq4(acc[ai][bj][m][0], sr, sbv[bj][0]), deq4(acc[ai][bj][m][1], sr, sbv[bj][1])); }
        } else if (u.pn < 16) {
            const int col0 = (u.pn - 8) * BM + wc * 32 + 8 * fq;
#pragma unroll
            for (int ai = 0; ai < 2; ++ai)
#pragma unroll
                for (int m = 0; m < 4; ++m) { const int tok = row0 + ai * HALF + m * 16, R = tok >> 6, cl = tok & 63; const float sr = sa[tok];
                    const int tokpart = (((cl >> 2) & 1) * 8 + (cl >> 3)) * 4 + (cl & 3);
#pragma unroll
                    for (int bj = 0; bj < 2; ++bj) { const int c = col0 + bj * HALF, hh = c >> 7, d0 = c & 127;
                        *(u32x4*)(Kb + ((size_t)(((R * 16 + hh) * 4 + (d0 >> 5)) * 64 + tokpart) * 4 + ((d0 >> 3) & 3)) * 8) = pack8(deq4(acc[ai][bj][m][0], sr, sbv[bj][0]), deq4(acc[ai][bj][m][1], sr, sbv[bj][1])); } }
        } else {
            const int col0 = (u.pn - 16) * BM + wc * 32 + 8 * fq;
            f32x4 bv[2][2];
#pragma unroll
            for (int bj = 0; bj < 2; ++bj)
#pragma unroll
                for (int n = 0; n < 2; ++n) bv[bj][n] = *(const f32x4*)(bias + col0 + bj * HALF + 4 * n);
#pragma unroll
            for (int ai = 0; ai < 2; ++ai)
#pragma unroll
                for (int m = 0; m < 4; ++m) { const int row = row0 + ai * HALF + m * 16; const float sr = sa[row]; bf16_t* rowp = G + (size_t)row * (2 * D) + col0;
#pragma unroll
                    for (int bj = 0; bj < 2; ++bj) *(u32x4*)(rowp + bj * HALF) = pack8(sig4(deq4(acc[ai][bj][m][0], sr, sbv[bj][0]) + bv[bj][0]), sig4(deq4(acc[ai][bj][m][1], sr, sbv[bj][1]) + bv[bj][1])); }
        }
    }
};
struct EpiPlainQ {
    static constexpr bool PERM = true, AFTER_DRAIN = false;
    bf16_t* O; int ldc; const float* sa; const float* sb;
    __device__ __forceinline__ void operator()(const f32x4 (&acc)[2][2][4][2], const Unit& u, int wr, int wc, int fr, int fq) const {
        const int row0 = u.pm * BM + wr * 64 + fr, col0 = u.pn * BM + wc * 32 + 8 * fq;
        f32x4 sbv[2][2];
#pragma unroll
        for (int bj = 0; bj < 2; ++bj)
#pragma unroll
            for (int n = 0; n < 2; ++n) sbv[bj][n] = *(const f32x4*)(sb + col0 + bj * HALF + 4 * n);
#pragma unroll
        for (int ai = 0; ai < 2; ++ai)
#pragma unroll
            for (int m = 0; m < 4; ++m) { const int row = row0 + ai * HALF + m * 16; const float sr = sa[row]; bf16_t* rowp = O + (size_t)row * ldc + col0;
#pragma unroll
                for (int bj = 0; bj < 2; ++bj) *(u32x4*)(rowp + bj * HALF) = pack8(deq4(acc[ai][bj][m][0], sr, sbv[bj][0]), deq4(acc[ai][bj][m][1], sr, sbv[bj][1])); }
    }
};
struct EpiVTQ {
    static constexpr bool PERM = true, AFTER_DRAIN = false;
    bf16_t* O; const float* sa; const float* sb;
    __device__ __forceinline__ void operator()(const f32x4 (&acc)[2][2][4][2], const Unit& u, int wr, int wc, int fr, int fq) const {
        const int row0 = u.pm * BM + wr * 64 + fr, col0 = u.pn * BM + wc * 32 + 8 * fq;
        f32x4 sbv[2][2];
#pragma unroll
        for (int bj = 0; bj < 2; ++bj)
#pragma unroll
            for (int n = 0; n < 2; ++n) sbv[bj][n] = *(const f32x4*)(sb + col0 + bj * HALF + 4 * n);
#pragma unroll
        for (int ai = 0; ai < 2; ++ai)
#pragma unroll
            for (int m = 0; m < 4; ++m) { const int row = row0 + ai * HALF + m * 16, hh = row >> 7, d = row & 127; const float sr = sa[row];
                const int dt = 2 * (d >> 5) + ((d >> 2) & 1), i = 4 * ((d >> 3) & 3) + (d & 3);
#pragma unroll
                for (int bj = 0; bj < 2; ++bj) { const int tok = col0 + bj * HALF, R = tok >> 6, o = (tok & 63) >> 3;
                    *(u32x4*)(O + ((size_t)((((R * 16 + hh) * 8 + dt) * 8 + o) * 16 + i)) * 8) = pack8(deq4(acc[ai][bj][m][0], sr, sbv[bj][0]), deq4(acc[ai][bj][m][1], sr, sbv[bj][1])); } }
    }
};
struct EpiSwigluQ {
    static constexpr bool PERM = true, AFTER_DRAIN = false;
    bf16_t* H0; bf16_t* H1; int pm_split; const float* sa; const float* sb;
    __device__ __forceinline__ void operator()(const f32x4 (&acc)[2][2][4][2], const Unit& u, int wr, int wc, int fr, int fq) const {
        bf16_t* base = u.pm < pm_split ? H0 + (size_t)u.pm * BM * DFF : H1 + (size_t)(u.pm - pm_split) * BM * DFF;
        const int row0 = wr * 64 + fr, col0 = u.pn * HALF + wc * 32 + 8 * fq, cg0 = u.pn * BM + wc * 32 + 8 * fq;
        f32x4 sbv[2][2];
#pragma unroll
        for (int bj = 0; bj < 2; ++bj)
#pragma unroll
            for (int n = 0; n < 2; ++n) sbv[bj][n] = *(const f32x4*)(sb + cg0 + bj * HALF + 4 * n);
#pragma unroll
        for (int ai = 0; ai < 2; ++ai)
#pragma unroll
            for (int m = 0; m < 4; ++m) { const float sr = sa[u.pm * BM + row0 + ai * HALF + m * 16];
                f32x4 h[2];
#pragma unroll
                for (int n = 0; n < 2; ++n) { const f32x4 g = deq4(acc[ai][0][m][n], sr, sbv[0][n]), up = deq4(acc[ai][1][m][n], sr, sbv[1][n]);
#pragma unroll
                    for (int j = 0; j < 4; ++j) h[n][j] = g[j] * sigmoidf_(g[j]) * up[j]; }
                *(u32x4*)(base + (size_t)(row0 + ai * HALF + m * 16) * DFF + col0) = pack8(h[0], h[1]); }
    }
};

__device__ __forceinline__ v8i32 cat8(const bf16x8 lo, const bf16x8 hi) { return __builtin_shufflevector(__builtin_bit_cast(v4i32, lo), __builtin_bit_cast(v4i32, hi), 0, 1, 2, 3, 4, 5, 6, 7); }
__device__ __forceinline__ void mfma_fp8_acc(f32x4& c, const v8i32 a, const v8i32 b, int sa, int sb) {
    asm volatile("v_mfma_scale_f32_16x16x128_f8f6f4 %0, %1, %2, %0, %3, %4 op_sel_hi:[0,0,0]" : "+v"(c) : "v"(a), "v"(b), "v"(sa), "v"(sb)); }
constexpr int FP8_SCALE = 0x73737373;
template <class Epi, class Sched, bool ALIGN_EPI = false, bool SP2 = false, int QM = 0  , int DBG = 0>
__device__ __forceinline__ void gemm_phase(LAS unsigned char* lds, const Gemm g, const Sched& S, const Epi& E) {
    int tid = threadIdx.x; asm volatile("" : "+v"(tid));
    const int wid = __builtin_amdgcn_readfirstlane(tid >> 6), lane = tid & 63, wr = wid >> 2, wc = wid & 3, fr = lane & 15, fq = lane >> 4;
    const int RB = g.rb, nt = RB / (BK * 2);
    unsigned voffA[2], voffB[2];
#pragma unroll
    for (int i = 0; i < 2; ++i) { int R, C; stage_rc(tid * 16 + i * 8192, R, C); const int Rb = Epi::PERM ? ((R & ~31) + perm32(R & 31)) : R;
        voffA[i] = (unsigned)(R * RB + C * 2); voffB[i] = (unsigned)(Rb * RB + C * 2); }
    const size_t kstep = (size_t)(BK * 2);
    const size_t hstep = (size_t)HALF * RB;
    const unsigned ldsw = (unsigned)wid * 1024u;
    const int aoff0 = lds_byte(wr * 64 + fr, fq * 8), aoff1 = lds_byte(wr * 64 + fr, 32 + fq * 8), boff0 = lds_byte(wc * 32 + fr, fq * 8), boff1 = lds_byte(wc * 32 + fr, 32 + fq * 8);
#define PG8_SA(b, h) (((b) * 2 + (h)) * HTB)
#define PG8_SB(b, h) ((4 + (b) * 2 + (h)) * HTB)
#define PG8_STAGE(bufoff, gbase, voff) do { if constexpr (DBG != 3) _Pragma("unroll") for (int _i = 0; _i < 2; ++_i) \
        __builtin_amdgcn_global_load_lds((const unsigned*)((const char*)(gbase) + (voff)[_i]), (LAS unsigned*)(lds + (bufoff) + ldsw + _i * 8192), 16, 0, 0); } while (0)
#define PG8_LDA(dst, b, h) do { if constexpr (DBG != 2) _Pragma("unroll") for (int m = 0; m < 4; ++m) _Pragma("unroll") for (int k = 0; k < 2; ++k) dst[m][k] = *(const LAS bf16x8*)(lds + PG8_SA(b, h) + (k ? aoff1 : aoff0) + m * 2048); } while (0)
#define PG8_LDB(dst, b, h) do { if constexpr (DBG != 2) _Pragma("unroll") for (int n = 0; n < 2; ++n) _Pragma("unroll") for (int k = 0; k < 2; ++k) dst[n][k] = *(const LAS bf16x8*)(lds + PG8_SB(b, h) + (k ? boff1 : boff0) + n * 2048); } while (0)
#define PG8_MMA(ai, bj, At, Bt) do { __builtin_amdgcn_s_setprio(1); if constexpr (DBG == 1) { } else if constexpr (QM == 2) { _Pragma("unroll") for (int m = 0; m < 4; ++m) _Pragma("unroll") for (int n = 0; n < 2; ++n) _Pragma("unroll") for (int k = 0; k < 2; ++k) \
        acc[ai][bj][m][n] = __builtin_bit_cast(f32x4, __builtin_amdgcn_mfma_i32_16x16x64_i8(__builtin_bit_cast(v4i32, Bt[n][k]), __builtin_bit_cast(v4i32, At[m][k]), __builtin_bit_cast(v4i32, acc[ai][bj][m][n]), 0, 0, 0)); } else if constexpr (QM == 1) { _Pragma("unroll") for (int m = 0; m < 4; ++m) _Pragma("unroll") for (int n = 0; n < 2; ++n) \
        mfma_fp8_acc(acc[ai][bj][m][n], cat8(Bt[n][0], Bt[n][1]), cat8(At[m][0], At[m][1]), fp8_sa, fp8_sb); } else { \
        _Pragma("unroll") for (int m = 0; m < 4; ++m) _Pragma("unroll") for (int n = 0; n < 2; ++n) _Pragma("unroll") for (int k = 0; k < 2; ++k) \
        acc[ai][bj][m][n] = __builtin_amdgcn_mfma_f32_16x16x32_bf16(Bt[n][k], At[m][k], acc[ai][bj][m][n], 0, 0, 0); } __builtin_amdgcn_s_setprio(0); } while (0)
#define PG8_WAIT_V(n) asm volatile("s_waitcnt vmcnt(" #n ")" ::: "memory")
#define PG8_WAIT_L(n) asm volatile("s_waitcnt lgkmcnt(" #n ")" ::: "memory")
#define PG8_BAR __builtin_amdgcn_s_barrier()
#define PG8_SCHED __builtin_amdgcn_sched_barrier(0)
    Unit cur, nxt; int ui = 0;
    const int fp8_sa = FP8_SCALE, fp8_sb = 0x7F7F7F7F;
    if (!S.next(0, cur)) return;
    f32x4 acc[2][2][4][2];
#pragma unroll
    for (int a = 0; a < 2; ++a)
#pragma unroll
        for (int b = 0; b < 2; ++b)
#pragma unroll
            for (int m = 0; m < 4; ++m)
#pragma unroll
                for (int n = 0; n < 2; ++n) acc[a][b][m][n] = (f32x4){0.f, 0.f, 0.f, 0.f};
    bf16x8 At[4][2], B0[2][2], B1[2][2];
    const char* cA = g.abase(cur.pm); const char* cB = g.bbase(cur.pn);
    S.a_ready(cur);
    if constexpr (SP2) {
        PG8_STAGE(PG8_SB(0, 0), cB, voffB); PG8_STAGE(PG8_SB(0, 1), cB + hstep, voffB); PG8_STAGE(PG8_SA(0, 0), cA, voffA); PG8_STAGE(PG8_SA(0, 1), cA + hstep, voffA);
        if (wr == 1) PG8_BAR;
        PG8_WAIT_V(2); PG8_BAR;
        PG8_STAGE(PG8_SB(1, 0), cB + kstep, voffB); PG8_STAGE(PG8_SA(1, 0), cA + kstep, voffA); PG8_STAGE(PG8_SB(1, 1), cB + hstep + kstep, voffB);
        PG8_WAIT_V(6); PG8_BAR;
    } else {
        PG8_STAGE(PG8_SB(0, 0), cB, voffB); PG8_STAGE(PG8_SA(0, 0), cA, voffA); PG8_STAGE(PG8_SB(0, 1), cB + hstep, voffB); PG8_STAGE(PG8_SA(0, 1), cA + hstep, voffA);
        if (wr == 1) PG8_BAR;
        PG8_WAIT_V(4); PG8_BAR;
        PG8_STAGE(PG8_SB(1, 0), cB + kstep, voffB); PG8_STAGE(PG8_SA(1, 0), cA + kstep, voffA); PG8_STAGE(PG8_SB(1, 1), cB + hstep + kstep, voffB);
        PG8_WAIT_V(6); PG8_BAR;
    }
    for (;;) {
        const bool has_next = S.next(ui + 1, nxt);
        const char* nA = has_next ? g.abase(nxt.pm) : cA; const char* nB = has_next ? g.bbase(nxt.pn) : cB;
        for (int t = 0; t < nt; t += 2) {
            const bool last = (t == nt - 2);
            const char* a1 = cA + (size_t)(t + 1) * kstep;
            const char* a2 = last ? nA : cA + (size_t)(t + 2) * kstep; const char* b2 = last ? nB : cB + (size_t)(t + 2) * kstep;
            const char* a3 = a2 + kstep; const char* b3 = b2 + kstep;
            if (last && has_next) S.a_ready(nxt);
            if constexpr (SP2) {
            PG8_LDB(B0, 0, 0); PG8_LDB(B1, 0, 1); PG8_SCHED; PG8_LDA(At, 0, 0); PG8_STAGE(PG8_SA(1, 1), a1 + hstep, voffA);
            PG8_WAIT_V(8); PG8_WAIT_L(0); PG8_BAR; PG8_MMA(0, 0, At, B0); PG8_MMA(0, 1, At, B1); PG8_BAR; PG8_SCHED;
            PG8_LDA(At, 0, 1); PG8_STAGE(PG8_SB(0, 0), b2, voffB); PG8_STAGE(PG8_SB(0, 1), b2 + hstep, voffB); PG8_STAGE(PG8_SA(0, 0), a2, voffA);
            PG8_WAIT_V(8); PG8_WAIT_L(0); PG8_BAR; PG8_MMA(1, 0, At, B0); PG8_MMA(1, 1, At, B1); PG8_BAR; PG8_SCHED;
            PG8_LDB(B0, 1, 0); PG8_LDB(B1, 1, 1); PG8_SCHED; PG8_LDA(At, 1, 0); PG8_STAGE(PG8_SA(0, 1), a2 + hstep, voffA);
            PG8_WAIT_V(8); PG8_WAIT_L(0); PG8_BAR; PG8_MMA(0, 0, At, B0); PG8_MMA(0, 1, At, B1); PG8_BAR; PG8_SCHED;
            PG8_LDA(At, 1, 1); PG8_STAGE(PG8_SB(1, 0), b3, voffB); PG8_STAGE(PG8_SB(1, 1), b3 + hstep, voffB); PG8_STAGE(PG8_SA(1, 0), a3, voffA);
            PG8_WAIT_V(8); PG8_WAIT_L(0); PG8_BAR; PG8_MMA(1, 0, At, B0); PG8_MMA(1, 1, At, B1); PG8_BAR; PG8_SCHED;
            } else {
            PG8_LDB(B0, 0, 0); PG8_SCHED; PG8_LDA(At, 0, 0); PG8_STAGE(PG8_SA(1, 1), a1 + hstep, voffA);
            PG8_WAIT_L(8); PG8_BAR; PG8_WAIT_L(0); PG8_MMA(0, 0, At, B0); PG8_BAR; PG8_SCHED;
            PG8_LDB(B1, 0, 1); PG8_STAGE(PG8_SB(0, 0), b2, voffB);
            PG8_BAR; PG8_WAIT_L(0); PG8_MMA(0, 1, At, B1); PG8_BAR;
            PG8_LDA(At, 0, 1); PG8_STAGE(PG8_SA(0, 0), a2, voffA);
            PG8_BAR; PG8_WAIT_L(0); PG8_MMA(1, 0, At, B0); PG8_BAR; PG8_SCHED;
            PG8_STAGE(PG8_SB(0, 1), b2 + hstep, voffB);
            PG8_WAIT_V(6); PG8_BAR; PG8_MMA(1, 1, At, B1); PG8_BAR;
            PG8_LDB(B0, 1, 0); PG8_SCHED; PG8_LDA(At, 1, 0); PG8_STAGE(PG8_SA(0, 1), a2 + hstep, voffA);
            PG8_WAIT_L(8); PG8_BAR; PG8_WAIT_L(0); PG8_MMA(0, 0, At, B0); PG8_BAR; PG8_SCHED;
            PG8_LDB(B1, 1, 1); PG8_STAGE(PG8_SB(1, 0), b3, voffB);
            PG8_BAR; PG8_WAIT_L(0); PG8_MMA(0, 1, At, B1); PG8_BAR;
            PG8_LDA(At, 1, 1); PG8_STAGE(PG8_SA(1, 0), a3, voffA);
            PG8_BAR; PG8_WAIT_L(0); PG8_MMA(1, 0, At, B0); PG8_BAR; PG8_SCHED;
            PG8_STAGE(PG8_SB(1, 1), b3 + hstep, voffB);
            PG8_WAIT_V(6); PG8_BAR; PG8_MMA(1, 1, At, B1); PG8_BAR;
            }
        }
        if constexpr (ALIGN_EPI) { if (wr == 0) PG8_BAR; }
        if constexpr (!Epi::AFTER_DRAIN) { if constexpr (DBG != 4) E(acc, cur, wr, wc, fr, fq); else { _Pragma("unroll") for (int a_ = 0; a_ < 2; ++a_) _Pragma("unroll") for (int b_ = 0; b_ < 2; ++b_) _Pragma("unroll") for (int m_ = 0; m_ < 4; ++m_) _Pragma("unroll") for (int n_ = 0; n_ < 2; ++n_) asm volatile("" :: "v"(acc[a_][b_][m_][n_])); } S.done(cur); }
        if (!has_next) break;
#pragma unroll
        for (int a = 0; a < 2; ++a)
#pragma unroll
            for (int b = 0; b < 2; ++b)
#pragma unroll
                for (int m = 0; m < 4; ++m)
#pragma unroll
                    for (int n = 0; n < 2; ++n) acc[a][b][m][n] = (f32x4){0.f, 0.f, 0.f, 0.f};
        cur = nxt; cA = nA; cB = nB; ++ui;
        if constexpr (ALIGN_EPI) { if (wr == 1) PG8_BAR; }
    }
    PG8_WAIT_V(0);
    if constexpr (!ALIGN_EPI) { if (wr == 0) PG8_BAR; }
    PG8_BAR;
    if constexpr (Epi::AFTER_DRAIN) { E.fused(acc, cur, wr, wc, fr, fq, lds, wid, lane); S.done(cur); }
#undef PG8_SA
#undef PG8_SB
#undef PG8_STAGE
#undef PG8_LDA
#undef PG8_LDB
#undef PG8_MMA
#undef PG8_WAIT_V
#undef PG8_WAIT_L
#undef PG8_BAR
#undef PG8_SCHED
}
}
#define XB_TMO      128
#define XB_XCNT(j)  (256  + 64 * (j))
#define XB_XSUB(j)  (1280 + 64 * (j))
#define XB_XGEN(j)  (2304 + 64 * (j))
#define XB_TOP      3328
#define XB_TOPGEN   3392
#define XCD_BAR_WORDS 3456
#define XB_SPIN_CAP (1u << 18)

__device__ __forceinline__ unsigned xb_ld(unsigned* p)              { return __hip_atomic_load(p, __ATOMIC_RELAXED, __HIP_MEMORY_SCOPE_AGENT); }
__device__ __forceinline__ unsigned xb_add(unsigned* p, unsigned v) { return __hip_atomic_fetch_add(p, v, __ATOMIC_RELAXED, __HIP_MEMORY_SCOPE_AGENT); }
__device__ __forceinline__ unsigned xb_xcc_id() { return (unsigned)__builtin_amdgcn_s_getreg((3 << 11) | 20) & 0xFu; }
#define XB_SPIN(cond, bar) do { unsigned _sp = 0; while (cond) { __builtin_amdgcn_s_sleep(1); \
    if ((++_sp & 255u) == 0u) { if (xb_ld(&(bar)[XB_TMO])) break; if (_sp > XB_SPIN_CAP) { atomicAdd(&(bar)[XB_TMO], 1u); break; } } } } while (0)

struct XcdBarrier {
    unsigned* bar; unsigned x;
    volatile LAS unsigned* st;
};

__device__ __forceinline__ XcdBarrier xcd_barrier_post(unsigned* bar, volatile LAS unsigned* st) {
    XcdBarrier b; b.bar = bar; b.x = xb_xcc_id(); b.st = st;
    if (threadIdx.x == 0) (void)xb_add(&bar[XB_XCNT(b.x)], 1u);
    return b;
}
__device__ __forceinline__ void xcd_barrier_complete(unsigned* bar, unsigned x, unsigned& nloc, unsigned& nx) {
    const unsigned G = gridDim.x * gridDim.y * gridDim.z;
    unsigned sum, cnt, mine, sp = 0u;
    for (;;) {
        sum = 0u; cnt = 0u; mine = 0u;
#pragma unroll
        for (unsigned j = 0; j < 16; ++j) { const unsigned c = xb_ld(&bar[XB_XCNT(j)]); sum += c; cnt += (c > 0u) ? 1u : 0u; mine = (j == x) ? c : mine; }
        if (sum == G) break;
        __builtin_amdgcn_s_sleep(1);
        if ((++sp & 255u) == 0u) { if (xb_ld(&bar[XB_TMO])) break; if (sp > XB_SPIN_CAP) { atomicAdd(&bar[XB_TMO], 1u); break; } }
    }
    nloc = mine > 0u ? mine : 1u; nx = cnt > 0u ? cnt : 1u;
}

__device__ __forceinline__ void xcd_barrier(const XcdBarrier& b) {
    asm volatile("s_waitcnt vmcnt(0)" ::: "memory");
    __syncthreads();
    if (threadIdx.x == 0) {
        unsigned* bar = b.bar;
        __builtin_amdgcn_s_waitcnt(0);
        unsigned nloc = b.st[0], nx = b.st[1];
        if (nloc == 0u) { xcd_barrier_complete(bar, b.x, nloc, nx); b.st[0] = nloc; b.st[1] = nx; }
        const unsigned old = xb_add(&bar[XB_XSUB(b.x)], 1u);
        const unsigned gen = old / nloc;
        if (old + 1u == (gen + 1u) * nloc) {
            __builtin_amdgcn_fence(__ATOMIC_RELEASE, "agent");
            asm volatile("s_waitcnt vmcnt(0)" ::: "memory");
            const unsigned og = xb_add(&bar[XB_TOP], 1u);
            const unsigned tg = og / nx;
            if (og + 1u == (tg + 1u) * nx) xb_add(&bar[XB_TOPGEN], 1u);
            else XB_SPIN(xb_ld(&bar[XB_TOPGEN]) == tg, bar);
            __builtin_amdgcn_fence(__ATOMIC_ACQUIRE, "agent");
            xb_add(&bar[XB_XGEN(b.x)], 1u);
            asm volatile("s_waitcnt vmcnt(0)" ::: "memory");
        } else {
            XB_SPIN(xb_ld(&bar[XB_XGEN(b.x)]) == gen, bar);
            __builtin_amdgcn_fence(__ATOMIC_ACQUIRE, "agent");
            asm volatile("s_waitcnt vmcnt(0)" ::: "memory");
        }
    }
    __syncthreads();
}


struct Frame {
    LAS unsigned char* lds;
    int tid, lane, wave, G, gw, ngw;
    const float *in_XP, *in_XS, *in_WIN, *in_WCONV, *in_BCONV, *in_WR, *in_BR, *in_WI, *in_BI, *in_LAM, *in_RPB, *in_WNO, *in_WLO, *in_WM, *in_BM, *in_WOUT, *in_GMPRE, *in_GMPOST, *in_GFPRE, *in_GFPOST, *in_WFG, *in_WFU, *in_WFD; float* out; unsigned char* ws;
};
enum { I_XP = 0, I_XS, I_WIN, I_WCONV, I_BCONV, I_WR, I_BR, I_WI, I_BI, I_LAM, I_RPB, I_WNO, I_WLO, I_WM, I_BM, I_WOUT, I_GMPRE, I_GMPOST, I_GFPRE, I_GFPOST, I_WFG, I_WFU, I_WFD };
__device__ __forceinline__ int opaque(int x) { asm volatile("" : "+v"(x)); return x; }
template <class T> __device__ __forceinline__ T* wsp(const Frame& F, size_t off) { return (T*)(F.ws + off); }
__device__ __forceinline__ const float* xrow(const Frame& F, int m) { return m < LP ? F.in_XP + (size_t)m * D : F.in_XS + (size_t)(m - LP) * D; }

__device__ __forceinline__ void tr_item(const float* src, int ldsrc, int k0, int n0, bf16_t* dst, int ldd, int drow0, LAS float* scr, int lane) {
#pragma unroll 8
    for (int i = 0; i < 32; ++i) { const int kk = 2 * i + (lane >> 5); scr[kk * 33 + (lane & 31)] = src[(size_t)(k0 + kk) * ldsrc + n0 + (lane & 31)]; }
    LDS_WAIT(); asm volatile("" ::: "memory");
    const int c = lane & 7;
#pragma unroll
    for (int j = 0; j < 4; ++j) { const int n = (lane >> 3) + 8 * j; const LAS float* s = scr + (8 * c) * 33 + n;
        u32x4 o; o.x = pk2(s[0 * 33], s[1 * 33]); o.y = pk2(s[2 * 33], s[3 * 33]); o.z = pk2(s[4 * 33], s[5 * 33]); o.w = pk2(s[6 * 33], s[7 * 33]);
        *(u32x4*)(dst + (size_t)(drow0 + n) * ldd + k0 + 8 * c) = o; }
    LDS_WAIT(); asm volatile("" ::: "memory");
}
__device__ __forceinline__ unsigned pk4_fp8(float a, float b, float c, float d) { int p = __builtin_amdgcn_cvt_pk_fp8_f32(a, b, 0, false); p = __builtin_amdgcn_cvt_pk_fp8_f32(c, d, p, true); return (unsigned)p; }
__device__ __forceinline__ void tr_item8(const float* src, int ldsrc, int k0, int n0, unsigned char* dst, int ldd, int drow0, LAS float* scr, int lane) {
#pragma unroll 8
    for (int i = 0; i < 32; ++i) { const int kk = 2 * i + (lane >> 5); scr[kk * 33 + (lane & 31)] = src[(size_t)(k0 + kk) * ldsrc + n0 + (lane & 31)]; }
    LDS_WAIT(); asm volatile("" ::: "memory");
    const int c = lane & 7;
#pragma unroll
    for (int j = 0; j < 4; ++j) { const int n = (lane >> 3) + 8 * j; const LAS float* s = scr + (8 * c) * 33 + n;
        u32x2 o; o.x = pk4_fp8(s[0 * 33] * 256.f, s[1 * 33] * 256.f, s[2 * 33] * 256.f, s[3 * 33] * 256.f); o.y = pk4_fp8(s[4 * 33] * 256.f, s[5 * 33] * 256.f, s[6 * 33] * 256.f, s[7 * 33] * 256.f);
        *(u32x2*)(dst + (size_t)(drow0 + n) * ldd + k0 + 8 * c) = o; }
    LDS_WAIT(); asm volatile("" ::: "memory");
}
__device__ __forceinline__ unsigned pk4_i8(float a, float b, float c, float d) { return ((unsigned)(int)a & 255u) | (((unsigned)(int)b & 255u) << 8) | (((unsigned)(int)c & 255u) << 16) | ((unsigned)(int)d << 24); }
__device__ __forceinline__ void tr_strip_i8(const float* src, int ldsrc, int K, int n0, signed char* dst, int drow0, float* cs, LAS float* scr, int lane) {
    const float* sp = src + n0 + (lane & 31) + (size_t)(lane >> 5) * ldsrc;
    float mx = 0.f;
    { const float* p = sp; const size_t step = (size_t)2 * ldsrc;
      for (int k0 = 0; k0 < K; k0 += 64) {
        float t[32];
#pragma unroll
        for (int i = 0; i < 32; ++i) { t[i] = *p; p += step; }
#pragma unroll
        for (int i = 0; i < 32; ++i) mx = fmaxf(mx, fabsf(t[i]));
      } }
    mx = fmaxf(mx, __shfl_xor(mx, 32));
    const float amax = fmaxf(mx, 1e-20f), inv = 127.0f / amax;
    if (lane < 32) cs[drow0 + lane] = amax * (1.0f / 127.0f);
    const int c = lane & 7;
    for (int k0 = 0; k0 < K; k0 += 64) {
        { const float* p = sp + (size_t)k0 * ldsrc; const size_t step = (size_t)2 * ldsrc; LAS float* w = scr + (lane >> 5) * 33 + (lane & 31);
          float t[32];
#pragma unroll
          for (int i = 0; i < 32; ++i) { t[i] = *p; p += step; }
#pragma unroll
          for (int i = 0; i < 32; ++i) w[i * 66] = rintf(t[i] * inv); }
        LDS_WAIT(); asm volatile("" ::: "memory");
#pragma unroll
        for (int j = 0; j < 4; ++j) { const int n = (lane >> 3) + 8 * j; const LAS float* t = scr + (8 * c) * 33 + n;
            u32x2 o; o.x = pk4_i8(t[0 * 33], t[1 * 33], t[2 * 33], t[3 * 33]); o.y = pk4_i8(t[4 * 33], t[5 * 33], t[6 * 33], t[7 * 33]);
            *(u32x2*)(dst + (size_t)(drow0 + n) * K + k0 + 8 * c) = o; }
        LDS_WAIT(); asm volatile("" ::: "memory");
    }
}
__device__ __forceinline__ void fwht32(float (&v)[32]) {
#pragma unroll
    for (int st = 1; st < 32; st <<= 1)
#pragma unroll
        for (int i = 0; i < 32; ++i) if (!(i & st)) { const float a = v[i], b = v[i + st]; v[i] = a + b; v[i + st] = a - b; }
#pragma unroll
    for (int i = 0; i < 32; ++i) v[i] *= 0.17677669529663687f;
}
__device__ __forceinline__ void had_tile_load(const float* src, int ldsrc, int k0, int n0, LAS float* scr, int lane, float (&v)[32]) {
    { const float* p = src + (size_t)(k0 + (lane >> 5)) * ldsrc + n0 + (lane & 31); const size_t step = (size_t)2 * ldsrc; LAS float* w = scr + (lane >> 5) * 33 + (lane & 31); float t[32];
#pragma unroll
      for (int i = 0; i < 32; ++i) { t[i] = *p; p += step; }
#pragma unroll
      for (int i = 0; i < 32; ++i) w[i * 66] = t[i]; }
    LDS_WAIT(); asm volatile("" ::: "memory");
    const LAS float* hv = scr + (32 * (lane >> 5)) * 33 + (lane & 31);
#pragma unroll
    for (int i = 0; i < 32; ++i) v[i] = hv[i * 33];
    fwht32(v);
}
__device__ __forceinline__ void had_tile_amax(const float* src, int ldsrc, int k0, int n0, unsigned* am, LAS float* scr, int lane) {
    float v[32]; had_tile_load(src, ldsrc, k0, n0, scr, lane, v);
    float mx = 0.f;
#pragma unroll
    for (int i = 0; i < 32; ++i) mx = fmaxf(mx, fabsf(v[i]));
    mx = fmaxf(mx, __shfl_xor(mx, 32));
    if (lane < 32) atomicMax(am + n0 + lane, __builtin_bit_cast(unsigned, mx));
    LDS_WAIT(); asm volatile("" ::: "memory");
}
__device__ __forceinline__ void had_tile_quant(const float* src, int ldsrc, int K, int k0, int n0, signed char* dst, const unsigned* am, float* cs, LAS float* scr, int lane) {
    const float amax = fmaxf(__builtin_bit_cast(float, am[n0 + (lane & 31)]), 1e-20f), inv = 127.0f / amax;
    if (k0 == 0 && lane < 32) cs[n0 + lane] = amax * (1.0f / 127.0f);
    float v[32]; had_tile_load(src, ldsrc, k0, n0, scr, lane, v);
    LAS float* hv = scr + (32 * (lane >> 5)) * 33 + (lane & 31);
#pragma unroll
    for (int i = 0; i < 32; ++i) hv[i * 33] = rintf(v[i] * inv);
    LDS_WAIT(); asm volatile("" ::: "memory");
    const int c = lane & 7;
#pragma unroll
    for (int j = 0; j < 4; ++j) { const int n = (lane >> 3) + 8 * j; const LAS float* t = scr + (8 * c) * 33 + n;
        u32x2 o; o.x = pk4_i8(t[0 * 33], t[1 * 33], t[2 * 33], t[3 * 33]); o.y = pk4_i8(t[4 * 33], t[5 * 33], t[6 * 33], t[7 * 33]);
        *(u32x2*)(dst + (size_t)(n0 + n) * K + k0 + 8 * c) = o; }
    LDS_WAIT(); asm volatile("" ::: "memory");
}
#define TR_JOB(SRC, LDSRC, KK, NN, DST, DROW_EXPR) { const int nblk = (NN) / 32, nit = ((KK) / 64) * nblk; \
    if (r < nit) { const int kb = r / nblk, nb = r % nblk, n0 = 32 * nb; tr_item((SRC), (LDSRC), 64 * kb, n0, (DST), (KK), (DROW_EXPR), scr, F.lane); continue; } r -= nit; }
#define TR_JOB8(SRC, LDSRC, KK, NN, DST, DROW_EXPR) { const int nblk = (NN) / 32, nit = ((KK) / 64) * nblk; \
    if (r < nit) { const int kb = r / nblk, nb = r % nblk, n0 = 32 * nb; tr_item8((SRC), (LDSRC), 64 * kb, n0, (DST), (KK), (DROW_EXPR), scr, F.lane); continue; } r -= nit; }

__device__ __forceinline__ void p0_prologue(Frame& F) {
    const int tid_ = opaque(F.tid);
    LAS float* scr = (LAS float*)(F.lds + F.wave * 8448);
    const float* w_in = F.in_WIN;
    bf16_t* WCAT = wsp<bf16_t>(F, WS_WCAT); signed char* W8 = wsp<signed char>(F, WS_W8); signed char* WV8 = wsp<signed char>(F, WS_WVT); signed char* WGU8 = wsp<signed char>(F, WS_WGU);
    float* CS = wsp<float>(F, WS_CS);
    constexpr int NSM = 64;
    constexpr int IT_SM = 2 * 4;
    constexpr int S_Q = NAW / 32, S_M = 2 * D / 32, S_F = DFF / 32;
    constexpr int NSTRIP = 3 * S_Q + S_M + 2 * S_F;
    constexpr int N_AMAX = (DFF / 64) * (D / 32);
    constexpr int N_BIG = 2 * (D / 64) * (NAW / 32) + 2 * (NAW / 64) * (D / 32) + (D / 64) * (D / 32) + N_AMAX;
    constexpr int NITEMS = N_BIG + NSM * IT_SM;
    for (int it = F.gw; it < NSTRIP + NITEMS; it += F.ngw) {
        if (it < NSTRIP) {
            int q = it; const float* src; int ld, n0, drow0; signed char* dst; float* cs;
            if (q < S_Q) { src = w_in; ld = INW; n0 = 32 * q; dst = W8; drow0 = n0; cs = CS + CS_QKM; }
            else if ((q -= S_Q) < S_Q) { src = w_in + NAW; ld = INW; n0 = 32 * q; dst = W8; drow0 = 2048 + n0; cs = CS + CS_QKM; }
            else if ((q -= S_Q) < S_M) { src = F.in_WM; ld = 2 * D; n0 = 32 * q; dst = W8; drow0 = 4096 + n0; cs = CS + CS_QKM; }
            else if ((q -= S_M) < S_Q) { src = w_in + 2 * NAW; ld = INW; n0 = 32 * q; dst = WV8; drow0 = n0; cs = CS + CS_V; }
            else if ((q -= S_Q) < S_F) { src = F.in_WFG; ld = DFF; n0 = 32 * q; dst = WGU8; drow0 = (n0 >> 7) * 256 + (n0 & 127); cs = CS + CS_GU; }
            else { q -= S_F; src = F.in_WFU; ld = DFF; n0 = 32 * q; dst = WGU8; drow0 = (n0 >> 7) * 256 + 128 + (n0 & 127); cs = CS + CS_GU; }
            tr_strip_i8(src, ld, D, n0, dst, drow0, cs, scr, F.lane);
            continue;
        }
        int r = it - NSTRIP;
        TR_JOB(w_in + 3 * NAW, INW, D, NAW, WCAT, 0 + n0)
        TR_JOB(w_in + 4 * NAW, INW, D, NAW, WCAT, 2048 + n0)
        TR_JOB(F.in_WNO, D, NAW, D, wsp<bf16_t>(F, WS_WNO), n0)
        TR_JOB(F.in_WLO, D, LW, D, wsp<bf16_t>(F, WS_WLO), n0)
        TR_JOB(F.in_WOUT, D, D, D, wsp<bf16_t>(F, WS_WO), n0)
        if (r < N_AMAX) { had_tile_amax(F.in_WFD, D, 64 * (r / (D / 32)), 32 * (r % (D / 32)), (unsigned*)(F.ws + WS_AM), scr, F.lane); continue; } r -= N_AMAX;
        {
            const int mi = r / IT_SM, ri = r % IT_SM, d = mi >> 5, g = (mi >> 4) & 1, n = mi & 15, kb = ri >> 2, nb = ri & 3;
            const float* src = (g ? F.in_WI : F.in_WR) + (size_t)(d * NBLK + n) * BW * BW;
            tr_item(src, BW, 64 * kb, 32 * nb, wsp<bf16_t>(F, WS_WG) + (size_t)mi * BW * BW, BW, 32 * nb, scr, F.lane);
        }
    }
    LAS f32x4* gl = (LAS f32x4*)(F.lds + 69632);
    for (int i = tid_; i < D / 4; i += NTHR) gl[i] = ((const f32x4*)F.in_GMPRE)[i];
    __syncthreads();
    bf16_t* XN = wsp<bf16_t>(F, WS_XN); signed char* XN8 = wsp<signed char>(F, WS_XN8); float* RS1 = wsp<float>(F, WS_RS1);
    for (int m = F.gw; m < L; m += F.ngw) {
        asm volatile("" ::: "memory");
        const f32x4* xr = (const f32x4*)xrow(F, m) + F.lane;
        f32x4 v[16]; float s = 0.f;
#pragma unroll
        for (int j = 0; j < 16; ++j) { v[j] = xr[64 * j]; s += (v[j].x * v[j].x + v[j].y * v[j].y) + (v[j].z * v[j].z + v[j].w * v[j].w); }
        const float rstd = 1.0f / sqrtf(wave_sum(s) * (1.0f / D) + EPS);
        u32x2* o8 = (u32x2*)(XN + (size_t)m * D) + F.lane; unsigned* o4 = (unsigned*)(XN8 + (size_t)m * D) + F.lane;
        float mx = 0.f;
#pragma unroll
        for (int j = 0; j < 16; ++j) { v[j] = v[j] * rstd * gl[F.lane + 64 * j]; mx = fmaxf(fmaxf(mx, fmaxf(fabsf(v[j].x), fabsf(v[j].y))), fmaxf(fabsf(v[j].z), fabsf(v[j].w))); }
        const float amax = fmaxf(wave_max(mx), 1e-20f), inv = 127.0f / amax;
        if (F.lane == 0) RS1[m] = amax * (1.0f / 127.0f);
#pragma unroll
        for (int j = 0; j < 16; ++j) { const f32x4 y = v[j]; u32x2 o; o.x = pk2(y.x, y.y); o.y = pk2(y.z, y.w); o8[64 * j] = o;
            o4[64 * j] = pk4_i8(rintf(y.x * inv), rintf(y.y * inv), rintf(y.z * inv), rintf(y.w * inv)); }
    }
    __syncthreads();
}

#ifndef ATT_SYNC
#define ATT_SYNC 1
#endif
template <int ADBG = 0> __device__ __forceinline__ void attn_mfma(Frame& F) {
    const int tid_ = opaque(F.tid);
    bf16_t* Q = wsp<bf16_t>(F, WS_Q); const bf16_t* Kb = wsp<bf16_t>(F, WS_K); const bf16_t* VT = wsp<bf16_t>(F, WS_VT);
    LAS float* rp = (LAS float*)F.lds;
    for (int i = tid_; i < NH * 15 * 31; i += NTHR) rp[i] = F.in_RPB[i];
    __syncthreads();
    const int fr = F.lane & 15, fq = F.lane >> 4;
    const float scale = 0.08838834764831845f;
    for (int base = blockIdx.x * NWAVES; base < (L / GRIDW) * NH * 4; base += F.ngw) {
        const int item = base + F.wave;
        asm volatile("" ::: "memory");
        const int g = item & 3, h = (item >> 2) & 15, rg = item >> 6;
        const int s0 = rg < LP / GRIDW ? 0 : LP, rows = rg < LP / GRIDW ? LP / GRIDW : LS / GRIDW, r = rg < LP / GRIDW ? rg : rg - LP / GRIDW;
        int rs = r - 4; rs = rs < 0 ? 0 : (rs > rows - 8 ? rows - 8 : rs);
        const int w0 = g == 0 ? 0 : (g == 1 ? 8 : (g == 2 ? 24 : 32));
        const int c = 16 * g + fr;
        int cs = c - 8; cs = cs < 0 ? 0 : (cs > GRIDW - 16 ? GRIDW - 16 : cs);
        bf16_t* qrow = Q + (size_t)(s0 + r * GRIDW + c) * NAW + h * HD;
        bf16x8 qf[4];
#pragma unroll
        for (int s = 0; s < 4; ++s) qf[s] = *(const bf16x8*)(qrow + 8 * fq + 32 * s);
        f32x4 sacc[8][2];
        const int Rg = s0 / GRIDW + rs, p0 = w0 >> 3;
        const bf16_t* kbase = Kb + (size_t)(Rg * 16 + h) * 8192 + p0 * 128 + fr * 32 + fq * 8;
        bf16x8 kb[8][2][4];
#define ATT_LDK(kr) do { _Pragma("unroll") for (int T = 0; T < 2; ++T) _Pragma("unroll") for (int s = 0; s < 4; ++s) kb[kr][T][s] = (ADBG & 1) ? qf[s] : (ADBG & 4) ? *(const bf16x8*)(Kb + (size_t)(s0 + rs * GRIDW) * NAW + h * HD * GRIDW + ((kr) * 8 + T * 4 + s) * 512 + F.lane * 8) : *(const bf16x8*)(kbase + (size_t)(kr) * (16 * 8192) + (s * 2 + T) * 1024); } while (0)
        ATT_LDK(0); ATT_LDK(1);
#pragma unroll
        for (int kr = 0; kr < 8; ++kr) {
            if (ATT_SYNC && (kr & 1) == 0) __builtin_amdgcn_s_barrier();
            if (kr + 2 < 8) ATT_LDK(kr + 2);
            __builtin_amdgcn_sched_barrier(0);
#pragma unroll
            for (int T = 0; T < 2; ++T) { f32x4 a = (f32x4){0.f, 0.f, 0.f, 0.f};
#pragma unroll
                for (int s = 0; s < 4; ++s) a = __builtin_amdgcn_mfma_f32_16x16x32_bf16(kb[kr][T][s], qf[s], a, 0, 0, 0);
                sacc[kr][T] = a; }
            __builtin_amdgcn_sched_barrier(0);
        }
#undef ATT_LDK
        bf16x8 vb[8][8];
        const bf16_t* vbase = VT + (size_t)(Rg * 16 + h) * 8192 + p0 * 128 + fq * 128 + fr * 8;
#define ATT_LDV(kr) do { _Pragma("unroll") for (int dt = 0; dt < 8; ++dt) vb[kr][dt] = (ADBG & 2) ? qf[dt & 3] : (ADBG & 4) ? *(const bf16x8*)(VT + (size_t)(h * HD) * L + s0 + rs * GRIDW + ((kr) * 8 + dt) * 512 + F.lane * 8) : *(const bf16x8*)(vbase + (size_t)(kr) * (16 * 8192) + dt * 1024); } while (0)
        ATT_LDV(0); ATT_LDV(1);
        __builtin_amdgcn_sched_barrier(0);
        const int elo = cs - w0 - 8 * fq, dc0 = w0 + 8 * fq - c + 15;
        const LAS float* rph = rp + h * 465 + (rs - r + 7) * 31;
        float mx = -3.0e38f;
#pragma unroll
        for (int e = 0; e < 8; ++e) { const bool valid = (e >= elo) && (e < elo + 16); const int bi = valid ? dc0 + e : 0;
#pragma unroll
            for (int kr = 0; kr < 8; ++kr) { const float sv = valid ? sacc[kr][e >> 2][e & 3] * scale + rph[kr * 31 + bi] : -3.0e38f; sacc[kr][e >> 2][e & 3] = sv; mx = fmaxf(mx, sv); } }
        mx = fmaxf(mx, __shfl_xor(mx, 16)); mx = fmaxf(mx, __shfl_xor(mx, 32));
        float lsum = 0.f; bf16x8 pf[8];
#pragma unroll
        for (int kr = 0; kr < 8; ++kr) { float p[8];
#pragma unroll
            for (int e = 0; e < 8; ++e) { p[e] = __expf(sacc[kr][e >> 2][e & 3] - mx); lsum += p[e]; }
            u32x4 w; w.x = pk2(p[0], p[1]); w.y = pk2(p[2], p[3]); w.z = pk2(p[4], p[5]); w.w = pk2(p[6], p[7]);
            pf[kr] = __builtin_bit_cast(bf16x8, w); }
        lsum += __shfl_xor(lsum, 16); lsum += __shfl_xor(lsum, 32);
        f32x4 oacc[8];
#pragma unroll
        for (int dt = 0; dt < 8; ++dt) oacc[dt] = (f32x4){0.f, 0.f, 0.f, 0.f};
#pragma unroll
        for (int kr = 0; kr < 8; ++kr) {
            if (ATT_SYNC && (kr & 1) == 0) __builtin_amdgcn_s_barrier();
            if (kr + 2 < 8) ATT_LDV(kr + 2);
            __builtin_amdgcn_sched_barrier(0);
#pragma unroll
            for (int dt = 0; dt < 8; ++dt) oacc[dt] = __builtin_amdgcn_mfma_f32_16x16x32_bf16(vb[kr][dt], pf[kr], oacc[dt], 0, 0, 0);
            __builtin_amdgcn_sched_barrier(0);
        }
#undef ATT_LDV
        const float inv = 1.0f / lsum;
#ifdef ATTN_OUT_OFF
        bf16_t* orow = wsp<bf16_t>(F, (size_t)ATTN_OUT_OFF * MiB) + (size_t)(s0 + r * GRIDW + c) * NAW + h * HD;
#else
        bf16_t* orow = qrow;
#endif
#pragma unroll
        for (int u = 0; u < 4; ++u) *(u32x4*)(orow + 32 * u + 8 * fq) = pg8::pack8(oacc[2 * u] * inv, oacc[2 * u + 1] * inv);
    }
    __syncthreads();
}

__device__ __forceinline__ void attn_mfma_lds(Frame& F) {
    const int tid_ = opaque(F.tid);
    bf16_t* Q = wsp<bf16_t>(F, WS_Q); const bf16_t* Kb = wsp<bf16_t>(F, WS_K); const bf16_t* VT = wsp<bf16_t>(F, WS_VT);
    LAS float* rp = (LAS float*)F.lds;
    LAS unsigned char* ring = F.lds + 30720;
    for (int i = tid_; i < NH * 15 * 31; i += NTHR) rp[i] = F.in_RPB[i];
    __syncthreads();
    const int lane = tid_ & 63, fr = lane & 15, fq = lane >> 4, w = F.wave, hl = w >> 2, g = w & 3;
    const float scale = 0.08838834764831845f;
    constexpr int NIT = (L / GRIDW) * NH * 4;
    const int w0 = g == 0 ? 0 : (g == 1 ? 8 : (g == 2 ? 24 : 32)), p0 = w0 >> 3;
    const int c = 16 * g + fr;
    int cs = c - 8; cs = cs < 0 ? 0 : (cs > GRIDW - 16 ? GRIDW - 16 : cs);
#define ATL_SRC(b, st) ([&]() -> const bf16_t* { const int rg_ = (b) >> 6, hb_ = ((b) >> 2) & 15; const int rows_ = rg_ < LP / GRIDW ? LP / GRIDW : LS / GRIDW, r_ = rg_ < LP / GRIDW ? rg_ : rg_ - LP / GRIDW; \
        int rs_ = r_ - 4; rs_ = rs_ < 0 ? 0 : (rs_ > rows_ - 8 ? rows_ - 8 : rs_); const int Rg_ = (rg_ < LP / GRIDW ? 0 : LP / GRIDW) + rs_; \
        return ((st) < 8 ? Kb : VT) + (size_t)((Rg_ + ((st) & 7)) * 16 + hb_) * 8192; }())
#define ATL_ISSUE(src, slot) do { const bf16_t* s_ = (src) + tid_ * 8; LAS unsigned char* d_ = ring + (slot) * 32768 + w * 1024; _Pragma("unroll") for (int k_ = 0; k_ < 4; ++k_) \
        __builtin_amdgcn_global_load_lds((const unsigned*)(s_ + k_ * 4096), (LAS unsigned*)(d_ + k_ * 8192), 16, 0, 0); } while (0)
    int base = blockIdx.x * NWAVES;
    if (base < NIT) { ATL_ISSUE(ATL_SRC(base, 0), 0); ATL_ISSUE(ATL_SRC(base, 1), 1); }
    int b0 = 0;
    for (; base < NIT; base += F.ngw) {
        asm volatile("" ::: "memory");
        const int h = ((base >> 2) & 15) + hl, rg = base >> 6;
        const int s0 = rg < LP / GRIDW ? 0 : LP, rows = rg < LP / GRIDW ? LP / GRIDW : LS / GRIDW, r = rg < LP / GRIDW ? rg : rg - LP / GRIDW;
        int rs = r - 4; rs = rs < 0 ? 0 : (rs > rows - 8 ? rows - 8 : rs);
        const int nbase = base + F.ngw < NIT ? base + F.ngw : base;
        bf16_t* qrow = Q + (size_t)(s0 + r * GRIDW + c) * NAW + h * HD;
        bf16x8 qf[4];
#pragma unroll
        for (int s = 0; s < 4; ++s) qf[s] = *(const bf16x8*)(qrow + 8 * fq + 32 * s);
        f32x4 sacc[8][2]; f32x4 oacc[8]; bf16x8 pf[8]; float lsum = 0.f;
#pragma unroll
        for (int dt = 0; dt < 8; ++dt) oacc[dt] = (f32x4){0.f, 0.f, 0.f, 0.f};
        const int koff = hl * 16384 + (p0 * 128 + fr * 32 + fq * 8) * 2, voff = hl * 16384 + (p0 * 128 + fq * 128 + fr * 8) * 2;
#pragma unroll
        for (int st = 0; st < 16; ++st) {
            asm volatile("s_waitcnt vmcnt(4)" ::: "memory"); asm volatile("s_waitcnt lgkmcnt(0)" ::: "memory"); __builtin_amdgcn_s_barrier(); asm volatile("" ::: "memory");
            { const int slot2 = (b0 + st + 2) % 3; if (st + 2 < 16) ATL_ISSUE(ATL_SRC(base, st + 2), slot2); else ATL_ISSUE(ATL_SRC(nbase, st + 2 - 16), slot2); }
            const LAS unsigned char* buf = ring + ((b0 + st) % 3) * 32768;
            if (st < 8) {
#pragma unroll
                for (int T = 0; T < 2; ++T) { f32x4 a = (f32x4){0.f, 0.f, 0.f, 0.f};
#pragma unroll
                    for (int s2 = 0; s2 < 4; ++s2) a = __builtin_amdgcn_mfma_f32_16x16x32_bf16(*(const LAS bf16x8*)(buf + koff + (s2 * 2 + T) * 2048), qf[s2], a, 0, 0, 0);
                    sacc[st][T] = a; }
            } else {
                if (st == 8) {
                    const int elo = cs - w0 - 8 * fq, dc0 = w0 + 8 * fq - c + 15;
                    const LAS float* rph = rp + h * 465 + (rs - r + 7) * 31;
                    float mx = -3.0e38f;
#pragma unroll
                    for (int e = 0; e < 8; ++e) { const bool valid = (e >= elo) && (e < elo + 16); const int bi = valid ? dc0 + e : 0;
#pragma unroll
                        for (int kr = 0; kr < 8; ++kr) { const float sv = valid ? sacc[kr][e >> 2][e & 3] * scale + rph[kr * 31 + bi] : -3.0e38f; sacc[kr][e >> 2][e & 3] = sv; mx = fmaxf(mx, sv); } }
                    mx = fmaxf(mx, __shfl_xor(mx, 16)); mx = fmaxf(mx, __shfl_xor(mx, 32));
#pragma unroll
                    for (int kr = 0; kr < 8; ++kr) { float p[8];
#pragma unroll
                        for (int e = 0; e < 8; ++e) { p[e] = __expf(sacc[kr][e >> 2][e & 3] - mx); lsum += p[e]; }
                        u32x4 wv; wv.x = pk2(p[0], p[1]); wv.y = pk2(p[2], p[3]); wv.z = pk2(p[4], p[5]); wv.w = pk2(p[6], p[7]);
                        pf[kr] = __builtin_bit_cast(bf16x8, wv); }
                    lsum += __shfl_xor(lsum, 16); lsum += __shfl_xor(lsum, 32);
                }
#pragma unroll
                for (int dt = 0; dt < 8; ++dt) oacc[dt] = __builtin_amdgcn_mfma_f32_16x16x32_bf16(*(const LAS bf16x8*)(buf + voff + dt * 2048), pf[st - 8], oacc[dt], 0, 0, 0);
            }
        }
        b0 = (b0 + 16) % 3;
        const float inv = 1.0f / lsum;
#pragma unroll
        for (int u = 0; u < 4; ++u) *(u32x4*)(qrow + 32 * u + 8 * fq) = pg8::pack8(oacc[2 * u] * inv, oacc[2 * u + 1] * inv);
    }
#undef ATL_SRC
#undef ATL_ISSUE
    asm volatile("s_waitcnt vmcnt(0)" ::: "memory");
    __syncthreads();
}

__device__ __forceinline__ void conv_phase(Frame& F) {
    const int tid_ = opaque(F.tid);
    const bf16_t* XR = wsp<bf16_t>(F, WS_XR); bf16_t* XC = wsp<bf16_t>(F, WS_XC);
    const float* wc = F.in_WCONV; const float* bc = F.in_BCONV;
    const int nth = F.G * NTHR;
    for (int it = blockIdx.x * NTHR + tid_; it < L * (LW / 8); it += nth) {
        const int t = it / (LW / 8), c0 = (it % (LW / 8)) * 8;
        const int s0 = t < LP ? 0 : LP, len = t < LP ? LP : LS, tl = t - s0;
        float acc[8];
#pragma unroll
        for (int e = 0; e < 8; ++e) acc[e] = bc[c0 + e];
#pragma unroll
        for (int j = 0; j < 4; ++j) { const int tt = tl + j - 2; if (tt < 0 || tt >= len) continue;
            f32x4 x0, x1; pg8::unpack8(*(const u32x4*)(XR + (size_t)(s0 + tt) * LW + c0), x0, x1);
            const f32x4 w0 = *(const f32x4*)(wc + j * LW + c0), w1 = *(const f32x4*)(wc + j * LW + c0 + 4);
#pragma unroll
            for (int e = 0; e < 4; ++e) { acc[e] += w0[e] * x0[e]; acc[4 + e] += w1[e] * x1[e]; } }
        *(u32x4*)(XC + (size_t)t * LW + c0) = pg8::pack8((f32x4){acc[0], acc[1], acc[2], acc[3]}, (f32x4){acc[4], acc[5], acc[6], acc[7]});
    }
}

struct LruW { bf16x8 w[2][4]; float br, bi, cl; };
template <int DIR> __device__ __forceinline__ void lru_load_w(const Frame& F, LruW& W, int n, int w, int fr, int fq) {
    const bf16_t* wg = wsp<bf16_t>(F, WS_WG);
#pragma unroll
    for (int g = 0; g < 2; ++g)
#pragma unroll
        for (int s = 0; s < 4; ++s) W.w[g][s] = *(const bf16x8*)(wg + ((size_t)((DIR * 2 + g) * NBLK + n) * BW + 16 * w + fr) * BW + 32 * fq + 8 * s);
    const int ch = n * BW + 16 * w + fr;
    W.br = F.in_BR[DIR * LW + ch]; W.bi = F.in_BI[DIR * LW + ch];
    const float lam = F.in_LAM[DIR * LW + ch];
    W.cl = -8.0f * ((lam > 15.f) ? __expf(-lam) : log1pf(__expf(-lam)));
}
template <int LDBG = 0> __device__ __forceinline__ void lru_gate(float pr, float pi, float xc, const LruW& W, bool first, float& a, float& u) {
    if constexpr (LDBG == 1) { a = pr + W.br; u = pi * xc + W.bi; return; }
    const float r = sigmoidf_(pr + W.br), ig = sigmoidf_(pi + W.bi);
    a = __expf(W.cl * r);
    const float mult = first ? 1.0f : __builtin_amdgcn_sqrtf(fmaxf(1.0f - a * a, 0.f));
    u = mult * ig * xc;
}
struct LruX { bf16x8 x[4][4]; };
__device__ __forceinline__ void lru_load_x(LruX& X, const bf16_t* XC, int tb, int n, int fr, int fq) {
#pragma unroll
    for (int tau = 0; tau < 4; ++tau) { const bf16_t* xp = XC + ((size_t)((((tb >> 6) * NBLK + n) * 4 + tau) * 4) * 64 + fr * 4 + fq) * 8;
#pragma unroll
        for (int s = 0; s < 4; ++s) X.x[tau][s] = *(const bf16x8*)(xp + s * 512); }
}
__device__ __forceinline__ void lru_tile(const LruX& X, int tau, bool hiw, const LruW& W, const bf16x8 idf0, const bf16x8 idf1, f32x4& pr, f32x4& pi, f32x4& xct) {
    pr = (f32x4){0.f, 0.f, 0.f, 0.f}; pi = pr;
#pragma unroll
    for (int s = 0; s < 4; ++s) { pr = __builtin_amdgcn_mfma_f32_16x16x32_bf16(X.x[tau][s], W.w[0][s], pr, 0, 0, 0); pi = __builtin_amdgcn_mfma_f32_16x16x32_bf16(X.x[tau][s], W.w[1][s], pi, 0, 0, 0); }
    const bf16x8 x0 = hiw ? X.x[tau][2] : X.x[tau][0], x1 = hiw ? X.x[tau][3] : X.x[tau][1];
    xct = __builtin_amdgcn_mfma_f32_16x16x32_bf16(x0, idf0, (f32x4){0.f, 0.f, 0.f, 0.f}, 0, 0, 0);
    xct = __builtin_amdgcn_mfma_f32_16x16x32_bf16(x1, idf1, xct, 0, 0, 0);
}
__device__ __forceinline__ void lru_idfrags(int w, int fr, int fq, bf16x8& idf0, bf16x8& idf1) {
#pragma unroll
    for (int e = 0; e < 8; ++e) { const bool on = (fq == (w >> 1)) && ((fr & 7) == e); idf0[e] = (on && fr < 8) ? (short)0x3F80 : (short)0; idf1[e] = (on && fr >= 8) ? (short)0x3F80 : (short)0; }
}
constexpr int LRU_CH = 256, LRU_NCH = L / LRU_CH, LRU_NCH_P = LP / LRU_CH;
__device__ __forceinline__ void conv_unit(Frame& F, int cg, int n) {
    const int tid_ = opaque(F.tid);
    const bf16_t* XR = wsp<bf16_t>(F, WS_XR); bf16_t* XC = wsp<bf16_t>(F, WS_XC);
    const float* wc = F.in_WCONV; const float* bc = F.in_BCONV;
    const int c0 = n * BW + (tid_ & 15) * 8;
    const int s0 = cg < LRU_NCH_P ? 0 : LP, len = cg < LRU_NCH_P ? LP : LS;
    f32x4 w[4][2]; f32x4 b0 = *(const f32x4*)(bc + c0), b1 = *(const f32x4*)(bc + c0 + 4);
#pragma unroll
    for (int j = 0; j < 4; ++j) { w[j][0] = *(const f32x4*)(wc + j * LW + c0); w[j][1] = *(const f32x4*)(wc + j * LW + c0 + 4); }
#pragma unroll
    for (int i = 0; i < 8; ++i) {
        const int t = cg * LRU_CH + (tid_ >> 4) + 32 * i, tl = t - s0;
        f32x4 a0 = b0, a1 = b1;
#pragma unroll
        for (int j = 0; j < 4; ++j) { const int tt = tl + j - 2; if (tt < 0 || tt >= len) continue;
            f32x4 x0, x1; pg8::unpack8(*(const u32x4*)(XR + (size_t)(s0 + tt) * LW + c0), x0, x1); a0 += w[j][0] * x0; a1 += w[j][1] * x1; }
        const int tg = t & 63, cq = tid_ & 15;
        *(u32x4*)(XC + ((size_t)(((((t >> 6) * NBLK + n) * 4 + ((tg >> 2) & 3)) * 4 + (cq & 3)) * 16 + 4 * (tg >> 4) + (tg & 3)) * 4 + (cq >> 2)) * 8) = pg8::pack8(a0, a1);
    }
}
__device__ __forceinline__ void lru_pass_a(Frame& F) {
    const int fr = F.lane & 15, fq = F.lane >> 4, w = F.wave;
    const bf16_t* XC = wsp<bf16_t>(F, WS_XC); f32x2* SUMM = wsp<f32x2>(F, WS_SUM);
    bf16x8 idf0, idf1; lru_idfrags(w, fr, fq, idf0, idf1);
    for (int u = blockIdx.x; u < LRU_NCH * NBLK; u += F.G) {
        const int cg = u >> 4, n = u & 15;
        conv_unit(F, cg, n); VM_WAIT(); __syncthreads();
        LruW Wf, Wb; lru_load_w<0>(F, Wf, n, w, fr, fq); lru_load_w<1>(F, Wb, n, w, fr, fq);
        const bool c_first = (cg == 0 || cg == LRU_NCH_P), c_last = (cg == LRU_NCH_P - 1 || cg == LRU_NCH - 1);
        float Af = 1.f, Hf = 0.f, Ab = 1.f, Hb = 0.f;
        LruX X, Xn; lru_load_x(X, XC, cg * LRU_CH, n, fr, fq);
        for (int gi = 0; gi < 4; ++gi) {
            if (gi < 3) lru_load_x(Xn, XC, cg * LRU_CH + (gi + 1) * 64, n, fr, fq);
            float pf = 1.f, hf = 0.f, pb = 1.f, hb = 0.f;
#pragma unroll
            for (int tau = 0; tau < 4; ++tau) {
                f32x4 prf, pif, prb, pib, xct, xct2;
                lru_tile(X, tau, (w & 1) != 0, Wf, idf0, idf1, prf, pif, xct);
                lru_tile(X, tau, (w & 1) != 0, Wb, idf0, idf1, prb, pib, xct2);
#pragma unroll
                for (int j = 0; j < 4; ++j) {
                    float a, uu;
                    lru_gate(prf[j], pif[j], xct[j], Wf, c_first && gi == 0 && fq == 0 && tau == 0 && j == 0, a, uu); hf = a * hf + uu; pf *= a;
                    lru_gate(prb[j], pib[j], xct[j], Wb, c_last && gi == 3 && fq == 3 && tau == 3 && j == 3, a, uu); hb += pb * uu; pb *= a;
                }
            }
            float gPf = 1.f, gHf = 0.f, gPb = 1.f, gHb = 0.f;
#pragma unroll
            for (int qq = 0; qq < 4; ++qq) { const int src = fr + 16 * qq;
                float P = __shfl(pf, src), H = __shfl(hf, src); gHf = P * gHf + H; gPf *= P;
                P = __shfl(pb, src); H = __shfl(hb, src); gHb += gPb * H; gPb *= P; }
            Hf = gPf * Hf + gHf; Af *= gPf; Hb += Ab * gHb; Ab *= gPb;
            X = Xn;
        }
        if (fq == 0) { const int ch = n * BW + 16 * w + fr; SUMM[(size_t)(cg * 2 + 0) * LW + ch] = (f32x2){Af, Hf}; SUMM[(size_t)(cg * 2 + 1) * LW + ch] = (f32x2){Ab, Hb}; }
    }
}
__device__ __forceinline__ void lru_pass_b(Frame& F) {
    const int tid_ = opaque(F.tid);
    const int gt = blockIdx.x * NTHR + tid_; if (gt >= 4 * LW) return;
    const int ch = gt % LW, d = (gt / LW) & 1, seq = gt / (2 * LW), c0 = seq ? LRU_NCH_P : 0, nc = seq ? LRU_NCH - LRU_NCH_P : LRU_NCH_P;
    const f32x2* SUMM = wsp<f32x2>(F, WS_SUM); float* CIN = wsp<float>(F, WS_SUM + 4 * MiB);
    float s = 0.f;
    for (int i0 = 0; i0 < nc; i0 += 8) {
        f32x2 ah[8];
#pragma unroll
        for (int e = 0; e < 8; ++e) { const int cg = d ? c0 + nc - 1 - (i0 + e) : c0 + i0 + e; ah[e] = SUMM[(size_t)(cg * 2 + d) * LW + ch]; }
#pragma unroll
        for (int e = 0; e < 8; ++e) { const int cg = d ? c0 + nc - 1 - (i0 + e) : c0 + i0 + e; CIN[(size_t)(cg * 2 + d) * LW + ch] = s; s = ah[e].x * s + ah[e].y; }
    }
}
template <int LDBG = 0> __device__ __forceinline__ void lru_pass_c(Frame& F) {
    const int tid_ = opaque(F.tid);
    const int fr = F.lane & 15, fq = F.lane >> 4, w = F.wave;
    const bf16_t* XC = wsp<bf16_t>(F, WS_XC); const float* CIN = wsp<float>(F, WS_SUM + 4 * MiB);
    const bf16_t* GR = wsp<bf16_t>(F, WS_GR); bf16_t* LRU = wsp<bf16_t>(F, WS_XR);
    LAS bf16_t* hfb = (LAS bf16_t*)(F.lds + w * 8192);
    LAS bf16_t* grt = (LAS bf16_t*)(F.lds + 65536);
    bf16x8 idf0, idf1; lru_idfrags(w, fr, fq, idf0, idf1);
    for (int u = blockIdx.x; u < LRU_NCH * NBLK; u += F.G) {
        const int cg = u >> 4, n = u & 15, ch = n * BW + 16 * w + fr;
        const bool c_first = (cg == 0 || cg == LRU_NCH_P), c_last = (cg == LRU_NCH_P - 1 || cg == LRU_NCH - 1);
        { const bf16_t* gsrc = GR + (size_t)(cg * LRU_CH + (tid_ >> 4)) * LW + n * BW + (tid_ & 15) * 8; LAS bf16_t* ldst = grt + w * 512;
#pragma unroll 1
          for (int k = 0; k < 8; ++k) { __builtin_amdgcn_global_load_lds((const unsigned*)gsrc, (LAS unsigned*)ldst, 16, 0, 0); gsrc += (size_t)32 * LW; ldst += NTHR * 8; } }
        {
            LruW W; lru_load_w<0>(F, W, n, w, fr, fq);
            float s = CIN[(size_t)(cg * 2 + 0) * LW + ch];
            LruX X, Xn; lru_load_x(X, XC, cg * LRU_CH, n, fr, fq);
            for (int gi = 0; gi < 4; ++gi) {
                if (gi < 3 && LDBG != 2) lru_load_x(Xn, XC, cg * LRU_CH + (gi + 1) * 64, n, fr, fq);
                float a[16], uu[16];
#pragma unroll
                for (int tau = 0; tau < 4; ++tau) { f32x4 pr, pi, xct; lru_tile(X, tau, (w & 1) != 0, W, idf0, idf1, pr, pi, xct);
#pragma unroll
                    for (int j = 0; j < 4; ++j) lru_gate<LDBG>(pr[j], pi[j], xct[j], W, c_first && gi == 0 && fq == 0 && tau == 0 && j == 0, a[4 * tau + j], uu[4 * tau + j]); }
                float p = 1.f, h = 0.f;
#pragma unroll
                for (int t = 0; t < 16; ++t) { h = a[t] * h + uu[t]; p *= a[t]; }
                float hin = s, sg = s;
#pragma unroll
                for (int qq = 0; qq < 4; ++qq) { const float P = __shfl(p, fr + 16 * qq), H = __shfl(h, fr + 16 * qq); sg = P * sg + H; if (qq < fq) hin = P * hin + H; }
                s = sg;
                float hh = hin;
#pragma unroll
                for (int t = 0; t < 16; ++t) { hh = a[t] * hh + uu[t]; hfb[(gi * 64 + 16 * fq + t) * 16 + fr] = (bf16_t)f2bf(hh); }
                X = Xn;
            }
        }
        VM_WAIT(); __syncthreads();
        {
            LruW W; lru_load_w<1>(F, W, n, w, fr, fq);
            float s = CIN[(size_t)(cg * 2 + 1) * LW + ch];
            LruX X, Xn; lru_load_x(X, XC, cg * LRU_CH + 3 * 64, n, fr, fq);
            for (int gi = 3; gi >= 0; --gi) {
                if (gi > 0 && LDBG != 2) lru_load_x(Xn, XC, cg * LRU_CH + (gi - 1) * 64, n, fr, fq);
                float a[16], uu[16];
#pragma unroll
                for (int tau = 0; tau < 4; ++tau) { f32x4 pr, pi, xct; lru_tile(X, tau, (w & 1) != 0, W, idf0, idf1, pr, pi, xct);
#pragma unroll
                    for (int j = 0; j < 4; ++j) lru_gate<LDBG>(pr[j], pi[j], xct[j], W, c_last && gi == 3 && fq == 3 && tau == 3 && j == 3, a[4 * tau + j], uu[4 * tau + j]); }
                float p = 1.f, h = 0.f;
#pragma unroll
                for (int t = 15; t >= 0; --t) { h = a[t] * h + uu[t]; p *= a[t]; }
                float hin = s, sg = s;
#pragma unroll
                for (int qq = 3; qq >= 0; --qq) { const float P = __shfl(p, fr + 16 * qq), H = __shfl(h, fr + 16 * qq); sg = P * sg + H; if (qq > fq) hin = P * hin + H; }
                s = sg;
                float hh = hin;
#pragma unroll
                for (int t = 15; t >= 0; --t) { hh = a[t] * hh + uu[t];
                    const int tl = gi * 64 + 16 * fq + t; LAS bf16_t* gp = grt + tl * BW + 16 * w + fr;
                    *gp = (bf16_t)f2bf((bf1(hfb[tl * 16 + fr]) + hh) * gelu_tanh(bf1(*gp))); }
                X = Xn;
            }
        }
        LDS_WAIT(); __syncthreads();
        { bf16_t* gdst = LRU + (size_t)(cg * LRU_CH + (tid_ >> 4)) * LW + n * BW + (tid_ & 15) * 8; const LAS bf16_t* lsrc = grt + tid_ * 8;
#pragma unroll 1
          for (int k = 0; k < 8; ++k) { *(u32x4*)gdst = *(const LAS u32x4*)lsrc; gdst += (size_t)32 * LW; lsrc += NTHR * 8; } }
        LDS_WAIT(); __syncthreads();
    }
}

constexpr int HQW_EARLY = 96 * (D / 32);
__device__ __forceinline__ void hq_wtiles(Frame& F, int lo, int hi, int first, int stride) {
    const int lane = opaque(F.tid) & 63;
    LAS float* scr = (LAS float*)(F.lds + F.wave * 8448);
    for (int it = lo + first; it < hi; it += stride)
        had_tile_quant(F.in_WFD, D, DFF, 64 * (it / (D / 32)), 32 * (it % (D / 32)), wsp<signed char>(F, WS_WD), (const unsigned*)(F.ws + WS_AM), wsp<float>(F, WS_CS) + CS_D, scr, lane);
}
__device__ __forceinline__ void hq_phase(Frame& F) {
    const int lane = opaque(F.tid) & 63;
    const bf16_t* H0 = (const bf16_t*)F.out; const bf16_t* H1 = wsp<bf16_t>(F, WS_HIDS);
    signed char* Q0 = wsp<signed char>(F, WS_H8P); signed char* Q1 = wsp<signed char>(F, WS_H8S); float* RS3 = wsp<float>(F, WS_RS3);
    hq_wtiles(F, HQW_EARLY, (DFF / 64) * (D / 32), F.gw, F.ngw);
    constexpr int NB = DFF / 32;
    for (int m = F.gw; m < L; m += F.ngw) {
        const bf16_t* src = m < LP ? H0 + (size_t)m * DFF : H1 + (size_t)(m - LP) * DFF;
        signed char* dst = m < LP ? Q0 + (size_t)m * DFF : Q1 + (size_t)(m - LP) * DFF;
        u32x4 raw[6][4];
#pragma unroll
        for (int it = 0; it < 6; ++it) { const int b = lane + 64 * it; const u32x4* p = (const u32x4*)(src + (b < NB ? b : lane) * 32);
#pragma unroll
            for (int i = 0; i < 4; ++i) raw[it][i] = p[i]; }
        float mx = 0.f;
#pragma unroll
        for (int it = 0; it < 6; ++it) { float v[32];
#pragma unroll
            for (int i = 0; i < 4; ++i) { const u32x4 u = raw[it][i]; v[8 * i + 0] = bflo(u.x); v[8 * i + 1] = bfhi(u.x); v[8 * i + 2] = bflo(u.y); v[8 * i + 3] = bfhi(u.y); v[8 * i + 4] = bflo(u.z); v[8 * i + 5] = bfhi(u.z); v[8 * i + 6] = bflo(u.w); v[8 * i + 7] = bfhi(u.w); }
            fwht32(v);
            float bm = 0.f;
#pragma unroll
            for (int i = 0; i < 32; ++i) bm = fmaxf(bm, fabsf(v[i]));
            mx = fmaxf(mx, (lane + 64 * it < NB) ? bm : 0.f); }
        const float amax = fmaxf(wave_max(mx), 1e-20f), inv = 127.0f / amax;
        if (lane == 0) RS3[m] = amax * (1.0f / 127.0f);
#pragma unroll
        for (int it = 0; it < 6; ++it) { const int b = lane + 64 * it; float v[32];
#pragma unroll
            for (int i = 0; i < 4; ++i) { const u32x4 u = raw[it][i]; v[8 * i + 0] = bflo(u.x); v[8 * i + 1] = bfhi(u.x); v[8 * i + 2] = bflo(u.y); v[8 * i + 3] = bfhi(u.y); v[8 * i + 4] = bflo(u.z); v[8 * i + 5] = bfhi(u.z); v[8 * i + 6] = bflo(u.w); v[8 * i + 7] = bfhi(u.w); }
            fwht32(v);
            u32x4 o0, o1;
            o0.x = pk4_i8(rintf(v[0] * inv), rintf(v[1] * inv), rintf(v[2] * inv), rintf(v[3] * inv)); o0.y = pk4_i8(rintf(v[4] * inv), rintf(v[5] * inv), rintf(v[6] * inv), rintf(v[7] * inv));
            o0.z = pk4_i8(rintf(v[8] * inv), rintf(v[9] * inv), rintf(v[10] * inv), rintf(v[11] * inv)); o0.w = pk4_i8(rintf(v[12] * inv), rintf(v[13] * inv), rintf(v[14] * inv), rintf(v[15] * inv));
            o1.x = pk4_i8(rintf(v[16] * inv), rintf(v[17] * inv), rintf(v[18] * inv), rintf(v[19] * inv)); o1.y = pk4_i8(rintf(v[20] * inv), rintf(v[21] * inv), rintf(v[22] * inv), rintf(v[23] * inv));
            o1.z = pk4_i8(rintf(v[24] * inv), rintf(v[25] * inv), rintf(v[26] * inv), rintf(v[27] * inv)); o1.w = pk4_i8(rintf(v[28] * inv), rintf(v[29] * inv), rintf(v[30] * inv), rintf(v[31] * inv));
            if (b < NB) { *(u32x4*)(dst + b * 32) = o0; *(u32x4*)(dst + b * 32 + 16) = o1; } }
    }
}

__device__ __forceinline__ f32x4 up4(const u32x2 u) { return (f32x4){bflo(u.x), bfhi(u.x), bflo(u.y), bfhi(u.y)}; }
__device__ __forceinline__ void mid_phase(Frame& F) {
    const int tid_ = opaque(F.tid);
    bf16_t* MIX = wsp<bf16_t>(F, WS_MIX); signed char* XN8 = wsp<signed char>(F, WS_XN8); float* RS2 = wsp<float>(F, WS_RS2);
    LAS f32x4* gpost = (LAS f32x4*)F.lds; LAS f32x4* gpre = gpost + D / 4;
    for (int i = tid_; i < D / 4; i += NTHR) { gpost[i] = ((const f32x4*)F.in_GMPOST)[i]; gpre[i] = ((const f32x4*)F.in_GFPRE)[i]; }
    __syncthreads();
    for (int m = F.gw; m < L; m += F.ngw) {
        asm volatile("" ::: "memory");
        const f32x4* xr = (const f32x4*)xrow(F, m) + F.lane; const u32x2* mr = (const u32x2*)(MIX + (size_t)m * D) + F.lane;
        f32x4 v[16]; u32x2 mx[16]; float s = 0.f;
#pragma unroll
        for (int j = 0; j < 16; ++j) { v[j] = xr[64 * j]; mx[j] = mr[64 * j]; const f32x4 a = up4(mx[j]); s += (a.x * a.x + a.y * a.y) + (a.z * a.z + a.w * a.w); }
        const float rstd1 = 1.0f / sqrtf(wave_sum(s) * (1.0f / D) + EPS);
        float s2 = 0.f;
#pragma unroll
        for (int j = 0; j < 16; ++j) { v[j] = v[j] + up4(mx[j]) * rstd1 * gpost[F.lane + 64 * j]; s2 += (v[j].x * v[j].x + v[j].y * v[j].y) + (v[j].z * v[j].z + v[j].w * v[j].w); }
        const float rstd2 = 1.0f / sqrtf(wave_sum(s2) * (1.0f / D) + EPS);
        { u32x2* xw = (u32x2*)(MIX + (size_t)m * D) + F.lane;
#pragma unroll
          for (int j = 0; j < 16; ++j) xw[64 * j] = (u32x2){pk2(v[j].x, v[j].y), pk2(v[j].z, v[j].w)}; }
        float mx2 = 0.f;
#pragma unroll
        for (int j = 0; j < 16; ++j) { v[j] = v[j] * rstd2 * gpre[F.lane + 64 * j]; mx2 = fmaxf(fmaxf(mx2, fmaxf(fabsf(v[j].x), fabsf(v[j].y))), fmaxf(fabsf(v[j].z), fabsf(v[j].w))); }
        const float amax = fmaxf(wave_max(mx2), 1e-20f), inv = 127.0f / amax;
        if (F.lane == 0) RS2[m] = amax * (1.0f / 127.0f);
        unsigned* o4 = (unsigned*)(XN8 + (size_t)m * D) + F.lane;
#pragma unroll
        for (int j = 0; j < 16; ++j) o4[64 * j] = pk4_i8(rintf(v[j].x * inv), rintf(v[j].y * inv), rintf(v[j].z * inv), rintf(v[j].w * inv));
    }
    __syncthreads();
}
__device__ __forceinline__ void final_phase(Frame& F) {
    const int tid_ = opaque(F.tid);
    const bf16_t* X1 = wsp<bf16_t>(F, WS_MIX); const bf16_t* FB = wsp<bf16_t>(F, WS_F);
    LAS f32x4* gfp = (LAS f32x4*)F.lds;
    for (int i = tid_; i < D / 4; i += NTHR) gfp[i] = ((const f32x4*)F.in_GFPOST)[i];
    __syncthreads();
    for (int m = F.gw; m < L; m += F.ngw) {
        asm volatile("" ::: "memory");
        const u32x2* mr = (const u32x2*)(X1 + (size_t)m * D) + F.lane; const u32x2* fr = (const u32x2*)(FB + (size_t)m * D) + F.lane;
        u32x2 fx[16], x1[16]; float s = 0.f;
#pragma unroll
        for (int j = 0; j < 16; ++j) { fx[j] = fr[64 * j]; x1[j] = mr[64 * j]; const f32x4 a = up4(fx[j]); s += (a.x * a.x + a.y * a.y) + (a.z * a.z + a.w * a.w); }
        const float rstd3 = 1.0f / sqrtf(wave_sum(s) * (1.0f / D) + EPS);
        f32x4* o = (f32x4*)(F.out + (size_t)m * D) + F.lane;
#pragma unroll
        for (int j = 0; j < 16; ++j) o[64 * j] = up4(x1[j]) + up4(fx[j]) * rstd3 * gfp[F.lane + 64 * j];
    }
}

constexpr int LDS_STAGE = pg8::STAGE_BYTES;
constexpr int LDS_MISC = LDS_STAGE;
constexpr int LDS_BYTES = LDS_STAGE + 1024;
#ifndef MK_N_LAUNCHES
#define MK_N_LAUNCHES 1
#endif
constexpr int NPHASE = 12;
struct Args { const float* in[23]; float* out; unsigned char* ws; int ph_lo, ph_hi; };

__global__ void __launch_bounds__(NTHR, 2) fwd_kernel(Args args) {
    extern __shared__ __attribute__((aligned(16))) unsigned char lds_raw[];
    Frame F;
    F.lds = (LAS unsigned char*)lds_raw;
    F.tid = threadIdx.x; F.lane = (int)__builtin_amdgcn_mbcnt_hi(~0u, __builtin_amdgcn_mbcnt_lo(~0u, 0u)); F.wave = __builtin_amdgcn_readfirstlane(F.tid >> 6);
    F.G = gridDim.x; F.gw = blockIdx.x * NWAVES + F.wave; F.ngw = F.G * NWAVES;
    F.in_XP = args.in[0]; F.in_XS = args.in[1]; F.in_WIN = args.in[2]; F.in_WCONV = args.in[3]; F.in_BCONV = args.in[4]; F.in_WR = args.in[5]; F.in_BR = args.in[6]; F.in_WI = args.in[7]; F.in_BI = args.in[8]; F.in_LAM = args.in[9]; F.in_RPB = args.in[10]; F.in_WNO = args.in[11]; F.in_WLO = args.in[12]; F.in_WM = args.in[13]; F.in_BM = args.in[14]; F.in_WOUT = args.in[15]; F.in_GMPRE = args.in[16]; F.in_GMPOST = args.in[17]; F.in_GFPRE = args.in[18]; F.in_GFPOST = args.in[19]; F.in_WFG = args.in[20]; F.in_WFU = args.in[21]; F.in_WFD = args.in[22];
    F.out = args.out; F.ws = args.ws;
    volatile LAS unsigned* MISC = (volatile LAS unsigned*)(F.lds + LDS_MISC);
    if (F.tid < 256) MISC[F.tid] = 0u;
    __syncthreads();
    const int lo = args.ph_lo, hi = args.ph_hi;
    const bool fused = (hi - lo) > 1;
    XcdBarrier bar; bar.bar = (unsigned*)(F.ws + WS_CTL); bar.x = 0; bar.st = nullptr;
    if (fused) bar = xcd_barrier_post((unsigned*)(F.ws + WS_CTL), MISC + 8);
#ifndef PH_MASK
#define PH_MASK 0xfff
#endif
#define IN(k) (((PH_MASK >> (k)) & 1) && lo <= (k) && (k) < hi)
#define SEAM(k) do { if (IN(k) && IN((k) + 1)) xcd_barrier(bar); } while (0)
    LAS unsigned char* stage = F.lds;

#ifdef ATTN_OUT_OFF
#define NA_BUF ((size_t)ATTN_OUT_OFF * MiB)
#else
#define NA_BUF WS_Q
#endif
#ifndef DUP_MASK
#define DUP_MASK 0
#endif
#define RUN(k, ...) if (IN(k)) { __VA_ARGS__ if (((DUP_MASK) >> (k)) & 1) { __VA_ARGS__ } }
    RUN(0, { p0_prologue(F); }) SEAM(0);
    RUN(1, {
        { pg8::Gemm g{wsp<bf16_t>(F, WS_XN8), wsp<bf16_t>(F, WS_XN8), 1 << 30, wsp<bf16_t>(F, WS_W8), L, 2 * NAW + 2 * D, D}; pg8::StaticOrder S; S.init(L, 2 * NAW + 2 * D, F.G, (int)blockIdx.x);
          pg8::EpiProjQ E{wsp<bf16_t>(F, WS_Q), wsp<bf16_t>(F, WS_K), (bf16_t*)F.out, F.in_BM, wsp<float>(F, WS_RS1), wsp<float>(F, WS_CS) + CS_QKM};
          pg8::gemm_phase<pg8::EpiProjQ, pg8::StaticOrder, true, true, 2>(stage, g, S, E); }
        { pg8::Gemm g{wsp<bf16_t>(F, WS_XN), wsp<bf16_t>(F, WS_XN), 1 << 30, wsp<bf16_t>(F, WS_WCAT), L, 2 * NAW, 2 * D}; pg8::StaticOrder S; S.init(L, 2 * NAW, F.G, (int)blockIdx.x);
          pg8::EpiProj E{wsp<bf16_t>(F, WS_XR), wsp<bf16_t>(F, WS_GR), wsp<bf16_t>(F, WS_GR), wsp<bf16_t>(F, WS_GR), (bf16_t*)F.out, F.in_BM, 1 << 30};
          pg8::gemm_phase<pg8::EpiProj, pg8::StaticOrder, true, true, 0>(stage, g, S, E); }
        { pg8::Gemm g{wsp<bf16_t>(F, WS_WVT), wsp<bf16_t>(F, WS_WVT), 1 << 30, wsp<bf16_t>(F, WS_XN8), NAW, L, D}; pg8::StaticOrder S; S.init(NAW, L, F.G, (int)blockIdx.x);
          pg8::EpiVTQ E{wsp<bf16_t>(F, WS_VT), wsp<float>(F, WS_CS) + CS_V, wsp<float>(F, WS_RS1)};
          pg8::gemm_phase<pg8::EpiVTQ, pg8::StaticOrder, true, true, 2>(stage, g, S, E); }
    }) SEAM(1);
    RUN(2, { lru_pass_a(F); }) SEAM(2);
    #ifdef ATTN_OUT_OFF
    if (IN(3)) { lru_pass_b(F); } SEAM(3);
    if (IN(4)) { lru_pass_c<0>(F); xcd_barrier(bar); if (ATTN_DUP) attn_mfma<ATTN_DUP - 1>(F); attn_mfma<0>(F); } SEAM(4);
#else
    if (IN(3)) { lru_pass_b(F); attn_mfma_lds(F); } SEAM(3);
#ifdef LRUC_DBG
    if (IN(4)) { lru_pass_c<LRUC_DBG>(F); lru_pass_c<0>(F); } SEAM(4);
#else
    RUN(4, { lru_pass_c<0>(F); }) SEAM(4);
#endif
#endif
    if (IN(5)) {
        { pg8::Gemm g{wsp<bf16_t>(F, NA_BUF), wsp<bf16_t>(F, NA_BUF), 1 << 30, wsp<bf16_t>(F, WS_WNO), L, D, 2 * NAW}; pg8::StaticOrder S; S.init(L, D, F.G, (int)blockIdx.x);
          pg8::EpiMulG<false> E{wsp<bf16_t>(F, WS_T1), (const bf16_t*)F.out, 0};
          pg8::gemm_phase<pg8::EpiMulG<false>, pg8::StaticOrder, true, true>(stage, g, S, E); }
        { pg8::Gemm g{wsp<bf16_t>(F, WS_XR), wsp<bf16_t>(F, WS_XR), 1 << 30, wsp<bf16_t>(F, WS_WLO), L, D, 2 * LW}; pg8::StaticOrder S; S.init(L, D, F.G, (int)blockIdx.x);
          pg8::EpiMulG<true> E{wsp<bf16_t>(F, WS_T1), (const bf16_t*)F.out, D};
          pg8::gemm_phase<pg8::EpiMulG<true>, pg8::StaticOrder, true, true>(stage, g, S, E); }
    } SEAM(5);
    RUN(6, {
        pg8::Gemm g{wsp<bf16_t>(F, WS_T1), wsp<bf16_t>(F, WS_T1), 1 << 30, wsp<bf16_t>(F, WS_WO), L, D, 2 * D}; pg8::StaticOrder S; S.init(L, D, F.G, (int)blockIdx.x);
        pg8::EpiPlain E{wsp<bf16_t>(F, WS_MIX), D};
        pg8::gemm_phase<pg8::EpiPlain, pg8::StaticOrder, true, true>(stage, g, S, E);
    }) SEAM(6);
    RUN(7, { mid_phase(F); }) SEAM(7);
    RUN(8, {
        pg8::Gemm g{wsp<bf16_t>(F, WS_XN8), wsp<bf16_t>(F, WS_XN8), 1 << 30, wsp<bf16_t>(F, WS_WGU), L, 2 * DFF, D}; pg8::StaticOrder S; S.init(L, 2 * DFF, F.G, (int)blockIdx.x);
        pg8::EpiSwigluQ E{(bf16_t*)F.out, wsp<bf16_t>(F, WS_HIDS), LP / 256, wsp<float>(F, WS_RS2), wsp<float>(F, WS_CS) + CS_GU};
        pg8::gemm_phase<pg8::EpiSwigluQ, pg8::StaticOrder, false, true, 2>(stage, g, S, E);
        { const int rem = S.nwg % F.G;
          if ((int)blockIdx.x >= rem) hq_wtiles(F, 0, HQW_EARLY, ((int)blockIdx.x - rem) * NWAVES + F.wave, (F.G - rem) * NWAVES); }
    }) SEAM(8);
    RUN(9, { hq_phase(F); }) SEAM(9);
    RUN(10, {
        pg8::Gemm g{wsp<bf16_t>(F, WS_H8P), wsp<bf16_t>(F, WS_H8S), LP / 256, wsp<bf16_t>(F, WS_WD), L, D, DFF}; pg8::StaticOrder S; S.init(L, D, F.G, (int)blockIdx.x);
        pg8::EpiPlainQ E{wsp<bf16_t>(F, WS_F), D, wsp<float>(F, WS_RS3), wsp<float>(F, WS_CS) + CS_D};
        pg8::gemm_phase<pg8::EpiPlainQ, pg8::StaticOrder, true, true, 2>(stage, g, S, E);
    }) SEAM(10);
    RUN(11, { final_phase(F); })
#undef RUN
#undef IN
#undef SEAM
}

extern "C" void kernel_launch(void* const* d_in, const int* in_sizes, int n_in, void* d_out, int out_size, void* d_ws, size_t ws_size, hipStream_t stream) {
    static int grid = 0;
    if (grid == 0) {
        if (n_in != 23 || in_sizes[0] != LP * D || in_sizes[1] != LS * D || out_size != L * D || ws_size < WS_END) {
            fprintf(stderr, "kernel_launch: unexpected shapes: n_in %d in0 %d out %d ws %zu (need %zu)\n", n_in, n_in > 0 ? in_sizes[0] : -1, out_size, ws_size, (size_t)WS_END); grid = -1; return; }
        int dev = 0, cus = 0, per_cu = 0;
        if (hipGetDevice(&dev) != hipSuccess || hipDeviceGetAttribute(&cus, hipDeviceAttributeMultiprocessorCount, dev) != hipSuccess) { grid = -1; return; }
        if (hipFuncSetAttribute((const void*)fwd_kernel, hipFuncAttributeMaxDynamicSharedMemorySize, LDS_BYTES) != hipSuccess) { fprintf(stderr, "kernel_launch: hipFuncSetAttribute failed\n"); grid = -1; return; }
        if (hipOccupancyMaxActiveBlocksPerMultiprocessor(&per_cu, (const void*)fwd_kernel, NTHR, LDS_BYTES) != hipSuccess || per_cu < 1) { fprintf(stderr, "kernel_launch: occupancy query says %d\n", per_cu); }
        (void)hipGetLastError();
        grid = cus;
    }
    if (grid < 0) return;
    (void)hipMemsetAsync((char*)d_ws + WS_CTL, 0, CTL_ZERO_BYTES, stream);
#ifdef DBG_ZERO_ALL
    (void)hipMemsetAsync((char*)d_ws, 0, WS_END, stream); (void)hipMemsetAsync((char*)d_out, 0, (size_t)L * D * 4, stream);
#endif
    Args a{};
    for (int i = 0; i < 23; ++i) a.in[i] = (const float*)d_in[i];
    a.out = (float*)d_out; a.ws = (unsigned char*)d_ws;
#if MK_N_LAUNCHES == 1
    a.ph_lo = 0; a.ph_hi = NPHASE;
    hipLaunchKernelGGL(fwd_kernel, dim3(grid), dim3(NTHR), LDS_BYTES, stream, a);
#else
    for (int p = 0; p < NPHASE; ++p) {
#ifdef DBG_PH_MASK
        if (!((DBG_PH_MASK >> p) & 1)) continue;
#endif
        a.ph_lo = p; a.ph_hi = p + 1; hipLaunchKernelGGL(fwd_kernel, dim3(grid), dim3(NTHR), LDS_BYTES, stream, a); }
#endif
}
```

```cpp
#include <hip/hip_runtime.h>
#include <cstdio>
#include <cstdint>

#define LAS __attribute__((address_space(3)))
typedef unsigned short bf16_t;
typedef short bf16x8 __attribute__((ext_vector_type(8)));
typedef float f32x4 __attribute__((ext_vector_type(4)));
typedef float f32x2 __attribute__((ext_vector_type(2)));
typedef unsigned u32x4 __attribute__((ext_vector_type(4)));
typedef unsigned u32x2 __attribute__((ext_vector_type(2)));

constexpr int D = 4096, LP = 16384, LS = 8192, L = LP + LS;
constexpr int GRIDW = 64, HD = 128, NH = 16, NAW = 2048, LW = 2048, NBLK = 16, BW = 128, DFF = 11008, INW = 10240;
constexpr float EPS = 1e-6f;
constexpr int NWAVES = 8, NTHR = 512;

constexpr size_t MiB = 1u << 20;
constexpr size_t WS_CTL = 0, CTL_ZERO_BYTES = 64 * 1024;
constexpr size_t WS_AM = 32 * 1024;
constexpr size_t WS_RSTD = 1 * MiB;
constexpr size_t WS_RS1 = 1 * MiB + 128 * 1024;
constexpr size_t WS_RS2 = 1 * MiB + 256 * 1024;
constexpr size_t WS_CS = 1 * MiB + 384 * 1024;
constexpr size_t WS_SUM = 2 * MiB;
constexpr size_t WS_WCAT = 8 * MiB;
constexpr size_t WS_W8 = 40 * MiB;
constexpr size_t WS_WVT = 88 * MiB;
constexpr size_t WS_XN8 = 96 * MiB;
constexpr size_t WS_WNO = 192 * MiB;
constexpr size_t WS_WLO = 208 * MiB;
constexpr size_t WS_WO = 224 * MiB;
constexpr size_t WS_WGU = 256 * MiB;
constexpr size_t WS_WD = 342 * MiB;
constexpr size_t WS_WG = 428 * MiB;
constexpr size_t WS_XN = 430 * MiB;
constexpr size_t WS_Q = 622 * MiB;
constexpr size_t WS_XR = 718 * MiB;
constexpr size_t WS_K = 814 * MiB;
constexpr size_t WS_VT = 910 * MiB;
constexpr size_t WS_GR = 1006 * MiB;
constexpr size_t WS_XC = 1102 * MiB;
constexpr size_t WS_END = 1198 * MiB;
constexpr int CS_QKM = 0, CS_V = 12288, CS_GU = 12288 + 2048, CS_D = 12288 + 2048 + 22016;
constexpr size_t WS_RS3 = 1 * MiB + 640 * 1024;
constexpr size_t WS_H8P = WS_XN, WS_H8S = WS_XN8;
constexpr size_t WS_T1 = WS_K;
constexpr size_t WS_MIX = WS_GR;
constexpr size_t WS_HIDS = WS_Q;
constexpr size_t WS_F = WS_K;
constexpr size_t WS_HF = WS_K;

#define LDS_WAIT() asm volatile("s_waitcnt lgkmcnt(0)" ::: "memory")
#define VM_WAIT() asm volatile("s_waitcnt vmcnt(0)" ::: "memory")
typedef __bf16 bf16x2n_t __attribute__((ext_vector_type(2)));
__device__ __forceinline__ unsigned pk2(float lo, float hi) { const bf16x2n_t r = __builtin_convertvector((f32x2){lo, hi}, bf16x2n_t); return __builtin_bit_cast(unsigned, r); }
__device__ __forceinline__ unsigned f2bf(float f) { return pk2(f, 0.f) & 0xffffu; }
__device__ __forceinline__ float bflo(unsigned u) { return __builtin_bit_cast(float, u << 16); }
__device__ __forceinline__ float bfhi(unsigned u) { return __builtin_bit_cast(float, u & 0xffff0000u); }
__device__ __forceinline__ float bf1(bf16_t u) { return __builtin_bit_cast(float, (unsigned)u << 16); }
__device__ __forceinline__ float wave_sum(float v) {
#pragma unroll
    for (int o = 1; o < 64; o <<= 1) v += __shfl_xor(v, o);
    return v;
}
__device__ __forceinline__ float wave_max(float v) {
#pragma unroll
    for (int o = 1; o < 64; o <<= 1) v = fmaxf(v, __shfl_xor(v, o));
    return v;
}
__device__ __forceinline__ float sigmoidf_(float v) { return __builtin_amdgcn_rcpf(1.0f + __expf(-v)); }
__device__ __forceinline__ float gelu_tanh(float v) { const float y = 0.7978845608f * (v + 0.044715f * v * v * v); const float e = __expf(2.0f * y); return 0.5f * v * (2.0f - 2.0f * __builtin_amdgcn_rcpf(e + 1.0f)); }

namespace pg8 {
constexpr int BM = 256, BK = 64, HALF = 128, HTB = HALF * BK * 2  , STAGE_BYTES = 8 * HTB, NXCD = 8, WGM = 4;

__host__ __device__ __forceinline__ int lds_byte(int r, int c) { return (r >> 3) * 1024 + (r & 7) * 128 + ((((c >> 3) ^ r) & 7) << 4) + (c & 7) * 2; }
__host__ __device__ __forceinline__ void stage_rc(int b, int& R, int& C) { const int ch = b >> 10, rr = (b >> 7) & 7, slot = (b >> 4) & 7; R = ch * 8 + rr; C = ((slot ^ rr) & 7) * 8; }
__host__ __device__ __forceinline__ int perm32(int rho) { const int n = rho >> 4, i = rho & 15; return 8 * (i >> 2) + 4 * n + (i & 3); }

struct Unit { int pm, pn; };
struct Gemm {
    const bf16_t* A; const bf16_t* A2; int pm_split; const bf16_t* Bt; int M, N, rb;
    __device__ __forceinline__ const char* abase(int pm) const { const size_t t = (size_t)BM * rb; return pm < pm_split ? (const char*)A + (size_t)pm * t : (const char*)A2 + (size_t)(pm - pm_split) * t; }
    __device__ __forceinline__ const char* bbase(int pn) const { return (const char*)Bt + (size_t)pn * BM * rb; }
};

struct StaticOrder {
    int nM, nN, nwg, G, c;
    __host__ __device__ void init(int M, int N, int G_, int c_) { nM = M / BM; nN = N / BM; nwg = nM * nN; G = G_; c = c_; }
    __host__ __device__ bool next(int i, Unit& u) const {
        const long Lx = (long)i * G + c; if (Lx >= nwg) return false;
        int wgid = (int)Lx; { const int q = nwg / NXCD, r = nwg % NXCD, xcd = wgid % NXCD, off = wgid / NXCD; wgid = (xcd < r ? xcd * (q + 1) : r * (q + 1) + (xcd - r) * q) + off; }
        const int nig = WGM * nN, gid = wgid / nig, fm = gid * WGM, gsz = (nM - fm) < WGM ? (nM - fm) : WGM;
        u.pm = fm + ((wgid % nig) % gsz); u.pn = (wgid % nig) / gsz; return true;
    }
    __device__ __forceinline__ void a_ready(const Unit&) const {}
    __device__ __forceinline__ void done(const Unit&) const {}
};

typedef int v8i32 __attribute__((ext_vector_type(8)));
typedef int v4i32 __attribute__((ext_vector_type(4)));
typedef __bf16 bf16x2_t __attribute__((ext_vector_type(2)));
__device__ __forceinline__ unsigned cvt_pk_bf16(float lo, float hi) { const bf16x2_t r = __builtin_convertvector((f32x2){lo, hi}, bf16x2_t); return __builtin_bit_cast(unsigned, r); }
__device__ __forceinline__ u32x4 pack8(const f32x4 v0, const f32x4 v1) { u32x4 w; w.x = cvt_pk_bf16(v0[0], v0[1]); w.y = cvt_pk_bf16(v0[2], v0[3]); w.z = cvt_pk_bf16(v1[0], v1[1]); w.w = cvt_pk_bf16(v1[2], v1[3]); return w; }
__device__ __forceinline__ void unpack8(const u32x4 w, f32x4& v0, f32x4& v1) { v0 = (f32x4){bflo(w.x), bfhi(w.x), bflo(w.y), bfhi(w.y)}; v1 = (f32x4){bflo(w.z), bfhi(w.z), bflo(w.w), bfhi(w.w)}; }
__device__ __forceinline__ f32x4 sig4(const f32x4 v) { f32x4 r; r[0] = sigmoidf_(v[0]); r[1] = sigmoidf_(v[1]); r[2] = sigmoidf_(v[2]); r[3] = sigmoidf_(v[3]); return r; }

struct EpiPlain {
    static constexpr bool PERM = true, AFTER_DRAIN = false;
    bf16_t* O; int ldc;
    __device__ __forceinline__ void operator()(const f32x4 (&acc)[2][2][4][2], const Unit& u, int wr, int wc, int fr, int fq) const {
        const int row0 = u.pm * BM + wr * 64 + fr, col0 = u.pn * BM + wc * 32 + 8 * fq;
#pragma unroll
        for (int ai = 0; ai < 2; ++ai)
#pragma unroll
            for (int m = 0; m < 4; ++m) { bf16_t* rowp = O + (size_t)(row0 + ai * HALF + m * 16) * ldc + col0;
#pragma unroll
                for (int bj = 0; bj < 2; ++bj) *(u32x4*)(rowp + bj * HALF) = pack8(acc[ai][bj][m][0], acc[ai][bj][m][1]); }
    }
};
struct EpiVT {
    static constexpr bool PERM = true, AFTER_DRAIN = false;
    bf16_t* O;
    __device__ __forceinline__ void operator()(const f32x4 (&acc)[2][2][4][2], const Unit& u, int wr, int wc, int fr, int fq) const {
        const int row0 = u.pm * BM + wr * 64 + fr, col0 = u.pn * BM + wc * 32 + 8 * fq;
#pragma unroll
        for (int ai = 0; ai < 2; ++ai)
#pragma unroll
            for (int m = 0; m < 4; ++m) { const int row = row0 + ai * HALF + m * 16, hh = row >> 7, d = row & 127;
                const int dt = 2 * (d >> 5) + ((d >> 2) & 1), i = 4 * ((d >> 3) & 3) + (d & 3);
#pragma unroll
                for (int bj = 0; bj < 2; ++bj) { const int tok = col0 + bj * HALF, R = tok >> 6, o = (tok & 63) >> 3;
                    *(u32x4*)(O + ((size_t)((((R * 16 + hh) * 8 + dt) * 8 + o) * 16 + i)) * 8) = pack8(acc[ai][bj][m][0], acc[ai][bj][m][1]); } }
    }
};
struct EpiProj {
    static constexpr bool PERM = true, AFTER_DRAIN = false;
    bf16_t* P0; bf16_t* P1; bf16_t* P2; bf16_t* P3; bf16_t* G; const float* bias; int pn_gate0;
    __device__ __forceinline__ void operator()(const f32x4 (&acc)[2][2][4][2], const Unit& u, int wr, int wc, int fr, int fq) const {
        const int row0 = u.pm * BM + wr * 64 + fr;
        if (u.pn < pn_gate0) {
            const int t = u.pn >> 3; bf16_t* base = t == 0 ? P0 : (t == 1 ? P1 : (t == 2 ? P2 : P3));
            const int col0 = (u.pn & 7) * BM + wc * 32 + 8 * fq;
            if (t == 2) {
#pragma unroll
                for (int ai = 0; ai < 2; ++ai)
#pragma unroll
                    for (int m = 0; m < 4; ++m) { const int tok = row0 + ai * HALF + m * 16, R = tok >> 6, cl = tok & 63;
                        const int tokpart = (((cl >> 2) & 1) * 8 + (cl >> 3)) * 4 + (cl & 3);
#pragma unroll
                        for (int bj = 0; bj < 2; ++bj) { const int c = col0 + bj * HALF, hh = c >> 7, d0 = c & 127;
                            *(u32x4*)(base + ((size_t)(((R * 16 + hh) * 4 + (d0 >> 5)) * 64 + tokpart) * 4 + ((d0 >> 3) & 3)) * 8) = pack8(acc[ai][bj][m][0], acc[ai][bj][m][1]); } }
            } else {
#pragma unroll
            for (int ai = 0; ai < 2; ++ai)
#pragma unroll
                for (int m = 0; m < 4; ++m) { bf16_t* rowp = base + (size_t)(row0 + ai * HALF + m * 16) * NAW + col0;
#pragma unroll
                    for (int bj = 0; bj < 2; ++bj) *(u32x4*)(rowp + bj * HALF) = pack8(acc[ai][bj][m][0], acc[ai][bj][m][1]); }
            }
        } else {
            const int col0 = (u.pn - pn_gate0) * BM + wc * 32 + 8 * fq;
            f32x4 bv[2][2];
#pragma unroll
            for (int bj = 0; bj < 2; ++bj)
#pragma unroll
                for (int n = 0; n < 2; ++n) bv[bj][n] = *(const f32x4*)(bias + col0 + bj * HALF + 4 * n);
#pragma unroll
            for (int ai = 0; ai < 2; ++ai)
#pragma unroll
                for (int m = 0; m < 4; ++m) { bf16_t* rowp = G + (size_t)(row0 + ai * HALF + m * 16) * (2 * D) + col0;
#pragma unroll
                    for (int bj = 0; bj < 2; ++bj) *(u32x4*)(rowp + bj * HALF) = pack8(sig4(acc[ai][bj][m][0] + bv[bj][0]), sig4(acc[ai][bj][m][1] + bv[bj][1])); }
        }
    }
};
template <bool ADD> struct EpiMulG {
    static constexpr bool PERM = true, AFTER_DRAIN = false;
    bf16_t* O; const bf16_t* G; int goff;
    __device__ __forceinline__ void operator()(const f32x4 (&acc)[2][2][4][2], const Unit& u, int wr, int wc, int fr, int fq) const {
        const int row0 = u.pm * BM + wr * 64 + fr, col0 = u.pn * BM + wc * 32 + 8 * fq;
#pragma unroll
        for (int ai = 0; ai < 2; ++ai)
#pragma unroll
            for (int m = 0; m < 4; ++m) { const size_t row = (size_t)(row0 + ai * HALF + m * 16); bf16_t* rowp = O + row * D + col0; const bf16_t* gp = G + row * (2 * D) + goff + col0;
#pragma unroll
                for (int bj = 0; bj < 2; ++bj) {
                    f32x4 g0, g1; unpack8(*(const u32x4*)(gp + bj * HALF), g0, g1);
                    f32x4 v0 = acc[ai][bj][m][0] * g0, v1 = acc[ai][bj][m][1] * g1;
                    if (ADD) { f32x4 t0, t1; unpack8(*(const u32x4*)(rowp + bj * HALF), t0, t1); v0 += t0; v1 += t1; }
                    *(u32x4*)(rowp + bj * HALF) = pack8(v0, v1); } }
    }
};
struct EpiSwiglu {
    static constexpr bool PERM = true, AFTER_DRAIN = false;
    bf16_t* H0; bf16_t* H1; int pm_split;
    __device__ __forceinline__ void operator()(const f32x4 (&acc)[2][2][4][2], const Unit& u, int wr, int wc, int fr, int fq) const {
        bf16_t* base = u.pm < pm_split ? H0 + (size_t)u.pm * BM * DFF : H1 + (size_t)(u.pm - pm_split) * BM * DFF;
        const int row0 = wr * 64 + fr, col0 = u.pn * HALF + wc * 32 + 8 * fq;
#pragma unroll
        for (int ai = 0; ai < 2; ++ai)
#pragma unroll
            for (int m = 0; m < 4; ++m) {
                f32x4 h[2];
#pragma unroll
                for (int n = 0; n < 2; ++n) { const f32x4 g = acc[ai][0][m][n], up = acc[ai][1][m][n];
#pragma unroll
                    for (int j = 0; j < 4; ++j) h[n][j] = g[j] * sigmoidf_(g[j]) * up[j]; }
                *(u32x4*)(base + (size_t)(row0 + ai * HALF + m * 16) * DFF + col0) = pack8(h[0], h[1]); }
    }
};

__device__ __forceinline__ f32x4 deq4(const f32x4 accbits, const float sa, const f32x4 sb) { const v4i32 q = __builtin_bit_cast(v4i32, accbits); return (f32x4){(float)q.x, (float)q.y, (float)q.z, (float)q.w} * sa * sb; }
struct EpiProjQ {
    static constexpr bool PERM = true, AFTER_DRAIN = false;
    bf16_t* Qb; bf16_t* Kb; bf16_t* G; const float* bias; const float* sa; const float* sb;
    __device__ __forceinline__ void operator()(const f32x4 (&acc)[2][2][4][2], const Unit& u, int wr, int wc, int fr, int fq) const {
        const int row0 = u.pm * BM + wr * 64 + fr, cg0 = u.pn * BM + wc * 32 + 8 * fq;
        f32x4 sbv[2][2];
#pragma unroll
        for (int bj = 0; bj < 2; ++bj)
#pragma unroll
            for (int n = 0; n < 2; ++n) sbv[bj][n] = *(const f32x4*)(sb + cg0 + bj * HALF + 4 * n);
        if (u.pn < 8) {
            const int col0 = u.pn * BM + wc * 32 + 8 * fq;
#pragma unroll
            for (int ai = 0; ai < 2; ++ai)
#pragma unroll
                for (int m = 0; m < 4; ++m) { const int row = row0 + ai * HALF + m * 16; const float sr = sa[row]; bf16_t* rowp = Qb + (size_t)row * NAW + col0;
#pragma unroll
                    for (int bj = 0; bj < 2; ++bj) *(u32x4*)(rowp + bj * HALF) = pack8(deq4(acc[ai][bj][m][0], sr, sbv[bj][0]), deq4(acc[ai][bj][m][1], sr, sbv[bj][1])); }
        } else if (u.pn < 16) {
            const int col0 = (u.pn - 8) * BM + wc * 32 + 8 * fq;
#pragma unroll
            for (int ai = 0; ai < 2; ++ai)
#pragma unroll
                for (int m = 0; m < 4; ++m) { const int tok = row0 + ai * HALF + m * 16, R = tok >> 6, cl = tok & 63; const float sr = sa[tok];
                    const int tokpart = (((cl >> 2) & 1) * 8 + (cl >> 3)) * 4 + (cl & 3);
#pragma unroll
                    for (int bj = 0; bj < 2; ++bj) { const int c = col0 + bj * HALF, hh = c >> 7, d0 = c & 127;
                        *(u32x4*)(Kb + ((size_t)(((R * 16 + hh) * 4 + (d0 >> 5)) * 64 + tokpart) * 4 + ((d0 >> 3) & 3)) * 8) = pack8(deq4(acc[ai][bj][m][0], sr, sbv[bj][0]), deq4(acc[ai][bj][m][1], sr, sbv[bj][1])); } }
        } else {
            const int col0 = (u.pn - 16) * BM + wc * 32 + 8 * fq;
            f32x4 bv[2][2];
#pragma unroll
            for (int bj = 0; bj < 2; ++bj)
#pragma unroll
                for (int n = 0; n < 2; ++n) bv[bj][n] = *(const f32x4*)(bias + col0 + bj * HALF + 4 * n);
#pragma unroll
            for (int ai = 0; ai < 2; ++ai)
#pragma unroll
                for (int m = 0; m < 4; ++m) { const int row = row0 + ai * HALF + m * 16; const float sr = sa[row]; bf16_t* rowp = G + (size_t)row * (2 * D) + col0;
#pragma unroll
                    for (int bj = 0; bj < 2; ++bj) *(u32x4*)(rowp + bj * HALF) = pack8(sig4(deq4(acc[ai][bj][m][0], sr, sbv[bj][0]) + bv[bj][0]), sig4(deq4(acc[ai][bj][m][1], sr, sbv[bj][1]) + bv[bj][1])); }
        }
    }
};
struct EpiPlainQ {
    static constexpr bool PERM = true, AFTER_DRAIN = false;
    bf16_t* O; int ldc; const float* sa; const float* sb;
    __device__ __forceinline__ void operator()(const f32x4 (&acc)[2][2][4][2], const Unit& u, int wr, int wc, int fr, int fq) const {
        const int row0 = u.pm * BM + wr * 64 + fr, col0 = u.pn * BM + wc * 32 + 8 * fq;
        f32x4 sbv[2][2];
#pragma unroll
        for (int bj = 0; bj < 2; ++bj)
#pragma unroll
            for (int n = 0; n < 2; ++n) sbv[bj][n] = *(const f32x4*)(sb + col0 + bj * HALF + 4 * n);
#pragma unroll
        for (int ai = 0; ai < 2; ++ai)
#pragma unroll
            for (int m = 0; m < 4; ++m) { const int row = row0 + ai * HALF + m * 16; const float sr = sa[row]; bf16_t* rowp = O + (size_t)row * ldc + col0;
#pragma unroll
                for (int bj = 0; bj < 2; ++bj) *(u32x4*)(rowp + bj * HALF) = pack8(deq4(acc[ai][bj][m][0], sr, sbv[bj][0]), deq4(acc[ai][bj][m][1], sr, sbv[bj][1])); }
    }
};
struct EpiVTQ {
    static constexpr bool PERM = true, AFTER_DRAIN = false;
    bf16_t* O; const float* sa; const float* sb;
    __device__ __forceinline__ void operator()(const f32x4 (&acc)[2][2][4][2], const Unit& u, int wr, int wc, int fr, int fq) const {
        const int row0 = u.pm * BM + wr * 64 + fr, col0 = u.pn * BM + wc * 32 + 8 * fq;
        f32x4 sbv[2][2];
#pragma unroll
        for (int bj = 0; bj < 2; ++bj)
#pragma unroll
            for (int n = 0; n < 2; ++n) sbv[bj][n] = *(const f32x4*)(sb + col0 + bj * HALF + 4 * n);
#pragma unroll
        for (int ai = 0; ai < 2; ++ai)
#pragma unroll
            for (int m = 0; m < 4; ++m) { const int row = row0 + ai * HALF + m * 16, hh = row >> 7, d = row & 127; const float sr = sa[row];
                const int dt = 2 * (d >> 5) + ((d >> 2) & 1), i = 4 * ((d >> 3) & 3) + (d & 3);
#pragma unroll
                for (int bj = 0; bj < 2; ++bj) { const int tok = col0 + bj * HALF, R = tok >> 6, o = (tok & 63) >> 3;
                    *(u32x4*)(O + ((size_t)((((R * 16 + hh) * 8 + dt) * 8 + o) * 16 + i)) * 8) = pack8(deq4(acc[ai][bj][m][0], sr, sbv[bj][0]), deq4(acc[ai][bj][m][1], sr, sbv[bj][1])); } }
    }
};
struct EpiSwigluQ {
    static constexpr bool PERM = true, AFTER_DRAIN = false;
    bf16_t* H0; bf16_t* H1; int pm_split; const float* sa; const float* sb;
    __device__ __forceinline__ void operator()(const f32x4 (&acc)[2][2][4][2], const Unit& u, int wr, int wc, int fr, int fq) const {
        bf16_t* base = u.pm < pm_split ? H0 + (size_t)u.pm * BM * DFF : H1 + (size_t)(u.pm - pm_split) * BM * DFF;
        const int row0 = wr * 64 + fr, col0 = u.pn * HALF + wc * 32 + 8 * fq, cg0 = u.pn * BM + wc * 32 + 8 * fq;
        f32x4 sbv[2][2];
#pragma unroll
        for (int bj = 0; bj < 2; ++bj)
#pragma unroll
            for (int n = 0; n < 2; ++n) sbv[bj][n] = *(const f32x4*)(sb + cg0 + bj * HALF + 4 * n);
#pragma unroll
        for (int ai = 0; ai < 2; ++ai)
#pragma unroll
            for (int m = 0; m < 4; ++m) { const float sr = sa[u.pm * BM + row0 + ai * HALF + m * 16];
                f32x4 h[2];
#pragma unroll
                for (int n = 0; n < 2; ++n) { const f32x4 g = deq4(acc[ai][0][m][n], sr, sbv[0][n]), up = deq4(acc[ai][1][m][n], sr, sbv[1][n]);
#pragma unroll
                    for (int j = 0; j < 4; ++j) h[n][j] = g[j] * sigmoidf_(g[j]) * up[j]; }
                *(u32x4*)(base + (size_t)(row0 + ai * HALF + m * 16) * DFF + col0) = pack8(h[0], h[1]); }
    }
};

__device__ __forceinline__ v8i32 cat8(const bf16x8 lo, const bf16x8 hi) { return __builtin_shufflevector(__builtin_bit_cast(v4i32, lo), __builtin_bit_cast(v4i32, hi), 0, 1, 2, 3, 4, 5, 6, 7); }
__device__ __forceinline__ void mfma_fp8_acc(f32x4& c, const v8i32 a, const v8i32 b, int sa, int sb) {
    asm volatile("v_mfma_scale_f32_16x16x128_f8f6f4 %0, %1, %2, %0, %3, %4 op_sel_hi:[0,0,0]" : "+v"(c) : "v"(a), "v"(b), "v"(sa), "v"(sb)); }
constexpr int FP8_SCALE = 0x73737373;
template <class Epi, class Sched, bool ALIGN_EPI = false, bool SP2 = false, int QM = 0  , int DBG = 0>
__device__ __forceinline__ void gemm_phase(LAS unsigned char* lds, const Gemm g, const Sched& S, const Epi& E) {
    int tid = threadIdx.x; asm volatile("" : "+v"(tid));
    const int wid = __builtin_amdgcn_readfirstlane(tid >> 6), lane = tid & 63, wr = wid >> 2, wc = wid & 3, fr = lane & 15, fq = lane >> 4;
    const int RB = g.rb, nt = RB / (BK * 2);
    unsigned voffA[2], voffB[2];
#pragma unroll
    for (int i = 0; i < 2; ++i) { int R, C; stage_rc(tid * 16 + i * 8192, R, C); const int Rb = Epi::PERM ? ((R & ~31) + perm32(R & 31)) : R;
        voffA[i] = (unsigned)(R * RB + C * 2); voffB[i] = (unsigned)(Rb * RB + C * 2); }
    const size_t kstep = (size_t)(BK * 2);
    const size_t hstep = (size_t)HALF * RB;
    const unsigned ldsw = (unsigned)wid * 1024u;
    const int aoff0 = lds_byte(wr * 64 + fr, fq * 8), aoff1 = lds_byte(wr * 64 + fr, 32 + fq * 8), boff0 = lds_byte(wc * 32 + fr, fq * 8), boff1 = lds_byte(wc * 32 + fr, 32 + fq * 8);
#define PG8_SA(b, h) (((b) * 2 + (h)) * HTB)
#define PG8_SB(b, h) ((4 + (b) * 2 + (h)) * HTB)
#define PG8_STAGE(bufoff, gbase, voff) do { if constexpr (DBG != 3) _Pragma("unroll") for (int _i = 0; _i < 2; ++_i) \
        __builtin_amdgcn_global_load_lds((const unsigned*)((const char*)(gbase) + (voff)[_i]), (LAS unsigned*)(lds + (bufoff) + ldsw + _i * 8192), 16, 0, 0); } while (0)
#define PG8_LDA(dst, b, h) do { if constexpr (DBG != 2) _Pragma("unroll") for (int m = 0; m < 4; ++m) _Pragma("unroll") for (int k = 0; k < 2; ++k) dst[m][k] = *(const LAS bf16x8*)(lds + PG8_SA(b, h) + (k ? aoff1 : aoff0) + m * 2048); } while (0)
#define PG8_LDB(dst, b, h) do { if constexpr (DBG != 2) _Pragma("unroll") for (int n = 0; n < 2; ++n) _Pragma("unroll") for (int k = 0; k < 2; ++k) dst[n][k] = *(const LAS bf16x8*)(lds + PG8_SB(b, h) + (k ? boff1 : boff0) + n * 2048); } while (0)
#define PG8_MMA(ai, bj, At, Bt) do { __builtin_amdgcn_s_setprio(1); if constexpr (DBG == 1) { } else if constexpr (QM == 2) { _Pragma("unroll") for (int m = 0; m < 4; ++m) _Pragma("unroll") for (int n = 0; n < 2; ++n) _Pragma("unroll") for (int k = 0; k < 2; ++k) \
        acc[ai][bj][m][n] = __builtin_bit_cast(f32x4, __builtin_amdgcn_mfma_i32_16x16x64_i8(__builtin_bit_cast(v4i32, Bt[n][k]), __builtin_bit_cast(v4i32, At[m][k]), __builtin_bit_cast(v4i32, acc[ai][bj][m][n]), 0, 0, 0)); } else if constexpr (QM == 1) { _Pragma("unroll") for (int m = 0; m < 4; ++m) _Pragma("unroll") for (int n = 0; n < 2; ++n) \
        mfma_fp8_acc(acc[ai][bj][m][n], cat8(Bt[n][0], Bt[n][1]), cat8(At[m][0], At[m][1]), fp8_sa, fp8_sb); } else { \
        _Pragma("unroll") for (int m = 0; m < 4; ++m) _Pragma("unroll") for (int n = 0; n < 2; ++n) _Pragma("unroll") for (int k = 0; k < 2; ++k) \
        acc[ai][bj][m][n] = __builtin_amdgcn_mfma_f32_16x16x32_bf16(Bt[n][k], At[m][k], acc[ai][bj][m][n], 0, 0, 0); } __builtin_amdgcn_s_setprio(0); } while (0)
#define PG8_WAIT_V(n) asm volatile("s_waitcnt vmcnt(" #n ")" ::: "memory")
#define PG8_WAIT_L(n) asm volatile("s_waitcnt lgkmcnt(" #n ")" ::: "memory")
#define PG8_BAR __builtin_amdgcn_s_barrier()
#define PG8_SCHED __builtin_amdgcn_sched_barrier(0)
    Unit cur, nxt; int ui = 0;
    const int fp8_sa = FP8_SCALE, fp8_sb = 0x7F7F7F7F;
    if (!S.next(0, cur)) return;
    f32x4 acc[2][2][4][2];
#pragma unroll
    for (int a = 0; a < 2; ++a)
#pragma unroll
        for (int b = 0; b < 2; ++b)
#pragma unroll
            for (int m = 0; m < 4; ++m)
#pragma unroll
                for (int n = 0; n < 2; ++n) acc[a][b][m][n] = (f32x4){0.f, 0.f, 0.f, 0.f};
    bf16x8 At[4][2], B0[2][2], B1[2][2];
    const char* cA = g.abase(cur.pm); const char* cB = g.bbase(cur.pn);
    S.a_ready(cur);
    if constexpr (SP2) {
        PG8_STAGE(PG8_SB(0, 0), cB, voffB); PG8_STAGE(PG8_SB(0, 1), cB + hstep, voffB); PG8_STAGE(PG8_SA(0, 0), cA, voffA); PG8_STAGE(PG8_SA(0, 1), cA + hstep, voffA);
        if (wr == 1) PG8_BAR;
        PG8_WAIT_V(2); PG8_BAR;
        PG8_STAGE(PG8_SB(1, 0), cB + kstep, voffB); PG8_STAGE(PG8_SA(1, 0), cA + kstep, voffA); PG8_STAGE(PG8_SB(1, 1), cB + hstep + kstep, voffB);
        PG8_WAIT_V(6); PG8_BAR;
    } else {
        PG8_STAGE(PG8_SB(0, 0), cB, voffB); PG8_STAGE(PG8_SA(0, 0), cA, voffA); PG8_STAGE(PG8_SB(0, 1), cB + hstep, voffB); PG8_STAGE(PG8_SA(0, 1), cA + hstep, voffA);
        if (wr == 1) PG8_BAR;
        PG8_WAIT_V(4); PG8_BAR;
        PG8_STAGE(PG8_SB(1, 0), cB + kstep, voffB); PG8_STAGE(PG8_SA(1, 0), cA + kstep, voffA); PG8_STAGE(PG8_SB(1, 1), cB + hstep + kstep, voffB);
        PG8_WAIT_V(6); PG8_BAR;
    }
    for (;;) {
        const bool has_next = S.next(ui + 1, nxt);
        const char* nA = has_next ? g.abase(nxt.pm) : cA; const char* nB = has_next ? g.bbase(nxt.pn) : cB;
        for (int t = 0; t < nt; t += 2) {
            const bool last = (t == nt - 2);
            const char* a1 = cA + (size_t)(t + 1) * kstep;
            const char* a2 = last ? nA : cA + (size_t)(t + 2) * kstep; const char* b2 = last ? nB : cB + (size_t)(t + 2) * kstep;
            const char* a3 = a2 + kstep; const char* b3 = b2 + kstep;
            if (last && has_next) S.a_ready(nxt);
            if constexpr (SP2) {
            PG8_LDB(B0, 0, 0); PG8_LDB(B1, 0, 1); PG8_SCHED; PG8_LDA(At, 0, 0); PG8_STAGE(PG8_SA(1, 1), a1 + hstep, voffA);
            PG8_WAIT_V(8); PG8_WAIT_L(0); PG8_BAR; PG8_MMA(0, 0, At, B0); PG8_MMA(0, 1, At, B1); PG8_BAR; PG8_SCHED;
            PG8_LDA(At, 0, 1); PG8_STAGE(PG8_SB(0, 0), b2, voffB); PG8_STAGE(PG8_SB(0, 1), b2 + hstep, voffB); PG8_STAGE(PG8_SA(0, 0), a2, voffA);
            PG8_WAIT_V(8); PG8_WAIT_L(0); PG8_BAR; PG8_MMA(1, 0, At, B0); PG8_MMA(1, 1, At, B1); PG8_BAR; PG8_SCHED;
            PG8_LDB(B0, 1, 0); PG8_LDB(B1, 1, 1); PG8_SCHED; PG8_LDA(At, 1, 0); PG8_STAGE(PG8_SA(0, 1), a2 + hstep, voffA);
            PG8_WAIT_V(8); PG8_WAIT_L(0); PG8_BAR; PG8_MMA(0, 0, At, B0); PG8_MMA(0, 1, At, B1); PG8_BAR; PG8_SCHED;
            PG8_LDA(At, 1, 1); PG8_STAGE(PG8_SB(1, 0), b3, voffB); PG8_STAGE(PG8_SB(1, 1), b3 + hstep, voffB); PG8_STAGE(PG8_SA(1, 0), a3, voffA);
            PG8_WAIT_V(8); PG8_WAIT_L(0); PG8_BAR; PG8_MMA(1, 0, At, B0); PG8_MMA(1, 1, At, B1); PG8_BAR; PG8_SCHED;
            } else {
            PG8_LDB(B0, 0, 0); PG8_SCHED; PG8_LDA(At, 0, 0); PG8_STAGE(PG8_SA(1, 1), a1 + hstep, voffA);
            PG8_WAIT_L(8); PG8_BAR; PG8_WAIT_L(0); PG8_MMA(0, 0, At, B0); PG8_BAR; PG8_SCHED;
            PG8_LDB(B1, 0, 1); PG8_STAGE(PG8_SB(0, 0), b2, voffB);
            PG8_BAR; PG8_WAIT_L(0); PG8_MMA(0, 1, At, B1); PG8_BAR;
            PG8_LDA(At, 0, 1); PG8_STAGE(PG8_SA(0, 0), a2, voffA);
            PG8_BAR; PG8_WAIT_L(0); PG8_MMA(1, 0, At, B0); PG8_BAR; PG8_SCHED;
            PG8_STAGE(PG8_SB(0, 1), b2 + hstep, voffB);
            PG8_WAIT_V(6); PG8_BAR; PG8_MMA(1, 1, At, B1); PG8_BAR;
            PG8_LDB(B0, 1, 0); PG8_SCHED; PG8_LDA(At, 1, 0); PG8_STAGE(PG8_SA(0, 1), a2 + hstep, voffA);
            PG8_WAIT_L(8); PG8_BAR; PG8_WAIT_L(0); PG8_MMA(0, 0, At, B0); PG8_BAR; PG8_SCHED;
            PG8_LDB(B1, 1, 1); PG8_STAGE(PG8_SB(1, 0), b3, voffB);
            PG8_BAR; PG8_WAIT_L(0); PG8_MMA(0, 1, At, B1); PG8_BAR;
            PG8_LDA(At, 1, 1); PG8_STAGE(PG8_SA(1, 0), a3, voffA);
            PG8_BAR; PG8_WAIT_L(0); PG8_MMA(1, 0, At, B0); PG8_BAR; PG8_SCHED;
            PG8_STAGE(PG8_SB(1, 1), b3 + hstep, voffB);
            PG8_WAIT_V(6); PG8_BAR; PG8_MMA(1, 1, At, B1); PG8_BAR;
            }
        }
        if constexpr (ALIGN_EPI) { if (wr == 0) PG8_BAR; }
        if constexpr (!Epi::AFTER_DRAIN) { if constexpr (DBG != 4) E(acc, cur, wr, wc, fr, fq); else { _Pragma("unroll") for (int a_ = 0; a_ < 2; ++a_) _Pragma("unroll") for (int b_ = 0; b_ < 2; ++b_) _Pragma("unroll") for (int m_ = 0; m_ < 4; ++m_) _Pragma("unroll") for (int n_ = 0; n_ < 2; ++n_) asm volatile("" :: "v"(acc[a_][b_][m_][n_])); } S.done(cur); }
        if (!has_next) break;
#pragma unroll
        for (int a = 0; a < 2; ++a)
#pragma unroll
            for (int b = 0; b < 2; ++b)
#pragma unroll
                for (int m = 0; m < 4; ++m)
#pragma unroll
                    for (int n = 0; n < 2; ++n) acc[a][b][m][n] = (f32x4){0.f, 0.f, 0.f, 0.f};
        cur = nxt; cA = nA; cB = nB; ++ui;
        if constexpr (ALIGN_EPI) { if (wr == 1) PG8_BAR; }
    }
    PG8_WAIT_V(0);
    if constexpr (!ALIGN_EPI) { if (wr == 0) PG8_BAR; }
    PG8_BAR;
    if constexpr (Epi::AFTER_DRAIN) { E.fused(acc, cur, wr, wc, fr, fq, lds, wid, lane); S.done(cur); }
#undef PG8_SA
#undef PG8_SB
#undef PG8_STAGE
#undef PG8_LDA
#undef PG8_LDB
#undef PG8_MMA
#undef PG8_WAIT_V
#undef PG8_WAIT_L
#undef PG8_BAR
#undef PG8_SCHED
}
}
#define XB_TMO      128
#define XB_XCNT(j)  (256  + 64 * (j))
#define XB_XSUB(j)  (1280 + 64 * (j))
#define XB_XGEN(j)  (2304 + 64 * (j))
#define XB_TOP      3328
#define XB_TOPGEN   3392
#define XCD_BAR_WORDS 3456
#define XB_SPIN_CAP (1u << 18)

__device__ __forceinline__ unsigned xb_ld(unsigned* p)              { return __hip_atomic_load(p, __ATOMIC_RELAXED, __HIP_MEMORY_SCOPE_AGENT); }
__device__ __forceinline__ unsigned xb_add(unsigned* p, unsigned v) { return __hip_atomic_fetch_add(p, v, __ATOMIC_RELAXED, __HIP_MEMORY_SCOPE_AGENT); }
__device__ __forceinline__ unsigned xb_xcc_id() { return (unsigned)__builtin_amdgcn_s_getreg((3 << 11) | 20) & 0xFu; }
#define XB_SPIN(cond, bar) do { unsigned _sp = 0; while (cond) { __builtin_amdgcn_s_sleep(1); \
    if ((++_sp & 255u) == 0u) { if (xb_ld(&(bar)[XB_TMO])) break; if (_sp > XB_SPIN_CAP) { atomicAdd(&(bar)[XB_TMO], 1u); break; } } } } while (0)

struct XcdBarrier {
    unsigned* bar; unsigned x;
    volatile LAS unsigned* st;
};

__device__ __forceinline__ XcdBarrier xcd_barrier_post(unsigned* bar, volatile LAS unsigned* st) {
    XcdBarrier b; b.bar = bar; b.x = xb_xcc_id(); b.st = st;
    if (threadIdx.x == 0) (void)xb_add(&bar[XB_XCNT(b.x)], 1u);
    return b;
}
__device__ __forceinline__ void xcd_barrier_complete(unsigned* bar, unsigned x, unsigned& nloc, unsigned& nx) {
    const unsigned G = gridDim.x * gridDim.y * gridDim.z;
    unsigned sum, cnt, mine, sp = 0u;
    for (;;) {
        sum = 0u; cnt = 0u; mine = 0u;
#pragma unroll
        for (unsigned j = 0; j < 16; ++j) { const unsigned c = xb_ld(&bar[XB_XCNT(j)]); sum += c; cnt += (c > 0u) ? 1u : 0u; mine = (j == x) ? c : mine; }
        if (sum == G) break;
        __builtin_amdgcn_s_sleep(1);
        if ((++sp & 255u) == 0u) { if (xb_ld(&bar[XB_TMO])) break; if (sp > XB_SPIN_CAP) { atomicAdd(&bar[XB_TMO], 1u); break; } }
    }
    nloc = mine > 0u ? mine : 1u; nx = cnt > 0u ? cnt : 1u;
}

__device__ __forceinline__ void xcd_barrier(const XcdBarrier& b) {
    asm volatile("s_waitcnt vmcnt(0)" ::: "memory");
    __syncthreads();
    if (threadIdx.x == 0) {
        unsigned* bar = b.bar;
        __builtin_amdgcn_s_waitcnt(0);
        unsigned nloc = b.st[0], nx = b.st[1];
        if (nloc == 0u) { xcd_barrier_complete(bar, b.x, nloc, nx); b.st[0] = nloc; b.st[1] = nx; }
        const unsigned old = xb_add(&bar[XB_XSUB(b.x)], 1u);
        const unsigned gen = old / nloc;
        if (old + 1u == (gen + 1u) * nloc) {
            __builtin_amdgcn_fence(__ATOMIC_RELEASE, "agent");
            asm volatile("s_waitcnt vmcnt(0)" ::: "memory");
            const unsigned og = xb_add(&bar[XB_TOP], 1u);
            const unsigned tg = og / nx;
            if (og + 1u == (tg + 1u) * nx) xb_add(&bar[XB_TOPGEN], 1u);
            else XB_SPIN(xb_ld(&bar[XB_TOPGEN]) == tg, bar);
            __builtin_amdgcn_fence(__ATOMIC_ACQUIRE, "agent");
            xb_add(&bar[XB_XGEN(b.x)], 1u);
            asm volatile("s_waitcnt vmcnt(0)" ::: "memory");
        } else {
            XB_SPIN(xb_ld(&bar[XB_XGEN(b.x)]) == gen, bar);
            __builtin_amdgcn_fence(__ATOMIC_ACQUIRE, "agent");
            asm volatile("s_waitcnt vmcnt(0)" ::: "memory");
        }
    }
    __syncthreads();
}


struct Frame {
    LAS unsigned char* lds;
    int tid, lane, wave, G, gw, ngw;
    const float *in_XP, *in_XS, *in_WIN, *in_WCONV, *in_BCONV, *in_WR, *in_BR, *in_WI, *in_BI, *in_LAM, *in_RPB, *in_WNO, *in_WLO, *in_WM, *in_BM, *in_WOUT, *in_GMPRE, *in_GMPOST, *in_GFPRE, *in_GFPOST, *in_WFG, *in_WFU, *in_WFD; float* out; unsigned char* ws;
};
enum { I_XP = 0, I_XS, I_WIN, I_WCONV, I_BCONV, I_WR, I_BR, I_WI, I_BI, I_LAM, I_RPB, I_WNO, I_WLO, I_WM, I_BM, I_WOUT, I_GMPRE, I_GMPOST, I_GFPRE, I_GFPOST, I_WFG, I_WFU, I_WFD };
__device__ __forceinline__ int opaque(int x) { asm volatile("" : "+v"(x)); return x; }
template <class T> __device__ __forceinline__ T* wsp(const Frame& F, size_t off) { return (T*)(F.ws + off); }
__device__ __forceinline__ const float* xrow(const Frame& F, int m) { return m < LP ? F.in_XP + (size_t)m * D : F.in_XS + (size_t)(m - LP) * D; }

__device__ __forceinline__ void tr_item(const float* src, int ldsrc, int k0, int n0, bf16_t* dst, int ldd, int drow0, LAS float* scr, int lane) {
#pragma unroll 8
    for (int i = 0; i < 32; ++i) { const int kk = 2 * i + (lane >> 5); scr[kk * 33 + (lane & 31)] = src[(size_t)(k0 + kk) * ldsrc + n0 + (lane & 31)]; }
    LDS_WAIT(); asm volatile("" ::: "memory");
    const int c = lane & 7;
#pragma unroll
    for (int j = 0; j < 4; ++j) { const int n = (lane >> 3) + 8 * j; const LAS float* s = scr + (8 * c) * 33 + n;
        u32x4 o; o.x = pk2(s[0 * 33], s[1 * 33]); o.y = pk2(s[2 * 33], s[3 * 33]); o.z = pk2(s[4 * 33], s[5 * 33]); o.w = pk2(s[6 * 33], s[7 * 33]);
        *(u32x4*)(dst + (size_t)(drow0 + n) * ldd + k0 + 8 * c) = o; }
    LDS_WAIT(); asm volatile("" ::: "memory");
}
__device__ __forceinline__ unsigned pk4_fp8(float a, float b, float c, float d) { int p = __builtin_amdgcn_cvt_pk_fp8_f32(a, b, 0, false); p = __builtin_amdgcn_cvt_pk_fp8_f32(c, d, p, true); return (unsigned)p; }
__device__ __forceinline__ void tr_item8(const float* src, int ldsrc, int k0, int n0, unsigned char* dst, int ldd, int drow0, LAS float* scr, int lane) {
#pragma unroll 8
    for (int i = 0; i < 32; ++i) { const int kk = 2 * i + (lane >> 5); scr[kk * 33 + (lane & 31)] = src[(size_t)(k0 + kk) * ldsrc + n0 + (lane & 31)]; }
    LDS_WAIT(); asm volatile("" ::: "memory");
    const int c = lane & 7;
#pragma unroll
    for (int j = 0; j < 4; ++j) { const int n = (lane >> 3) + 8 * j; const LAS float* s = scr + (8 * c) * 33 + n;
        u32x2 o; o.x = pk4_fp8(s[0 * 33] * 256.f, s[1 * 33] * 256.f, s[2 * 33] * 256.f, s[3 * 33] * 256.f); o.y = pk4_fp8(s[4 * 33] * 256.f, s[5 * 33] * 256.f, s[6 * 33] * 256.f, s[7 * 33] * 256.f);
        *(u32x2*)(dst + (size_t)(drow0 + n) * ldd + k0 + 8 * c) = o; }
    LDS_WAIT(); asm volatile("" ::: "memory");
}
__device__ __forceinline__ unsigned pk4_i8(float a, float b, float c, float d) { return ((unsigned)(int)a & 255u) | (((unsigned)(int)b & 255u) << 8) | (((unsigned)(int)c & 255u) << 16) | ((unsigned)(int)d << 24); }
__device__ __forceinline__ void tr_strip_i8(const float* src, int ldsrc, int K, int n0, signed char* dst, int drow0, float* cs, LAS float* scr, int lane) {
    const float* sp = src + n0 + (lane & 31) + (size_t)(lane >> 5) * ldsrc;
    float mx = 0.f;
    { const float* p = sp; const size_t step = (size_t)2 * ldsrc;
      for (int k0 = 0; k0 < K; k0 += 64) {
        float t[32];
#pragma unroll
        for (int i = 0; i < 32; ++i) { t[i] = *p; p += step; }
#pragma unroll
        for (int i = 0; i < 32; ++i) mx = fmaxf(mx, fabsf(t[i]));
      } }
    mx = fmaxf(mx, __shfl_xor(mx, 32));
    const float amax = fmaxf(mx, 1e-20f), inv = 127.0f / amax;
    if (lane < 32) cs[drow0 + lane] = amax * (1.0f / 127.0f);
    const int c = lane & 7;
    for (int k0 = 0; k0 < K; k0 += 64) {
        { const float* p = sp + (size_t)k0 * ldsrc; const size_t step = (size_t)2 * ldsrc; LAS float* w = scr + (lane >> 5) * 33 + (lane & 31);
          float t[32];
#pragma unroll
          for (int i = 0; i < 32; ++i) { t[i] = *p; p += step; }
#pragma unroll
          for (int i = 0; i < 32; ++i) w[i * 66] = rintf(t[i] * inv); }
        LDS_WAIT(); asm volatile("" ::: "memory");
#pragma unroll
        for (int j = 0; j < 4; ++j) { const int n = (lane >> 3) + 8 * j; const LAS float* t = scr + (8 * c) * 33 + n;
            u32x2 o; o.x = pk4_i8(t[0 * 33], t[1 * 33], t[2 * 33], t[3 * 33]); o.y = pk4_i8(t[4 * 33], t[5 * 33], t[6 * 33], t[7 * 33]);
            *(u32x2*)(dst + (size_t)(drow0 + n) * K + k0 + 8 * c) = o; }
        LDS_WAIT(); asm volatile("" ::: "memory");
    }
}
__device__ __forceinline__ void fwht32(float (&v)[32]) {
#pragma unroll
    for (int st = 1; st < 32; st <<= 1)
#pragma unroll
        for (int i = 0; i < 32; ++i) if (!(i & st)) { const float a = v[i], b = v[i + st]; v[i] = a + b; v[i + st] = a - b; }
#pragma unroll
    for (int i = 0; i < 32; ++i) v[i] *= 0.17677669529663687f;
}
__device__ __forceinline__ void had_tile_load(const float* src, int ldsrc, int k0, int n0, LAS float* scr, int lane, float (&v)[32]) {
    { const float* p = src + (size_t)(k0 + (lane >> 5)) * ldsrc + n0 + (lane & 31); const size_t step = (size_t)2 * ldsrc; LAS float* w = scr + (lane >> 5) * 33 + (lane & 31); float t[32];
#pragma unroll
      for (int i = 0; i < 32; ++i) { t[i] = *p; p += step; }
#pragma unroll
      for (int i = 0; i < 32; ++i) w[i * 66] = t[i]; }
    LDS_WAIT(); asm volatile("" ::: "memory");
    const LAS float* hv = scr + (32 * (lane >> 5)) * 33 + (lane & 31);
#pragma unroll
    for (int i = 0; i < 32; ++i) v[i] = hv[i * 33];
    fwht32(v);
}
__device__ __forceinline__ void had_tile_amax(const float* src, int ldsrc, int k0, int n0, unsigned* am, LAS float* scr, int lane) {
    float v[32]; had_tile_load(src, ldsrc, k0, n0, scr, lane, v);
    float mx = 0.f;
#pragma unroll
    for (int i = 0; i < 32; ++i) mx = fmaxf(mx, fabsf(v[i]));
    mx = fmaxf(mx, __shfl_xor(mx, 32));
    if (lane < 32) atomicMax(am + n0 + lane, __builtin_bit_cast(unsigned, mx));
    LDS_WAIT(); asm volatile("" ::: "memory");
}
__device__ __forceinline__ void had_tile_quant(const float* src, int ldsrc, int K, int k0, int n0, signed char* dst, const unsigned* am, float* cs, LAS float* scr, int lane) {
    const float amax = fmaxf(__builtin_bit_cast(float, am[n0 + (lane & 31)]), 1e-20f), inv = 127.0f / amax;
    if (k0 == 0 && lane < 32) cs[n0 + lane] = amax * (1.0f / 127.0f);
    float v[32]; had_tile_load(src, ldsrc, k0, n0, scr, lane, v);
    LAS float* hv = scr + (32 * (lane >> 5)) * 33 + (lane & 31);
#pragma unroll
    for (int i = 0; i < 32; ++i) hv[i * 33] = rintf(v[i] * inv);
    LDS_WAIT(); asm volatile("" ::: "memory");
    const int c = lane & 7;
#pragma unroll
    for (int j = 0; j < 4; ++j) { const int n = (lane >> 3) + 8 * j; const LAS float* t = scr + (8 * c) * 33 + n;
        u32x2 o; o.x = pk4_i8(t[0 * 33], t[1 * 33], t[2 * 33], t[3 * 33]); o.y = pk4_i8(t[4 * 33], t[5 * 33], t[6 * 33], t[7 * 33]);
        *(u32x2*)(dst + (size_t)(n0 + n) * K + k0 + 8 * c) = o; }
    LDS_WAIT(); asm volatile("" ::: "memory");
}
#define TR_JOB(SRC, LDSRC, KK, NN, DST, DROW_EXPR) { const int nblk = (NN) / 32, nit = ((KK) / 64) * nblk; \
    if (r < nit) { const int kb = r / nblk, nb = r % nblk, n0 = 32 * nb; tr_item((SRC), (LDSRC), 64 * kb, n0, (DST), (KK), (DROW_EXPR), scr, F.lane); continue; } r -= nit; }
#define TR_JOB8(SRC, LDSRC, KK, NN, DST, DROW_EXPR) { const int nblk = (NN) / 32, nit = ((KK) / 64) * nblk; \
    if (r < nit) { const int kb = r / nblk, nb = r % nblk, n0 = 32 * nb; tr_item8((SRC), (LDSRC), 64 * kb, n0, (DST), (KK), (DROW_EXPR), scr, F.lane); continue; } r -= nit; }

__device__ __forceinline__ void p0_prologue(Frame& F) {
    const int tid_ = opaque(F.tid);
    LAS float* scr = (LAS float*)(F.lds + F.wave * 8448);
    const float* w_in = F.in_WIN;
    bf16_t* WCAT = wsp<bf16_t>(F, WS_WCAT); signed char* W8 = wsp<signed char>(F, WS_W8); signed char* WV8 = wsp<signed char>(F, WS_WVT); signed char* WGU8 = wsp<signed char>(F, WS_WGU);
    float* CS = wsp<float>(F, WS_CS);
    constexpr int NSM = 64;
    constexpr int IT_SM = 2 * 4;
    constexpr int S_Q = NAW / 32, S_M = 2 * D / 32, S_F = DFF / 32;
    constexpr int NSTRIP = 3 * S_Q + S_M + 2 * S_F;
    constexpr int N_AMAX = (DFF / 64) * (D / 32);
    constexpr int N_BIG = 2 * (D / 64) * (NAW / 32) + 2 * (NAW / 64) * (D / 32) + (D / 64) * (D / 32) + N_AMAX;
    constexpr int NITEMS = N_BIG + NSM * IT_SM;
    for (int it = F.gw; it < NSTRIP + NITEMS; it += F.ngw) {
        if (it < NSTRIP) {
            int q = it; const float* src; int ld, n0, drow0; signed char* dst; float* cs;
            if (q < S_Q) { src = w_in; ld = INW; n0 = 32 * q; dst = W8; drow0 = n0; cs = CS + CS_QKM; }
            else if ((q -= S_Q) < S_Q) { src = w_in + NAW; ld = INW; n0 = 32 * q; dst = W8; drow0 = 2048 + n0; cs = CS + CS_QKM; }
            else if ((q -= S_Q) < S_M) { src = F.in_WM; ld = 2 * D; n0 = 32 * q; dst = W8; drow0 = 4096 + n0; cs = CS + CS_QKM; }
            else if ((q -= S_M) < S_Q) { src = w_in + 2 * NAW; ld = INW; n0 = 32 * q; dst = WV8; drow0 = n0; cs = CS + CS_V; }
            else if ((q -= S_Q) < S_F) { src = F.in_WFG; ld = DFF; n0 = 32 * q; dst = WGU8; drow0 = (n0 >> 7) * 256 + (n0 & 127); cs = CS + CS_GU; }
            else { q -= S_F; src = F.in_WFU; ld = DFF; n0 = 32 * q; dst = WGU8; drow0 = (n0 >> 7) * 256 + 128 + (n0 & 127); cs = CS + CS_GU; }
            tr_strip_i8(src, ld, D, n0, dst, drow0, cs, scr, F.lane);
            continue;
        }
        int r = it - NSTRIP;
        TR_JOB(w_in + 3 * NAW, INW, D, NAW, WCAT, 0 + n0)
        TR_JOB(w_in + 4 * NAW, INW, D, NAW, WCAT, 2048 + n0)
        TR_JOB(F.in_WNO, D, NAW, D, wsp<bf16_t>(F, WS_WNO), n0)
        TR_JOB(F.in_WLO, D, LW, D, wsp<bf16_t>(F, WS_WLO), n0)
        TR_JOB(F.in_WOUT, D, D, D, wsp<bf16_t>(F, WS_WO), n0)
        if (r < N_AMAX) { had_tile_amax(F.in_WFD, D, 64 * (r / (D / 32)), 32 * (r % (D / 32)), (unsigned*)(F.ws + WS_AM), scr, F.lane); continue; } r -= N_AMAX;
        {
            const int mi = r / IT_SM, ri = r % IT_SM, d = mi >> 5, g = (mi >> 4) & 1, n = mi & 15, kb = ri >> 2, nb = ri & 3;
            const float* src = (g ? F.in_WI : F.in_WR) + (size_t)(d * NBLK + n) * BW * BW;
            tr_item(src, BW, 64 * kb, 32 * nb, wsp<bf16_t>(F, WS_WG) + (size_t)mi * BW * BW, BW, 32 * nb, scr, F.lane);
        }
    }
    LAS f32x4* gl = (LAS f32x4*)(F.lds + 69632);
    for (int i = tid_; i < D / 4; i += NTHR) gl[i] = ((const f32x4*)F.in_GMPRE)[i];
    __syncthreads();
    bf16_t* XN = wsp<bf16_t>(F, WS_XN); signed char* XN8 = wsp<signed char>(F, WS_XN8); float* RS1 = wsp<float>(F, WS_RS1);
    for (int m = F.gw; m < L; m += F.ngw) {
        asm volatile("" ::: "memory");
        const f32x4* xr = (const f32x4*)xrow(F, m) + F.lane;
        f32x4 v[16]; float s = 0.f;
#pragma unroll
        for (int j = 0; j < 16; ++j) { v[j] = xr[64 * j]; s += (v[j].x * v[j].x + v[j].y * v[j].y) + (v[j].z * v[j].z + v[j].w * v[j].w); }
        const float rstd = 1.0f / sqrtf(wave_sum(s) * (1.0f / D) + EPS);
        u32x2* o8 = (u32x2*)(XN + (size_t)m * D) + F.lane; unsigned* o4 = (unsigned*)(XN8 + (size_t)m * D) + F.lane;
        float mx = 0.f;
#pragma unroll
        for (int j = 0; j < 16; ++j) { v[j] = v[j] * rstd * gl[F.lane + 64 * j]; mx = fmaxf(fmaxf(mx, fmaxf(fabsf(v[j].x), fabsf(v[j].y))), fmaxf(fabsf(v[j].z), fabsf(v[j].w))); }
        const float amax = fmaxf(wave_max(mx), 1e-20f), inv = 127.0f / amax;
        if (F.lane == 0) RS1[m] = amax * (1.0f / 127.0f);
#pragma unroll
        for (int j = 0; j < 16; ++j) { const f32x4 y = v[j]; u32x2 o; o.x = pk2(y.x, y.y); o.y = pk2(y.z, y.w); o8[64 * j] = o;
            o4[64 * j] = pk4_i8(rintf(y.x * inv), rintf(y.y * inv), rintf(y.z * inv), rintf(y.w * inv)); }
    }
    __syncthreads();
}

#ifndef ATT_SYNC
#define ATT_SYNC 1
#endif
template <int ADBG = 0> __device__ __forceinline__ void attn_mfma(Frame& F) {
    const int tid_ = opaque(F.tid);
    bf16_t* Q = wsp<bf16_t>(F, WS_Q); const bf16_t* Kb = wsp<bf16_t>(F, WS_K); const bf16_t* VT = wsp<bf16_t>(F, WS_VT);
    LAS float* rp = (LAS float*)F.lds;
    for (int i = tid_; i < NH * 15 * 31; i += NTHR) rp[i] = F.in_RPB[i];
    __syncthreads();
    const int fr = F.lane & 15, fq = F.lane >> 4;
    const float scale = 0.08838834764831845f;
    for (int base = blockIdx.x * NWAVES; base < (L / GRIDW) * NH * 4; base += F.ngw) {
        const int item = base + F.wave;
        asm volatile("" ::: "memory");
        const int g = item & 3, h = (item >> 2) & 15, rg = item >> 6;
        const int s0 = rg < LP / GRIDW ? 0 : LP, rows = rg < LP / GRIDW ? LP / GRIDW : LS / GRIDW, r = rg < LP / GRIDW ? rg : rg - LP / GRIDW;
        int rs = r - 4; rs = rs < 0 ? 0 : (rs > rows - 8 ? rows - 8 : rs);
        const int w0 = g == 0 ? 0 : (g == 1 ? 8 : (g == 2 ? 24 : 32));
        const int c = 16 * g + fr;
        int cs = c - 8; cs = cs < 0 ? 0 : (cs > GRIDW - 16 ? GRIDW - 16 : cs);
        bf16_t* qrow = Q + (size_t)(s0 + r * GRIDW + c) * NAW + h * HD;
        bf16x8 qf[4];
#pragma unroll
        for (int s = 0; s < 4; ++s) qf[s] = *(const bf16x8*)(qrow + 8 * fq + 32 * s);
        f32x4 sacc[8][2];
        const int Rg = s0 / GRIDW + rs, p0 = w0 >> 3;
        const bf16_t* kbase = Kb + (size_t)(Rg * 16 + h) * 8192 + p0 * 128 + fr * 32 + fq * 8;
        bf16x8 kb[8][2][4];
#define ATT_LDK(kr) do { _Pragma("unroll") for (int T = 0; T < 2; ++T) _Pragma("unroll") for (int s = 0; s < 4; ++s) kb[kr][T][s] = (ADBG & 1) ? qf[s] : (ADBG & 4) ? *(const bf16x8*)(Kb + (size_t)(s0 + rs * GRIDW) * NAW + h * HD * GRIDW + ((kr) * 8 + T * 4 + s) * 512 + F.lane * 8) : *(const bf16x8*)(kbase + (size_t)(kr) * (16 * 8192) + (s * 2 + T) * 1024); } while (0)
        ATT_LDK(0); ATT_LDK(1);
#pragma unroll
        for (int kr = 0; kr < 8; ++kr) {
            if (ATT_SYNC && (kr & 1) == 0) __builtin_amdgcn_s_barrier();
            if (kr + 2 < 8) ATT_LDK(kr + 2);
            __builtin_amdgcn_sched_barrier(0);
#pragma unroll
            for (int T = 0; T < 2; ++T) { f32x4 a = (f32x4){0.f, 0.f, 0.f, 0.f};
#pragma unroll
                for (int s = 0; s < 4; ++s) a = __builtin_amdgcn_mfma_f32_16x16x32_bf16(kb[kr][T][s], qf[s], a, 0, 0, 0);
                sacc[kr][T] = a; }
            __builtin_amdgcn_sched_barrier(0);
        }
#undef ATT_LDK
        bf16x8 vb[8][8];
        const bf16_t* vbase = VT + (size_t)(Rg * 16 + h) * 8192 + p0 * 128 + fq * 128 + fr * 8;
#define ATT_LDV(kr) do { _Pragma("unroll") for (int dt = 0; dt < 8; ++dt) vb[kr][dt] = (ADBG & 2) ? qf[dt & 3] : (ADBG & 4) ? *(const bf16x8*)(VT + (size_t)(h * HD) * L + s0 + rs * GRIDW + ((kr) * 8 + dt) * 512 + F.lane * 8) : *(const bf16x8*)(vbase + (size_t)(kr) * (16 * 8192) + dt * 1024); } while (0)
        ATT_LDV(0); ATT_LDV(1);
        __builtin_amdgcn_sched_barrier(0);
        const int elo = cs - w0 - 8 * fq, dc0 = w0 + 8 * fq - c + 15;
        const LAS float* rph = rp + h * 465 + (rs - r + 7) * 31;
        float mx = -3.0e38f;
#pragma unroll
        for (int e = 0; e < 8; ++e) { const bool valid = (e >= elo) && (e < elo + 16); const int bi = valid ? dc0 + e : 0;
#pragma unroll
            for (int kr = 0; kr < 8; ++kr) { const float sv = valid ? sacc[kr][e >> 2][e & 3] * scale + rph[kr * 31 + bi] : -3.0e38f; sacc[kr][e >> 2][e & 3] = sv; mx = fmaxf(mx, sv); } }
        mx = fmaxf(mx, __shfl_xor(mx, 16)); mx = fmaxf(mx, __shfl_xor(mx, 32));
        float lsum = 0.f; bf16x8 pf[8];
#pragma unroll
        for (int kr = 0; kr < 8; ++kr) { float p[8];
#pragma unroll
            for (int e = 0; e < 8; ++e) { p[e] = __expf(sacc[kr][e >> 2][e & 3] - mx); lsum += p[e]; }
            u32x4 w; w.x = pk2(p[0], p[1]); w.y = pk2(p[2], p[3]); w.z = pk2(p[4], p[5]); w.w = pk2(p[6], p[7]);
            pf[kr] = __builtin_bit_cast(bf16x8, w); }
        lsum += __shfl_xor(lsum, 16); lsum += __shfl_xor(lsum, 32);
        f32x4 oacc[8];
#pragma unroll
        for (int dt = 0; dt < 8; ++dt) oacc[dt] = (f32x4){0.f, 0.f, 0.f, 0.f};
#pragma unroll
        for (int kr = 0; kr < 8; ++kr) {
            if (ATT_SYNC && (kr & 1) == 0) __builtin_amdgcn_s_barrier();
            if (kr + 2 < 8) ATT_LDV(kr + 2);
            __builtin_amdgcn_sched_barrier(0);
#pragma unroll
            for (int dt = 0; dt < 8; ++dt) oacc[dt] = __builtin_amdgcn_mfma_f32_16x16x32_bf16(vb[kr][dt], pf[kr], oacc[dt], 0, 0, 0);
            __builtin_amdgcn_sched_barrier(0);
        }
#undef ATT_LDV
        const float inv = 1.0f / lsum;
#ifdef ATTN_OUT_OFF
        bf16_t* orow = wsp<bf16_t>(F, (size_t)ATTN_OUT_OFF * MiB) + (size_t)(s0 + r * GRIDW + c) * NAW + h * HD;
#else
        bf16_t* orow = qrow;
#endif
#pragma unroll
        for (int u = 0; u < 4; ++u) *(u32x4*)(orow + 32 * u + 8 * fq) = pg8::pack8(oacc[2 * u] * inv, oacc[2 * u + 1] * inv);
    }
    __syncthreads();
}

__device__ __forceinline__ void attn_mfma_lds(Frame& F) {
    const int tid_ = opaque(F.tid);
    bf16_t* Q = wsp<bf16_t>(F, WS_Q); const bf16_t* Kb = wsp<bf16_t>(F, WS_K); const bf16_t* VT = wsp<bf16_t>(F, WS_VT);
    LAS float* rp = (LAS float*)F.lds;
    LAS unsigned char* ring = F.lds + 30720;
    for (int i = tid_; i < NH * 15 * 31; i += NTHR) rp[i] = F.in_RPB[i];
    __syncthreads();
    const int lane = tid_ & 63, fr = lane & 15, fq = lane >> 4, w = F.wave, hl = w >> 2, g = w & 3;
    const float scale = 0.08838834764831845f;
    constexpr int NIT = (L / GRIDW) * NH * 4;
    const int w0 = g == 0 ? 0 : (g == 1 ? 8 : (g == 2 ? 24 : 32)), p0 = w0 >> 3;
    const int c = 16 * g + fr;
    int cs = c - 8; cs = cs < 0 ? 0 : (cs > GRIDW - 16 ? GRIDW - 16 : cs);
#define ATL_SRC(b, st) ([&]() -> const bf16_t* { const int rg_ = (b) >> 6, hb_ = ((b) >> 2) & 15; const int rows_ = rg_ < LP / GRIDW ? LP / GRIDW : LS / GRIDW, r_ = rg_ < LP / GRIDW ? rg_ : rg_ - LP / GRIDW; \
        int rs_ = r_ - 4; rs_ = rs_ < 0 ? 0 : (rs_ > rows_ - 8 ? rows_ - 8 : rs_); const int Rg_ = (rg_ < LP / GRIDW ? 0 : LP / GRIDW) + rs_; \
        return ((st) < 8 ? Kb : VT) + (size_t)((Rg_ + ((st) & 7)) * 16 + hb_) * 8192; }())
#define ATL_ISSUE(src, slot) do { const bf16_t* s_ = (src) + tid_ * 8; LAS unsigned char* d_ = ring + (slot) * 32768 + w * 1024; _Pragma("unroll") for (int k_ = 0; k_ < 4; ++k_) \
        __builtin_amdgcn_global_load_lds((const unsigned*)(s_ + k_ * 4096), (LAS unsigned*)(d_ + k_ * 8192), 16, 0, 0); } while (0)
    int base = blockIdx.x * NWAVES;
    if (base < NIT) { ATL_ISSUE(ATL_SRC(base, 0), 0); ATL_ISSUE(ATL_SRC(base, 1), 1); }
    int b0 = 0;
    for (; base < NIT; base += F.ngw) {
        asm volatile("" ::: "memory");
        const int h = ((base >> 2) & 15) + hl, rg = base >> 6;
        const int s0 = rg < LP / GRIDW ? 0 : LP, rows = rg < LP / GRIDW ? LP / GRIDW : LS / GRIDW, r = rg < LP / GRIDW ? rg : rg - LP / GRIDW;
        int rs = r - 4; rs = rs < 0 ? 0 : (rs > rows - 8 ? rows - 8 : rs);
        const int nbase = base + F.ngw < NIT ? base + F.ngw : base;
        bf16_t* qrow = Q + (size_t)(s0 + r * GRIDW + c) * NAW + h * HD;
        bf16x8 qf[4];
#pragma unroll
        for (int s = 0; s < 4; ++s) qf[s] = *(const bf16x8*)(qrow + 8 * fq + 32 * s);
        f32x4 sacc[8][2]; f32x4 oacc[8]; bf16x8 pf[8]; float lsum = 0.f;
#pragma unroll
        for (int dt = 0; dt < 8; ++dt) oacc[dt] = (f32x4){0.f, 0.f, 0.f, 0.f};
        const int koff = hl * 16384 + (p0 * 128 + fr * 32 + fq * 8) * 2, voff = hl * 16384 + (p0 * 128 + fq * 128 + fr * 8) * 2;
#pragma unroll
        for (int st = 0; st < 16; ++st) {
            asm volatile("s_waitcnt vmcnt(4)" ::: "memory"); asm volatile("s_waitcnt lgkmcnt(0)" ::: "memory"); __builtin_amdgcn_s_barrier(); asm volatile("" ::: "memory");
            { const int slot2 = (b0 + st + 2) % 3; if (st + 2 < 16) ATL_ISSUE(ATL_SRC(base, st + 2), slot2); else ATL_ISSUE(ATL_SRC(nbase, st + 2 - 16), slot2); }
            const LAS unsigned char* buf = ring + ((b0 + st) % 3) * 32768;
            if (st < 8) {
#pragma unroll
                for (int T = 0; T < 2; ++T) { f32x4 a = (f32x4){0.f, 0.f, 0.f, 0.f};
#pragma unroll
                    for (int s2 = 0; s2 < 4; ++s2) a = __builtin_amdgcn_mfma_f32_16x16x32_bf16(*(const LAS bf16x8*)(buf + koff + (s2 * 2 + T) * 2048), qf[s2], a, 0, 0, 0);
                    sacc[st][T] = a; }
            } else {
                if (st == 8) {
                    const int elo = cs - w0 - 8 * fq, dc0 = w0 + 8 * fq - c + 15;
                    const LAS float* rph = rp + h * 465 + (rs - r + 7) * 31;
                    float mx = -3.0e38f;
#pragma unroll
                    for (int e = 0; e < 8; ++e) { const bool valid = (e >= elo) && (e < elo + 16); const int bi = valid ? dc0 + e : 0;
#pragma unroll
                        for (int kr = 0; kr < 8; ++kr) { const float sv = valid ? sacc[kr][e >> 2][e & 3] * scale + rph[kr * 31 + bi] : -3.0e38f; sacc[kr][e >> 2][e & 3] = sv; mx = fmaxf(mx, sv); } }
                    mx = fmaxf(mx, __shfl_xor(mx, 16)); mx = fmaxf(mx, __shfl_xor(mx, 32));
#pragma unroll
                    for (int kr = 0; kr < 8; ++kr) { float p[8];
#pragma unroll
                        for (int e = 0; e < 8; ++e) { p[e] = __expf(sacc[kr][e >> 2][e & 3] - mx); lsum += p[e]; }
                        u32x4 wv; wv.x = pk2(p[0], p[1]); wv.y = pk2(p[2], p[3]); wv.z = pk2(p[4], p[5]); wv.w = pk2(p[6], p[7]);
                        pf[kr] = __builtin_bit_cast(bf16x8, wv); }
                    lsum += __shfl_xor(lsum, 16); lsum += __shfl_xor(lsum, 32);
                }
#pragma unroll
                for (int dt = 0; dt < 8; ++dt) oacc[dt] = __builtin_amdgcn_mfma_f32_16x16x32_bf16(*(const LAS bf16x8*)(buf + voff + dt * 2048), pf[st - 8], oacc[dt], 0, 0, 0);
            }
        }
        b0 = (b0 + 16) % 3;
        const float inv = 1.0f / lsum;
#pragma unroll
        for (int u = 0; u < 4; ++u) *(u32x4*)(qrow + 32 * u + 8 * fq) = pg8::pack8(oacc[2 * u] * inv, oacc[2 * u + 1] * inv);
    }
#undef ATL_SRC
#undef ATL_ISSUE
    asm volatile("s_waitcnt vmcnt(0)" ::: "memory");
    __syncthreads();
}

__device__ __forceinline__ void conv_phase(Frame& F) {
    const int tid_ = opaque(F.tid);
    const bf16_t* XR = wsp<bf16_t>(F, WS_XR); bf16_t* XC = wsp<bf16_t>(F, WS_XC);
    const float* wc = F.in_WCONV; const float* bc = F.in_BCONV;
    const int nth = F.G * NTHR;
    for (int it = blockIdx.x * NTHR + tid_; it < L * (LW / 8); it += nth) {
        const int t = it / (LW / 8), c0 = (it % (LW / 8)) * 8;
        const int s0 = t < LP ? 0 : LP, len = t < LP ? LP : LS, tl = t - s0;
        float acc[8];
#pragma unroll
        for (int e = 0; e < 8; ++e) acc[e] = bc[c0 + e];
#pragma unroll
        for (int j = 0; j < 4; ++j) { const int tt = tl + j - 2; if (tt < 0 || tt >= len) continue;
            f32x4 x0, x1; pg8::unpack8(*(const u32x4*)(XR + (size_t)(s0 + tt) * LW + c0), x0, x1);
            const f32x4 w0 = *(const f32x4*)(wc + j * LW + c0), w1 = *(const f32x4*)(wc + j * LW + c0 + 4);
#pragma unroll
            for (int e = 0; e < 4; ++e) { acc[e] += w0[e] * x0[e]; acc[4 + e] += w1[e] * x1[e]; } }
        *(u32x4*)(XC + (size_t)t * LW + c0) = pg8::pack8((f32x4){acc[0], acc[1], acc[2], acc[3]}, (f32x4){acc[4], acc[5], acc[6], acc[7]});
    }
}

struct LruW { bf16x8 w[2][4]; float br, bi, cl; };
template <int DIR> __device__ __forceinline__ void lru_load_w(const Frame& F, LruW& W, int n, int w, int fr, int fq) {
    const bf16_t* wg = wsp<bf16_t>(F, WS_WG);
#pragma unroll
    for (int g = 0; g < 2; ++g)
#pragma unroll
        for (int s = 0; s < 4; ++s) W.w[g][s] = *(const bf16x8*)(wg + ((size_t)((DIR * 2 + g) * NBLK + n) * BW + 16 * w + fr) * BW + 32 * fq + 8 * s);
    const int ch = n * BW + 16 * w + fr;
    W.br = -1.44269504f * F.in_BR[DIR * LW + ch]; W.bi = -1.44269504f * F.in_BI[DIR * LW + ch];
    const float lam = F.in_LAM[DIR * LW + ch];
    W.cl = -8.0f * 1.44269504f * ((lam > 15.f) ? __expf(-lam) : log1pf(__expf(-lam)));
}
template <int LDBG = 0> __device__ __forceinline__ void lru_gate(float pr, float pi, float xc, const LruW& W, bool first, float& a, float& u) {
    if constexpr (LDBG == 1) { a = pr + W.br; u = pi * xc + W.bi; return; }
    const float r = __builtin_amdgcn_rcpf(1.0f + __builtin_amdgcn_exp2f(__builtin_fmaf(pr, -1.44269504f, W.br))), d = 1.0f + __builtin_amdgcn_exp2f(__builtin_fmaf(pi, -1.44269504f, W.bi));
    a = __builtin_amdgcn_exp2f(W.cl * r);
    const float y = first ? 1.0f : fmaxf(1.0f - a * a, 0.f);
    u = xc * y * __builtin_amdgcn_rsqf(fmaxf(y, 1e-30f) * d * d);
}
struct LruX { bf16x8 x[4][4]; };
__device__ __forceinline__ void lru_load_x(LruX& X, const bf16_t* XC, int tb, int n, int fr, int fq) {
#pragma unroll
    for (int tau = 0; tau < 4; ++tau) { const bf16_t* xp = XC + ((size_t)((((tb >> 6) * NBLK + n) * 4 + tau) * 4) * 64 + fr * 4 + fq) * 8;
#pragma unroll
        for (int s = 0; s < 4; ++s) X.x[tau][s] = *(const bf16x8*)(xp + s * 512); }
}
__device__ __forceinline__ void lru_tile(const LruX& X, int tau, bool hiw, const LruW& W, const bf16x8 idf0, const bf16x8 idf1, f32x4& pr, f32x4& pi, f32x4& xct) {
    pr = (f32x4){0.f, 0.f, 0.f, 0.f}; pi = pr;
#pragma unroll
    for (int s = 0; s < 4; ++s) { pr = __builtin_amdgcn_mfma_f32_16x16x32_bf16(X.x[tau][s], W.w[0][s], pr, 0, 0, 0); pi = __builtin_amdgcn_mfma_f32_16x16x32_bf16(X.x[tau][s], W.w[1][s], pi, 0, 0, 0); }
    const bf16x8 x0 = hiw ? X.x[tau][2] : X.x[tau][0], x1 = hiw ? X.x[tau][3] : X.x[tau][1];
    xct = __builtin_amdgcn_mfma_f32_16x16x32_bf16(x0, idf0, (f32x4){0.f, 0.f, 0.f, 0.f}, 0, 0, 0);
    xct = __builtin_amdgcn_mfma_f32_16x16x32_bf16(x1, idf1, xct, 0, 0, 0);
}
__device__ __forceinline__ void lru_idfrags(int w, int fr, int fq, bf16x8& idf0, bf16x8& idf1) {
#pragma unroll
    for (int e = 0; e < 8; ++e) { const bool on = (fq == (w >> 1)) && ((fr & 7) == e); idf0[e] = (on && fr < 8) ? (short)0x3F80 : (short)0; idf1[e] = (on && fr >= 8) ? (short)0x3F80 : (short)0; }
}
constexpr int LRU_CH = 256, LRU_NCH = L / LRU_CH, LRU_NCH_P = LP / LRU_CH;
__device__ __forceinline__ void conv_unit(Frame& F, int cg, int n) {
    const int tid_ = opaque(F.tid);
    const bf16_t* XR = wsp<bf16_t>(F, WS_XR); bf16_t* XC = wsp<bf16_t>(F, WS_XC);
    const float* wc = F.in_WCONV; const float* bc = F.in_BCONV;
    const int c0 = n * BW + (tid_ & 15) * 8;
    const int s0 = cg < LRU_NCH_P ? 0 : LP, len = cg < LRU_NCH_P ? LP : LS;
    f32x4 w[4][2]; f32x4 b0 = *(const f32x4*)(bc + c0), b1 = *(const f32x4*)(bc + c0 + 4);
#pragma unroll
    for (int j = 0; j < 4; ++j) { w[j][0] = *(const f32x4*)(wc + j * LW + c0); w[j][1] = *(const f32x4*)(wc + j * LW + c0 + 4); }
#pragma unroll
    for (int i = 0; i < 8; ++i) {
        const int t = cg * LRU_CH + (tid_ >> 4) + 32 * i, tl = t - s0;
        f32x4 a0 = b0, a1 = b1;
#pragma unroll
        for (int j = 0; j < 4; ++j) { const int tt = tl + j - 2; if (tt < 0 || tt >= len) continue;
            f32x4 x0, x1; pg8::unpack8(*(const u32x4*)(XR + (size_t)(s0 + tt) * LW + c0), x0, x1); a0 += w[j][0] * x0; a1 += w[j][1] * x1; }
        const int tg = t & 63, cq = tid_ & 15;
        *(u32x4*)(XC + ((size_t)(((((t >> 6) * NBLK + n) * 4 + ((tg >> 2) & 3)) * 4 + (cq & 3)) * 16 + 4 * (tg >> 4) + (tg & 3)) * 4 + (cq >> 2)) * 8) = pg8::pack8(a0, a1);
    }
}
__device__ __forceinline__ void lru_pass_a(Frame& F) {
    const int fr = F.lane & 15, fq = F.lane >> 4, w = F.wave;
    const bf16_t* XC = wsp<bf16_t>(F, WS_XC); f32x2* SUMM = wsp<f32x2>(F, WS_SUM);
    bf16x8 idf0, idf1; lru_idfrags(w, fr, fq, idf0, idf1);
    for (int u = blockIdx.x; u < LRU_NCH * NBLK; u += F.G) {
        const int cg = u >> 4, n = u & 15;
        conv_unit(F, cg, n); VM_WAIT(); __syncthreads();
        LruW Wf, Wb; lru_load_w<0>(F, Wf, n, w, fr, fq); lru_load_w<1>(F, Wb, n, w, fr, fq);
        const bool c_first = (cg == 0 || cg == LRU_NCH_P), c_last = (cg == LRU_NCH_P - 1 || cg == LRU_NCH - 1);
        float Af = 1.f, Hf = 0.f, Ab = 1.f, Hb = 0.f;
        LruX X, Xn; lru_load_x(X, XC, cg * LRU_CH, n, fr, fq);
        for (int gi = 0; gi < 4; ++gi) {
            if (gi < 3) lru_load_x(Xn, XC, cg * LRU_CH + (gi + 1) * 64, n, fr, fq);
            float pf = 1.f, hf = 0.f, pb = 1.f, hb = 0.f;
#pragma unroll
            for (int tau = 0; tau < 4; ++tau) {
                f32x4 prf, pif, prb, pib, xct, xct2;
                lru_tile(X, tau, (w & 1) != 0, Wf, idf0, idf1, prf, pif, xct);
                lru_tile(X, tau, (w & 1) != 0, Wb, idf0, idf1, prb, pib, xct2);
#pragma unroll
                for (int j = 0; j < 4; ++j) {
                    float a, uu;
                    lru_gate(prf[j], pif[j], xct[j], Wf, c_first && gi == 0 && fq == 0 && tau == 0 && j == 0, a, uu); hf = a * hf + uu; pf *= a;
                    lru_gate(prb[j], pib[j], xct[j], Wb, c_last && gi == 3 && fq == 3 && tau == 3 && j == 3, a, uu); hb += pb * uu; pb *= a;
                }
            }
            float gPf = 1.f, gHf = 0.f, gPb = 1.f, gHb = 0.f;
#pragma unroll
            for (int qq = 0; qq < 4; ++qq) { const int src = fr + 16 * qq;
                float P = __shfl(pf, src), H = __shfl(hf, src); gHf = P * gHf + H; gPf *= P;
                P = __shfl(pb, src); H = __shfl(hb, src); gHb += gPb * H; gPb *= P; }
            Hf = gPf * Hf + gHf; Af *= gPf; Hb += Ab * gHb; Ab *= gPb;
            X = Xn;
        }
        if (fq == 0) { const int ch = n * BW + 16 * w + fr; SUMM[(size_t)(cg * 2 + 0) * LW + ch] = (f32x2){Af, Hf}; SUMM[(size_t)(cg * 2 + 1) * LW + ch] = (f32x2){Ab, Hb}; }
    }
}
__device__ __forceinline__ void lru_pass_b(Frame& F) {
    const int tid_ = opaque(F.tid);
    const int gt = blockIdx.x * NTHR + tid_; if (gt >= 4 * LW) return;
    const int ch = gt % LW, d = (gt / LW) & 1, seq = gt / (2 * LW), c0 = seq ? LRU_NCH_P : 0, nc = seq ? LRU_NCH - LRU_NCH_P : LRU_NCH_P;
    const f32x2* SUMM = wsp<f32x2>(F, WS_SUM); float* CIN = wsp<float>(F, WS_SUM + 4 * MiB);
    float s = 0.f;
    for (int i0 = 0; i0 < nc; i0 += 32) {
        f32x2 ah[32];
#pragma unroll
        for (int e = 0; e < 32; ++e) { const int cg = d ? c0 + nc - 1 - (i0 + e) : c0 + i0 + e; ah[e] = SUMM[(size_t)(cg * 2 + d) * LW + ch]; }
#pragma unroll
        for (int e = 0; e < 32; ++e) { const int cg = d ? c0 + nc - 1 - (i0 + e) : c0 + i0 + e; CIN[(size_t)(cg * 2 + d) * LW + ch] = s; s = ah[e].x * s + ah[e].y; }
    }
}
template <int LDBG = 0> __device__ __forceinline__ void lru_pass_c(Frame& F) {
    const int tid_ = opaque(F.tid);
    const int fr = F.lane & 15, fq = F.lane >> 4, w = F.wave;
    const bf16_t* XC = wsp<bf16_t>(F, WS_XC); const float* CIN = wsp<float>(F, WS_SUM + 4 * MiB);
    const bf16_t* GR = wsp<bf16_t>(F, WS_GR); bf16_t* LRU = wsp<bf16_t>(F, WS_XR);
    LAS bf16_t* hfb = (LAS bf16_t*)(F.lds + w * 8192);
    LAS bf16_t* grt = (LAS bf16_t*)(F.lds + 65536);
    bf16x8 idf0, idf1; lru_idfrags(w, fr, fq, idf0, idf1);
    for (int u = blockIdx.x; u < LRU_NCH * NBLK; u += F.G) {
        const int cg = u >> 4, n = u & 15, ch = n * BW + 16 * w + fr;
        const bool c_first = (cg == 0 || cg == LRU_NCH_P), c_last = (cg == LRU_NCH_P - 1 || cg == LRU_NCH - 1);
        { const bf16_t* gsrc = GR + (size_t)(cg * LRU_CH + (tid_ >> 4)) * LW + n * BW + (tid_ & 15) * 8; LAS bf16_t* ldst = grt + w * 512;
#pragma unroll 1
          for (int k = 0; k < 8; ++k) { __builtin_amdgcn_global_load_lds((const unsigned*)gsrc, (LAS unsigned*)ldst, 16, 0, 0); gsrc += (size_t)32 * LW; ldst += NTHR * 8; } }
        LruX X, Xn;
        {
            LruW W; lru_load_w<0>(F, W, n, w, fr, fq);
            float s = CIN[(size_t)(cg * 2 + 0) * LW + ch];
            lru_load_x(X, XC, cg * LRU_CH, n, fr, fq);
            for (int gi = 0; gi < 4; ++gi) {
                if (gi < 3 && LDBG != 2) lru_load_x(Xn, XC, cg * LRU_CH + (gi + 1) * 64, n, fr, fq);
                float a[16], uu[16];
#pragma unroll
                for (int tau = 0; tau < 4; ++tau) { f32x4 pr, pi, xct; lru_tile(X, tau, (w & 1) != 0, W, idf0, idf1, pr, pi, xct);
#pragma unroll
                    for (int j = 0; j < 4; ++j) lru_gate<LDBG>(pr[j], pi[j], xct[j], W, c_first && gi == 0 && fq == 0 && tau == 0 && j == 0, a[4 * tau + j], uu[4 * tau + j]); }
                float p = 1.f, h = 0.f;
#pragma unroll
                for (int t = 0; t < 16; ++t) { h = a[t] * h + uu[t]; p *= a[t]; }
                float hin = s, sg = s;
#pragma unroll
                for (int qq = 0; qq < 4; ++qq) { const float P = __shfl(p, fr + 16 * qq), H = __shfl(h, fr + 16 * qq); sg = P * sg + H; if (qq < fq) hin = P * hin + H; }
                s = sg;
                float hh = hin;
#pragma unroll
                for (int t = 0; t < 16; ++t) { hh = a[t] * hh + uu[t]; hfb[(gi * 64 + 16 * fq + t) * 16 + fr] = (bf16_t)f2bf(hh); }
                X = Xn;
            }
        }
        {
            LruW W; lru_load_w<1>(F, W, n, w, fr, fq);
            float s = CIN[(size_t)(cg * 2 + 1) * LW + ch];
            VM_WAIT(); __syncthreads();
            for (int gi = 3; gi >= 0; --gi) {
                if (gi > 0 && LDBG != 2) lru_load_x(Xn, XC, cg * LRU_CH + (gi - 1) * 64, n, fr, fq);
                float a[16], uu[16];
#pragma unroll
                for (int tau = 0; tau < 4; ++tau) { f32x4 pr, pi, xct; lru_tile(X, tau, (w & 1) != 0, W, idf0, idf1, pr, pi, xct);
#pragma unroll
                    for (int j = 0; j < 4; ++j) lru_gate<LDBG>(pr[j], pi[j], xct[j], W, c_last && gi == 3 && fq == 3 && tau == 3 && j == 3, a[4 * tau + j], uu[4 * tau + j]); }
                float p = 1.f, h = 0.f;
#pragma unroll
                for (int t = 15; t >= 0; --t) { h = a[t] * h + uu[t]; p *= a[t]; }
                float hin = s, sg = s;
#pragma unroll
                for (int qq = 3; qq >= 0; --qq) { const float P = __shfl(p, fr + 16 * qq), H = __shfl(h, fr + 16 * qq); sg = P * sg + H; if (qq > fq) hin = P * hin + H; }
                s = sg;
                float hh = hin;
#pragma unroll
                for (int t = 15; t >= 0; --t) { hh = a[t] * hh + uu[t];
                    const int tl = gi * 64 + 16 * fq + t; LAS bf16_t* gp = grt + tl * BW + 16 * w + fr;
                    *gp = (bf16_t)f2bf((bf1(hfb[tl * 16 + fr]) + hh) * gelu_tanh(bf1(*gp))); }
                X = Xn;
            }
        }
        LDS_WAIT(); __syncthreads();
        { bf16_t* gdst = LRU + (size_t)(cg * LRU_CH + (tid_ >> 4)) * LW + n * BW + (tid_ & 15) * 8; const LAS bf16_t* lsrc = grt + tid_ * 8;
#pragma unroll 1
          for (int k = 0; k < 8; ++k) { *(u32x4*)gdst = *(const LAS u32x4*)lsrc; gdst += (size_t)32 * LW; lsrc += NTHR * 8; } }
        LDS_WAIT(); __syncthreads();
    }
}

constexpr int HQW_EARLY = 96 * (D / 32);
__device__ __forceinline__ void hq_wtiles(Frame& F, int lo, int hi, int first, int stride) {
    const int lane = opaque(F.tid) & 63;
    LAS float* scr = (LAS float*)(F.lds + F.wave * 8448);
    for (int it = lo + first; it < hi; it += stride)
        had_tile_quant(F.in_WFD, D, DFF, 64 * (it / (D / 32)), 32 * (it % (D / 32)), wsp<signed char>(F, WS_WD), (const unsigned*)(F.ws + WS_AM), wsp<float>(F, WS_CS) + CS_D, scr, lane);
}
__device__ __forceinline__ void hq_phase(Frame& F) {
    const int lane = opaque(F.tid) & 63;
    const bf16_t* H0 = (const bf16_t*)F.out; const bf16_t* H1 = wsp<bf16_t>(F, WS_HIDS);
    signed char* Q0 = wsp<signed char>(F, WS_H8P); signed char* Q1 = wsp<signed char>(F, WS_H8S); float* RS3 = wsp<float>(F, WS_RS3);
    hq_wtiles(F, HQW_EARLY, (DFF / 64) * (D / 32), F.gw, F.ngw);
    constexpr int NB = DFF / 32;
    for (int m = F.gw; m < L; m += F.ngw) {
        const bf16_t* src = m < LP ? H0 + (size_t)m * DFF : H1 + (size_t)(m - LP) * DFF;
        signed char* dst = m < LP ? Q0 + (size_t)m * DFF : Q1 + (size_t)(m - LP) * DFF;
        u32x4 raw[6][4];
#pragma unroll
        for (int it = 0; it < 6; ++it) { const int b = lane + 64 * it; const u32x4* p = (const u32x4*)(src + (b < NB ? b : lane) * 32);
#pragma unroll
            for (int i = 0; i < 4; ++i) raw[it][i] = p[i]; }
        float mx = 0.f;
#pragma unroll
        for (int it = 0; it < 6; ++it) { float v[32];
#pragma unroll
            for (int i = 0; i < 4; ++i) { const u32x4 u = raw[it][i]; v[8 * i + 0] = bflo(u.x); v[8 * i + 1] = bfhi(u.x); v[8 * i + 2] = bflo(u.y); v[8 * i + 3] = bfhi(u.y); v[8 * i + 4] = bflo(u.z); v[8 * i + 5] = bfhi(u.z); v[8 * i + 6] = bflo(u.w); v[8 * i + 7] = bfhi(u.w); }
            fwht32(v);
            float bm = 0.f;
#pragma unroll
            for (int i = 0; i < 32; ++i) bm = fmaxf(bm, fabsf(v[i]));
            mx = fmaxf(mx, (lane + 64 * it < NB) ? bm : 0.f); }
        const float amax = fmaxf(wave_max(mx), 1e-20f), inv = 127.0f / amax;
        if (lane == 0) RS3[m] = amax * (1.0f / 127.0f);
#pragma unroll
        for (int it = 0; it < 6; ++it) { const int b = lane + 64 * it; float v[32];
#pragma unroll
            for (int i = 0; i < 4; ++i) { const u32x4 u = raw[it][i]; v[8 * i + 0] = bflo(u.x); v[8 * i + 1] = bfhi(u.x); v[8 * i + 2] = bflo(u.y); v[8 * i + 3] = bfhi(u.y); v[8 * i + 4] = bflo(u.z); v[8 * i + 5] = bfhi(u.z); v[8 * i + 6] = bflo(u.w); v[8 * i + 7] = bfhi(u.w); }
            fwht32(v);
            u32x4 o0, o1;
            o0.x = pk4_i8(rintf(v[0] * inv), rintf(v[1] * inv), rintf(v[2] * inv), rintf(v[3] * inv)); o0.y = pk4_i8(rintf(v[4] * inv), rintf(v[5] * inv), rintf(v[6] * inv), rintf(v[7] * inv));
            o0.z = pk4_i8(rintf(v[8] * inv), rintf(v[9] * inv), rintf(v[10] * inv), rintf(v[11] * inv)); o0.w = pk4_i8(rintf(v[12] * inv), rintf(v[13] * inv), rintf(v[14] * inv), rintf(v[15] * inv));
            o1.x = pk4_i8(rintf(v[16] * inv), rintf(v[17] * inv), rintf(v[18] * inv), rintf(v[19] * inv)); o1.y = pk4_i8(rintf(v[20] * inv), rintf(v[21] * inv), rintf(v[22] * inv), rintf(v[23] * inv));
            o1.z = pk4_i8(rintf(v[24] * inv), rintf(v[25] * inv), rintf(v[26] * inv), rintf(v[27] * inv)); o1.w = pk4_i8(rintf(v[28] * inv), rintf(v[29] * inv), rintf(v[30] * inv), rintf(v[31] * inv));
            if (b < NB) { *(u32x4*)(dst + b * 32) = o0; *(u32x4*)(dst + b * 32 + 16) = o1; } }
    }
}

__device__ __forceinline__ f32x4 up4(const u32x2 u) { return (f32x4){bflo(u.x), bfhi(u.x), bflo(u.y), bfhi(u.y)}; }
__device__ __forceinline__ void mid_phase(Frame& F) {
    const int tid_ = opaque(F.tid);
    bf16_t* MIX = wsp<bf16_t>(F, WS_MIX); signed char* XN8 = wsp<signed char>(F, WS_XN8); float* RS2 = wsp<float>(F, WS_RS2);
    LAS f32x4* gpost = (LAS f32x4*)F.lds; LAS f32x4* gpre = gpost + D / 4;
    for (int i = tid_; i < D / 4; i += NTHR) { gpost[i] = ((const f32x4*)F.in_GMPOST)[i]; gpre[i] = ((const f32x4*)F.in_GFPRE)[i]; }
    __syncthreads();
    for (int m = F.gw; m < L; m += F.ngw) {
        asm volatile("" ::: "memory");
        const f32x4* xr = (const f32x4*)xrow(F, m) + F.lane; const u32x2* mr = (const u32x2*)(MIX + (size_t)m * D) + F.lane;
        f32x4 v[16]; u32x2 mx[16]; float s = 0.f;
#pragma unroll
        for (int j = 0; j < 16; ++j) { v[j] = xr[64 * j]; mx[j] = mr[64 * j]; const f32x4 a = up4(mx[j]); s += (a.x * a.x + a.y * a.y) + (a.z * a.z + a.w * a.w); }
        const float rstd1 = 1.0f / sqrtf(wave_sum(s) * (1.0f / D) + EPS);
        float s2 = 0.f;
#pragma unroll
        for (int j = 0; j < 16; ++j) { v[j] = v[j] + up4(mx[j]) * rstd1 * gpost[F.lane + 64 * j]; s2 += (v[j].x * v[j].x + v[j].y * v[j].y) + (v[j].z * v[j].z + v[j].w * v[j].w); }
        const float rstd2 = 1.0f / sqrtf(wave_sum(s2) * (1.0f / D) + EPS);
        { u32x2* xw = (u32x2*)(MIX + (size_t)m * D) + F.lane;
#pragma unroll
          for (int j = 0; j < 16; ++j) xw[64 * j] = (u32x2){pk2(v[j].x, v[j].y), pk2(v[j].z, v[j].w)}; }
        float mx2 = 0.f;
#pragma unroll
        for (int j = 0; j < 16; ++j) { v[j] = v[j] * rstd2 * gpre[F.lane + 64 * j]; mx2 = fmaxf(fmaxf(mx2, fmaxf(fabsf(v[j].x), fabsf(v[j].y))), fmaxf(fabsf(v[j].z), fabsf(v[j].w))); }
        const float amax = fmaxf(wave_max(mx2), 1e-20f), inv = 127.0f / amax;
        if (F.lane == 0) RS2[m] = amax * (1.0f / 127.0f);
        unsigned* o4 = (unsigned*)(XN8 + (size_t)m * D) + F.lane;
#pragma unroll
        for (int j = 0; j < 16; ++j) o4[64 * j] = pk4_i8(rintf(v[j].x * inv), rintf(v[j].y * inv), rintf(v[j].z * inv), rintf(v[j].w * inv));
    }
    __syncthreads();
}
__device__ __forceinline__ void final_phase(Frame& F) {
    const int tid_ = opaque(F.tid);
    const bf16_t* X1 = wsp<bf16_t>(F, WS_MIX); const bf16_t* FB = wsp<bf16_t>(F, WS_F);
    LAS f32x4* gfp = (LAS f32x4*)F.lds;
    for (int i = tid_; i < D / 4; i += NTHR) gfp[i] = ((const f32x4*)F.in_GFPOST)[i];
    __syncthreads();
    for (int m = F.gw; m < L; m += F.ngw) {
        asm volatile("" ::: "memory");
        const u32x2* mr = (const u32x2*)(X1 + (size_t)m * D) + F.lane; const u32x2* fr = (const u32x2*)(FB + (size_t)m * D) + F.lane;
        u32x2 fx[16], x1[16]; float s = 0.f;
#pragma unroll
        for (int j = 0; j < 16; ++j) { fx[j] = fr[64 * j]; x1[j] = mr[64 * j]; const f32x4 a = up4(fx[j]); s += (a.x * a.x + a.y * a.y) + (a.z * a.z + a.w * a.w); }
        const float rstd3 = 1.0f / sqrtf(wave_sum(s) * (1.0f / D) + EPS);
        f32x4* o = (f32x4*)(F.out + (size_t)m * D) + F.lane;
#pragma unroll
        for (int j = 0; j < 16; ++j) o[64 * j] = up4(x1[j]) + up4(fx[j]) * rstd3 * gfp[F.lane + 64 * j];
    }
}

constexpr int LDS_STAGE = pg8::STAGE_BYTES;
constexpr int LDS_MISC = LDS_STAGE;
constexpr int LDS_BYTES = LDS_STAGE + 1024;
#ifndef MK_N_LAUNCHES
#define MK_N_LAUNCHES 1
#endif
constexpr int NPHASE = 12;
struct Args { const float* in[23]; float* out; unsigned char* ws; int ph_lo, ph_hi; };

__global__ void __launch_bounds__(NTHR, 2) fwd_kernel(Args args) {
    extern __shared__ __attribute__((aligned(16))) unsigned char lds_raw[];
    Frame F;
    F.lds = (LAS unsigned char*)lds_raw;
    F.tid = threadIdx.x; F.lane = (int)__builtin_amdgcn_mbcnt_hi(~0u, __builtin_amdgcn_mbcnt_lo(~0u, 0u)); F.wave = __builtin_amdgcn_readfirstlane(F.tid >> 6);
    F.G = gridDim.x; F.gw = blockIdx.x * NWAVES + F.wave; F.ngw = F.G * NWAVES;
    F.in_XP = args.in[0]; F.in_XS = args.in[1]; F.in_WIN = args.in[2]; F.in_WCONV = args.in[3]; F.in_BCONV = args.in[4]; F.in_WR = args.in[5]; F.in_BR = args.in[6]; F.in_WI = args.in[7]; F.in_BI = args.in[8]; F.in_LAM = args.in[9]; F.in_RPB = args.in[10]; F.in_WNO = args.in[11]; F.in_WLO = args.in[12]; F.in_WM = args.in[13]; F.in_BM = args.in[14]; F.in_WOUT = args.in[15]; F.in_GMPRE = args.in[16]; F.in_GMPOST = args.in[17]; F.in_GFPRE = args.in[18]; F.in_GFPOST = args.in[19]; F.in_WFG = args.in[20]; F.in_WFU = args.in[21]; F.in_WFD = args.in[22];
    F.out = args.out; F.ws = args.ws;
    volatile LAS unsigned* MISC = (volatile LAS unsigned*)(F.lds + LDS_MISC);
    if (F.tid < 256) MISC[F.tid] = 0u;
    __syncthreads();
    const int lo = args.ph_lo, hi = args.ph_hi;
    const bool fused = (hi - lo) > 1;
    XcdBarrier bar; bar.bar = (unsigned*)(F.ws + WS_CTL); bar.x = 0; bar.st = nullptr;
    if (fused) bar = xcd_barrier_post((unsigned*)(F.ws + WS_CTL), MISC + 8);
#ifndef PH_MASK
#define PH_MASK 0xfff
#endif
#define IN(k) (((PH_MASK >> (k)) & 1) && lo <= (k) && (k) < hi)
#define SEAM(k) do { if (IN(k) && IN((k) + 1)) xcd_barrier(bar); } while (0)
    LAS unsigned char* stage = F.lds;

#ifdef ATTN_OUT_OFF
#define NA_BUF ((size_t)ATTN_OUT_OFF * MiB)
#else
#define NA_BUF WS_Q
#endif
#ifndef DUP_MASK
#define DUP_MASK 0
#endif
#define RUN(k, ...) if (IN(k)) { __VA_ARGS__ if (((DUP_MASK) >> (k)) & 1) { __VA_ARGS__ } }
    RUN(0, { p0_prologue(F); }) SEAM(0);
    RUN(1, {
        { pg8::Gemm g{wsp<bf16_t>(F, WS_XN8), wsp<bf16_t>(F, WS_XN8), 1 << 30, wsp<bf16_t>(F, WS_W8), L, 2 * NAW + 2 * D, D}; pg8::StaticOrder S; S.init(L, 2 * NAW + 2 * D, F.G, (int)blockIdx.x);
          pg8::EpiProjQ E{wsp<bf16_t>(F, WS_Q), wsp<bf16_t>(F, WS_K), (bf16_t*)F.out, F.in_BM, wsp<float>(F, WS_RS1), wsp<float>(F, WS_CS) + CS_QKM};
          pg8::gemm_phase<pg8::EpiProjQ, pg8::StaticOrder, true, true, 2>(stage, g, S, E); }
        { pg8::Gemm g{wsp<bf16_t>(F, WS_XN), wsp<bf16_t>(F, WS_XN), 1 << 30, wsp<bf16_t>(F, WS_WCAT), L, 2 * NAW, 2 * D}; pg8::StaticOrder S; S.init(L, 2 * NAW, F.G, (int)blockIdx.x);
          pg8::EpiProj E{wsp<bf16_t>(F, WS_XR), wsp<bf16_t>(F, WS_GR), wsp<bf16_t>(F, WS_GR), wsp<bf16_t>(F, WS_GR), (bf16_t*)F.out, F.in_BM, 1 << 30};
          pg8::gemm_phase<pg8::EpiProj, pg8::StaticOrder, true, true, 0>(stage, g, S, E); }
        { pg8::Gemm g{wsp<bf16_t>(F, WS_WVT), wsp<bf16_t>(F, WS_WVT), 1 << 30, wsp<bf16_t>(F, WS_XN8), NAW, L, D}; pg8::StaticOrder S; S.init(NAW, L, F.G, (int)blockIdx.x);
          pg8::EpiVTQ E{wsp<bf16_t>(F, WS_VT), wsp<float>(F, WS_CS) + CS_V, wsp<float>(F, WS_RS1)};
          pg8::gemm_phase<pg8::EpiVTQ, pg8::StaticOrder, true, true, 2>(stage, g, S, E); }
    }) SEAM(1);
    RUN(2, { lru_pass_a(F); }) SEAM(2);
    #ifdef ATTN_OUT_OFF
    if (IN(3)) { lru_pass_b(F); } SEAM(3);
    if (IN(4)) { lru_pass_c<0>(F); xcd_barrier(bar); if (ATTN_DUP) attn_mfma<ATTN_DUP - 1>(F); attn_mfma<0>(F); } SEAM(4);
#else
    if (IN(3)) { lru_pass_b(F); attn_mfma_lds(F); } SEAM(3);
#ifdef LRUC_DBG
    if (IN(4)) { lru_pass_c<LRUC_DBG>(F); lru_pass_c<0>(F); } SEAM(4);
#else
    RUN(4, { lru_pass_c<0>(F); }) SEAM(4);
#endif
#endif
    if (IN(5)) {
        { pg8::Gemm g{wsp<bf16_t>(F, NA_BUF), wsp<bf16_t>(F, NA_BUF), 1 << 30, wsp<bf16_t>(F, WS_WNO), L, D, 2 * NAW}; pg8::StaticOrder S; S.init(L, D, F.G, (int)blockIdx.x);
          pg8::EpiMulG<false> E{wsp<bf16_t>(F, WS_T1), (const bf16_t*)F.out, 0};
          pg8::gemm_phase<pg8::EpiMulG<false>, pg8::StaticOrder, true, true>(stage, g, S, E); }
        { pg8::Gemm g{wsp<bf16_t>(F, WS_XR), wsp<bf16_t>(F, WS_XR), 1 << 30, wsp<bf16_t>(F, WS_WLO), L, D, 2 * LW}; pg8::StaticOrder S; S.init(L, D, F.G, (int)blockIdx.x);
          pg8::EpiMulG<true> E{wsp<bf16_t>(F, WS_T1), (const bf16_t*)F.out, D};
          pg8::gemm_phase<pg8::EpiMulG<true>, pg8::StaticOrder, true, true>(stage, g, S, E); }
    } SEAM(5);
    RUN(6, {
        pg8::Gemm g{wsp<bf16_t>(F, WS_T1), wsp<bf16_t>(F, WS_T1), 1 << 30, wsp<bf16_t>(F, WS_WO), L, D, 2 * D}; pg8::StaticOrder S; S.init(L, D, F.G, (int)blockIdx.x);
        pg8::EpiPlain E{wsp<bf16_t>(F, WS_MIX), D};
        pg8::gemm_phase<pg8::EpiPlain, pg8::StaticOrder, true, true>(stage, g, S, E);
    }) SEAM(6);
    RUN(7, { mid_phase(F); }) SEAM(7);
    RUN(8, {
        pg8::Gemm g{wsp<bf16_t>(F, WS_XN8), wsp<bf16_t>(F, WS_XN8), 1 << 30, wsp<bf16_t>(F, WS_WGU), L, 2 * DFF, D}; pg8::StaticOrder S; S.init(L, 2 * DFF, F.G, (int)blockIdx.x);
        pg8::EpiSwigluQ E{(bf16_t*)F.out, wsp<bf16_t>(F, WS_HIDS), LP / 256, wsp<float>(F, WS_RS2), wsp<float>(F, WS_CS) + CS_GU};
        pg8::gemm_phase<pg8::EpiSwigluQ, pg8::StaticOrder, false, true, 2>(stage, g, S, E);
        { const int rem = S.nwg % F.G;
          if ((int)blockIdx.x >= rem) hq_wtiles(F, 0, HQW_EARLY, ((int)blockIdx.x - rem) * NWAVES + F.wave, (F.G - rem) * NWAVES); }
    }) SEAM(8);
    RUN(9, { hq_phase(F); }) SEAM(9);
    RUN(10, {
        pg8::Gemm g{wsp<bf16_t>(F, WS_H8P), wsp<bf16_t>(F, WS_H8S), LP / 256, wsp<bf16_t>(F, WS_WD), L, D, DFF}; pg8::StaticOrder S; S.init(L, D, F.G, (int)blockIdx.x);
        pg8::EpiPlainQ E{wsp<bf16_t>(F, WS_F), D, wsp<float>(F, WS_RS3), wsp<float>(F, WS_CS) + CS_D};
        pg8::gemm_phase<pg8::EpiPlainQ, pg8::StaticOrder, true, true, 2>(stage, g, S, E);
    }) SEAM(10);
    RUN(11, { final_phase(F); })
#undef RUN
#undef IN
#undef SEAM
}

extern "C" void kernel_launch(void* const* d_in, const int* in_sizes, int n_in, void* d_out, int out_size, void* d_ws, size_t ws_size, hipStream_t stream) {
    static int grid = 0;
    if (grid == 0) {
        if (n_in != 23 || in_sizes[0] != LP * D || in_sizes[1] != LS * D || out_size != L * D || ws_size < WS_END) {
            fprintf(stderr, "kernel_launch: unexpected shapes: n_in %d in0 %d out %d ws %zu (need %zu)\n", n_in, n_in > 0 ? in_sizes[0] : -1, out_size, ws_size, (size_t)WS_END); grid = -1; return; }
        int dev = 0, cus = 0, per_cu = 0;
        if (hipGetDevice(&dev) != hipSuccess || hipDeviceGetAttribute(&cus, hipDeviceAttributeMultiprocessorCount, dev) != hipSuccess) { grid = -1; return; }
        if (hipFuncSetAttribute((const void*)fwd_kernel, hipFuncAttributeMaxDynamicSharedMemorySize, LDS_BYTES) != hipSuccess) { fprintf(stderr, "kernel_launch: hipFuncSetAttribute failed\n"); grid = -1; return; }
        if (hipOccupancyMaxActiveBlocksPerMultiprocessor(&per_cu, (const void*)fwd_kernel, NTHR, LDS_BYTES) != hipSuccess || per_cu < 1) { fprintf(stderr, "kernel_launch: occupancy query says %d\n", per_cu); }
        (void)hipGetLastError();
        grid = cus;
    }
    if (grid < 0) return;
    (void)hipMemsetAsync((char*)d_ws + WS_CTL, 0, CTL_ZERO_BYTES, stream);
#ifdef DBG_ZERO_ALL
    (void)hipMemsetAsync((char*)d_ws, 0, WS_END, stream); (void)hipMemsetAsync((char*)d_out, 0, (size_t)L * D * 4, stream);
#endif
    Args a{};
    for (int i = 0; i < 23; ++i) a.in[i] = (const float*)d_in[i];
    a.out = (float*)d_out; a.ws = (unsigned char*)d_ws;
#if MK_N_LAUNCHES == 1
    a.ph_lo = 0; a.ph_hi = NPHASE;
    hipLaunchKernelGGL(fwd_kernel, dim3(grid), dim3(NTHR), LDS_BYTES, stream, a);
#else
    for (int p = 0; p < NPHASE; ++p) {
#ifdef DBG_PH_MASK
        if (!((DBG_PH_MASK >> p) & 1)) continue;
#endif
        a.ph_lo = p; a.ph_hi = p + 1; hipLaunchKernelGGL(fwd_kernel, dim3(grid), dim3(NTHR), LDS_BYTES, stream, a); }
#endif
}
```

```cpp
#include <hip/hip_runtime.h>
#include <cstdio>
#include <cstdint>

#define LAS __attribute__((address_space(3)))
typedef unsigned short bf16_t;
typedef short bf16x8 __attribute__((ext_vector_type(8)));
typedef float f32x4 __attribute__((ext_vector_type(4)));
typedef float f32x2 __attribute__((ext_vector_type(2)));
typedef unsigned u32x4 __attribute__((ext_vector_type(4)));
typedef unsigned u32x2 __attribute__((ext_vector_type(2)));

constexpr int D = 4096, LP = 16384, LS = 8192, L = LP + LS;
constexpr int GRIDW = 64, HD = 128, NH = 16, NAW = 2048, LW = 2048, NBLK = 16, BW = 128, DFF = 11008, INW = 10240;
constexpr float EPS = 1e-6f;
constexpr int NWAVES = 8, NTHR = 512;

constexpr size_t MiB = 1u << 20;
constexpr size_t WS_CTL = 0, CTL_ZERO_BYTES = 64 * 1024;
constexpr size_t WS_AM = 32 * 1024;
constexpr size_t WS_RSTD = 1 * MiB;
constexpr size_t WS_RS1 = 1 * MiB + 128 * 1024;
constexpr size_t WS_RS2 = 1 * MiB + 256 * 1024;
constexpr size_t WS_CS = 1 * MiB + 384 * 1024;
constexpr size_t WS_SUM = 2 * MiB;
constexpr size_t WS_WCAT = 8 * MiB;
constexpr size_t WS_W8 = 40 * MiB;
constexpr size_t WS_WVT = 88 * MiB;
constexpr size_t WS_XN8 = 96 * MiB;
constexpr size_t WS_WNO = 192 * MiB;
constexpr size_t WS_WLO = 208 * MiB;
constexpr size_t WS_WO = 224 * MiB;
constexpr size_t WS_WGU = 256 * MiB;
constexpr size_t WS_WD = 342 * MiB;
constexpr size_t WS_WG = 428 * MiB;
constexpr size_t WS_XN = 430 * MiB;
constexpr size_t WS_Q = 622 * MiB;
constexpr size_t WS_XR = 718 * MiB;
constexpr size_t WS_K = 814 * MiB;
constexpr size_t WS_VT = 910 * MiB;
constexpr size_t WS_GR = 1006 * MiB;
constexpr size_t WS_XC = 1102 * MiB;
constexpr size_t WS_END = 1198 * MiB;
constexpr int CS_QKM = 0, CS_V = 12288, CS_GU = 12288 + 2048, CS_D = 12288 + 2048 + 22016;
constexpr size_t WS_RS3 = 1 * MiB + 640 * 1024;
constexpr size_t WS_H8P = WS_XN, WS_H8S = WS_XN8;
constexpr size_t WS_T1 = WS_K;
constexpr size_t WS_MIX = WS_GR;
constexpr size_t WS_HIDS = WS_Q;
constexpr size_t WS_F = WS_K;
constexpr size_t WS_HF = WS_K;

#define LDS_WAIT() asm volatile("s_waitcnt lgkmcnt(0)" ::: "memory")
#define VM_WAIT() asm volatile("s_waitcnt vmcnt(0)" ::: "memory")
typedef __bf16 bf16x2n_t __attribute__((ext_vector_type(2)));
__device__ __forceinline__ unsigned pk2(float lo, float hi) { const bf16x2n_t r = __builtin_convertvector((f32x2){lo, hi}, bf16x2n_t); return __builtin_bit_cast(unsigned, r); }
__device__ __forceinline__ unsigned f2bf(float f) { return pk2(f, 0.f) & 0xffffu; }
__device__ __forceinline__ float bflo(unsigned u) { return __builtin_bit_cast(float, u << 16); }
__device__ __forceinline__ float bfhi(unsigned u) { return __builtin_bit_cast(float, u & 0xffff0000u); }
__device__ __forceinline__ float bf1(bf16_t u) { return __builtin_bit_cast(float, (unsigned)u << 16); }
__device__ __forceinline__ float wave_sum(float v) {
#pragma unroll
    for (int o = 1; o < 64; o <<= 1) v += __shfl_xor(v, o);
    return v;
}
__device__ __forceinline__ float wave_max(float v) {
#pragma unroll
    for (int o = 1; o < 64; o <<= 1) v = fmaxf(v, __shfl_xor(v, o));
    return v;
}
__device__ __forceinline__ float sigmoidf_(float v) { return __builtin_amdgcn_rcpf(1.0f + __expf(-v)); }
__device__ __forceinline__ float gelu_tanh(float v) { const float y = 0.7978845608f * (v + 0.044715f * v * v * v); const float e = __expf(2.0f * y); return 0.5f * v * (2.0f - 2.0f * __builtin_amdgcn_rcpf(e + 1.0f)); }

namespace pg8 {
constexpr int BM = 256, BK = 64, HALF = 128, HTB = HALF * BK * 2  , STAGE_BYTES = 8 * HTB, NXCD = 8, WGM = 4;

__host__ __device__ __forceinline__ int lds_byte(int r, int c) { return (r >> 3) * 1024 + (r & 7) * 128 + ((((c >> 3) ^ r) & 7) << 4) + (c & 7) * 2; }
__host__ __device__ __forceinline__ void stage_rc(int b, int& R, int& C) { const int ch = b >> 10, rr = (b >> 7) & 7, slot = (b >> 4) & 7; R = ch * 8 + rr; C = ((slot ^ rr) & 7) * 8; }
__host__ __device__ __forceinline__ int perm32(int rho) { const int n = rho >> 4, i = rho & 15; return 8 * (i >> 2) + 4 * n + (i & 3); }

struct Unit { int pm, pn; };
struct Gemm {
    const bf16_t* A; const bf16_t* A2; int pm_split; const bf16_t* Bt; int M, N, rb;
    __device__ __forceinline__ const char* abase(int pm) const { const size_t t = (size_t)BM * rb; return pm < pm_split ? (const char*)A + (size_t)pm * t : (const char*)A2 + (size_t)(pm - pm_split) * t; }
    __device__ __forceinline__ const char* bbase(int pn) const { return (const char*)Bt + (size_t)pn * BM * rb; }
};

struct StaticOrder {
    int nM, nN, nwg, G, c;
    __host__ __device__ void init(int M, int N, int G_, int c_) { nM = M / BM; nN = N / BM; nwg = nM * nN; G = G_; c = c_; }
    __host__ __device__ bool next(int i, Unit& u) const {
        const long Lx = (long)i * G + c; if (Lx >= nwg) return false;
        int wgid = (int)Lx; { const int q = nwg / NXCD, r = nwg % NXCD, xcd = wgid % NXCD, off = wgid / NXCD; wgid = (xcd < r ? xcd * (q + 1) : r * (q + 1) + (xcd - r) * q) + off; }
        const int nig = WGM * nN, gid = wgid / nig, fm = gid * WGM, gsz = (nM - fm) < WGM ? (nM - fm) : WGM;
        u.pm = fm + ((wgid % nig) % gsz); u.pn = (wgid % nig) / gsz; return true;
    }
    __device__ __forceinline__ void a_ready(const Unit&) const {}
    __device__ __forceinline__ void done(const Unit&) const {}
};

typedef int v8i32 __attribute__((ext_vector_type(8)));
typedef int v4i32 __attribute__((ext_vector_type(4)));
typedef __bf16 bf16x2_t __attribute__((ext_vector_type(2)));
__device__ __forceinline__ unsigned cvt_pk_bf16(float lo, float hi) { const bf16x2_t r = __builtin_convertvector((f32x2){lo, hi}, bf16x2_t); return __builtin_bit_cast(unsigned, r); }
__device__ __forceinline__ u32x4 pack8(const f32x4 v0, const f32x4 v1) { u32x4 w; w.x = cvt_pk_bf16(v0[0], v0[1]); w.y = cvt_pk_bf16(v0[2], v0[3]); w.z = cvt_pk_bf16(v1[0], v1[1]); w.w = cvt_pk_bf16(v1[2], v1[3]); return w; }
__device__ __forceinline__ void unpack8(const u32x4 w, f32x4& v0, f32x4& v1) { v0 = (f32x4){bflo(w.x), bfhi(w.x), bflo(w.y), bfhi(w.y)}; v1 = (f32x4){bflo(w.z), bfhi(w.z), bflo(w.w), bfhi(w.w)}; }
__device__ __forceinline__ f32x4 sig4(const f32x4 v) { f32x4 r; r[0] = sigmoidf_(v[0]); r[1] = sigmoidf_(v[1]); r[2] = sigmoidf_(v[2]); r[3] = sigmoidf_(v[3]); return r; }

struct EpiPlain {
    static constexpr bool PERM = true, AFTER_DRAIN = false;
    bf16_t* O; int ldc;
    __device__ __forceinline__ void operator()(const f32x4 (&acc)[2][2][4][2], const Unit& u, int wr, int wc, int fr, int fq) const {
        const int row0 = u.pm * BM + wr * 64 + fr, col0 = u.pn * BM + wc * 32 + 8 * fq;
#pragma unroll
        for (int ai = 0; ai < 2; ++ai)
#pragma unroll
            for (int m = 0; m < 4; ++m) { bf16_t* rowp = O + (size_t)(row0 + ai * HALF + m * 16) * ldc + col0;
#pragma unroll
                for (int bj = 0; bj < 2; ++bj) *(u32x4*)(rowp + bj * HALF) = pack8(acc[ai][bj][m][0], acc[ai][bj][m][1]); }
    }
};
struct EpiVT {
    static constexpr bool PERM = true, AFTER_DRAIN = false;
    bf16_t* O;
    __device__ __forceinline__ void operator()(const f32x4 (&acc)[2][2][4][2], const Unit& u, int wr, int wc, int fr, int fq) const {
        const int row0 = u.pm * BM + wr * 64 + fr, col0 = u.pn * BM + wc * 32 + 8 * fq;
#pragma unroll
        for (int ai = 0; ai < 2; ++ai)
#pragma unroll
            for (int m = 0; m < 4; ++m) { const int row = row0 + ai * HALF + m * 16, hh = row >> 7, d = row & 127;
                const int dt = 2 * (d >> 5) + ((d >> 2) & 1), i = 4 * ((d >> 3) & 3) + (d & 3);
#pragma unroll
                for (int bj = 0; bj < 2; ++bj) { const int tok = col0 + bj * HALF, R = tok >> 6, o = (tok & 63) >> 3;
                    *(u32x4*)(O + ((size_t)((((R * 16 + hh) * 8 + dt) * 8 + o) * 16 + i)) * 8) = pack8(acc[ai][bj][m][0], acc[ai][bj][m][1]); } }
    }
};
struct EpiProj {
    static constexpr bool PERM = true, AFTER_DRAIN = false;
    bf16_t* P0; bf16_t* P1; bf16_t* P2; bf16_t* P3; bf16_t* G; const float* bias; int pn_gate0;
    __device__ __forceinline__ void operator()(const f32x4 (&acc)[2][2][4][2], const Unit& u, int wr, int wc, int fr, int fq) const {
        const int row0 = u.pm * BM + wr * 64 + fr;
        if (u.pn < pn_gate0) {
            const int t = u.pn >> 3; bf16_t* base = t == 0 ? P0 : (t == 1 ? P1 : (t == 2 ? P2 : P3));
            const int col0 = (u.pn & 7) * BM + wc * 32 + 8 * fq;
            if (t == 2) {
#pragma unroll
                for (int ai = 0; ai < 2; ++ai)
#pragma unroll
                    for (int m = 0; m < 4; ++m) { const int tok = row0 + ai * HALF + m * 16, R = tok >> 6, cl = tok & 63;
                        const int tokpart = (((cl >> 2) & 1) * 8 + (cl >> 3)) * 4 + (cl & 3);
#pragma unroll
                        for (int bj = 0; bj < 2; ++bj) { const int c = col0 + bj * HALF, hh = c >> 7, d0 = c & 127;
                            *(u32x4*)(base + ((size_t)(((R * 16 + hh) * 4 + (d0 >> 5)) * 64 + tokpart) * 4 + ((d0 >> 3) & 3)) * 8) = pack8(acc[ai][bj][m][0], acc[ai][bj][m][1]); } }
            } else {
#pragma unroll
            for (int ai = 0; ai < 2; ++ai)
#pragma unroll
                for (int m = 0; m < 4; ++m) { bf16_t* rowp = base + (size_t)(row0 + ai * HALF + m * 16) * NAW + col0;
#pragma unroll
                    for (int bj = 0; bj < 2; ++bj) *(u32x4*)(rowp + bj * HALF) = pack8(acc[ai][bj][m][0], acc[ai][bj][m][1]); }
            }
        } else {
            const int col0 = (u.pn - pn_gate0) * BM + wc * 32 + 8 * fq;
            f32x4 bv[2][2];
#pragma unroll
            for (int bj = 0; bj < 2; ++bj)
#pragma unroll
                for (int n = 0; n < 2; ++n) bv[bj][n] = *(const f32x4*)(bias + col0 + bj * HALF + 4 * n);
#pragma unroll
            for (int ai = 0; ai < 2; ++ai)
#pragma unroll
                for (int m = 0; m < 4; ++m) { bf16_t* rowp = G + (size_t)(row0 + ai * HALF + m * 16) * (2 * D) + col0;
#pragma unroll
                    for (int bj = 0; bj < 2; ++bj) *(u32x4*)(rowp + bj * HALF) = pack8(sig4(acc[ai][bj][m][0] + bv[bj][0]), sig4(acc[ai][bj][m][1] + bv[bj][1])); }
        }
    }
};
template <bool ADD> struct EpiMulG {
    static constexpr bool PERM = true, AFTER_DRAIN = false;
    bf16_t* O; const bf16_t* G; int goff;
    __device__ __forceinline__ void operator()(const f32x4 (&acc)[2][2][4][2], const Unit& u, int wr, int wc, int fr, int fq) const {
        const int row0 = u.pm * BM + wr * 64 + fr, col0 = u.pn * BM + wc * 32 + 8 * fq;
#pragma unroll
        for (int ai = 0; ai < 2; ++ai)
#pragma unroll
            for (int m = 0; m < 4; ++m) { const size_t row = (size_t)(row0 + ai * HALF + m * 16); bf16_t* rowp = O + row * D + col0; const bf16_t* gp = G + row * (2 * D) + goff + col0;
#pragma unroll
                for (int bj = 0; bj < 2; ++bj) {
                    f32x4 g0, g1; unpack8(*(const u32x4*)(gp + bj * HALF), g0, g1);
                    f32x4 v0 = acc[ai][bj][m][0] * g0, v1 = acc[ai][bj][m][1] * g1;
                    if (ADD) { f32x4 t0, t1; unpack8(*(const u32x4*)(rowp + bj * HALF), t0, t1); v0 += t0; v1 += t1; }
                    *(u32x4*)(rowp + bj * HALF) = pack8(v0, v1); } }
    }
};
struct EpiSwiglu {
    static constexpr bool PERM = true, AFTER_DRAIN = false;
    bf16_t* H0; bf16_t* H1; int pm_split;
    __device__ __forceinline__ void operator()(const f32x4 (&acc)[2][2][4][2], const Unit& u, int wr, int wc, int fr, int fq) const {
        bf16_t* base = u.pm < pm_split ? H0 + (size_t)u.pm * BM * DFF : H1 + (size_t)(u.pm - pm_split) * BM * DFF;
        const int row0 = wr * 64 + fr, col0 = u.pn * HALF + wc * 32 + 8 * fq;
#pragma unroll
        for (int ai = 0; ai < 2; ++ai)
#pragma unroll
            for (int m = 0; m < 4; ++m) {
                f32x4 h[2];
#pragma unroll
                for (int n = 0; n < 2; ++n) { const f32x4 g = acc[ai][0][m][n], up = acc[ai][1][m][n];
#pragma unroll
                    for (int j = 0; j < 4; ++j) h[n][j] = g[j] * sigmoidf_(g[j]) * up[j]; }
                *(u32x4*)(base + (size_t)(row0 + ai * HALF + m * 16) * DFF + col0) = pack8(h[0], h[1]); }
    }
};

__device__ __forceinline__ f32x4 deq4(const f32x4 accbits, const float sa, const f32x4 sb) { const v4i32 q = __builtin_bit_cast(v4i32, accbits); return (f32x4){(float)q.x, (float)q.y, (float)q.z, (float)q.w} * sa * sb; }
struct EpiProjQ {
    static constexpr bool PERM = true, AFTER_DRAIN = false;
    bf16_t* Qb; bf16_t* Kb; bf16_t* G; const float* bias; const float* sa; const float* sb;
    __device__ __forceinline__ void operator()(const f32x4 (&acc)[2][2][4][2], const Unit& u, int wr, int wc, int fr, int fq) const {
        const int row0 = u.pm * BM + wr * 64 + fr, cg0 = u.pn * BM + wc * 32 + 8 * fq;
        f32x4 sbv[2][2];
#pragma unroll
        for (int bj = 0; bj < 2; ++bj)
#pragma unroll
            for (int n = 0; n < 2; ++n) sbv[bj][n] = *(const f32x4*)(sb + cg0 + bj * HALF + 4 * n);
        if (u.pn < 8) {
            const int col0 = u.pn * BM + wc * 32 + 8 * fq;
#pragma unroll
            for (int ai = 0; ai < 2; ++ai)
#pragma unroll
                for (int m = 0; m < 4; ++m) { const int row = row0 + ai * HALF + m * 16; const float sr = sa[row]; bf16_t* rowp = Qb + (size_t)row * NAW + col0;
#pragma unroll
                    for (int bj = 0; bj < 2; ++bj) *(u32x4*)(rowp + bj * HALF) = pack8(deq4(acc[ai][bj][m][0], sr, sbv[bj][0]), deq4(acc[ai][bj][m][1], sr, sbv[bj][1])); }
        } else if (u.pn < 16) {
            const int col0 = (u.pn - 8) * BM + wc * 32 + 8 * fq;
#pragma unroll
            for (int ai = 0; ai < 2; ++ai)
#pragma unroll
                for (int m = 0; m < 4; ++m) { const int tok = row0 + ai * HALF + m * 16, R = tok >> 6, cl = tok & 63; const float sr = sa[tok];
                    const int tokpart = (((cl >> 2) & 1) * 8 + (cl >> 3)) * 4 + (cl & 3);
#pragma unroll
                    for (int bj = 0; bj < 2; ++bj) { const int c = col0 + bj * HALF, hh = c >> 7, d0 = c & 127;
                        *(u32x4*)(Kb + ((size_t)(((R * 16 + hh) * 4 + (d0 >> 5)) * 64 + tokpart) * 4 + ((d0 >> 3) & 3)) * 8) = pack8(deq4(acc[ai][bj][m][0], sr, sbv[bj][0]), deq4(acc[ai][bj][m][1], sr, sbv[bj][1])); } }
        } else {
            const int col0 = (u.pn - 16) * BM + wc * 32 + 8 * fq;
            f32x4 bv[2][2];
#pragma unroll
            for (int bj = 0; bj < 2; ++bj)
#pragma unroll
                for (int n = 0; n < 2; ++n) bv[bj][n] = *(const f32x4*)(bias + col0 + bj * HALF + 4 * n);
#pragma unroll
            for (int ai = 0; ai < 2; ++ai)
#pragma unroll
                for (int m = 0; m < 4; ++m) { const int row = row0 + ai * HALF + m * 16; const float sr = sa[row]; bf16_t* rowp = G + (size_t)row * (2 * D) + col0;
#pragma unroll
                    for (int bj = 0; bj < 2; ++bj) *(u32x4*)(rowp + bj * HALF) = pack8(sig4(deq4(acc[ai][bj][m][0], sr, sbv[bj][0]) + bv[bj][0]), sig4(deq4(acc[ai][bj][m][1], sr, sbv[bj][1]) + bv[bj][1])); }
        }
    }
};
struct EpiPlainQ {
    static constexpr bool PERM = true, AFTER_DRAIN = false;
    bf16_t* O; int ldc; const float* sa; const float* sb;
    __device__ __forceinline__ void operator()(const f32x4 (&acc)[2][2][4][2], const Unit& u, int wr, int wc, int fr, int fq) const {
        const int row0 = u.pm * BM + wr * 64 + fr, col0 = u.pn * BM + wc * 32 + 8 * fq;
        f32x4 sbv[2][2];
#pragma unroll
        for (int bj = 0; bj < 2; ++bj)
#pragma unroll
            for (int n = 0; n < 2; ++n) sbv[bj][n] = *(const f32x4*)(sb + col0 + bj * HALF + 4 * n);
#pragma unroll
        for (int ai = 0; ai < 2; ++ai)
#pragma unroll
            for (int m = 0; m < 4; ++m) { const int row = row0 + ai * HALF + m * 16; const float sr = sa[row]; bf16_t* rowp = O + (size_t)row * ldc + col0;
#pragma unroll
                for (int bj = 0; bj < 2; ++bj) *(u32x4*)(rowp + bj * HALF) = pack8(deq4(acc[ai][bj][m][0], sr, sbv[bj][0]), deq4(acc[ai][bj][m][1], sr, sbv[bj][1])); }
    }
};
struct EpiVTQ {
    static constexpr bool PERM = true, AFTER_DRAIN = false;
    bf16_t* O; const float* sa; const float* sb;
    __device__ __forceinline__ void operator()(const f32x4 (&acc)[2][2][4][2], const Unit& u, int wr, int wc, int fr, int fq) const {
        const int row0 = u.pm * BM + wr * 64 + fr, col0 = u.pn * BM + wc * 32 + 8 * fq;
        f32x4 sbv[2][2];
#pragma unroll
        for (int bj = 0; bj < 2; ++bj)
#pragma unroll
            for (int n = 0; n < 2; ++n) sbv[bj][n] = *(const f32x4*)(sb + col0 + bj * HALF + 4 * n);
#pragma unroll
        for (int ai = 0; ai < 2; ++ai)
#pragma unroll
            for (int m = 0; m < 4; ++m) { const int row = row0 + ai * HALF + m * 16, hh = row >> 7, d = row & 127; const float sr = sa[row];
                const int dt = 2 * (d >> 5) + ((d >> 2) & 1), i = 4 * ((d >> 3) & 3) + (d & 3);
#pragma unroll
                for (int bj = 0; bj < 2; ++bj) { const int tok = col0 + bj * HALF, R = tok >> 6, o = (tok & 63) >> 3;
                    *(u32x4*)(O + ((size_t)((((R * 16 + hh) * 8 + dt) * 8 + o) * 16 + i)) * 8) = pack8(deq4(acc[ai][bj][m][0], sr, sbv[bj][0]), deq4(acc[ai][bj][m][1], sr, sbv[bj][1])); } }
    }
};
struct EpiSwigluQ {
    static constexpr bool PERM = true, AFTER_DRAIN = false;
    bf16_t* H0; bf16_t* H1; int pm_split; const float* sa; const float* sb;
    __device__ __forceinline__ void operator()(const f32x4 (&acc)[2][2][4][2], const Unit& u, int wr, int wc, int fr, int fq) const {
        bf16_t* base = u.pm < pm_split ? H0 + (size_t)u.pm * BM * DFF : H1 + (size_t)(u.pm - pm_split) * BM * DFF;
        const int row0 = wr * 64 + fr, col0 = u.pn * HALF + wc * 32 + 8 * fq, cg0 = u.pn * BM + wc * 32 + 8 * fq;
        f32x4 sbv[2][2];
#pragma unroll
        for (int bj = 0; bj < 2; ++bj)
#pragma unroll
            for (int n = 0; n < 2; ++n) sbv[bj][n] = *(const f32x4*)(sb + cg0 + bj * HALF + 4 * n);
#pragma unroll
        for (int ai = 0; ai < 2; ++ai)
#pragma unroll
            for (int m = 0; m < 4; ++m) { const float sr = sa[u.pm * BM + row0 + ai * HALF + m * 16];
                f32x4 h[2];
#pragma unroll
                for (int n = 0; n < 2; ++n) { const f32x4 g = deq4(acc[ai][0][m][n], sr, sbv[0][n]), up = deq4(acc[ai][1][m][n], sr, sbv[1][n]);
#pragma unroll
                    for (int j = 0; j < 4; ++j) h[n][j] = g[j] * sigmoidf_(g[j]) * up[j]; }
                *(u32x4*)(base + (size_t)(row0 + ai * HALF + m * 16) * DFF + col0) = pack8(h[0], h[1]); }
    }
};

__device__ __forceinline__ v8i32 cat8(const bf16x8 lo, const bf16x8 hi) { return __builtin_shufflevector(__builtin_bit_cast(v4i32, lo), __builtin_bit_cast(v4i32, hi), 0, 1, 2, 3, 4, 5, 6, 7); }
__device__ __forceinline__ void mfma_fp8_acc(f32x4& c, const v8i32 a, const v8i32 b, int sa, int sb) {
    asm volatile("v_mfma_scale_f32_16x16x128_f8f6f4 %0, %1, %2, %0, %3, %4 op_sel_hi:[0,0,0]" : "+v"(c) : "v"(a), "v"(b), "v"(sa), "v"(sb)); }
constexpr int FP8_SCALE = 0x73737373;
template <class Epi, class Sched, bool ALIGN_EPI = false, bool SP2 = false, int QM = 0  , int DBG = 0>
__device__ __forceinline__ void gemm_phase(LAS unsigned char* lds, const Gemm g, const Sched& S, const Epi& E) {
    int tid = threadIdx.x; asm volatile("" : "+v"(tid));
    const int wid = __builtin_amdgcn_readfirstlane(tid >> 6), lane = tid & 63, wr = wid >> 2, wc = wid & 3, fr = lane & 15, fq = lane >> 4;
    const int RB = g.rb, nt = RB / (BK * 2);
    unsigned voffA[2], voffB[2];
#pragma unroll
    for (int i = 0; i < 2; ++i) { int R, C; stage_rc(tid * 16 + i * 8192, R, C); const int Rb = Epi::PERM ? ((R & ~31) + perm32(R & 31)) : R;
        voffA[i] = (unsigned)(R * RB + C * 2); voffB[i] = (unsigned)(Rb * RB + C * 2); }
    const size_t kstep = (size_t)(BK * 2);
    const size_t hstep = (size_t)HALF * RB;
    const unsigned ldsw = (unsigned)wid * 1024u;
    const int aoff0 = lds_byte(wr * 64 + fr, fq * 8), aoff1 = lds_byte(wr * 64 + fr, 32 + fq * 8), boff0 = lds_byte(wc * 32 + fr, fq * 8), boff1 = lds_byte(wc * 32 + fr, 32 + fq * 8);
#define PG8_SA(b, h) (((b) * 2 + (h)) * HTB)
#define PG8_SB(b, h) ((4 + (b) * 2 + (h)) * HTB)
#define PG8_STAGE(bufoff, gbase, voff) do { if constexpr (DBG != 3) _Pragma("unroll") for (int _i = 0; _i < 2; ++_i) \
        __builtin_amdgcn_global_load_lds((const unsigned*)((const char*)(gbase) + (voff)[_i]), (LAS unsigned*)(lds + (bufoff) + ldsw + _i * 8192), 16, 0, 0); } while (0)
#define PG8_LDA(dst, b, h) do { if constexpr (DBG != 2) _Pragma("unroll") for (int m = 0; m < 4; ++m) _Pragma("unroll") for (int k = 0; k < 2; ++k) dst[m][k] = *(const LAS bf16x8*)(lds + PG8_SA(b, h) + (k ? aoff1 : aoff0) + m * 2048); } while (0)
#define PG8_LDB(dst, b, h) do { if constexpr (DBG != 2) _Pragma("unroll") for (int n = 0; n < 2; ++n) _Pragma("unroll") for (int k = 0; k < 2; ++k) dst[n][k] = *(const LAS bf16x8*)(lds + PG8_SB(b, h) + (k ? boff1 : boff0) + n * 2048); } while (0)
#define PG8_MMA(ai, bj, At, Bt) do { __builtin_amdgcn_s_setprio(1); if constexpr (DBG == 1) { } else if constexpr (QM == 2) { _Pragma("unroll") for (int m = 0; m < 4; ++m) _Pragma("unroll") for (int n = 0; n < 2; ++n) _Pragma("unroll") for (int k = 0; k < 2; ++k) \
        acc[ai][bj][m][n] = __builtin_bit_cast(f32x4, __builtin_amdgcn_mfma_i32_16x16x64_i8(__builtin_bit_cast(v4i32, Bt[n][k]), __builtin_bit_cast(v4i32, At[m][k]), __builtin_bit_cast(v4i32, acc[ai][bj][m][n]), 0, 0, 0)); } else if constexpr (QM == 1) { _Pragma("unroll") for (int m = 0; m < 4; ++m) _Pragma("unroll") for (int n = 0; n < 2; ++n) \
        mfma_fp8_acc(acc[ai][bj][m][n], cat8(Bt[n][0], Bt[n][1]), cat8(At[m][0], At[m][1]), fp8_sa, fp8_sb); } else { \
        _Pragma("unroll") for (int m = 0; m < 4; ++m) _Pragma("unroll") for (int n = 0; n < 2; ++n) _Pragma("unroll") for (int k = 0; k < 2; ++k) \
        acc[ai][bj][m][n] = __builtin_amdgcn_mfma_f32_16x16x32_bf16(Bt[n][k], At[m][k], acc[ai][bj][m][n], 0, 0, 0); } __builtin_amdgcn_s_setprio(0); } while (0)
#define PG8_WAIT_V(n) asm volatile("s_waitcnt vmcnt(" #n ")" ::: "memory")
#define PG8_WAIT_L(n) asm volatile("s_waitcnt lgkmcnt(" #n ")" ::: "memory")
#define PG8_BAR __builtin_amdgcn_s_barrier()
#define PG8_SCHED __builtin_amdgcn_sched_barrier(0)
    Unit cur, nxt; int ui = 0;
    const int fp8_sa = FP8_SCALE, fp8_sb = 0x7F7F7F7F;
    if (!S.next(0, cur)) return;
    f32x4 acc[2][2][4][2];
#pragma unroll
    for (int a = 0; a < 2; ++a)
#pragma unroll
        for (int b = 0; b < 2; ++b)
#pragma unroll
            for (int m = 0; m < 4; ++m)
#pragma unroll
                for (int n = 0; n < 2; ++n) acc[a][b][m][n] = (f32x4){0.f, 0.f, 0.f, 0.f};
    bf16x8 At[4][2], B0[2][2], B1[2][2];
    const char* cA = g.abase(cur.pm); const char* cB = g.bbase(cur.pn);
    S.a_ready(cur);
    if constexpr (SP2) {
        PG8_STAGE(PG8_SB(0, 0), cB, voffB); PG8_STAGE(PG8_SB(0, 1), cB + hstep, voffB); PG8_STAGE(PG8_SA(0, 0), cA, voffA); PG8_STAGE(PG8_SA(0, 1), cA + hstep, voffA);
        if (wr == 1) PG8_BAR;
        PG8_WAIT_V(2); PG8_BAR;
        PG8_STAGE(PG8_SB(1, 0), cB + kstep, voffB); PG8_STAGE(PG8_SA(1, 0), cA + kstep, voffA); PG8_STAGE(PG8_SB(1, 1), cB + hstep + kstep, voffB);
        PG8_WAIT_V(6); PG8_BAR;
    } else {
        PG8_STAGE(PG8_SB(0, 0), cB, voffB); PG8_STAGE(PG8_SA(0, 0), cA, voffA); PG8_STAGE(PG8_SB(0, 1), cB + hstep, voffB); PG8_STAGE(PG8_SA(0, 1), cA + hstep, voffA);
        if (wr == 1) PG8_BAR;
        PG8_WAIT_V(4); PG8_BAR;
        PG8_STAGE(PG8_SB(1, 0), cB + kstep, voffB); PG8_STAGE(PG8_SA(1, 0), cA + kstep, voffA); PG8_STAGE(PG8_SB(1, 1), cB + hstep + kstep, voffB);
        PG8_WAIT_V(6); PG8_BAR;
    }
    for (;;) {
        const bool has_next = S.next(ui + 1, nxt);
        const char* nA = has_next ? g.abase(nxt.pm) : cA; const char* nB = has_next ? g.bbase(nxt.pn) : cB;
        for (int t = 0; t < nt; t += 2) {
            const bool last = (t == nt - 2);
            const char* a1 = cA + (size_t)(t + 1) * kstep;
            const char* a2 = last ? nA : cA + (size_t)(t + 2) * kstep; const char* b2 = last ? nB : cB + (size_t)(t + 2) * kstep;
            const char* a3 = a2 + kstep; const char* b3 = b2 + kstep;
            if (last && has_next) S.a_ready(nxt);
            if constexpr (SP2) {
            PG8_LDB(B0, 0, 0); PG8_LDB(B1, 0, 1); PG8_SCHED; PG8_LDA(At, 0, 0); PG8_STAGE(PG8_SA(1, 1), a1 + hstep, voffA);
            PG8_WAIT_V(8); PG8_WAIT_L(0); PG8_BAR; PG8_MMA(0, 0, At, B0); PG8_MMA(0, 1, At, B1); PG8_BAR; PG8_SCHED;
            PG8_LDA(At, 0, 1); PG8_STAGE(PG8_SB(0, 0), b2, voffB); PG8_STAGE(PG8_SB(0, 1), b2 + hstep, voffB); PG8_STAGE(PG8_SA(0, 0), a2, voffA);
            PG8_WAIT_V(8); PG8_WAIT_L(0); PG8_BAR; PG8_MMA(1, 0, At, B0); PG8_MMA(1, 1, At, B1); PG8_BAR; PG8_SCHED;
            PG8_LDB(B0, 1, 0); PG8_LDB(B1, 1, 1); PG8_SCHED; PG8_LDA(At, 1, 0); PG8_STAGE(PG8_SA(0, 1), a2 + hstep, voffA);
            PG8_WAIT_V(8); PG8_WAIT_L(0); PG8_BAR; PG8_MMA(0, 0, At, B0); PG8_MMA(0, 1, At, B1); PG8_BAR; PG8_SCHED;
            PG8_LDA(At, 1, 1); PG8_STAGE(PG8_SB(1, 0), b3, voffB); PG8_STAGE(PG8_SB(1, 1), b3 + hstep, voffB); PG8_STAGE(PG8_SA(1, 0), a3, voffA);
            PG8_WAIT_V(8); PG8_WAIT_L(0); PG8_BAR; PG8_MMA(1, 0, At, B0); PG8_MMA(1, 1, At, B1); PG8_BAR; PG8_SCHED;
            } else {
            PG8_LDB(B0, 0, 0); PG8_SCHED; PG8_LDA(At, 0, 0); PG8_STAGE(PG8_SA(1, 1), a1 + hstep, voffA);
            PG8_WAIT_L(8); PG8_BAR; PG8_WAIT_L(0); PG8_MMA(0, 0, At, B0); PG8_BAR; PG8_SCHED;
            PG8_LDB(B1, 0, 1); PG8_STAGE(PG8_SB(0, 0), b2, voffB);
            PG8_BAR; PG8_WAIT_L(0); PG8_MMA(0, 1, At, B1); PG8_BAR;
            PG8_LDA(At, 0, 1); PG8_STAGE(PG8_SA(0, 0), a2, voffA);
            PG8_BAR; PG8_WAIT_L(0); PG8_MMA(1, 0, At, B0); PG8_BAR; PG8_SCHED;
            PG8_STAGE(PG8_SB(0, 1), b2 + hstep, voffB);
            PG8_WAIT_V(6); PG8_BAR; PG8_MMA(1, 1, At, B1); PG8_BAR;
            PG8_LDB(B0, 1, 0); PG8_SCHED; PG8_LDA(At, 1, 0); PG8_STAGE(PG8_SA(0, 1), a2 + hstep, voffA);
            PG8_WAIT_L(8); PG8_BAR; PG8_WAIT_L(0); PG8_MMA(0, 0, At, B0); PG8_BAR; PG8_SCHED;
            PG8_LDB(B1, 1, 1); PG8_STAGE(PG8_SB(1, 0), b3, voffB);
            PG8_BAR; PG8_WAIT_L(0); PG8_MMA(0, 1, At, B1); PG8_BAR;
            PG8_LDA(At, 1, 1); PG8_STAGE(PG8_SA(1, 0), a3, voffA);
            PG8_BAR; PG8_WAIT_L(0); PG8_MMA(1, 0, At, B0); PG8_BAR; PG8_SCHED;
            PG8_STAGE(PG8_SB(1, 1), b3 + hstep, voffB);
            PG8_WAIT_V(6); PG8_BAR; PG8_MMA(1, 1, At, B1); PG8_BAR;
            }
        }
        if constexpr (ALIGN_EPI) { if (wr == 0) PG8_BAR; }
        if constexpr (!Epi::AFTER_DRAIN) { if constexpr (DBG != 4) E(acc, cur, wr, wc, fr, fq); else { _Pragma("unroll") for (int a_ = 0; a_ < 2; ++a_) _Pragma("unroll") for (int b_ = 0; b_ < 2; ++b_) _Pragma("unroll") for (int m_ = 0; m_ < 4; ++m_) _Pragma("unroll") for (int n_ = 0; n_ < 2; ++n_) asm volatile("" :: "v"(acc[a_][b_][m_][n_])); } S.done(cur); }
        if (!has_next) break;
#pragma unroll
        for (int a = 0; a < 2; ++a)
#pragma unroll
            for (int b = 0; b < 2; ++b)
#pragma unroll
                for (int m = 0; m < 4; ++m)
#pragma unroll
                    for (int n = 0; n < 2; ++n) acc[a][b][m][n] = (f32x4){0.f, 0.f, 0.f, 0.f};
        cur = nxt; cA = nA; cB = nB; ++ui;
        if constexpr (ALIGN_EPI) { if (wr == 1) PG8_BAR; }
    }
    PG8_WAIT_V(0);
    if constexpr (!ALIGN_EPI) { if (wr == 0) PG8_BAR; }
    PG8_BAR;
    if constexpr (Epi::AFTER_DRAIN) { E.fused(acc, cur, wr, wc, fr, fq, lds, wid, lane); S.done(cur); }
#undef PG8_SA
#undef PG8_SB
#undef PG8_STAGE
#undef PG8_LDA
#undef PG8_LDB
#undef PG8_MMA
#undef PG8_WAIT_V
#undef PG8_WAIT_L
#undef PG8_BAR
#undef PG8_SCHED
}
}
#define XB_TMO      128
#define XB_XCNT(j)  (256  + 64 * (j))
#define XB_XSUB(j)  (1280 + 64 * (j))
#define XB_XGEN(j)  (2304 + 64 * (j))
#define XB_TOP      3328
#define XB_TOPGEN   3392
#define XCD_BAR_WORDS 3456
#define XB_SPIN_CAP (1u << 18)

__device__ __forceinline__ unsigned xb_ld(unsigned* p)              { return __hip_atomic_load(p, __ATOMIC_RELAXED, __HIP_MEMORY_SCOPE_AGENT); }
__device__ __forceinline__ unsigned xb_add(unsigned* p, unsigned v) { return __hip_atomic_fetch_add(p, v, __ATOMIC_RELAXED, __HIP_MEMORY_SCOPE_AGENT); }
__device__ __forceinline__ unsigned xb_xcc_id() { return (unsigned)__builtin_amdgcn_s_getreg((3 << 11) | 20) & 0xFu; }
#define XB_SPIN(cond, bar) do { unsigned _sp = 0; while (cond) { __builtin_amdgcn_s_sleep(1); \
    if ((++_sp & 255u) == 0u) { if (xb_ld(&(bar)[XB_TMO])) break; if (_sp > XB_SPIN_CAP) { atomicAdd(&(bar)[XB_TMO], 1u); break; } } } } while (0)

struct XcdBarrier {
    unsigned* bar; unsigned x;
    volatile LAS unsigned* st;
};

__device__ __forceinline__ XcdBarrier xcd_barrier_post(unsigned* bar, volatile LAS unsigned* st) {
    XcdBarrier b; b.bar = bar; b.x = xb_xcc_id(); b.st = st;
    if (threadIdx.x == 0) (void)xb_add(&bar[XB_XCNT(b.x)], 1u);
    return b;
}
__device__ __forceinline__ void xcd_barrier_complete(unsigned* bar, unsigned x, unsigned& nloc, unsigned& nx) {
    const unsigned G = gridDim.x * gridDim.y * gridDim.z;
    unsigned sum, cnt, mine, sp = 0u;
    for (;;) {
        sum = 0u; cnt = 0u; mine = 0u;
#pragma unroll
        for (unsigned j = 0; j < 16; ++j) { const unsigned c = xb_ld(&bar[XB_XCNT(j)]); sum += c; cnt += (c > 0u) ? 1u : 0u; mine = (j == x) ? c : mine; }
        if (sum == G) break;
        __builtin_amdgcn_s_sleep(1);
        if ((++sp & 255u) == 0u) { if (xb_ld(&bar[XB_TMO])) break; if (sp > XB_SPIN_CAP) { atomicAdd(&bar[XB_TMO], 1u); break; } }
    }
    nloc = mine > 0u ? mine : 1u; nx = cnt > 0u ? cnt : 1u;
}

__device__ __forceinline__ void xcd_barrier(const XcdBarrier& b) {
    asm volatile("s_waitcnt vmcnt(0)" ::: "memory");
    __syncthreads();
    if (threadIdx.x == 0) {
        unsigned* bar = b.bar;
        __builtin_amdgcn_s_waitcnt(0);
        unsigned nloc = b.st[0], nx = b.st[1];
        if (nloc == 0u) { xcd_barrier_complete(bar, b.x, nloc, nx); b.st[0] = nloc; b.st[1] = nx; }
        const unsigned old = xb_add(&bar[XB_XSUB(b.x)], 1u);
        const unsigned gen = old / nloc;
        if (old + 1u == (gen + 1u) * nloc) {
            __builtin_amdgcn_fence(__ATOMIC_RELEASE, "agent");
            asm volatile("s_waitcnt vmcnt(0)" ::: "memory");
            const unsigned og = xb_add(&bar[XB_TOP], 1u);
            const unsigned tg = og / nx;
            if (og + 1u == (tg + 1u) * nx) xb_add(&bar[XB_TOPGEN], 1u);
            else XB_SPIN(xb_ld(&bar[XB_TOPGEN]) == tg, bar);
            __builtin_amdgcn_fence(__ATOMIC_ACQUIRE, "agent");
            xb_add(&bar[XB_XGEN(b.x)], 1u);
            asm volatile("s_waitcnt vmcnt(0)" ::: "memory");
        } else {
            XB_SPIN(xb_ld(&bar[XB_XGEN(b.x)]) == gen, bar);
            __builtin_amdgcn_fence(__ATOMIC_ACQUIRE, "agent");
            asm volatile("s_waitcnt vmcnt(0)" ::: "memory");
        }
    }
    __syncthreads();
}


struct Frame {
    LAS unsigned char* lds;
    int tid, lane, wave, G, gw, ngw;
    const float *in_XP, *in_XS, *in_WIN, *in_WCONV, *in_BCONV, *in_WR, *in_BR, *in_WI, *in_BI, *in_LAM, *in_RPB, *in_WNO, *in_WLO, *in_WM, *in_BM, *in_WOUT, *in_GMPRE, *in_GMPOST, *in_GFPRE, *in_GFPOST, *in_WFG, *in_WFU, *in_WFD; float* out; unsigned char* ws;
};
enum { I_XP = 0, I_XS, I_WIN, I_WCONV, I_BCONV, I_WR, I_BR, I_WI, I_BI, I_LAM, I_RPB, I_WNO, I_WLO, I_WM, I_BM, I_WOUT, I_GMPRE, I_GMPOST, I_GFPRE, I_GFPOST, I_WFG, I_WFU, I_WFD };
__device__ __forceinline__ int opaque(int x) { asm volatile("" : "+v"(x)); return x; }
template <class T> __device__ __forceinline__ T* wsp(const Frame& F, size_t off) { return (T*)(F.ws + off); }
__device__ __forceinline__ const float* xrow(const Frame& F, int m) { return m < LP ? F.in_XP + (size_t)m * D : F.in_XS + (size_t)(m - LP) * D; }

__device__ __forceinline__ void tr_item(const float* src, int ldsrc, int k0, int n0, bf16_t* dst, int ldd, int drow0, LAS float* scr, int lane) {
#pragma unroll 8
    for (int i = 0; i < 32; ++i) { const int kk = 2 * i + (lane >> 5); scr[kk * 33 + (lane & 31)] = src[(size_t)(k0 + kk) * ldsrc + n0 + (lane & 31)]; }
    LDS_WAIT(); asm volatile("" ::: "memory");
    const int c = lane & 7;
#pragma unroll
    for (int j = 0; j < 4; ++j) { const int n = (lane >> 3) + 8 * j; const LAS float* s = scr + (8 * c) * 33 + n;
        u32x4 o; o.x = pk2(s[0 * 33], s[1 * 33]); o.y = pk2(s[2 * 33], s[3 * 33]); o.z = pk2(s[4 * 33], s[5 * 33]); o.w = pk2(s[6 * 33], s[7 * 33]);
        *(u32x4*)(dst + (size_t)(drow0 + n) * ldd + k0 + 8 * c) = o; }
    LDS_WAIT(); asm volatile("" ::: "memory");
}
__device__ __forceinline__ unsigned pk4_fp8(float a, float b, float c, float d) { int p = __builtin_amdgcn_cvt_pk_fp8_f32(a, b, 0, false); p = __builtin_amdgcn_cvt_pk_fp8_f32(c, d, p, true); return (unsigned)p; }
__device__ __forceinline__ void tr_item8(const float* src, int ldsrc, int k0, int n0, unsigned char* dst, int ldd, int drow0, LAS float* scr, int lane) {
#pragma unroll 8
    for (int i = 0; i < 32; ++i) { const int kk = 2 * i + (lane >> 5); scr[kk * 33 + (lane & 31)] = src[(size_t)(k0 + kk) * ldsrc + n0 + (lane & 31)]; }
    LDS_WAIT(); asm volatile("" ::: "memory");
    const int c = lane & 7;
#pragma unroll
    for (int j = 0; j < 4; ++j) { const int n = (lane >> 3) + 8 * j; const LAS float* s = scr + (8 * c) * 33 + n;
        u32x2 o; o.x = pk4_fp8(s[0 * 33] * 256.f, s[1 * 33] * 256.f, s[2 * 33] * 256.f, s[3 * 33] * 256.f); o.y = pk4_fp8(s[4 * 33] * 256.f, s[5 * 33] * 256.f, s[6 * 33] * 256.f, s[7 * 33] * 256.f);
        *(u32x2*)(dst + (size_t)(drow0 + n) * ldd + k0 + 8 * c) = o; }
    LDS_WAIT(); asm volatile("" ::: "memory");
}
__device__ __forceinline__ unsigned pk4_i8(float a, float b, float c, float d) { return ((unsigned)(int)a & 255u) | (((unsigned)(int)b & 255u) << 8) | (((unsigned)(int)c & 255u) << 16) | ((unsigned)(int)d << 24); }
__device__ __forceinline__ void tr_strip_i8(const float* src, int ldsrc, int K, int n0, signed char* dst, int drow0, float* cs, LAS float* scr, int lane) {
    const float* sp = src + n0 + (lane & 31) + (size_t)(lane >> 5) * ldsrc;
    float mx = 0.f;
    { const float* p = sp; const size_t step = (size_t)2 * ldsrc;
      for (int k0 = 0; k0 < K; k0 += 64) {
        float t[32];
#pragma unroll
        for (int i = 0; i < 32; ++i) { t[i] = *p; p += step; }
#pragma unroll
        for (int i = 0; i < 32; ++i) mx = fmaxf(mx, fabsf(t[i]));
      } }
    mx = fmaxf(mx, __shfl_xor(mx, 32));
    const float amax = fmaxf(mx, 1e-20f), inv = 127.0f / amax;
    if (lane < 32) cs[drow0 + lane] = amax * (1.0f / 127.0f);
    const int c = lane & 7;
    for (int k0 = 0; k0 < K; k0 += 64) {
        { const float* p = sp + (size_t)k0 * ldsrc; const size_t step = (size_t)2 * ldsrc; LAS float* w = scr + (lane >> 5) * 33 + (lane & 31);
          float t[32];
#pragma unroll
          for (int i = 0; i < 32; ++i) { t[i] = *p; p += step; }
#pragma unroll
          for (int i = 0; i < 32; ++i) w[i * 66] = rintf(t[i] * inv); }
        LDS_WAIT(); asm volatile("" ::: "memory");
#pragma unroll
        for (int j = 0; j < 4; ++j) { const int n = (lane >> 3) + 8 * j; const LAS float* t = scr + (8 * c) * 33 + n;
            u32x2 o; o.x = pk4_i8(t[0 * 33], t[1 * 33], t[2 * 33], t[3 * 33]); o.y = pk4_i8(t[4 * 33], t[5 * 33], t[6 * 33], t[7 * 33]);
            *(u32x2*)(dst + (size_t)(drow0 + n) * K + k0 + 8 * c) = o; }
        LDS_WAIT(); asm volatile("" ::: "memory");
    }
}
__device__ __forceinline__ void fwht32(float (&v)[32]) {
#pragma unroll
    for (int st = 1; st < 32; st <<= 1)
#pragma unroll
        for (int i = 0; i < 32; ++i) if (!(i & st)) { const float a = v[i], b = v[i + st]; v[i] = a + b; v[i + st] = a - b; }
#pragma unroll
    for (int i = 0; i < 32; ++i) v[i] *= 0.17677669529663687f;
}
__device__ __forceinline__ void had_tile_load(const float* src, int ldsrc, int k0, int n0, LAS float* scr, int lane, float (&v)[32]) {
    { const float* p = src + (size_t)(k0 + (lane >> 5)) * ldsrc + n0 + (lane & 31); const size_t step = (size_t)2 * ldsrc; LAS float* w = scr + (lane >> 5) * 33 + (lane & 31); float t[32];
#pragma unroll
      for (int i = 0; i < 32; ++i) { t[i] = *p; p += step; }
#pragma unroll
      for (int i = 0; i < 32; ++i) w[i * 66] = t[i]; }
    LDS_WAIT(); asm volatile("" ::: "memory");
    const LAS float* hv = scr + (32 * (lane >> 5)) * 33 + (lane & 31);
#pragma unroll
    for (int i = 0; i < 32; ++i) v[i] = hv[i * 33];
    fwht32(v);
}
__device__ __forceinline__ void had_tile_amax(const float* src, int ldsrc, int k0, int n0, unsigned* am, LAS float* scr, int lane) {
    float v[32]; had_tile_load(src, ldsrc, k0, n0, scr, lane, v);
    float mx = 0.f;
#pragma unroll
    for (int i = 0; i < 32; ++i) mx = fmaxf(mx, fabsf(v[i]));
    mx = fmaxf(mx, __shfl_xor(mx, 32));
    if (lane < 32) atomicMax(am + n0 + lane, __builtin_bit_cast(unsigned, mx));
    LDS_WAIT(); asm volatile("" ::: "memory");
}
__device__ __forceinline__ void had_tile_quant(const float* src, int ldsrc, int K, int k0, int n0, signed char* dst, const unsigned* am, float* cs, LAS float* scr, int lane) {
    const float amax = fmaxf(__builtin_bit_cast(float, am[n0 + (lane & 31)]), 1e-20f), inv = 127.0f / amax;
    if (k0 == 0 && lane < 32) cs[n0 + lane] = amax * (1.0f / 127.0f);
    float v[32]; had_tile_load(src, ldsrc, k0, n0, scr, lane, v);
    LAS float* hv = scr + (32 * (lane >> 5)) * 33 + (lane & 31);
#pragma unroll
    for (int i = 0; i < 32; ++i) hv[i * 33] = rintf(v[i] * inv);
    LDS_WAIT(); asm volatile("" ::: "memory");
    const int c = lane & 7;
#pragma unroll
    for (int j = 0; j < 4; ++j) { const int n = (lane >> 3) + 8 * j; const LAS float* t = scr + (8 * c) * 33 + n;
        u32x2 o; o.x = pk4_i8(t[0 * 33], t[1 * 33], t[2 * 33], t[3 * 33]); o.y = pk4_i8(t[4 * 33], t[5 * 33], t[6 * 33], t[7 * 33]);
        *(u32x2*)(dst + (size_t)(n0 + n) * K + k0 + 8 * c) = o; }
    LDS_WAIT(); asm volatile("" ::: "memory");
}
#define TR_JOB(SRC, LDSRC, KK, NN, DST, DROW_EXPR) { const int nblk = (NN) / 32, nit = ((KK) / 64) * nblk; \
    if (r < nit) { const int kb = r / nblk, nb = r % nblk, n0 = 32 * nb; tr_item((SRC), (LDSRC), 64 * kb, n0, (DST), (KK), (DROW_EXPR), scr, F.lane); continue; } r -= nit; }
#define TR_JOB8(SRC, LDSRC, KK, NN, DST, DROW_EXPR) { const int nblk = (NN) / 32, nit = ((KK) / 64) * nblk; \
    if (r < nit) { const int kb = r / nblk, nb = r % nblk, n0 = 32 * nb; tr_item8((SRC), (LDSRC), 64 * kb, n0, (DST), (KK), (DROW_EXPR), scr, F.lane); continue; } r -= nit; }

__device__ __forceinline__ void p0_prologue(Frame& F) {
    const int tid_ = opaque(F.tid);
    LAS float* scr = (LAS float*)(F.lds + F.wave * 8448);
    const float* w_in = F.in_WIN;
    bf16_t* WCAT = wsp<bf16_t>(F, WS_WCAT); signed char* W8 = wsp<signed char>(F, WS_W8); signed char* WV8 = wsp<signed char>(F, WS_WVT); signed char* WGU8 = wsp<signed char>(F, WS_WGU);
    float* CS = wsp<float>(F, WS_CS);
    constexpr int NSM = 64;
    constexpr int IT_SM = 2 * 4;
    constexpr int S_Q = NAW / 32, S_M = 2 * D / 32, S_F = DFF / 32;
    constexpr int NSTRIP = 3 * S_Q + S_M + 2 * S_F;
    constexpr int N_AMAX = (DFF / 64) * (D / 32);
    constexpr int N_BIG = 2 * (D / 64) * (NAW / 32) + 2 * (NAW / 64) * (D / 32) + (D / 64) * (D / 32) + N_AMAX;
    constexpr int NITEMS = N_BIG + NSM * IT_SM;
    for (int it = F.gw; it < NSTRIP + NITEMS; it += F.ngw) {
        if (it < NSTRIP) {
            int q = it; const float* src; int ld, n0, drow0; signed char* dst; float* cs;
            if (q < S_Q) { src = w_in; ld = INW; n0 = 32 * q; dst = W8; drow0 = n0; cs = CS + CS_QKM; }
            else if ((q -= S_Q) < S_Q) { src = w_in + NAW; ld = INW; n0 = 32 * q; dst = W8; drow0 = 2048 + n0; cs = CS + CS_QKM; }
            else if ((q -= S_Q) < S_M) { src = F.in_WM; ld = 2 * D; n0 = 32 * q; dst = W8; drow0 = 4096 + n0; cs = CS + CS_QKM; }
            else if ((q -= S_M) < S_Q) { src = w_in + 2 * NAW; ld = INW; n0 = 32 * q; dst = WV8; drow0 = n0; cs = CS + CS_V; }
            else if ((q -= S_Q) < S_F) { src = F.in_WFG; ld = DFF; n0 = 32 * q; dst = WGU8; drow0 = (n0 >> 7) * 256 + (n0 & 127); cs = CS + CS_GU; }
            else { q -= S_F; src = F.in_WFU; ld = DFF; n0 = 32 * q; dst = WGU8; drow0 = (n0 >> 7) * 256 + 128 + (n0 & 127); cs = CS + CS_GU; }
            tr_strip_i8(src, ld, D, n0, dst, drow0, cs, scr, F.lane);
            continue;
        }
        int r = it - NSTRIP;
        TR_JOB(w_in + 3 * NAW, INW, D, NAW, WCAT, 0 + n0)
        TR_JOB(w_in + 4 * NAW, INW, D, NAW, WCAT, 2048 + n0)
        TR_JOB(F.in_WNO, D, NAW, D, wsp<bf16_t>(F, WS_WNO), n0)
        TR_JOB(F.in_WLO, D, LW, D, wsp<bf16_t>(F, WS_WLO), n0)
        TR_JOB(F.in_WOUT, D, D, D, wsp<bf16_t>(F, WS_WO), n0)
        if (r < N_AMAX) { had_tile_amax(F.in_WFD, D, 64 * (r / (D / 32)), 32 * (r % (D / 32)), (unsigned*)(F.ws + WS_AM), scr, F.lane); continue; } r -= N_AMAX;
        {
            const int mi = r / IT_SM, ri = r % IT_SM, d = mi >> 5, g = (mi >> 4) & 1, n = mi & 15, kb = ri >> 2, nb = ri & 3;
            const float* src = (g ? F.in_WI : F.in_WR) + (size_t)(d * NBLK + n) * BW * BW;
            tr_item(src, BW, 64 * kb, 32 * nb, wsp<bf16_t>(F, WS_WG) + (size_t)mi * BW * BW, BW, 32 * nb, scr, F.lane);
        }
    }
    LAS f32x4* gl = (LAS f32x4*)(F.lds + 69632);
    for (int i = tid_; i < D / 4; i += NTHR) gl[i] = ((const f32x4*)F.in_GMPRE)[i];
    __syncthreads();
    bf16_t* XN = wsp<bf16_t>(F, WS_XN); signed char* XN8 = wsp<signed char>(F, WS_XN8); float* RS1 = wsp<float>(F, WS_RS1);
    for (int m = F.gw; m < L; m += F.ngw) {
        asm volatile("" ::: "memory");
        const f32x4* xr = (const f32x4*)xrow(F, m) + F.lane;
        f32x4 v[16]; float s = 0.f;
#pragma unroll
        for (int j = 0; j < 16; ++j) { v[j] = xr[64 * j]; s += (v[j].x * v[j].x + v[j].y * v[j].y) + (v[j].z * v[j].z + v[j].w * v[j].w); }
        const float rstd = 1.0f / sqrtf(wave_sum(s) * (1.0f / D) + EPS);
        u32x2* o8 = (u32x2*)(XN + (size_t)m * D) + F.lane; unsigned* o4 = (unsigned*)(XN8 + (size_t)m * D) + F.lane;
        float mx = 0.f;
#pragma unroll
        for (int j = 0; j < 16; ++j) { v[j] = v[j] * rstd * gl[F.lane + 64 * j]; mx = fmaxf(fmaxf(mx, fmaxf(fabsf(v[j].x), fabsf(v[j].y))), fmaxf(fabsf(v[j].z), fabsf(v[j].w))); }
        const float amax = fmaxf(wave_max(mx), 1e-20f), inv = 127.0f / amax;
        if (F.lane == 0) RS1[m] = amax * (1.0f / 127.0f);
#pragma unroll
        for (int j = 0; j < 16; ++j) { const f32x4 y = v[j]; u32x2 o; o.x = pk2(y.x, y.y); o.y = pk2(y.z, y.w); o8[64 * j] = o;
            o4[64 * j] = pk4_i8(rintf(y.x * inv), rintf(y.y * inv), rintf(y.z * inv), rintf(y.w * inv)); }
    }
    __syncthreads();
}

#ifndef ATT_SYNC
#define ATT_SYNC 1
#endif
template <int ADBG = 0> __device__ __forceinline__ void attn_mfma(Frame& F) {
    const int tid_ = opaque(F.tid);
    bf16_t* Q = wsp<bf16_t>(F, WS_Q); const bf16_t* Kb = wsp<bf16_t>(F, WS_K); const bf16_t* VT = wsp<bf16_t>(F, WS_VT);
    LAS float* rp = (LAS float*)F.lds;
    for (int i = tid_; i < NH * 15 * 31; i += NTHR) rp[i] = F.in_RPB[i];
    __syncthreads();
    const int fr = F.lane & 15, fq = F.lane >> 4;
    const float scale = 0.08838834764831845f;
    for (int base = blockIdx.x * NWAVES; base < (L / GRIDW) * NH * 4; base += F.ngw) {
        const int item = base + F.wave;
        asm volatile("" ::: "memory");
        const int g = item & 3, h = (item >> 2) & 15, rg = item >> 6;
        const int s0 = rg < LP / GRIDW ? 0 : LP, rows = rg < LP / GRIDW ? LP / GRIDW : LS / GRIDW, r = rg < LP / GRIDW ? rg : rg - LP / GRIDW;
        int rs = r - 4; rs = rs < 0 ? 0 : (rs > rows - 8 ? rows - 8 : rs);
        const int w0 = g == 0 ? 0 : (g == 1 ? 8 : (g == 2 ? 24 : 32));
        const int c = 16 * g + fr;
        int cs = c - 8; cs = cs < 0 ? 0 : (cs > GRIDW - 16 ? GRIDW - 16 : cs);
        bf16_t* qrow = Q + (size_t)(s0 + r * GRIDW + c) * NAW + h * HD;
        bf16x8 qf[4];
#pragma unroll
        for (int s = 0; s < 4; ++s) qf[s] = *(const bf16x8*)(qrow + 8 * fq + 32 * s);
        f32x4 sacc[8][2];
        const int Rg = s0 / GRIDW + rs, p0 = w0 >> 3;
        const bf16_t* kbase = Kb + (size_t)(Rg * 16 + h) * 8192 + p0 * 128 + fr * 32 + fq * 8;
        bf16x8 kb[8][2][4];
#define ATT_LDK(kr) do { _Pragma("unroll") for (int T = 0; T < 2; ++T) _Pragma("unroll") for (int s = 0; s < 4; ++s) kb[kr][T][s] = (ADBG & 1) ? qf[s] : (ADBG & 4) ? *(const bf16x8*)(Kb + (size_t)(s0 + rs * GRIDW) * NAW + h * HD * GRIDW + ((kr) * 8 + T * 4 + s) * 512 + F.lane * 8) : *(const bf16x8*)(kbase + (size_t)(kr) * (16 * 8192) + (s * 2 + T) * 1024); } while (0)
        ATT_LDK(0); ATT_LDK(1);
#pragma unroll
        for (int kr = 0; kr < 8; ++kr) {
            if (ATT_SYNC && (kr & 1) == 0) __builtin_amdgcn_s_barrier();
            if (kr + 2 < 8) ATT_LDK(kr + 2);
            __builtin_amdgcn_sched_barrier(0);
#pragma unroll
            for (int T = 0; T < 2; ++T) { f32x4 a = (f32x4){0.f, 0.f, 0.f, 0.f};
#pragma unroll
                for (int s = 0; s < 4; ++s) a = __builtin_amdgcn_mfma_f32_16x16x32_bf16(kb[kr][T][s], qf[s], a, 0, 0, 0);
                sacc[kr][T] = a; }
            __builtin_amdgcn_sched_barrier(0);
        }
#undef ATT_LDK
        bf16x8 vb[8][8];
        const bf16_t* vbase = VT + (size_t)(Rg * 16 + h) * 8192 + p0 * 128 + fq * 128 + fr * 8;
#define ATT_LDV(kr) do { _Pragma("unroll") for (int dt = 0; dt < 8; ++dt) vb[kr][dt] = (ADBG & 2) ? qf[dt & 3] : (ADBG & 4) ? *(const bf16x8*)(VT + (size_t)(h * HD) * L + s0 + rs * GRIDW + ((kr) * 8 + dt) * 512 + F.lane * 8) : *(const bf16x8*)(vbase + (size_t)(kr) * (16 * 8192) + dt * 1024); } while (0)
        ATT_LDV(0); ATT_LDV(1);
        __builtin_amdgcn_sched_barrier(0);
        const int elo = cs - w0 - 8 * fq, dc0 = w0 + 8 * fq - c + 15;
        const LAS float* rph = rp + h * 465 + (rs - r + 7) * 31;
        float mx = -3.0e38f;
#pragma unroll
        for (int e = 0; e < 8; ++e) { const bool valid = (e >= elo) && (e < elo + 16); const int bi = valid ? dc0 + e : 0;
#pragma unroll
            for (int kr = 0; kr < 8; ++kr) { const float sv = valid ? sacc[kr][e >> 2][e & 3] * scale + rph[kr * 31 + bi] : -3.0e38f; sacc[kr][e >> 2][e & 3] = sv; mx = fmaxf(mx, sv); } }
        mx = fmaxf(mx, __shfl_xor(mx, 16)); mx = fmaxf(mx, __shfl_xor(mx, 32));
        float lsum = 0.f; bf16x8 pf[8];
#pragma unroll
        for (int kr = 0; kr < 8; ++kr) { float p[8];
#pragma unroll
            for (int e = 0; e < 8; ++e) { p[e] = __expf(sacc[kr][e >> 2][e & 3] - mx); lsum += p[e]; }
            u32x4 w; w.x = pk2(p[0], p[1]); w.y = pk2(p[2], p[3]); w.z = pk2(p[4], p[5]); w.w = pk2(p[6], p[7]);
            pf[kr] = __builtin_bit_cast(bf16x8, w); }
        lsum += __shfl_xor(lsum, 16); lsum += __shfl_xor(lsum, 32);
        f32x4 oacc[8];
#pragma unroll
        for (int dt = 0; dt < 8; ++dt) oacc[dt] = (f32x4){0.f, 0.f, 0.f, 0.f};
#pragma unroll
        for (int kr = 0; kr < 8; ++kr) {
            if (ATT_SYNC && (kr & 1) == 0) __builtin_amdgcn_s_barrier();
            if (kr + 2 < 8) ATT_LDV(kr + 2);
            __builtin_amdgcn_sched_barrier(0);
#pragma unroll
            for (int dt = 0; dt < 8; ++dt) oacc[dt] = __builtin_amdgcn_mfma_f32_16x16x32_bf16(vb[kr][dt], pf[kr], oacc[dt], 0, 0, 0);
            __builtin_amdgcn_sched_barrier(0);
        }
#undef ATT_LDV
        const float inv = 1.0f / lsum;
#ifdef ATTN_OUT_OFF
        bf16_t* orow = wsp<bf16_t>(F, (size_t)ATTN_OUT_OFF * MiB) + (size_t)(s0 + r * GRIDW + c) * NAW + h * HD;
#else
        bf16_t* orow = qrow;
#endif
#pragma unroll
        for (int u = 0; u < 4; ++u) *(u32x4*)(orow + 32 * u + 8 * fq) = pg8::pack8(oacc[2 * u] * inv, oacc[2 * u + 1] * inv);
    }
    __syncthreads();
}

__device__ __forceinline__ void attn_mfma_lds(Frame& F) {
    const int tid_ = opaque(F.tid);
    bf16_t* Q = wsp<bf16_t>(F, WS_Q); const bf16_t* Kb = wsp<bf16_t>(F, WS_K); const bf16_t* VT = wsp<bf16_t>(F, WS_VT);
    LAS float* rp = (LAS float*)F.lds;
    LAS unsigned char* ring = F.lds + 30720;
    for (int i = tid_; i < NH * 15 * 31; i += NTHR) rp[i] = F.in_RPB[i];
    __syncthreads();
    const int lane = tid_ & 63, fr = lane & 15, fq = lane >> 4, w = F.wave, hl = w >> 2, g = w & 3;
    const float scale = 0.08838834764831845f;
    constexpr int NIT = (L / GRIDW) * NH * 4;
    const int w0 = g == 0 ? 0 : (g == 1 ? 8 : (g == 2 ? 24 : 32)), p0 = w0 >> 3;
    const int c = 16 * g + fr;
    int cs = c - 8; cs = cs < 0 ? 0 : (cs > GRIDW - 16 ? GRIDW - 16 : cs);
#define ATL_SRC(b, st) ([&]() -> const bf16_t* { const int rg_ = (b) >> 6, hb_ = ((b) >> 2) & 15; const int rows_ = rg_ < LP / GRIDW ? LP / GRIDW : LS / GRIDW, r_ = rg_ < LP / GRIDW ? rg_ : rg_ - LP / GRIDW; \
        int rs_ = r_ - 4; rs_ = rs_ < 0 ? 0 : (rs_ > rows_ - 8 ? rows_ - 8 : rs_); const int Rg_ = (rg_ < LP / GRIDW ? 0 : LP / GRIDW) + rs_; \
        return ((st) < 8 ? Kb : VT) + (size_t)((Rg_ + ((st) & 7)) * 16 + hb_) * 8192; }())
#define ATL_ISSUE(src, slot) do { const bf16_t* s_ = (src) + tid_ * 8; LAS unsigned char* d_ = ring + (slot) * 32768 + w * 1024; _Pragma("unroll") for (int k_ = 0; k_ < 4; ++k_) \
        __builtin_amdgcn_global_load_lds((const unsigned*)(s_ + k_ * 4096), (LAS unsigned*)(d_ + k_ * 8192), 16, 0, 0); } while (0)
    int base = blockIdx.x * NWAVES;
    if (base < NIT) { ATL_ISSUE(ATL_SRC(base, 0), 0); ATL_ISSUE(ATL_SRC(base, 1), 1); }
    int b0 = 0;
    for (; base < NIT; base += F.ngw) {
        asm volatile("" ::: "memory");
        const int h = ((base >> 2) & 15) + hl, rg = base >> 6;
        const int s0 = rg < LP / GRIDW ? 0 : LP, rows = rg < LP / GRIDW ? LP / GRIDW : LS / GRIDW, r = rg < LP / GRIDW ? rg : rg - LP / GRIDW;
        int rs = r - 4; rs = rs < 0 ? 0 : (rs > rows - 8 ? rows - 8 : rs);
        const int nbase = base + F.ngw < NIT ? base + F.ngw : base;
        bf16_t* qrow = Q + (size_t)(s0 + r * GRIDW + c) * NAW + h * HD;
        bf16x8 qf[4];
#pragma unroll
        for (int s = 0; s < 4; ++s) qf[s] = *(const bf16x8*)(qrow + 8 * fq + 32 * s);
        f32x4 sacc[8][2]; f32x4 oacc[8]; bf16x8 pf[8]; float lsum = 0.f;
#pragma unroll
        for (int dt = 0; dt < 8; ++dt) oacc[dt] = (f32x4){0.f, 0.f, 0.f, 0.f};
        const int koff = hl * 16384 + (p0 * 128 + fr * 32 + fq * 8) * 2, voff = hl * 16384 + (p0 * 128 + fq * 128 + fr * 8) * 2;
#pragma unroll
        for (int st = 0; st < 16; ++st) {
            asm volatile("s_waitcnt vmcnt(4)" ::: "memory"); asm volatile("s_waitcnt lgkmcnt(0)" ::: "memory"); __builtin_amdgcn_s_barrier(); asm volatile("" ::: "memory");
            { const int slot2 = (b0 + st + 2) % 3; if (st + 2 < 16) ATL_ISSUE(ATL_SRC(base, st + 2), slot2); else ATL_ISSUE(ATL_SRC(nbase, st + 2 - 16), slot2); }
            const LAS unsigned char* buf = ring + ((b0 + st) % 3) * 32768;
            if (st < 8) {
#pragma unroll
                for (int T = 0; T < 2; ++T) { f32x4 a = (f32x4){0.f, 0.f, 0.f, 0.f};
#pragma unroll
                    for (int s2 = 0; s2 < 4; ++s2) a = __builtin_amdgcn_mfma_f32_16x16x32_bf16(*(const LAS bf16x8*)(buf + koff + (s2 * 2 + T) * 2048), qf[s2], a, 0, 0, 0);
                    sacc[st][T] = a; }
            } else {
                if (st == 8) {
                    const int elo = cs - w0 - 8 * fq, dc0 = w0 + 8 * fq - c + 15;
                    const LAS float* rph = rp + h * 465 + (rs - r + 7) * 31;
                    float mx = -3.0e38f;
#pragma unroll
                    for (int e = 0; e < 8; ++e) { const bool valid = (e >= elo) && (e < elo + 16); const int bi = valid ? dc0 + e : 0;
#pragma unroll
                        for (int kr = 0; kr < 8; ++kr) { const float sv = valid ? sacc[kr][e >> 2][e & 3] * scale + rph[kr * 31 + bi] : -3.0e38f; sacc[kr][e >> 2][e & 3] = sv; mx = fmaxf(mx, sv); } }
                    mx = fmaxf(mx, __shfl_xor(mx, 16)); mx = fmaxf(mx, __shfl_xor(mx, 32));
#pragma unroll
                    for (int kr = 0; kr < 8; ++kr) { float p[8];
#pragma unroll
                        for (int e = 0; e < 8; ++e) { p[e] = __expf(sacc[kr][e >> 2][e & 3] - mx); lsum += p[e]; }
                        u32x4 wv; wv.x = pk2(p[0], p[1]); wv.y = pk2(p[2], p[3]); wv.z = pk2(p[4], p[5]); wv.w = pk2(p[6], p[7]);
                        pf[kr] = __builtin_bit_cast(bf16x8, wv); }
                    lsum += __shfl_xor(lsum, 16); lsum += __shfl_xor(lsum, 32);
                }
#pragma unroll
                for (int dt = 0; dt < 8; ++dt) oacc[dt] = __builtin_amdgcn_mfma_f32_16x16x32_bf16(*(const LAS bf16x8*)(buf + voff + dt * 2048), pf[st - 8], oacc[dt], 0, 0, 0);
            }
        }
        b0 = (b0 + 16) % 3;
        const float inv = 1.0f / lsum;
#pragma unroll
        for (int u = 0; u < 4; ++u) *(u32x4*)(qrow + 32 * u + 8 * fq) = pg8::pack8(oacc[2 * u] * inv, oacc[2 * u + 1] * inv);
    }
#undef ATL_SRC
#undef ATL_ISSUE
    asm volatile("s_waitcnt vmcnt(0)" ::: "memory");
    __syncthreads();
}

__device__ __forceinline__ void conv_phase(Frame& F) {
    const int tid_ = opaque(F.tid);
    const bf16_t* XR = wsp<bf16_t>(F, WS_XR); bf16_t* XC = wsp<bf16_t>(F, WS_XC);
    const float* wc = F.in_WCONV; const float* bc = F.in_BCONV;
    const int nth = F.G * NTHR;
    for (int it = blockIdx.x * NTHR + tid_; it < L * (LW / 8); it += nth) {
        const int t = it / (LW / 8), c0 = (it % (LW / 8)) * 8;
        const int s0 = t < LP ? 0 : LP, len = t < LP ? LP : LS, tl = t - s0;
        float acc[8];
#pragma unroll
        for (int e = 0; e < 8; ++e) acc[e] = bc[c0 + e];
#pragma unroll
        for (int j = 0; j < 4; ++j) { const int tt = tl + j - 2; if (tt < 0 || tt >= len) continue;
            f32x4 x0, x1; pg8::unpack8(*(const u32x4*)(XR + (size_t)(s0 + tt) * LW + c0), x0, x1);
            const f32x4 w0 = *(const f32x4*)(wc + j * LW + c0), w1 = *(const f32x4*)(wc + j * LW + c0 + 4);
#pragma unroll
            for (int e = 0; e < 4; ++e) { acc[e] += w0[e] * x0[e]; acc[4 + e] += w1[e] * x1[e]; } }
        *(u32x4*)(XC + (size_t)t * LW + c0) = pg8::pack8((f32x4){acc[0], acc[1], acc[2], acc[3]}, (f32x4){acc[4], acc[5], acc[6], acc[7]});
    }
}

struct LruW { bf16x8 w[2][4]; float br, bi, cl; };
template <int DIR> __device__ __forceinline__ void lru_load_w(const Frame& F, LruW& W, int n, int w, int fr, int fq) {
    const bf16_t* wg = wsp<bf16_t>(F, WS_WG);
#pragma unroll
    for (int g = 0; g < 2; ++g)
#pragma unroll
        for (int s = 0; s < 4; ++s) W.w[g][s] = *(const bf16x8*)(wg + ((size_t)((DIR * 2 + g) * NBLK + n) * BW + 16 * w + fr) * BW + 32 * fq + 8 * s);
    const int ch = n * BW + 16 * w + fr;
    W.br = -1.44269504f * F.in_BR[DIR * LW + ch]; W.bi = -1.44269504f * F.in_BI[DIR * LW + ch];
    const float lam = F.in_LAM[DIR * LW + ch];
    W.cl = -8.0f * 1.44269504f * ((lam > 15.f) ? __expf(-lam) : log1pf(__expf(-lam)));
}
template <int LDBG = 0> __device__ __forceinline__ void lru_gate(float pr, float pi, float xc, const LruW& W, bool first, float& a, float& u) {
    if constexpr (LDBG == 1) { a = pr + W.br; u = pi * xc + W.bi; return; }
    const float r = __builtin_amdgcn_rcpf(1.0f + __builtin_amdgcn_exp2f(__builtin_fmaf(pr, -1.44269504f, W.br))), d = 1.0f + __builtin_amdgcn_exp2f(__builtin_fmaf(pi, -1.44269504f, W.bi));
    a = __builtin_amdgcn_exp2f(W.cl * r);
    const float y = first ? 1.0f : fmaxf(1.0f - a * a, 0.f);
    u = xc * y * __builtin_amdgcn_rsqf(fmaxf(y, 1e-30f) * d * d);
}
struct LruX { bf16x8 x[4][4]; };
__device__ __forceinline__ void lru_load_x(LruX& X, const bf16_t* XC, int tb, int n, int fr, int fq) {
#pragma unroll
    for (int tau = 0; tau < 4; ++tau) { const bf16_t* xp = XC + ((size_t)((((tb >> 6) * NBLK + n) * 4 + tau) * 4) * 64 + fr * 4 + fq) * 8;
#pragma unroll
        for (int s = 0; s < 4; ++s) X.x[tau][s] = *(const bf16x8*)(xp + s * 512); }
}
__device__ __forceinline__ void lru_tile(const LruX& X, int tau, bool hiw, const LruW& W, const bf16x8 idf0, const bf16x8 idf1, f32x4& pr, f32x4& pi, f32x4& xct) {
    pr = (f32x4){0.f, 0.f, 0.f, 0.f}; pi = pr;
#pragma unroll
    for (int s = 0; s < 4; ++s) { pr = __builtin_amdgcn_mfma_f32_16x16x32_bf16(X.x[tau][s], W.w[0][s], pr, 0, 0, 0); pi = __builtin_amdgcn_mfma_f32_16x16x32_bf16(X.x[tau][s], W.w[1][s], pi, 0, 0, 0); }
    const bf16x8 x0 = hiw ? X.x[tau][2] : X.x[tau][0], x1 = hiw ? X.x[tau][3] : X.x[tau][1];
    xct = __builtin_amdgcn_mfma_f32_16x16x32_bf16(x0, idf0, (f32x4){0.f, 0.f, 0.f, 0.f}, 0, 0, 0);
    xct = __builtin_amdgcn_mfma_f32_16x16x32_bf16(x1, idf1, xct, 0, 0, 0);
}
__device__ __forceinline__ void lru_idfrags(int w, int fr, int fq, bf16x8& idf0, bf16x8& idf1) {
#pragma unroll
    for (int e = 0; e < 8; ++e) { const bool on = (fq == (w >> 1)) && ((fr & 7) == e); idf0[e] = (on && fr < 8) ? (short)0x3F80 : (short)0; idf1[e] = (on && fr >= 8) ? (short)0x3F80 : (short)0; }
}
constexpr int LRU_CH = 256, LRU_NCH = L / LRU_CH, LRU_NCH_P = LP / LRU_CH;
__device__ __forceinline__ void conv_unit(Frame& F, int cg, int n) {
    const int tid_ = opaque(F.tid);
    const bf16_t* XR = wsp<bf16_t>(F, WS_XR); bf16_t* XC = wsp<bf16_t>(F, WS_XC);
    const float* wc = F.in_WCONV; const float* bc = F.in_BCONV;
    const int c0 = n * BW + (tid_ & 15) * 8;
    const int s0 = cg < LRU_NCH_P ? 0 : LP, len = cg < LRU_NCH_P ? LP : LS;
    f32x4 w[4][2]; f32x4 b0 = *(const f32x4*)(bc + c0), b1 = *(const f32x4*)(bc + c0 + 4);
#pragma unroll
    for (int j = 0; j < 4; ++j) { w[j][0] = *(const f32x4*)(wc + j * LW + c0); w[j][1] = *(const f32x4*)(wc + j * LW + c0 + 4); }
#pragma unroll
    for (int i = 0; i < 8; ++i) {
        const int t = cg * LRU_CH + (tid_ >> 4) + 32 * i, tl = t - s0;
        f32x4 a0 = b0, a1 = b1;
#pragma unroll
        for (int j = 0; j < 4; ++j) { const int tt = tl + j - 2; if (tt < 0 || tt >= len) continue;
            f32x4 x0, x1; pg8::unpack8(*(const u32x4*)(XR + (size_t)(s0 + tt) * LW + c0), x0, x1); a0 += w[j][0] * x0; a1 += w[j][1] * x1; }
        const int tg = t & 63, cq = tid_ & 15;
        *(u32x4*)(XC + ((size_t)(((((t >> 6) * NBLK + n) * 4 + ((tg >> 2) & 3)) * 4 + (cq & 3)) * 16 + 4 * (tg >> 4) + (tg & 3)) * 4 + (cq >> 2)) * 8) = pg8::pack8(a0, a1);
    }
}
__device__ __forceinline__ void conv_req(const Frame& F, int cg, int n, int tid_, u32x4 (&R)[11]) {
    const bf16_t* XR = wsp<bf16_t>(F, WS_XR);
    const int s0 = cg < LRU_NCH_P ? 0 : LP, len = cg < LRU_NCH_P ? LP : LS;
    const int t0 = cg * LRU_CH + 8 * (tid_ >> 4) - 2, c0 = n * BW + (tid_ & 15) * 8;
#pragma unroll
    for (int k = 0; k < 11; ++k) { const int tl = t0 + k - s0; R[k] = (u32x4){0u, 0u, 0u, 0u}; if (tl >= 0 && tl < len) R[k] = *(const u32x4*)(XR + (size_t)(t0 + k) * LW + c0); }
}
__device__ __forceinline__ void conv_fin(const Frame& F, int cg, int n, int tid_, const u32x4 (&R)[11], LAS unsigned char* tile, const LAS float* cw) {
    bf16_t* XC = wsp<bf16_t>(F, WS_XC);
    const int g = tid_ >> 4, cq = tid_ & 15;
    f32x4 w[4][2];
#pragma unroll
    for (int j = 0; j < 4; ++j) { w[j][0] = *(const LAS f32x4*)(cw + j * BW + cq * 8); w[j][1] = *(const LAS f32x4*)(cw + j * BW + cq * 8 + 4); }
    const f32x4 b0 = *(const LAS f32x4*)(cw + 4 * BW + cq * 8), b1 = *(const LAS f32x4*)(cw + 4 * BW + cq * 8 + 4);
#pragma unroll
    for (int i = 0; i < 8; ++i) {
        f32x4 a0 = b0, a1 = b1;
#pragma unroll
        for (int j = 0; j < 4; ++j) { f32x4 x0, x1; pg8::unpack8(R[i + j], x0, x1); a0 += w[j][0] * x0; a1 += w[j][1] * x1; }
        const int t = cg * LRU_CH + 8 * g + i, tg = t & 63;
        const int fo = ((((((tg >> 2) & 3) * 4 + (cq & 3)) * 16 + 4 * (tg >> 4) + (tg & 3)) * 4 + (cq >> 2)) * 8);
        const u32x4 o = pg8::pack8(a0, a1);
        *(u32x4*)(XC + (size_t)((t >> 6) * NBLK + n) * 8192 + fo) = o;
        *(LAS u32x4*)(tile + ((t >> 6) & 3) * 16384 + fo * 2) = o;
    }
}
__device__ __forceinline__ void lru_load_x_lds(LruX& X, const LAS unsigned char* tile, int gl, int fr, int fq) {
#pragma unroll
    for (int tau = 0; tau < 4; ++tau)
#pragma unroll
        for (int s = 0; s < 4; ++s) X.x[tau][s] = *(const LAS bf16x8*)(tile + ((((gl * 4 + tau) * 4 + s) * 16 + fr) * 4 + fq) * 16);
}
__device__ __forceinline__ void lru_pass_a(Frame& F) {
    const int tid_ = opaque(F.tid);
    const int fr = F.lane & 15, fq = F.lane >> 4, w = F.wave;
    f32x2* SUMM = wsp<f32x2>(F, WS_SUM);
    LAS unsigned char* tile = F.lds; LAS float* cw = (LAS float*)(F.lds + 65536);
    bf16x8 idf0, idf1; lru_idfrags(w, fr, fq, idf0, idf1);
    int u = blockIdx.x, ncur = -1;
    u32x4 R[11];
    if (u < LRU_NCH * NBLK) conv_req(F, u >> 4, u & 15, tid_, R);
    LruW Wf, Wb;
    for (; u < LRU_NCH * NBLK; u += F.G) {
        const int cg = u >> 4, n = u & 15;
        if (n != ncur) {
            ncur = n; lru_load_w<0>(F, Wf, n, w, fr, fq); lru_load_w<1>(F, Wb, n, w, fr, fq);
            for (int i = tid_; i < 5 * BW; i += NTHR) cw[i] = i < 4 * BW ? F.in_WCONV[(i >> 7) * LW + n * BW + (i & 127)] : F.in_BCONV[n * BW + (i & 127)];
            LDS_WAIT(); __builtin_amdgcn_s_barrier();
        }
        asm volatile("" ::: "memory");
        conv_fin(F, cg, n, tid_, R, tile, cw);
        { const int un = u + F.G; if (un < LRU_NCH * NBLK) conv_req(F, un >> 4, un & 15, tid_, R); }
        LDS_WAIT(); __builtin_amdgcn_s_barrier();
        const bool c_first = (cg == 0 || cg == LRU_NCH_P), c_last = (cg == LRU_NCH_P - 1 || cg == LRU_NCH - 1);
        float Af = 1.f, Hf = 0.f, Ab = 1.f, Hb = 0.f;
        for (int gi = 0; gi < 4; ++gi) {
            float pf = 1.f, hf = 0.f, pb = 1.f, hb = 0.f;
#pragma unroll 2
            for (int tau = 0; tau < 4; ++tau) {
                bf16x8 x[4];
#pragma unroll
                for (int s_ = 0; s_ < 4; ++s_) x[s_] = *(const LAS bf16x8*)(tile + ((((gi * 4 + tau) * 4 + s_) * 16 + fr) * 4 + fq) * 16);
                f32x4 prf = (f32x4){0.f, 0.f, 0.f, 0.f}, pif = prf, prb = prf, pib = prf, xct;
#pragma unroll
                for (int s_ = 0; s_ < 4; ++s_) { prf = __builtin_amdgcn_mfma_f32_16x16x32_bf16(x[s_], Wf.w[0][s_], prf, 0, 0, 0); pif = __builtin_amdgcn_mfma_f32_16x16x32_bf16(x[s_], Wf.w[1][s_], pif, 0, 0, 0);
                    prb = __builtin_amdgcn_mfma_f32_16x16x32_bf16(x[s_], Wb.w[0][s_], prb, 0, 0, 0); pib = __builtin_amdgcn_mfma_f32_16x16x32_bf16(x[s_], Wb.w[1][s_], pib, 0, 0, 0); }
                xct = __builtin_amdgcn_mfma_f32_16x16x32_bf16((w & 1) ? x[2] : x[0], idf0, (f32x4){0.f, 0.f, 0.f, 0.f}, 0, 0, 0);
                xct = __builtin_amdgcn_mfma_f32_16x16x32_bf16((w & 1) ? x[3] : x[1], idf1, xct, 0, 0, 0);
#pragma unroll
                for (int j = 0; j < 4; ++j) {
                    float a, uu;
                    lru_gate(prf[j], pif[j], xct[j], Wf, c_first && gi == 0 && fq == 0 && tau == 0 && j == 0, a, uu); hf = a * hf + uu; pf *= a;
                    lru_gate(prb[j], pib[j], xct[j], Wb, c_last && gi == 3 && fq == 3 && tau == 3 && j == 3, a, uu); hb += pb * uu; pb *= a;
                }
            }
            float gPf = 1.f, gHf = 0.f, gPb = 1.f, gHb = 0.f;
#pragma unroll
            for (int qq = 0; qq < 4; ++qq) { const int src = fr + 16 * qq;
                float P = __shfl(pf, src), H = __shfl(hf, src); gHf = P * gHf + H; gPf *= P;
                P = __shfl(pb, src); H = __shfl(hb, src); gHb += gPb * H; gPb *= P; }
            Hf = gPf * Hf + gHf; Af *= gPf; Hb += Ab * gHb; Ab *= gPb;
        }
        if (fq == 0) { const int ch = n * BW + 16 * w + fr; SUMM[(size_t)(cg * 2 + 0) * LW + ch] = (f32x2){Af, Hf}; SUMM[(size_t)(cg * 2 + 1) * LW + ch] = (f32x2){Ab, Hb}; }
        LDS_WAIT(); __builtin_amdgcn_s_barrier();
    }
    VM_WAIT();
}
__device__ __forceinline__ void lru_pass_b(Frame& F) {
    const int tid_ = opaque(F.tid);
    const int gt = blockIdx.x * NTHR + tid_; if (gt >= 4 * LW) return;
    const int ch = gt % LW, d = (gt / LW) & 1, seq = gt / (2 * LW), c0 = seq ? LRU_NCH_P : 0, nc = seq ? LRU_NCH - LRU_NCH_P : LRU_NCH_P;
    const f32x2* SUMM = wsp<f32x2>(F, WS_SUM); float* CIN = wsp<float>(F, WS_SUM + 4 * MiB);
    float s = 0.f;
    for (int i0 = 0; i0 < nc; i0 += 32) {
        f32x2 ah[32];
#pragma unroll
        for (int e = 0; e < 32; ++e) { const int cg = d ? c0 + nc - 1 - (i0 + e) : c0 + i0 + e; ah[e] = SUMM[(size_t)(cg * 2 + d) * LW + ch]; }
#pragma unroll
        for (int e = 0; e < 32; ++e) { const int cg = d ? c0 + nc - 1 - (i0 + e) : c0 + i0 + e; CIN[(size_t)(cg * 2 + d) * LW + ch] = s; s = ah[e].x * s + ah[e].y; }
    }
}
template <int LDBG = 0> __device__ __forceinline__ void lru_pass_c(Frame& F) {
    const int tid_ = opaque(F.tid);
    const int fr = F.lane & 15, fq = F.lane >> 4, w = F.wave;
    const bf16_t* XC = wsp<bf16_t>(F, WS_XC); const float* CIN = wsp<float>(F, WS_SUM + 4 * MiB);
    const bf16_t* GR = wsp<bf16_t>(F, WS_GR); bf16_t* LRU = wsp<bf16_t>(F, WS_XR);
    LAS bf16_t* hfb = (LAS bf16_t*)(F.lds + w * 8192);
    LAS bf16_t* grt = (LAS bf16_t*)(F.lds + 65536);
    bf16x8 idf0, idf1; lru_idfrags(w, fr, fq, idf0, idf1);
    for (int u = blockIdx.x; u < LRU_NCH * NBLK; u += F.G) {
        const int cg = u >> 4, n = u & 15, ch = n * BW + 16 * w + fr;
        const bool c_first = (cg == 0 || cg == LRU_NCH_P), c_last = (cg == LRU_NCH_P - 1 || cg == LRU_NCH - 1);
        { const bf16_t* gsrc = GR + (size_t)(cg * LRU_CH + (tid_ >> 4)) * LW + n * BW + (tid_ & 15) * 8; LAS bf16_t* ldst = grt + w * 512;
#pragma unroll 1
          for (int k = 0; k < 8; ++k) { __builtin_amdgcn_global_load_lds((const unsigned*)gsrc, (LAS unsigned*)ldst, 16, 0, 0); gsrc += (size_t)32 * LW; ldst += NTHR * 8; } }
        LruX X, Xn;
        {
            LruW W; lru_load_w<0>(F, W, n, w, fr, fq);
            float s = CIN[(size_t)(cg * 2 + 0) * LW + ch];
            lru_load_x(X, XC, cg * LRU_CH, n, fr, fq);
            for (int gi = 0; gi < 4; ++gi) {
                if (gi < 3 && LDBG != 2) lru_load_x(Xn, XC, cg * LRU_CH + (gi + 1) * 64, n, fr, fq);
                float a[16], uu[16];
#pragma unroll
                for (int tau = 0; tau < 4; ++tau) { f32x4 pr, pi, xct; lru_tile(X, tau, (w & 1) != 0, W, idf0, idf1, pr, pi, xct);
#pragma unroll
                    for (int j = 0; j < 4; ++j) lru_gate<LDBG>(pr[j], pi[j], xct[j], W, c_first && gi == 0 && fq == 0 && tau == 0 && j == 0, a[4 * tau + j], uu[4 * tau + j]); }
                float p = 1.f, h = 0.f;
#pragma unroll
                for (int t = 0; t < 16; ++t) { h = a[t] * h + uu[t]; p *= a[t]; }
                float hin = s, sg = s;
#pragma unroll
                for (int qq = 0; qq < 4; ++qq) { const float P = __shfl(p, fr + 16 * qq), H = __shfl(h, fr + 16 * qq); sg = P * sg + H; if (qq < fq) hin = P * hin + H; }
                s = sg;
                float hh = hin;
#pragma unroll
                for (int t = 0; t < 16; ++t) { hh = a[t] * hh + uu[t]; hfb[(gi * 64 + 16 * fq + t) * 16 + fr] = (bf16_t)f2bf(hh); }
                X = Xn;
            }
        }
        {
            LruW W; lru_load_w<1>(F, W, n, w, fr, fq);
            float s = CIN[(size_t)(cg * 2 + 1) * LW + ch];
            VM_WAIT(); __syncthreads();
            for (int gi = 3; gi >= 0; --gi) {
                if (gi > 0 && LDBG != 2) lru_load_x(Xn, XC, cg * LRU_CH + (gi - 1) * 64, n, fr, fq);
                float a[16], uu[16];
#pragma unroll
                for (int tau = 0; tau < 4; ++tau) { f32x4 pr, pi, xct; lru_tile(X, tau, (w & 1) != 0, W, idf0, idf1, pr, pi, xct);
#pragma unroll
                    for (int j = 0; j < 4; ++j) lru_gate<LDBG>(pr[j], pi[j], xct[j], W, c_last && gi == 3 && fq == 3 && tau == 3 && j == 3, a[4 * tau + j], uu[4 * tau + j]); }
                float p = 1.f, h = 0.f;
#pragma unroll
                for (int t = 15; t >= 0; --t) { h = a[t] * h + uu[t]; p *= a[t]; }
                float hin = s, sg = s;
#pragma unroll
                for (int qq = 3; qq >= 0; --qq) { const float P = __shfl(p, fr + 16 * qq), H = __shfl(h, fr + 16 * qq); sg = P * sg + H; if (qq > fq) hin = P * hin + H; }
                s = sg;
                float hh = hin;
#pragma unroll
                for (int t = 15; t >= 0; --t) { hh = a[t] * hh + uu[t];
                    const int tl = gi * 64 + 16 * fq + t; LAS bf16_t* gp = grt + tl * BW + 16 * w + fr;
                    *gp = (bf16_t)f2bf((bf1(hfb[tl * 16 + fr]) + hh) * gelu_tanh(bf1(*gp))); }
                X = Xn;
            }
        }
        LDS_WAIT(); __syncthreads();
        { bf16_t* gdst = LRU + (size_t)(cg * LRU_CH + (tid_ >> 4)) * LW + n * BW + (tid_ & 15) * 8; const LAS bf16_t* lsrc = grt + tid_ * 8;
#pragma unroll 1
          for (int k = 0; k < 8; ++k) { *(u32x4*)gdst = *(const LAS u32x4*)lsrc; gdst += (size_t)32 * LW; lsrc += NTHR * 8; } }
        LDS_WAIT(); __syncthreads();
    }
}

constexpr int HQW_EARLY = 96 * (D / 32);
__device__ __forceinline__ void hq_wtiles(Frame& F, int lo, int hi, int first, int stride) {
    const int lane = opaque(F.tid) & 63;
    LAS float* scr = (LAS float*)(F.lds + F.wave * 8448);
    for (int it = lo + first; it < hi; it += stride)
        had_tile_quant(F.in_WFD, D, DFF, 64 * (it / (D / 32)), 32 * (it % (D / 32)), wsp<signed char>(F, WS_WD), (const unsigned*)(F.ws + WS_AM), wsp<float>(F, WS_CS) + CS_D, scr, lane);
}
__device__ __forceinline__ void hq_phase(Frame& F) {
    const int lane = opaque(F.tid) & 63;
    const bf16_t* H0 = (const bf16_t*)F.out; const bf16_t* H1 = wsp<bf16_t>(F, WS_HIDS);
    signed char* Q0 = wsp<signed char>(F, WS_H8P); signed char* Q1 = wsp<signed char>(F, WS_H8S); float* RS3 = wsp<float>(F, WS_RS3);
    hq_wtiles(F, HQW_EARLY, (DFF / 64) * (D / 32), F.gw, F.ngw);
    constexpr int NB = DFF / 32;
    for (int m = F.gw; m < L; m += F.ngw) {
        const bf16_t* src = m < LP ? H0 + (size_t)m * DFF : H1 + (size_t)(m - LP) * DFF;
        signed char* dst = m < LP ? Q0 + (size_t)m * DFF : Q1 + (size_t)(m - LP) * DFF;
        u32x4 raw[6][4];
#pragma unroll
        for (int it = 0; it < 6; ++it) { const int b = lane + 64 * it; const u32x4* p = (const u32x4*)(src + (b < NB ? b : lane) * 32);
#pragma unroll
            for (int i = 0; i < 4; ++i) raw[it][i] = p[i]; }
        float mx = 0.f;
#pragma unroll
        for (int it = 0; it < 6; ++it) { float v[32];
#pragma unroll
            for (int i = 0; i < 4; ++i) { const u32x4 u = raw[it][i]; v[8 * i + 0] = bflo(u.x); v[8 * i + 1] = bfhi(u.x); v[8 * i + 2] = bflo(u.y); v[8 * i + 3] = bfhi(u.y); v[8 * i + 4] = bflo(u.z); v[8 * i + 5] = bfhi(u.z); v[8 * i + 6] = bflo(u.w); v[8 * i + 7] = bfhi(u.w); }
            fwht32(v);
            float bm = 0.f;
#pragma unroll
            for (int i = 0; i < 32; ++i) bm = fmaxf(bm, fabsf(v[i]));
            mx = fmaxf(mx, (lane + 64 * it < NB) ? bm : 0.f); }
        const float amax = fmaxf(wave_max(mx), 1e-20f), inv = 127.0f / amax;
        if (lane == 0) RS3[m] = amax * (1.0f / 127.0f);
#pragma unroll
        for (int it = 0; it < 6; ++it) { const int b = lane + 64 * it; float v[32];
#pragma unroll
            for (int i = 0; i < 4; ++i) { const u32x4 u = raw[it][i]; v[8 * i + 0] = bflo(u.x); v[8 * i + 1] = bfhi(u.x); v[8 * i + 2] = bflo(u.y); v[8 * i + 3] = bfhi(u.y); v[8 * i + 4] = bflo(u.z); v[8 * i + 5] = bfhi(u.z); v[8 * i + 6] = bflo(u.w); v[8 * i + 7] = bfhi(u.w); }
            fwht32(v);
            u32x4 o0, o1;
            o0.x = pk4_i8(rintf(v[0] * inv), rintf(v[1] * inv), rintf(v[2] * inv), rintf(v[3] * inv)); o0.y = pk4_i8(rintf(v[4] * inv), rintf(v[5] * inv), rintf(v[6] * inv), rintf(v[7] * inv));
            o0.z = pk4_i8(rintf(v[8] * inv), rintf(v[9] * inv), rintf(v[10] * inv), rintf(v[11] * inv)); o0.w = pk4_i8(rintf(v[12] * inv), rintf(v[13] * inv), rintf(v[14] * inv), rintf(v[15] * inv));
            o1.x = pk4_i8(rintf(v[16] * inv), rintf(v[17] * inv), rintf(v[18] * inv), rintf(v[19] * inv)); o1.y = pk4_i8(rintf(v[20] * inv), rintf(v[21] * inv), rintf(v[22] * inv), rintf(v[23] * inv));
            o1.z = pk4_i8(rintf(v[24] * inv), rintf(v[25] * inv), rintf(v[26] * inv), rintf(v[27] * inv)); o1.w = pk4_i8(rintf(v[28] * inv), rintf(v[29] * inv), rintf(v[30] * inv), rintf(v[31] * inv));
            if (b < NB) { *(u32x4*)(dst + b * 32) = o0; *(u32x4*)(dst + b * 32 + 16) = o1; } }
    }
}

__device__ __forceinline__ f32x4 up4(const u32x2 u) { return (f32x4){bflo(u.x), bfhi(u.x), bflo(u.y), bfhi(u.y)}; }
__device__ __forceinline__ void mid_phase(Frame& F) {
    const int tid_ = opaque(F.tid);
    bf16_t* MIX = wsp<bf16_t>(F, WS_MIX); signed char* XN8 = wsp<signed char>(F, WS_XN8); float* RS2 = wsp<float>(F, WS_RS2);
    LAS f32x4* gpost = (LAS f32x4*)F.lds; LAS f32x4* gpre = gpost + D / 4;
    for (int i = tid_; i < D / 4; i += NTHR) { gpost[i] = ((const f32x4*)F.in_GMPOST)[i]; gpre[i] = ((const f32x4*)F.in_GFPRE)[i]; }
    __syncthreads();
    for (int m = F.gw; m < L; m += F.ngw) {
        asm volatile("" ::: "memory");
        const f32x4* xr = (const f32x4*)xrow(F, m) + F.lane; const u32x2* mr = (const u32x2*)(MIX + (size_t)m * D) + F.lane;
        f32x4 v[16]; u32x2 mx[16]; float s = 0.f;
#pragma unroll
        for (int j = 0; j < 16; ++j) { v[j] = xr[64 * j]; mx[j] = mr[64 * j]; const f32x4 a = up4(mx[j]); s += (a.x * a.x + a.y * a.y) + (a.z * a.z + a.w * a.w); }
        const float rstd1 = 1.0f / sqrtf(wave_sum(s) * (1.0f / D) + EPS);
        float s2 = 0.f;
#pragma unroll
        for (int j = 0; j < 16; ++j) { v[j] = v[j] + up4(mx[j]) * rstd1 * gpost[F.lane + 64 * j]; s2 += (v[j].x * v[j].x + v[j].y * v[j].y) + (v[j].z * v[j].z + v[j].w * v[j].w); }
        const float rstd2 = 1.0f / sqrtf(wave_sum(s2) * (1.0f / D) + EPS);
        { u32x2* xw = (u32x2*)(MIX + (size_t)m * D) + F.lane;
#pragma unroll
          for (int j = 0; j < 16; ++j) xw[64 * j] = (u32x2){pk2(v[j].x, v[j].y), pk2(v[j].z, v[j].w)}; }
        float mx2 = 0.f;
#pragma unroll
        for (int j = 0; j < 16; ++j) { v[j] = v[j] * rstd2 * gpre[F.lane + 64 * j]; mx2 = fmaxf(fmaxf(mx2, fmaxf(fabsf(v[j].x), fabsf(v[j].y))), fmaxf(fabsf(v[j].z), fabsf(v[j].w))); }
        const float amax = fmaxf(wave_max(mx2), 1e-20f), inv = 127.0f / amax;
        if (F.lane == 0) RS2[m] = amax * (1.0f / 127.0f);
        unsigned* o4 = (unsigned*)(XN8 + (size_t)m * D) + F.lane;
#pragma unroll
        for (int j = 0; j < 16; ++j) o4[64 * j] = pk4_i8(rintf(v[j].x * inv), rintf(v[j].y * inv), rintf(v[j].z * inv), rintf(v[j].w * inv));
    }
    __syncthreads();
}
__device__ __forceinline__ void final_phase(Frame& F) {
    const int tid_ = opaque(F.tid);
    const bf16_t* X1 = wsp<bf16_t>(F, WS_MIX); const bf16_t* FB = wsp<bf16_t>(F, WS_F);
    LAS f32x4* gfp = (LAS f32x4*)F.lds;
    for (int i = tid_; i < D / 4; i += NTHR) gfp[i] = ((const f32x4*)F.in_GFPOST)[i];
    __syncthreads();
    for (int m = F.gw; m < L; m += F.ngw) {
        asm volatile("" ::: "memory");
        const u32x2* mr = (const u32x2*)(X1 + (size_t)m * D) + F.lane; const u32x2* fr = (const u32x2*)(FB + (size_t)m * D) + F.lane;
        u32x2 fx[16], x1[16]; float s = 0.f;
#pragma unroll
        for (int j = 0; j < 16; ++j) { fx[j] = fr[64 * j]; x1[j] = mr[64 * j]; const f32x4 a = up4(fx[j]); s += (a.x * a.x + a.y * a.y) + (a.z * a.z + a.w * a.w); }
        const float rstd3 = 1.0f / sqrtf(wave_sum(s) * (1.0f / D) + EPS);
        f32x4* o = (f32x4*)(F.out + (size_t)m * D) + F.lane;
#pragma unroll
        for (int j = 0; j < 16; ++j) o[64 * j] = up4(x1[j]) + up4(fx[j]) * rstd3 * gfp[F.lane + 64 * j];
    }
}

constexpr int LDS_STAGE = pg8::STAGE_BYTES;
constexpr int LDS_MISC = LDS_STAGE;
constexpr int LDS_BYTES = LDS_STAGE + 1024;
#ifndef MK_N_LAUNCHES
#define MK_N_LAUNCHES 1
#endif
constexpr int NPHASE = 12;
struct Args { const float* in[23]; float* out; unsigned char* ws; int ph_lo, ph_hi; };

__global__ void __launch_bounds__(NTHR, 2) fwd_kernel(Args args) {
    extern __shared__ __attribute__((aligned(16))) unsigned char lds_raw[];
    Frame F;
    F.lds = (LAS unsigned char*)lds_raw;
    F.tid = threadIdx.x; F.lane = (int)__builtin_amdgcn_mbcnt_hi(~0u, __builtin_amdgcn_mbcnt_lo(~0u, 0u)); F.wave = __builtin_amdgcn_readfirstlane(F.tid >> 6);
    F.G = gridDim.x; F.gw = blockIdx.x * NWAVES + F.wave; F.ngw = F.G * NWAVES;
    F.in_XP = args.in[0]; F.in_XS = args.in[1]; F.in_WIN = args.in[2]; F.in_WCONV = args.in[3]; F.in_BCONV = args.in[4]; F.in_WR = args.in[5]; F.in_BR = args.in[6]; F.in_WI = args.in[7]; F.in_BI = args.in[8]; F.in_LAM = args.in[9]; F.in_RPB = args.in[10]; F.in_WNO = args.in[11]; F.in_WLO = args.in[12]; F.in_WM = args.in[13]; F.in_BM = args.in[14]; F.in_WOUT = args.in[15]; F.in_GMPRE = args.in[16]; F.in_GMPOST = args.in[17]; F.in_GFPRE = args.in[18]; F.in_GFPOST = args.in[19]; F.in_WFG = args.in[20]; F.in_WFU = args.in[21]; F.in_WFD = args.in[22];
    F.out = args.out; F.ws = args.ws;
    volatile LAS unsigned* MISC = (volatile LAS unsigned*)(F.lds + LDS_MISC);
    if (F.tid < 256) MISC[F.tid] = 0u;
    __syncthreads();
    const int lo = args.ph_lo, hi = args.ph_hi;
    const bool fused = (hi - lo) > 1;
    XcdBarrier bar; bar.bar = (unsigned*)(F.ws + WS_CTL); bar.x = 0; bar.st = nullptr;
    if (fused) bar = xcd_barrier_post((unsigned*)(F.ws + WS_CTL), MISC + 8);
#ifndef PH_MASK
#define PH_MASK 0xfff
#endif
#define IN(k) (((PH_MASK >> (k)) & 1) && lo <= (k) && (k) < hi)
#define SEAM(k) do { if (IN(k) && IN((k) + 1)) xcd_barrier(bar); } while (0)
    LAS unsigned char* stage = F.lds;

#ifdef ATTN_OUT_OFF
#define NA_BUF ((size_t)ATTN_OUT_OFF * MiB)
#else
#define NA_BUF WS_Q
#endif
#ifndef DUP_MASK
#define DUP_MASK 0
#endif
#define RUN(k, ...) if (IN(k)) { __VA_ARGS__ if (((DUP_MASK) >> (k)) & 1) { __VA_ARGS__ } }
    RUN(0, { p0_prologue(F); }) SEAM(0);
    RUN(1, {
        { pg8::Gemm g{wsp<bf16_t>(F, WS_XN8), wsp<bf16_t>(F, WS_XN8), 1 << 30, wsp<bf16_t>(F, WS_W8), L, 2 * NAW + 2 * D, D}; pg8::StaticOrder S; S.init(L, 2 * NAW + 2 * D, F.G, (int)blockIdx.x);
          pg8::EpiProjQ E{wsp<bf16_t>(F, WS_Q), wsp<bf16_t>(F, WS_K), (bf16_t*)F.out, F.in_BM, wsp<float>(F, WS_RS1), wsp<float>(F, WS_CS) + CS_QKM};
          pg8::gemm_phase<pg8::EpiProjQ, pg8::StaticOrder, true, true, 2>(stage, g, S, E); }
        { pg8::Gemm g{wsp<bf16_t>(F, WS_XN), wsp<bf16_t>(F, WS_XN), 1 << 30, wsp<bf16_t>(F, WS_WCAT), L, 2 * NAW, 2 * D}; pg8::StaticOrder S; S.init(L, 2 * NAW, F.G, (int)blockIdx.x);
          pg8::EpiProj E{wsp<bf16_t>(F, WS_XR), wsp<bf16_t>(F, WS_GR), wsp<bf16_t>(F, WS_GR), wsp<bf16_t>(F, WS_GR), (bf16_t*)F.out, F.in_BM, 1 << 30};
          pg8::gemm_phase<pg8::EpiProj, pg8::StaticOrder, true, true, 0>(stage, g, S, E); }
        { pg8::Gemm g{wsp<bf16_t>(F, WS_WVT), wsp<bf16_t>(F, WS_WVT), 1 << 30, wsp<bf16_t>(F, WS_XN8), NAW, L, D}; pg8::StaticOrder S; S.init(NAW, L, F.G, (int)blockIdx.x);
          pg8::EpiVTQ E{wsp<bf16_t>(F, WS_VT), wsp<float>(F, WS_CS) + CS_V, wsp<float>(F, WS_RS1)};
          pg8::gemm_phase<pg8::EpiVTQ, pg8::StaticOrder, true, true, 2>(stage, g, S, E); }
    }) SEAM(1);
    RUN(2, { lru_pass_a(F); }) SEAM(2);
    #ifdef ATTN_OUT_OFF
    if (IN(3)) { lru_pass_b(F); } SEAM(3);
    if (IN(4)) { lru_pass_c<0>(F); xcd_barrier(bar); if (ATTN_DUP) attn_mfma<ATTN_DUP - 1>(F); attn_mfma<0>(F); } SEAM(4);
#else
    if (IN(3)) { lru_pass_b(F); attn_mfma_lds(F); } SEAM(3);
#ifdef LRUC_DBG
    if (IN(4)) { lru_pass_c<LRUC_DBG>(F); lru_pass_c<0>(F); } SEAM(4);
#else
    RUN(4, { lru_pass_c<0>(F); }) SEAM(4);
#endif
#endif
    if (IN(5)) {
        { pg8::Gemm g{wsp<bf16_t>(F, NA_BUF), wsp<bf16_t>(F, NA_BUF), 1 << 30, wsp<bf16_t>(F, WS_WNO), L, D, 2 * NAW}; pg8::StaticOrder S; S.init(L, D, F.G, (int)blockIdx.x);
          pg8::EpiMulG<false> E{wsp<bf16_t>(F, WS_T1), (const bf16_t*)F.out, 0};
          pg8::gemm_phase<pg8::EpiMulG<false>, pg8::StaticOrder, true, true>(stage, g, S, E); }
        { pg8::Gemm g{wsp<bf16_t>(F, WS_XR), wsp<bf16_t>(F, WS_XR), 1 << 30, wsp<bf16_t>(F, WS_WLO), L, D, 2 * LW}; pg8::StaticOrder S; S.init(L, D, F.G, (int)blockIdx.x);
          pg8::EpiMulG<true> E{wsp<bf16_t>(F, WS_T1), (const bf16_t*)F.out, D};
          pg8::gemm_phase<pg8::EpiMulG<true>, pg8::StaticOrder, true, true>(stage, g, S, E); }
    } SEAM(5);
    RUN(6, {
        pg8::Gemm g{wsp<bf16_t>(F, WS_T1), wsp<bf16_t>(F, WS_T1), 1 << 30, wsp<bf16_t>(F, WS_WO), L, D, 2 * D}; pg8::StaticOrder S; S.init(L, D, F.G, (int)blockIdx.x);
        pg8::EpiPlain E{wsp<bf16_t>(F, WS_MIX), D};
        pg8::gemm_phase<pg8::EpiPlain, pg8::StaticOrder, true, true>(stage, g, S, E);
    }) SEAM(6);
    RUN(7, { mid_phase(F); }) SEAM(7);
    RUN(8, {
        pg8::Gemm g{wsp<bf16_t>(F, WS_XN8), wsp<bf16_t>(F, WS_XN8), 1 << 30, wsp<bf16_t>(F, WS_WGU), L, 2 * DFF, D}; pg8::StaticOrder S; S.init(L, 2 * DFF, F.G, (int)blockIdx.x);
        pg8::EpiSwigluQ E{(bf16_t*)F.out, wsp<bf16_t>(F, WS_HIDS), LP / 256, wsp<float>(F, WS_RS2), wsp<float>(F, WS_CS) + CS_GU};
        pg8::gemm_phase<pg8::EpiSwigluQ, pg8::StaticOrder, false, true, 2>(stage, g, S, E);
        { const int rem = S.nwg % F.G;
          if ((int)blockIdx.x >= rem) hq_wtiles(F, 0, HQW_EARLY, ((int)blockIdx.x - rem) * NWAVES + F.wave, (F.G - rem) * NWAVES); }
    }) SEAM(8);
    RUN(9, { hq_phase(F); }) SEAM(9);
    RUN(10, {
        pg8::Gemm g{wsp<bf16_t>(F, WS_H8P), wsp<bf16_t>(F, WS_H8S), LP / 256, wsp<bf16_t>(F, WS_WD), L, D, DFF}; pg8::StaticOrder S; S.init(L, D, F.G, (int)blockIdx.x);
        pg8::EpiPlainQ E{wsp<bf16_t>(F, WS_F), D, wsp<float>(F, WS_RS3), wsp<float>(F, WS_CS) + CS_D};
        pg8::gemm_phase<pg8::EpiPlainQ, pg8::StaticOrder, true, true, 2>(stage, g, S, E);
    }) SEAM(10);
    RUN(11, { final_phase(F); })
#undef RUN
#undef IN
#undef SEAM
}

extern "C" void kernel_launch(void* const* d_in, const int* in_sizes, int n_in, void* d_out, int out_size, void* d_ws, size_t ws_size, hipStream_t stream) {
    static int grid = 0;
    if (grid == 0) {
        if (n_in != 23 || in_sizes[0] != LP * D || in_sizes[1] != LS * D || out_size != L * D || ws_size < WS_END) {
            fprintf(stderr, "kernel_launch: unexpected shapes: n_in %d in0 %d out %d ws %zu (need %zu)\n", n_in, n_in > 0 ? in_sizes[0] : -1, out_size, ws_size, (size_t)WS_END); grid = -1; return; }
        int dev = 0, cus = 0, per_cu = 0;
        if (hipGetDevice(&dev) != hipSuccess || hipDeviceGetAttribute(&cus, hipDeviceAttributeMultiprocessorCount, dev) != hipSuccess) { grid = -1; return; }
        if (hipFuncSetAttribute((const void*)fwd_kernel, hipFuncAttributeMaxDynamicSharedMemorySize, LDS_BYTES) != hipSuccess) { fprintf(stderr, "kernel_launch: hipFuncSetAttribute failed\n"); grid = -1; return; }
        if (hipOccupancyMaxActiveBlocksPerMultiprocessor(&per_cu, (const void*)fwd_kernel, NTHR, LDS_BYTES) != hipSuccess || per_cu < 1) { fprintf(stderr, "kernel_launch: occupancy query says %d\n", per_cu); }
        (void)hipGetLastError();
        grid = cus;
    }
    if (grid < 0) return;
    (void)hipMemsetAsync((char*)d_ws + WS_CTL, 0, CTL_ZERO_BYTES, stream);
#ifdef DBG_ZERO_ALL
    (void)hipMemsetAsync((char*)d_ws, 0, WS_END, stream); (void)hipMemsetAsync((char*)d_out, 0, (size_t)L * D * 4, stream);
#endif
    Args a{};
    for (int i = 0; i < 23; ++i) a.in[i] = (const float*)d_in[i];
    a.out = (float*)d_out; a.ws = (unsigned char*)d_ws;
#if MK_N_LAUNCHES == 1
    a.ph_lo = 0; a.ph_hi = NPHASE;
    hipLaunchKernelGGL(fwd_kernel, dim3(grid), dim3(NTHR), LDS_BYTES, stream, a);
#else
    for (int p = 0; p < NPHASE; ++p) {
#ifdef DBG_PH_MASK
        if (!((DBG_PH_MASK >> p) & 1)) continue;
#endif
        a.ph_lo = p; a.ph_hi = p + 1; hipLaunchKernelGGL(fwd_kernel, dim3(grid), dim3(NTHR), LDS_BYTES, stream, a); }
#endif
}
```

```cpp
#include <hip/hip_runtime.h>
#include <cstdio>
#include <cstdint>

#define LAS __attribute__((address_space(3)))
typedef unsigned short bf16_t;
typedef short bf16x8 __attribute__((ext_vector_type(8)));
typedef float f32x4 __attribute__((ext_vector_type(4)));
typedef float f32x2 __attribute__((ext_vector_type(2)));
typedef unsigned u32x4 __attribute__((ext_vector_type(4)));
typedef unsigned u32x2 __attribute__((ext_vector_type(2)));

constexpr int D = 4096, LP = 16384, LS = 8192, L = LP + LS;
constexpr int GRIDW = 64, HD = 128, NH = 16, NAW = 2048, LW = 2048, NBLK = 16, BW = 128, DFF = 11008, INW = 10240;
constexpr float EPS = 1e-6f;
constexpr int NWAVES = 8, NTHR = 512;

constexpr size_t MiB = 1u << 20;
constexpr size_t WS_CTL = 0, CTL_ZERO_BYTES = 64 * 1024;
constexpr size_t WS_AM = 32 * 1024;
constexpr size_t WS_RSTD = 1 * MiB;
constexpr size_t WS_RS1 = 1 * MiB + 128 * 1024;
constexpr size_t WS_RS2 = 1 * MiB + 256 * 1024;
constexpr size_t WS_CS = 1 * MiB + 384 * 1024;
constexpr size_t WS_SUM = 2 * MiB;
constexpr size_t WS_WCAT = 8 * MiB;
constexpr size_t WS_W8 = 40 * MiB;
constexpr size_t WS_WVT = 88 * MiB;
constexpr size_t WS_XN8 = 96 * MiB;
constexpr size_t WS_WNO = 192 * MiB;
constexpr size_t WS_WLO = 208 * MiB;
constexpr size_t WS_WO = 224 * MiB;
constexpr size_t WS_WGU = 256 * MiB;
constexpr size_t WS_WD = 342 * MiB;
constexpr size_t WS_WG = 428 * MiB;
constexpr size_t WS_XN = 430 * MiB;
constexpr size_t WS_Q = 622 * MiB;
constexpr size_t WS_XR = 718 * MiB;
constexpr size_t WS_K = 814 * MiB;
constexpr size_t WS_VT = 910 * MiB;
constexpr size_t WS_GR = 1006 * MiB;
constexpr size_t WS_XC = 1102 * MiB;
constexpr size_t WS_END = 1198 * MiB;
constexpr int CS_QKM = 0, CS_V = 12288, CS_GU = 12288 + 2048, CS_D = 12288 + 2048 + 22016;
constexpr size_t WS_RS3 = 1 * MiB + 640 * 1024;
constexpr size_t WS_H8P = WS_XN, WS_H8S = WS_XN8;
constexpr size_t WS_T1 = WS_K;
constexpr size_t WS_MIX = WS_GR;
constexpr size_t WS_HIDS = WS_Q;
constexpr size_t WS_F = WS_K;
constexpr size_t WS_HF = WS_K;

#define LDS_WAIT() asm volatile("s_waitcnt lgkmcnt(0)" ::: "memory")
#define VM_WAIT() asm volatile("s_waitcnt vmcnt(0)" ::: "memory")
typedef __bf16 bf16x2n_t __attribute__((ext_vector_type(2)));
__device__ __forceinline__ unsigned pk2(float lo, float hi) { const bf16x2n_t r = __builtin_convertvector((f32x2){lo, hi}, bf16x2n_t); return __builtin_bit_cast(unsigned, r); }
__device__ __forceinline__ unsigned f2bf(float f) { return pk2(f, 0.f) & 0xffffu; }
__device__ __forceinline__ float bflo(unsigned u) { return __builtin_bit_cast(float, u << 16); }
__device__ __forceinline__ float bfhi(unsigned u) { return __builtin_bit_cast(float, u & 0xffff0000u); }
__device__ __forceinline__ float bf1(bf16_t u) { return __builtin_bit_cast(float, (unsigned)u << 16); }
__device__ __forceinline__ float wave_sum(float v) {
#pragma unroll
    for (int o = 1; o < 64; o <<= 1) v += __shfl_xor(v, o);
    return v;
}
__device__ __forceinline__ float wave_max(float v) {
#pragma unroll
    for (int o = 1; o < 64; o <<= 1) v = fmaxf(v, __shfl_xor(v, o));
    return v;
}
__device__ __forceinline__ float sigmoidf_(float v) { return __builtin_amdgcn_rcpf(1.0f + __expf(-v)); }
__device__ __forceinline__ float gelu_tanh(float v) { const float z = v * __builtin_fmaf(v * v, -0.1029432f, -2.3022082f); return v * __builtin_amdgcn_rcpf(1.0f + __builtin_amdgcn_exp2f(z)); }

namespace pg8 {
constexpr int BM = 256, BK = 64, HALF = 128, HTB = HALF * BK * 2  , STAGE_BYTES = 8 * HTB, NXCD = 8, WGM = 4;

__host__ __device__ __forceinline__ int lds_byte(int r, int c) { return (r >> 3) * 1024 + (r & 7) * 128 + ((((c >> 3) ^ r) & 7) << 4) + (c & 7) * 2; }
__host__ __device__ __forceinline__ void stage_rc(int b, int& R, int& C) { const int ch = b >> 10, rr = (b >> 7) & 7, slot = (b >> 4) & 7; R = ch * 8 + rr; C = ((slot ^ rr) & 7) * 8; }
__host__ __device__ __forceinline__ int perm32(int rho) { const int n = rho >> 4, i = rho & 15; return 8 * (i >> 2) + 4 * n + (i & 3); }

struct Unit { int pm, pn; };
struct Gemm {
    const bf16_t* A; const bf16_t* A2; int pm_split; const bf16_t* Bt; int M, N, rb;
    __device__ __forceinline__ const char* abase(int pm) const { const size_t t = (size_t)BM * rb; return pm < pm_split ? (const char*)A + (size_t)pm * t : (const char*)A2 + (size_t)(pm - pm_split) * t; }
    __device__ __forceinline__ const char* bbase(int pn) const { return (const char*)Bt + (size_t)pn * BM * rb; }
};

struct StaticOrder {
    int nM, nN, nwg, G, c;
    __host__ __device__ void init(int M, int N, int G_, int c_) { nM = M / BM; nN = N / BM; nwg = nM * nN; G = G_; c = c_; }
    __host__ __device__ bool next(int i, Unit& u) const {
        const long Lx = (long)i * G + c; if (Lx >= nwg) return false;
        int wgid = (int)Lx; { const int q = nwg / NXCD, r = nwg % NXCD, xcd = wgid % NXCD, off = wgid / NXCD; wgid = (xcd < r ? xcd * (q + 1) : r * (q + 1) + (xcd - r) * q) + off; }
        const int nig = WGM * nN, gid = wgid / nig, fm = gid * WGM, gsz = (nM - fm) < WGM ? (nM - fm) : WGM;
        u.pm = fm + ((wgid % nig) % gsz); u.pn = (wgid % nig) / gsz; return true;
    }
    __device__ __forceinline__ void a_ready(const Unit&) const {}
    __device__ __forceinline__ void done(const Unit&) const {}
};

typedef int v8i32 __attribute__((ext_vector_type(8)));
typedef int v4i32 __attribute__((ext_vector_type(4)));
typedef __bf16 bf16x2_t __attribute__((ext_vector_type(2)));
__device__ __forceinline__ unsigned cvt_pk_bf16(float lo, float hi) { const bf16x2_t r = __builtin_convertvector((f32x2){lo, hi}, bf16x2_t); return __builtin_bit_cast(unsigned, r); }
__device__ __forceinline__ u32x4 pack8(const f32x4 v0, const f32x4 v1) { u32x4 w; w.x = cvt_pk_bf16(v0[0], v0[1]); w.y = cvt_pk_bf16(v0[2], v0[3]); w.z = cvt_pk_bf16(v1[0], v1[1]); w.w = cvt_pk_bf16(v1[2], v1[3]); return w; }
__device__ __forceinline__ void unpack8(const u32x4 w, f32x4& v0, f32x4& v1) { v0 = (f32x4){bflo(w.x), bfhi(w.x), bflo(w.y), bfhi(w.y)}; v1 = (f32x4){bflo(w.z), bfhi(w.z), bflo(w.w), bfhi(w.w)}; }
__device__ __forceinline__ f32x4 sig4(const f32x4 v) { f32x4 r; r[0] = sigmoidf_(v[0]); r[1] = sigmoidf_(v[1]); r[2] = sigmoidf_(v[2]); r[3] = sigmoidf_(v[3]); return r; }

struct EpiPlain {
    static constexpr bool PERM = true, AFTER_DRAIN = false;
    bf16_t* O; int ldc;
    __device__ __forceinline__ void operator()(const f32x4 (&acc)[2][2][4][2], const Unit& u, int wr, int wc, int fr, int fq) const {
        const int row0 = u.pm * BM + wr * 64 + fr, col0 = u.pn * BM + wc * 32 + 8 * fq;
#pragma unroll
        for (int ai = 0; ai < 2; ++ai)
#pragma unroll
            for (int m = 0; m < 4; ++m) { bf16_t* rowp = O + (size_t)(row0 + ai * HALF + m * 16) * ldc + col0;
#pragma unroll
                for (int bj = 0; bj < 2; ++bj) *(u32x4*)(rowp + bj * HALF) = pack8(acc[ai][bj][m][0], acc[ai][bj][m][1]); }
    }
};
struct EpiVT {
    static constexpr bool PERM = true, AFTER_DRAIN = false;
    bf16_t* O;
    __device__ __forceinline__ void operator()(const f32x4 (&acc)[2][2][4][2], const Unit& u, int wr, int wc, int fr, int fq) const {
        const int row0 = u.pm * BM + wr * 64 + fr, col0 = u.pn * BM + wc * 32 + 8 * fq;
#pragma unroll
        for (int ai = 0; ai < 2; ++ai)
#pragma unroll
            for (int m = 0; m < 4; ++m) { const int row = row0 + ai * HALF + m * 16, hh = row >> 7, d = row & 127;
                const int dt = 2 * (d >> 5) + ((d >> 2) & 1), i = 4 * ((d >> 3) & 3) + (d & 3);
#pragma unroll
                for (int bj = 0; bj < 2; ++bj) { const int tok = col0 + bj * HALF, R = tok >> 6, o = (tok & 63) >> 3;
                    *(u32x4*)(O + ((size_t)((((R * 16 + hh) * 8 + dt) * 8 + o) * 16 + i)) * 8) = pack8(acc[ai][bj][m][0], acc[ai][bj][m][1]); } }
    }
};
struct EpiProj {
    static constexpr bool PERM = true, AFTER_DRAIN = false;
    bf16_t* P0; bf16_t* P1; bf16_t* P2; bf16_t* P3; bf16_t* G; const float* bias; int pn_gate0;
    __device__ __forceinline__ void operator()(const f32x4 (&acc)[2][2][4][2], const Unit& u, int wr, int wc, int fr, int fq) const {
        const int row0 = u.pm * BM + wr * 64 + fr;
        if (u.pn < pn_gate0) {
            const int t = u.pn >> 3; bf16_t* base = t == 0 ? P0 : (t == 1 ? P1 : (t == 2 ? P2 : P3));
            const int col0 = (u.pn & 7) * BM + wc * 32 + 8 * fq;
            if (t == 2) {
#pragma unroll
                for (int ai = 0; ai < 2; ++ai)
#pragma unroll
                    for (int m = 0; m < 4; ++m) { const int tok = row0 + ai * HALF + m * 16, R = tok >> 6, cl = tok & 63;
                        const int tokpart = (((cl >> 2) & 1) * 8 + (cl >> 3)) * 4 + (cl & 3);
#pragma unroll
                        for (int bj = 0; bj < 2; ++bj) { const int c = col0 + bj * HALF, hh = c >> 7, d0 = c & 127;
                            *(u32x4*)(base + ((size_t)(((R * 16 + hh) * 4 + (d0 >> 5)) * 64 + tokpart) * 4 + ((d0 >> 3) & 3)) * 8) = pack8(acc[ai][bj][m][0], acc[ai][bj][m][1]); } }
            } else {
#pragma unroll
            for (int ai = 0; ai < 2; ++ai)
#pragma unroll
                for (int m = 0; m < 4; ++m) { bf16_t* rowp = base + (size_t)(row0 + ai * HALF + m * 16) * NAW + col0;
#pragma unroll
                    for (int bj = 0; bj < 2; ++bj) *(u32x4*)(rowp + bj * HALF) = pack8(acc[ai][bj][m][0], acc[ai][bj][m][1]); }
            }
        } else {
            const int col0 = (u.pn - pn_gate0) * BM + wc * 32 + 8 * fq;
            f32x4 bv[2][2];
#pragma unroll
            for (int bj = 0; bj < 2; ++bj)
#pragma unroll
                for (int n = 0; n < 2; ++n) bv[bj][n] = *(const f32x4*)(bias + col0 + bj * HALF + 4 * n);
#pragma unroll
            for (int ai = 0; ai < 2; ++ai)
#pragma unroll
                for (int m = 0; m < 4; ++m) { bf16_t* rowp = G + (size_t)(row0 + ai * HALF + m * 16) * (2 * D) + col0;
#pragma unroll
                    for (int bj = 0; bj < 2; ++bj) *(u32x4*)(rowp + bj * HALF) = pack8(sig4(acc[ai][bj][m][0] + bv[bj][0]), sig4(acc[ai][bj][m][1] + bv[bj][1])); }
        }
    }
};
template <bool ADD> struct EpiMulG {
    static constexpr bool PERM = true, AFTER_DRAIN = false;
    bf16_t* O; const bf16_t* G; int goff;
    __device__ __forceinline__ void operator()(const f32x4 (&acc)[2][2][4][2], const Unit& u, int wr, int wc, int fr, int fq) const {
        const int row0 = u.pm * BM + wr * 64 + fr, col0 = u.pn * BM + wc * 32 + 8 * fq;
#pragma unroll
        for (int ai = 0; ai < 2; ++ai)
#pragma unroll
            for (int m = 0; m < 4; ++m) { const size_t row = (size_t)(row0 + ai * HALF + m * 16); bf16_t* rowp = O + row * D + col0; const bf16_t* gp = G + row * (2 * D) + goff + col0;
#pragma unroll
                for (int bj = 0; bj < 2; ++bj) {
                    f32x4 g0, g1; unpack8(*(const u32x4*)(gp + bj * HALF), g0, g1);
                    f32x4 v0 = acc[ai][bj][m][0] * g0, v1 = acc[ai][bj][m][1] * g1;
                    if (ADD) { f32x4 t0, t1; unpack8(*(const u32x4*)(rowp + bj * HALF), t0, t1); v0 += t0; v1 += t1; }
                    *(u32x4*)(rowp + bj * HALF) = pack8(v0, v1); } }
    }
};
struct EpiSwiglu {
    static constexpr bool PERM = true, AFTER_DRAIN = false;
    bf16_t* H0; bf16_t* H1; int pm_split;
    __device__ __forceinline__ void operator()(const f32x4 (&acc)[2][2][4][2], const Unit& u, int wr, int wc, int fr, int fq) const {
        bf16_t* base = u.pm < pm_split ? H0 + (size_t)u.pm * BM * DFF : H1 + (size_t)(u.pm - pm_split) * BM * DFF;
        const int row0 = wr * 64 + fr, col0 = u.pn * HALF + wc * 32 + 8 * fq;
#pragma unroll
        for (int ai = 0; ai < 2; ++ai)
#pragma unroll
            for (int m = 0; m < 4; ++m) {
                f32x4 h[2];
#pragma unroll
                for (int n = 0; n < 2; ++n) { const f32x4 g = acc[ai][0][m][n], up = acc[ai][1][m][n];
#pragma unroll
                    for (int j = 0; j < 4; ++j) h[n][j] = g[j] * sigmoidf_(g[j]) * up[j]; }
                *(u32x4*)(base + (size_t)(row0 + ai * HALF + m * 16) * DFF + col0) = pack8(h[0], h[1]); }
    }
};

__device__ __forceinline__ f32x4 deq4(const f32x4 accbits, const float sa, const f32x4 sb) { const v4i32 q = __builtin_bit_cast(v4i32, accbits); return (f32x4){(float)q.x, (float)q.y, (float)q.z, (float)q.w} * sa * sb; }
struct EpiProjQ {
    static constexpr bool PERM = true, AFTER_DRAIN = false;
    bf16_t* Qb; bf16_t* Kb; bf16_t* G; const float* bias; const float* sa; const float* sb;
    __device__ __forceinline__ void operator()(const f32x4 (&acc)[2][2][4][2], const Unit& u, int wr, int wc, int fr, int fq) const {
        const int row0 = u.pm * BM + wr * 64 + fr, cg0 = u.pn * BM + wc * 32 + 8 * fq;
        f32x4 sbv[2][2];
#pragma unroll
        for (int bj = 0; bj < 2; ++bj)
#pragma unroll
            for (int n = 0; n < 2; ++n) sbv[bj][n] = *(const f32x4*)(sb + cg0 + bj * HALF + 4 * n);
        if (u.pn < 8) {
            const int col0 = u.pn * BM + wc * 32 + 8 * fq;
#pragma unroll
            for (int ai = 0; ai < 2; ++ai)
#pragma unroll
                for (int m = 0; m < 4; ++m) { const int row = row0 + ai * HALF + m * 16; const float sr = sa[row]; bf16_t* rowp = Qb + (size_t)row * NAW + col0;
#pragma unroll
                    for (int bj = 0; bj < 2; ++bj) *(u32x4*)(rowp + bj * HALF) = pack8(deq4(acc[ai][bj][m][0], sr, sbv[bj][0]), deq4(acc[ai][bj][m][1], sr, sbv[bj][1])); }
        } else if (u.pn < 16) {
            const int col0 = (u.pn - 8) * BM + wc * 32 + 8 * fq;
#pragma unroll
            for (int ai = 0; ai < 2; ++ai)
#pragma unroll
                for (int m = 0; m < 4; ++m) { const int tok = row0 + ai * HALF + m * 16, R = tok >> 6, cl = tok & 63; const float sr = sa[tok];
                    const int tokpart = (((cl >> 2) & 1) * 8 + (cl >> 3)) * 4 + (cl & 3);
#pragma unroll
                    for (int bj = 0; bj < 2; ++bj) { const int c = col0 + bj * HALF, hh = c >> 7, d0 = c & 127;
                        *(u32x4*)(Kb + ((size_t)(((R * 16 + hh) * 4 + (d0 >> 5)) * 64 + tokpart) * 4 + ((d0 >> 3) & 3)) * 8) = pack8(deq4(acc[ai][bj][m][0], sr, sbv[bj][0]), deq4(acc[ai][bj][m][1], sr, sbv[bj][1])); } }
        } else {
            const int col0 = (u.pn - 16) * BM + wc * 32 + 8 * fq;
            f32x4 bv[2][2];
#pragma unroll
            for (int bj = 0; bj < 2; ++bj)
#pragma unroll
                for (int n = 0; n < 2; ++n) bv[bj][n] = *(const f32x4*)(bias + col0 + bj * HALF + 4 * n);
#pragma unroll
            for (int ai = 0; ai < 2; ++ai)
#pragma unroll
                for (int m = 0; m < 4; ++m) { const int row = row0 + ai * HALF + m * 16; const float sr = sa[row]; bf16_t* rowp = G + (size_t)row * (2 * D) + col0;
#pragma unroll
                    for (int bj = 0; bj < 2; ++bj) *(u32x4*)(rowp + bj * HALF) = pack8(sig4(deq4(acc[ai][bj][m][0], sr, sbv[bj][0]) + bv[bj][0]), sig4(deq4(acc[ai][bj][m][1], sr, sbv[bj][1]) + bv[bj][1])); }
        }
    }
};
struct EpiPlainQ {
    static constexpr bool PERM = true, AFTER_DRAIN = false;
    bf16_t* O; int ldc; const float* sa; const float* sb;
    __device__ __forceinline__ void operator()(const f32x4 (&acc)[2][2][4][2], const Unit& u, int wr, int wc, int fr, int fq) const {
        const int row0 = u.pm * BM + wr * 64 + fr, col0 = u.pn * BM + wc * 32 + 8 * fq;
        f32x4 sbv[2][2];
#pragma unroll
        for (int bj = 0; bj < 2; ++bj)
#pragma unroll
            for (int n = 0; n < 2; ++n) sbv[bj][n] = *(const f32x4*)(sb + col0 + bj * HALF + 4 * n);
#pragma unroll
        for (int ai = 0; ai < 2; ++ai)
#pragma unroll
            for (int m = 0; m < 4; ++m) { const int row = row0 + ai * HALF + m * 16; const float sr = sa[row]; bf16_t* rowp = O + (size_t)row * ldc + col0;
#pragma unroll
                for (int bj = 0; bj < 2; ++bj) *(u32x4*)(rowp + bj * HALF) = pack8(deq4(acc[ai][bj][m][0], sr, sbv[bj][0]), deq4(acc[ai][bj][m][1], sr, sbv[bj][1])); }
    }
};
struct EpiVTQ {
    static constexpr bool PERM = true, AFTER_DRAIN = false;
    bf16_t* O; const float* sa; const float* sb;
    __device__ __forceinline__ void operator()(const f32x4 (&acc)[2][2][4][2], const Unit& u, int wr, int wc, int fr, int fq) const {
        const int row0 = u.pm * BM + wr * 64 + fr, col0 = u.pn * BM + wc * 32 + 8 * fq;
        f32x4 sbv[2][2];
#pragma unroll
        for (int bj = 0; bj < 2; ++bj)
#pragma unroll
            for (int n = 0; n < 2; ++n) sbv[bj][n] = *(const f32x4*)(sb + col0 + bj * HALF + 4 * n);
#pragma unroll
        for (int ai = 0; ai < 2; ++ai)
#pragma unroll
            for (int m = 0; m < 4; ++m) { const int row = row0 + ai * HALF + m * 16, hh = row >> 7, d = row & 127; const float sr = sa[row];
                const int dt = 2 * (d >> 5) + ((d >> 2) & 1), i = 4 * ((d >> 3) & 3) + (d & 3);
#pragma unroll
                for (int bj = 0; bj < 2; ++bj) { const int tok = col0 + bj * HALF, R = tok >> 6, o = (tok & 63) >> 3;
                    *(u32x4*)(O + ((size_t)((((R * 16 + hh) * 8 + dt) * 8 + o) * 16 + i)) * 8) = pack8(deq4(acc[ai][bj][m][0], sr, sbv[bj][0]), deq4(acc[ai][bj][m][1], sr, sbv[bj][1])); } }
    }
};
struct EpiSwigluQ {
    static constexpr bool PERM = true, AFTER_DRAIN = false;
    bf16_t* H0; bf16_t* H1; int pm_split; const float* sa; const float* sb;
    __device__ __forceinline__ void operator()(const f32x4 (&acc)[2][2][4][2], const Unit& u, int wr, int wc, int fr, int fq) const {
        bf16_t* base = u.pm < pm_split ? H0 + (size_t)u.pm * BM * DFF : H1 + (size_t)(u.pm - pm_split) * BM * DFF;
        const int row0 = wr * 64 + fr, col0 = u.pn * HALF + wc * 32 + 8 * fq, cg0 = u.pn * BM + wc * 32 + 8 * fq;
        f32x4 sbv[2][2];
#pragma unroll
        for (int bj = 0; bj < 2; ++bj)
#pragma unroll
            for (int n = 0; n < 2; ++n) sbv[bj][n] = *(const f32x4*)(sb + cg0 + bj * HALF + 4 * n);
#pragma unroll
        for (int ai = 0; ai < 2; ++ai)
#pragma unroll
            for (int m = 0; m < 4; ++m) { const float sr = sa[u.pm * BM + row0 + ai * HALF + m * 16];
                f32x4 h[2];
#pragma unroll
                for (int n = 0; n < 2; ++n) { const f32x4 g = deq4(acc[ai][0][m][n], sr, sbv[0][n]), up = deq4(acc[ai][1][m][n], sr, sbv[1][n]);
#pragma unroll
                    for (int j = 0; j < 4; ++j) h[n][j] = g[j] * sigmoidf_(g[j]) * up[j]; }
                *(u32x4*)(base + (size_t)(row0 + ai * HALF + m * 16) * DFF + col0) = pack8(h[0], h[1]); }
    }
};

__device__ __forceinline__ v8i32 cat8(const bf16x8 lo, const bf16x8 hi) { return __builtin_shufflevector(__builtin_bit_cast(v4i32, lo), __builtin_bit_cast(v4i32, hi), 0, 1, 2, 3, 4, 5, 6, 7); }
__device__ __forceinline__ void mfma_fp8_acc(f32x4& c, const v8i32 a, const v8i32 b, int sa, int sb) {
    asm volatile("v_mfma_scale_f32_16x16x128_f8f6f4 %0, %1, %2, %0, %3, %4 op_sel_hi:[0,0,0]" : "+v"(c) : "v"(a), "v"(b), "v"(sa), "v"(sb)); }
constexpr int FP8_SCALE = 0x73737373;
template <class Epi, class Sched, bool ALIGN_EPI = false, bool SP2 = false, int QM = 0  , int DBG = 0>
__device__ __forceinline__ void gemm_phase(LAS unsigned char* lds, const Gemm g, const Sched& S, const Epi& E) {
    int tid = threadIdx.x; asm volatile("" : "+v"(tid));
    const int wid = __builtin_amdgcn_readfirstlane(tid >> 6), lane = tid & 63, wr = wid >> 2, wc = wid & 3, fr = lane & 15, fq = lane >> 4;
    const int RB = g.rb, nt = RB / (BK * 2);
    unsigned voffA[2], voffB[2];
#pragma unroll
    for (int i = 0; i < 2; ++i) { int R, C; stage_rc(tid * 16 + i * 8192, R, C); const int Rb = Epi::PERM ? ((R & ~31) + perm32(R & 31)) : R;
        voffA[i] = (unsigned)(R * RB + C * 2); voffB[i] = (unsigned)(Rb * RB + C * 2); }
    const size_t kstep = (size_t)(BK * 2);
    const size_t hstep = (size_t)HALF * RB;
    const unsigned ldsw = (unsigned)wid * 1024u;
    const int aoff0 = lds_byte(wr * 64 + fr, fq * 8), aoff1 = lds_byte(wr * 64 + fr, 32 + fq * 8), boff0 = lds_byte(wc * 32 + fr, fq * 8), boff1 = lds_byte(wc * 32 + fr, 32 + fq * 8);
#define PG8_SA(b, h) (((b) * 2 + (h)) * HTB)
#define PG8_SB(b, h) ((4 + (b) * 2 + (h)) * HTB)
#define PG8_STAGE(bufoff, gbase, voff) do { if constexpr (DBG != 3) _Pragma("unroll") for (int _i = 0; _i < 2; ++_i) \
        __builtin_amdgcn_global_load_lds((const unsigned*)((const char*)(gbase) + (voff)[_i]), (LAS unsigned*)(lds + (bufoff) + ldsw + _i * 8192), 16, 0, 0); } while (0)
#define PG8_LDA(dst, b, h) do { if constexpr (DBG != 2) _Pragma("unroll") for (int m = 0; m < 4; ++m) _Pragma("unroll") for (int k = 0; k < 2; ++k) dst[m][k] = *(const LAS bf16x8*)(lds + PG8_SA(b, h) + (k ? aoff1 : aoff0) + m * 2048); } while (0)
#define PG8_LDB(dst, b, h) do { if constexpr (DBG != 2) _Pragma("unroll") for (int n = 0; n < 2; ++n) _Pragma("unroll") for (int k = 0; k < 2; ++k) dst[n][k] = *(const LAS bf16x8*)(lds + PG8_SB(b, h) + (k ? boff1 : boff0) + n * 2048); } while (0)
#define PG8_MMA(ai, bj, At, Bt) do { __builtin_amdgcn_s_setprio(1); if constexpr (DBG == 1) { } else if constexpr (QM == 2) { _Pragma("unroll") for (int m = 0; m < 4; ++m) _Pragma("unroll") for (int n = 0; n < 2; ++n) _Pragma("unroll") for (int k = 0; k < 2; ++k) \
        acc[ai][bj][m][n] = __builtin_bit_cast(f32x4, __builtin_amdgcn_mfma_i32_16x16x64_i8(__builtin_bit_cast(v4i32, Bt[n][k]), __builtin_bit_cast(v4i32, At[m][k]), __builtin_bit_cast(v4i32, acc[ai][bj][m][n]), 0, 0, 0)); } else if constexpr (QM == 1) { _Pragma("unroll") for (int m = 0; m < 4; ++m) _Pragma("unroll") for (int n = 0; n < 2; ++n) \
        mfma_fp8_acc(acc[ai][bj][m][n], cat8(Bt[n][0], Bt[n][1]), cat8(At[m][0], At[m][1]), fp8_sa, fp8_sb); } else { \
        _Pragma("unroll") for (int m = 0; m < 4; ++m) _Pragma("unroll") for (int n = 0; n < 2; ++n) _Pragma("unroll") for (int k = 0; k < 2; ++k) \
        acc[ai][bj][m][n] = __builtin_amdgcn_mfma_f32_16x16x32_bf16(Bt[n][k], At[m][k], acc[ai][bj][m][n], 0, 0, 0); } __builtin_amdgcn_s_setprio(0); } while (0)
#define PG8_WAIT_V(n) asm volatile("s_waitcnt vmcnt(" #n ")" ::: "memory")
#define PG8_WAIT_L(n) asm volatile("s_waitcnt lgkmcnt(" #n ")" ::: "memory")
#define PG8_BAR __builtin_amdgcn_s_barrier()
#define PG8_SCHED __builtin_amdgcn_sched_barrier(0)
    Unit cur, nxt; int ui = 0;
    const int fp8_sa = FP8_SCALE, fp8_sb = 0x7F7F7F7F;
    if (!S.next(0, cur)) return;
    f32x4 acc[2][2][4][2];
#pragma unroll
    for (int a = 0; a < 2; ++a)
#pragma unroll
        for (int b = 0; b < 2; ++b)
#pragma unroll
            for (int m = 0; m < 4; ++m)
#pragma unroll
                for (int n = 0; n < 2; ++n) acc[a][b][m][n] = (f32x4){0.f, 0.f, 0.f, 0.f};
    bf16x8 At[4][2], B0[2][2], B1[2][2];
    const char* cA = g.abase(cur.pm); const char* cB = g.bbase(cur.pn);
    S.a_ready(cur);
    if constexpr (SP2) {
        PG8_STAGE(PG8_SB(0, 0), cB, voffB); PG8_STAGE(PG8_SB(0, 1), cB + hstep, voffB); PG8_STAGE(PG8_SA(0, 0), cA, voffA); PG8_STAGE(PG8_SA(0, 1), cA + hstep, voffA);
        if (wr == 1) PG8_BAR;
        PG8_WAIT_V(2); PG8_BAR;
        PG8_STAGE(PG8_SB(1, 0), cB + kstep, voffB); PG8_STAGE(PG8_SA(1, 0), cA + kstep, voffA); PG8_STAGE(PG8_SB(1, 1), cB + hstep + kstep, voffB);
        PG8_WAIT_V(6); PG8_BAR;
    } else {
        PG8_STAGE(PG8_SB(0, 0), cB, voffB); PG8_STAGE(PG8_SA(0, 0), cA, voffA); PG8_STAGE(PG8_SB(0, 1), cB + hstep, voffB); PG8_STAGE(PG8_SA(0, 1), cA + hstep, voffA);
        if (wr == 1) PG8_BAR;
        PG8_WAIT_V(4); PG8_BAR;
        PG8_STAGE(PG8_SB(1, 0), cB + kstep, voffB); PG8_STAGE(PG8_SA(1, 0), cA + kstep, voffA); PG8_STAGE(PG8_SB(1, 1), cB + hstep + kstep, voffB);
        PG8_WAIT_V(6); PG8_BAR;
    }
    for (;;) {
        const bool has_next = S.next(ui + 1, nxt);
        const char* nA = has_next ? g.abase(nxt.pm) : cA; const char* nB = has_next ? g.bbase(nxt.pn) : cB;
        for (int t = 0; t < nt; t += 2) {
            const bool last = (t == nt - 2);
            const char* a1 = cA + (size_t)(t + 1) * kstep;
            const char* a2 = last ? nA : cA + (size_t)(t + 2) * kstep; const char* b2 = last ? nB : cB + (size_t)(t + 2) * kstep;
            const char* a3 = a2 + kstep; const char* b3 = b2 + kstep;
            if (last && has_next) S.a_ready(nxt);
            if constexpr (SP2) {
            PG8_LDB(B0, 0, 0); PG8_LDB(B1, 0, 1); PG8_SCHED; PG8_LDA(At, 0, 0); PG8_STAGE(PG8_SA(1, 1), a1 + hstep, voffA);
            PG8_WAIT_V(8); PG8_WAIT_L(0); PG8_BAR; PG8_MMA(0, 0, At, B0); PG8_MMA(0, 1, At, B1); PG8_BAR; PG8_SCHED;
            PG8_LDA(At, 0, 1); PG8_STAGE(PG8_SB(0, 0), b2, voffB); PG8_STAGE(PG8_SB(0, 1), b2 + hstep, voffB); PG8_STAGE(PG8_SA(0, 0), a2, voffA);
            PG8_WAIT_V(8); PG8_WAIT_L(0); PG8_BAR; PG8_MMA(1, 0, At, B0); PG8_MMA(1, 1, At, B1); PG8_BAR; PG8_SCHED;
            PG8_LDB(B0, 1, 0); PG8_LDB(B1, 1, 1); PG8_SCHED; PG8_LDA(At, 1, 0); PG8_STAGE(PG8_SA(0, 1), a2 + hstep, voffA);
            PG8_WAIT_V(8); PG8_WAIT_L(0); PG8_BAR; PG8_MMA(0, 0, At, B0); PG8_MMA(0, 1, At, B1); PG8_BAR; PG8_SCHED;
            PG8_LDA(At, 1, 1); PG8_STAGE(PG8_SB(1, 0), b3, voffB); PG8_STAGE(PG8_SB(1, 1), b3 + hstep, voffB); PG8_STAGE(PG8_SA(1, 0), a3, voffA);
            PG8_WAIT_V(8); PG8_WAIT_L(0); PG8_BAR; PG8_MMA(1, 0, At, B0); PG8_MMA(1, 1, At, B1); PG8_BAR; PG8_SCHED;
            } else {
            PG8_LDB(B0, 0, 0); PG8_SCHED; PG8_LDA(At, 0, 0); PG8_STAGE(PG8_SA(1, 1), a1 + hstep, voffA);
            PG8_WAIT_L(8); PG8_BAR; PG8_WAIT_L(0); PG8_MMA(0, 0, At, B0); PG8_BAR; PG8_SCHED;
            PG8_LDB(B1, 0, 1); PG8_STAGE(PG8_SB(0, 0), b2, voffB);
            PG8_BAR; PG8_WAIT_L(0); PG8_MMA(0, 1, At, B1); PG8_BAR;
            PG8_LDA(At, 0, 1); PG8_STAGE(PG8_SA(0, 0), a2, voffA);
            PG8_BAR; PG8_WAIT_L(0); PG8_MMA(1, 0, At, B0); PG8_BAR; PG8_SCHED;
            PG8_STAGE(PG8_SB(0, 1), b2 + hstep, voffB);
            PG8_WAIT_V(6); PG8_BAR; PG8_MMA(1, 1, At, B1); PG8_BAR;
            PG8_LDB(B0, 1, 0); PG8_SCHED; PG8_LDA(At, 1, 0); PG8_STAGE(PG8_SA(0, 1), a2 + hstep, voffA);
            PG8_WAIT_L(8); PG8_BAR; PG8_WAIT_L(0); PG8_MMA(0, 0, At, B0); PG8_BAR; PG8_SCHED;
            PG8_LDB(B1, 1, 1); PG8_STAGE(PG8_SB(1, 0), b3, voffB);
            PG8_BAR; PG8_WAIT_L(0); PG8_MMA(0, 1, At, B1); PG8_BAR;
            PG8_LDA(At, 1, 1); PG8_STAGE(PG8_SA(1, 0), a3, voffA);
            PG8_BAR; PG8_WAIT_L(0); PG8_MMA(1, 0, At, B0); PG8_BAR; PG8_SCHED;
            PG8_STAGE(PG8_SB(1, 1), b3 + hstep, voffB);
            PG8_WAIT_V(6); PG8_BAR; PG8_MMA(1, 1, At, B1); PG8_BAR;
            }
        }
        if constexpr (ALIGN_EPI) { if (wr == 0) PG8_BAR; }
        if constexpr (!Epi::AFTER_DRAIN) { if constexpr (DBG != 4) E(acc, cur, wr, wc, fr, fq); else { _Pragma("unroll") for (int a_ = 0; a_ < 2; ++a_) _Pragma("unroll") for (int b_ = 0; b_ < 2; ++b_) _Pragma("unroll") for (int m_ = 0; m_ < 4; ++m_) _Pragma("unroll") for (int n_ = 0; n_ < 2; ++n_) asm volatile("" :: "v"(acc[a_][b_][m_][n_])); } S.done(cur); }
        if (!has_next) break;
#pragma unroll
        for (int a = 0; a < 2; ++a)
#pragma unroll
            for (int b = 0; b < 2; ++b)
#pragma unroll
                for (int m = 0; m < 4; ++m)
#pragma unroll
                    for (int n = 0; n < 2; ++n) acc[a][b][m][n] = (f32x4){0.f, 0.f, 0.f, 0.f};
        cur = nxt; cA = nA; cB = nB; ++ui;
        if constexpr (ALIGN_EPI) { if (wr == 1) PG8_BAR; }
    }
    PG8_WAIT_V(0);
    if constexpr (!ALIGN_EPI) { if (wr == 0) PG8_BAR; }
    PG8_BAR;
    if constexpr (Epi::AFTER_DRAIN) { E.fused(acc, cur, wr, wc, fr, fq, lds, wid, lane); S.done(cur); }
#undef PG8_SA
#undef PG8_SB
#undef PG8_STAGE
#undef PG8_LDA
#undef PG8_LDB
#undef PG8_MMA
#undef PG8_WAIT_V
#undef PG8_WAIT_L
#undef PG8_BAR
#undef PG8_SCHED
}
}
#define XB_TMO      128
#define XB_XCNT(j)  (256  + 64 * (j))
#define XB_XSUB(j)  (1280 + 64 * (j))
#define XB_XGEN(j)  (2304 + 64 * (j))
#define XB_TOP      3328
#define XB_TOPGEN   3392
#define XCD_BAR_WORDS 3456
#define XB_SPIN_CAP (1u << 18)

__device__ __forceinline__ unsigned xb_ld(unsigned* p)              { return __hip_atomic_load(p, __ATOMIC_RELAXED, __HIP_MEMORY_SCOPE_AGENT); }
__device__ __forceinline__ unsigned xb_add(unsigned* p, unsigned v) { return __hip_atomic_fetch_add(p, v, __ATOMIC_RELAXED, __HIP_MEMORY_SCOPE_AGENT); }
__device__ __forceinline__ unsigned xb_xcc_id() { return (unsigned)__builtin_amdgcn_s_getreg((3 << 11) | 20) & 0xFu; }
#define XB_SPIN(cond, bar) do { unsigned _sp = 0; while (cond) { __builtin_amdgcn_s_sleep(1); \
    if ((++_sp & 255u) == 0u) { if (xb_ld(&(bar)[XB_TMO])) break; if (_sp > XB_SPIN_CAP) { atomicAdd(&(bar)[XB_TMO], 1u); break; } } } } while (0)

struct XcdBarrier {
    unsigned* bar; unsigned x;
    volatile LAS unsigned* st;
};

__device__ __forceinline__ XcdBarrier xcd_barrier_post(unsigned* bar, volatile LAS unsigned* st) {
    XcdBarrier b; b.bar = bar; b.x = xb_xcc_id(); b.st = st;
    if (threadIdx.x == 0) (void)xb_add(&bar[XB_XCNT(b.x)], 1u);
    return b;
}
__device__ __forceinline__ void xcd_barrier_complete(unsigned* bar, unsigned x, unsigned& nloc, unsigned& nx) {
    const unsigned G = gridDim.x * gridDim.y * gridDim.z;
    unsigned sum, cnt, mine, sp = 0u;
    for (;;) {
        sum = 0u; cnt = 0u; mine = 0u;
#pragma unroll
        for (unsigned j = 0; j < 16; ++j) { const unsigned c = xb_ld(&bar[XB_XCNT(j)]); sum += c; cnt += (c > 0u) ? 1u : 0u; mine = (j == x) ? c : mine; }
        if (sum == G) break;
        __builtin_amdgcn_s_sleep(1);
        if ((++sp & 255u) == 0u) { if (xb_ld(&bar[XB_TMO])) break; if (sp > XB_SPIN_CAP) { atomicAdd(&bar[XB_TMO], 1u); break; } }
    }
    nloc = mine > 0u ? mine : 1u; nx = cnt > 0u ? cnt : 1u;
}

__device__ __forceinline__ void xcd_barrier(const XcdBarrier& b) {
    asm volatile("s_waitcnt vmcnt(0)" ::: "memory");
    __syncthreads();
    if (threadIdx.x == 0) {
        unsigned* bar = b.bar;
        __builtin_amdgcn_s_waitcnt(0);
        unsigned nloc = b.st[0], nx = b.st[1];
        if (nloc == 0u) { xcd_barrier_complete(bar, b.x, nloc, nx); b.st[0] = nloc; b.st[1] = nx; }
        const unsigned old = xb_add(&bar[XB_XSUB(b.x)], 1u);
        const unsigned gen = old / nloc;
        if (old + 1u == (gen + 1u) * nloc) {
            __builtin_amdgcn_fence(__ATOMIC_RELEASE, "agent");
            asm volatile("s_waitcnt vmcnt(0)" ::: "memory");
            const unsigned og = xb_add(&bar[XB_TOP], 1u);
            const unsigned tg = og / nx;
            if (og + 1u == (tg + 1u) * nx) xb_add(&bar[XB_TOPGEN], 1u);
            else XB_SPIN(xb_ld(&bar[XB_TOPGEN]) == tg, bar);
            __builtin_amdgcn_fence(__ATOMIC_ACQUIRE, "agent");
            xb_add(&bar[XB_XGEN(b.x)], 1u);
            asm volatile("s_waitcnt vmcnt(0)" ::: "memory");
        } else {
            XB_SPIN(xb_ld(&bar[XB_XGEN(b.x)]) == gen, bar);
            __builtin_amdgcn_fence(__ATOMIC_ACQUIRE, "agent");
            asm volatile("s_waitcnt vmcnt(0)" ::: "memory");
        }
    }
    __syncthreads();
}


struct Frame {
    LAS unsigned char* lds;
    int tid, lane, wave, G, gw, ngw;
    const float *in_XP, *in_XS, *in_WIN, *in_WCONV, *in_BCONV, *in_WR, *in_BR, *in_WI, *in_BI, *in_LAM, *in_RPB, *in_WNO, *in_WLO, *in_WM, *in_BM, *in_WOUT, *in_GMPRE, *in_GMPOST, *in_GFPRE, *in_GFPOST, *in_WFG, *in_WFU, *in_WFD; float* out; unsigned char* ws;
};
enum { I_XP = 0, I_XS, I_WIN, I_WCONV, I_BCONV, I_WR, I_BR, I_WI, I_BI, I_LAM, I_RPB, I_WNO, I_WLO, I_WM, I_BM, I_WOUT, I_GMPRE, I_GMPOST, I_GFPRE, I_GFPOST, I_WFG, I_WFU, I_WFD };
__device__ __forceinline__ int opaque(int x) { asm volatile("" : "+v"(x)); return x; }
template <class T> __device__ __forceinline__ T* wsp(const Frame& F, size_t off) { return (T*)(F.ws + off); }
__device__ __forceinline__ const float* xrow(const Frame& F, int m) { return m < LP ? F.in_XP + (size_t)m * D : F.in_XS + (size_t)(m - LP) * D; }

__device__ __forceinline__ void tr_item(const float* src, int ldsrc, int k0, int n0, bf16_t* dst, int ldd, int drow0, LAS float* scr, int lane) {
#pragma unroll 8
    for (int i = 0; i < 32; ++i) { const int kk = 2 * i + (lane >> 5); scr[kk * 33 + (lane & 31)] = src[(size_t)(k0 + kk) * ldsrc + n0 + (lane & 31)]; }
    LDS_WAIT(); asm volatile("" ::: "memory");
    const int c = lane & 7;
#pragma unroll
    for (int j = 0; j < 4; ++j) { const int n = (lane >> 3) + 8 * j; const LAS float* s = scr + (8 * c) * 33 + n;
        u32x4 o; o.x = pk2(s[0 * 33], s[1 * 33]); o.y = pk2(s[2 * 33], s[3 * 33]); o.z = pk2(s[4 * 33], s[5 * 33]); o.w = pk2(s[6 * 33], s[7 * 33]);
        *(u32x4*)(dst + (size_t)(drow0 + n) * ldd + k0 + 8 * c) = o; }
    LDS_WAIT(); asm volatile("" ::: "memory");
}
__device__ __forceinline__ unsigned pk4_fp8(float a, float b, float c, float d) { int p = __builtin_amdgcn_cvt_pk_fp8_f32(a, b, 0, false); p = __builtin_amdgcn_cvt_pk_fp8_f32(c, d, p, true); return (unsigned)p; }
__device__ __forceinline__ void tr_item8(const float* src, int ldsrc, int k0, int n0, unsigned char* dst, int ldd, int drow0, LAS float* scr, int lane) {
#pragma unroll 8
    for (int i = 0; i < 32; ++i) { const int kk = 2 * i + (lane >> 5); scr[kk * 33 + (lane & 31)] = src[(size_t)(k0 + kk) * ldsrc + n0 + (lane & 31)]; }
    LDS_WAIT(); asm volatile("" ::: "memory");
    const int c = lane & 7;
#pragma unroll
    for (int j = 0; j < 4; ++j) { const int n = (lane >> 3) + 8 * j; const LAS float* s = scr + (8 * c) * 33 + n;
        u32x2 o; o.x = pk4_fp8(s[0 * 33] * 256.f, s[1 * 33] * 256.f, s[2 * 33] * 256.f, s[3 * 33] * 256.f); o.y = pk4_fp8(s[4 * 33] * 256.f, s[5 * 33] * 256.f, s[6 * 33] * 256.f, s[7 * 33] * 256.f);
        *(u32x2*)(dst + (size_t)(drow0 + n) * ldd + k0 + 8 * c) = o; }
    LDS_WAIT(); asm volatile("" ::: "memory");
}
__device__ __forceinline__ unsigned pk4_i8(float a, float b, float c, float d) { return ((unsigned)(int)a & 255u) | (((unsigned)(int)b & 255u) << 8) | (((unsigned)(int)c & 255u) << 16) | ((unsigned)(int)d << 24); }
__device__ __forceinline__ void tr_strip_i8(const float* src, int ldsrc, int K, int n0, signed char* dst, int drow0, float* cs, LAS float* scr, int lane) {
    const float* sp = src + n0 + (lane & 31) + (size_t)(lane >> 5) * ldsrc;
    float mx = 0.f;
    { const float* p = sp; const size_t step = (size_t)2 * ldsrc;
      for (int k0 = 0; k0 < K; k0 += 64) {
        float t[32];
#pragma unroll
        for (int i = 0; i < 32; ++i) { t[i] = *p; p += step; }
#pragma unroll
        for (int i = 0; i < 32; ++i) mx = fmaxf(mx, fabsf(t[i]));
      } }
    mx = fmaxf(mx, __shfl_xor(mx, 32));
    const float amax = fmaxf(mx, 1e-20f), inv = 127.0f / amax;
    if (lane < 32) cs[drow0 + lane] = amax * (1.0f / 127.0f);
    const int c = lane & 7;
    for (int k0 = 0; k0 < K; k0 += 64) {
        { const float* p = sp + (size_t)k0 * ldsrc; const size_t step = (size_t)2 * ldsrc; LAS float* w = scr + (lane >> 5) * 33 + (lane & 31);
          float t[32];
#pragma unroll
          for (int i = 0; i < 32; ++i) { t[i] = *p; p += step; }
#pragma unroll
          for (int i = 0; i < 32; ++i) w[i * 66] = rintf(t[i] * inv); }
        LDS_WAIT(); asm volatile("" ::: "memory");
#pragma unroll
        for (int j = 0; j < 4; ++j) { const int n = (lane >> 3) + 8 * j; const LAS float* t = scr + (8 * c) * 33 + n;
            u32x2 o; o.x = pk4_i8(t[0 * 33], t[1 * 33], t[2 * 33], t[3 * 33]); o.y = pk4_i8(t[4 * 33], t[5 * 33], t[6 * 33], t[7 * 33]);
            *(u32x2*)(dst + (size_t)(drow0 + n) * K + k0 + 8 * c) = o; }
        LDS_WAIT(); asm volatile("" ::: "memory");
    }
}
__device__ __forceinline__ void fwht32(float (&v)[32]) {
#pragma unroll
    for (int st = 1; st < 32; st <<= 1)
#pragma unroll
        for (int i = 0; i < 32; ++i) if (!(i & st)) { const float a = v[i], b = v[i + st]; v[i] = a + b; v[i + st] = a - b; }
#pragma unroll
    for (int i = 0; i < 32; ++i) v[i] *= 0.17677669529663687f;
}
__device__ __forceinline__ void had_tile_load(const float* src, int ldsrc, int k0, int n0, LAS float* scr, int lane, float (&v)[32]) {
    { const float* p = src + (size_t)(k0 + (lane >> 5)) * ldsrc + n0 + (lane & 31); const size_t step = (size_t)2 * ldsrc; LAS float* w = scr + (lane >> 5) * 33 + (lane & 31); float t[32];
#pragma unroll
      for (int i = 0; i < 32; ++i) { t[i] = *p; p += step; }
#pragma unroll
      for (int i = 0; i < 32; ++i) w[i * 66] = t[i]; }
    LDS_WAIT(); asm volatile("" ::: "memory");
    const LAS float* hv = scr + (32 * (lane >> 5)) * 33 + (lane & 31);
#pragma unroll
    for (int i = 0; i < 32; ++i) v[i] = hv[i * 33];
    fwht32(v);
}
__device__ __forceinline__ void had_tile_amax(const float* src, int ldsrc, int k0, int n0, unsigned* am, LAS float* scr, int lane) {
    float v[32]; had_tile_load(src, ldsrc, k0, n0, scr, lane, v);
    float mx = 0.f;
#pragma unroll
    for (int i = 0; i < 32; ++i) mx = fmaxf(mx, fabsf(v[i]));
    mx = fmaxf(mx, __shfl_xor(mx, 32));
    if (lane < 32) atomicMax(am + n0 + lane, __builtin_bit_cast(unsigned, mx));
    LDS_WAIT(); asm volatile("" ::: "memory");
}
__device__ __forceinline__ void had_tile_quant(const float* src, int ldsrc, int K, int k0, int n0, signed char* dst, const unsigned* am, float* cs, LAS float* scr, int lane) {
    const float amax = fmaxf(__builtin_bit_cast(float, am[n0 + (lane & 31)]), 1e-20f), inv = 127.0f / amax;
    if (k0 == 0 && lane < 32) cs[n0 + lane] = amax * (1.0f / 127.0f);
    float v[32]; had_tile_load(src, ldsrc, k0, n0, scr, lane, v);
    LAS float* hv = scr + (32 * (lane >> 5)) * 33 + (lane & 31);
#pragma unroll
    for (int i = 0; i < 32; ++i) hv[i * 33] = rintf(v[i] * inv);
    LDS_WAIT(); asm volatile("" ::: "memory");
    const int c = lane & 7;
#pragma unroll
    for (int j = 0; j < 4; ++j) { const int n = (lane >> 3) + 8 * j; const LAS float* t = scr + (8 * c) * 33 + n;
        u32x2 o; o.x = pk4_i8(t[0 * 33], t[1 * 33], t[2 * 33], t[3 * 33]); o.y = pk4_i8(t[4 * 33], t[5 * 33], t[6 * 33], t[7 * 33]);
        *(u32x2*)(dst + (size_t)(n0 + n) * K + k0 + 8 * c) = o; }
    LDS_WAIT(); asm volatile("" ::: "memory");
}
#define TR_JOB(SRC, LDSRC, KK, NN, DST, DROW_EXPR) { const int nblk = (NN) / 32, nit = ((KK) / 64) * nblk; \
    if (r < nit) { const int kb = r / nblk, nb = r % nblk, n0 = 32 * nb; tr_item((SRC), (LDSRC), 64 * kb, n0, (DST), (KK), (DROW_EXPR), scr, F.lane); continue; } r -= nit; }
#define TR_JOB8(SRC, LDSRC, KK, NN, DST, DROW_EXPR) { const int nblk = (NN) / 32, nit = ((KK) / 64) * nblk; \
    if (r < nit) { const int kb = r / nblk, nb = r % nblk, n0 = 32 * nb; tr_item8((SRC), (LDSRC), 64 * kb, n0, (DST), (KK), (DROW_EXPR), scr, F.lane); continue; } r -= nit; }

__device__ __forceinline__ void p0_prologue(Frame& F) {
    const int tid_ = opaque(F.tid);
    LAS float* scr = (LAS float*)(F.lds + F.wave * 8448);
    const float* w_in = F.in_WIN;
    bf16_t* WCAT = wsp<bf16_t>(F, WS_WCAT); signed char* W8 = wsp<signed char>(F, WS_W8); signed char* WV8 = wsp<signed char>(F, WS_WVT); signed char* WGU8 = wsp<signed char>(F, WS_WGU);
    float* CS = wsp<float>(F, WS_CS);
    constexpr int NSM = 64;
    constexpr int IT_SM = 2 * 4;
    constexpr int S_Q = NAW / 32, S_M = 2 * D / 32, S_F = DFF / 32;
    constexpr int NSTRIP = 3 * S_Q + S_M + 2 * S_F;
    constexpr int N_AMAX = (DFF / 64) * (D / 32);
    constexpr int N_BIG = 2 * (D / 64) * (NAW / 32) + 2 * (NAW / 64) * (D / 32) + (D / 64) * (D / 32) + N_AMAX;
    constexpr int NITEMS = N_BIG + NSM * IT_SM;
    for (int it = F.gw; it < NSTRIP + NITEMS; it += F.ngw) {
        if (it < NSTRIP) {
            int q = it; const float* src; int ld, n0, drow0; signed char* dst; float* cs;
            if (q < S_Q) { src = w_in; ld = INW; n0 = 32 * q; dst = W8; drow0 = n0; cs = CS + CS_QKM; }
            else if ((q -= S_Q) < S_Q) { src = w_in + NAW; ld = INW; n0 = 32 * q; dst = W8; drow0 = 2048 + n0; cs = CS + CS_QKM; }
            else if ((q -= S_Q) < S_M) { src = F.in_WM; ld = 2 * D; n0 = 32 * q; dst = W8; drow0 = 4096 + n0; cs = CS + CS_QKM; }
            else if ((q -= S_M) < S_Q) { src = w_in + 2 * NAW; ld = INW; n0 = 32 * q; dst = WV8; drow0 = n0; cs = CS + CS_V; }
            else if ((q -= S_Q) < S_F) { src = F.in_WFG; ld = DFF; n0 = 32 * q; dst = WGU8; drow0 = (n0 >> 7) * 256 + (n0 & 127); cs = CS + CS_GU; }
            else { q -= S_F; src = F.in_WFU; ld = DFF; n0 = 32 * q; dst = WGU8; drow0 = (n0 >> 7) * 256 + 128 + (n0 & 127); cs = CS + CS_GU; }
            tr_strip_i8(src, ld, D, n0, dst, drow0, cs, scr, F.lane);
            continue;
        }
        int r = it - NSTRIP;
        TR_JOB(w_in + 3 * NAW, INW, D, NAW, WCAT, 0 + n0)
        TR_JOB(w_in + 4 * NAW, INW, D, NAW, WCAT, 2048 + n0)
        TR_JOB(F.in_WNO, D, NAW, D, wsp<bf16_t>(F, WS_WNO), n0)
        TR_JOB(F.in_WLO, D, LW, D, wsp<bf16_t>(F, WS_WLO), n0)
        TR_JOB(F.in_WOUT, D, D, D, wsp<bf16_t>(F, WS_WO), n0)
        if (r < N_AMAX) { had_tile_amax(F.in_WFD, D, 64 * (r / (D / 32)), 32 * (r % (D / 32)), (unsigned*)(F.ws + WS_AM), scr, F.lane); continue; } r -= N_AMAX;
        {
            const int mi = r / IT_SM, ri = r % IT_SM, d = mi >> 5, g = (mi >> 4) & 1, n = mi & 15, kb = ri >> 2, nb = ri & 3;
            const float* src = (g ? F.in_WI : F.in_WR) + (size_t)(d * NBLK + n) * BW * BW;
            tr_item(src, BW, 64 * kb, 32 * nb, wsp<bf16_t>(F, WS_WG) + (size_t)mi * BW * BW, BW, 32 * nb, scr, F.lane);
        }
    }
    LAS f32x4* gl = (LAS f32x4*)(F.lds + 69632);
    for (int i = tid_; i < D / 4; i += NTHR) gl[i] = ((const f32x4*)F.in_GMPRE)[i];
    __syncthreads();
    bf16_t* XN = wsp<bf16_t>(F, WS_XN); signed char* XN8 = wsp<signed char>(F, WS_XN8); float* RS1 = wsp<float>(F, WS_RS1);
    for (int m = F.gw; m < L; m += F.ngw) {
        asm volatile("" ::: "memory");
        const f32x4* xr = (const f32x4*)xrow(F, m) + F.lane;
        f32x4 v[16]; float s = 0.f;
#pragma unroll
        for (int j = 0; j < 16; ++j) { v[j] = xr[64 * j]; s += (v[j].x * v[j].x + v[j].y * v[j].y) + (v[j].z * v[j].z + v[j].w * v[j].w); }
        const float rstd = 1.0f / sqrtf(wave_sum(s) * (1.0f / D) + EPS);
        u32x2* o8 = (u32x2*)(XN + (size_t)m * D) + F.lane; unsigned* o4 = (unsigned*)(XN8 + (size_t)m * D) + F.lane;
        float mx = 0.f;
#pragma unroll
        for (int j = 0; j < 16; ++j) { v[j] = v[j] * rstd * gl[F.lane + 64 * j]; mx = fmaxf(fmaxf(mx, fmaxf(fabsf(v[j].x), fabsf(v[j].y))), fmaxf(fabsf(v[j].z), fabsf(v[j].w))); }
        const float amax = fmaxf(wave_max(mx), 1e-20f), inv = 127.0f / amax;
        if (F.lane == 0) RS1[m] = amax * (1.0f / 127.0f);
#pragma unroll
        for (int j = 0; j < 16; ++j) { const f32x4 y = v[j]; u32x2 o; o.x = pk2(y.x, y.y); o.y = pk2(y.z, y.w); o8[64 * j] = o;
            o4[64 * j] = pk4_i8(rintf(y.x * inv), rintf(y.y * inv), rintf(y.z * inv), rintf(y.w * inv)); }
    }
    __syncthreads();
}

#ifndef ATT_SYNC
#define ATT_SYNC 1
#endif
template <int ADBG = 0> __device__ __forceinline__ void attn_mfma(Frame& F) {
    const int tid_ = opaque(F.tid);
    bf16_t* Q = wsp<bf16_t>(F, WS_Q); const bf16_t* Kb = wsp<bf16_t>(F, WS_K); const bf16_t* VT = wsp<bf16_t>(F, WS_VT);
    LAS float* rp = (LAS float*)F.lds;
    for (int i = tid_; i < NH * 15 * 31; i += NTHR) rp[i] = F.in_RPB[i];
    __syncthreads();
    const int fr = F.lane & 15, fq = F.lane >> 4;
    const float scale = 0.08838834764831845f;
    for (int base = blockIdx.x * NWAVES; base < (L / GRIDW) * NH * 4; base += F.ngw) {
        const int item = base + F.wave;
        asm volatile("" ::: "memory");
        const int g = item & 3, h = (item >> 2) & 15, rg = item >> 6;
        const int s0 = rg < LP / GRIDW ? 0 : LP, rows = rg < LP / GRIDW ? LP / GRIDW : LS / GRIDW, r = rg < LP / GRIDW ? rg : rg - LP / GRIDW;
        int rs = r - 4; rs = rs < 0 ? 0 : (rs > rows - 8 ? rows - 8 : rs);
        const int w0 = g == 0 ? 0 : (g == 1 ? 8 : (g == 2 ? 24 : 32));
        const int c = 16 * g + fr;
        int cs = c - 8; cs = cs < 0 ? 0 : (cs > GRIDW - 16 ? GRIDW - 16 : cs);
        bf16_t* qrow = Q + (size_t)(s0 + r * GRIDW + c) * NAW + h * HD;
        bf16x8 qf[4];
#pragma unroll
        for (int s = 0; s < 4; ++s) qf[s] = *(const bf16x8*)(qrow + 8 * fq + 32 * s);
        f32x4 sacc[8][2];
        const int Rg = s0 / GRIDW + rs, p0 = w0 >> 3;
        const bf16_t* kbase = Kb + (size_t)(Rg * 16 + h) * 8192 + p0 * 128 + fr * 32 + fq * 8;
        bf16x8 kb[8][2][4];
#define ATT_LDK(kr) do { _Pragma("unroll") for (int T = 0; T < 2; ++T) _Pragma("unroll") for (int s = 0; s < 4; ++s) kb[kr][T][s] = (ADBG & 1) ? qf[s] : (ADBG & 4) ? *(const bf16x8*)(Kb + (size_t)(s0 + rs * GRIDW) * NAW + h * HD * GRIDW + ((kr) * 8 + T * 4 + s) * 512 + F.lane * 8) : *(const bf16x8*)(kbase + (size_t)(kr) * (16 * 8192) + (s * 2 + T) * 1024); } while (0)
        ATT_LDK(0); ATT_LDK(1);
#pragma unroll
        for (int kr = 0; kr < 8; ++kr) {
            if (ATT_SYNC && (kr & 1) == 0) __builtin_amdgcn_s_barrier();
            if (kr + 2 < 8) ATT_LDK(kr + 2);
            __builtin_amdgcn_sched_barrier(0);
#pragma unroll
            for (int T = 0; T < 2; ++T) { f32x4 a = (f32x4){0.f, 0.f, 0.f, 0.f};
#pragma unroll
                for (int s = 0; s < 4; ++s) a = __builtin_amdgcn_mfma_f32_16x16x32_bf16(kb[kr][T][s], qf[s], a, 0, 0, 0);
                sacc[kr][T] = a; }
            __builtin_amdgcn_sched_barrier(0);
        }
#undef ATT_LDK
        bf16x8 vb[8][8];
        const bf16_t* vbase = VT + (size_t)(Rg * 16 + h) * 8192 + p0 * 128 + fq * 128 + fr * 8;
#define ATT_LDV(kr) do { _Pragma("unroll") for (int dt = 0; dt < 8; ++dt) vb[kr][dt] = (ADBG & 2) ? qf[dt & 3] : (ADBG & 4) ? *(const bf16x8*)(VT + (size_t)(h * HD) * L + s0 + rs * GRIDW + ((kr) * 8 + dt) * 512 + F.lane * 8) : *(const bf16x8*)(vbase + (size_t)(kr) * (16 * 8192) + dt * 1024); } while (0)
        ATT_LDV(0); ATT_LDV(1);
        __builtin_amdgcn_sched_barrier(0);
        const int elo = cs - w0 - 8 * fq, dc0 = w0 + 8 * fq - c + 15;
        const LAS float* rph = rp + h * 465 + (rs - r + 7) * 31;
        float mx = -3.0e38f;
#pragma unroll
        for (int e = 0; e < 8; ++e) { const bool valid = (e >= elo) && (e < elo + 16); const int bi = valid ? dc0 + e : 0;
#pragma unroll
            for (int kr = 0; kr < 8; ++kr) { const float sv = valid ? sacc[kr][e >> 2][e & 3] * scale + rph[kr * 31 + bi] : -3.0e38f; sacc[kr][e >> 2][e & 3] = sv; mx = fmaxf(mx, sv); } }
        mx = fmaxf(mx, __shfl_xor(mx, 16)); mx = fmaxf(mx, __shfl_xor(mx, 32));
        float lsum = 0.f; bf16x8 pf[8];
#pragma unroll
        for (int kr = 0; kr < 8; ++kr) { float p[8];
#pragma unroll
            for (int e = 0; e < 8; ++e) { p[e] = __expf(sacc[kr][e >> 2][e & 3] - mx); lsum += p[e]; }
            u32x4 w; w.x = pk2(p[0], p[1]); w.y = pk2(p[2], p[3]); w.z = pk2(p[4], p[5]); w.w = pk2(p[6], p[7]);
            pf[kr] = __builtin_bit_cast(bf16x8, w); }
        lsum += __shfl_xor(lsum, 16); lsum += __shfl_xor(lsum, 32);
        f32x4 oacc[8];
#pragma unroll
        for (int dt = 0; dt < 8; ++dt) oacc[dt] = (f32x4){0.f, 0.f, 0.f, 0.f};
#pragma unroll
        for (int kr = 0; kr < 8; ++kr) {
            if (ATT_SYNC && (kr & 1) == 0) __builtin_amdgcn_s_barrier();
            if (kr + 2 < 8) ATT_LDV(kr + 2);
            __builtin_amdgcn_sched_barrier(0);
#pragma unroll
            for (int dt = 0; dt < 8; ++dt) oacc[dt] = __builtin_amdgcn_mfma_f32_16x16x32_bf16(vb[kr][dt], pf[kr], oacc[dt], 0, 0, 0);
            __builtin_amdgcn_sched_barrier(0);
        }
#undef ATT_LDV
        const float inv = 1.0f / lsum;
#ifdef ATTN_OUT_OFF
        bf16_t* orow = wsp<bf16_t>(F, (size_t)ATTN_OUT_OFF * MiB) + (size_t)(s0 + r * GRIDW + c) * NAW + h * HD;
#else
        bf16_t* orow = qrow;
#endif
#pragma unroll
        for (int u = 0; u < 4; ++u) *(u32x4*)(orow + 32 * u + 8 * fq) = pg8::pack8(oacc[2 * u] * inv, oacc[2 * u + 1] * inv);
    }
    __syncthreads();
}

__device__ __forceinline__ void attn_mfma_lds(Frame& F) {
    const int tid_ = opaque(F.tid);
    bf16_t* Q = wsp<bf16_t>(F, WS_Q); const bf16_t* Kb = wsp<bf16_t>(F, WS_K); const bf16_t* VT = wsp<bf16_t>(F, WS_VT);
    LAS float* rp = (LAS float*)F.lds;
    LAS unsigned char* ring = F.lds + 30720;
    for (int i = tid_; i < NH * 15 * 31; i += NTHR) rp[i] = F.in_RPB[i];
    __syncthreads();
    const int lane = tid_ & 63, fr = lane & 15, fq = lane >> 4, w = F.wave, hl = w >> 2, g = w & 3;
    const float scale = 0.08838834764831845f;
    constexpr int NIT = (L / GRIDW) * NH * 4;
    const int w0 = g == 0 ? 0 : (g == 1 ? 8 : (g == 2 ? 24 : 32)), p0 = w0 >> 3;
    const int c = 16 * g + fr;
    int cs = c - 8; cs = cs < 0 ? 0 : (cs > GRIDW - 16 ? GRIDW - 16 : cs);
#define ATL_SRC(b, st) ([&]() -> const bf16_t* { const int rg_ = (b) >> 6, hb_ = ((b) >> 2) & 15; const int rows_ = rg_ < LP / GRIDW ? LP / GRIDW : LS / GRIDW, r_ = rg_ < LP / GRIDW ? rg_ : rg_ - LP / GRIDW; \
        int rs_ = r_ - 4; rs_ = rs_ < 0 ? 0 : (rs_ > rows_ - 8 ? rows_ - 8 : rs_); const int Rg_ = (rg_ < LP / GRIDW ? 0 : LP / GRIDW) + rs_; \
        return ((st) < 8 ? Kb : VT) + (size_t)((Rg_ + ((st) & 7)) * 16 + hb_) * 8192; }())
#define ATL_ISSUE(src, slot) do { const bf16_t* s_ = (src) + tid_ * 8; LAS unsigned char* d_ = ring + (slot) * 32768 + w * 1024; _Pragma("unroll") for (int k_ = 0; k_ < 4; ++k_) \
        __builtin_amdgcn_global_load_lds((const unsigned*)(s_ + k_ * 4096), (LAS unsigned*)(d_ + k_ * 8192), 16, 0, 0); } while (0)
    int base = blockIdx.x * NWAVES;
    if (base < NIT) { ATL_ISSUE(ATL_SRC(base, 0), 0); ATL_ISSUE(ATL_SRC(base, 1), 1); }
    int b0 = 0;
    for (; base < NIT; base += F.ngw) {
        asm volatile("" ::: "memory");
        const int h = ((base >> 2) & 15) + hl, rg = base >> 6;
        const int s0 = rg < LP / GRIDW ? 0 : LP, rows = rg < LP / GRIDW ? LP / GRIDW : LS / GRIDW, r = rg < LP / GRIDW ? rg : rg - LP / GRIDW;
        int rs = r - 4; rs = rs < 0 ? 0 : (rs > rows - 8 ? rows - 8 : rs);
        const int nbase = base + F.ngw < NIT ? base + F.ngw : base;
        bf16_t* qrow = Q + (size_t)(s0 + r * GRIDW + c) * NAW + h * HD;
        bf16x8 qf[4];
#pragma unroll
        for (int s = 0; s < 4; ++s) qf[s] = *(const bf16x8*)(qrow + 8 * fq + 32 * s);
        f32x4 sacc[8][2]; f32x4 oacc[8]; bf16x8 pf[8]; float lsum = 0.f;
#pragma unroll
        for (int dt = 0; dt < 8; ++dt) oacc[dt] = (f32x4){0.f, 0.f, 0.f, 0.f};
        const int koff = hl * 16384 + (p0 * 128 + fr * 32 + fq * 8) * 2, voff = hl * 16384 + (p0 * 128 + fq * 128 + fr * 8) * 2;
#pragma unroll
        for (int st = 0; st < 16; ++st) {
            asm volatile("s_waitcnt vmcnt(4)" ::: "memory"); asm volatile("s_waitcnt lgkmcnt(0)" ::: "memory"); __builtin_amdgcn_s_barrier(); asm volatile("" ::: "memory");
            { const int slot2 = (b0 + st + 2) % 3; if (st + 2 < 16) ATL_ISSUE(ATL_SRC(base, st + 2), slot2); else ATL_ISSUE(ATL_SRC(nbase, st + 2 - 16), slot2); }
            const LAS unsigned char* buf = ring + ((b0 + st) % 3) * 32768;
            if (st < 8) {
#pragma unroll
                for (int T = 0; T < 2; ++T) { f32x4 a = (f32x4){0.f, 0.f, 0.f, 0.f};
#pragma unroll
                    for (int s2 = 0; s2 < 4; ++s2) a = __builtin_amdgcn_mfma_f32_16x16x32_bf16(*(const LAS bf16x8*)(buf + koff + (s2 * 2 + T) * 2048), qf[s2], a, 0, 0, 0);
                    sacc[st][T] = a; }
            } else {
                if (st == 8) {
                    const int elo = cs - w0 - 8 * fq, dc0 = w0 + 8 * fq - c + 15;
                    const LAS float* rph = rp + h * 465 + (rs - r + 7) * 31;
                    float mx = -3.0e38f;
#pragma unroll
                    for (int e = 0; e < 8; ++e) { const bool valid = (e >= elo) && (e < elo + 16); const int bi = valid ? dc0 + e : 0;
#pragma unroll
                        for (int kr = 0; kr < 8; ++kr) { const float sv = valid ? sacc[kr][e >> 2][e & 3] * scale + rph[kr * 31 + bi] : -3.0e38f; sacc[kr][e >> 2][e & 3] = sv; mx = fmaxf(mx, sv); } }
                    mx = fmaxf(mx, __shfl_xor(mx, 16)); mx = fmaxf(mx, __shfl_xor(mx, 32));
#pragma unroll
                    for (int kr = 0; kr < 8; ++kr) { float p[8];
#pragma unroll
                        for (int e = 0; e < 8; ++e) { p[e] = __expf(sacc[kr][e >> 2][e & 3] - mx); lsum += p[e]; }
                        u32x4 wv; wv.x = pk2(p[0], p[1]); wv.y = pk2(p[2], p[3]); wv.z = pk2(p[4], p[5]); wv.w = pk2(p[6], p[7]);
                        pf[kr] = __builtin_bit_cast(bf16x8, wv); }
                    lsum += __shfl_xor(lsum, 16); lsum += __shfl_xor(lsum, 32);
                }
#pragma unroll
                for (int dt = 0; dt < 8; ++dt) oacc[dt] = __builtin_amdgcn_mfma_f32_16x16x32_bf16(*(const LAS bf16x8*)(buf + voff + dt * 2048), pf[st - 8], oacc[dt], 0, 0, 0);
            }
        }
        b0 = (b0 + 16) % 3;
        const float inv = 1.0f / lsum;
#pragma unroll
        for (int u = 0; u < 4; ++u) *(u32x4*)(qrow + 32 * u + 8 * fq) = pg8::pack8(oacc[2 * u] * inv, oacc[2 * u + 1] * inv);
    }
#undef ATL_SRC
#undef ATL_ISSUE
    asm volatile("s_waitcnt vmcnt(0)" ::: "memory");
    __syncthreads();
}

__device__ __forceinline__ void conv_phase(Frame& F) {
    const int tid_ = opaque(F.tid);
    const bf16_t* XR = wsp<bf16_t>(F, WS_XR); bf16_t* XC = wsp<bf16_t>(F, WS_XC);
    const float* wc = F.in_WCONV; const float* bc = F.in_BCONV;
    const int nth = F.G * NTHR;
    for (int it = blockIdx.x * NTHR + tid_; it < L * (LW / 8); it += nth) {
        const int t = it / (LW / 8), c0 = (it % (LW / 8)) * 8;
        const int s0 = t < LP ? 0 : LP, len = t < LP ? LP : LS, tl = t - s0;
        float acc[8];
#pragma unroll
        for (int e = 0; e < 8; ++e) acc[e] = bc[c0 + e];
#pragma unroll
        for (int j = 0; j < 4; ++j) { const int tt = tl + j - 2; if (tt < 0 || tt >= len) continue;
            f32x4 x0, x1; pg8::unpack8(*(const u32x4*)(XR + (size_t)(s0 + tt) * LW + c0), x0, x1);
            const f32x4 w0 = *(const f32x4*)(wc + j * LW + c0), w1 = *(const f32x4*)(wc + j * LW + c0 + 4);
#pragma unroll
            for (int e = 0; e < 4; ++e) { acc[e] += w0[e] * x0[e]; acc[4 + e] += w1[e] * x1[e]; } }
        *(u32x4*)(XC + (size_t)t * LW + c0) = pg8::pack8((f32x4){acc[0], acc[1], acc[2], acc[3]}, (f32x4){acc[4], acc[5], acc[6], acc[7]});
    }
}

struct LruW { bf16x8 w[2][4]; float br, bi, cl; };
template <int DIR> __device__ __forceinline__ void lru_load_w(const Frame& F, LruW& W, int n, int w, int fr, int fq) {
    const bf16_t* wg = wsp<bf16_t>(F, WS_WG);
#pragma unroll
    for (int g = 0; g < 2; ++g)
#pragma unroll
        for (int s = 0; s < 4; ++s) W.w[g][s] = *(const bf16x8*)(wg + ((size_t)((DIR * 2 + g) * NBLK + n) * BW + 16 * w + fr) * BW + 32 * fq + 8 * s);
    const int ch = n * BW + 16 * w + fr;
    W.br = -1.44269504f * F.in_BR[DIR * LW + ch]; W.bi = -1.44269504f * F.in_BI[DIR * LW + ch];
    const float lam = F.in_LAM[DIR * LW + ch];
    W.cl = -8.0f * 1.44269504f * ((lam > 15.f) ? __expf(-lam) : log1pf(__expf(-lam)));
}
template <int LDBG = 0> __device__ __forceinline__ void lru_gate(float pr, float pi, float xc, const LruW& W, bool first, float& a, float& u) {
    if constexpr (LDBG == 1) { a = pr + W.br; u = pi * xc + W.bi; return; }
    const float r = __builtin_amdgcn_rcpf(1.0f + __builtin_amdgcn_exp2f(__builtin_fmaf(pr, -1.44269504f, W.br))), d = 1.0f + __builtin_amdgcn_exp2f(__builtin_fmaf(pi, -1.44269504f, W.bi));
    a = __builtin_amdgcn_exp2f(W.cl * r);
    const float y = first ? 1.0f : fmaxf(__builtin_fmaf(-a, a, 1.0f), 1e-30f);
    u = xc * y * __builtin_amdgcn_rsqf(y * d * d);
}
struct LruX { bf16x8 x[4][4]; };
__device__ __forceinline__ void lru_load_x(LruX& X, const bf16_t* XC, int tb, int n, int fr, int fq) {
#pragma unroll
    for (int tau = 0; tau < 4; ++tau) { const bf16_t* xp = XC + ((size_t)((((tb >> 6) * NBLK + n) * 4 + tau) * 4) * 64 + fr * 4 + fq) * 8;
#pragma unroll
        for (int s = 0; s < 4; ++s) X.x[tau][s] = *(const bf16x8*)(xp + s * 512); }
}
__device__ __forceinline__ void lru_tile(const LruX& X, int tau, bool hiw, const LruW& W, const bf16x8 idf0, const bf16x8 idf1, f32x4& pr, f32x4& pi, f32x4& xct) {
    pr = (f32x4){0.f, 0.f, 0.f, 0.f}; pi = pr;
#pragma unroll
    for (int s = 0; s < 4; ++s) { pr = __builtin_amdgcn_mfma_f32_16x16x32_bf16(X.x[tau][s], W.w[0][s], pr, 0, 0, 0); pi = __builtin_amdgcn_mfma_f32_16x16x32_bf16(X.x[tau][s], W.w[1][s], pi, 0, 0, 0); }
    const bf16x8 x0 = hiw ? X.x[tau][2] : X.x[tau][0], x1 = hiw ? X.x[tau][3] : X.x[tau][1];
    xct = __builtin_amdgcn_mfma_f32_16x16x32_bf16(x0, idf0, (f32x4){0.f, 0.f, 0.f, 0.f}, 0, 0, 0);
    xct = __builtin_amdgcn_mfma_f32_16x16x32_bf16(x1, idf1, xct, 0, 0, 0);
}
__device__ __forceinline__ void lru_tile_lds(const LAS unsigned char* tile, int gl, int tau, bool hiw, const LruW& W, const bf16x8 idf0, const bf16x8 idf1, int fr, int fq, f32x4& pr, f32x4& pi, f32x4& xct) {
    bf16x8 x[4];
#pragma unroll
    for (int s = 0; s < 4; ++s) x[s] = *(const LAS bf16x8*)(tile + ((((gl * 4 + tau) * 4 + s) * 16 + fr) * 4 + fq) * 16);
    pr = (f32x4){0.f, 0.f, 0.f, 0.f}; pi = pr;
#pragma unroll
    for (int s = 0; s < 4; ++s) { pr = __builtin_amdgcn_mfma_f32_16x16x32_bf16(x[s], W.w[0][s], pr, 0, 0, 0); pi = __builtin_amdgcn_mfma_f32_16x16x32_bf16(x[s], W.w[1][s], pi, 0, 0, 0); }
    xct = __builtin_amdgcn_mfma_f32_16x16x32_bf16(hiw ? x[2] : x[0], idf0, (f32x4){0.f, 0.f, 0.f, 0.f}, 0, 0, 0);
    xct = __builtin_amdgcn_mfma_f32_16x16x32_bf16(hiw ? x[3] : x[1], idf1, xct, 0, 0, 0);
}
__device__ __forceinline__ void lru_idfrags(int w, int fr, int fq, bf16x8& idf0, bf16x8& idf1) {
#pragma unroll
    for (int e = 0; e < 8; ++e) { const bool on = (fq == (w >> 1)) && ((fr & 7) == e); idf0[e] = (on && fr < 8) ? (short)0x3F80 : (short)0; idf1[e] = (on && fr >= 8) ? (short)0x3F80 : (short)0; }
}
constexpr int LRU_CH = 256, LRU_NCH = L / LRU_CH, LRU_NCH_P = LP / LRU_CH;
__device__ __forceinline__ void conv_unit(Frame& F, int cg, int n) {
    const int tid_ = opaque(F.tid);
    const bf16_t* XR = wsp<bf16_t>(F, WS_XR); bf16_t* XC = wsp<bf16_t>(F, WS_XC);
    const float* wc = F.in_WCONV; const float* bc = F.in_BCONV;
    const int c0 = n * BW + (tid_ & 15) * 8;
    const int s0 = cg < LRU_NCH_P ? 0 : LP, len = cg < LRU_NCH_P ? LP : LS;
    f32x4 w[4][2]; f32x4 b0 = *(const f32x4*)(bc + c0), b1 = *(const f32x4*)(bc + c0 + 4);
#pragma unroll
    for (int j = 0; j < 4; ++j) { w[j][0] = *(const f32x4*)(wc + j * LW + c0); w[j][1] = *(const f32x4*)(wc + j * LW + c0 + 4); }
#pragma unroll
    for (int i = 0; i < 8; ++i) {
        const int t = cg * LRU_CH + (tid_ >> 4) + 32 * i, tl = t - s0;
        f32x4 a0 = b0, a1 = b1;
#pragma unroll
        for (int j = 0; j < 4; ++j) { const int tt = tl + j - 2; if (tt < 0 || tt >= len) continue;
            f32x4 x0, x1; pg8::unpack8(*(const u32x4*)(XR + (size_t)(s0 + tt) * LW + c0), x0, x1); a0 += w[j][0] * x0; a1 += w[j][1] * x1; }
        const int tg = t & 63, cq = tid_ & 15;
        *(u32x4*)(XC + ((size_t)(((((t >> 6) * NBLK + n) * 4 + ((tg >> 2) & 3)) * 4 + (cq & 3)) * 16 + 4 * (tg >> 4) + (tg & 3)) * 4 + (cq >> 2)) * 8) = pg8::pack8(a0, a1);
    }
}
__device__ __forceinline__ void conv_req(const Frame& F, int cg, int n, int tid_, u32x4 (&R)[11]) {
    const bf16_t* XR = wsp<bf16_t>(F, WS_XR);
    const int s0 = cg < LRU_NCH_P ? 0 : LP, len = cg < LRU_NCH_P ? LP : LS;
    const int t0 = cg * LRU_CH + 8 * (tid_ >> 4) - 2, c0 = n * BW + (tid_ & 15) * 8;
#pragma unroll
    for (int k = 0; k < 11; ++k) { const int tl = t0 + k - s0; R[k] = (u32x4){0u, 0u, 0u, 0u}; if (tl >= 0 && tl < len) R[k] = *(const u32x4*)(XR + (size_t)(t0 + k) * LW + c0); }
}
__device__ __forceinline__ void conv_fin(const Frame& F, int cg, int n, int tid_, const u32x4 (&R)[11], LAS unsigned char* tile, const LAS float* cw) {
    bf16_t* XC = wsp<bf16_t>(F, WS_XC);
    const int g = tid_ >> 4, cq = tid_ & 15;
    f32x4 w[4][2];
#pragma unroll
    for (int j = 0; j < 4; ++j) { w[j][0] = *(const LAS f32x4*)(cw + j * BW + cq * 8); w[j][1] = *(const LAS f32x4*)(cw + j * BW + cq * 8 + 4); }
    const f32x4 b0 = *(const LAS f32x4*)(cw + 4 * BW + cq * 8), b1 = *(const LAS f32x4*)(cw + 4 * BW + cq * 8 + 4);
#pragma unroll
    for (int i = 0; i < 8; ++i) {
        f32x4 a0 = b0, a1 = b1;
#pragma unroll
        for (int j = 0; j < 4; ++j) { f32x4 x0, x1; pg8::unpack8(R[i + j], x0, x1); a0 += w[j][0] * x0; a1 += w[j][1] * x1; }
        const int t = cg * LRU_CH + 8 * g + i, tg = t & 63;
        const int fo = ((((((tg >> 2) & 3) * 4 + (cq & 3)) * 16 + 4 * (tg >> 4) + (tg & 3)) * 4 + (cq >> 2)) * 8);
        const u32x4 o = pg8::pack8(a0, a1);
        *(u32x4*)(XC + (size_t)((t >> 6) * NBLK + n) * 8192 + fo) = o;
        *(LAS u32x4*)(tile + ((t >> 6) & 3) * 16384 + fo * 2) = o;
    }
}
__device__ __forceinline__ void lru_load_x_lds(LruX& X, const LAS unsigned char* tile, int gl, int fr, int fq) {
#pragma unroll
    for (int tau = 0; tau < 4; ++tau)
#pragma unroll
        for (int s = 0; s < 4; ++s) X.x[tau][s] = *(const LAS bf16x8*)(tile + ((((gl * 4 + tau) * 4 + s) * 16 + fr) * 4 + fq) * 16);
}
__device__ __forceinline__ void lru_pass_a(Frame& F) {
    const int tid_ = opaque(F.tid);
    const int fr = F.lane & 15, fq = F.lane >> 4, w = F.wave;
    f32x2* SUMM = wsp<f32x2>(F, WS_SUM);
    LAS unsigned char* tile = F.lds; LAS float* cw = (LAS float*)(F.lds + 65536);
    bf16x8 idf0, idf1; lru_idfrags(w, fr, fq, idf0, idf1);
    int u = blockIdx.x, ncur = -1;
    u32x4 R[11];
    if (u < LRU_NCH * NBLK) conv_req(F, u >> 4, u & 15, tid_, R);
    LruW Wf, Wb;
    for (; u < LRU_NCH * NBLK; u += F.G) {
        const int cg = u >> 4, n = u & 15;
        if (n != ncur) {
            ncur = n; lru_load_w<0>(F, Wf, n, w, fr, fq); lru_load_w<1>(F, Wb, n, w, fr, fq);
            for (int i = tid_; i < 5 * BW; i += NTHR) cw[i] = i < 4 * BW ? F.in_WCONV[(i >> 7) * LW + n * BW + (i & 127)] : F.in_BCONV[n * BW + (i & 127)];
            LDS_WAIT(); __builtin_amdgcn_s_barrier();
        }
        asm volatile("" ::: "memory");
        conv_fin(F, cg, n, tid_, R, tile, cw);
        { const int un = u + F.G; if (un < LRU_NCH * NBLK) conv_req(F, un >> 4, un & 15, tid_, R); }
        LDS_WAIT(); __builtin_amdgcn_s_barrier();
        const bool c_first = (cg == 0 || cg == LRU_NCH_P), c_last = (cg == LRU_NCH_P - 1 || cg == LRU_NCH - 1);
        float Af = 1.f, Hf = 0.f, Ab = 1.f, Hb = 0.f;
        for (int gi = 0; gi < 4; ++gi) {
            float pf = 1.f, hf = 0.f, pb = 1.f, hb = 0.f;
#pragma unroll 2
            for (int tau = 0; tau < 4; ++tau) {
                bf16x8 x[4];
#pragma unroll
                for (int s_ = 0; s_ < 4; ++s_) x[s_] = *(const LAS bf16x8*)(tile + ((((gi * 4 + tau) * 4 + s_) * 16 + fr) * 4 + fq) * 16);
                f32x4 prf = (f32x4){0.f, 0.f, 0.f, 0.f}, pif = prf, prb = prf, pib = prf, xct;
#pragma unroll
                for (int s_ = 0; s_ < 4; ++s_) { prf = __builtin_amdgcn_mfma_f32_16x16x32_bf16(x[s_], Wf.w[0][s_], prf, 0, 0, 0); pif = __builtin_amdgcn_mfma_f32_16x16x32_bf16(x[s_], Wf.w[1][s_], pif, 0, 0, 0);
                    prb = __builtin_amdgcn_mfma_f32_16x16x32_bf16(x[s_], Wb.w[0][s_], prb, 0, 0, 0); pib = __builtin_amdgcn_mfma_f32_16x16x32_bf16(x[s_], Wb.w[1][s_], pib, 0, 0, 0); }
                xct = __builtin_amdgcn_mfma_f32_16x16x32_bf16((w & 1) ? x[2] : x[0], idf0, (f32x4){0.f, 0.f, 0.f, 0.f}, 0, 0, 0);
                xct = __builtin_amdgcn_mfma_f32_16x16x32_bf16((w & 1) ? x[3] : x[1], idf1, xct, 0, 0, 0);
#pragma unroll
                for (int j = 0; j < 4; ++j) {
                    float a, uu;
                    lru_gate(prf[j], pif[j], xct[j], Wf, c_first && gi == 0 && fq == 0 && tau == 0 && j == 0, a, uu); hf = a * hf + uu; pf *= a;
                    lru_gate(prb[j], pib[j], xct[j], Wb, c_last && gi == 3 && fq == 3 && tau == 3 && j == 3, a, uu); hb += pb * uu; pb *= a;
                }
            }
            float gPf = 1.f, gHf = 0.f, gPb = 1.f, gHb = 0.f;
#pragma unroll
            for (int qq = 0; qq < 4; ++qq) { const int src = fr + 16 * qq;
                float P = __shfl(pf, src), H = __shfl(hf, src); gHf = P * gHf + H; gPf *= P;
                P = __shfl(pb, src); H = __shfl(hb, src); gHb += gPb * H; gPb *= P; }
            Hf = gPf * Hf + gHf; Af *= gPf; Hb += Ab * gHb; Ab *= gPb;
        }
        if (fq == 0) { const int ch = n * BW + 16 * w + fr; SUMM[(size_t)(cg * 2 + 0) * LW + ch] = (f32x2){Af, Hf}; SUMM[(size_t)(cg * 2 + 1) * LW + ch] = (f32x2){Ab, Hb}; }
        LDS_WAIT(); __builtin_amdgcn_s_barrier();
    }
    VM_WAIT();
}
__device__ __forceinline__ void lru_pass_b(Frame& F) {
    const int tid_ = opaque(F.tid);
    const int gt = blockIdx.x * NTHR + tid_; if (gt >= 4 * LW) return;
    const int ch = gt % LW, d = (gt / LW) & 1, seq = gt / (2 * LW), c0 = seq ? LRU_NCH_P : 0, nc = seq ? LRU_NCH - LRU_NCH_P : LRU_NCH_P;
    const f32x2* SUMM = wsp<f32x2>(F, WS_SUM); float* CIN = wsp<float>(F, WS_SUM + 4 * MiB);
    float s = 0.f;
    for (int i0 = 0; i0 < nc; i0 += 32) {
        f32x2 ah[32];
#pragma unroll
        for (int e = 0; e < 32; ++e) { const int cg = d ? c0 + nc - 1 - (i0 + e) : c0 + i0 + e; ah[e] = SUMM[(size_t)(cg * 2 + d) * LW + ch]; }
#pragma unroll
        for (int e = 0; e < 32; ++e) { const int cg = d ? c0 + nc - 1 - (i0 + e) : c0 + i0 + e; CIN[(size_t)(cg * 2 + d) * LW + ch] = s; s = ah[e].x * s + ah[e].y; }
    }
}
template <int LDBG = 0> __device__ __forceinline__ void lru_pass_c(Frame& F) {
    const int tid_ = opaque(F.tid);
    const int fr = F.lane & 15, fq = F.lane >> 4, w = F.wave;
    const bf16_t* XC = wsp<bf16_t>(F, WS_XC); const float* CIN = wsp<float>(F, WS_SUM + 4 * MiB);
    const bf16_t* GR = wsp<bf16_t>(F, WS_GR); bf16_t* LRU = wsp<bf16_t>(F, WS_XR);
    LAS unsigned char* tile = F.lds;
    LAS bf16_t* hfb = (LAS bf16_t*)(F.lds + 65536 + w * 8192);
    bf16x8 idf0, idf1; lru_idfrags(w, fr, fq, idf0, idf1);
    LruW Wf, Wb; int ncur = -1;
    for (int u = blockIdx.x; u < LRU_NCH * NBLK; u += F.G) {
        const int cg = u >> 4, n = u & 15, ch = n * BW + 16 * w + fr;
        const bool c_first = (cg == 0 || cg == LRU_NCH_P), c_last = (cg == LRU_NCH_P - 1 || cg == LRU_NCH - 1);
        { const bf16_t* gsrc = XC + (size_t)(cg * 4 * NBLK + n) * 8192 + tid_ * 8; LAS unsigned char* ldst = tile + w * 1024;
#pragma unroll 1
          for (int k = 0; k < 8; ++k) { __builtin_amdgcn_global_load_lds((const unsigned*)gsrc, (LAS unsigned*)ldst, 16, 0, 0); gsrc += (k & 1) ? (size_t)NBLK * 8192 - 4096 : 4096; ldst += 8192; } }
        if (n != ncur) { ncur = n; lru_load_w<0>(F, Wf, n, w, fr, fq); lru_load_w<1>(F, Wb, n, w, fr, fq); }
        const float cin_f = CIN[(size_t)(cg * 2 + 0) * LW + ch], cin_b = CIN[(size_t)(cg * 2 + 1) * LW + ch];
        const bf16_t* grp = GR + (size_t)(cg * LRU_CH + 16 * fq) * LW + ch; bf16_t* outp = LRU + (size_t)(cg * LRU_CH + 16 * fq) * LW + ch;
        VM_WAIT(); __builtin_amdgcn_s_barrier();
        {
            const LruW& W = Wf;
            float s = cin_f;
            for (int gi = 0; gi < 4; ++gi) {
                float a[16], uu[16];
#pragma unroll
                for (int tau = 0; tau < 4; ++tau) { f32x4 pr, pi, xct; lru_tile_lds(tile, gi, tau, (w & 1) != 0, W, idf0, idf1, fr, fq, pr, pi, xct);
#pragma unroll
                    for (int j = 0; j < 4; ++j) lru_gate<LDBG>(pr[j], pi[j], xct[j], W, c_first && gi == 0 && fq == 0 && tau == 0 && j == 0, a[4 * tau + j], uu[4 * tau + j]); }
                float p = 1.f, h = 0.f;
#pragma unroll
                for (int t = 0; t < 16; ++t) { h = a[t] * h + uu[t]; p *= a[t]; }
                float hin = s, sg = s;
#pragma unroll
                for (int qq = 0; qq < 4; ++qq) { const float P = __shfl(p, fr + 16 * qq), H = __shfl(h, fr + 16 * qq); sg = P * sg + H; if (qq < fq) hin = P * hin + H; }
                s = sg;
                float hh = hin;
#pragma unroll
                for (int t = 0; t < 16; ++t) { hh = a[t] * hh + uu[t]; hfb[(gi * 64 + 16 * fq + t) * 16 + fr] = (bf16_t)f2bf(hh); }
            }
        }
        {
            const LruW& W = Wb;
            float s = cin_b;
            bf16_t grn[16];
#pragma unroll
            for (int t = 0; t < 16; ++t) grn[t] = grp[(size_t)(3 * 64 + t) * LW];
            for (int gi = 3; gi >= 0; --gi) {
                bf16_t grc[16];
#pragma unroll
                for (int t = 0; t < 16; ++t) grc[t] = grn[t];
                if (gi > 0) {
#pragma unroll
                    for (int t = 0; t < 16; ++t) grn[t] = grp[(size_t)((gi - 1) * 64 + t) * LW]; }
                float a[16], uu[16];
#pragma unroll
                for (int tau = 0; tau < 4; ++tau) { f32x4 pr, pi, xct; lru_tile_lds(tile, gi, tau, (w & 1) != 0, W, idf0, idf1, fr, fq, pr, pi, xct);
#pragma unroll
                    for (int j = 0; j < 4; ++j) lru_gate<LDBG>(pr[j], pi[j], xct[j], W, c_last && gi == 3 && fq == 3 && tau == 3 && j == 3, a[4 * tau + j], uu[4 * tau + j]); }
                float p = 1.f, h = 0.f;
#pragma unroll
                for (int t = 15; t >= 0; --t) { h = a[t] * h + uu[t]; p *= a[t]; }
                float hin = s, sg = s;
#pragma unroll
                for (int qq = 3; qq >= 0; --qq) { const float P = __shfl(p, fr + 16 * qq), H = __shfl(h, fr + 16 * qq); sg = P * sg + H; if (qq > fq) hin = P * hin + H; }
                s = sg;
                float hh = hin;
#pragma unroll
                for (int t = 15; t >= 0; --t) { hh = a[t] * hh + uu[t];
                    outp[(size_t)(gi * 64 + t) * LW] = (bf16_t)f2bf((bf1(hfb[(gi * 64 + 16 * fq + t) * 16 + fr]) + hh) * gelu_tanh(bf1(grc[t]))); }
            }
        }
        LDS_WAIT(); __builtin_amdgcn_s_barrier();
    }
}

constexpr int HQW_EARLY = 96 * (D / 32);
__device__ __forceinline__ void hq_wtiles(Frame& F, int lo, int hi, int first, int stride) {
    const int lane = opaque(F.tid) & 63;
    LAS float* scr = (LAS float*)(F.lds + F.wave * 8448);
    for (int it = lo + first; it < hi; it += stride)
        had_tile_quant(F.in_WFD, D, DFF, 64 * (it / (D / 32)), 32 * (it % (D / 32)), wsp<signed char>(F, WS_WD), (const unsigned*)(F.ws + WS_AM), wsp<float>(F, WS_CS) + CS_D, scr, lane);
}
__device__ __forceinline__ void hq_phase(Frame& F) {
    const int lane = opaque(F.tid) & 63;
    const bf16_t* H0 = (const bf16_t*)F.out; const bf16_t* H1 = wsp<bf16_t>(F, WS_HIDS);
    signed char* Q0 = wsp<signed char>(F, WS_H8P); signed char* Q1 = wsp<signed char>(F, WS_H8S); float* RS3 = wsp<float>(F, WS_RS3);
    hq_wtiles(F, HQW_EARLY, (DFF / 64) * (D / 32), F.gw, F.ngw);
    constexpr int NB = DFF / 32;
    for (int m = F.gw; m < L; m += F.ngw) {
        const bf16_t* src = m < LP ? H0 + (size_t)m * DFF : H1 + (size_t)(m - LP) * DFF;
        signed char* dst = m < LP ? Q0 + (size_t)m * DFF : Q1 + (size_t)(m - LP) * DFF;
        u32x4 raw[6][4];
#pragma unroll
        for (int it = 0; it < 6; ++it) { const int b = lane + 64 * it; const u32x4* p = (const u32x4*)(src + (b < NB ? b : lane) * 32);
#pragma unroll
            for (int i = 0; i < 4; ++i) raw[it][i] = p[i]; }
        float mx = 0.f;
#pragma unroll
        for (int it = 0; it < 6; ++it) { float v[32];
#pragma unroll
            for (int i = 0; i < 4; ++i) { const u32x4 u = raw[it][i]; v[8 * i + 0] = bflo(u.x); v[8 * i + 1] = bfhi(u.x); v[8 * i + 2] = bflo(u.y); v[8 * i + 3] = bfhi(u.y); v[8 * i + 4] = bflo(u.z); v[8 * i + 5] = bfhi(u.z); v[8 * i + 6] = bflo(u.w); v[8 * i + 7] = bfhi(u.w); }
            fwht32(v);
            float bm = 0.f;
#pragma unroll
            for (int i = 0; i < 32; ++i) bm = fmaxf(bm, fabsf(v[i]));
            mx = fmaxf(mx, (lane + 64 * it < NB) ? bm : 0.f); }
        const float amax = fmaxf(wave_max(mx), 1e-20f), inv = 127.0f / amax;
        if (lane == 0) RS3[m] = amax * (1.0f / 127.0f);
#pragma unroll
        for (int it = 0; it < 6; ++it) { const int b = lane + 64 * it; float v[32];
#pragma unroll
            for (int i = 0; i < 4; ++i) { const u32x4 u = raw[it][i]; v[8 * i + 0] = bflo(u.x); v[8 * i + 1] = bfhi(u.x); v[8 * i + 2] = bflo(u.y); v[8 * i + 3] = bfhi(u.y); v[8 * i + 4] = bflo(u.z); v[8 * i + 5] = bfhi(u.z); v[8 * i + 6] = bflo(u.w); v[8 * i + 7] = bfhi(u.w); }
            fwht32(v);
            u32x4 o0, o1;
            o0.x = pk4_i8(rintf(v[0] * inv), rintf(v[1] * inv), rintf(v[2] * inv), rintf(v[3] * inv)); o0.y = pk4_i8(rintf(v[4] * inv), rintf(v[5] * inv), rintf(v[6] * inv), rintf(v[7] * inv));
            o0.z = pk4_i8(rintf(v[8] * inv), rintf(v[9] * inv), rintf(v[10] * inv), rintf(v[11] * inv)); o0.w = pk4_i8(rintf(v[12] * inv), rintf(v[13] * inv), rintf(v[14] * inv), rintf(v[15] * inv));
            o1.x = pk4_i8(rintf(v[16] * inv), rintf(v[17] * inv), rintf(v[18] * inv), rintf(v[19] * inv)); o1.y = pk4_i8(rintf(v[20] * inv), rintf(v[21] * inv), rintf(v[22] * inv), rintf(v[23] * inv));
            o1.z = pk4_i8(rintf(v[24] * inv), rintf(v[25] * inv), rintf(v[26] * inv), rintf(v[27] * inv)); o1.w = pk4_i8(rintf(v[28] * inv), rintf(v[29] * inv), rintf(v[30] * inv), rintf(v[31] * inv));
            if (b < NB) { *(u32x4*)(dst + b * 32) = o0; *(u32x4*)(dst + b * 32 + 16) = o1; } }
    }
}

__device__ __forceinline__ f32x4 up4(const u32x2 u) { return (f32x4){bflo(u.x), bfhi(u.x), bflo(u.y), bfhi(u.y)}; }
__device__ __forceinline__ void mid_phase(Frame& F) {
    const int tid_ = opaque(F.tid);
    bf16_t* MIX = wsp<bf16_t>(F, WS_MIX); signed char* XN8 = wsp<signed char>(F, WS_XN8); float* RS2 = wsp<float>(F, WS_RS2);
    LAS f32x4* gpost = (LAS f32x4*)F.lds; LAS f32x4* gpre = gpost + D / 4;
    for (int i = tid_; i < D / 4; i += NTHR) { gpost[i] = ((const f32x4*)F.in_GMPOST)[i]; gpre[i] = ((const f32x4*)F.in_GFPRE)[i]; }
    __syncthreads();
    for (int m = F.gw; m < L; m += F.ngw) {
        asm volatile("" ::: "memory");
        const f32x4* xr = (const f32x4*)xrow(F, m) + F.lane; const u32x2* mr = (const u32x2*)(MIX + (size_t)m * D) + F.lane;
        f32x4 v[16]; u32x2 mx[16]; float s = 0.f;
#pragma unroll
        for (int j = 0; j < 16; ++j) { v[j] = xr[64 * j]; mx[j] = mr[64 * j]; const f32x4 a = up4(mx[j]); s += (a.x * a.x + a.y * a.y) + (a.z * a.z + a.w * a.w); }
        const float rstd1 = 1.0f / sqrtf(wave_sum(s) * (1.0f / D) + EPS);
        float s2 = 0.f;
#pragma unroll
        for (int j = 0; j < 16; ++j) { v[j] = v[j] + up4(mx[j]) * rstd1 * gpost[F.lane + 64 * j]; s2 += (v[j].x * v[j].x + v[j].y * v[j].y) + (v[j].z * v[j].z + v[j].w * v[j].w); }
        const float rstd2 = 1.0f / sqrtf(wave_sum(s2) * (1.0f / D) + EPS);
        { u32x2* xw = (u32x2*)(MIX + (size_t)m * D) + F.lane;
#pragma unroll
          for (int j = 0; j < 16; ++j) xw[64 * j] = (u32x2){pk2(v[j].x, v[j].y), pk2(v[j].z, v[j].w)}; }
        float mx2 = 0.f;
#pragma unroll
        for (int j = 0; j < 16; ++j) { v[j] = v[j] * rstd2 * gpre[F.lane + 64 * j]; mx2 = fmaxf(fmaxf(mx2, fmaxf(fabsf(v[j].x), fabsf(v[j].y))), fmaxf(fabsf(v[j].z), fabsf(v[j].w))); }
        const float amax = fmaxf(wave_max(mx2), 1e-20f), inv = 127.0f / amax;
        if (F.lane == 0) RS2[m] = amax * (1.0f / 127.0f);
        unsigned* o4 = (unsigned*)(XN8 + (size_t)m * D) + F.lane;
#pragma unroll
        for (int j = 0; j < 16; ++j) o4[64 * j] = pk4_i8(rintf(v[j].x * inv), rintf(v[j].y * inv), rintf(v[j].z * inv), rintf(v[j].w * inv));
    }
    __syncthreads();
}
__device__ __forceinline__ void final_phase(Frame& F) {
    const int tid_ = opaque(F.tid);
    const bf16_t* X1 = wsp<bf16_t>(F, WS_MIX); const bf16_t* FB = wsp<bf16_t>(F, WS_F);
    LAS f32x4* gfp = (LAS f32x4*)F.lds;
    for (int i = tid_; i < D / 4; i += NTHR) gfp[i] = ((const f32x4*)F.in_GFPOST)[i];
    __syncthreads();
    for (int m = F.gw; m < L; m += F.ngw) {
        asm volatile("" ::: "memory");
        const u32x2* mr = (const u32x2*)(X1 + (size_t)m * D) + F.lane; const u32x2* fr = (const u32x2*)(FB + (size_t)m * D) + F.lane;
        u32x2 fx[16], x1[16]; float s = 0.f;
#pragma unroll
        for (int j = 0; j < 16; ++j) { fx[j] = fr[64 * j]; x1[j] = mr[64 * j]; const f32x4 a = up4(fx[j]); s += (a.x * a.x + a.y * a.y) + (a.z * a.z + a.w * a.w); }
        const float rstd3 = 1.0f / sqrtf(wave_sum(s) * (1.0f / D) + EPS);
        f32x4* o = (f32x4*)(F.out + (size_t)m * D) + F.lane;
#pragma unroll
        for (int j = 0; j < 16; ++j) o[64 * j] = up4(x1[j]) + up4(fx[j]) * rstd3 * gfp[F.lane + 64 * j];
    }
}

constexpr int LDS_STAGE = pg8::STAGE_BYTES;
constexpr int LDS_MISC = LDS_STAGE;
constexpr int LDS_BYTES = LDS_STAGE + 1024;
#ifndef MK_N_LAUNCHES
#define MK_N_LAUNCHES 1
#endif
constexpr int NPHASE = 12;
struct Args { const float* in[23]; float* out; unsigned char* ws; int ph_lo, ph_hi; };

__global__ void __launch_bounds__(NTHR, 2) fwd_kernel(Args args) {
    extern __shared__ __attribute__((aligned(16))) unsigned char lds_raw[];
    Frame F;
    F.lds = (LAS unsigned char*)lds_raw;
    F.tid = threadIdx.x; F.lane = (int)__builtin_amdgcn_mbcnt_hi(~0u, __builtin_amdgcn_mbcnt_lo(~0u, 0u)); F.wave = __builtin_amdgcn_readfirstlane(F.tid >> 6);
    F.G = gridDim.x; F.gw = blockIdx.x * NWAVES + F.wave; F.ngw = F.G * NWAVES;
    F.in_XP = args.in[0]; F.in_XS = args.in[1]; F.in_WIN = args.in[2]; F.in_WCONV = args.in[3]; F.in_BCONV = args.in[4]; F.in_WR = args.in[5]; F.in_BR = args.in[6]; F.in_WI = args.in[7]; F.in_BI = args.in[8]; F.in_LAM = args.in[9]; F.in_RPB = args.in[10]; F.in_WNO = args.in[11]; F.in_WLO = args.in[12]; F.in_WM = args.in[13]; F.in_BM = args.in[14]; F.in_WOUT = args.in[15]; F.in_GMPRE = args.in[16]; F.in_GMPOST = args.in[17]; F.in_GFPRE = args.in[18]; F.in_GFPOST = args.in[19]; F.in_WFG = args.in[20]; F.in_WFU = args.in[21]; F.in_WFD = args.in[22];
    F.out = args.out; F.ws = args.ws;
    volatile LAS unsigned* MISC = (volatile LAS unsigned*)(F.lds + LDS_MISC);
    if (F.tid < 256) MISC[F.tid] = 0u;
    __syncthreads();
    const int lo = args.ph_lo, hi = args.ph_hi;
    const bool fused = (hi - lo) > 1;
    XcdBarrier bar; bar.bar = (unsigned*)(F.ws + WS_CTL); bar.x = 0; bar.st = nullptr;
    if (fused) bar = xcd_barrier_post((unsigned*)(F.ws + WS_CTL), MISC + 8);
#ifndef PH_MASK
#define PH_MASK 0xfff
#endif
#define IN(k) (((PH_MASK >> (k)) & 1) && lo <= (k) && (k) < hi)
#define SEAM(k) do { if (IN(k) && IN((k) + 1)) xcd_barrier(bar); } while (0)
    LAS unsigned char* stage = F.lds;

#ifdef ATTN_OUT_OFF
#define NA_BUF ((size_t)ATTN_OUT_OFF * MiB)
#else
#define NA_BUF WS_Q
#endif
#ifndef DUP_MASK
#define DUP_MASK 0
#endif
#define RUN(k, ...) if (IN(k)) { __VA_ARGS__ if (((DUP_MASK) >> (k)) & 1) { __VA_ARGS__ } }
    RUN(0, { p0_prologue(F); }) SEAM(0);
    RUN(1, {
        { pg8::Gemm g{wsp<bf16_t>(F, WS_XN8), wsp<bf16_t>(F, WS_XN8), 1 << 30, wsp<bf16_t>(F, WS_W8), L, 2 * NAW + 2 * D, D}; pg8::StaticOrder S; S.init(L, 2 * NAW + 2 * D, F.G, (int)blockIdx.x);
          pg8::EpiProjQ E{wsp<bf16_t>(F, WS_Q), wsp<bf16_t>(F, WS_K), (bf16_t*)F.out, F.in_BM, wsp<float>(F, WS_RS1), wsp<float>(F, WS_CS) + CS_QKM};
          pg8::gemm_phase<pg8::EpiProjQ, pg8::StaticOrder, true, true, 2>(stage, g, S, E); }
        { pg8::Gemm g{wsp<bf16_t>(F, WS_XN), wsp<bf16_t>(F, WS_XN), 1 << 30, wsp<bf16_t>(F, WS_WCAT), L, 2 * NAW, 2 * D}; pg8::StaticOrder S; S.init(L, 2 * NAW, F.G, (int)blockIdx.x);
          pg8::EpiProj E{wsp<bf16_t>(F, WS_XR), wsp<bf16_t>(F, WS_GR), wsp<bf16_t>(F, WS_GR), wsp<bf16_t>(F, WS_GR), (bf16_t*)F.out, F.in_BM, 1 << 30};
          pg8::gemm_phase<pg8::EpiProj, pg8::StaticOrder, true, true, 0>(stage, g, S, E); }
        { pg8::Gemm g{wsp<bf16_t>(F, WS_WVT), wsp<bf16_t>(F, WS_WVT), 1 << 30, wsp<bf16_t>(F, WS_XN8), NAW, L, D}; pg8::StaticOrder S; S.init(NAW, L, F.G, (int)blockIdx.x);
          pg8::EpiVTQ E{wsp<bf16_t>(F, WS_VT), wsp<float>(F, WS_CS) + CS_V, wsp<float>(F, WS_RS1)};
          pg8::gemm_phase<pg8::EpiVTQ, pg8::StaticOrder, true, true, 2>(stage, g, S, E); }
    }) SEAM(1);
    RUN(2, { lru_pass_a(F); }) SEAM(2);
    #ifdef ATTN_OUT_OFF
    if (IN(3)) { lru_pass_b(F); } SEAM(3);
    if (IN(4)) { lru_pass_c<0>(F); xcd_barrier(bar); if (ATTN_DUP) attn_mfma<ATTN_DUP - 1>(F); attn_mfma<0>(F); } SEAM(4);
#else
    if (IN(3)) { lru_pass_b(F); attn_mfma_lds(F); } SEAM(3);
#ifdef LRUC_DBG
    if (IN(4)) { lru_pass_c<LRUC_DBG>(F); lru_pass_c<0>(F); } SEAM(4);
#else
    RUN(4, { lru_pass_c<0>(F); }) SEAM(4);
#endif
#endif
    if (IN(5)) {
        { pg8::Gemm g{wsp<bf16_t>(F, NA_BUF), wsp<bf16_t>(F, NA_BUF), 1 << 30, wsp<bf16_t>(F, WS_WNO), L, D, 2 * NAW}; pg8::StaticOrder S; S.init(L, D, F.G, (int)blockIdx.x);
          pg8::EpiMulG<false> E{wsp<bf16_t>(F, WS_T1), (const bf16_t*)F.out, 0};
          pg8::gemm_phase<pg8::EpiMulG<false>, pg8::StaticOrder, true, true>(stage, g, S, E); }
        { pg8::Gemm g{wsp<bf16_t>(F, WS_XR), wsp<bf16_t>(F, WS_XR), 1 << 30, wsp<bf16_t>(F, WS_WLO), L, D, 2 * LW}; pg8::StaticOrder S; S.init(L, D, F.G, (int)blockIdx.x);
          pg8::EpiMulG<true> E{wsp<bf16_t>(F, WS_T1), (const bf16_t*)F.out, D};
          pg8::gemm_phase<pg8::EpiMulG<true>, pg8::StaticOrder, true, true>(stage, g, S, E); }
    } SEAM(5);
    RUN(6, {
        pg8::Gemm g{wsp<bf16_t>(F, WS_T1), wsp<bf16_t>(F, WS_T1), 1 << 30, wsp<bf16_t>(F, WS_WO), L, D, 2 * D}; pg8::StaticOrder S; S.init(L, D, F.G, (int)blockIdx.x);
        pg8::EpiPlain E{wsp<bf16_t>(F, WS_MIX), D};
        pg8::gemm_phase<pg8::EpiPlain, pg8::StaticOrder, true, true>(stage, g, S, E);
    }) SEAM(6);
    RUN(7, { mid_phase(F); }) SEAM(7);
    RUN(8, {
        pg8::Gemm g{wsp<bf16_t>(F, WS_XN8), wsp<bf16_t>(F, WS_XN8), 1 << 30, wsp<bf16_t>(F, WS_WGU), L, 2 * DFF, D}; pg8::StaticOrder S; S.init(L, 2 * DFF, F.G, (int)blockIdx.x);
        pg8::EpiSwigluQ E{(bf16_t*)F.out, wsp<bf16_t>(F, WS_HIDS), LP / 256, wsp<float>(F, WS_RS2), wsp<float>(F, WS_CS) + CS_GU};
        pg8::gemm_phase<pg8::EpiSwigluQ, pg8::StaticOrder, false, true, 2>(stage, g, S, E);
        { const int rem = S.nwg % F.G;
          if ((int)blockIdx.x >= rem) hq_wtiles(F, 0, HQW_EARLY, ((int)blockIdx.x - rem) * NWAVES + F.wave, (F.G - rem) * NWAVES); }
    }) SEAM(8);
    RUN(9, { hq_phase(F); }) SEAM(9);
    RUN(10, {
        pg8::Gemm g{wsp<bf16_t>(F, WS_H8P), wsp<bf16_t>(F, WS_H8S), LP / 256, wsp<bf16_t>(F, WS_WD), L, D, DFF}; pg8::StaticOrder S; S.init(L, D, F.G, (int)blockIdx.x);
        pg8::EpiPlainQ E{wsp<bf16_t>(F, WS_F), D, wsp<float>(F, WS_RS3), wsp<float>(F, WS_CS) + CS_D};
        pg8::gemm_phase<pg8::EpiPlainQ, pg8::StaticOrder, true, true, 2>(stage, g, S, E);
    }) SEAM(10);
    RUN(11, { final_phase(F); })
#undef RUN
#undef IN
#undef SEAM
}

extern "C" void kernel_launch(void* const* d_in, const int* in_sizes, int n_in, void* d_out, int out_size, void* d_ws, size_t ws_size, hipStream_t stream) {
    static int grid = 0;
    if (grid == 0) {
        if (n_in != 23 || in_sizes[0] != LP * D || in_sizes[1] != LS * D || out_size != L * D || ws_size < WS_END) {
            fprintf(stderr, "kernel_launch: unexpected shapes: n_in %d in0 %d out %d ws %zu (need %zu)\n", n_in, n_in > 0 ? in_sizes[0] : -1, out_size, ws_size, (size_t)WS_END); grid = -1; return; }
        int dev = 0, cus = 0, per_cu = 0;
        if (hipGetDevice(&dev) != hipSuccess || hipDeviceGetAttribute(&cus, hipDeviceAttributeMultiprocessorCount, dev) != hipSuccess) { grid = -1; return; }
        if (hipFuncSetAttribute((const void*)fwd_kernel, hipFuncAttributeMaxDynamicSharedMemorySize, LDS_BYTES) != hipSuccess) { fprintf(stderr, "kernel_launch: hipFuncSetAttribute failed\n"); grid = -1; return; }
        if (hipOccupancyMaxActiveBlocksPerMultiprocessor(&per_cu, (const void*)fwd_kernel, NTHR, LDS_BYTES) != hipSuccess || per_cu < 1) { fprintf(stderr, "kernel_launch: occupancy query says %d\n", per_cu); }
        (void)hipGetLastError();
        grid = cus;
    }
    if (grid < 0) return;
    (void)hipMemsetAsync((char*)d_ws + WS_CTL, 0, CTL_ZERO_BYTES, stream);
#ifdef DBG_ZERO_ALL
    (void)hipMemsetAsync((char*)d_ws, 0, WS_END, stream); (void)hipMemsetAsync((char*)d_out, 0, (size_t)L * D * 4, stream);
#endif
    Args a{};
    for (int i = 0; i < 23; ++i) a.in[i] = (const float*)d_in[i];
    a.out = (float*)d_out; a.ws = (unsigned char*)d_ws;
#if MK_N_LAUNCHES == 1
    a.ph_lo = 0; a.ph_hi = NPHASE;
    hipLaunchKernelGGL(fwd_kernel, dim3(grid), dim3(NTHR), LDS_BYTES, stream, a);
#else
    for (int p = 0; p < NPHASE; ++p) {
#ifdef DBG_PH_MASK
        if (!((DBG_PH_MASK >> p) & 1)) continue;
#endif
        a.ph_lo = p; a.ph_hi = p + 1; hipLaunchKernelGGL(fwd_kernel, dim3(grid), dim3(NTHR), LDS_BYTES, stream, a); }
#endif
}
```

```cpp
#include <hip/hip_runtime.h>
#include <cstdio>
#include <cstdint>

#define LAS __attribute__((address_space(3)))
typedef unsigned short bf16_t;
typedef short bf16x8 __attribute__((ext_vector_type(8)));
typedef float f32x4 __attribute__((ext_vector_type(4)));
typedef float f32x2 __attribute__((ext_vector_type(2)));
typedef unsigned u32x4 __attribute__((ext_vector_type(4)));
typedef unsigned u32x2 __attribute__((ext_vector_type(2)));

constexpr int D = 4096, LP = 16384, LS = 8192, L = LP + LS;
constexpr int GRIDW = 64, HD = 128, NH = 16, NAW = 2048, LW = 2048, NBLK = 16, BW = 128, DFF = 11008, INW = 10240;
constexpr float EPS = 1e-6f;
constexpr int NWAVES = 8, NTHR = 512;

constexpr size_t MiB = 1u << 20;
constexpr size_t WS_CTL = 0, CTL_ZERO_BYTES = 64 * 1024;
constexpr size_t WS_AM = 32 * 1024;
constexpr size_t WS_RSTD = 1 * MiB;
constexpr size_t WS_RS1 = 1 * MiB + 128 * 1024;
constexpr size_t WS_RS2 = 1 * MiB + 256 * 1024;
constexpr size_t WS_CS = 1 * MiB + 384 * 1024;
constexpr size_t WS_SUM = 2 * MiB;
constexpr size_t WS_WCAT = 8 * MiB;
constexpr size_t WS_W8 = 40 * MiB;
constexpr size_t WS_WVT = 88 * MiB;
constexpr size_t WS_XN8 = 96 * MiB;
constexpr size_t WS_WNO = 192 * MiB;
constexpr size_t WS_WLO = 208 * MiB;
constexpr size_t WS_WO = 224 * MiB;
constexpr size_t WS_WGU = 256 * MiB;
constexpr size_t WS_WD = 342 * MiB;
constexpr size_t WS_WG = 428 * MiB;
constexpr size_t WS_XN = 430 * MiB;
constexpr size_t WS_Q = 622 * MiB;
constexpr size_t WS_XR = 718 * MiB;
constexpr size_t WS_K = 814 * MiB;
constexpr size_t WS_VT = 910 * MiB;
constexpr size_t WS_GR = 1006 * MiB;
constexpr size_t WS_XC = 1102 * MiB;
constexpr size_t WS_END = 1198 * MiB;
constexpr int CS_QKM = 0, CS_V = 12288, CS_GU = 12288 + 2048, CS_D = 12288 + 2048 + 22016;
constexpr size_t WS_RS3 = 1 * MiB + 640 * 1024;
constexpr size_t WS_H8P = WS_XN, WS_H8S = WS_XN8;
constexpr size_t WS_T1 = WS_K;
constexpr size_t WS_MIX = WS_GR;
constexpr size_t WS_HIDS = WS_Q;
constexpr size_t WS_F = WS_K;
constexpr size_t WS_HF = WS_K;

#define LDS_WAIT() asm volatile("s_waitcnt lgkmcnt(0)" ::: "memory")
#define VM_WAIT() asm volatile("s_waitcnt vmcnt(0)" ::: "memory")
typedef __bf16 bf16x2n_t __attribute__((ext_vector_type(2)));
__device__ __forceinline__ unsigned pk2(float lo, float hi) { const bf16x2n_t r = __builtin_convertvector((f32x2){lo, hi}, bf16x2n_t); return __builtin_bit_cast(unsigned, r); }
__device__ __forceinline__ unsigned f2bf(float f) { return pk2(f, 0.f) & 0xffffu; }
__device__ __forceinline__ float bflo(unsigned u) { return __builtin_bit_cast(float, u << 16); }
__device__ __forceinline__ float bfhi(unsigned u) { return __builtin_bit_cast(float, u & 0xffff0000u); }
__device__ __forceinline__ float bf1(bf16_t u) { return __builtin_bit_cast(float, (unsigned)u << 16); }
__device__ __forceinline__ float wave_sum(float v) {
#pragma unroll
    for (int o = 1; o < 64; o <<= 1) v += __shfl_xor(v, o);
    return v;
}
__device__ __forceinline__ float wave_max(float v) {
#pragma unroll
    for (int o = 1; o < 64; o <<= 1) v = fmaxf(v, __shfl_xor(v, o));
    return v;
}
__device__ __forceinline__ float sigmoidf_(float v) { return __builtin_amdgcn_rcpf(1.0f + __expf(-v)); }
__device__ __forceinline__ float gelu_tanh(float v) { const float z = v * __builtin_fmaf(v * v, -0.1029432f, -2.3022082f); return v * __builtin_amdgcn_rcpf(1.0f + __builtin_amdgcn_exp2f(z)); }

namespace pg8 {
constexpr int BM = 256, BK = 64, HALF = 128, HTB = HALF * BK * 2  , STAGE_BYTES = 8 * HTB, NXCD = 8, WGM = 4;

__host__ __device__ __forceinline__ int lds_byte(int r, int c) { return (r >> 3) * 1024 + (r & 7) * 128 + ((((c >> 3) ^ r) & 7) << 4) + (c & 7) * 2; }
__host__ __device__ __forceinline__ void stage_rc(int b, int& R, int& C) { const int ch = b >> 10, rr = (b >> 7) & 7, slot = (b >> 4) & 7; R = ch * 8 + rr; C = ((slot ^ rr) & 7) * 8; }
__host__ __device__ __forceinline__ int perm32(int rho) { const int n = rho >> 4, i = rho & 15; return 8 * (i >> 2) + 4 * n + (i & 3); }

struct Unit { int pm, pn; };
struct Gemm {
    const bf16_t* A; const bf16_t* A2; int pm_split; const bf16_t* Bt; int M, N, rb;
    __device__ __forceinline__ const char* abase(int pm) const { const size_t t = (size_t)BM * rb; return pm < pm_split ? (const char*)A + (size_t)pm * t : (const char*)A2 + (size_t)(pm - pm_split) * t; }
    __device__ __forceinline__ const char* bbase(int pn) const { return (const char*)Bt + (size_t)pn * BM * rb; }
};

struct StaticOrder {
    int nM, nN, nwg, G, c;
    __host__ __device__ void init(int M, int N, int G_, int c_) { nM = M / BM; nN = N / BM; nwg = nM * nN; G = G_; c = c_; }
    __host__ __device__ bool next(int i, Unit& u) const {
        const long Lx = (long)i * G + c; if (Lx >= nwg) return false;
        int wgid = (int)Lx; { const int q = nwg / NXCD, r = nwg % NXCD, xcd = wgid % NXCD, off = wgid / NXCD; wgid = (xcd < r ? xcd * (q + 1) : r * (q + 1) + (xcd - r) * q) + off; }
        const int nig = WGM * nN, gid = wgid / nig, fm = gid * WGM, gsz = (nM - fm) < WGM ? (nM - fm) : WGM;
        u.pm = fm + ((wgid % nig) % gsz); u.pn = (wgid % nig) / gsz; return true;
    }
    __device__ __forceinline__ void a_ready(const Unit&) const {}
    __device__ __forceinline__ void done(const Unit&) const {}
};

typedef int v8i32 __attribute__((ext_vector_type(8)));
typedef int v4i32 __attribute__((ext_vector_type(4)));
typedef __bf16 bf16x2_t __attribute__((ext_vector_type(2)));
__device__ __forceinline__ unsigned cvt_pk_bf16(float lo, float hi) { const bf16x2_t r = __builtin_convertvector((f32x2){lo, hi}, bf16x2_t); return __builtin_bit_cast(unsigned, r); }
__device__ __forceinline__ u32x4 pack8(const f32x4 v0, const f32x4 v1) { u32x4 w; w.x = cvt_pk_bf16(v0[0], v0[1]); w.y = cvt_pk_bf16(v0[2], v0[3]); w.z = cvt_pk_bf16(v1[0], v1[1]); w.w = cvt_pk_bf16(v1[2], v1[3]); return w; }
__device__ __forceinline__ void unpack8(const u32x4 w, f32x4& v0, f32x4& v1) { v0 = (f32x4){bflo(w.x), bfhi(w.x), bflo(w.y), bfhi(w.y)}; v1 = (f32x4){bflo(w.z), bfhi(w.z), bflo(w.w), bfhi(w.w)}; }
__device__ __forceinline__ f32x4 sig4(const f32x4 v) { f32x4 r; r[0] = sigmoidf_(v[0]); r[1] = sigmoidf_(v[1]); r[2] = sigmoidf_(v[2]); r[3] = sigmoidf_(v[3]); return r; }

struct EpiPlain {
    static constexpr bool PERM = true, AFTER_DRAIN = false;
    bf16_t* O; int ldc;
    __device__ __forceinline__ void operator()(const f32x4 (&acc)[2][2][4][2], const Unit& u, int wr, int wc, int fr, int fq) const {
        const int row0 = u.pm * BM + wr * 64 + fr, col0 = u.pn * BM + wc * 32 + 8 * fq;
#pragma unroll
        for (int ai = 0; ai < 2; ++ai)
#pragma unroll
            for (int m = 0; m < 4; ++m) { bf16_t* rowp = O + (size_t)(row0 + ai * HALF + m * 16) * ldc + col0;
#pragma unroll
                for (int bj = 0; bj < 2; ++bj) *(u32x4*)(rowp + bj * HALF) = pack8(acc[ai][bj][m][0], acc[ai][bj][m][1]); }
    }
};
struct EpiVT {
    static constexpr bool PERM = true, AFTER_DRAIN = false;
    bf16_t* O;
    __device__ __forceinline__ void operator()(const f32x4 (&acc)[2][2][4][2], const Unit& u, int wr, int wc, int fr, int fq) const {
        const int row0 = u.pm * BM + wr * 64 + fr, col0 = u.pn * BM + wc * 32 + 8 * fq;
#pragma unroll
        for (int ai = 0; ai < 2; ++ai)
#pragma unroll
            for (int m = 0; m < 4; ++m) { const int row = row0 + ai * HALF + m * 16, hh = row >> 7, d = row & 127;
                const int dt = 2 * (d >> 5) + ((d >> 2) & 1), i = 4 * ((d >> 3) & 3) + (d & 3);
#pragma unroll
                for (int bj = 0; bj < 2; ++bj) { const int tok = col0 + bj * HALF, R = tok >> 6, o = (tok & 63) >> 3;
                    *(u32x4*)(O + ((size_t)((((R * 16 + hh) * 8 + dt) * 8 + o) * 16 + i)) * 8) = pack8(acc[ai][bj][m][0], acc[ai][bj][m][1]); } }
    }
};
struct EpiProj {
    static constexpr bool PERM = true, AFTER_DRAIN = false;
    bf16_t* P0; bf16_t* P1; bf16_t* P2; bf16_t* P3; bf16_t* G; const float* bias; int pn_gate0;
    __device__ __forceinline__ void operator()(const f32x4 (&acc)[2][2][4][2], const Unit& u, int wr, int wc, int fr, int fq) const {
        const int row0 = u.pm * BM + wr * 64 + fr;
        if (u.pn < pn_gate0) {
            const int t = u.pn >> 3; bf16_t* base = t == 0 ? P0 : (t == 1 ? P1 : (t == 2 ? P2 : P3));
            const int col0 = (u.pn & 7) * BM + wc * 32 + 8 * fq;
            if (t == 2) {
#pragma unroll
                for (int ai = 0; ai < 2; ++ai)
#pragma unroll
                    for (int m = 0; m < 4; ++m) { const int tok = row0 + ai * HALF + m * 16, R = tok >> 6, cl = tok & 63;
                        const int tokpart = (((cl >> 2) & 1) * 8 + (cl >> 3)) * 4 + (cl & 3);
#pragma unroll
                        for (int bj = 0; bj < 2; ++bj) { const int c = col0 + bj * HALF, hh = c >> 7, d0 = c & 127;
                            *(u32x4*)(base + ((size_t)(((R * 16 + hh) * 4 + (d0 >> 5)) * 64 + tokpart) * 4 + ((d0 >> 3) & 3)) * 8) = pack8(acc[ai][bj][m][0], acc[ai][bj][m][1]); } }
            } else {
#pragma unroll
            for (int ai = 0; ai < 2; ++ai)
#pragma unroll
                for (int m = 0; m < 4; ++m) { bf16_t* rowp = base + (size_t)(row0 + ai * HALF + m * 16) * NAW + col0;
#pragma unroll
                    for (int bj = 0; bj < 2; ++bj) *(u32x4*)(rowp + bj * HALF) = pack8(acc[ai][bj][m][0], acc[ai][bj][m][1]); }
            }
        } else {
            const int col0 = (u.pn - pn_gate0) * BM + wc * 32 + 8 * fq;
            f32x4 bv[2][2];
#pragma unroll
            for (int bj = 0; bj < 2; ++bj)
#pragma unroll
                for (int n = 0; n < 2; ++n) bv[bj][n] = *(const f32x4*)(bias + col0 + bj * HALF + 4 * n);
#pragma unroll
            for (int ai = 0; ai < 2; ++ai)
#pragma unroll
                for (int m = 0; m < 4; ++m) { bf16_t* rowp = G + (size_t)(row0 + ai * HALF + m * 16) * (2 * D) + col0;
#pragma unroll
                    for (int bj = 0; bj < 2; ++bj) *(u32x4*)(rowp + bj * HALF) = pack8(sig4(acc[ai][bj][m][0] + bv[bj][0]), sig4(acc[ai][bj][m][1] + bv[bj][1])); }
        }
    }
};
template <bool ADD> struct EpiMulG {
    static constexpr bool PERM = true, AFTER_DRAIN = false;
    bf16_t* O; const bf16_t* G; int goff;
    __device__ __forceinline__ void operator()(const f32x4 (&acc)[2][2][4][2], const Unit& u, int wr, int wc, int fr, int fq) const {
        const int row0 = u.pm * BM + wr * 64 + fr, col0 = u.pn * BM + wc * 32 + 8 * fq;
#pragma unroll
        for (int ai = 0; ai < 2; ++ai)
#pragma unroll
            for (int m = 0; m < 4; ++m) { const size_t row = (size_t)(row0 + ai * HALF + m * 16); bf16_t* rowp = O + row * D + col0; const bf16_t* gp = G + row * (2 * D) + goff + col0;
#pragma unroll
                for (int bj = 0; bj < 2; ++bj) {
                    f32x4 g0, g1; unpack8(*(const u32x4*)(gp + bj * HALF), g0, g1);
                    f32x4 v0 = acc[ai][bj][m][0] * g0, v1 = acc[ai][bj][m][1] * g1;
                    if (ADD) { f32x4 t0, t1; unpack8(*(const u32x4*)(rowp + bj * HALF), t0, t1); v0 += t0; v1 += t1; }
                    *(u32x4*)(rowp + bj * HALF) = pack8(v0, v1); } }
    }
};
struct EpiSwiglu {
    static constexpr bool PERM = true, AFTER_DRAIN = false;
    bf16_t* H0; bf16_t* H1; int pm_split;
    __device__ __forceinline__ void operator()(const f32x4 (&acc)[2][2][4][2], const Unit& u, int wr, int wc, int fr, int fq) const {
        bf16_t* base = u.pm < pm_split ? H0 + (size_t)u.pm * BM * DFF : H1 + (size_t)(u.pm - pm_split) * BM * DFF;
        const int row0 = wr * 64 + fr, col0 = u.pn * HALF + wc * 32 + 8 * fq;
#pragma unroll
        for (int ai = 0; ai < 2; ++ai)
#pragma unroll
            for (int m = 0; m < 4; ++m) {
                f32x4 h[2];
#pragma unroll
                for (int n = 0; n < 2; ++n) { const f32x4 g = acc[ai][0][m][n], up = acc[ai][1][m][n];
#pragma unroll
                    for (int j = 0; j < 4; ++j) h[n][j] = g[j] * sigmoidf_(g[j]) * up[j]; }
                *(u32x4*)(base + (size_t)(row0 + ai * HALF + m * 16) * DFF + col0) = pack8(h[0], h[1]); }
    }
};

__device__ __forceinline__ f32x4 deq4(const f32x4 accbits, const float sa, const f32x4 sb) { const v4i32 q = __builtin_bit_cast(v4i32, accbits); return (f32x4){(float)q.x, (float)q.y, (float)q.z, (float)q.w} * sa * sb; }
struct EpiProjQ {
    static constexpr bool PERM = true, AFTER_DRAIN = false;
    bf16_t* Qb; bf16_t* Kb; bf16_t* G; const float* bias; const float* sa; const float* sb;
    __device__ __forceinline__ void operator()(const f32x4 (&acc)[2][2][4][2], const Unit& u, int wr, int wc, int fr, int fq) const {
        const int row0 = u.pm * BM + wr * 64 + fr, cg0 = u.pn * BM + wc * 32 + 8 * fq;
        f32x4 sbv[2][2];
#pragma unroll
        for (int bj = 0; bj < 2; ++bj)
#pragma unroll
            for (int n = 0; n < 2; ++n) sbv[bj][n] = *(const f32x4*)(sb + cg0 + bj * HALF + 4 * n);
        if (u.pn < 8) {
            const int col0 = u.pn * BM + wc * 32 + 8 * fq;
#pragma unroll
            for (int ai = 0; ai < 2; ++ai)
#pragma unroll
                for (int m = 0; m < 4; ++m) { const int row = row0 + ai * HALF + m * 16; const float sr = sa[row]; bf16_t* rowp = Qb + (size_t)row * NAW + col0;
#pragma unroll
                    for (int bj = 0; bj < 2; ++bj) *(u32x4*)(rowp + bj * HALF) = pack8(deq4(acc[ai][bj][m][0], sr, sbv[bj][0]), deq4(acc[ai][bj][m][1], sr, sbv[bj][1])); }
        } else if (u.pn < 16) {
            const int col0 = (u.pn - 8) * BM + wc * 32 + 8 * fq;
#pragma unroll
            for (int ai = 0; ai < 2; ++ai)
#pragma unroll
                for (int m = 0; m < 4; ++m) { const int tok = row0 + ai * HALF + m * 16, R = tok >> 6, cl = tok & 63; const float sr = sa[tok];
                    const int tokpart = (((cl >> 2) & 1) * 8 + (cl >> 3)) * 4 + (cl & 3);
#pragma unroll
                    for (int bj = 0; bj < 2; ++bj) { const int c = col0 + bj * HALF, hh = c >> 7, d0 = c & 127;
                        *(u32x4*)(Kb + ((size_t)(((R * 16 + hh) * 4 + (d0 >> 5)) * 64 + tokpart) * 4 + ((d0 >> 3) & 3)) * 8) = pack8(deq4(acc[ai][bj][m][0], sr, sbv[bj][0]), deq4(acc[ai][bj][m][1], sr, sbv[bj][1])); } }
        } else {
            const int col0 = (u.pn - 16) * BM + wc * 32 + 8 * fq;
            f32x4 bv[2][2];
#pragma unroll
            for (int bj = 0; bj < 2; ++bj)
#pragma unroll
                for (int n = 0; n < 2; ++n) bv[bj][n] = *(const f32x4*)(bias + col0 + bj * HALF + 4 * n);
#pragma unroll
            for (int ai = 0; ai < 2; ++ai)
#pragma unroll
                for (int m = 0; m < 4; ++m) { const int row = row0 + ai * HALF + m * 16; const float sr = sa[row]; bf16_t* rowp = G + (size_t)row * (2 * D) + col0;
#pragma unroll
                    for (int bj = 0; bj < 2; ++bj) *(u32x4*)(rowp + bj * HALF) = pack8(sig4(deq4(acc[ai][bj][m][0], sr, sbv[bj][0]) + bv[bj][0]), sig4(deq4(acc[ai][bj][m][1], sr, sbv[bj][1]) + bv[bj][1])); }
        }
    }
};
struct EpiPlainQ {
    static constexpr bool PERM = true, AFTER_DRAIN = false;
    bf16_t* O; int ldc; const float* sa; const float* sb;
    __device__ __forceinline__ void operator()(const f32x4 (&acc)[2][2][4][2], const Unit& u, int wr, int wc, int fr, int fq) const {
        const int row0 = u.pm * BM + wr * 64 + fr, col0 = u.pn * BM + wc * 32 + 8 * fq;
        f32x4 sbv[2][2];
#pragma unroll
        for (int bj = 0; bj < 2; ++bj)
#pragma unroll
            for (int n = 0; n < 2; ++n) sbv[bj][n] = *(const f32x4*)(sb + col0 + bj * HALF + 4 * n);
#pragma unroll
        for (int ai = 0; ai < 2; ++ai)
#pragma unroll
            for (int m = 0; m < 4; ++m) { const int row = row0 + ai * HALF + m * 16; const float sr = sa[row]; bf16_t* rowp = O + (size_t)row * ldc + col0;
#pragma unroll
                for (int bj = 0; bj < 2; ++bj) *(u32x4*)(rowp + bj * HALF) = pack8(deq4(acc[ai][bj][m][0], sr, sbv[bj][0]), deq4(acc[ai][bj][m][1], sr, sbv[bj][1])); }
    }
};
struct EpiVTQ {
    static constexpr bool PERM = true, AFTER_DRAIN = false;
    bf16_t* O; const float* sa; const float* sb;
    __device__ __forceinline__ void operator()(const f32x4 (&acc)[2][2][4][2], const Unit& u, int wr, int wc, int fr, int fq) const {
        const int row0 = u.pm * BM + wr * 64 + fr, col0 = u.pn * BM + wc * 32 + 8 * fq;
        f32x4 sbv[2][2];
#pragma unroll
        for (int bj = 0; bj < 2; ++bj)
#pragma unroll
            for (int n = 0; n < 2; ++n) sbv[bj][n] = *(const f32x4*)(sb + col0 + bj * HALF + 4 * n);
#pragma unroll
        for (int ai = 0; ai < 2; ++ai)
#pragma unroll
            for (int m = 0; m < 4; ++m) { const int row = row0 + ai * HALF + m * 16, hh = row >> 7, d = row & 127; const float sr = sa[row];
                const int dt = 2 * (d >> 5) + ((d >> 2) & 1), i = 4 * ((d >> 3) & 3) + (d & 3);
#pragma unroll
                for (int bj = 0; bj < 2; ++bj) { const int tok = col0 + bj * HALF, R = tok >> 6, o = (tok & 63) >> 3;
                    *(u32x4*)(O + ((size_t)((((R * 16 + hh) * 8 + dt) * 8 + o) * 16 + i)) * 8) = pack8(deq4(acc[ai][bj][m][0], sr, sbv[bj][0]), deq4(acc[ai][bj][m][1], sr, sbv[bj][1])); } }
    }
};
struct EpiSwigluQ {
    static constexpr bool PERM = true, AFTER_DRAIN = false;
    bf16_t* H0; bf16_t* H1; int pm_split; const float* sa; const float* sb;
    __device__ __forceinline__ void operator()(const f32x4 (&acc)[2][2][4][2], const Unit& u, int wr, int wc, int fr, int fq) const {
        bf16_t* base = u.pm < pm_split ? H0 + (size_t)u.pm * BM * DFF : H1 + (size_t)(u.pm - pm_split) * BM * DFF;
        const int row0 = wr * 64 + fr, col0 = u.pn * HALF + wc * 32 + 8 * fq, cg0 = u.pn * BM + wc * 32 + 8 * fq;
        f32x4 sbv[2][2];
#pragma unroll
        for (int bj = 0; bj < 2; ++bj)
#pragma unroll
            for (int n = 0; n < 2; ++n) sbv[bj][n] = *(const f32x4*)(sb + cg0 + bj * HALF + 4 * n);
#pragma unroll
        for (int ai = 0; ai < 2; ++ai)
#pragma unroll
            for (int m = 0; m < 4; ++m) { const float sr = sa[u.pm * BM + row0 + ai * HALF + m * 16];
                f32x4 h[2];
#pragma unroll
                for (int n = 0; n < 2; ++n) { const f32x4 g = deq4(acc[ai][0][m][n], sr, sbv[0][n]), up = deq4(acc[ai][1][m][n], sr, sbv[1][n]);
#pragma unroll
                    for (int j = 0; j < 4; ++j) h[n][j] = g[j] * sigmoidf_(g[j]) * up[j]; }
                *(u32x4*)(base + (size_t)(row0 + ai * HALF + m * 16) * DFF + col0) = pack8(h[0], h[1]); }
    }
};

__device__ __forceinline__ v8i32 cat8(const bf16x8 lo, const bf16x8 hi) { return __builtin_shufflevector(__builtin_bit_cast(v4i32, lo), __builtin_bit_cast(v4i32, hi), 0, 1, 2, 3, 4, 5, 6, 7); }
__device__ __forceinline__ void mfma_fp8_acc(f32x4& c, const v8i32 a, const v8i32 b, int sa, int sb) {
    asm volatile("v_mfma_scale_f32_16x16x128_f8f6f4 %0, %1, %2, %0, %3, %4 op_sel_hi:[0,0,0]" : "+v"(c) : "v"(a), "v"(b), "v"(sa), "v"(sb)); }
constexpr int FP8_SCALE = 0x73737373;
template <class Epi, class Sched, bool ALIGN_EPI = false, bool SP2 = false, int QM = 0  , int DBG = 0>
__device__ __forceinline__ void gemm_phase(LAS unsigned char* lds, const Gemm g, const Sched& S, const Epi& E) {
    int tid = threadIdx.x; asm volatile("" : "+v"(tid));
    const int wid = __builtin_amdgcn_readfirstlane(tid >> 6), lane = tid & 63, wr = wid >> 2, wc = wid & 3, fr = lane & 15, fq = lane >> 4;
    const int RB = g.rb, nt = RB / (BK * 2);
    unsigned voffA[2], voffB[2];
#pragma unroll
    for (int i = 0; i < 2; ++i) { int R, C; stage_rc(tid * 16 + i * 8192, R, C); const int Rb = Epi::PERM ? ((R & ~31) + perm32(R & 31)) : R;
        voffA[i] = (unsigned)(R * RB + C * 2); voffB[i] = (unsigned)(Rb * RB + C * 2); }
    const size_t kstep = (size_t)(BK * 2);
    const size_t hstep = (size_t)HALF * RB;
    const unsigned ldsw = (unsigned)wid * 1024u;
    const int aoff0 = lds_byte(wr * 64 + fr, fq * 8), aoff1 = lds_byte(wr * 64 + fr, 32 + fq * 8), boff0 = lds_byte(wc * 32 + fr, fq * 8), boff1 = lds_byte(wc * 32 + fr, 32 + fq * 8);
#define PG8_SA(b, h) (((b) * 2 + (h)) * HTB)
#define PG8_SB(b, h) ((4 + (b) * 2 + (h)) * HTB)
#define PG8_STAGE(bufoff, gbase, voff) do { if constexpr (DBG != 3) _Pragma("unroll") for (int _i = 0; _i < 2; ++_i) \
        __builtin_amdgcn_global_load_lds((const unsigned*)((const char*)(gbase) + (voff)[_i]), (LAS unsigned*)(lds + (bufoff) + ldsw + _i * 8192), 16, 0, 0); } while (0)
#define PG8_LDA(dst, b, h) do { if constexpr (DBG != 2) _Pragma("unroll") for (int m = 0; m < 4; ++m) _Pragma("unroll") for (int k = 0; k < 2; ++k) dst[m][k] = *(const LAS bf16x8*)(lds + PG8_SA(b, h) + (k ? aoff1 : aoff0) + m * 2048); } while (0)
#define PG8_LDB(dst, b, h) do { if constexpr (DBG != 2) _Pragma("unroll") for (int n = 0; n < 2; ++n) _Pragma("unroll") for (int k = 0; k < 2; ++k) dst[n][k] = *(const LAS bf16x8*)(lds + PG8_SB(b, h) + (k ? boff1 : boff0) + n * 2048); } while (0)
#define PG8_MMA(ai, bj, At, Bt) do { __builtin_amdgcn_s_setprio(1); if constexpr (DBG == 1) { } else if constexpr (QM == 2) { _Pragma("unroll") for (int m = 0; m < 4; ++m) _Pragma("unroll") for (int n = 0; n < 2; ++n) _Pragma("unroll") for (int k = 0; k < 2; ++k) \
        acc[ai][bj][m][n] = __builtin_bit_cast(f32x4, __builtin_amdgcn_mfma_i32_16x16x64_i8(__builtin_bit_cast(v4i32, Bt[n][k]), __builtin_bit_cast(v4i32, At[m][k]), __builtin_bit_cast(v4i32, acc[ai][bj][m][n]), 0, 0, 0)); } else if constexpr (QM == 1) { _Pragma("unroll") for (int m = 0; m < 4; ++m) _Pragma("unroll") for (int n = 0; n < 2; ++n) \
        mfma_fp8_acc(acc[ai][bj][m][n], cat8(Bt[n][0], Bt[n][1]), cat8(At[m][0], At[m][1]), fp8_sa, fp8_sb); } else { \
        _Pragma("unroll") for (int m = 0; m < 4; ++m) _Pragma("unroll") for (int n = 0; n < 2; ++n) _Pragma("unroll") for (int k = 0; k < 2; ++k) \
        acc[ai][bj][m][n] = __builtin_amdgcn_mfma_f32_16x16x32_bf16(Bt[n][k], At[m][k], acc[ai][bj][m][n], 0, 0, 0); } __builtin_amdgcn_s_setprio(0); } while (0)
#define PG8_WAIT_V(n) asm volatile("s_waitcnt vmcnt(" #n ")" ::: "memory")
#define PG8_WAIT_L(n) asm volatile("s_waitcnt lgkmcnt(" #n ")" ::: "memory")
#define PG8_BAR __builtin_amdgcn_s_barrier()
#define PG8_SCHED __builtin_amdgcn_sched_barrier(0)
    Unit cur, nxt; int ui = 0;
    const int fp8_sa = FP8_SCALE, fp8_sb = 0x7F7F7F7F;
    if (!S.next(0, cur)) return;
    f32x4 acc[2][2][4][2];
#pragma unroll
    for (int a = 0; a < 2; ++a)
#pragma unroll
        for (int b = 0; b < 2; ++b)
#pragma unroll
            for (int m = 0; m < 4; ++m)
#pragma unroll
                for (int n = 0; n < 2; ++n) acc[a][b][m][n] = (f32x4){0.f, 0.f, 0.f, 0.f};
    bf16x8 At[4][2], B0[2][2], B1[2][2];
    const char* cA = g.abase(cur.pm); const char* cB = g.bbase(cur.pn);
    S.a_ready(cur);
    if constexpr (SP2) {
        PG8_STAGE(PG8_SB(0, 0), cB, voffB); PG8_STAGE(PG8_SB(0, 1), cB + hstep, voffB); PG8_STAGE(PG8_SA(0, 0), cA, voffA); PG8_STAGE(PG8_SA(0, 1), cA + hstep, voffA);
        if (wr == 1) PG8_BAR;
        PG8_WAIT_V(2); PG8_BAR;
        PG8_STAGE(PG8_SB(1, 0), cB + kstep, voffB); PG8_STAGE(PG8_SA(1, 0), cA + kstep, voffA); PG8_STAGE(PG8_SB(1, 1), cB + hstep + kstep, voffB);
        PG8_WAIT_V(6); PG8_BAR;
    } else {
        PG8_STAGE(PG8_SB(0, 0), cB, voffB); PG8_STAGE(PG8_SA(0, 0), cA, voffA); PG8_STAGE(PG8_SB(0, 1), cB + hstep, voffB); PG8_STAGE(PG8_SA(0, 1), cA + hstep, voffA);
        if (wr == 1) PG8_BAR;
        PG8_WAIT_V(4); PG8_BAR;
        PG8_STAGE(PG8_SB(1, 0), cB + kstep, voffB); PG8_STAGE(PG8_SA(1, 0), cA + kstep, voffA); PG8_STAGE(PG8_SB(1, 1), cB + hstep + kstep, voffB);
        PG8_WAIT_V(6); PG8_BAR;
    }
    for (;;) {
        const bool has_next = S.next(ui + 1, nxt);
        const char* nA = has_next ? g.abase(nxt.pm) : cA; const char* nB = has_next ? g.bbase(nxt.pn) : cB;
        for (int t = 0; t < nt; t += 2) {
            const bool last = (t == nt - 2);
            const char* a1 = cA + (size_t)(t + 1) * kstep;
            const char* a2 = last ? nA : cA + (size_t)(t + 2) * kstep; const char* b2 = last ? nB : cB + (size_t)(t + 2) * kstep;
            const char* a3 = a2 + kstep; const char* b3 = b2 + kstep;
            if (last && has_next) S.a_ready(nxt);
            if constexpr (SP2) {
            PG8_LDB(B0, 0, 0); PG8_LDB(B1, 0, 1); PG8_SCHED; PG8_LDA(At, 0, 0); PG8_STAGE(PG8_SA(1, 1), a1 + hstep, voffA);
            PG8_WAIT_V(8); PG8_WAIT_L(0); PG8_BAR; PG8_MMA(0, 0, At, B0); PG8_MMA(0, 1, At, B1); PG8_BAR; PG8_SCHED;
            PG8_LDA(At, 0, 1); PG8_STAGE(PG8_SB(0, 0), b2, voffB); PG8_STAGE(PG8_SB(0, 1), b2 + hstep, voffB); PG8_STAGE(PG8_SA(0, 0), a2, voffA);
            PG8_WAIT_V(8); PG8_WAIT_L(0); PG8_BAR; PG8_MMA(1, 0, At, B0); PG8_MMA(1, 1, At, B1); PG8_BAR; PG8_SCHED;
            PG8_LDB(B0, 1, 0); PG8_LDB(B1, 1, 1); PG8_SCHED; PG8_LDA(At, 1, 0); PG8_STAGE(PG8_SA(0, 1), a2 + hstep, voffA);
            PG8_WAIT_V(8); PG8_WAIT_L(0); PG8_BAR; PG8_MMA(0, 0, At, B0); PG8_MMA(0, 1, At, B1); PG8_BAR; PG8_SCHED;
            PG8_LDA(At, 1, 1); PG8_STAGE(PG8_SB(1, 0), b3, voffB); PG8_STAGE(PG8_SB(1, 1), b3 + hstep, voffB); PG8_STAGE(PG8_SA(1, 0), a3, voffA);
            PG8_WAIT_V(8); PG8_WAIT_L(0); PG8_BAR; PG8_MMA(1, 0, At, B0); PG8_MMA(1, 1, At, B1); PG8_BAR; PG8_SCHED;
            } else {
            PG8_LDB(B0, 0, 0); PG8_SCHED; PG8_LDA(At, 0, 0); PG8_STAGE(PG8_SA(1, 1), a1 + hstep, voffA);
            PG8_WAIT_L(8); PG8_BAR; PG8_WAIT_L(0); PG8_MMA(0, 0, At, B0); PG8_BAR; PG8_SCHED;
            PG8_LDB(B1, 0, 1); PG8_STAGE(PG8_SB(0, 0), b2, voffB);
            PG8_BAR; PG8_WAIT_L(0); PG8_MMA(0, 1, At, B1); PG8_BAR;
            PG8_LDA(At, 0, 1); PG8_STAGE(PG8_SA(0, 0), a2, voffA);
            PG8_BAR; PG8_WAIT_L(0); PG8_MMA(1, 0, At, B0); PG8_BAR; PG8_SCHED;
            PG8_STAGE(PG8_SB(0, 1), b2 + hstep, voffB);
            PG8_WAIT_V(6); PG8_BAR; PG8_MMA(1, 1, At, B1); PG8_BAR;
            PG8_LDB(B0, 1, 0); PG8_SCHED; PG8_LDA(At, 1, 0); PG8_STAGE(PG8_SA(0, 1), a2 + hstep, voffA);
            PG8_WAIT_L(8); PG8_BAR; PG8_WAIT_L(0); PG8_MMA(0, 0, At, B0); PG8_BAR; PG8_SCHED;
            PG8_LDB(B1, 1, 1); PG8_STAGE(PG8_SB(1, 0), b3, voffB);
            PG8_BAR; PG8_WAIT_L(0); PG8_MMA(0, 1, At, B1); PG8_BAR;
            PG8_LDA(At, 1, 1); PG8_STAGE(PG8_SA(1, 0), a3, voffA);
            PG8_BAR; PG8_WAIT_L(0); PG8_MMA(1, 0, At, B0); PG8_BAR; PG8_SCHED;
            PG8_STAGE(PG8_SB(1, 1), b3 + hstep, voffB);
            PG8_WAIT_V(6); PG8_BAR; PG8_MMA(1, 1, At, B1); PG8_BAR;
            }
        }
        if constexpr (ALIGN_EPI) { if (wr == 0) PG8_BAR; }
        if constexpr (!Epi::AFTER_DRAIN) { if constexpr (DBG != 4) E(acc, cur, wr, wc, fr, fq); else { _Pragma("unroll") for (int a_ = 0; a_ < 2; ++a_) _Pragma("unroll") for (int b_ = 0; b_ < 2; ++b_) _Pragma("unroll") for (int m_ = 0; m_ < 4; ++m_) _Pragma("unroll") for (int n_ = 0; n_ < 2; ++n_) asm volatile("" :: "v"(acc[a_][b_][m_][n_])); } S.done(cur); }
        if (!has_next) break;
#pragma unroll
        for (int a = 0; a < 2; ++a)
#pragma unroll
            for (int b = 0; b < 2; ++b)
#pragma unroll
                for (int m = 0; m < 4; ++m)
#pragma unroll
                    for (int n = 0; n < 2; ++n) acc[a][b][m][n] = (f32x4){0.f, 0.f, 0.f, 0.f};
        cur = nxt; cA = nA; cB = nB; ++ui;
        if constexpr (ALIGN_EPI) { if (wr == 1) PG8_BAR; }
    }
    PG8_WAIT_V(0);
    if constexpr (!ALIGN_EPI) { if (wr == 0) PG8_BAR; }
    PG8_BAR;
    if constexpr (Epi::AFTER_DRAIN) { E.fused(acc, cur, wr, wc, fr, fq, lds, wid, lane); S.done(cur); }
#undef PG8_SA
#undef PG8_SB
#undef PG8_STAGE
#undef PG8_LDA
#undef PG8_LDB
#undef PG8_MMA
#undef PG8_WAIT_V
#undef PG8_WAIT_L
#undef PG8_BAR
#undef PG8_SCHED
}
}
#define XB_TMO      128
#define XB_XCNT(j)  (256  + 64 * (j))
#define XB_XSUB(j)  (1280 + 64 * (j))
#define XB_XGEN(j)  (2304 + 64 * (j))
#define XB_TOP      3328
#define XB_TOPGEN   3392
#define XCD_BAR_WORDS 3456
#define XB_SPIN_CAP (1u << 18)

__device__ __forceinline__ unsigned xb_ld(unsigned* p)              { return __hip_atomic_load(p, __ATOMIC_RELAXED, __HIP_MEMORY_SCOPE_AGENT); }
__device__ __forceinline__ unsigned xb_add(unsigned* p, unsigned v) { return __hip_atomic_fetch_add(p, v, __ATOMIC_RELAXED, __HIP_MEMORY_SCOPE_AGENT); }
__device__ __forceinline__ unsigned xb_xcc_id() { return (unsigned)__builtin_amdgcn_s_getreg((3 << 11) | 20) & 0xFu; }
#define XB_SPIN(cond, bar) do { unsigned _sp = 0; while (cond) { __builtin_amdgcn_s_sleep(1); \
    if ((++_sp & 255u) == 0u) { if (xb_ld(&(bar)[XB_TMO])) break; if (_sp > XB_SPIN_CAP) { atomicAdd(&(bar)[XB_TMO], 1u); break; } } } } while (0)

struct XcdBarrier {
    unsigned* bar; unsigned x;
    volatile LAS unsigned* st;
};

__device__ __forceinline__ XcdBarrier xcd_barrier_post(unsigned* bar, volatile LAS unsigned* st) {
    XcdBarrier b; b.bar = bar; b.x = xb_xcc_id(); b.st = st;
    if (threadIdx.x == 0) (void)xb_add(&bar[XB_XCNT(b.x)], 1u);
    return b;
}
__device__ __forceinline__ void xcd_barrier_complete(unsigned* bar, unsigned x, unsigned& nloc, unsigned& nx) {
    const unsigned G = gridDim.x * gridDim.y * gridDim.z;
    unsigned sum, cnt, mine, sp = 0u;
    for (;;) {
        sum = 0u; cnt = 0u; mine = 0u;
#pragma unroll
        for (unsigned j = 0; j < 16; ++j) { const unsigned c = xb_ld(&bar[XB_XCNT(j)]); sum += c; cnt += (c > 0u) ? 1u : 0u; mine = (j == x) ? c : mine; }
        if (sum == G) break;
        __builtin_amdgcn_s_sleep(1);
        if ((++sp & 255u) == 0u) { if (xb_ld(&bar[XB_TMO])) break; if (sp > XB_SPIN_CAP) { atomicAdd(&bar[XB_TMO], 1u); break; } }
    }
    nloc = mine > 0u ? mine : 1u; nx = cnt > 0u ? cnt : 1u;
}

__device__ __forceinline__ void xcd_barrier(const XcdBarrier& b) {
    asm volatile("s_waitcnt vmcnt(0)" ::: "memory");
    __syncthreads();
    if (threadIdx.x == 0) {
        unsigned* bar = b.bar;
        __builtin_amdgcn_s_waitcnt(0);
        unsigned nloc = b.st[0], nx = b.st[1];
        if (nloc == 0u) { xcd_barrier_complete(bar, b.x, nloc, nx); b.st[0] = nloc; b.st[1] = nx; }
        const unsigned old = xb_add(&bar[XB_XSUB(b.x)], 1u);
        const unsigned gen = old / nloc;
        if (old + 1u == (gen + 1u) * nloc) {
            __builtin_amdgcn_fence(__ATOMIC_RELEASE, "agent");
            asm volatile("s_waitcnt vmcnt(0)" ::: "memory");
            const unsigned og = xb_add(&bar[XB_TOP], 1u);
            const unsigned tg = og / nx;
            if (og + 1u == (tg + 1u) * nx) xb_add(&bar[XB_TOPGEN], 1u);
            else XB_SPIN(xb_ld(&bar[XB_TOPGEN]) == tg, bar);
            __builtin_amdgcn_fence(__ATOMIC_ACQUIRE, "agent");
            xb_add(&bar[XB_XGEN(b.x)], 1u);
            asm volatile("s_waitcnt vmcnt(0)" ::: "memory");
        } else {
            XB_SPIN(xb_ld(&bar[XB_XGEN(b.x)]) == gen, bar);
            __builtin_amdgcn_fence(__ATOMIC_ACQUIRE, "agent");
            asm volatile("s_waitcnt vmcnt(0)" ::: "memory");
        }
    }
    __syncthreads();
}


struct Frame {
    LAS unsigned char* lds;
    int tid, lane, wave, G, gw, ngw;
    const float *in_XP, *in_XS, *in_WIN, *in_WCONV, *in_BCONV, *in_WR, *in_BR, *in_WI, *in_BI, *in_LAM, *in_RPB, *in_WNO, *in_WLO, *in_WM, *in_BM, *in_WOUT, *in_GMPRE, *in_GMPOST, *in_GFPRE, *in_GFPOST, *in_WFG, *in_WFU, *in_WFD; float* out; unsigned char* ws;
};
enum { I_XP = 0, I_XS, I_WIN, I_WCONV, I_BCONV, I_WR, I_BR, I_WI, I_BI, I_LAM, I_RPB, I_WNO, I_WLO, I_WM, I_BM, I_WOUT, I_GMPRE, I_GMPOST, I_GFPRE, I_GFPOST, I_WFG, I_WFU, I_WFD };
__device__ __forceinline__ int opaque(int x) { asm volatile("" : "+v"(x)); return x; }
template <class T> __device__ __forceinline__ T* wsp(const Frame& F, size_t off) { return (T*)(F.ws + off); }
__device__ __forceinline__ const float* xrow(const Frame& F, int m) { return m < LP ? F.in_XP + (size_t)m * D : F.in_XS + (size_t)(m - LP) * D; }

__device__ __forceinline__ void tr_item(const float* src, int ldsrc, int k0, int n0, bf16_t* dst, int ldd, int drow0, LAS float* scr, int lane) {
#pragma unroll 8
    for (int i = 0; i < 32; ++i) { const int kk = 2 * i + (lane >> 5); scr[kk * 33 + (lane & 31)] = src[(size_t)(k0 + kk) * ldsrc + n0 + (lane & 31)]; }
    LDS_WAIT(); asm volatile("" ::: "memory");
    const int c = lane & 7;
#pragma unroll
    for (int j = 0; j < 4; ++j) { const int n = (lane >> 3) + 8 * j; const LAS float* s = scr + (8 * c) * 33 + n;
        u32x4 o; o.x = pk2(s[0 * 33], s[1 * 33]); o.y = pk2(s[2 * 33], s[3 * 33]); o.z = pk2(s[4 * 33], s[5 * 33]); o.w = pk2(s[6 * 33], s[7 * 33]);
        *(u32x4*)(dst + (size_t)(drow0 + n) * ldd + k0 + 8 * c) = o; }
    LDS_WAIT(); asm volatile("" ::: "memory");
}
__device__ __forceinline__ unsigned pk4_fp8(float a, float b, float c, float d) { int p = __builtin_amdgcn_cvt_pk_fp8_f32(a, b, 0, false); p = __builtin_amdgcn_cvt_pk_fp8_f32(c, d, p, true); return (unsigned)p; }
__device__ __forceinline__ void tr_item8(const float* src, int ldsrc, int k0, int n0, unsigned char* dst, int ldd, int drow0, LAS float* scr, int lane) {
#pragma unroll 8
    for (int i = 0; i < 32; ++i) { const int kk = 2 * i + (lane >> 5); scr[kk * 33 + (lane & 31)] = src[(size_t)(k0 + kk) * ldsrc + n0 + (lane & 31)]; }
    LDS_WAIT(); asm volatile("" ::: "memory");
    const int c = lane & 7;
#pragma unroll
    for (int j = 0; j < 4; ++j) { const int n = (lane >> 3) + 8 * j; const LAS float* s = scr + (8 * c) * 33 + n;
        u32x2 o; o.x = pk4_fp8(s[0 * 33] * 256.f, s[1 * 33] * 256.f, s[2 * 33] * 256.f, s[3 * 33] * 256.f); o.y = pk4_fp8(s[4 * 33] * 256.f, s[5 * 33] * 256.f, s[6 * 33] * 256.f, s[7 * 33] * 256.f);
        *(u32x2*)(dst + (size_t)(drow0 + n) * ldd + k0 + 8 * c) = o; }
    LDS_WAIT(); asm volatile("" ::: "memory");
}
__device__ __forceinline__ unsigned pk4_i8(float a, float b, float c, float d) { return ((unsigned)(int)a & 255u) | (((unsigned)(int)b & 255u) << 8) | (((unsigned)(int)c & 255u) << 16) | ((unsigned)(int)d << 24); }
__device__ __forceinline__ void tr_strip_i8(const float* src, int ldsrc, int K, int n0, signed char* dst, int drow0, float* cs, LAS float* scr, int lane) {
    const float* sp = src + n0 + (lane & 31) + (size_t)(lane >> 5) * ldsrc;
    float mx = 0.f;
    { const float* p = sp; const size_t step = (size_t)2 * ldsrc;
      for (int k0 = 0; k0 < K; k0 += 64) {
        float t[32];
#pragma unroll
        for (int i = 0; i < 32; ++i) { t[i] = *p; p += step; }
#pragma unroll
        for (int i = 0; i < 32; ++i) mx = fmaxf(mx, fabsf(t[i]));
      } }
    mx = fmaxf(mx, __shfl_xor(mx, 32));
    const float amax = fmaxf(mx, 1e-20f), inv = 127.0f / amax;
    if (lane < 32) cs[drow0 + lane] = amax * (1.0f / 127.0f);
    const int c = lane & 7;
    for (int k0 = 0; k0 < K; k0 += 64) {
        { const float* p = sp + (size_t)k0 * ldsrc; const size_t step = (size_t)2 * ldsrc; LAS float* w = scr + (lane >> 5) * 33 + (lane & 31);
          float t[32];
#pragma unroll
          for (int i = 0; i < 32; ++i) { t[i] = *p; p += step; }
#pragma unroll
          for (int i = 0; i < 32; ++i) w[i * 66] = rintf(t[i] * inv); }
        LDS_WAIT(); asm volatile("" ::: "memory");
#pragma unroll
        for (int j = 0; j < 4; ++j) { const int n = (lane >> 3) + 8 * j; const LAS float* t = scr + (8 * c) * 33 + n;
            u32x2 o; o.x = pk4_i8(t[0 * 33], t[1 * 33], t[2 * 33], t[3 * 33]); o.y = pk4_i8(t[4 * 33], t[5 * 33], t[6 * 33], t[7 * 33]);
            *(u32x2*)(dst + (size_t)(drow0 + n) * K + k0 + 8 * c) = o; }
        LDS_WAIT(); asm volatile("" ::: "memory");
    }
}
__device__ __forceinline__ void fwht32(float (&v)[32]) {
#pragma unroll
    for (int st = 1; st < 32; st <<= 1)
#pragma unroll
        for (int i = 0; i < 32; ++i) if (!(i & st)) { const float a = v[i], b = v[i + st]; v[i] = a + b; v[i + st] = a - b; }
#pragma unroll
    for (int i = 0; i < 32; ++i) v[i] *= 0.17677669529663687f;
}
__device__ __forceinline__ void had_tile_load(const float* src, int ldsrc, int k0, int n0, LAS float* scr, int lane, float (&v)[32]) {
    { const float* p = src + (size_t)(k0 + (lane >> 5)) * ldsrc + n0 + (lane & 31); const size_t step = (size_t)2 * ldsrc; LAS float* w = scr + (lane >> 5) * 33 + (lane & 31); float t[32];
#pragma unroll
      for (int i = 0; i < 32; ++i) { t[i] = *p; p += step; }
#pragma unroll
      for (int i = 0; i < 32; ++i) w[i * 66] = t[i]; }
    LDS_WAIT(); asm volatile("" ::: "memory");
    const LAS float* hv = scr + (32 * (lane >> 5)) * 33 + (lane & 31);
#pragma unroll
    for (int i = 0; i < 32; ++i) v[i] = hv[i * 33];
    fwht32(v);
}
__device__ __forceinline__ void had_tile_amax(const float* src, int ldsrc, int k0, int n0, unsigned* am, LAS float* scr, int lane) {
    float v[32]; had_tile_load(src, ldsrc, k0, n0, scr, lane, v);
    float mx = 0.f;
#pragma unroll
    for (int i = 0; i < 32; ++i) mx = fmaxf(mx, fabsf(v[i]));
    mx = fmaxf(mx, __shfl_xor(mx, 32));
    if (lane < 32) atomicMax(am + n0 + lane, __builtin_bit_cast(unsigned, mx));
    LDS_WAIT(); asm volatile("" ::: "memory");
}
__device__ __forceinline__ void had_tile_quant(const float* src, int ldsrc, int K, int k0, int n0, signed char* dst, const unsigned* am, float* cs, LAS float* scr, int lane) {
    const float amax = fmaxf(__builtin_bit_cast(float, am[n0 + (lane & 31)]), 1e-20f), inv = 127.0f / amax;
    if (k0 == 0 && lane < 32) cs[n0 + lane] = amax * (1.0f / 127.0f);
    float v[32]; had_tile_load(src, ldsrc, k0, n0, scr, lane, v);
    LAS float* hv = scr + (32 * (lane >> 5)) * 33 + (lane & 31);
#pragma unroll
    for (int i = 0; i < 32; ++i) hv[i * 33] = rintf(v[i] * inv);
    LDS_WAIT(); asm volatile("" ::: "memory");
    const int c = lane & 7;
#pragma unroll
    for (int j = 0; j < 4; ++j) { const int n = (lane >> 3) + 8 * j; const LAS float* t = scr + (8 * c) * 33 + n;
        u32x2 o; o.x = pk4_i8(t[0 * 33], t[1 * 33], t[2 * 33], t[3 * 33]); o.y = pk4_i8(t[4 * 33], t[5 * 33], t[6 * 33], t[7 * 33]);
        *(u32x2*)(dst + (size_t)(n0 + n) * K + k0 + 8 * c) = o; }
    LDS_WAIT(); asm volatile("" ::: "memory");
}
#define TR_JOB(SRC, LDSRC, KK, NN, DST, DROW_EXPR) { const int nblk = (NN) / 32, nit = ((KK) / 64) * nblk; \
    if (r < nit) { const int kb = r / nblk, nb = r % nblk, n0 = 32 * nb; tr_item((SRC), (LDSRC), 64 * kb, n0, (DST), (KK), (DROW_EXPR), scr, F.lane); continue; } r -= nit; }
#define TR_JOB8(SRC, LDSRC, KK, NN, DST, DROW_EXPR) { const int nblk = (NN) / 32, nit = ((KK) / 64) * nblk; \
    if (r < nit) { const int kb = r / nblk, nb = r % nblk, n0 = 32 * nb; tr_item8((SRC), (LDSRC), 64 * kb, n0, (DST), (KK), (DROW_EXPR), scr, F.lane); continue; } r -= nit; }

__device__ __forceinline__ void p0_prologue(Frame& F) {
    const int tid_ = opaque(F.tid);
    LAS float* scr = (LAS float*)(F.lds + F.wave * 8448);
    const float* w_in = F.in_WIN;
    bf16_t* WCAT = wsp<bf16_t>(F, WS_WCAT); signed char* W8 = wsp<signed char>(F, WS_W8); signed char* WV8 = wsp<signed char>(F, WS_WVT); signed char* WGU8 = wsp<signed char>(F, WS_WGU);
    float* CS = wsp<float>(F, WS_CS);
    constexpr int NSM = 64;
    constexpr int IT_SM = 2 * 4;
    constexpr int S_Q = NAW / 32, S_M = 2 * D / 32, S_F = DFF / 32;
    constexpr int NSTRIP = 3 * S_Q + S_M + 2 * S_F;
    constexpr int N_AMAX = (DFF / 64) * (D / 32);
    constexpr int N_BIG = 2 * (D / 64) * (NAW / 32) + 2 * (NAW / 64) * (D / 32) + (D / 64) * (D / 32) + N_AMAX;
    constexpr int NITEMS = N_BIG + NSM * IT_SM;
    for (int it = F.gw; it < NSTRIP + NITEMS; it += F.ngw) {
        if (it < NSTRIP) {
            int q = it; const float* src; int ld, n0, drow0; signed char* dst; float* cs;
            if (q < S_Q) { src = w_in; ld = INW; n0 = 32 * q; dst = W8; drow0 = n0; cs = CS + CS_QKM; }
            else if ((q -= S_Q) < S_Q) { src = w_in + NAW; ld = INW; n0 = 32 * q; dst = W8; drow0 = 2048 + n0; cs = CS + CS_QKM; }
            else if ((q -= S_Q) < S_M) { src = F.in_WM; ld = 2 * D; n0 = 32 * q; dst = W8; drow0 = 4096 + n0; cs = CS + CS_QKM; }
            else if ((q -= S_M) < S_Q) { src = w_in + 2 * NAW; ld = INW; n0 = 32 * q; dst = WV8; drow0 = n0; cs = CS + CS_V; }
            else if ((q -= S_Q) < S_F) { src = F.in_WFG; ld = DFF; n0 = 32 * q; dst = WGU8; drow0 = (n0 >> 7) * 256 + (n0 & 127); cs = CS + CS_GU; }
            else { q -= S_F; src = F.in_WFU; ld = DFF; n0 = 32 * q; dst = WGU8; drow0 = (n0 >> 7) * 256 + 128 + (n0 & 127); cs = CS + CS_GU; }
            tr_strip_i8(src, ld, D, n0, dst, drow0, cs, scr, F.lane);
            continue;
        }
        int r = it - NSTRIP;
        TR_JOB(w_in + 3 * NAW, INW, D, NAW, WCAT, 0 + n0)
        TR_JOB(w_in + 4 * NAW, INW, D, NAW, WCAT, 2048 + n0)
        TR_JOB(F.in_WNO, D, NAW, D, wsp<bf16_t>(F, WS_WNO), n0)
        TR_JOB(F.in_WLO, D, LW, D, wsp<bf16_t>(F, WS_WLO), n0)
        TR_JOB(F.in_WOUT, D, D, D, wsp<bf16_t>(F, WS_WO), n0)
        if (r < N_AMAX) { had_tile_amax(F.in_WFD, D, 64 * (r / (D / 32)), 32 * (r % (D / 32)), (unsigned*)(F.ws + WS_AM), scr, F.lane); continue; } r -= N_AMAX;
        {
            const int mi = r / IT_SM, ri = r % IT_SM, d = mi >> 5, g = (mi >> 4) & 1, n = mi & 15, kb = ri >> 2, nb = ri & 3;
            const float* src = (g ? F.in_WI : F.in_WR) + (size_t)(d * NBLK + n) * BW * BW;
            tr_item(src, BW, 64 * kb, 32 * nb, wsp<bf16_t>(F, WS_WG) + (size_t)mi * BW * BW, BW, 32 * nb, scr, F.lane);
        }
    }
    LAS f32x4* gl = (LAS f32x4*)(F.lds + 69632);
    for (int i = tid_; i < D / 4; i += NTHR) gl[i] = ((const f32x4*)F.in_GMPRE)[i];
    __syncthreads();
    bf16_t* XN = wsp<bf16_t>(F, WS_XN); signed char* XN8 = wsp<signed char>(F, WS_XN8); float* RS1 = wsp<float>(F, WS_RS1);
    for (int m = F.gw; m < L; m += F.ngw) {
        asm volatile("" ::: "memory");
        const f32x4* xr = (const f32x4*)xrow(F, m) + F.lane;
        f32x4 v[16]; float s = 0.f;
#pragma unroll
        for (int j = 0; j < 16; ++j) { v[j] = xr[64 * j]; s += (v[j].x * v[j].x + v[j].y * v[j].y) + (v[j].z * v[j].z + v[j].w * v[j].w); }
        const float rstd = 1.0f / sqrtf(wave_sum(s) * (1.0f / D) + EPS);
        u32x2* o8 = (u32x2*)(XN + (size_t)m * D) + F.lane; unsigned* o4 = (unsigned*)(XN8 + (size_t)m * D) + F.lane;
        float mx = 0.f;
#pragma unroll
        for (int j = 0; j < 16; ++j) { v[j] = v[j] * rstd * gl[F.lane + 64 * j]; mx = fmaxf(fmaxf(mx, fmaxf(fabsf(v[j].x), fabsf(v[j].y))), fmaxf(fabsf(v[j].z), fabsf(v[j].w))); }
        const float amax = fmaxf(wave_max(mx), 1e-20f), inv = 127.0f / amax;
        if (F.lane == 0) RS1[m] = amax * (1.0f / 127.0f);
#pragma unroll
        for (int j = 0; j < 16; ++j) { const f32x4 y = v[j]; u32x2 o; o.x = pk2(y.x, y.y); o.y = pk2(y.z, y.w); o8[64 * j] = o;
            o4[64 * j] = pk4_i8(rintf(y.x * inv), rintf(y.y * inv), rintf(y.z * inv), rintf(y.w * inv)); }
    }
    __syncthreads();
}

#ifndef ATT_SYNC
#define ATT_SYNC 1
#endif
template <int ADBG = 0> __device__ __forceinline__ void attn_mfma(Frame& F) {
    const int tid_ = opaque(F.tid);
    bf16_t* Q = wsp<bf16_t>(F, WS_Q); const bf16_t* Kb = wsp<bf16_t>(F, WS_K); const bf16_t* VT = wsp<bf16_t>(F, WS_VT);
    LAS float* rp = (LAS float*)F.lds;
    for (int i = tid_; i < NH * 15 * 31; i += NTHR) rp[i] = F.in_RPB[i];
    __syncthreads();
    const int fr = F.lane & 15, fq = F.lane >> 4;
    const float scale = 0.08838834764831845f;
    for (int base = blockIdx.x * NWAVES; base < (L / GRIDW) * NH * 4; base += F.ngw) {
        const int item = base + F.wave;
        asm volatile("" ::: "memory");
        const int g = item & 3, h = (item >> 2) & 15, rg = item >> 6;
        const int s0 = rg < LP / GRIDW ? 0 : LP, rows = rg < LP / GRIDW ? LP / GRIDW : LS / GRIDW, r = rg < LP / GRIDW ? rg : rg - LP / GRIDW;
        int rs = r - 4; rs = rs < 0 ? 0 : (rs > rows - 8 ? rows - 8 : rs);
        const int w0 = g == 0 ? 0 : (g == 1 ? 8 : (g == 2 ? 24 : 32));
        const int c = 16 * g + fr;
        int cs = c - 8; cs = cs < 0 ? 0 : (cs > GRIDW - 16 ? GRIDW - 16 : cs);
        bf16_t* qrow = Q + (size_t)(s0 + r * GRIDW + c) * NAW + h * HD;
        bf16x8 qf[4];
#pragma unroll
        for (int s = 0; s < 4; ++s) qf[s] = *(const bf16x8*)(qrow + 8 * fq + 32 * s);
        f32x4 sacc[8][2];
        const int Rg = s0 / GRIDW + rs, p0 = w0 >> 3;
        const bf16_t* kbase = Kb + (size_t)(Rg * 16 + h) * 8192 + p0 * 128 + fr * 32 + fq * 8;
        bf16x8 kb[8][2][4];
#define ATT_LDK(kr) do { _Pragma("unroll") for (int T = 0; T < 2; ++T) _Pragma("unroll") for (int s = 0; s < 4; ++s) kb[kr][T][s] = (ADBG & 1) ? qf[s] : (ADBG & 4) ? *(const bf16x8*)(Kb + (size_t)(s0 + rs * GRIDW) * NAW + h * HD * GRIDW + ((kr) * 8 + T * 4 + s) * 512 + F.lane * 8) : *(const bf16x8*)(kbase + (size_t)(kr) * (16 * 8192) + (s * 2 + T) * 1024); } while (0)
        ATT_LDK(0); ATT_LDK(1);
#pragma unroll
        for (int kr = 0; kr < 8; ++kr) {
            if (ATT_SYNC && (kr & 1) == 0) __builtin_amdgcn_s_barrier();
            if (kr + 2 < 8) ATT_LDK(kr + 2);
            __builtin_amdgcn_sched_barrier(0);
#pragma unroll
            for (int T = 0; T < 2; ++T) { f32x4 a = (f32x4){0.f, 0.f, 0.f, 0.f};
#pragma unroll
                for (int s = 0; s < 4; ++s) a = __builtin_amdgcn_mfma_f32_16x16x32_bf16(kb[kr][T][s], qf[s], a, 0, 0, 0);
                sacc[kr][T] = a; }
            __builtin_amdgcn_sched_barrier(0);
        }
#undef ATT_LDK
        bf16x8 vb[8][8];
        const bf16_t* vbase = VT + (size_t)(Rg * 16 + h) * 8192 + p0 * 128 + fq * 128 + fr * 8;
#define ATT_LDV(kr) do { _Pragma("unroll") for (int dt = 0; dt < 8; ++dt) vb[kr][dt] = (ADBG & 2) ? qf[dt & 3] : (ADBG & 4) ? *(const bf16x8*)(VT + (size_t)(h * HD) * L + s0 + rs * GRIDW + ((kr) * 8 + dt) * 512 + F.lane * 8) : *(const bf16x8*)(vbase + (size_t)(kr) * (16 * 8192) + dt * 1024); } while (0)
        ATT_LDV(0); ATT_LDV(1);
        __builtin_amdgcn_sched_barrier(0);
        const int elo = cs - w0 - 8 * fq, dc0 = w0 + 8 * fq - c + 15;
        const LAS float* rph = rp + h * 465 + (rs - r + 7) * 31;
        float mx = -3.0e38f;
#pragma unroll
        for (int e = 0; e < 8; ++e) { const bool valid = (e >= elo) && (e < elo + 16); const int bi = valid ? dc0 + e : 0;
#pragma unroll
            for (int kr = 0; kr < 8; ++kr) { const float sv = valid ? sacc[kr][e >> 2][e & 3] * scale + rph[kr * 31 + bi] : -3.0e38f; sacc[kr][e >> 2][e & 3] = sv; mx = fmaxf(mx, sv); } }
        mx = fmaxf(mx, __shfl_xor(mx, 16)); mx = fmaxf(mx, __shfl_xor(mx, 32));
        float lsum = 0.f; bf16x8 pf[8];
#pragma unroll
        for (int kr = 0; kr < 8; ++kr) { float p[8];
#pragma unroll
            for (int e = 0; e < 8; ++e) { p[e] = __expf(sacc[kr][e >> 2][e & 3] - mx); lsum += p[e]; }
            u32x4 w; w.x = pk2(p[0], p[1]); w.y = pk2(p[2], p[3]); w.z = pk2(p[4], p[5]); w.w = pk2(p[6], p[7]);
            pf[kr] = __builtin_bit_cast(bf16x8, w); }
        lsum += __shfl_xor(lsum, 16); lsum += __shfl_xor(lsum, 32);
        f32x4 oacc[8];
#pragma unroll
        for (int dt = 0; dt < 8; ++dt) oacc[dt] = (f32x4){0.f, 0.f, 0.f, 0.f};
#pragma unroll
        for (int kr = 0; kr < 8; ++kr) {
            if (ATT_SYNC && (kr & 1) == 0) __builtin_amdgcn_s_barrier();
            if (kr + 2 < 8) ATT_LDV(kr + 2);
            __builtin_amdgcn_sched_barrier(0);
#pragma unroll
            for (int dt = 0; dt < 8; ++dt) oacc[dt] = __builtin_amdgcn_mfma_f32_16x16x32_bf16(vb[kr][dt], pf[kr], oacc[dt], 0, 0, 0);
            __builtin_amdgcn_sched_barrier(0);
        }
#undef ATT_LDV
        const float inv = 1.0f / lsum;
#ifdef ATTN_OUT_OFF
        bf16_t* orow = wsp<bf16_t>(F, (size_t)ATTN_OUT_OFF * MiB) + (size_t)(s0 + r * GRIDW + c) * NAW + h * HD;
#else
        bf16_t* orow = qrow;
#endif
#pragma unroll
        for (int u = 0; u < 4; ++u) *(u32x4*)(orow + 32 * u + 8 * fq) = pg8::pack8(oacc[2 * u] * inv, oacc[2 * u + 1] * inv);
    }
    __syncthreads();
}

__device__ __forceinline__ void attn_mfma_lds(Frame& F) {
    const int tid_ = opaque(F.tid);
    bf16_t* Q = wsp<bf16_t>(F, WS_Q); const bf16_t* Kb = wsp<bf16_t>(F, WS_K); const bf16_t* VT = wsp<bf16_t>(F, WS_VT);
    LAS float* rp = (LAS float*)F.lds;
    LAS unsigned char* ring = F.lds + 30720;
    for (int i = tid_; i < NH * 15 * 31; i += NTHR) rp[i] = F.in_RPB[i];
    __syncthreads();
    const int lane = tid_ & 63, fr = lane & 15, fq = lane >> 4, w = F.wave, hl = w >> 2, g = w & 3;
    const float scale = 0.08838834764831845f;
    constexpr int NIT = (L / GRIDW) * NH * 4;
    const int w0 = g == 0 ? 0 : (g == 1 ? 8 : (g == 2 ? 24 : 32)), p0 = w0 >> 3;
    const int c = 16 * g + fr;
    int cs = c - 8; cs = cs < 0 ? 0 : (cs > GRIDW - 16 ? GRIDW - 16 : cs);
#define ATL_SRC(b, st) ([&]() -> const bf16_t* { const int rg_ = (b) >> 6, hb_ = ((b) >> 2) & 15; const int rows_ = rg_ < LP / GRIDW ? LP / GRIDW : LS / GRIDW, r_ = rg_ < LP / GRIDW ? rg_ : rg_ - LP / GRIDW; \
        int rs_ = r_ - 4; rs_ = rs_ < 0 ? 0 : (rs_ > rows_ - 8 ? rows_ - 8 : rs_); const int Rg_ = (rg_ < LP / GRIDW ? 0 : LP / GRIDW) + rs_; \
        return ((st) < 8 ? Kb : VT) + (size_t)((Rg_ + ((st) & 7)) * 16 + hb_) * 8192; }())
#define ATL_ISSUE(src, slot) do { const bf16_t* s_ = (src) + tid_ * 8; LAS unsigned char* d_ = ring + (slot) * 32768 + w * 1024; _Pragma("unroll") for (int k_ = 0; k_ < 4; ++k_) \
        __builtin_amdgcn_global_load_lds((const unsigned*)(s_ + k_ * 4096), (LAS unsigned*)(d_ + k_ * 8192), 16, 0, 0); } while (0)
    int base = blockIdx.x * NWAVES;
    if (base < NIT) { ATL_ISSUE(ATL_SRC(base, 0), 0); ATL_ISSUE(ATL_SRC(base, 1), 1); }
    int b0 = 0;
    for (; base < NIT; base += F.ngw) {
        asm volatile("" ::: "memory");
        const int h = ((base >> 2) & 15) + hl, rg = base >> 6;
        const int s0 = rg < LP / GRIDW ? 0 : LP, rows = rg < LP / GRIDW ? LP / GRIDW : LS / GRIDW, r = rg < LP / GRIDW ? rg : rg - LP / GRIDW;
        int rs = r - 4; rs = rs < 0 ? 0 : (rs > rows - 8 ? rows - 8 : rs);
        const int nbase = base + F.ngw < NIT ? base + F.ngw : base;
        bf16_t* qrow = Q + (size_t)(s0 + r * GRIDW + c) * NAW + h * HD;
        bf16x8 qf[4];
#pragma unroll
        for (int s = 0; s < 4; ++s) qf[s] = *(const bf16x8*)(qrow + 8 * fq + 32 * s);
        f32x4 sacc[8][2]; f32x4 oacc[8]; bf16x8 pf[8]; float lsum = 0.f;
#pragma unroll
        for (int dt = 0; dt < 8; ++dt) oacc[dt] = (f32x4){0.f, 0.f, 0.f, 0.f};
        const int koff = hl * 16384 + (p0 * 128 + fr * 32 + fq * 8) * 2, voff = hl * 16384 + (p0 * 128 + fq * 128 + fr * 8) * 2;
#pragma unroll
        for (int st = 0; st < 16; ++st) {
            asm volatile("s_waitcnt vmcnt(4)" ::: "memory"); asm volatile("s_waitcnt lgkmcnt(0)" ::: "memory"); __builtin_amdgcn_s_barrier(); asm volatile("" ::: "memory");
            { const int slot2 = (b0 + st + 2) % 3; if (st + 2 < 16) ATL_ISSUE(ATL_SRC(base, st + 2), slot2); else ATL_ISSUE(ATL_SRC(nbase, st + 2 - 16), slot2); }
            const LAS unsigned char* buf = ring + ((b0 + st) % 3) * 32768;
            if (st < 8) {
#pragma unroll
                for (int T = 0; T < 2; ++T) { f32x4 a = (f32x4){0.f, 0.f, 0.f, 0.f};
#pragma unroll
                    for (int s2 = 0; s2 < 4; ++s2) a = __builtin_amdgcn_mfma_f32_16x16x32_bf16(*(const LAS bf16x8*)(buf + koff + (s2 * 2 + T) * 2048), qf[s2], a, 0, 0, 0);
                    sacc[st][T] = a; }
            } else {
                if (st == 8) {
                    const int elo = cs - w0 - 8 * fq, dc0 = w0 + 8 * fq - c + 15;
                    const LAS float* rph = rp + h * 465 + (rs - r + 7) * 31;
                    float mx = -3.0e38f;
#pragma unroll
                    for (int e = 0; e < 8; ++e) { const bool valid = (e >= elo) && (e < elo + 16); const int bi = valid ? dc0 + e : 0;
#pragma unroll
                        for (int kr = 0; kr < 8; ++kr) { const float sv = valid ? sacc[kr][e >> 2][e & 3] * scale + rph[kr * 31 + bi] : -3.0e38f; sacc[kr][e >> 2][e & 3] = sv; mx = fmaxf(mx, sv); } }
                    mx = fmaxf(mx, __shfl_xor(mx, 16)); mx = fmaxf(mx, __shfl_xor(mx, 32));
#pragma unroll
                    for (int kr = 0; kr < 8; ++kr) { float p[8];
#pragma unroll
                        for (int e = 0; e < 8; ++e) { p[e] = __expf(sacc[kr][e >> 2][e & 3] - mx); lsum += p[e]; }
                        u32x4 wv; wv.x = pk2(p[0], p[1]); wv.y = pk2(p[2], p[3]); wv.z = pk2(p[4], p[5]); wv.w = pk2(p[6], p[7]);
                        pf[kr] = __builtin_bit_cast(bf16x8, wv); }
                    lsum += __shfl_xor(lsum, 16); lsum += __shfl_xor(lsum, 32);
                }
#pragma unroll
                for (int dt = 0; dt < 8; ++dt) oacc[dt] = __builtin_amdgcn_mfma_f32_16x16x32_bf16(*(const LAS bf16x8*)(buf + voff + dt * 2048), pf[st - 8], oacc[dt], 0, 0, 0);
            }
        }
        b0 = (b0 + 16) % 3;
        const float inv = 1.0f / lsum;
#pragma unroll
        for (int u = 0; u < 4; ++u) *(u32x4*)(qrow + 32 * u + 8 * fq) = pg8::pack8(oacc[2 * u] * inv, oacc[2 * u + 1] * inv);
    }
#undef ATL_SRC
#undef ATL_ISSUE
    asm volatile("s_waitcnt vmcnt(0)" ::: "memory");
    __syncthreads();
}

__device__ __forceinline__ void conv_phase(Frame& F) {
    const int tid_ = opaque(F.tid);
    const bf16_t* XR = wsp<bf16_t>(F, WS_XR); bf16_t* XC = wsp<bf16_t>(F, WS_XC);
    const float* wc = F.in_WCONV; const float* bc = F.in_BCONV;
    const int nth = F.G * NTHR;
    for (int it = blockIdx.x * NTHR + tid_; it < L * (LW / 8); it += nth) {
        const int t = it / (LW / 8), c0 = (it % (LW / 8)) * 8;
        const int s0 = t < LP ? 0 : LP, len = t < LP ? LP : LS, tl = t - s0;
        float acc[8];
#pragma unroll
        for (int e = 0; e < 8; ++e) acc[e] = bc[c0 + e];
#pragma unroll
        for (int j = 0; j < 4; ++j) { const int tt = tl + j - 2; if (tt < 0 || tt >= len) continue;
            f32x4 x0, x1; pg8::unpack8(*(const u32x4*)(XR + (size_t)(s0 + tt) * LW + c0), x0, x1);
            const f32x4 w0 = *(const f32x4*)(wc + j * LW + c0), w1 = *(const f32x4*)(wc + j * LW + c0 + 4);
#pragma unroll
            for (int e = 0; e < 4; ++e) { acc[e] += w0[e] * x0[e]; acc[4 + e] += w1[e] * x1[e]; } }
        *(u32x4*)(XC + (size_t)t * LW + c0) = pg8::pack8((f32x4){acc[0], acc[1], acc[2], acc[3]}, (f32x4){acc[4], acc[5], acc[6], acc[7]});
    }
}

struct LruW { bf16x8 w[2][4]; float br, bi, cl; };
template <int DIR> __device__ __forceinline__ void lru_load_w(const Frame& F, LruW& W, int n, int w, int fr, int fq) {
    const bf16_t* wg = wsp<bf16_t>(F, WS_WG);
#pragma unroll
    for (int g = 0; g < 2; ++g)
#pragma unroll
        for (int s = 0; s < 4; ++s) W.w[g][s] = *(const bf16x8*)(wg + ((size_t)((DIR * 2 + g) * NBLK + n) * BW + 16 * w + fr) * BW + 32 * fq + 8 * s);
    const int ch = n * BW + 16 * w + fr;
    W.br = -1.44269504f * F.in_BR[DIR * LW + ch]; W.bi = -1.44269504f * F.in_BI[DIR * LW + ch];
    const float lam = F.in_LAM[DIR * LW + ch];
    W.cl = -8.0f * 1.44269504f * ((lam > 15.f) ? __expf(-lam) : log1pf(__expf(-lam)));
}
template <int LDBG = 0> __device__ __forceinline__ void lru_gate(float pr, float pi, float xc, const LruW& W, bool first, float& a, float& u) {
    if constexpr (LDBG == 1) { a = pr + W.br; u = pi * xc + W.bi; return; }
    const float r = __builtin_amdgcn_rcpf(1.0f + __builtin_amdgcn_exp2f(__builtin_fmaf(pr, -1.44269504f, W.br))), d = 1.0f + __builtin_amdgcn_exp2f(__builtin_fmaf(pi, -1.44269504f, W.bi));
    a = __builtin_amdgcn_exp2f(W.cl * r);
    const float y = first ? 1.0f : fmaxf(__builtin_fmaf(-a, a, 1.0f), 1e-30f);
    u = xc * y * __builtin_amdgcn_rsqf(y * d * d);
}
struct LruX { bf16x8 x[4][4]; };
__device__ __forceinline__ void lru_load_x(LruX& X, const bf16_t* XC, int tb, int n, int fr, int fq) {
#pragma unroll
    for (int tau = 0; tau < 4; ++tau) { const bf16_t* xp = XC + ((size_t)((((tb >> 6) * NBLK + n) * 4 + tau) * 4) * 64 + fr * 4 + fq) * 8;
#pragma unroll
        for (int s = 0; s < 4; ++s) X.x[tau][s] = *(const bf16x8*)(xp + s * 512); }
}
__device__ __forceinline__ void lru_tile(const LruX& X, int tau, bool hiw, const LruW& W, const bf16x8 idf0, const bf16x8 idf1, f32x4& pr, f32x4& pi, f32x4& xct) {
    pr = (f32x4){0.f, 0.f, 0.f, 0.f}; pi = pr;
#pragma unroll
    for (int s = 0; s < 4; ++s) { pr = __builtin_amdgcn_mfma_f32_16x16x32_bf16(X.x[tau][s], W.w[0][s], pr, 0, 0, 0); pi = __builtin_amdgcn_mfma_f32_16x16x32_bf16(X.x[tau][s], W.w[1][s], pi, 0, 0, 0); }
    const bf16x8 x0 = hiw ? X.x[tau][2] : X.x[tau][0], x1 = hiw ? X.x[tau][3] : X.x[tau][1];
    xct = __builtin_amdgcn_mfma_f32_16x16x32_bf16(x0, idf0, (f32x4){0.f, 0.f, 0.f, 0.f}, 0, 0, 0);
    xct = __builtin_amdgcn_mfma_f32_16x16x32_bf16(x1, idf1, xct, 0, 0, 0);
}
__device__ __forceinline__ void lru_tile_lds(const LAS unsigned char* tile, int gl, int tau, bool hiw, const LruW& W, const bf16x8 idf0, const bf16x8 idf1, int fr, int fq, f32x4& pr, f32x4& pi, f32x4& xct) {
    bf16x8 x[4];
#pragma unroll
    for (int s = 0; s < 4; ++s) x[s] = *(const LAS bf16x8*)(tile + ((((gl * 4 + tau) * 4 + s) * 16 + fr) * 4 + fq) * 16);
    pr = (f32x4){0.f, 0.f, 0.f, 0.f}; pi = pr;
#pragma unroll
    for (int s = 0; s < 4; ++s) { pr = __builtin_amdgcn_mfma_f32_16x16x32_bf16(x[s], W.w[0][s], pr, 0, 0, 0); pi = __builtin_amdgcn_mfma_f32_16x16x32_bf16(x[s], W.w[1][s], pi, 0, 0, 0); }
    const LAS unsigned char* xi = tile + ((((gl * 4 + tau) * 4 + (hiw ? 2 : 0)) * 16 + fr) * 4 + fq) * 16;
    xct = __builtin_amdgcn_mfma_f32_16x16x32_bf16(*(const LAS bf16x8*)xi, idf0, (f32x4){0.f, 0.f, 0.f, 0.f}, 0, 0, 0);
    xct = __builtin_amdgcn_mfma_f32_16x16x32_bf16(*(const LAS bf16x8*)(xi + 1024), idf1, xct, 0, 0, 0);
}
__device__ __forceinline__ void lru_idfrags(int w, int fr, int fq, bf16x8& idf0, bf16x8& idf1) {
#pragma unroll
    for (int e = 0; e < 8; ++e) { const bool on = (fq == (w >> 1)) && ((fr & 7) == e); idf0[e] = (on && fr < 8) ? (short)0x3F80 : (short)0; idf1[e] = (on && fr >= 8) ? (short)0x3F80 : (short)0; }
}
constexpr int LRU_CH = 256, LRU_NCH = L / LRU_CH, LRU_NCH_P = LP / LRU_CH;
__device__ __forceinline__ void conv_unit(Frame& F, int cg, int n) {
    const int tid_ = opaque(F.tid);
    const bf16_t* XR = wsp<bf16_t>(F, WS_XR); bf16_t* XC = wsp<bf16_t>(F, WS_XC);
    const float* wc = F.in_WCONV; const float* bc = F.in_BCONV;
    const int c0 = n * BW + (tid_ & 15) * 8;
    const int s0 = cg < LRU_NCH_P ? 0 : LP, len = cg < LRU_NCH_P ? LP : LS;
    f32x4 w[4][2]; f32x4 b0 = *(const f32x4*)(bc + c0), b1 = *(const f32x4*)(bc + c0 + 4);
#pragma unroll
    for (int j = 0; j < 4; ++j) { w[j][0] = *(const f32x4*)(wc + j * LW + c0); w[j][1] = *(const f32x4*)(wc + j * LW + c0 + 4); }
#pragma unroll
    for (int i = 0; i < 8; ++i) {
        const int t = cg * LRU_CH + (tid_ >> 4) + 32 * i, tl = t - s0;
        f32x4 a0 = b0, a1 = b1;
#pragma unroll
        for (int j = 0; j < 4; ++j) { const int tt = tl + j - 2; if (tt < 0 || tt >= len) continue;
            f32x4 x0, x1; pg8::unpack8(*(const u32x4*)(XR + (size_t)(s0 + tt) * LW + c0), x0, x1); a0 += w[j][0] * x0; a1 += w[j][1] * x1; }
        const int tg = t & 63, cq = tid_ & 15;
        *(u32x4*)(XC + ((size_t)(((((t >> 6) * NBLK + n) * 4 + ((tg >> 2) & 3)) * 4 + (cq & 3)) * 16 + 4 * (tg >> 4) + (tg & 3)) * 4 + (cq >> 2)) * 8) = pg8::pack8(a0, a1);
    }
}
__device__ __forceinline__ void conv_req(const Frame& F, int cg, int n, int tid_, u32x4 (&R)[11]) {
    const bf16_t* XR = wsp<bf16_t>(F, WS_XR);
    const int s0 = cg < LRU_NCH_P ? 0 : LP, len = cg < LRU_NCH_P ? LP : LS;
    const int t0 = cg * LRU_CH + 8 * (tid_ >> 4) - 2, c0 = n * BW + (tid_ & 15) * 8;
#pragma unroll
    for (int k = 0; k < 11; ++k) { const int tl = t0 + k - s0; R[k] = (u32x4){0u, 0u, 0u, 0u}; if (tl >= 0 && tl < len) R[k] = *(const u32x4*)(XR + (size_t)(t0 + k) * LW + c0); }
}
__device__ __forceinline__ void conv_fin(const Frame& F, int cg, int n, int tid_, const u32x4 (&R)[11], LAS unsigned char* tile, const LAS float* cw) {
    bf16_t* XC = wsp<bf16_t>(F, WS_XC);
    const int g = tid_ >> 4, cq = tid_ & 15;
    f32x4 w[4][2];
#pragma unroll
    for (int j = 0; j < 4; ++j) { w[j][0] = *(const LAS f32x4*)(cw + j * BW + cq * 8); w[j][1] = *(const LAS f32x4*)(cw + j * BW + cq * 8 + 4); }
    const f32x4 b0 = *(const LAS f32x4*)(cw + 4 * BW + cq * 8), b1 = *(const LAS f32x4*)(cw + 4 * BW + cq * 8 + 4);
#pragma unroll
    for (int i = 0; i < 8; ++i) {
        f32x4 a0 = b0, a1 = b1;
#pragma unroll
        for (int j = 0; j < 4; ++j) { f32x4 x0, x1; pg8::unpack8(R[i + j], x0, x1); a0 += w[j][0] * x0; a1 += w[j][1] * x1; }
        const int t = cg * LRU_CH + 8 * g + i, tg = t & 63;
        const int fo = ((((((tg >> 2) & 3) * 4 + (cq & 3)) * 16 + 4 * (tg >> 4) + (tg & 3)) * 4 + (cq >> 2)) * 8);
        const u32x4 o = pg8::pack8(a0, a1);
        *(u32x4*)(XC + (size_t)((t >> 6) * NBLK + n) * 8192 + fo) = o;
        *(LAS u32x4*)(tile + ((t >> 6) & 3) * 16384 + fo * 2) = o;
    }
}
__device__ __forceinline__ void lru_load_x_lds(LruX& X, const LAS unsigned char* tile, int gl, int fr, int fq) {
#pragma unroll
    for (int tau = 0; tau < 4; ++tau)
#pragma unroll
        for (int s = 0; s < 4; ++s) X.x[tau][s] = *(const LAS bf16x8*)(tile + ((((gl * 4 + tau) * 4 + s) * 16 + fr) * 4 + fq) * 16);
}
__device__ __forceinline__ void lru_pass_a(Frame& F) {
    const int tid_ = opaque(F.tid);
    const int fr = F.lane & 15, fq = F.lane >> 4, w = F.wave;
    f32x2* SUMM = wsp<f32x2>(F, WS_SUM);
    LAS unsigned char* tile = F.lds; LAS float* cw = (LAS float*)(F.lds + 65536);
    bf16x8 idf0, idf1; lru_idfrags(w, fr, fq, idf0, idf1);
    int u = blockIdx.x, ncur = -1;
    u32x4 R[11];
    if (u < LRU_NCH * NBLK) conv_req(F, u >> 4, u & 15, tid_, R);
    LruW Wf, Wb;
    for (; u < LRU_NCH * NBLK; u += F.G) {
        const int cg = u >> 4, n = u & 15;
        if (n != ncur) {
            ncur = n; lru_load_w<0>(F, Wf, n, w, fr, fq); lru_load_w<1>(F, Wb, n, w, fr, fq);
            for (int i = tid_; i < 5 * BW; i += NTHR) cw[i] = i < 4 * BW ? F.in_WCONV[(i >> 7) * LW + n * BW + (i & 127)] : F.in_BCONV[n * BW + (i & 127)];
            LDS_WAIT(); __builtin_amdgcn_s_barrier();
        }
        asm volatile("" ::: "memory");
        conv_fin(F, cg, n, tid_, R, tile, cw);
        { const int un = u + F.G; if (un < LRU_NCH * NBLK) conv_req(F, un >> 4, un & 15, tid_, R); }
        LDS_WAIT(); __builtin_amdgcn_s_barrier();
        const bool c_first = (cg == 0 || cg == LRU_NCH_P), c_last = (cg == LRU_NCH_P - 1 || cg == LRU_NCH - 1);
        float Af = 1.f, Hf = 0.f, Ab = 1.f, Hb = 0.f;
        for (int gi = 0; gi < 4; ++gi) {
            float pf = 1.f, hf = 0.f, pb = 1.f, hb = 0.f;
#pragma unroll 2
            for (int tau = 0; tau < 4; ++tau) {
                bf16x8 x[4];
#pragma unroll
                for (int s_ = 0; s_ < 4; ++s_) x[s_] = *(const LAS bf16x8*)(tile + ((((gi * 4 + tau) * 4 + s_) * 16 + fr) * 4 + fq) * 16);
                f32x4 prf = (f32x4){0.f, 0.f, 0.f, 0.f}, pif = prf, prb = prf, pib = prf, xct;
#pragma unroll
                for (int s_ = 0; s_ < 4; ++s_) { prf = __builtin_amdgcn_mfma_f32_16x16x32_bf16(x[s_], Wf.w[0][s_], prf, 0, 0, 0); pif = __builtin_amdgcn_mfma_f32_16x16x32_bf16(x[s_], Wf.w[1][s_], pif, 0, 0, 0);
                    prb = __builtin_amdgcn_mfma_f32_16x16x32_bf16(x[s_], Wb.w[0][s_], prb, 0, 0, 0); pib = __builtin_amdgcn_mfma_f32_16x16x32_bf16(x[s_], Wb.w[1][s_], pib, 0, 0, 0); }
                xct = __builtin_amdgcn_mfma_f32_16x16x32_bf16((w & 1) ? x[2] : x[0], idf0, (f32x4){0.f, 0.f, 0.f, 0.f}, 0, 0, 0);
                xct = __builtin_amdgcn_mfma_f32_16x16x32_bf16((w & 1) ? x[3] : x[1], idf1, xct, 0, 0, 0);
#pragma unroll
                for (int j = 0; j < 4; ++j) {
                    float a, uu;
                    lru_gate(prf[j], pif[j], xct[j], Wf, c_first && gi == 0 && fq == 0 && tau == 0 && j == 0, a, uu); hf = a * hf + uu; pf *= a;
                    lru_gate(prb[j], pib[j], xct[j], Wb, c_last && gi == 3 && fq == 3 && tau == 3 && j == 3, a, uu); hb += pb * uu; pb *= a;
                }
            }
            float gPf = 1.f, gHf = 0.f, gPb = 1.f, gHb = 0.f;
#pragma unroll
            for (int qq = 0; qq < 4; ++qq) { const int src = fr + 16 * qq;
                float P = __shfl(pf, src), H = __shfl(hf, src); gHf = P * gHf + H; gPf *= P;
                P = __shfl(pb, src); H = __shfl(hb, src); gHb += gPb * H; gPb *= P; }
            Hf = gPf * Hf + gHf; Af *= gPf; Hb += Ab * gHb; Ab *= gPb;
        }
        if (fq == 0) { const int ch = n * BW + 16 * w + fr; SUMM[(size_t)(cg * 2 + 0) * LW + ch] = (f32x2){Af, Hf}; SUMM[(size_t)(cg * 2 + 1) * LW + ch] = (f32x2){Ab, Hb}; }
        LDS_WAIT(); __builtin_amdgcn_s_barrier();
    }
    VM_WAIT();
}
__device__ __forceinline__ void lru_pass_b(Frame& F) {
    const int tid_ = opaque(F.tid);
    const int gt = blockIdx.x * NTHR + tid_; if (gt >= 4 * LW) return;
    const int ch = gt % LW, d = (gt / LW) & 1, seq = gt / (2 * LW), c0 = seq ? LRU_NCH_P : 0, nc = seq ? LRU_NCH - LRU_NCH_P : LRU_NCH_P;
    const f32x2* SUMM = wsp<f32x2>(F, WS_SUM); float* CIN = wsp<float>(F, WS_SUM + 4 * MiB);
    float s = 0.f;
    for (int i0 = 0; i0 < nc; i0 += 32) {
        f32x2 ah[32];
#pragma unroll
        for (int e = 0; e < 32; ++e) { const int cg = d ? c0 + nc - 1 - (i0 + e) : c0 + i0 + e; ah[e] = SUMM[(size_t)(cg * 2 + d) * LW + ch]; }
#pragma unroll
        for (int e = 0; e < 32; ++e) { const int cg = d ? c0 + nc - 1 - (i0 + e) : c0 + i0 + e; CIN[(size_t)(cg * 2 + d) * LW + ch] = s; s = ah[e].x * s + ah[e].y; }
    }
}
template <int LDBG = 0> __device__ __forceinline__ void lru_pass_c(Frame& F) {
    const int tid_ = opaque(F.tid);
    const int fr = F.lane & 15, fq = F.lane >> 4, w = F.wave;
    const bf16_t* XC = wsp<bf16_t>(F, WS_XC); const float* CIN = wsp<float>(F, WS_SUM + 4 * MiB);
    const bf16_t* GR = wsp<bf16_t>(F, WS_GR); bf16_t* LRU = wsp<bf16_t>(F, WS_XR);
    LAS unsigned char* tile = F.lds;
    LAS unsigned char* hfl = F.lds + 65536 + w * 8192 + F.lane * 32;
    asm volatile("" : "+v"(hfl));
    bf16x8 idf0, idf1; lru_idfrags(w, fr, fq, idf0, idf1);
    LruW Wf, Wb; int ncur = -1;
    for (int u = blockIdx.x; u < LRU_NCH * NBLK; u += F.G) {
        const int cg = u >> 4, n = u & 15, ch = n * BW + 16 * w + fr;
        const bool c_first = (cg == 0 || cg == LRU_NCH_P), c_last = (cg == LRU_NCH_P - 1 || cg == LRU_NCH - 1);
        { const bf16_t* gsrc = XC + (size_t)(cg * 4 * NBLK + n) * 8192 + tid_ * 8; LAS unsigned char* ldst = tile + w * 1024;
#pragma unroll 1
          for (int k = 0; k < 8; ++k) { __builtin_amdgcn_global_load_lds((const unsigned*)gsrc, (LAS unsigned*)ldst, 16, 0, 0); gsrc += (k & 1) ? (size_t)NBLK * 8192 - 4096 : 4096; ldst += 8192; } }
        if (n != ncur) { ncur = n; lru_load_w<0>(F, Wf, n, w, fr, fq); lru_load_w<1>(F, Wb, n, w, fr, fq); }
        const float cin_f = CIN[(size_t)(cg * 2 + 0) * LW + ch], cin_b = CIN[(size_t)(cg * 2 + 1) * LW + ch];
        const bf16_t* grp = GR + (size_t)(cg * LRU_CH + 16 * fq) * LW + ch; bf16_t* outp = LRU + (size_t)(cg * LRU_CH + 16 * fq) * LW + ch;
        VM_WAIT(); __builtin_amdgcn_s_barrier();
        {
            const LruW& W = Wf;
            float s = cin_f;
            for (int gi = 0; gi < 4; ++gi) {
                float a[16], uu[16];
#pragma unroll
                for (int tau = 0; tau < 4; ++tau) { f32x4 pr, pi, xct; lru_tile_lds(tile, gi, tau, (w & 1) != 0, W, idf0, idf1, fr, fq, pr, pi, xct);
#pragma unroll
                    for (int j = 0; j < 4; ++j) lru_gate<LDBG>(pr[j], pi[j], xct[j], W, c_first && gi == 0 && fq == 0 && tau == 0 && j == 0, a[4 * tau + j], uu[4 * tau + j]); }
                float p = 1.f, h = 0.f;
#pragma unroll
                for (int t = 0; t < 16; ++t) { h = a[t] * h + uu[t]; p *= a[t]; }
                float hin = s, sg = s;
#pragma unroll
                for (int qq = 0; qq < 4; ++qq) { const float P = __shfl(p, fr + 16 * qq), H = __shfl(h, fr + 16 * qq); sg = P * sg + H; if (qq < fq) hin = P * hin + H; }
                s = sg;
                float hh = hin;
#pragma unroll
                for (int t = 0; t < 16; ++t) { hh = a[t] * hh + uu[t]; a[t] = hh; }
                *(LAS u32x4*)(hfl + gi * 2048) = (u32x4){pk2(a[0], a[1]), pk2(a[2], a[3]), pk2(a[4], a[5]), pk2(a[6], a[7])};
                *(LAS u32x4*)(hfl + gi * 2048 + 16) = (u32x4){pk2(a[8], a[9]), pk2(a[10], a[11]), pk2(a[12], a[13]), pk2(a[14], a[15])};
            }
        }
        {
            const LruW& W = Wb;
            float s = cin_b;
            bf16_t grn[16];
#pragma unroll
            for (int t = 0; t < 16; ++t) grn[t] = grp[(size_t)(3 * 64 + t) * LW];
            for (int gi = 3; gi >= 0; --gi) {
                bf16_t grc[16];
#pragma unroll
                for (int t = 0; t < 16; ++t) grc[t] = grn[t];
                if (gi > 0) {
#pragma unroll
                    for (int t = 0; t < 16; ++t) grn[t] = grp[(size_t)((gi - 1) * 64 + t) * LW]; }
                float a[16], uu[16];
#pragma unroll
                for (int tau = 0; tau < 4; ++tau) { f32x4 pr, pi, xct; lru_tile_lds(tile, gi, tau, (w & 1) != 0, W, idf0, idf1, fr, fq, pr, pi, xct);
#pragma unroll
                    for (int j = 0; j < 4; ++j) lru_gate<LDBG>(pr[j], pi[j], xct[j], W, c_last && gi == 3 && fq == 3 && tau == 3 && j == 3, a[4 * tau + j], uu[4 * tau + j]); }
                float p = 1.f, h = 0.f;
#pragma unroll
                for (int t = 15; t >= 0; --t) { h = a[t] * h + uu[t]; p *= a[t]; }
                float hin = s, sg = s;
#pragma unroll
                for (int qq = 3; qq >= 0; --qq) { const float P = __shfl(p, fr + 16 * qq), H = __shfl(h, fr + 16 * qq); sg = P * sg + H; if (qq > fq) hin = P * hin + H; }
                s = sg;
                float hh = hin;
                const u32x4 hf0 = *(const LAS u32x4*)(hfl + gi * 2048), hf1 = *(const LAS u32x4*)(hfl + gi * 2048 + 16);
                const unsigned hfw[8] = {hf0.x, hf0.y, hf0.z, hf0.w, hf1.x, hf1.y, hf1.z, hf1.w};
#pragma unroll
                for (int t = 15; t >= 0; --t) { hh = a[t] * hh + uu[t];
                    outp[(size_t)(gi * 64 + t) * LW] = (bf16_t)f2bf((((t & 1) ? bfhi(hfw[t >> 1]) : bflo(hfw[t >> 1])) + hh) * gelu_tanh(bf1(grc[t]))); }
            }
        }
        LDS_WAIT(); __builtin_amdgcn_s_barrier();
    }
}

constexpr int HQW_EARLY = 96 * (D / 32);
__device__ __forceinline__ void hq_wtiles(Frame& F, int lo, int hi, int first, int stride) {
    const int lane = opaque(F.tid) & 63;
    LAS float* scr = (LAS float*)(F.lds + F.wave * 8448);
    for (int it = lo + first; it < hi; it += stride)
        had_tile_quant(F.in_WFD, D, DFF, 64 * (it / (D / 32)), 32 * (it % (D / 32)), wsp<signed char>(F, WS_WD), (const unsigned*)(F.ws + WS_AM), wsp<float>(F, WS_CS) + CS_D, scr, lane);
}
__device__ __forceinline__ void hq_phase(Frame& F) {
    const int lane = opaque(F.tid) & 63;
    const bf16_t* H0 = (const bf16_t*)F.out; const bf16_t* H1 = wsp<bf16_t>(F, WS_HIDS);
    signed char* Q0 = wsp<signed char>(F, WS_H8P); signed char* Q1 = wsp<signed char>(F, WS_H8S); float* RS3 = wsp<float>(F, WS_RS3);
    hq_wtiles(F, HQW_EARLY, (DFF / 64) * (D / 32), F.gw, F.ngw);
    constexpr int NB = DFF / 32;
    for (int m = F.gw; m < L; m += F.ngw) {
        const bf16_t* src = m < LP ? H0 + (size_t)m * DFF : H1 + (size_t)(m - LP) * DFF;
        signed char* dst = m < LP ? Q0 + (size_t)m * DFF : Q1 + (size_t)(m - LP) * DFF;
        u32x4 raw[6][4];
#pragma unroll
        for (int it = 0; it < 6; ++it) { const int b = lane + 64 * it; const u32x4* p = (const u32x4*)(src + (b < NB ? b : lane) * 32);
#pragma unroll
            for (int i = 0; i < 4; ++i) raw[it][i] = p[i]; }
        float mx = 0.f;
#pragma unroll
        for (int it = 0; it < 6; ++it) { float v[32];
#pragma unroll
            for (int i = 0; i < 4; ++i) { const u32x4 u = raw[it][i]; v[8 * i + 0] = bflo(u.x); v[8 * i + 1] = bfhi(u.x); v[8 * i + 2] = bflo(u.y); v[8 * i + 3] = bfhi(u.y); v[8 * i + 4] = bflo(u.z); v[8 * i + 5] = bfhi(u.z); v[8 * i + 6] = bflo(u.w); v[8 * i + 7] = bfhi(u.w); }
            fwht32(v);
            float bm = 0.f;
#pragma unroll
            for (int i = 0; i < 32; ++i) bm = fmaxf(bm, fabsf(v[i]));
            mx = fmaxf(mx, (lane + 64 * it < NB) ? bm : 0.f); }
        const float amax = fmaxf(wave_max(mx), 1e-20f), inv = 127.0f / amax;
        if (lane == 0) RS3[m] = amax * (1.0f / 127.0f);
#pragma unroll
        for (int it = 0; it < 6; ++it) { const int b = lane + 64 * it; float v[32];
#pragma unroll
            for (int i = 0; i < 4; ++i) { const u32x4 u = raw[it][i]; v[8 * i + 0] = bflo(u.x); v[8 * i + 1] = bfhi(u.x); v[8 * i + 2] = bflo(u.y); v[8 * i + 3] = bfhi(u.y); v[8 * i + 4] = bflo(u.z); v[8 * i + 5] = bfhi(u.z); v[8 * i + 6] = bflo(u.w); v[8 * i + 7] = bfhi(u.w); }
            fwht32(v);
            u32x4 o0, o1;
            o0.x = pk4_i8(rintf(v[0] * inv), rintf(v[1] * inv), rintf(v[2] * inv), rintf(v[3] * inv)); o0.y = pk4_i8(rintf(v[4] * inv), rintf(v[5] * inv), rintf(v[6] * inv), rintf(v[7] * inv));
            o0.z = pk4_i8(rintf(v[8] * inv), rintf(v[9] * inv), rintf(v[10] * inv), rintf(v[11] * inv)); o0.w = pk4_i8(rintf(v[12] * inv), rintf(v[13] * inv), rintf(v[14] * inv), rintf(v[15] * inv));
            o1.x = pk4_i8(rintf(v[16] * inv), rintf(v[17] * inv), rintf(v[18] * inv), rintf(v[19] * inv)); o1.y = pk4_i8(rintf(v[20] * inv), rintf(v[21] * inv), rintf(v[22] * inv), rintf(v[23] * inv));
            o1.z = pk4_i8(rintf(v[24] * inv), rintf(v[25] * inv), rintf(v[26] * inv), rintf(v[27] * inv)); o1.w = pk4_i8(rintf(v[28] * inv), rintf(v[29] * inv), rintf(v[30] * inv), rintf(v[31] * inv));
            if (b < NB) { *(u32x4*)(dst + b * 32) = o0; *(u32x4*)(dst + b * 32 + 16) = o1; } }
    }
}

__device__ __forceinline__ f32x4 up4(const u32x2 u) { return (f32x4){bflo(u.x), bfhi(u.x), bflo(u.y), bfhi(u.y)}; }
__device__ __forceinline__ void mid_phase(Frame& F) {
    const int tid_ = opaque(F.tid);
    bf16_t* MIX = wsp<bf16_t>(F, WS_MIX); signed char* XN8 = wsp<signed char>(F, WS_XN8); float* RS2 = wsp<float>(F, WS_RS2);
    LAS f32x4* gpost = (LAS f32x4*)F.lds; LAS f32x4* gpre = gpost + D / 4;
    for (int i = tid_; i < D / 4; i += NTHR) { gpost[i] = ((const f32x4*)F.in_GMPOST)[i]; gpre[i] = ((const f32x4*)F.in_GFPRE)[i]; }
    __syncthreads();
    for (int m = F.gw; m < L; m += F.ngw) {
        asm volatile("" ::: "memory");
        const f32x4* xr = (const f32x4*)xrow(F, m) + F.lane; const u32x2* mr = (const u32x2*)(MIX + (size_t)m * D) + F.lane;
        f32x4 v[16]; u32x2 mx[16]; float s = 0.f;
#pragma unroll
        for (int j = 0; j < 16; ++j) { v[j] = xr[64 * j]; mx[j] = mr[64 * j]; const f32x4 a = up4(mx[j]); s += (a.x * a.x + a.y * a.y) + (a.z * a.z + a.w * a.w); }
        const float rstd1 = 1.0f / sqrtf(wave_sum(s) * (1.0f / D) + EPS);
        float s2 = 0.f;
#pragma unroll
        for (int j = 0; j < 16; ++j) { v[j] = v[j] + up4(mx[j]) * rstd1 * gpost[F.lane + 64 * j]; s2 += (v[j].x * v[j].x + v[j].y * v[j].y) + (v[j].z * v[j].z + v[j].w * v[j].w); }
        const float rstd2 = 1.0f / sqrtf(wave_sum(s2) * (1.0f / D) + EPS);
        { u32x2* xw = (u32x2*)(MIX + (size_t)m * D) + F.lane;
#pragma unroll
          for (int j = 0; j < 16; ++j) xw[64 * j] = (u32x2){pk2(v[j].x, v[j].y), pk2(v[j].z, v[j].w)}; }
        float mx2 = 0.f;
#pragma unroll
        for (int j = 0; j < 16; ++j) { v[j] = v[j] * rstd2 * gpre[F.lane + 64 * j]; mx2 = fmaxf(fmaxf(mx2, fmaxf(fabsf(v[j].x), fabsf(v[j].y))), fmaxf(fabsf(v[j].z), fabsf(v[j].w))); }
        const float amax = fmaxf(wave_max(mx2), 1e-20f), inv = 127.0f / amax;
        if (F.lane == 0) RS2[m] = amax * (1.0f / 127.0f);
        unsigned* o4 = (unsigned*)(XN8 + (size_t)m * D) + F.lane;
#pragma unroll
        for (int j = 0; j < 16; ++j) o4[64 * j] = pk4_i8(rintf(v[j].x * inv), rintf(v[j].y * inv), rintf(v[j].z * inv), rintf(v[j].w * inv));
    }
    __syncthreads();
}
__device__ __forceinline__ void final_phase(Frame& F) {
    const int tid_ = opaque(F.tid);
    const bf16_t* X1 = wsp<bf16_t>(F, WS_MIX); const bf16_t* FB = wsp<bf16_t>(F, WS_F);
    LAS f32x4* gfp = (LAS f32x4*)F.lds;
    for (int i = tid_; i < D / 4; i += NTHR) gfp[i] = ((const f32x4*)F.in_GFPOST)[i];
    __syncthreads();
    for (int m = F.gw; m < L; m += F.ngw) {
        asm volatile("" ::: "memory");
        const u32x2* mr = (const u32x2*)(X1 + (size_t)m * D) + F.lane; const u32x2* fr = (const u32x2*)(FB + (size_t)m * D) + F.lane;
        u32x2 fx[16], x1[16]; float s = 0.f;
#pragma unroll
        for (int j = 0; j < 16; ++j) { fx[j] = fr[64 * j]; x1[j] = mr[64 * j]; const f32x4 a = up4(fx[j]); s += (a.x * a.x + a.y * a.y) + (a.z * a.z + a.w * a.w); }
        const float rstd3 = 1.0f / sqrtf(wave_sum(s) * (1.0f / D) + EPS);
        f32x4* o = (f32x4*)(F.out + (size_t)m * D) + F.lane;
#pragma unroll
        for (int j = 0; j < 16; ++j) o[64 * j] = up4(x1[j]) + up4(fx[j]) * rstd3 * gfp[F.lane + 64 * j];
    }
}

constexpr int LDS_STAGE = pg8::STAGE_BYTES;
constexpr int LDS_MISC = LDS_STAGE;
constexpr int LDS_BYTES = LDS_STAGE + 1024;
#ifndef MK_N_LAUNCHES
#define MK_N_LAUNCHES 1
#endif
constexpr int NPHASE = 12;
struct Args { const float* in[23]; float* out; unsigned char* ws; int ph_lo, ph_hi; };

__global__ void __launch_bounds__(NTHR, 2) fwd_kernel(Args args) {
    extern __shared__ __attribute__((aligned(16))) unsigned char lds_raw[];
    Frame F;
    F.lds = (LAS unsigned char*)lds_raw;
    F.tid = threadIdx.x; F.lane = (int)__builtin_amdgcn_mbcnt_hi(~0u, __builtin_amdgcn_mbcnt_lo(~0u, 0u)); F.wave = __builtin_amdgcn_readfirstlane(F.tid >> 6);
    F.G = gridDim.x; F.gw = blockIdx.x * NWAVES + F.wave; F.ngw = F.G * NWAVES;
    F.in_XP = args.in[0]; F.in_XS = args.in[1]; F.in_WIN = args.in[2]; F.in_WCONV = args.in[3]; F.in_BCONV = args.in[4]; F.in_WR = args.in[5]; F.in_BR = args.in[6]; F.in_WI = args.in[7]; F.in_BI = args.in[8]; F.in_LAM = args.in[9]; F.in_RPB = args.in[10]; F.in_WNO = args.in[11]; F.in_WLO = args.in[12]; F.in_WM = args.in[13]; F.in_BM = args.in[14]; F.in_WOUT = args.in[15]; F.in_GMPRE = args.in[16]; F.in_GMPOST = args.in[17]; F.in_GFPRE = args.in[18]; F.in_GFPOST = args.in[19]; F.in_WFG = args.in[20]; F.in_WFU = args.in[21]; F.in_WFD = args.in[22];
    F.out = args.out; F.ws = args.ws;
    volatile LAS unsigned* MISC = (volatile LAS unsigned*)(F.lds + LDS_MISC);
    if (F.tid < 256) MISC[F.tid] = 0u;
    __syncthreads();
    const int lo = args.ph_lo, hi = args.ph_hi;
    const bool fused = (hi - lo) > 1;
    XcdBarrier bar; bar.bar = (unsigned*)(F.ws + WS_CTL); bar.x = 0; bar.st = nullptr;
    if (fused) bar = xcd_barrier_post((unsigned*)(F.ws + WS_CTL), MISC + 8);
#ifndef PH_MASK
#define PH_MASK 0xfff
#endif
#define IN(k) (((PH_MASK >> (k)) & 1) && lo <= (k) && (k) < hi)
#define SEAM(k) do { if (IN(k) && IN((k) + 1)) xcd_barrier(bar); } while (0)
    LAS unsigned char* stage = F.lds;

#ifdef ATTN_OUT_OFF
#define NA_BUF ((size_t)ATTN_OUT_OFF * MiB)
#else
#define NA_BUF WS_Q
#endif
#ifndef DUP_MASK
#define DUP_MASK 0
#endif
#define RUN(k, ...) if (IN(k)) { __VA_ARGS__ if (((DUP_MASK) >> (k)) & 1) { __VA_ARGS__ } }
    RUN(0, { p0_prologue(F); }) SEAM(0);
    RUN(1, {
        { pg8::Gemm g{wsp<bf16_t>(F, WS_XN8), wsp<bf16_t>(F, WS_XN8), 1 << 30, wsp<bf16_t>(F, WS_W8), L, 2 * NAW + 2 * D, D}; pg8::StaticOrder S; S.init(L, 2 * NAW + 2 * D, F.G, (int)blockIdx.x);
          pg8::EpiProjQ E{wsp<bf16_t>(F, WS_Q), wsp<bf16_t>(F, WS_K), (bf16_t*)F.out, F.in_BM, wsp<float>(F, WS_RS1), wsp<float>(F, WS_CS) + CS_QKM};
          pg8::gemm_phase<pg8::EpiProjQ, pg8::StaticOrder, true, true, 2>(stage, g, S, E); }
        { pg8::Gemm g{wsp<bf16_t>(F, WS_XN), wsp<bf16_t>(F, WS_XN), 1 << 30, wsp<bf16_t>(F, WS_WCAT), L, 2 * NAW, 2 * D}; pg8::StaticOrder S; S.init(L, 2 * NAW, F.G, (int)blockIdx.x);
          pg8::EpiProj E{wsp<bf16_t>(F, WS_XR), wsp<bf16_t>(F, WS_GR), wsp<bf16_t>(F, WS_GR), wsp<bf16_t>(F, WS_GR), (bf16_t*)F.out, F.in_BM, 1 << 30};
          pg8::gemm_phase<pg8::EpiProj, pg8::StaticOrder, true, true, 0>(stage, g, S, E); }
        { pg8::Gemm g{wsp<bf16_t>(F, WS_WVT), wsp<bf16_t>(F, WS_WVT), 1 << 30, wsp<bf16_t>(F, WS_XN8), NAW, L, D}; pg8::StaticOrder S; S.init(NAW, L, F.G, (int)blockIdx.x);
          pg8::EpiVTQ E{wsp<bf16_t>(F, WS_VT), wsp<float>(F, WS_CS) + CS_V, wsp<float>(F, WS_RS1)};
          pg8::gemm_phase<pg8::EpiVTQ, pg8::StaticOrder, true, true, 2>(stage, g, S, E); }
    }) SEAM(1);
    RUN(2, { lru_pass_a(F); }) SEAM(2);
    #ifdef ATTN_OUT_OFF
    if (IN(3)) { lru_pass_b(F); } SEAM(3);
    if (IN(4)) { lru_pass_c<0>(F); xcd_barrier(bar); if (ATTN_DUP) attn_mfma<ATTN_DUP - 1>(F); attn_mfma<0>(F); } SEAM(4);
#else
    if (IN(3)) { lru_pass_b(F); attn_mfma_lds(F); } SEAM(3);
#ifdef LRUC_DBG
    if (IN(4)) { lru_pass_c<LRUC_DBG>(F); lru_pass_c<0>(F); } SEAM(4);
#else
    RUN(4, { lru_pass_c<0>(F); }) SEAM(4);
#endif
#endif
    if (IN(5)) {
        { pg8::Gemm g{wsp<bf16_t>(F, NA_BUF), wsp<bf16_t>(F, NA_BUF), 1 << 30, wsp<bf16_t>(F, WS_WNO), L, D, 2 * NAW}; pg8::StaticOrder S; S.init(L, D, F.G, (int)blockIdx.x);
          pg8::EpiMulG<false> E{wsp<bf16_t>(F, WS_T1), (const bf16_t*)F.out, 0};
          pg8::gemm_phase<pg8::EpiMulG<false>, pg8::StaticOrder, true, true>(stage, g, S, E); }
        { pg8::Gemm g{wsp<bf16_t>(F, WS_XR), wsp<bf16_t>(F, WS_XR), 1 << 30, wsp<bf16_t>(F, WS_WLO), L, D, 2 * LW}; pg8::StaticOrder S; S.init(L, D, F.G, (int)blockIdx.x);
          pg8::EpiMulG<true> E{wsp<bf16_t>(F, WS_T1), (const bf16_t*)F.out, D};
          pg8::gemm_phase<pg8::EpiMulG<true>, pg8::StaticOrder, true, true>(stage, g, S, E); }
    } SEAM(5);
    RUN(6, {
        pg8::Gemm g{wsp<bf16_t>(F, WS_T1), wsp<bf16_t>(F, WS_T1), 1 << 30, wsp<bf16_t>(F, WS_WO), L, D, 2 * D}; pg8::StaticOrder S; S.init(L, D, F.G, (int)blockIdx.x);
        pg8::EpiPlain E{wsp<bf16_t>(F, WS_MIX), D};
        pg8::gemm_phase<pg8::EpiPlain, pg8::StaticOrder, true, true>(stage, g, S, E);
    }) SEAM(6);
    RUN(7, { mid_phase(F); }) SEAM(7);
    RUN(8, {
        pg8::Gemm g{wsp<bf16_t>(F, WS_XN8), wsp<bf16_t>(F, WS_XN8), 1 << 30, wsp<bf16_t>(F, WS_WGU), L, 2 * DFF, D}; pg8::StaticOrder S; S.init(L, 2 * DFF, F.G, (int)blockIdx.x);
        pg8::EpiSwigluQ E{(bf16_t*)F.out, wsp<bf16_t>(F, WS_HIDS), LP / 256, wsp<float>(F, WS_RS2), wsp<float>(F, WS_CS) + CS_GU};
        pg8::gemm_phase<pg8::EpiSwigluQ, pg8::StaticOrder, false, true, 2>(stage, g, S, E);
        { const int rem = S.nwg % F.G;
          if ((int)blockIdx.x >= rem) hq_wtiles(F, 0, HQW_EARLY, ((int)blockIdx.x - rem) * NWAVES + F.wave, (F.G - rem) * NWAVES); }
    }) SEAM(8);
    RUN(9, { hq_phase(F); }) SEAM(9);
    RUN(10, {
        pg8::Gemm g{wsp<bf16_t>(F, WS_H8P), wsp<bf16_t>(F, WS_H8S), LP / 256, wsp<bf16_t>(F, WS_WD), L, D, DFF}; pg8::StaticOrder S; S.init(L, D, F.G, (int)blockIdx.x);
        pg8::EpiPlainQ E{wsp<bf16_t>(F, WS_F), D, wsp<float>(F, WS_RS3), wsp<float>(F, WS_CS) + CS_D};
        pg8::gemm_phase<pg8::EpiPlainQ, pg8::StaticOrder, true, true, 2>(stage, g, S, E);
    }) SEAM(10);
    RUN(11, { final_phase(F); })
#undef RUN
#undef IN
#undef SEAM
}

extern "C" void kernel_launch(void* const* d_in, const int* in_sizes, int n_in, void* d_out, int out_size, void* d_ws, size_t ws_size, hipStream_t stream) {
    static int grid = 0;
    if (grid == 0) {
        if (n_in != 23 || in_sizes[0] != LP * D || in_sizes[1] != LS * D || out_size != L * D || ws_size < WS_END) {
            fprintf(stderr, "kernel_launch: unexpected shapes: n_in %d in0 %d out %d ws %zu (need %zu)\n", n_in, n_in > 0 ? in_sizes[0] : -1, out_size, ws_size, (size_t)WS_END); grid = -1; return; }
        int dev = 0, cus = 0, per_cu = 0;
        if (hipGetDevice(&dev) != hipSuccess || hipDeviceGetAttribute(&cus, hipDeviceAttributeMultiprocessorCount, dev) != hipSuccess) { grid = -1; return; }
        if (hipFuncSetAttribute((const void*)fwd_kernel, hipFuncAttributeMaxDynamicSharedMemorySize, LDS_BYTES) != hipSuccess) { fprintf(stderr, "kernel_launch: hipFuncSetAttribute failed\n"); grid = -1; return; }
        if (hipOccupancyMaxActiveBlocksPerMultiprocessor(&per_cu, (const void*)fwd_kernel, NTHR, LDS_BYTES) != hipSuccess || per_cu < 1) { fprintf(stderr, "kernel_launch: occupancy query says %d\n", per_cu); }
        (void)hipGetLastError();
        grid = cus;
    }
    if (grid < 0) return;
    (void)hipMemsetAsync((char*)d_ws + WS_CTL, 0, CTL_ZERO_BYTES, stream);
#ifdef DBG_ZERO_ALL
    (void)hipMemsetAsync((char*)d_ws, 0, WS_END, stream); (void)hipMemsetAsync((char*)d_out, 0, (size_t)L * D * 4, stream);
#endif
    Args a{};
    for (int i = 0; i < 23; ++i) a.in[i] = (const float*)d_in[i];
    a.out = (float*)d_out; a.ws = (unsigned char*)d_ws;
#if MK_N_LAUNCHES == 1
    a.ph_lo = 0; a.ph_hi = NPHASE;
    hipLaunchKernelGGL(fwd_kernel, dim3(grid), dim3(NTHR), LDS_BYTES, stream, a);
#else
    for (int p = 0; p < NPHASE; ++p) {
#ifdef DBG_PH_MASK
        if (!((DBG_PH_MASK >> p) & 1)) continue;
#endif
        a.ph_lo = p; a.ph_hi = p + 1; hipLaunchKernelGGL(fwd_kernel, dim3(grid), dim3(NTHR), LDS_BYTES, stream, a); }
#endif
}
```

```cpp
#include <hip/hip_runtime.h>
#include <cstdio>
#include <cstdint>

#define LAS __attribute__((address_space(3)))
typedef unsigned short bf16_t;
typedef short bf16x8 __attribute__((ext_vector_type(8)));
typedef float f32x4 __attribute__((ext_vector_type(4)));
typedef float f32x2 __attribute__((ext_vector_type(2)));
typedef unsigned u32x4 __attribute__((ext_vector_type(4)));
typedef unsigned u32x2 __attribute__((ext_vector_type(2)));

constexpr int D = 4096, LP = 16384, LS = 8192, L = LP + LS;
constexpr int GRIDW = 64, HD = 128, NH = 16, NAW = 2048, LW = 2048, NBLK = 16, BW = 128, DFF = 11008, INW = 10240;
constexpr float EPS = 1e-6f;
constexpr int NWAVES = 8, NTHR = 512;

constexpr size_t MiB = 1u << 20;
constexpr size_t WS_CTL = 0, CTL_ZERO_BYTES = 64 * 1024;
constexpr size_t WS_AM = 32 * 1024;
constexpr size_t WS_RSTD = 1 * MiB;
constexpr size_t WS_RS1 = 1 * MiB + 128 * 1024;
constexpr size_t WS_RS2 = 1 * MiB + 256 * 1024;
constexpr size_t WS_CS = 1 * MiB + 384 * 1024;
constexpr size_t WS_SUM = 2 * MiB;
constexpr size_t WS_WCAT = 8 * MiB;
constexpr size_t WS_W8 = 40 * MiB;
constexpr size_t WS_WVT = 88 * MiB;
constexpr size_t WS_XN8 = 96 * MiB;
constexpr size_t WS_WNO = 192 * MiB;
constexpr size_t WS_WLO = 208 * MiB;
constexpr size_t WS_WO = 224 * MiB;
constexpr size_t WS_WGU = 256 * MiB;
constexpr size_t WS_WD = 342 * MiB;
constexpr size_t WS_WG = 428 * MiB;
constexpr size_t WS_XN = 430 * MiB;
constexpr size_t WS_Q = 622 * MiB;
constexpr size_t WS_XR = 718 * MiB;
constexpr size_t WS_K = 814 * MiB;
constexpr size_t WS_VT = 910 * MiB;
constexpr size_t WS_GR = 1006 * MiB;
constexpr size_t WS_XC = 1102 * MiB;
constexpr size_t WS_END = 1198 * MiB;
constexpr int CS_QKM = 0, CS_V = 12288, CS_GU = 12288 + 2048, CS_D = 12288 + 2048 + 22016;
constexpr size_t WS_RS3 = 1 * MiB + 640 * 1024;
constexpr size_t WS_H8P = WS_XN, WS_H8S = WS_XN8;
constexpr size_t WS_T1 = WS_K;
constexpr size_t WS_MIX = WS_GR;
constexpr size_t WS_HIDS = WS_Q;
constexpr size_t WS_F = WS_K;
constexpr size_t WS_HF = WS_K;

#define LDS_WAIT() asm volatile("s_waitcnt lgkmcnt(0)" ::: "memory")
#define VM_WAIT() asm volatile("s_waitcnt vmcnt(0)" ::: "memory")
typedef __bf16 bf16x2n_t __attribute__((ext_vector_type(2)));
__device__ __forceinline__ unsigned pk2(float lo, float hi) { const bf16x2n_t r = __builtin_convertvector((f32x2){lo, hi}, bf16x2n_t); return __builtin_bit_cast(unsigned, r); }
__device__ __forceinline__ unsigned f2bf(float f) { return pk2(f, 0.f) & 0xffffu; }
__device__ __forceinline__ float bflo(unsigned u) { return __builtin_bit_cast(float, u << 16); }
__device__ __forceinline__ float bfhi(unsigned u) { return __builtin_bit_cast(float, u & 0xffff0000u); }
__device__ __forceinline__ float bf1(bf16_t u) { return __builtin_bit_cast(float, (unsigned)u << 16); }
__device__ __forceinline__ float wave_sum(float v) {
#pragma unroll
    for (int o = 1; o < 64; o <<= 1) v += __shfl_xor(v, o);
    return v;
}
__device__ __forceinline__ float wave_max(float v) {
#pragma unroll
    for (int o = 1; o < 64; o <<= 1) v = fmaxf(v, __shfl_xor(v, o));
    return v;
}
__device__ __forceinline__ float sigmoidf_(float v) { return __builtin_amdgcn_rcpf(1.0f + __expf(-v)); }
__device__ __forceinline__ float gelu_tanh(float v) { const float z = v * __builtin_fmaf(v * v, -0.1029432f, -2.3022082f); return v * __builtin_amdgcn_rcpf(1.0f + __builtin_amdgcn_exp2f(z)); }

namespace pg8 {
constexpr int BM = 256, BK = 64, HALF = 128, HTB = HALF * BK * 2  , STAGE_BYTES = 8 * HTB, NXCD = 8, WGM = 4;

__host__ __device__ __forceinline__ int lds_byte(int r, int c) { return (r >> 3) * 1024 + (r & 7) * 128 + ((((c >> 3) ^ r) & 7) << 4) + (c & 7) * 2; }
__host__ __device__ __forceinline__ void stage_rc(int b, int& R, int& C) { const int ch = b >> 10, rr = (b >> 7) & 7, slot = (b >> 4) & 7; R = ch * 8 + rr; C = ((slot ^ rr) & 7) * 8; }
__host__ __device__ __forceinline__ int perm32(int rho) { const int n = rho >> 4, i = rho & 15; return 8 * (i >> 2) + 4 * n + (i & 3); }

struct Unit { int pm, pn; };
struct Gemm {
    const bf16_t* A; const bf16_t* A2; int pm_split; const bf16_t* Bt; int M, N, rb;
    __device__ __forceinline__ const char* abase(int pm) const { const size_t t = (size_t)BM * rb; return pm < pm_split ? (const char*)A + (size_t)pm * t : (const char*)A2 + (size_t)(pm - pm_split) * t; }
    __device__ __forceinline__ const char* bbase(int pn) const { return (const char*)Bt + (size_t)pn * BM * rb; }
};

struct StaticOrder {
    int nM, nN, nwg, G, c;
    __host__ __device__ void init(int M, int N, int G_, int c_) { nM = M / BM; nN = N / BM; nwg = nM * nN; G = G_; c = c_; }
    __host__ __device__ bool next(int i, Unit& u) const {
        const long Lx = (long)i * G + c; if (Lx >= nwg) return false;
        int wgid = (int)Lx; { const int q = nwg / NXCD, r = nwg % NXCD, xcd = wgid % NXCD, off = wgid / NXCD; wgid = (xcd < r ? xcd * (q + 1) : r * (q + 1) + (xcd - r) * q) + off; }
        const int nig = WGM * nN, gid = wgid / nig, fm = gid * WGM, gsz = (nM - fm) < WGM ? (nM - fm) : WGM;
        u.pm = fm + ((wgid % nig) % gsz); u.pn = (wgid % nig) / gsz; return true;
    }
    __device__ __forceinline__ void a_ready(const Unit&) const {}
    __device__ __forceinline__ void done(const Unit&) const {}
};

typedef int v8i32 __attribute__((ext_vector_type(8)));
typedef int v4i32 __attribute__((ext_vector_type(4)));
typedef __bf16 bf16x2_t __attribute__((ext_vector_type(2)));
__device__ __forceinline__ unsigned cvt_pk_bf16(float lo, float hi) { const bf16x2_t r = __builtin_convertvector((f32x2){lo, hi}, bf16x2_t); return __builtin_bit_cast(unsigned, r); }
__device__ __forceinline__ u32x4 pack8(const f32x4 v0, const f32x4 v1) { u32x4 w; w.x = cvt_pk_bf16(v0[0], v0[1]); w.y = cvt_pk_bf16(v0[2], v0[3]); w.z = cvt_pk_bf16(v1[0], v1[1]); w.w = cvt_pk_bf16(v1[2], v1[3]); return w; }
__device__ __forceinline__ void unpack8(const u32x4 w, f32x4& v0, f32x4& v1) { v0 = (f32x4){bflo(w.x), bfhi(w.x), bflo(w.y), bfhi(w.y)}; v1 = (f32x4){bflo(w.z), bfhi(w.z), bflo(w.w), bfhi(w.w)}; }
__device__ __forceinline__ f32x4 sig4(const f32x4 v) { f32x4 r; r[0] = sigmoidf_(v[0]); r[1] = sigmoidf_(v[1]); r[2] = sigmoidf_(v[2]); r[3] = sigmoidf_(v[3]); return r; }

struct EpiPlain {
    static constexpr bool PERM = true, AFTER_DRAIN = false;
    bf16_t* O; int ldc;
    __device__ __forceinline__ void operator()(const f32x4 (&acc)[2][2][4][2], const Unit& u, int wr, int wc, int fr, int fq) const {
        const int row0 = u.pm * BM + wr * 64 + fr, col0 = u.pn * BM + wc * 32 + 8 * fq;
#pragma unroll
        for (int ai = 0; ai < 2; ++ai)
#pragma unroll
            for (int m = 0; m < 4; ++m) { bf16_t* rowp = O + (size_t)(row0 + ai * HALF + m * 16) * ldc + col0;
#pragma unroll
                for (int bj = 0; bj < 2; ++bj) *(u32x4*)(rowp + bj * HALF) = pack8(acc[ai][bj][m][0], acc[ai][bj][m][1]); }
    }
};
struct EpiVT {
    static constexpr bool PERM = true, AFTER_DRAIN = false;
    bf16_t* O;
    __device__ __forceinline__ void operator()(const f32x4 (&acc)[2][2][4][2], const Unit& u, int wr, int wc, int fr, int fq) const {
        const int row0 = u.pm * BM + wr * 64 + fr, col0 = u.pn * BM + wc * 32 + 8 * fq;
#pragma unroll
        for (int ai = 0; ai < 2; ++ai)
#pragma unroll
            for (int m = 0; m < 4; ++m) { const int row = row0 + ai * HALF + m * 16, hh = row >> 7, d = row & 127;
                const int dt = 2 * (d >> 5) + ((d >> 2) & 1), i = 4 * ((d >> 3) & 3) + (d & 3);
#pragma unroll
                for (int bj = 0; bj < 2; ++bj) { const int tok = col0 + bj * HALF, R = tok >> 6, o = (tok & 63) >> 3;
                    *(u32x4*)(O + ((size_t)((((R * 16 + hh) * 8 + dt) * 8 + o) * 16 + i)) * 8) = pack8(acc[ai][bj][m][0], acc[ai][bj][m][1]); } }
    }
};
struct EpiProj {
    static constexpr bool PERM = true, AFTER_DRAIN = false;
    bf16_t* P0; bf16_t* P1; bf16_t* P2; bf16_t* P3; bf16_t* G; const float* bias; int pn_gate0;
    __device__ __forceinline__ void operator()(const f32x4 (&acc)[2][2][4][2], const Unit& u, int wr, int wc, int fr, int fq) const {
        const int row0 = u.pm * BM + wr * 64 + fr;
        if (u.pn < pn_gate0) {
            const int t = u.pn >> 3; bf16_t* base = t == 0 ? P0 : (t == 1 ? P1 : (t == 2 ? P2 : P3));
            const int col0 = (u.pn & 7) * BM + wc * 32 + 8 * fq;
            if (t == 2) {
#pragma unroll
                for (int ai = 0; ai < 2; ++ai)
#pragma unroll
                    for (int m = 0; m < 4; ++m) { const int tok = row0 + ai * HALF + m * 16, R = tok >> 6, cl = tok & 63;
                        const int tokpart = (((cl >> 2) & 1) * 8 + (cl >> 3)) * 4 + (cl & 3);
#pragma unroll
                        for (int bj = 0; bj < 2; ++bj) { const int c = col0 + bj * HALF, hh = c >> 7, d0 = c & 127;
                            *(u32x4*)(base + ((size_t)(((R * 16 + hh) * 4 + (d0 >> 5)) * 64 + tokpart) * 4 + ((d0 >> 3) & 3)) * 8) = pack8(acc[ai][bj][m][0], acc[ai][bj][m][1]); } }
            } else {
#pragma unroll
            for (int ai = 0; ai < 2; ++ai)
#pragma unroll
                for (int m = 0; m < 4; ++m) { bf16_t* rowp = base + (size_t)(row0 + ai * HALF + m * 16) * NAW + col0;
#pragma unroll
                    for (int bj = 0; bj < 2; ++bj) *(u32x4*)(rowp + bj * HALF) = pack8(acc[ai][bj][m][0], acc[ai][bj][m][1]); }
            }
        } else {
            const int col0 = (u.pn - pn_gate0) * BM + wc * 32 + 8 * fq;
            f32x4 bv[2][2];
#pragma unroll
            for (int bj = 0; bj < 2; ++bj)
#pragma unroll
                for (int n = 0; n < 2; ++n) bv[bj][n] = *(const f32x4*)(bias + col0 + bj * HALF + 4 * n);
#pragma unroll
            for (int ai = 0; ai < 2; ++ai)
#pragma unroll
                for (int m = 0; m < 4; ++m) { bf16_t* rowp = G + (size_t)(row0 + ai * HALF + m * 16) * (2 * D) + col0;
#pragma unroll
                    for (int bj = 0; bj < 2; ++bj) *(u32x4*)(rowp + bj * HALF) = pack8(sig4(acc[ai][bj][m][0] + bv[bj][0]), sig4(acc[ai][bj][m][1] + bv[bj][1])); }
        }
    }
};
template <bool ADD> struct EpiMulG {
    static constexpr bool PERM = true, AFTER_DRAIN = false;
    bf16_t* O; const bf16_t* G; int goff;
    __device__ __forceinline__ void operator()(const f32x4 (&acc)[2][2][4][2], const Unit& u, int wr, int wc, int fr, int fq) const {
        const int row0 = u.pm * BM + wr * 64 + fr, col0 = u.pn * BM + wc * 32 + 8 * fq;
#pragma unroll
        for (int ai = 0; ai < 2; ++ai)
#pragma unroll
            for (int m = 0; m < 4; ++m) { const size_t row = (size_t)(row0 + ai * HALF + m * 16); bf16_t* rowp = O + row * D + col0; const bf16_t* gp = G + row * (2 * D) + goff + col0;
#pragma unroll
                for (int bj = 0; bj < 2; ++bj) {
                    f32x4 g0, g1; unpack8(*(const u32x4*)(gp + bj * HALF), g0, g1);
                    f32x4 v0 = acc[ai][bj][m][0] * g0, v1 = acc[ai][bj][m][1] * g1;
                    if (ADD) { f32x4 t0, t1; unpack8(*(const u32x4*)(rowp + bj * HALF), t0, t1); v0 += t0; v1 += t1; }
                    *(u32x4*)(rowp + bj * HALF) = pack8(v0, v1); } }
    }
};
struct EpiSwiglu {
    static constexpr bool PERM = true, AFTER_DRAIN = false;
    bf16_t* H0; bf16_t* H1; int pm_split;
    __device__ __forceinline__ void operator()(const f32x4 (&acc)[2][2][4][2], const Unit& u, int wr, int wc, int fr, int fq) const {
        bf16_t* base = u.pm < pm_split ? H0 + (size_t)u.pm * BM * DFF : H1 + (size_t)(u.pm - pm_split) * BM * DFF;
        const int row0 = wr * 64 + fr, col0 = u.pn * HALF + wc * 32 + 8 * fq;
#pragma unroll
        for (int ai = 0; ai < 2; ++ai)
#pragma unroll
            for (int m = 0; m < 4; ++m) {
                f32x4 h[2];
#pragma unroll
                for (int n = 0; n < 2; ++n) { const f32x4 g = acc[ai][0][m][n], up = acc[ai][1][m][n];
#pragma unroll
                    for (int j = 0; j < 4; ++j) h[n][j] = g[j] * sigmoidf_(g[j]) * up[j]; }
                *(u32x4*)(base + (size_t)(row0 + ai * HALF + m * 16) * DFF + col0) = pack8(h[0], h[1]); }
    }
};

__device__ __forceinline__ f32x4 deq4(const f32x4 accbits, const float sa, const f32x4 sb) { const v4i32 q = __builtin_bit_cast(v4i32, accbits); return (f32x4){(float)q.x, (float)q.y, (float)q.z, (float)q.w} * sa * sb; }
struct EpiProjQ {
    static constexpr bool PERM = true, AFTER_DRAIN = false;
    bf16_t* Qb; bf16_t* Kb; bf16_t* G; const float* bias; const float* sa; const float* sb;
    __device__ __forceinline__ void operator()(const f32x4 (&acc)[2][2][4][2], const Unit& u, int wr, int wc, int fr, int fq) const {
        const int row0 = u.pm * BM + wr * 64 + fr, cg0 = u.pn * BM + wc * 32 + 8 * fq;
        f32x4 sbv[2][2];
#pragma unroll
        for (int bj = 0; bj < 2; ++bj)
#pragma unroll
            for (int n = 0; n < 2; ++n) sbv[bj][n] = *(const f32x4*)(sb + cg0 + bj * HALF + 4 * n);
        if (u.pn < 8) {
            const int col0 = u.pn * BM + wc * 32 + 8 * fq;
#pragma unroll
            for (int ai = 0; ai < 2; ++ai)
#pragma unroll
                for (int m = 0; m < 4; ++m) { const int row = row0 + ai * HALF + m * 16; const float sr = sa[row]; bf16_t* rowp = Qb + (size_t)row * NAW + col0;
#pragma unroll
                    for (int bj = 0; bj < 2; ++bj) *(u32x4*)(rowp + bj * HALF) = pack8(deq4(acc[ai][bj][m][0], sr, sbv[bj][0]), deq4(acc[ai][bj][m][1], sr, sbv[bj][1])); }
        } else if (u.pn < 16) {
            const int col0 = (u.pn - 8) * BM + wc * 32 + 8 * fq;
#pragma unroll
            for (int ai = 0; ai < 2; ++ai)
#pragma unroll
                for (int m = 0; m < 4; ++m) { const int tok = row0 + ai * HALF + m * 16, R = tok >> 6, cl = tok & 63; const float sr = sa[tok];
                    const int tokpart = (((cl >> 2) & 1) * 8 + (cl >> 3)) * 4 + (cl & 3);
#pragma unroll
                    for (int bj = 0; bj < 2; ++bj) { const int c = col0 + bj * HALF, hh = c >> 7, d0 = c & 127;
                        *(u32x4*)(Kb + ((size_t)(((R * 16 + hh) * 4 + (d0 >> 5)) * 64 + tokpart) * 4 + ((d0 >> 3) & 3)) * 8) = pack8(deq4(acc[ai][bj][m][0], sr, sbv[bj][0]), deq4(acc[ai][bj][m][1], sr, sbv[bj][1])); } }
        } else {
            const int col0 = (u.pn - 16) * BM + wc * 32 + 8 * fq;
            f32x4 bv[2][2];
#pragma unroll
            for (int bj = 0; bj < 2; ++bj)
#pragma unroll
                for (int n = 0; n < 2; ++n) bv[bj][n] = *(const f32x4*)(bias + col0 + bj * HALF + 4 * n);
#pragma unroll
            for (int ai = 0; ai < 2; ++ai)
#pragma unroll
                for (int m = 0; m < 4; ++m) { const int row = row0 + ai * HALF + m * 16; const float sr = sa[row]; bf16_t* rowp = G + (size_t)row * (2 * D) + col0;
#pragma unroll
                    for (int bj = 0; bj < 2; ++bj) *(u32x4*)(rowp + bj * HALF) = pack8(sig4(deq4(acc[ai][bj][m][0], sr, sbv[bj][0]) + bv[bj][0]), sig4(deq4(acc[ai][bj][m][1], sr, sbv[bj][1]) + bv[bj][1])); }
        }
    }
};
struct EpiPlainQ {
    static constexpr bool PERM = true, AFTER_DRAIN = false;
    bf16_t* O; int ldc; const float* sa; const float* sb;
    __device__ __forceinline__ void operator()(const f32x4 (&acc)[2][2][4][2], const Unit& u, int wr, int wc, int fr, int fq) const {
        const int row0 = u.pm * BM + wr * 64 + fr, col0 = u.pn * BM + wc * 32 + 8 * fq;
        f32x4 sbv[2][2];
#pragma unroll
        for (int bj = 0; bj < 2; ++bj)
#pragma unroll
            for (int n = 0; n < 2; ++n) sbv[bj][n] = *(const f32x4*)(sb + col0 + bj * HALF + 4 * n);
#pragma unroll
        for (int ai = 0; ai < 2; ++ai)
#pragma unroll
            for (int m = 0; m < 4; ++m) { const int row = row0 + ai * HALF + m * 16; const float sr = sa[row]; bf16_t* rowp = O + (size_t)row * ldc + col0;
#pragma unroll
                for (int bj = 0; bj < 2; ++bj) *(u32x4*)(rowp + bj * HALF) = pack8(deq4(acc[ai][bj][m][0], sr, sbv[bj][0]), deq4(acc[ai][bj][m][1], sr, sbv[bj][1])); }
    }
};
struct EpiVTQ {
    static constexpr bool PERM = true, AFTER_DRAIN = false;
    bf16_t* O; const float* sa; const float* sb;
    __device__ __forceinline__ void operator()(const f32x4 (&acc)[2][2][4][2], const Unit& u, int wr, int wc, int fr, int fq) const {
        const int row0 = u.pm * BM + wr * 64 + fr, col0 = u.pn * BM + wc * 32 + 8 * fq;
        f32x4 sbv[2][2];
#pragma unroll
        for (int bj = 0; bj < 2; ++bj)
#pragma unroll
            for (int n = 0; n < 2; ++n) sbv[bj][n] = *(const f32x4*)(sb + col0 + bj * HALF + 4 * n);
#pragma unroll
        for (int ai = 0; ai < 2; ++ai)
#pragma unroll
            for (int m = 0; m < 4; ++m) { const int row = row0 + ai * HALF + m * 16, hh = row >> 7, d = row & 127; const float sr = sa[row];
                const int dt = 2 * (d >> 5) + ((d >> 2) & 1), i = 4 * ((d >> 3) & 3) + (d & 3);
#pragma unroll
                for (int bj = 0; bj < 2; ++bj) { const int tok = col0 + bj * HALF, R = tok >> 6, o = (tok & 63) >> 3;
                    *(u32x4*)(O + ((size_t)((((R * 16 + hh) * 8 + dt) * 8 + o) * 16 + i)) * 8) = pack8(deq4(acc[ai][bj][m][0], sr, sbv[bj][0]), deq4(acc[ai][bj][m][1], sr, sbv[bj][1])); } }
    }
};
struct EpiSwigluQ {
    static constexpr bool PERM = true, AFTER_DRAIN = false;
    bf16_t* H0; bf16_t* H1; int pm_split; const float* sa; const float* sb;
    __device__ __forceinline__ void operator()(const f32x4 (&acc)[2][2][4][2], const Unit& u, int wr, int wc, int fr, int fq) const {
        bf16_t* base = u.pm < pm_split ? H0 + (size_t)u.pm * BM * DFF : H1 + (size_t)(u.pm - pm_split) * BM * DFF;
        const int row0 = wr * 64 + fr, col0 = u.pn * HALF + wc * 32 + 8 * fq, cg0 = u.pn * BM + wc * 32 + 8 * fq;
        f32x4 sbv[2][2];
#pragma unroll
        for (int bj = 0; bj < 2; ++bj)
#pragma unroll
            for (int n = 0; n < 2; ++n) sbv[bj][n] = *(const f32x4*)(sb + cg0 + bj * HALF + 4 * n);
#pragma unroll
        for (int ai = 0; ai < 2; ++ai)
#pragma unroll
            for (int m = 0; m < 4; ++m) { const float sr = sa[u.pm * BM + row0 + ai * HALF + m * 16];
                f32x4 h[2];
#pragma unroll
                for (int n = 0; n < 2; ++n) { const f32x4 g = deq4(acc[ai][0][m][n], sr, sbv[0][n]), up = deq4(acc[ai][1][m][n], sr, sbv[1][n]);
#pragma unroll
                    for (int j = 0; j < 4; ++j) h[n][j] = g[j] * sigmoidf_(g[j]) * up[j]; }
                *(u32x4*)(base + (size_t)(row0 + ai * HALF + m * 16) * DFF + col0) = pack8(h[0], h[1]); }
    }
};

__device__ __forceinline__ v8i32 cat8(const bf16x8 lo, const bf16x8 hi) { return __builtin_shufflevector(__builtin_bit_cast(v4i32, lo), __builtin_bit_cast(v4i32, hi), 0, 1, 2, 3, 4, 5, 6, 7); }
__device__ __forceinline__ void mfma_fp8_acc(f32x4& c, const v8i32 a, const v8i32 b, int sa, int sb) {
    asm volatile("v_mfma_scale_f32_16x16x128_f8f6f4 %0, %1, %2, %0, %3, %4 op_sel_hi:[0,0,0]" : "+v"(c) : "v"(a), "v"(b), "v"(sa), "v"(sb)); }
constexpr int FP8_SCALE = 0x73737373;
template <class Epi, class Sched, bool ALIGN_EPI = false, bool SP2 = false, int QM = 0  , int DBG = 0>
__device__ __forceinline__ void gemm_phase(LAS unsigned char* lds, const Gemm g, const Sched& S, const Epi& E) {
    int tid = threadIdx.x; asm volatile("" : "+v"(tid));
    const int wid = __builtin_amdgcn_readfirstlane(tid >> 6), lane = tid & 63, wr = wid >> 2, wc = wid & 3, fr = lane & 15, fq = lane >> 4;
    const int RB = g.rb, nt = RB / (BK * 2);
    unsigned voffA[2], voffB[2];
#pragma unroll
    for (int i = 0; i < 2; ++i) { int R, C; stage_rc(tid * 16 + i * 8192, R, C); const int Rb = Epi::PERM ? ((R & ~31) + perm32(R & 31)) : R;
        voffA[i] = (unsigned)(R * RB + C * 2); voffB[i] = (unsigned)(Rb * RB + C * 2); }
    const size_t kstep = (size_t)(BK * 2);
    const size_t hstep = (size_t)HALF * RB;
    const unsigned ldsw = (unsigned)wid * 1024u;
    const int aoff0 = lds_byte(wr * 64 + fr, fq * 8), aoff1 = lds_byte(wr * 64 + fr, 32 + fq * 8), boff0 = lds_byte(wc * 32 + fr, fq * 8), boff1 = lds_byte(wc * 32 + fr, 32 + fq * 8);
#define PG8_SA(b, h) (((b) * 2 + (h)) * HTB)
#define PG8_SB(b, h) ((4 + (b) * 2 + (h)) * HTB)
#define PG8_STAGE(bufoff, gbase, voff) do { if constexpr (DBG != 3) _Pragma("unroll") for (int _i = 0; _i < 2; ++_i) \
        __builtin_amdgcn_global_load_lds((const unsigned*)((const char*)(gbase) + (voff)[_i]), (LAS unsigned*)(lds + (bufoff) + ldsw + _i * 8192), 16, 0, 0); } while (0)
#define PG8_LDA(dst, b, h) do { if constexpr (DBG != 2) _Pragma("unroll") for (int m = 0; m < 4; ++m) _Pragma("unroll") for (int k = 0; k < 2; ++k) dst[m][k] = *(const LAS bf16x8*)(lds + PG8_SA(b, h) + (k ? aoff1 : aoff0) + m * 2048); } while (0)
#define PG8_LDB(dst, b, h) do { if constexpr (DBG != 2) _Pragma("unroll") for (int n = 0; n < 2; ++n) _Pragma("unroll") for (int k = 0; k < 2; ++k) dst[n][k] = *(const LAS bf16x8*)(lds + PG8_SB(b, h) + (k ? boff1 : boff0) + n * 2048); } while (0)
#define PG8_MMA(ai, bj, At, Bt) do { __builtin_amdgcn_s_setprio(1); if constexpr (DBG == 1) { } else if constexpr (QM == 2) { _Pragma("unroll") for (int m = 0; m < 4; ++m) _Pragma("unroll") for (int n = 0; n < 2; ++n) _Pragma("unroll") for (int k = 0; k < 2; ++k) \
        acc[ai][bj][m][n] = __builtin_bit_cast(f32x4, __builtin_amdgcn_mfma_i32_16x16x64_i8(__builtin_bit_cast(v4i32, Bt[n][k]), __builtin_bit_cast(v4i32, At[m][k]), __builtin_bit_cast(v4i32, acc[ai][bj][m][n]), 0, 0, 0)); } else if constexpr (QM == 1) { _Pragma("unroll") for (int m = 0; m < 4; ++m) _Pragma("unroll") for (int n = 0; n < 2; ++n) \
        mfma_fp8_acc(acc[ai][bj][m][n], cat8(Bt[n][0], Bt[n][1]), cat8(At[m][0], At[m][1]), fp8_sa, fp8_sb); } else { \
        _Pragma("unroll") for (int m = 0; m < 4; ++m) _Pragma("unroll") for (int n = 0; n < 2; ++n) _Pragma("unroll") for (int k = 0; k < 2; ++k) \
        acc[ai][bj][m][n] = __builtin_amdgcn_mfma_f32_16x16x32_bf16(Bt[n][k], At[m][k], acc[ai][bj][m][n], 0, 0, 0); } __builtin_amdgcn_s_setprio(0); } while (0)
#define PG8_WAIT_V(n) asm volatile("s_waitcnt vmcnt(" #n ")" ::: "memory")
#define PG8_WAIT_L(n) asm volatile("s_waitcnt lgkmcnt(" #n ")" ::: "memory")
#define PG8_BAR __builtin_amdgcn_s_barrier()
#define PG8_SCHED __builtin_amdgcn_sched_barrier(0)
    Unit cur, nxt; int ui = 0;
    const int fp8_sa = FP8_SCALE, fp8_sb = 0x7F7F7F7F;
    if (!S.next(0, cur)) return;
    f32x4 acc[2][2][4][2];
#pragma unroll
    for (int a = 0; a < 2; ++a)
#pragma unroll
        for (int b = 0; b < 2; ++b)
#pragma unroll
            for (int m = 0; m < 4; ++m)
#pragma unroll
                for (int n = 0; n < 2; ++n) acc[a][b][m][n] = (f32x4){0.f, 0.f, 0.f, 0.f};
    bf16x8 At[4][2], B0[2][2], B1[2][2];
    const char* cA = g.abase(cur.pm); const char* cB = g.bbase(cur.pn);
    S.a_ready(cur);
    if constexpr (SP2) {
        PG8_STAGE(PG8_SB(0, 0), cB, voffB); PG8_STAGE(PG8_SB(0, 1), cB + hstep, voffB); PG8_STAGE(PG8_SA(0, 0), cA, voffA); PG8_STAGE(PG8_SA(0, 1), cA + hstep, voffA);
        if (wr == 1) PG8_BAR;
        PG8_WAIT_V(2); PG8_BAR;
        PG8_STAGE(PG8_SB(1, 0), cB + kstep, voffB); PG8_STAGE(PG8_SA(1, 0), cA + kstep, voffA); PG8_STAGE(PG8_SB(1, 1), cB + hstep + kstep, voffB);
        PG8_WAIT_V(6); PG8_BAR;
    } else {
        PG8_STAGE(PG8_SB(0, 0), cB, voffB); PG8_STAGE(PG8_SA(0, 0), cA, voffA); PG8_STAGE(PG8_SB(0, 1), cB + hstep, voffB); PG8_STAGE(PG8_SA(0, 1), cA + hstep, voffA);
        if (wr == 1) PG8_BAR;
        PG8_WAIT_V(4); PG8_BAR;
        PG8_STAGE(PG8_SB(1, 0), cB + kstep, voffB); PG8_STAGE(PG8_SA(1, 0), cA + kstep, voffA); PG8_STAGE(PG8_SB(1, 1), cB + hstep + kstep, voffB);
        PG8_WAIT_V(6); PG8_BAR;
    }
    for (;;) {
        const bool has_next = S.next(ui + 1, nxt);
        const char* nA = has_next ? g.abase(nxt.pm) : cA; const char* nB = has_next ? g.bbase(nxt.pn) : cB;
        for (int t = 0; t < nt; t += 2) {
            const bool last = (t == nt - 2);
            const char* a1 = cA + (size_t)(t + 1) * kstep;
            const char* a2 = last ? nA : cA + (size_t)(t + 2) * kstep; const char* b2 = last ? nB : cB + (size_t)(t + 2) * kstep;
            const char* a3 = a2 + kstep; const char* b3 = b2 + kstep;
            if (last && has_next) S.a_ready(nxt);
            if constexpr (SP2) {
            PG8_LDB(B0, 0, 0); PG8_LDB(B1, 0, 1); PG8_SCHED; PG8_LDA(At, 0, 0); PG8_STAGE(PG8_SA(1, 1), a1 + hstep, voffA);
            PG8_WAIT_V(8); PG8_WAIT_L(0); PG8_BAR; PG8_MMA(0, 0, At, B0); PG8_MMA(0, 1, At, B1); PG8_BAR; PG8_SCHED;
            PG8_LDA(At, 0, 1); PG8_STAGE(PG8_SB(0, 0), b2, voffB); PG8_STAGE(PG8_SB(0, 1), b2 + hstep, voffB); PG8_STAGE(PG8_SA(0, 0), a2, voffA);
            PG8_WAIT_V(8); PG8_WAIT_L(0); PG8_BAR; PG8_MMA(1, 0, At, B0); PG8_MMA(1, 1, At, B1); PG8_BAR; PG8_SCHED;
            PG8_LDB(B0, 1, 0); PG8_LDB(B1, 1, 1); PG8_SCHED; PG8_LDA(At, 1, 0); PG8_STAGE(PG8_SA(0, 1), a2 + hstep, voffA);
            PG8_WAIT_V(8); PG8_WAIT_L(0); PG8_BAR; PG8_MMA(0, 0, At, B0); PG8_MMA(0, 1, At, B1); PG8_BAR; PG8_SCHED;
            PG8_LDA(At, 1, 1); PG8_STAGE(PG8_SB(1, 0), b3, voffB); PG8_STAGE(PG8_SB(1, 1), b3 + hstep, voffB); PG8_STAGE(PG8_SA(1, 0), a3, voffA);
            PG8_WAIT_V(8); PG8_WAIT_L(0); PG8_BAR; PG8_MMA(1, 0, At, B0); PG8_MMA(1, 1, At, B1); PG8_BAR; PG8_SCHED;
            } else {
            PG8_LDB(B0, 0, 0); PG8_SCHED; PG8_LDA(At, 0, 0); PG8_STAGE(PG8_SA(1, 1), a1 + hstep, voffA);
            PG8_WAIT_L(8); PG8_BAR; PG8_WAIT_L(0); PG8_MMA(0, 0, At, B0); PG8_BAR; PG8_SCHED;
            PG8_LDB(B1, 0, 1); PG8_STAGE(PG8_SB(0, 0), b2, voffB);
            PG8_BAR; PG8_WAIT_L(0); PG8_MMA(0, 1, At, B1); PG8_BAR;
            PG8_LDA(At, 0, 1); PG8_STAGE(PG8_SA(0, 0), a2, voffA);
            PG8_BAR; PG8_WAIT_L(0); PG8_MMA(1, 0, At, B0); PG8_BAR; PG8_SCHED;
            PG8_STAGE(PG8_SB(0, 1), b2 + hstep, voffB);
            PG8_WAIT_V(6); PG8_BAR; PG8_MMA(1, 1, At, B1); PG8_BAR;
            PG8_LDB(B0, 1, 0); PG8_SCHED; PG8_LDA(At, 1, 0); PG8_STAGE(PG8_SA(0, 1), a2 + hstep, voffA);
            PG8_WAIT_L(8); PG8_BAR; PG8_WAIT_L(0); PG8_MMA(0, 0, At, B0); PG8_BAR; PG8_SCHED;
            PG8_LDB(B1, 1, 1); PG8_STAGE(PG8_SB(1, 0), b3, voffB);
            PG8_BAR; PG8_WAIT_L(0); PG8_MMA(0, 1, At, B1); PG8_BAR;
            PG8_LDA(At, 1, 1); PG8_STAGE(PG8_SA(1, 0), a3, voffA);
            PG8_BAR; PG8_WAIT_L(0); PG8_MMA(1, 0, At, B0); PG8_BAR; PG8_SCHED;
            PG8_STAGE(PG8_SB(1, 1), b3 + hstep, voffB);
            PG8_WAIT_V(6); PG8_BAR; PG8_MMA(1, 1, At, B1); PG8_BAR;
            }
        }
        if constexpr (ALIGN_EPI) { if (wr == 0) PG8_BAR; }
        if constexpr (!Epi::AFTER_DRAIN) { if constexpr (DBG != 4) E(acc, cur, wr, wc, fr, fq); else { _Pragma("unroll") for (int a_ = 0; a_ < 2; ++a_) _Pragma("unroll") for (int b_ = 0; b_ < 2; ++b_) _Pragma("unroll") for (int m_ = 0; m_ < 4; ++m_) _Pragma("unroll") for (int n_ = 0; n_ < 2; ++n_) asm volatile("" :: "v"(acc[a_][b_][m_][n_])); } S.done(cur); }
        if (!has_next) break;
#pragma unroll
        for (int a = 0; a < 2; ++a)
#pragma unroll
            for (int b = 0; b < 2; ++b)
#pragma unroll
                for (int m = 0; m < 4; ++m)
#pragma unroll
                    for (int n = 0; n < 2; ++n) acc[a][b][m][n] = (f32x4){0.f, 0.f, 0.f, 0.f};
        cur = nxt; cA = nA; cB = nB; ++ui;
        if constexpr (ALIGN_EPI) { if (wr == 1) PG8_BAR; }
    }
    PG8_WAIT_V(0);
    if constexpr (!ALIGN_EPI) { if (wr == 0) PG8_BAR; }
    PG8_BAR;
    if constexpr (Epi::AFTER_DRAIN) { E.fused(acc, cur, wr, wc, fr, fq, lds, wid, lane); S.done(cur); }
#undef PG8_SA
#undef PG8_SB
#undef PG8_STAGE
#undef PG8_LDA
#undef PG8_LDB
#undef PG8_MMA
#undef PG8_WAIT_V
#undef PG8_WAIT_L
#undef PG8_BAR
#undef PG8_SCHED
}
}
#define XB_TMO      128
#define XB_XCNT(j)  (256  + 64 * (j))
#define XB_XSUB(j)  (1280 + 64 * (j))
#define XB_XGEN(j)  (2304 + 64 * (j))
#define XB_TOP      3328
#define XB_TOPGEN   3392
#define XCD_BAR_WORDS 3456
#define XB_SPIN_CAP (1u << 18)

__device__ __forceinline__ unsigned xb_ld(unsigned* p)              { return __hip_atomic_load(p, __ATOMIC_RELAXED, __HIP_MEMORY_SCOPE_AGENT); }
__device__ __forceinline__ unsigned xb_add(unsigned* p, unsigned v) { return __hip_atomic_fetch_add(p, v, __ATOMIC_RELAXED, __HIP_MEMORY_SCOPE_AGENT); }
__device__ __forceinline__ unsigned xb_xcc_id() { return (unsigned)__builtin_amdgcn_s_getreg((3 << 11) | 20) & 0xFu; }
#define XB_SPIN(cond, bar) do { unsigned _sp = 0; while (cond) { __builtin_amdgcn_s_sleep(1); \
    if ((++_sp & 255u) == 0u) { if (xb_ld(&(bar)[XB_TMO])) break; if (_sp > XB_SPIN_CAP) { atomicAdd(&(bar)[XB_TMO], 1u); break; } } } } while (0)

struct XcdBarrier {
    unsigned* bar; unsigned x;
    volatile LAS unsigned* st;
};

__device__ __forceinline__ XcdBarrier xcd_barrier_post(unsigned* bar, volatile LAS unsigned* st) {
    XcdBarrier b; b.bar = bar; b.x = xb_xcc_id(); b.st = st;
    if (threadIdx.x == 0) (void)xb_add(&bar[XB_XCNT(b.x)], 1u);
    return b;
}
__device__ __forceinline__ void xcd_barrier_complete(unsigned* bar, unsigned x, unsigned& nloc, unsigned& nx) {
    const unsigned G = gridDim.x * gridDim.y * gridDim.z;
    unsigned sum, cnt, mine, sp = 0u;
    for (;;) {
        sum = 0u; cnt = 0u; mine = 0u;
#pragma unroll
        for (unsigned j = 0; j < 16; ++j) { const unsigned c = xb_ld(&bar[XB_XCNT(j)]); sum += c; cnt += (c > 0u) ? 1u : 0u; mine = (j == x) ? c : mine; }
        if (sum == G) break;
        __builtin_amdgcn_s_sleep(1);
        if ((++sp & 255u) == 0u) { if (xb_ld(&bar[XB_TMO])) break; if (sp > XB_SPIN_CAP) { atomicAdd(&bar[XB_TMO], 1u); break; } }
    }
    nloc = mine > 0u ? mine : 1u; nx = cnt > 0u ? cnt : 1u;
}

__device__ __forceinline__ void xcd_barrier(const XcdBarrier& b) {
    asm volatile("s_waitcnt vmcnt(0)" ::: "memory");
    __syncthreads();
    if (threadIdx.x == 0) {
        unsigned* bar = b.bar;
        __builtin_amdgcn_s_waitcnt(0);
        unsigned nloc = b.st[0], nx = b.st[1];
        if (nloc == 0u) { xcd_barrier_complete(bar, b.x, nloc, nx); b.st[0] = nloc; b.st[1] = nx; }
        const unsigned old = xb_add(&bar[XB_XSUB(b.x)], 1u);
        const unsigned gen = old / nloc;
        if (old + 1u == (gen + 1u) * nloc) {
            __builtin_amdgcn_fence(__ATOMIC_RELEASE, "agent");
            asm volatile("s_waitcnt vmcnt(0)" ::: "memory");
            const unsigned og = xb_add(&bar[XB_TOP], 1u);
            const unsigned tg = og / nx;
            if (og + 1u == (tg + 1u) * nx) xb_add(&bar[XB_TOPGEN], 1u);
            else XB_SPIN(xb_ld(&bar[XB_TOPGEN]) == tg, bar);
            __builtin_amdgcn_fence(__ATOMIC_ACQUIRE, "agent");
            xb_add(&bar[XB_XGEN(b.x)], 1u);
            asm volatile("s_waitcnt vmcnt(0)" ::: "memory");
        } else {
            XB_SPIN(xb_ld(&bar[XB_XGEN(b.x)]) == gen, bar);
            __builtin_amdgcn_fence(__ATOMIC_ACQUIRE, "agent");
            asm volatile("s_waitcnt vmcnt(0)" ::: "memory");
        }
    }
    __syncthreads();
}


struct Frame {
    LAS unsigned char* lds;
    int tid, lane, wave, G, gw, ngw;
    const float *in_XP, *in_XS, *in_WIN, *in_WCONV, *in_BCONV, *in_WR, *in_BR, *in_WI, *in_BI, *in_LAM, *in_RPB, *in_WNO, *in_WLO, *in_WM, *in_BM, *in_WOUT, *in_GMPRE, *in_GMPOST, *in_GFPRE, *in_GFPOST, *in_WFG, *in_WFU, *in_WFD; float* out; unsigned char* ws;
};
enum { I_XP = 0, I_XS, I_WIN, I_WCONV, I_BCONV, I_WR, I_BR, I_WI, I_BI, I_LAM, I_RPB, I_WNO, I_WLO, I_WM, I_BM, I_WOUT, I_GMPRE, I_GMPOST, I_GFPRE, I_GFPOST, I_WFG, I_WFU, I_WFD };
__device__ __forceinline__ int opaque(int x) { asm volatile("" : "+v"(x)); return x; }
template <class T> __device__ __forceinline__ T* wsp(const Frame& F, size_t off) { return (T*)(F.ws + off); }
__device__ __forceinline__ const float* xrow(const Frame& F, int m) { return m < LP ? F.in_XP + (size_t)m * D : F.in_XS + (size_t)(m - LP) * D; }

__device__ __forceinline__ void tr_item(const float* src, int ldsrc, int k0, int n0, bf16_t* dst, int ldd, int drow0, LAS float* scr, int lane) {
#pragma unroll 8
    for (int i = 0; i < 32; ++i) { const int kk = 2 * i + (lane >> 5); scr[kk * 33 + (lane & 31)] = src[(size_t)(k0 + kk) * ldsrc + n0 + (lane & 31)]; }
    LDS_WAIT(); asm volatile("" ::: "memory");
    const int c = lane & 7;
#pragma unroll
    for (int j = 0; j < 4; ++j) { const int n = (lane >> 3) + 8 * j; const LAS float* s = scr + (8 * c) * 33 + n;
        u32x4 o; o.x = pk2(s[0 * 33], s[1 * 33]); o.y = pk2(s[2 * 33], s[3 * 33]); o.z = pk2(s[4 * 33], s[5 * 33]); o.w = pk2(s[6 * 33], s[7 * 33]);
        *(u32x4*)(dst + (size_t)(drow0 + n) * ldd + k0 + 8 * c) = o; }
    LDS_WAIT(); asm volatile("" ::: "memory");
}
__device__ __forceinline__ unsigned pk4_fp8(float a, float b, float c, float d) { int p = __builtin_amdgcn_cvt_pk_fp8_f32(a, b, 0, false); p = __builtin_amdgcn_cvt_pk_fp8_f32(c, d, p, true); return (unsigned)p; }
__device__ __forceinline__ void tr_item8(const float* src, int ldsrc, int k0, int n0, unsigned char* dst, int ldd, int drow0, LAS float* scr, int lane) {
#pragma unroll 8
    for (int i = 0; i < 32; ++i) { const int kk = 2 * i + (lane >> 5); scr[kk * 33 + (lane & 31)] = src[(size_t)(k0 + kk) * ldsrc + n0 + (lane & 31)]; }
    LDS_WAIT(); asm volatile("" ::: "memory");
    const int c = lane & 7;
#pragma unroll
    for (int j = 0; j < 4; ++j) { const int n = (lane >> 3) + 8 * j; const LAS float* s = scr + (8 * c) * 33 + n;
        u32x2 o; o.x = pk4_fp8(s[0 * 33] * 256.f, s[1 * 33] * 256.f, s[2 * 33] * 256.f, s[3 * 33] * 256.f); o.y = pk4_fp8(s[4 * 33] * 256.f, s[5 * 33] * 256.f, s[6 * 33] * 256.f, s[7 * 33] * 256.f);
        *(u32x2*)(dst + (size_t)(drow0 + n) * ldd + k0 + 8 * c) = o; }
    LDS_WAIT(); asm volatile("" ::: "memory");
}
__device__ __forceinline__ unsigned pk4_i8(float a, float b, float c, float d) { return ((unsigned)(int)a & 255u) | (((unsigned)(int)b & 255u) << 8) | (((unsigned)(int)c & 255u) << 16) | ((unsigned)(int)d << 24); }
__device__ __forceinline__ void tr_strip_i8(const float* src, int ldsrc, int K, int kb, int ke, int n0, signed char* dst, int drow0, float* cs, LAS float* scr, LAS float* red, int lane, int wave) {
    const float* sp = src + n0 + (lane & 31) + (size_t)(kb + (lane >> 5)) * ldsrc;
    float mx = 0.f;
    { const float* p = sp; const size_t step = (size_t)2 * ldsrc;
      for (int k0 = kb; k0 < ke; k0 += 64) {
        float t[32];
#pragma unroll
        for (int i = 0; i < 32; ++i) { t[i] = *p; p += step; }
#pragma unroll
        for (int i = 0; i < 32; ++i) mx = fmaxf(mx, fabsf(t[i]));
      } }
    mx = fmaxf(mx, __shfl_xor(mx, 32));
    if (lane < 32) red[wave * 32 + lane] = mx;
    LDS_WAIT(); __syncthreads();
    float amax = 1e-20f;
#pragma unroll
    for (int w_ = 0; w_ < NWAVES; ++w_) amax = fmaxf(amax, red[w_ * 32 + (lane & 31)]);
    const float inv = 127.0f / amax;
    if (wave == 0 && lane < 32) cs[drow0 + lane] = amax * (1.0f / 127.0f);
    const int c = lane & 7;
    for (int k0 = kb; k0 < ke; k0 += 64) {
        { const float* p = sp + (size_t)(k0 - kb) * ldsrc; const size_t step = (size_t)2 * ldsrc; LAS float* w = scr + (lane >> 5) * 33 + (lane & 31);
          float t[32];
#pragma unroll
          for (int i = 0; i < 32; ++i) { t[i] = *p; p += step; }
#pragma unroll
          for (int i = 0; i < 32; ++i) w[i * 66] = rintf(t[i] * inv); }
        LDS_WAIT(); asm volatile("" ::: "memory");
#pragma unroll
        for (int j = 0; j < 4; ++j) { const int n = (lane >> 3) + 8 * j; const LAS float* t = scr + (8 * c) * 33 + n;
            u32x2 o; o.x = pk4_i8(t[0 * 33], t[1 * 33], t[2 * 33], t[3 * 33]); o.y = pk4_i8(t[4 * 33], t[5 * 33], t[6 * 33], t[7 * 33]);
            *(u32x2*)(dst + (size_t)(drow0 + n) * K + k0 + 8 * c) = o; }
        LDS_WAIT(); asm volatile("" ::: "memory");
    }
    __syncthreads();
}
__device__ __forceinline__ void fwht32(float (&v)[32]) {
#pragma unroll
    for (int st = 1; st < 32; st <<= 1)
#pragma unroll
        for (int i = 0; i < 32; ++i) if (!(i & st)) { const float a = v[i], b = v[i + st]; v[i] = a + b; v[i + st] = a - b; }
#pragma unroll
    for (int i = 0; i < 32; ++i) v[i] *= 0.17677669529663687f;
}
__device__ __forceinline__ void had_tile_load(const float* src, int ldsrc, int k0, int n0, LAS float* scr, int lane, float (&v)[32]) {
    { const float* p = src + (size_t)(k0 + (lane >> 5)) * ldsrc + n0 + (lane & 31); const size_t step = (size_t)2 * ldsrc; LAS float* w = scr + (lane >> 5) * 33 + (lane & 31); float t[32];
#pragma unroll
      for (int i = 0; i < 32; ++i) { t[i] = *p; p += step; }
#pragma unroll
      for (int i = 0; i < 32; ++i) w[i * 66] = t[i]; }
    LDS_WAIT(); asm volatile("" ::: "memory");
    const LAS float* hv = scr + (32 * (lane >> 5)) * 33 + (lane & 31);
#pragma unroll
    for (int i = 0; i < 32; ++i) v[i] = hv[i * 33];
    fwht32(v);
}
__device__ __forceinline__ void had_tile_amax(const float* src, int ldsrc, int k0, int n0, unsigned* am, LAS float* scr, int lane) {
    float v[32]; had_tile_load(src, ldsrc, k0, n0, scr, lane, v);
    float mx = 0.f;
#pragma unroll
    for (int i = 0; i < 32; ++i) mx = fmaxf(mx, fabsf(v[i]));
    mx = fmaxf(mx, __shfl_xor(mx, 32));
    if (lane < 32) atomicMax(am + n0 + lane, __builtin_bit_cast(unsigned, mx));
    LDS_WAIT(); asm volatile("" ::: "memory");
}
__device__ __forceinline__ void had_tile_quant(const float* src, int ldsrc, int K, int k0, int n0, signed char* dst, const unsigned* am, float* cs, LAS float* scr, int lane) {
    const float amax = fmaxf(__builtin_bit_cast(float, am[n0 + (lane & 31)]), 1e-20f), inv = 127.0f / amax;
    if (k0 == 0 && lane < 32) cs[n0 + lane] = amax * (1.0f / 127.0f);
    float v[32]; had_tile_load(src, ldsrc, k0, n0, scr, lane, v);
    LAS float* hv = scr + (32 * (lane >> 5)) * 33 + (lane & 31);
#pragma unroll
    for (int i = 0; i < 32; ++i) hv[i * 33] = rintf(v[i] * inv);
    LDS_WAIT(); asm volatile("" ::: "memory");
    const int c = lane & 7;
#pragma unroll
    for (int j = 0; j < 4; ++j) { const int n = (lane >> 3) + 8 * j; const LAS float* t = scr + (8 * c) * 33 + n;
        u32x2 o; o.x = pk4_i8(t[0 * 33], t[1 * 33], t[2 * 33], t[3 * 33]); o.y = pk4_i8(t[4 * 33], t[5 * 33], t[6 * 33], t[7 * 33]);
        *(u32x2*)(dst + (size_t)(n0 + n) * K + k0 + 8 * c) = o; }
    LDS_WAIT(); asm volatile("" ::: "memory");
}
#define TR_JOB(SRC, LDSRC, KK, NN, DST, DROW_EXPR) { const int nblk = (NN) / 32, nit = ((KK) / 64) * nblk; \
    if (r < nit) { const int kb = r / nblk, nb = r % nblk, n0 = 32 * nb; tr_item((SRC), (LDSRC), 64 * kb, n0, (DST), (KK), (DROW_EXPR), scr, F.lane); continue; } r -= nit; }
#define TR_JOB8(SRC, LDSRC, KK, NN, DST, DROW_EXPR) { const int nblk = (NN) / 32, nit = ((KK) / 64) * nblk; \
    if (r < nit) { const int kb = r / nblk, nb = r % nblk, n0 = 32 * nb; tr_item8((SRC), (LDSRC), 64 * kb, n0, (DST), (KK), (DROW_EXPR), scr, F.lane); continue; } r -= nit; }

__device__ __forceinline__ void p0_prologue(Frame& F) {
    const int tid_ = opaque(F.tid);
    LAS float* scr = (LAS float*)(F.lds + F.wave * 8448);
    const float* w_in = F.in_WIN;
    bf16_t* WCAT = wsp<bf16_t>(F, WS_WCAT); signed char* W8 = wsp<signed char>(F, WS_W8); signed char* WV8 = wsp<signed char>(F, WS_WVT); signed char* WGU8 = wsp<signed char>(F, WS_WGU);
    float* CS = wsp<float>(F, WS_CS);
    constexpr int NSM = 64;
    constexpr int IT_SM = 2 * 4;
    constexpr int S_Q = NAW / 32, S_M = 2 * D / 32, S_F = DFF / 32;
    constexpr int NSTRIP = 3 * S_Q + S_M + 2 * S_F;
    constexpr int N_AMAX = (DFF / 64) * (D / 32);
    constexpr int N_BIG = 2 * (D / 64) * (NAW / 32) + 2 * (NAW / 64) * (D / 32) + (D / 64) * (D / 32) + N_AMAX;
    constexpr int NITEMS = N_BIG + NSM * IT_SM;
    LAS float* red = (LAS float*)(F.lds + 68608);
    for (int it = blockIdx.x; it < NSTRIP; it += F.G) {
        {
            int q = it; const float* src; int ld, n0, drow0; signed char* dst; float* cs;
            if (q < S_Q) { src = w_in; ld = INW; n0 = 32 * q; dst = W8; drow0 = n0; cs = CS + CS_QKM; }
            else if ((q -= S_Q) < S_Q) { src = w_in + NAW; ld = INW; n0 = 32 * q; dst = W8; drow0 = 2048 + n0; cs = CS + CS_QKM; }
            else if ((q -= S_Q) < S_M) { src = F.in_WM; ld = 2 * D; n0 = 32 * q; dst = W8; drow0 = 4096 + n0; cs = CS + CS_QKM; }
            else if ((q -= S_M) < S_Q) { src = w_in + 2 * NAW; ld = INW; n0 = 32 * q; dst = WV8; drow0 = n0; cs = CS + CS_V; }
            else if ((q -= S_Q) < S_F) { src = F.in_WFG; ld = DFF; n0 = 32 * q; dst = WGU8; drow0 = (n0 >> 7) * 256 + (n0 & 127); cs = CS + CS_GU; }
            else { q -= S_F; src = F.in_WFU; ld = DFF; n0 = 32 * q; dst = WGU8; drow0 = (n0 >> 7) * 256 + 128 + (n0 & 127); cs = CS + CS_GU; }
            tr_strip_i8(src, ld, D, F.wave * (D / NWAVES), (F.wave + 1) * (D / NWAVES), n0, dst, drow0, cs, scr, red, F.lane, F.wave);
        }
    }
    for (int it = F.gw; it < NITEMS; it += F.ngw) {
        int r = it;
        TR_JOB(w_in + 3 * NAW, INW, D, NAW, WCAT, 0 + n0)
        TR_JOB(w_in + 4 * NAW, INW, D, NAW, WCAT, 2048 + n0)
        TR_JOB(F.in_WNO, D, NAW, D, wsp<bf16_t>(F, WS_WNO), n0)
        TR_JOB(F.in_WLO, D, LW, D, wsp<bf16_t>(F, WS_WLO), n0)
        TR_JOB(F.in_WOUT, D, D, D, wsp<bf16_t>(F, WS_WO), n0)
        if (r < N_AMAX) { had_tile_amax(F.in_WFD, D, 64 * (r / (D / 32)), 32 * (r % (D / 32)), (unsigned*)(F.ws + WS_AM), scr, F.lane); continue; } r -= N_AMAX;
        {
            const int mi = r / IT_SM, ri = r % IT_SM, d = mi >> 5, g = (mi >> 4) & 1, n = mi & 15, kb = ri >> 2, nb = ri & 3;
            const float* src = (g ? F.in_WI : F.in_WR) + (size_t)(d * NBLK + n) * BW * BW;
            tr_item(src, BW, 64 * kb, 32 * nb, wsp<bf16_t>(F, WS_WG) + (size_t)mi * BW * BW, BW, 32 * nb, scr, F.lane);
        }
    }
    LAS f32x4* gl = (LAS f32x4*)(F.lds + 69632);
    for (int i = tid_; i < D / 4; i += NTHR) gl[i] = ((const f32x4*)F.in_GMPRE)[i];
    __syncthreads();
    bf16_t* XN = wsp<bf16_t>(F, WS_XN); signed char* XN8 = wsp<signed char>(F, WS_XN8); float* RS1 = wsp<float>(F, WS_RS1);
    for (int m = F.gw; m < L; m += F.ngw) {
        asm volatile("" ::: "memory");
        const f32x4* xr = (const f32x4*)xrow(F, m) + F.lane;
        f32x4 v[16]; float s = 0.f;
#pragma unroll
        for (int j = 0; j < 16; ++j) { v[j] = xr[64 * j]; s += (v[j].x * v[j].x + v[j].y * v[j].y) + (v[j].z * v[j].z + v[j].w * v[j].w); }
        const float rstd = 1.0f / sqrtf(wave_sum(s) * (1.0f / D) + EPS);
        u32x2* o8 = (u32x2*)(XN + (size_t)m * D) + F.lane; unsigned* o4 = (unsigned*)(XN8 + (size_t)m * D) + F.lane;
        float mx = 0.f;
#pragma unroll
        for (int j = 0; j < 16; ++j) { v[j] = v[j] * rstd * gl[F.lane + 64 * j]; mx = fmaxf(fmaxf(mx, fmaxf(fabsf(v[j].x), fabsf(v[j].y))), fmaxf(fabsf(v[j].z), fabsf(v[j].w))); }
        const float amax = fmaxf(wave_max(mx), 1e-20f), inv = 127.0f / amax;
        if (F.lane == 0) RS1[m] = amax * (1.0f / 127.0f);
#pragma unroll
        for (int j = 0; j < 16; ++j) { const f32x4 y = v[j]; u32x2 o; o.x = pk2(y.x, y.y); o.y = pk2(y.z, y.w); o8[64 * j] = o;
            o4[64 * j] = pk4_i8(rintf(y.x * inv), rintf(y.y * inv), rintf(y.z * inv), rintf(y.w * inv)); }
    }
    __syncthreads();
}

#ifndef ATT_SYNC
#define ATT_SYNC 1
#endif
template <int ADBG = 0> __device__ __forceinline__ void attn_mfma(Frame& F) {
    const int tid_ = opaque(F.tid);
    bf16_t* Q = wsp<bf16_t>(F, WS_Q); const bf16_t* Kb = wsp<bf16_t>(F, WS_K); const bf16_t* VT = wsp<bf16_t>(F, WS_VT);
    LAS float* rp = (LAS float*)F.lds;
    for (int i = tid_; i < NH * 15 * 31; i += NTHR) rp[i] = F.in_RPB[i];
    __syncthreads();
    const int fr = F.lane & 15, fq = F.lane >> 4;
    const float scale = 0.08838834764831845f;
    for (int base = blockIdx.x * NWAVES; base < (L / GRIDW) * NH * 4; base += F.ngw) {
        const int item = base + F.wave;
        asm volatile("" ::: "memory");
        const int g = item & 3, h = (item >> 2) & 15, rg = item >> 6;
        const int s0 = rg < LP / GRIDW ? 0 : LP, rows = rg < LP / GRIDW ? LP / GRIDW : LS / GRIDW, r = rg < LP / GRIDW ? rg : rg - LP / GRIDW;
        int rs = r - 4; rs = rs < 0 ? 0 : (rs > rows - 8 ? rows - 8 : rs);
        const int w0 = g == 0 ? 0 : (g == 1 ? 8 : (g == 2 ? 24 : 32));
        const int c = 16 * g + fr;
        int cs = c - 8; cs = cs < 0 ? 0 : (cs > GRIDW - 16 ? GRIDW - 16 : cs);
        bf16_t* qrow = Q + (size_t)(s0 + r * GRIDW + c) * NAW + h * HD;
        bf16x8 qf[4];
#pragma unroll
        for (int s = 0; s < 4; ++s) qf[s] = *(const bf16x8*)(qrow + 8 * fq + 32 * s);
        f32x4 sacc[8][2];
        const int Rg = s0 / GRIDW + rs, p0 = w0 >> 3;
        const bf16_t* kbase = Kb + (size_t)(Rg * 16 + h) * 8192 + p0 * 128 + fr * 32 + fq * 8;
        bf16x8 kb[8][2][4];
#define ATT_LDK(kr) do { _Pragma("unroll") for (int T = 0; T < 2; ++T) _Pragma("unroll") for (int s = 0; s < 4; ++s) kb[kr][T][s] = (ADBG & 1) ? qf[s] : (ADBG & 4) ? *(const bf16x8*)(Kb + (size_t)(s0 + rs * GRIDW) * NAW + h * HD * GRIDW + ((kr) * 8 + T * 4 + s) * 512 + F.lane * 8) : *(const bf16x8*)(kbase + (size_t)(kr) * (16 * 8192) + (s * 2 + T) * 1024); } while (0)
        ATT_LDK(0); ATT_LDK(1);
#pragma unroll
        for (int kr = 0; kr < 8; ++kr) {
            if (ATT_SYNC && (kr & 1) == 0) __builtin_amdgcn_s_barrier();
            if (kr + 2 < 8) ATT_LDK(kr + 2);
            __builtin_amdgcn_sched_barrier(0);
#pragma unroll
            for (int T = 0; T < 2; ++T) { f32x4 a = (f32x4){0.f, 0.f, 0.f, 0.f};
#pragma unroll
                for (int s = 0; s < 4; ++s) a = __builtin_amdgcn_mfma_f32_16x16x32_bf16(kb[kr][T][s], qf[s], a, 0, 0, 0);
                sacc[kr][T] = a; }
            __builtin_amdgcn_sched_barrier(0);
        }
#undef ATT_LDK
        bf16x8 vb[8][8];
        const bf16_t* vbase = VT + (size_t)(Rg * 16 + h) * 8192 + p0 * 128 + fq * 128 + fr * 8;
#define ATT_LDV(kr) do { _Pragma("unroll") for (int dt = 0; dt < 8; ++dt) vb[kr][dt] = (ADBG & 2) ? qf[dt & 3] : (ADBG & 4) ? *(const bf16x8*)(VT + (size_t)(h * HD) * L + s0 + rs * GRIDW + ((kr) * 8 + dt) * 512 + F.lane * 8) : *(const bf16x8*)(vbase + (size_t)(kr) * (16 * 8192) + dt * 1024); } while (0)
        ATT_LDV(0); ATT_LDV(1);
        __builtin_amdgcn_sched_barrier(0);
        const int elo = cs - w0 - 8 * fq, dc0 = w0 + 8 * fq - c + 15;
        const LAS float* rph = rp + h * 465 + (rs - r + 7) * 31;
        float mx = -3.0e38f;
#pragma unroll
        for (int e = 0; e < 8; ++e) { const bool valid = (e >= elo) && (e < elo + 16); const int bi = valid ? dc0 + e : 0;
#pragma unroll
            for (int kr = 0; kr < 8; ++kr) { const float sv = valid ? sacc[kr][e >> 2][e & 3] * scale + rph[kr * 31 + bi] : -3.0e38f; sacc[kr][e >> 2][e & 3] = sv; mx = fmaxf(mx, sv); } }
        mx = fmaxf(mx, __shfl_xor(mx, 16)); mx = fmaxf(mx, __shfl_xor(mx, 32));
        float lsum = 0.f; bf16x8 pf[8];
#pragma unroll
        for (int kr = 0; kr < 8; ++kr) { float p[8];
#pragma unroll
            for (int e = 0; e < 8; ++e) { p[e] = __expf(sacc[kr][e >> 2][e & 3] - mx); lsum += p[e]; }
            u32x4 w; w.x = pk2(p[0], p[1]); w.y = pk2(p[2], p[3]); w.z = pk2(p[4], p[5]); w.w = pk2(p[6], p[7]);
            pf[kr] = __builtin_bit_cast(bf16x8, w); }
        lsum += __shfl_xor(lsum, 16); lsum += __shfl_xor(lsum, 32);
        f32x4 oacc[8];
#pragma unroll
        for (int dt = 0; dt < 8; ++dt) oacc[dt] = (f32x4){0.f, 0.f, 0.f, 0.f};
#pragma unroll
        for (int kr = 0; kr < 8; ++kr) {
            if (ATT_SYNC && (kr & 1) == 0) __builtin_amdgcn_s_barrier();
            if (kr + 2 < 8) ATT_LDV(kr + 2);
            __builtin_amdgcn_sched_barrier(0);
#pragma unroll
            for (int dt = 0; dt < 8; ++dt) oacc[dt] = __builtin_amdgcn_mfma_f32_16x16x32_bf16(vb[kr][dt], pf[kr], oacc[dt], 0, 0, 0);
            __builtin_amdgcn_sched_barrier(0);
        }
#undef ATT_LDV
        const float inv = 1.0f / lsum;
#ifdef ATTN_OUT_OFF
        bf16_t* orow = wsp<bf16_t>(F, (size_t)ATTN_OUT_OFF * MiB) + (size_t)(s0 + r * GRIDW + c) * NAW + h * HD;
#else
        bf16_t* orow = qrow;
#endif
#pragma unroll
        for (int u = 0; u < 4; ++u) *(u32x4*)(orow + 32 * u + 8 * fq) = pg8::pack8(oacc[2 * u] * inv, oacc[2 * u + 1] * inv);
    }
    __syncthreads();
}

__device__ __forceinline__ void attn_mfma_lds(Frame& F) {
    const int tid_ = opaque(F.tid);
    bf16_t* Q = wsp<bf16_t>(F, WS_Q); const bf16_t* Kb = wsp<bf16_t>(F, WS_K); const bf16_t* VT = wsp<bf16_t>(F, WS_VT);
    LAS float* rp = (LAS float*)F.lds;
    LAS unsigned char* ring = F.lds + 30720;
    for (int i = tid_; i < NH * 15 * 31; i += NTHR) rp[i] = F.in_RPB[i];
    __syncthreads();
    const int lane = tid_ & 63, fr = lane & 15, fq = lane >> 4, w = F.wave, hl = w >> 2, g = w & 3;
    const float scale = 0.08838834764831845f;
    constexpr int NIT = (L / GRIDW) * NH * 4;
    const int w0 = g == 0 ? 0 : (g == 1 ? 8 : (g == 2 ? 24 : 32)), p0 = w0 >> 3;
    const int c = 16 * g + fr;
    int cs = c - 8; cs = cs < 0 ? 0 : (cs > GRIDW - 16 ? GRIDW - 16 : cs);
#define ATL_SRC(b, st) ([&]() -> const bf16_t* { const int rg_ = (b) >> 6, hb_ = ((b) >> 2) & 15; const int rows_ = rg_ < LP / GRIDW ? LP / GRIDW : LS / GRIDW, r_ = rg_ < LP / GRIDW ? rg_ : rg_ - LP / GRIDW; \
        int rs_ = r_ - 4; rs_ = rs_ < 0 ? 0 : (rs_ > rows_ - 8 ? rows_ - 8 : rs_); const int Rg_ = (rg_ < LP / GRIDW ? 0 : LP / GRIDW) + rs_; \
        return ((st) < 8 ? Kb : VT) + (size_t)((Rg_ + ((st) & 7)) * 16 + hb_) * 8192; }())
#define ATL_ISSUE(src, slot) do { const bf16_t* s_ = (src) + tid_ * 8; LAS unsigned char* d_ = ring + (slot) * 32768 + w * 1024; _Pragma("unroll") for (int k_ = 0; k_ < 4; ++k_) \
        __builtin_amdgcn_global_load_lds((const unsigned*)(s_ + k_ * 4096), (LAS unsigned*)(d_ + k_ * 8192), 16, 0, 0); } while (0)
    int base = blockIdx.x * NWAVES;
    if (base < NIT) { ATL_ISSUE(ATL_SRC(base, 0), 0); ATL_ISSUE(ATL_SRC(base, 1), 1); }
    int b0 = 0;
    for (; base < NIT; base += F.ngw) {
        asm volatile("" ::: "memory");
        const int h = ((base >> 2) & 15) + hl, rg = base >> 6;
        const int s0 = rg < LP / GRIDW ? 0 : LP, rows = rg < LP / GRIDW ? LP / GRIDW : LS / GRIDW, r = rg < LP / GRIDW ? rg : rg - LP / GRIDW;
        int rs = r - 4; rs = rs < 0 ? 0 : (rs > rows - 8 ? rows - 8 : rs);
        const int nbase = base + F.ngw < NIT ? base + F.ngw : base;
        bf16_t* qrow = Q + (size_t)(s0 + r * GRIDW + c) * NAW + h * HD;
        bf16x8 qf[4];
#pragma unroll
        for (int s = 0; s < 4; ++s) qf[s] = *(const bf16x8*)(qrow + 8 * fq + 32 * s);
        f32x4 sacc[8][2]; f32x4 oacc[8]; bf16x8 pf[8]; float lsum = 0.f;
#pragma unroll
        for (int dt = 0; dt < 8; ++dt) oacc[dt] = (f32x4){0.f, 0.f, 0.f, 0.f};
        const int koff = hl * 16384 + (p0 * 128 + fr * 32 + fq * 8) * 2, voff = hl * 16384 + (p0 * 128 + fq * 128 + fr * 8) * 2;
#pragma unroll
        for (int st = 0; st < 16; ++st) {
            asm volatile("s_waitcnt vmcnt(4)" ::: "memory"); asm volatile("s_waitcnt lgkmcnt(0)" ::: "memory"); __builtin_amdgcn_s_barrier(); asm volatile("" ::: "memory");
            { const int slot2 = (b0 + st + 2) % 3; if (st + 2 < 16) ATL_ISSUE(ATL_SRC(base, st + 2), slot2); else ATL_ISSUE(ATL_SRC(nbase, st + 2 - 16), slot2); }
            const LAS unsigned char* buf = ring + ((b0 + st) % 3) * 32768;
            if (st < 8) {
#pragma unroll
                for (int T = 0; T < 2; ++T) { f32x4 a = (f32x4){0.f, 0.f, 0.f, 0.f};
#pragma unroll
                    for (int s2 = 0; s2 < 4; ++s2) a = __builtin_amdgcn_mfma_f32_16x16x32_bf16(*(const LAS bf16x8*)(buf + koff + (s2 * 2 + T) * 2048), qf[s2], a, 0, 0, 0);
                    sacc[st][T] = a; }
            } else {
                if (st == 8) {
                    const int elo = cs - w0 - 8 * fq, dc0 = w0 + 8 * fq - c + 15;
                    const LAS float* rph = rp + h * 465 + (rs - r + 7) * 31;
                    float mx = -3.0e38f;
#pragma unroll
                    for (int e = 0; e < 8; ++e) { const bool valid = (e >= elo) && (e < elo + 16); const int bi = valid ? dc0 + e : 0;
#pragma unroll
                        for (int kr = 0; kr < 8; ++kr) { const float sv = valid ? sacc[kr][e >> 2][e & 3] * scale + rph[kr * 31 + bi] : -3.0e38f; sacc[kr][e >> 2][e & 3] = sv; mx = fmaxf(mx, sv); } }
                    mx = fmaxf(mx, __shfl_xor(mx, 16)); mx = fmaxf(mx, __shfl_xor(mx, 32));
#pragma unroll
                    for (int kr = 0; kr < 8; ++kr) { float p[8];
#pragma unroll
                        for (int e = 0; e < 8; ++e) { p[e] = __expf(sacc[kr][e >> 2][e & 3] - mx); lsum += p[e]; }
                        u32x4 wv; wv.x = pk2(p[0], p[1]); wv.y = pk2(p[2], p[3]); wv.z = pk2(p[4], p[5]); wv.w = pk2(p[6], p[7]);
                        pf[kr] = __builtin_bit_cast(bf16x8, wv); }
                    lsum += __shfl_xor(lsum, 16); lsum += __shfl_xor(lsum, 32);
                }
#pragma unroll
                for (int dt = 0; dt < 8; ++dt) oacc[dt] = __builtin_amdgcn_mfma_f32_16x16x32_bf16(*(const LAS bf16x8*)(buf + voff + dt * 2048), pf[st - 8], oacc[dt], 0, 0, 0);
            }
        }
        b0 = (b0 + 16) % 3;
        const float inv = 1.0f / lsum;
#pragma unroll
        for (int u = 0; u < 4; ++u) *(u32x4*)(qrow + 32 * u + 8 * fq) = pg8::pack8(oacc[2 * u] * inv, oacc[2 * u + 1] * inv);
    }
#undef ATL_SRC
#undef ATL_ISSUE
    asm volatile("s_waitcnt vmcnt(0)" ::: "memory");
    __syncthreads();
}

__device__ __forceinline__ void conv_phase(Frame& F) {
    const int tid_ = opaque(F.tid);
    const bf16_t* XR = wsp<bf16_t>(F, WS_XR); bf16_t* XC = wsp<bf16_t>(F, WS_XC);
    const float* wc = F.in_WCONV; const float* bc = F.in_BCONV;
    const int nth = F.G * NTHR;
    for (int it = blockIdx.x * NTHR + tid_; it < L * (LW / 8); it += nth) {
        const int t = it / (LW / 8), c0 = (it % (LW / 8)) * 8;
        const int s0 = t < LP ? 0 : LP, len = t < LP ? LP : LS, tl = t - s0;
        float acc[8];
#pragma unroll
        for (int e = 0; e < 8; ++e) acc[e] = bc[c0 + e];
#pragma unroll
        for (int j = 0; j < 4; ++j) { const int tt = tl + j - 2; if (tt < 0 || tt >= len) continue;
            f32x4 x0, x1; pg8::unpack8(*(const u32x4*)(XR + (size_t)(s0 + tt) * LW + c0), x0, x1);
            const f32x4 w0 = *(const f32x4*)(wc + j * LW + c0), w1 = *(const f32x4*)(wc + j * LW + c0 + 4);
#pragma unroll
            for (int e = 0; e < 4; ++e) { acc[e] += w0[e] * x0[e]; acc[4 + e] += w1[e] * x1[e]; } }
        *(u32x4*)(XC + (size_t)t * LW + c0) = pg8::pack8((f32x4){acc[0], acc[1], acc[2], acc[3]}, (f32x4){acc[4], acc[5], acc[6], acc[7]});
    }
}

struct LruW { bf16x8 w[2][4]; float br, bi, cl; };
template <int DIR> __device__ __forceinline__ void lru_load_w(const Frame& F, LruW& W, int n, int w, int fr, int fq) {
    const bf16_t* wg = wsp<bf16_t>(F, WS_WG);
#pragma unroll
    for (int g = 0; g < 2; ++g)
#pragma unroll
        for (int s = 0; s < 4; ++s) W.w[g][s] = *(const bf16x8*)(wg + ((size_t)((DIR * 2 + g) * NBLK + n) * BW + 16 * w + fr) * BW + 32 * fq + 8 * s);
    const int ch = n * BW + 16 * w + fr;
    W.br = -1.44269504f * F.in_BR[DIR * LW + ch]; W.bi = -1.44269504f * F.in_BI[DIR * LW + ch];
    const float lam = F.in_LAM[DIR * LW + ch];
    W.cl = -8.0f * 1.44269504f * ((lam > 15.f) ? __expf(-lam) : log1pf(__expf(-lam)));
}
template <int LDBG = 0> __device__ __forceinline__ void lru_gate(float pr, float pi, float xc, const LruW& W, bool first, float& a, float& u) {
    if constexpr (LDBG == 1) { a = pr + W.br; u = pi * xc + W.bi; return; }
    const float r = __builtin_amdgcn_rcpf(1.0f + __builtin_amdgcn_exp2f(__builtin_fmaf(pr, -1.44269504f, W.br))), d = 1.0f + __builtin_amdgcn_exp2f(__builtin_fmaf(pi, -1.44269504f, W.bi));
    a = __builtin_amdgcn_exp2f(W.cl * r);
    const float y = first ? 1.0f : fmaxf(__builtin_fmaf(-a, a, 1.0f), 1e-30f);
    u = xc * y * __builtin_amdgcn_rsqf(y * d * d);
}
struct LruX { bf16x8 x[4][4]; };
__device__ __forceinline__ void lru_load_x(LruX& X, const bf16_t* XC, int tb, int n, int fr, int fq) {
#pragma unroll
    for (int tau = 0; tau < 4; ++tau) { const bf16_t* xp = XC + ((size_t)((((tb >> 6) * NBLK + n) * 4 + tau) * 4) * 64 + fr * 4 + fq) * 8;
#pragma unroll
        for (int s = 0; s < 4; ++s) X.x[tau][s] = *(const bf16x8*)(xp + s * 512); }
}
__device__ __forceinline__ void lru_tile(const LruX& X, int tau, bool hiw, const LruW& W, const bf16x8 idf0, const bf16x8 idf1, f32x4& pr, f32x4& pi, f32x4& xct) {
    pr = (f32x4){0.f, 0.f, 0.f, 0.f}; pi = pr;
#pragma unroll
    for (int s = 0; s < 4; ++s) { pr = __builtin_amdgcn_mfma_f32_16x16x32_bf16(X.x[tau][s], W.w[0][s], pr, 0, 0, 0); pi = __builtin_amdgcn_mfma_f32_16x16x32_bf16(X.x[tau][s], W.w[1][s], pi, 0, 0, 0); }
    const bf16x8 x0 = hiw ? X.x[tau][2] : X.x[tau][0], x1 = hiw ? X.x[tau][3] : X.x[tau][1];
    xct = __builtin_amdgcn_mfma_f32_16x16x32_bf16(x0, idf0, (f32x4){0.f, 0.f, 0.f, 0.f}, 0, 0, 0);
    xct = __builtin_amdgcn_mfma_f32_16x16x32_bf16(x1, idf1, xct, 0, 0, 0);
}
__device__ __forceinline__ void lru_tile_lds(const LAS unsigned char* tile, const LAS unsigned char* xcl, int gl, int tau, const LruW& W, int fr, int fq, f32x4& pr, f32x4& pi, f32x4& xct) {
    bf16x8 x[4];
#pragma unroll
    for (int s = 0; s < 4; ++s) x[s] = *(const LAS bf16x8*)(tile + ((((gl * 4 + tau) * 4 + s) * 16 + fr) * 4 + fq) * 16);
    pr = (f32x4){0.f, 0.f, 0.f, 0.f}; pi = pr;
#pragma unroll
    for (int s = 0; s < 4; ++s) { pr = __builtin_amdgcn_mfma_f32_16x16x32_bf16(x[s], W.w[0][s], pr, 0, 0, 0); pi = __builtin_amdgcn_mfma_f32_16x16x32_bf16(x[s], W.w[1][s], pi, 0, 0, 0); }
#pragma unroll
    for (int j = 0; j < 4; ++j) xct[j] = bf1(*(const LAS bf16_t*)(xcl + (gl * 4 + tau) * 4096 + j * 64));
}
__device__ __forceinline__ void lru_idfrags(int w, int fr, int fq, bf16x8& idf0, bf16x8& idf1) {
#pragma unroll
    for (int e = 0; e < 8; ++e) { const bool on = (fq == (w >> 1)) && ((fr & 7) == e); idf0[e] = (on && fr < 8) ? (short)0x3F80 : (short)0; idf1[e] = (on && fr >= 8) ? (short)0x3F80 : (short)0; }
}
constexpr int LRU_CH = 256, LRU_NCH = L / LRU_CH, LRU_NCH_P = LP / LRU_CH;
__device__ __forceinline__ void conv_unit(Frame& F, int cg, int n) {
    const int tid_ = opaque(F.tid);
    const bf16_t* XR = wsp<bf16_t>(F, WS_XR); bf16_t* XC = wsp<bf16_t>(F, WS_XC);
    const float* wc = F.in_WCONV; const float* bc = F.in_BCONV;
    const int c0 = n * BW + (tid_ & 15) * 8;
    const int s0 = cg < LRU_NCH_P ? 0 : LP, len = cg < LRU_NCH_P ? LP : LS;
    f32x4 w[4][2]; f32x4 b0 = *(const f32x4*)(bc + c0), b1 = *(const f32x4*)(bc + c0 + 4);
#pragma unroll
    for (int j = 0; j < 4; ++j) { w[j][0] = *(const f32x4*)(wc + j * LW + c0); w[j][1] = *(const f32x4*)(wc + j * LW + c0 + 4); }
#pragma unroll
    for (int i = 0; i < 8; ++i) {
        const int t = cg * LRU_CH + (tid_ >> 4) + 32 * i, tl = t - s0;
        f32x4 a0 = b0, a1 = b1;
#pragma unroll
        for (int j = 0; j < 4; ++j) { const int tt = tl + j - 2; if (tt < 0 || tt >= len) continue;
            f32x4 x0, x1; pg8::unpack8(*(const u32x4*)(XR + (size_t)(s0 + tt) * LW + c0), x0, x1); a0 += w[j][0] * x0; a1 += w[j][1] * x1; }
        const int tg = t & 63, cq = tid_ & 15;
        *(u32x4*)(XC + ((size_t)(((((t >> 6) * NBLK + n) * 4 + ((tg >> 2) & 3)) * 4 + (cq & 3)) * 16 + 4 * (tg >> 4) + (tg & 3)) * 4 + (cq >> 2)) * 8) = pg8::pack8(a0, a1);
    }
}
__device__ __forceinline__ void conv_req(const Frame& F, int cg, int n, int tid_, u32x4 (&R)[11]) {
    const bf16_t* XR = wsp<bf16_t>(F, WS_XR);
    const int s0 = cg < LRU_NCH_P ? 0 : LP, len = cg < LRU_NCH_P ? LP : LS;
    const int t0 = cg * LRU_CH + 8 * (tid_ >> 4) - 2, c0 = n * BW + (tid_ & 15) * 8;
#pragma unroll
    for (int k = 0; k < 11; ++k) { const int tl = t0 + k - s0; R[k] = (u32x4){0u, 0u, 0u, 0u}; if (tl >= 0 && tl < len) R[k] = *(const u32x4*)(XR + (size_t)(t0 + k) * LW + c0); }
}
__device__ __forceinline__ void conv_fin(const Frame& F, int cg, int n, int tid_, const u32x4 (&R)[11], LAS unsigned char* tile, const LAS float* cw) {
    bf16_t* XC = wsp<bf16_t>(F, WS_XC);
    const int g = tid_ >> 4, cq = tid_ & 15;
    f32x4 w[4][2];
#pragma unroll
    for (int j = 0; j < 4; ++j) { w[j][0] = *(const LAS f32x4*)(cw + j * BW + cq * 8); w[j][1] = *(const LAS f32x4*)(cw + j * BW + cq * 8 + 4); }
    const f32x4 b0 = *(const LAS f32x4*)(cw + 4 * BW + cq * 8), b1 = *(const LAS f32x4*)(cw + 4 * BW + cq * 8 + 4);
#pragma unroll
    for (int i = 0; i < 8; ++i) {
        f32x4 a0 = b0, a1 = b1;
#pragma unroll
        for (int j = 0; j < 4; ++j) { f32x4 x0, x1; pg8::unpack8(R[i + j], x0, x1); a0 += w[j][0] * x0; a1 += w[j][1] * x1; }
        const int t = cg * LRU_CH + 8 * g + i, tg = t & 63;
        const int fo = ((((((tg >> 2) & 3) * 4 + (cq & 3)) * 16 + 4 * (tg >> 4) + (tg & 3)) * 4 + (cq >> 2)) * 8);
        const u32x4 o = pg8::pack8(a0, a1);
        *(u32x4*)(XC + (size_t)((t >> 6) * NBLK + n) * 8192 + fo) = o;
        *(LAS u32x4*)(tile + ((t >> 6) & 3) * 16384 + fo * 2) = o;
    }
}
__device__ __forceinline__ void lru_load_x_lds(LruX& X, const LAS unsigned char* tile, int gl, int fr, int fq) {
#pragma unroll
    for (int tau = 0; tau < 4; ++tau)
#pragma unroll
        for (int s = 0; s < 4; ++s) X.x[tau][s] = *(const LAS bf16x8*)(tile + ((((gl * 4 + tau) * 4 + s) * 16 + fr) * 4 + fq) * 16);
}
__device__ __forceinline__ void lru_pass_a(Frame& F) {
    const int tid_ = opaque(F.tid);
    const int fr = F.lane & 15, fq = F.lane >> 4, w = F.wave;
    f32x2* SUMM = wsp<f32x2>(F, WS_SUM);
    LAS unsigned char* tile = F.lds; LAS float* cw = (LAS float*)(F.lds + 65536);
    bf16x8 idf0, idf1; lru_idfrags(w, fr, fq, idf0, idf1);
    int u = blockIdx.x, ncur = -1;
    u32x4 R[11];
    if (u < LRU_NCH * NBLK) conv_req(F, u >> 4, u & 15, tid_, R);
    LruW Wf, Wb;
    for (; u < LRU_NCH * NBLK; u += F.G) {
        const int cg = u >> 4, n = u & 15;
        if (n != ncur) {
            ncur = n; lru_load_w<0>(F, Wf, n, w, fr, fq); lru_load_w<1>(F, Wb, n, w, fr, fq);
            for (int i = tid_; i < 5 * BW; i += NTHR) cw[i] = i < 4 * BW ? F.in_WCONV[(i >> 7) * LW + n * BW + (i & 127)] : F.in_BCONV[n * BW + (i & 127)];
            LDS_WAIT(); __builtin_amdgcn_s_barrier();
        }
        asm volatile("" ::: "memory");
        conv_fin(F, cg, n, tid_, R, tile, cw);
        { const int un = u + F.G; if (un < LRU_NCH * NBLK) conv_req(F, un >> 4, un & 15, tid_, R); }
        LDS_WAIT(); __builtin_amdgcn_s_barrier();
        const bool c_first = (cg == 0 || cg == LRU_NCH_P), c_last = (cg == LRU_NCH_P - 1 || cg == LRU_NCH - 1);
        float Af = 1.f, Hf = 0.f, Ab = 1.f, Hb = 0.f;
        for (int gi = 0; gi < 4; ++gi) {
            float pf = 1.f, hf = 0.f, pb = 1.f, hb = 0.f;
#pragma unroll 2
            for (int tau = 0; tau < 4; ++tau) {
                bf16x8 x[4];
#pragma unroll
                for (int s_ = 0; s_ < 4; ++s_) x[s_] = *(const LAS bf16x8*)(tile + ((((gi * 4 + tau) * 4 + s_) * 16 + fr) * 4 + fq) * 16);
                f32x4 prf = (f32x4){0.f, 0.f, 0.f, 0.f}, pif = prf, prb = prf, pib = prf, xct;
#pragma unroll
                for (int s_ = 0; s_ < 4; ++s_) { prf = __builtin_amdgcn_mfma_f32_16x16x32_bf16(x[s_], Wf.w[0][s_], prf, 0, 0, 0); pif = __builtin_amdgcn_mfma_f32_16x16x32_bf16(x[s_], Wf.w[1][s_], pif, 0, 0, 0);
                    prb = __builtin_amdgcn_mfma_f32_16x16x32_bf16(x[s_], Wb.w[0][s_], prb, 0, 0, 0); pib = __builtin_amdgcn_mfma_f32_16x16x32_bf16(x[s_], Wb.w[1][s_], pib, 0, 0, 0); }
                xct = __builtin_amdgcn_mfma_f32_16x16x32_bf16((w & 1) ? x[2] : x[0], idf0, (f32x4){0.f, 0.f, 0.f, 0.f}, 0, 0, 0);
                xct = __builtin_amdgcn_mfma_f32_16x16x32_bf16((w & 1) ? x[3] : x[1], idf1, xct, 0, 0, 0);
#pragma unroll
                for (int j = 0; j < 4; ++j) {
                    float a, uu;
                    lru_gate(prf[j], pif[j], xct[j], Wf, c_first && gi == 0 && fq == 0 && tau == 0 && j == 0, a, uu); hf = a * hf + uu; pf *= a;
                    lru_gate(prb[j], pib[j], xct[j], Wb, c_last && gi == 3 && fq == 3 && tau == 3 && j == 3, a, uu); hb += pb * uu; pb *= a;
                }
            }
            float gPf = 1.f, gHf = 0.f, gPb = 1.f, gHb = 0.f;
#pragma unroll
            for (int qq = 0; qq < 4; ++qq) { const int src = fr + 16 * qq;
                float P = __shfl(pf, src), H = __shfl(hf, src); gHf = P * gHf + H; gPf *= P;
                P = __shfl(pb, src); H = __shfl(hb, src); gHb += gPb * H; gPb *= P; }
            Hf = gPf * Hf + gHf; Af *= gPf; Hb += Ab * gHb; Ab *= gPb;
        }
        if (fq == 0) { const int ch = n * BW + 16 * w + fr; SUMM[(size_t)(cg * 2 + 0) * LW + ch] = (f32x2){Af, Hf}; SUMM[(size_t)(cg * 2 + 1) * LW + ch] = (f32x2){Ab, Hb}; }
        LDS_WAIT(); __builtin_amdgcn_s_barrier();
    }
    VM_WAIT();
}
__device__ __forceinline__ void lru_pass_b(Frame& F) {
    const int tid_ = opaque(F.tid);
    const int gt = blockIdx.x * NTHR + tid_; if (gt >= 4 * LW) return;
    const int ch = gt % LW, d = (gt / LW) & 1, seq = gt / (2 * LW), c0 = seq ? LRU_NCH_P : 0, nc = seq ? LRU_NCH - LRU_NCH_P : LRU_NCH_P;
    const f32x2* SUMM = wsp<f32x2>(F, WS_SUM); float* CIN = wsp<float>(F, WS_SUM + 4 * MiB);
    float s = 0.f;
    for (int i0 = 0; i0 < nc; i0 += 32) {
        f32x2 ah[32];
#pragma unroll
        for (int e = 0; e < 32; ++e) { const int cg = d ? c0 + nc - 1 - (i0 + e) : c0 + i0 + e; ah[e] = SUMM[(size_t)(cg * 2 + d) * LW + ch]; }
#pragma unroll
        for (int e = 0; e < 32; ++e) { const int cg = d ? c0 + nc - 1 - (i0 + e) : c0 + i0 + e; CIN[(size_t)(cg * 2 + d) * LW + ch] = s; s = ah[e].x * s + ah[e].y; }
    }
}
template <int LDBG = 0> __device__ __forceinline__ void lru_pass_c(Frame& F) {
    const int tid_ = opaque(F.tid);
    const int fr = F.lane & 15, fq = F.lane >> 4, w = F.wave;
    const bf16_t* XC = wsp<bf16_t>(F, WS_XC); const float* CIN = wsp<float>(F, WS_SUM + 4 * MiB);
    const bf16_t* GR = wsp<bf16_t>(F, WS_GR); bf16_t* LRU = wsp<bf16_t>(F, WS_XR);
    LAS unsigned char* tile = F.lds;
    LAS unsigned char* hfl = F.lds + 65536 + w * 8192 + F.lane * 32;
    asm volatile("" : "+v"(hfl));
    const LAS unsigned char* xcl = tile + ((((2 * (w & 1) + (fr >> 3)) * 16 + 4 * fq) * 4 + (w >> 1)) * 16 + (fr & 7) * 2);
    asm volatile("" : "+v"(xcl));
    LruW Wf, Wb; int ncur = -1;
    for (int u = blockIdx.x; u < LRU_NCH * NBLK; u += F.G) {
        const int cg = u >> 4, n = u & 15, ch = n * BW + 16 * w + fr;
        const bool c_first = (cg == 0 || cg == LRU_NCH_P), c_last = (cg == LRU_NCH_P - 1 || cg == LRU_NCH - 1);
        { const bf16_t* gsrc = XC + (size_t)(cg * 4 * NBLK + n) * 8192 + tid_ * 8; LAS unsigned char* ldst = tile + w * 1024;
#pragma unroll 1
          for (int k = 0; k < 8; ++k) { __builtin_amdgcn_global_load_lds((const unsigned*)gsrc, (LAS unsigned*)ldst, 16, 0, 0); gsrc += (k & 1) ? (size_t)NBLK * 8192 - 4096 : 4096; ldst += 8192; } }
        asm volatile("" ::: "memory");
        if (n != ncur) { ncur = n; lru_load_w<0>(F, Wf, n, w, fr, fq); lru_load_w<1>(F, Wb, n, w, fr, fq); }
        const float cin_f = CIN[(size_t)(cg * 2 + 0) * LW + ch], cin_b = CIN[(size_t)(cg * 2 + 1) * LW + ch];
        const bf16_t* grp = GR + (size_t)(cg * LRU_CH + 16 * fq) * LW + ch; bf16_t* outp = LRU + (size_t)(cg * LRU_CH + 16 * fq) * LW + ch;
        bf16_t grn[16];
#pragma unroll
        for (int t = 0; t < 16; ++t) grn[t] = grp[(size_t)(3 * 64 + t) * LW];
        asm volatile("s_waitcnt vmcnt(16)" ::: "memory"); __builtin_amdgcn_s_barrier();
        {
            const LruW& W = Wf;
            float s = cin_f;
            for (int gi = 0; gi < 4; ++gi) {
                float a[16], uu[16];
#pragma unroll
                for (int tau = 0; tau < 4; ++tau) { f32x4 pr, pi, xct; lru_tile_lds(tile, xcl, gi, tau, W, fr, fq, pr, pi, xct);
#pragma unroll
                    for (int j = 0; j < 4; ++j) lru_gate<LDBG>(pr[j], pi[j], xct[j], W, c_first && gi == 0 && fq == 0 && tau == 0 && j == 0, a[4 * tau + j], uu[4 * tau + j]); }
                float p = 1.f, h = 0.f;
#pragma unroll
                for (int t = 0; t < 16; ++t) { h = a[t] * h + uu[t]; p *= a[t]; }
                float hin = s, sg = s;
#pragma unroll
                for (int qq = 0; qq < 4; ++qq) { const float P = __shfl(p, fr + 16 * qq), H = __shfl(h, fr + 16 * qq); sg = P * sg + H; if (qq < fq) hin = P * hin + H; }
                s = sg;
                float hh = hin;
#pragma unroll
                for (int t = 0; t < 16; ++t) { hh = a[t] * hh + uu[t]; a[t] = hh; }
                *(LAS u32x4*)(hfl + gi * 2048) = (u32x4){pk2(a[0], a[1]), pk2(a[2], a[3]), pk2(a[4], a[5]), pk2(a[6], a[7])};
                *(LAS u32x4*)(hfl + gi * 2048 + 16) = (u32x4){pk2(a[8], a[9]), pk2(a[10], a[11]), pk2(a[12], a[13]), pk2(a[14], a[15])};
            }
        }
        {
            const LruW& W = Wb;
            float s = cin_b;
            for (int gi = 3; gi >= 0; --gi) {
                bf16_t grc[16];
#pragma unroll
                for (int t = 0; t < 16; ++t) grc[t] = grn[t];
                if (gi > 0) {
#pragma unroll
                    for (int t = 0; t < 16; ++t) grn[t] = grp[(size_t)((gi - 1) * 64 + t) * LW]; }
                float a[16], uu[16];
#pragma unroll
                for (int tau = 0; tau < 4; ++tau) { f32x4 pr, pi, xct; lru_tile_lds(tile, xcl, gi, tau, W, fr, fq, pr, pi, xct);
#pragma unroll
                    for (int j = 0; j < 4; ++j) lru_gate<LDBG>(pr[j], pi[j], xct[j], W, c_last && gi == 3 && fq == 3 && tau == 3 && j == 3, a[4 * tau + j], uu[4 * tau + j]); }
                float p = 1.f, h = 0.f;
#pragma unroll
                for (int t = 15; t >= 0; --t) { h = a[t] * h + uu[t]; p *= a[t]; }
                float hin = s, sg = s;
#pragma unroll
                for (int qq = 3; qq >= 0; --qq) { const float P = __shfl(p, fr + 16 * qq), H = __shfl(h, fr + 16 * qq); sg = P * sg + H; if (qq > fq) hin = P * hin + H; }
                s = sg;
                float hh = hin;
                const u32x4 hf0 = *(const LAS u32x4*)(hfl + gi * 2048), hf1 = *(const LAS u32x4*)(hfl + gi * 2048 + 16);
                const unsigned hfw[8] = {hf0.x, hf0.y, hf0.z, hf0.w, hf1.x, hf1.y, hf1.z, hf1.w};
#pragma unroll
                for (int t = 15; t >= 0; --t) { hh = a[t] * hh + uu[t];
                    outp[(size_t)(gi * 64 + t) * LW] = (bf16_t)f2bf((((t & 1) ? bfhi(hfw[t >> 1]) : bflo(hfw[t >> 1])) + hh) * gelu_tanh(bf1(grc[t]))); }
            }
        }
        LDS_WAIT(); __builtin_amdgcn_s_barrier();
    }
}

constexpr int HQW_EARLY = 96 * (D / 32);
__device__ __forceinline__ void hq_wtiles(Frame& F, int lo, int hi, int first, int stride) {
    const int lane = opaque(F.tid) & 63;
    LAS float* scr = (LAS float*)(F.lds + F.wave * 8448);
    for (int it = lo + first; it < hi; it += stride)
        had_tile_quant(F.in_WFD, D, DFF, 64 * (it / (D / 32)), 32 * (it % (D / 32)), wsp<signed char>(F, WS_WD), (const unsigned*)(F.ws + WS_AM), wsp<float>(F, WS_CS) + CS_D, scr, lane);
}
__device__ __forceinline__ void hq_phase(Frame& F) {
    const int lane = opaque(F.tid) & 63;
    const bf16_t* H0 = (const bf16_t*)F.out; const bf16_t* H1 = wsp<bf16_t>(F, WS_HIDS);
    signed char* Q0 = wsp<signed char>(F, WS_H8P); signed char* Q1 = wsp<signed char>(F, WS_H8S); float* RS3 = wsp<float>(F, WS_RS3);
    hq_wtiles(F, HQW_EARLY, (DFF / 64) * (D / 32), F.gw, F.ngw);
    constexpr int NB = DFF / 32;
    for (int m = F.gw; m < L; m += F.ngw) {
        const bf16_t* src = m < LP ? H0 + (size_t)m * DFF : H1 + (size_t)(m - LP) * DFF;
        signed char* dst = m < LP ? Q0 + (size_t)m * DFF : Q1 + (size_t)(m - LP) * DFF;
        u32x4 raw[6][4];
#pragma unroll
        for (int it = 0; it < 6; ++it) { const int b = lane + 64 * it; const u32x4* p = (const u32x4*)(src + (b < NB ? b : lane) * 32);
#pragma unroll
            for (int i = 0; i < 4; ++i) raw[it][i] = p[i]; }
        float mx = 0.f;
#pragma unroll
        for (int it = 0; it < 6; ++it) { float v[32];
#pragma unroll
            for (int i = 0; i < 4; ++i) { const u32x4 u = raw[it][i]; v[8 * i + 0] = bflo(u.x); v[8 * i + 1] = bfhi(u.x); v[8 * i + 2] = bflo(u.y); v[8 * i + 3] = bfhi(u.y); v[8 * i + 4] = bflo(u.z); v[8 * i + 5] = bfhi(u.z); v[8 * i + 6] = bflo(u.w); v[8 * i + 7] = bfhi(u.w); }
            fwht32(v);
            float bm = 0.f;
#pragma unroll
            for (int i = 0; i < 32; ++i) bm = fmaxf(bm, fabsf(v[i]));
            mx = fmaxf(mx, (lane + 64 * it < NB) ? bm : 0.f); }
        const float amax = fmaxf(wave_max(mx), 1e-20f), inv = 127.0f / amax;
        if (lane == 0) RS3[m] = amax * (1.0f / 127.0f);
#pragma unroll
        for (int it = 0; it < 6; ++it) { const int b = lane + 64 * it; float v[32];
#pragma unroll
            for (int i = 0; i < 4; ++i) { const u32x4 u = raw[it][i]; v[8 * i + 0] = bflo(u.x); v[8 * i + 1] = bfhi(u.x); v[8 * i + 2] = bflo(u.y); v[8 * i + 3] = bfhi(u.y); v[8 * i + 4] = bflo(u.z); v[8 * i + 5] = bfhi(u.z); v[8 * i + 6] = bflo(u.w); v[8 * i + 7] = bfhi(u.w); }
            fwht32(v);
            u32x4 o0, o1;
            o0.x = pk4_i8(rintf(v[0] * inv), rintf(v[1] * inv), rintf(v[2] * inv), rintf(v[3] * inv)); o0.y = pk4_i8(rintf(v[4] * inv), rintf(v[5] * inv), rintf(v[6] * inv), rintf(v[7] * inv));
            o0.z = pk4_i8(rintf(v[8] * inv), rintf(v[9] * inv), rintf(v[10] * inv), rintf(v[11] * inv)); o0.w = pk4_i8(rintf(v[12] * inv), rintf(v[13] * inv), rintf(v[14] * inv), rintf(v[15] * inv));
            o1.x = pk4_i8(rintf(v[16] * inv), rintf(v[17] * inv), rintf(v[18] * inv), rintf(v[19] * inv)); o1.y = pk4_i8(rintf(v[20] * inv), rintf(v[21] * inv), rintf(v[22] * inv), rintf(v[23] * inv));
            o1.z = pk4_i8(rintf(v[24] * inv), rintf(v[25] * inv), rintf(v[26] * inv), rintf(v[27] * inv)); o1.w = pk4_i8(rintf(v[28] * inv), rintf(v[29] * inv), rintf(v[30] * inv), rintf(v[31] * inv));
            if (b < NB) { *(u32x4*)(dst + b * 32) = o0; *(u32x4*)(dst + b * 32 + 16) = o1; } }
    }
}

__device__ __forceinline__ f32x4 up4(const u32x2 u) { return (f32x4){bflo(u.x), bfhi(u.x), bflo(u.y), bfhi(u.y)}; }
__device__ __forceinline__ void mid_phase(Frame& F) {
    const int tid_ = opaque(F.tid);
    bf16_t* MIX = wsp<bf16_t>(F, WS_MIX); signed char* XN8 = wsp<signed char>(F, WS_XN8); float* RS2 = wsp<float>(F, WS_RS2);
    LAS f32x4* gpost = (LAS f32x4*)F.lds; LAS f32x4* gpre = gpost + D / 4;
    for (int i = tid_; i < D / 4; i += NTHR) { gpost[i] = ((const f32x4*)F.in_GMPOST)[i]; gpre[i] = ((const f32x4*)F.in_GFPRE)[i]; }
    __syncthreads();
    for (int m = F.gw; m < L; m += F.ngw) {
        asm volatile("" ::: "memory");
        const f32x4* xr = (const f32x4*)xrow(F, m) + F.lane; const u32x2* mr = (const u32x2*)(MIX + (size_t)m * D) + F.lane;
        f32x4 v[16]; u32x2 mx[16]; float s = 0.f;
#pragma unroll
        for (int j = 0; j < 16; ++j) { v[j] = xr[64 * j]; mx[j] = mr[64 * j]; const f32x4 a = up4(mx[j]); s += (a.x * a.x + a.y * a.y) + (a.z * a.z + a.w * a.w); }
        const float rstd1 = 1.0f / sqrtf(wave_sum(s) * (1.0f / D) + EPS);
        float s2 = 0.f;
#pragma unroll
        for (int j = 0; j < 16; ++j) { v[j] = v[j] + up4(mx[j]) * rstd1 * gpost[F.lane + 64 * j]; s2 += (v[j].x * v[j].x + v[j].y * v[j].y) + (v[j].z * v[j].z + v[j].w * v[j].w); }
        const float rstd2 = 1.0f / sqrtf(wave_sum(s2) * (1.0f / D) + EPS);
        { u32x2* xw = (u32x2*)(MIX + (size_t)m * D) + F.lane;
#pragma unroll
          for (int j = 0; j < 16; ++j) xw[64 * j] = (u32x2){pk2(v[j].x, v[j].y), pk2(v[j].z, v[j].w)}; }
        float mx2 = 0.f;
#pragma unroll
        for (int j = 0; j < 16; ++j) { v[j] = v[j] * rstd2 * gpre[F.lane + 64 * j]; mx2 = fmaxf(fmaxf(mx2, fmaxf(fabsf(v[j].x), fabsf(v[j].y))), fmaxf(fabsf(v[j].z), fabsf(v[j].w))); }
        const float amax = fmaxf(wave_max(mx2), 1e-20f), inv = 127.0f / amax;
        if (F.lane == 0) RS2[m] = amax * (1.0f / 127.0f);
        unsigned* o4 = (unsigned*)(XN8 + (size_t)m * D) + F.lane;
#pragma unroll
        for (int j = 0; j < 16; ++j) o4[64 * j] = pk4_i8(rintf(v[j].x * inv), rintf(v[j].y * inv), rintf(v[j].z * inv), rintf(v[j].w * inv));
    }
    __syncthreads();
}
__device__ __forceinline__ void final_phase(Frame& F) {
    const int tid_ = opaque(F.tid);
    const bf16_t* X1 = wsp<bf16_t>(F, WS_MIX); const bf16_t* FB = wsp<bf16_t>(F, WS_F);
    LAS f32x4* gfp = (LAS f32x4*)F.lds;
    for (int i = tid_; i < D / 4; i += NTHR) gfp[i] = ((const f32x4*)F.in_GFPOST)[i];
    __syncthreads();
    for (int m = F.gw; m < L; m += F.ngw) {
        asm volatile("" ::: "memory");
        const u32x2* mr = (const u32x2*)(X1 + (size_t)m * D) + F.lane; const u32x2* fr = (const u32x2*)(FB + (size_t)m * D) + F.lane;
        u32x2 fx[16], x1[16]; float s = 0.f;
#pragma unroll
        for (int j = 0; j < 16; ++j) { fx[j] = fr[64 * j]; x1[j] = mr[64 * j]; const f32x4 a = up4(fx[j]); s += (a.x * a.x + a.y * a.y) + (a.z * a.z + a.w * a.w); }
        const float rstd3 = 1.0f / sqrtf(wave_sum(s) * (1.0f / D) + EPS);
        f32x4* o = (f32x4*)(F.out + (size_t)m * D) + F.lane;
#pragma unroll
        for (int j = 0; j < 16; ++j) o[64 * j] = up4(x1[j]) + up4(fx[j]) * rstd3 * gfp[F.lane + 64 * j];
    }
}

constexpr int LDS_STAGE = pg8::STAGE_BYTES;
constexpr int LDS_MISC = LDS_STAGE;
constexpr int LDS_BYTES = LDS_STAGE + 1024;
#ifndef MK_N_LAUNCHES
#define MK_N_LAUNCHES 1
#endif
constexpr int NPHASE = 12;
struct Args { const float* in[23]; float* out; unsigned char* ws; int ph_lo, ph_hi; };

__global__ void __launch_bounds__(NTHR, 2) fwd_kernel(Args args) {
    extern __shared__ __attribute__((aligned(16))) unsigned char lds_raw[];
    Frame F;
    F.lds = (LAS unsigned char*)lds_raw;
    F.tid = threadIdx.x; F.lane = (int)__builtin_amdgcn_mbcnt_hi(~0u, __builtin_amdgcn_mbcnt_lo(~0u, 0u)); F.wave = __builtin_amdgcn_readfirstlane(F.tid >> 6);
    F.G = gridDim.x; F.gw = blockIdx.x * NWAVES + F.wave; F.ngw = F.G * NWAVES;
    F.in_XP = args.in[0]; F.in_XS = args.in[1]; F.in_WIN = args.in[2]; F.in_WCONV = args.in[3]; F.in_BCONV = args.in[4]; F.in_WR = args.in[5]; F.in_BR = args.in[6]; F.in_WI = args.in[7]; F.in_BI = args.in[8]; F.in_LAM = args.in[9]; F.in_RPB = args.in[10]; F.in_WNO = args.in[11]; F.in_WLO = args.in[12]; F.in_WM = args.in[13]; F.in_BM = args.in[14]; F.in_WOUT = args.in[15]; F.in_GMPRE = args.in[16]; F.in_GMPOST = args.in[17]; F.in_GFPRE = args.in[18]; F.in_GFPOST = args.in[19]; F.in_WFG = args.in[20]; F.in_WFU = args.in[21]; F.in_WFD = args.in[22];
    F.out = args.out; F.ws = args.ws;
    volatile LAS unsigned* MISC = (volatile LAS unsigned*)(F.lds + LDS_MISC);
    if (F.tid < 256) MISC[F.tid] = 0u;
    __syncthreads();
    const int lo = args.ph_lo, hi = args.ph_hi;
    const bool fused = (hi - lo) > 1;
    XcdBarrier bar; bar.bar = (unsigned*)(F.ws + WS_CTL); bar.x = 0; bar.st = nullptr;
    if (fused) bar = xcd_barrier_post((unsigned*)(F.ws + WS_CTL), MISC + 8);
#ifndef PH_MASK
#define PH_MASK 0xfff
#endif
#define IN(k) (((PH_MASK >> (k)) & 1) && lo <= (k) && (k) < hi)
#define SEAM(k) do { if (IN(k) && IN((k) + 1)) xcd_barrier(bar); } while (0)
    LAS unsigned char* stage = F.lds;

#ifdef ATTN_OUT_OFF
#define NA_BUF ((size_t)ATTN_OUT_OFF * MiB)
#else
#define NA_BUF WS_Q
#endif
#ifndef DUP_MASK
#define DUP_MASK 0
#endif
#define RUN(k, ...) if (IN(k)) { __VA_ARGS__ if (((DUP_MASK) >> (k)) & 1) { __VA_ARGS__ } }
    RUN(0, { p0_prologue(F); }) SEAM(0);
    RUN(1, {
        { pg8::Gemm g{wsp<bf16_t>(F, WS_XN8), wsp<bf16_t>(F, WS_XN8), 1 << 30, wsp<bf16_t>(F, WS_W8), L, 2 * NAW + 2 * D, D}; pg8::StaticOrder S; S.init(L, 2 * NAW + 2 * D, F.G, (int)blockIdx.x);
          pg8::EpiProjQ E{wsp<bf16_t>(F, WS_Q), wsp<bf16_t>(F, WS_K), (bf16_t*)F.out, F.in_BM, wsp<float>(F, WS_RS1), wsp<float>(F, WS_CS) + CS_QKM};
          pg8::gemm_phase<pg8::EpiProjQ, pg8::StaticOrder, true, true, 2>(stage, g, S, E); }
        { pg8::Gemm g{wsp<bf16_t>(F, WS_XN), wsp<bf16_t>(F, WS_XN), 1 << 30, wsp<bf16_t>(F, WS_WCAT), L, 2 * NAW, 2 * D}; pg8::StaticOrder S; S.init(L, 2 * NAW, F.G, (int)blockIdx.x);
          pg8::EpiProj E{wsp<bf16_t>(F, WS_XR), wsp<bf16_t>(F, WS_GR), wsp<bf16_t>(F, WS_GR), wsp<bf16_t>(F, WS_GR), (bf16_t*)F.out, F.in_BM, 1 << 30};
          pg8::gemm_phase<pg8::EpiProj, pg8::StaticOrder, true, true, 0>(stage, g, S, E); }
        { pg8::Gemm g{wsp<bf16_t>(F, WS_WVT), wsp<bf16_t>(F, WS_WVT), 1 << 30, wsp<bf16_t>(F, WS_XN8), NAW, L, D}; pg8::StaticOrder S; S.init(NAW, L, F.G, (int)blockIdx.x);
          pg8::EpiVTQ E{wsp<bf16_t>(F, WS_VT), wsp<float>(F, WS_CS) + CS_V, wsp<float>(F, WS_RS1)};
          pg8::gemm_phase<pg8::EpiVTQ, pg8::StaticOrder, true, true, 2>(stage, g, S, E); }
    }) SEAM(1);
    RUN(2, { lru_pass_a(F); }) SEAM(2);
    #ifdef ATTN_OUT_OFF
    if (IN(3)) { lru_pass_b(F); } SEAM(3);
    if (IN(4)) { lru_pass_c<0>(F); xcd_barrier(bar); if (ATTN_DUP) attn_mfma<ATTN_DUP - 1>(F); attn_mfma<0>(F); } SEAM(4);
#else
    if (IN(3)) { lru_pass_b(F); attn_mfma_lds(F); } SEAM(3);
#ifdef LRUC_DBG
    if (IN(4)) { lru_pass_c<LRUC_DBG>(F); lru_pass_c<0>(F); } SEAM(4);
#else
    RUN(4, { lru_pass_c<0>(F); }) SEAM(4);
#endif
#endif
    if (IN(5)) {
        { pg8::Gemm g{wsp<bf16_t>(F, NA_BUF), wsp<bf16_t>(F, NA_BUF), 1 << 30, wsp<bf16_t>(F, WS_WNO), L, D, 2 * NAW}; pg8::StaticOrder S; S.init(L, D, F.G, (int)blockIdx.x);
          pg8::EpiMulG<false> E{wsp<bf16_t>(F, WS_T1), (const bf16_t*)F.out, 0};
          pg8::gemm_phase<pg8::EpiMulG<false>, pg8::StaticOrder, true, true>(stage, g, S, E); }
        { pg8::Gemm g{wsp<bf16_t>(F, WS_XR), wsp<bf16_t>(F, WS_XR), 1 << 30, wsp<bf16_t>(F, WS_WLO), L, D, 2 * LW}; pg8::StaticOrder S; S.init(L, D, F.G, (int)blockIdx.x);
          pg8::EpiMulG<true> E{wsp<bf16_t>(F, WS_T1), (const bf16_t*)F.out, D};
          pg8::gemm_phase<pg8::EpiMulG<true>, pg8::StaticOrder, true, true>(stage, g, S, E); }
    } SEAM(5);
    RUN(6, {
        pg8::Gemm g{wsp<bf16_t>(F, WS_T1), wsp<bf16_t>(F, WS_T1), 1 << 30, wsp<bf16_t>(F, WS_WO), L, D, 2 * D}; pg8::StaticOrder S; S.init(L, D, F.G, (int)blockIdx.x);
        pg8::EpiPlain E{wsp<bf16_t>(F, WS_MIX), D};
        pg8::gemm_phase<pg8::EpiPlain, pg8::StaticOrder, true, true>(stage, g, S, E);
    }) SEAM(6);
    RUN(7, { mid_phase(F); }) SEAM(7);
    RUN(8, {
        pg8::Gemm g{wsp<bf16_t>(F, WS_XN8), wsp<bf16_t>(F, WS_XN8), 1 << 30, wsp<bf16_t>(F, WS_WGU), L, 2 * DFF, D}; pg8::StaticOrder S; S.init(L, 2 * DFF, F.G, (int)blockIdx.x);
        pg8::EpiSwigluQ E{(bf16_t*)F.out, wsp<bf16_t>(F, WS_HIDS), LP / 256, wsp<float>(F, WS_RS2), wsp<float>(F, WS_CS) + CS_GU};
        pg8::gemm_phase<pg8::EpiSwigluQ, pg8::StaticOrder, false, true, 2>(stage, g, S, E);
        { const int rem = S.nwg % F.G;
          if ((int)blockIdx.x >= rem) hq_wtiles(F, 0, HQW_EARLY, ((int)blockIdx.x - rem) * NWAVES + F.wave, (F.G - rem) * NWAVES); }
    }) SEAM(8);
    RUN(9, { hq_phase(F); }) SEAM(9);
    RUN(10, {
        pg8::Gemm g{wsp<bf16_t>(F, WS_H8P), wsp<bf16_t>(F, WS_H8S), LP / 256, wsp<bf16_t>(F, WS_WD), L, D, DFF}; pg8::StaticOrder S; S.init(L, D, F.G, (int)blockIdx.x);
        pg8::EpiPlainQ E{wsp<bf16_t>(F, WS_F), D, wsp<float>(F, WS_RS3), wsp<float>(F, WS_CS) + CS_D};
        pg8::gemm_phase<pg8::EpiPlainQ, pg8::StaticOrder, true, true, 2>(stage, g, S, E);
    }) SEAM(10);
    RUN(11, { final_phase(F); })
#undef RUN
#undef IN
#undef SEAM
}

extern "C" void kernel_launch(void* const* d_in, const int* in_sizes, int n_in, void* d_out, int out_size, void* d_ws, size_t ws_size, hipStream_t stream) {
    static int grid = 0;
    if (grid == 0) {
        if (n_in != 23 || in_sizes[0] != LP * D || in_sizes[1] != LS * D || out_size != L * D || ws_size < WS_END) {
            fprintf(stderr, "kernel_launch: unexpected shapes: n_in %d in0 %d out %d ws %zu (need %zu)\n", n_in, n_in > 0 ? in_sizes[0] : -1, out_size, ws_size, (size_t)WS_END); grid = -1; return; }
        int dev = 0, cus = 0, per_cu = 0;
        if (hipGetDevice(&dev) != hipSuccess || hipDeviceGetAttribute(&cus, hipDeviceAttributeMultiprocessorCount, dev) != hipSuccess) { grid = -1; return; }
        if (hipFuncSetAttribute((const void*)fwd_kernel, hipFuncAttributeMaxDynamicSharedMemorySize, LDS_BYTES) != hipSuccess) { fprintf(stderr, "kernel_launch: hipFuncSetAttribute failed\n"); grid = -1; return; }
        if (hipOccupancyMaxActiveBlocksPerMultiprocessor(&per_cu, (const void*)fwd_kernel, NTHR, LDS_BYTES) != hipSuccess || per_cu < 1) { fprintf(stderr, "kernel_launch: occupancy query says %d\n", per_cu); }
        (void)hipGetLastError();
        grid = cus;
    }
    if (grid < 0) return;
    (void)hipMemsetAsync((char*)d_ws + WS_CTL, 0, CTL_ZERO_BYTES, stream);
#ifdef DBG_ZERO_ALL
    (void)hipMemsetAsync((char*)d_ws, 0, WS_END, stream); (void)hipMemsetAsync((char*)d_out, 0, (size_t)L * D * 4, stream);
#endif
    Args a{};
    for (int i = 0; i < 23; ++i) a.in[i] = (const float*)d_in[i];
    a.out = (float*)d_out; a.ws = (unsigned char*)d_ws;
#if MK_N_LAUNCHES == 1
    a.ph_lo = 0; a.ph_hi = NPHASE;
    hipLaunchKernelGGL(fwd_kernel, dim3(grid), dim3(NTHR), LDS_BYTES, stream, a);
#else
    for (int p = 0; p < NPHASE; ++p) {
#ifdef DBG_PH_MASK
        if (!((DBG_PH_MASK >> p) & 1)) continue;
#endif
        a.ph_lo = p; a.ph_hi = p + 1; hipLaunchKernelGGL(fwd_kernel, dim3(grid), dim3(NTHR), LDS_BYTES, stream, a); }
#endif
}
```

```cpp
#include <hip/hip_runtime.h>
#include <cstdio>
#include <cstdint>

#define LAS __attribute__((address_space(3)))
typedef unsigned short bf16_t;
typedef short bf16x8 __attribute__((ext_vector_type(8)));
typedef float f32x4 __attribute__((ext_vector_type(4)));
typedef float f32x2 __attribute__((ext_vector_type(2)));
typedef unsigned u32x4 __attribute__((ext_vector_type(4)));
typedef unsigned u32x2 __attribute__((ext_vector_type(2)));

constexpr int D = 4096, LP = 16384, LS = 8192, L = LP + LS;
constexpr int GRIDW = 64, HD = 128, NH = 16, NAW = 2048, LW = 2048, NBLK = 16, BW = 128, DFF = 11008, INW = 10240;
constexpr float EPS = 1e-6f;
constexpr int NWAVES = 8, NTHR = 512;

constexpr size_t MiB = 1u << 20;
constexpr size_t WS_CTL = 0, CTL_ZERO_BYTES = 64 * 1024;
constexpr size_t WS_AM = 32 * 1024;
constexpr size_t WS_RSTD = 1 * MiB;
constexpr size_t WS_RS1 = 1 * MiB + 128 * 1024;
constexpr size_t WS_RS2 = 1 * MiB + 256 * 1024;
constexpr size_t WS_CS = 1 * MiB + 384 * 1024;
constexpr size_t WS_SUM = 2 * MiB;
constexpr size_t WS_WCAT = 8 * MiB;
constexpr size_t WS_W8 = 40 * MiB;
constexpr size_t WS_WVT = 88 * MiB;
constexpr size_t WS_XN8 = 96 * MiB;
constexpr size_t WS_WNO = 192 * MiB;
constexpr size_t WS_WLO = 208 * MiB;
constexpr size_t WS_WO = 224 * MiB;
constexpr size_t WS_WGU = 256 * MiB;
constexpr size_t WS_WD = 342 * MiB;
constexpr size_t WS_WG = 428 * MiB;
constexpr size_t WS_XN = 430 * MiB;
constexpr size_t WS_Q = 622 * MiB;
constexpr size_t WS_XR = 718 * MiB;
constexpr size_t WS_K = 814 * MiB;
constexpr size_t WS_VT = 910 * MiB;
constexpr size_t WS_GR = 1006 * MiB;
constexpr size_t WS_XC = 1102 * MiB;
constexpr size_t WS_END = 1198 * MiB;
constexpr int CS_QKM = 0, CS_V = 12288, CS_GU = 12288 + 2048, CS_D = 12288 + 2048 + 22016;
constexpr size_t WS_RS3 = 1 * MiB + 640 * 1024;
constexpr size_t WS_H8P = WS_XN, WS_H8S = WS_XN8;
constexpr size_t WS_T1 = WS_K;
constexpr size_t WS_MIX = WS_GR;
constexpr size_t WS_HIDS = WS_Q;
constexpr size_t WS_F = WS_K;
constexpr size_t WS_HF = WS_K;

#define LDS_WAIT() asm volatile("s_waitcnt lgkmcnt(0)" ::: "memory")
#define VM_WAIT() asm volatile("s_waitcnt vmcnt(0)" ::: "memory")
typedef __bf16 bf16x2n_t __attribute__((ext_vector_type(2)));
__device__ __forceinline__ unsigned pk2(float lo, float hi) { const bf16x2n_t r = __builtin_convertvector((f32x2){lo, hi}, bf16x2n_t); return __builtin_bit_cast(unsigned, r); }
__device__ __forceinline__ unsigned f2bf(float f) { return pk2(f, 0.f) & 0xffffu; }
__device__ __forceinline__ float bflo(unsigned u) { return __builtin_bit_cast(float, u << 16); }
__device__ __forceinline__ float bfhi(unsigned u) { return __builtin_bit_cast(float, u & 0xffff0000u); }
__device__ __forceinline__ float bf1(bf16_t u) { return __builtin_bit_cast(float, (unsigned)u << 16); }
__device__ __forceinline__ float wave_sum(float v) {
#pragma unroll
    for (int o = 1; o < 64; o <<= 1) v += __shfl_xor(v, o);
    return v;
}
__device__ __forceinline__ float wave_max(float v) {
#pragma unroll
    for (int o = 1; o < 64; o <<= 1) v = fmaxf(v, __shfl_xor(v, o));
    return v;
}
__device__ __forceinline__ float sigmoidf_(float v) { return __builtin_amdgcn_rcpf(1.0f + __expf(-v)); }
__device__ __forceinline__ float gelu_tanh(float v) { const float z = v * __builtin_fmaf(v * v, -0.1029432f, -2.3022082f); return v * __builtin_amdgcn_rcpf(1.0f + __builtin_amdgcn_exp2f(z)); }

namespace pg8 {
constexpr int BM = 256, BK = 64, HALF = 128, HTB = HALF * BK * 2  , STAGE_BYTES = 8 * HTB, NXCD = 8, WGM = 4;

__host__ __device__ __forceinline__ int lds_byte(int r, int c) { return (r >> 3) * 1024 + (r & 7) * 128 + ((((c >> 3) ^ r) & 7) << 4) + (c & 7) * 2; }
__host__ __device__ __forceinline__ void stage_rc(int b, int& R, int& C) { const int ch = b >> 10, rr = (b >> 7) & 7, slot = (b >> 4) & 7; R = ch * 8 + rr; C = ((slot ^ rr) & 7) * 8; }
__host__ __device__ __forceinline__ int perm32(int rho) { const int n = rho >> 4, i = rho & 15; return 8 * (i >> 2) + 4 * n + (i & 3); }

struct Unit { int pm, pn; };
struct Gemm {
    const bf16_t* A; const bf16_t* A2; int pm_split; const bf16_t* Bt; int M, N, rb;
    __device__ __forceinline__ const char* abase(int pm) const { const size_t t = (size_t)BM * rb; return pm < pm_split ? (const char*)A + (size_t)pm * t : (const char*)A2 + (size_t)(pm - pm_split) * t; }
    __device__ __forceinline__ const char* bbase(int pn) const { return (const char*)Bt + (size_t)pn * BM * rb; }
};

struct StaticOrder {
    int nM, nN, nwg, G, c;
    __host__ __device__ void init(int M, int N, int G_, int c_) { nM = M / BM; nN = N / BM; nwg = nM * nN; G = G_; c = c_; }
    __host__ __device__ bool next(int i, Unit& u) const {
        const long Lx = (long)i * G + c; if (Lx >= nwg) return false;
        int wgid = (int)Lx; { const int q = nwg / NXCD, r = nwg % NXCD, xcd = wgid % NXCD, off = wgid / NXCD; wgid = (xcd < r ? xcd * (q + 1) : r * (q + 1) + (xcd - r) * q) + off; }
        const int nig = WGM * nN, gid = wgid / nig, fm = gid * WGM, gsz = (nM - fm) < WGM ? (nM - fm) : WGM;
        u.pm = fm + ((wgid % nig) % gsz); u.pn = (wgid % nig) / gsz; return true;
    }
    __device__ __forceinline__ void a_ready(const Unit&) const {}
    __device__ __forceinline__ void done(const Unit&) const {}
};

typedef int v8i32 __attribute__((ext_vector_type(8)));
typedef int v4i32 __attribute__((ext_vector_type(4)));
typedef __bf16 bf16x2_t __attribute__((ext_vector_type(2)));
__device__ __forceinline__ unsigned cvt_pk_bf16(float lo, float hi) { const bf16x2_t r = __builtin_convertvector((f32x2){lo, hi}, bf16x2_t); return __builtin_bit_cast(unsigned, r); }
__device__ __forceinline__ u32x4 pack8(const f32x4 v0, const f32x4 v1) { u32x4 w; w.x = cvt_pk_bf16(v0[0], v0[1]); w.y = cvt_pk_bf16(v0[2], v0[3]); w.z = cvt_pk_bf16(v1[0], v1[1]); w.w = cvt_pk_bf16(v1[2], v1[3]); return w; }
__device__ __forceinline__ void unpack8(const u32x4 w, f32x4& v0, f32x4& v1) { v0 = (f32x4){bflo(w.x), bfhi(w.x), bflo(w.y), bfhi(w.y)}; v1 = (f32x4){bflo(w.z), bfhi(w.z), bflo(w.w), bfhi(w.w)}; }
__device__ __forceinline__ f32x4 sig4(const f32x4 v) { f32x4 r; r[0] = sigmoidf_(v[0]); r[1] = sigmoidf_(v[1]); r[2] = sigmoidf_(v[2]); r[3] = sigmoidf_(v[3]); return r; }

struct EpiPlain {
    static constexpr bool PERM = true, AFTER_DRAIN = false;
    bf16_t* O; int ldc;
    __device__ __forceinline__ void operator()(const f32x4 (&acc)[2][2][4][2], const Unit& u, int wr, int wc, int fr, int fq) const {
        const int row0 = u.pm * BM + wr * 64 + fr, col0 = u.pn * BM + wc * 32 + 8 * fq;
#pragma unroll
        for (int ai = 0; ai < 2; ++ai)
#pragma unroll
            for (int m = 0; m < 4; ++m) { bf16_t* rowp = O + (size_t)(row0 + ai * HALF + m * 16) * ldc + col0;
#pragma unroll
                for (int bj = 0; bj < 2; ++bj) *(u32x4*)(rowp + bj * HALF) = pack8(acc[ai][bj][m][0], acc[ai][bj][m][1]); }
    }
};
struct EpiVT {
    static constexpr bool PERM = true, AFTER_DRAIN = false;
    bf16_t* O;
    __device__ __forceinline__ void operator()(const f32x4 (&acc)[2][2][4][2], const Unit& u, int wr, int wc, int fr, int fq) const {
        const int row0 = u.pm * BM + wr * 64 + fr, col0 = u.pn * BM + wc * 32 + 8 * fq;
#pragma unroll
        for (int ai = 0; ai < 2; ++ai)
#pragma unroll
            for (int m = 0; m < 4; ++m) { const int row = row0 + ai * HALF + m * 16, hh = row >> 7, d = row & 127;
                const int dt = 2 * (d >> 5) + ((d >> 2) & 1), i = 4 * ((d >> 3) & 3) + (d & 3);
#pragma unroll
                for (int bj = 0; bj < 2; ++bj) { const int tok = col0 + bj * HALF, R = tok >> 6, o = (tok & 63) >> 3;
                    *(u32x4*)(O + ((size_t)((((R * 16 + hh) * 8 + dt) * 8 + o) * 16 + i)) * 8) = pack8(acc[ai][bj][m][0], acc[ai][bj][m][1]); } }
    }
};
struct EpiProj {
    static constexpr bool PERM = true, AFTER_DRAIN = false;
    bf16_t* P0; bf16_t* P1; bf16_t* P2; bf16_t* P3; bf16_t* G; const float* bias; int pn_gate0;
    __device__ __forceinline__ void operator()(const f32x4 (&acc)[2][2][4][2], const Unit& u, int wr, int wc, int fr, int fq) const {
        const int row0 = u.pm * BM + wr * 64 + fr;
        if (u.pn < pn_gate0) {
            const int t = u.pn >> 3; bf16_t* base = t == 0 ? P0 : (t == 1 ? P1 : (t == 2 ? P2 : P3));
            const int col0 = (u.pn & 7) * BM + wc * 32 + 8 * fq;
            if (t == 2) {
#pragma unroll
                for (int ai = 0; ai < 2; ++ai)
#pragma unroll
                    for (int m = 0; m < 4; ++m) { const int tok = row0 + ai * HALF + m * 16, R = tok >> 6, cl = tok & 63;
                        const int tokpart = (((cl >> 2) & 1) * 8 + (cl >> 3)) * 4 + (cl & 3);
#pragma unroll
                        for (int bj = 0; bj < 2; ++bj) { const int c = col0 + bj * HALF, hh = c >> 7, d0 = c & 127;
                            *(u32x4*)(base + ((size_t)(((R * 16 + hh) * 4 + (d0 >> 5)) * 64 + tokpart) * 4 + ((d0 >> 3) & 3)) * 8) = pack8(acc[ai][bj][m][0], acc[ai][bj][m][1]); } }
            } else {
#pragma unroll
            for (int ai = 0; ai < 2; ++ai)
#pragma unroll
                for (int m = 0; m < 4; ++m) { bf16_t* rowp = base + (size_t)(row0 + ai * HALF + m * 16) * NAW + col0;
#pragma unroll
                    for (int bj = 0; bj < 2; ++bj) *(u32x4*)(rowp + bj * HALF) = pack8(acc[ai][bj][m][0], acc[ai][bj][m][1]); }
            }
        } else {
            const int col0 = (u.pn - pn_gate0) * BM + wc * 32 + 8 * fq;
            f32x4 bv[2][2];
#pragma unroll
            for (int bj = 0; bj < 2; ++bj)
#pragma unroll
                for (int n = 0; n < 2; ++n) bv[bj][n] = *(const f32x4*)(bias + col0 + bj * HALF + 4 * n);
#pragma unroll
            for (int ai = 0; ai < 2; ++ai)
#pragma unroll
                for (int m = 0; m < 4; ++m) { bf16_t* rowp = G + (size_t)(row0 + ai * HALF + m * 16) * (2 * D) + col0;
#pragma unroll
                    for (int bj = 0; bj < 2; ++bj) *(u32x4*)(rowp + bj * HALF) = pack8(sig4(acc[ai][bj][m][0] + bv[bj][0]), sig4(acc[ai][bj][m][1] + bv[bj][1])); }
        }
    }
};
template <bool ADD> struct EpiMulG {
    static constexpr bool PERM = true, AFTER_DRAIN = false;
    bf16_t* O; const bf16_t* G; int goff;
    __device__ __forceinline__ void operator()(const f32x4 (&acc)[2][2][4][2], const Unit& u, int wr, int wc, int fr, int fq) const {
        const int row0 = u.pm * BM + wr * 64 + fr, col0 = u.pn * BM + wc * 32 + 8 * fq;
#pragma unroll
        for (int ai = 0; ai < 2; ++ai)
#pragma unroll
            for (int m = 0; m < 4; ++m) { const size_t row = (size_t)(row0 + ai * HALF + m * 16); bf16_t* rowp = O + row * D + col0; const bf16_t* gp = G + row * (2 * D) + goff + col0;
#pragma unroll
                for (int bj = 0; bj < 2; ++bj) {
                    f32x4 g0, g1; unpack8(*(const u32x4*)(gp + bj * HALF), g0, g1);
                    f32x4 v0 = acc[ai][bj][m][0] * g0, v1 = acc[ai][bj][m][1] * g1;
                    if (ADD) { f32x4 t0, t1; unpack8(*(const u32x4*)(rowp + bj * HALF), t0, t1); v0 += t0; v1 += t1; }
                    *(u32x4*)(rowp + bj * HALF) = pack8(v0, v1); } }
    }
};
struct EpiSwiglu {
    static constexpr bool PERM = true, AFTER_DRAIN = false;
    bf16_t* H0; bf16_t* H1; int pm_split;
    __device__ __forceinline__ void operator()(const f32x4 (&acc)[2][2][4][2], const Unit& u, int wr, int wc, int fr, int fq) const {
        bf16_t* base = u.pm < pm_split ? H0 + (size_t)u.pm * BM * DFF : H1 + (size_t)(u.pm - pm_split) * BM * DFF;
        const int row0 = wr * 64 + fr, col0 = u.pn * HALF + wc * 32 + 8 * fq;
#pragma unroll
        for (int ai = 0; ai < 2; ++ai)
#pragma unroll
            for (int m = 0; m < 4; ++m) {
                f32x4 h[2];
#pragma unroll
                for (int n = 0; n < 2; ++n) { const f32x4 g = acc[ai][0][m][n], up = acc[ai][1][m][n];
#pragma unroll
                    for (int j = 0; j < 4; ++j) h[n][j] = g[j] * sigmoidf_(g[j]) * up[j]; }
                *(u32x4*)(base + (size_t)(row0 + ai * HALF + m * 16) * DFF + col0) = pack8(h[0], h[1]); }
    }
};

__device__ __forceinline__ f32x4 deq4(const f32x4 accbits, const float sa, const f32x4 sb) { const v4i32 q = __builtin_bit_cast(v4i32, accbits); return (f32x4){(float)q.x, (float)q.y, (float)q.z, (float)q.w} * sa * sb; }
struct EpiProjQ {
    static constexpr bool PERM = true, AFTER_DRAIN = false;
    bf16_t* Qb; bf16_t* Kb; bf16_t* G; const float* bias; const float* sa; const float* sb;
    __device__ __forceinline__ void operator()(const f32x4 (&acc)[2][2][4][2], const Unit& u, int wr, int wc, int fr, int fq) const {
        const int row0 = u.pm * BM + wr * 64 + fr, cg0 = u.pn * BM + wc * 32 + 8 * fq;
        f32x4 sbv[2][2];
#pragma unroll
        for (int bj = 0; bj < 2; ++bj)
#pragma unroll
            for (int n = 0; n < 2; ++n) sbv[bj][n] = *(const f32x4*)(sb + cg0 + bj * HALF + 4 * n);
        if (u.pn < 8) {
            const int col0 = u.pn * BM + wc * 32 + 8 * fq;
#pragma unroll
            for (int ai = 0; ai < 2; ++ai)
#pragma unroll
                for (int m = 0; m < 4; ++m) { const int row = row0 + ai * HALF + m * 16; const float sr = sa[row]; bf16_t* rowp = Qb + (size_t)row * NAW + col0;
#pragma unroll
                    for (int bj = 0; bj < 2; ++bj) *(u32x4*)(rowp + bj * HALF) = pack8(deq4(acc[ai][bj][m][0], sr, sbv[bj][0]), deq4(acc[ai][bj][m][1], sr, sbv[bj][1])); }
        } else if (u.pn < 16) {
            const int col0 = (u.pn - 8) * BM + wc * 32 + 8 * fq;
#pragma unroll
            for (int ai = 0; ai < 2; ++ai)
#pragma unroll
                for (int m = 0; m < 4; ++m) { const int tok = row0 + ai * HALF + m * 16, R = tok >> 6, cl = tok & 63; const float sr = sa[tok];
                    const int tokpart = (((cl >> 2) & 1) * 8 + (cl >> 3)) * 4 + (cl & 3);
#pragma unroll
                    for (int bj = 0; bj < 2; ++bj) { const int c = col0 + bj * HALF, hh = c >> 7, d0 = c & 127;
                        *(u32x4*)(Kb + ((size_t)(((R * 16 + hh) * 4 + (d0 >> 5)) * 64 + tokpart) * 4 + ((d0 >> 3) & 3)) * 8) = pack8(deq4(acc[ai][bj][m][0], sr, sbv[bj][0]), deq4(acc[ai][bj][m][1], sr, sbv[bj][1])); } }
        } else {
            const int col0 = (u.pn - 16) * BM + wc * 32 + 8 * fq;
            f32x4 bv[2][2];
#pragma unroll
            for (int bj = 0; bj < 2; ++bj)
#pragma unroll
                for (int n = 0; n < 2; ++n) bv[bj][n] = *(const f32x4*)(bias + col0 + bj * HALF + 4 * n);
#pragma unroll
            for (int ai = 0; ai < 2; ++ai)
#pragma unroll
                for (int m = 0; m < 4; ++m) { const int row = row0 + ai * HALF + m * 16; const float sr = sa[row]; bf16_t* rowp = G + (size_t)row * (2 * D) + col0;
#pragma unroll
                    for (int bj = 0; bj < 2; ++bj) *(u32x4*)(rowp + bj * HALF) = pack8(sig4(deq4(acc[ai][bj][m][0], sr, sbv[bj][0]) + bv[bj][0]), sig4(deq4(acc[ai][bj][m][1], sr, sbv[bj][1]) + bv[bj][1])); }
        }
    }
};
struct EpiPlainQ {
    static constexpr bool PERM = true, AFTER_DRAIN = false;
    bf16_t* O; int ldc; const float* sa; const float* sb;
    __device__ __forceinline__ void operator()(const f32x4 (&acc)[2][2][4][2], const Unit& u, int wr, int wc, int fr, int fq) const {
        const int row0 = u.pm * BM + wr * 64 + fr, col0 = u.pn * BM + wc * 32 + 8 * fq;
        f32x4 sbv[2][2];
#pragma unroll
        for (int bj = 0; bj < 2; ++bj)
#pragma unroll
            for (int n = 0; n < 2; ++n) sbv[bj][n] = *(const f32x4*)(sb + col0 + bj * HALF + 4 * n);
#pragma unroll
        for (int ai = 0; ai < 2; ++ai)
#pragma unroll
            for (int m = 0; m < 4; ++m) { const int row = row0 + ai * HALF + m * 16; const float sr = sa[row]; bf16_t* rowp = O + (size_t)row * ldc + col0;
#pragma unroll
                for (int bj = 0; bj < 2; ++bj) *(u32x4*)(rowp + bj * HALF) = pack8(deq4(acc[ai][bj][m][0], sr, sbv[bj][0]), deq4(acc[ai][bj][m][1], sr, sbv[bj][1])); }
    }
};
struct EpiVTQ {
    static constexpr bool PERM = true, AFTER_DRAIN = false;
    bf16_t* O; const float* sa; const float* sb;
    __device__ __forceinline__ void operator()(const f32x4 (&acc)[2][2][4][2], const Unit& u, int wr, int wc, int fr, int fq) const {
        const int row0 = u.pm * BM + wr * 64 + fr, col0 = u.pn * BM + wc * 32 + 8 * fq;
        f32x4 sbv[2][2];
#pragma unroll
        for (int bj = 0; bj < 2; ++bj)
#pragma unroll
            for (int n = 0; n < 2; ++n) sbv[bj][n] = *(const f32x4*)(sb + col0 + bj * HALF + 4 * n);
#pragma unroll
        for (int ai = 0; ai < 2; ++ai)
#pragma unroll
            for (int m = 0; m < 4; ++m) { const int row = row0 + ai * HALF + m * 16, hh = row >> 7, d = row & 127; const float sr = sa[row];
                const int dt = 2 * (d >> 5) + ((d >> 2) & 1), i = 4 * ((d >> 3) & 3) + (d & 3);
#pragma unroll
                for (int bj = 0; bj < 2; ++bj) { const int tok = col0 + bj * HALF, R = tok >> 6, o = (tok & 63) >> 3;
                    *(u32x4*)(O + ((size_t)((((R * 16 + hh) * 8 + dt) * 8 + o) * 16 + i)) * 8) = pack8(deq4(acc[ai][bj][m][0], sr, sbv[bj][0]), deq4(acc[ai][bj][m][1], sr, sbv[bj][1])); } }
    }
};
struct EpiSwigluQ {
    static constexpr bool PERM = true, AFTER_DRAIN = false;
    bf16_t* H0; bf16_t* H1; int pm_split; const float* sa; const float* sb;
    __device__ __forceinline__ void operator()(const f32x4 (&acc)[2][2][4][2], const Unit& u, int wr, int wc, int fr, int fq) const {
        bf16_t* base = u.pm < pm_split ? H0 + (size_t)u.pm * BM * DFF : H1 + (size_t)(u.pm - pm_split) * BM * DFF;
        const int row0 = wr * 64 + fr, col0 = u.pn * HALF + wc * 32 + 8 * fq, cg0 = u.pn * BM + wc * 32 + 8 * fq;
        f32x4 sbv[2][2];
#pragma unroll
        for (int bj = 0; bj < 2; ++bj)
#pragma unroll
            for (int n = 0; n < 2; ++n) sbv[bj][n] = *(const f32x4*)(sb + cg0 + bj * HALF + 4 * n);
#pragma unroll
        for (int ai = 0; ai < 2; ++ai)
#pragma unroll
            for (int m = 0; m < 4; ++m) { const float sr = sa[u.pm * BM + row0 + ai * HALF + m * 16];
                f32x4 h[2];
#pragma unroll
                for (int n = 0; n < 2; ++n) { const f32x4 g = deq4(acc[ai][0][m][n], sr, sbv[0][n]), up = deq4(acc[ai][1][m][n], sr, sbv[1][n]);
#pragma unroll
                    for (int j = 0; j < 4; ++j) h[n][j] = g[j] * sigmoidf_(g[j]) * up[j]; }
                *(u32x4*)(base + (size_t)(row0 + ai * HALF + m * 16) * DFF + col0) = pack8(h[0], h[1]); }
    }
};

__device__ __forceinline__ v8i32 cat8(const bf16x8 lo, const bf16x8 hi) { return __builtin_shufflevector(__builtin_bit_cast(v4i32, lo), __builtin_bit_cast(v4i32, hi), 0, 1, 2, 3, 4, 5, 6, 7); }
__device__ __forceinline__ void mfma_fp8_acc(f32x4& c, const v8i32 a, const v8i32 b, int sa, int sb) {
    asm volatile("v_mfma_scale_f32_16x16x128_f8f6f4 %0, %1, %2, %0, %3, %4 op_sel_hi:[0,0,0]" : "+v"(c) : "v"(a), "v"(b), "v"(sa), "v"(sb)); }
constexpr int FP8_SCALE = 0x73737373;
template <class Epi, class Sched, bool ALIGN_EPI = false, bool SP2 = false, int QM = 0  , int DBG = 0>
__device__ __forceinline__ void gemm_phase(LAS unsigned char* lds, const Gemm g, const Sched& S, const Epi& E) {
    int tid = threadIdx.x; asm volatile("" : "+v"(tid));
    const int wid = __builtin_amdgcn_readfirstlane(tid >> 6), lane = tid & 63, wr = wid >> 2, wc = wid & 3, fr = lane & 15, fq = lane >> 4;
    const int RB = g.rb, nt = RB / (BK * 2);
    unsigned voffA[2], voffB[2];
#pragma unroll
    for (int i = 0; i < 2; ++i) { int R, C; stage_rc(tid * 16 + i * 8192, R, C); const int Rb = Epi::PERM ? ((R & ~31) + perm32(R & 31)) : R;
        voffA[i] = (unsigned)(R * RB + C * 2); voffB[i] = (unsigned)(Rb * RB + C * 2); }
    const size_t kstep = (size_t)(BK * 2);
    const size_t hstep = (size_t)HALF * RB;
    const unsigned ldsw = (unsigned)wid * 1024u;
    const int aoff0 = lds_byte(wr * 64 + fr, fq * 8), aoff1 = lds_byte(wr * 64 + fr, 32 + fq * 8), boff0 = lds_byte(wc * 32 + fr, fq * 8), boff1 = lds_byte(wc * 32 + fr, 32 + fq * 8);
#define PG8_SA(b, h) (((b) * 2 + (h)) * HTB)
#define PG8_SB(b, h) ((4 + (b) * 2 + (h)) * HTB)
#define PG8_STAGE(bufoff, gbase, voff) do { if constexpr (DBG != 3) _Pragma("unroll") for (int _i = 0; _i < 2; ++_i) \
        __builtin_amdgcn_global_load_lds((const unsigned*)((const char*)(gbase) + (voff)[_i]), (LAS unsigned*)(lds + (bufoff) + ldsw + _i * 8192), 16, 0, 0); } while (0)
#define PG8_LDA(dst, b, h) do { if constexpr (DBG != 2) _Pragma("unroll") for (int m = 0; m < 4; ++m) _Pragma("unroll") for (int k = 0; k < 2; ++k) dst[m][k] = *(const LAS bf16x8*)(lds + PG8_SA(b, h) + (k ? aoff1 : aoff0) + m * 2048); } while (0)
#define PG8_LDB(dst, b, h) do { if constexpr (DBG != 2) _Pragma("unroll") for (int n = 0; n < 2; ++n) _Pragma("unroll") for (int k = 0; k < 2; ++k) dst[n][k] = *(const LAS bf16x8*)(lds + PG8_SB(b, h) + (k ? boff1 : boff0) + n * 2048); } while (0)
#define PG8_MMA(ai, bj, At, Bt) do { __builtin_amdgcn_s_setprio(1); if constexpr (DBG == 1) { } else if constexpr (QM == 2) { _Pragma("unroll") for (int m = 0; m < 4; ++m) _Pragma("unroll") for (int n = 0; n < 2; ++n) _Pragma("unroll") for (int k = 0; k < 2; ++k) \
        acc[ai][bj][m][n] = __builtin_bit_cast(f32x4, __builtin_amdgcn_mfma_i32_16x16x64_i8(__builtin_bit_cast(v4i32, Bt[n][k]), __builtin_bit_cast(v4i32, At[m][k]), __builtin_bit_cast(v4i32, acc[ai][bj][m][n]), 0, 0, 0)); } else if constexpr (QM == 1) { _Pragma("unroll") for (int m = 0; m < 4; ++m) _Pragma("unroll") for (int n = 0; n < 2; ++n) \
        mfma_fp8_acc(acc[ai][bj][m][n], cat8(Bt[n][0], Bt[n][1]), cat8(At[m][0], At[m][1]), fp8_sa, fp8_sb); } else { \
        _Pragma("unroll") for (int m = 0; m < 4; ++m) _Pragma("unroll") for (int n = 0; n < 2; ++n) _Pragma("unroll") for (int k = 0; k < 2; ++k) \
        acc[ai][bj][m][n] = __builtin_amdgcn_mfma_f32_16x16x32_bf16(Bt[n][k], At[m][k], acc[ai][bj][m][n], 0, 0, 0); } __builtin_amdgcn_s_setprio(0); } while (0)
#define PG8_WAIT_V(n) asm volatile("s_waitcnt vmcnt(" #n ")" ::: "memory")
#define PG8_WAIT_L(n) asm volatile("s_waitcnt lgkmcnt(" #n ")" ::: "memory")
#define PG8_BAR __builtin_amdgcn_s_barrier()
#define PG8_SCHED __builtin_amdgcn_sched_barrier(0)
    Unit cur, nxt; int ui = 0;
    const int fp8_sa = FP8_SCALE, fp8_sb = 0x7F7F7F7F;
    if (!S.next(0, cur)) return;
    f32x4 acc[2][2][4][2];
#pragma unroll
    for (int a = 0; a < 2; ++a)
#pragma unroll
        for (int b = 0; b < 2; ++b)
#pragma unroll
            for (int m = 0; m < 4; ++m)
#pragma unroll
                for (int n = 0; n < 2; ++n) acc[a][b][m][n] = (f32x4){0.f, 0.f, 0.f, 0.f};
    bf16x8 At[4][2], B0[2][2], B1[2][2];
    const char* cA = g.abase(cur.pm); const char* cB = g.bbase(cur.pn);
    S.a_ready(cur);
    if constexpr (SP2) {
        PG8_STAGE(PG8_SB(0, 0), cB, voffB); PG8_STAGE(PG8_SB(0, 1), cB + hstep, voffB); PG8_STAGE(PG8_SA(0, 0), cA, voffA); PG8_STAGE(PG8_SA(0, 1), cA + hstep, voffA);
        if (wr == 1) PG8_BAR;
        PG8_WAIT_V(2); PG8_BAR;
        PG8_STAGE(PG8_SB(1, 0), cB + kstep, voffB); PG8_STAGE(PG8_SA(1, 0), cA + kstep, voffA); PG8_STAGE(PG8_SB(1, 1), cB + hstep + kstep, voffB);
        PG8_WAIT_V(6); PG8_BAR;
    } else {
        PG8_STAGE(PG8_SB(0, 0), cB, voffB); PG8_STAGE(PG8_SA(0, 0), cA, voffA); PG8_STAGE(PG8_SB(0, 1), cB + hstep, voffB); PG8_STAGE(PG8_SA(0, 1), cA + hstep, voffA);
        if (wr == 1) PG8_BAR;
        PG8_WAIT_V(4); PG8_BAR;
        PG8_STAGE(PG8_SB(1, 0), cB + kstep, voffB); PG8_STAGE(PG8_SA(1, 0), cA + kstep, voffA); PG8_STAGE(PG8_SB(1, 1), cB + hstep + kstep, voffB);
        PG8_WAIT_V(6); PG8_BAR;
    }
    for (;;) {
        const bool has_next = S.next(ui + 1, nxt);
        const char* nA = has_next ? g.abase(nxt.pm) : cA; const char* nB = has_next ? g.bbase(nxt.pn) : cB;
        for (int t = 0; t < nt; t += 2) {
            const bool last = (t == nt - 2);
            const char* a1 = cA + (size_t)(t + 1) * kstep;
            const char* a2 = last ? nA : cA + (size_t)(t + 2) * kstep; const char* b2 = last ? nB : cB + (size_t)(t + 2) * kstep;
            const char* a3 = a2 + kstep; const char* b3 = b2 + kstep;
            if (last && has_next) S.a_ready(nxt);
            if constexpr (SP2) {
            PG8_LDB(B0, 0, 0); PG8_LDB(B1, 0, 1); PG8_SCHED; PG8_LDA(At, 0, 0); PG8_STAGE(PG8_SA(1, 1), a1 + hstep, voffA);
            PG8_WAIT_V(8); PG8_WAIT_L(0); PG8_BAR; PG8_MMA(0, 0, At, B0); PG8_MMA(0, 1, At, B1); PG8_BAR; PG8_SCHED;
            PG8_LDA(At, 0, 1); PG8_STAGE(PG8_SB(0, 0), b2, voffB); PG8_STAGE(PG8_SB(0, 1), b2 + hstep, voffB); PG8_STAGE(PG8_SA(0, 0), a2, voffA);
            PG8_WAIT_V(8); PG8_WAIT_L(0); PG8_BAR; PG8_MMA(1, 0, At, B0); PG8_MMA(1, 1, At, B1); PG8_BAR; PG8_SCHED;
            PG8_LDB(B0, 1, 0); PG8_LDB(B1, 1, 1); PG8_SCHED; PG8_LDA(At, 1, 0); PG8_STAGE(PG8_SA(0, 1), a2 + hstep, voffA);
            PG8_WAIT_V(8); PG8_WAIT_L(0); PG8_BAR; PG8_MMA(0, 0, At, B0); PG8_MMA(0, 1, At, B1); PG8_BAR; PG8_SCHED;
            PG8_LDA(At, 1, 1); PG8_STAGE(PG8_SB(1, 0), b3, voffB); PG8_STAGE(PG8_SB(1, 1), b3 + hstep, voffB); PG8_STAGE(PG8_SA(1, 0), a3, voffA);
            PG8_WAIT_V(8); PG8_WAIT_L(0); PG8_BAR; PG8_MMA(1, 0, At, B0); PG8_MMA(1, 1, At, B1); PG8_BAR; PG8_SCHED;
            } else {
            PG8_LDB(B0, 0, 0); PG8_SCHED; PG8_LDA(At, 0, 0); PG8_STAGE(PG8_SA(1, 1), a1 + hstep, voffA);
            PG8_WAIT_L(8); PG8_BAR; PG8_WAIT_L(0); PG8_MMA(0, 0, At, B0); PG8_BAR; PG8_SCHED;
            PG8_LDB(B1, 0, 1); PG8_STAGE(PG8_SB(0, 0), b2, voffB);
            PG8_BAR; PG8_WAIT_L(0); PG8_MMA(0, 1, At, B1); PG8_BAR;
            PG8_LDA(At, 0, 1); PG8_STAGE(PG8_SA(0, 0), a2, voffA);
            PG8_BAR; PG8_WAIT_L(0); PG8_MMA(1, 0, At, B0); PG8_BAR; PG8_SCHED;
            PG8_STAGE(PG8_SB(0, 1), b2 + hstep, voffB);
            PG8_WAIT_V(6); PG8_BAR; PG8_MMA(1, 1, At, B1); PG8_BAR;
            PG8_LDB(B0, 1, 0); PG8_SCHED; PG8_LDA(At, 1, 0); PG8_STAGE(PG8_SA(0, 1), a2 + hstep, voffA);
            PG8_WAIT_L(8); PG8_BAR; PG8_WAIT_L(0); PG8_MMA(0, 0, At, B0); PG8_BAR; PG8_SCHED;
            PG8_LDB(B1, 1, 1); PG8_STAGE(PG8_SB(1, 0), b3, voffB);
            PG8_BAR; PG8_WAIT_L(0); PG8_MMA(0, 1, At, B1); PG8_BAR;
            PG8_LDA(At, 1, 1); PG8_STAGE(PG8_SA(1, 0), a3, voffA);
            PG8_BAR; PG8_WAIT_L(0); PG8_MMA(1, 0, At, B0); PG8_BAR; PG8_SCHED;
            PG8_STAGE(PG8_SB(1, 1), b3 + hstep, voffB);
            PG8_WAIT_V(6); PG8_BAR; PG8_MMA(1, 1, At, B1); PG8_BAR;
            }
        }
        if constexpr (ALIGN_EPI) { if (wr == 0) PG8_BAR; }
        if constexpr (!Epi::AFTER_DRAIN) { if constexpr (DBG != 4) E(acc, cur, wr, wc, fr, fq); else { _Pragma("unroll") for (int a_ = 0; a_ < 2; ++a_) _Pragma("unroll") for (int b_ = 0; b_ < 2; ++b_) _Pragma("unroll") for (int m_ = 0; m_ < 4; ++m_) _Pragma("unroll") for (int n_ = 0; n_ < 2; ++n_) asm volatile("" :: "v"(acc[a_][b_][m_][n_])); } S.done(cur); }
        if (!has_next) break;
#pragma unroll
        for (int a = 0; a < 2; ++a)
#pragma unroll
            for (int b = 0; b < 2; ++b)
#pragma unroll
                for (int m = 0; m < 4; ++m)
#pragma unroll
                    for (int n = 0; n < 2; ++n) acc[a][b][m][n] = (f32x4){0.f, 0.f, 0.f, 0.f};
        cur = nxt; cA = nA; cB = nB; ++ui;
        if constexpr (ALIGN_EPI) { if (wr == 1) PG8_BAR; }
    }
    PG8_WAIT_V(0);
    if constexpr (!ALIGN_EPI) { if (wr == 0) PG8_BAR; }
    PG8_BAR;
    if constexpr (Epi::AFTER_DRAIN) { E.fused(acc, cur, wr, wc, fr, fq, lds, wid, lane); S.done(cur); }
#undef PG8_SA
#undef PG8_SB
#undef PG8_STAGE
#undef PG8_LDA
#undef PG8_LDB
#undef PG8_MMA
#undef PG8_WAIT_V
#undef PG8_WAIT_L
#undef PG8_BAR
#undef PG8_SCHED
}
}
#define XB_TMO      128
#define XB_XCNT(j)  (256  + 64 * (j))
#define XB_XSUB(j)  (1280 + 64 * (j))
#define XB_XGEN(j)  (2304 + 64 * (j))
#define XB_TOP      3328
#define XB_TOPGEN   3392
#define XCD_BAR_WORDS 3456
#define XB_SPIN_CAP (1u << 18)

__device__ __forceinline__ unsigned xb_ld(unsigned* p)              { return __hip_atomic_load(p, __ATOMIC_RELAXED, __HIP_MEMORY_SCOPE_AGENT); }
__device__ __forceinline__ unsigned xb_add(unsigned* p, unsigned v) { return __hip_atomic_fetch_add(p, v, __ATOMIC_RELAXED, __HIP_MEMORY_SCOPE_AGENT); }
__device__ __forceinline__ unsigned xb_xcc_id() { return (unsigned)__builtin_amdgcn_s_getreg((3 << 11) | 20) & 0xFu; }
#define XB_SPIN(cond, bar) do { unsigned _sp = 0; while (cond) { __builtin_amdgcn_s_sleep(1); \
    if ((++_sp & 255u) == 0u) { if (xb_ld(&(bar)[XB_TMO])) break; if (_sp > XB_SPIN_CAP) { atomicAdd(&(bar)[XB_TMO], 1u); break; } } } } while (0)

struct XcdBarrier {
    unsigned* bar; unsigned x;
    volatile LAS unsigned* st;
};

__device__ __forceinline__ XcdBarrier xcd_barrier_post(unsigned* bar, volatile LAS unsigned* st) {
    XcdBarrier b; b.bar = bar; b.x = xb_xcc_id(); b.st = st;
    if (threadIdx.x == 0) (void)xb_add(&bar[XB_XCNT(b.x)], 1u);
    return b;
}
__device__ __forceinline__ void xcd_barrier_complete(unsigned* bar, unsigned x, unsigned& nloc, unsigned& nx) {
    const unsigned G = gridDim.x * gridDim.y * gridDim.z;
    unsigned sum, cnt, mine, sp = 0u;
    for (;;) {
        sum = 0u; cnt = 0u; mine = 0u;
#pragma unroll
        for (unsigned j = 0; j < 16; ++j) { const unsigned c = xb_ld(&bar[XB_XCNT(j)]); sum += c; cnt += (c > 0u) ? 1u : 0u; mine = (j == x) ? c : mine; }
        if (sum == G) break;
        __builtin_amdgcn_s_sleep(1);
        if ((++sp & 255u) == 0u) { if (xb_ld(&bar[XB_TMO])) break; if (sp > XB_SPIN_CAP) { atomicAdd(&bar[XB_TMO], 1u); break; } }
    }
    nloc = mine > 0u ? mine : 1u; nx = cnt > 0u ? cnt : 1u;
}

__device__ __forceinline__ void xcd_barrier(const XcdBarrier& b) {
    asm volatile("s_waitcnt vmcnt(0)" ::: "memory");
    __syncthreads();
    if (threadIdx.x == 0) {
        unsigned* bar = b.bar;
        __builtin_amdgcn_s_waitcnt(0);
        unsigned nloc = b.st[0], nx = b.st[1];
        if (nloc == 0u) { xcd_barrier_complete(bar, b.x, nloc, nx); b.st[0] = nloc; b.st[1] = nx; }
        const unsigned old = xb_add(&bar[XB_XSUB(b.x)], 1u);
        const unsigned gen = old / nloc;
        if (old + 1u == (gen + 1u) * nloc) {
            __builtin_amdgcn_fence(__ATOMIC_RELEASE, "agent");
            asm volatile("s_waitcnt vmcnt(0)" ::: "memory");
            const unsigned og = xb_add(&bar[XB_TOP], 1u);
            const unsigned tg = og / nx;
            if (og + 1u == (tg + 1u) * nx) xb_add(&bar[XB_TOPGEN], 1u);
            else XB_SPIN(xb_ld(&bar[XB_TOPGEN]) == tg, bar);
            __builtin_amdgcn_fence(__ATOMIC_ACQUIRE, "agent");
            xb_add(&bar[XB_XGEN(b.x)], 1u);
            asm volatile("s_waitcnt vmcnt(0)" ::: "memory");
        } else {
            XB_SPIN(xb_ld(&bar[XB_XGEN(b.x)]) == gen, bar);
            __builtin_amdgcn_fence(__ATOMIC_ACQUIRE, "agent");
            asm volatile("s_waitcnt vmcnt(0)" ::: "memory");
        }
    }
    __syncthreads();
}


struct Frame {
    LAS unsigned char* lds;
    int tid, lane, wave, G, gw, ngw;
    const float *in_XP, *in_XS, *in_WIN, *in_WCONV, *in_BCONV, *in_WR, *in_BR, *in_WI, *in_BI, *in_LAM, *in_RPB, *in_WNO, *in_WLO, *in_WM, *in_BM, *in_WOUT, *in_GMPRE, *in_GMPOST, *in_GFPRE, *in_GFPOST, *in_WFG, *in_WFU, *in_WFD; float* out; unsigned char* ws;
};
enum { I_XP = 0, I_XS, I_WIN, I_WCONV, I_BCONV, I_WR, I_BR, I_WI, I_BI, I_LAM, I_RPB, I_WNO, I_WLO, I_WM, I_BM, I_WOUT, I_GMPRE, I_GMPOST, I_GFPRE, I_GFPOST, I_WFG, I_WFU, I_WFD };
__device__ __forceinline__ int opaque(int x) { asm volatile("" : "+v"(x)); return x; }
template <class T> __device__ __forceinline__ T* wsp(const Frame& F, size_t off) { return (T*)(F.ws + off); }
__device__ __forceinline__ const float* xrow(const Frame& F, int m) { return m < LP ? F.in_XP + (size_t)m * D : F.in_XS + (size_t)(m - LP) * D; }

__device__ __forceinline__ void tr_item(const float* src, int ldsrc, int k0, int n0, bf16_t* dst, int ldd, int drow0, LAS float* scr, int lane) {
#pragma unroll 8
    for (int i = 0; i < 32; ++i) { const int kk = 2 * i + (lane >> 5); scr[kk * 33 + (lane & 31)] = src[(size_t)(k0 + kk) * ldsrc + n0 + (lane & 31)]; }
    LDS_WAIT(); asm volatile("" ::: "memory");
    const int c = lane & 7;
#pragma unroll
    for (int j = 0; j < 4; ++j) { const int n = (lane >> 3) + 8 * j; const LAS float* s = scr + (8 * c) * 33 + n;
        u32x4 o; o.x = pk2(s[0 * 33], s[1 * 33]); o.y = pk2(s[2 * 33], s[3 * 33]); o.z = pk2(s[4 * 33], s[5 * 33]); o.w = pk2(s[6 * 33], s[7 * 33]);
        *(u32x4*)(dst + (size_t)(drow0 + n) * ldd + k0 + 8 * c) = o; }
    LDS_WAIT(); asm volatile("" ::: "memory");
}
__device__ __forceinline__ unsigned pk4_fp8(float a, float b, float c, float d) { int p = __builtin_amdgcn_cvt_pk_fp8_f32(a, b, 0, false); p = __builtin_amdgcn_cvt_pk_fp8_f32(c, d, p, true); return (unsigned)p; }
__device__ __forceinline__ void tr_item8(const float* src, int ldsrc, int k0, int n0, unsigned char* dst, int ldd, int drow0, LAS float* scr, int lane) {
#pragma unroll 8
    for (int i = 0; i < 32; ++i) { const int kk = 2 * i + (lane >> 5); scr[kk * 33 + (lane & 31)] = src[(size_t)(k0 + kk) * ldsrc + n0 + (lane & 31)]; }
    LDS_WAIT(); asm volatile("" ::: "memory");
    const int c = lane & 7;
#pragma unroll
    for (int j = 0; j < 4; ++j) { const int n = (lane >> 3) + 8 * j; const LAS float* s = scr + (8 * c) * 33 + n;
        u32x2 o; o.x = pk4_fp8(s[0 * 33] * 256.f, s[1 * 33] * 256.f, s[2 * 33] * 256.f, s[3 * 33] * 256.f); o.y = pk4_fp8(s[4 * 33] * 256.f, s[5 * 33] * 256.f, s[6 * 33] * 256.f, s[7 * 33] * 256.f);
        *(u32x2*)(dst + (size_t)(drow0 + n) * ldd + k0 + 8 * c) = o; }
    LDS_WAIT(); asm volatile("" ::: "memory");
}
__device__ __forceinline__ unsigned pk4_i8(float a, float b, float c, float d) { return ((unsigned)(int)a & 255u) | (((unsigned)(int)b & 255u) << 8) | (((unsigned)(int)c & 255u) << 16) | ((unsigned)(int)d << 24); }
__device__ __forceinline__ void tr_strip_i8(const float* src, int ldsrc, int K, int kb, int n0, signed char* dst, int drow0, float* cs, LAS float* scr, LAS float* red, int lane, int wave) {
    const __amdgpu_buffer_rsrc_t rs = __builtin_amdgcn_make_buffer_rsrc((void*)(src + n0 + (size_t)kb * ldsrc), (short)0, 0x7fffffff, 0x00020000);
    const int voff = ((lane & 31) + (lane >> 5) * ldsrc) * 4;
    unsigned hold[8][16];
    float mx = 0.f;
#pragma unroll
    for (int tr = 0; tr < 8; ++tr) {
        float t[32];
#pragma unroll
        for (int i = 0; i < 32; ++i) t[i] = __builtin_bit_cast(float, __builtin_amdgcn_raw_buffer_load_b32(rs, voff, (2 * (tr * 32 + i)) * ldsrc * 4, 0));
#pragma unroll
        for (int i = 0; i < 32; ++i) mx = fmaxf(mx, fabsf(t[i]));
#pragma unroll
        for (int i = 0; i < 16; ++i) { hold[tr][i] = pk2(t[2 * i], t[2 * i + 1]); asm volatile("" : "+v"(hold[tr][i])); }
        asm volatile("" ::: "memory");
    }
    mx = fmaxf(mx, __shfl_xor(mx, 32));
    if (lane < 32) red[wave * 32 + lane] = mx;
    LDS_WAIT(); __syncthreads();
    float amax = 1e-20f;
#pragma unroll
    for (int w_ = 0; w_ < NWAVES; ++w_) amax = fmaxf(amax, red[w_ * 32 + (lane & 31)]);
    const float inv = 127.0f / amax;
    if (wave == 0 && lane < 32) cs[drow0 + lane] = amax * (1.0f / 127.0f);
    const int c = lane & 7;
#pragma unroll
    for (int tr = 0; tr < 8; ++tr) {
        { LAS float* w = scr + (lane >> 5) * 33 + (lane & 31);
#pragma unroll
          for (int i = 0; i < 16; ++i) { unsigned h = hold[tr][i]; asm volatile("" : "+v"(h));
              w[(2 * i) * 66] = rintf(bflo(h) * inv); w[(2 * i + 1) * 66] = rintf(bfhi(h) * inv); } }
        LDS_WAIT(); asm volatile("" ::: "memory");
#pragma unroll
        for (int j = 0; j < 4; ++j) { const int n = (lane >> 3) + 8 * j; const LAS float* t = scr + (8 * c) * 33 + n;
            u32x2 o; o.x = pk4_i8(t[0 * 33], t[1 * 33], t[2 * 33], t[3 * 33]); o.y = pk4_i8(t[4 * 33], t[5 * 33], t[6 * 33], t[7 * 33]);
            *(u32x2*)(dst + (size_t)(drow0 + n) * K + kb + 64 * tr + 8 * c) = o; }
        LDS_WAIT(); asm volatile("" ::: "memory");
    }
    __syncthreads();
}
__device__ __forceinline__ void fwht32(float (&v)[32]) {
#pragma unroll
    for (int st = 1; st < 32; st <<= 1)
#pragma unroll
        for (int i = 0; i < 32; ++i) if (!(i & st)) { const float a = v[i], b = v[i + st]; v[i] = a + b; v[i + st] = a - b; }
#pragma unroll
    for (int i = 0; i < 32; ++i) v[i] *= 0.17677669529663687f;
}
__device__ __forceinline__ void had_tile_load(const float* src, int ldsrc, int k0, int n0, LAS float* scr, int lane, float (&v)[32]) {
    { const float* p = src + (size_t)(k0 + (lane >> 5)) * ldsrc + n0 + (lane & 31); const size_t step = (size_t)2 * ldsrc; LAS float* w = scr + (lane >> 5) * 33 + (lane & 31); float t[32];
#pragma unroll
      for (int i = 0; i < 32; ++i) { t[i] = *p; p += step; }
#pragma unroll
      for (int i = 0; i < 32; ++i) w[i * 66] = t[i]; }
    LDS_WAIT(); asm volatile("" ::: "memory");
    const LAS float* hv = scr + (32 * (lane >> 5)) * 33 + (lane & 31);
#pragma unroll
    for (int i = 0; i < 32; ++i) v[i] = hv[i * 33];
    fwht32(v);
}
__device__ __forceinline__ void had_tile_amax(const float* src, int ldsrc, int k0, int n0, unsigned* am, LAS float* scr, int lane) {
    float v[32]; had_tile_load(src, ldsrc, k0, n0, scr, lane, v);
    float mx = 0.f;
#pragma unroll
    for (int i = 0; i < 32; ++i) mx = fmaxf(mx, fabsf(v[i]));
    mx = fmaxf(mx, __shfl_xor(mx, 32));
    if (lane < 32) atomicMax(am + n0 + lane, __builtin_bit_cast(unsigned, mx));
    LDS_WAIT(); asm volatile("" ::: "memory");
}
__device__ __forceinline__ void had_tile_quant(const float* src, int ldsrc, int K, int k0, int n0, signed char* dst, const unsigned* am, float* cs, LAS float* scr, int lane) {
    const float amax = fmaxf(__builtin_bit_cast(float, am[n0 + (lane & 31)]), 1e-20f), inv = 127.0f / amax;
    if (k0 == 0 && lane < 32) cs[n0 + lane] = amax * (1.0f / 127.0f);
    float v[32]; had_tile_load(src, ldsrc, k0, n0, scr, lane, v);
    LAS float* hv = scr + (32 * (lane >> 5)) * 33 + (lane & 31);
#pragma unroll
    for (int i = 0; i < 32; ++i) hv[i * 33] = rintf(v[i] * inv);
    LDS_WAIT(); asm volatile("" ::: "memory");
    const int c = lane & 7;
#pragma unroll
    for (int j = 0; j < 4; ++j) { const int n = (lane >> 3) + 8 * j; const LAS float* t = scr + (8 * c) * 33 + n;
        u32x2 o; o.x = pk4_i8(t[0 * 33], t[1 * 33], t[2 * 33], t[3 * 33]); o.y = pk4_i8(t[4 * 33], t[5 * 33], t[6 * 33], t[7 * 33]);
        *(u32x2*)(dst + (size_t)(n0 + n) * K + k0 + 8 * c) = o; }
    LDS_WAIT(); asm volatile("" ::: "memory");
}
#define TR_JOB(SRC, LDSRC, KK, NN, DST, DROW_EXPR) { const int nblk = (NN) / 32, nit = ((KK) / 64) * nblk; \
    if (r < nit) { const int kb = r / nblk, nb = r % nblk, n0 = 32 * nb; tr_item((SRC), (LDSRC), 64 * kb, n0, (DST), (KK), (DROW_EXPR), scr, F.lane); continue; } r -= nit; }
#define TR_JOB8(SRC, LDSRC, KK, NN, DST, DROW_EXPR) { const int nblk = (NN) / 32, nit = ((KK) / 64) * nblk; \
    if (r < nit) { const int kb = r / nblk, nb = r % nblk, n0 = 32 * nb; tr_item8((SRC), (LDSRC), 64 * kb, n0, (DST), (KK), (DROW_EXPR), scr, F.lane); continue; } r -= nit; }

__device__ __forceinline__ void p0_prologue(Frame& F) {
    const int tid_ = opaque(F.tid);
    LAS float* scr = (LAS float*)(F.lds + F.wave * 8448);
    const float* w_in = F.in_WIN;
    bf16_t* WCAT = wsp<bf16_t>(F, WS_WCAT); signed char* W8 = wsp<signed char>(F, WS_W8); signed char* WV8 = wsp<signed char>(F, WS_WVT); signed char* WGU8 = wsp<signed char>(F, WS_WGU);
    float* CS = wsp<float>(F, WS_CS);
    constexpr int NSM = 64;
    constexpr int IT_SM = 2 * 4;
    constexpr int S_Q = NAW / 32, S_M = 2 * D / 32, S_F = DFF / 32;
    constexpr int NSTRIP = 3 * S_Q + S_M + 2 * S_F;
    constexpr int N_AMAX = (DFF / 64) * (D / 32);
    constexpr int N_BIG = 2 * (D / 64) * (NAW / 32) + 2 * (NAW / 64) * (D / 32) + (D / 64) * (D / 32) + N_AMAX;
    constexpr int NITEMS = N_BIG + NSM * IT_SM;
    LAS float* red = (LAS float*)(F.lds + 68608);
    for (int it = blockIdx.x; it < NSTRIP; it += F.G) {
        {
            int q = it; const float* src; int ld, n0, drow0; signed char* dst; float* cs;
            if (q < S_Q) { src = w_in; ld = INW; n0 = 32 * q; dst = W8; drow0 = n0; cs = CS + CS_QKM; }
            else if ((q -= S_Q) < S_Q) { src = w_in + NAW; ld = INW; n0 = 32 * q; dst = W8; drow0 = 2048 + n0; cs = CS + CS_QKM; }
            else if ((q -= S_Q) < S_M) { src = F.in_WM; ld = 2 * D; n0 = 32 * q; dst = W8; drow0 = 4096 + n0; cs = CS + CS_QKM; }
            else if ((q -= S_M) < S_Q) { src = w_in + 2 * NAW; ld = INW; n0 = 32 * q; dst = WV8; drow0 = n0; cs = CS + CS_V; }
            else if ((q -= S_Q) < S_F) { src = F.in_WFG; ld = DFF; n0 = 32 * q; dst = WGU8; drow0 = (n0 >> 7) * 256 + (n0 & 127); cs = CS + CS_GU; }
            else { q -= S_F; src = F.in_WFU; ld = DFF; n0 = 32 * q; dst = WGU8; drow0 = (n0 >> 7) * 256 + 128 + (n0 & 127); cs = CS + CS_GU; }
            tr_strip_i8(src, ld, D, F.wave * (D / NWAVES), n0, dst, drow0, cs, scr, red, F.lane, F.wave);
        }
    }
    for (int it = F.gw; it < NITEMS; it += F.ngw) {
        int r = it;
        TR_JOB(w_in + 3 * NAW, INW, D, NAW, WCAT, 0 + n0)
        TR_JOB(w_in + 4 * NAW, INW, D, NAW, WCAT, 2048 + n0)
        TR_JOB(F.in_WNO, D, NAW, D, wsp<bf16_t>(F, WS_WNO), n0)
        TR_JOB(F.in_WLO, D, LW, D, wsp<bf16_t>(F, WS_WLO), n0)
        TR_JOB(F.in_WOUT, D, D, D, wsp<bf16_t>(F, WS_WO), n0)
        if (r < N_AMAX) { had_tile_amax(F.in_WFD, D, 64 * (r / (D / 32)), 32 * (r % (D / 32)), (unsigned*)(F.ws + WS_AM), scr, F.lane); continue; } r -= N_AMAX;
        {
            const int mi = r / IT_SM, ri = r % IT_SM, d = mi >> 5, g = (mi >> 4) & 1, n = mi & 15, kb = ri >> 2, nb = ri & 3;
            const float* src = (g ? F.in_WI : F.in_WR) + (size_t)(d * NBLK + n) * BW * BW;
            tr_item(src, BW, 64 * kb, 32 * nb, wsp<bf16_t>(F, WS_WG) + (size_t)mi * BW * BW, BW, 32 * nb, scr, F.lane);
        }
    }
    LAS f32x4* gl = (LAS f32x4*)(F.lds + 69632);
    for (int i = tid_; i < D / 4; i += NTHR) gl[i] = ((const f32x4*)F.in_GMPRE)[i];
    __syncthreads();
    bf16_t* XN = wsp<bf16_t>(F, WS_XN); signed char* XN8 = wsp<signed char>(F, WS_XN8); float* RS1 = wsp<float>(F, WS_RS1);
    for (int m = F.gw; m < L; m += F.ngw) {
        asm volatile("" ::: "memory");
        const f32x4* xr = (const f32x4*)xrow(F, m) + F.lane;
        f32x4 v[16]; float s = 0.f;
#pragma unroll
        for (int j = 0; j < 16; ++j) { v[j] = xr[64 * j]; s += (v[j].x * v[j].x + v[j].y * v[j].y) + (v[j].z * v[j].z + v[j].w * v[j].w); }
        const float rstd = 1.0f / sqrtf(wave_sum(s) * (1.0f / D) + EPS);
        u32x2* o8 = (u32x2*)(XN + (size_t)m * D) + F.lane; unsigned* o4 = (unsigned*)(XN8 + (size_t)m * D) + F.lane;
        float mx = 0.f;
#pragma unroll
        for (int j = 0; j < 16; ++j) { v[j] = v[j] * rstd * gl[F.lane + 64 * j]; mx = fmaxf(fmaxf(mx, fmaxf(fabsf(v[j].x), fabsf(v[j].y))), fmaxf(fabsf(v[j].z), fabsf(v[j].w))); }
        const float amax = fmaxf(wave_max(mx), 1e-20f), inv = 127.0f / amax;
        if (F.lane == 0) RS1[m] = amax * (1.0f / 127.0f);
#pragma unroll
        for (int j = 0; j < 16; ++j) { const f32x4 y = v[j]; u32x2 o; o.x = pk2(y.x, y.y); o.y = pk2(y.z, y.w); o8[64 * j] = o;
            o4[64 * j] = pk4_i8(rintf(y.x * inv), rintf(y.y * inv), rintf(y.z * inv), rintf(y.w * inv)); }
    }
    __syncthreads();
}

#ifndef ATT_SYNC
#define ATT_SYNC 1
#endif
template <int ADBG = 0> __device__ __forceinline__ void attn_mfma(Frame& F) {
    const int tid_ = opaque(F.tid);
    bf16_t* Q = wsp<bf16_t>(F, WS_Q); const bf16_t* Kb = wsp<bf16_t>(F, WS_K); const bf16_t* VT = wsp<bf16_t>(F, WS_VT);
    LAS float* rp = (LAS float*)F.lds;
    for (int i = tid_; i < NH * 15 * 31; i += NTHR) rp[i] = F.in_RPB[i];
    __syncthreads();
    const int fr = F.lane & 15, fq = F.lane >> 4;
    const float scale = 0.08838834764831845f;
    for (int base = blockIdx.x * NWAVES; base < (L / GRIDW) * NH * 4; base += F.ngw) {
        const int item = base + F.wave;
        asm volatile("" ::: "memory");
        const int g = item & 3, h = (item >> 2) & 15, rg = item >> 6;
        const int s0 = rg < LP / GRIDW ? 0 : LP, rows = rg < LP / GRIDW ? LP / GRIDW : LS / GRIDW, r = rg < LP / GRIDW ? rg : rg - LP / GRIDW;
        int rs = r - 4; rs = rs < 0 ? 0 : (rs > rows - 8 ? rows - 8 : rs);
        const int w0 = g == 0 ? 0 : (g == 1 ? 8 : (g == 2 ? 24 : 32));
        const int c = 16 * g + fr;
        int cs = c - 8; cs = cs < 0 ? 0 : (cs > GRIDW - 16 ? GRIDW - 16 : cs);
        bf16_t* qrow = Q + (size_t)(s0 + r * GRIDW + c) * NAW + h * HD;
        bf16x8 qf[4];
#pragma unroll
        for (int s = 0; s < 4; ++s) qf[s] = *(const bf16x8*)(qrow + 8 * fq + 32 * s);
        f32x4 sacc[8][2];
        const int Rg = s0 / GRIDW + rs, p0 = w0 >> 3;
        const bf16_t* kbase = Kb + (size_t)(Rg * 16 + h) * 8192 + p0 * 128 + fr * 32 + fq * 8;
        bf16x8 kb[8][2][4];
#define ATT_LDK(kr) do { _Pragma("unroll") for (int T = 0; T < 2; ++T) _Pragma("unroll") for (int s = 0; s < 4; ++s) kb[kr][T][s] = (ADBG & 1) ? qf[s] : (ADBG & 4) ? *(const bf16x8*)(Kb + (size_t)(s0 + rs * GRIDW) * NAW + h * HD * GRIDW + ((kr) * 8 + T * 4 + s) * 512 + F.lane * 8) : *(const bf16x8*)(kbase + (size_t)(kr) * (16 * 8192) + (s * 2 + T) * 1024); } while (0)
        ATT_LDK(0); ATT_LDK(1);
#pragma unroll
        for (int kr = 0; kr < 8; ++kr) {
            if (ATT_SYNC && (kr & 1) == 0) __builtin_amdgcn_s_barrier();
            if (kr + 2 < 8) ATT_LDK(kr + 2);
            __builtin_amdgcn_sched_barrier(0);
#pragma unroll
            for (int T = 0; T < 2; ++T) { f32x4 a = (f32x4){0.f, 0.f, 0.f, 0.f};
#pragma unroll
                for (int s = 0; s < 4; ++s) a = __builtin_amdgcn_mfma_f32_16x16x32_bf16(kb[kr][T][s], qf[s], a, 0, 0, 0);
                sacc[kr][T] = a; }
            __builtin_amdgcn_sched_barrier(0);
        }
#undef ATT_LDK
        bf16x8 vb[8][8];
        const bf16_t* vbase = VT + (size_t)(Rg * 16 + h) * 8192 + p0 * 128 + fq * 128 + fr * 8;
#define ATT_LDV(kr) do { _Pragma("unroll") for (int dt = 0; dt < 8; ++dt) vb[kr][dt] = (ADBG & 2) ? qf[dt & 3] : (ADBG & 4) ? *(const bf16x8*)(VT + (size_t)(h * HD) * L + s0 + rs * GRIDW + ((kr) * 8 + dt) * 512 + F.lane * 8) : *(const bf16x8*)(vbase + (size_t)(kr) * (16 * 8192) + dt * 1024); } while (0)
        ATT_LDV(0); ATT_LDV(1);
        __builtin_amdgcn_sched_barrier(0);
        const int elo = cs - w0 - 8 * fq, dc0 = w0 + 8 * fq - c + 15;
        const LAS float* rph = rp + h * 465 + (rs - r + 7) * 31;
        float mx = -3.0e38f;
#pragma unroll
        for (int e = 0; e < 8; ++e) { const bool valid = (e >= elo) && (e < elo + 16); const int bi = valid ? dc0 + e : 0;
#pragma unroll
            for (int kr = 0; kr < 8; ++kr) { const float sv = valid ? sacc[kr][e >> 2][e & 3] * scale + rph[kr * 31 + bi] : -3.0e38f; sacc[kr][e >> 2][e & 3] = sv; mx = fmaxf(mx, sv); } }
        mx = fmaxf(mx, __shfl_xor(mx, 16)); mx = fmaxf(mx, __shfl_xor(mx, 32));
        float lsum = 0.f; bf16x8 pf[8];
#pragma unroll
        for (int kr = 0; kr < 8; ++kr) { float p[8];
#pragma unroll
            for (int e = 0; e < 8; ++e) { p[e] = __expf(sacc[kr][e >> 2][e & 3] - mx); lsum += p[e]; }
            u32x4 w; w.x = pk2(p[0], p[1]); w.y = pk2(p[2], p[3]); w.z = pk2(p[4], p[5]); w.w = pk2(p[6], p[7]);
            pf[kr] = __builtin_bit_cast(bf16x8, w); }
        lsum += __shfl_xor(lsum, 16); lsum += __shfl_xor(lsum, 32);
        f32x4 oacc[8];
#pragma unroll
        for (int dt = 0; dt < 8; ++dt) oacc[dt] = (f32x4){0.f, 0.f, 0.f, 0.f};
#pragma unroll
        for (int kr = 0; kr < 8; ++kr) {
            if (ATT_SYNC && (kr & 1) == 0) __builtin_amdgcn_s_barrier();
            if (kr + 2 < 8) ATT_LDV(kr + 2);
            __builtin_amdgcn_sched_barrier(0);
#pragma unroll
            for (int dt = 0; dt < 8; ++dt) oacc[dt] = __builtin_amdgcn_mfma_f32_16x16x32_bf16(vb[kr][dt], pf[kr], oacc[dt], 0, 0, 0);
            __builtin_amdgcn_sched_barrier(0);
        }
#undef ATT_LDV
        const float inv = 1.0f / lsum;
#ifdef ATTN_OUT_OFF
        bf16_t* orow = wsp<bf16_t>(F, (size_t)ATTN_OUT_OFF * MiB) + (size_t)(s0 + r * GRIDW + c) * NAW + h * HD;
#else
        bf16_t* orow = qrow;
#endif
#pragma unroll
        for (int u = 0; u < 4; ++u) *(u32x4*)(orow + 32 * u + 8 * fq) = pg8::pack8(oacc[2 * u] * inv, oacc[2 * u + 1] * inv);
    }
    __syncthreads();
}

__device__ __forceinline__ void attn_mfma_lds(Frame& F) {
    const int tid_ = opaque(F.tid);
    bf16_t* Q = wsp<bf16_t>(F, WS_Q); const bf16_t* Kb = wsp<bf16_t>(F, WS_K); const bf16_t* VT = wsp<bf16_t>(F, WS_VT);
    LAS float* rp = (LAS float*)F.lds;
    LAS unsigned char* ring = F.lds + 30720;
    for (int i = tid_; i < NH * 15 * 31; i += NTHR) rp[i] = F.in_RPB[i];
    __syncthreads();
    const int lane = tid_ & 63, fr = lane & 15, fq = lane >> 4, w = F.wave, hl = w >> 2, g = w & 3;
    const float scale = 0.08838834764831845f;
    constexpr int NIT = (L / GRIDW) * NH * 4;
    const int w0 = g == 0 ? 0 : (g == 1 ? 8 : (g == 2 ? 24 : 32)), p0 = w0 >> 3;
    const int c = 16 * g + fr;
    int cs = c - 8; cs = cs < 0 ? 0 : (cs > GRIDW - 16 ? GRIDW - 16 : cs);
#define ATL_SRC(b, st) ([&]() -> const bf16_t* { const int rg_ = (b) >> 6, hb_ = ((b) >> 2) & 15; const int rows_ = rg_ < LP / GRIDW ? LP / GRIDW : LS / GRIDW, r_ = rg_ < LP / GRIDW ? rg_ : rg_ - LP / GRIDW; \
        int rs_ = r_ - 4; rs_ = rs_ < 0 ? 0 : (rs_ > rows_ - 8 ? rows_ - 8 : rs_); const int Rg_ = (rg_ < LP / GRIDW ? 0 : LP / GRIDW) + rs_; \
        return ((st) < 8 ? Kb : VT) + (size_t)((Rg_ + ((st) & 7)) * 16 + hb_) * 8192; }())
#define ATL_ISSUE(src, slot) do { const bf16_t* s_ = (src) + tid_ * 8; LAS unsigned char* d_ = ring + (slot) * 32768 + w * 1024; _Pragma("unroll") for (int k_ = 0; k_ < 4; ++k_) \
        __builtin_amdgcn_global_load_lds((const unsigned*)(s_ + k_ * 4096), (LAS unsigned*)(d_ + k_ * 8192), 16, 0, 0); } while (0)
    int base = blockIdx.x * NWAVES;
    if (base < NIT) { ATL_ISSUE(ATL_SRC(base, 0), 0); ATL_ISSUE(ATL_SRC(base, 1), 1); }
    int b0 = 0;
    for (; base < NIT; base += F.ngw) {
        asm volatile("" ::: "memory");
        const int h = ((base >> 2) & 15) + hl, rg = base >> 6;
        const int s0 = rg < LP / GRIDW ? 0 : LP, rows = rg < LP / GRIDW ? LP / GRIDW : LS / GRIDW, r = rg < LP / GRIDW ? rg : rg - LP / GRIDW;
        int rs = r - 4; rs = rs < 0 ? 0 : (rs > rows - 8 ? rows - 8 : rs);
        const int nbase = base + F.ngw < NIT ? base + F.ngw : base;
        bf16_t* qrow = Q + (size_t)(s0 + r * GRIDW + c) * NAW + h * HD;
        bf16x8 qf[4];
#pragma unroll
        for (int s = 0; s < 4; ++s) qf[s] = *(const bf16x8*)(qrow + 8 * fq + 32 * s);
        f32x4 sacc[8][2]; f32x4 oacc[8]; bf16x8 pf[8]; float lsum = 0.f;
#pragma unroll
        for (int dt = 0; dt < 8; ++dt) oacc[dt] = (f32x4){0.f, 0.f, 0.f, 0.f};
        const int koff = hl * 16384 + (p0 * 128 + fr * 32 + fq * 8) * 2, voff = hl * 16384 + (p0 * 128 + fq * 128 + fr * 8) * 2;
#pragma unroll
        for (int st = 0; st < 16; ++st) {
            asm volatile("s_waitcnt vmcnt(4)" ::: "memory"); asm volatile("s_waitcnt lgkmcnt(0)" ::: "memory"); __builtin_amdgcn_s_barrier(); asm volatile("" ::: "memory");
            { const int slot2 = (b0 + st + 2) % 3; if (st + 2 < 16) ATL_ISSUE(ATL_SRC(base, st + 2), slot2); else ATL_ISSUE(ATL_SRC(nbase, st + 2 - 16), slot2); }
            const LAS unsigned char* buf = ring + ((b0 + st) % 3) * 32768;
            if (st < 8) {
#pragma unroll
                for (int T = 0; T < 2; ++T) { f32x4 a = (f32x4){0.f, 0.f, 0.f, 0.f};
#pragma unroll
                    for (int s2 = 0; s2 < 4; ++s2) a = __builtin_amdgcn_mfma_f32_16x16x32_bf16(*(const LAS bf16x8*)(buf + koff + (s2 * 2 + T) * 2048), qf[s2], a, 0, 0, 0);
                    sacc[st][T] = a; }
            } else {
                if (st == 8) {
                    const int elo = cs - w0 - 8 * fq, dc0 = w0 + 8 * fq - c + 15;
                    const LAS float* rph = rp + h * 465 + (rs - r + 7) * 31;
                    float mx = -3.0e38f;
#pragma unroll
                    for (int e = 0; e < 8; ++e) { const bool valid = (e >= elo) && (e < elo + 16); const int bi = valid ? dc0 + e : 0;
#pragma unroll
                        for (int kr = 0; kr < 8; ++kr) { const float sv = valid ? sacc[kr][e >> 2][e & 3] * scale + rph[kr * 31 + bi] : -3.0e38f; sacc[kr][e >> 2][e & 3] = sv; mx = fmaxf(mx, sv); } }
                    mx = fmaxf(mx, __shfl_xor(mx, 16)); mx = fmaxf(mx, __shfl_xor(mx, 32));
#pragma unroll
                    for (int kr = 0; kr < 8; ++kr) { float p[8];
#pragma unroll
                        for (int e = 0; e < 8; ++e) { p[e] = __expf(sacc[kr][e >> 2][e & 3] - mx); lsum += p[e]; }
                        u32x4 wv; wv.x = pk2(p[0], p[1]); wv.y = pk2(p[2], p[3]); wv.z = pk2(p[4], p[5]); wv.w = pk2(p[6], p[7]);
                        pf[kr] = __builtin_bit_cast(bf16x8, wv); }
                    lsum += __shfl_xor(lsum, 16); lsum += __shfl_xor(lsum, 32);
                }
#pragma unroll
                for (int dt = 0; dt < 8; ++dt) oacc[dt] = __builtin_amdgcn_mfma_f32_16x16x32_bf16(*(const LAS bf16x8*)(buf + voff + dt * 2048), pf[st - 8], oacc[dt], 0, 0, 0);
            }
        }
        b0 = (b0 + 16) % 3;
        const float inv = 1.0f / lsum;
#pragma unroll
        for (int u = 0; u < 4; ++u) *(u32x4*)(qrow + 32 * u + 8 * fq) = pg8::pack8(oacc[2 * u] * inv, oacc[2 * u + 1] * inv);
    }
#undef ATL_SRC
#undef ATL_ISSUE
    asm volatile("s_waitcnt vmcnt(0)" ::: "memory");
    __syncthreads();
}

__device__ __forceinline__ void conv_phase(Frame& F) {
    const int tid_ = opaque(F.tid);
    const bf16_t* XR = wsp<bf16_t>(F, WS_XR); bf16_t* XC = wsp<bf16_t>(F, WS_XC);
    const float* wc = F.in_WCONV; const float* bc = F.in_BCONV;
    const int nth = F.G * NTHR;
    for (int it = blockIdx.x * NTHR + tid_; it < L * (LW / 8); it += nth) {
        const int t = it / (LW / 8), c0 = (it % (LW / 8)) * 8;
        const int s0 = t < LP ? 0 : LP, len = t < LP ? LP : LS, tl = t - s0;
        float acc[8];
#pragma unroll
        for (int e = 0; e < 8; ++e) acc[e] = bc[c0 + e];
#pragma unroll
        for (int j = 0; j < 4; ++j) { const int tt = tl + j - 2; if (tt < 0 || tt >= len) continue;
            f32x4 x0, x1; pg8::unpack8(*(const u32x4*)(XR + (size_t)(s0 + tt) * LW + c0), x0, x1);
            const f32x4 w0 = *(const f32x4*)(wc + j * LW + c0), w1 = *(const f32x4*)(wc + j * LW + c0 + 4);
#pragma unroll
            for (int e = 0; e < 4; ++e) { acc[e] += w0[e] * x0[e]; acc[4 + e] += w1[e] * x1[e]; } }
        *(u32x4*)(XC + (size_t)t * LW + c0) = pg8::pack8((f32x4){acc[0], acc[1], acc[2], acc[3]}, (f32x4){acc[4], acc[5], acc[6], acc[7]});
    }
}

struct LruW { bf16x8 w[2][4]; float br, bi, cl; };
template <int DIR> __device__ __forceinline__ void lru_load_w(const Frame& F, LruW& W, int n, int w, int fr, int fq) {
    const bf16_t* wg = wsp<bf16_t>(F, WS_WG);
#pragma unroll
    for (int g = 0; g < 2; ++g)
#pragma unroll
        for (int s = 0; s < 4; ++s) W.w[g][s] = *(const bf16x8*)(wg + ((size_t)((DIR * 2 + g) * NBLK + n) * BW + 16 * w + fr) * BW + 32 * fq + 8 * s);
    const int ch = n * BW + 16 * w + fr;
    W.br = -1.44269504f * F.in_BR[DIR * LW + ch]; W.bi = -1.44269504f * F.in_BI[DIR * LW + ch];
    const float lam = F.in_LAM[DIR * LW + ch];
    W.cl = -8.0f * 1.44269504f * ((lam > 15.f) ? __expf(-lam) : log1pf(__expf(-lam)));
}
template <int LDBG = 0> __device__ __forceinline__ void lru_gate(float pr, float pi, float xc, const LruW& W, bool first, float& a, float& u) {
    if constexpr (LDBG == 1) { a = pr + W.br; u = pi * xc + W.bi; return; }
    const float r = __builtin_amdgcn_rcpf(1.0f + __builtin_amdgcn_exp2f(__builtin_fmaf(pr, -1.44269504f, W.br))), d = 1.0f + __builtin_amdgcn_exp2f(__builtin_fmaf(pi, -1.44269504f, W.bi));
    a = __builtin_amdgcn_exp2f(W.cl * r);
    const float y = first ? 1.0f : fmaxf(__builtin_fmaf(-a, a, 1.0f), 1e-30f);
    u = xc * y * __builtin_amdgcn_rsqf(y * d * d);
}
struct LruX { bf16x8 x[4][4]; };
__device__ __forceinline__ void lru_load_x(LruX& X, const bf16_t* XC, int tb, int n, int fr, int fq) {
#pragma unroll
    for (int tau = 0; tau < 4; ++tau) { const bf16_t* xp = XC + ((size_t)((((tb >> 6) * NBLK + n) * 4 + tau) * 4) * 64 + fr * 4 + fq) * 8;
#pragma unroll
        for (int s = 0; s < 4; ++s) X.x[tau][s] = *(const bf16x8*)(xp + s * 512); }
}
__device__ __forceinline__ void lru_tile(const LruX& X, int tau, bool hiw, const LruW& W, const bf16x8 idf0, const bf16x8 idf1, f32x4& pr, f32x4& pi, f32x4& xct) {
    pr = (f32x4){0.f, 0.f, 0.f, 0.f}; pi = pr;
#pragma unroll
    for (int s = 0; s < 4; ++s) { pr = __builtin_amdgcn_mfma_f32_16x16x32_bf16(X.x[tau][s], W.w[0][s], pr, 0, 0, 0); pi = __builtin_amdgcn_mfma_f32_16x16x32_bf16(X.x[tau][s], W.w[1][s], pi, 0, 0, 0); }
    const bf16x8 x0 = hiw ? X.x[tau][2] : X.x[tau][0], x1 = hiw ? X.x[tau][3] : X.x[tau][1];
    xct = __builtin_amdgcn_mfma_f32_16x16x32_bf16(x0, idf0, (f32x4){0.f, 0.f, 0.f, 0.f}, 0, 0, 0);
    xct = __builtin_amdgcn_mfma_f32_16x16x32_bf16(x1, idf1, xct, 0, 0, 0);
}
__device__ __forceinline__ void lru_tile_lds(const LAS unsigned char* tile, const LAS unsigned char* xcl, int gl, int tau, const LruW& W, int fr, int fq, f32x4& pr, f32x4& pi, f32x4& xct) {
    bf16x8 x[4];
#pragma unroll
    for (int s = 0; s < 4; ++s) x[s] = *(const LAS bf16x8*)(tile + ((((gl * 4 + tau) * 4 + s) * 16 + fr) * 4 + fq) * 16);
    pr = (f32x4){0.f, 0.f, 0.f, 0.f}; pi = pr;
#pragma unroll
    for (int s = 0; s < 4; ++s) { pr = __builtin_amdgcn_mfma_f32_16x16x32_bf16(x[s], W.w[0][s], pr, 0, 0, 0); pi = __builtin_amdgcn_mfma_f32_16x16x32_bf16(x[s], W.w[1][s], pi, 0, 0, 0); }
#pragma unroll
    for (int j = 0; j < 4; ++j) xct[j] = bf1(*(const LAS bf16_t*)(xcl + (gl * 4 + tau) * 4096 + j * 64));
}
__device__ __forceinline__ void lru_idfrags(int w, int fr, int fq, bf16x8& idf0, bf16x8& idf1) {
#pragma unroll
    for (int e = 0; e < 8; ++e) { const bool on = (fq == (w >> 1)) && ((fr & 7) == e); idf0[e] = (on && fr < 8) ? (short)0x3F80 : (short)0; idf1[e] = (on && fr >= 8) ? (short)0x3F80 : (short)0; }
}
constexpr int LRU_CH = 256, LRU_NCH = L / LRU_CH, LRU_NCH_P = LP / LRU_CH;
__device__ __forceinline__ void conv_unit(Frame& F, int cg, int n) {
    const int tid_ = opaque(F.tid);
    const bf16_t* XR = wsp<bf16_t>(F, WS_XR); bf16_t* XC = wsp<bf16_t>(F, WS_XC);
    const float* wc = F.in_WCONV; const float* bc = F.in_BCONV;
    const int c0 = n * BW + (tid_ & 15) * 8;
    const int s0 = cg < LRU_NCH_P ? 0 : LP, len = cg < LRU_NCH_P ? LP : LS;
    f32x4 w[4][2]; f32x4 b0 = *(const f32x4*)(bc + c0), b1 = *(const f32x4*)(bc + c0 + 4);
#pragma unroll
    for (int j = 0; j < 4; ++j) { w[j][0] = *(const f32x4*)(wc + j * LW + c0); w[j][1] = *(const f32x4*)(wc + j * LW + c0 + 4); }
#pragma unroll
    for (int i = 0; i < 8; ++i) {
        const int t = cg * LRU_CH + (tid_ >> 4) + 32 * i, tl = t - s0;
        f32x4 a0 = b0, a1 = b1;
#pragma unroll
        for (int j = 0; j < 4; ++j) { const int tt = tl + j - 2; if (tt < 0 || tt >= len) continue;
            f32x4 x0, x1; pg8::unpack8(*(const u32x4*)(XR + (size_t)(s0 + tt) * LW + c0), x0, x1); a0 += w[j][0] * x0; a1 += w[j][1] * x1; }
        const int tg = t & 63, cq = tid_ & 15;
        *(u32x4*)(XC + ((size_t)(((((t >> 6) * NBLK + n) * 4 + ((tg >> 2) & 3)) * 4 + (cq & 3)) * 16 + 4 * (tg >> 4) + (tg & 3)) * 4 + (cq >> 2)) * 8) = pg8::pack8(a0, a1);
    }
}
__device__ __forceinline__ void conv_req(const Frame& F, int cg, int n, int tid_, u32x4 (&R)[11]) {
    const bf16_t* XR = wsp<bf16_t>(F, WS_XR);
    const int s0 = cg < LRU_NCH_P ? 0 : LP, len = cg < LRU_NCH_P ? LP : LS;
    const int t0 = cg * LRU_CH + 8 * (tid_ >> 4) - 2, c0 = n * BW + (tid_ & 15) * 8;
#pragma unroll
    for (int k = 0; k < 11; ++k) { const int tl = t0 + k - s0; R[k] = (u32x4){0u, 0u, 0u, 0u}; if (tl >= 0 && tl < len) R[k] = *(const u32x4*)(XR + (size_t)(t0 + k) * LW + c0); }
}
__device__ __forceinline__ void conv_fin(const Frame& F, int cg, int n, int tid_, const u32x4 (&R)[11], LAS unsigned char* tile, const LAS float* cw) {
    bf16_t* XC = wsp<bf16_t>(F, WS_XC);
    const int g = tid_ >> 4, cq = tid_ & 15;
    f32x4 w[4][2];
#pragma unroll
    for (int j = 0; j < 4; ++j) { w[j][0] = *(const LAS f32x4*)(cw + j * BW + cq * 8); w[j][1] = *(const LAS f32x4*)(cw + j * BW + cq * 8 + 4); }
    const f32x4 b0 = *(const LAS f32x4*)(cw + 4 * BW + cq * 8), b1 = *(const LAS f32x4*)(cw + 4 * BW + cq * 8 + 4);
#pragma unroll
    for (int i = 0; i < 8; ++i) {
        f32x4 a0 = b0, a1 = b1;
#pragma unroll
        for (int j = 0; j < 4; ++j) { f32x4 x0, x1; pg8::unpack8(R[i + j], x0, x1); a0 += w[j][0] * x0; a1 += w[j][1] * x1; }
        const int t = cg * LRU_CH + 8 * g + i, tg = t & 63;
        const int fo = ((((((tg >> 2) & 3) * 4 + (cq & 3)) * 16 + 4 * (tg >> 4) + (tg & 3)) * 4 + (cq >> 2)) * 8);
        const u32x4 o = pg8::pack8(a0, a1);
        *(u32x4*)(XC + (size_t)((t >> 6) * NBLK + n) * 8192 + fo) = o;
        *(LAS u32x4*)(tile + ((t >> 6) & 3) * 16384 + fo * 2) = o;
    }
}
__device__ __forceinline__ void lru_load_x_lds(LruX& X, const LAS unsigned char* tile, int gl, int fr, int fq) {
#pragma unroll
    for (int tau = 0; tau < 4; ++tau)
#pragma unroll
        for (int s = 0; s < 4; ++s) X.x[tau][s] = *(const LAS bf16x8*)(tile + ((((gl * 4 + tau) * 4 + s) * 16 + fr) * 4 + fq) * 16);
}
__device__ __forceinline__ void lru_pass_a(Frame& F) {
    const int tid_ = opaque(F.tid);
    const int fr = F.lane & 15, fq = F.lane >> 4, w = F.wave;
    f32x2* SUMM = wsp<f32x2>(F, WS_SUM);
    LAS unsigned char* tile = F.lds; LAS float* cw = (LAS float*)(F.lds + 65536);
    bf16x8 idf0, idf1; lru_idfrags(w, fr, fq, idf0, idf1);
    int u = blockIdx.x, ncur = -1;
    u32x4 R[11];
    if (u < LRU_NCH * NBLK) conv_req(F, u >> 4, u & 15, tid_, R);
    LruW Wf, Wb;
    for (; u < LRU_NCH * NBLK; u += F.G) {
        const int cg = u >> 4, n = u & 15;
        if (n != ncur) {
            ncur = n; lru_load_w<0>(F, Wf, n, w, fr, fq); lru_load_w<1>(F, Wb, n, w, fr, fq);
            for (int i = tid_; i < 5 * BW; i += NTHR) cw[i] = i < 4 * BW ? F.in_WCONV[(i >> 7) * LW + n * BW + (i & 127)] : F.in_BCONV[n * BW + (i & 127)];
            LDS_WAIT(); __builtin_amdgcn_s_barrier();
        }
        asm volatile("" ::: "memory");
        conv_fin(F, cg, n, tid_, R, tile, cw);
        { const int un = u + F.G; if (un < LRU_NCH * NBLK) conv_req(F, un >> 4, un & 15, tid_, R); }
        LDS_WAIT(); __builtin_amdgcn_s_barrier();
        const bool c_first = (cg == 0 || cg == LRU_NCH_P), c_last = (cg == LRU_NCH_P - 1 || cg == LRU_NCH - 1);
        float Af = 1.f, Hf = 0.f, Ab = 1.f, Hb = 0.f;
        for (int gi = 0; gi < 4; ++gi) {
            float pf = 1.f, hf = 0.f, pb = 1.f, hb = 0.f;
#pragma unroll 2
            for (int tau = 0; tau < 4; ++tau) {
                bf16x8 x[4];
#pragma unroll
                for (int s_ = 0; s_ < 4; ++s_) x[s_] = *(const LAS bf16x8*)(tile + ((((gi * 4 + tau) * 4 + s_) * 16 + fr) * 4 + fq) * 16);
                f32x4 prf = (f32x4){0.f, 0.f, 0.f, 0.f}, pif = prf, prb = prf, pib = prf, xct;
#pragma unroll
                for (int s_ = 0; s_ < 4; ++s_) { prf = __builtin_amdgcn_mfma_f32_16x16x32_bf16(x[s_], Wf.w[0][s_], prf, 0, 0, 0); pif = __builtin_amdgcn_mfma_f32_16x16x32_bf16(x[s_], Wf.w[1][s_], pif, 0, 0, 0);
                    prb = __builtin_amdgcn_mfma_f32_16x16x32_bf16(x[s_], Wb.w[0][s_], prb, 0, 0, 0); pib = __builtin_amdgcn_mfma_f32_16x16x32_bf16(x[s_], Wb.w[1][s_], pib, 0, 0, 0); }
                xct = __builtin_amdgcn_mfma_f32_16x16x32_bf16((w & 1) ? x[2] : x[0], idf0, (f32x4){0.f, 0.f, 0.f, 0.f}, 0, 0, 0);
                xct = __builtin_amdgcn_mfma_f32_16x16x32_bf16((w & 1) ? x[3] : x[1], idf1, xct, 0, 0, 0);
#pragma unroll
                for (int j = 0; j < 4; ++j) {
                    float a, uu;
                    lru_gate(prf[j], pif[j], xct[j], Wf, c_first && gi == 0 && fq == 0 && tau == 0 && j == 0, a, uu); hf = a * hf + uu; pf *= a;
                    lru_gate(prb[j], pib[j], xct[j], Wb, c_last && gi == 3 && fq == 3 && tau == 3 && j == 3, a, uu); hb += pb * uu; pb *= a;
                }
            }
            float gPf = 1.f, gHf = 0.f, gPb = 1.f, gHb = 0.f;
#pragma unroll
            for (int qq = 0; qq < 4; ++qq) { const int src = fr + 16 * qq;
                float P = __shfl(pf, src), H = __shfl(hf, src); gHf = P * gHf + H; gPf *= P;
                P = __shfl(pb, src); H = __shfl(hb, src); gHb += gPb * H; gPb *= P; }
            Hf = gPf * Hf + gHf; Af *= gPf; Hb += Ab * gHb; Ab *= gPb;
        }
        if (fq == 0) { const int ch = n * BW + 16 * w + fr; SUMM[(size_t)(cg * 2 + 0) * LW + ch] = (f32x2){Af, Hf}; SUMM[(size_t)(cg * 2 + 1) * LW + ch] = (f32x2){Ab, Hb}; }
        LDS_WAIT(); __builtin_amdgcn_s_barrier();
    }
    VM_WAIT();
}
__device__ __forceinline__ void lru_pass_b(Frame& F) {
    const int tid_ = opaque(F.tid);
    const int gt = blockIdx.x * NTHR + tid_; if (gt >= 4 * LW) return;
    const int ch = gt % LW, d = (gt / LW) & 1, seq = gt / (2 * LW), c0 = seq ? LRU_NCH_P : 0, nc = seq ? LRU_NCH - LRU_NCH_P : LRU_NCH_P;
    const f32x2* SUMM = wsp<f32x2>(F, WS_SUM); float* CIN = wsp<float>(F, WS_SUM + 4 * MiB);
    float s = 0.f;
    for (int i0 = 0; i0 < nc; i0 += 32) {
        f32x2 ah[32];
#pragma unroll
        for (int e = 0; e < 32; ++e) { const int cg = d ? c0 + nc - 1 - (i0 + e) : c0 + i0 + e; ah[e] = SUMM[(size_t)(cg * 2 + d) * LW + ch]; }
#pragma unroll
        for (int e = 0; e < 32; ++e) { const int cg = d ? c0 + nc - 1 - (i0 + e) : c0 + i0 + e; CIN[(size_t)(cg * 2 + d) * LW + ch] = s; s = ah[e].x * s + ah[e].y; }
    }
}
template <int LDBG = 0> __device__ __forceinline__ void lru_pass_c(Frame& F) {
    const int tid_ = opaque(F.tid);
    const int fr = F.lane & 15, fq = F.lane >> 4, w = F.wave;
    const bf16_t* XC = wsp<bf16_t>(F, WS_XC); const float* CIN = wsp<float>(F, WS_SUM + 4 * MiB);
    const bf16_t* GR = wsp<bf16_t>(F, WS_GR); bf16_t* LRU = wsp<bf16_t>(F, WS_XR);
    LAS unsigned char* tile = F.lds;
    LAS unsigned char* hfl = F.lds + 65536 + w * 8192 + F.lane * 32;
    asm volatile("" : "+v"(hfl));
    const LAS unsigned char* xcl = tile + ((((2 * (w & 1) + (fr >> 3)) * 16 + 4 * fq) * 4 + (w >> 1)) * 16 + (fr & 7) * 2);
    asm volatile("" : "+v"(xcl));
    LruW Wf, Wb; int ncur = -1;
    for (int u = blockIdx.x; u < LRU_NCH * NBLK; u += F.G) {
        const int cg = u >> 4, n = u & 15, ch = n * BW + 16 * w + fr;
        const bool c_first = (cg == 0 || cg == LRU_NCH_P), c_last = (cg == LRU_NCH_P - 1 || cg == LRU_NCH - 1);
        { const bf16_t* gsrc = XC + (size_t)(cg * 4 * NBLK + n) * 8192 + tid_ * 8; LAS unsigned char* ldst = tile + w * 1024;
#pragma unroll 1
          for (int k = 0; k < 8; ++k) { __builtin_amdgcn_global_load_lds((const unsigned*)gsrc, (LAS unsigned*)ldst, 16, 0, 0); gsrc += (k & 1) ? (size_t)NBLK * 8192 - 4096 : 4096; ldst += 8192; } }
        asm volatile("" ::: "memory");
        if (n != ncur) { ncur = n; lru_load_w<0>(F, Wf, n, w, fr, fq); lru_load_w<1>(F, Wb, n, w, fr, fq); }
        const float cin_f = CIN[(size_t)(cg * 2 + 0) * LW + ch], cin_b = CIN[(size_t)(cg * 2 + 1) * LW + ch];
        const bf16_t* grp = GR + (size_t)(cg * LRU_CH + 16 * fq) * LW + ch; bf16_t* outp = LRU + (size_t)(cg * LRU_CH + 16 * fq) * LW + ch;
        bf16_t grn[16];
#pragma unroll
        for (int t = 0; t < 16; ++t) grn[t] = grp[(size_t)(3 * 64 + t) * LW];
        asm volatile("s_waitcnt vmcnt(16)" ::: "memory"); __builtin_amdgcn_s_barrier();
        {
            const LruW& W = Wf;
            float s = cin_f;
            for (int gi = 0; gi < 4; ++gi) {
                float a[16], uu[16];
#pragma unroll
                for (int tau = 0; tau < 4; ++tau) { f32x4 pr, pi, xct; lru_tile_lds(tile, xcl, gi, tau, W, fr, fq, pr, pi, xct);
#pragma unroll
                    for (int j = 0; j < 4; ++j) lru_gate<LDBG>(pr[j], pi[j], xct[j], W, c_first && gi == 0 && fq == 0 && tau == 0 && j == 0, a[4 * tau + j], uu[4 * tau + j]); }
                float p = 1.f, h = 0.f;
#pragma unroll
                for (int t = 0; t < 16; ++t) { h = a[t] * h + uu[t]; p *= a[t]; }
                float hin = s, sg = s;
#pragma unroll
                for (int qq = 0; qq < 4; ++qq) { const float P = __shfl(p, fr + 16 * qq), H = __shfl(h, fr + 16 * qq); sg = P * sg + H; if (qq < fq) hin = P * hin + H; }
                s = sg;
                float hh = hin;
#pragma unroll
                for (int t = 0; t < 16; ++t) { hh = a[t] * hh + uu[t]; a[t] = hh; }
                *(LAS u32x4*)(hfl + gi * 2048) = (u32x4){pk2(a[0], a[1]), pk2(a[2], a[3]), pk2(a[4], a[5]), pk2(a[6], a[7])};
                *(LAS u32x4*)(hfl + gi * 2048 + 16) = (u32x4){pk2(a[8], a[9]), pk2(a[10], a[11]), pk2(a[12], a[13]), pk2(a[14], a[15])};
            }
        }
        {
            const LruW& W = Wb;
            float s = cin_b;
            for (int gi = 3; gi >= 0; --gi) {
                bf16_t grc[16];
#pragma unroll
                for (int t = 0; t < 16; ++t) grc[t] = grn[t];
                if (gi > 0) {
#pragma unroll
                    for (int t = 0; t < 16; ++t) grn[t] = grp[(size_t)((gi - 1) * 64 + t) * LW]; }
                float a[16], uu[16];
#pragma unroll
                for (int tau = 0; tau < 4; ++tau) { f32x4 pr, pi, xct; lru_tile_lds(tile, xcl, gi, tau, W, fr, fq, pr, pi, xct);
#pragma unroll
                    for (int j = 0; j < 4; ++j) lru_gate<LDBG>(pr[j], pi[j], xct[j], W, c_last && gi == 3 && fq == 3 && tau == 3 && j == 3, a[4 * tau + j], uu[4 * tau + j]); }
                float p = 1.f, h = 0.f;
#pragma unroll
                for (int t = 15; t >= 0; --t) { h = a[t] * h + uu[t]; p *= a[t]; }
                float hin = s, sg = s;
#pragma unroll
                for (int qq = 3; qq >= 0; --qq) { const float P = __shfl(p, fr + 16 * qq), H = __shfl(h, fr + 16 * qq); sg = P * sg + H; if (qq > fq) hin = P * hin + H; }
                s = sg;
                float hh = hin;
                const u32x4 hf0 = *(const LAS u32x4*)(hfl + gi * 2048), hf1 = *(const LAS u32x4*)(hfl + gi * 2048 + 16);
                const unsigned hfw[8] = {hf0.x, hf0.y, hf0.z, hf0.w, hf1.x, hf1.y, hf1.z, hf1.w};
#pragma unroll
                for (int t = 15; t >= 0; --t) { hh = a[t] * hh + uu[t];
                    outp[(size_t)(gi * 64 + t) * LW] = (bf16_t)f2bf((((t & 1) ? bfhi(hfw[t >> 1]) : bflo(hfw[t >> 1])) + hh) * gelu_tanh(bf1(grc[t]))); }
            }
        }
        LDS_WAIT(); __builtin_amdgcn_s_barrier();
    }
}

constexpr int HQW_EARLY = 96 * (D / 32);
__device__ __forceinline__ void hq_wtiles(Frame& F, int lo, int hi, int first, int stride) {
    const int lane = opaque(F.tid) & 63;
    LAS float* scr = (LAS float*)(F.lds + F.wave * 8448);
    for (int it = lo + first; it < hi; it += stride)
        had_tile_quant(F.in_WFD, D, DFF, 64 * (it / (D / 32)), 32 * (it % (D / 32)), wsp<signed char>(F, WS_WD), (const unsigned*)(F.ws + WS_AM), wsp<float>(F, WS_CS) + CS_D, scr, lane);
}
__device__ __forceinline__ void hq_phase(Frame& F) {
    const int lane = opaque(F.tid) & 63;
    const bf16_t* H0 = (const bf16_t*)F.out; const bf16_t* H1 = wsp<bf16_t>(F, WS_HIDS);
    signed char* Q0 = wsp<signed char>(F, WS_H8P); signed char* Q1 = wsp<signed char>(F, WS_H8S); float* RS3 = wsp<float>(F, WS_RS3);
    hq_wtiles(F, HQW_EARLY, (DFF / 64) * (D / 32), F.gw, F.ngw);
    constexpr int NB = DFF / 32;
    for (int m = F.gw; m < L; m += F.ngw) {
        const bf16_t* src = m < LP ? H0 + (size_t)m * DFF : H1 + (size_t)(m - LP) * DFF;
        signed char* dst = m < LP ? Q0 + (size_t)m * DFF : Q1 + (size_t)(m - LP) * DFF;
        u32x4 raw[6][4];
#pragma unroll
        for (int it = 0; it < 6; ++it) { const int b = lane + 64 * it; const u32x4* p = (const u32x4*)(src + (b < NB ? b : lane) * 32);
#pragma unroll
            for (int i = 0; i < 4; ++i) raw[it][i] = p[i]; }
        float mx = 0.f;
#pragma unroll
        for (int it = 0; it < 6; ++it) { float v[32];
#pragma unroll
            for (int i = 0; i < 4; ++i) { const u32x4 u = raw[it][i]; v[8 * i + 0] = bflo(u.x); v[8 * i + 1] = bfhi(u.x); v[8 * i + 2] = bflo(u.y); v[8 * i + 3] = bfhi(u.y); v[8 * i + 4] = bflo(u.z); v[8 * i + 5] = bfhi(u.z); v[8 * i + 6] = bflo(u.w); v[8 * i + 7] = bfhi(u.w); }
            fwht32(v);
            float bm = 0.f;
#pragma unroll
            for (int i = 0; i < 32; ++i) bm = fmaxf(bm, fabsf(v[i]));
            mx = fmaxf(mx, (lane + 64 * it < NB) ? bm : 0.f); }
        const float amax = fmaxf(wave_max(mx), 1e-20f), inv = 127.0f / amax;
        if (lane == 0) RS3[m] = amax * (1.0f / 127.0f);
#pragma unroll
        for (int it = 0; it < 6; ++it) { const int b = lane + 64 * it; float v[32];
#pragma unroll
            for (int i = 0; i < 4; ++i) { const u32x4 u = raw[it][i]; v[8 * i + 0] = bflo(u.x); v[8 * i + 1] = bfhi(u.x); v[8 * i + 2] = bflo(u.y); v[8 * i + 3] = bfhi(u.y); v[8 * i + 4] = bflo(u.z); v[8 * i + 5] = bfhi(u.z); v[8 * i + 6] = bflo(u.w); v[8 * i + 7] = bfhi(u.w); }
            fwht32(v);
            u32x4 o0, o1;
            o0.x = pk4_i8(rintf(v[0] * inv), rintf(v[1] * inv), rintf(v[2] * inv), rintf(v[3] * inv)); o0.y = pk4_i8(rintf(v[4] * inv), rintf(v[5] * inv), rintf(v[6] * inv), rintf(v[7] * inv));
            o0.z = pk4_i8(rintf(v[8] * inv), rintf(v[9] * inv), rintf(v[10] * inv), rintf(v[11] * inv)); o0.w = pk4_i8(rintf(v[12] * inv), rintf(v[13] * inv), rintf(v[14] * inv), rintf(v[15] * inv));
            o1.x = pk4_i8(rintf(v[16] * inv), rintf(v[17] * inv), rintf(v[18] * inv), rintf(v[19] * inv)); o1.y = pk4_i8(rintf(v[20] * inv), rintf(v[21] * inv), rintf(v[22] * inv), rintf(v[23] * inv));
            o1.z = pk4_i8(rintf(v[24] * inv), rintf(v[25] * inv), rintf(v[26] * inv), rintf(v[27] * inv)); o1.w = pk4_i8(rintf(v[28] * inv), rintf(v[29] * inv), rintf(v[30] * inv), rintf(v[31] * inv));
            if (b < NB) { *(u32x4*)(dst + b * 32) = o0; *(u32x4*)(dst + b * 32 + 16) = o1; } }
    }
}

__device__ __forceinline__ f32x4 up4(const u32x2 u) { return (f32x4){bflo(u.x), bfhi(u.x), bflo(u.y), bfhi(u.y)}; }
__device__ __forceinline__ void mid_phase(Frame& F) {
    const int tid_ = opaque(F.tid);
    bf16_t* MIX = wsp<bf16_t>(F, WS_MIX); signed char* XN8 = wsp<signed char>(F, WS_XN8); float* RS2 = wsp<float>(F, WS_RS2);
    LAS f32x4* gpost = (LAS f32x4*)F.lds; LAS f32x4* gpre = gpost + D / 4;
    for (int i = tid_; i < D / 4; i += NTHR) { gpost[i] = ((const f32x4*)F.in_GMPOST)[i]; gpre[i] = ((const f32x4*)F.in_GFPRE)[i]; }
    __syncthreads();
    for (int m = F.gw; m < L; m += F.ngw) {
        asm volatile("" ::: "memory");
        const f32x4* xr = (const f32x4*)xrow(F, m) + F.lane; const u32x2* mr = (const u32x2*)(MIX + (size_t)m * D) + F.lane;
        f32x4 v[16]; u32x2 mx[16]; float s = 0.f;
#pragma unroll
        for (int j = 0; j < 16; ++j) { v[j] = xr[64 * j]; mx[j] = mr[64 * j]; const f32x4 a = up4(mx[j]); s += (a.x * a.x + a.y * a.y) + (a.z * a.z + a.w * a.w); }
        const float rstd1 = 1.0f / sqrtf(wave_sum(s) * (1.0f / D) + EPS);
        float s2 = 0.f;
#pragma unroll
        for (int j = 0; j < 16; ++j) { v[j] = v[j] + up4(mx[j]) * rstd1 * gpost[F.lane + 64 * j]; s2 += (v[j].x * v[j].x + v[j].y * v[j].y) + (v[j].z * v[j].z + v[j].w * v[j].w); }
        const float rstd2 = 1.0f / sqrtf(wave_sum(s2) * (1.0f / D) + EPS);
        { u32x2* xw = (u32x2*)(MIX + (size_t)m * D) + F.lane;
#pragma unroll
          for (int j = 0; j < 16; ++j) xw[64 * j] = (u32x2){pk2(v[j].x, v[j].y), pk2(v[j].z, v[j].w)}; }
        float mx2 = 0.f;
#pragma unroll
        for (int j = 0; j < 16; ++j) { v[j] = v[j] * rstd2 * gpre[F.lane + 64 * j]; mx2 = fmaxf(fmaxf(mx2, fmaxf(fabsf(v[j].x), fabsf(v[j].y))), fmaxf(fabsf(v[j].z), fabsf(v[j].w))); }
        const float amax = fmaxf(wave_max(mx2), 1e-20f), inv = 127.0f / amax;
        if (F.lane == 0) RS2[m] = amax * (1.0f / 127.0f);
        unsigned* o4 = (unsigned*)(XN8 + (size_t)m * D) + F.lane;
#pragma unroll
        for (int j = 0; j < 16; ++j) o4[64 * j] = pk4_i8(rintf(v[j].x * inv), rintf(v[j].y * inv), rintf(v[j].z * inv), rintf(v[j].w * inv));
    }
    __syncthreads();
}
__device__ __forceinline__ void final_phase(Frame& F) {
    const int tid_ = opaque(F.tid);
    const bf16_t* X1 = wsp<bf16_t>(F, WS_MIX); const bf16_t* FB = wsp<bf16_t>(F, WS_F);
    LAS f32x4* gfp = (LAS f32x4*)F.lds;
    for (int i = tid_; i < D / 4; i += NTHR) gfp[i] = ((const f32x4*)F.in_GFPOST)[i];
    __syncthreads();
    for (int m = F.gw; m < L; m += F.ngw) {
        asm volatile("" ::: "memory");
        const u32x2* mr = (const u32x2*)(X1 + (size_t)m * D) + F.lane; const u32x2* fr = (const u32x2*)(FB + (size_t)m * D) + F.lane;
        u32x2 fx[16], x1[16]; float s = 0.f;
#pragma unroll
        for (int j = 0; j < 16; ++j) { fx[j] = fr[64 * j]; x1[j] = mr[64 * j]; const f32x4 a = up4(fx[j]); s += (a.x * a.x + a.y * a.y) + (a.z * a.z + a.w * a.w); }
        const float rstd3 = 1.0f / sqrtf(wave_sum(s) * (1.0f / D) + EPS);
        f32x4* o = (f32x4*)(F.out + (size_t)m * D) + F.lane;
#pragma unroll
        for (int j = 0; j < 16; ++j) o[64 * j] = up4(x1[j]) + up4(fx[j]) * rstd3 * gfp[F.lane + 64 * j];
    }
}

constexpr int LDS_STAGE = pg8::STAGE_BYTES;
constexpr int LDS_MISC = LDS_STAGE;
constexpr int LDS_BYTES = LDS_STAGE + 1024;
#ifndef MK_N_LAUNCHES
#define MK_N_LAUNCHES 1
#endif
constexpr int NPHASE = 12;
struct Args { const float* in[23]; float* out; unsigned char* ws; int ph_lo, ph_hi; };

__global__ void __launch_bounds__(NTHR, 2) fwd_kernel(Args args) {
    extern __shared__ __attribute__((aligned(16))) unsigned char lds_raw[];
    Frame F;
    F.lds = (LAS unsigned char*)lds_raw;
    F.tid = threadIdx.x; F.lane = (int)__builtin_amdgcn_mbcnt_hi(~0u, __builtin_amdgcn_mbcnt_lo(~0u, 0u)); F.wave = __builtin_amdgcn_readfirstlane(F.tid >> 6);
    F.G = gridDim.x; F.gw = blockIdx.x * NWAVES + F.wave; F.ngw = F.G * NWAVES;
    F.in_XP = args.in[0]; F.in_XS = args.in[1]; F.in_WIN = args.in[2]; F.in_WCONV = args.in[3]; F.in_BCONV = args.in[4]; F.in_WR = args.in[5]; F.in_BR = args.in[6]; F.in_WI = args.in[7]; F.in_BI = args.in[8]; F.in_LAM = args.in[9]; F.in_RPB = args.in[10]; F.in_WNO = args.in[11]; F.in_WLO = args.in[12]; F.in_WM = args.in[13]; F.in_BM = args.in[14]; F.in_WOUT = args.in[15]; F.in_GMPRE = args.in[16]; F.in_GMPOST = args.in[17]; F.in_GFPRE = args.in[18]; F.in_GFPOST = args.in[19]; F.in_WFG = args.in[20]; F.in_WFU = args.in[21]; F.in_WFD = args.in[22];
    F.out = args.out; F.ws = args.ws;
    volatile LAS unsigned* MISC = (volatile LAS unsigned*)(F.lds + LDS_MISC);
    if (F.tid < 256) MISC[F.tid] = 0u;
    __syncthreads();
    const int lo = args.ph_lo, hi = args.ph_hi;
    const bool fused = (hi - lo) > 1;
    XcdBarrier bar; bar.bar = (unsigned*)(F.ws + WS_CTL); bar.x = 0; bar.st = nullptr;
    if (fused) bar = xcd_barrier_post((unsigned*)(F.ws + WS_CTL), MISC + 8);
#ifndef PH_MASK
#define PH_MASK 0xfff
#endif
#define IN(k) (((PH_MASK >> (k)) & 1) && lo <= (k) && (k) < hi)
#define SEAM(k) do { if (IN(k) && IN((k) + 1)) xcd_barrier(bar); } while (0)
    LAS unsigned char* stage = F.lds;

#ifdef ATTN_OUT_OFF
#define NA_BUF ((size_t)ATTN_OUT_OFF * MiB)
#else
#define NA_BUF WS_Q
#endif
#ifndef DUP_MASK
#define DUP_MASK 0
#endif
#define RUN(k, ...) if (IN(k)) { __VA_ARGS__ if (((DUP_MASK) >> (k)) & 1) { __VA_ARGS__ } }
    RUN(0, { p0_prologue(F); }) SEAM(0);
    RUN(1, {
        { pg8::Gemm g{wsp<bf16_t>(F, WS_XN8), wsp<bf16_t>(F, WS_XN8), 1 << 30, wsp<bf16_t>(F, WS_W8), L, 2 * NAW + 2 * D, D}; pg8::StaticOrder S; S.init(L, 2 * NAW + 2 * D, F.G, (int)blockIdx.x);
          pg8::EpiProjQ E{wsp<bf16_t>(F, WS_Q), wsp<bf16_t>(F, WS_K), (bf16_t*)F.out, F.in_BM, wsp<float>(F, WS_RS1), wsp<float>(F, WS_CS) + CS_QKM};
          pg8::gemm_phase<pg8::EpiProjQ, pg8::StaticOrder, true, true, 2>(stage, g, S, E); }
        { pg8::Gemm g{wsp<bf16_t>(F, WS_XN), wsp<bf16_t>(F, WS_XN), 1 << 30, wsp<bf16_t>(F, WS_WCAT), L, 2 * NAW, 2 * D}; pg8::StaticOrder S; S.init(L, 2 * NAW, F.G, (int)blockIdx.x);
          pg8::EpiProj E{wsp<bf16_t>(F, WS_XR), wsp<bf16_t>(F, WS_GR), wsp<bf16_t>(F, WS_GR), wsp<bf16_t>(F, WS_GR), (bf16_t*)F.out, F.in_BM, 1 << 30};
          pg8::gemm_phase<pg8::EpiProj, pg8::StaticOrder, true, true, 0>(stage, g, S, E); }
        { pg8::Gemm g{wsp<bf16_t>(F, WS_WVT), wsp<bf16_t>(F, WS_WVT), 1 << 30, wsp<bf16_t>(F, WS_XN8), NAW, L, D}; pg8::StaticOrder S; S.init(NAW, L, F.G, (int)blockIdx.x);
          pg8::EpiVTQ E{wsp<bf16_t>(F, WS_VT), wsp<float>(F, WS_CS) + CS_V, wsp<float>(F, WS_RS1)};
          pg8::gemm_phase<pg8::EpiVTQ, pg8::StaticOrder, true, true, 2>(stage, g, S, E); }
    }) SEAM(1);
    RUN(2, { lru_pass_a(F); }) SEAM(2);
    #ifdef ATTN_OUT_OFF
    if (IN(3)) { lru_pass_b(F); } SEAM(3);
    if (IN(4)) { lru_pass_c<0>(F); xcd_barrier(bar); if (ATTN_DUP) attn_mfma<ATTN_DUP - 1>(F); attn_mfma<0>(F); } SEAM(4);
#else
    if (IN(3)) { lru_pass_b(F); attn_mfma_lds(F); } SEAM(3);
#ifdef LRUC_DBG
    if (IN(4)) { lru_pass_c<LRUC_DBG>(F); lru_pass_c<0>(F); } SEAM(4);
#else
    RUN(4, { lru_pass_c<0>(F); }) SEAM(4);
#endif
#endif
    if (IN(5)) {
        { pg8::Gemm g{wsp<bf16_t>(F, NA_BUF), wsp<bf16_t>(F, NA_BUF), 1 << 30, wsp<bf16_t>(F, WS_WNO), L, D, 2 * NAW}; pg8::StaticOrder S; S.init(L, D, F.G, (int)blockIdx.x);
          pg8::EpiMulG<false> E{wsp<bf16_t>(F, WS_T1), (const bf16_t*)F.out, 0};
          pg8::gemm_phase<pg8::EpiMulG<false>, pg8::StaticOrder, true, true>(stage, g, S, E); }
        { pg8::Gemm g{wsp<bf16_t>(F, WS_XR), wsp<bf16_t>(F, WS_XR), 1 << 30, wsp<bf16_t>(F, WS_WLO), L, D, 2 * LW}; pg8::StaticOrder S; S.init(L, D, F.G, (int)blockIdx.x);
          pg8::EpiMulG<true> E{wsp<bf16_t>(F, WS_T1), (const bf16_t*)F.out, D};
          pg8::gemm_phase<pg8::EpiMulG<true>, pg8::StaticOrder, true, true>(stage, g, S, E); }
    } SEAM(5);
    RUN(6, {
        pg8::Gemm g{wsp<bf16_t>(F, WS_T1), wsp<bf16_t>(F, WS_T1), 1 << 30, wsp<bf16_t>(F, WS_WO), L, D, 2 * D}; pg8::StaticOrder S; S.init(L, D, F.G, (int)blockIdx.x);
        pg8::EpiPlain E{wsp<bf16_t>(F, WS_MIX), D};
        pg8::gemm_phase<pg8::EpiPlain, pg8::StaticOrder, true, true>(stage, g, S, E);
    }) SEAM(6);
    RUN(7, { mid_phase(F); }) SEAM(7);
    RUN(8, {
        pg8::Gemm g{wsp<bf16_t>(F, WS_XN8), wsp<bf16_t>(F, WS_XN8), 1 << 30, wsp<bf16_t>(F, WS_WGU), L, 2 * DFF, D}; pg8::StaticOrder S; S.init(L, 2 * DFF, F.G, (int)blockIdx.x);
        pg8::EpiSwigluQ E{(bf16_t*)F.out, wsp<bf16_t>(F, WS_HIDS), LP / 256, wsp<float>(F, WS_RS2), wsp<float>(F, WS_CS) + CS_GU};
        pg8::gemm_phase<pg8::EpiSwigluQ, pg8::StaticOrder, false, true, 2>(stage, g, S, E);
        { const int rem = S.nwg % F.G;
          if ((int)blockIdx.x >= rem) hq_wtiles(F, 0, HQW_EARLY, ((int)blockIdx.x - rem) * NWAVES + F.wave, (F.G - rem) * NWAVES); }
    }) SEAM(8);
    RUN(9, { hq_phase(F); }) SEAM(9);
    RUN(10, {
        pg8::Gemm g{wsp<bf16_t>(F, WS_H8P), wsp<bf16_t>(F, WS_H8S), LP / 256, wsp<bf16_t>(F, WS_WD), L, D, DFF}; pg8::StaticOrder S; S.init(L, D, F.G, (int)blockIdx.x);
        pg8::EpiPlainQ E{wsp<bf16_t>(F, WS_F), D, wsp<float>(F, WS_RS3), wsp<float>(F, WS_CS) + CS_D};
        pg8::gemm_phase<pg8::EpiPlainQ, pg8::StaticOrder, true, true, 2>(stage, g, S, E);
    }) SEAM(10);
    RUN(11, { final_phase(F); })
#undef RUN
#undef IN
#undef SEAM
}

extern "C" void kernel_launch(void* const* d_in, const int* in_sizes, int n_in, void* d_out, int out_size, void* d_ws, size_t ws_size, hipStream_t stream) {
    static int grid = 0;
    if (grid == 0) {
        if (n_in != 23 || in_sizes[0] != LP * D || in_sizes[1] != LS * D || out_size != L * D || ws_size < WS_END) {
            fprintf(stderr, "kernel_launch: unexpected shapes: n_in %d in0 %d out %d ws %zu (need %zu)\n", n_in, n_in > 0 ? in_sizes[0] : -1, out_size, ws_size, (size_t)WS_END); grid = -1; return; }
        int dev = 0, cus = 0, per_cu = 0;
        if (hipGetDevice(&dev) != hipSuccess || hipDeviceGetAttribute(&cus, hipDeviceAttributeMultiprocessorCount, dev) != hipSuccess) { grid = -1; return; }
        if (hipFuncSetAttribute((const void*)fwd_kernel, hipFuncAttributeMaxDynamicSharedMemorySize, LDS_BYTES) != hipSuccess) { fprintf(stderr, "kernel_launch: hipFuncSetAttribute failed\n"); grid = -1; return; }
        if (hipOccupancyMaxActiveBlocksPerMultiprocessor(&per_cu, (const void*)fwd_kernel, NTHR, LDS_BYTES) != hipSuccess || per_cu < 1) { fprintf(stderr, "kernel_launch: occupancy query says %d\n", per_cu); }
        (void)hipGetLastError();
        grid = cus;
    }
    if (grid < 0) return;
    (void)hipMemsetAsync((char*)d_ws + WS_CTL, 0, CTL_ZERO_BYTES, stream);
#ifdef DBG_ZERO_ALL
    (void)hipMemsetAsync((char*)d_ws, 0, WS_END, stream); (void)hipMemsetAsync((char*)d_out, 0, (size_t)L * D * 4, stream);
#endif
    Args a{};
    for (int i = 0; i < 23; ++i) a.in[i] = (const float*)d_in[i];
    a.out = (float*)d_out; a.ws = (unsigned char*)d_ws;
#if MK_N_LAUNCHES == 1
    a.ph_lo = 0; a.ph_hi = NPHASE;
    hipLaunchKernelGGL(fwd_kernel, dim3(grid), dim3(NTHR), LDS_BYTES, stream, a);
#else
    for (int p = 0; p < NPHASE; ++p) {
#ifdef DBG_PH_MASK
        if (!((DBG_PH_MASK >> p) & 1)) continue;
#endif
        a.ph_lo = p; a.ph_hi = p + 1; hipLaunchKernelGGL(fwd_kernel, dim3(grid), dim3(NTHR), LDS_BYTES, stream, a); }
#endif
}
```

```cpp
#include <hip/hip_runtime.h>
#include <cstdio>
#include <cstdint>

#define LAS __attribute__((address_space(3)))
typedef unsigned short bf16_t;
typedef short bf16x8 __attribute__((ext_vector_type(8)));
typedef float f32x4 __attribute__((ext_vector_type(4)));
typedef float f32x2 __attribute__((ext_vector_type(2)));
typedef unsigned u32x4 __attribute__((ext_vector_type(4)));
typedef unsigned u32x2 __attribute__((ext_vector_type(2)));

constexpr int D = 4096, LP = 16384, LS = 8192, L = LP + LS;
constexpr int GRIDW = 64, HD = 128, NH = 16, NAW = 2048, LW = 2048, NBLK = 16, BW = 128, DFF = 11008, INW = 10240;
constexpr float EPS = 1e-6f;
constexpr int NWAVES = 8, NTHR = 512;

constexpr size_t MiB = 1u << 20;
constexpr size_t WS_CTL = 0, CTL_ZERO_BYTES = 64 * 1024;
constexpr size_t WS_AM = 32 * 1024;
constexpr size_t WS_RSTD = 1 * MiB;
constexpr size_t WS_RS1 = 1 * MiB + 128 * 1024;
constexpr size_t WS_RS2 = 1 * MiB + 256 * 1024;
constexpr size_t WS_CS = 1 * MiB + 384 * 1024;
constexpr size_t WS_SUM = 2 * MiB;
constexpr size_t WS_WCAT = 8 * MiB;
constexpr size_t WS_W8 = 40 * MiB;
constexpr size_t WS_WVT = 88 * MiB;
constexpr size_t WS_XN8 = 96 * MiB;
constexpr size_t WS_WNO = 192 * MiB;
constexpr size_t WS_WLO = 208 * MiB;
constexpr size_t WS_WO = 224 * MiB;
constexpr size_t WS_WGU = 256 * MiB;
constexpr size_t WS_WD = 342 * MiB;
constexpr size_t WS_WG = 428 * MiB;
constexpr size_t WS_XN = 430 * MiB;
constexpr size_t WS_Q = 622 * MiB;
constexpr size_t WS_XR = 718 * MiB;
constexpr size_t WS_K = 814 * MiB;
constexpr size_t WS_VT = 910 * MiB;
constexpr size_t WS_GR = 1006 * MiB;
constexpr size_t WS_XC = 1102 * MiB;
constexpr size_t WS_END = 1198 * MiB;
constexpr int CS_QKM = 0, CS_V = 12288, CS_GU = 12288 + 2048, CS_D = 12288 + 2048 + 22016;
constexpr size_t WS_RS3 = 1 * MiB + 640 * 1024;
constexpr size_t WS_H8P = WS_XN, WS_H8S = WS_XN8;
constexpr size_t WS_T1 = WS_K;
constexpr size_t WS_MIX = WS_GR;
constexpr size_t WS_HIDS = WS_Q;
constexpr size_t WS_F = WS_K;
constexpr size_t WS_HF = WS_K;

#define LDS_WAIT() asm volatile("s_waitcnt lgkmcnt(0)" ::: "memory")
#define VM_WAIT() asm volatile("s_waitcnt vmcnt(0)" ::: "memory")
typedef __bf16 bf16x2n_t __attribute__((ext_vector_type(2)));
__device__ __forceinline__ unsigned pk2(float lo, float hi) { const bf16x2n_t r = __builtin_convertvector((f32x2){lo, hi}, bf16x2n_t); return __builtin_bit_cast(unsigned, r); }
__device__ __forceinline__ unsigned f2bf(float f) { return pk2(f, 0.f) & 0xffffu; }
__device__ __forceinline__ float bflo(unsigned u) { return __builtin_bit_cast(float, u << 16); }
__device__ __forceinline__ float bfhi(unsigned u) { return __builtin_bit_cast(float, u & 0xffff0000u); }
__device__ __forceinline__ float bf1(bf16_t u) { return __builtin_bit_cast(float, (unsigned)u << 16); }
__device__ __forceinline__ float wave_sum(float v) {
#pragma unroll
    for (int o = 1; o < 64; o <<= 1) v += __shfl_xor(v, o);
    return v;
}
__device__ __forceinline__ float wave_max(float v) {
#pragma unroll
    for (int o = 1; o < 64; o <<= 1) v = fmaxf(v, __shfl_xor(v, o));
    return v;
}
__device__ __forceinline__ float sigmoidf_(float v) { return __builtin_amdgcn_rcpf(1.0f + __expf(-v)); }
__device__ __forceinline__ float gelu_tanh(float v) { const float z = v * __builtin_fmaf(v * v, -0.1029432f, -2.3022082f); return v * __builtin_amdgcn_rcpf(1.0f + __builtin_amdgcn_exp2f(z)); }

namespace pg8 {
constexpr int BM = 256, BK = 64, HALF = 128, HTB = HALF * BK * 2  , STAGE_BYTES = 8 * HTB, NXCD = 8, WGM = 4;

__host__ __device__ __forceinline__ int lds_byte(int r, int c) { return (r >> 3) * 1024 + (r & 7) * 128 + ((((c >> 3) ^ r) & 7) << 4) + (c & 7) * 2; }
__host__ __device__ __forceinline__ void stage_rc(int b, int& R, int& C) { const int ch = b >> 10, rr = (b >> 7) & 7, slot = (b >> 4) & 7; R = ch * 8 + rr; C = ((slot ^ rr) & 7) * 8; }
__host__ __device__ __forceinline__ int perm32(int rho) { const int n = rho >> 4, i = rho & 15; return 8 * (i >> 2) + 4 * n + (i & 3); }

struct Unit { int pm, pn; };
struct Gemm {
    const bf16_t* A; const bf16_t* A2; int pm_split; const bf16_t* Bt; int M, N, rb;
    __device__ __forceinline__ const char* abase(int pm) const { const size_t t = (size_t)BM * rb; return pm < pm_split ? (const char*)A + (size_t)pm * t : (const char*)A2 + (size_t)(pm - pm_split) * t; }
    __device__ __forceinline__ const char* bbase(int pn) const { return (const char*)Bt + (size_t)pn * BM * rb; }
};

struct StaticOrder {
    int nM, nN, nwg, G, c;
    __host__ __device__ void init(int M, int N, int G_, int c_) { nM = M / BM; nN = N / BM; nwg = nM * nN; G = G_; c = c_; }
    __host__ __device__ bool next(int i, Unit& u) const {
        const long Lx = (long)i * G + c; if (Lx >= nwg) return false;
        int wgid = (int)Lx; { const int q = nwg / NXCD, r = nwg % NXCD, xcd = wgid % NXCD, off = wgid / NXCD; wgid = (xcd < r ? xcd * (q + 1) : r * (q + 1) + (xcd - r) * q) + off; }
        const int nig = WGM * nN, gid = wgid / nig, fm = gid * WGM, gsz = (nM - fm) < WGM ? (nM - fm) : WGM;
        u.pm = fm + ((wgid % nig) % gsz); u.pn = (wgid % nig) / gsz; return true;
    }
    __device__ __forceinline__ void a_ready(const Unit&) const {}
    __device__ __forceinline__ void done(const Unit&) const {}
};

typedef int v8i32 __attribute__((ext_vector_type(8)));
typedef int v4i32 __attribute__((ext_vector_type(4)));
typedef __bf16 bf16x2_t __attribute__((ext_vector_type(2)));
__device__ __forceinline__ unsigned cvt_pk_bf16(float lo, float hi) { const bf16x2_t r = __builtin_convertvector((f32x2){lo, hi}, bf16x2_t); return __builtin_bit_cast(unsigned, r); }
__device__ __forceinline__ u32x4 pack8(const f32x4 v0, const f32x4 v1) { u32x4 w; w.x = cvt_pk_bf16(v0[0], v0[1]); w.y = cvt_pk_bf16(v0[2], v0[3]); w.z = cvt_pk_bf16(v1[0], v1[1]); w.w = cvt_pk_bf16(v1[2], v1[3]); return w; }
__device__ __forceinline__ void unpack8(const u32x4 w, f32x4& v0, f32x4& v1) { v0 = (f32x4){bflo(w.x), bfhi(w.x), bflo(w.y), bfhi(w.y)}; v1 = (f32x4){bflo(w.z), bfhi(w.z), bflo(w.w), bfhi(w.w)}; }
__device__ __forceinline__ f32x4 sig4(const f32x4 v) { f32x4 r; r[0] = sigmoidf_(v[0]); r[1] = sigmoidf_(v[1]); r[2] = sigmoidf_(v[2]); r[3] = sigmoidf_(v[3]); return r; }

struct EpiPlain {
    static constexpr bool PERM = true, AFTER_DRAIN = false;
    bf16_t* O; int ldc;
    __device__ __forceinline__ void operator()(const f32x4 (&acc)[2][2][4][2], const Unit& u, int wr, int wc, int fr, int fq) const {
        const int row0 = u.pm * BM + wr * 64 + fr, col0 = u.pn * BM + wc * 32 + 8 * fq;
#pragma unroll
        for (int ai = 0; ai < 2; ++ai)
#pragma unroll
            for (int m = 0; m < 4; ++m) { bf16_t* rowp = O + (size_t)(row0 + ai * HALF + m * 16) * ldc + col0;
#pragma unroll
                for (int bj = 0; bj < 2; ++bj) *(u32x4*)(rowp + bj * HALF) = pack8(acc[ai][bj][m][0], acc[ai][bj][m][1]); }
    }
};
struct EpiVT {
    static constexpr bool PERM = true, AFTER_DRAIN = false;
    bf16_t* O;
    __device__ __forceinline__ void operator()(const f32x4 (&acc)[2][2][4][2], const Unit& u, int wr, int wc, int fr, int fq) const {
        const int row0 = u.pm * BM + wr * 64 + fr, col0 = u.pn * BM + wc * 32 + 8 * fq;
#pragma unroll
        for (int ai = 0; ai < 2; ++ai)
#pragma unroll
            for (int m = 0; m < 4; ++m) { const int row = row0 + ai * HALF + m * 16, hh = row >> 7, d = row & 127;
                const int dt = 2 * (d >> 5) + ((d >> 2) & 1), i = 4 * ((d >> 3) & 3) + (d & 3);
#pragma unroll
                for (int bj = 0; bj < 2; ++bj) { const int tok = col0 + bj * HALF, R = tok >> 6, o = (tok & 63) >> 3;
                    *(u32x4*)(O + ((size_t)((((R * 16 + hh) * 8 + dt) * 8 + o) * 16 + i)) * 8) = pack8(acc[ai][bj][m][0], acc[ai][bj][m][1]); } }
    }
};
struct EpiProj {
    static constexpr bool PERM = true, AFTER_DRAIN = false;
    bf16_t* P0; bf16_t* P1; bf16_t* P2; bf16_t* P3; bf16_t* G; const float* bias; int pn_gate0;
    __device__ __forceinline__ void operator()(const f32x4 (&acc)[2][2][4][2], const Unit& u, int wr, int wc, int fr, int fq) const {
        const int row0 = u.pm * BM + wr * 64 + fr;
        if (u.pn < pn_gate0) {
            const int t = u.pn >> 3; bf16_t* base = t == 0 ? P0 : (t == 1 ? P1 : (t == 2 ? P2 : P3));
            const int col0 = (u.pn & 7) * BM + wc * 32 + 8 * fq;
            if (t == 2) {
#pragma unroll
                for (int ai = 0; ai < 2; ++ai)
#pragma unroll
                    for (int m = 0; m < 4; ++m) { const int tok = row0 + ai * HALF + m * 16, R = tok >> 6, cl = tok & 63;
                        const int tokpart = (((cl >> 2) & 1) * 8 + (cl >> 3)) * 4 + (cl & 3);
#pragma unroll
                        for (int bj = 0; bj < 2; ++bj) { const int c = col0 + bj * HALF, hh = c >> 7, d0 = c & 127;
                            *(u32x4*)(base + ((size_t)(((R * 16 + hh) * 4 + (d0 >> 5)) * 64 + tokpart) * 4 + ((d0 >> 3) & 3)) * 8) = pack8(acc[ai][bj][m][0], acc[ai][bj][m][1]); } }
            } else {
#pragma unroll
            for (int ai = 0; ai < 2; ++ai)
#pragma unroll
                for (int m = 0; m < 4; ++m) { bf16_t* rowp = base + (size_t)(row0 + ai * HALF + m * 16) * NAW + col0;
#pragma unroll
                    for (int bj = 0; bj < 2; ++bj) *(u32x4*)(rowp + bj * HALF) = pack8(acc[ai][bj][m][0], acc[ai][bj][m][1]); }
            }
        } else {
            const int col0 = (u.pn - pn_gate0) * BM + wc * 32 + 8 * fq;
            f32x4 bv[2][2];
#pragma unroll
            for (int bj = 0; bj < 2; ++bj)
#pragma unroll
                for (int n = 0; n < 2; ++n) bv[bj][n] = *(const f32x4*)(bias + col0 + bj * HALF + 4 * n);
#pragma unroll
            for (int ai = 0; ai < 2; ++ai)
#pragma unroll
                for (int m = 0; m < 4; ++m) { bf16_t* rowp = G + (size_t)(row0 + ai * HALF + m * 16) * (2 * D) + col0;
#pragma unroll
                    for (int bj = 0; bj < 2; ++bj) *(u32x4*)(rowp + bj * HALF) = pack8(sig4(acc[ai][bj][m][0] + bv[bj][0]), sig4(acc[ai][bj][m][1] + bv[bj][1])); }
        }
    }
};
template <bool ADD> struct EpiMulG {
    static constexpr bool PERM = true, AFTER_DRAIN = false;
    bf16_t* O; const bf16_t* G; int goff;
    __device__ __forceinline__ void operator()(const f32x4 (&acc)[2][2][4][2], const Unit& u, int wr, int wc, int fr, int fq) const {
        const int row0 = u.pm * BM + wr * 64 + fr, col0 = u.pn * BM + wc * 32 + 8 * fq;
#pragma unroll
        for (int ai = 0; ai < 2; ++ai)
#pragma unroll
            for (int m = 0; m < 4; ++m) { const size_t row = (size_t)(row0 + ai * HALF + m * 16); bf16_t* rowp = O + row * D + col0; const bf16_t* gp = G + row * (2 * D) + goff + col0;
#pragma unroll
                for (int bj = 0; bj < 2; ++bj) {
                    f32x4 g0, g1; unpack8(*(const u32x4*)(gp + bj * HALF), g0, g1);
                    f32x4 v0 = acc[ai][bj][m][0] * g0, v1 = acc[ai][bj][m][1] * g1;
                    if (ADD) { f32x4 t0, t1; unpack8(*(const u32x4*)(rowp + bj * HALF), t0, t1); v0 += t0; v1 += t1; }
                    *(u32x4*)(rowp + bj * HALF) = pack8(v0, v1); } }
    }
};
struct EpiSwiglu {
    static constexpr bool PERM = true, AFTER_DRAIN = false;
    bf16_t* H0; bf16_t* H1; int pm_split;
    __device__ __forceinline__ void operator()(const f32x4 (&acc)[2][2][4][2], const Unit& u, int wr, int wc, int fr, int fq) const {
        bf16_t* base = u.pm < pm_split ? H0 + (size_t)u.pm * BM * DFF : H1 + (size_t)(u.pm - pm_split) * BM * DFF;
        const int row0 = wr * 64 + fr, col0 = u.pn * HALF + wc * 32 + 8 * fq;
#pragma unroll
        for (int ai = 0; ai < 2; ++ai)
#pragma unroll
            for (int m = 0; m < 4; ++m) {
                f32x4 h[2];
#pragma unroll
                for (int n = 0; n < 2; ++n) { const f32x4 g = acc[ai][0][m][n], up = acc[ai][1][m][n];
#pragma unroll
                    for (int j = 0; j < 4; ++j) h[n][j] = g[j] * sigmoidf_(g[j]) * up[j]; }
                *(u32x4*)(base + (size_t)(row0 + ai * HALF + m * 16) * DFF + col0) = pack8(h[0], h[1]); }
    }
};

__device__ __forceinline__ f32x4 deq4(const f32x4 accbits, const float sa, const f32x4 sb) { const v4i32 q = __builtin_bit_cast(v4i32, accbits); return (f32x4){(float)q.x, (float)q.y, (float)q.z, (float)q.w} * sa * sb; }
struct EpiProjQ {
    static constexpr bool PERM = true, AFTER_DRAIN = false;
    bf16_t* Qb; bf16_t* Kb; bf16_t* G; const float* bias; const float* sa; const float* sb;
    __device__ __forceinline__ void operator()(const f32x4 (&acc)[2][2][4][2], const Unit& u, int wr, int wc, int fr, int fq) const {
        const int row0 = u.pm * BM + wr * 64 + fr, cg0 = u.pn * BM + wc * 32 + 8 * fq;
        f32x4 sbv[2][2];
#pragma unroll
        for (int bj = 0; bj < 2; ++bj)
#pragma unroll
            for (int n = 0; n < 2; ++n) sbv[bj][n] = *(const f32x4*)(sb + cg0 + bj * HALF + 4 * n);
        if (u.pn < 8) {
            const int col0 = u.pn * BM + wc * 32 + 8 * fq;
#pragma unroll
            for (int ai = 0; ai < 2; ++ai)
#pragma unroll
                for (int m = 0; m < 4; ++m) { const int row = row0 + ai * HALF + m * 16; const float sr = sa[row]; bf16_t* rowp = Qb + (size_t)row * NAW + col0;
#pragma unroll
                    for (int bj = 0; bj < 2; ++bj) *(u32x4*)(rowp + bj * HALF) = pack8(deq4(acc[ai][bj][m][0], sr, sbv[bj][0]), deq4(acc[ai][bj][m][1], sr, sbv[bj][1])); }
        } else if (u.pn < 16) {
            const int col0 = (u.pn - 8) * BM + wc * 32 + 8 * fq;
#pragma unroll
            for (int ai = 0; ai < 2; ++ai)
#pragma unroll
                for (int m = 0; m < 4; ++m) { const int tok = row0 + ai * HALF + m * 16, R = tok >> 6, cl = tok & 63; const float sr = sa[tok];
                    const int tokpart = (((cl >> 2) & 1) * 8 + (cl >> 3)) * 4 + (cl & 3);
#pragma unroll
                    for (int bj = 0; bj < 2; ++bj) { const int c = col0 + bj * HALF, hh = c >> 7, d0 = c & 127;
                        *(u32x4*)(Kb + ((size_t)(((R * 16 + hh) * 4 + (d0 >> 5)) * 64 + tokpart) * 4 + ((d0 >> 3) & 3)) * 8) = pack8(deq4(acc[ai][bj][m][0], sr, sbv[bj][0]), deq4(acc[ai][bj][m][1], sr, sbv[bj][1])); } }
        } else {
            const int col0 = (u.pn - 16) * BM + wc * 32 + 8 * fq;
            f32x4 bv[2][2];
#pragma unroll
            for (int bj = 0; bj < 2; ++bj)
#pragma unroll
                for (int n = 0; n < 2; ++n) bv[bj][n] = *(const f32x4*)(bias + col0 + bj * HALF + 4 * n);
#pragma unroll
            for (int ai = 0; ai < 2; ++ai)
#pragma unroll
                for (int m = 0; m < 4; ++m) { const int row = row0 + ai * HALF + m * 16; const float sr = sa[row]; bf16_t* rowp = G + (size_t)row * (2 * D) + col0;
#pragma unroll
                    for (int bj = 0; bj < 2; ++bj) *(u32x4*)(rowp + bj * HALF) = pack8(sig4(deq4(acc[ai][bj][m][0], sr, sbv[bj][0]) + bv[bj][0]), sig4(deq4(acc[ai][bj][m][1], sr, sbv[bj][1]) + bv[bj][1])); }
        }
    }
};
struct EpiPlainQ {
    static constexpr bool PERM = true, AFTER_DRAIN = false;
    bf16_t* O; int ldc; const float* sa; const float* sb;
    __device__ __forceinline__ void operator()(const f32x4 (&acc)[2][2][4][2], const Unit& u, int wr, int wc, int fr, int fq) const {
        const int row0 = u.pm * BM + wr * 64 + fr, col0 = u.pn * BM + wc * 32 + 8 * fq;
        f32x4 sbv[2][2];
#pragma unroll
        for (int bj = 0; bj < 2; ++bj)
#pragma unroll
            for (int n = 0; n < 2; ++n) sbv[bj][n] = *(const f32x4*)(sb + col0 + bj * HALF + 4 * n);
#pragma unroll
        for (int ai = 0; ai < 2; ++ai)
#pragma unroll
            for (int m = 0; m < 4; ++m) { const int row = row0 + ai * HALF + m * 16; const float sr = sa[row]; bf16_t* rowp = O + (size_t)row * ldc + col0;
#pragma unroll
                for (int bj = 0; bj < 2; ++bj) *(u32x4*)(rowp + bj * HALF) = pack8(deq4(acc[ai][bj][m][0], sr, sbv[bj][0]), deq4(acc[ai][bj][m][1], sr, sbv[bj][1])); }
    }
};
struct EpiVTQ {
    static constexpr bool PERM = true, AFTER_DRAIN = false;
    bf16_t* O; const float* sa; const float* sb;
    __device__ __forceinline__ void operator()(const f32x4 (&acc)[2][2][4][2], const Unit& u, int wr, int wc, int fr, int fq) const {
        const int row0 = u.pm * BM + wr * 64 + fr, col0 = u.pn * BM + wc * 32 + 8 * fq;
        f32x4 sbv[2][2];
#pragma unroll
        for (int bj = 0; bj < 2; ++bj)
#pragma unroll
            for (int n = 0; n < 2; ++n) sbv[bj][n] = *(const f32x4*)(sb + col0 + bj * HALF + 4 * n);
#pragma unroll
        for (int ai = 0; ai < 2; ++ai)
#pragma unroll
            for (int m = 0; m < 4; ++m) { const int row = row0 + ai * HALF + m * 16, hh = row >> 7, d = row & 127; const float sr = sa[row];
                const int dt = 2 * (d >> 5) + ((d >> 2) & 1), i = 4 * ((d >> 3) & 3) + (d & 3);
#pragma unroll
                for (int bj = 0; bj < 2; ++bj) { const int tok = col0 + bj * HALF, R = tok >> 6, o = (tok & 63) >> 3;
                    *(u32x4*)(O + ((size_t)((((R * 16 + hh) * 8 + dt) * 8 + o) * 16 + i)) * 8) = pack8(deq4(acc[ai][bj][m][0], sr, sbv[bj][0]), deq4(acc[ai][bj][m][1], sr, sbv[bj][1])); } }
    }
};
struct EpiSwigluQ {
    static constexpr bool PERM = true, AFTER_DRAIN = false;
    bf16_t* H0; bf16_t* H1; int pm_split; const float* sa; const float* sb;
    __device__ __forceinline__ void operator()(const f32x4 (&acc)[2][2][4][2], const Unit& u, int wr, int wc, int fr, int fq) const {
        bf16_t* base = u.pm < pm_split ? H0 + (size_t)u.pm * BM * DFF : H1 + (size_t)(u.pm - pm_split) * BM * DFF;
        const int row0 = wr * 64 + fr, col0 = u.pn * HALF + wc * 32 + 8 * fq, cg0 = u.pn * BM + wc * 32 + 8 * fq;
        f32x4 sbv[2][2];
#pragma unroll
        for (int bj = 0; bj < 2; ++bj)
#pragma unroll
            for (int n = 0; n < 2; ++n) sbv[bj][n] = *(const f32x4*)(sb + cg0 + bj * HALF + 4 * n);
#pragma unroll
        for (int ai = 0; ai < 2; ++ai)
#pragma unroll
            for (int m = 0; m < 4; ++m) { const float sr = sa[u.pm * BM + row0 + ai * HALF + m * 16];
                f32x4 h[2];
#pragma unroll
                for (int n = 0; n < 2; ++n) { const f32x4 g = deq4(acc[ai][0][m][n], sr, sbv[0][n]), up = deq4(acc[ai][1][m][n], sr, sbv[1][n]);
#pragma unroll
                    for (int j = 0; j < 4; ++j) h[n][j] = g[j] * sigmoidf_(g[j]) * up[j]; }
                *(u32x4*)(base + (size_t)(row0 + ai * HALF + m * 16) * DFF + col0) = pack8(h[0], h[1]); }
    }
};

__device__ __forceinline__ v8i32 cat8(const bf16x8 lo, const bf16x8 hi) { return __builtin_shufflevector(__builtin_bit_cast(v4i32, lo), __builtin_bit_cast(v4i32, hi), 0, 1, 2, 3, 4, 5, 6, 7); }
__device__ __forceinline__ void mfma_fp8_acc(f32x4& c, const v8i32 a, const v8i32 b, int sa, int sb) {
    asm volatile("v_mfma_scale_f32_16x16x128_f8f6f4 %0, %1, %2, %0, %3, %4 op_sel_hi:[0,0,0]" : "+v"(c) : "v"(a), "v"(b), "v"(sa), "v"(sb)); }
constexpr int FP8_SCALE = 0x73737373;
template <class Epi, class Sched, bool ALIGN_EPI = false, bool SP2 = false, int QM = 0  , int DBG = 0>
__device__ __forceinline__ void gemm_phase(LAS unsigned char* lds, const Gemm g, const Sched& S, const Epi& E) {
    int tid = threadIdx.x; asm volatile("" : "+v"(tid));
    const int wid = __builtin_amdgcn_readfirstlane(tid >> 6), lane = tid & 63, wr = wid >> 2, wc = wid & 3, fr = lane & 15, fq = lane >> 4;
    const int RB = g.rb, nt = RB / (BK * 2);
    unsigned voffA[2], voffB[2];
#pragma unroll
    for (int i = 0; i < 2; ++i) { int R, C; stage_rc(tid * 16 + i * 8192, R, C); const int Rb = Epi::PERM ? ((R & ~31) + perm32(R & 31)) : R;
        voffA[i] = (unsigned)(R * RB + C * 2); voffB[i] = (unsigned)(Rb * RB + C * 2); }
    const size_t kstep = (size_t)(BK * 2);
    const size_t hstep = (size_t)HALF * RB;
    const unsigned ldsw = (unsigned)wid * 1024u;
    const int aoff0 = lds_byte(wr * 64 + fr, fq * 8), aoff1 = lds_byte(wr * 64 + fr, 32 + fq * 8), boff0 = lds_byte(wc * 32 + fr, fq * 8), boff1 = lds_byte(wc * 32 + fr, 32 + fq * 8);
#define PG8_SA(b, h) (((b) * 2 + (h)) * HTB)
#define PG8_SB(b, h) ((4 + (b) * 2 + (h)) * HTB)
#define PG8_STAGE(bufoff, gbase, voff) do { if constexpr (DBG != 3) _Pragma("unroll") for (int _i = 0; _i < 2; ++_i) \
        __builtin_amdgcn_global_load_lds((const unsigned*)((const char*)(gbase) + (voff)[_i]), (LAS unsigned*)(lds + (bufoff) + ldsw + _i * 8192), 16, 0, 0); } while (0)
#define PG8_LDA(dst, b, h) do { if constexpr (DBG != 2) _Pragma("unroll") for (int m = 0; m < 4; ++m) _Pragma("unroll") for (int k = 0; k < 2; ++k) dst[m][k] = *(const LAS bf16x8*)(lds + PG8_SA(b, h) + (k ? aoff1 : aoff0) + m * 2048); } while (0)
#define PG8_LDB(dst, b, h) do { if constexpr (DBG != 2) _Pragma("unroll") for (int n = 0; n < 2; ++n) _Pragma("unroll") for (int k = 0; k < 2; ++k) dst[n][k] = *(const LAS bf16x8*)(lds + PG8_SB(b, h) + (k ? boff1 : boff0) + n * 2048); } while (0)
#define PG8_MMA(ai, bj, At, Bt) do { __builtin_amdgcn_s_setprio(1); if constexpr (DBG == 1) { } else if constexpr (QM == 2) { _Pragma("unroll") for (int m = 0; m < 4; ++m) _Pragma("unroll") for (int n = 0; n < 2; ++n) _Pragma("unroll") for (int k = 0; k < 2; ++k) \
        acc[ai][bj][m][n] = __builtin_bit_cast(f32x4, __builtin_amdgcn_mfma_i32_16x16x64_i8(__builtin_bit_cast(v4i32, Bt[n][k]), __builtin_bit_cast(v4i32, At[m][k]), __builtin_bit_cast(v4i32, acc[ai][bj][m][n]), 0, 0, 0)); } else if constexpr (QM == 1) { _Pragma("unroll") for (int m = 0; m < 4; ++m) _Pragma("unroll") for (int n = 0; n < 2; ++n) \
        mfma_fp8_acc(acc[ai][bj][m][n], cat8(Bt[n][0], Bt[n][1]), cat8(At[m][0], At[m][1]), fp8_sa, fp8_sb); } else { \
        _Pragma("unroll") for (int m = 0; m < 4; ++m) _Pragma("unroll") for (int n = 0; n < 2; ++n) _Pragma("unroll") for (int k = 0; k < 2; ++k) \
        acc[ai][bj][m][n] = __builtin_amdgcn_mfma_f32_16x16x32_bf16(Bt[n][k], At[m][k], acc[ai][bj][m][n], 0, 0, 0); } __builtin_amdgcn_s_setprio(0); } while (0)
#define PG8_WAIT_V(n) asm volatile("s_waitcnt vmcnt(" #n ")" ::: "memory")
#define PG8_WAIT_L(n) asm volatile("s_waitcnt lgkmcnt(" #n ")" ::: "memory")
#define PG8_BAR __builtin_amdgcn_s_barrier()
#define PG8_SCHED __builtin_amdgcn_sched_barrier(0)
    Unit cur, nxt; int ui = 0;
    const int fp8_sa = FP8_SCALE, fp8_sb = 0x7F7F7F7F;
    if (!S.next(0, cur)) return;
    f32x4 acc[2][2][4][2];
#pragma unroll
    for (int a = 0; a < 2; ++a)
#pragma unroll
        for (int b = 0; b < 2; ++b)
#pragma unroll
            for (int m = 0; m < 4; ++m)
#pragma unroll
                for (int n = 0; n < 2; ++n) acc[a][b][m][n] = (f32x4){0.f, 0.f, 0.f, 0.f};
    bf16x8 At[4][2], B0[2][2], B1[2][2];
    const char* cA = g.abase(cur.pm); const char* cB = g.bbase(cur.pn);
    S.a_ready(cur);
    if constexpr (SP2) {
        PG8_STAGE(PG8_SB(0, 0), cB, voffB); PG8_STAGE(PG8_SB(0, 1), cB + hstep, voffB); PG8_STAGE(PG8_SA(0, 0), cA, voffA); PG8_STAGE(PG8_SA(0, 1), cA + hstep, voffA);
        if (wr == 1) PG8_BAR;
        PG8_WAIT_V(2); PG8_BAR;
        PG8_STAGE(PG8_SB(1, 0), cB + kstep, voffB); PG8_STAGE(PG8_SA(1, 0), cA + kstep, voffA); PG8_STAGE(PG8_SB(1, 1), cB + hstep + kstep, voffB);
        PG8_WAIT_V(6); PG8_BAR;
    } else {
        PG8_STAGE(PG8_SB(0, 0), cB, voffB); PG8_STAGE(PG8_SA(0, 0), cA, voffA); PG8_STAGE(PG8_SB(0, 1), cB + hstep, voffB); PG8_STAGE(PG8_SA(0, 1), cA + hstep, voffA);
        if (wr == 1) PG8_BAR;
        PG8_WAIT_V(4); PG8_BAR;
        PG8_STAGE(PG8_SB(1, 0), cB + kstep, voffB); PG8_STAGE(PG8_SA(1, 0), cA + kstep, voffA); PG8_STAGE(PG8_SB(1, 1), cB + hstep + kstep, voffB);
        PG8_WAIT_V(6); PG8_BAR;
    }
    for (;;) {
        const bool has_next = S.next(ui + 1, nxt);
        const char* nA = has_next ? g.abase(nxt.pm) : cA; const char* nB = has_next ? g.bbase(nxt.pn) : cB;
        for (int t = 0; t < nt; t += 2) {
            const bool last = (t == nt - 2);
            const char* a1 = cA + (size_t)(t + 1) * kstep;
            const char* a2 = last ? nA : cA + (size_t)(t + 2) * kstep; const char* b2 = last ? nB : cB + (size_t)(t + 2) * kstep;
            const char* a3 = a2 + kstep; const char* b3 = b2 + kstep;
            if (last && has_next) S.a_ready(nxt);
            if constexpr (SP2) {
            PG8_LDB(B0, 0, 0); PG8_LDB(B1, 0, 1); PG8_SCHED; PG8_LDA(At, 0, 0); PG8_STAGE(PG8_SA(1, 1), a1 + hstep, voffA);
            PG8_WAIT_V(8); PG8_WAIT_L(0); PG8_BAR; PG8_MMA(0, 0, At, B0); PG8_MMA(0, 1, At, B1); PG8_BAR; PG8_SCHED;
            PG8_LDA(At, 0, 1); PG8_STAGE(PG8_SB(0, 0), b2, voffB); PG8_STAGE(PG8_SB(0, 1), b2 + hstep, voffB); PG8_STAGE(PG8_SA(0, 0), a2, voffA);
            PG8_WAIT_V(8); PG8_WAIT_L(0); PG8_BAR; PG8_MMA(1, 0, At, B0); PG8_MMA(1, 1, At, B1); PG8_BAR; PG8_SCHED;
            PG8_LDB(B0, 1, 0); PG8_LDB(B1, 1, 1); PG8_SCHED; PG8_LDA(At, 1, 0); PG8_STAGE(PG8_SA(0, 1), a2 + hstep, voffA);
            PG8_WAIT_V(8); PG8_WAIT_L(0); PG8_BAR; PG8_MMA(0, 0, At, B0); PG8_MMA(0, 1, At, B1); PG8_BAR; PG8_SCHED;
            PG8_LDA(At, 1, 1); PG8_STAGE(PG8_SB(1, 0), b3, voffB); PG8_STAGE(PG8_SB(1, 1), b3 + hstep, voffB); PG8_STAGE(PG8_SA(1, 0), a3, voffA);
            PG8_WAIT_V(8); PG8_WAIT_L(0); PG8_BAR; PG8_MMA(1, 0, At, B0); PG8_MMA(1, 1, At, B1); PG8_BAR; PG8_SCHED;
            } else {
            PG8_LDB(B0, 0, 0); PG8_SCHED; PG8_LDA(At, 0, 0); PG8_STAGE(PG8_SA(1, 1), a1 + hstep, voffA);
            PG8_WAIT_L(8); PG8_BAR; PG8_WAIT_L(0); PG8_MMA(0, 0, At, B0); PG8_BAR; PG8_SCHED;
            PG8_LDB(B1, 0, 1); PG8_STAGE(PG8_SB(0, 0), b2, voffB);
            PG8_BAR; PG8_WAIT_L(0); PG8_MMA(0, 1, At, B1); PG8_BAR;
            PG8_LDA(At, 0, 1); PG8_STAGE(PG8_SA(0, 0), a2, voffA);
            PG8_BAR; PG8_WAIT_L(0); PG8_MMA(1, 0, At, B0); PG8_BAR; PG8_SCHED;
            PG8_STAGE(PG8_SB(0, 1), b2 + hstep, voffB);
            PG8_WAIT_V(6); PG8_BAR; PG8_MMA(1, 1, At, B1); PG8_BAR;
            PG8_LDB(B0, 1, 0); PG8_SCHED; PG8_LDA(At, 1, 0); PG8_STAGE(PG8_SA(0, 1), a2 + hstep, voffA);
            PG8_WAIT_L(8); PG8_BAR; PG8_WAIT_L(0); PG8_MMA(0, 0, At, B0); PG8_BAR; PG8_SCHED;
            PG8_LDB(B1, 1, 1); PG8_STAGE(PG8_SB(1, 0), b3, voffB);
            PG8_BAR; PG8_WAIT_L(0); PG8_MMA(0, 1, At, B1); PG8_BAR;
            PG8_LDA(At, 1, 1); PG8_STAGE(PG8_SA(1, 0), a3, voffA);
            PG8_BAR; PG8_WAIT_L(0); PG8_MMA(1, 0, At, B0); PG8_BAR; PG8_SCHED;
            PG8_STAGE(PG8_SB(1, 1), b3 + hstep, voffB);
            PG8_WAIT_V(6); PG8_BAR; PG8_MMA(1, 1, At, B1); PG8_BAR;
            }
        }
        if constexpr (ALIGN_EPI) { if (wr == 0) PG8_BAR; }
        if constexpr (!Epi::AFTER_DRAIN) { if constexpr (DBG != 4) E(acc, cur, wr, wc, fr, fq); else { _Pragma("unroll") for (int a_ = 0; a_ < 2; ++a_) _Pragma("unroll") for (int b_ = 0; b_ < 2; ++b_) _Pragma("unroll") for (int m_ = 0; m_ < 4; ++m_) _Pragma("unroll") for (int n_ = 0; n_ < 2; ++n_) asm volatile("" :: "v"(acc[a_][b_][m_][n_])); } S.done(cur); }
        if (!has_next) break;
#pragma unroll
        for (int a = 0; a < 2; ++a)
#pragma unroll
            for (int b = 0; b < 2; ++b)
#pragma unroll
                for (int m = 0; m < 4; ++m)
#pragma unroll
                    for (int n = 0; n < 2; ++n) acc[a][b][m][n] = (f32x4){0.f, 0.f, 0.f, 0.f};
        cur = nxt; cA = nA; cB = nB; ++ui;
        if constexpr (ALIGN_EPI) { if (wr == 1) PG8_BAR; }
    }
    PG8_WAIT_V(0);
    if constexpr (!ALIGN_EPI) { if (wr == 0) PG8_BAR; }
    PG8_BAR;
    if constexpr (Epi::AFTER_DRAIN) { E.fused(acc, cur, wr, wc, fr, fq, lds, wid, lane); S.done(cur); }
#undef PG8_SA
#undef PG8_SB
#undef PG8_STAGE
#undef PG8_LDA
#undef PG8_LDB
#undef PG8_MMA
#undef PG8_WAIT_V
#undef PG8_WAIT_L
#undef PG8_BAR
#undef PG8_SCHED
}
}
#define XB_TMO      128
#define XB_XCNT(j)  (256  + 64 * (j))
#define XB_XSUB(j)  (1280 + 64 * (j))
#define XB_XGEN(j)  (2304 + 64 * (j))
#define XB_TOP      3328
#define XB_TOPGEN   3392
#define XCD_BAR_WORDS 3456
#define XB_SPIN_CAP (1u << 18)

__device__ __forceinline__ unsigned xb_ld(unsigned* p)              { return __hip_atomic_load(p, __ATOMIC_RELAXED, __HIP_MEMORY_SCOPE_AGENT); }
__device__ __forceinline__ unsigned xb_add(unsigned* p, unsigned v) { return __hip_atomic_fetch_add(p, v, __ATOMIC_RELAXED, __HIP_MEMORY_SCOPE_AGENT); }
__device__ __forceinline__ unsigned xb_xcc_id() { return (unsigned)__builtin_amdgcn_s_getreg((3 << 11) | 20) & 0xFu; }
#define XB_SPIN(cond, bar) do { unsigned _sp = 0; while (cond) { __builtin_amdgcn_s_sleep(1); \
    if ((++_sp & 255u) == 0u) { if (xb_ld(&(bar)[XB_TMO])) break; if (_sp > XB_SPIN_CAP) { atomicAdd(&(bar)[XB_TMO], 1u); break; } } } } while (0)

struct XcdBarrier {
    unsigned* bar; unsigned x;
    volatile LAS unsigned* st;
};

__device__ __forceinline__ XcdBarrier xcd_barrier_post(unsigned* bar, volatile LAS unsigned* st) {
    XcdBarrier b; b.bar = bar; b.x = xb_xcc_id(); b.st = st;
    if (threadIdx.x == 0) (void)xb_add(&bar[XB_XCNT(b.x)], 1u);
    return b;
}
__device__ __forceinline__ void xcd_barrier_complete(unsigned* bar, unsigned x, unsigned& nloc, unsigned& nx) {
    const unsigned G = gridDim.x * gridDim.y * gridDim.z;
    unsigned sum, cnt, mine, sp = 0u;
    for (;;) {
        sum = 0u; cnt = 0u; mine = 0u;
#pragma unroll
        for (unsigned j = 0; j < 16; ++j) { const unsigned c = xb_ld(&bar[XB_XCNT(j)]); sum += c; cnt += (c > 0u) ? 1u : 0u; mine = (j == x) ? c : mine; }
        if (sum == G) break;
        __builtin_amdgcn_s_sleep(1);
        if ((++sp & 255u) == 0u) { if (xb_ld(&bar[XB_TMO])) break; if (sp > XB_SPIN_CAP) { atomicAdd(&bar[XB_TMO], 1u); break; } }
    }
    nloc = mine > 0u ? mine : 1u; nx = cnt > 0u ? cnt : 1u;
}

__device__ __forceinline__ void xcd_barrier(const XcdBarrier& b) {
    asm volatile("s_waitcnt vmcnt(0)" ::: "memory");
    __syncthreads();
    if (threadIdx.x == 0) {
        unsigned* bar = b.bar;
        __builtin_amdgcn_s_waitcnt(0);
        unsigned nloc = b.st[0], nx = b.st[1];
        if (nloc == 0u) { xcd_barrier_complete(bar, b.x, nloc, nx); b.st[0] = nloc; b.st[1] = nx; }
        const unsigned old = xb_add(&bar[XB_XSUB(b.x)], 1u);
        const unsigned gen = old / nloc;
        if (old + 1u == (gen + 1u) * nloc) {
            __builtin_amdgcn_fence(__ATOMIC_RELEASE, "agent");
            asm volatile("s_waitcnt vmcnt(0)" ::: "memory");
            const unsigned og = xb_add(&bar[XB_TOP], 1u);
            const unsigned tg = og / nx;
            if (og + 1u == (tg + 1u) * nx) xb_add(&bar[XB_TOPGEN], 1u);
            else XB_SPIN(xb_ld(&bar[XB_TOPGEN]) == tg, bar);
            __builtin_amdgcn_fence(__ATOMIC_ACQUIRE, "agent");
            xb_add(&bar[XB_XGEN(b.x)], 1u);
            asm volatile("s_waitcnt vmcnt(0)" ::: "memory");
        } else {
            XB_SPIN(xb_ld(&bar[XB_XGEN(b.x)]) == gen, bar);
            __builtin_amdgcn_fence(__ATOMIC_ACQUIRE, "agent");
            asm volatile("s_waitcnt vmcnt(0)" ::: "memory");
        }
    }
    __syncthreads();
}


struct Frame {
    LAS unsigned char* lds;
    int tid, lane, wave, G, gw, ngw;
    const float *in_XP, *in_XS, *in_WIN, *in_WCONV, *in_BCONV, *in_WR, *in_BR, *in_WI, *in_BI, *in_LAM, *in_RPB, *in_WNO, *in_WLO, *in_WM, *in_BM, *in_WOUT, *in_GMPRE, *in_GMPOST, *in_GFPRE, *in_GFPOST, *in_WFG, *in_WFU, *in_WFD; float* out; unsigned char* ws;
};
enum { I_XP = 0, I_XS, I_WIN, I_WCONV, I_BCONV, I_WR, I_BR, I_WI, I_BI, I_LAM, I_RPB, I_WNO, I_WLO, I_WM, I_BM, I_WOUT, I_GMPRE, I_GMPOST, I_GFPRE, I_GFPOST, I_WFG, I_WFU, I_WFD };
__device__ __forceinline__ int opaque(int x) { asm volatile("" : "+v"(x)); return x; }
template <class T> __device__ __forceinline__ T* wsp(const Frame& F, size_t off) { return (T*)(F.ws + off); }
__device__ __forceinline__ const float* xrow(const Frame& F, int m) { return m < LP ? F.in_XP + (size_t)m * D : F.in_XS + (size_t)(m - LP) * D; }

__device__ __forceinline__ void tr_item(const float* src, int ldsrc, int k0, int n0, bf16_t* dst, int ldd, int drow0, LAS float* scr, int lane) {
#pragma unroll 8
    for (int i = 0; i < 32; ++i) { const int kk = 2 * i + (lane >> 5); scr[kk * 33 + (lane & 31)] = src[(size_t)(k0 + kk) * ldsrc + n0 + (lane & 31)]; }
    LDS_WAIT(); asm volatile("" ::: "memory");
    const int c = lane & 7;
#pragma unroll
    for (int j = 0; j < 4; ++j) { const int n = (lane >> 3) + 8 * j; const LAS float* s = scr + (8 * c) * 33 + n;
        u32x4 o; o.x = pk2(s[0 * 33], s[1 * 33]); o.y = pk2(s[2 * 33], s[3 * 33]); o.z = pk2(s[4 * 33], s[5 * 33]); o.w = pk2(s[6 * 33], s[7 * 33]);
        *(u32x4*)(dst + (size_t)(drow0 + n) * ldd + k0 + 8 * c) = o; }
    LDS_WAIT(); asm volatile("" ::: "memory");
}
__device__ __forceinline__ unsigned pk4_fp8(float a, float b, float c, float d) { int p = __builtin_amdgcn_cvt_pk_fp8_f32(a, b, 0, false); p = __builtin_amdgcn_cvt_pk_fp8_f32(c, d, p, true); return (unsigned)p; }
__device__ __forceinline__ void tr_item8(const float* src, int ldsrc, int k0, int n0, unsigned char* dst, int ldd, int drow0, LAS float* scr, int lane) {
#pragma unroll 8
    for (int i = 0; i < 32; ++i) { const int kk = 2 * i + (lane >> 5); scr[kk * 33 + (lane & 31)] = src[(size_t)(k0 + kk) * ldsrc + n0 + (lane & 31)]; }
    LDS_WAIT(); asm volatile("" ::: "memory");
    const int c = lane & 7;
#pragma unroll
    for (int j = 0; j < 4; ++j) { const int n = (lane >> 3) + 8 * j; const LAS float* s = scr + (8 * c) * 33 + n;
        u32x2 o; o.x = pk4_fp8(s[0 * 33] * 256.f, s[1 * 33] * 256.f, s[2 * 33] * 256.f, s[3 * 33] * 256.f); o.y = pk4_fp8(s[4 * 33] * 256.f, s[5 * 33] * 256.f, s[6 * 33] * 256.f, s[7 * 33] * 256.f);
        *(u32x2*)(dst + (size_t)(drow0 + n) * ldd + k0 + 8 * c) = o; }
    LDS_WAIT(); asm volatile("" ::: "memory");
}
__device__ __forceinline__ unsigned pk4_i8(float a, float b, float c, float d) { return ((unsigned)(int)a & 255u) | (((unsigned)(int)b & 255u) << 8) | (((unsigned)(int)c & 255u) << 16) | ((unsigned)(int)d << 24); }
__device__ __forceinline__ void tr_strip_i8(const float* src, int ldsrc, int K, int kb, int n0, signed char* dst, int drow0, float* cs, LAS float* scr, LAS float* red, int lane, int wave) {
    const __amdgpu_buffer_rsrc_t rs = __builtin_amdgcn_make_buffer_rsrc((void*)(src + n0 + (size_t)kb * ldsrc), (short)0, 0x7fffffff, 0x00020000);
    const int voff = ((lane & 31) + (lane >> 5) * ldsrc) * 4;
    unsigned hold[8][16];
    float mx = 0.f;
#pragma unroll
    for (int tr = 0; tr < 8; ++tr) {
        float t[32];
#pragma unroll
        for (int i = 0; i < 32; ++i) t[i] = __builtin_bit_cast(float, __builtin_amdgcn_raw_buffer_load_b32(rs, voff, (2 * (tr * 32 + i)) * ldsrc * 4, 0));
#pragma unroll
        for (int i = 0; i < 32; ++i) mx = fmaxf(mx, fabsf(t[i]));
#pragma unroll
        for (int i = 0; i < 16; ++i) { hold[tr][i] = pk2(t[2 * i], t[2 * i + 1]); asm volatile("" : "+v"(hold[tr][i])); }
        asm volatile("" ::: "memory");
    }
    mx = fmaxf(mx, __shfl_xor(mx, 32));
    if (lane < 32) red[wave * 32 + lane] = mx;
    LDS_WAIT(); __syncthreads();
    float amax = 1e-20f;
#pragma unroll
    for (int w_ = 0; w_ < NWAVES; ++w_) amax = fmaxf(amax, red[w_ * 32 + (lane & 31)]);
    const float inv = 127.0f / amax;
    if (wave == 0 && lane < 32) cs[drow0 + lane] = amax * (1.0f / 127.0f);
    const int c = lane & 7;
#pragma unroll
    for (int tr = 0; tr < 8; ++tr) {
        { LAS float* w = scr + (lane >> 5) * 33 + (lane & 31);
#pragma unroll
          for (int i = 0; i < 16; ++i) { unsigned h = hold[tr][i]; asm volatile("" : "+v"(h));
              w[(2 * i) * 66] = rintf(bflo(h) * inv); w[(2 * i + 1) * 66] = rintf(bfhi(h) * inv); } }
        LDS_WAIT(); asm volatile("" ::: "memory");
#pragma unroll
        for (int j = 0; j < 4; ++j) { const int n = (lane >> 3) + 8 * j; const LAS float* t = scr + (8 * c) * 33 + n;
            u32x2 o; o.x = pk4_i8(t[0 * 33], t[1 * 33], t[2 * 33], t[3 * 33]); o.y = pk4_i8(t[4 * 33], t[5 * 33], t[6 * 33], t[7 * 33]);
            *(u32x2*)(dst + (size_t)(drow0 + n) * K + kb + 64 * tr + 8 * c) = o; }
        LDS_WAIT(); asm volatile("" ::: "memory");
    }
    __syncthreads();
}
__device__ __forceinline__ void fwht32(float (&v)[32]) {
#pragma unroll
    for (int st = 1; st < 32; st <<= 1)
#pragma unroll
        for (int i = 0; i < 32; ++i) if (!(i & st)) { const float a = v[i], b = v[i + st]; v[i] = a + b; v[i + st] = a - b; }
#pragma unroll
    for (int i = 0; i < 32; ++i) v[i] *= 0.17677669529663687f;
}
__device__ __forceinline__ void had_tile_load(const float* src, int ldsrc, int k0, int n0, LAS float* scr, int lane, float (&v)[32]) {
    { const float* p = src + (size_t)(k0 + (lane >> 5)) * ldsrc + n0 + (lane & 31); const size_t step = (size_t)2 * ldsrc; LAS float* w = scr + (lane >> 5) * 33 + (lane & 31); float t[32];
#pragma unroll
      for (int i = 0; i < 32; ++i) { t[i] = *p; p += step; }
#pragma unroll
      for (int i = 0; i < 32; ++i) w[i * 66] = t[i]; }
    LDS_WAIT(); asm volatile("" ::: "memory");
    const LAS float* hv = scr + (32 * (lane >> 5)) * 33 + (lane & 31);
#pragma unroll
    for (int i = 0; i < 32; ++i) v[i] = hv[i * 33];
    fwht32(v);
}
__device__ __forceinline__ void had_tile_amax(const float* src, int ldsrc, int k0, int n0, unsigned* am, LAS float* scr, int lane) {
    float v[32]; had_tile_load(src, ldsrc, k0, n0, scr, lane, v);
    float mx = 0.f;
#pragma unroll
    for (int i = 0; i < 32; ++i) mx = fmaxf(mx, fabsf(v[i]));
    mx = fmaxf(mx, __shfl_xor(mx, 32));
    if (lane < 32) atomicMax(am + n0 + lane, __builtin_bit_cast(unsigned, mx));
    LDS_WAIT(); asm volatile("" ::: "memory");
}
__device__ __forceinline__ void had_tile_quant(const float* src, int ldsrc, int K, int k0, int n0, signed char* dst, const unsigned* am, float* cs, LAS float* scr, int lane) {
    const float amax = fmaxf(__builtin_bit_cast(float, am[n0 + (lane & 31)]), 1e-20f), inv = 127.0f / amax;
    if (k0 == 0 && lane < 32) cs[n0 + lane] = amax * (1.0f / 127.0f);
    float v[32]; had_tile_load(src, ldsrc, k0, n0, scr, lane, v);
    LAS float* hv = scr + (32 * (lane >> 5)) * 33 + (lane & 31);
#pragma unroll
    for (int i = 0; i < 32; ++i) hv[i * 33] = rintf(v[i] * inv);
    LDS_WAIT(); asm volatile("" ::: "memory");
    const int c = lane & 7;
#pragma unroll
    for (int j = 0; j < 4; ++j) { const int n = (lane >> 3) + 8 * j; const LAS float* t = scr + (8 * c) * 33 + n;
        u32x2 o; o.x = pk4_i8(t[0 * 33], t[1 * 33], t[2 * 33], t[3 * 33]); o.y = pk4_i8(t[4 * 33], t[5 * 33], t[6 * 33], t[7 * 33]);
        *(u32x2*)(dst + (size_t)(n0 + n) * K + k0 + 8 * c) = o; }
    LDS_WAIT(); asm volatile("" ::: "memory");
}
#define TR_JOB(SRC, LDSRC, KK, NN, DST, DROW_EXPR) { const int nblk = (NN) / 32, nit = ((KK) / 64) * nblk; \
    if (r < nit) { const int kb = r / nblk, nb = r % nblk, n0 = 32 * nb; tr_item((SRC), (LDSRC), 64 * kb, n0, (DST), (KK), (DROW_EXPR), scr, F.lane); continue; } r -= nit; }
#define TR_JOB8(SRC, LDSRC, KK, NN, DST, DROW_EXPR) { const int nblk = (NN) / 32, nit = ((KK) / 64) * nblk; \
    if (r < nit) { const int kb = r / nblk, nb = r % nblk, n0 = 32 * nb; tr_item8((SRC), (LDSRC), 64 * kb, n0, (DST), (KK), (DROW_EXPR), scr, F.lane); continue; } r -= nit; }

__device__ __forceinline__ void p0_prologue(Frame& F) {
    const int tid_ = opaque(F.tid);
    LAS float* scr = (LAS float*)(F.lds + F.wave * 8448);
    const float* w_in = F.in_WIN;
    bf16_t* WCAT = wsp<bf16_t>(F, WS_WCAT); signed char* W8 = wsp<signed char>(F, WS_W8); signed char* WV8 = wsp<signed char>(F, WS_WVT); signed char* WGU8 = wsp<signed char>(F, WS_WGU);
    float* CS = wsp<float>(F, WS_CS);
    constexpr int NSM = 64;
    constexpr int IT_SM = 2 * 4;
    constexpr int S_Q = NAW / 32, S_M = 2 * D / 32, S_F = DFF / 32;
    constexpr int NSTRIP = 3 * S_Q + S_M + 2 * S_F;
    constexpr int N_AMAX = (DFF / 64) * (D / 32);
    constexpr int N_BIG = 2 * (D / 64) * (NAW / 32) + 2 * (NAW / 64) * (D / 32) + (D / 64) * (D / 32) + N_AMAX;
    constexpr int NITEMS = N_BIG + NSM * IT_SM;
    LAS float* red = (LAS float*)(F.lds + 68608);
    for (int it = blockIdx.x; it < NSTRIP; it += F.G) {
        {
            int q = it; const float* src; int ld, n0, drow0; signed char* dst; float* cs;
            if (q < S_Q) { src = w_in; ld = INW; n0 = 32 * q; dst = W8; drow0 = n0; cs = CS + CS_QKM; }
            else if ((q -= S_Q) < S_Q) { src = w_in + NAW; ld = INW; n0 = 32 * q; dst = W8; drow0 = 2048 + n0; cs = CS + CS_QKM; }
            else if ((q -= S_Q) < S_M) { src = F.in_WM; ld = 2 * D; n0 = 32 * q; dst = W8; drow0 = 4096 + n0; cs = CS + CS_QKM; }
            else if ((q -= S_M) < S_Q) { src = w_in + 2 * NAW; ld = INW; n0 = 32 * q; dst = WV8; drow0 = n0; cs = CS + CS_V; }
            else if ((q -= S_Q) < S_F) { src = F.in_WFG; ld = DFF; n0 = 32 * q; dst = WGU8; drow0 = (n0 >> 7) * 256 + (n0 & 127); cs = CS + CS_GU; }
            else { q -= S_F; src = F.in_WFU; ld = DFF; n0 = 32 * q; dst = WGU8; drow0 = (n0 >> 7) * 256 + 128 + (n0 & 127); cs = CS + CS_GU; }
            tr_strip_i8(src, ld, D, F.wave * (D / NWAVES), n0, dst, drow0, cs, scr, red, F.lane, F.wave);
        }
    }
    for (int it = F.gw; it < NITEMS; it += F.ngw) {
        int r = it;
        TR_JOB(w_in + 3 * NAW, INW, D, NAW, WCAT, 0 + n0)
        TR_JOB(w_in + 4 * NAW, INW, D, NAW, WCAT, 2048 + n0)
        TR_JOB(F.in_WNO, D, NAW, D, wsp<bf16_t>(F, WS_WNO), n0)
        TR_JOB(F.in_WLO, D, LW, D, wsp<bf16_t>(F, WS_WLO), n0)
        TR_JOB(F.in_WOUT, D, D, D, wsp<bf16_t>(F, WS_WO), n0)
        if (r < N_AMAX) { had_tile_amax(F.in_WFD, D, 64 * (r / (D / 32)), 32 * (r % (D / 32)), (unsigned*)(F.ws + WS_AM), scr, F.lane); continue; } r -= N_AMAX;
        {
            const int mi = r / IT_SM, ri = r % IT_SM, d = mi >> 5, g = (mi >> 4) & 1, n = mi & 15, kb = ri >> 2, nb = ri & 3;
            const float* src = (g ? F.in_WI : F.in_WR) + (size_t)(d * NBLK + n) * BW * BW;
            tr_item(src, BW, 64 * kb, 32 * nb, wsp<bf16_t>(F, WS_WG) + (size_t)mi * BW * BW, BW, 32 * nb, scr, F.lane);
        }
    }
    LAS f32x4* gl = (LAS f32x4*)(F.lds + 69632);
    for (int i = tid_; i < D / 4; i += NTHR) gl[i] = ((const f32x4*)F.in_GMPRE)[i];
    __syncthreads();
    bf16_t* XN = wsp<bf16_t>(F, WS_XN); signed char* XN8 = wsp<signed char>(F, WS_XN8); float* RS1 = wsp<float>(F, WS_RS1);
    for (int m = F.gw; m < L; m += F.ngw) {
        asm volatile("" ::: "memory");
        const f32x4* xr = (const f32x4*)xrow(F, m) + F.lane;
        f32x4 v[16]; float s = 0.f;
#pragma unroll
        for (int j = 0; j < 16; ++j) { v[j] = xr[64 * j]; s += (v[j].x * v[j].x + v[j].y * v[j].y) + (v[j].z * v[j].z + v[j].w * v[j].w); }
        const float rstd = 1.0f / sqrtf(wave_sum(s) * (1.0f / D) + EPS);
        u32x2* o8 = (u32x2*)(XN + (size_t)m * D) + F.lane; unsigned* o4 = (unsigned*)(XN8 + (size_t)m * D) + F.lane;
        float mx = 0.f;
#pragma unroll
        for (int j = 0; j < 16; ++j) { v[j] = v[j] * rstd * gl[F.lane + 64 * j]; mx = fmaxf(fmaxf(mx, fmaxf(fabsf(v[j].x), fabsf(v[j].y))), fmaxf(fabsf(v[j].z), fabsf(v[j].w))); }
        const float amax = fmaxf(wave_max(mx), 1e-20f), inv = 127.0f / amax;
        if (F.lane == 0) RS1[m] = amax * (1.0f / 127.0f);
#pragma unroll
        for (int j = 0; j < 16; ++j) { const f32x4 y = v[j]; u32x2 o; o.x = pk2(y.x, y.y); o.y = pk2(y.z, y.w); o8[64 * j] = o;
            o4[64 * j] = pk4_i8(rintf(y.x * inv), rintf(y.y * inv), rintf(y.z * inv), rintf(y.w * inv)); }
    }
    __syncthreads();
}

#ifndef ATT_SYNC
#define ATT_SYNC 1
#endif
template <int ADBG = 0> __device__ __forceinline__ void attn_mfma(Frame& F) {
    const int tid_ = opaque(F.tid);
    bf16_t* Q = wsp<bf16_t>(F, WS_Q); const bf16_t* Kb = wsp<bf16_t>(F, WS_K); const bf16_t* VT = wsp<bf16_t>(F, WS_VT);
    LAS float* rp = (LAS float*)F.lds;
    for (int i = tid_; i < NH * 15 * 31; i += NTHR) rp[i] = F.in_RPB[i];
    __syncthreads();
    const int fr = F.lane & 15, fq = F.lane >> 4;
    const float scale = 0.08838834764831845f;
    for (int base = blockIdx.x * NWAVES; base < (L / GRIDW) * NH * 4; base += F.ngw) {
        const int item = base + F.wave;
        asm volatile("" ::: "memory");
        const int g = item & 3, h = (item >> 2) & 15, rg = item >> 6;
        const int s0 = rg < LP / GRIDW ? 0 : LP, rows = rg < LP / GRIDW ? LP / GRIDW : LS / GRIDW, r = rg < LP / GRIDW ? rg : rg - LP / GRIDW;
        int rs = r - 4; rs = rs < 0 ? 0 : (rs > rows - 8 ? rows - 8 : rs);
        const int w0 = g == 0 ? 0 : (g == 1 ? 8 : (g == 2 ? 24 : 32));
        const int c = 16 * g + fr;
        int cs = c - 8; cs = cs < 0 ? 0 : (cs > GRIDW - 16 ? GRIDW - 16 : cs);
        bf16_t* qrow = Q + (size_t)(s0 + r * GRIDW + c) * NAW + h * HD;
        bf16x8 qf[4];
#pragma unroll
        for (int s = 0; s < 4; ++s) qf[s] = *(const bf16x8*)(qrow + 8 * fq + 32 * s);
        f32x4 sacc[8][2];
        const int Rg = s0 / GRIDW + rs, p0 = w0 >> 3;
        const bf16_t* kbase = Kb + (size_t)(Rg * 16 + h) * 8192 + p0 * 128 + fr * 32 + fq * 8;
        bf16x8 kb[8][2][4];
#define ATT_LDK(kr) do { _Pragma("unroll") for (int T = 0; T < 2; ++T) _Pragma("unroll") for (int s = 0; s < 4; ++s) kb[kr][T][s] = (ADBG & 1) ? qf[s] : (ADBG & 4) ? *(const bf16x8*)(Kb + (size_t)(s0 + rs * GRIDW) * NAW + h * HD * GRIDW + ((kr) * 8 + T * 4 + s) * 512 + F.lane * 8) : *(const bf16x8*)(kbase + (size_t)(kr) * (16 * 8192) + (s * 2 + T) * 1024); } while (0)
        ATT_LDK(0); ATT_LDK(1);
#pragma unroll
        for (int kr = 0; kr < 8; ++kr) {
            if (ATT_SYNC && (kr & 1) == 0) __builtin_amdgcn_s_barrier();
            if (kr + 2 < 8) ATT_LDK(kr + 2);
            __builtin_amdgcn_sched_barrier(0);
#pragma unroll
            for (int T = 0; T < 2; ++T) { f32x4 a = (f32x4){0.f, 0.f, 0.f, 0.f};
#pragma unroll
                for (int s = 0; s < 4; ++s) a = __builtin_amdgcn_mfma_f32_16x16x32_bf16(kb[kr][T][s], qf[s], a, 0, 0, 0);
                sacc[kr][T] = a; }
            __builtin_amdgcn_sched_barrier(0);
        }
#undef ATT_LDK
        bf16x8 vb[8][8];
        const bf16_t* vbase = VT + (size_t)(Rg * 16 + h) * 8192 + p0 * 128 + fq * 128 + fr * 8;
#define ATT_LDV(kr) do { _Pragma("unroll") for (int dt = 0; dt < 8; ++dt) vb[kr][dt] = (ADBG & 2) ? qf[dt & 3] : (ADBG & 4) ? *(const bf16x8*)(VT + (size_t)(h * HD) * L + s0 + rs * GRIDW + ((kr) * 8 + dt) * 512 + F.lane * 8) : *(const bf16x8*)(vbase + (size_t)(kr) * (16 * 8192) + dt * 1024); } while (0)
        ATT_LDV(0); ATT_LDV(1);
        __builtin_amdgcn_sched_barrier(0);
        const int elo = cs - w0 - 8 * fq, dc0 = w0 + 8 * fq - c + 15;
        const LAS float* rph = rp + h * 465 + (rs - r + 7) * 31;
        float mx = -3.0e38f;
#pragma unroll
        for (int e = 0; e < 8; ++e) { const bool valid = (e >= elo) && (e < elo + 16); const int bi = valid ? dc0 + e : 0;
#pragma unroll
            for (int kr = 0; kr < 8; ++kr) { const float sv = valid ? sacc[kr][e >> 2][e & 3] * scale + rph[kr * 31 + bi] : -3.0e38f; sacc[kr][e >> 2][e & 3] = sv; mx = fmaxf(mx, sv); } }
        mx = fmaxf(mx, __shfl_xor(mx, 16)); mx = fmaxf(mx, __shfl_xor(mx, 32));
        float lsum = 0.f; bf16x8 pf[8];
#pragma unroll
        for (int kr = 0; kr < 8; ++kr) { float p[8];
#pragma unroll
            for (int e = 0; e < 8; ++e) { p[e] = __expf(sacc[kr][e >> 2][e & 3] - mx); lsum += p[e]; }
            u32x4 w; w.x = pk2(p[0], p[1]); w.y = pk2(p[2], p[3]); w.z = pk2(p[4], p[5]); w.w = pk2(p[6], p[7]);
            pf[kr] = __builtin_bit_cast(bf16x8, w); }
        lsum += __shfl_xor(lsum, 16); lsum += __shfl_xor(lsum, 32);
        f32x4 oacc[8];
#pragma unroll
        for (int dt = 0; dt < 8; ++dt) oacc[dt] = (f32x4){0.f, 0.f, 0.f, 0.f};
#pragma unroll
        for (int kr = 0; kr < 8; ++kr) {
            if (ATT_SYNC && (kr & 1) == 0) __builtin_amdgcn_s_barrier();
            if (kr + 2 < 8) ATT_LDV(kr + 2);
            __builtin_amdgcn_sched_barrier(0);
#pragma unroll
            for (int dt = 0; dt < 8; ++dt) oacc[dt] = __builtin_amdgcn_mfma_f32_16x16x32_bf16(vb[kr][dt], pf[kr], oacc[dt], 0, 0, 0);
            __builtin_amdgcn_sched_barrier(0);
        }
#undef ATT_LDV
        const float inv = 1.0f / lsum;
#ifdef ATTN_OUT_OFF
        bf16_t* orow = wsp<bf16_t>(F, (size_t)ATTN_OUT_OFF * MiB) + (size_t)(s0 + r * GRIDW + c) * NAW + h * HD;
#else
        bf16_t* orow = qrow;
#endif
#pragma unroll
        for (int u = 0; u < 4; ++u) *(u32x4*)(orow + 32 * u + 8 * fq) = pg8::pack8(oacc[2 * u] * inv, oacc[2 * u + 1] * inv);
    }
    __syncthreads();
}

__device__ __forceinline__ void attn_mfma_lds(Frame& F) {
    const int tid_ = opaque(F.tid);
    bf16_t* Q = wsp<bf16_t>(F, WS_Q); const bf16_t* Kb = wsp<bf16_t>(F, WS_K); const bf16_t* VT = wsp<bf16_t>(F, WS_VT);
    LAS float* rp = (LAS float*)F.lds;
    LAS unsigned char* ring = F.lds + 30720;
    for (int i = tid_; i < NH * 15 * 31; i += NTHR) rp[i] = F.in_RPB[i];
    __syncthreads();
    const int lane = tid_ & 63, fr = lane & 15, fq = lane >> 4, w = F.wave, hl = w >> 2, g = w & 3;
    const float scale = 0.08838834764831845f;
    constexpr int NIT = (L / GRIDW) * NH * 4;
    const int w0 = g == 0 ? 0 : (g == 1 ? 8 : (g == 2 ? 24 : 32)), p0 = w0 >> 3;
    const int c = 16 * g + fr;
    int cs = c - 8; cs = cs < 0 ? 0 : (cs > GRIDW - 16 ? GRIDW - 16 : cs);
#define ATL_SRC(b, st) ([&]() -> const bf16_t* { const int rg_ = (b) >> 6, hb_ = ((b) >> 2) & 15; const int rows_ = rg_ < LP / GRIDW ? LP / GRIDW : LS / GRIDW, r_ = rg_ < LP / GRIDW ? rg_ : rg_ - LP / GRIDW; \
        int rs_ = r_ - 4; rs_ = rs_ < 0 ? 0 : (rs_ > rows_ - 8 ? rows_ - 8 : rs_); const int Rg_ = (rg_ < LP / GRIDW ? 0 : LP / GRIDW) + rs_; \
        return ((st) < 8 ? Kb : VT) + (size_t)((Rg_ + ((st) & 7)) * 16 + hb_) * 8192; }())
#define ATL_ISSUE(src, slot) do { const bf16_t* s_ = (src) + tid_ * 8; LAS unsigned char* d_ = ring + (slot) * 32768 + w * 1024; _Pragma("unroll") for (int k_ = 0; k_ < 4; ++k_) \
        __builtin_amdgcn_global_load_lds((const unsigned*)(s_ + k_ * 4096), (LAS unsigned*)(d_ + k_ * 8192), 16, 0, 0); } while (0)
    int base = blockIdx.x * NWAVES;
    if (base < NIT) { ATL_ISSUE(ATL_SRC(base, 0), 0); ATL_ISSUE(ATL_SRC(base, 1), 1); }
    int b0 = 0;
    for (; base < NIT; base += F.ngw) {
        asm volatile("" ::: "memory");
        const int h = ((base >> 2) & 15) + hl, rg = base >> 6;
        const int s0 = rg < LP / GRIDW ? 0 : LP, rows = rg < LP / GRIDW ? LP / GRIDW : LS / GRIDW, r = rg < LP / GRIDW ? rg : rg - LP / GRIDW;
        int rs = r - 4; rs = rs < 0 ? 0 : (rs > rows - 8 ? rows - 8 : rs);
        const int nbase = base + F.ngw < NIT ? base + F.ngw : base;
        bf16_t* qrow = Q + (size_t)(s0 + r * GRIDW + c) * NAW + h * HD;
        bf16x8 qf[4];
#pragma unroll
        for (int s = 0; s < 4; ++s) qf[s] = *(const bf16x8*)(qrow + 8 * fq + 32 * s);
        f32x4 sacc[8][2]; f32x4 oacc[8]; bf16x8 pf[8]; float lsum = 0.f;
#pragma unroll
        for (int dt = 0; dt < 8; ++dt) oacc[dt] = (f32x4){0.f, 0.f, 0.f, 0.f};
        const int koff = hl * 16384 + (p0 * 128 + fr * 32 + fq * 8) * 2, voff = hl * 16384 + (p0 * 128 + fq * 128 + fr * 8) * 2;
#pragma unroll
        for (int st = 0; st < 16; ++st) {
            asm volatile("s_waitcnt vmcnt(4)" ::: "memory"); asm volatile("s_waitcnt lgkmcnt(0)" ::: "memory"); __builtin_amdgcn_s_barrier(); asm volatile("" ::: "memory");
            { const int slot2 = (b0 + st + 2) % 3; if (st + 2 < 16) ATL_ISSUE(ATL_SRC(base, st + 2), slot2); else ATL_ISSUE(ATL_SRC(nbase, st + 2 - 16), slot2); }
            const LAS unsigned char* buf = ring + ((b0 + st) % 3) * 32768;
            if (st < 8) {
#pragma unroll
                for (int T = 0; T < 2; ++T) { f32x4 a = (f32x4){0.f, 0.f, 0.f, 0.f};
#pragma unroll
                    for (int s2 = 0; s2 < 4; ++s2) a = __builtin_amdgcn_mfma_f32_16x16x32_bf16(*(const LAS bf16x8*)(buf + koff + (s2 * 2 + T) * 2048), qf[s2], a, 0, 0, 0);
                    sacc[st][T] = a; }
            } else {
                if (st == 8) {
                    const int elo = cs - w0 - 8 * fq, dc0 = w0 + 8 * fq - c + 15;
                    const LAS float* rph = rp + h * 465 + (rs - r + 7) * 31;
                    float mx = -3.0e38f;
#pragma unroll
                    for (int e = 0; e < 8; ++e) { const bool valid = (e >= elo) && (e < elo + 16); const int bi = valid ? dc0 + e : 0;
#pragma unroll
                        for (int kr = 0; kr < 8; ++kr) { const float sv = valid ? sacc[kr][e >> 2][e & 3] * scale + rph[kr * 31 + bi] : -3.0e38f; sacc[kr][e >> 2][e & 3] = sv; mx = fmaxf(mx, sv); } }
                    mx = fmaxf(mx, __shfl_xor(mx, 16)); mx = fmaxf(mx, __shfl_xor(mx, 32));
#pragma unroll
                    for (int kr = 0; kr < 8; ++kr) { float p[8];
#pragma unroll
                        for (int e = 0; e < 8; ++e) { p[e] = __expf(sacc[kr][e >> 2][e & 3] - mx); lsum += p[e]; }
                        u32x4 wv; wv.x = pk2(p[0], p[1]); wv.y = pk2(p[2], p[3]); wv.z = pk2(p[4], p[5]); wv.w = pk2(p[6], p[7]);
                        pf[kr] = __builtin_bit_cast(bf16x8, wv); }
                    lsum += __shfl_xor(lsum, 16); lsum += __shfl_xor(lsum, 32);
                }
#pragma unroll
                for (int dt = 0; dt < 8; ++dt) oacc[dt] = __builtin_amdgcn_mfma_f32_16x16x32_bf16(*(const LAS bf16x8*)(buf + voff + dt * 2048), pf[st - 8], oacc[dt], 0, 0, 0);
            }
        }
        b0 = (b0 + 16) % 3;
        const float inv = 1.0f / lsum;
#pragma unroll
        for (int u = 0; u < 4; ++u) *(u32x4*)(qrow + 32 * u + 8 * fq) = pg8::pack8(oacc[2 * u] * inv, oacc[2 * u + 1] * inv);
    }
#undef ATL_SRC
#undef ATL_ISSUE
    asm volatile("s_waitcnt vmcnt(0)" ::: "memory");
    __syncthreads();
}

__device__ __forceinline__ void conv_phase(Frame& F) {
    const int tid_ = opaque(F.tid);
    const bf16_t* XR = wsp<bf16_t>(F, WS_XR); bf16_t* XC = wsp<bf16_t>(F, WS_XC);
    const float* wc = F.in_WCONV; const float* bc = F.in_BCONV;
    const int nth = F.G * NTHR;
    for (int it = blockIdx.x * NTHR + tid_; it < L * (LW / 8); it += nth) {
        const int t = it / (LW / 8), c0 = (it % (LW / 8)) * 8;
        const int s0 = t < LP ? 0 : LP, len = t < LP ? LP : LS, tl = t - s0;
        float acc[8];
#pragma unroll
        for (int e = 0; e < 8; ++e) acc[e] = bc[c0 + e];
#pragma unroll
        for (int j = 0; j < 4; ++j) { const int tt = tl + j - 2; if (tt < 0 || tt >= len) continue;
            f32x4 x0, x1; pg8::unpack8(*(const u32x4*)(XR + (size_t)(s0 + tt) * LW + c0), x0, x1);
            const f32x4 w0 = *(const f32x4*)(wc + j * LW + c0), w1 = *(const f32x4*)(wc + j * LW + c0 + 4);
#pragma unroll
            for (int e = 0; e < 4; ++e) { acc[e] += w0[e] * x0[e]; acc[4 + e] += w1[e] * x1[e]; } }
        *(u32x4*)(XC + (size_t)t * LW + c0) = pg8::pack8((f32x4){acc[0], acc[1], acc[2], acc[3]}, (f32x4){acc[4], acc[5], acc[6], acc[7]});
    }
}

struct LruW { bf16x8 w[2][4]; float br, bi, cl; };
template <int DIR> __device__ __forceinline__ void lru_load_w(const Frame& F, LruW& W, int n, int w, int fr, int fq) {
    const bf16_t* wg = wsp<bf16_t>(F, WS_WG);
#pragma unroll
    for (int g = 0; g < 2; ++g)
#pragma unroll
        for (int s = 0; s < 4; ++s) W.w[g][s] = *(const bf16x8*)(wg + ((size_t)((DIR * 2 + g) * NBLK + n) * BW + 16 * w + fr) * BW + 32 * fq + 8 * s);
    const int ch = n * BW + 16 * w + fr;
    W.br = -1.44269504f * F.in_BR[DIR * LW + ch]; W.bi = -1.44269504f * F.in_BI[DIR * LW + ch];
    const float lam = F.in_LAM[DIR * LW + ch];
    W.cl = -8.0f * 1.44269504f * ((lam > 15.f) ? __expf(-lam) : log1pf(__expf(-lam)));
}
template <int LDBG = 0> __device__ __forceinline__ void lru_gate(float pr, float pi, float xc, const LruW& W, bool first, float& a, float& u) {
    if constexpr (LDBG == 1) { a = pr + W.br; u = pi * xc + W.bi; return; }
    const float r = __builtin_amdgcn_rcpf(1.0f + __builtin_amdgcn_exp2f(__builtin_fmaf(pr, -1.44269504f, W.br))), d = 1.0f + __builtin_amdgcn_exp2f(__builtin_fmaf(pi, -1.44269504f, W.bi));
    a = __builtin_amdgcn_exp2f(W.cl * r);
    const float y = first ? 1.0f : fmaxf(__builtin_fmaf(-a, a, 1.0f), 1e-30f);
    u = xc * y * __builtin_amdgcn_rsqf(y * d * d);
}
struct LruX { bf16x8 x[4][4]; };
__device__ __forceinline__ void lru_load_x(LruX& X, const bf16_t* XC, int tb, int n, int fr, int fq) {
#pragma unroll
    for (int tau = 0; tau < 4; ++tau) { const bf16_t* xp = XC + ((size_t)((((tb >> 6) * NBLK + n) * 4 + tau) * 4) * 64 + fr * 4 + fq) * 8;
#pragma unroll
        for (int s = 0; s < 4; ++s) X.x[tau][s] = *(const bf16x8*)(xp + s * 512); }
}
__device__ __forceinline__ void lru_tile(const LruX& X, int tau, bool hiw, const LruW& W, const bf16x8 idf0, const bf16x8 idf1, f32x4& pr, f32x4& pi, f32x4& xct) {
    pr = (f32x4){0.f, 0.f, 0.f, 0.f}; pi = pr;
#pragma unroll
    for (int s = 0; s < 4; ++s) { pr = __builtin_amdgcn_mfma_f32_16x16x32_bf16(X.x[tau][s], W.w[0][s], pr, 0, 0, 0); pi = __builtin_amdgcn_mfma_f32_16x16x32_bf16(X.x[tau][s], W.w[1][s], pi, 0, 0, 0); }
    const bf16x8 x0 = hiw ? X.x[tau][2] : X.x[tau][0], x1 = hiw ? X.x[tau][3] : X.x[tau][1];
    xct = __builtin_amdgcn_mfma_f32_16x16x32_bf16(x0, idf0, (f32x4){0.f, 0.f, 0.f, 0.f}, 0, 0, 0);
    xct = __builtin_amdgcn_mfma_f32_16x16x32_bf16(x1, idf1, xct, 0, 0, 0);
}
__device__ __forceinline__ void lru_tile_lds(const LAS unsigned char* tile, const LAS unsigned char* xcl, int gl, int tau, const LruW& W, int fr, int fq, f32x4& pr, f32x4& pi, f32x4& xct) {
    bf16x8 x[4];
#pragma unroll
    for (int s = 0; s < 4; ++s) x[s] = *(const LAS bf16x8*)(tile + ((((gl * 4 + tau) * 4 + s) * 16 + fr) * 4 + fq) * 16);
    pr = (f32x4){0.f, 0.f, 0.f, 0.f}; pi = pr;
#pragma unroll
    for (int s = 0; s < 4; ++s) { pr = __builtin_amdgcn_mfma_f32_16x16x32_bf16(x[s], W.w[0][s], pr, 0, 0, 0); pi = __builtin_amdgcn_mfma_f32_16x16x32_bf16(x[s], W.w[1][s], pi, 0, 0, 0); }
#pragma unroll
    for (int j = 0; j < 4; ++j) xct[j] = bf1(*(const LAS bf16_t*)(xcl + (gl * 4 + tau) * 4096 + j * 64));
}
__device__ __forceinline__ void lru_idfrags(int w, int fr, int fq, bf16x8& idf0, bf16x8& idf1) {
#pragma unroll
    for (int e = 0; e < 8; ++e) { const bool on = (fq == (w >> 1)) && ((fr & 7) == e); idf0[e] = (on && fr < 8) ? (short)0x3F80 : (short)0; idf1[e] = (on && fr >= 8) ? (short)0x3F80 : (short)0; }
}
constexpr int LRU_CH = 256, LRU_NCH = L / LRU_CH, LRU_NCH_P = LP / LRU_CH;
__device__ __forceinline__ void conv_unit(Frame& F, int cg, int n) {
    const int tid_ = opaque(F.tid);
    const bf16_t* XR = wsp<bf16_t>(F, WS_XR); bf16_t* XC = wsp<bf16_t>(F, WS_XC);
    const float* wc = F.in_WCONV; const float* bc = F.in_BCONV;
    const int c0 = n * BW + (tid_ & 15) * 8;
    const int s0 = cg < LRU_NCH_P ? 0 : LP, len = cg < LRU_NCH_P ? LP : LS;
    f32x4 w[4][2]; f32x4 b0 = *(const f32x4*)(bc + c0), b1 = *(const f32x4*)(bc + c0 + 4);
#pragma unroll
    for (int j = 0; j < 4; ++j) { w[j][0] = *(const f32x4*)(wc + j * LW + c0); w[j][1] = *(const f32x4*)(wc + j * LW + c0 + 4); }
#pragma unroll
    for (int i = 0; i < 8; ++i) {
        const int t = cg * LRU_CH + (tid_ >> 4) + 32 * i, tl = t - s0;
        f32x4 a0 = b0, a1 = b1;
#pragma unroll
        for (int j = 0; j < 4; ++j) { const int tt = tl + j - 2; if (tt < 0 || tt >= len) continue;
            f32x4 x0, x1; pg8::unpack8(*(const u32x4*)(XR + (size_t)(s0 + tt) * LW + c0), x0, x1); a0 += w[j][0] * x0; a1 += w[j][1] * x1; }
        const int tg = t & 63, cq = tid_ & 15;
        *(u32x4*)(XC + ((size_t)(((((t >> 6) * NBLK + n) * 4 + ((tg >> 2) & 3)) * 4 + (cq & 3)) * 16 + 4 * (tg >> 4) + (tg & 3)) * 4 + (cq >> 2)) * 8) = pg8::pack8(a0, a1);
    }
}
__device__ __forceinline__ void conv_req(const Frame& F, int cg, int n, int tid_, u32x4 (&R)[11]) {
    const bf16_t* XR = wsp<bf16_t>(F, WS_XR);
    const int s0 = cg < LRU_NCH_P ? 0 : LP, len = cg < LRU_NCH_P ? LP : LS;
    const int t0 = cg * LRU_CH + 8 * (tid_ >> 4) - 2, c0 = n * BW + (tid_ & 15) * 8;
#pragma unroll
    for (int k = 0; k < 11; ++k) { const int tl = t0 + k - s0; R[k] = (u32x4){0u, 0u, 0u, 0u}; if (tl >= 0 && tl < len) R[k] = *(const u32x4*)(XR + (size_t)(t0 + k) * LW + c0); }
}
__device__ __forceinline__ void conv_fin(const Frame& F, int cg, int n, int tid_, const u32x4 (&R)[11], LAS unsigned char* tile, const LAS float* cw) {
    bf16_t* XC = wsp<bf16_t>(F, WS_XC);
    const int g = tid_ >> 4, cq = tid_ & 15;
    f32x4 w[4][2];
#pragma unroll
    for (int j = 0; j < 4; ++j) { w[j][0] = *(const LAS f32x4*)(cw + j * BW + cq * 8); w[j][1] = *(const LAS f32x4*)(cw + j * BW + cq * 8 + 4); }
    const f32x4 b0 = *(const LAS f32x4*)(cw + 4 * BW + cq * 8), b1 = *(const LAS f32x4*)(cw + 4 * BW + cq * 8 + 4);
#pragma unroll
    for (int i = 0; i < 8; ++i) {
        f32x4 a0 = b0, a1 = b1;
#pragma unroll
        for (int j = 0; j < 4; ++j) { f32x4 x0, x1; pg8::unpack8(R[i + j], x0, x1); a0 += w[j][0] * x0; a1 += w[j][1] * x1; }
        const int t = cg * LRU_CH + 8 * g + i, tg = t & 63;
        const int fo = ((((((tg >> 2) & 3) * 4 + (cq & 3)) * 16 + 4 * (tg >> 4) + (tg & 3)) * 4 + (cq >> 2)) * 8);
        const u32x4 o = pg8::pack8(a0, a1);
        *(u32x4*)(XC + (size_t)((t >> 6) * NBLK + n) * 8192 + fo) = o;
        *(LAS u32x4*)(tile + ((t >> 6) & 3) * 16384 + fo * 2) = o;
    }
}
__device__ __forceinline__ void lru_load_x_lds(LruX& X, const LAS unsigned char* tile, int gl, int fr, int fq) {
#pragma unroll
    for (int tau = 0; tau < 4; ++tau)
#pragma unroll
        for (int s = 0; s < 4; ++s) X.x[tau][s] = *(const LAS bf16x8*)(tile + ((((gl * 4 + tau) * 4 + s) * 16 + fr) * 4 + fq) * 16);
}
__device__ __forceinline__ void lru_pass_a(Frame& F) {
    const int tid_ = opaque(F.tid);
    const int fr = F.lane & 15, fq = F.lane >> 4, w = F.wave;
    f32x2* SUMM = wsp<f32x2>(F, WS_SUM);
    LAS unsigned char* tile = F.lds; LAS float* cw = (LAS float*)(F.lds + 65536);
    bf16x8 idf0, idf1; lru_idfrags(w, fr, fq, idf0, idf1);
    int u = blockIdx.x, ncur = -1;
    u32x4 R[11];
    if (u < LRU_NCH * NBLK) conv_req(F, u >> 4, u & 15, tid_, R);
    LruW Wf, Wb;
    for (; u < LRU_NCH * NBLK; u += F.G) {
        const int cg = u >> 4, n = u & 15;
        if (n != ncur) {
            ncur = n; lru_load_w<0>(F, Wf, n, w, fr, fq); lru_load_w<1>(F, Wb, n, w, fr, fq);
            for (int i = tid_; i < 5 * BW; i += NTHR) cw[i] = i < 4 * BW ? F.in_WCONV[(i >> 7) * LW + n * BW + (i & 127)] : F.in_BCONV[n * BW + (i & 127)];
            LDS_WAIT(); __builtin_amdgcn_s_barrier();
        }
        asm volatile("" ::: "memory");
        conv_fin(F, cg, n, tid_, R, tile, cw);
        { const int un = u + F.G; if (un < LRU_NCH * NBLK) conv_req(F, un >> 4, un & 15, tid_, R); }
        LDS_WAIT(); __builtin_amdgcn_s_barrier();
        const bool c_first = (cg == 0 || cg == LRU_NCH_P), c_last = (cg == LRU_NCH_P - 1 || cg == LRU_NCH - 1);
        float Af = 1.f, Hf = 0.f, Ab = 1.f, Hb = 0.f;
        for (int gi = 0; gi < 4; ++gi) {
            float pf = 1.f, hf = 0.f, pb = 1.f, hb = 0.f;
#pragma unroll 2
            for (int tau = 0; tau < 4; ++tau) {
                bf16x8 x[4];
#pragma unroll
                for (int s_ = 0; s_ < 4; ++s_) x[s_] = *(const LAS bf16x8*)(tile + ((((gi * 4 + tau) * 4 + s_) * 16 + fr) * 4 + fq) * 16);
                f32x4 prf = (f32x4){0.f, 0.f, 0.f, 0.f}, pif = prf, prb = prf, pib = prf, xct;
#pragma unroll
                for (int s_ = 0; s_ < 4; ++s_) { prf = __builtin_amdgcn_mfma_f32_16x16x32_bf16(x[s_], Wf.w[0][s_], prf, 0, 0, 0); pif = __builtin_amdgcn_mfma_f32_16x16x32_bf16(x[s_], Wf.w[1][s_], pif, 0, 0, 0);
                    prb = __builtin_amdgcn_mfma_f32_16x16x32_bf16(x[s_], Wb.w[0][s_], prb, 0, 0, 0); pib = __builtin_amdgcn_mfma_f32_16x16x32_bf16(x[s_], Wb.w[1][s_], pib, 0, 0, 0); }
                xct = __builtin_amdgcn_mfma_f32_16x16x32_bf16((w & 1) ? x[2] : x[0], idf0, (f32x4){0.f, 0.f, 0.f, 0.f}, 0, 0, 0);
                xct = __builtin_amdgcn_mfma_f32_16x16x32_bf16((w & 1) ? x[3] : x[1], idf1, xct, 0, 0, 0);
#pragma unroll
                for (int j = 0; j < 4; ++j) {
                    float a, uu;
                    lru_gate(prf[j], pif[j], xct[j], Wf, c_first && gi == 0 && fq == 0 && tau == 0 && j == 0, a, uu); hf = a * hf + uu; pf *= a;
                    lru_gate(prb[j], pib[j], xct[j], Wb, c_last && gi == 3 && fq == 3 && tau == 3 && j == 3, a, uu); hb += pb * uu; pb *= a;
                }
            }
            float gPf = 1.f, gHf = 0.f, gPb = 1.f, gHb = 0.f;
#pragma unroll
            for (int qq = 0; qq < 4; ++qq) { const int src = fr + 16 * qq;
                float P = __shfl(pf, src), H = __shfl(hf, src); gHf = P * gHf + H; gPf *= P;
                P = __shfl(pb, src); H = __shfl(hb, src); gHb += gPb * H; gPb *= P; }
            Hf = gPf * Hf + gHf; Af *= gPf; Hb += Ab * gHb; Ab *= gPb;
        }
        if (fq == 0) { const int ch = n * BW + 16 * w + fr; SUMM[(size_t)(cg * 2 + 0) * LW + ch] = (f32x2){Af, Hf}; SUMM[(size_t)(cg * 2 + 1) * LW + ch] = (f32x2){Ab, Hb}; }
        LDS_WAIT(); __builtin_amdgcn_s_barrier();
    }
    VM_WAIT();
}
__device__ __forceinline__ void lru_pass_b(Frame& F) {
    const int tid_ = opaque(F.tid);
    const int gt = blockIdx.x * NTHR + tid_; if (gt >= 4 * LW) return;
    const int ch = gt % LW, d = (gt / LW) & 1, seq = gt / (2 * LW), c0 = seq ? LRU_NCH_P : 0, nc = seq ? LRU_NCH - LRU_NCH_P : LRU_NCH_P;
    const f32x2* SUMM = wsp<f32x2>(F, WS_SUM); float* CIN = wsp<float>(F, WS_SUM + 4 * MiB);
    float s = 0.f;
    for (int i0 = 0; i0 < nc; i0 += 32) {
        f32x2 ah[32];
#pragma unroll
        for (int e = 0; e < 32; ++e) { const int cg = d ? c0 + nc - 1 - (i0 + e) : c0 + i0 + e; ah[e] = SUMM[(size_t)(cg * 2 + d) * LW + ch]; }
#pragma unroll
        for (int e = 0; e < 32; ++e) { const int cg = d ? c0 + nc - 1 - (i0 + e) : c0 + i0 + e; CIN[(size_t)(cg * 2 + d) * LW + ch] = s; s = ah[e].x * s + ah[e].y; }
    }
}
template <int LDBG = 0> __device__ __forceinline__ void lru_pass_c(Frame& F) {
    const int tid_ = opaque(F.tid);
    const int fr = F.lane & 15, fq = F.lane >> 4, w = F.wave;
    const bf16_t* XC = wsp<bf16_t>(F, WS_XC); const float* CIN = wsp<float>(F, WS_SUM + 4 * MiB);
    const bf16_t* GR = wsp<bf16_t>(F, WS_GR); bf16_t* LRU = wsp<bf16_t>(F, WS_XR);
    LAS unsigned char* tile = F.lds;
    LAS unsigned char* hfl = F.lds + 65536 + w * 8192 + F.lane * 32;
    asm volatile("" : "+v"(hfl));
    const LAS unsigned char* xcl = tile + ((((2 * (w & 1) + (fr >> 3)) * 16 + 4 * fq) * 4 + (w >> 1)) * 16 + (fr & 7) * 2);
    asm volatile("" : "+v"(xcl));
    LruW Wf, Wb; int ncur = -1;
    for (int u = blockIdx.x; u < LRU_NCH * NBLK; u += F.G) {
        const int cg = u >> 4, n = u & 15, ch = n * BW + 16 * w + fr;
        const bool c_first = (cg == 0 || cg == LRU_NCH_P), c_last = (cg == LRU_NCH_P - 1 || cg == LRU_NCH - 1);
        { const bf16_t* gsrc = XC + (size_t)(cg * 4 * NBLK + n) * 8192 + tid_ * 8; LAS unsigned char* ldst = tile + w * 1024;
#pragma unroll 1
          for (int k = 0; k < 8; ++k) { __builtin_amdgcn_global_load_lds((const unsigned*)gsrc, (LAS unsigned*)ldst, 16, 0, 0); gsrc += (k & 1) ? (size_t)NBLK * 8192 - 4096 : 4096; ldst += 8192; } }
        asm volatile("" ::: "memory");
        if (n != ncur) { ncur = n; lru_load_w<0>(F, Wf, n, w, fr, fq); lru_load_w<1>(F, Wb, n, w, fr, fq); }
        const float cin_f = CIN[(size_t)(cg * 2 + 0) * LW + ch], cin_b = CIN[(size_t)(cg * 2 + 1) * LW + ch];
        const bf16_t* grp = GR + (size_t)(cg * LRU_CH + 16 * fq) * LW + ch; bf16_t* outp = LRU + (size_t)(cg * LRU_CH + 16 * fq) * LW + ch;
        bf16_t grn[16];
#pragma unroll
        for (int t = 0; t < 16; ++t) grn[t] = grp[(size_t)(3 * 64 + t) * LW];
        asm volatile("s_waitcnt vmcnt(16)" ::: "memory"); __builtin_amdgcn_s_barrier();
        {
            const LruW& W = Wf;
            float s = cin_f;
            for (int gi = 0; gi < 4; ++gi) {
                float a[16], uu[16];
#pragma unroll
                for (int tau = 0; tau < 4; ++tau) { f32x4 pr, pi, xct; lru_tile_lds(tile, xcl, gi, tau, W, fr, fq, pr, pi, xct);
#pragma unroll
                    for (int j = 0; j < 4; ++j) lru_gate<LDBG>(pr[j], pi[j], xct[j], W, c_first && gi == 0 && fq == 0 && tau == 0 && j == 0, a[4 * tau + j], uu[4 * tau + j]); }
                float p = 1.f, h = 0.f;
#pragma unroll
                for (int t = 0; t < 16; ++t) { h = a[t] * h + uu[t]; p *= a[t]; }
                float hin = s, sg = s;
#pragma unroll
                for (int qq = 0; qq < 4; ++qq) { const float P = __shfl(p, fr + 16 * qq), H = __shfl(h, fr + 16 * qq); sg = P * sg + H; if (qq < fq) hin = P * hin + H; }
                s = sg;
                float hh = hin;
#pragma unroll
                for (int t = 0; t < 16; ++t) { hh = a[t] * hh + uu[t]; a[t] = hh; }
                *(LAS u32x4*)(hfl + gi * 2048) = (u32x4){pk2(a[0], a[1]), pk2(a[2], a[3]), pk2(a[4], a[5]), pk2(a[6], a[7])};
                *(LAS u32x4*)(hfl + gi * 2048 + 16) = (u32x4){pk2(a[8], a[9]), pk2(a[10], a[11]), pk2(a[12], a[13]), pk2(a[14], a[15])};
            }
        }
        {
            const LruW& W = Wb;
            float s = cin_b;
            for (int gi = 3; gi >= 0; --gi) {
                bf16_t grc[16];
#pragma unroll
                for (int t = 0; t < 16; ++t) grc[t] = grn[t];
                if (gi > 0) {
#pragma unroll
                    for (int t = 0; t < 16; ++t) grn[t] = grp[(size_t)((gi - 1) * 64 + t) * LW]; }
                float a[16], uu[16];
#pragma unroll
                for (int tau = 0; tau < 4; ++tau) { f32x4 pr, pi, xct; lru_tile_lds(tile, xcl, gi, tau, W, fr, fq, pr, pi, xct);
#pragma unroll
                    for (int j = 0; j < 4; ++j) lru_gate<LDBG>(pr[j], pi[j], xct[j], W, c_last && gi == 3 && fq == 3 && tau == 3 && j == 3, a[4 * tau + j], uu[4 * tau + j]); }
                float p = 1.f, h = 0.f;
#pragma unroll
                for (int t = 15; t >= 0; --t) { h = a[t] * h + uu[t]; p *= a[t]; }
                float hin = s, sg = s;
#pragma unroll
                for (int qq = 3; qq >= 0; --qq) { const float P = __shfl(p, fr + 16 * qq), H = __shfl(h, fr + 16 * qq); sg = P * sg + H; if (qq > fq) hin = P * hin + H; }
                s = sg;
                float hh = hin;
                const u32x4 hf0 = *(const LAS u32x4*)(hfl + gi * 2048), hf1 = *(const LAS u32x4*)(hfl + gi * 2048 + 16);
                const unsigned hfw[8] = {hf0.x, hf0.y, hf0.z, hf0.w, hf1.x, hf1.y, hf1.z, hf1.w};
#pragma unroll
                for (int t = 15; t >= 0; --t) { hh = a[t] * hh + uu[t];
                    outp[(size_t)(gi * 64 + t) * LW] = (bf16_t)f2bf((((t & 1) ? bfhi(hfw[t >> 1]) : bflo(hfw[t >> 1])) + hh) * gelu_tanh(bf1(grc[t]))); }
            }
        }
        LDS_WAIT(); __builtin_amdgcn_s_barrier();
    }
}

constexpr int HQW_EARLY = 96 * (D / 32);
__device__ __forceinline__ void hq_wtiles(Frame& F, int lo, int hi, int first, int stride) {
    const int lane = opaque(F.tid) & 63;
    LAS float* scr = (LAS float*)(F.lds + F.wave * 8448);
    for (int it = lo + first; it < hi; it += stride)
        had_tile_quant(F.in_WFD, D, DFF, 64 * (it / (D / 32)), 32 * (it % (D / 32)), wsp<signed char>(F, WS_WD), (const unsigned*)(F.ws + WS_AM), wsp<float>(F, WS_CS) + CS_D, scr, lane);
}
__device__ __forceinline__ void hq_phase(Frame& F) {
    const int lane = opaque(F.tid) & 63;
    const bf16_t* H0 = (const bf16_t*)F.out; const bf16_t* H1 = wsp<bf16_t>(F, WS_HIDS);
    signed char* Q0 = wsp<signed char>(F, WS_H8P); signed char* Q1 = wsp<signed char>(F, WS_H8S); float* RS3 = wsp<float>(F, WS_RS3);
    hq_wtiles(F, HQW_EARLY, (DFF / 64) * (D / 32), F.gw, F.ngw);
    constexpr int NB = DFF / 32;
    for (int m = F.gw; m < L; m += F.ngw) {
        const bf16_t* src = m < LP ? H0 + (size_t)m * DFF : H1 + (size_t)(m - LP) * DFF;
        signed char* dst = m < LP ? Q0 + (size_t)m * DFF : Q1 + (size_t)(m - LP) * DFF;
        u32x4 raw[6][4];
#pragma unroll
        for (int it = 0; it < 6; ++it) { const int b = lane + 64 * it; const u32x4* p = (const u32x4*)(src + (b < NB ? b : lane) * 32);
#pragma unroll
            for (int i = 0; i < 4; ++i) raw[it][i] = p[i]; }
        float mx = 0.f;
#pragma unroll
        for (int it = 0; it < 6; ++it) { float v[32];
#pragma unroll
            for (int i = 0; i < 4; ++i) { const u32x4 u = raw[it][i]; v[8 * i + 0] = bflo(u.x); v[8 * i + 1] = bfhi(u.x); v[8 * i + 2] = bflo(u.y); v[8 * i + 3] = bfhi(u.y); v[8 * i + 4] = bflo(u.z); v[8 * i + 5] = bfhi(u.z); v[8 * i + 6] = bflo(u.w); v[8 * i + 7] = bfhi(u.w); }
            fwht32(v);
            float bm = 0.f;
#pragma unroll
            for (int i = 0; i < 32; ++i) bm = fmaxf(bm, fabsf(v[i]));
            mx = fmaxf(mx, (lane + 64 * it < NB) ? bm : 0.f); }
        const float amax = fmaxf(wave_max(mx), 1e-20f), inv = 127.0f / amax;
        if (lane == 0) RS3[m] = amax * (1.0f / 127.0f);
#pragma unroll
        for (int it = 0; it < 6; ++it) { const int b = lane + 64 * it; float v[32];
#pragma unroll
            for (int i = 0; i < 4; ++i) { const u32x4 u = raw[it][i]; v[8 * i + 0] = bflo(u.x); v[8 * i + 1] = bfhi(u.x); v[8 * i + 2] = bflo(u.y); v[8 * i + 3] = bfhi(u.y); v[8 * i + 4] = bflo(u.z); v[8 * i + 5] = bfhi(u.z); v[8 * i + 6] = bflo(u.w); v[8 * i + 7] = bfhi(u.w); }
            fwht32(v);
            u32x4 o0, o1;
            o0.x = pk4_i8(rintf(v[0] * inv), rintf(v[1] * inv), rintf(v[2] * inv), rintf(v[3] * inv)); o0.y = pk4_i8(rintf(v[4] * inv), rintf(v[5] * inv), rintf(v[6] * inv), rintf(v[7] * inv));
            o0.z = pk4_i8(rintf(v[8] * inv), rintf(v[9] * inv), rintf(v[10] * inv), rintf(v[11] * inv)); o0.w = pk4_i8(rintf(v[12] * inv), rintf(v[13] * inv), rintf(v[14] * inv), rintf(v[15] * inv));
            o1.x = pk4_i8(rintf(v[16] * inv), rintf(v[17] * inv), rintf(v[18] * inv), rintf(v[19] * inv)); o1.y = pk4_i8(rintf(v[20] * inv), rintf(v[21] * inv), rintf(v[22] * inv), rintf(v[23] * inv));
            o1.z = pk4_i8(rintf(v[24] * inv), rintf(v[25] * inv), rintf(v[26] * inv), rintf(v[27] * inv)); o1.w = pk4_i8(rintf(v[28] * inv), rintf(v[29] * inv), rintf(v[30] * inv), rintf(v[31] * inv));
            if (b < NB) { *(u32x4*)(dst + b * 32) = o0; *(u32x4*)(dst + b * 32 + 16) = o1; } }
    }
}

__device__ __forceinline__ f32x4 up4(const u32x2 u) { return (f32x4){bflo(u.x), bfhi(u.x), bflo(u.y), bfhi(u.y)}; }
__device__ __forceinline__ void mid_phase(Frame& F) {
    const int tid_ = opaque(F.tid);
    bf16_t* MIX = wsp<bf16_t>(F, WS_MIX); signed char* XN8 = wsp<signed char>(F, WS_XN8); float* RS2 = wsp<float>(F, WS_RS2);
    LAS f32x4* gpost = (LAS f32x4*)F.lds; LAS f32x4* gpre = gpost + D / 4;
    for (int i = tid_; i < D / 4; i += NTHR) { gpost[i] = ((const f32x4*)F.in_GMPOST)[i]; gpre[i] = ((const f32x4*)F.in_GFPRE)[i]; }
    __syncthreads();
    for (int m = F.gw; m < L; m += F.ngw) {
        asm volatile("" ::: "memory");
        const f32x4* xr = (const f32x4*)xrow(F, m) + F.lane; const u32x2* mr = (const u32x2*)(MIX + (size_t)m * D) + F.lane;
        f32x4 v[16]; u32x2 mx[16]; float s = 0.f;
#pragma unroll
        for (int j = 0; j < 16; ++j) { v[j] = xr[64 * j]; mx[j] = mr[64 * j]; const f32x4 a = up4(mx[j]); s += (a.x * a.x + a.y * a.y) + (a.z * a.z + a.w * a.w); }
        const float rstd1 = 1.0f / sqrtf(wave_sum(s) * (1.0f / D) + EPS);
        float s2 = 0.f;
#pragma unroll
        for (int j = 0; j < 16; ++j) { v[j] = v[j] + up4(mx[j]) * rstd1 * gpost[F.lane + 64 * j]; s2 += (v[j].x * v[j].x + v[j].y * v[j].y) + (v[j].z * v[j].z + v[j].w * v[j].w); }
        const float rstd2 = 1.0f / sqrtf(wave_sum(s2) * (1.0f / D) + EPS);
        { u32x2* xw = (u32x2*)(MIX + (size_t)m * D) + F.lane;
#pragma unroll
          for (int j = 0; j < 16; ++j) xw[64 * j] = (u32x2){pk2(v[j].x, v[j].y), pk2(v[j].z, v[j].w)}; }
        float mx2 = 0.f;
#pragma unroll
        for (int j = 0; j < 16; ++j) { v[j] = v[j] * rstd2 * gpre[F.lane + 64 * j]; mx2 = fmaxf(fmaxf(mx2, fmaxf(fabsf(v[j].x), fabsf(v[j].y))), fmaxf(fabsf(v[j].z), fabsf(v[j].w))); }
        const float amax = fmaxf(wave_max(mx2), 1e-20f), inv = 127.0f / amax;
        if (F.lane == 0) RS2[m] = amax * (1.0f / 127.0f);
        unsigned* o4 = (unsigned*)(XN8 + (size_t)m * D) + F.lane;
#pragma unroll
        for (int j = 0; j < 16; ++j) o4[64 * j] = pk4_i8(rintf(v[j].x * inv), rintf(v[j].y * inv), rintf(v[j].z * inv), rintf(v[j].w * inv));
    }
    __syncthreads();
}
__device__ __forceinline__ void final_phase(Frame& F) {
    const int tid_ = opaque(F.tid);
    const bf16_t* X1 = wsp<bf16_t>(F, WS_MIX); const bf16_t* FB = wsp<bf16_t>(F, WS_F);
    LAS f32x4* gfp = (LAS f32x4*)F.lds;
    for (int i = tid_; i < D / 4; i += NTHR) gfp[i] = ((const f32x4*)F.in_GFPOST)[i];
    __syncthreads();
    for (int m = F.gw; m < L; m += F.ngw) {
        asm volatile("" ::: "memory");
        const u32x2* mr = (const u32x2*)(X1 + (size_t)m * D) + F.lane; const u32x2* fr = (const u32x2*)(FB + (size_t)m * D) + F.lane;
        u32x2 fx[16], x1[16]; float s = 0.f;
#pragma unroll
        for (int j = 0; j < 16; ++j) { fx[j] = fr[64 * j]; x1[j] = mr[64 * j]; const f32x4 a = up4(fx[j]); s += (a.x * a.x + a.y * a.y) + (a.z * a.z + a.w * a.w); }
        const float rstd3 = 1.0f / sqrtf(wave_sum(s) * (1.0f / D) + EPS);
        f32x4* o = (f32x4*)(F.out + (size_t)m * D) + F.lane;
#pragma unroll
        for (int j = 0; j < 16; ++j) o[64 * j] = up4(x1[j]) + up4(fx[j]) * rstd3 * gfp[F.lane + 64 * j];
    }
}

constexpr int LDS_STAGE = pg8::STAGE_BYTES;
constexpr int LDS_MISC = LDS_STAGE;
constexpr int LDS_BYTES = LDS_STAGE + 1024;
#ifndef MK_N_LAUNCHES
#define MK_N_LAUNCHES 1
#endif
constexpr int NPHASE = 12;
struct Args { const float* in[23]; float* out; unsigned char* ws; int ph_lo, ph_hi; };

__global__ void __launch_bounds__(NTHR, 2) fwd_kernel(Args args) {
    extern __shared__ __attribute__((aligned(16))) unsigned char lds_raw[];
    Frame F;
    F.lds = (LAS unsigned char*)lds_raw;
    F.tid = threadIdx.x; F.lane = (int)__builtin_amdgcn_mbcnt_hi(~0u, __builtin_amdgcn_mbcnt_lo(~0u, 0u)); F.wave = __builtin_amdgcn_readfirstlane(F.tid >> 6);
    F.G = gridDim.x; F.gw = blockIdx.x * NWAVES + F.wave; F.ngw = F.G * NWAVES;
    F.in_XP = args.in[0]; F.in_XS = args.in[1]; F.in_WIN = args.in[2]; F.in_WCONV = args.in[3]; F.in_BCONV = args.in[4]; F.in_WR = args.in[5]; F.in_BR = args.in[6]; F.in_WI = args.in[7]; F.in_BI = args.in[8]; F.in_LAM = args.in[9]; F.in_RPB = args.in[10]; F.in_WNO = args.in[11]; F.in_WLO = args.in[12]; F.in_WM = args.in[13]; F.in_BM = args.in[14]; F.in_WOUT = args.in[15]; F.in_GMPRE = args.in[16]; F.in_GMPOST = args.in[17]; F.in_GFPRE = args.in[18]; F.in_GFPOST = args.in[19]; F.in_WFG = args.in[20]; F.in_WFU = args.in[21]; F.in_WFD = args.in[22];
    F.out = args.out; F.ws = args.ws;
    volatile LAS unsigned* MISC = (volatile LAS unsigned*)(F.lds + LDS_MISC);
    if (F.tid < 256) MISC[F.tid] = 0u;
    __syncthreads();
    const int lo = args.ph_lo, hi = args.ph_hi;
    const bool fused = (hi - lo) > 1;
    XcdBarrier bar; bar.bar = (unsigned*)(F.ws + WS_CTL); bar.x = 0; bar.st = nullptr;
    if (fused) bar = xcd_barrier_post((unsigned*)(F.ws + WS_CTL), MISC + 8);
#ifndef PH_MASK
#define PH_MASK 0xfff
#endif
#define IN(k) (((PH_MASK >> (k)) & 1) && lo <= (k) && (k) < hi)
#define SEAM(k) do { if (IN(k) && IN((k) + 1)) xcd_barrier(bar); } while (0)
    LAS unsigned char* stage = F.lds;

#ifdef ATTN_OUT_OFF
#define NA_BUF ((size_t)ATTN_OUT_OFF * MiB)
#else
#define NA_BUF WS_Q
#endif
#ifndef DUP_MASK
#define DUP_MASK 0
#endif
#define RUN(k, ...) if (IN(k)) { __VA_ARGS__ if (((DUP_MASK) >> (k)) & 1) { __VA_ARGS__ } }
    RUN(0, { p0_prologue(F); }) SEAM(0);
    RUN(1, {
        { pg8::Gemm g{wsp<bf16_t>(F, WS_XN8), wsp<bf16_t>(F, WS_XN8), 1 << 30, wsp<bf16_t>(F, WS_W8), L, 2 * NAW + 2 * D, D}; pg8::StaticOrder S; S.init(L, 2 * NAW + 2 * D, F.G, (int)blockIdx.x);
          pg8::EpiProjQ E{wsp<bf16_t>(F, WS_Q), wsp<bf16_t>(F, WS_K), (bf16_t*)F.out, F.in_BM, wsp<float>(F, WS_RS1), wsp<float>(F, WS_CS) + CS_QKM};
          pg8::gemm_phase<pg8::EpiProjQ, pg8::StaticOrder, true, true, 2>(stage, g, S, E); }
        { pg8::Gemm g{wsp<bf16_t>(F, WS_XN), wsp<bf16_t>(F, WS_XN), 1 << 30, wsp<bf16_t>(F, WS_WCAT), L, 2 * NAW, 2 * D}; pg8::StaticOrder S; S.init(L, 2 * NAW, F.G, (int)blockIdx.x);
          pg8::EpiProj E{wsp<bf16_t>(F, WS_XR), wsp<bf16_t>(F, WS_GR), wsp<bf16_t>(F, WS_GR), wsp<bf16_t>(F, WS_GR), (bf16_t*)F.out, F.in_BM, 1 << 30};
          pg8::gemm_phase<pg8::EpiProj, pg8::StaticOrder, true, true, 0>(stage, g, S, E); }
        { pg8::Gemm g{wsp<bf16_t>(F, WS_WVT), wsp<bf16_t>(F, WS_WVT), 1 << 30, wsp<bf16_t>(F, WS_XN8), NAW, L, D}; pg8::StaticOrder S; S.init(NAW, L, F.G, (int)blockIdx.x);
          pg8::EpiVTQ E{wsp<bf16_t>(F, WS_VT), wsp<float>(F, WS_CS) + CS_V, wsp<float>(F, WS_RS1)};
          pg8::gemm_phase<pg8::EpiVTQ, pg8::StaticOrder, true, true, 2>(stage, g, S, E); }
    }) SEAM(1);
    RUN(2, { lru_pass_a(F); }) SEAM(2);
    #ifdef ATTN_OUT_OFF
    if (IN(3)) { lru_pass_b(F); } SEAM(3);
    if (IN(4)) { lru_pass_c<0>(F); xcd_barrier(bar); if (ATTN_DUP) attn_mfma<ATTN_DUP - 1>(F); attn_mfma<0>(F); } SEAM(4);
#else
    if (IN(3)) { lru_pass_b(F); attn_mfma_lds(F); } SEAM(3);
#ifdef LRUC_DBG
    if (IN(4)) { lru_pass_c<LRUC_DBG>(F); lru_pass_c<0>(F); } SEAM(4);
#else
    RUN(4, { lru_pass_c<0>(F); }) SEAM(4);
#endif
#endif
    if (IN(5)) {
        { pg8::Gemm g{wsp<bf16_t>(F, NA_BUF), wsp<bf16_t>(F, NA_BUF), 1 << 30, wsp<bf16_t>(F, WS_WNO), L, D, 2 * NAW}; pg8::StaticOrder S; S.init(L, D, F.G, (int)blockIdx.x);
          pg8::EpiMulG<false> E{wsp<bf16_t>(F, WS_T1), (const bf16_t*)F.out, 0};
          pg8::gemm_phase<pg8::EpiMulG<false>, pg8::StaticOrder, true, true>(stage, g, S, E); }
        { pg8::Gemm g{wsp<bf16_t>(F, WS_XR), wsp<bf16_t>(F, WS_XR), 1 << 30, wsp<bf16_t>(F, WS_WLO), L, D, 2 * LW}; pg8::StaticOrder S; S.init(L, D, F.G, (int)blockIdx.x);
          pg8::EpiMulG<true> E{wsp<bf16_t>(F, WS_T1), (const bf16_t*)F.out, D};
          pg8::gemm_phase<pg8::EpiMulG<true>, pg8::StaticOrder, true, true>(stage, g, S, E); }
    } SEAM(5);
    RUN(6, {
        pg8::Gemm g{wsp<bf16_t>(F, WS_T1), wsp<bf16_t>(F, WS_T1), 1 << 30, wsp<bf16_t>(F, WS_WO), L, D, 2 * D}; pg8::StaticOrder S; S.init(L, D, F.G, (int)blockIdx.x);
        pg8::EpiPlain E{wsp<bf16_t>(F, WS_MIX), D};
        pg8::gemm_phase<pg8::EpiPlain, pg8::StaticOrder, true, true>(stage, g, S, E);
    }) SEAM(6);
    RUN(7, { mid_phase(F); }) SEAM(7);
    RUN(8, {
        pg8::Gemm g{wsp<bf16_t>(F, WS_XN8), wsp<bf16_t>(F, WS_XN8), 1 << 30, wsp<bf16_t>(F, WS_WGU), L, 2 * DFF, D}; pg8::StaticOrder S; S.init(L, 2 * DFF, F.G, (int)blockIdx.x);
        pg8::EpiSwigluQ E{(bf16_t*)F.out, wsp<bf16_t>(F, WS_HIDS), LP / 256, wsp<float>(F, WS_RS2), wsp<float>(F, WS_CS) + CS_GU};
        pg8::gemm_phase<pg8::EpiSwigluQ, pg8::StaticOrder, true, true, 2>(stage, g, S, E);
        { const int rem = S.nwg % F.G;
          if ((int)blockIdx.x >= rem) hq_wtiles(F, 0, HQW_EARLY, ((int)blockIdx.x - rem) * NWAVES + F.wave, (F.G - rem) * NWAVES); }
    }) SEAM(8);
    RUN(9, { hq_phase(F); }) SEAM(9);
    RUN(10, {
        pg8::Gemm g{wsp<bf16_t>(F, WS_H8P), wsp<bf16_t>(F, WS_H8S), LP / 256, wsp<bf16_t>(F, WS_WD), L, D, DFF}; pg8::StaticOrder S; S.init(L, D, F.G, (int)blockIdx.x);
        pg8::EpiPlainQ E{wsp<bf16_t>(F, WS_F), D, wsp<float>(F, WS_RS3), wsp<float>(F, WS_CS) + CS_D};
        pg8::gemm_phase<pg8::EpiPlainQ, pg8::StaticOrder, true, true, 2>(stage, g, S, E);
    }) SEAM(10);
    RUN(11, { final_phase(F); })
#undef RUN
#undef IN
#undef SEAM
}

extern "C" void kernel_launch(void* const* d_in, const int* in_sizes, int n_in, void* d_out, int out_size, void* d_ws, size_t ws_size, hipStream_t stream) {
    static int grid = 0;
    if (grid == 0) {
        if (n_in != 23 || in_sizes[0] != LP * D || in_sizes[1] != LS * D || out_size != L * D || ws_size < WS_END) {
            fprintf(stderr, "kernel_launch: unexpected shapes: n_in %d in0 %d out %d ws %zu (need %zu)\n", n_in, n_in > 0 ? in_sizes[0] : -1, out_size, ws_size, (size_t)WS_END); grid = -1; return; }
        int dev = 0, cus = 0, per_cu = 0;
        if (hipGetDevice(&dev) != hipSuccess || hipDeviceGetAttribute(&cus, hipDeviceAttributeMultiprocessorCount, dev) != hipSuccess) { grid = -1; return; }
        if (hipFuncSetAttribute((const void*)fwd_kernel, hipFuncAttributeMaxDynamicSharedMemorySize, LDS_BYTES) != hipSuccess) { fprintf(stderr, "kernel_launch: hipFuncSetAttribute failed\n"); grid = -1; return; }
        if (hipOccupancyMaxActiveBlocksPerMultiprocessor(&per_cu, (const void*)fwd_kernel, NTHR, LDS_BYTES) != hipSuccess || per_cu < 1) { fprintf(stderr, "kernel_launch: occupancy query says %d\n", per_cu); }
        (void)hipGetLastError();
        grid = cus;
    }
    if (grid < 0) return;
    (void)hipMemsetAsync((char*)d_ws + WS_CTL, 0, CTL_ZERO_BYTES, stream);
#ifdef DBG_ZERO_ALL
    (void)hipMemsetAsync((char*)d_ws, 0, WS_END, stream); (void)hipMemsetAsync((char*)d_out, 0, (size_t)L * D * 4, stream);
#endif
    Args a{};
    for (int i = 0; i < 23; ++i) a.in[i] = (const float*)d_in[i];
    a.out = (float*)d_out; a.ws = (unsigned char*)d_ws;
#if MK_N_LAUNCHES == 1
    a.ph_lo = 0; a.ph_hi = NPHASE;
    hipLaunchKernelGGL(fwd_kernel, dim3(grid), dim3(NTHR), LDS_BYTES, stream, a);
#else
    for (int p = 0; p < NPHASE; ++p) {
#ifdef DBG_PH_MASK
        if (!((DBG_PH_MASK >> p) & 1)) continue;
#endif
        a.ph_lo = p; a.ph_hi = p + 1; hipLaunchKernelGGL(fwd_kernel, dim3(grid), dim3(NTHR), LDS_BYTES, stream, a); }
#endif
}
```
